# Optimizing an MI355X kernel written in HIP

```python
import math
import jax, jax.numpy as jnp
from jax import lax
import numpy as np

D_MODEL = 1024
BATCH = 1
SEQ = 16384
DEPTH = 4

GRID_W = 64
CTX_LEN = 256
EPS = 1e-6

N_BRANCH = 3
BRANCH_WIDTH = 512

S5_WIDTH = BRANCH_WIDTH
S5_GROUP_CH = 16
S5_GROUPS = S5_WIDTH // S5_GROUP_CH
S5_STATE = 64
S5_DT_MIN = 1e-3
S5_DT_MAX = 1e-1

SSD_WIDTH = BRANCH_WIDTH
SSD_HEAD_DIM = 64
SSD_HEADS = SSD_WIDTH // SSD_HEAD_DIM
SSD_GROUPS = 2
SSD_STATE = 128
SSD_CONV = 5
SSD_CHUNK = 128
SSD_CONV_CH = SSD_WIDTH + 2 * SSD_GROUPS * SSD_STATE

ATTN_HEADS = 8
ATTN_KV_HEADS = 2
ATTN_HEAD_DIM = 64
ATTN_WIDTH = ATTN_HEADS * ATTN_HEAD_DIM
ATTN_WINDOW = 128
ATTN_BLOCK = 128
ROPE_BASE = 10000.0

IN_SIZES = (S5_WIDTH, SSD_WIDTH, SSD_CONV_CH, 2 * SSD_HEADS, ATTN_WIDTH,
            ATTN_KV_HEADS * ATTN_HEAD_DIM, ATTN_KV_HEADS * ATTN_HEAD_DIM, N_BRANCH * D_MODEL)
IN_WIDTH = sum(IN_SIZES)

N_EXPERTS = 16
EXPERT_FF = 1024
EC_CAPACITY_FACTOR = 2

kernel_name = "hybrid_s5_ssd_swa_ec_dit"

F32 = jnp.float32


def rmsnorm(x, g):
    xf = x.astype(F32)
    y = xf * lax.rsqrt(jnp.mean(xf * xf, axis=-1, keepdims=True) + EPS)
    return (y * g.astype(F32)).astype(x.dtype)


def split_cols(t):
    out, start = [], 0
    for s in IN_SIZES:
        out.append(t[..., start:start + s])
        start += s
    return out


def cmul(ar, ai, br, bi):
    return ar * br - ai * bi, ar * bi + ai * br


def complex_affine_combine(e1, e2):
    a1r, a1i, b1r, b1i = e1
    a2r, a2i, b2r, b2i = e2
    ar, ai = cmul(a2r, a2i, a1r, a1i)
    tr, ti = cmul(a2r, a2i, b1r, b1i)
    return ar, ai, tr + b2r, ti + b2i


def s5_discretise(lam_re, lam_im, log_dt, b_re, b_im):
    lr, li = lam_re.astype(F32), lam_im.astype(F32)
    dt = jnp.exp(log_dt.astype(F32))[:, None]
    mag = jnp.exp(lr * dt)
    abr, abi = mag * jnp.cos(li * dt), mag * jnp.sin(li * dt)
    den = lr * lr + li * li
    fr = ((abr - 1.0) * lr + abi * li) / den
    fi = (abi * lr - (abr - 1.0) * li) / den
    bbr, bbi = cmul(fr[..., None], fi[..., None], b_re.astype(F32), b_im.astype(F32))
    return abr, abi, bbr, bbi


def s5_scan(u, abr, abi, bbr, bbi, h0, reverse):
    if reverse:
        u = jnp.flip(u, 1)
    bur = jnp.einsum('gpk,bngk->bngp', bbr, u)
    bui = jnp.einsum('gpk,bngk->bngp', bbi, u)
    ar = jnp.broadcast_to(abr, bur.shape)
    ai = jnp.broadcast_to(abi, bui.shape)
    acr, aci, hr, hi = lax.associative_scan(complex_affine_combine, (ar, ai, bur, bui), axis=1)
    if h0 is not None:
        tr, ti = cmul(acr, aci, h0[0][:, None], h0[1][:, None])
        hr, hi = hr + tr, hi + ti
    return hr, hi


def s5_readout(hr, hi, c_re, c_im, reverse):
    y = (jnp.einsum('gkp,bngp->bngk', c_re.astype(F32), hr)
         - jnp.einsum('gkp,bngp->bngk', c_im.astype(F32), hi))
    return jnp.flip(y, 1) if reverse else y


def s5_branch(u, uc, lam_re, lam_im, log_dt, b_re, b_im, c_re, c_im, d_skip, w_glu, b_glu, need_ctx_out):
    b, n, _ = u.shape
    nc = uc.shape[1]
    uf, ucf = u.astype(F32), uc.astype(F32)
    ug = uf.reshape(b, n, S5_GROUPS, S5_GROUP_CH)
    ugc = ucf.reshape(b, nc, S5_GROUPS, S5_GROUP_CH)
    ys, ycs = [], []
    for direction in range(2):
        rev = direction == 1
        abr, abi, bbr, bbi = s5_discretise(lam_re[direction], lam_im[direction], log_dt[direction],
                                           b_re[direction], b_im[direction])
        hcr, hci = s5_scan(ugc, abr, abi, bbr, bbi, None, rev)
        hr, hi = s5_scan(ug, abr, abi, bbr, bbi, (hcr[:, -1], hci[:, -1]), rev)
        ys.append(s5_readout(hr, hi, c_re[direction], c_im[direction], rev))
        if need_ctx_out:
            ycs.append(s5_readout(hcr, hci, c_re[direction], c_im[direction], rev))
    d = d_skip.astype(F32)

    def glu(yg, uu):
        yy = yg.reshape(uu.shape) + d * uu
        a = jax.nn.gelu(yy)
        return (a * jax.nn.sigmoid(a @ w_glu.astype(F32) + b_glu.astype(F32))).astype(u.dtype)

    y = glu(ys[0] + ys[1], uf)
    yc = glu(ycs[0] + ycs[1], ucf) if need_ctx_out else None
    return y, yc


def dwconv_centred(x, w, bias):
    k = w.shape[0]
    y = lax.conv_general_dilated(x, w[:, None, :], window_strides=(1,), padding=[(k // 2, k // 2)],
                                 dimension_numbers=('NWC', 'WIO', 'NWC'), feature_group_count=x.shape[-1])
    return y + bias


def ssd_scan(x, dt, a, bm, cm, h0, reverse, need_y):
    if reverse:
        x, dt, bm, cm = (jnp.flip(t, 1) for t in (x, dt, bm, cm))
    b, n, h, p = x.shape
    g, nst = bm.shape[2], bm.shape[3]
    r = h // g
    q = SSD_CHUNK
    nch = n // q
    xc = x.reshape(b, nch, q, g, r, p)
    dtc = dt.reshape(b, nch, q, g, r)
    bc = bm.reshape(b, nch, q, g, nst)
    cc = cm.reshape(b, nch, q, g, nst)
    acum = jnp.cumsum(dtc * a.reshape(g, r), axis=2)
    decay_to_end = jnp.exp(acum[:, :, -1:] - acum)
    states = jnp.einsum('bcjgn,bcjgrp->bcgrpn', bc, (decay_to_end * dtc)[..., None] * xc)
    chunk_decay = jnp.exp(acum[:, :, -1])
    if h0 is None:
        h0 = jnp.zeros((b, g, r, p, nst), F32)

    def step(hc, inp):
        s, dec = inp
        return hc * dec[..., None, None] + s, hc

    h_final, h_in = lax.scan(step, h0, (jnp.moveaxis(states, 1, 0), jnp.moveaxis(chunk_decay, 1, 0)))
    if not need_y:
        return None, h_final
    h_in = jnp.moveaxis(h_in, 0, 1)
    causal = jnp.tril(jnp.ones((q, q), bool))
    seg = acum[:, :, :, None] - acum[:, :, None, :]
    lmat = jnp.exp(jnp.where(causal[:, :, None, None], seg, -jnp.inf))
    cb = jnp.einsum('bcign,bcjgn->bcijg', cc, bc)
    wts = cb[..., None] * lmat * dtc[:, :, None]
    y = jnp.einsum('bcijgr,bcjgrp->bcigrp', wts, xc)
    y = y + jnp.einsum('bcign,bcgrpn->bcigrp', cc, h_in) * jnp.exp(acum)[..., None]
    y = y.reshape(b, n, h, p)
    if reverse:
        y = jnp.flip(y, 1)
    return y, h_final


def ssd_branch(z, xbc, dtr, zc, xbcc, dtrc, conv_w, conv_b, a_log, dt_bias, d_skip, norm_g, need_ctx_out):
    a = -jnp.exp(a_log.astype(F32))

    def prep(xbc_, dtr_):
        t = jax.nn.silu(dwconv_centred(xbc_, conv_w, conv_b)).astype(F32)
        b, n, _ = t.shape
        o1 = SSD_WIDTH
        o2 = SSD_WIDTH + SSD_GROUPS * SSD_STATE
        xs = t[..., :o1].reshape(b, n, SSD_HEADS, SSD_HEAD_DIM)
        bm = t[..., o1:o2].reshape(b, n, SSD_GROUPS, SSD_STATE)
        cm = t[..., o2:].reshape(b, n, SSD_GROUPS, SSD_STATE)
        dt = jax.nn.softplus(dtr_.astype(F32).reshape(b, n, 2, SSD_HEADS) + dt_bias.astype(F32))
        return xs, bm, cm, dt

    xs, bm, cm, dt = prep(xbc, dtr)
    xsc, bmc, cmc, dtc = prep(xbcc, dtrc)
    d = d_skip.astype(F32)[:, None]
    y = d * xs
    yc = d * xsc if need_ctx_out else None
    for direction in range(2):
        rev = direction == 1
        y_ctx, h_ctx = ssd_scan(xsc, dtc[:, :, direction], a[direction], bmc, cmc, None, rev, need_ctx_out)
        y_lat, _ = ssd_scan(xs, dt[:, :, direction], a[direction], bm, cm, h_ctx, rev, True)
        y = y + y_lat
        if need_ctx_out:
            yc = yc + y_ctx

    def gated_norm(yy, zz):
        b, n = yy.shape[:2]
        return rmsnorm(yy.reshape(b, n, SSD_WIDTH) * jax.nn.silu(zz.astype(F32)), norm_g).astype(zz.dtype)

    return gated_norm(y, z), (gated_norm(yc, zc) if need_ctx_out else None)


def axial_rope_angles(n):
    rows = n // GRID_W
    row = jnp.repeat(jnp.arange(rows, dtype=F32), GRID_W)
    col = jnp.tile(jnp.arange(GRID_W, dtype=F32), rows)
    m = ATTN_HEAD_DIM // 4
    inv_freq = ROPE_BASE ** (-jnp.arange(m, dtype=F32) / m)
    return row[:, None] * inv_freq, col[:, None] * inv_freq


def rope_axis(x, ang):
    m = ang.shape[-1]
    cos, sin = jnp.cos(ang)[:, None, :], jnp.sin(ang)[:, None, :]
    x1, x2 = x[..., :m], x[..., m:]
    return jnp.concatenate([x1 * cos - x2 * sin, x2 * cos + x1 * sin], axis=-1)


def axial_rope(x, ang_r, ang_c):
    half = x.shape[-1] // 2
    return jnp.concatenate([rope_axis(x[..., :half], ang_r), rope_axis(x[..., half:], ang_c)], axis=-1)


def window_attention(q, k, v, kc, vc, sink):
    b, n, hk, r, dh = q.shape
    blk = ATTN_BLOCK
    nb = n // blk
    scale = dh ** -0.5
    qb = q.reshape(b, nb, blk, hk, r, dh)

    def band(t):
        tp = jnp.pad(t, ((0, 0), (blk, blk), (0, 0), (0, 0))).reshape(b, nb + 2, blk, hk, dh)
        return jnp.concatenate([tp[:, :-2], tp[:, 1:-1], tp[:, 2:]], axis=2)

    kw, vw = band(k), band(v)
    s_loc = jnp.einsum('bnqhrd,bnkhd->bnhrqk', qb, kw) * scale
    qi = jnp.arange(blk)
    kj = jnp.arange(3 * blk) - blk
    rel = jnp.abs(qi[:, None] - kj[None, :]) <= ATTN_WINDOW
    kpos = jnp.arange(nb)[:, None] * blk + kj[None, :]
    valid = (kpos >= 0) & (kpos < n)
    mask = rel[None] & valid[:, None, :]
    s_loc = jnp.where(mask[None, :, None, None], s_loc, -jnp.inf)
    s_ctx = jnp.einsum('bnqhrd,bkhd->bnhrqk', qb, kc) * scale
    s_sink = jnp.broadcast_to(sink[None, None, :, :, None, None], s_loc.shape[:-1] + (1,))
    p = jax.nn.softmax(jnp.concatenate([s_loc, s_ctx, s_sink], axis=-1), axis=-1)
    nk = 3 * blk
    o = (jnp.einsum('bnhrqk,bnkhd->bnqhrd', p[..., :nk], vw)
         + jnp.einsum('bnhrqk,bkhd->bnqhrd', p[..., nk:nk + kc.shape[1]], vc))
    return o.reshape(b, n, hk * r * dh)


def context_attention(qc, kc, vc, sink):
    b, nc, hk, r, dh = qc.shape
    s = jnp.einsum('bqhrd,bkhd->bhrqk', qc, kc) * dh ** -0.5
    s_sink = jnp.broadcast_to(sink[None, :, :, None, None], s.shape[:-1] + (1,))
    p = jax.nn.softmax(jnp.concatenate([s, s_sink], axis=-1), axis=-1)[..., :kc.shape[1]]
    return jnp.einsum('bhrqk,bkhd->bqhrd', p, vc).reshape(b, nc, hk * r * dh)


def attention_branch(q, k, v, qc, kc, vc, sink, need_ctx_out):
    b, n, _ = q.shape
    nc = kc.shape[1]
    hk, r, dh = ATTN_KV_HEADS, ATTN_HEADS // ATTN_KV_HEADS, ATTN_HEAD_DIM
    ang_r, ang_c = axial_rope_angles(n)
    qh = axial_rope(q.astype(F32).reshape(b, n, ATTN_HEADS, dh), ang_r, ang_c).reshape(b, n, hk, r, dh)
    kh = axial_rope(k.astype(F32).reshape(b, n, hk, dh), ang_r, ang_c)
    vh = v.astype(F32).reshape(b, n, hk, dh)
    kch = kc.astype(F32).reshape(b, nc, hk, dh)
    vch = vc.astype(F32).reshape(b, nc, hk, dh)
    sink_hr = sink.astype(F32).reshape(hk, r)
    y = window_attention(qh, kh, vh, kch, vch, sink_hr).astype(q.dtype)
    yc = None
    if need_ctx_out:
        qch = qc.astype(F32).reshape(b, nc, hk, r, dh)
        yc = context_attention(qch, kch, vch, sink_hr).astype(q.dtype)
    return y, yc


def mixing_sublayer(h, hc, w_in, lam_re, lam_im, log_dt, b_re, b_im, c_re, c_im, s5_d, w_glu, b_glu,
                    conv_w, conv_b, a_log, dt_bias, ssd_d, ssd_norm_g, sink, w_branch, w_out, need_ctx_out):
    u, z, xbc, dtr, q, k, v, gates = split_cols(h @ w_in)
    uc, zc, xbcc, dtrc, qc, kc, vc, gatesc = split_cols(hc @ w_in)
    ya, yac = s5_branch(u, uc, lam_re, lam_im, log_dt, b_re, b_im, c_re, c_im, s5_d, w_glu, b_glu, need_ctx_out)
    yb, ybc = ssd_branch(z, xbc, dtr, zc, xbcc, dtrc, conv_w, conv_b, a_log, dt_bias, ssd_d, ssd_norm_g,
                         need_ctx_out)
    yc_, ycc = attention_branch(q, k, v, qc, kc, vc, sink, need_ctx_out)

    def merge(y1, y2, y3, g):
        b, n = g.shape[:2]
        br = jnp.einsum('bnkc,kcd->bnkd', jnp.stack([y1, y2, y3], axis=2), w_branch)
        gate = jax.nn.sigmoid(g.reshape(b, n, N_BRANCH, D_MODEL).astype(F32)).astype(br.dtype)
        return jnp.einsum('bnkd,bnkd->bnd', gate, br) @ w_out

    out = merge(ya, yb, yc_, gates)
    outc = merge(yac, ybc, ycc, gatesc) if need_ctx_out else None
    return out, outc


def expert_choice_ffn(h, w_router, w_gate, w_up, w_down):
    b, n, d = h.shape
    cap = EC_CAPACITY_FACTOR * n // N_EXPERTS
    aff = jax.nn.softmax(jnp.einsum('bnd,de->bne', h, w_router).astype(F32), axis=-1)
    g, idx = lax.top_k(jnp.swapaxes(aff, 1, 2), cap)
    xe = jax.vmap(lambda hb, ib: hb[ib])(h, idx)
    hid = jax.nn.silu(jnp.einsum('becd,edf->becf', xe, w_gate)) * jnp.einsum('becd,edf->becf', xe, w_up)
    ye = jnp.einsum('becf,efd->becd', hid, w_down) * g[..., None].astype(h.dtype)

    def combine(ib, yb):
        return jnp.zeros((n, d), yb.dtype).at[ib.reshape(-1)].add(yb.reshape(-1, d))

    return jax.vmap(combine)(idx, ye)


def setup_inputs(seed: int = 0) -> dict:
    key = jax.random.key(seed)
    keys = iter(jax.random.split(key, 64))
    D = D_MODEL

    def normal(shape, scale):
        return jax.random.normal(next(keys), shape, F32) * scale

    def uniform(shape, lo, hi):
        return jax.random.uniform(next(keys), shape, F32, lo, hi)

    n_idx = jnp.arange(S5_STATE, dtype=F32)
    ssd_dt = jnp.exp(uniform((DEPTH, 2, SSD_HEADS), math.log(1e-3), math.log(1e-1)))
    s5_shape = (DEPTH, 2, S5_GROUPS, S5_STATE)
    return {
        "x": normal((BATCH, SEQ, D), 1.0),
        "c": normal((BATCH, D), 1.0),
        "ctx": normal((BATCH, CTX_LEN, D), 1.0),
        "c_ctx": normal((D,), 1.0),
        "w_mod": normal((DEPTH, D, 6 * D), 0.5 * D ** -0.5),
        "b_mod": normal((DEPTH, 6 * D), 0.01),
        "norm1_g": 1.0 + normal((DEPTH, D), 0.02),
        "norm2_g": 1.0 + normal((DEPTH, D), 0.02),
        "w_in": normal((DEPTH, D, IN_WIDTH), D ** -0.5),
        "s5_lam_re": -0.5 + normal(s5_shape, 0.01),
        "s5_lam_im": math.pi * n_idx + normal(s5_shape, 0.01),
        "s5_log_dt": uniform((DEPTH, 2, S5_GROUPS), math.log(S5_DT_MIN), math.log(S5_DT_MAX)),
        "s5_b_re": normal((DEPTH, 2, S5_GROUPS, S5_STATE, S5_GROUP_CH), (2 * S5_GROUP_CH) ** -0.5),
        "s5_b_im": normal((DEPTH, 2, S5_GROUPS, S5_STATE, S5_GROUP_CH), (2 * S5_GROUP_CH) ** -0.5),
        "s5_c_re": normal((DEPTH, 2, S5_GROUPS, S5_GROUP_CH, S5_STATE), S5_STATE ** -0.5),
        "s5_c_im": normal((DEPTH, 2, S5_GROUPS, S5_GROUP_CH, S5_STATE), S5_STATE ** -0.5),
        "s5_d": normal((DEPTH, S5_WIDTH), 0.5),
        "s5_w_glu": normal((DEPTH, S5_WIDTH, S5_WIDTH), S5_WIDTH ** -0.5),
        "s5_b_glu": normal((DEPTH, S5_WIDTH), 0.01),
        "ssd_conv_w": normal((DEPTH, SSD_CONV, SSD_CONV_CH), SSD_CONV ** -0.5),
        "ssd_conv_b": normal((DEPTH, SSD_CONV_CH), 0.01),
        "ssd_a_log": jnp.log(uniform((DEPTH, 2, SSD_HEADS), 1.0, 16.0)),
        "ssd_dt_bias": ssd_dt + jnp.log(-jnp.expm1(-ssd_dt)),
        "ssd_d": 1.0 + normal((DEPTH, SSD_HEADS), 0.1),
        "ssd_norm_g": 1.0 + normal((DEPTH, SSD_WIDTH), 0.02),
        "attn_sink": normal((DEPTH, ATTN_HEADS), 0.5),
        "w_branch": normal((DEPTH, N_BRANCH, BRANCH_WIDTH, D), BRANCH_WIDTH ** -0.5),
        "w_out": normal((DEPTH, D, D), D ** -0.5),
        "w_router": normal((DEPTH, D, N_EXPERTS), D ** -0.5),
        "w_e_gate": normal((DEPTH, N_EXPERTS, D, EXPERT_FF), D ** -0.5),
        "w_e_up": normal((DEPTH, N_EXPERTS, D, EXPERT_FF), D ** -0.5),
        "w_e_down": normal((DEPTH, N_EXPERTS, EXPERT_FF, D), EXPERT_FF ** -0.5),
        "final_norm_g": 1.0 + normal((D,), 0.02),
    }


def reference(x, c, ctx, c_ctx, w_mod, b_mod, norm1_g, norm2_g, w_in, s5_lam_re, s5_lam_im, s5_log_dt,
              s5_b_re, s5_b_im, s5_c_re, s5_c_im, s5_d, s5_w_glu, s5_b_glu, ssd_conv_w, ssd_conv_b,
              ssd_a_log, ssd_dt_bias, ssd_d, ssd_norm_g, attn_sink, w_branch, w_out, w_router,
              w_e_gate, w_e_up, w_e_down, final_norm_g):
    D = D_MODEL
    xc = ctx
    silu_c = jax.nn.silu(c)
    silu_cc = jax.nn.silu(c_ctx)
    for i in range(DEPTH):
        ctx_out = i < DEPTH - 1
        mod = silu_c @ w_mod[i] + b_mod[i]
        modc = silu_cc @ w_mod[i] + b_mod[i]
        sh1, sc1, g1, sh2, sc2, g2 = [mod[:, None, j * D:(j + 1) * D] for j in range(6)]
        csh1, csc1, cg1, csh2, csc2, cg2 = [modc[j * D:(j + 1) * D] for j in range(6)]

        h = rmsnorm(x, norm1_g[i]) * (1.0 + sc1) + sh1
        hc = rmsnorm(xc, norm1_g[i]) * (1.0 + csc1) + csh1
        mix, mixc = mixing_sublayer(
            h, hc, w_in[i], s5_lam_re[i], s5_lam_im[i], s5_log_dt[i], s5_b_re[i], s5_b_im[i],
            s5_c_re[i], s5_c_im[i], s5_d[i], s5_w_glu[i], s5_b_glu[i], ssd_conv_w[i], ssd_conv_b[i],
            ssd_a_log[i], ssd_dt_bias[i], ssd_d[i], ssd_norm_g[i], attn_sink[i], w_branch[i], w_out[i],
            ctx_out)
        x = x + g1 * mix
        h2 = rmsnorm(x, norm2_g[i]) * (1.0 + sc2) + sh2
        x = x + g2 * expert_choice_ffn(h2, w_router[i], w_e_gate[i], w_e_up[i], w_e_down[i])
        if ctx_out:
            xc = xc + cg1 * mixc
            hc2 = rmsnorm(xc, norm2_g[i]) * (1.0 + csc2) + csh2
            xc = xc + cg2 * expert_choice_ffn(hc2, w_router[i], w_e_gate[i], w_e_up[i], w_e_down[i])
    return rmsnorm(x, final_norm_g)
```

```cpp
#include <hip/hip_runtime.h>
#include <cstdio>
#include <cstdint>

#ifndef MK_PER_PHASE
#define MK_PER_PHASE 0
#endif

namespace pg8 {
#define PG8_LAS __attribute__((address_space(3)))
typedef unsigned short bf16_t;
typedef short bf16x8 __attribute__((ext_vector_type(8)));
typedef float f32x4 __attribute__((ext_vector_type(4)));
typedef unsigned u32x4 __attribute__((ext_vector_type(4)));
constexpr int BM = 256, BK = 64, HALF = 128, HTB = HALF * BK * 2  , STAGE_BYTES = 8 * HTB, NXCD = 8, WGM = 8;

__host__ __device__ __forceinline__ int lds_byte(int r, int c) { const int st = (r >> 4) * 2 + (c >> 5), rr = r & 15, cc = c & 31, ob = rr * 64 + cc * 2; return st * 1024 + (ob ^ (((ob >> 9) & 1) << 5)); }
__host__ __device__ __forceinline__ void stage_rc(int b, int& R, int& C) { const int st = b / 1024, sb = b % 1024, swz = sb ^ (((sb >> 9) & 1) << 5); R = (st >> 1) * 16 + swz / 64; C = (st & 1) * 32 + (swz % 64) / 2; }
__host__ __device__ __forceinline__ int perm32(int rho) { const int n = rho >> 4, i = rho & 15; return 8 * (i >> 2) + 4 * n + (i & 3); }

struct Unit { int pm, pn; };
struct Gemm { const bf16_t* A; const bf16_t* Bt; int M, N, K; };

struct StaticOrder {
    int nM, nN, nwg, G, c;
    __host__ __device__ void init(int M, int N, int G_, int c_) { nM = M / BM; nN = N / BM; nwg = nM * nN; G = G_; c = c_; }
    __host__ __device__ bool next(int i, Unit& u) const {
        const long L = (long)i * G + c; if (L >= nwg) return false;
        int wgid = (int)L; { const int q = nwg / NXCD, r = nwg % NXCD, xcd = wgid % NXCD, off = wgid / NXCD; wgid = (xcd < r ? xcd * (q + 1) : r * (q + 1) + (xcd - r) * q) + off; }
        const int nig = WGM * nN, gid = wgid / nig, fm = gid * WGM, gsz = (nM - fm) < WGM ? (nM - fm) : WGM;
        u.pm = fm + ((wgid % nig) % gsz); u.pn = (wgid % nig) / gsz; return true;
    }
    __device__ __forceinline__ void a_ready(const Unit&) const {}
    __device__ __forceinline__ void done(const Unit&) const {}
};
__device__ __forceinline__ unsigned cvt_pk_bf16(float lo, float hi) { unsigned r; asm volatile("v_cvt_pk_bf16_f32 %0, %1, %2" : "=v"(r) : "v"(lo), "v"(hi)); return r; }
template <class Epi, class Sched, bool STAMP = false>
__device__ __forceinline__ void gemm_phase(PG8_LAS unsigned char* lds, const Gemm g, const Sched& S, const Epi& E, unsigned long long* stamps) {
    int tid_l = threadIdx.x; asm volatile("" : "+v"(tid_l));
    const int tid = tid_l, wid = __builtin_amdgcn_readfirstlane(tid >> 6), lane = tid & 63, wr = wid >> 2, wc = wid & 3, fr = lane & 15, fq = lane >> 4;
    const int K = g.K, nt = K / BK;
    int ts_lo = 0, ts_hi = 0, nts = 0; const unsigned long long rt_entry = STAMP ? (unsigned long long)wall_clock64() : 0ull;
#define PG8_STAMP() do { if (STAMP && wid == 0 && nts < 64) { const unsigned long long _c = (unsigned long long)clock64(); \
        ts_lo = (lane == nts) ? (int)(unsigned)_c : ts_lo; ts_hi = (lane == nts) ? (int)(unsigned)(_c >> 32) : ts_hi; ++nts; } } while (0)
    PG8_STAMP();
    unsigned voffA[2], voffB[2];
#pragma unroll
    for (int i = 0; i < 2; ++i) { int R, C; stage_rc(tid * 16 + i * 8192, R, C); const int Rb = Epi::PERM ? ((R & ~31) + perm32(R & 31)) : R;
        voffA[i] = (unsigned)(R * K + C) * 2u; voffB[i] = (unsigned)(Rb * K + C) * 2u; }
    const size_t kstep = (size_t)(BK * 2);
    const size_t hstep = (size_t)HALF * K * 2;
    const size_t tstep = 2 * hstep;
    const unsigned ldsw = (unsigned)wid * 1024u;
    const int aoff = lds_byte(wr * 64 + fr, fq * 8), boff = lds_byte(wc * 32 + fr, fq * 8);
#define PG8_SA(b, h) (((b) * 2 + (h)) * HTB)
#define PG8_SB(b, h) ((4 + (b) * 2 + (h)) * HTB)
#define PG8_STAGE(bufoff, gbase, voff) do { _Pragma("unroll") for (int _i = 0; _i < 2; ++_i) \
        __builtin_amdgcn_global_load_lds((const unsigned*)((const char*)(gbase) + (voff)[_i]), (PG8_LAS unsigned*)(lds + (bufoff) + ldsw + _i * 8192), 16, 0, 0); } while (0)
#define PG8_LDA(dst, b, h) do { _Pragma("unroll") for (int m = 0; m < 4; ++m) _Pragma("unroll") for (int k = 0; k < 2; ++k) dst[m][k] = *(const PG8_LAS bf16x8*)(lds + PG8_SA(b, h) + aoff + m * 2048 + k * 1024); } while (0)
#define PG8_LDB(dst, b, h) do { _Pragma("unroll") for (int n = 0; n < 2; ++n) _Pragma("unroll") for (int k = 0; k < 2; ++k) dst[n][k] = *(const PG8_LAS bf16x8*)(lds + PG8_SB(b, h) + boff + n * 2048 + k * 1024); } while (0)
#define PG8_MMA(ai, bj, At, Bt) do { __builtin_amdgcn_s_setprio(1); _Pragma("unroll") for (int m = 0; m < 4; ++m) _Pragma("unroll") for (int n = 0; n < 2; ++n) _Pragma("unroll") for (int k = 0; k < 2; ++k) \
        acc[ai][bj][m][n] = __builtin_amdgcn_mfma_f32_16x16x32_bf16(Bt[n][k], At[m][k], acc[ai][bj][m][n], 0, 0, 0); __builtin_amdgcn_s_setprio(0); } while (0)
#define PG8_WAIT_V(n) asm volatile("s_waitcnt vmcnt(" #n ")" ::: "memory")
#define PG8_WAIT_L(n) asm volatile("s_waitcnt lgkmcnt(" #n ")" ::: "memory")
#define PG8_BAR __builtin_amdgcn_s_barrier()
#define PG8_SCHED __builtin_amdgcn_sched_barrier(0)
    Unit cur, nxt; int ui = 0;
    if (!S.next(0, cur)) return;
    f32x4 acc[2][2][4][2];
#pragma unroll
    for (int a = 0; a < 2; ++a)
#pragma unroll
        for (int b = 0; b < 2; ++b)
#pragma unroll
            for (int m = 0; m < 4; ++m)
#pragma unroll
                for (int n = 0; n < 2; ++n) acc[a][b][m][n] = (f32x4){0.f, 0.f, 0.f, 0.f};
    bf16x8 At[4][2], B0[2][2], B1[2][2];
    const char* cA = (const char*)g.A + (size_t)cur.pm * tstep; const char* cB = (const char*)g.Bt + (size_t)cur.pn * tstep;
    S.a_ready(cur);
    PG8_STAGE(PG8_SB(0, 0), cB, voffB); PG8_STAGE(PG8_SA(0, 0), cA, voffA); PG8_STAGE(PG8_SB(0, 1), cB + hstep, voffB); PG8_STAGE(PG8_SA(0, 1), cA + hstep, voffA);
    if (wr == 1) PG8_BAR;
    PG8_WAIT_V(4); PG8_BAR;
    PG8_STAGE(PG8_SB(1, 0), cB + kstep, voffB); PG8_STAGE(PG8_SA(1, 0), cA + kstep, voffA); PG8_STAGE(PG8_SB(1, 1), cB + hstep + kstep, voffB);
    PG8_WAIT_V(6); PG8_BAR;
    PG8_STAMP();
    for (;;) {
        const bool has_next = S.next(ui + 1, nxt);
        const char* nA = has_next ? (const char*)g.A + (size_t)nxt.pm * tstep : cA; const char* nB = has_next ? (const char*)g.Bt + (size_t)nxt.pn * tstep : cB;
        for (int t = 0; t < nt; t += 2) {
            const bool last = (t == nt - 2);
            const char* a1 = cA + (size_t)(t + 1) * kstep;
            const char* a2 = last ? nA : cA + (size_t)(t + 2) * kstep; const char* b2 = last ? nB : cB + (size_t)(t + 2) * kstep;
            const char* a3 = a2 + kstep; const char* b3 = b2 + kstep;
            if (last && has_next) S.a_ready(nxt);
            PG8_LDB(B0, 0, 0); PG8_SCHED; PG8_LDA(At, 0, 0); PG8_STAGE(PG8_SA(1, 1), a1 + hstep, voffA);
            PG8_WAIT_L(8); PG8_BAR; PG8_WAIT_L(0); PG8_MMA(0, 0, At, B0); PG8_BAR; PG8_SCHED;
            PG8_LDB(B1, 0, 1); PG8_STAGE(PG8_SB(0, 0), b2, voffB);
            PG8_BAR; PG8_WAIT_L(0); PG8_MMA(0, 1, At, B1); PG8_BAR;
            PG8_LDA(At, 0, 1); PG8_STAGE(PG8_SA(0, 0), a2, voffA);
            PG8_BAR; PG8_WAIT_L(0); PG8_MMA(1, 0, At, B0); PG8_BAR; PG8_SCHED;
            PG8_STAGE(PG8_SB(0, 1), b2 + hstep, voffB);
            PG8_WAIT_V(6); PG8_BAR; PG8_MMA(1, 1, At, B1); PG8_BAR;
            PG8_LDB(B0, 1, 0); PG8_SCHED; PG8_LDA(At, 1, 0); PG8_STAGE(PG8_SA(0, 1), a2 + hstep, voffA);
            PG8_WAIT_L(8); PG8_BAR; PG8_WAIT_L(0); PG8_MMA(0, 0, At, B0); PG8_BAR; PG8_SCHED;
            PG8_LDB(B1, 1, 1); PG8_STAGE(PG8_SB(1, 0), b3, voffB);
            PG8_BAR; PG8_WAIT_L(0); PG8_MMA(0, 1, At, B1); PG8_BAR;
            PG8_LDA(At, 1, 1); PG8_STAGE(PG8_SA(1, 0), a3, voffA);
            PG8_BAR; PG8_WAIT_L(0); PG8_MMA(1, 0, At, B0); PG8_BAR; PG8_SCHED;
            PG8_STAGE(PG8_SB(1, 1), b3 + hstep, voffB);
            PG8_WAIT_V(6); PG8_BAR; PG8_MMA(1, 1, At, B1); PG8_BAR;
        }
        PG8_STAMP();
        if constexpr (!Epi::AFTER_DRAIN) { E(acc, cur, wr, wc, fr, fq); S.done(cur); }
        PG8_STAMP();
        if (!has_next) break;
#pragma unroll
        for (int a = 0; a < 2; ++a)
#pragma unroll
            for (int b = 0; b < 2; ++b)
#pragma unroll
                for (int m = 0; m < 4; ++m)
#pragma unroll
                    for (int n = 0; n < 2; ++n) acc[a][b][m][n] = (f32x4){0.f, 0.f, 0.f, 0.f};
        cur = nxt; cA = nA; cB = nB; ++ui;
    }
    PG8_WAIT_V(0);
    if (wr == 0) PG8_BAR;
    PG8_BAR;
    if constexpr (Epi::AFTER_DRAIN) { E.fused(acc, cur, wr, wc, fr, fq, lds, wid, lane); S.done(cur); }
    PG8_STAMP();
    if (STAMP && wid == 0) { stamps[lane] = lane < nts ? (((unsigned long long)(unsigned)ts_hi << 32) | (unsigned)ts_lo) : 0ull;
        if (lane == 62) stamps[62] = rt_entry; if (lane == 63) stamps[63] = (unsigned long long)wall_clock64(); }
#undef PG8_STAMP
#undef PG8_SA
#undef PG8_SB
#undef PG8_STAGE
#undef PG8_LDA
#undef PG8_LDB
#undef PG8_MMA
#undef PG8_WAIT_V
#undef PG8_WAIT_L
#undef PG8_BAR
#undef PG8_SCHED
}
}

#define GAS __attribute__((address_space(1)))
#define LAS __attribute__((address_space(3)))
typedef unsigned short bf16;
typedef float f32x4 __attribute__((ext_vector_type(4)));
typedef unsigned u32x4 __attribute__((ext_vector_type(4)));
typedef unsigned u32x2 __attribute__((ext_vector_type(2)));

constexpr int D = 1024, NLAT = 16384, NCTX = 256, T = NLAT + NCTX, DEPTH = 4;
constexpr int IN_W = 5904, PJ = 5888;
constexpr int U0 = 0, Z0 = 512, XB0 = 1024, Q0 = 2048, K0 = 2560, V0 = 2688, GT0 = 2816;
constexpr int NE = 16, ESLOTS = 2304, CAP_L = 2048, CAP_C = 32;
constexpr int NCH = 130;
constexpr float EPS = 1e-6f;
constexpr int NWAVES = 8, NTHR = 512;
constexpr int LDS_BYTES = 155648;
constexpr int MISC_OFF = LDS_BYTES - 1024 + 512;
constexpr int NPH_LAYER = 13, NPHASES = 1 + DEPTH * NPH_LAYER + 1;

constexpr size_t al256(size_t x) { return (x + 255) & ~(size_t)255; }
constexpr size_t WS_CTL = 0, CTL_BYTES = 1u << 20;
constexpr size_t WS_MOD = WS_CTL + CTL_BYTES;
constexpr size_t WS_XC = al256(WS_MOD + (size_t)DEPTH * 2 * 6144 * 4);
constexpr size_t WS_WIN = al256(WS_XC + (size_t)NCTX * D * 4);
constexpr size_t WS_WGLU = al256(WS_WIN + (size_t)PJ * D * 2);
constexpr size_t WS_WBR = al256(WS_WGLU + (size_t)512 * 512 * 2);
constexpr size_t WS_WOUT = al256(WS_WBR + (size_t)3 * 1024 * 512 * 2);
constexpr size_t WS_WUP = al256(WS_WOUT + (size_t)1024 * 1024 * 2);
constexpr size_t WS_WDN = al256(WS_WUP + (size_t)NE * 2048 * 1024 * 2);
constexpr size_t WS_H = al256(WS_WDN + (size_t)NE * 1024 * 1024 * 2);
constexpr size_t WS_PROJ = al256(WS_H + (size_t)T * D * 2);
constexpr size_t WS_XE = WS_PROJ;
constexpr size_t WS_HID = al256(WS_XE + (size_t)NE * ESLOTS * D * 2);
constexpr size_t WS_DT = al256(WS_PROJ + (size_t)T * PJ * 2);
constexpr size_t WS_CV = al256(WS_DT + (size_t)T * 16 * 4);
constexpr size_t WS_S5E = al256(WS_CV + (size_t)T * 1024 * 2);
constexpr size_t WS_S5H = al256(WS_S5E + (size_t)2 * 32 * NCH * 128 * 4);
constexpr size_t WS_YD = al256(WS_S5H + (size_t)2 * 32 * NCH * 128 * 4);
constexpr size_t WS_SA = al256(WS_YD + (size_t)2 * T * 512 * 4);
constexpr size_t WS_Y3 = al256(WS_SA + (size_t)T * 512 * 2);
constexpr size_t WS_PM = al256(WS_Y3 + (size_t)3 * T * 512 * 2);
constexpr size_t WS_MB = al256(WS_PM + (size_t)T * D * 4);
constexpr size_t WS_YE = WS_PM;
constexpr size_t WS_AFFT = al256(WS_MB + (size_t)T * D * 2);
constexpr size_t WS_IDX = al256(WS_AFFT + (size_t)NE * T * 4);
constexpr size_t WS_GSEL = al256(WS_IDX + (size_t)NE * ESLOTS * 4);
constexpr size_t WS_INV = al256(WS_GSEL + (size_t)NE * ESLOTS * 4);
constexpr size_t WS_END = al256(WS_INV + (size_t)T * 16 * 4);
static_assert(WS_HID + (size_t)NE * ESLOTS * D * 2 <= WS_DT, "XE|HID overlay fits PROJ");
static_assert(WS_YE + (size_t)NE * ESLOTS * D * 2 <= WS_AFFT, "YE overlay fits PM|MB");
static_assert(WS_END < (size_t)1000 * 1024 * 1024, "workspace");
constexpr int CW_BAR = 4096;

__device__ __forceinline__ float bf2f(unsigned b) { return __uint_as_float(b << 16); }
__device__ __forceinline__ float bflo(unsigned w) { return __uint_as_float(w << 16); }
__device__ __forceinline__ float bfhi(unsigned w) { return __uint_as_float(w & 0xffff0000u); }
__device__ __forceinline__ unsigned f2bf(float f) { unsigned u = __float_as_uint(f); u += 0x7FFFu + ((u >> 16) & 1u); return u >> 16; }
__device__ __forceinline__ unsigned pk2(float lo, float hi) { return f2bf(lo) | (f2bf(hi) << 16); }
__device__ __forceinline__ float wsum(float v) {
#pragma unroll
    for (int o = 1; o < 64; o <<= 1) v += __shfl_xor(v, o);
    return v;
}
__device__ __forceinline__ float wmaxf(float v) {
#pragma unroll
    for (int o = 1; o < 64; o <<= 1) v = fmaxf(v, __shfl_xor(v, o));
    return v;
}
__device__ __forceinline__ float silu_f(float x) { return x / (1.f + expf(-x)); }
__device__ __forceinline__ float sigmoid_f(float x) { return 1.f / (1.f + expf(-x)); }
__device__ __forceinline__ float softplus_f(float x) { return x > 20.f ? x : log1pf(expf(x)); }
__device__ __forceinline__ float gelu_tanh_f(float x) { const float u = 0.7978845608028654f * (x + 0.044715f * x * x * x); return 0.5f * x * (1.f + tanhf(u)); }
#define LDS_FENCE() asm volatile("s_waitcnt lgkmcnt(0)" ::: "memory")
__device__ __forceinline__ int scan_row(int d, int s) { return d == 0 ? s : (s < NCTX ? (NCTX - 1 - s) : (T + NCTX - 1 - s)); }

namespace pg8 {
struct EpiStoreBf16 {
    static constexpr bool PERM = true, AFTER_DRAIN = false;
    bf16_t* O; int ldc;
    __device__ __forceinline__ void operator()(const f32x4 (&acc)[2][2][4][2], const Unit& u, int wr, int wc, int fr, int fq) const {
        const int row0 = u.pm * BM + wr * 64 + fr, col0 = u.pn * BM + wc * 32 + 8 * fq;
#pragma unroll
        for (int ai = 0; ai < 2; ++ai)
#pragma unroll
            for (int m = 0; m < 4; ++m) { bf16_t* rowp = O + (size_t)(row0 + ai * HALF + m * 16) * ldc + col0;
#pragma unroll
                for (int bj = 0; bj < 2; ++bj) { const f32x4 v0 = acc[ai][bj][m][0], v1 = acc[ai][bj][m][1];
                    u32x4 w; w.x = cvt_pk_bf16(v0[0], v0[1]); w.y = cvt_pk_bf16(v0[2], v0[3]); w.z = cvt_pk_bf16(v1[0], v1[1]); w.w = cvt_pk_bf16(v1[2], v1[3]);
                    *(u32x4*)(rowp + bj * HALF) = w; } }
    }
};
struct EpiGlu {
    static constexpr bool PERM = true, AFTER_DRAIN = false;
    const bf16_t* A; const float* bias; bf16_t* O;
    __device__ __forceinline__ void operator()(const f32x4 (&acc)[2][2][4][2], const Unit& u, int wr, int wc, int fr, int fq) const {
        const int row0 = u.pm * BM + wr * 64 + fr, col0 = u.pn * BM + wc * 32 + 8 * fq;
#pragma unroll
        for (int ai = 0; ai < 2; ++ai)
#pragma unroll
            for (int m = 0; m < 4; ++m) { const size_t ro = (size_t)(row0 + ai * HALF + m * 16) * 512 + col0;
#pragma unroll
                for (int bj = 0; bj < 2; ++bj) { const f32x4 v0 = acc[ai][bj][m][0], v1 = acc[ai][bj][m][1];
                    const u32x4 a = *(const u32x4*)(A + ro + bj * HALF);
                    const f32x4 b0 = *(const f32x4*)(bias + col0 + bj * HALF), b1 = *(const f32x4*)(bias + col0 + bj * HALF + 4);
                    float o[8];
                    o[0] = bflo(a.x) * sigmoid_f(v0[0] + b0[0]); o[1] = bfhi(a.x) * sigmoid_f(v0[1] + b0[1]);
                    o[2] = bflo(a.y) * sigmoid_f(v0[2] + b0[2]); o[3] = bfhi(a.y) * sigmoid_f(v0[3] + b0[3]);
                    o[4] = bflo(a.z) * sigmoid_f(v1[0] + b1[0]); o[5] = bfhi(a.z) * sigmoid_f(v1[1] + b1[1]);
                    o[6] = bflo(a.w) * sigmoid_f(v1[2] + b1[2]); o[7] = bfhi(a.w) * sigmoid_f(v1[3] + b1[3]);
                    u32x4 w; w.x = cvt_pk_bf16(o[0], o[1]); w.y = cvt_pk_bf16(o[2], o[3]); w.z = cvt_pk_bf16(o[4], o[5]); w.w = cvt_pk_bf16(o[6], o[7]);
                    *(u32x4*)(O + ro + bj * HALF) = w; } }
    }
};
struct MergeOrder {
    int G, c;
    __device__ __forceinline__ bool next(int i, Unit& u) const { const int pr = (i / 3) * G + c; if (pr >= 65 * 4) return false; const int k = i % 3; u.pm = k * 65 + (pr >> 2); u.pn = k * 4 + (pr & 3); return true; }
    __device__ __forceinline__ void a_ready(const Unit&) const {}
    __device__ __forceinline__ void done(const Unit&) const {}
};
struct EpiMerge {
    static constexpr bool PERM = true, AFTER_DRAIN = false;
    const bf16_t* proj; float* PM; bf16_t* MB;
    __device__ __forceinline__ void operator()(const f32x4 (&acc)[2][2][4][2], const Unit& u, int wr, int wc, int fr, int fq) const {
        const int k = u.pn >> 2, pn = u.pn & 3, pm = u.pm - 65 * k;
        const int row0 = pm * BM + wr * 64 + fr, col0 = pn * BM + wc * 32 + 8 * fq;
#pragma unroll
        for (int ai = 0; ai < 2; ++ai)
#pragma unroll
            for (int m = 0; m < 4; ++m) { const int row = row0 + ai * HALF + m * 16;
#pragma unroll
                for (int bj = 0; bj < 2; ++bj) { const f32x4 v0 = acc[ai][bj][m][0], v1 = acc[ai][bj][m][1];
                    const int col = col0 + bj * HALF;
                    const u32x4 g = *(const u32x4*)(proj + (size_t)row * PJ + GT0 + k * 1024 + col);
                    f32x4 o0, o1;
                    o0[0] = sigmoid_f(bflo(g.x)) * v0[0]; o0[1] = sigmoid_f(bfhi(g.x)) * v0[1]; o0[2] = sigmoid_f(bflo(g.y)) * v0[2]; o0[3] = sigmoid_f(bfhi(g.y)) * v0[3];
                    o1[0] = sigmoid_f(bflo(g.z)) * v1[0]; o1[1] = sigmoid_f(bfhi(g.z)) * v1[1]; o1[2] = sigmoid_f(bflo(g.w)) * v1[2]; o1[3] = sigmoid_f(bfhi(g.w)) * v1[3];
                    float* pp = PM + (size_t)row * 1024 + col;
                    if (k > 0) { o0 += *(const f32x4*)pp; o1 += *(const f32x4*)(pp + 4); }
                    if (k < 2) { *(f32x4*)pp = o0; *(f32x4*)(pp + 4) = o1; }
                    else { u32x4 w; w.x = cvt_pk_bf16(o0[0], o0[1]); w.y = cvt_pk_bf16(o0[2], o0[3]); w.z = cvt_pk_bf16(o1[0], o1[1]); w.w = cvt_pk_bf16(o1[2], o1[3]);
                        *(u32x4*)(MB + (size_t)row * 1024 + col) = w; } } }
    }
};
struct EpiResid {
    static constexpr bool PERM = false, AFTER_DRAIN = false;
    float* XL; float* XC; const float* g_lat; const float* g_ctx;
    __device__ __forceinline__ void operator()(const f32x4 (&acc)[2][2][4][2], const Unit& u, int wr, int wc, int fr, int fq) const {
        const bool isc = (u.pm == 0);
        float* base = isc ? XC : (XL - (size_t)NCTX * D); const float* gv = isc ? g_ctx : g_lat;
        const int row0 = u.pm * BM + wr * 64 + fr, col0 = u.pn * BM + wc * 32 + 4 * fq;
#pragma unroll
        for (int ai = 0; ai < 2; ++ai)
#pragma unroll
            for (int m = 0; m < 4; ++m) { float* rowp = base + (size_t)(row0 + ai * HALF + m * 16) * D + col0;
#pragma unroll
                for (int bj = 0; bj < 2; ++bj)
#pragma unroll
                    for (int n = 0; n < 2; ++n) { float* pp = rowp + bj * HALF + n * 16; const f32x4 g = *(const f32x4*)(gv + col0 + bj * HALF + n * 16);
                        f32x4 x = *(const f32x4*)pp; x += g * acc[ai][bj][m][n]; *(f32x4*)pp = x; } }
    }
};
struct ExpertOrder {
    int G, c, nnt;
    __device__ __forceinline__ bool next(int i, Unit& u) const { const int L = i * G + c; if (L >= NE * 9 * nnt) return false; const int e = L / (9 * nnt), rem = L % (9 * nnt); u.pm = e * 9 + rem % 9; u.pn = e * nnt + rem / 9; return true; }
    __device__ __forceinline__ void a_ready(const Unit&) const {}
    __device__ __forceinline__ void done(const Unit&) const {}
};
struct EpiSwiGlu {
    static constexpr bool PERM = true, AFTER_DRAIN = false;
    bf16_t* HID;
    __device__ __forceinline__ void operator()(const f32x4 (&acc)[2][2][4][2], const Unit& u, int wr, int wc, int fr, int fq) const {
        const int row0 = u.pm * BM + wr * 64 + fr, col0 = (u.pn & 7) * 128 + wc * 32 + 8 * fq;
#pragma unroll
        for (int ai = 0; ai < 2; ++ai)
#pragma unroll
            for (int m = 0; m < 4; ++m) { const f32x4 g0 = acc[ai][0][m][0], g1 = acc[ai][0][m][1], u0 = acc[ai][1][m][0], u1 = acc[ai][1][m][1];
                u32x4 w;
                w.x = cvt_pk_bf16(silu_f(g0[0]) * u0[0], silu_f(g0[1]) * u0[1]); w.y = cvt_pk_bf16(silu_f(g0[2]) * u0[2], silu_f(g0[3]) * u0[3]);
                w.z = cvt_pk_bf16(silu_f(g1[0]) * u1[0], silu_f(g1[1]) * u1[1]); w.w = cvt_pk_bf16(silu_f(g1[2]) * u1[2], silu_f(g1[3]) * u1[3]);
                *(u32x4*)(HID + (size_t)(row0 + ai * HALF + m * 16) * 1024 + col0) = w; }
    }
};
struct EpiDown {
    static constexpr bool PERM = true, AFTER_DRAIN = false;
    bf16_t* YE; const float* gsel;
    __device__ __forceinline__ void operator()(const f32x4 (&acc)[2][2][4][2], const Unit& u, int wr, int wc, int fr, int fq) const {
        const int row0 = u.pm * BM + wr * 64 + fr, col0 = (u.pn & 3) * BM + wc * 32 + 8 * fq;
#pragma unroll
        for (int ai = 0; ai < 2; ++ai)
#pragma unroll
            for (int m = 0; m < 4; ++m) { const int row = row0 + ai * HALF + m * 16; const float gs = gsel[row];
#pragma unroll
                for (int bj = 0; bj < 2; ++bj) { const f32x4 v0 = acc[ai][bj][m][0] * gs, v1 = acc[ai][bj][m][1] * gs;
                    u32x4 w; w.x = cvt_pk_bf16(v0[0], v0[1]); w.y = cvt_pk_bf16(v0[2], v0[3]); w.z = cvt_pk_bf16(v1[0], v1[1]); w.w = cvt_pk_bf16(v1[2], v1[3]);
                    *(u32x4*)(YE + (size_t)row * 1024 + col0 + bj * HALF) = w; } }
    }
};
}
#define XB_TMO      128
#define XB_XCNT(j)  (256  + 64 * (j))
#define XB_XSUB(j)  (1280 + 64 * (j))
#define XB_XGEN(j)  (2304 + 64 * (j))
#define XB_TOP      3328
#define XB_TOPGEN   3392
#define XCD_BAR_WORDS 3456
#define XB_SPIN_CAP (1u << 18)
#define LAS __attribute__((address_space(3)))

__device__ __forceinline__ unsigned xb_ld(unsigned* p)              { return __hip_atomic_load(p, __ATOMIC_RELAXED, __HIP_MEMORY_SCOPE_AGENT); }
__device__ __forceinline__ unsigned xb_add(unsigned* p, unsigned v) { return __hip_atomic_fetch_add(p, v, __ATOMIC_RELAXED, __HIP_MEMORY_SCOPE_AGENT); }
__device__ __forceinline__ unsigned xb_xcc_id() { return (unsigned)__builtin_amdgcn_s_getreg((3 << 11) | 20) & 0xFu; }
#define XB_SPIN(cond, bar) do { unsigned _sp = 0; while (cond) { __builtin_amdgcn_s_sleep(1); \
    if ((++_sp & 255u) == 0u) { if (xb_ld(&(bar)[XB_TMO])) break; if (_sp > XB_SPIN_CAP) { atomicAdd(&(bar)[XB_TMO], 1u); break; } } } } while (0)

struct XcdBarrier {
    unsigned* bar; unsigned x;
    volatile LAS unsigned* st;
};

__device__ __forceinline__ XcdBarrier xcd_barrier_post(unsigned* bar, volatile LAS unsigned* st) {
    XcdBarrier b; b.bar = bar; b.x = xb_xcc_id(); b.st = st;
    if (threadIdx.x == 0) (void)xb_add(&bar[XB_XCNT(b.x)], 1u);
    return b;
}
__device__ __forceinline__ void xcd_barrier_complete(unsigned* bar, unsigned x, unsigned& nloc, unsigned& nx) {
    const unsigned G = gridDim.x * gridDim.y * gridDim.z;
    unsigned sum, cnt, mine, sp = 0u;
    for (;;) {
        sum = 0u; cnt = 0u; mine = 0u;
#pragma unroll
        for (unsigned j = 0; j < 16; ++j) { const unsigned c = xb_ld(&bar[XB_XCNT(j)]); sum += c; cnt += (c > 0u) ? 1u : 0u; mine = (j == x) ? c : mine; }
        if (sum == G) break;
        __builtin_amdgcn_s_sleep(1);
        if ((++sp & 255u) == 0u) { if (xb_ld(&bar[XB_TMO])) break; if (sp > XB_SPIN_CAP) { atomicAdd(&bar[XB_TMO], 1u); break; } }
    }
    nloc = mine > 0u ? mine : 1u; nx = cnt > 0u ? cnt : 1u;
}

__device__ __forceinline__ void xcd_barrier(const XcdBarrier& b) {
    asm volatile("s_waitcnt vmcnt(0)" ::: "memory");
    __syncthreads();
    if (threadIdx.x == 0) {
        unsigned* bar = b.bar;
        __builtin_amdgcn_s_waitcnt(0);
        unsigned nloc = b.st[0], nx = b.st[1];
        if (nloc == 0u) { xcd_barrier_complete(bar, b.x, nloc, nx); b.st[0] = nloc; b.st[1] = nx; }
        const unsigned old = xb_add(&bar[XB_XSUB(b.x)], 1u);
        const unsigned gen = old / nloc;
        if (old + 1u == (gen + 1u) * nloc) {
            __builtin_amdgcn_fence(__ATOMIC_RELEASE, "agent");
            asm volatile("s_waitcnt vmcnt(0)" ::: "memory");
            const unsigned og = xb_add(&bar[XB_TOP], 1u);
            const unsigned tg = og / nx;
            if (og + 1u == (tg + 1u) * nx) xb_add(&bar[XB_TOPGEN], 1u);
            else XB_SPIN(xb_ld(&bar[XB_TOPGEN]) == tg, bar);
            __builtin_amdgcn_fence(__ATOMIC_ACQUIRE, "agent");
            xb_add(&bar[XB_XGEN(b.x)], 1u);
            asm volatile("s_waitcnt vmcnt(0)" ::: "memory");
        } else {
            XB_SPIN(xb_ld(&bar[XB_XGEN(b.x)]) == gen, bar);
            __builtin_amdgcn_fence(__ATOMIC_ACQUIRE, "agent");
            asm volatile("s_waitcnt vmcnt(0)" ::: "memory");
        }
    }
    __syncthreads();
}


struct P {
    const float *x, *c, *ctx, *c_ctx, *w_mod, *b_mod, *norm1_g, *norm2_g, *w_in, *lam_re, *lam_im, *log_dt, *b_re, *b_im, *c_re, *c_im, *s5_d, *w_glu, *b_glu,
        *conv_w, *conv_b, *a_log, *dt_bias, *ssd_d, *ssd_norm_g, *sink, *w_branch, *w_out, *w_router, *w_eg, *w_eu, *w_ed, *final_g;
    float* XL;
    float *MOD, *XC, *DT, *S5E, *S5H, *YD, *PM, *AFFT, *GSEL;
    bf16 *WIN, *WGLU, *WBR, *WOUT, *WUP, *WDN, *H, *PROJ, *XE, *HID, *CV, *SA, *Y3, *MB, *YE;
    int *IDX, *INV;
    int tid, lane, wave, bid, G;
};


constexpr int PTAB_OFF = LDS_BYTES - 1024;
__device__ __forceinline__ unsigned long long ld_tab(volatile LAS unsigned* t, int k) {
    const unsigned lo = __builtin_amdgcn_readfirstlane(t[2 * k]), hi = __builtin_amdgcn_readfirstlane(t[2 * k + 1]);
    return ((unsigned long long)hi << 32) | lo;
}
__device__ __forceinline__ void build_P(P& p, LAS unsigned char* lds) {
    int tid_l = threadIdx.x, bid_l = blockIdx.x, g_l = gridDim.x;
    asm volatile("" : "+v"(tid_l), "+s"(bid_l), "+s"(g_l));
    p.tid = tid_l; p.lane = p.tid & 63; p.wave = __builtin_amdgcn_readfirstlane(p.tid >> 6); p.bid = bid_l; p.G = g_l;
    unsigned tbase = (unsigned)(size_t)(lds + PTAB_OFF); asm volatile("" : "+v"(tbase));
    volatile LAS unsigned* tb = (volatile LAS unsigned*)(size_t)tbase;
#define INP(k) ((const float*)ld_tab(tb, k))
    p.x = INP(0); p.c = INP(1); p.ctx = INP(2); p.c_ctx = INP(3); p.w_mod = INP(4); p.b_mod = INP(5); p.norm1_g = INP(6); p.norm2_g = INP(7);
    p.w_in = INP(8); p.lam_re = INP(9); p.lam_im = INP(10); p.log_dt = INP(11); p.b_re = INP(12); p.b_im = INP(13); p.c_re = INP(14); p.c_im = INP(15);
    p.s5_d = INP(16); p.w_glu = INP(17); p.b_glu = INP(18); p.conv_w = INP(19); p.conv_b = INP(20); p.a_log = INP(21); p.dt_bias = INP(22); p.ssd_d = INP(23);
    p.ssd_norm_g = INP(24); p.sink = INP(25); p.w_branch = INP(26); p.w_out = INP(27); p.w_router = INP(28); p.w_eg = INP(29); p.w_eu = INP(30); p.w_ed = INP(31);
    p.final_g = INP(32);
#undef INP
    p.XL = (float*)ld_tab(tb, 33);
    unsigned char* ws = (unsigned char*)ld_tab(tb, 34);
    p.MOD = (float*)(ws + WS_MOD); p.XC = (float*)(ws + WS_XC); p.DT = (float*)(ws + WS_DT); p.S5E = (float*)(ws + WS_S5E); p.S5H = (float*)(ws + WS_S5H); p.YD = (float*)(ws + WS_YD);
    p.PM = (float*)(ws + WS_PM); p.AFFT = (float*)(ws + WS_AFFT); p.GSEL = (float*)(ws + WS_GSEL);
    p.WIN = (bf16*)(ws + WS_WIN); p.WGLU = (bf16*)(ws + WS_WGLU); p.WBR = (bf16*)(ws + WS_WBR); p.WOUT = (bf16*)(ws + WS_WOUT); p.WUP = (bf16*)(ws + WS_WUP); p.WDN = (bf16*)(ws + WS_WDN);
    p.H = (bf16*)(ws + WS_H); p.PROJ = (bf16*)(ws + WS_PROJ); p.XE = (bf16*)(ws + WS_XE); p.HID = (bf16*)(ws + WS_HID); p.CV = (bf16*)(ws + WS_CV); p.SA = (bf16*)(ws + WS_SA);
    p.Y3 = (bf16*)(ws + WS_Y3); p.MB = (bf16*)(ws + WS_MB); p.YE = (bf16*)(ws + WS_YE);
    p.IDX = (int*)(ws + WS_IDX); p.INV = (int*)(ws + WS_INV);
}
__device__ __forceinline__ void phase_mod(const P& p, LAS unsigned char* lds) {
    LAS float* sc = (LAS float*)lds;
    LAS float* part = sc + 2048;
    for (int i = p.tid; i < 1024; i += NTHR) { sc[i] = silu_f(p.c[i]); sc[1024 + i] = silu_f(p.c_ctx[i]); }
    __syncthreads();
    for (int it = p.bid; it < DEPTH * 48; it += p.G) {
        const int l = it / 48, cb = it % 48, c0 = cb * 128 + 2 * p.lane;
        const float* W = p.w_mod + (size_t)l * 1024 * 6144 + c0;
        float a00 = 0.f, a01 = 0.f, a10 = 0.f, a11 = 0.f;
        const int kb = p.wave * 128;
#pragma unroll 8
        for (int k = kb; k < kb + 128; ++k) { const float2 w = *(const float2*)(W + (size_t)k * 6144); const float s0 = sc[k], s1 = sc[1024 + k];
            a00 += s0 * w.x; a01 += s0 * w.y; a10 += s1 * w.x; a11 += s1 * w.y; }
        part[(p.wave * 2 + 0) * 128 + 2 * p.lane] = a00; part[(p.wave * 2 + 0) * 128 + 2 * p.lane + 1] = a01;
        part[(p.wave * 2 + 1) * 128 + 2 * p.lane] = a10; part[(p.wave * 2 + 1) * 128 + 2 * p.lane + 1] = a11;
        __syncthreads();
        if (p.tid < 256) { const int s = p.tid >> 7, col = p.tid & 127; float r = p.b_mod[l * 6144 + cb * 128 + col];
#pragma unroll
            for (int w = 0; w < 8; ++w) r += part[(w * 2 + s) * 128 + col];
            p.MOD[(size_t)(l * 2 + s) * 6144 + cb * 128 + col] = r; }
        __syncthreads();
    }
}

__device__ __forceinline__ void tr_item(const float* src, int ldw, int K, bf16* dst, int kb, LAS float* scr, int lane) {
    const int k0 = 64 * kb;
#pragma unroll 8
    for (int i = 0; i < 32; ++i) { const int kk = 2 * i + (lane >> 5); scr[kk * 33 + (lane & 31)] = src[(size_t)(k0 + kk) * ldw + (lane & 31)]; }
    LDS_FENCE();
    const int c = lane & 7;
#pragma unroll
    for (int j = 0; j < 4; ++j) { const int n = (lane >> 3) + 8 * j; const LAS float* s = scr + (8 * c) * 33 + n;
        u32x4 o; o.x = pk2(s[0 * 33], s[1 * 33]); o.y = pk2(s[2 * 33], s[3 * 33]); o.z = pk2(s[4 * 33], s[5 * 33]); o.w = pk2(s[6 * 33], s[7 * 33]);
        *(u32x4*)(dst + (size_t)n * K + k0 + 8 * c) = o; }
    LDS_FENCE();
}
__device__ __forceinline__ void convert_weights(const P& p, int l, LAS unsigned char* lds) {
    LAS float* scr = (LAS float*)(lds + p.wave * 8704);
    const int gw = p.bid * NWAVES + p.wave, NGW = p.G * NWAVES;
    constexpr int I_A = 64 * 16, I_B = 120 * 16, I_GLU = 16 * 8, I_BR = 3 * 32 * 8, I_OUT = 32 * 16, I_E = 16 * 32 * 16;
    constexpr int NIT = I_A + I_B + I_GLU + I_BR + I_OUT + 3 * I_E;
    const float* win = p.w_in + (size_t)l * 1024 * IN_W;
    for (int it = gw; it < NIT; it += NGW) {
        int r = it;
        if (r < I_A) { const int nb = r >> 4, kb = r & 15; tr_item(win + 32 * nb, IN_W, 1024, p.WIN + (size_t)(32 * nb) * 1024, kb, scr, p.lane); continue; } r -= I_A;
        if (r < I_B) { const int nb = r >> 4, kb = r & 15; tr_item(win + 2064 + 32 * nb, IN_W, 1024, p.WIN + (size_t)(2048 + 32 * nb) * 1024, kb, scr, p.lane); continue; } r -= I_B;
        if (r < I_GLU) { const int nb = r >> 3, kb = r & 7; tr_item(p.w_glu + (size_t)l * 512 * 512 + 32 * nb, 512, 512, p.WGLU + (size_t)(32 * nb) * 512, kb, scr, p.lane); continue; } r -= I_GLU;
        if (r < I_BR) { const int kk = r >> 8, nb = (r >> 3) & 31, kb = r & 7;
            tr_item(p.w_branch + ((size_t)l * 3 + kk) * 512 * 1024 + 32 * nb, 1024, 512, p.WBR + (size_t)(kk * 1024 + 32 * nb) * 512, kb, scr, p.lane); continue; } r -= I_BR;
        if (r < I_OUT) { const int nb = r >> 4, kb = r & 15; tr_item(p.w_out + (size_t)l * 1024 * 1024 + 32 * nb, 1024, 1024, p.WOUT + (size_t)(32 * nb) * 1024, kb, scr, p.lane); continue; } r -= I_OUT;
        const int which = r / I_E; r -= which * I_E;
        const int e = r >> 9, nb = (r >> 4) & 31, kb = r & 15;
        const size_t eo = ((size_t)l * NE + e) * 1024 * 1024;
        if (which == 0) tr_item(p.w_eg + eo + 32 * nb, 1024, 1024, p.WUP + (size_t)(e * 2048 + 256 * (nb >> 2) + 32 * (nb & 3)) * 1024, kb, scr, p.lane);
        else if (which == 1) tr_item(p.w_eu + eo + 32 * nb, 1024, 1024, p.WUP + (size_t)(e * 2048 + 256 * (nb >> 2) + 128 + 32 * (nb & 3)) * 1024, kb, scr, p.lane);
        else tr_item(p.w_ed + eo + 32 * nb, 1024, 1024, p.WDN + (size_t)(e * 1024 + 32 * nb) * 1024, kb, scr, p.lane);
    }
}

template <int MODE> __device__ __forceinline__ void row_pass(const P& p, int l, LAS unsigned char* lds) {
    LAS float* W16 = (LAS float*)lds;
    if (MODE != 2) {
        const float* src = (MODE == 0) ? (p.w_in + (size_t)l * 1024 * IN_W + 2048) : (p.w_router + (size_t)l * 1024 * 16);
        const int ld = (MODE == 0) ? IN_W : 16;
        for (int i = p.tid; i < 1024 * 16; i += NTHR) { const int k = i >> 4, j = i & 15; W16[k * 20 + j] = src[(size_t)k * ld + j]; }
        __syncthreads();
    }
    const int gw = p.bid * NWAVES + p.wave, NGW = p.G * NWAVES, lane = p.lane;
    for (int row = gw + (MODE == 2 ? NCTX : 0); row < T; row += NGW) {
        const bool isc = row < NCTX;
        float* xrow = isc ? (p.XC + (size_t)row * D) : (p.XL + (size_t)(row - NCTX) * D);
        float v[16];
        if (MODE == 0 && l == 0) { const float* s = isc ? (p.ctx + (size_t)row * D) : (p.x + (size_t)(row - NCTX) * D);
#pragma unroll
            for (int i = 0; i < 16; ++i) v[i] = s[lane + 64 * i];
        } else {
#pragma unroll
            for (int i = 0; i < 16; ++i) v[i] = xrow[lane + 64 * i];
        }
        if ((MODE == 0 && l > 0) || MODE == 2) {
            const int lp = (MODE == 2) ? (DEPTH - 1) : (l - 1);
            const float* g2 = p.MOD + (size_t)(lp * 2 + (isc ? 1 : 0)) * 6144 + 5 * D;
            float s[16];
#pragma unroll
            for (int i = 0; i < 16; ++i) s[i] = 0.f;
            for (int e = 0; e < NE; ++e) { const int slot = p.INV[(size_t)row * 16 + e];
                if (slot >= 0) { const bf16* yr = p.YE + ((size_t)e * ESLOTS + slot) * D;
#pragma unroll
                    for (int i = 0; i < 16; ++i) s[i] += bf2f(yr[lane + 64 * i]); } }
#pragma unroll
            for (int i = 0; i < 16; ++i) v[i] += g2[lane + 64 * i] * s[i];
        }
        if (MODE == 0) {
#pragma unroll
            for (int i = 0; i < 16; ++i) xrow[lane + 64 * i] = v[i];
        }
        float ss = 0.f;
#pragma unroll
        for (int i = 0; i < 16; ++i) ss += v[i] * v[i];
        const float rstd = rsqrtf(wsum(ss) * (1.f / D) + EPS);
        if (MODE == 2) {
#pragma unroll
            for (int i = 0; i < 16; ++i) xrow[lane + 64 * i] = v[i] * rstd * p.final_g[lane + 64 * i];
            continue;
        }
        const float* gam = (MODE == 0 ? p.norm1_g : p.norm2_g) + (size_t)l * D;
        const float* md = p.MOD + (size_t)(l * 2 + (isc ? 1 : 0)) * 6144 + (MODE == 0 ? 0 : 3 * D);
        bf16* hrow = p.H + (size_t)row * D;
        float acc[16];
#pragma unroll
        for (int j = 0; j < 16; ++j) acc[j] = 0.f;
#pragma unroll
        for (int i = 0; i < 16; ++i) { const int k = lane + 64 * i;
            const float hv = v[i] * rstd * gam[k] * (1.f + md[D + k]) + md[k];
            hrow[k] = (bf16)f2bf(hv);
            const LAS f32x4* wr = (const LAS f32x4*)(W16 + k * 20);
            const f32x4 w0 = wr[0], w1 = wr[1], w2 = wr[2], w3 = wr[3];
            acc[0] += hv * w0[0]; acc[1] += hv * w0[1]; acc[2] += hv * w0[2]; acc[3] += hv * w0[3];
            acc[4] += hv * w1[0]; acc[5] += hv * w1[1]; acc[6] += hv * w1[2]; acc[7] += hv * w1[3];
            acc[8] += hv * w2[0]; acc[9] += hv * w2[1]; acc[10] += hv * w2[2]; acc[11] += hv * w2[3];
            acc[12] += hv * w3[0]; acc[13] += hv * w3[1]; acc[14] += hv * w3[2]; acc[15] += hv * w3[3];
            if ((i & 1) == 1) asm volatile("" ::: "memory"); }
#pragma unroll
        for (int j = 0; j < 16; ++j) acc[j] = wsum(acc[j]);
        if (MODE == 0) {
            float mine = 0.f;
#pragma unroll
            for (int j = 0; j < 16; ++j) mine = (lane == j) ? acc[j] : mine;
            if (lane < 16) p.DT[(size_t)row * 16 + lane] = softplus_f(mine + p.dt_bias[l * 16 + lane]);
        } else {
            float mx = acc[0];
#pragma unroll
            for (int j = 1; j < 16; ++j) mx = fmaxf(mx, acc[j]);
            float sum = 0.f, mine = 0.f;
#pragma unroll
            for (int j = 0; j < 16; ++j) { const float e = expf(acc[j] - mx); sum += e; mine = (lane == j) ? e : mine; }
            if (lane < 16) p.AFFT[(size_t)lane * T + row] = mine / sum;
        }
    }
}

struct S5Lane { float abr, abi; float bbr[16], bbi[16]; };
__device__ __forceinline__ void s5_lane_params(const P& p, int l, int d, int g, int lane, S5Lane& o, bool withB) {
    const size_t gi = ((size_t)(l * 2 + d) * 32 + g);
    const float lr = p.lam_re[gi * 64 + lane], li = p.lam_im[gi * 64 + lane], dt = expf(p.log_dt[gi]);
    const float mag = expf(lr * dt); float sn, cs; sincosf(li * dt, &sn, &cs);
    o.abr = mag * cs; o.abi = mag * sn;
    if (withB) {
        const float den = lr * lr + li * li;
        const float fr = ((o.abr - 1.f) * lr + o.abi * li) / den, fi = (o.abi * lr - (o.abr - 1.f) * li) / den;
        const f32x4* br = (const f32x4*)(p.b_re + (gi * 64 + lane) * 16); const f32x4* bi = (const f32x4*)(p.b_im + (gi * 64 + lane) * 16);
#pragma unroll
        for (int q = 0; q < 4; ++q) { const f32x4 r4 = br[q], i4 = bi[q];
#pragma unroll
            for (int j = 0; j < 4; ++j) { o.bbr[4 * q + j] = fr * r4[j] - fi * i4[j]; o.bbi[4 * q + j] = fr * i4[j] + fi * r4[j]; } }
    }
}
__device__ __forceinline__ void s5_stage_u(const P& p, int r0, int g, LAS unsigned char* ub, int lane) {
#pragma unroll
    for (int j = 0; j < 4; ++j) { const int q = lane + 64 * j, i = q >> 1, half = q & 1;
        const u32x4 w = *(const u32x4*)(p.PROJ + (size_t)(r0 + i) * PJ + U0 + g * 16 + half * 8);
        *(LAS u32x4*)(ub + i * 32 + half * 16) = w; }
    LDS_FENCE();
}
__device__ __forceinline__ void s5_step(const S5Lane& s, const LAS unsigned char* ub, int i, float& hr, float& hi) {
    const u32x4 a = *(const LAS u32x4*)(ub + i * 32), b = *(const LAS u32x4*)(ub + i * 32 + 16);
    float u[16];
    u[0] = bflo(a.x); u[1] = bfhi(a.x); u[2] = bflo(a.y); u[3] = bfhi(a.y); u[4] = bflo(a.z); u[5] = bfhi(a.z); u[6] = bflo(a.w); u[7] = bfhi(a.w);
    u[8] = bflo(b.x); u[9] = bfhi(b.x); u[10] = bflo(b.y); u[11] = bfhi(b.y); u[12] = bflo(b.z); u[13] = bfhi(b.z); u[14] = bflo(b.w); u[15] = bfhi(b.w);
    float br = 0.f, bi = 0.f;
#pragma unroll
    for (int k = 0; k < 16; ++k) { br += s.bbr[k] * u[k]; bi += s.bbi[k] * u[k]; }
    const float nr = s.abr * hr - s.abi * hi + br, ni = s.abr * hi + s.abi * hr + bi;
    hr = nr; hi = ni;
}

__device__ __forceinline__ void phase_premix(const P& p, int l, LAS unsigned char* lds) {
    const float* cw = p.conv_w + (size_t)l * 5 * 1024; const float* cb = p.conv_b + (size_t)l * 1024;
    for (int idx = p.bid * NTHR + p.tid; idx < T * 128; idx += p.G * NTHR) {
        const int row = idx >> 7, c8 = (idx & 127) * 8;
        const int lo = row < NCTX ? 0 : NCTX, hi = row < NCTX ? NCTX : T;
        float a[8];
        { const f32x4 b0 = *(const f32x4*)(cb + c8), b1 = *(const f32x4*)(cb + c8 + 4);
          a[0] = b0[0]; a[1] = b0[1]; a[2] = b0[2]; a[3] = b0[3]; a[4] = b1[0]; a[5] = b1[1]; a[6] = b1[2]; a[7] = b1[3]; }
#pragma unroll
        for (int j = 0; j < 5; ++j) { const int r = row + j - 2;
            if (r >= lo && r < hi) { const u32x4 xv = *(const u32x4*)(p.PROJ + (size_t)r * PJ + XB0 + c8);
                const f32x4 w0 = *(const f32x4*)(cw + j * 1024 + c8), w1 = *(const f32x4*)(cw + j * 1024 + c8 + 4);
                a[0] += w0[0] * bflo(xv.x); a[1] += w0[1] * bfhi(xv.x); a[2] += w0[2] * bflo(xv.y); a[3] += w0[3] * bfhi(xv.y);
                a[4] += w1[0] * bflo(xv.z); a[5] += w1[1] * bfhi(xv.z); a[6] += w1[2] * bflo(xv.w); a[7] += w1[3] * bfhi(xv.w); } }
        u32x4 o; o.x = pk2(silu_f(a[0]), silu_f(a[1])); o.y = pk2(silu_f(a[2]), silu_f(a[3])); o.z = pk2(silu_f(a[4]), silu_f(a[5])); o.w = pk2(silu_f(a[6]), silu_f(a[7]));
        *(u32x4*)(p.CV + (size_t)row * 1024 + c8) = o;
    }
    for (int idx = p.bid * NTHR + p.tid; idx < NLAT * 160; idx += p.G * NTHR) {
        const int i = idx & 15, hh = (idx >> 4) % 10, t = idx / 160;
        bf16* base = p.PROJ + (size_t)(NCTX + t) * PJ + (hh < 8 ? Q0 + hh * 64 : K0 + (hh - 8) * 64);
        const float inv = exp2f(-(float)i * 0.83048202372184058696f);
        const float ar = (float)(t >> 6) * inv, ac = (float)(t & 63) * inv;
        float sr, cr, sc, cc; sincosf(ar, &sr, &cr); sincosf(ac, &sc, &cc);
        { const float x1 = bf2f(base[i]), x2 = bf2f(base[16 + i]); base[i] = (bf16)f2bf(x1 * cr - x2 * sr); base[16 + i] = (bf16)f2bf(x2 * cr + x1 * sr); }
        { const float x1 = bf2f(base[32 + i]), x2 = bf2f(base[48 + i]); base[32 + i] = (bf16)f2bf(x1 * cc - x2 * sc); base[48 + i] = (bf16)f2bf(x2 * cc + x1 * sc); }
    }
    LAS unsigned char* ub = lds + p.wave * 4096;
    const int gw = p.bid * NWAVES + p.wave, NGW = p.G * NWAVES;
    for (int it = gw; it < 2 * 32 * NCH; it += NGW) {
        const int d = it / (32 * NCH), g = (it / NCH) & 31, c = it % NCH;
        S5Lane s; s5_lane_params(p, l, d, g, p.lane, s, true);
        const int r0 = (d == 0) ? 128 * c : (c < 2 ? 128 * (1 - c) : 128 * (NCH + 1 - c));
        s5_stage_u(p, r0, g, ub, p.lane);
        float hr = 0.f, hi = 0.f;
        for (int i = 0; i < 128; ++i) s5_step(s, ub, d == 0 ? i : 127 - i, hr, hi);
        float* E = p.S5E + ((size_t)(d * 32 + g) * NCH + c) * 128;
        E[p.lane] = hr; E[64 + p.lane] = hi;
        LDS_FENCE();
    }
}

__device__ __forceinline__ void ssd_scan_naive(const P& p, int l) {
    for (int it = p.bid * 4 + p.wave; it < 1024; it += p.G * 4) {
        const int d = it >> 9, hd = (it >> 6) & 7, pp = it & 63, grp = hd >> 2;
        const float a = -expf(p.a_log[l * 16 + d * 8 + hd]);
        const int colB = 512 + grp * 128 + p.lane, colC = 768 + grp * 128 + p.lane, colX = hd * 64 + pp, dcol = d * 8 + hd;
        float h0 = 0.f, h1 = 0.f;
        for (int s0 = 0; s0 < T; s0 += 8) {
            unsigned b0[8], b1[8], c0[8], c1[8], xx[8]; float dtv[8]; int rr[8];
#pragma unroll
            for (int j = 0; j < 8; ++j) { const int r = scan_row(d, s0 + j); rr[j] = r; const bf16* cv = p.CV + (size_t)r * 1024;
                b0[j] = cv[colB]; b1[j] = cv[colB + 64]; c0[j] = cv[colC]; c1[j] = cv[colC + 64]; xx[j] = cv[colX]; dtv[j] = p.DT[(size_t)r * 16 + dcol]; }
#pragma unroll
            for (int j = 0; j < 8; ++j) { const float dec = expf(dtv[j] * a), dx = dtv[j] * bf2f(xx[j]);
                h0 = dec * h0 + dx * bf2f(b0[j]); h1 = dec * h1 + dx * bf2f(b1[j]);
                const float y = wsum(bf2f(c0[j]) * h0 + bf2f(c1[j]) * h1);
                if (p.lane == 0) p.YD[((size_t)d * T + rr[j]) * 512 + colX] = y; }
        }
    }
}
__device__ __forceinline__ void s5_carry_scan(const P& p, int l, int aw, int NAW) {
    for (int it = aw; it < 64; it += NAW) {
        const int d = it >> 5, g = it & 31;
        S5Lane s; s5_lane_params(p, l, d, g, p.lane, s, false);
        float ar = s.abr, ai = s.abi;
#pragma unroll
        for (int q = 0; q < 7; ++q) { const float nr = ar * ar - ai * ai, ni = 2.f * ar * ai; ar = nr; ai = ni; }
        float hr = 0.f, hi = 0.f;
        const float* E = p.S5E + (size_t)(d * 32 + g) * NCH * 128; float* Hn = p.S5H + (size_t)(d * 32 + g) * NCH * 128;
        for (int c = 0; c < NCH; ++c) { Hn[c * 128 + p.lane] = hr; Hn[c * 128 + 64 + p.lane] = hi;
            const float er = E[c * 128 + p.lane], ei = E[c * 128 + 64 + p.lane];
            const float nr = ar * hr - ai * hi + er, ni = ar * hi + ai * hr + ei; hr = nr; hi = ni; }
    }
}
__device__ __forceinline__ void attention_naive(const P& p, int l, int aw, int NAW, LAS float* pbuf) {
    const int lane = p.lane;
    for (int it = aw; it < T * 8; it += NAW) {
        const int row = it >> 3, hq = it & 7, kvh = hq >> 2;
        const bool isc = row < NCTX; const int t = row - NCTX;
        const int jlo = isc ? 0 : (t - 128 < 0 ? 0 : t - 128), jhi = isc ? -1 : (t + 128 > NLAT - 1 ? NLAT - 1 : t + 128);
        const int nloc = jhi - jlo + 1, nk = nloc + NCTX;
        const float sink = p.sink[l * 8 + hq];
        float q[64];
        { const u32x4* qp = (const u32x4*)(p.PROJ + (size_t)row * PJ + Q0 + hq * 64);
#pragma unroll
          for (int c = 0; c < 8; ++c) { const u32x4 w = qp[c]; q[8 * c] = bflo(w.x); q[8 * c + 1] = bfhi(w.x); q[8 * c + 2] = bflo(w.y); q[8 * c + 3] = bfhi(w.y);
              q[8 * c + 4] = bflo(w.z); q[8 * c + 5] = bfhi(w.z); q[8 * c + 6] = bflo(w.w); q[8 * c + 7] = bfhi(w.w); } }
        float sc[9]; float mx = sink;
#pragma unroll
        for (int i = 0; i < 9; ++i) { const int kk = lane + 64 * i; float s = -INFINITY;
            if (kk < nk) { const int krow = kk < nloc ? NCTX + jlo + kk : kk - nloc;
                const u32x4* kp = (const u32x4*)(p.PROJ + (size_t)krow * PJ + K0 + kvh * 64); float dot = 0.f;
#pragma unroll
                for (int c = 0; c < 8; ++c) { const u32x4 w = kp[c];
                    dot += q[8 * c] * bflo(w.x) + q[8 * c + 1] * bfhi(w.x) + q[8 * c + 2] * bflo(w.y) + q[8 * c + 3] * bfhi(w.y)
                         + q[8 * c + 4] * bflo(w.z) + q[8 * c + 5] * bfhi(w.z) + q[8 * c + 6] * bflo(w.w) + q[8 * c + 7] * bfhi(w.w); }
                s = dot * 0.125f; }
            sc[i] = s; mx = fmaxf(mx, s); }
        mx = wmaxf(mx);
        float sum = 0.f;
#pragma unroll
        for (int i = 0; i < 9; ++i) { const int kk = lane + 64 * i; const float e = (kk < nk) ? expf(sc[i] - mx) : 0.f; pbuf[kk] = e; sum += e; }
        const float den = wsum(sum) + expf(sink - mx);
        LDS_FENCE();
        float o = 0.f;
        const bf16* vb = p.PROJ + V0 + kvh * 64 + lane;
#pragma unroll 4
        for (int kk = 0; kk < nk; ++kk) { const int vrow = kk < nloc ? NCTX + jlo + kk : kk - nloc; o += pbuf[kk] * bf2f(vb[(size_t)vrow * PJ]); }
        p.Y3[((size_t)2 * T + row) * 512 + hq * 64 + lane] = (bf16)f2bf(o / den);
        LDS_FENCE();
    }
}

__device__ __forceinline__ void phase_postmix(const P& p, int l, LAS unsigned char* lds) {
    constexpr int CSH_BYTES = 2 * 2 * 16 * 68 * 4, WREG = 16640;
    LAS float* Csh = (LAS float*)lds;
    LAS unsigned char* wreg = lds + CSH_BYTES + p.wave * WREG;
    LAS unsigned char* ub = wreg;
    LAS float* Hb = (LAS float*)(wreg + 4096);
    LAS float* Yb = (LAS float*)(wreg + 4096 + 4224);
    const int lane = p.lane;
    for (int it = p.bid; it < 32 * 17; it += p.G) {
        const int g = it / 17, chunk = (it % 17) * 8 + p.wave;
        __syncthreads();
        for (int i = p.tid; i < 2 * 2 * 16 * 64; i += NTHR) { const int pq = i & 63, k = (i >> 6) & 15, ri = (i >> 10) & 1, d = i >> 11;
            const float* src = ri ? p.c_im : p.c_re; Csh[((d * 2 + ri) * 16 + k) * 68 + pq] = src[(((size_t)(l * 2 + d) * 32 + g) * 16 + k) * 64 + pq]; }
        __syncthreads();
        if (chunk < NCH) {
            const int r0 = 128 * chunk;
            s5_stage_u(p, r0, g, ub, lane);
            for (int d = 0; d < 2; ++d) {
                S5Lane s; s5_lane_params(p, l, d, g, lane, s, true);
                const int cs = (d == 0) ? chunk : (chunk < 2 ? 1 - chunk : NCH + 1 - chunk);
                const float* Hn = p.S5H + ((size_t)(d * 32 + g) * NCH + cs) * 128;
                float hr = Hn[lane], hi = Hn[64 + lane];
                const LAS float* Cr = Csh + (d * 2 + 0) * 16 * 68; const LAS float* Ci = Csh + (d * 2 + 1) * 16 * 68;
                for (int sub = 0; sub < 16; ++sub) {
#pragma unroll
                    for (int j = 0; j < 8; ++j) { const int is = sub * 8 + j; s5_step(s, ub, d == 0 ? is : 127 - is, hr, hi); Hb[j * 132 + lane] = hr; Hb[j * 132 + 64 + lane] = hi; }
                    LDS_FENCE();
#pragma unroll
                    for (int m = 0; m < 2; ++m) { const int o = lane + 64 * m, j = o >> 4, k = o & 15; float y = 0.f;
#pragma unroll
                        for (int q = 0; q < 16; ++q) { const f32x4 cr = *(const LAS f32x4*)(Cr + k * 68 + 4 * q), ci = *(const LAS f32x4*)(Ci + k * 68 + 4 * q);
                            const f32x4 xr = *(const LAS f32x4*)(Hb + j * 132 + 4 * q), xi = *(const LAS f32x4*)(Hb + j * 132 + 64 + 4 * q);
                            y += cr[0] * xr[0] + cr[1] * xr[1] + cr[2] * xr[2] + cr[3] * xr[3] - ci[0] * xi[0] - ci[1] * xi[1] - ci[2] * xi[2] - ci[3] * xi[3]; }
                        const int is = sub * 8 + j, i = (d == 0) ? is : 127 - is;
                        if (d == 0) Yb[i * 16 + k] = y; else Yb[i * 16 + k] += y; }
                    LDS_FENCE();
                }
            }
            const float* dsk = p.s5_d + (size_t)l * 512 + g * 16;
#pragma unroll
            for (int m = 0; m < 2; ++m) { const int i = lane + 64 * m;
                const u32x4 ua = *(const LAS u32x4*)(ub + i * 32), ubv = *(const LAS u32x4*)(ub + i * 32 + 16);
                float u[16];
                u[0] = bflo(ua.x); u[1] = bfhi(ua.x); u[2] = bflo(ua.y); u[3] = bfhi(ua.y); u[4] = bflo(ua.z); u[5] = bfhi(ua.z); u[6] = bflo(ua.w); u[7] = bfhi(ua.w);
                u[8] = bflo(ubv.x); u[9] = bfhi(ubv.x); u[10] = bflo(ubv.y); u[11] = bfhi(ubv.y); u[12] = bflo(ubv.z); u[13] = bfhi(ubv.z); u[14] = bflo(ubv.w); u[15] = bfhi(ubv.w);
                float a[16];
#pragma unroll
                for (int k = 0; k < 16; ++k) a[k] = gelu_tanh_f(Yb[i * 16 + k] + dsk[k] * u[k]);
                u32x4 o0, o1; o0.x = pk2(a[0], a[1]); o0.y = pk2(a[2], a[3]); o0.z = pk2(a[4], a[5]); o0.w = pk2(a[6], a[7]);
                o1.x = pk2(a[8], a[9]); o1.y = pk2(a[10], a[11]); o1.z = pk2(a[12], a[13]); o1.w = pk2(a[14], a[15]);
                bf16* dst = p.SA + (size_t)(r0 + i) * 512 + g * 16;
                *(u32x4*)dst = o0; *(u32x4*)(dst + 8) = o1; }
            LDS_FENCE();
        }
    }
    const int gw = p.bid * NWAVES + p.wave, NGW = p.G * NWAVES;
    for (int row = gw; row < T; row += NGW) {
        const int ch = lane * 8;
        const float dsk = p.ssd_d[l * 8 + (ch >> 6)];
        const float* y0 = p.YD + (size_t)row * 512 + ch; const float* y1 = p.YD + ((size_t)T + row) * 512 + ch;
        const f32x4 a0 = *(const f32x4*)y0, a1 = *(const f32x4*)(y0 + 4), b0 = *(const f32x4*)y1, b1 = *(const f32x4*)(y1 + 4);
        const u32x4 xs = *(const u32x4*)(p.CV + (size_t)row * 1024 + ch), zz = *(const u32x4*)(p.PROJ + (size_t)row * PJ + Z0 + ch);
        float v[8];
        v[0] = (a0[0] + b0[0] + dsk * bflo(xs.x)) * silu_f(bflo(zz.x)); v[1] = (a0[1] + b0[1] + dsk * bfhi(xs.x)) * silu_f(bfhi(zz.x));
        v[2] = (a0[2] + b0[2] + dsk * bflo(xs.y)) * silu_f(bflo(zz.y)); v[3] = (a0[3] + b0[3] + dsk * bfhi(xs.y)) * silu_f(bfhi(zz.y));
        v[4] = (a1[0] + b1[0] + dsk * bflo(xs.z)) * silu_f(bflo(zz.z)); v[5] = (a1[1] + b1[1] + dsk * bfhi(xs.z)) * silu_f(bfhi(zz.z));
        v[6] = (a1[2] + b1[2] + dsk * bflo(xs.w)) * silu_f(bflo(zz.w)); v[7] = (a1[3] + b1[3] + dsk * bfhi(xs.w)) * silu_f(bfhi(zz.w));
        float ss = 0.f;
#pragma unroll
        for (int i = 0; i < 8; ++i) ss += v[i] * v[i];
        const float rstd = rsqrtf(wsum(ss) * (1.f / 512.f) + EPS);
        const float* ng = p.ssd_norm_g + (size_t)l * 512 + ch;
        const f32x4 g0 = *(const f32x4*)ng, g1 = *(const f32x4*)(ng + 4);
        u32x4 o; o.x = pk2(v[0] * rstd * g0[0], v[1] * rstd * g0[1]); o.y = pk2(v[2] * rstd * g0[2], v[3] * rstd * g0[3]);
        o.z = pk2(v[4] * rstd * g1[0], v[5] * rstd * g1[1]); o.w = pk2(v[6] * rstd * g1[2], v[7] * rstd * g1[3]);
        *(u32x4*)(p.Y3 + ((size_t)T + row) * 512 + ch) = o;
    }
}

__device__ __forceinline__ void phase_select(const P& p, LAS unsigned char* lds) {
    LAS unsigned* keys = (LAS unsigned*)lds;
    LAS unsigned* hist = keys + 16384;
    LAS unsigned* misc = hist + 256;
    const int tid = p.tid, lane = p.lane, wave = p.wave;
    for (int it = p.bid; it < 32; it += p.G) {
        const int set = it >> 4, e = it & 15;
        const int n = set ? NCTX : NLAT, cap = set ? CAP_C : CAP_L, row0 = set ? 0 : NCTX, slot0 = set ? CAP_L : 0;
        const float* src = p.AFFT + (size_t)e * T + row0;
        __syncthreads();
        for (int i = tid; i < n; i += NTHR) keys[i] = __float_as_uint(src[i]);
        unsigned prefix = 0u, mask = 0u, need = (unsigned)cap;
        for (int pass = 3; pass >= 0; --pass) {
            if (tid < 256) hist[tid] = 0u;
            __syncthreads();
            for (int i = tid; i < n; i += NTHR) { const unsigned k = keys[i]; if ((k & mask) == prefix) __hip_atomic_fetch_add(&hist[(k >> (8 * pass)) & 255u], 1u, __ATOMIC_RELAXED, __HIP_MEMORY_SCOPE_WORKGROUP); }
            __syncthreads();
            if (wave == 0) {
                const unsigned h0 = hist[4 * lane], h1 = hist[4 * lane + 1], h2 = hist[4 * lane + 2], h3 = hist[4 * lane + 3];
                const unsigned c = h0 + h1 + h2 + h3; unsigned S = c;
#pragma unroll
                for (int o = 1; o < 64; o <<= 1) { const unsigned t = __shfl_down(S, o); if (lane + o < 64) S += t; }
                const unsigned Snext = S - c;
                if (S >= need && Snext < need) { unsigned rem = need - Snext; unsigned bin;
                    if (h3 >= rem) bin = 3; else { rem -= h3; if (h2 >= rem) bin = 2; else { rem -= h2; if (h1 >= rem) bin = 1; else { rem -= h1; bin = 0; } } }
                    misc[0] = 4 * lane + bin; misc[1] = rem; }
            }
            __syncthreads();
            prefix |= misc[0] << (8 * pass); mask |= 0xFFu << (8 * pass); need = misc[1];
            __syncthreads();
        }
        unsigned selbase = 0u, eqbase = 0u;
        for (int base = 0; base < n; base += NTHR) {
            const int i = base + tid; const bool valid = i < n; const unsigned k = valid ? keys[i] : 0u;
            const bool eq = valid && k == prefix, gt = valid && k > prefix;
            const unsigned long long lt = (1ull << lane) - 1ull;
            const unsigned long long be = __ballot(eq);
            if (lane == 0) misc[8 + wave] = (unsigned)__popcll(be);
            __syncthreads();
            unsigned woff = 0u, tot = 0u;
#pragma unroll
            for (int w = 0; w < 8; ++w) { const unsigned v = misc[8 + w]; woff += (w < wave) ? v : 0u; tot += v; }
            const unsigned eqrank = eqbase + woff + (unsigned)__popcll(be & lt);
            const bool sel = gt || (eq && eqrank < need);
            const unsigned long long bs = __ballot(sel);
            if (lane == 0) misc[16 + wave] = (unsigned)__popcll(bs);
            __syncthreads();
            unsigned woff2 = 0u, tot2 = 0u;
#pragma unroll
            for (int w = 0; w < 8; ++w) { const unsigned v = misc[16 + w]; woff2 += (w < wave) ? v : 0u; tot2 += v; }
            if (valid) { const int row = row0 + i;
                if (sel) { const int slot = slot0 + (int)(selbase + woff2 + (unsigned)__popcll(bs & lt));
                    p.IDX[e * ESLOTS + slot] = row; p.GSEL[e * ESLOTS + slot] = __uint_as_float(k); p.INV[(size_t)row * 16 + e] = slot; }
                else p.INV[(size_t)row * 16 + e] = -1; }
            selbase += tot2; eqbase += tot;
            __syncthreads();
        }
    }
}
__device__ __forceinline__ void phase_gather(const P& p) {
    const int gw = p.bid * NWAVES + p.wave, NGW = p.G * NWAVES, lane = p.lane;
    for (int idx = gw; idx < NE * ESLOTS; idx += NGW) {
        const int slot = idx % ESLOTS; const bool valid = slot < CAP_L + CAP_C;
        u32x4 a = (u32x4){0u, 0u, 0u, 0u}, b = a;
        if (valid) { const int row = p.IDX[idx]; const u32x4* s = (const u32x4*)(p.H + (size_t)row * D); a = s[lane]; b = s[64 + lane]; }
        else if (lane == 0) p.GSEL[idx] = 0.f;
        u32x4* dst = (u32x4*)(p.XE + (size_t)idx * D); dst[lane] = a; dst[64 + lane] = b;
    }
}

#ifndef SKIPMASK
#define SKIPMASK 0
#endif
struct Args { const float* in[33]; float* out; unsigned char* ws; int ph_lo, ph_hi; };
static_assert(sizeof(Args) == 35 * 8 + 8, "no padding");

__global__ void __launch_bounds__(NTHR, 2) fwd_kernel(Args args) {
    extern __shared__ __attribute__((aligned(16))) unsigned char lds_raw[];
    LAS unsigned char* lds = (LAS unsigned char*)lds_raw;
    const int tid_ = threadIdx.x;
    if (tid_ == 0) {
        LAS unsigned long long* tab = (LAS unsigned long long*)(lds + PTAB_OFF);
#pragma unroll
        for (int k = 0; k < 33; ++k) tab[k] = (unsigned long long)args.in[k];
        tab[33] = (unsigned long long)args.out; tab[34] = (unsigned long long)args.ws;
    }
    volatile LAS unsigned* MISC = (volatile LAS unsigned*)(lds + MISC_OFF);
    if (tid_ < 64) MISC[tid_] = 0u;
    __syncthreads();
    XcdBarrier bar; bar.bar = (unsigned*)(args.ws + WS_CTL) + CW_BAR; bar.x = 0; bar.st = nullptr;
    if (!MK_PER_PHASE) bar = xcd_barrier_post((unsigned*)(args.ws + WS_CTL) + CW_BAR, MISC + 8);

    const int lo = args.ph_lo, hi = args.ph_hi;
#define IN(k) (lo <= (k) && (k) < hi)
#define SEAM(k) do { if (!MK_PER_PHASE && (k) + 1 < hi) xcd_barrier(bar); } while (0)

    if (IN(0)) { P p; build_P(p, lds); phase_mod(p, lds); SEAM(0); }

    for (int l = 0; l < DEPTH; ++l) {
        const int pb = 1 + NPH_LAYER * l;
        if (!(SKIPMASK >> 0 & 1) && IN(pb + 0)) { P p; build_P(p, lds); convert_weights(p, l, lds); __syncthreads(); row_pass<0>(p, l, lds); SEAM(pb + 0); }
        if (!(SKIPMASK >> 1 & 1) && IN(pb + 1)) { P p; build_P(p, lds); pg8::Gemm g{p.H, p.WIN, T, PJ, D}; pg8::StaticOrder S; S.init(T, PJ, p.G, p.bid); pg8::EpiStoreBf16 E{p.PROJ, PJ};
            pg8::gemm_phase<pg8::EpiStoreBf16, pg8::StaticOrder, false>(lds, g, S, E, nullptr); SEAM(pb + 1); }
        if (!(SKIPMASK >> 2 & 1) && IN(pb + 2)) { P p; build_P(p, lds); phase_premix(p, l, lds); SEAM(pb + 2); }
        if (!(SKIPMASK >> 3 & 1) && IN(pb + 3)) { P p; build_P(p, lds);
            if (p.wave < 4) ssd_scan_naive(p, l);
            else { const int aw = p.bid * 4 + (p.wave - 4), NAW = p.G * 4; s5_carry_scan(p, l, aw, NAW); attention_naive(p, l, aw, NAW, (LAS float*)(lds + p.wave * 4096)); }
            SEAM(pb + 3); }
        if (!(SKIPMASK >> 4 & 1) && IN(pb + 4)) { P p; build_P(p, lds); phase_postmix(p, l, lds); SEAM(pb + 4); }
        if (!(SKIPMASK >> 5 & 1) && IN(pb + 5)) { P p; build_P(p, lds); pg8::Gemm g{p.SA, p.WGLU, T, 512, 512}; pg8::StaticOrder S; S.init(T, 512, p.G, p.bid); pg8::EpiGlu E{p.SA, p.b_glu + (size_t)l * 512, p.Y3};
            pg8::gemm_phase<pg8::EpiGlu, pg8::StaticOrder, false>(lds, g, S, E, nullptr); SEAM(pb + 5); }
        if (!(SKIPMASK >> 6 & 1) && IN(pb + 6)) { P p; build_P(p, lds); pg8::Gemm g{p.Y3, p.WBR, 3 * T, 3072, 512}; pg8::MergeOrder S{p.G, p.bid}; pg8::EpiMerge E{p.PROJ, p.PM, p.MB};
            pg8::gemm_phase<pg8::EpiMerge, pg8::MergeOrder, false>(lds, g, S, E, nullptr); SEAM(pb + 6); }
        if (!(SKIPMASK >> 7 & 1) && IN(pb + 7)) { P p; build_P(p, lds); pg8::Gemm g{p.MB, p.WOUT, T, D, D}; pg8::StaticOrder S; S.init(T, D, p.G, p.bid);
            pg8::EpiResid E{p.XL, p.XC, p.MOD + (size_t)(l * 2 + 0) * 6144 + 2 * D, p.MOD + (size_t)(l * 2 + 1) * 6144 + 2 * D};
            pg8::gemm_phase<pg8::EpiResid, pg8::StaticOrder, false>(lds, g, S, E, nullptr); SEAM(pb + 7); }
        if (!(SKIPMASK >> 8 & 1) && IN(pb + 8)) { P p; build_P(p, lds); row_pass<1>(p, l, lds); SEAM(pb + 8); }
        if (!(SKIPMASK >> 9 & 1) && IN(pb + 9)) { P p; build_P(p, lds); phase_select(p, lds); SEAM(pb + 9); }
        if (!(SKIPMASK >> 10 & 1) && IN(pb + 10)) { P p; build_P(p, lds); phase_gather(p); SEAM(pb + 10); }
        if (!(SKIPMASK >> 11 & 1) && IN(pb + 11)) { P p; build_P(p, lds); pg8::Gemm g{p.XE, p.WUP, NE * ESLOTS, NE * 2048, D}; pg8::ExpertOrder S{p.G, p.bid, 8}; pg8::EpiSwiGlu E{p.HID};
            pg8::gemm_phase<pg8::EpiSwiGlu, pg8::ExpertOrder, false>(lds, g, S, E, nullptr); SEAM(pb + 11); }
        if (!(SKIPMASK >> 12 & 1) && IN(pb + 12)) { P p; build_P(p, lds); pg8::Gemm g{p.HID, p.WDN, NE * ESLOTS, NE * 1024, D}; pg8::ExpertOrder S{p.G, p.bid, 4}; pg8::EpiDown E{p.YE, p.GSEL};
            pg8::gemm_phase<pg8::EpiDown, pg8::ExpertOrder, false>(lds, g, S, E, nullptr); SEAM(pb + 12); }
    }
    if (IN(NPHASES - 1)) { P p; build_P(p, lds); row_pass<2>(p, 0, lds); }
#undef IN
#undef SEAM
}

extern "C" void kernel_launch(void* const* d_in, const int* in_sizes, int n_in, void* d_out, int out_size, void* d_ws, size_t ws_size, hipStream_t stream) {
    static int grid = 0;
    if (grid == 0) {
        if (n_in != 33 || out_size != NLAT * D || ws_size < WS_END) { fprintf(stderr, "kernel_launch: unexpected shapes: n_in %d out %d ws %zu (need %zu)\n", n_in, out_size, ws_size, (size_t)WS_END); grid = -1; return; }
        int dev = 0, cus = 0, per_cu = 0;
        if (hipGetDevice(&dev) != hipSuccess || hipDeviceGetAttribute(&cus, hipDeviceAttributeMultiprocessorCount, dev) != hipSuccess) { grid = -1; return; }
        if (hipFuncSetAttribute((const void*)fwd_kernel, hipFuncAttributeMaxDynamicSharedMemorySize, LDS_BYTES) != hipSuccess) { fprintf(stderr, "kernel_launch: hipFuncSetAttribute failed\n"); grid = -1; return; }
        if (hipOccupancyMaxActiveBlocksPerMultiprocessor(&per_cu, (const void*)fwd_kernel, NTHR, LDS_BYTES) != hipSuccess || per_cu < 1) { fprintf(stderr, "kernel_launch: occupancy query says %d\n", per_cu); (void)hipGetLastError(); }
        grid = cus;
    }
    if (grid < 0) return;
    (void)hipMemsetAsync((char*)d_ws + WS_CTL, 0, CTL_BYTES, stream);
    Args a{};
    for (int i = 0; i < 33; ++i) a.in[i] = (const float*)d_in[i];
    a.out = (float*)d_out; a.ws = (unsigned char*)d_ws;
#if MK_PER_PHASE
    for (int ph = 0; ph < NPHASES; ++ph) { a.ph_lo = ph; a.ph_hi = ph + 1; hipLaunchKernelGGL(fwd_kernel, dim3(grid), dim3(NTHR), LDS_BYTES, stream, a); }
#else
    a.ph_lo = 0; a.ph_hi = NPHASES;
    hipLaunchKernelGGL(fwd_kernel, dim3(grid), dim3(NTHR), LDS_BYTES, stream, a);
#endif
}
```

```cpp
#include <hip/hip_runtime.h>
#include <cstdio>
#include <cstdint>

#ifndef MK_PER_PHASE
#define MK_PER_PHASE 0
#endif

namespace pg8 {
#define PG8_LAS __attribute__((address_space(3)))
typedef unsigned short bf16_t;
typedef short bf16x8 __attribute__((ext_vector_type(8)));
typedef float f32x4 __attribute__((ext_vector_type(4)));
typedef unsigned u32x4 __attribute__((ext_vector_type(4)));
constexpr int BM = 256, BK = 64, HALF = 128, HTB = HALF * BK * 2  , STAGE_BYTES = 8 * HTB, NXCD = 8, WGM = 8;

__host__ __device__ __forceinline__ int lds_byte(int r, int c) { const int st = (r >> 4) * 2 + (c >> 5), rr = r & 15, cc = c & 31, ob = rr * 64 + cc * 2; return st * 1024 + (ob ^ (((ob >> 9) & 1) << 5)); }
__host__ __device__ __forceinline__ void stage_rc(int b, int& R, int& C) { const int st = b / 1024, sb = b % 1024, swz = sb ^ (((sb >> 9) & 1) << 5); R = (st >> 1) * 16 + swz / 64; C = (st & 1) * 32 + (swz % 64) / 2; }
__host__ __device__ __forceinline__ int perm32(int rho) { const int n = rho >> 4, i = rho & 15; return 8 * (i >> 2) + 4 * n + (i & 3); }

struct Unit { int pm, pn; };
struct Gemm { const bf16_t* A; const bf16_t* Bt; int M, N, K; };

struct StaticOrder {
    int nM, nN, nwg, G, c;
    __host__ __device__ void init(int M, int N, int G_, int c_) { nM = M / BM; nN = N / BM; nwg = nM * nN; G = G_; c = c_; }
    __host__ __device__ bool next(int i, Unit& u) const {
        const long L = (long)i * G + c; if (L >= nwg) return false;
        int wgid = (int)L; { const int q = nwg / NXCD, r = nwg % NXCD, xcd = wgid % NXCD, off = wgid / NXCD; wgid = (xcd < r ? xcd * (q + 1) : r * (q + 1) + (xcd - r) * q) + off; }
        const int nig = WGM * nN, gid = wgid / nig, fm = gid * WGM, gsz = (nM - fm) < WGM ? (nM - fm) : WGM;
        u.pm = fm + ((wgid % nig) % gsz); u.pn = (wgid % nig) / gsz; return true;
    }
    __device__ __forceinline__ void a_ready(const Unit&) const {}
    __device__ __forceinline__ void done(const Unit&) const {}
};
__device__ __forceinline__ unsigned cvt_pk_bf16(float lo, float hi) { unsigned r; asm volatile("v_cvt_pk_bf16_f32 %0, %1, %2" : "=v"(r) : "v"(lo), "v"(hi)); return r; }
template <class Epi, class Sched, bool STAMP = false>
__device__ __forceinline__ void gemm_phase(PG8_LAS unsigned char* lds, const Gemm g, const Sched& S, const Epi& E, unsigned long long* stamps) {
    int tid_l = threadIdx.x; asm volatile("" : "+v"(tid_l));
    const int tid = tid_l, wid = __builtin_amdgcn_readfirstlane(tid >> 6), lane = tid & 63, wr = wid >> 2, wc = wid & 3, fr = lane & 15, fq = lane >> 4;
    const int K = g.K, nt = K / BK;
    int ts_lo = 0, ts_hi = 0, nts = 0; const unsigned long long rt_entry = STAMP ? (unsigned long long)wall_clock64() : 0ull;
#define PG8_STAMP() do { if (STAMP && wid == 0 && nts < 64) { const unsigned long long _c = (unsigned long long)clock64(); \
        ts_lo = (lane == nts) ? (int)(unsigned)_c : ts_lo; ts_hi = (lane == nts) ? (int)(unsigned)(_c >> 32) : ts_hi; ++nts; } } while (0)
    PG8_STAMP();
    unsigned voffA[2], voffB[2];
#pragma unroll
    for (int i = 0; i < 2; ++i) { int R, C; stage_rc(tid * 16 + i * 8192, R, C); const int Rb = Epi::PERM ? ((R & ~31) + perm32(R & 31)) : R;
        voffA[i] = (unsigned)(R * K + C) * 2u; voffB[i] = (unsigned)(Rb * K + C) * 2u; }
    const size_t kstep = (size_t)(BK * 2);
    const size_t hstep = (size_t)HALF * K * 2;
    const size_t tstep = 2 * hstep;
    const unsigned ldsw = (unsigned)wid * 1024u;
    const int aoff = lds_byte(wr * 64 + fr, fq * 8), boff = lds_byte(wc * 32 + fr, fq * 8);
#define PG8_SA(b, h) (((b) * 2 + (h)) * HTB)
#define PG8_SB(b, h) ((4 + (b) * 2 + (h)) * HTB)
#define PG8_STAGE(bufoff, gbase, voff) do { _Pragma("unroll") for (int _i = 0; _i < 2; ++_i) \
        __builtin_amdgcn_global_load_lds((const unsigned*)((const char*)(gbase) + (voff)[_i]), (PG8_LAS unsigned*)(lds + (bufoff) + ldsw + _i * 8192), 16, 0, 0); } while (0)
#define PG8_LDA(dst, b, h) do { _Pragma("unroll") for (int m = 0; m < 4; ++m) _Pragma("unroll") for (int k = 0; k < 2; ++k) dst[m][k] = *(const PG8_LAS bf16x8*)(lds + PG8_SA(b, h) + aoff + m * 2048 + k * 1024); } while (0)
#define PG8_LDB(dst, b, h) do { _Pragma("unroll") for (int n = 0; n < 2; ++n) _Pragma("unroll") for (int k = 0; k < 2; ++k) dst[n][k] = *(const PG8_LAS bf16x8*)(lds + PG8_SB(b, h) + boff + n * 2048 + k * 1024); } while (0)
#define PG8_MMA(ai, bj, At, Bt) do { __builtin_amdgcn_s_setprio(1); _Pragma("unroll") for (int m = 0; m < 4; ++m) _Pragma("unroll") for (int n = 0; n < 2; ++n) _Pragma("unroll") for (int k = 0; k < 2; ++k) \
        acc[ai][bj][m][n] = __builtin_amdgcn_mfma_f32_16x16x32_bf16(Bt[n][k], At[m][k], acc[ai][bj][m][n], 0, 0, 0); __builtin_amdgcn_s_setprio(0); } while (0)
#define PG8_WAIT_V(n) asm volatile("s_waitcnt vmcnt(" #n ")" ::: "memory")
#define PG8_WAIT_L(n) asm volatile("s_waitcnt lgkmcnt(" #n ")" ::: "memory")
#define PG8_BAR __builtin_amdgcn_s_barrier()
#define PG8_SCHED __builtin_amdgcn_sched_barrier(0)
    Unit cur, nxt; int ui = 0;
    if (!S.next(0, cur)) return;
    f32x4 acc[2][2][4][2];
#pragma unroll
    for (int a = 0; a < 2; ++a)
#pragma unroll
        for (int b = 0; b < 2; ++b)
#pragma unroll
            for (int m = 0; m < 4; ++m)
#pragma unroll
                for (int n = 0; n < 2; ++n) acc[a][b][m][n] = (f32x4){0.f, 0.f, 0.f, 0.f};
    bf16x8 At[4][2], B0[2][2], B1[2][2];
    const char* cA = (const char*)g.A + (size_t)cur.pm * tstep; const char* cB = (const char*)g.Bt + (size_t)cur.pn * tstep;
    S.a_ready(cur);
    PG8_STAGE(PG8_SB(0, 0), cB, voffB); PG8_STAGE(PG8_SA(0, 0), cA, voffA); PG8_STAGE(PG8_SB(0, 1), cB + hstep, voffB); PG8_STAGE(PG8_SA(0, 1), cA + hstep, voffA);
    if (wr == 1) PG8_BAR;
    PG8_WAIT_V(4); PG8_BAR;
    PG8_STAGE(PG8_SB(1, 0), cB + kstep, voffB); PG8_STAGE(PG8_SA(1, 0), cA + kstep, voffA); PG8_STAGE(PG8_SB(1, 1), cB + hstep + kstep, voffB);
    PG8_WAIT_V(6); PG8_BAR;
    PG8_STAMP();
    for (;;) {
        const bool has_next = S.next(ui + 1, nxt);
        const char* nA = has_next ? (const char*)g.A + (size_t)nxt.pm * tstep : cA; const char* nB = has_next ? (const char*)g.Bt + (size_t)nxt.pn * tstep : cB;
        for (int t = 0; t < nt; t += 2) {
            const bool last = (t == nt - 2);
            const char* a1 = cA + (size_t)(t + 1) * kstep;
            const char* a2 = last ? nA : cA + (size_t)(t + 2) * kstep; const char* b2 = last ? nB : cB + (size_t)(t + 2) * kstep;
            const char* a3 = a2 + kstep; const char* b3 = b2 + kstep;
            if (last && has_next) S.a_ready(nxt);
            PG8_LDB(B0, 0, 0); PG8_SCHED; PG8_LDA(At, 0, 0); PG8_STAGE(PG8_SA(1, 1), a1 + hstep, voffA);
            PG8_WAIT_L(8); PG8_BAR; PG8_WAIT_L(0); PG8_MMA(0, 0, At, B0); PG8_BAR; PG8_SCHED;
            PG8_LDB(B1, 0, 1); PG8_STAGE(PG8_SB(0, 0), b2, voffB);
            PG8_BAR; PG8_WAIT_L(0); PG8_MMA(0, 1, At, B1); PG8_BAR;
            PG8_LDA(At, 0, 1); PG8_STAGE(PG8_SA(0, 0), a2, voffA);
            PG8_BAR; PG8_WAIT_L(0); PG8_MMA(1, 0, At, B0); PG8_BAR; PG8_SCHED;
            PG8_STAGE(PG8_SB(0, 1), b2 + hstep, voffB);
            PG8_WAIT_V(6); PG8_BAR; PG8_MMA(1, 1, At, B1); PG8_BAR;
            PG8_LDB(B0, 1, 0); PG8_SCHED; PG8_LDA(At, 1, 0); PG8_STAGE(PG8_SA(0, 1), a2 + hstep, voffA);
            PG8_WAIT_L(8); PG8_BAR; PG8_WAIT_L(0); PG8_MMA(0, 0, At, B0); PG8_BAR; PG8_SCHED;
            PG8_LDB(B1, 1, 1); PG8_STAGE(PG8_SB(1, 0), b3, voffB);
            PG8_BAR; PG8_WAIT_L(0); PG8_MMA(0, 1, At, B1); PG8_BAR;
            PG8_LDA(At, 1, 1); PG8_STAGE(PG8_SA(1, 0), a3, voffA);
            PG8_BAR; PG8_WAIT_L(0); PG8_MMA(1, 0, At, B0); PG8_BAR; PG8_SCHED;
            PG8_STAGE(PG8_SB(1, 1), b3 + hstep, voffB);
            PG8_WAIT_V(6); PG8_BAR; PG8_MMA(1, 1, At, B1); PG8_BAR;
        }
        PG8_STAMP();
        if constexpr (!Epi::AFTER_DRAIN) { E(acc, cur, wr, wc, fr, fq); S.done(cur); }
        PG8_STAMP();
        if (!has_next) break;
#pragma unroll
        for (int a = 0; a < 2; ++a)
#pragma unroll
            for (int b = 0; b < 2; ++b)
#pragma unroll
                for (int m = 0; m < 4; ++m)
#pragma unroll
                    for (int n = 0; n < 2; ++n) acc[a][b][m][n] = (f32x4){0.f, 0.f, 0.f, 0.f};
        cur = nxt; cA = nA; cB = nB; ++ui;
    }
    PG8_WAIT_V(0);
    if (wr == 0) PG8_BAR;
    PG8_BAR;
    if constexpr (Epi::AFTER_DRAIN) { E.fused(acc, cur, wr, wc, fr, fq, lds, wid, lane); S.done(cur); }
    PG8_STAMP();
    if (STAMP && wid == 0) { stamps[lane] = lane < nts ? (((unsigned long long)(unsigned)ts_hi << 32) | (unsigned)ts_lo) : 0ull;
        if (lane == 62) stamps[62] = rt_entry; if (lane == 63) stamps[63] = (unsigned long long)wall_clock64(); }
#undef PG8_STAMP
#undef PG8_SA
#undef PG8_SB
#undef PG8_STAGE
#undef PG8_LDA
#undef PG8_LDB
#undef PG8_MMA
#undef PG8_WAIT_V
#undef PG8_WAIT_L
#undef PG8_BAR
#undef PG8_SCHED
}
}

#define GAS __attribute__((address_space(1)))
#define LAS __attribute__((address_space(3)))
typedef unsigned short bf16;
typedef float f32x4 __attribute__((ext_vector_type(4)));
typedef unsigned u32x4 __attribute__((ext_vector_type(4)));
typedef unsigned u32x2 __attribute__((ext_vector_type(2)));

constexpr int D = 1024, NLAT = 16384, NCTX = 256, T = NLAT + NCTX, DEPTH = 4;
constexpr int IN_W = 5904, PJ = 5888;
constexpr int U0 = 0, Z0 = 512, XB0 = 1024, Q0 = 2048, K0 = 2560, V0 = 2688, GT0 = 2816;
constexpr int NE = 16, ESLOTS = 2304, CAP_L = 2048, CAP_C = 32;
constexpr int NCH = 130;
constexpr float EPS = 1e-6f;
constexpr int NWAVES = 8, NTHR = 512;
constexpr int LDS_BYTES = 155648;
constexpr int MISC_OFF = LDS_BYTES - 1024 + 512;
constexpr int NPH_LAYER = 14, NPHASES = 1 + DEPTH * NPH_LAYER + 1;

constexpr size_t al256(size_t x) { return (x + 255) & ~(size_t)255; }
constexpr size_t WS_CTL = 0, CTL_BYTES = 1u << 20;
constexpr size_t WS_MOD = WS_CTL + CTL_BYTES;
constexpr size_t WS_XC = al256(WS_MOD + (size_t)DEPTH * 2 * 6144 * 4);
constexpr size_t WS_WIN = al256(WS_XC + (size_t)NCTX * D * 4);
constexpr size_t WS_WGLU = al256(WS_WIN + (size_t)PJ * D * 2);
constexpr size_t WS_WBR = al256(WS_WGLU + (size_t)512 * 512 * 2);
constexpr size_t WS_WOUT = al256(WS_WBR + (size_t)3 * 1024 * 512 * 2);
constexpr size_t WS_WUP = al256(WS_WOUT + (size_t)1024 * 1024 * 2);
constexpr size_t WS_WDN = al256(WS_WUP + (size_t)NE * 2048 * 1024 * 2);
constexpr size_t WS_H = al256(WS_WDN + (size_t)NE * 1024 * 1024 * 2);
constexpr size_t WS_PROJ = al256(WS_H + (size_t)T * D * 2);
constexpr size_t WS_XE = WS_PROJ;
constexpr size_t WS_HID = al256(WS_XE + (size_t)NE * ESLOTS * D * 2);
constexpr size_t WS_DT = al256(WS_PROJ + (size_t)T * PJ * 2);
constexpr size_t WS_CV = al256(WS_DT + (size_t)T * 16 * 4);
constexpr size_t WS_S5E = al256(WS_CV + (size_t)T * 1024 * 2);
constexpr size_t WS_S5H = al256(WS_S5E + (size_t)2 * 32 * NCH * 128 * 4);
constexpr size_t WS_YD = al256(WS_S5H + (size_t)2 * 32 * NCH * 128 * 4);
constexpr size_t WS_SA = al256(WS_YD + (size_t)2 * T * 512 * 4);
constexpr size_t WS_Y3 = al256(WS_SA + (size_t)T * 512 * 2);
constexpr size_t WS_PM = al256(WS_Y3 + (size_t)3 * T * 512 * 2);
constexpr size_t WS_MB = al256(WS_PM + (size_t)T * D * 4);
constexpr size_t WS_YE = WS_PM;
constexpr size_t WS_AFFT = al256(WS_MB + (size_t)T * D * 2);
constexpr size_t WS_IDX = al256(WS_AFFT + (size_t)NE * T * 4);
constexpr size_t WS_GSEL = al256(WS_IDX + (size_t)NE * ESLOTS * 4);
constexpr size_t WS_INV = al256(WS_GSEL + (size_t)NE * ESLOTS * 4);
constexpr size_t WS_DEC = al256(WS_INV + (size_t)T * 16 * 4);
constexpr size_t WS_END = al256(WS_DEC + (size_t)2 * NCH * 8 * 4);
constexpr size_t WS_SST = WS_YD;
constexpr size_t WS_HIN = WS_PM;
constexpr size_t WS_YS = al256(WS_HIN + (size_t)2 * NCH * 8 * 8192 * 2);
static_assert(WS_YS + (size_t)T * 512 * 2 <= WS_AFFT, "HIN|YS overlay fits PM|MB");
static_assert(WS_HID + (size_t)NE * ESLOTS * D * 2 <= WS_DT, "XE|HID overlay fits PROJ");
static_assert(WS_YE + (size_t)NE * ESLOTS * D * 2 <= WS_AFFT, "YE overlay fits PM|MB");
static_assert(WS_END < (size_t)1000 * 1024 * 1024, "workspace");
constexpr int CW_BAR = 4096;

__device__ __forceinline__ float bf2f(unsigned b) { return __uint_as_float(b << 16); }
__device__ __forceinline__ float bflo(unsigned w) { return __uint_as_float(w << 16); }
__device__ __forceinline__ float bfhi(unsigned w) { return __uint_as_float(w & 0xffff0000u); }
__device__ __forceinline__ unsigned f2bf(float f) { unsigned u = __float_as_uint(f); u += 0x7FFFu + ((u >> 16) & 1u); return u >> 16; }
__device__ __forceinline__ unsigned pk2(float lo, float hi) { return f2bf(lo) | (f2bf(hi) << 16); }
__device__ __forceinline__ float wsum(float v) {
#pragma unroll
    for (int o = 1; o < 64; o <<= 1) v += __shfl_xor(v, o);
    return v;
}
__device__ __forceinline__ float wmaxf(float v) {
#pragma unroll
    for (int o = 1; o < 64; o <<= 1) v = fmaxf(v, __shfl_xor(v, o));
    return v;
}
__device__ __forceinline__ float silu_f(float x) { return x / (1.f + expf(-x)); }
__device__ __forceinline__ float sigmoid_f(float x) { return 1.f / (1.f + expf(-x)); }
__device__ __forceinline__ float softplus_f(float x) { return x > 20.f ? x : log1pf(expf(x)); }
__device__ __forceinline__ float gelu_tanh_f(float x) { const float u = 0.7978845608028654f * (x + 0.044715f * x * x * x); return 0.5f * x * (1.f + tanhf(u)); }
#define LDS_FENCE() asm volatile("s_waitcnt lgkmcnt(0)" ::: "memory")
__device__ __forceinline__ int scan_row(int d, int s) { return d == 0 ? s : (s < NCTX ? (NCTX - 1 - s) : (T + NCTX - 1 - s)); }

namespace pg8 {
struct EpiStoreBf16 {
    static constexpr bool PERM = true, AFTER_DRAIN = false;
    bf16_t* O; int ldc;
    __device__ __forceinline__ void operator()(const f32x4 (&acc)[2][2][4][2], const Unit& u, int wr, int wc, int fr, int fq) const {
        const int row0 = u.pm * BM + wr * 64 + fr, col0 = u.pn * BM + wc * 32 + 8 * fq;
#pragma unroll
        for (int ai = 0; ai < 2; ++ai)
#pragma unroll
            for (int m = 0; m < 4; ++m) { bf16_t* rowp = O + (size_t)(row0 + ai * HALF + m * 16) * ldc + col0;
#pragma unroll
                for (int bj = 0; bj < 2; ++bj) { const f32x4 v0 = acc[ai][bj][m][0], v1 = acc[ai][bj][m][1];
                    u32x4 w; w.x = cvt_pk_bf16(v0[0], v0[1]); w.y = cvt_pk_bf16(v0[2], v0[3]); w.z = cvt_pk_bf16(v1[0], v1[1]); w.w = cvt_pk_bf16(v1[2], v1[3]);
                    *(u32x4*)(rowp + bj * HALF) = w; } }
    }
};
struct EpiGlu {
    static constexpr bool PERM = true, AFTER_DRAIN = false;
    const bf16_t* A; const float* bias; bf16_t* O;
    __device__ __forceinline__ void operator()(const f32x4 (&acc)[2][2][4][2], const Unit& u, int wr, int wc, int fr, int fq) const {
        const int row0 = u.pm * BM + wr * 64 + fr, col0 = u.pn * BM + wc * 32 + 8 * fq;
#pragma unroll
        for (int ai = 0; ai < 2; ++ai)
#pragma unroll
            for (int m = 0; m < 4; ++m) { const size_t ro = (size_t)(row0 + ai * HALF + m * 16) * 512 + col0;
#pragma unroll
                for (int bj = 0; bj < 2; ++bj) { const f32x4 v0 = acc[ai][bj][m][0], v1 = acc[ai][bj][m][1];
                    const u32x4 a = *(const u32x4*)(A + ro + bj * HALF);
                    const f32x4 b0 = *(const f32x4*)(bias + col0 + bj * HALF), b1 = *(const f32x4*)(bias + col0 + bj * HALF + 4);
                    float o[8];
                    o[0] = bflo(a.x) * sigmoid_f(v0[0] + b0[0]); o[1] = bfhi(a.x) * sigmoid_f(v0[1] + b0[1]);
                    o[2] = bflo(a.y) * sigmoid_f(v0[2] + b0[2]); o[3] = bfhi(a.y) * sigmoid_f(v0[3] + b0[3]);
                    o[4] = bflo(a.z) * sigmoid_f(v1[0] + b1[0]); o[5] = bfhi(a.z) * sigmoid_f(v1[1] + b1[1]);
                    o[6] = bflo(a.w) * sigmoid_f(v1[2] + b1[2]); o[7] = bfhi(a.w) * sigmoid_f(v1[3] + b1[3]);
                    u32x4 w; w.x = cvt_pk_bf16(o[0], o[1]); w.y = cvt_pk_bf16(o[2], o[3]); w.z = cvt_pk_bf16(o[4], o[5]); w.w = cvt_pk_bf16(o[6], o[7]);
                    *(u32x4*)(O + ro + bj * HALF) = w; } }
    }
};
struct MergeOrder {
    int G, c;
    __device__ __forceinline__ bool next(int i, Unit& u) const { const int pr = (i / 3) * G + c; if (pr >= 65 * 4) return false; const int k = i % 3; u.pm = k * 65 + (pr >> 2); u.pn = k * 4 + (pr & 3); return true; }
    __device__ __forceinline__ void a_ready(const Unit&) const {}
    __device__ __forceinline__ void done(const Unit&) const {}
};
struct EpiMerge {
    static constexpr bool PERM = true, AFTER_DRAIN = false;
    const bf16_t* proj; float* PM; bf16_t* MB;
    __device__ __forceinline__ void operator()(const f32x4 (&acc)[2][2][4][2], const Unit& u, int wr, int wc, int fr, int fq) const {
        const int k = u.pn >> 2, pn = u.pn & 3, pm = u.pm - 65 * k;
        const int row0 = pm * BM + wr * 64 + fr, col0 = pn * BM + wc * 32 + 8 * fq;
#pragma unroll
        for (int ai = 0; ai < 2; ++ai)
#pragma unroll
            for (int m = 0; m < 4; ++m) { const int row = row0 + ai * HALF + m * 16;
#pragma unroll
                for (int bj = 0; bj < 2; ++bj) { const f32x4 v0 = acc[ai][bj][m][0], v1 = acc[ai][bj][m][1];
                    const int col = col0 + bj * HALF;
                    const u32x4 g = *(const u32x4*)(proj + (size_t)row * PJ + GT0 + k * 1024 + col);
                    f32x4 o0, o1;
                    o0[0] = sigmoid_f(bflo(g.x)) * v0[0]; o0[1] = sigmoid_f(bfhi(g.x)) * v0[1]; o0[2] = sigmoid_f(bflo(g.y)) * v0[2]; o0[3] = sigmoid_f(bfhi(g.y)) * v0[3];
                    o1[0] = sigmoid_f(bflo(g.z)) * v1[0]; o1[1] = sigmoid_f(bfhi(g.z)) * v1[1]; o1[2] = sigmoid_f(bflo(g.w)) * v1[2]; o1[3] = sigmoid_f(bfhi(g.w)) * v1[3];
                    float* pp = PM + (size_t)row * 1024 + col;
                    if (k > 0) { o0 += *(const f32x4*)pp; o1 += *(const f32x4*)(pp + 4); }
                    if (k < 2) { *(f32x4*)pp = o0; *(f32x4*)(pp + 4) = o1; }
                    else { u32x4 w; w.x = cvt_pk_bf16(o0[0], o0[1]); w.y = cvt_pk_bf16(o0[2], o0[3]); w.z = cvt_pk_bf16(o1[0], o1[1]); w.w = cvt_pk_bf16(o1[2], o1[3]);
                        *(u32x4*)(MB + (size_t)row * 1024 + col) = w; } } }
    }
};
struct EpiResid {
    static constexpr bool PERM = false, AFTER_DRAIN = false;
    float* XL; float* XC; const float* g_lat; const float* g_ctx;
    __device__ __forceinline__ void operator()(const f32x4 (&acc)[2][2][4][2], const Unit& u, int wr, int wc, int fr, int fq) const {
        const bool isc = (u.pm == 0);
        float* base = isc ? XC : (XL - (size_t)NCTX * D); const float* gv = isc ? g_ctx : g_lat;
        const int row0 = u.pm * BM + wr * 64 + fr, col0 = u.pn * BM + wc * 32 + 4 * fq;
#pragma unroll
        for (int ai = 0; ai < 2; ++ai)
#pragma unroll
            for (int m = 0; m < 4; ++m) { float* rowp = base + (size_t)(row0 + ai * HALF + m * 16) * D + col0;
#pragma unroll
                for (int bj = 0; bj < 2; ++bj)
#pragma unroll
                    for (int n = 0; n < 2; ++n) { float* pp = rowp + bj * HALF + n * 16; const f32x4 g = *(const f32x4*)(gv + col0 + bj * HALF + n * 16);
                        f32x4 x = *(const f32x4*)pp; x += g * acc[ai][bj][m][n]; *(f32x4*)pp = x; } }
    }
};
struct ExpertOrder {
    int G, c, nnt;
    __device__ __forceinline__ bool next(int i, Unit& u) const { const int L = i * G + c; if (L >= NE * 9 * nnt) return false; const int e = L / (9 * nnt), rem = L % (9 * nnt); u.pm = e * 9 + rem % 9; u.pn = e * nnt + rem / 9; return true; }
    __device__ __forceinline__ void a_ready(const Unit&) const {}
    __device__ __forceinline__ void done(const Unit&) const {}
};
struct EpiSwiGlu {
    static constexpr bool PERM = true, AFTER_DRAIN = false;
    bf16_t* HID;
    __device__ __forceinline__ void operator()(const f32x4 (&acc)[2][2][4][2], const Unit& u, int wr, int wc, int fr, int fq) const {
        const int row0 = u.pm * BM + wr * 64 + fr, col0 = (u.pn & 7) * 128 + wc * 32 + 8 * fq;
#pragma unroll
        for (int ai = 0; ai < 2; ++ai)
#pragma unroll
            for (int m = 0; m < 4; ++m) { const f32x4 g0 = acc[ai][0][m][0], g1 = acc[ai][0][m][1], u0 = acc[ai][1][m][0], u1 = acc[ai][1][m][1];
                u32x4 w;
                w.x = cvt_pk_bf16(silu_f(g0[0]) * u0[0], silu_f(g0[1]) * u0[1]); w.y = cvt_pk_bf16(silu_f(g0[2]) * u0[2], silu_f(g0[3]) * u0[3]);
                w.z = cvt_pk_bf16(silu_f(g1[0]) * u1[0], silu_f(g1[1]) * u1[1]); w.w = cvt_pk_bf16(silu_f(g1[2]) * u1[2], silu_f(g1[3]) * u1[3]);
                *(u32x4*)(HID + (size_t)(row0 + ai * HALF + m * 16) * 1024 + col0) = w; }
    }
};
struct EpiDown {
    static constexpr bool PERM = true, AFTER_DRAIN = false;
    bf16_t* YE; const float* gsel;
    __device__ __forceinline__ void operator()(const f32x4 (&acc)[2][2][4][2], const Unit& u, int wr, int wc, int fr, int fq) const {
        const int row0 = u.pm * BM + wr * 64 + fr, col0 = (u.pn & 3) * BM + wc * 32 + 8 * fq;
#pragma unroll
        for (int ai = 0; ai < 2; ++ai)
#pragma unroll
            for (int m = 0; m < 4; ++m) { const int row = row0 + ai * HALF + m * 16; const float gs = gsel[row];
#pragma unroll
                for (int bj = 0; bj < 2; ++bj) { const f32x4 v0 = acc[ai][bj][m][0] * gs, v1 = acc[ai][bj][m][1] * gs;
                    u32x4 w; w.x = cvt_pk_bf16(v0[0], v0[1]); w.y = cvt_pk_bf16(v0[2], v0[3]); w.z = cvt_pk_bf16(v1[0], v1[1]); w.w = cvt_pk_bf16(v1[2], v1[3]);
                    *(u32x4*)(YE + (size_t)row * 1024 + col0 + bj * HALF) = w; } }
    }
};
}
#define XB_TMO      128
#define XB_XCNT(j)  (256  + 64 * (j))
#define XB_XSUB(j)  (1280 + 64 * (j))
#define XB_XGEN(j)  (2304 + 64 * (j))
#define XB_TOP      3328
#define XB_TOPGEN   3392
#define XCD_BAR_WORDS 3456
#define XB_SPIN_CAP (1u << 18)
#define LAS __attribute__((address_space(3)))

__device__ __forceinline__ unsigned xb_ld(unsigned* p)              { return __hip_atomic_load(p, __ATOMIC_RELAXED, __HIP_MEMORY_SCOPE_AGENT); }
__device__ __forceinline__ unsigned xb_add(unsigned* p, unsigned v) { return __hip_atomic_fetch_add(p, v, __ATOMIC_RELAXED, __HIP_MEMORY_SCOPE_AGENT); }
__device__ __forceinline__ unsigned xb_xcc_id() { return (unsigned)__builtin_amdgcn_s_getreg((3 << 11) | 20) & 0xFu; }
#define XB_SPIN(cond, bar) do { unsigned _sp = 0; while (cond) { __builtin_amdgcn_s_sleep(1); \
    if ((++_sp & 255u) == 0u) { if (xb_ld(&(bar)[XB_TMO])) break; if (_sp > XB_SPIN_CAP) { atomicAdd(&(bar)[XB_TMO], 1u); break; } } } } while (0)

struct XcdBarrier {
    unsigned* bar; unsigned x;
    volatile LAS unsigned* st;
};

__device__ __forceinline__ XcdBarrier xcd_barrier_post(unsigned* bar, volatile LAS unsigned* st) {
    XcdBarrier b; b.bar = bar; b.x = xb_xcc_id(); b.st = st;
    if (threadIdx.x == 0) (void)xb_add(&bar[XB_XCNT(b.x)], 1u);
    return b;
}
__device__ __forceinline__ void xcd_barrier_complete(unsigned* bar, unsigned x, unsigned& nloc, unsigned& nx) {
    const unsigned G = gridDim.x * gridDim.y * gridDim.z;
    unsigned sum, cnt, mine, sp = 0u;
    for (;;) {
        sum = 0u; cnt = 0u; mine = 0u;
#pragma unroll
        for (unsigned j = 0; j < 16; ++j) { const unsigned c = xb_ld(&bar[XB_XCNT(j)]); sum += c; cnt += (c > 0u) ? 1u : 0u; mine = (j == x) ? c : mine; }
        if (sum == G) break;
        __builtin_amdgcn_s_sleep(1);
        if ((++sp & 255u) == 0u) { if (xb_ld(&bar[XB_TMO])) break; if (sp > XB_SPIN_CAP) { atomicAdd(&bar[XB_TMO], 1u); break; } }
    }
    nloc = mine > 0u ? mine : 1u; nx = cnt > 0u ? cnt : 1u;
}

__device__ __forceinline__ void xcd_barrier(const XcdBarrier& b) {
    asm volatile("s_waitcnt vmcnt(0)" ::: "memory");
    __syncthreads();
    if (threadIdx.x == 0) {
        unsigned* bar = b.bar;
        __builtin_amdgcn_s_waitcnt(0);
        unsigned nloc = b.st[0], nx = b.st[1];
        if (nloc == 0u) { xcd_barrier_complete(bar, b.x, nloc, nx); b.st[0] = nloc; b.st[1] = nx; }
        const unsigned old = xb_add(&bar[XB_XSUB(b.x)], 1u);
        const unsigned gen = old / nloc;
        if (old + 1u == (gen + 1u) * nloc) {
            __builtin_amdgcn_fence(__ATOMIC_RELEASE, "agent");
            asm volatile("s_waitcnt vmcnt(0)" ::: "memory");
            const unsigned og = xb_add(&bar[XB_TOP], 1u);
            const unsigned tg = og / nx;
            if (og + 1u == (tg + 1u) * nx) xb_add(&bar[XB_TOPGEN], 1u);
            else XB_SPIN(xb_ld(&bar[XB_TOPGEN]) == tg, bar);
            __builtin_amdgcn_fence(__ATOMIC_ACQUIRE, "agent");
            xb_add(&bar[XB_XGEN(b.x)], 1u);
            asm volatile("s_waitcnt vmcnt(0)" ::: "memory");
        } else {
            XB_SPIN(xb_ld(&bar[XB_XGEN(b.x)]) == gen, bar);
            __builtin_amdgcn_fence(__ATOMIC_ACQUIRE, "agent");
            asm volatile("s_waitcnt vmcnt(0)" ::: "memory");
        }
    }
    __syncthreads();
}


struct P {
    const float *x, *c, *ctx, *c_ctx, *w_mod, *b_mod, *norm1_g, *norm2_g, *w_in, *lam_re, *lam_im, *log_dt, *b_re, *b_im, *c_re, *c_im, *s5_d, *w_glu, *b_glu,
        *conv_w, *conv_b, *a_log, *dt_bias, *ssd_d, *ssd_norm_g, *sink, *w_branch, *w_out, *w_router, *w_eg, *w_eu, *w_ed, *final_g;
    float* XL;
    float *MOD, *XC, *DT, *S5E, *S5H, *YD, *PM, *AFFT, *GSEL;
    bf16 *WIN, *WGLU, *WBR, *WOUT, *WUP, *WDN, *H, *PROJ, *XE, *HID, *CV, *SA, *Y3, *MB, *YE;
    int *IDX, *INV;
    int tid, lane, wave, bid, G;
};


constexpr int PTAB_OFF = LDS_BYTES - 1024;
__device__ __forceinline__ unsigned long long ld_tab(volatile LAS unsigned* t, int k) {
    const unsigned lo = __builtin_amdgcn_readfirstlane(t[2 * k]), hi = __builtin_amdgcn_readfirstlane(t[2 * k + 1]);
    return ((unsigned long long)hi << 32) | lo;
}
__device__ __forceinline__ void build_P(P& p, LAS unsigned char* lds) {
    int tid_l = threadIdx.x, bid_l = blockIdx.x, g_l = gridDim.x;
    asm volatile("" : "+v"(tid_l), "+s"(bid_l), "+s"(g_l));
    p.tid = tid_l; p.lane = p.tid & 63; p.wave = __builtin_amdgcn_readfirstlane(p.tid >> 6); p.bid = bid_l; p.G = g_l;
    unsigned tbase = (unsigned)(size_t)(lds + PTAB_OFF); asm volatile("" : "+v"(tbase));
    volatile LAS unsigned* tb = (volatile LAS unsigned*)(size_t)tbase;
#define INP(k) ((const float*)ld_tab(tb, k))
    p.x = INP(0); p.c = INP(1); p.ctx = INP(2); p.c_ctx = INP(3); p.w_mod = INP(4); p.b_mod = INP(5); p.norm1_g = INP(6); p.norm2_g = INP(7);
    p.w_in = INP(8); p.lam_re = INP(9); p.lam_im = INP(10); p.log_dt = INP(11); p.b_re = INP(12); p.b_im = INP(13); p.c_re = INP(14); p.c_im = INP(15);
    p.s5_d = INP(16); p.w_glu = INP(17); p.b_glu = INP(18); p.conv_w = INP(19); p.conv_b = INP(20); p.a_log = INP(21); p.dt_bias = INP(22); p.ssd_d = INP(23);
    p.ssd_norm_g = INP(24); p.sink = INP(25); p.w_branch = INP(26); p.w_out = INP(27); p.w_router = INP(28); p.w_eg = INP(29); p.w_eu = INP(30); p.w_ed = INP(31);
    p.final_g = INP(32);
#undef INP
    p.XL = (float*)ld_tab(tb, 33);
    unsigned char* ws = (unsigned char*)ld_tab(tb, 34);
    p.MOD = (float*)(ws + WS_MOD); p.XC = (float*)(ws + WS_XC); p.DT = (float*)(ws + WS_DT); p.S5E = (float*)(ws + WS_S5E); p.S5H = (float*)(ws + WS_S5H); p.YD = (float*)(ws + WS_YD);
    p.PM = (float*)(ws + WS_PM); p.AFFT = (float*)(ws + WS_AFFT); p.GSEL = (float*)(ws + WS_GSEL);
    p.WIN = (bf16*)(ws + WS_WIN); p.WGLU = (bf16*)(ws + WS_WGLU); p.WBR = (bf16*)(ws + WS_WBR); p.WOUT = (bf16*)(ws + WS_WOUT); p.WUP = (bf16*)(ws + WS_WUP); p.WDN = (bf16*)(ws + WS_WDN);
    p.H = (bf16*)(ws + WS_H); p.PROJ = (bf16*)(ws + WS_PROJ); p.XE = (bf16*)(ws + WS_XE); p.HID = (bf16*)(ws + WS_HID); p.CV = (bf16*)(ws + WS_CV); p.SA = (bf16*)(ws + WS_SA);
    p.Y3 = (bf16*)(ws + WS_Y3); p.MB = (bf16*)(ws + WS_MB); p.YE = (bf16*)(ws + WS_YE);
    p.IDX = (int*)(ws + WS_IDX); p.INV = (int*)(ws + WS_INV);
}
__device__ __forceinline__ void phase_mod(const P& p, LAS unsigned char* lds) {
    LAS float* sc = (LAS float*)lds;
    LAS float* part = sc + 2048;
    for (int i = p.tid; i < 1024; i += NTHR) { sc[i] = silu_f(p.c[i]); sc[1024 + i] = silu_f(p.c_ctx[i]); }
    __syncthreads();
    for (int it = p.bid; it < DEPTH * 48; it += p.G) {
        const int l = it / 48, cb = it % 48, c0 = cb * 128 + 2 * p.lane;
        const float* W = p.w_mod + (size_t)l * 1024 * 6144 + c0;
        float a00 = 0.f, a01 = 0.f, a10 = 0.f, a11 = 0.f;
        const int kb = p.wave * 128;
#pragma unroll 8
        for (int k = kb; k < kb + 128; ++k) { const float2 w = *(const float2*)(W + (size_t)k * 6144); const float s0 = sc[k], s1 = sc[1024 + k];
            a00 += s0 * w.x; a01 += s0 * w.y; a10 += s1 * w.x; a11 += s1 * w.y; }
        part[(p.wave * 2 + 0) * 128 + 2 * p.lane] = a00; part[(p.wave * 2 + 0) * 128 + 2 * p.lane + 1] = a01;
        part[(p.wave * 2 + 1) * 128 + 2 * p.lane] = a10; part[(p.wave * 2 + 1) * 128 + 2 * p.lane + 1] = a11;
        __syncthreads();
        if (p.tid < 256) { const int s = p.tid >> 7, col = p.tid & 127; float r = p.b_mod[l * 6144 + cb * 128 + col];
#pragma unroll
            for (int w = 0; w < 8; ++w) r += part[(w * 2 + s) * 128 + col];
            p.MOD[(size_t)(l * 2 + s) * 6144 + cb * 128 + col] = r; }
        __syncthreads();
    }
}

__device__ __forceinline__ void tr_item(const float* src, int ldw, int K, bf16* dst, int kb, LAS float* scr, int lane) {
    const int k0 = 64 * kb;
#pragma unroll 8
    for (int i = 0; i < 32; ++i) { const int kk = 2 * i + (lane >> 5); scr[kk * 33 + (lane & 31)] = src[(size_t)(k0 + kk) * ldw + (lane & 31)]; }
    LDS_FENCE();
    const int c = lane & 7;
#pragma unroll
    for (int j = 0; j < 4; ++j) { const int n = (lane >> 3) + 8 * j; const LAS float* s = scr + (8 * c) * 33 + n;
        u32x4 o; o.x = pk2(s[0 * 33], s[1 * 33]); o.y = pk2(s[2 * 33], s[3 * 33]); o.z = pk2(s[4 * 33], s[5 * 33]); o.w = pk2(s[6 * 33], s[7 * 33]);
        *(u32x4*)(dst + (size_t)n * K + k0 + 8 * c) = o; }
    LDS_FENCE();
}
__device__ __forceinline__ void convert_weights(const P& p, int l, LAS unsigned char* lds) {
    LAS float* scr = (LAS float*)(lds + p.wave * 8704);
    const int gw = p.bid * NWAVES + p.wave, NGW = p.G * NWAVES;
    constexpr int I_A = 64 * 16, I_B = 120 * 16, I_GLU = 16 * 8, I_BR = 3 * 32 * 8, I_OUT = 32 * 16, I_E = 16 * 32 * 16;
    constexpr int NIT = I_A + I_B + I_GLU + I_BR + I_OUT + 3 * I_E;
    const float* win = p.w_in + (size_t)l * 1024 * IN_W;
    for (int it = gw; it < NIT; it += NGW) {
        int r = it;
        if (r < I_A) { const int nb = r >> 4, kb = r & 15; tr_item(win + 32 * nb, IN_W, 1024, p.WIN + (size_t)(32 * nb) * 1024, kb, scr, p.lane); continue; } r -= I_A;
        if (r < I_B) { const int nb = r >> 4, kb = r & 15; tr_item(win + 2064 + 32 * nb, IN_W, 1024, p.WIN + (size_t)(2048 + 32 * nb) * 1024, kb, scr, p.lane); continue; } r -= I_B;
        if (r < I_GLU) { const int nb = r >> 3, kb = r & 7; tr_item(p.w_glu + (size_t)l * 512 * 512 + 32 * nb, 512, 512, p.WGLU + (size_t)(32 * nb) * 512, kb, scr, p.lane); continue; } r -= I_GLU;
        if (r < I_BR) { const int kk = r >> 8, nb = (r >> 3) & 31, kb = r & 7;
            tr_item(p.w_branch + ((size_t)l * 3 + kk) * 512 * 1024 + 32 * nb, 1024, 512, p.WBR + (size_t)(kk * 1024 + 32 * nb) * 512, kb, scr, p.lane); continue; } r -= I_BR;
        if (r < I_OUT) { const int nb = r >> 4, kb = r & 15; tr_item(p.w_out + (size_t)l * 1024 * 1024 + 32 * nb, 1024, 1024, p.WOUT + (size_t)(32 * nb) * 1024, kb, scr, p.lane); continue; } r -= I_OUT;
        const int which = r / I_E; r -= which * I_E;
        const int e = r >> 9, nb = (r >> 4) & 31, kb = r & 15;
        const size_t eo = ((size_t)l * NE + e) * 1024 * 1024;
        if (which == 0) tr_item(p.w_eg + eo + 32 * nb, 1024, 1024, p.WUP + (size_t)(e * 2048 + 256 * (nb >> 2) + 32 * (nb & 3)) * 1024, kb, scr, p.lane);
        else if (which == 1) tr_item(p.w_eu + eo + 32 * nb, 1024, 1024, p.WUP + (size_t)(e * 2048 + 256 * (nb >> 2) + 128 + 32 * (nb & 3)) * 1024, kb, scr, p.lane);
        else tr_item(p.w_ed + eo + 32 * nb, 1024, 1024, p.WDN + (size_t)(e * 1024 + 32 * nb) * 1024, kb, scr, p.lane);
    }
}

template <int MODE> __device__ __forceinline__ void row_pass(const P& p, int l, LAS unsigned char* lds) {
    LAS float* W16 = (LAS float*)lds;
    if (MODE != 2) {
        const float* src = (MODE == 0) ? (p.w_in + (size_t)l * 1024 * IN_W + 2048) : (p.w_router + (size_t)l * 1024 * 16);
        const int ld = (MODE == 0) ? IN_W : 16;
        for (int i = p.tid; i < 1024 * 16; i += NTHR) { const int k = i >> 4, j = i & 15; W16[k * 20 + j] = src[(size_t)k * ld + j]; }
        __syncthreads();
    }
    const int gw = p.bid * NWAVES + p.wave, NGW = p.G * NWAVES, lane = p.lane;
    for (int row = gw + (MODE == 2 ? NCTX : 0); row < T; row += NGW) {
        const bool isc = row < NCTX;
        float* xrow = isc ? (p.XC + (size_t)row * D) : (p.XL + (size_t)(row - NCTX) * D);
        float v[16];
        if (MODE == 0 && l == 0) { const float* s = isc ? (p.ctx + (size_t)row * D) : (p.x + (size_t)(row - NCTX) * D);
#pragma unroll
            for (int i = 0; i < 16; ++i) v[i] = s[lane + 64 * i];
        } else {
#pragma unroll
            for (int i = 0; i < 16; ++i) v[i] = xrow[lane + 64 * i];
        }
        if ((MODE == 0 && l > 0) || MODE == 2) {
            const int lp = (MODE == 2) ? (DEPTH - 1) : (l - 1);
            const float* g2 = p.MOD + (size_t)(lp * 2 + (isc ? 1 : 0)) * 6144 + 5 * D;
            float s[16];
#pragma unroll
            for (int i = 0; i < 16; ++i) s[i] = 0.f;
            for (int e = 0; e < NE; ++e) { const int slot = p.INV[(size_t)row * 16 + e];
                if (slot >= 0) { const bf16* yr = p.YE + ((size_t)e * ESLOTS + slot) * D;
#pragma unroll
                    for (int i = 0; i < 16; ++i) s[i] += bf2f(yr[lane + 64 * i]); } }
#pragma unroll
            for (int i = 0; i < 16; ++i) v[i] += g2[lane + 64 * i] * s[i];
        }
        if (MODE == 0) {
#pragma unroll
            for (int i = 0; i < 16; ++i) xrow[lane + 64 * i] = v[i];
        }
        float ss = 0.f;
#pragma unroll
        for (int i = 0; i < 16; ++i) ss += v[i] * v[i];
        const float rstd = rsqrtf(wsum(ss) * (1.f / D) + EPS);
        if (MODE == 2) {
#pragma unroll
            for (int i = 0; i < 16; ++i) xrow[lane + 64 * i] = v[i] * rstd * p.final_g[lane + 64 * i];
            continue;
        }
        const float* gam = (MODE == 0 ? p.norm1_g : p.norm2_g) + (size_t)l * D;
        const float* md = p.MOD + (size_t)(l * 2 + (isc ? 1 : 0)) * 6144 + (MODE == 0 ? 0 : 3 * D);
        bf16* hrow = p.H + (size_t)row * D;
        float acc[16];
#pragma unroll
        for (int j = 0; j < 16; ++j) acc[j] = 0.f;
#pragma unroll
        for (int i = 0; i < 16; ++i) { const int k = lane + 64 * i;
            const float hv = v[i] * rstd * gam[k] * (1.f + md[D + k]) + md[k];
            hrow[k] = (bf16)f2bf(hv);
            const LAS f32x4* wr = (const LAS f32x4*)(W16 + k * 20);
            const f32x4 w0 = wr[0], w1 = wr[1], w2 = wr[2], w3 = wr[3];
            acc[0] += hv * w0[0]; acc[1] += hv * w0[1]; acc[2] += hv * w0[2]; acc[3] += hv * w0[3];
            acc[4] += hv * w1[0]; acc[5] += hv * w1[1]; acc[6] += hv * w1[2]; acc[7] += hv * w1[3];
            acc[8] += hv * w2[0]; acc[9] += hv * w2[1]; acc[10] += hv * w2[2]; acc[11] += hv * w2[3];
            acc[12] += hv * w3[0]; acc[13] += hv * w3[1]; acc[14] += hv * w3[2]; acc[15] += hv * w3[3];
            if ((i & 1) == 1) asm volatile("" ::: "memory"); }
#pragma unroll
        for (int j = 0; j < 16; ++j) acc[j] = wsum(acc[j]);
        if (MODE == 0) {
            float mine = 0.f;
#pragma unroll
            for (int j = 0; j < 16; ++j) mine = (lane == j) ? acc[j] : mine;
            if (lane < 16) p.DT[(size_t)row * 16 + lane] = softplus_f(mine + p.dt_bias[l * 16 + lane]);
        } else {
            float mx = acc[0];
#pragma unroll
            for (int j = 1; j < 16; ++j) mx = fmaxf(mx, acc[j]);
            float sum = 0.f, mine = 0.f;
#pragma unroll
            for (int j = 0; j < 16; ++j) { const float e = expf(acc[j] - mx); sum += e; mine = (lane == j) ? e : mine; }
            if (lane < 16) p.AFFT[(size_t)lane * T + row] = mine / sum;
        }
    }
}

struct S5Lane { float abr, abi; float bbr[16], bbi[16]; };
__device__ __forceinline__ void s5_lane_params(const P& p, int l, int d, int g, int lane, S5Lane& o, bool withB) {
    const size_t gi = ((size_t)(l * 2 + d) * 32 + g);
    const float lr = p.lam_re[gi * 64 + lane], li = p.lam_im[gi * 64 + lane], dt = expf(p.log_dt[gi]);
    const float mag = expf(lr * dt); float sn, cs; sincosf(li * dt, &sn, &cs);
    o.abr = mag * cs; o.abi = mag * sn;
    if (withB) {
        const float den = lr * lr + li * li;
        const float fr = ((o.abr - 1.f) * lr + o.abi * li) / den, fi = (o.abi * lr - (o.abr - 1.f) * li) / den;
        const f32x4* br = (const f32x4*)(p.b_re + (gi * 64 + lane) * 16); const f32x4* bi = (const f32x4*)(p.b_im + (gi * 64 + lane) * 16);
#pragma unroll
        for (int q = 0; q < 4; ++q) { const f32x4 r4 = br[q], i4 = bi[q];
#pragma unroll
            for (int j = 0; j < 4; ++j) { o.bbr[4 * q + j] = fr * r4[j] - fi * i4[j]; o.bbi[4 * q + j] = fr * i4[j] + fi * r4[j]; } }
    }
}
__device__ __forceinline__ void s5_stage_u(const P& p, int r0, int g, LAS unsigned char* ub, int lane) {
#pragma unroll
    for (int j = 0; j < 4; ++j) { const int q = lane + 64 * j, i = q >> 1, half = q & 1;
        const u32x4 w = *(const u32x4*)(p.PROJ + (size_t)(r0 + i) * PJ + U0 + g * 16 + half * 8);
        *(LAS u32x4*)(ub + i * 32 + half * 16) = w; }
    LDS_FENCE();
}
__device__ __forceinline__ void s5_step(const S5Lane& s, const LAS unsigned char* ub, int i, float& hr, float& hi) {
    const u32x4 a = *(const LAS u32x4*)(ub + i * 32), b = *(const LAS u32x4*)(ub + i * 32 + 16);
    float u[16];
    u[0] = bflo(a.x); u[1] = bfhi(a.x); u[2] = bflo(a.y); u[3] = bfhi(a.y); u[4] = bflo(a.z); u[5] = bfhi(a.z); u[6] = bflo(a.w); u[7] = bfhi(a.w);
    u[8] = bflo(b.x); u[9] = bfhi(b.x); u[10] = bflo(b.y); u[11] = bfhi(b.y); u[12] = bflo(b.z); u[13] = bfhi(b.z); u[14] = bflo(b.w); u[15] = bfhi(b.w);
    float br = 0.f, bi = 0.f;
#pragma unroll
    for (int k = 0; k < 16; ++k) { br += s.bbr[k] * u[k]; bi += s.bbi[k] * u[k]; }
    const float nr = s.abr * hr - s.abi * hi + br, ni = s.abr * hi + s.abi * hr + bi;
    hr = nr; hi = ni;
}

__device__ __forceinline__ void phase_premix(const P& p, int l, LAS unsigned char* lds) {
    const float* cw = p.conv_w + (size_t)l * 5 * 1024; const float* cb = p.conv_b + (size_t)l * 1024;
    for (int idx = p.bid * NTHR + p.tid; idx < T * 128; idx += p.G * NTHR) {
        const int row = idx >> 7, c8 = (idx & 127) * 8;
        const int lo = row < NCTX ? 0 : NCTX, hi = row < NCTX ? NCTX : T;
        float a[8];
        { const f32x4 b0 = *(const f32x4*)(cb + c8), b1 = *(const f32x4*)(cb + c8 + 4);
          a[0] = b0[0]; a[1] = b0[1]; a[2] = b0[2]; a[3] = b0[3]; a[4] = b1[0]; a[5] = b1[1]; a[6] = b1[2]; a[7] = b1[3]; }
#pragma unroll
        for (int j = 0; j < 5; ++j) { const int r = row + j - 2;
            if (r >= lo && r < hi) { const u32x4 xv = *(const u32x4*)(p.PROJ + (size_t)r * PJ + XB0 + c8);
                const f32x4 w0 = *(const f32x4*)(cw + j * 1024 + c8), w1 = *(const f32x4*)(cw + j * 1024 + c8 + 4);
                a[0] += w0[0] * bflo(xv.x); a[1] += w0[1] * bfhi(xv.x); a[2] += w0[2] * bflo(xv.y); a[3] += w0[3] * bfhi(xv.y);
                a[4] += w1[0] * bflo(xv.z); a[5] += w1[1] * bfhi(xv.z); a[6] += w1[2] * bflo(xv.w); a[7] += w1[3] * bfhi(xv.w); } }
        u32x4 o; o.x = pk2(silu_f(a[0]), silu_f(a[1])); o.y = pk2(silu_f(a[2]), silu_f(a[3])); o.z = pk2(silu_f(a[4]), silu_f(a[5])); o.w = pk2(silu_f(a[6]), silu_f(a[7]));
        *(u32x4*)(p.CV + (size_t)row * 1024 + c8) = o;
    }
    for (int idx = p.bid * NTHR + p.tid; idx < NLAT * 160; idx += p.G * NTHR) {
        const int i = idx & 15, hh = (idx >> 4) % 10, t = idx / 160;
        bf16* base = p.PROJ + (size_t)(NCTX + t) * PJ + (hh < 8 ? Q0 + hh * 64 : K0 + (hh - 8) * 64);
        const float inv = exp2f(-(float)i * 0.83048202372184058696f);
        const float ar = (float)(t >> 6) * inv, ac = (float)(t & 63) * inv;
        float sr, cr, sc, cc; sincosf(ar, &sr, &cr); sincosf(ac, &sc, &cc);
        { const float x1 = bf2f(base[i]), x2 = bf2f(base[16 + i]); base[i] = (bf16)f2bf(x1 * cr - x2 * sr); base[16 + i] = (bf16)f2bf(x2 * cr + x1 * sr); }
        { const float x1 = bf2f(base[32 + i]), x2 = bf2f(base[48 + i]); base[32 + i] = (bf16)f2bf(x1 * cc - x2 * sc); base[48 + i] = (bf16)f2bf(x2 * cc + x1 * sc); }
    }
    LAS unsigned char* ub = lds + p.wave * 4096;
    const int gw = p.bid * NWAVES + p.wave, NGW = p.G * NWAVES;
    for (int it = gw; it < 2 * 32 * NCH; it += NGW) {
        const int d = it / (32 * NCH), g = (it / NCH) & 31, c = it % NCH;
        S5Lane s; s5_lane_params(p, l, d, g, p.lane, s, true);
        const int r0 = (d == 0) ? 128 * c : (c < 2 ? 128 * (1 - c) : 128 * (NCH + 1 - c));
        s5_stage_u(p, r0, g, ub, p.lane);
        float hr = 0.f, hi = 0.f;
        for (int i = 0; i < 128; ++i) s5_step(s, ub, d == 0 ? i : 127 - i, hr, hi);
        float* E = p.S5E + ((size_t)(d * 32 + g) * NCH + c) * 128;
        E[p.lane] = hr; E[64 + p.lane] = hi;
        LDS_FENCE();
    }
}

__device__ __forceinline__ void ssd_scan_naive(const P& p, int l) {
    for (int it = p.bid * 4 + p.wave; it < 1024; it += p.G * 4) {
        const int d = it >> 9, hd = (it >> 6) & 7, pp = it & 63, grp = hd >> 2;
        const float a = -expf(p.a_log[l * 16 + d * 8 + hd]);
        const int colB = 512 + grp * 128 + p.lane, colC = 768 + grp * 128 + p.lane, colX = hd * 64 + pp, dcol = d * 8 + hd;
        float h0 = 0.f, h1 = 0.f;
        for (int s0 = 0; s0 < T; s0 += 8) {
            unsigned b0[8], b1[8], c0[8], c1[8], xx[8]; float dtv[8]; int rr[8];
#pragma unroll
            for (int j = 0; j < 8; ++j) { const int r = scan_row(d, s0 + j); rr[j] = r; const bf16* cv = p.CV + (size_t)r * 1024;
                b0[j] = cv[colB]; b1[j] = cv[colB + 64]; c0[j] = cv[colC]; c1[j] = cv[colC + 64]; xx[j] = cv[colX]; dtv[j] = p.DT[(size_t)r * 16 + dcol]; }
#pragma unroll
            for (int j = 0; j < 8; ++j) { const float dec = expf(dtv[j] * a), dx = dtv[j] * bf2f(xx[j]);
                h0 = dec * h0 + dx * bf2f(b0[j]); h1 = dec * h1 + dx * bf2f(b1[j]);
                const float y = wsum(bf2f(c0[j]) * h0 + bf2f(c1[j]) * h1);
                if (p.lane == 0) p.YD[((size_t)d * T + rr[j]) * 512 + colX] = y; }
        }
    }
}
__device__ __forceinline__ void s5_carry_scan(const P& p, int l, int aw, int NAW) {
    for (int it = aw; it < 64; it += NAW) {
        const int d = it >> 5, g = it & 31;
        S5Lane s; s5_lane_params(p, l, d, g, p.lane, s, false);
        float ar = s.abr, ai = s.abi;
#pragma unroll
        for (int q = 0; q < 7; ++q) { const float nr = ar * ar - ai * ai, ni = 2.f * ar * ai; ar = nr; ai = ni; }
        float hr = 0.f, hi = 0.f;
        const float* E = p.S5E + (size_t)(d * 32 + g) * NCH * 128; float* Hn = p.S5H + (size_t)(d * 32 + g) * NCH * 128;
        for (int c = 0; c < NCH; ++c) { Hn[c * 128 + p.lane] = hr; Hn[c * 128 + 64 + p.lane] = hi;
            const float er = E[c * 128 + p.lane], ei = E[c * 128 + 64 + p.lane];
            const float nr = ar * hr - ai * hi + er, ni = ar * hi + ai * hr + ei; hr = nr; hi = ni; }
    }
}
__device__ __forceinline__ void attention_naive(const P& p, int l, int aw, int NAW, LAS float* pbuf) {
    const int lane = p.lane;
    for (int it = aw; it < T * 8; it += NAW) {
        const int row = it >> 3, hq = it & 7, kvh = hq >> 2;
        const bool isc = row < NCTX; const int t = row - NCTX;
        const int jlo = isc ? 0 : (t - 128 < 0 ? 0 : t - 128), jhi = isc ? -1 : (t + 128 > NLAT - 1 ? NLAT - 1 : t + 128);
        const int nloc = jhi - jlo + 1, nk = nloc + NCTX;
        const float sink = p.sink[l * 8 + hq];
        float q[64];
        { const u32x4* qp = (const u32x4*)(p.PROJ + (size_t)row * PJ + Q0 + hq * 64);
#pragma unroll
          for (int c = 0; c < 8; ++c) { const u32x4 w = qp[c]; q[8 * c] = bflo(w.x); q[8 * c + 1] = bfhi(w.x); q[8 * c + 2] = bflo(w.y); q[8 * c + 3] = bfhi(w.y);
              q[8 * c + 4] = bflo(w.z); q[8 * c + 5] = bfhi(w.z); q[8 * c + 6] = bflo(w.w); q[8 * c + 7] = bfhi(w.w); } }
        float sc[9]; float mx = sink;
#pragma unroll
        for (int i = 0; i < 9; ++i) { const int kk = lane + 64 * i; float s = -INFINITY;
            if (kk < nk) { const int krow = kk < nloc ? NCTX + jlo + kk : kk - nloc;
                const u32x4* kp = (const u32x4*)(p.PROJ + (size_t)krow * PJ + K0 + kvh * 64); float dot = 0.f;
#pragma unroll
                for (int c = 0; c < 8; ++c) { const u32x4 w = kp[c];
                    dot += q[8 * c] * bflo(w.x) + q[8 * c + 1] * bfhi(w.x) + q[8 * c + 2] * bflo(w.y) + q[8 * c + 3] * bfhi(w.y)
                         + q[8 * c + 4] * bflo(w.z) + q[8 * c + 5] * bfhi(w.z) + q[8 * c + 6] * bflo(w.w) + q[8 * c + 7] * bfhi(w.w); }
                s = dot * 0.125f; }
            sc[i] = s; mx = fmaxf(mx, s); }
        mx = wmaxf(mx);
        float sum = 0.f;
#pragma unroll
        for (int i = 0; i < 9; ++i) { const int kk = lane + 64 * i; const float e = (kk < nk) ? expf(sc[i] - mx) : 0.f; pbuf[kk] = e; sum += e; }
        const float den = wsum(sum) + expf(sink - mx);
        LDS_FENCE();
        float o = 0.f;
        const bf16* vb = p.PROJ + V0 + kvh * 64 + lane;
#pragma unroll 4
        for (int kk = 0; kk < nk; ++kk) { const int vrow = kk < nloc ? NCTX + jlo + kk : kk - nloc; o += pbuf[kk] * bf2f(vb[(size_t)vrow * PJ]); }
        p.Y3[((size_t)2 * T + row) * 512 + hq * 64 + lane] = (bf16)f2bf(o / den);
        LDS_FENCE();
    }
}

__device__ __forceinline__ void phase_postmix(const P& p, int l, LAS unsigned char* lds) {
    constexpr int CSH_BYTES = 2 * 2 * 16 * 68 * 4, WREG = 16640;
    LAS float* Csh = (LAS float*)lds;
    LAS unsigned char* wreg = lds + CSH_BYTES + p.wave * WREG;
    LAS unsigned char* ub = wreg;
    LAS float* Hb = (LAS float*)(wreg + 4096);
    LAS float* Yb = (LAS float*)(wreg + 4096 + 4224);
    const int lane = p.lane;
    for (int it = p.bid; it < 32 * 17; it += p.G) {
        const int g = it / 17, chunk = (it % 17) * 8 + p.wave;
        __syncthreads();
        for (int i = p.tid; i < 2 * 2 * 16 * 64; i += NTHR) { const int pq = i & 63, k = (i >> 6) & 15, ri = (i >> 10) & 1, d = i >> 11;
            const float* src = ri ? p.c_im : p.c_re; Csh[((d * 2 + ri) * 16 + k) * 68 + pq] = src[(((size_t)(l * 2 + d) * 32 + g) * 16 + k) * 64 + pq]; }
        __syncthreads();
        if (chunk < NCH) {
            const int r0 = 128 * chunk;
            s5_stage_u(p, r0, g, ub, lane);
            for (int d = 0; d < 2; ++d) {
                S5Lane s; s5_lane_params(p, l, d, g, lane, s, true);
                const int cs = (d == 0) ? chunk : (chunk < 2 ? 1 - chunk : NCH + 1 - chunk);
                const float* Hn = p.S5H + ((size_t)(d * 32 + g) * NCH + cs) * 128;
                float hr = Hn[lane], hi = Hn[64 + lane];
                const LAS float* Cr = Csh + (d * 2 + 0) * 16 * 68; const LAS float* Ci = Csh + (d * 2 + 1) * 16 * 68;
                for (int sub = 0; sub < 16; ++sub) {
#pragma unroll
                    for (int j = 0; j < 8; ++j) { const int is = sub * 8 + j; s5_step(s, ub, d == 0 ? is : 127 - is, hr, hi); Hb[j * 132 + lane] = hr; Hb[j * 132 + 64 + lane] = hi; }
                    LDS_FENCE();
#pragma unroll
                    for (int m = 0; m < 2; ++m) { const int o = lane + 64 * m, j = o >> 4, k = o & 15; float y = 0.f;
#pragma unroll
                        for (int q = 0; q < 16; ++q) { const f32x4 cr = *(const LAS f32x4*)(Cr + k * 68 + 4 * q), ci = *(const LAS f32x4*)(Ci + k * 68 + 4 * q);
                            const f32x4 xr = *(const LAS f32x4*)(Hb + j * 132 + 4 * q), xi = *(const LAS f32x4*)(Hb + j * 132 + 64 + 4 * q);
                            y += cr[0] * xr[0] + cr[1] * xr[1] + cr[2] * xr[2] + cr[3] * xr[3] - ci[0] * xi[0] - ci[1] * xi[1] - ci[2] * xi[2] - ci[3] * xi[3]; }
                        const int is = sub * 8 + j, i = (d == 0) ? is : 127 - is;
                        if (d == 0) Yb[i * 16 + k] = y; else Yb[i * 16 + k] += y; }
                    LDS_FENCE();
                }
            }
            const float* dsk = p.s5_d + (size_t)l * 512 + g * 16;
#pragma unroll
            for (int m = 0; m < 2; ++m) { const int i = lane + 64 * m;
                const u32x4 ua = *(const LAS u32x4*)(ub + i * 32), ubv = *(const LAS u32x4*)(ub + i * 32 + 16);
                float u[16];
                u[0] = bflo(ua.x); u[1] = bfhi(ua.x); u[2] = bflo(ua.y); u[3] = bfhi(ua.y); u[4] = bflo(ua.z); u[5] = bfhi(ua.z); u[6] = bflo(ua.w); u[7] = bfhi(ua.w);
                u[8] = bflo(ubv.x); u[9] = bfhi(ubv.x); u[10] = bflo(ubv.y); u[11] = bfhi(ubv.y); u[12] = bflo(ubv.z); u[13] = bfhi(ubv.z); u[14] = bflo(ubv.w); u[15] = bfhi(ubv.w);
                float a[16];
#pragma unroll
                for (int k = 0; k < 16; ++k) a[k] = gelu_tanh_f(Yb[i * 16 + k] + dsk[k] * u[k]);
                u32x4 o0, o1; o0.x = pk2(a[0], a[1]); o0.y = pk2(a[2], a[3]); o0.z = pk2(a[4], a[5]); o0.w = pk2(a[6], a[7]);
                o1.x = pk2(a[8], a[9]); o1.y = pk2(a[10], a[11]); o1.z = pk2(a[12], a[13]); o1.w = pk2(a[14], a[15]);
                bf16* dst = p.SA + (size_t)(r0 + i) * 512 + g * 16;
                *(u32x4*)dst = o0; *(u32x4*)(dst + 8) = o1; }
            LDS_FENCE();
        }
    }
}

__device__ __forceinline__ void phase_select(const P& p, LAS unsigned char* lds) {
    LAS unsigned* keys = (LAS unsigned*)lds;
    LAS unsigned* hist = keys + 16384;
    LAS unsigned* misc = hist + 256;
    const int tid = p.tid, lane = p.lane, wave = p.wave;
    for (int it = p.bid; it < 32; it += p.G) {
        const int set = it >> 4, e = it & 15;
        const int n = set ? NCTX : NLAT, cap = set ? CAP_C : CAP_L, row0 = set ? 0 : NCTX, slot0 = set ? CAP_L : 0;
        const float* src = p.AFFT + (size_t)e * T + row0;
        __syncthreads();
        for (int i = tid; i < n; i += NTHR) keys[i] = __float_as_uint(src[i]);
        unsigned prefix = 0u, mask = 0u, need = (unsigned)cap;
        for (int pass = 3; pass >= 0; --pass) {
            if (tid < 256) hist[tid] = 0u;
            __syncthreads();
            for (int i = tid; i < n; i += NTHR) { const unsigned k = keys[i]; if ((k & mask) == prefix) __hip_atomic_fetch_add(&hist[(k >> (8 * pass)) & 255u], 1u, __ATOMIC_RELAXED, __HIP_MEMORY_SCOPE_WORKGROUP); }
            __syncthreads();
            if (wave == 0) {
                const unsigned h0 = hist[4 * lane], h1 = hist[4 * lane + 1], h2 = hist[4 * lane + 2], h3 = hist[4 * lane + 3];
                const unsigned c = h0 + h1 + h2 + h3; unsigned S = c;
#pragma unroll
                for (int o = 1; o < 64; o <<= 1) { const unsigned t = __shfl_down(S, o); if (lane + o < 64) S += t; }
                const unsigned Snext = S - c;
                if (S >= need && Snext < need) { unsigned rem = need - Snext; unsigned bin;
                    if (h3 >= rem) bin = 3; else { rem -= h3; if (h2 >= rem) bin = 2; else { rem -= h2; if (h1 >= rem) bin = 1; else { rem -= h1; bin = 0; } } }
                    misc[0] = 4 * lane + bin; misc[1] = rem; }
            }
            __syncthreads();
            prefix |= misc[0] << (8 * pass); mask |= 0xFFu << (8 * pass); need = misc[1];
            __syncthreads();
        }
        unsigned selbase = 0u, eqbase = 0u;
        for (int base = 0; base < n; base += NTHR) {
            const int i = base + tid; const bool valid = i < n; const unsigned k = valid ? keys[i] : 0u;
            const bool eq = valid && k == prefix, gt = valid && k > prefix;
            const unsigned long long lt = (1ull << lane) - 1ull;
            const unsigned long long be = __ballot(eq);
            if (lane == 0) misc[8 + wave] = (unsigned)__popcll(be);
            __syncthreads();
            unsigned woff = 0u, tot = 0u;
#pragma unroll
            for (int w = 0; w < 8; ++w) { const unsigned v = misc[8 + w]; woff += (w < wave) ? v : 0u; tot += v; }
            const unsigned eqrank = eqbase + woff + (unsigned)__popcll(be & lt);
            const bool sel = gt || (eq && eqrank < need);
            const unsigned long long bs = __ballot(sel);
            if (lane == 0) misc[16 + wave] = (unsigned)__popcll(bs);
            __syncthreads();
            unsigned woff2 = 0u, tot2 = 0u;
#pragma unroll
            for (int w = 0; w < 8; ++w) { const unsigned v = misc[16 + w]; woff2 += (w < wave) ? v : 0u; tot2 += v; }
            if (valid) { const int row = row0 + i;
                if (sel) { const int slot = slot0 + (int)(selbase + woff2 + (unsigned)__popcll(bs & lt));
                    p.IDX[e * ESLOTS + slot] = row; p.GSEL[e * ESLOTS + slot] = __uint_as_float(k); p.INV[(size_t)row * 16 + e] = slot; }
                else p.INV[(size_t)row * 16 + e] = -1; }
            selbase += tot2; eqbase += tot;
            __syncthreads();
        }
    }
}
__device__ __forceinline__ void phase_gather(const P& p) {
    const int gw = p.bid * NWAVES + p.wave, NGW = p.G * NWAVES, lane = p.lane;
    for (int idx = gw; idx < NE * ESLOTS; idx += NGW) {
        const int slot = idx % ESLOTS; const bool valid = slot < CAP_L + CAP_C;
        u32x4 a = (u32x4){0u, 0u, 0u, 0u}, b = a;
        if (valid) { const int row = p.IDX[idx]; const u32x4* s = (const u32x4*)(p.H + (size_t)row * D); a = s[lane]; b = s[64 + lane]; }
        else if (lane == 0) p.GSEL[idx] = 0.f;
        u32x4* dst = (u32x4*)(p.XE + (size_t)idx * D); dst[lane] = a; dst[64 + lane] = b;
    }
}

typedef short bf16x8 __attribute__((ext_vector_type(8)));
#define MFMA16(a, b, c) __builtin_amdgcn_mfma_f32_16x16x32_bf16((a), (b), (c), 0, 0, 0)
constexpr int LDP = 272;
constexpr int LDQ = 144;
__device__ __forceinline__ bf16x8 ld_frag(const LAS unsigned char* base, int row, int kcol, int ldb) { return *(const LAS bf16x8*)(base + row * ldb + kcol * 2); }
__device__ __forceinline__ void st_b16(LAS unsigned char* p, unsigned v) { *(LAS unsigned short*)p = (unsigned short)v; }
__device__ __forceinline__ float wscan_incl(float v, int lane) {
#pragma unroll
    for (int o = 1; o < 64; o <<= 1) { const float t = __shfl_up(v, o); if (lane >= o) v += t; }
    return v;
}
__device__ __forceinline__ int chunk_r0(int d, int cs) { return d == 0 ? 128 * cs : (cs < 2 ? 128 * (1 - cs) : 128 * (NCH + 1 - cs)); }
__device__ __forceinline__ int scan_chunk_of(int d, int cn) { return d == 0 ? cn : (cn < 2 ? 1 - cn : NCH + 1 - cn); }

__device__ __forceinline__ void ssd_acum(const float* DT, int r0, int d, int col, float a, int lane, LAS float* acum, LAS float* dtv, float& total) {
    const int j0 = d == 0 ? lane : 127 - lane, j1 = d == 0 ? 64 + lane : 63 - lane;
    const float dt0 = DT[(size_t)(r0 + j0) * 16 + col], dt1 = DT[(size_t)(r0 + j1) * 16 + col];
    const float s0 = wscan_incl(dt0 * a, lane); const float t0 = __shfl(s0, 63);
    const float s1 = wscan_incl(dt1 * a, lane) + t0; total = __shfl(s1, 63);
    acum[j0] = s0; acum[j1] = s1; dtv[j0] = dt0; dtv[j1] = dt1;
}

__device__ __forceinline__ void ssd_states(const P& p, int l, LAS unsigned char* lds, float* SST, float* DEC) {
    LAS unsigned char* BT = lds;
    LAS unsigned char* XW = lds + 128 * LDP;
    LAS float* wj = (LAS float*)(lds + 128 * LDP + 4 * 64 * LDP);
    const int tid = p.tid, lane = p.lane, wave = p.wave, quad = lane >> 4, l15 = lane & 15;
    for (int u = p.bid; u < 2 * NCH * 2; u += p.G) {
        const int d = u / (2 * NCH), cs = (u % (2 * NCH)) >> 1, g = u & 1;
        const int r0 = chunk_r0(d, cs);
        __syncthreads();
        if (wave < 4) { const int h = g * 4 + wave; const float a = -expf(p.a_log[l * 16 + d * 8 + h]); float total;
            LAS float* ac = wj + 512 + wave * 128; LAS float* dv = wj + 1024 + wave * 128;
            ssd_acum(p.DT, r0, d, d * 8 + h, a, lane, ac, dv, total);
            LDS_FENCE();
            wj[wave * 128 + lane] = expf(total - ac[lane]) * dv[lane]; wj[wave * 128 + 64 + lane] = expf(total - ac[64 + lane]) * dv[64 + lane];
            if (lane == 0) DEC[(d * NCH + cs) * 8 + h] = expf(total); }
        __syncthreads();
        for (int idx = tid; idx < 128 * 16; idx += NTHR) { const int j = idx >> 4, n8 = (idx & 15) * 8;
            const u32x4 v = *(const u32x4*)(p.CV + (size_t)(r0 + j) * 1024 + 512 + g * 128 + n8);
            LAS unsigned char* dst = BT + n8 * LDP + 2 * j;
            st_b16(dst, v.x & 0xffffu); st_b16(dst + LDP, v.x >> 16); st_b16(dst + 2 * LDP, v.y & 0xffffu); st_b16(dst + 3 * LDP, v.y >> 16);
            st_b16(dst + 4 * LDP, v.z & 0xffffu); st_b16(dst + 5 * LDP, v.z >> 16); st_b16(dst + 6 * LDP, v.w & 0xffffu); st_b16(dst + 7 * LDP, v.w >> 16); }
        for (int idx = tid; idx < 128 * 32; idx += NTHR) { const int j = idx >> 5, c8 = (idx & 31) * 8, hh = c8 >> 6, p8 = c8 & 63;
            const u32x4 v = *(const u32x4*)(p.CV + (size_t)(r0 + j) * 1024 + g * 256 + c8); const float w = wj[hh * 128 + j];
            LAS unsigned char* dst = XW + (hh * 64 + p8) * LDP + 2 * j;
            st_b16(dst, f2bf(bflo(v.x) * w)); st_b16(dst + LDP, f2bf(bfhi(v.x) * w)); st_b16(dst + 2 * LDP, f2bf(bflo(v.y) * w)); st_b16(dst + 3 * LDP, f2bf(bfhi(v.y) * w));
            st_b16(dst + 4 * LDP, f2bf(bflo(v.z) * w)); st_b16(dst + 5 * LDP, f2bf(bfhi(v.z) * w)); st_b16(dst + 6 * LDP, f2bf(bflo(v.w) * w)); st_b16(dst + 7 * LDP, f2bf(bfhi(v.w) * w)); }
        __syncthreads();
        const int hh = wave >> 1, ph = wave & 1;
        f32x4 acc[2][8];
#pragma unroll
        for (int a = 0; a < 2; ++a)
#pragma unroll
            for (int b = 0; b < 8; ++b) acc[a][b] = (f32x4){0.f, 0.f, 0.f, 0.f};
#pragma unroll
        for (int ks = 0; ks < 4; ++ks) {
            bf16x8 af[2];
#pragma unroll
            for (int pt = 0; pt < 2; ++pt) af[pt] = ld_frag(XW + hh * 64 * LDP, ph * 32 + pt * 16 + l15, ks * 32 + 8 * quad, LDP);
#pragma unroll
            for (int nt = 0; nt < 8; ++nt) { const bf16x8 bfr = ld_frag(BT, nt * 16 + l15, ks * 32 + 8 * quad, LDP);
#pragma unroll
                for (int pt = 0; pt < 2; ++pt) acc[pt][nt] = MFMA16(af[pt], bfr, acc[pt][nt]); }
        }
        float* S = SST + ((size_t)(d * NCH + cs) * 8 + g * 4 + hh) * 8192;
#pragma unroll
        for (int pt = 0; pt < 2; ++pt)
#pragma unroll
            for (int nt = 0; nt < 8; ++nt)
#pragma unroll
                for (int r = 0; r < 4; ++r) S[(ph * 32 + pt * 16 + 4 * quad + r) * 128 + nt * 16 + l15] = acc[pt][nt][r];
    }
}

__device__ __forceinline__ void scan_carries(const P& p, int l, const float* SST, const float* DEC, bf16* HIN) {
    for (int e = p.bid * NTHR + p.tid; e < 2 * 8 * 8192; e += p.G * NTHR) {
        const int d = e >> 16, h = (e >> 13) & 7, pn = e & 8191;
        float hs = 0.f;
        for (int c0 = 0; c0 < NCH; c0 += 10) {
            float s[10], dc[10];
#pragma unroll
            for (int j = 0; j < 10; ++j) { const size_t ci = (size_t)(d * NCH + c0 + j) * 8 + h; s[j] = SST[ci * 8192 + pn]; dc[j] = DEC[ci]; }
#pragma unroll
            for (int j = 0; j < 10; ++j) { const size_t ci = (size_t)(d * NCH + c0 + j) * 8 + h; HIN[ci * 8192 + pn] = (bf16)f2bf(hs); hs = hs * dc[j] + s[j]; }
        }
    }
    for (int e = p.bid * NTHR + p.tid; e < 2 * 32 * 64; e += p.G * NTHR) {
        const int d = e >> 11, g = (e >> 6) & 31, pq = e & 63;
        S5Lane s; s5_lane_params(p, l, d, g, pq, s, false);
        float ar = s.abr, ai = s.abi;
#pragma unroll
        for (int q = 0; q < 7; ++q) { const float nr = ar * ar - ai * ai, ni = 2.f * ar * ai; ar = nr; ai = ni; }
        float hr = 0.f, hi = 0.f;
        const float* E = p.S5E + (size_t)(d * 32 + g) * NCH * 128 + pq; float* Hn = p.S5H + (size_t)(d * 32 + g) * NCH * 128 + pq;
        for (int c0 = 0; c0 < NCH; c0 += 10) {
            float er[10], ei[10];
#pragma unroll
            for (int j = 0; j < 10; ++j) { er[j] = E[(c0 + j) * 128]; ei[j] = E[(c0 + j) * 128 + 64]; }
#pragma unroll
            for (int j = 0; j < 10; ++j) { Hn[(c0 + j) * 128] = hr; Hn[(c0 + j) * 128 + 64] = hi;
                const float nr = ar * hr - ai * hi + er[j], ni = ar * hi + ai * hr + ei[j]; hr = nr; hi = ni; }
        }
    }
}

__device__ __forceinline__ void ssd_outputs(const P& p, int l, LAS unsigned char* lds, const bf16* HIN, bf16* YS) {
    LAS unsigned char* Cm = lds;
    LAS unsigned char* Bm = lds + 128 * LDP;
    LAS unsigned char* XT = lds + 2 * 128 * LDP;
    LAS unsigned char* Wm = lds + 2 * 128 * LDP + 64 * LDP;
    LAS float* sm = (LAS float*)(lds + 3 * 128 * LDP + 64 * LDP);
    const int tid = p.tid, lane = p.lane, wave = p.wave, quad = lane >> 4, l15 = lane & 15;
    for (int u = p.bid; u < NCH * 8; u += p.G) {
        const int cn = u >> 3, h = u & 7, g = h >> 2, r0 = 128 * cn;
        __syncthreads();
        if (wave < 2) { const int d = wave; const float a = -expf(p.a_log[l * 16 + d * 8 + h]); float total;
            ssd_acum(p.DT, r0, d, d * 8 + h, a, lane, sm + d * 128, sm + 256 + d * 128, total); }
        for (int idx = tid; idx < 128 * 16; idx += NTHR) { const int j = idx >> 4, n8 = (idx & 15) * 8;
            const bf16* src = p.CV + (size_t)(r0 + j) * 1024 + g * 128 + n8;
            *(LAS u32x4*)(Bm + j * LDP + n8 * 2) = *(const u32x4*)(src + 512); *(LAS u32x4*)(Cm + j * LDP + n8 * 2) = *(const u32x4*)(src + 768); }
        for (int idx = tid; idx < 128 * 8; idx += NTHR) { const int j = idx >> 3, p8 = (idx & 7) * 8;
            const u32x4 v = *(const u32x4*)(p.CV + (size_t)(r0 + j) * 1024 + h * 64 + p8);
            LAS unsigned char* dst = XT + p8 * LDP + 2 * j;
            st_b16(dst, v.x & 0xffffu); st_b16(dst + LDP, v.x >> 16); st_b16(dst + 2 * LDP, v.y & 0xffffu); st_b16(dst + 3 * LDP, v.y >> 16);
            st_b16(dst + 4 * LDP, v.z & 0xffffu); st_b16(dst + 5 * LDP, v.z >> 16); st_b16(dst + 6 * LDP, v.w & 0xffffu); st_b16(dst + 7 * LDP, v.w >> 16); }
        __syncthreads();
        f32x4 G[8];
#pragma unroll
        for (int jt = 0; jt < 8; ++jt) G[jt] = (f32x4){0.f, 0.f, 0.f, 0.f};
#pragma unroll
        for (int ks = 0; ks < 4; ++ks) { const bf16x8 af = ld_frag(Cm, 16 * wave + l15, ks * 32 + 8 * quad, LDP);
#pragma unroll
            for (int jt = 0; jt < 8; ++jt) G[jt] = MFMA16(af, ld_frag(Bm, 16 * jt + l15, ks * 32 + 8 * quad, LDP), G[jt]); }
        __syncthreads();
        for (int idx = tid; idx < 2 * 64 * 16; idx += NTHR) { const int d = idx >> 10, pp = (idx >> 4) & 63, n8 = (idx & 15) * 8;
            const int cs = scan_chunk_of(d, cn);
            *(LAS u32x4*)(Bm + (d * 64 + pp) * LDP + n8 * 2) = *(const u32x4*)(HIN + ((size_t)(d * NCH + cs) * 8 + h) * 8192 + pp * 128 + n8); }
        __syncthreads();
        f32x4 Y[4];
#pragma unroll
        for (int pt = 0; pt < 4; ++pt) Y[pt] = (f32x4){0.f, 0.f, 0.f, 0.f};
#pragma unroll
        for (int d = 0; d < 2; ++d) {
            const LAS float* ac = sm + d * 128; const LAS float* dv = sm + 256 + d * 128;
            float ai[4];
#pragma unroll
            for (int r = 0; r < 4; ++r) ai[r] = ac[16 * wave + 4 * quad + r];
#pragma unroll
            for (int jt = 0; jt < 8; ++jt) { const int j = 16 * jt + l15; const float aj = ac[j], dj = dv[j];
#pragma unroll
                for (int r = 0; r < 4; ++r) { const int i = 16 * wave + 4 * quad + r; const bool valid = (d == 0) ? (j <= i) : (j >= i);
                    const float w = valid ? G[jt][r] * expf(ai[r] - aj) * dj : 0.f;
                    st_b16(Wm + i * LDP + 2 * j, f2bf(w)); } }
            LDS_FENCE();
            f32x4 Y2[4];
#pragma unroll
            for (int pt = 0; pt < 4; ++pt) Y2[pt] = (f32x4){0.f, 0.f, 0.f, 0.f};
#pragma unroll
            for (int ks = 0; ks < 4; ++ks) { const bf16x8 wf = ld_frag(Wm, 16 * wave + l15, ks * 32 + 8 * quad, LDP), cf = ld_frag(Cm, 16 * wave + l15, ks * 32 + 8 * quad, LDP);
#pragma unroll
                for (int pt = 0; pt < 4; ++pt) { Y[pt] = MFMA16(wf, ld_frag(XT, 16 * pt + l15, ks * 32 + 8 * quad, LDP), Y[pt]);
                    Y2[pt] = MFMA16(cf, ld_frag(Bm + d * 64 * LDP, 16 * pt + l15, ks * 32 + 8 * quad, LDP), Y2[pt]); } }
#pragma unroll
            for (int r = 0; r < 4; ++r) { const float ea = expf(ai[r]);
#pragma unroll
                for (int pt = 0; pt < 4; ++pt) Y[pt][r] += ea * Y2[pt][r]; }
            LDS_FENCE();
        }
#pragma unroll
        for (int pt = 0; pt < 4; ++pt)
#pragma unroll
            for (int r = 0; r < 4; ++r) YS[(size_t)(r0 + 16 * wave + 4 * quad + r) * 512 + h * 64 + 16 * pt + l15] = (bf16)f2bf(Y[pt][r]);
    }
}

__device__ __forceinline__ void ssd_gated_norm(const P& p, int l, const bf16* YS) {
    const int gw = p.bid * NWAVES + p.wave, NGW = p.G * NWAVES, lane = p.lane;
    for (int row = gw; row < T; row += NGW) {
        const int ch = lane * 8;
        const float dsk = p.ssd_d[l * 8 + (ch >> 6)];
        const u32x4 yv = *(const u32x4*)(YS + (size_t)row * 512 + ch);
        const u32x4 xs = *(const u32x4*)(p.CV + (size_t)row * 1024 + ch), zz = *(const u32x4*)(p.PROJ + (size_t)row * PJ + Z0 + ch);
        float v[8];
        v[0] = (bflo(yv.x) + dsk * bflo(xs.x)) * silu_f(bflo(zz.x)); v[1] = (bfhi(yv.x) + dsk * bfhi(xs.x)) * silu_f(bfhi(zz.x));
        v[2] = (bflo(yv.y) + dsk * bflo(xs.y)) * silu_f(bflo(zz.y)); v[3] = (bfhi(yv.y) + dsk * bfhi(xs.y)) * silu_f(bfhi(zz.y));
        v[4] = (bflo(yv.z) + dsk * bflo(xs.z)) * silu_f(bflo(zz.z)); v[5] = (bfhi(yv.z) + dsk * bfhi(xs.z)) * silu_f(bfhi(zz.z));
        v[6] = (bflo(yv.w) + dsk * bflo(xs.w)) * silu_f(bflo(zz.w)); v[7] = (bfhi(yv.w) + dsk * bfhi(xs.w)) * silu_f(bfhi(zz.w));
        float ss = 0.f;
#pragma unroll
        for (int i = 0; i < 8; ++i) ss += v[i] * v[i];
        const float rstd = rsqrtf(wsum(ss) * (1.f / 512.f) + EPS);
        const float* ng = p.ssd_norm_g + (size_t)l * 512 + ch;
        const f32x4 g0 = *(const f32x4*)ng, g1 = *(const f32x4*)(ng + 4);
        u32x4 o; o.x = pk2(v[0] * rstd * g0[0], v[1] * rstd * g0[1]); o.y = pk2(v[2] * rstd * g0[2], v[3] * rstd * g0[3]);
        o.z = pk2(v[4] * rstd * g1[0], v[5] * rstd * g1[1]); o.w = pk2(v[6] * rstd * g1[2], v[7] * rstd * g1[3]);
        *(u32x4*)(p.Y3 + ((size_t)T + row) * 512 + ch) = o;
    }
}

__device__ __forceinline__ void attention_mfma(const P& p, int l, LAS unsigned char* lds, int u_begin, int u_end, int u_first, int u_stride) {
    LAS unsigned char* Kt = lds;
    LAS unsigned char* VT = lds + 64 * LDQ;
    LAS unsigned char* Pw = lds + 2 * 64 * LDQ + p.wave * 64 * LDQ;
    const int tid = p.tid, lane = p.lane, wave = p.wave, quad = lane >> 4, l15 = lane & 15;
    const float C2 = 0.125f * 1.4426950408889634f;
    for (int u = u_begin + u_first; u < u_end; u += u_stride) {
        const int qb = u >> 1, kvh = u & 1, hq = kvh * 4 + (wave >> 1);
        const bool isc = qb < 2; const int nb = qb - 2;
        const int qrow0 = 128 * qb + 64 * (wave & 1);
        bf16x8 Qf[4][2];
#pragma unroll
        for (int qt = 0; qt < 4; ++qt)
#pragma unroll
            for (int ks = 0; ks < 2; ++ks) Qf[qt][ks] = *(const bf16x8*)(p.PROJ + (size_t)(qrow0 + 16 * qt + l15) * PJ + Q0 + hq * 64 + ks * 32 + 8 * quad);
        f32x4 O[4][4];
#pragma unroll
        for (int a = 0; a < 4; ++a)
#pragma unroll
            for (int b = 0; b < 4; ++b) O[a][b] = (f32x4){0.f, 0.f, 0.f, 0.f};
        float mrow[4], lrow[4];
        const float sk = p.sink[l * 8 + hq] * 1.4426950408889634f;
#pragma unroll
        for (int qt = 0; qt < 4; ++qt) { mrow[qt] = sk; lrow[qt] = 1.f; }
        const int ntile = isc ? 4 : 10;
        for (int ti = 0; ti < ntile; ++ti) {
            int krow0; bool local;
            if (isc || ti >= 6) { krow0 = 64 * (isc ? ti : ti - 6); local = false; }
            else { krow0 = NCTX + 128 * (nb - 1) + 64 * ti; local = true; }
            if (local && (krow0 < NCTX || krow0 >= T)) continue;
            __syncthreads();
            { const int key = tid >> 3, pc = tid & 7;
              const bf16* src = p.PROJ + (size_t)(krow0 + key) * PJ + kvh * 64 + pc * 8;
              *(LAS u32x4*)(Kt + key * LDQ + pc * 16) = *(const u32x4*)(src + K0);
              const u32x4 v = *(const u32x4*)(src + V0);
              LAS unsigned char* dst = VT + (pc * 8) * LDQ + 2 * key;
              st_b16(dst, v.x & 0xffffu); st_b16(dst + LDQ, v.x >> 16); st_b16(dst + 2 * LDQ, v.y & 0xffffu); st_b16(dst + 3 * LDQ, v.y >> 16);
              st_b16(dst + 4 * LDQ, v.z & 0xffffu); st_b16(dst + 5 * LDQ, v.z >> 16); st_b16(dst + 6 * LDQ, v.w & 0xffffu); st_b16(dst + 7 * LDQ, v.w >> 16); }
            __syncthreads();
            f32x4 S[4][4];
#pragma unroll
            for (int a = 0; a < 4; ++a)
#pragma unroll
                for (int b = 0; b < 4; ++b) S[a][b] = (f32x4){0.f, 0.f, 0.f, 0.f};
#pragma unroll
            for (int ks = 0; ks < 2; ++ks)
#pragma unroll
                for (int kt = 0; kt < 4; ++kt) { const bf16x8 kf = ld_frag(Kt, 16 * kt + l15, ks * 32 + 8 * quad, LDQ);
#pragma unroll
                    for (int qt = 0; qt < 4; ++qt) S[kt][qt] = MFMA16(kf, Qf[qt][ks], S[kt][qt]); }
#pragma unroll
            for (int qt = 0; qt < 4; ++qt) {
                const int tq = qrow0 + 16 * qt + l15;
                float mx = -1e30f;
#pragma unroll
                for (int kt = 0; kt < 4; ++kt)
#pragma unroll
                    for (int r = 0; r < 4; ++r) { const int tk = krow0 + 16 * kt + 4 * quad + r; const int df = tq - tk;
                        const bool ok = !local || (df <= 128 && df >= -128);
                        const float s = ok ? S[kt][qt][r] * C2 : -1e30f; S[kt][qt][r] = s; mx = fmaxf(mx, s); }
                mx = fmaxf(mx, __shfl_xor(mx, 16)); mx = fmaxf(mx, __shfl_xor(mx, 32));
                const float mn = fmaxf(mrow[qt], mx), alpha = exp2f(mrow[qt] - mn);
                float ls = 0.f;
#pragma unroll
                for (int kt = 0; kt < 4; ++kt) { float e0 = exp2f(S[kt][qt][0] - mn), e1 = exp2f(S[kt][qt][1] - mn), e2 = exp2f(S[kt][qt][2] - mn), e3 = exp2f(S[kt][qt][3] - mn);
                    ls += (e0 + e1) + (e2 + e3);
                    u32x2 w; w.x = pk2(e0, e1); w.y = pk2(e2, e3);
                    *(LAS u32x2*)(Pw + (16 * qt + l15) * LDQ + (16 * kt + 4 * quad) * 2) = w; }
                ls += __shfl_xor(ls, 16); ls += __shfl_xor(ls, 32);
                lrow[qt] = lrow[qt] * alpha + ls; mrow[qt] = mn;
#pragma unroll
                for (int dt = 0; dt < 4; ++dt) O[dt][qt] *= alpha;
            }
            LDS_FENCE();
#pragma unroll
            for (int ks = 0; ks < 2; ++ks) {
                bf16x8 pf[4];
#pragma unroll
                for (int qt = 0; qt < 4; ++qt) pf[qt] = ld_frag(Pw, 16 * qt + l15, ks * 32 + 8 * quad, LDQ);
#pragma unroll
                for (int dt = 0; dt < 4; ++dt) { const bf16x8 vf = ld_frag(VT, 16 * dt + l15, ks * 32 + 8 * quad, LDQ);
#pragma unroll
                    for (int qt = 0; qt < 4; ++qt) O[dt][qt] = MFMA16(vf, pf[qt], O[dt][qt]); }
            }
            LDS_FENCE();
        }
#pragma unroll
        for (int qt = 0; qt < 4; ++qt) { const float inv = 1.f / lrow[qt];
            bf16* orow = p.Y3 + ((size_t)2 * T + qrow0 + 16 * qt + l15) * 512 + hq * 64;
#pragma unroll
            for (int dt = 0; dt < 4; ++dt) { u32x2 w; w.x = pk2(O[dt][qt][0] * inv, O[dt][qt][1] * inv); w.y = pk2(O[dt][qt][2] * inv, O[dt][qt][3] * inv);
                *(u32x2*)(orow + 16 * dt + 4 * quad) = w; } }
    }
}

#ifndef SKIPMASK
#define SKIPMASK 0
#endif
struct Args { const float* in[33]; float* out; unsigned char* ws; int ph_lo, ph_hi; };
static_assert(sizeof(Args) == 35 * 8 + 8, "no padding");

__global__ void __launch_bounds__(NTHR, 2) fwd_kernel(Args args) {
    extern __shared__ __attribute__((aligned(16))) unsigned char lds_raw[];
    LAS unsigned char* lds = (LAS unsigned char*)lds_raw;
    const int tid_ = threadIdx.x;
    if (tid_ == 0) {
        LAS unsigned long long* tab = (LAS unsigned long long*)(lds + PTAB_OFF);
#pragma unroll
        for (int k = 0; k < 33; ++k) tab[k] = (unsigned long long)args.in[k];
        tab[33] = (unsigned long long)args.out; tab[34] = (unsigned long long)args.ws;
    }
    volatile LAS unsigned* MISC = (volatile LAS unsigned*)(lds + MISC_OFF);
    if (tid_ < 64) MISC[tid_] = 0u;
    __syncthreads();
    XcdBarrier bar; bar.bar = (unsigned*)(args.ws + WS_CTL) + CW_BAR; bar.x = 0; bar.st = nullptr;
    if (!MK_PER_PHASE) bar = xcd_barrier_post((unsigned*)(args.ws + WS_CTL) + CW_BAR, MISC + 8);

    const int lo = args.ph_lo, hi = args.ph_hi;
#define IN(k) (lo <= (k) && (k) < hi)
#define SEAM(k) do { if (!MK_PER_PHASE && (k) + 1 < hi) xcd_barrier(bar); } while (0)

    if (IN(0)) { P p; build_P(p, lds); phase_mod(p, lds); SEAM(0); }

    for (int l = 0; l < DEPTH; ++l) {
        const int pb = 1 + NPH_LAYER * l;
        unsigned char* wsb; { unsigned tb_ = (unsigned)(size_t)(lds + PTAB_OFF); asm volatile("" : "+v"(tb_)); wsb = (unsigned char*)ld_tab((volatile LAS unsigned*)(size_t)tb_, 34); }
        if (!(SKIPMASK >> 0 & 1) && IN(pb + 0)) { P p; build_P(p, lds); convert_weights(p, l, lds); __syncthreads(); row_pass<0>(p, l, lds); SEAM(pb + 0); }
        if (!(SKIPMASK >> 1 & 1) && IN(pb + 1)) { P p; build_P(p, lds); pg8::Gemm g{p.H, p.WIN, T, PJ, D}; pg8::StaticOrder S; S.init(T, PJ, p.G, p.bid); pg8::EpiStoreBf16 E{p.PROJ, PJ};
            pg8::gemm_phase<pg8::EpiStoreBf16, pg8::StaticOrder, false>(lds, g, S, E, nullptr); SEAM(pb + 1); }
        if (!(SKIPMASK >> 2 & 1) && IN(pb + 2)) { P p; build_P(p, lds); phase_premix(p, l, lds); SEAM(pb + 2); }
        if (!(SKIPMASK >> 3 & 1) && IN(pb + 3)) { P p; build_P(p, lds);
            ssd_states(p, l, lds, (float*)(wsb + WS_SST), (float*)(wsb + WS_DEC)); __syncthreads();
            attention_mfma(p, l, lds, 4, 2 * NCH, p.bid, p.G);
            SEAM(pb + 3); }
        if (!(SKIPMASK >> 4 & 1) && IN(pb + 4)) { P p; build_P(p, lds);
            if (p.bid >= p.G - 4) attention_mfma(p, l, lds, 0, 4, p.bid - (p.G - 4), 4);
            scan_carries(p, l, (const float*)(wsb + WS_SST), (const float*)(wsb + WS_DEC), (bf16*)(wsb + WS_HIN));
            SEAM(pb + 4); }
        if (!(SKIPMASK >> 5 & 1) && IN(pb + 5)) { P p; build_P(p, lds);
            ssd_outputs(p, l, lds, (const bf16*)(wsb + WS_HIN), (bf16*)(wsb + WS_YS)); __syncthreads();
            phase_postmix(p, l, lds); SEAM(pb + 5); }
        if (!(SKIPMASK >> 6 & 1) && IN(pb + 6)) { P p; build_P(p, lds); pg8::Gemm g{p.SA, p.WGLU, T, 512, 512}; pg8::StaticOrder S; S.init(T, 512, p.G, p.bid); pg8::EpiGlu E{p.SA, p.b_glu + (size_t)l * 512, p.Y3};
            pg8::gemm_phase<pg8::EpiGlu, pg8::StaticOrder, false>(lds, g, S, E, nullptr);
            ssd_gated_norm(p, l, (const bf16*)(wsb + WS_YS)); SEAM(pb + 6); }
        if (!(SKIPMASK >> 7 & 1) && IN(pb + 7)) { P p; build_P(p, lds); pg8::Gemm g{p.Y3, p.WBR, 3 * T, 3072, 512}; pg8::MergeOrder S{p.G, p.bid}; pg8::EpiMerge E{p.PROJ, p.PM, p.MB};
            pg8::gemm_phase<pg8::EpiMerge, pg8::MergeOrder, false>(lds, g, S, E, nullptr); SEAM(pb + 7); }
        if (!(SKIPMASK >> 8 & 1) && IN(pb + 8)) { P p; build_P(p, lds); pg8::Gemm g{p.MB, p.WOUT, T, D, D}; pg8::StaticOrder S; S.init(T, D, p.G, p.bid);
            pg8::EpiResid E{p.XL, p.XC, p.MOD + (size_t)(l * 2 + 0) * 6144 + 2 * D, p.MOD + (size_t)(l * 2 + 1) * 6144 + 2 * D};
            pg8::gemm_phase<pg8::EpiResid, pg8::StaticOrder, false>(lds, g, S, E, nullptr); SEAM(pb + 8); }
        if (!(SKIPMASK >> 9 & 1) && IN(pb + 9)) { P p; build_P(p, lds); row_pass<1>(p, l, lds); SEAM(pb + 9); }
        if (!(SKIPMASK >> 10 & 1) && IN(pb + 10)) { P p; build_P(p, lds); phase_select(p, lds); SEAM(pb + 10); }
        if (!(SKIPMASK >> 11 & 1) && IN(pb + 11)) { P p; build_P(p, lds); phase_gather(p); SEAM(pb + 11); }
        if (!(SKIPMASK >> 12 & 1) && IN(pb + 12)) { P p; build_P(p, lds); pg8::Gemm g{p.XE, p.WUP, NE * ESLOTS, NE * 2048, D}; pg8::ExpertOrder S{p.G, p.bid, 8}; pg8::EpiSwiGlu E{p.HID};
            pg8::gemm_phase<pg8::EpiSwiGlu, pg8::ExpertOrder, false>(lds, g, S, E, nullptr); SEAM(pb + 12); }
        if (!(SKIPMASK >> 13 & 1) && IN(pb + 13)) { P p; build_P(p, lds); pg8::Gemm g{p.HID, p.WDN, NE * ESLOTS, NE * 1024, D}; pg8::ExpertOrder S{p.G, p.bid, 4}; pg8::EpiDown E{p.YE, p.GSEL};
            pg8::gemm_phase<pg8::EpiDown, pg8::ExpertOrder, false>(lds, g, S, E, nullptr); SEAM(pb + 13); }
    }
    if (IN(NPHASES - 1)) { P p; build_P(p, lds); row_pass<2>(p, 0, lds); }
#undef IN
#undef SEAM
}

extern "C" void kernel_launch(void* const* d_in, const int* in_sizes, int n_in, void* d_out, int out_size, void* d_ws, size_t ws_size, hipStream_t stream) {
    static int grid = 0;
    if (grid == 0) {
        if (n_in != 33 || out_size != NLAT * D || ws_size < WS_END) { fprintf(stderr, "kernel_launch: unexpected shapes: n_in %d out %d ws %zu (need %zu)\n", n_in, out_size, ws_size, (size_t)WS_END); grid = -1; return; }
        int dev = 0, cus = 0, per_cu = 0;
        if (hipGetDevice(&dev) != hipSuccess || hipDeviceGetAttribute(&cus, hipDeviceAttributeMultiprocessorCount, dev) != hipSuccess) { grid = -1; return; }
        if (hipFuncSetAttribute((const void*)fwd_kernel, hipFuncAttributeMaxDynamicSharedMemorySize, LDS_BYTES) != hipSuccess) { fprintf(stderr, "kernel_launch: hipFuncSetAttribute failed\n"); grid = -1; return; }
        if (hipOccupancyMaxActiveBlocksPerMultiprocessor(&per_cu, (const void*)fwd_kernel, NTHR, LDS_BYTES) != hipSuccess || per_cu < 1) { fprintf(stderr, "kernel_launch: occupancy query says %d\n", per_cu); (void)hipGetLastError(); }
        grid = cus;
    }
    if (grid < 0) return;
    (void)hipMemsetAsync((char*)d_ws + WS_CTL, 0, CTL_BYTES, stream);
    Args a{};
    for (int i = 0; i < 33; ++i) a.in[i] = (const float*)d_in[i];
    a.out = (float*)d_out; a.ws = (unsigned char*)d_ws;
#if MK_PER_PHASE
    for (int ph = 0; ph < NPHASES; ++ph) { a.ph_lo = ph; a.ph_hi = ph + 1; hipLaunchKernelGGL(fwd_kernel, dim3(grid), dim3(NTHR), LDS_BYTES, stream, a); }
#else
    a.ph_lo = 0; a.ph_hi = NPHASES;
    hipLaunchKernelGGL(fwd_kernel, dim3(grid), dim3(NTHR), LDS_BYTES, stream, a);
#endif
}
```

```cpp
#include <hip/hip_runtime.h>
#include <cstdio>
#include <cstdint>

#ifndef MK_PER_PHASE
#define MK_PER_PHASE 0
#endif

namespace pg8 {
#define PG8_LAS __attribute__((address_space(3)))
typedef unsigned short bf16_t;
typedef short bf16x8 __attribute__((ext_vector_type(8)));
typedef float f32x4 __attribute__((ext_vector_type(4)));
typedef unsigned u32x4 __attribute__((ext_vector_type(4)));
constexpr int BM = 256, BK = 64, HALF = 128, HTB = HALF * BK * 2  , STAGE_BYTES = 8 * HTB, NXCD = 8, WGM = 8;

__host__ __device__ __forceinline__ int lds_byte(int r, int c) { const int st = (r >> 4) * 2 + (c >> 5), rr = r & 15, cc = c & 31, ob = rr * 64 + cc * 2; return st * 1024 + (ob ^ (((ob >> 9) & 1) << 5)); }
__host__ __device__ __forceinline__ void stage_rc(int b, int& R, int& C) { const int st = b / 1024, sb = b % 1024, swz = sb ^ (((sb >> 9) & 1) << 5); R = (st >> 1) * 16 + swz / 64; C = (st & 1) * 32 + (swz % 64) / 2; }
__host__ __device__ __forceinline__ int perm32(int rho) { const int n = rho >> 4, i = rho & 15; return 8 * (i >> 2) + 4 * n + (i & 3); }

struct Unit { int pm, pn; };
struct Gemm { const bf16_t* A; const bf16_t* Bt; int M, N, K; };

struct StaticOrder {
    int nM, nN, nwg, G, c;
    __host__ __device__ void init(int M, int N, int G_, int c_) { nM = M / BM; nN = N / BM; nwg = nM * nN; G = G_; c = c_; }
    __host__ __device__ bool next(int i, Unit& u) const {
        const long L = (long)i * G + c; if (L >= nwg) return false;
        int wgid = (int)L; { const int q = nwg / NXCD, r = nwg % NXCD, xcd = wgid % NXCD, off = wgid / NXCD; wgid = (xcd < r ? xcd * (q + 1) : r * (q + 1) + (xcd - r) * q) + off; }
        const int nig = WGM * nN, gid = wgid / nig, fm = gid * WGM, gsz = (nM - fm) < WGM ? (nM - fm) : WGM;
        u.pm = fm + ((wgid % nig) % gsz); u.pn = (wgid % nig) / gsz; return true;
    }
    __device__ __forceinline__ void a_ready(const Unit&) const {}
    __device__ __forceinline__ void done(const Unit&) const {}
};
__device__ __forceinline__ unsigned cvt_pk_bf16(float lo, float hi) { unsigned r; asm volatile("v_cvt_pk_bf16_f32 %0, %1, %2" : "=v"(r) : "v"(lo), "v"(hi)); return r; }
template <class Epi, class Sched, bool STAMP = false>
__device__ __forceinline__ void gemm_phase(PG8_LAS unsigned char* lds, const Gemm g, const Sched& S, const Epi& E, unsigned long long* stamps) {
    int tid_l = threadIdx.x; asm volatile("" : "+v"(tid_l));
    const int tid = tid_l, wid = __builtin_amdgcn_readfirstlane(tid >> 6), lane = tid & 63, wr = wid >> 2, wc = wid & 3, fr = lane & 15, fq = lane >> 4;
    const int K = g.K, nt = K / BK;
    int ts_lo = 0, ts_hi = 0, nts = 0; const unsigned long long rt_entry = STAMP ? (unsigned long long)wall_clock64() : 0ull;
#define PG8_STAMP() do { if (STAMP && wid == 0 && nts < 64) { const unsigned long long _c = (unsigned long long)clock64(); \
        ts_lo = (lane == nts) ? (int)(unsigned)_c : ts_lo; ts_hi = (lane == nts) ? (int)(unsigned)(_c >> 32) : ts_hi; ++nts; } } while (0)
    PG8_STAMP();
    unsigned voffA[2], voffB[2];
#pragma unroll
    for (int i = 0; i < 2; ++i) { int R, C; stage_rc(tid * 16 + i * 8192, R, C); const int Rb = Epi::PERM ? ((R & ~31) + perm32(R & 31)) : R;
        voffA[i] = (unsigned)(R * K + C) * 2u; voffB[i] = (unsigned)(Rb * K + C) * 2u; }
    const size_t kstep = (size_t)(BK * 2);
    const size_t hstep = (size_t)HALF * K * 2;
    const size_t tstep = 2 * hstep;
    const unsigned ldsw = (unsigned)wid * 1024u;
    const int aoff = lds_byte(wr * 64 + fr, fq * 8), boff = lds_byte(wc * 32 + fr, fq * 8);
#define PG8_SA(b, h) (((b) * 2 + (h)) * HTB)
#define PG8_SB(b, h) ((4 + (b) * 2 + (h)) * HTB)
#define PG8_STAGE(bufoff, gbase, voff) do { _Pragma("unroll") for (int _i = 0; _i < 2; ++_i) \
        __builtin_amdgcn_global_load_lds((const unsigned*)((const char*)(gbase) + (voff)[_i]), (PG8_LAS unsigned*)(lds + (bufoff) + ldsw + _i * 8192), 16, 0, 0); } while (0)
#define PG8_LDA(dst, b, h) do { _Pragma("unroll") for (int m = 0; m < 4; ++m) _Pragma("unroll") for (int k = 0; k < 2; ++k) dst[m][k] = *(const PG8_LAS bf16x8*)(lds + PG8_SA(b, h) + aoff + m * 2048 + k * 1024); } while (0)
#define PG8_LDB(dst, b, h) do { _Pragma("unroll") for (int n = 0; n < 2; ++n) _Pragma("unroll") for (int k = 0; k < 2; ++k) dst[n][k] = *(const PG8_LAS bf16x8*)(lds + PG8_SB(b, h) + boff + n * 2048 + k * 1024); } while (0)
#define PG8_MMA(ai, bj, At, Bt) do { __builtin_amdgcn_s_setprio(1); _Pragma("unroll") for (int m = 0; m < 4; ++m) _Pragma("unroll") for (int n = 0; n < 2; ++n) _Pragma("unroll") for (int k = 0; k < 2; ++k) \
        acc[ai][bj][m][n] = __builtin_amdgcn_mfma_f32_16x16x32_bf16(Bt[n][k], At[m][k], acc[ai][bj][m][n], 0, 0, 0); __builtin_amdgcn_s_setprio(0); } while (0)
#define PG8_WAIT_V(n) asm volatile("s_waitcnt vmcnt(" #n ")" ::: "memory")
#define PG8_WAIT_L(n) asm volatile("s_waitcnt lgkmcnt(" #n ")" ::: "memory")
#define PG8_BAR __builtin_amdgcn_s_barrier()
#define PG8_SCHED __builtin_amdgcn_sched_barrier(0)
    Unit cur, nxt; int ui = 0;
    if (!S.next(0, cur)) return;
    f32x4 acc[2][2][4][2];
#pragma unroll
    for (int a = 0; a < 2; ++a)
#pragma unroll
        for (int b = 0; b < 2; ++b)
#pragma unroll
            for (int m = 0; m < 4; ++m)
#pragma unroll
                for (int n = 0; n < 2; ++n) acc[a][b][m][n] = (f32x4){0.f, 0.f, 0.f, 0.f};
    bf16x8 At[4][2], B0[2][2], B1[2][2];
    const char* cA = (const char*)g.A + (size_t)cur.pm * tstep; const char* cB = (const char*)g.Bt + (size_t)cur.pn * tstep;
    S.a_ready(cur);
    PG8_STAGE(PG8_SB(0, 0), cB, voffB); PG8_STAGE(PG8_SA(0, 0), cA, voffA); PG8_STAGE(PG8_SB(0, 1), cB + hstep, voffB); PG8_STAGE(PG8_SA(0, 1), cA + hstep, voffA);
    if (wr == 1) PG8_BAR;
    PG8_WAIT_V(4); PG8_BAR;
    PG8_STAGE(PG8_SB(1, 0), cB + kstep, voffB); PG8_STAGE(PG8_SA(1, 0), cA + kstep, voffA); PG8_STAGE(PG8_SB(1, 1), cB + hstep + kstep, voffB);
    PG8_WAIT_V(6); PG8_BAR;
    PG8_STAMP();
    for (;;) {
        const bool has_next = S.next(ui + 1, nxt);
        const char* nA = has_next ? (const char*)g.A + (size_t)nxt.pm * tstep : cA; const char* nB = has_next ? (const char*)g.Bt + (size_t)nxt.pn * tstep : cB;
        for (int t = 0; t < nt; t += 2) {
            const bool last = (t == nt - 2);
            const char* a1 = cA + (size_t)(t + 1) * kstep;
            const char* a2 = last ? nA : cA + (size_t)(t + 2) * kstep; const char* b2 = last ? nB : cB + (size_t)(t + 2) * kstep;
            const char* a3 = a2 + kstep; const char* b3 = b2 + kstep;
            if (last && has_next) S.a_ready(nxt);
            PG8_LDB(B0, 0, 0); PG8_SCHED; PG8_LDA(At, 0, 0); PG8_STAGE(PG8_SA(1, 1), a1 + hstep, voffA);
            PG8_WAIT_L(8); PG8_BAR; PG8_WAIT_L(0); PG8_MMA(0, 0, At, B0); PG8_BAR; PG8_SCHED;
            PG8_LDB(B1, 0, 1); PG8_STAGE(PG8_SB(0, 0), b2, voffB);
            PG8_BAR; PG8_WAIT_L(0); PG8_MMA(0, 1, At, B1); PG8_BAR;
            PG8_LDA(At, 0, 1); PG8_STAGE(PG8_SA(0, 0), a2, voffA);
            PG8_BAR; PG8_WAIT_L(0); PG8_MMA(1, 0, At, B0); PG8_BAR; PG8_SCHED;
            PG8_STAGE(PG8_SB(0, 1), b2 + hstep, voffB);
            PG8_WAIT_V(6); PG8_BAR; PG8_MMA(1, 1, At, B1); PG8_BAR;
            PG8_LDB(B0, 1, 0); PG8_SCHED; PG8_LDA(At, 1, 0); PG8_STAGE(PG8_SA(0, 1), a2 + hstep, voffA);
            PG8_WAIT_L(8); PG8_BAR; PG8_WAIT_L(0); PG8_MMA(0, 0, At, B0); PG8_BAR; PG8_SCHED;
            PG8_LDB(B1, 1, 1); PG8_STAGE(PG8_SB(1, 0), b3, voffB);
            PG8_BAR; PG8_WAIT_L(0); PG8_MMA(0, 1, At, B1); PG8_BAR;
            PG8_LDA(At, 1, 1); PG8_STAGE(PG8_SA(1, 0), a3, voffA);
            PG8_BAR; PG8_WAIT_L(0); PG8_MMA(1, 0, At, B0); PG8_BAR; PG8_SCHED;
            PG8_STAGE(PG8_SB(1, 1), b3 + hstep, voffB);
            PG8_WAIT_V(6); PG8_BAR; PG8_MMA(1, 1, At, B1); PG8_BAR;
        }
        PG8_STAMP();
        if constexpr (!Epi::AFTER_DRAIN) { E(acc, cur, wr, wc, fr, fq); S.done(cur); }
        PG8_STAMP();
        if (!has_next) break;
#pragma unroll
        for (int a = 0; a < 2; ++a)
#pragma unroll
            for (int b = 0; b < 2; ++b)
#pragma unroll
                for (int m = 0; m < 4; ++m)
#pragma unroll
                    for (int n = 0; n < 2; ++n) acc[a][b][m][n] = (f32x4){0.f, 0.f, 0.f, 0.f};
        cur = nxt; cA = nA; cB = nB; ++ui;
    }
    PG8_WAIT_V(0);
    if (wr == 0) PG8_BAR;
    PG8_BAR;
    if constexpr (Epi::AFTER_DRAIN) { E.fused(acc, cur, wr, wc, fr, fq, lds, wid, lane); S.done(cur); }
    PG8_STAMP();
    if (STAMP && wid == 0) { stamps[lane] = lane < nts ? (((unsigned long long)(unsigned)ts_hi << 32) | (unsigned)ts_lo) : 0ull;
        if (lane == 62) stamps[62] = rt_entry; if (lane == 63) stamps[63] = (unsigned long long)wall_clock64(); }
#undef PG8_STAMP
#undef PG8_SA
#undef PG8_SB
#undef PG8_STAGE
#undef PG8_LDA
#undef PG8_LDB
#undef PG8_MMA
#undef PG8_WAIT_V
#undef PG8_WAIT_L
#undef PG8_BAR
#undef PG8_SCHED
}
}

#define GAS __attribute__((address_space(1)))
#define LAS __attribute__((address_space(3)))
typedef unsigned short bf16;
typedef float f32x4 __attribute__((ext_vector_type(4)));
typedef unsigned u32x4 __attribute__((ext_vector_type(4)));
typedef unsigned u32x2 __attribute__((ext_vector_type(2)));

constexpr int D = 1024, NLAT = 16384, NCTX = 256, T = NLAT + NCTX, DEPTH = 4;
constexpr int IN_W = 5904, PJ = 5888;
constexpr int U0 = 0, Z0 = 512, XB0 = 1024, Q0 = 2048, K0 = 2560, V0 = 2688, GT0 = 2816;
constexpr int NE = 16, ESLOTS = 2304, CAP_L = 2048, CAP_C = 32;
constexpr int NCH = 130;
constexpr float EPS = 1e-6f;
constexpr int NWAVES = 8, NTHR = 512;
constexpr int LDS_BYTES = 155648;
constexpr int MISC_OFF = LDS_BYTES - 1024 + 512;
constexpr int NPH_LAYER = 14, NPHASES = 1 + DEPTH * NPH_LAYER + 1;

constexpr size_t al256(size_t x) { return (x + 255) & ~(size_t)255; }
constexpr size_t WS_CTL = 0, CTL_BYTES = 1u << 20;
constexpr size_t WS_MOD = WS_CTL + CTL_BYTES;
constexpr size_t WS_XC = al256(WS_MOD + (size_t)DEPTH * 2 * 6144 * 4);
constexpr size_t WS_WIN = al256(WS_XC + (size_t)NCTX * D * 4);
constexpr size_t WS_WGLU = al256(WS_WIN + (size_t)PJ * D * 2);
constexpr size_t WS_WBR = al256(WS_WGLU + (size_t)512 * 512 * 2);
constexpr size_t WS_WOUT = al256(WS_WBR + (size_t)3 * 1024 * 512 * 2);
constexpr size_t WS_WUP = al256(WS_WOUT + (size_t)1024 * 1024 * 2);
constexpr size_t WS_WDN = al256(WS_WUP + (size_t)NE * 2048 * 1024 * 2);
constexpr size_t WS_H = al256(WS_WDN + (size_t)NE * 1024 * 1024 * 2);
constexpr size_t WS_PROJ = al256(WS_H + (size_t)T * D * 2);
constexpr size_t WS_XE = WS_PROJ;
constexpr size_t WS_HID = al256(WS_XE + (size_t)NE * ESLOTS * D * 2);
constexpr size_t WS_DT = al256(WS_PROJ + (size_t)T * PJ * 2);
constexpr size_t WS_CV = al256(WS_DT + (size_t)T * 16 * 4);
constexpr size_t WS_S5E = al256(WS_CV + (size_t)T * 1024 * 2);
constexpr size_t WS_S5H = al256(WS_S5E + (size_t)2 * 32 * NCH * 128 * 4);
constexpr size_t WS_YD = al256(WS_S5H + (size_t)2 * 32 * NCH * 128 * 4);
constexpr size_t WS_SA = al256(WS_YD + (size_t)2 * T * 512 * 4);
constexpr size_t WS_Y3 = al256(WS_SA + (size_t)T * 512 * 2);
constexpr size_t WS_PM = al256(WS_Y3 + (size_t)3 * T * 512 * 2);
constexpr size_t WS_MB = al256(WS_PM + (size_t)T * D * 4);
constexpr size_t WS_YE = WS_PM;
constexpr size_t WS_AFFT = al256(WS_MB + (size_t)T * D * 2);
constexpr size_t WS_IDX = al256(WS_AFFT + (size_t)NE * T * 4);
constexpr size_t WS_GSEL = al256(WS_IDX + (size_t)NE * ESLOTS * 4);
constexpr size_t WS_INV = al256(WS_GSEL + (size_t)NE * ESLOTS * 4);
constexpr size_t WS_DEC = al256(WS_INV + (size_t)T * 16 * 4);
constexpr size_t WS_S5BB = al256(WS_DEC + (size_t)2 * NCH * 8 * 4);
constexpr size_t WS_S5CC = al256(WS_S5BB + (size_t)2 * 32 * 128 * 32 * 2);
constexpr size_t WS_S5AB = al256(WS_S5CC + (size_t)2 * 32 * 16 * 128 * 2);
constexpr size_t WS_END = al256(WS_S5AB + (size_t)2 * 32 * 64 * 2 * 4);
constexpr size_t WS_SST = WS_YD;
constexpr size_t WS_HIN = WS_PM;
constexpr size_t WS_YS = al256(WS_HIN + (size_t)2 * NCH * 8 * 8192 * 2);
static_assert(WS_YS + (size_t)T * 512 * 2 <= WS_AFFT, "HIN|YS overlay fits PM|MB");
static_assert(WS_HID + (size_t)NE * ESLOTS * D * 2 <= WS_DT, "XE|HID overlay fits PROJ");
static_assert(WS_YE + (size_t)NE * ESLOTS * D * 2 <= WS_AFFT, "YE overlay fits PM|MB");
static_assert(WS_END < (size_t)1000 * 1024 * 1024, "workspace");
constexpr int CW_BAR = 4096;

__device__ __forceinline__ float bf2f(unsigned b) { return __uint_as_float(b << 16); }
__device__ __forceinline__ float bflo(unsigned w) { return __uint_as_float(w << 16); }
__device__ __forceinline__ float bfhi(unsigned w) { return __uint_as_float(w & 0xffff0000u); }
__device__ __forceinline__ unsigned f2bf(float f) { unsigned u = __float_as_uint(f); u += 0x7FFFu + ((u >> 16) & 1u); return u >> 16; }
__device__ __forceinline__ unsigned pk2(float lo, float hi) { return f2bf(lo) | (f2bf(hi) << 16); }
__device__ __forceinline__ float wsum(float v) {
#pragma unroll
    for (int o = 1; o < 64; o <<= 1) v += __shfl_xor(v, o);
    return v;
}
__device__ __forceinline__ float wmaxf(float v) {
#pragma unroll
    for (int o = 1; o < 64; o <<= 1) v = fmaxf(v, __shfl_xor(v, o));
    return v;
}
__device__ __forceinline__ float silu_f(float x) { return x / (1.f + expf(-x)); }
__device__ __forceinline__ float sigmoid_f(float x) { return 1.f / (1.f + expf(-x)); }
__device__ __forceinline__ float softplus_f(float x) { return x > 20.f ? x : log1pf(expf(x)); }
__device__ __forceinline__ float gelu_tanh_f(float x) { const float u = 0.7978845608028654f * (x + 0.044715f * x * x * x); return 0.5f * x * (1.f + tanhf(u)); }
#define LDS_FENCE() asm volatile("s_waitcnt lgkmcnt(0)" ::: "memory")
__device__ __forceinline__ int scan_row(int d, int s) { return d == 0 ? s : (s < NCTX ? (NCTX - 1 - s) : (T + NCTX - 1 - s)); }

namespace pg8 {
struct EpiStoreBf16 {
    static constexpr bool PERM = true, AFTER_DRAIN = false;
    bf16_t* O; int ldc;
    __device__ __forceinline__ void operator()(const f32x4 (&acc)[2][2][4][2], const Unit& u, int wr, int wc, int fr, int fq) const {
        const int row0 = u.pm * BM + wr * 64 + fr, col0 = u.pn * BM + wc * 32 + 8 * fq;
#pragma unroll
        for (int ai = 0; ai < 2; ++ai)
#pragma unroll
            for (int m = 0; m < 4; ++m) { bf16_t* rowp = O + (size_t)(row0 + ai * HALF + m * 16) * ldc + col0;
#pragma unroll
                for (int bj = 0; bj < 2; ++bj) { const f32x4 v0 = acc[ai][bj][m][0], v1 = acc[ai][bj][m][1];
                    u32x4 w; w.x = cvt_pk_bf16(v0[0], v0[1]); w.y = cvt_pk_bf16(v0[2], v0[3]); w.z = cvt_pk_bf16(v1[0], v1[1]); w.w = cvt_pk_bf16(v1[2], v1[3]);
                    *(u32x4*)(rowp + bj * HALF) = w; } }
    }
};
struct EpiGlu {
    static constexpr bool PERM = true, AFTER_DRAIN = false;
    const bf16_t* A; const float* bias; bf16_t* O;
    __device__ __forceinline__ void operator()(const f32x4 (&acc)[2][2][4][2], const Unit& u, int wr, int wc, int fr, int fq) const {
        const int row0 = u.pm * BM + wr * 64 + fr, col0 = u.pn * BM + wc * 32 + 8 * fq;
#pragma unroll
        for (int ai = 0; ai < 2; ++ai)
#pragma unroll
            for (int m = 0; m < 4; ++m) { const size_t ro = (size_t)(row0 + ai * HALF + m * 16) * 512 + col0;
#pragma unroll
                for (int bj = 0; bj < 2; ++bj) { const f32x4 v0 = acc[ai][bj][m][0], v1 = acc[ai][bj][m][1];
                    const u32x4 a = *(const u32x4*)(A + ro + bj * HALF);
                    const f32x4 b0 = *(const f32x4*)(bias + col0 + bj * HALF), b1 = *(const f32x4*)(bias + col0 + bj * HALF + 4);
                    float o[8];
                    o[0] = bflo(a.x) * sigmoid_f(v0[0] + b0[0]); o[1] = bfhi(a.x) * sigmoid_f(v0[1] + b0[1]);
                    o[2] = bflo(a.y) * sigmoid_f(v0[2] + b0[2]); o[3] = bfhi(a.y) * sigmoid_f(v0[3] + b0[3]);
                    o[4] = bflo(a.z) * sigmoid_f(v1[0] + b1[0]); o[5] = bfhi(a.z) * sigmoid_f(v1[1] + b1[1]);
                    o[6] = bflo(a.w) * sigmoid_f(v1[2] + b1[2]); o[7] = bfhi(a.w) * sigmoid_f(v1[3] + b1[3]);
                    u32x4 w; w.x = cvt_pk_bf16(o[0], o[1]); w.y = cvt_pk_bf16(o[2], o[3]); w.z = cvt_pk_bf16(o[4], o[5]); w.w = cvt_pk_bf16(o[6], o[7]);
                    *(u32x4*)(O + ro + bj * HALF) = w; } }
    }
};
struct MergeOrder {
    int G, c;
    __device__ __forceinline__ bool next(int i, Unit& u) const { const int pr = (i / 3) * G + c; if (pr >= 65 * 4) return false; const int k = i % 3; u.pm = k * 65 + (pr >> 2); u.pn = k * 4 + (pr & 3); return true; }
    __device__ __forceinline__ void a_ready(const Unit&) const {}
    __device__ __forceinline__ void done(const Unit&) const {}
};
struct EpiMerge {
    static constexpr bool PERM = true, AFTER_DRAIN = false;
    const bf16_t* proj; float* PM; bf16_t* MB;
    __device__ __forceinline__ void operator()(const f32x4 (&acc)[2][2][4][2], const Unit& u, int wr, int wc, int fr, int fq) const {
        const int k = u.pn >> 2, pn = u.pn & 3, pm = u.pm - 65 * k;
        const int row0 = pm * BM + wr * 64 + fr, col0 = pn * BM + wc * 32 + 8 * fq;
#pragma unroll
        for (int ai = 0; ai < 2; ++ai)
#pragma unroll
            for (int m = 0; m < 4; ++m) { const int row = row0 + ai * HALF + m * 16;
#pragma unroll
                for (int bj = 0; bj < 2; ++bj) { const f32x4 v0 = acc[ai][bj][m][0], v1 = acc[ai][bj][m][1];
                    const int col = col0 + bj * HALF;
                    const u32x4 g = *(const u32x4*)(proj + (size_t)row * PJ + GT0 + k * 1024 + col);
                    f32x4 o0, o1;
                    o0[0] = sigmoid_f(bflo(g.x)) * v0[0]; o0[1] = sigmoid_f(bfhi(g.x)) * v0[1]; o0[2] = sigmoid_f(bflo(g.y)) * v0[2]; o0[3] = sigmoid_f(bfhi(g.y)) * v0[3];
                    o1[0] = sigmoid_f(bflo(g.z)) * v1[0]; o1[1] = sigmoid_f(bfhi(g.z)) * v1[1]; o1[2] = sigmoid_f(bflo(g.w)) * v1[2]; o1[3] = sigmoid_f(bfhi(g.w)) * v1[3];
                    float* pp = PM + (size_t)row * 1024 + col;
                    if (k > 0) { o0 += *(const f32x4*)pp; o1 += *(const f32x4*)(pp + 4); }
                    if (k < 2) { *(f32x4*)pp = o0; *(f32x4*)(pp + 4) = o1; }
                    else { u32x4 w; w.x = cvt_pk_bf16(o0[0], o0[1]); w.y = cvt_pk_bf16(o0[2], o0[3]); w.z = cvt_pk_bf16(o1[0], o1[1]); w.w = cvt_pk_bf16(o1[2], o1[3]);
                        *(u32x4*)(MB + (size_t)row * 1024 + col) = w; } } }
    }
};
struct EpiResid {
    static constexpr bool PERM = false, AFTER_DRAIN = false;
    float* XL; float* XC; const float* g_lat; const float* g_ctx;
    __device__ __forceinline__ void operator()(const f32x4 (&acc)[2][2][4][2], const Unit& u, int wr, int wc, int fr, int fq) const {
        const bool isc = (u.pm == 0);
        float* base = isc ? XC : (XL - (size_t)NCTX * D); const float* gv = isc ? g_ctx : g_lat;
        const int row0 = u.pm * BM + wr * 64 + fr, col0 = u.pn * BM + wc * 32 + 4 * fq;
#pragma unroll
        for (int ai = 0; ai < 2; ++ai)
#pragma unroll
            for (int m = 0; m < 4; ++m) { float* rowp = base + (size_t)(row0 + ai * HALF + m * 16) * D + col0;
#pragma unroll
                for (int bj = 0; bj < 2; ++bj)
#pragma unroll
                    for (int n = 0; n < 2; ++n) { float* pp = rowp + bj * HALF + n * 16; const f32x4 g = *(const f32x4*)(gv + col0 + bj * HALF + n * 16);
                        f32x4 x = *(const f32x4*)pp; x += g * acc[ai][bj][m][n]; *(f32x4*)pp = x; } }
    }
};
struct ExpertOrder {
    int G, c, nnt;
    __device__ __forceinline__ bool next(int i, Unit& u) const { const int L = i * G + c; if (L >= NE * 9 * nnt) return false; const int e = L / (9 * nnt), rem = L % (9 * nnt); u.pm = e * 9 + rem % 9; u.pn = e * nnt + rem / 9; return true; }
    __device__ __forceinline__ void a_ready(const Unit&) const {}
    __device__ __forceinline__ void done(const Unit&) const {}
};
struct EpiSwiGlu {
    static constexpr bool PERM = true, AFTER_DRAIN = false;
    bf16_t* HID;
    __device__ __forceinline__ void operator()(const f32x4 (&acc)[2][2][4][2], const Unit& u, int wr, int wc, int fr, int fq) const {
        const int row0 = u.pm * BM + wr * 64 + fr, col0 = (u.pn & 7) * 128 + wc * 32 + 8 * fq;
#pragma unroll
        for (int ai = 0; ai < 2; ++ai)
#pragma unroll
            for (int m = 0; m < 4; ++m) { const f32x4 g0 = acc[ai][0][m][0], g1 = acc[ai][0][m][1], u0 = acc[ai][1][m][0], u1 = acc[ai][1][m][1];
                u32x4 w;
                w.x = cvt_pk_bf16(silu_f(g0[0]) * u0[0], silu_f(g0[1]) * u0[1]); w.y = cvt_pk_bf16(silu_f(g0[2]) * u0[2], silu_f(g0[3]) * u0[3]);
                w.z = cvt_pk_bf16(silu_f(g1[0]) * u1[0], silu_f(g1[1]) * u1[1]); w.w = cvt_pk_bf16(silu_f(g1[2]) * u1[2], silu_f(g1[3]) * u1[3]);
                *(u32x4*)(HID + (size_t)(row0 + ai * HALF + m * 16) * 1024 + col0) = w; }
    }
};
struct EpiDown {
    static constexpr bool PERM = true, AFTER_DRAIN = false;
    bf16_t* YE; const float* gsel;
    __device__ __forceinline__ void operator()(const f32x4 (&acc)[2][2][4][2], const Unit& u, int wr, int wc, int fr, int fq) const {
        const int row0 = u.pm * BM + wr * 64 + fr, col0 = (u.pn & 3) * BM + wc * 32 + 8 * fq;
#pragma unroll
        for (int ai = 0; ai < 2; ++ai)
#pragma unroll
            for (int m = 0; m < 4; ++m) { const int row = row0 + ai * HALF + m * 16; const float gs = gsel[row];
#pragma unroll
                for (int bj = 0; bj < 2; ++bj) { const f32x4 v0 = acc[ai][bj][m][0] * gs, v1 = acc[ai][bj][m][1] * gs;
                    u32x4 w; w.x = cvt_pk_bf16(v0[0], v0[1]); w.y = cvt_pk_bf16(v0[2], v0[3]); w.z = cvt_pk_bf16(v1[0], v1[1]); w.w = cvt_pk_bf16(v1[2], v1[3]);
                    *(u32x4*)(YE + (size_t)row * 1024 + col0 + bj * HALF) = w; } }
    }
};
}
#define XB_TMO      128
#define XB_XCNT(j)  (256  + 64 * (j))
#define XB_XSUB(j)  (1280 + 64 * (j))
#define XB_XGEN(j)  (2304 + 64 * (j))
#define XB_TOP      3328
#define XB_TOPGEN   3392
#define XCD_BAR_WORDS 3456
#define XB_SPIN_CAP (1u << 18)
#define LAS __attribute__((address_space(3)))

__device__ __forceinline__ unsigned xb_ld(unsigned* p)              { return __hip_atomic_load(p, __ATOMIC_RELAXED, __HIP_MEMORY_SCOPE_AGENT); }
__device__ __forceinline__ unsigned xb_add(unsigned* p, unsigned v) { return __hip_atomic_fetch_add(p, v, __ATOMIC_RELAXED, __HIP_MEMORY_SCOPE_AGENT); }
__device__ __forceinline__ unsigned xb_xcc_id() { return (unsigned)__builtin_amdgcn_s_getreg((3 << 11) | 20) & 0xFu; }
#define XB_SPIN(cond, bar) do { unsigned _sp = 0; while (cond) { __builtin_amdgcn_s_sleep(1); \
    if ((++_sp & 255u) == 0u) { if (xb_ld(&(bar)[XB_TMO])) break; if (_sp > XB_SPIN_CAP) { atomicAdd(&(bar)[XB_TMO], 1u); break; } } } } while (0)

struct XcdBarrier {
    unsigned* bar; unsigned x;
    volatile LAS unsigned* st;
};

__device__ __forceinline__ XcdBarrier xcd_barrier_post(unsigned* bar, volatile LAS unsigned* st) {
    XcdBarrier b; b.bar = bar; b.x = xb_xcc_id(); b.st = st;
    if (threadIdx.x == 0) (void)xb_add(&bar[XB_XCNT(b.x)], 1u);
    return b;
}
__device__ __forceinline__ void xcd_barrier_complete(unsigned* bar, unsigned x, unsigned& nloc, unsigned& nx) {
    const unsigned G = gridDim.x * gridDim.y * gridDim.z;
    unsigned sum, cnt, mine, sp = 0u;
    for (;;) {
        sum = 0u; cnt = 0u; mine = 0u;
#pragma unroll
        for (unsigned j = 0; j < 16; ++j) { const unsigned c = xb_ld(&bar[XB_XCNT(j)]); sum += c; cnt += (c > 0u) ? 1u : 0u; mine = (j == x) ? c : mine; }
        if (sum == G) break;
        __builtin_amdgcn_s_sleep(1);
        if ((++sp & 255u) == 0u) { if (xb_ld(&bar[XB_TMO])) break; if (sp > XB_SPIN_CAP) { atomicAdd(&bar[XB_TMO], 1u); break; } }
    }
    nloc = mine > 0u ? mine : 1u; nx = cnt > 0u ? cnt : 1u;
}

__device__ __forceinline__ void xcd_barrier(const XcdBarrier& b) {
    asm volatile("s_waitcnt vmcnt(0)" ::: "memory");
    __syncthreads();
    if (threadIdx.x == 0) {
        unsigned* bar = b.bar;
        __builtin_amdgcn_s_waitcnt(0);
        unsigned nloc = b.st[0], nx = b.st[1];
        if (nloc == 0u) { xcd_barrier_complete(bar, b.x, nloc, nx); b.st[0] = nloc; b.st[1] = nx; }
        const unsigned old = xb_add(&bar[XB_XSUB(b.x)], 1u);
        const unsigned gen = old / nloc;
        if (old + 1u == (gen + 1u) * nloc) {
            __builtin_amdgcn_fence(__ATOMIC_RELEASE, "agent");
            asm volatile("s_waitcnt vmcnt(0)" ::: "memory");
            const unsigned og = xb_add(&bar[XB_TOP], 1u);
            const unsigned tg = og / nx;
            if (og + 1u == (tg + 1u) * nx) xb_add(&bar[XB_TOPGEN], 1u);
            else XB_SPIN(xb_ld(&bar[XB_TOPGEN]) == tg, bar);
            __builtin_amdgcn_fence(__ATOMIC_ACQUIRE, "agent");
            xb_add(&bar[XB_XGEN(b.x)], 1u);
            asm volatile("s_waitcnt vmcnt(0)" ::: "memory");
        } else {
            XB_SPIN(xb_ld(&bar[XB_XGEN(b.x)]) == gen, bar);
            __builtin_amdgcn_fence(__ATOMIC_ACQUIRE, "agent");
            asm volatile("s_waitcnt vmcnt(0)" ::: "memory");
        }
    }
    __syncthreads();
}


struct P {
    const float *x, *c, *ctx, *c_ctx, *w_mod, *b_mod, *norm1_g, *norm2_g, *w_in, *lam_re, *lam_im, *log_dt, *b_re, *b_im, *c_re, *c_im, *s5_d, *w_glu, *b_glu,
        *conv_w, *conv_b, *a_log, *dt_bias, *ssd_d, *ssd_norm_g, *sink, *w_branch, *w_out, *w_router, *w_eg, *w_eu, *w_ed, *final_g;
    float* XL;
    float *MOD, *XC, *DT, *S5E, *S5H, *YD, *PM, *AFFT, *GSEL;
    bf16 *WIN, *WGLU, *WBR, *WOUT, *WUP, *WDN, *H, *PROJ, *XE, *HID, *CV, *SA, *Y3, *MB, *YE;
    int *IDX, *INV;
    int tid, lane, wave, bid, G;
};


constexpr int PTAB_OFF = LDS_BYTES - 1024;
__device__ __forceinline__ unsigned long long ld_tab(volatile LAS unsigned* t, int k) {
    const unsigned lo = __builtin_amdgcn_readfirstlane(t[2 * k]), hi = __builtin_amdgcn_readfirstlane(t[2 * k + 1]);
    return ((unsigned long long)hi << 32) | lo;
}
__device__ __forceinline__ void build_P(P& p, LAS unsigned char* lds) {
    int tid_l = threadIdx.x, bid_l = blockIdx.x, g_l = gridDim.x;
    asm volatile("" : "+v"(tid_l), "+s"(bid_l), "+s"(g_l));
    p.tid = tid_l; p.lane = p.tid & 63; p.wave = __builtin_amdgcn_readfirstlane(p.tid >> 6); p.bid = bid_l; p.G = g_l;
    unsigned tbase = (unsigned)(size_t)(lds + PTAB_OFF); asm volatile("" : "+v"(tbase));
    volatile LAS unsigned* tb = (volatile LAS unsigned*)(size_t)tbase;
#define INP(k) ((const float*)ld_tab(tb, k))
    p.x = INP(0); p.c = INP(1); p.ctx = INP(2); p.c_ctx = INP(3); p.w_mod = INP(4); p.b_mod = INP(5); p.norm1_g = INP(6); p.norm2_g = INP(7);
    p.w_in = INP(8); p.lam_re = INP(9); p.lam_im = INP(10); p.log_dt = INP(11); p.b_re = INP(12); p.b_im = INP(13); p.c_re = INP(14); p.c_im = INP(15);
    p.s5_d = INP(16); p.w_glu = INP(17); p.b_glu = INP(18); p.conv_w = INP(19); p.conv_b = INP(20); p.a_log = INP(21); p.dt_bias = INP(22); p.ssd_d = INP(23);
    p.ssd_norm_g = INP(24); p.sink = INP(25); p.w_branch = INP(26); p.w_out = INP(27); p.w_router = INP(28); p.w_eg = INP(29); p.w_eu = INP(30); p.w_ed = INP(31);
    p.final_g = INP(32);
#undef INP
    p.XL = (float*)ld_tab(tb, 33);
    unsigned char* ws = (unsigned char*)ld_tab(tb, 34);
    p.MOD = (float*)(ws + WS_MOD); p.XC = (float*)(ws + WS_XC); p.DT = (float*)(ws + WS_DT); p.S5E = (float*)(ws + WS_S5E); p.S5H = (float*)(ws + WS_S5H); p.YD = (float*)(ws + WS_YD);
    p.PM = (float*)(ws + WS_PM); p.AFFT = (float*)(ws + WS_AFFT); p.GSEL = (float*)(ws + WS_GSEL);
    p.WIN = (bf16*)(ws + WS_WIN); p.WGLU = (bf16*)(ws + WS_WGLU); p.WBR = (bf16*)(ws + WS_WBR); p.WOUT = (bf16*)(ws + WS_WOUT); p.WUP = (bf16*)(ws + WS_WUP); p.WDN = (bf16*)(ws + WS_WDN);
    p.H = (bf16*)(ws + WS_H); p.PROJ = (bf16*)(ws + WS_PROJ); p.XE = (bf16*)(ws + WS_XE); p.HID = (bf16*)(ws + WS_HID); p.CV = (bf16*)(ws + WS_CV); p.SA = (bf16*)(ws + WS_SA);
    p.Y3 = (bf16*)(ws + WS_Y3); p.MB = (bf16*)(ws + WS_MB); p.YE = (bf16*)(ws + WS_YE);
    p.IDX = (int*)(ws + WS_IDX); p.INV = (int*)(ws + WS_INV);
}
__device__ __forceinline__ void phase_mod(const P& p, LAS unsigned char* lds) {
    LAS float* sc = (LAS float*)lds;
    LAS float* part = sc + 2048;
    for (int i = p.tid; i < 1024; i += NTHR) { sc[i] = silu_f(p.c[i]); sc[1024 + i] = silu_f(p.c_ctx[i]); }
    __syncthreads();
    for (int it = p.bid; it < DEPTH * 48; it += p.G) {
        const int l = it / 48, cb = it % 48, c0 = cb * 128 + 2 * p.lane;
        const float* W = p.w_mod + (size_t)l * 1024 * 6144 + c0;
        float a00 = 0.f, a01 = 0.f, a10 = 0.f, a11 = 0.f;
        const int kb = p.wave * 128;
#pragma unroll 8
        for (int k = kb; k < kb + 128; ++k) { const float2 w = *(const float2*)(W + (size_t)k * 6144); const float s0 = sc[k], s1 = sc[1024 + k];
            a00 += s0 * w.x; a01 += s0 * w.y; a10 += s1 * w.x; a11 += s1 * w.y; }
        part[(p.wave * 2 + 0) * 128 + 2 * p.lane] = a00; part[(p.wave * 2 + 0) * 128 + 2 * p.lane + 1] = a01;
        part[(p.wave * 2 + 1) * 128 + 2 * p.lane] = a10; part[(p.wave * 2 + 1) * 128 + 2 * p.lane + 1] = a11;
        __syncthreads();
        if (p.tid < 256) { const int s = p.tid >> 7, col = p.tid & 127; float r = p.b_mod[l * 6144 + cb * 128 + col];
#pragma unroll
            for (int w = 0; w < 8; ++w) r += part[(w * 2 + s) * 128 + col];
            p.MOD[(size_t)(l * 2 + s) * 6144 + cb * 128 + col] = r; }
        __syncthreads();
    }
}

__device__ __forceinline__ void tr_item(const float* src, int ldw, int K, bf16* dst, int kb, LAS float* scr, int lane) {
    const int k0 = 64 * kb;
#pragma unroll 8
    for (int i = 0; i < 32; ++i) { const int kk = 2 * i + (lane >> 5); scr[kk * 33 + (lane & 31)] = src[(size_t)(k0 + kk) * ldw + (lane & 31)]; }
    LDS_FENCE();
    const int c = lane & 7;
#pragma unroll
    for (int j = 0; j < 4; ++j) { const int n = (lane >> 3) + 8 * j; const LAS float* s = scr + (8 * c) * 33 + n;
        u32x4 o; o.x = pk2(s[0 * 33], s[1 * 33]); o.y = pk2(s[2 * 33], s[3 * 33]); o.z = pk2(s[4 * 33], s[5 * 33]); o.w = pk2(s[6 * 33], s[7 * 33]);
        *(u32x4*)(dst + (size_t)n * K + k0 + 8 * c) = o; }
    LDS_FENCE();
}
__device__ __forceinline__ void convert_weights(const P& p, int l, LAS unsigned char* lds) {
    LAS float* scr = (LAS float*)(lds + p.wave * 8704);
    const int gw = p.bid * NWAVES + p.wave, NGW = p.G * NWAVES;
    constexpr int I_A = 64 * 16, I_B = 120 * 16, I_GLU = 16 * 8, I_BR = 3 * 32 * 8, I_OUT = 32 * 16, I_E = 16 * 32 * 16;
    constexpr int NIT = I_A + I_B + I_GLU + I_BR + I_OUT + 3 * I_E;
    const float* win = p.w_in + (size_t)l * 1024 * IN_W;
    for (int it = gw; it < NIT; it += NGW) {
        int r = it;
        if (r < I_A) { const int nb = r >> 4, kb = r & 15; tr_item(win + 32 * nb, IN_W, 1024, p.WIN + (size_t)(32 * nb) * 1024, kb, scr, p.lane); continue; } r -= I_A;
        if (r < I_B) { const int nb = r >> 4, kb = r & 15; tr_item(win + 2064 + 32 * nb, IN_W, 1024, p.WIN + (size_t)(2048 + 32 * nb) * 1024, kb, scr, p.lane); continue; } r -= I_B;
        if (r < I_GLU) { const int nb = r >> 3, kb = r & 7; tr_item(p.w_glu + (size_t)l * 512 * 512 + 32 * nb, 512, 512, p.WGLU + (size_t)(32 * nb) * 512, kb, scr, p.lane); continue; } r -= I_GLU;
        if (r < I_BR) { const int kk = r >> 8, nb = (r >> 3) & 31, kb = r & 7;
            tr_item(p.w_branch + ((size_t)l * 3 + kk) * 512 * 1024 + 32 * nb, 1024, 512, p.WBR + (size_t)(kk * 1024 + 32 * nb) * 512, kb, scr, p.lane); continue; } r -= I_BR;
        if (r < I_OUT) { const int nb = r >> 4, kb = r & 15; tr_item(p.w_out + (size_t)l * 1024 * 1024 + 32 * nb, 1024, 1024, p.WOUT + (size_t)(32 * nb) * 1024, kb, scr, p.lane); continue; } r -= I_OUT;
        const int which = r / I_E; r -= which * I_E;
        const int e = r >> 9, nb = (r >> 4) & 31, kb = r & 15;
        const size_t eo = ((size_t)l * NE + e) * 1024 * 1024;
        if (which == 0) tr_item(p.w_eg + eo + 32 * nb, 1024, 1024, p.WUP + (size_t)(e * 2048 + 256 * (nb >> 2) + 32 * (nb & 3)) * 1024, kb, scr, p.lane);
        else if (which == 1) tr_item(p.w_eu + eo + 32 * nb, 1024, 1024, p.WUP + (size_t)(e * 2048 + 256 * (nb >> 2) + 128 + 32 * (nb & 3)) * 1024, kb, scr, p.lane);
        else tr_item(p.w_ed + eo + 32 * nb, 1024, 1024, p.WDN + (size_t)(e * 1024 + 32 * nb) * 1024, kb, scr, p.lane);
    }
}

template <int MODE> __device__ __forceinline__ void row_pass(const P& p, int l, LAS unsigned char* lds) {
    LAS float* W16 = (LAS float*)lds;
    if (MODE != 2) {
        const float* src = (MODE == 0) ? (p.w_in + (size_t)l * 1024 * IN_W + 2048) : (p.w_router + (size_t)l * 1024 * 16);
        const int ld = (MODE == 0) ? IN_W : 16;
        for (int i = p.tid; i < 1024 * 16; i += NTHR) { const int k = i >> 4, j = i & 15; W16[k * 20 + j] = src[(size_t)k * ld + j]; }
        __syncthreads();
    }
    const int gw = p.bid * NWAVES + p.wave, NGW = p.G * NWAVES, lane = p.lane;
    for (int row = gw + (MODE == 2 ? NCTX : 0); row < T; row += NGW) {
        const bool isc = row < NCTX;
        float* xrow = isc ? (p.XC + (size_t)row * D) : (p.XL + (size_t)(row - NCTX) * D);
        float v[16];
        if (MODE == 0 && l == 0) { const float* s = isc ? (p.ctx + (size_t)row * D) : (p.x + (size_t)(row - NCTX) * D);
#pragma unroll
            for (int i = 0; i < 16; ++i) v[i] = s[lane + 64 * i];
        } else {
#pragma unroll
            for (int i = 0; i < 16; ++i) v[i] = xrow[lane + 64 * i];
        }
        if ((MODE == 0 && l > 0) || MODE == 2) {
            const int lp = (MODE == 2) ? (DEPTH - 1) : (l - 1);
            const float* g2 = p.MOD + (size_t)(lp * 2 + (isc ? 1 : 0)) * 6144 + 5 * D;
            float s[16];
#pragma unroll
            for (int i = 0; i < 16; ++i) s[i] = 0.f;
            for (int e = 0; e < NE; ++e) { const int slot = p.INV[(size_t)row * 16 + e];
                if (slot >= 0) { const bf16* yr = p.YE + ((size_t)e * ESLOTS + slot) * D;
#pragma unroll
                    for (int i = 0; i < 16; ++i) s[i] += bf2f(yr[lane + 64 * i]); } }
#pragma unroll
            for (int i = 0; i < 16; ++i) v[i] += g2[lane + 64 * i] * s[i];
        }
        if (MODE == 0) {
#pragma unroll
            for (int i = 0; i < 16; ++i) xrow[lane + 64 * i] = v[i];
        }
        float ss = 0.f;
#pragma unroll
        for (int i = 0; i < 16; ++i) ss += v[i] * v[i];
        const float rstd = rsqrtf(wsum(ss) * (1.f / D) + EPS);
        if (MODE == 2) {
#pragma unroll
            for (int i = 0; i < 16; ++i) xrow[lane + 64 * i] = v[i] * rstd * p.final_g[lane + 64 * i];
            continue;
        }
        const float* gam = (MODE == 0 ? p.norm1_g : p.norm2_g) + (size_t)l * D;
        const float* md = p.MOD + (size_t)(l * 2 + (isc ? 1 : 0)) * 6144 + (MODE == 0 ? 0 : 3 * D);
        bf16* hrow = p.H + (size_t)row * D;
        float acc[16];
#pragma unroll
        for (int j = 0; j < 16; ++j) acc[j] = 0.f;
#pragma unroll
        for (int i = 0; i < 16; ++i) { const int k = lane + 64 * i;
            const float hv = v[i] * rstd * gam[k] * (1.f + md[D + k]) + md[k];
            hrow[k] = (bf16)f2bf(hv);
            const LAS f32x4* wr = (const LAS f32x4*)(W16 + k * 20);
            const f32x4 w0 = wr[0], w1 = wr[1], w2 = wr[2], w3 = wr[3];
            acc[0] += hv * w0[0]; acc[1] += hv * w0[1]; acc[2] += hv * w0[2]; acc[3] += hv * w0[3];
            acc[4] += hv * w1[0]; acc[5] += hv * w1[1]; acc[6] += hv * w1[2]; acc[7] += hv * w1[3];
            acc[8] += hv * w2[0]; acc[9] += hv * w2[1]; acc[10] += hv * w2[2]; acc[11] += hv * w2[3];
            acc[12] += hv * w3[0]; acc[13] += hv * w3[1]; acc[14] += hv * w3[2]; acc[15] += hv * w3[3];
            if ((i & 1) == 1) asm volatile("" ::: "memory"); }
#pragma unroll
        for (int j = 0; j < 16; ++j) acc[j] = wsum(acc[j]);
        if (MODE == 0) {
            float mine = 0.f;
#pragma unroll
            for (int j = 0; j < 16; ++j) mine = (lane == j) ? acc[j] : mine;
            if (lane < 16) p.DT[(size_t)row * 16 + lane] = softplus_f(mine + p.dt_bias[l * 16 + lane]);
        } else {
            float mx = acc[0];
#pragma unroll
            for (int j = 1; j < 16; ++j) mx = fmaxf(mx, acc[j]);
            float sum = 0.f, mine = 0.f;
#pragma unroll
            for (int j = 0; j < 16; ++j) { const float e = expf(acc[j] - mx); sum += e; mine = (lane == j) ? e : mine; }
            if (lane < 16) p.AFFT[(size_t)lane * T + row] = mine / sum;
        }
    }
}

struct S5Lane { float abr, abi; float bbr[16], bbi[16]; };
__device__ __forceinline__ void s5_lane_params(const P& p, int l, int d, int g, int lane, S5Lane& o, bool withB) {
    const size_t gi = ((size_t)(l * 2 + d) * 32 + g);
    const float lr = p.lam_re[gi * 64 + lane], li = p.lam_im[gi * 64 + lane], dt = expf(p.log_dt[gi]);
    const float mag = expf(lr * dt); float sn, cs; sincosf(li * dt, &sn, &cs);
    o.abr = mag * cs; o.abi = mag * sn;
    if (withB) {
        const float den = lr * lr + li * li;
        const float fr = ((o.abr - 1.f) * lr + o.abi * li) / den, fi = (o.abi * lr - (o.abr - 1.f) * li) / den;
        const f32x4* br = (const f32x4*)(p.b_re + (gi * 64 + lane) * 16); const f32x4* bi = (const f32x4*)(p.b_im + (gi * 64 + lane) * 16);
#pragma unroll
        for (int q = 0; q < 4; ++q) { const f32x4 r4 = br[q], i4 = bi[q];
#pragma unroll
            for (int j = 0; j < 4; ++j) { o.bbr[4 * q + j] = fr * r4[j] - fi * i4[j]; o.bbi[4 * q + j] = fr * i4[j] + fi * r4[j]; } }
    }
}
__device__ __forceinline__ void s5_stage_u(const P& p, int r0, int g, LAS unsigned char* ub, int lane) {
#pragma unroll
    for (int j = 0; j < 4; ++j) { const int q = lane + 64 * j, i = q >> 1, half = q & 1;
        const u32x4 w = *(const u32x4*)(p.PROJ + (size_t)(r0 + i) * PJ + U0 + g * 16 + half * 8);
        *(LAS u32x4*)(ub + i * 32 + half * 16) = w; }
    LDS_FENCE();
}
__device__ __forceinline__ void s5_step(const S5Lane& s, const LAS unsigned char* ub, int i, float& hr, float& hi) {
    const u32x4 a = *(const LAS u32x4*)(ub + i * 32), b = *(const LAS u32x4*)(ub + i * 32 + 16);
    float u[16];
    u[0] = bflo(a.x); u[1] = bfhi(a.x); u[2] = bflo(a.y); u[3] = bfhi(a.y); u[4] = bflo(a.z); u[5] = bfhi(a.z); u[6] = bflo(a.w); u[7] = bfhi(a.w);
    u[8] = bflo(b.x); u[9] = bfhi(b.x); u[10] = bflo(b.y); u[11] = bfhi(b.y); u[12] = bflo(b.z); u[13] = bfhi(b.z); u[14] = bflo(b.w); u[15] = bfhi(b.w);
    float br = 0.f, bi = 0.f;
#pragma unroll
    for (int k = 0; k < 16; ++k) { br += s.bbr[k] * u[k]; bi += s.bbi[k] * u[k]; }
    const float nr = s.abr * hr - s.abi * hi + br, ni = s.abr * hi + s.abi * hr + bi;
    hr = nr; hi = ni;
}

__device__ __forceinline__ void phase_premix(const P& p, int l, LAS unsigned char* lds, bool do_rope) {
    const float* cw = p.conv_w + (size_t)l * 5 * 1024; const float* cb = p.conv_b + (size_t)l * 1024;
    for (int idx = p.bid * NTHR + p.tid; idx < T * 128; idx += p.G * NTHR) {
        const int row = idx >> 7, c8 = (idx & 127) * 8;
        const int lo = row < NCTX ? 0 : NCTX, hi = row < NCTX ? NCTX : T;
        float a[8];
        { const f32x4 b0 = *(const f32x4*)(cb + c8), b1 = *(const f32x4*)(cb + c8 + 4);
          a[0] = b0[0]; a[1] = b0[1]; a[2] = b0[2]; a[3] = b0[3]; a[4] = b1[0]; a[5] = b1[1]; a[6] = b1[2]; a[7] = b1[3]; }
#pragma unroll
        for (int j = 0; j < 5; ++j) { const int r = row + j - 2;
            if (r >= lo && r < hi) { const u32x4 xv = *(const u32x4*)(p.PROJ + (size_t)r * PJ + XB0 + c8);
                const f32x4 w0 = *(const f32x4*)(cw + j * 1024 + c8), w1 = *(const f32x4*)(cw + j * 1024 + c8 + 4);
                a[0] += w0[0] * bflo(xv.x); a[1] += w0[1] * bfhi(xv.x); a[2] += w0[2] * bflo(xv.y); a[3] += w0[3] * bfhi(xv.y);
                a[4] += w1[0] * bflo(xv.z); a[5] += w1[1] * bfhi(xv.z); a[6] += w1[2] * bflo(xv.w); a[7] += w1[3] * bfhi(xv.w); } }
        u32x4 o; o.x = pk2(silu_f(a[0]), silu_f(a[1])); o.y = pk2(silu_f(a[2]), silu_f(a[3])); o.z = pk2(silu_f(a[4]), silu_f(a[5])); o.w = pk2(silu_f(a[6]), silu_f(a[7]));
        *(u32x4*)(p.CV + (size_t)row * 1024 + c8) = o;
    }
    if (do_rope) for (int idx = p.bid * NTHR + p.tid; idx < NLAT * 160; idx += p.G * NTHR) {
        const int i = idx & 15, hh = (idx >> 4) % 10, t = idx / 160;
        bf16* base = p.PROJ + (size_t)(NCTX + t) * PJ + (hh < 8 ? Q0 + hh * 64 : K0 + (hh - 8) * 64);
        const float inv = exp2f(-(float)i * 0.83048202372184058696f);
        const float ar = (float)(t >> 6) * inv, ac = (float)(t & 63) * inv;
        float sr, cr, sc, cc; sincosf(ar, &sr, &cr); sincosf(ac, &sc, &cc);
        { const float x1 = bf2f(base[i]), x2 = bf2f(base[16 + i]); base[i] = (bf16)f2bf(x1 * cr - x2 * sr); base[16 + i] = (bf16)f2bf(x2 * cr + x1 * sr); }
        { const float x1 = bf2f(base[32 + i]), x2 = bf2f(base[48 + i]); base[32 + i] = (bf16)f2bf(x1 * cc - x2 * sc); base[48 + i] = (bf16)f2bf(x2 * cc + x1 * sc); }
    }
}

__device__ __forceinline__ void ssd_scan_naive(const P& p, int l) {
    for (int it = p.bid * 4 + p.wave; it < 1024; it += p.G * 4) {
        const int d = it >> 9, hd = (it >> 6) & 7, pp = it & 63, grp = hd >> 2;
        const float a = -expf(p.a_log[l * 16 + d * 8 + hd]);
        const int colB = 512 + grp * 128 + p.lane, colC = 768 + grp * 128 + p.lane, colX = hd * 64 + pp, dcol = d * 8 + hd;
        float h0 = 0.f, h1 = 0.f;
        for (int s0 = 0; s0 < T; s0 += 8) {
            unsigned b0[8], b1[8], c0[8], c1[8], xx[8]; float dtv[8]; int rr[8];
#pragma unroll
            for (int j = 0; j < 8; ++j) { const int r = scan_row(d, s0 + j); rr[j] = r; const bf16* cv = p.CV + (size_t)r * 1024;
                b0[j] = cv[colB]; b1[j] = cv[colB + 64]; c0[j] = cv[colC]; c1[j] = cv[colC + 64]; xx[j] = cv[colX]; dtv[j] = p.DT[(size_t)r * 16 + dcol]; }
#pragma unroll
            for (int j = 0; j < 8; ++j) { const float dec = expf(dtv[j] * a), dx = dtv[j] * bf2f(xx[j]);
                h0 = dec * h0 + dx * bf2f(b0[j]); h1 = dec * h1 + dx * bf2f(b1[j]);
                const float y = wsum(bf2f(c0[j]) * h0 + bf2f(c1[j]) * h1);
                if (p.lane == 0) p.YD[((size_t)d * T + rr[j]) * 512 + colX] = y; }
        }
    }
}
__device__ __forceinline__ void s5_carry_scan(const P& p, int l, int aw, int NAW) {
    for (int it = aw; it < 64; it += NAW) {
        const int d = it >> 5, g = it & 31;
        S5Lane s; s5_lane_params(p, l, d, g, p.lane, s, false);
        float ar = s.abr, ai = s.abi;
#pragma unroll
        for (int q = 0; q < 7; ++q) { const float nr = ar * ar - ai * ai, ni = 2.f * ar * ai; ar = nr; ai = ni; }
        float hr = 0.f, hi = 0.f;
        const float* E = p.S5E + (size_t)(d * 32 + g) * NCH * 128; float* Hn = p.S5H + (size_t)(d * 32 + g) * NCH * 128;
        for (int c = 0; c < NCH; ++c) { Hn[c * 128 + p.lane] = hr; Hn[c * 128 + 64 + p.lane] = hi;
            const float er = E[c * 128 + p.lane], ei = E[c * 128 + 64 + p.lane];
            const float nr = ar * hr - ai * hi + er, ni = ar * hi + ai * hr + ei; hr = nr; hi = ni; }
    }
}
__device__ __forceinline__ void attention_naive(const P& p, int l, int aw, int NAW, LAS float* pbuf) {
    const int lane = p.lane;
    for (int it = aw; it < T * 8; it += NAW) {
        const int row = it >> 3, hq = it & 7, kvh = hq >> 2;
        const bool isc = row < NCTX; const int t = row - NCTX;
        const int jlo = isc ? 0 : (t - 128 < 0 ? 0 : t - 128), jhi = isc ? -1 : (t + 128 > NLAT - 1 ? NLAT - 1 : t + 128);
        const int nloc = jhi - jlo + 1, nk = nloc + NCTX;
        const float sink = p.sink[l * 8 + hq];
        float q[64];
        { const u32x4* qp = (const u32x4*)(p.PROJ + (size_t)row * PJ + Q0 + hq * 64);
#pragma unroll
          for (int c = 0; c < 8; ++c) { const u32x4 w = qp[c]; q[8 * c] = bflo(w.x); q[8 * c + 1] = bfhi(w.x); q[8 * c + 2] = bflo(w.y); q[8 * c + 3] = bfhi(w.y);
              q[8 * c + 4] = bflo(w.z); q[8 * c + 5] = bfhi(w.z); q[8 * c + 6] = bflo(w.w); q[8 * c + 7] = bfhi(w.w); } }
        float sc[9]; float mx = sink;
#pragma unroll
        for (int i = 0; i < 9; ++i) { const int kk = lane + 64 * i; float s = -INFINITY;
            if (kk < nk) { const int krow = kk < nloc ? NCTX + jlo + kk : kk - nloc;
                const u32x4* kp = (const u32x4*)(p.PROJ + (size_t)krow * PJ + K0 + kvh * 64); float dot = 0.f;
#pragma unroll
                for (int c = 0; c < 8; ++c) { const u32x4 w = kp[c];
                    dot += q[8 * c] * bflo(w.x) + q[8 * c + 1] * bfhi(w.x) + q[8 * c + 2] * bflo(w.y) + q[8 * c + 3] * bfhi(w.y)
                         + q[8 * c + 4] * bflo(w.z) + q[8 * c + 5] * bfhi(w.z) + q[8 * c + 6] * bflo(w.w) + q[8 * c + 7] * bfhi(w.w); }
                s = dot * 0.125f; }
            sc[i] = s; mx = fmaxf(mx, s); }
        mx = wmaxf(mx);
        float sum = 0.f;
#pragma unroll
        for (int i = 0; i < 9; ++i) { const int kk = lane + 64 * i; const float e = (kk < nk) ? expf(sc[i] - mx) : 0.f; pbuf[kk] = e; sum += e; }
        const float den = wsum(sum) + expf(sink - mx);
        LDS_FENCE();
        float o = 0.f;
        const bf16* vb = p.PROJ + V0 + kvh * 64 + lane;
#pragma unroll 4
        for (int kk = 0; kk < nk; ++kk) { const int vrow = kk < nloc ? NCTX + jlo + kk : kk - nloc; o += pbuf[kk] * bf2f(vb[(size_t)vrow * PJ]); }
        p.Y3[((size_t)2 * T + row) * 512 + hq * 64 + lane] = (bf16)f2bf(o / den);
        LDS_FENCE();
    }
}

__device__ __forceinline__ void phase_postmix(const P& p, int l, LAS unsigned char* lds) {
    constexpr int CSH_BYTES = 2 * 2 * 16 * 68 * 4, WREG = 16640;
    LAS float* Csh = (LAS float*)lds;
    LAS unsigned char* wreg = lds + CSH_BYTES + p.wave * WREG;
    LAS unsigned char* ub = wreg;
    LAS float* Hb = (LAS float*)(wreg + 4096);
    LAS float* Yb = (LAS float*)(wreg + 4096 + 4224);
    const int lane = p.lane;
    for (int it = p.bid; it < 32 * 17; it += p.G) {
        const int g = it / 17, chunk = (it % 17) * 8 + p.wave;
        __syncthreads();
        for (int i = p.tid; i < 2 * 2 * 16 * 64; i += NTHR) { const int pq = i & 63, k = (i >> 6) & 15, ri = (i >> 10) & 1, d = i >> 11;
            const float* src = ri ? p.c_im : p.c_re; Csh[((d * 2 + ri) * 16 + k) * 68 + pq] = src[(((size_t)(l * 2 + d) * 32 + g) * 16 + k) * 64 + pq]; }
        __syncthreads();
        if (chunk < NCH) {
            const int r0 = 128 * chunk;
            s5_stage_u(p, r0, g, ub, lane);
            for (int d = 0; d < 2; ++d) {
                S5Lane s; s5_lane_params(p, l, d, g, lane, s, true);
                const int cs = (d == 0) ? chunk : (chunk < 2 ? 1 - chunk : NCH + 1 - chunk);
                const float* Hn = p.S5H + ((size_t)(d * 32 + g) * NCH + cs) * 128;
                float hr = Hn[lane], hi = Hn[64 + lane];
                const LAS float* Cr = Csh + (d * 2 + 0) * 16 * 68; const LAS float* Ci = Csh + (d * 2 + 1) * 16 * 68;
                for (int sub = 0; sub < 16; ++sub) {
#pragma unroll
                    for (int j = 0; j < 8; ++j) { const int is = sub * 8 + j; s5_step(s, ub, d == 0 ? is : 127 - is, hr, hi); Hb[j * 132 + lane] = hr; Hb[j * 132 + 64 + lane] = hi; }
                    LDS_FENCE();
#pragma unroll
                    for (int m = 0; m < 2; ++m) { const int o = lane + 64 * m, j = o >> 4, k = o & 15; float y = 0.f;
#pragma unroll
                        for (int q = 0; q < 16; ++q) { const f32x4 cr = *(const LAS f32x4*)(Cr + k * 68 + 4 * q), ci = *(const LAS f32x4*)(Ci + k * 68 + 4 * q);
                            const f32x4 xr = *(const LAS f32x4*)(Hb + j * 132 + 4 * q), xi = *(const LAS f32x4*)(Hb + j * 132 + 64 + 4 * q);
                            y += cr[0] * xr[0] + cr[1] * xr[1] + cr[2] * xr[2] + cr[3] * xr[3] - ci[0] * xi[0] - ci[1] * xi[1] - ci[2] * xi[2] - ci[3] * xi[3]; }
                        const int is = sub * 8 + j, i = (d == 0) ? is : 127 - is;
                        if (d == 0) Yb[i * 16 + k] = y; else Yb[i * 16 + k] += y; }
                    LDS_FENCE();
                }
            }
            const float* dsk = p.s5_d + (size_t)l * 512 + g * 16;
#pragma unroll
            for (int m = 0; m < 2; ++m) { const int i = lane + 64 * m;
                const u32x4 ua = *(const LAS u32x4*)(ub + i * 32), ubv = *(const LAS u32x4*)(ub + i * 32 + 16);
                float u[16];
                u[0] = bflo(ua.x); u[1] = bfhi(ua.x); u[2] = bflo(ua.y); u[3] = bfhi(ua.y); u[4] = bflo(ua.z); u[5] = bfhi(ua.z); u[6] = bflo(ua.w); u[7] = bfhi(ua.w);
                u[8] = bflo(ubv.x); u[9] = bfhi(ubv.x); u[10] = bflo(ubv.y); u[11] = bfhi(ubv.y); u[12] = bflo(ubv.z); u[13] = bfhi(ubv.z); u[14] = bflo(ubv.w); u[15] = bfhi(ubv.w);
                float a[16];
#pragma unroll
                for (int k = 0; k < 16; ++k) a[k] = gelu_tanh_f(Yb[i * 16 + k] + dsk[k] * u[k]);
                u32x4 o0, o1; o0.x = pk2(a[0], a[1]); o0.y = pk2(a[2], a[3]); o0.z = pk2(a[4], a[5]); o0.w = pk2(a[6], a[7]);
                o1.x = pk2(a[8], a[9]); o1.y = pk2(a[10], a[11]); o1.z = pk2(a[12], a[13]); o1.w = pk2(a[14], a[15]);
                bf16* dst = p.SA + (size_t)(r0 + i) * 512 + g * 16;
                *(u32x4*)dst = o0; *(u32x4*)(dst + 8) = o1; }
            LDS_FENCE();
        }
    }
}

__device__ __forceinline__ void phase_select(const P& p, LAS unsigned char* lds) {
    LAS unsigned* keys = (LAS unsigned*)lds;
    LAS unsigned* hist = keys + 16384;
    LAS unsigned* misc = hist + 256;
    const int tid = p.tid, lane = p.lane, wave = p.wave;
    for (int it = p.bid; it < 32; it += p.G) {
        const int set = it >> 4, e = it & 15;
        const int n = set ? NCTX : NLAT, cap = set ? CAP_C : CAP_L, row0 = set ? 0 : NCTX, slot0 = set ? CAP_L : 0;
        const float* src = p.AFFT + (size_t)e * T + row0;
        __syncthreads();
        for (int i = tid; i < n; i += NTHR) keys[i] = __float_as_uint(src[i]);
        unsigned prefix = 0u, mask = 0u, need = (unsigned)cap;
        for (int pass = 3; pass >= 0; --pass) {
            if (tid < 256) hist[tid] = 0u;
            __syncthreads();
            for (int i = tid; i < n; i += NTHR) { const unsigned k = keys[i]; if ((k & mask) == prefix) __hip_atomic_fetch_add(&hist[(k >> (8 * pass)) & 255u], 1u, __ATOMIC_RELAXED, __HIP_MEMORY_SCOPE_WORKGROUP); }
            __syncthreads();
            if (wave == 0) {
                const unsigned h0 = hist[4 * lane], h1 = hist[4 * lane + 1], h2 = hist[4 * lane + 2], h3 = hist[4 * lane + 3];
                const unsigned c = h0 + h1 + h2 + h3; unsigned S = c;
#pragma unroll
                for (int o = 1; o < 64; o <<= 1) { const unsigned t = __shfl_down(S, o); if (lane + o < 64) S += t; }
                const unsigned Snext = S - c;
                if (S >= need && Snext < need) { unsigned rem = need - Snext; unsigned bin;
                    if (h3 >= rem) bin = 3; else { rem -= h3; if (h2 >= rem) bin = 2; else { rem -= h2; if (h1 >= rem) bin = 1; else { rem -= h1; bin = 0; } } }
                    misc[0] = 4 * lane + bin; misc[1] = rem; }
            }
            __syncthreads();
            prefix |= misc[0] << (8 * pass); mask |= 0xFFu << (8 * pass); need = misc[1];
            __syncthreads();
        }
        unsigned selbase = 0u, eqbase = 0u;
        for (int base = 0; base < n; base += NTHR) {
            const int i = base + tid; const bool valid = i < n; const unsigned k = valid ? keys[i] : 0u;
            const bool eq = valid && k == prefix, gt = valid && k > prefix;
            const unsigned long long lt = (1ull << lane) - 1ull;
            const unsigned long long be = __ballot(eq);
            if (lane == 0) misc[8 + wave] = (unsigned)__popcll(be);
            __syncthreads();
            unsigned woff = 0u, tot = 0u;
#pragma unroll
            for (int w = 0; w < 8; ++w) { const unsigned v = misc[8 + w]; woff += (w < wave) ? v : 0u; tot += v; }
            const unsigned eqrank = eqbase + woff + (unsigned)__popcll(be & lt);
            const bool sel = gt || (eq && eqrank < need);
            const unsigned long long bs = __ballot(sel);
            if (lane == 0) misc[16 + wave] = (unsigned)__popcll(bs);
            __syncthreads();
            unsigned woff2 = 0u, tot2 = 0u;
#pragma unroll
            for (int w = 0; w < 8; ++w) { const unsigned v = misc[16 + w]; woff2 += (w < wave) ? v : 0u; tot2 += v; }
            if (valid) { const int row = row0 + i;
                if (sel) { const int slot = slot0 + (int)(selbase + woff2 + (unsigned)__popcll(bs & lt));
                    p.IDX[e * ESLOTS + slot] = row; p.GSEL[e * ESLOTS + slot] = __uint_as_float(k); p.INV[(size_t)row * 16 + e] = slot; }
                else p.INV[(size_t)row * 16 + e] = -1; }
            selbase += tot2; eqbase += tot;
            __syncthreads();
        }
    }
}
__device__ __forceinline__ void phase_gather(const P& p) {
    const int gw = p.bid * NWAVES + p.wave, NGW = p.G * NWAVES, lane = p.lane;
    for (int idx = gw; idx < NE * ESLOTS; idx += NGW) {
        const int slot = idx % ESLOTS; const bool valid = slot < CAP_L + CAP_C;
        u32x4 a = (u32x4){0u, 0u, 0u, 0u}, b = a;
        if (valid) { const int row = p.IDX[idx]; const u32x4* s = (const u32x4*)(p.H + (size_t)row * D); a = s[lane]; b = s[64 + lane]; }
        else if (lane == 0) p.GSEL[idx] = 0.f;
        u32x4* dst = (u32x4*)(p.XE + (size_t)idx * D); dst[lane] = a; dst[64 + lane] = b;
    }
}

typedef short bf16x8 __attribute__((ext_vector_type(8)));
#define MFMA16(a, b, c) __builtin_amdgcn_mfma_f32_16x16x32_bf16((a), (b), (c), 0, 0, 0)
constexpr int LDP = 272;
constexpr int LDQ = 144;
__device__ __forceinline__ bf16x8 ld_frag(const LAS unsigned char* base, int row, int kcol, int ldb) { return *(const LAS bf16x8*)(base + row * ldb + kcol * 2); }
__device__ __forceinline__ void st_b16(LAS unsigned char* p, unsigned v) { *(LAS unsigned short*)p = (unsigned short)v; }
__device__ __forceinline__ float wscan_incl(float v, int lane) {
#pragma unroll
    for (int o = 1; o < 64; o <<= 1) { const float t = __shfl_up(v, o); if (lane >= o) v += t; }
    return v;
}
__device__ __forceinline__ int chunk_r0(int d, int cs) { return d == 0 ? 128 * cs : (cs < 2 ? 128 * (1 - cs) : 128 * (NCH + 1 - cs)); }
__device__ __forceinline__ int scan_chunk_of(int d, int cn) { return d == 0 ? cn : (cn < 2 ? 1 - cn : NCH + 1 - cn); }

__device__ __forceinline__ void ssd_acum(const float* DT, int r0, int d, int col, float a, int lane, LAS float* acum, LAS float* dtv, float& total) {
    const int j0 = d == 0 ? lane : 127 - lane, j1 = d == 0 ? 64 + lane : 63 - lane;
    const float dt0 = DT[(size_t)(r0 + j0) * 16 + col], dt1 = DT[(size_t)(r0 + j1) * 16 + col];
    const float s0 = wscan_incl(dt0 * a, lane); const float t0 = __shfl(s0, 63);
    const float s1 = wscan_incl(dt1 * a, lane) + t0; total = __shfl(s1, 63);
    acum[j0] = s0; acum[j1] = s1; dtv[j0] = dt0; dtv[j1] = dt1;
}

__device__ __forceinline__ void ssd_states(const P& p, int l, LAS unsigned char* lds, float* SST, float* DEC) {
    LAS unsigned char* BT = lds;
    LAS unsigned char* XW = lds + 128 * LDP;
    LAS float* wj = (LAS float*)(lds + 128 * LDP + 4 * 64 * LDP);
    const int tid = p.tid, lane = p.lane, wave = p.wave, quad = lane >> 4, l15 = lane & 15;
    for (int u = p.bid; u < 2 * NCH * 2; u += p.G) {
        const int d = u / (2 * NCH), cs = (u % (2 * NCH)) >> 1, g = u & 1;
        const int r0 = chunk_r0(d, cs);
        __syncthreads();
        if (wave < 4) { const int h = g * 4 + wave; const float a = -expf(p.a_log[l * 16 + d * 8 + h]); float total;
            LAS float* ac = wj + 512 + wave * 128; LAS float* dv = wj + 1024 + wave * 128;
            ssd_acum(p.DT, r0, d, d * 8 + h, a, lane, ac, dv, total);
            LDS_FENCE();
            wj[wave * 128 + lane] = expf(total - ac[lane]) * dv[lane]; wj[wave * 128 + 64 + lane] = expf(total - ac[64 + lane]) * dv[64 + lane];
            if (lane == 0) DEC[(d * NCH + cs) * 8 + h] = expf(total); }
        __syncthreads();
        for (int idx = tid; idx < 128 * 16; idx += NTHR) { const int j = idx >> 4, n8 = (idx & 15) * 8;
            const u32x4 v = *(const u32x4*)(p.CV + (size_t)(r0 + j) * 1024 + 512 + g * 128 + n8);
            LAS unsigned char* dst = BT + n8 * LDP + 2 * j;
            st_b16(dst, v.x & 0xffffu); st_b16(dst + LDP, v.x >> 16); st_b16(dst + 2 * LDP, v.y & 0xffffu); st_b16(dst + 3 * LDP, v.y >> 16);
            st_b16(dst + 4 * LDP, v.z & 0xffffu); st_b16(dst + 5 * LDP, v.z >> 16); st_b16(dst + 6 * LDP, v.w & 0xffffu); st_b16(dst + 7 * LDP, v.w >> 16); }
        for (int idx = tid; idx < 128 * 32; idx += NTHR) { const int j = idx >> 5, c8 = (idx & 31) * 8, hh = c8 >> 6, p8 = c8 & 63;
            const u32x4 v = *(const u32x4*)(p.CV + (size_t)(r0 + j) * 1024 + g * 256 + c8); const float w = wj[hh * 128 + j];
            LAS unsigned char* dst = XW + (hh * 64 + p8) * LDP + 2 * j;
            st_b16(dst, f2bf(bflo(v.x) * w)); st_b16(dst + LDP, f2bf(bfhi(v.x) * w)); st_b16(dst + 2 * LDP, f2bf(bflo(v.y) * w)); st_b16(dst + 3 * LDP, f2bf(bfhi(v.y) * w));
            st_b16(dst + 4 * LDP, f2bf(bflo(v.z) * w)); st_b16(dst + 5 * LDP, f2bf(bfhi(v.z) * w)); st_b16(dst + 6 * LDP, f2bf(bflo(v.w) * w)); st_b16(dst + 7 * LDP, f2bf(bfhi(v.w) * w)); }
        __syncthreads();
        const int hh = wave >> 1, ph = wave & 1;
        f32x4 acc[2][8];
#pragma unroll
        for (int a = 0; a < 2; ++a)
#pragma unroll
            for (int b = 0; b < 8; ++b) acc[a][b] = (f32x4){0.f, 0.f, 0.f, 0.f};
#pragma unroll
        for (int ks = 0; ks < 4; ++ks) {
            bf16x8 af[2];
#pragma unroll
            for (int pt = 0; pt < 2; ++pt) af[pt] = ld_frag(XW + hh * 64 * LDP, ph * 32 + pt * 16 + l15, ks * 32 + 8 * quad, LDP);
#pragma unroll
            for (int nt = 0; nt < 8; ++nt) { const bf16x8 bfr = ld_frag(BT, nt * 16 + l15, ks * 32 + 8 * quad, LDP);
#pragma unroll
                for (int pt = 0; pt < 2; ++pt) acc[pt][nt] = MFMA16(af[pt], bfr, acc[pt][nt]); }
        }
        float* S = SST + ((size_t)(d * NCH + cs) * 8 + g * 4 + hh) * 8192;
#pragma unroll
        for (int pt = 0; pt < 2; ++pt)
#pragma unroll
            for (int nt = 0; nt < 8; ++nt)
#pragma unroll
                for (int r = 0; r < 4; ++r) S[(ph * 32 + pt * 16 + 4 * quad + r) * 128 + nt * 16 + l15] = acc[pt][nt][r];
    }
}

__device__ __forceinline__ void scan_carries(const P& p, int l, const float* SST, const float* DEC, bf16* HIN) {
    for (int e = p.bid * NTHR + p.tid; e < 2 * 8 * 8192; e += p.G * NTHR) {
        const int d = e >> 16, h = (e >> 13) & 7, pn = e & 8191;
        float hs = 0.f;
        for (int c0 = 0; c0 < NCH; c0 += 10) {
            float s[10], dc[10];
#pragma unroll
            for (int j = 0; j < 10; ++j) { const size_t ci = (size_t)(d * NCH + c0 + j) * 8 + h; s[j] = SST[ci * 8192 + pn]; dc[j] = DEC[ci]; }
#pragma unroll
            for (int j = 0; j < 10; ++j) { const size_t ci = (size_t)(d * NCH + c0 + j) * 8 + h; HIN[ci * 8192 + pn] = (bf16)f2bf(hs); hs = hs * dc[j] + s[j]; }
        }
    }
    for (int e = p.bid * NTHR + p.tid; e < 2 * 32 * 64; e += p.G * NTHR) {
        const int d = e >> 11, g = (e >> 6) & 31, pq = e & 63;
        S5Lane s; s5_lane_params(p, l, d, g, pq, s, false);
        float ar = s.abr, ai = s.abi;
#pragma unroll
        for (int q = 0; q < 7; ++q) { const float nr = ar * ar - ai * ai, ni = 2.f * ar * ai; ar = nr; ai = ni; }
        float hr = 0.f, hi = 0.f;
        const float* E = p.S5E + (size_t)(d * 32 + g) * NCH * 128 + pq; float* Hn = p.S5H + (size_t)(d * 32 + g) * NCH * 128 + pq;
        for (int c0 = 0; c0 < NCH; c0 += 10) {
            float er[10], ei[10];
#pragma unroll
            for (int j = 0; j < 10; ++j) { er[j] = E[(c0 + j) * 128]; ei[j] = E[(c0 + j) * 128 + 64]; }
#pragma unroll
            for (int j = 0; j < 10; ++j) { Hn[(c0 + j) * 128] = hr; Hn[(c0 + j) * 128 + 64] = hi;
                const float nr = ar * hr - ai * hi + er[j], ni = ar * hi + ai * hr + ei[j]; hr = nr; hi = ni; }
        }
    }
}

__device__ __forceinline__ void ssd_outputs(const P& p, int l, LAS unsigned char* lds, const bf16* HIN, bf16* YS) {
    LAS unsigned char* Cm = lds;
    LAS unsigned char* Bm = lds + 128 * LDP;
    LAS unsigned char* XT = lds + 2 * 128 * LDP;
    LAS unsigned char* Wm = lds + 2 * 128 * LDP + 64 * LDP;
    LAS float* sm = (LAS float*)(lds + 3 * 128 * LDP + 64 * LDP);
    const int tid = p.tid, lane = p.lane, wave = p.wave, quad = lane >> 4, l15 = lane & 15;
    for (int u = p.bid; u < NCH * 8; u += p.G) {
        const int cn = u >> 3, h = u & 7, g = h >> 2, r0 = 128 * cn;
        __syncthreads();
        if (wave < 2) { const int d = wave; const float a = -expf(p.a_log[l * 16 + d * 8 + h]); float total;
            ssd_acum(p.DT, r0, d, d * 8 + h, a, lane, sm + d * 128, sm + 256 + d * 128, total); }
        for (int idx = tid; idx < 128 * 16; idx += NTHR) { const int j = idx >> 4, n8 = (idx & 15) * 8;
            const bf16* src = p.CV + (size_t)(r0 + j) * 1024 + g * 128 + n8;
            *(LAS u32x4*)(Bm + j * LDP + n8 * 2) = *(const u32x4*)(src + 512); *(LAS u32x4*)(Cm + j * LDP + n8 * 2) = *(const u32x4*)(src + 768); }
        for (int idx = tid; idx < 128 * 8; idx += NTHR) { const int j = idx >> 3, p8 = (idx & 7) * 8;
            const u32x4 v = *(const u32x4*)(p.CV + (size_t)(r0 + j) * 1024 + h * 64 + p8);
            LAS unsigned char* dst = XT + p8 * LDP + 2 * j;
            st_b16(dst, v.x & 0xffffu); st_b16(dst + LDP, v.x >> 16); st_b16(dst + 2 * LDP, v.y & 0xffffu); st_b16(dst + 3 * LDP, v.y >> 16);
            st_b16(dst + 4 * LDP, v.z & 0xffffu); st_b16(dst + 5 * LDP, v.z >> 16); st_b16(dst + 6 * LDP, v.w & 0xffffu); st_b16(dst + 7 * LDP, v.w >> 16); }
        __syncthreads();
        f32x4 G[8];
#pragma unroll
        for (int jt = 0; jt < 8; ++jt) G[jt] = (f32x4){0.f, 0.f, 0.f, 0.f};
#pragma unroll
        for (int ks = 0; ks < 4; ++ks) { const bf16x8 af = ld_frag(Cm, 16 * wave + l15, ks * 32 + 8 * quad, LDP);
#pragma unroll
            for (int jt = 0; jt < 8; ++jt) G[jt] = MFMA16(af, ld_frag(Bm, 16 * jt + l15, ks * 32 + 8 * quad, LDP), G[jt]); }
        __syncthreads();
        for (int idx = tid; idx < 2 * 64 * 16; idx += NTHR) { const int d = idx >> 10, pp = (idx >> 4) & 63, n8 = (idx & 15) * 8;
            const int cs = scan_chunk_of(d, cn);
            *(LAS u32x4*)(Bm + (d * 64 + pp) * LDP + n8 * 2) = *(const u32x4*)(HIN + ((size_t)(d * NCH + cs) * 8 + h) * 8192 + pp * 128 + n8); }
        __syncthreads();
        f32x4 Y[4];
#pragma unroll
        for (int pt = 0; pt < 4; ++pt) Y[pt] = (f32x4){0.f, 0.f, 0.f, 0.f};
#pragma unroll
        for (int d = 0; d < 2; ++d) {
            const LAS float* ac = sm + d * 128; const LAS float* dv = sm + 256 + d * 128;
            float ai[4];
#pragma unroll
            for (int r = 0; r < 4; ++r) ai[r] = ac[16 * wave + 4 * quad + r];
#pragma unroll
            for (int jt = 0; jt < 8; ++jt) { const int j = 16 * jt + l15; const float aj = ac[j], dj = dv[j];
#pragma unroll
                for (int r = 0; r < 4; ++r) { const int i = 16 * wave + 4 * quad + r; const bool valid = (d == 0) ? (j <= i) : (j >= i);
                    const float w = valid ? G[jt][r] * expf(ai[r] - aj) * dj : 0.f;
                    st_b16(Wm + i * LDP + 2 * j, f2bf(w)); } }
            LDS_FENCE();
            f32x4 Y2[4];
#pragma unroll
            for (int pt = 0; pt < 4; ++pt) Y2[pt] = (f32x4){0.f, 0.f, 0.f, 0.f};
#pragma unroll
            for (int ks = 0; ks < 4; ++ks) { const bf16x8 wf = ld_frag(Wm, 16 * wave + l15, ks * 32 + 8 * quad, LDP), cf = ld_frag(Cm, 16 * wave + l15, ks * 32 + 8 * quad, LDP);
#pragma unroll
                for (int pt = 0; pt < 4; ++pt) { Y[pt] = MFMA16(wf, ld_frag(XT, 16 * pt + l15, ks * 32 + 8 * quad, LDP), Y[pt]);
                    Y2[pt] = MFMA16(cf, ld_frag(Bm + d * 64 * LDP, 16 * pt + l15, ks * 32 + 8 * quad, LDP), Y2[pt]); } }
#pragma unroll
            for (int r = 0; r < 4; ++r) { const float ea = expf(ai[r]);
#pragma unroll
                for (int pt = 0; pt < 4; ++pt) Y[pt][r] += ea * Y2[pt][r]; }
            LDS_FENCE();
        }
#pragma unroll
        for (int pt = 0; pt < 4; ++pt)
#pragma unroll
            for (int r = 0; r < 4; ++r) YS[(size_t)(r0 + 16 * wave + 4 * quad + r) * 512 + h * 64 + 16 * pt + l15] = (bf16)f2bf(Y[pt][r]);
    }
}

__device__ __forceinline__ void ssd_gated_norm(const P& p, int l, const bf16* YS) {
    const int gw = p.bid * NWAVES + p.wave, NGW = p.G * NWAVES, lane = p.lane;
    for (int row = gw; row < T; row += NGW) {
        const int ch = lane * 8;
        const float dsk = p.ssd_d[l * 8 + (ch >> 6)];
        const u32x4 yv = *(const u32x4*)(YS + (size_t)row * 512 + ch);
        const u32x4 xs = *(const u32x4*)(p.CV + (size_t)row * 1024 + ch), zz = *(const u32x4*)(p.PROJ + (size_t)row * PJ + Z0 + ch);
        float v[8];
        v[0] = (bflo(yv.x) + dsk * bflo(xs.x)) * silu_f(bflo(zz.x)); v[1] = (bfhi(yv.x) + dsk * bfhi(xs.x)) * silu_f(bfhi(zz.x));
        v[2] = (bflo(yv.y) + dsk * bflo(xs.y)) * silu_f(bflo(zz.y)); v[3] = (bfhi(yv.y) + dsk * bfhi(xs.y)) * silu_f(bfhi(zz.y));
        v[4] = (bflo(yv.z) + dsk * bflo(xs.z)) * silu_f(bflo(zz.z)); v[5] = (bfhi(yv.z) + dsk * bfhi(xs.z)) * silu_f(bfhi(zz.z));
        v[6] = (bflo(yv.w) + dsk * bflo(xs.w)) * silu_f(bflo(zz.w)); v[7] = (bfhi(yv.w) + dsk * bfhi(xs.w)) * silu_f(bfhi(zz.w));
        float ss = 0.f;
#pragma unroll
        for (int i = 0; i < 8; ++i) ss += v[i] * v[i];
        const float rstd = rsqrtf(wsum(ss) * (1.f / 512.f) + EPS);
        const float* ng = p.ssd_norm_g + (size_t)l * 512 + ch;
        const f32x4 g0 = *(const f32x4*)ng, g1 = *(const f32x4*)(ng + 4);
        u32x4 o; o.x = pk2(v[0] * rstd * g0[0], v[1] * rstd * g0[1]); o.y = pk2(v[2] * rstd * g0[2], v[3] * rstd * g0[3]);
        o.z = pk2(v[4] * rstd * g1[0], v[5] * rstd * g1[1]); o.w = pk2(v[6] * rstd * g1[2], v[7] * rstd * g1[3]);
        *(u32x4*)(p.Y3 + ((size_t)T + row) * 512 + ch) = o;
    }
}

__device__ __forceinline__ void attention_mfma(const P& p, int l, LAS unsigned char* lds, int u_begin, int u_end, int u_first, int u_stride) {
    LAS unsigned char* Kt = lds;
    LAS unsigned char* VT = lds + 64 * LDQ;
    LAS unsigned char* Pw = lds + 2 * 64 * LDQ + p.wave * 64 * LDQ;
    const int tid = p.tid, lane = p.lane, wave = p.wave, quad = lane >> 4, l15 = lane & 15;
    const float C2 = 0.125f * 1.4426950408889634f;
    for (int u = u_begin + u_first; u < u_end; u += u_stride) {
        const int qb = u >> 1, kvh = u & 1, hq = kvh * 4 + (wave >> 1);
        const bool isc = qb < 2; const int nb = qb - 2;
        const int qrow0 = 128 * qb + 64 * (wave & 1);
        bf16x8 Qf[4][2];
#pragma unroll
        for (int qt = 0; qt < 4; ++qt)
#pragma unroll
            for (int ks = 0; ks < 2; ++ks) Qf[qt][ks] = *(const bf16x8*)(p.PROJ + (size_t)(qrow0 + 16 * qt + l15) * PJ + Q0 + hq * 64 + ks * 32 + 8 * quad);
        f32x4 O[4][4];
#pragma unroll
        for (int a = 0; a < 4; ++a)
#pragma unroll
            for (int b = 0; b < 4; ++b) O[a][b] = (f32x4){0.f, 0.f, 0.f, 0.f};
        float mrow[4], lrow[4];
        const float sk = p.sink[l * 8 + hq] * 1.4426950408889634f;
#pragma unroll
        for (int qt = 0; qt < 4; ++qt) { mrow[qt] = sk; lrow[qt] = 1.f; }
        const int ntile = isc ? 4 : 10;
        for (int ti = 0; ti < ntile; ++ti) {
            int krow0; bool local;
            if (isc || ti >= 6) { krow0 = 64 * (isc ? ti : ti - 6); local = false; }
            else { krow0 = NCTX + 128 * (nb - 1) + 64 * ti; local = true; }
            if (local && (krow0 < NCTX || krow0 >= T)) continue;
            __syncthreads();
            { const int key = tid >> 3, pc = tid & 7;
              const bf16* src = p.PROJ + (size_t)(krow0 + key) * PJ + kvh * 64 + pc * 8;
              *(LAS u32x4*)(Kt + key * LDQ + pc * 16) = *(const u32x4*)(src + K0);
              const u32x4 v = *(const u32x4*)(src + V0);
              LAS unsigned char* dst = VT + (pc * 8) * LDQ + 2 * key;
              st_b16(dst, v.x & 0xffffu); st_b16(dst + LDQ, v.x >> 16); st_b16(dst + 2 * LDQ, v.y & 0xffffu); st_b16(dst + 3 * LDQ, v.y >> 16);
              st_b16(dst + 4 * LDQ, v.z & 0xffffu); st_b16(dst + 5 * LDQ, v.z >> 16); st_b16(dst + 6 * LDQ, v.w & 0xffffu); st_b16(dst + 7 * LDQ, v.w >> 16); }
            __syncthreads();
            f32x4 S[4][4];
#pragma unroll
            for (int a = 0; a < 4; ++a)
#pragma unroll
                for (int b = 0; b < 4; ++b) S[a][b] = (f32x4){0.f, 0.f, 0.f, 0.f};
#pragma unroll
            for (int ks = 0; ks < 2; ++ks)
#pragma unroll
                for (int kt = 0; kt < 4; ++kt) { const bf16x8 kf = ld_frag(Kt, 16 * kt + l15, ks * 32 + 8 * quad, LDQ);
#pragma unroll
                    for (int qt = 0; qt < 4; ++qt) S[kt][qt] = MFMA16(kf, Qf[qt][ks], S[kt][qt]); }
#pragma unroll
            for (int qt = 0; qt < 4; ++qt) {
                const int tq = qrow0 + 16 * qt + l15;
                float mx = -1e30f;
#pragma unroll
                for (int kt = 0; kt < 4; ++kt)
#pragma unroll
                    for (int r = 0; r < 4; ++r) { const int tk = krow0 + 16 * kt + 4 * quad + r; const int df = tq - tk;
                        const bool ok = !local || (df <= 128 && df >= -128);
                        const float s = ok ? S[kt][qt][r] * C2 : -1e30f; S[kt][qt][r] = s; mx = fmaxf(mx, s); }
                mx = fmaxf(mx, __shfl_xor(mx, 16)); mx = fmaxf(mx, __shfl_xor(mx, 32));
                const float mn = fmaxf(mrow[qt], mx), alpha = exp2f(mrow[qt] - mn);
                float ls = 0.f;
#pragma unroll
                for (int kt = 0; kt < 4; ++kt) { float e0 = exp2f(S[kt][qt][0] - mn), e1 = exp2f(S[kt][qt][1] - mn), e2 = exp2f(S[kt][qt][2] - mn), e3 = exp2f(S[kt][qt][3] - mn);
                    ls += (e0 + e1) + (e2 + e3);
                    u32x2 w; w.x = pk2(e0, e1); w.y = pk2(e2, e3);
                    *(LAS u32x2*)(Pw + (16 * qt + l15) * LDQ + (16 * kt + 4 * quad) * 2) = w; }
                ls += __shfl_xor(ls, 16); ls += __shfl_xor(ls, 32);
                lrow[qt] = lrow[qt] * alpha + ls; mrow[qt] = mn;
#pragma unroll
                for (int dt = 0; dt < 4; ++dt) O[dt][qt] *= alpha;
            }
            LDS_FENCE();
#pragma unroll
            for (int ks = 0; ks < 2; ++ks) {
                bf16x8 pf[4];
#pragma unroll
                for (int qt = 0; qt < 4; ++qt) pf[qt] = ld_frag(Pw, 16 * qt + l15, ks * 32 + 8 * quad, LDQ);
#pragma unroll
                for (int dt = 0; dt < 4; ++dt) { const bf16x8 vf = ld_frag(VT, 16 * dt + l15, ks * 32 + 8 * quad, LDQ);
#pragma unroll
                    for (int qt = 0; qt < 4; ++qt) O[dt][qt] = MFMA16(vf, pf[qt], O[dt][qt]); }
            }
            LDS_FENCE();
        }
#pragma unroll
        for (int qt = 0; qt < 4; ++qt) { const float inv = 1.f / lrow[qt];
            bf16* orow = p.Y3 + ((size_t)2 * T + qrow0 + 16 * qt + l15) * 512 + hq * 64;
#pragma unroll
            for (int dt = 0; dt < 4; ++dt) { u32x2 w; w.x = pk2(O[dt][qt][0] * inv, O[dt][qt][1] * inv); w.y = pk2(O[dt][qt][2] * inv, O[dt][qt][3] * inv);
                *(u32x2*)(orow + 16 * dt + 4 * quad) = w; } }
    }
}

constexpr size_t S5BB_ELEMS = (size_t)2 * 32 * 128 * 32, S5CC_ELEMS = (size_t)2 * 32 * 16 * 128;
__device__ __forceinline__ void s5_tables(const P& p, int l, bf16* BB, bf16* CC, float* AB) {
    for (int e = p.bid * NTHR + p.tid; e < 2 * 32 * 64; e += p.G * NTHR) {
        const int d = e >> 11, g = (e >> 6) & 31, pq = e & 63, dg = d * 32 + g;
        S5Lane s; s5_lane_params(p, l, d, g, pq, s, true);
        AB[(size_t)e * 2] = s.abr; AB[(size_t)e * 2 + 1] = s.abi;
        u32x4* br = (u32x4*)(BB + ((size_t)dg * 128 + pq) * 32); u32x4* bi = (u32x4*)(BB + ((size_t)dg * 128 + 64 + pq) * 32);
        u32x4 w;
        w.x = pk2(s.bbr[0], s.bbr[1]); w.y = pk2(s.bbr[2], s.bbr[3]); w.z = pk2(s.bbr[4], s.bbr[5]); w.w = pk2(s.bbr[6], s.bbr[7]); br[0] = w;
        w.x = pk2(s.bbr[8], s.bbr[9]); w.y = pk2(s.bbr[10], s.bbr[11]); w.z = pk2(s.bbr[12], s.bbr[13]); w.w = pk2(s.bbr[14], s.bbr[15]); br[1] = w;
        w.x = pk2(s.bbi[0], s.bbi[1]); w.y = pk2(s.bbi[2], s.bbi[3]); w.z = pk2(s.bbi[4], s.bbi[5]); w.w = pk2(s.bbi[6], s.bbi[7]); bi[0] = w;
        w.x = pk2(s.bbi[8], s.bbi[9]); w.y = pk2(s.bbi[10], s.bbi[11]); w.z = pk2(s.bbi[12], s.bbi[13]); w.w = pk2(s.bbi[14], s.bbi[15]); bi[1] = w;
        const u32x4 z = (u32x4){0u, 0u, 0u, 0u}; br[2] = z; br[3] = z; bi[2] = z; bi[3] = z;
        const size_t ci = ((size_t)(l * 2 + d) * 32 + g) * 16;
#pragma unroll
        for (int k = 0; k < 16; ++k) { CC[((size_t)dg * 16 + k) * 128 + pq] = (bf16)f2bf(p.c_re[(ci + k) * 64 + pq]); CC[((size_t)dg * 16 + k) * 128 + 64 + pq] = (bf16)f2bf(-p.c_im[(ci + k) * 64 + pq]); }
    }
}
constexpr int S5_WREG = 4096 + 16 * 132 * 4 + 16 * LDP;
template <bool READOUT> __device__ __forceinline__ void s5_chunk_dir(int d, const bf16* BBdg, const bf16* CCdg, float abr, float abi, LAS unsigned char* wreg, int lane, float& hr, float& hi, f32x4 (&yacc)[8]) {
    const int quad = lane >> 4, l15 = lane & 15;
    LAS unsigned char* ub = wreg; LAS float* BuW = (LAS float*)(wreg + 4096); LAS unsigned char* Hw = wreg + 4096 + 16 * 132 * 4;
    bf16x8 BBf[8], CCf[4];
#pragma unroll
    for (int pt = 0; pt < 8; ++pt) BBf[pt] = *(const bf16x8*)(BBdg + (size_t)(16 * pt + l15) * 32 + 8 * quad);
    if (READOUT) {
#pragma unroll
        for (int ks = 0; ks < 4; ++ks) CCf[ks] = *(const bf16x8*)(CCdg + (size_t)l15 * 128 + ks * 32 + 8 * quad);
    }
#pragma unroll (READOUT ? 8 : 1)
    for (int ss = 0; ss < 8; ++ss) {
        const int sc = d ? 7 - ss : ss;
        bf16x8 uf = (bf16x8){0, 0, 0, 0, 0, 0, 0, 0};
        if (quad < 2) uf = *(const LAS bf16x8*)(ub + (16 * sc + l15) * 32 + quad * 16);
#pragma unroll
        for (int pt = 0; pt < 8; ++pt) { const f32x4 Dp = MFMA16(uf, BBf[pt], ((f32x4){0.f, 0.f, 0.f, 0.f}));
#pragma unroll
            for (int r = 0; r < 4; ++r) BuW[(4 * quad + r) * 132 + 16 * pt + l15] = Dp[r]; }
        LDS_FENCE();
#pragma unroll
        for (int st = 0; st < 16; ++st) { const int tl = d ? 15 - st : st;
            const float br = BuW[tl * 132 + lane], bi = BuW[tl * 132 + 64 + lane];
            const float nr = abr * hr - abi * hi + br, ni = abr * hi + abi * hr + bi; hr = nr; hi = ni;
            if (READOUT) { st_b16(Hw + tl * LDP + 2 * lane, f2bf(hr)); st_b16(Hw + tl * LDP + 128 + 2 * lane, f2bf(hi)); } }
        if (READOUT) {
            LDS_FENCE();
#pragma unroll
            for (int ks = 0; ks < 4; ++ks) yacc[sc] = MFMA16(ld_frag(Hw, l15, ks * 32 + 8 * quad, LDP), CCf[ks], yacc[sc]);
        }
        LDS_FENCE();
    }
}
__device__ __forceinline__ void s5_local_states(const P& p, LAS unsigned char* lds, const bf16* BB, const float* AB) {
    LAS unsigned char* wreg = lds + p.wave * S5_WREG;
    const int gw = p.bid * NWAVES + p.wave, NGW = p.G * NWAVES, lane = p.lane;
    for (int it = gw; it < 2 * 32 * NCH; it += NGW) {
        const int d = it / (32 * NCH), c = (it % (32 * NCH)) >> 5, g = it & 31, dg = d * 32 + g;
        s5_stage_u(p, chunk_r0(d, c), g, wreg, lane);
        float hr = 0.f, hi = 0.f; f32x4 dummy[8];
        const float abr = AB[((size_t)dg * 64 + lane) * 2], abi = AB[((size_t)dg * 64 + lane) * 2 + 1];
        if (d == 0) s5_chunk_dir<false>(0, BB + (size_t)dg * 128 * 32, nullptr, abr, abi, wreg, lane, hr, hi, dummy);
        else s5_chunk_dir<false>(1, BB + (size_t)dg * 128 * 32, nullptr, abr, abi, wreg, lane, hr, hi, dummy);
        float* E = p.S5E + ((size_t)dg * NCH + c) * 128;
        E[lane] = hr; E[64 + lane] = hi;
    }
}
__device__ __forceinline__ void s5_outputs(const P& p, int l, LAS unsigned char* lds, const bf16* BB, const bf16* CC, const float* AB) {
    LAS unsigned char* wreg = lds + p.wave * S5_WREG;
    const int gw = p.bid * NWAVES + p.wave, NGW = p.G * NWAVES, lane = p.lane, quad = lane >> 4, l15 = lane & 15;
    for (int it = gw; it < 32 * NCH; it += NGW) {
        const int cn = it >> 5, g = it & 31, r0 = 128 * cn;
        s5_stage_u(p, r0, g, wreg, lane);
        f32x4 yacc[8];
#pragma unroll
        for (int i = 0; i < 8; ++i) yacc[i] = (f32x4){0.f, 0.f, 0.f, 0.f};
#pragma unroll
        for (int d = 0; d < 2; ++d) { const int dg = d * 32 + g, cs = scan_chunk_of(d, cn);
            const float* Hn = p.S5H + ((size_t)dg * NCH + cs) * 128;
            float hr = Hn[lane], hi = Hn[64 + lane];
            s5_chunk_dir<true>(d, BB + (size_t)dg * 128 * 32, CC + (size_t)dg * 16 * 128, AB[((size_t)dg * 64 + lane) * 2], AB[((size_t)dg * 64 + lane) * 2 + 1], wreg, lane, hr, hi, yacc); }
        const float dsk = p.s5_d[(size_t)l * 512 + g * 16 + l15];
#pragma unroll
        for (int sc = 0; sc < 8; ++sc)
#pragma unroll
            for (int r = 0; r < 4; ++r) { const int t = 16 * sc + 4 * quad + r;
                const float u = bf2f(*(const LAS unsigned short*)(wreg + t * 32 + 2 * l15));
                p.SA[(size_t)(r0 + t) * 512 + g * 16 + l15] = (bf16)f2bf(gelu_tanh_f(yacc[sc][r] + dsk * u)); }
        LDS_FENCE();
    }
}

#ifndef SKIPMASK
#define SKIPMASK 0
#endif
struct Args { const float* in[33]; float* out; unsigned char* ws; int ph_lo, ph_hi; };
static_assert(sizeof(Args) == 35 * 8 + 8, "no padding");

__global__ void __launch_bounds__(NTHR, 2) fwd_kernel(Args args) {
    extern __shared__ __attribute__((aligned(16))) unsigned char lds_raw[];
    LAS unsigned char* lds = (LAS unsigned char*)lds_raw;
    const int tid_ = threadIdx.x;
    if (tid_ == 0) {
        LAS unsigned long long* tab = (LAS unsigned long long*)(lds + PTAB_OFF);
#pragma unroll
        for (int k = 0; k < 33; ++k) tab[k] = (unsigned long long)args.in[k];
        tab[33] = (unsigned long long)args.out; tab[34] = (unsigned long long)args.ws;
    }
    volatile LAS unsigned* MISC = (volatile LAS unsigned*)(lds + MISC_OFF);
    if (tid_ < 64) MISC[tid_] = 0u;
    __syncthreads();
    XcdBarrier bar; bar.bar = (unsigned*)(args.ws + WS_CTL) + CW_BAR; bar.x = 0; bar.st = nullptr;
    if (!MK_PER_PHASE) bar = xcd_barrier_post((unsigned*)(args.ws + WS_CTL) + CW_BAR, MISC + 8);

    const int lo = args.ph_lo, hi = args.ph_hi;
#define IN(k) (lo <= (k) && (k) < hi)
#define SEAM(k) do { if (!MK_PER_PHASE && (k) + 1 < hi) xcd_barrier(bar); } while (0)

    if (IN(0)) { P p; build_P(p, lds); phase_mod(p, lds); SEAM(0); }

#ifndef REPMASK
#define REPMASK 0
#endif
#define PHASE(k, ...) if (!((SKIPMASK >> (k)) & 1) && IN(pb + (k))) { for (int rep_ = 0; rep_ <= ((REPMASK >> (k)) & 1); ++rep_) { P p; build_P(p, lds); __VA_ARGS__; \
        if (rep_ < ((REPMASK >> (k)) & 1)) xcd_barrier(bar); } SEAM(pb + (k)); }
    for (int l = 0; l < DEPTH; ++l) {
        const int pb = 1 + NPH_LAYER * l;
        unsigned char* wsb; { unsigned tb_ = (unsigned)(size_t)(lds + PTAB_OFF); asm volatile("" : "+v"(tb_)); wsb = (unsigned char*)ld_tab((volatile LAS unsigned*)(size_t)tb_, 34); }
        PHASE(0, convert_weights(p, l, lds); s5_tables(p, l, (bf16*)(wsb + WS_S5BB), (bf16*)(wsb + WS_S5CC), (float*)(wsb + WS_S5AB)); __syncthreads(); if (rep_ == 0) row_pass<0>(p, l, lds))
        PHASE(1, pg8::Gemm g{p.H, p.WIN, T, PJ, D}; pg8::StaticOrder S; S.init(T, PJ, p.G, p.bid); pg8::EpiStoreBf16 E{p.PROJ, PJ};
            pg8::gemm_phase<pg8::EpiStoreBf16, pg8::StaticOrder, false>(lds, g, S, E, nullptr))
        PHASE(2, phase_premix(p, l, lds, rep_ == 0); s5_local_states(p, lds, (const bf16*)(wsb + WS_S5BB), (const float*)(wsb + WS_S5AB)))
        PHASE(3, ssd_states(p, l, lds, (float*)(wsb + WS_SST), (float*)(wsb + WS_DEC)); __syncthreads(); attention_mfma(p, l, lds, 4, 2 * NCH, p.bid, p.G))
        PHASE(4, if (p.bid >= p.G - 4) attention_mfma(p, l, lds, 0, 4, p.bid - (p.G - 4), 4);
            scan_carries(p, l, (const float*)(wsb + WS_SST), (const float*)(wsb + WS_DEC), (bf16*)(wsb + WS_HIN)))
        PHASE(5, ssd_outputs(p, l, lds, (const bf16*)(wsb + WS_HIN), (bf16*)(wsb + WS_YS)); __syncthreads(); s5_outputs(p, l, lds, (const bf16*)(wsb + WS_S5BB), (const bf16*)(wsb + WS_S5CC), (const float*)(wsb + WS_S5AB)))
        PHASE(6, pg8::Gemm g{p.SA, p.WGLU, T, 512, 512}; pg8::StaticOrder S; S.init(T, 512, p.G, p.bid); pg8::EpiGlu E{p.SA, p.b_glu + (size_t)l * 512, p.Y3};
            pg8::gemm_phase<pg8::EpiGlu, pg8::StaticOrder, false>(lds, g, S, E, nullptr); ssd_gated_norm(p, l, (const bf16*)(wsb + WS_YS)))
        PHASE(7, pg8::Gemm g{p.Y3, p.WBR, 3 * T, 3072, 512}; pg8::MergeOrder S{p.G, p.bid}; pg8::EpiMerge E{p.PROJ, p.PM, p.MB};
            pg8::gemm_phase<pg8::EpiMerge, pg8::MergeOrder, false>(lds, g, S, E, nullptr))
        PHASE(8, pg8::Gemm g{p.MB, p.WOUT, T, D, D}; pg8::StaticOrder S; S.init(T, D, p.G, p.bid);
            pg8::EpiResid E{p.XL, p.XC, p.MOD + (size_t)(l * 2 + 0) * 6144 + 2 * D, p.MOD + (size_t)(l * 2 + 1) * 6144 + 2 * D};
            pg8::gemm_phase<pg8::EpiResid, pg8::StaticOrder, false>(lds, g, S, E, nullptr))
        PHASE(9, row_pass<1>(p, l, lds))
        PHASE(10, phase_select(p, lds))
        PHASE(11, phase_gather(p))
        PHASE(12, pg8::Gemm g{p.XE, p.WUP, NE * ESLOTS, NE * 2048, D}; pg8::ExpertOrder S{p.G, p.bid, 8}; pg8::EpiSwiGlu E{p.HID};
            pg8::gemm_phase<pg8::EpiSwiGlu, pg8::ExpertOrder, false>(lds, g, S, E, nullptr))
        PHASE(13, pg8::Gemm g{p.HID, p.WDN, NE * ESLOTS, NE * 1024, D}; pg8::ExpertOrder S{p.G, p.bid, 4}; pg8::EpiDown E{p.YE, p.GSEL};
            pg8::gemm_phase<pg8::EpiDown, pg8::ExpertOrder, false>(lds, g, S, E, nullptr))
    }
    if (IN(NPHASES - 1)) { P p; build_P(p, lds); row_pass<2>(p, 0, lds); }
#undef IN
#undef SEAM
}

extern "C" void kernel_launch(void* const* d_in, const int* in_sizes, int n_in, void* d_out, int out_size, void* d_ws, size_t ws_size, hipStream_t stream) {
    static int grid = 0;
    if (grid == 0) {
        if (n_in != 33 || out_size != NLAT * D || ws_size < WS_END) { fprintf(stderr, "kernel_launch: unexpected shapes: n_in %d out %d ws %zu (need %zu)\n", n_in, out_size, ws_size, (size_t)WS_END); grid = -1; return; }
        int dev = 0, cus = 0, per_cu = 0;
        if (hipGetDevice(&dev) != hipSuccess || hipDeviceGetAttribute(&cus, hipDeviceAttributeMultiprocessorCount, dev) != hipSuccess) { grid = -1; return; }
        if (hipFuncSetAttribute((const void*)fwd_kernel, hipFuncAttributeMaxDynamicSharedMemorySize, LDS_BYTES) != hipSuccess) { fprintf(stderr, "kernel_launch: hipFuncSetAttribute failed\n"); grid = -1; return; }
        if (hipOccupancyMaxActiveBlocksPerMultiprocessor(&per_cu, (const void*)fwd_kernel, NTHR, LDS_BYTES) != hipSuccess || per_cu < 1) { fprintf(stderr, "kernel_launch: occupancy query says %d\n", per_cu); (void)hipGetLastError(); }
        grid = cus;
    }
    if (grid < 0) return;
    (void)hipMemsetAsync((char*)d_ws + WS_CTL, 0, CTL_BYTES, stream);
    Args a{};
    for (int i = 0; i < 33; ++i) a.in[i] = (const float*)d_in[i];
    a.out = (float*)d_out; a.ws = (unsigned char*)d_ws;
#if MK_PER_PHASE
    for (int ph = 0; ph < NPHASES; ++ph) { a.ph_lo = ph; a.ph_hi = ph + 1; hipLaunchKernelGGL(fwd_kernel, dim3(grid), dim3(NTHR), LDS_BYTES, stream, a); }
#else
    a.ph_lo = 0; a.ph_hi = NPHASES;
    hipLaunchKernelGGL(fwd_kernel, dim3(grid), dim3(NTHR), LDS_BYTES, stream, a);
#endif
}
```

```cpp
#include <hip/hip_runtime.h>
#include <cstdio>
#include <cstdint>

#ifndef MK_PER_PHASE
#define MK_PER_PHASE 0
#endif

namespace pg8 {
#define PG8_LAS __attribute__((address_space(3)))
typedef unsigned short bf16_t;
typedef short bf16x8 __attribute__((ext_vector_type(8)));
typedef float f32x4 __attribute__((ext_vector_type(4)));
typedef unsigned u32x4 __attribute__((ext_vector_type(4)));
constexpr int BM = 256, BK = 64, HALF = 128, HTB = HALF * BK * 2  , STAGE_BYTES = 8 * HTB, NXCD = 8, WGM = 8;

__host__ __device__ __forceinline__ int lds_byte(int r, int c) { const int st = (r >> 4) * 2 + (c >> 5), rr = r & 15, cc = c & 31, ob = rr * 64 + cc * 2; return st * 1024 + (ob ^ (((ob >> 9) & 1) << 5)); }
__host__ __device__ __forceinline__ void stage_rc(int b, int& R, int& C) { const int st = b / 1024, sb = b % 1024, swz = sb ^ (((sb >> 9) & 1) << 5); R = (st >> 1) * 16 + swz / 64; C = (st & 1) * 32 + (swz % 64) / 2; }
__host__ __device__ __forceinline__ int perm32(int rho) { const int n = rho >> 4, i = rho & 15; return 8 * (i >> 2) + 4 * n + (i & 3); }

struct Unit { int pm, pn; };
struct Gemm { const bf16_t* A; const bf16_t* Bt; int M, N, K; };

struct StaticOrder {
    int nM, nN, nwg, G, c;
    __host__ __device__ void init(int M, int N, int G_, int c_) { nM = M / BM; nN = N / BM; nwg = nM * nN; G = G_; c = c_; }
    __host__ __device__ bool next(int i, Unit& u) const {
        const long L = (long)i * G + c; if (L >= nwg) return false;
        int wgid = (int)L; { const int q = nwg / NXCD, r = nwg % NXCD, xcd = wgid % NXCD, off = wgid / NXCD; wgid = (xcd < r ? xcd * (q + 1) : r * (q + 1) + (xcd - r) * q) + off; }
        const int nig = WGM * nN, gid = wgid / nig, fm = gid * WGM, gsz = (nM - fm) < WGM ? (nM - fm) : WGM;
        u.pm = fm + ((wgid % nig) % gsz); u.pn = (wgid % nig) / gsz; return true;
    }
    __device__ __forceinline__ void a_ready(const Unit&) const {}
    __device__ __forceinline__ void done(const Unit&) const {}
};
__device__ __forceinline__ unsigned cvt_pk_bf16(float lo, float hi) { unsigned r; asm volatile("v_cvt_pk_bf16_f32 %0, %1, %2" : "=v"(r) : "v"(lo), "v"(hi)); return r; }
template <class Epi, class Sched, bool STAMP = false>
__device__ __forceinline__ void gemm_phase(PG8_LAS unsigned char* lds, const Gemm g, const Sched& S, const Epi& E, unsigned long long* stamps) {
    int tid_l = threadIdx.x; asm volatile("" : "+v"(tid_l));
    const int tid = tid_l, wid = __builtin_amdgcn_readfirstlane(tid >> 6), lane = tid & 63, wr = wid >> 2, wc = wid & 3, fr = lane & 15, fq = lane >> 4;
    const int K = g.K, nt = K / BK;
    int ts_lo = 0, ts_hi = 0, nts = 0; const unsigned long long rt_entry = STAMP ? (unsigned long long)wall_clock64() : 0ull;
#define PG8_STAMP() do { if (STAMP && wid == 0 && nts < 64) { const unsigned long long _c = (unsigned long long)clock64(); \
        ts_lo = (lane == nts) ? (int)(unsigned)_c : ts_lo; ts_hi = (lane == nts) ? (int)(unsigned)(_c >> 32) : ts_hi; ++nts; } } while (0)
    PG8_STAMP();
    unsigned voffA[2], voffB[2];
#pragma unroll
    for (int i = 0; i < 2; ++i) { int R, C; stage_rc(tid * 16 + i * 8192, R, C); const int Rb = Epi::PERM ? ((R & ~31) + perm32(R & 31)) : R;
        voffA[i] = (unsigned)(R * K + C) * 2u; voffB[i] = (unsigned)(Rb * K + C) * 2u; }
    const size_t kstep = (size_t)(BK * 2);
    const size_t hstep = (size_t)HALF * K * 2;
    const size_t tstep = 2 * hstep;
    const unsigned ldsw = (unsigned)wid * 1024u;
    const int aoff = lds_byte(wr * 64 + fr, fq * 8), boff = lds_byte(wc * 32 + fr, fq * 8);
#define PG8_SA(b, h) (((b) * 2 + (h)) * HTB)
#define PG8_SB(b, h) ((4 + (b) * 2 + (h)) * HTB)
#define PG8_STAGE(bufoff, gbase, voff) do { _Pragma("unroll") for (int _i = 0; _i < 2; ++_i) \
        __builtin_amdgcn_global_load_lds((const unsigned*)((const char*)(gbase) + (voff)[_i]), (PG8_LAS unsigned*)(lds + (bufoff) + ldsw + _i * 8192), 16, 0, 0); } while (0)
#define PG8_LDA(dst, b, h) do { _Pragma("unroll") for (int m = 0; m < 4; ++m) _Pragma("unroll") for (int k = 0; k < 2; ++k) dst[m][k] = *(const PG8_LAS bf16x8*)(lds + PG8_SA(b, h) + aoff + m * 2048 + k * 1024); } while (0)
#define PG8_LDB(dst, b, h) do { _Pragma("unroll") for (int n = 0; n < 2; ++n) _Pragma("unroll") for (int k = 0; k < 2; ++k) dst[n][k] = *(const PG8_LAS bf16x8*)(lds + PG8_SB(b, h) + boff + n * 2048 + k * 1024); } while (0)
#define PG8_MMA(ai, bj, At, Bt) do { __builtin_amdgcn_s_setprio(1); _Pragma("unroll") for (int m = 0; m < 4; ++m) _Pragma("unroll") for (int n = 0; n < 2; ++n) _Pragma("unroll") for (int k = 0; k < 2; ++k) \
        acc[ai][bj][m][n] = __builtin_amdgcn_mfma_f32_16x16x32_bf16(Bt[n][k], At[m][k], acc[ai][bj][m][n], 0, 0, 0); __builtin_amdgcn_s_setprio(0); } while (0)
#define PG8_WAIT_V(n) asm volatile("s_waitcnt vmcnt(" #n ")" ::: "memory")
#define PG8_WAIT_L(n) asm volatile("s_waitcnt lgkmcnt(" #n ")" ::: "memory")
#define PG8_BAR __builtin_amdgcn_s_barrier()
#define PG8_SCHED __builtin_amdgcn_sched_barrier(0)
    Unit cur, nxt; int ui = 0;
    if (!S.next(0, cur)) return;
    f32x4 acc[2][2][4][2];
#pragma unroll
    for (int a = 0; a < 2; ++a)
#pragma unroll
        for (int b = 0; b < 2; ++b)
#pragma unroll
            for (int m = 0; m < 4; ++m)
#pragma unroll
                for (int n = 0; n < 2; ++n) acc[a][b][m][n] = (f32x4){0.f, 0.f, 0.f, 0.f};
    bf16x8 At[4][2], B0[2][2], B1[2][2];
    const char* cA = (const char*)g.A + (size_t)cur.pm * tstep; const char* cB = (const char*)g.Bt + (size_t)cur.pn * tstep;
    S.a_ready(cur);
    PG8_STAGE(PG8_SB(0, 0), cB, voffB); PG8_STAGE(PG8_SA(0, 0), cA, voffA); PG8_STAGE(PG8_SB(0, 1), cB + hstep, voffB); PG8_STAGE(PG8_SA(0, 1), cA + hstep, voffA);
    if (wr == 1) PG8_BAR;
    PG8_WAIT_V(4); PG8_BAR;
    PG8_STAGE(PG8_SB(1, 0), cB + kstep, voffB); PG8_STAGE(PG8_SA(1, 0), cA + kstep, voffA); PG8_STAGE(PG8_SB(1, 1), cB + hstep + kstep, voffB);
    PG8_WAIT_V(6); PG8_BAR;
    PG8_STAMP();
    for (;;) {
        const bool has_next = S.next(ui + 1, nxt);
        const char* nA = has_next ? (const char*)g.A + (size_t)nxt.pm * tstep : cA; const char* nB = has_next ? (const char*)g.Bt + (size_t)nxt.pn * tstep : cB;
        for (int t = 0; t < nt; t += 2) {
            const bool last = (t == nt - 2);
            const char* a1 = cA + (size_t)(t + 1) * kstep;
            const char* a2 = last ? nA : cA + (size_t)(t + 2) * kstep; const char* b2 = last ? nB : cB + (size_t)(t + 2) * kstep;
            const char* a3 = a2 + kstep; const char* b3 = b2 + kstep;
            if (last && has_next) S.a_ready(nxt);
            PG8_LDB(B0, 0, 0); PG8_SCHED; PG8_LDA(At, 0, 0); PG8_STAGE(PG8_SA(1, 1), a1 + hstep, voffA);
            PG8_WAIT_L(8); PG8_BAR; PG8_WAIT_L(0); PG8_MMA(0, 0, At, B0); PG8_BAR; PG8_SCHED;
            PG8_LDB(B1, 0, 1); PG8_STAGE(PG8_SB(0, 0), b2, voffB);
            PG8_BAR; PG8_WAIT_L(0); PG8_MMA(0, 1, At, B1); PG8_BAR;
            PG8_LDA(At, 0, 1); PG8_STAGE(PG8_SA(0, 0), a2, voffA);
            PG8_BAR; PG8_WAIT_L(0); PG8_MMA(1, 0, At, B0); PG8_BAR; PG8_SCHED;
            PG8_STAGE(PG8_SB(0, 1), b2 + hstep, voffB);
            PG8_WAIT_V(6); PG8_BAR; PG8_MMA(1, 1, At, B1); PG8_BAR;
            PG8_LDB(B0, 1, 0); PG8_SCHED; PG8_LDA(At, 1, 0); PG8_STAGE(PG8_SA(0, 1), a2 + hstep, voffA);
            PG8_WAIT_L(8); PG8_BAR; PG8_WAIT_L(0); PG8_MMA(0, 0, At, B0); PG8_BAR; PG8_SCHED;
            PG8_LDB(B1, 1, 1); PG8_STAGE(PG8_SB(1, 0), b3, voffB);
            PG8_BAR; PG8_WAIT_L(0); PG8_MMA(0, 1, At, B1); PG8_BAR;
            PG8_LDA(At, 1, 1); PG8_STAGE(PG8_SA(1, 0), a3, voffA);
            PG8_BAR; PG8_WAIT_L(0); PG8_MMA(1, 0, At, B0); PG8_BAR; PG8_SCHED;
            PG8_STAGE(PG8_SB(1, 1), b3 + hstep, voffB);
            PG8_WAIT_V(6); PG8_BAR; PG8_MMA(1, 1, At, B1); PG8_BAR;
        }
        PG8_STAMP();
        if constexpr (!Epi::AFTER_DRAIN) { E(acc, cur, wr, wc, fr, fq); S.done(cur); }
        PG8_STAMP();
        if (!has_next) break;
#pragma unroll
        for (int a = 0; a < 2; ++a)
#pragma unroll
            for (int b = 0; b < 2; ++b)
#pragma unroll
                for (int m = 0; m < 4; ++m)
#pragma unroll
                    for (int n = 0; n < 2; ++n) acc[a][b][m][n] = (f32x4){0.f, 0.f, 0.f, 0.f};
        cur = nxt; cA = nA; cB = nB; ++ui;
    }
    PG8_WAIT_V(0);
    if (wr == 0) PG8_BAR;
    PG8_BAR;
    if constexpr (Epi::AFTER_DRAIN) { E.fused(acc, cur, wr, wc, fr, fq, lds, wid, lane); S.done(cur); }
    PG8_STAMP();
    if (STAMP && wid == 0) { stamps[lane] = lane < nts ? (((unsigned long long)(unsigned)ts_hi << 32) | (unsigned)ts_lo) : 0ull;
        if (lane == 62) stamps[62] = rt_entry; if (lane == 63) stamps[63] = (unsigned long long)wall_clock64(); }
#undef PG8_STAMP
#undef PG8_SA
#undef PG8_SB
#undef PG8_STAGE
#undef PG8_LDA
#undef PG8_LDB
#undef PG8_MMA
#undef PG8_WAIT_V
#undef PG8_WAIT_L
#undef PG8_BAR
#undef PG8_SCHED
}
}

#define GAS __attribute__((address_space(1)))
#define LAS __attribute__((address_space(3)))
typedef unsigned short bf16;
typedef float f32x4 __attribute__((ext_vector_type(4)));
typedef unsigned u32x4 __attribute__((ext_vector_type(4)));
typedef unsigned u32x2 __attribute__((ext_vector_type(2)));

constexpr int D = 1024, NLAT = 16384, NCTX = 256, T = NLAT + NCTX, DEPTH = 4;
constexpr int IN_W = 5904, PJ = 5888;
constexpr int U0 = 0, Z0 = 512, XB0 = 1024, Q0 = 2048, K0 = 2560, V0 = 2688, GT0 = 2816;
constexpr int NE = 16, ESLOTS = 2304, CAP_L = 2048, CAP_C = 32;
constexpr int NCH = 130;
constexpr float EPS = 1e-6f;
constexpr int NWAVES = 8, NTHR = 512;
constexpr int LDS_BYTES = 155648;
constexpr int MISC_OFF = LDS_BYTES - 1024 + 512;
constexpr int NPH_LAYER = 14, NPHASES = 1 + DEPTH * NPH_LAYER + 1;

constexpr size_t al256(size_t x) { return (x + 255) & ~(size_t)255; }
constexpr size_t WS_CTL = 0, CTL_BYTES = 1u << 20;
constexpr size_t WS_MOD = WS_CTL + CTL_BYTES;
constexpr size_t WS_XC = al256(WS_MOD + (size_t)DEPTH * 2 * 6144 * 4);
constexpr size_t WS_WIN = al256(WS_XC + (size_t)NCTX * D * 4);
constexpr size_t WS_WGLU = al256(WS_WIN + (size_t)PJ * D * 2);
constexpr size_t WS_WBR = al256(WS_WGLU + (size_t)512 * 512 * 2);
constexpr size_t WS_WOUT = al256(WS_WBR + (size_t)3 * 1024 * 512 * 2);
constexpr size_t WS_WUP = al256(WS_WOUT + (size_t)1024 * 1024 * 2);
constexpr size_t WS_WDN = al256(WS_WUP + (size_t)NE * 2048 * 1024 * 2);
constexpr size_t WS_H = al256(WS_WDN + (size_t)NE * 1024 * 1024 * 2);
constexpr size_t WS_PROJ = al256(WS_H + (size_t)T * D * 2);
constexpr size_t WS_XE = WS_PROJ;
constexpr size_t WS_HID = al256(WS_XE + (size_t)NE * ESLOTS * D * 2);
constexpr size_t WS_DT = al256(WS_PROJ + (size_t)T * PJ * 2);
constexpr size_t WS_CV = al256(WS_DT + (size_t)T * 16 * 4);
constexpr size_t WS_S5E = al256(WS_CV + (size_t)T * 1024 * 2);
constexpr size_t WS_S5H = al256(WS_S5E + (size_t)2 * 32 * NCH * 128 * 4);
constexpr size_t WS_YD = al256(WS_S5H + (size_t)2 * 32 * NCH * 128 * 4);
constexpr size_t WS_SA = al256(WS_YD + (size_t)2 * T * 512 * 4);
constexpr size_t WS_Y3 = al256(WS_SA + (size_t)T * 512 * 2);
constexpr size_t WS_PM = al256(WS_Y3 + (size_t)3 * T * 512 * 2);
constexpr size_t WS_MB = al256(WS_PM + (size_t)T * D * 4);
constexpr size_t WS_YE = WS_PM;
constexpr size_t WS_AFFT = al256(WS_MB + (size_t)T * D * 2);
constexpr size_t WS_IDX = al256(WS_AFFT + (size_t)NE * T * 4);
constexpr size_t WS_GSEL = al256(WS_IDX + (size_t)NE * ESLOTS * 4);
constexpr size_t WS_INV = al256(WS_GSEL + (size_t)NE * ESLOTS * 4);
constexpr size_t WS_DEC = al256(WS_INV + (size_t)T * 16 * 4);
constexpr size_t WS_S5BB = al256(WS_DEC + (size_t)2 * NCH * 8 * 4);
constexpr size_t WS_S5CC = al256(WS_S5BB + (size_t)2 * 32 * 128 * 32 * 2);
constexpr size_t WS_S5AB = al256(WS_S5CC + (size_t)2 * 32 * 16 * 128 * 2);
constexpr size_t WS_END = al256(WS_S5AB + (size_t)2 * 32 * 64 * 2 * 4);
constexpr size_t WS_SST = WS_YD;
constexpr size_t WS_HIN = WS_PM;
constexpr size_t WS_YS = al256(WS_HIN + (size_t)2 * NCH * 8 * 8192 * 2);
static_assert(WS_YS + (size_t)T * 512 * 2 <= WS_AFFT, "HIN|YS overlay fits PM|MB");
static_assert(WS_HID + (size_t)NE * ESLOTS * D * 2 <= WS_DT, "XE|HID overlay fits PROJ");
static_assert(WS_YE + (size_t)NE * ESLOTS * D * 2 <= WS_AFFT, "YE overlay fits PM|MB");
static_assert(WS_END < (size_t)1000 * 1024 * 1024, "workspace");
constexpr int CW_BAR = 4096;

__device__ __forceinline__ float bf2f(unsigned b) { return __uint_as_float(b << 16); }
__device__ __forceinline__ float bflo(unsigned w) { return __uint_as_float(w << 16); }
__device__ __forceinline__ float bfhi(unsigned w) { return __uint_as_float(w & 0xffff0000u); }
__device__ __forceinline__ unsigned f2bf(float f) { unsigned u = __float_as_uint(f); u += 0x7FFFu + ((u >> 16) & 1u); return u >> 16; }
__device__ __forceinline__ unsigned pk2(float lo, float hi) { return f2bf(lo) | (f2bf(hi) << 16); }
__device__ __forceinline__ float wsum(float v) {
#pragma unroll
    for (int o = 1; o < 64; o <<= 1) v += __shfl_xor(v, o);
    return v;
}
__device__ __forceinline__ float wmaxf(float v) {
#pragma unroll
    for (int o = 1; o < 64; o <<= 1) v = fmaxf(v, __shfl_xor(v, o));
    return v;
}
__device__ __forceinline__ float silu_f(float x) { return x / (1.f + expf(-x)); }
__device__ __forceinline__ float sigmoid_f(float x) { return 1.f / (1.f + expf(-x)); }
__device__ __forceinline__ float softplus_f(float x) { return x > 20.f ? x : log1pf(expf(x)); }
__device__ __forceinline__ float gelu_tanh_f(float x) { const float u = 0.7978845608028654f * (x + 0.044715f * x * x * x); return 0.5f * x * (1.f + tanhf(u)); }
#define LDS_FENCE() asm volatile("s_waitcnt lgkmcnt(0)" ::: "memory")
__device__ __forceinline__ int scan_row(int d, int s) { return d == 0 ? s : (s < NCTX ? (NCTX - 1 - s) : (T + NCTX - 1 - s)); }

namespace pg8 {
struct EpiStoreBf16 {
    static constexpr bool PERM = true, AFTER_DRAIN = false;
    bf16_t* O; int ldc;
    __device__ __forceinline__ void operator()(const f32x4 (&acc)[2][2][4][2], const Unit& u, int wr, int wc, int fr, int fq) const {
        const int row0 = u.pm * BM + wr * 64 + fr, col0 = u.pn * BM + wc * 32 + 8 * fq;
#pragma unroll
        for (int ai = 0; ai < 2; ++ai)
#pragma unroll
            for (int m = 0; m < 4; ++m) { bf16_t* rowp = O + (size_t)(row0 + ai * HALF + m * 16) * ldc + col0;
#pragma unroll
                for (int bj = 0; bj < 2; ++bj) { const f32x4 v0 = acc[ai][bj][m][0], v1 = acc[ai][bj][m][1];
                    u32x4 w; w.x = cvt_pk_bf16(v0[0], v0[1]); w.y = cvt_pk_bf16(v0[2], v0[3]); w.z = cvt_pk_bf16(v1[0], v1[1]); w.w = cvt_pk_bf16(v1[2], v1[3]);
                    *(u32x4*)(rowp + bj * HALF) = w; } }
    }
};
struct EpiGlu {
    static constexpr bool PERM = true, AFTER_DRAIN = false;
    const bf16_t* A; const float* bias; bf16_t* O;
    __device__ __forceinline__ void operator()(const f32x4 (&acc)[2][2][4][2], const Unit& u, int wr, int wc, int fr, int fq) const {
        const int row0 = u.pm * BM + wr * 64 + fr, col0 = u.pn * BM + wc * 32 + 8 * fq;
#pragma unroll
        for (int ai = 0; ai < 2; ++ai)
#pragma unroll
            for (int m = 0; m < 4; ++m) { const size_t ro = (size_t)(row0 + ai * HALF + m * 16) * 512 + col0;
#pragma unroll
                for (int bj = 0; bj < 2; ++bj) { const f32x4 v0 = acc[ai][bj][m][0], v1 = acc[ai][bj][m][1];
                    const u32x4 a = *(const u32x4*)(A + ro + bj * HALF);
                    const f32x4 b0 = *(const f32x4*)(bias + col0 + bj * HALF), b1 = *(const f32x4*)(bias + col0 + bj * HALF + 4);
                    float o[8];
                    o[0] = bflo(a.x) * sigmoid_f(v0[0] + b0[0]); o[1] = bfhi(a.x) * sigmoid_f(v0[1] + b0[1]);
                    o[2] = bflo(a.y) * sigmoid_f(v0[2] + b0[2]); o[3] = bfhi(a.y) * sigmoid_f(v0[3] + b0[3]);
                    o[4] = bflo(a.z) * sigmoid_f(v1[0] + b1[0]); o[5] = bfhi(a.z) * sigmoid_f(v1[1] + b1[1]);
                    o[6] = bflo(a.w) * sigmoid_f(v1[2] + b1[2]); o[7] = bfhi(a.w) * sigmoid_f(v1[3] + b1[3]);
                    u32x4 w; w.x = cvt_pk_bf16(o[0], o[1]); w.y = cvt_pk_bf16(o[2], o[3]); w.z = cvt_pk_bf16(o[4], o[5]); w.w = cvt_pk_bf16(o[6], o[7]);
                    *(u32x4*)(O + ro + bj * HALF) = w; } }
    }
};
struct RowOffOrder {
    StaticOrder b; int off;
    __device__ __forceinline__ void init(int M, int N, int G, int c, int off_) { b.init(M, N, G, c); off = off_; }
    __device__ __forceinline__ bool next(int i, Unit& u) const { if (!b.next(i, u)) return false; u.pm += off; return true; }
    __device__ __forceinline__ void a_ready(const Unit&) const {}
    __device__ __forceinline__ void done(const Unit&) const {}
};
struct MergeOrder {
    int G, c, off;
    __device__ __forceinline__ bool next(int i, Unit& u) const { const int pr = (i / 3) * G + c; if (pr >= (65 - off) * 4) return false; const int k = i % 3; u.pm = k * 65 + off + (pr >> 2); u.pn = k * 4 + (pr & 3); return true; }
    __device__ __forceinline__ void a_ready(const Unit&) const {}
    __device__ __forceinline__ void done(const Unit&) const {}
};
struct EpiMerge {
    static constexpr bool PERM = true, AFTER_DRAIN = false;
    const bf16_t* proj; float* PM; bf16_t* MB;
    __device__ __forceinline__ void operator()(const f32x4 (&acc)[2][2][4][2], const Unit& u, int wr, int wc, int fr, int fq) const {
        const int k = u.pn >> 2, pn = u.pn & 3, pm = u.pm - 65 * k;
        const int row0 = pm * BM + wr * 64 + fr, col0 = pn * BM + wc * 32 + 8 * fq;
#pragma unroll
        for (int ai = 0; ai < 2; ++ai)
#pragma unroll
            for (int m = 0; m < 4; ++m) { const int row = row0 + ai * HALF + m * 16;
#pragma unroll
                for (int bj = 0; bj < 2; ++bj) { const f32x4 v0 = acc[ai][bj][m][0], v1 = acc[ai][bj][m][1];
                    const int col = col0 + bj * HALF;
                    const u32x4 g = *(const u32x4*)(proj + (size_t)row * PJ + GT0 + k * 1024 + col);
                    f32x4 o0, o1;
                    o0[0] = sigmoid_f(bflo(g.x)) * v0[0]; o0[1] = sigmoid_f(bfhi(g.x)) * v0[1]; o0[2] = sigmoid_f(bflo(g.y)) * v0[2]; o0[3] = sigmoid_f(bfhi(g.y)) * v0[3];
                    o1[0] = sigmoid_f(bflo(g.z)) * v1[0]; o1[1] = sigmoid_f(bfhi(g.z)) * v1[1]; o1[2] = sigmoid_f(bflo(g.w)) * v1[2]; o1[3] = sigmoid_f(bfhi(g.w)) * v1[3];
                    float* pp = PM + (size_t)row * 1024 + col;
                    if (k > 0) { o0 += *(const f32x4*)pp; o1 += *(const f32x4*)(pp + 4); }
                    if (k < 2) { *(f32x4*)pp = o0; *(f32x4*)(pp + 4) = o1; }
                    else { u32x4 w; w.x = cvt_pk_bf16(o0[0], o0[1]); w.y = cvt_pk_bf16(o0[2], o0[3]); w.z = cvt_pk_bf16(o1[0], o1[1]); w.w = cvt_pk_bf16(o1[2], o1[3]);
                        *(u32x4*)(MB + (size_t)row * 1024 + col) = w; } } }
    }
};
struct EpiResid {
    static constexpr bool PERM = false, AFTER_DRAIN = false;
    float* XL; float* XC; const float* g_lat; const float* g_ctx;
    __device__ __forceinline__ void operator()(const f32x4 (&acc)[2][2][4][2], const Unit& u, int wr, int wc, int fr, int fq) const {
        const bool isc = (u.pm == 0);
        float* base = isc ? XC : (XL - (size_t)NCTX * D); const float* gv = isc ? g_ctx : g_lat;
        const int row0 = u.pm * BM + wr * 64 + fr, col0 = u.pn * BM + wc * 32 + 4 * fq;
#pragma unroll
        for (int ai = 0; ai < 2; ++ai)
#pragma unroll
            for (int m = 0; m < 4; ++m) { float* rowp = base + (size_t)(row0 + ai * HALF + m * 16) * D + col0;
#pragma unroll
                for (int bj = 0; bj < 2; ++bj)
#pragma unroll
                    for (int n = 0; n < 2; ++n) { float* pp = rowp + bj * HALF + n * 16; const f32x4 g = *(const f32x4*)(gv + col0 + bj * HALF + n * 16);
                        f32x4 x = *(const f32x4*)pp; x += g * acc[ai][bj][m][n]; *(f32x4*)pp = x; } }
    }
};
struct ExpertOrder {
    int G, c, nnt, nmt;
    __device__ __forceinline__ bool next(int i, Unit& u) const { const int L = i * G + c; if (L >= NE * nmt * nnt) return false; const int e = L / (nmt * nnt), rem = L % (nmt * nnt); u.pm = e * 9 + rem % nmt; u.pn = e * nnt + rem / nmt; return true; }
    __device__ __forceinline__ void a_ready(const Unit&) const {}
    __device__ __forceinline__ void done(const Unit&) const {}
};
struct EpiSwiGlu {
    static constexpr bool PERM = true, AFTER_DRAIN = false;
    bf16_t* HID;
    __device__ __forceinline__ void operator()(const f32x4 (&acc)[2][2][4][2], const Unit& u, int wr, int wc, int fr, int fq) const {
        const int row0 = u.pm * BM + wr * 64 + fr, col0 = (u.pn & 7) * 128 + wc * 32 + 8 * fq;
#pragma unroll
        for (int ai = 0; ai < 2; ++ai)
#pragma unroll
            for (int m = 0; m < 4; ++m) { const f32x4 g0 = acc[ai][0][m][0], g1 = acc[ai][0][m][1], u0 = acc[ai][1][m][0], u1 = acc[ai][1][m][1];
                u32x4 w;
                w.x = cvt_pk_bf16(silu_f(g0[0]) * u0[0], silu_f(g0[1]) * u0[1]); w.y = cvt_pk_bf16(silu_f(g0[2]) * u0[2], silu_f(g0[3]) * u0[3]);
                w.z = cvt_pk_bf16(silu_f(g1[0]) * u1[0], silu_f(g1[1]) * u1[1]); w.w = cvt_pk_bf16(silu_f(g1[2]) * u1[2], silu_f(g1[3]) * u1[3]);
                *(u32x4*)(HID + (size_t)(row0 + ai * HALF + m * 16) * 1024 + col0) = w; }
    }
};
struct EpiDown {
    static constexpr bool PERM = true, AFTER_DRAIN = false;
    bf16_t* YE; const float* gsel;
    __device__ __forceinline__ void operator()(const f32x4 (&acc)[2][2][4][2], const Unit& u, int wr, int wc, int fr, int fq) const {
        const int row0 = u.pm * BM + wr * 64 + fr, col0 = (u.pn & 3) * BM + wc * 32 + 8 * fq;
#pragma unroll
        for (int ai = 0; ai < 2; ++ai)
#pragma unroll
            for (int m = 0; m < 4; ++m) { const int row = row0 + ai * HALF + m * 16; const float gs = gsel[row];
#pragma unroll
                for (int bj = 0; bj < 2; ++bj) { const f32x4 v0 = acc[ai][bj][m][0] * gs, v1 = acc[ai][bj][m][1] * gs;
                    u32x4 w; w.x = cvt_pk_bf16(v0[0], v0[1]); w.y = cvt_pk_bf16(v0[2], v0[3]); w.z = cvt_pk_bf16(v1[0], v1[1]); w.w = cvt_pk_bf16(v1[2], v1[3]);
                    *(u32x4*)(YE + (size_t)row * 1024 + col0 + bj * HALF) = w; } }
    }
};
}
#define XB_TMO      128
#define XB_XCNT(j)  (256  + 64 * (j))
#define XB_XSUB(j)  (1280 + 64 * (j))
#define XB_XGEN(j)  (2304 + 64 * (j))
#define XB_TOP      3328
#define XB_TOPGEN   3392
#define XCD_BAR_WORDS 3456
#define XB_SPIN_CAP (1u << 18)
#define LAS __attribute__((address_space(3)))

__device__ __forceinline__ unsigned xb_ld(unsigned* p)              { return __hip_atomic_load(p, __ATOMIC_RELAXED, __HIP_MEMORY_SCOPE_AGENT); }
__device__ __forceinline__ unsigned xb_add(unsigned* p, unsigned v) { return __hip_atomic_fetch_add(p, v, __ATOMIC_RELAXED, __HIP_MEMORY_SCOPE_AGENT); }
__device__ __forceinline__ unsigned xb_xcc_id() { return (unsigned)__builtin_amdgcn_s_getreg((3 << 11) | 20) & 0xFu; }
#define XB_SPIN(cond, bar) do { unsigned _sp = 0; while (cond) { __builtin_amdgcn_s_sleep(1); \
    if ((++_sp & 255u) == 0u) { if (xb_ld(&(bar)[XB_TMO])) break; if (_sp > XB_SPIN_CAP) { atomicAdd(&(bar)[XB_TMO], 1u); break; } } } } while (0)

struct XcdBarrier {
    unsigned* bar; unsigned x;
    volatile LAS unsigned* st;
};

__device__ __forceinline__ XcdBarrier xcd_barrier_post(unsigned* bar, volatile LAS unsigned* st) {
    XcdBarrier b; b.bar = bar; b.x = xb_xcc_id(); b.st = st;
    if (threadIdx.x == 0) (void)xb_add(&bar[XB_XCNT(b.x)], 1u);
    return b;
}
__device__ __forceinline__ void xcd_barrier_complete(unsigned* bar, unsigned x, unsigned& nloc, unsigned& nx) {
    const unsigned G = gridDim.x * gridDim.y * gridDim.z;
    unsigned sum, cnt, mine, sp = 0u;
    for (;;) {
        sum = 0u; cnt = 0u; mine = 0u;
#pragma unroll
        for (unsigned j = 0; j < 16; ++j) { const unsigned c = xb_ld(&bar[XB_XCNT(j)]); sum += c; cnt += (c > 0u) ? 1u : 0u; mine = (j == x) ? c : mine; }
        if (sum == G) break;
        __builtin_amdgcn_s_sleep(1);
        if ((++sp & 255u) == 0u) { if (xb_ld(&bar[XB_TMO])) break; if (sp > XB_SPIN_CAP) { atomicAdd(&bar[XB_TMO], 1u); break; } }
    }
    nloc = mine > 0u ? mine : 1u; nx = cnt > 0u ? cnt : 1u;
}

__device__ __forceinline__ void xcd_barrier(const XcdBarrier& b) {
    asm volatile("s_waitcnt vmcnt(0)" ::: "memory");
    __syncthreads();
    if (threadIdx.x == 0) {
        unsigned* bar = b.bar;
        __builtin_amdgcn_s_waitcnt(0);
        unsigned nloc = b.st[0], nx = b.st[1];
        if (nloc == 0u) { xcd_barrier_complete(bar, b.x, nloc, nx); b.st[0] = nloc; b.st[1] = nx; }
        const unsigned old = xb_add(&bar[XB_XSUB(b.x)], 1u);
        const unsigned gen = old / nloc;
        if (old + 1u == (gen + 1u) * nloc) {
            __builtin_amdgcn_fence(__ATOMIC_RELEASE, "agent");
            asm volatile("s_waitcnt vmcnt(0)" ::: "memory");
            const unsigned og = xb_add(&bar[XB_TOP], 1u);
            const unsigned tg = og / nx;
            if (og + 1u == (tg + 1u) * nx) xb_add(&bar[XB_TOPGEN], 1u);
            else XB_SPIN(xb_ld(&bar[XB_TOPGEN]) == tg, bar);
            __builtin_amdgcn_fence(__ATOMIC_ACQUIRE, "agent");
            xb_add(&bar[XB_XGEN(b.x)], 1u);
            asm volatile("s_waitcnt vmcnt(0)" ::: "memory");
        } else {
            XB_SPIN(xb_ld(&bar[XB_XGEN(b.x)]) == gen, bar);
            __builtin_amdgcn_fence(__ATOMIC_ACQUIRE, "agent");
            asm volatile("s_waitcnt vmcnt(0)" ::: "memory");
        }
    }
    __syncthreads();
}


struct P {
    const float *x, *c, *ctx, *c_ctx, *w_mod, *b_mod, *norm1_g, *norm2_g, *w_in, *lam_re, *lam_im, *log_dt, *b_re, *b_im, *c_re, *c_im, *s5_d, *w_glu, *b_glu,
        *conv_w, *conv_b, *a_log, *dt_bias, *ssd_d, *ssd_norm_g, *sink, *w_branch, *w_out, *w_router, *w_eg, *w_eu, *w_ed, *final_g;
    float* XL;
    float *MOD, *XC, *DT, *S5E, *S5H, *YD, *PM, *AFFT, *GSEL;
    bf16 *WIN, *WGLU, *WBR, *WOUT, *WUP, *WDN, *H, *PROJ, *XE, *HID, *CV, *SA, *Y3, *MB, *YE;
    int *IDX, *INV;
    int tid, lane, wave, bid, G;
};


constexpr int PTAB_OFF = LDS_BYTES - 1024;
__device__ __forceinline__ unsigned long long ld_tab(volatile LAS unsigned* t, int k) {
    const unsigned lo = __builtin_amdgcn_readfirstlane(t[2 * k]), hi = __builtin_amdgcn_readfirstlane(t[2 * k + 1]);
    return ((unsigned long long)hi << 32) | lo;
}
__device__ __forceinline__ void build_P(P& p, LAS unsigned char* lds) {
    int tid_l = threadIdx.x, bid_l = blockIdx.x, g_l = gridDim.x;
    asm volatile("" : "+v"(tid_l), "+s"(bid_l), "+s"(g_l));
    p.tid = tid_l; p.lane = p.tid & 63; p.wave = __builtin_amdgcn_readfirstlane(p.tid >> 6); p.bid = bid_l; p.G = g_l;
    unsigned tbase = (unsigned)(size_t)(lds + PTAB_OFF); asm volatile("" : "+v"(tbase));
    volatile LAS unsigned* tb = (volatile LAS unsigned*)(size_t)tbase;
#define INP(k) ((const float*)ld_tab(tb, k))
    p.x = INP(0); p.c = INP(1); p.ctx = INP(2); p.c_ctx = INP(3); p.w_mod = INP(4); p.b_mod = INP(5); p.norm1_g = INP(6); p.norm2_g = INP(7);
    p.w_in = INP(8); p.lam_re = INP(9); p.lam_im = INP(10); p.log_dt = INP(11); p.b_re = INP(12); p.b_im = INP(13); p.c_re = INP(14); p.c_im = INP(15);
    p.s5_d = INP(16); p.w_glu = INP(17); p.b_glu = INP(18); p.conv_w = INP(19); p.conv_b = INP(20); p.a_log = INP(21); p.dt_bias = INP(22); p.ssd_d = INP(23);
    p.ssd_norm_g = INP(24); p.sink = INP(25); p.w_branch = INP(26); p.w_out = INP(27); p.w_router = INP(28); p.w_eg = INP(29); p.w_eu = INP(30); p.w_ed = INP(31);
    p.final_g = INP(32);
#undef INP
    p.XL = (float*)ld_tab(tb, 33);
    unsigned char* ws = (unsigned char*)ld_tab(tb, 34);
    p.MOD = (float*)(ws + WS_MOD); p.XC = (float*)(ws + WS_XC); p.DT = (float*)(ws + WS_DT); p.S5E = (float*)(ws + WS_S5E); p.S5H = (float*)(ws + WS_S5H); p.YD = (float*)(ws + WS_YD);
    p.PM = (float*)(ws + WS_PM); p.AFFT = (float*)(ws + WS_AFFT); p.GSEL = (float*)(ws + WS_GSEL);
    p.WIN = (bf16*)(ws + WS_WIN); p.WGLU = (bf16*)(ws + WS_WGLU); p.WBR = (bf16*)(ws + WS_WBR); p.WOUT = (bf16*)(ws + WS_WOUT); p.WUP = (bf16*)(ws + WS_WUP); p.WDN = (bf16*)(ws + WS_WDN);
    p.H = (bf16*)(ws + WS_H); p.PROJ = (bf16*)(ws + WS_PROJ); p.XE = (bf16*)(ws + WS_XE); p.HID = (bf16*)(ws + WS_HID); p.CV = (bf16*)(ws + WS_CV); p.SA = (bf16*)(ws + WS_SA);
    p.Y3 = (bf16*)(ws + WS_Y3); p.MB = (bf16*)(ws + WS_MB); p.YE = (bf16*)(ws + WS_YE);
    p.IDX = (int*)(ws + WS_IDX); p.INV = (int*)(ws + WS_INV);
}
__device__ __forceinline__ void phase_mod(const P& p, LAS unsigned char* lds) {
    LAS float* sc = (LAS float*)lds;
    LAS float* part = sc + 2048;
    for (int i = p.tid; i < 1024; i += NTHR) { sc[i] = silu_f(p.c[i]); sc[1024 + i] = silu_f(p.c_ctx[i]); }
    __syncthreads();
    for (int it = p.bid; it < DEPTH * 48; it += p.G) {
        const int l = it / 48, cb = it % 48, c0 = cb * 128 + 2 * p.lane;
        const float* W = p.w_mod + (size_t)l * 1024 * 6144 + c0;
        float a00 = 0.f, a01 = 0.f, a10 = 0.f, a11 = 0.f;
        const int kb = p.wave * 128;
#pragma unroll 8
        for (int k = kb; k < kb + 128; ++k) { const float2 w = *(const float2*)(W + (size_t)k * 6144); const float s0 = sc[k], s1 = sc[1024 + k];
            a00 += s0 * w.x; a01 += s0 * w.y; a10 += s1 * w.x; a11 += s1 * w.y; }
        part[(p.wave * 2 + 0) * 128 + 2 * p.lane] = a00; part[(p.wave * 2 + 0) * 128 + 2 * p.lane + 1] = a01;
        part[(p.wave * 2 + 1) * 128 + 2 * p.lane] = a10; part[(p.wave * 2 + 1) * 128 + 2 * p.lane + 1] = a11;
        __syncthreads();
        if (p.tid < 256) { const int s = p.tid >> 7, col = p.tid & 127; float r = p.b_mod[l * 6144 + cb * 128 + col];
#pragma unroll
            for (int w = 0; w < 8; ++w) r += part[(w * 2 + s) * 128 + col];
            p.MOD[(size_t)(l * 2 + s) * 6144 + cb * 128 + col] = r; }
        __syncthreads();
    }
}

__device__ __forceinline__ void tr_item(const float* src, int ldw, int K, bf16* dst, int kb, LAS float* scr, int lane) {
    const int k0 = 64 * kb, kr = lane >> 4, nq = lane & 15;
    f32x4 v[16];
#pragma unroll
    for (int i = 0; i < 16; ++i) v[i] = *(const f32x4*)(src + (size_t)(k0 + 4 * i + kr) * ldw + 4 * nq);
#pragma unroll
    for (int i = 0; i < 16; ++i) { const int k = 4 * i + kr, c = (k >> 3) & 7; *(LAS f32x4*)(scr + k * 64 + 4 * (nq ^ c)) = v[i]; }
    LDS_FENCE();
    const int c = lane & 7;
#pragma unroll
    for (int j = 0; j < 8; ++j) { const int n = (lane >> 3) + 8 * j; const LAS float* s = scr + (8 * c) * 64 + (n ^ (c << 2));
        u32x4 o; o.x = pk2(s[0 * 64], s[1 * 64]); o.y = pk2(s[2 * 64], s[3 * 64]); o.z = pk2(s[4 * 64], s[5 * 64]); o.w = pk2(s[6 * 64], s[7 * 64]);
        *(u32x4*)(dst + (size_t)n * K + k0 + 8 * c) = o; }
    LDS_FENCE();
}
__device__ __forceinline__ void convert_weights(const P& p, int l, LAS unsigned char* lds) {
    LAS float* scr = (LAS float*)(lds + p.wave * 16384);
    const int gw = p.bid * NWAVES + p.wave, NGW = p.G * NWAVES;
    constexpr int I_A = 32 * 16, I_B = 60 * 16, I_GLU = 8 * 8, I_BR = 3 * 16 * 8, I_OUT = 16 * 16, I_E = 16 * 16 * 16;
    constexpr int NIT = I_A + I_B + I_GLU + I_BR + I_OUT + 3 * I_E;
    const float* win = p.w_in + (size_t)l * 1024 * IN_W;
    for (int it = gw; it < NIT; it += NGW) {
        int r = it;
        if (r < I_A) { const int nb = r >> 4, kb = r & 15; tr_item(win + 64 * nb, IN_W, 1024, p.WIN + (size_t)(64 * nb) * 1024, kb, scr, p.lane); continue; } r -= I_A;
        if (r < I_B) { const int nb = r >> 4, kb = r & 15; tr_item(win + 2064 + 64 * nb, IN_W, 1024, p.WIN + (size_t)(2048 + 64 * nb) * 1024, kb, scr, p.lane); continue; } r -= I_B;
        if (r < I_GLU) { const int nb = r >> 3, kb = r & 7; tr_item(p.w_glu + (size_t)l * 512 * 512 + 64 * nb, 512, 512, p.WGLU + (size_t)(64 * nb) * 512, kb, scr, p.lane); continue; } r -= I_GLU;
        if (r < I_BR) { const int kk = r >> 7, nb = (r >> 3) & 15, kb = r & 7;
            tr_item(p.w_branch + ((size_t)l * 3 + kk) * 512 * 1024 + 64 * nb, 1024, 512, p.WBR + (size_t)(kk * 1024 + 64 * nb) * 512, kb, scr, p.lane); continue; } r -= I_BR;
        if (r < I_OUT) { const int nb = r >> 4, kb = r & 15; tr_item(p.w_out + (size_t)l * 1024 * 1024 + 64 * nb, 1024, 1024, p.WOUT + (size_t)(64 * nb) * 1024, kb, scr, p.lane); continue; } r -= I_OUT;
        const int which = r / I_E; r -= which * I_E;
        const int e = r >> 8, nb = (r >> 4) & 15, kb = r & 15;
        const size_t eo = ((size_t)l * NE + e) * 1024 * 1024;
        if (which == 0) tr_item(p.w_eg + eo + 64 * nb, 1024, 1024, p.WUP + (size_t)(e * 2048 + 256 * (nb >> 1) + 64 * (nb & 1)) * 1024, kb, scr, p.lane);
        else if (which == 1) tr_item(p.w_eu + eo + 64 * nb, 1024, 1024, p.WUP + (size_t)(e * 2048 + 256 * (nb >> 1) + 128 + 64 * (nb & 1)) * 1024, kb, scr, p.lane);
        else tr_item(p.w_ed + eo + 64 * nb, 1024, 1024, p.WDN + (size_t)(e * 1024 + 64 * nb) * 1024, kb, scr, p.lane);
    }
}

template <int MODE> __device__ __forceinline__ void row_pass(const P& p, int l, LAS unsigned char* lds, bool with_ctx = true) {
    LAS float* W16 = (LAS float*)lds;
    if (MODE != 2) {
        const float* src = (MODE == 0) ? (p.w_in + (size_t)l * 1024 * IN_W + 2048) : (p.w_router + (size_t)l * 1024 * 16);
        const int ld = (MODE == 0) ? IN_W : 16;
        for (int i = p.tid; i < 1024 * 16; i += NTHR) { const int k = i >> 4, j = i & 15; W16[k * 20 + j] = src[(size_t)k * ld + j]; }
        __syncthreads();
    }
    const int gw = p.bid * NWAVES + p.wave, NGW = p.G * NWAVES, lane = p.lane;
    for (int row = gw + ((MODE == 2 || !with_ctx) ? NCTX : 0); row < T; row += NGW) {
        const bool isc = row < NCTX;
        float* xrow = isc ? (p.XC + (size_t)row * D) : (p.XL + (size_t)(row - NCTX) * D);
        float v[16];
        if (MODE == 0 && l == 0) { const float* s = isc ? (p.ctx + (size_t)row * D) : (p.x + (size_t)(row - NCTX) * D);
#pragma unroll
            for (int i = 0; i < 16; ++i) v[i] = s[lane + 64 * i];
        } else {
#pragma unroll
            for (int i = 0; i < 16; ++i) v[i] = xrow[lane + 64 * i];
        }
        if ((MODE == 0 && l > 0) || MODE == 2) {
            const int lp = (MODE == 2) ? (DEPTH - 1) : (l - 1);
            const float* g2 = p.MOD + (size_t)(lp * 2 + (isc ? 1 : 0)) * 6144 + 5 * D;
            float s[16];
#pragma unroll
            for (int i = 0; i < 16; ++i) s[i] = 0.f;
            for (int e = 0; e < NE; ++e) { const int slot = p.INV[(size_t)row * 16 + e];
                if (slot >= 0) { const bf16* yr = p.YE + ((size_t)e * ESLOTS + slot) * D;
#pragma unroll
                    for (int i = 0; i < 16; ++i) s[i] += bf2f(yr[lane + 64 * i]); } }
#pragma unroll
            for (int i = 0; i < 16; ++i) v[i] += g2[lane + 64 * i] * s[i];
        }
        if (MODE == 0) {
#pragma unroll
            for (int i = 0; i < 16; ++i) xrow[lane + 64 * i] = v[i];
        }
        float ss = 0.f;
#pragma unroll
        for (int i = 0; i < 16; ++i) ss += v[i] * v[i];
        const float rstd = rsqrtf(wsum(ss) * (1.f / D) + EPS);
        if (MODE == 2) {
#pragma unroll
            for (int i = 0; i < 16; ++i) xrow[lane + 64 * i] = v[i] * rstd * p.final_g[lane + 64 * i];
            continue;
        }
        const float* gam = (MODE == 0 ? p.norm1_g : p.norm2_g) + (size_t)l * D;
        const float* md = p.MOD + (size_t)(l * 2 + (isc ? 1 : 0)) * 6144 + (MODE == 0 ? 0 : 3 * D);
        bf16* hrow = p.H + (size_t)row * D;
        float acc[16];
#pragma unroll
        for (int j = 0; j < 16; ++j) acc[j] = 0.f;
#pragma unroll
        for (int i = 0; i < 16; ++i) { const int k = lane + 64 * i;
            const float hv = v[i] * rstd * gam[k] * (1.f + md[D + k]) + md[k];
            hrow[k] = (bf16)f2bf(hv);
            const LAS f32x4* wr = (const LAS f32x4*)(W16 + k * 20);
            const f32x4 w0 = wr[0], w1 = wr[1], w2 = wr[2], w3 = wr[3];
            acc[0] += hv * w0[0]; acc[1] += hv * w0[1]; acc[2] += hv * w0[2]; acc[3] += hv * w0[3];
            acc[4] += hv * w1[0]; acc[5] += hv * w1[1]; acc[6] += hv * w1[2]; acc[7] += hv * w1[3];
            acc[8] += hv * w2[0]; acc[9] += hv * w2[1]; acc[10] += hv * w2[2]; acc[11] += hv * w2[3];
            acc[12] += hv * w3[0]; acc[13] += hv * w3[1]; acc[14] += hv * w3[2]; acc[15] += hv * w3[3];
            if ((i & 1) == 1) asm volatile("" ::: "memory"); }
#pragma unroll
        for (int j = 0; j < 16; ++j) acc[j] = wsum(acc[j]);
        if (MODE == 0) {
            float mine = 0.f;
#pragma unroll
            for (int j = 0; j < 16; ++j) mine = (lane == j) ? acc[j] : mine;
            if (lane < 16) p.DT[(size_t)row * 16 + lane] = softplus_f(mine + p.dt_bias[l * 16 + lane]);
        } else {
            float mx = acc[0];
#pragma unroll
            for (int j = 1; j < 16; ++j) mx = fmaxf(mx, acc[j]);
            float sum = 0.f, mine = 0.f;
#pragma unroll
            for (int j = 0; j < 16; ++j) { const float e = expf(acc[j] - mx); sum += e; mine = (lane == j) ? e : mine; }
            if (lane < 16) p.AFFT[(size_t)lane * T + row] = mine / sum;
        }
    }
}

struct S5Lane { float abr, abi; float bbr[16], bbi[16]; };
__device__ __forceinline__ void s5_lane_params(const P& p, int l, int d, int g, int lane, S5Lane& o, bool withB) {
    const size_t gi = ((size_t)(l * 2 + d) * 32 + g);
    const float lr = p.lam_re[gi * 64 + lane], li = p.lam_im[gi * 64 + lane], dt = expf(p.log_dt[gi]);
    const float mag = expf(lr * dt); float sn, cs; sincosf(li * dt, &sn, &cs);
    o.abr = mag * cs; o.abi = mag * sn;
    if (withB) {
        const float den = lr * lr + li * li;
        const float fr = ((o.abr - 1.f) * lr + o.abi * li) / den, fi = (o.abi * lr - (o.abr - 1.f) * li) / den;
        const f32x4* br = (const f32x4*)(p.b_re + (gi * 64 + lane) * 16); const f32x4* bi = (const f32x4*)(p.b_im + (gi * 64 + lane) * 16);
#pragma unroll
        for (int q = 0; q < 4; ++q) { const f32x4 r4 = br[q], i4 = bi[q];
#pragma unroll
            for (int j = 0; j < 4; ++j) { o.bbr[4 * q + j] = fr * r4[j] - fi * i4[j]; o.bbi[4 * q + j] = fr * i4[j] + fi * r4[j]; } }
    }
}
__device__ __forceinline__ void s5_stage_u(const P& p, int r0, int g, LAS unsigned char* ub, int lane) {
#pragma unroll
    for (int j = 0; j < 4; ++j) { const int q = lane + 64 * j, i = q >> 1, half = q & 1;
        const u32x4 w = *(const u32x4*)(p.PROJ + (size_t)(r0 + i) * PJ + U0 + g * 16 + half * 8);
        *(LAS u32x4*)(ub + i * 32 + half * 16) = w; }
    LDS_FENCE();
}
__device__ __forceinline__ void s5_step(const S5Lane& s, const LAS unsigned char* ub, int i, float& hr, float& hi) {
    const u32x4 a = *(const LAS u32x4*)(ub + i * 32), b = *(const LAS u32x4*)(ub + i * 32 + 16);
    float u[16];
    u[0] = bflo(a.x); u[1] = bfhi(a.x); u[2] = bflo(a.y); u[3] = bfhi(a.y); u[4] = bflo(a.z); u[5] = bfhi(a.z); u[6] = bflo(a.w); u[7] = bfhi(a.w);
    u[8] = bflo(b.x); u[9] = bfhi(b.x); u[10] = bflo(b.y); u[11] = bfhi(b.y); u[12] = bflo(b.z); u[13] = bfhi(b.z); u[14] = bflo(b.w); u[15] = bfhi(b.w);
    float br = 0.f, bi = 0.f;
#pragma unroll
    for (int k = 0; k < 16; ++k) { br += s.bbr[k] * u[k]; bi += s.bbi[k] * u[k]; }
    const float nr = s.abr * hr - s.abi * hi + br, ni = s.abr * hi + s.abi * hr + bi;
    hr = nr; hi = ni;
}

__device__ __forceinline__ void phase_premix(const P& p, int l, LAS unsigned char* lds, bool do_rope) {
    const float* cw = p.conv_w + (size_t)l * 5 * 1024; const float* cb = p.conv_b + (size_t)l * 1024;
    for (int idx = p.bid * NTHR + p.tid; idx < T * 128; idx += p.G * NTHR) {
        const int row = idx >> 7, c8 = (idx & 127) * 8;
        const int lo = row < NCTX ? 0 : NCTX, hi = row < NCTX ? NCTX : T;
        float a[8];
        { const f32x4 b0 = *(const f32x4*)(cb + c8), b1 = *(const f32x4*)(cb + c8 + 4);
          a[0] = b0[0]; a[1] = b0[1]; a[2] = b0[2]; a[3] = b0[3]; a[4] = b1[0]; a[5] = b1[1]; a[6] = b1[2]; a[7] = b1[3]; }
#pragma unroll
        for (int j = 0; j < 5; ++j) { const int r = row + j - 2;
            if (r >= lo && r < hi) { const u32x4 xv = *(const u32x4*)(p.PROJ + (size_t)r * PJ + XB0 + c8);
                const f32x4 w0 = *(const f32x4*)(cw + j * 1024 + c8), w1 = *(const f32x4*)(cw + j * 1024 + c8 + 4);
                a[0] += w0[0] * bflo(xv.x); a[1] += w0[1] * bfhi(xv.x); a[2] += w0[2] * bflo(xv.y); a[3] += w0[3] * bfhi(xv.y);
                a[4] += w1[0] * bflo(xv.z); a[5] += w1[1] * bfhi(xv.z); a[6] += w1[2] * bflo(xv.w); a[7] += w1[3] * bfhi(xv.w); } }
        u32x4 o; o.x = pk2(silu_f(a[0]), silu_f(a[1])); o.y = pk2(silu_f(a[2]), silu_f(a[3])); o.z = pk2(silu_f(a[4]), silu_f(a[5])); o.w = pk2(silu_f(a[6]), silu_f(a[7]));
        *(u32x4*)(p.CV + (size_t)row * 1024 + c8) = o;
    }
    if (do_rope) for (int idx = p.bid * NTHR + p.tid; idx < NLAT * 160; idx += p.G * NTHR) {
        const int i = idx & 15, hh = (idx >> 4) % 10, t = idx / 160;
        bf16* base = p.PROJ + (size_t)(NCTX + t) * PJ + (hh < 8 ? Q0 + hh * 64 : K0 + (hh - 8) * 64);
        const float inv = exp2f(-(float)i * 0.83048202372184058696f);
        const float ar = (float)(t >> 6) * inv, ac = (float)(t & 63) * inv;
        float sr, cr, sc, cc; sincosf(ar, &sr, &cr); sincosf(ac, &sc, &cc);
        { const float x1 = bf2f(base[i]), x2 = bf2f(base[16 + i]); base[i] = (bf16)f2bf(x1 * cr - x2 * sr); base[16 + i] = (bf16)f2bf(x2 * cr + x1 * sr); }
        { const float x1 = bf2f(base[32 + i]), x2 = bf2f(base[48 + i]); base[32 + i] = (bf16)f2bf(x1 * cc - x2 * sc); base[48 + i] = (bf16)f2bf(x2 * cc + x1 * sc); }
    }
}

__device__ __forceinline__ void ssd_scan_naive(const P& p, int l) {
    for (int it = p.bid * 4 + p.wave; it < 1024; it += p.G * 4) {
        const int d = it >> 9, hd = (it >> 6) & 7, pp = it & 63, grp = hd >> 2;
        const float a = -expf(p.a_log[l * 16 + d * 8 + hd]);
        const int colB = 512 + grp * 128 + p.lane, colC = 768 + grp * 128 + p.lane, colX = hd * 64 + pp, dcol = d * 8 + hd;
        float h0 = 0.f, h1 = 0.f;
        for (int s0 = 0; s0 < T; s0 += 8) {
            unsigned b0[8], b1[8], c0[8], c1[8], xx[8]; float dtv[8]; int rr[8];
#pragma unroll
            for (int j = 0; j < 8; ++j) { const int r = scan_row(d, s0 + j); rr[j] = r; const bf16* cv = p.CV + (size_t)r * 1024;
                b0[j] = cv[colB]; b1[j] = cv[colB + 64]; c0[j] = cv[colC]; c1[j] = cv[colC + 64]; xx[j] = cv[colX]; dtv[j] = p.DT[(size_t)r * 16 + dcol]; }
#pragma unroll
            for (int j = 0; j < 8; ++j) { const float dec = expf(dtv[j] * a), dx = dtv[j] * bf2f(xx[j]);
                h0 = dec * h0 + dx * bf2f(b0[j]); h1 = dec * h1 + dx * bf2f(b1[j]);
                const float y = wsum(bf2f(c0[j]) * h0 + bf2f(c1[j]) * h1);
                if (p.lane == 0) p.YD[((size_t)d * T + rr[j]) * 512 + colX] = y; }
        }
    }
}
__device__ __forceinline__ void s5_carry_scan(const P& p, int l, int aw, int NAW) {
    for (int it = aw; it < 64; it += NAW) {
        const int d = it >> 5, g = it & 31;
        S5Lane s; s5_lane_params(p, l, d, g, p.lane, s, false);
        float ar = s.abr, ai = s.abi;
#pragma unroll
        for (int q = 0; q < 7; ++q) { const float nr = ar * ar - ai * ai, ni = 2.f * ar * ai; ar = nr; ai = ni; }
        float hr = 0.f, hi = 0.f;
        const float* E = p.S5E + (size_t)(d * 32 + g) * NCH * 128; float* Hn = p.S5H + (size_t)(d * 32 + g) * NCH * 128;
        for (int c = 0; c < NCH; ++c) { Hn[c * 128 + p.lane] = hr; Hn[c * 128 + 64 + p.lane] = hi;
            const float er = E[c * 128 + p.lane], ei = E[c * 128 + 64 + p.lane];
            const float nr = ar * hr - ai * hi + er, ni = ar * hi + ai * hr + ei; hr = nr; hi = ni; }
    }
}
__device__ __forceinline__ void attention_naive(const P& p, int l, int aw, int NAW, LAS float* pbuf) {
    const int lane = p.lane;
    for (int it = aw; it < T * 8; it += NAW) {
        const int row = it >> 3, hq = it & 7, kvh = hq >> 2;
        const bool isc = row < NCTX; const int t = row - NCTX;
        const int jlo = isc ? 0 : (t - 128 < 0 ? 0 : t - 128), jhi = isc ? -1 : (t + 128 > NLAT - 1 ? NLAT - 1 : t + 128);
        const int nloc = jhi - jlo + 1, nk = nloc + NCTX;
        const float sink = p.sink[l * 8 + hq];
        float q[64];
        { const u32x4* qp = (const u32x4*)(p.PROJ + (size_t)row * PJ + Q0 + hq * 64);
#pragma unroll
          for (int c = 0; c < 8; ++c) { const u32x4 w = qp[c]; q[8 * c] = bflo(w.x); q[8 * c + 1] = bfhi(w.x); q[8 * c + 2] = bflo(w.y); q[8 * c + 3] = bfhi(w.y);
              q[8 * c + 4] = bflo(w.z); q[8 * c + 5] = bfhi(w.z); q[8 * c + 6] = bflo(w.w); q[8 * c + 7] = bfhi(w.w); } }
        float sc[9]; float mx = sink;
#pragma unroll
        for (int i = 0; i < 9; ++i) { const int kk = lane + 64 * i; float s = -INFINITY;
            if (kk < nk) { const int krow = kk < nloc ? NCTX + jlo + kk : kk - nloc;
                const u32x4* kp = (const u32x4*)(p.PROJ + (size_t)krow * PJ + K0 + kvh * 64); float dot = 0.f;
#pragma unroll
                for (int c = 0; c < 8; ++c) { const u32x4 w = kp[c];
                    dot += q[8 * c] * bflo(w.x) + q[8 * c + 1] * bfhi(w.x) + q[8 * c + 2] * bflo(w.y) + q[8 * c + 3] * bfhi(w.y)
                         + q[8 * c + 4] * bflo(w.z) + q[8 * c + 5] * bfhi(w.z) + q[8 * c + 6] * bflo(w.w) + q[8 * c + 7] * bfhi(w.w); }
                s = dot * 0.125f; }
            sc[i] = s; mx = fmaxf(mx, s); }
        mx = wmaxf(mx);
        float sum = 0.f;
#pragma unroll
        for (int i = 0; i < 9; ++i) { const int kk = lane + 64 * i; const float e = (kk < nk) ? expf(sc[i] - mx) : 0.f; pbuf[kk] = e; sum += e; }
        const float den = wsum(sum) + expf(sink - mx);
        LDS_FENCE();
        float o = 0.f;
        const bf16* vb = p.PROJ + V0 + kvh * 64 + lane;
#pragma unroll 4
        for (int kk = 0; kk < nk; ++kk) { const int vrow = kk < nloc ? NCTX + jlo + kk : kk - nloc; o += pbuf[kk] * bf2f(vb[(size_t)vrow * PJ]); }
        p.Y3[((size_t)2 * T + row) * 512 + hq * 64 + lane] = (bf16)f2bf(o / den);
        LDS_FENCE();
    }
}

__device__ __forceinline__ void phase_postmix(const P& p, int l, LAS unsigned char* lds) {
    constexpr int CSH_BYTES = 2 * 2 * 16 * 68 * 4, WREG = 16640;
    LAS float* Csh = (LAS float*)lds;
    LAS unsigned char* wreg = lds + CSH_BYTES + p.wave * WREG;
    LAS unsigned char* ub = wreg;
    LAS float* Hb = (LAS float*)(wreg + 4096);
    LAS float* Yb = (LAS float*)(wreg + 4096 + 4224);
    const int lane = p.lane;
    for (int it = p.bid; it < 32 * 17; it += p.G) {
        const int g = it / 17, chunk = (it % 17) * 8 + p.wave;
        __syncthreads();
        for (int i = p.tid; i < 2 * 2 * 16 * 64; i += NTHR) { const int pq = i & 63, k = (i >> 6) & 15, ri = (i >> 10) & 1, d = i >> 11;
            const float* src = ri ? p.c_im : p.c_re; Csh[((d * 2 + ri) * 16 + k) * 68 + pq] = src[(((size_t)(l * 2 + d) * 32 + g) * 16 + k) * 64 + pq]; }
        __syncthreads();
        if (chunk < NCH) {
            const int r0 = 128 * chunk;
            s5_stage_u(p, r0, g, ub, lane);
            for (int d = 0; d < 2; ++d) {
                S5Lane s; s5_lane_params(p, l, d, g, lane, s, true);
                const int cs = (d == 0) ? chunk : (chunk < 2 ? 1 - chunk : NCH + 1 - chunk);
                const float* Hn = p.S5H + ((size_t)(d * 32 + g) * NCH + cs) * 128;
                float hr = Hn[lane], hi = Hn[64 + lane];
                const LAS float* Cr = Csh + (d * 2 + 0) * 16 * 68; const LAS float* Ci = Csh + (d * 2 + 1) * 16 * 68;
                for (int sub = 0; sub < 16; ++sub) {
#pragma unroll
                    for (int j = 0; j < 8; ++j) { const int is = sub * 8 + j; s5_step(s, ub, d == 0 ? is : 127 - is, hr, hi); Hb[j * 132 + lane] = hr; Hb[j * 132 + 64 + lane] = hi; }
                    LDS_FENCE();
#pragma unroll
                    for (int m = 0; m < 2; ++m) { const int o = lane + 64 * m, j = o >> 4, k = o & 15; float y = 0.f;
#pragma unroll
                        for (int q = 0; q < 16; ++q) { const f32x4 cr = *(const LAS f32x4*)(Cr + k * 68 + 4 * q), ci = *(const LAS f32x4*)(Ci + k * 68 + 4 * q);
                            const f32x4 xr = *(const LAS f32x4*)(Hb + j * 132 + 4 * q), xi = *(const LAS f32x4*)(Hb + j * 132 + 64 + 4 * q);
                            y += cr[0] * xr[0] + cr[1] * xr[1] + cr[2] * xr[2] + cr[3] * xr[3] - ci[0] * xi[0] - ci[1] * xi[1] - ci[2] * xi[2] - ci[3] * xi[3]; }
                        const int is = sub * 8 + j, i = (d == 0) ? is : 127 - is;
                        if (d == 0) Yb[i * 16 + k] = y; else Yb[i * 16 + k] += y; }
                    LDS_FENCE();
                }
            }
            const float* dsk = p.s5_d + (size_t)l * 512 + g * 16;
#pragma unroll
            for (int m = 0; m < 2; ++m) { const int i = lane + 64 * m;
                const u32x4 ua = *(const LAS u32x4*)(ub + i * 32), ubv = *(const LAS u32x4*)(ub + i * 32 + 16);
                float u[16];
                u[0] = bflo(ua.x); u[1] = bfhi(ua.x); u[2] = bflo(ua.y); u[3] = bfhi(ua.y); u[4] = bflo(ua.z); u[5] = bfhi(ua.z); u[6] = bflo(ua.w); u[7] = bfhi(ua.w);
                u[8] = bflo(ubv.x); u[9] = bfhi(ubv.x); u[10] = bflo(ubv.y); u[11] = bfhi(ubv.y); u[12] = bflo(ubv.z); u[13] = bfhi(ubv.z); u[14] = bflo(ubv.w); u[15] = bfhi(ubv.w);
                float a[16];
#pragma unroll
                for (int k = 0; k < 16; ++k) a[k] = gelu_tanh_f(Yb[i * 16 + k] + dsk[k] * u[k]);
                u32x4 o0, o1; o0.x = pk2(a[0], a[1]); o0.y = pk2(a[2], a[3]); o0.z = pk2(a[4], a[5]); o0.w = pk2(a[6], a[7]);
                o1.x = pk2(a[8], a[9]); o1.y = pk2(a[10], a[11]); o1.z = pk2(a[12], a[13]); o1.w = pk2(a[14], a[15]);
                bf16* dst = p.SA + (size_t)(r0 + i) * 512 + g * 16;
                *(u32x4*)dst = o0; *(u32x4*)(dst + 8) = o1; }
            LDS_FENCE();
        }
    }
}

__device__ __forceinline__ void phase_select(const P& p, LAS unsigned char* lds, bool with_ctx) {
    LAS unsigned* keys = (LAS unsigned*)lds;
    LAS unsigned* hist = keys + 16384;
    LAS unsigned* misc = hist + 256;
    const int tid = p.tid, lane = p.lane, wave = p.wave;
    for (int it = p.bid; it < (with_ctx ? 32 : 16); it += p.G) {
        const int set = it >> 4, e = it & 15;
        const int n = set ? NCTX : NLAT, cap = set ? CAP_C : CAP_L, row0 = set ? 0 : NCTX, slot0 = set ? CAP_L : 0;
        const float* src = p.AFFT + (size_t)e * T + row0;
        __syncthreads();
        for (int i = tid; i < n; i += NTHR) keys[i] = __float_as_uint(src[i]);
        unsigned prefix = 0u, mask = 0u, need = (unsigned)cap;
        for (int pass = 3; pass >= 0; --pass) {
            if (tid < 256) hist[tid] = 0u;
            __syncthreads();
            for (int i = tid; i < n; i += NTHR) { const unsigned k = keys[i]; if ((k & mask) == prefix) __hip_atomic_fetch_add(&hist[(k >> (8 * pass)) & 255u], 1u, __ATOMIC_RELAXED, __HIP_MEMORY_SCOPE_WORKGROUP); }
            __syncthreads();
            if (wave == 0) {
                const unsigned h0 = hist[4 * lane], h1 = hist[4 * lane + 1], h2 = hist[4 * lane + 2], h3 = hist[4 * lane + 3];
                const unsigned c = h0 + h1 + h2 + h3; unsigned S = c;
#pragma unroll
                for (int o = 1; o < 64; o <<= 1) { const unsigned t = __shfl_down(S, o); if (lane + o < 64) S += t; }
                const unsigned Snext = S - c;
                if (S >= need && Snext < need) { unsigned rem = need - Snext; unsigned bin;
                    if (h3 >= rem) bin = 3; else { rem -= h3; if (h2 >= rem) bin = 2; else { rem -= h2; if (h1 >= rem) bin = 1; else { rem -= h1; bin = 0; } } }
                    misc[0] = 4 * lane + bin; misc[1] = rem; }
            }
            __syncthreads();
            prefix |= misc[0] << (8 * pass); mask |= 0xFFu << (8 * pass); need = misc[1];
            __syncthreads();
        }
        unsigned selbase = 0u, eqbase = 0u;
        for (int base = 0; base < n; base += NTHR) {
            const int i = base + tid; const bool valid = i < n; const unsigned k = valid ? keys[i] : 0u;
            const bool eq = valid && k == prefix, gt = valid && k > prefix;
            const unsigned long long lt = (1ull << lane) - 1ull;
            const unsigned long long be = __ballot(eq);
            if (lane == 0) misc[8 + wave] = (unsigned)__popcll(be);
            __syncthreads();
            unsigned woff = 0u, tot = 0u;
#pragma unroll
            for (int w = 0; w < 8; ++w) { const unsigned v = misc[8 + w]; woff += (w < wave) ? v : 0u; tot += v; }
            const unsigned eqrank = eqbase + woff + (unsigned)__popcll(be & lt);
            const bool sel = gt || (eq && eqrank < need);
            const unsigned long long bs = __ballot(sel);
            if (lane == 0) misc[16 + wave] = (unsigned)__popcll(bs);
            __syncthreads();
            unsigned woff2 = 0u, tot2 = 0u;
#pragma unroll
            for (int w = 0; w < 8; ++w) { const unsigned v = misc[16 + w]; woff2 += (w < wave) ? v : 0u; tot2 += v; }
            if (valid) { const int row = row0 + i;
                if (sel) { const int slot = slot0 + (int)(selbase + woff2 + (unsigned)__popcll(bs & lt));
                    p.IDX[e * ESLOTS + slot] = row; p.GSEL[e * ESLOTS + slot] = __uint_as_float(k); p.INV[(size_t)row * 16 + e] = slot; }
                else p.INV[(size_t)row * 16 + e] = -1; }
            selbase += tot2; eqbase += tot;
            __syncthreads();
        }
    }
}
__device__ __forceinline__ void phase_gather(const P& p, bool with_ctx) {
    const int gw = p.bid * NWAVES + p.wave, NGW = p.G * NWAVES, lane = p.lane;
    for (int idx = gw; idx < NE * ESLOTS; idx += NGW) {
        const int slot = idx % ESLOTS; const bool valid = slot < CAP_L + (with_ctx ? CAP_C : 0);
        u32x4 a = (u32x4){0u, 0u, 0u, 0u}, b = a;
        if (valid) { const int row = p.IDX[idx]; const u32x4* s = (const u32x4*)(p.H + (size_t)row * D); a = s[lane]; b = s[64 + lane]; }
        else if (lane == 0) p.GSEL[idx] = 0.f;
        u32x4* dst = (u32x4*)(p.XE + (size_t)idx * D); dst[lane] = a; dst[64 + lane] = b;
    }
}

typedef short bf16x8 __attribute__((ext_vector_type(8)));
#define MFMA16(a, b, c) __builtin_amdgcn_mfma_f32_16x16x32_bf16((a), (b), (c), 0, 0, 0)
constexpr int LDP = 272;
constexpr int LDQ = 144;
__device__ __forceinline__ bf16x8 ld_frag(const LAS unsigned char* base, int row, int kcol, int ldb) { return *(const LAS bf16x8*)(base + row * ldb + kcol * 2); }
__device__ __forceinline__ void st_b16(LAS unsigned char* p, unsigned v) { *(LAS unsigned short*)p = (unsigned short)v; }
__device__ __forceinline__ float wscan_incl(float v, int lane) {
#pragma unroll
    for (int o = 1; o < 64; o <<= 1) { const float t = __shfl_up(v, o); if (lane >= o) v += t; }
    return v;
}
__device__ __forceinline__ int chunk_r0(int d, int cs) { return d == 0 ? 128 * cs : (cs < 2 ? 128 * (1 - cs) : 128 * (NCH + 1 - cs)); }
__device__ __forceinline__ int scan_chunk_of(int d, int cn) { return d == 0 ? cn : (cn < 2 ? 1 - cn : NCH + 1 - cn); }

__device__ __forceinline__ void ssd_acum(const float* DT, int r0, int d, int col, float a, int lane, LAS float* acum, LAS float* dtv, float& total) {
    const int j0 = d == 0 ? lane : 127 - lane, j1 = d == 0 ? 64 + lane : 63 - lane;
    const float dt0 = DT[(size_t)(r0 + j0) * 16 + col], dt1 = DT[(size_t)(r0 + j1) * 16 + col];
    const float s0 = wscan_incl(dt0 * a, lane); const float t0 = __shfl(s0, 63);
    const float s1 = wscan_incl(dt1 * a, lane) + t0; total = __shfl(s1, 63);
    acum[j0] = s0; acum[j1] = s1; dtv[j0] = dt0; dtv[j1] = dt1;
}

__device__ __forceinline__ void ssd_states(const P& p, int l, LAS unsigned char* lds, float* SST, float* DEC) {
    LAS unsigned char* BT = lds;
    LAS unsigned char* XW = lds + 128 * LDP;
    LAS float* wj = (LAS float*)(lds + 128 * LDP + 4 * 64 * LDP);
    const int tid = p.tid, lane = p.lane, wave = p.wave, quad = lane >> 4, l15 = lane & 15;
    for (int u = p.bid; u < 2 * NCH * 2; u += p.G) {
        const int d = u / (2 * NCH), cs = (u % (2 * NCH)) >> 1, g = u & 1;
        const int r0 = chunk_r0(d, cs);
        __syncthreads();
        if (wave < 4) { const int h = g * 4 + wave; const float a = -expf(p.a_log[l * 16 + d * 8 + h]); float total;
            LAS float* ac = wj + 512 + wave * 128; LAS float* dv = wj + 1024 + wave * 128;
            ssd_acum(p.DT, r0, d, d * 8 + h, a, lane, ac, dv, total);
            LDS_FENCE();
            wj[wave * 128 + lane] = expf(total - ac[lane]) * dv[lane]; wj[wave * 128 + 64 + lane] = expf(total - ac[64 + lane]) * dv[64 + lane];
            if (lane == 0) DEC[(d * NCH + cs) * 8 + h] = expf(total); }
        __syncthreads();
        for (int idx = tid; idx < 128 * 16; idx += NTHR) { const int j = idx >> 4, n8 = (idx & 15) * 8;
            const u32x4 v = *(const u32x4*)(p.CV + (size_t)(r0 + j) * 1024 + 512 + g * 128 + n8);
            LAS unsigned char* dst = BT + n8 * LDP + 2 * j;
            st_b16(dst, v.x & 0xffffu); st_b16(dst + LDP, v.x >> 16); st_b16(dst + 2 * LDP, v.y & 0xffffu); st_b16(dst + 3 * LDP, v.y >> 16);
            st_b16(dst + 4 * LDP, v.z & 0xffffu); st_b16(dst + 5 * LDP, v.z >> 16); st_b16(dst + 6 * LDP, v.w & 0xffffu); st_b16(dst + 7 * LDP, v.w >> 16); }
        for (int idx = tid; idx < 128 * 32; idx += NTHR) { const int j = idx >> 5, c8 = (idx & 31) * 8, hh = c8 >> 6, p8 = c8 & 63;
            const u32x4 v = *(const u32x4*)(p.CV + (size_t)(r0 + j) * 1024 + g * 256 + c8); const float w = wj[hh * 128 + j];
            LAS unsigned char* dst = XW + (hh * 64 + p8) * LDP + 2 * j;
            st_b16(dst, f2bf(bflo(v.x) * w)); st_b16(dst + LDP, f2bf(bfhi(v.x) * w)); st_b16(dst + 2 * LDP, f2bf(bflo(v.y) * w)); st_b16(dst + 3 * LDP, f2bf(bfhi(v.y) * w));
            st_b16(dst + 4 * LDP, f2bf(bflo(v.z) * w)); st_b16(dst + 5 * LDP, f2bf(bfhi(v.z) * w)); st_b16(dst + 6 * LDP, f2bf(bflo(v.w) * w)); st_b16(dst + 7 * LDP, f2bf(bfhi(v.w) * w)); }
        __syncthreads();
        const int hh = wave >> 1, ph = wave & 1;
        f32x4 acc[2][8];
#pragma unroll
        for (int a = 0; a < 2; ++a)
#pragma unroll
            for (int b = 0; b < 8; ++b) acc[a][b] = (f32x4){0.f, 0.f, 0.f, 0.f};
#pragma unroll
        for (int ks = 0; ks < 4; ++ks) {
            bf16x8 af[2];
#pragma unroll
            for (int pt = 0; pt < 2; ++pt) af[pt] = ld_frag(XW + hh * 64 * LDP, ph * 32 + pt * 16 + l15, ks * 32 + 8 * quad, LDP);
#pragma unroll
            for (int nt = 0; nt < 8; ++nt) { const bf16x8 bfr = ld_frag(BT, nt * 16 + l15, ks * 32 + 8 * quad, LDP);
#pragma unroll
                for (int pt = 0; pt < 2; ++pt) acc[pt][nt] = MFMA16(af[pt], bfr, acc[pt][nt]); }
        }
        float* S = SST + ((size_t)(d * NCH + cs) * 8 + g * 4 + hh) * 8192;
#pragma unroll
        for (int pt = 0; pt < 2; ++pt)
#pragma unroll
            for (int nt = 0; nt < 8; ++nt)
#pragma unroll
                for (int r = 0; r < 4; ++r) S[(ph * 32 + pt * 16 + 4 * quad + r) * 128 + nt * 16 + l15] = acc[pt][nt][r];
    }
}

__device__ __forceinline__ void scan_carries(const P& p, int l, const float* SST, const float* DEC, bf16* HIN) {
    for (int e = p.bid * NTHR + p.tid; e < 2 * 8 * 8192; e += p.G * NTHR) {
        const int d = e >> 16, h = (e >> 13) & 7, pn = e & 8191;
        float hs = 0.f;
        for (int c0 = 0; c0 < NCH; c0 += 10) {
            float s[10], dc[10];
#pragma unroll
            for (int j = 0; j < 10; ++j) { const size_t ci = (size_t)(d * NCH + c0 + j) * 8 + h; s[j] = SST[ci * 8192 + pn]; dc[j] = DEC[ci]; }
#pragma unroll
            for (int j = 0; j < 10; ++j) { const size_t ci = (size_t)(d * NCH + c0 + j) * 8 + h; HIN[ci * 8192 + pn] = (bf16)f2bf(hs); hs = hs * dc[j] + s[j]; }
        }
    }
    for (int e = p.bid * NTHR + p.tid; e < 2 * 32 * 64; e += p.G * NTHR) {
        const int d = e >> 11, g = (e >> 6) & 31, pq = e & 63;
        S5Lane s; s5_lane_params(p, l, d, g, pq, s, false);
        float ar = s.abr, ai = s.abi;
#pragma unroll
        for (int q = 0; q < 7; ++q) { const float nr = ar * ar - ai * ai, ni = 2.f * ar * ai; ar = nr; ai = ni; }
        float hr = 0.f, hi = 0.f;
        const float* E = p.S5E + (size_t)(d * 32 + g) * NCH * 128 + pq; float* Hn = p.S5H + (size_t)(d * 32 + g) * NCH * 128 + pq;
        for (int c0 = 0; c0 < NCH; c0 += 10) {
            float er[10], ei[10];
#pragma unroll
            for (int j = 0; j < 10; ++j) { er[j] = E[(c0 + j) * 128]; ei[j] = E[(c0 + j) * 128 + 64]; }
#pragma unroll
            for (int j = 0; j < 10; ++j) { Hn[(c0 + j) * 128] = hr; Hn[(c0 + j) * 128 + 64] = hi;
                const float nr = ar * hr - ai * hi + er[j], ni = ar * hi + ai * hr + ei[j]; hr = nr; hi = ni; }
        }
    }
}

__device__ __forceinline__ void ssd_outputs(const P& p, int l, LAS unsigned char* lds, const bf16* HIN, bf16* YS) {
    LAS unsigned char* Cm = lds;
    LAS unsigned char* Bm = lds + 128 * LDP;
    LAS unsigned char* XT = lds + 2 * 128 * LDP;
    LAS unsigned char* Wm = lds + 2 * 128 * LDP + 64 * LDP;
    LAS float* sm = (LAS float*)(lds + 3 * 128 * LDP + 64 * LDP);
    const int tid = p.tid, lane = p.lane, wave = p.wave, quad = lane >> 4, l15 = lane & 15;
    for (int u = p.bid; u < NCH * 8; u += p.G) {
        const int cn = u >> 3, h = u & 7, g = h >> 2, r0 = 128 * cn;
        __syncthreads();
        if (wave < 2) { const int d = wave; const float a = -expf(p.a_log[l * 16 + d * 8 + h]); float total;
            ssd_acum(p.DT, r0, d, d * 8 + h, a, lane, sm + d * 128, sm + 256 + d * 128, total); }
        for (int idx = tid; idx < 128 * 16; idx += NTHR) { const int j = idx >> 4, n8 = (idx & 15) * 8;
            const bf16* src = p.CV + (size_t)(r0 + j) * 1024 + g * 128 + n8;
            *(LAS u32x4*)(Bm + j * LDP + n8 * 2) = *(const u32x4*)(src + 512); *(LAS u32x4*)(Cm + j * LDP + n8 * 2) = *(const u32x4*)(src + 768); }
        for (int idx = tid; idx < 128 * 8; idx += NTHR) { const int j = idx >> 3, p8 = (idx & 7) * 8;
            const u32x4 v = *(const u32x4*)(p.CV + (size_t)(r0 + j) * 1024 + h * 64 + p8);
            LAS unsigned char* dst = XT + p8 * LDP + 2 * j;
            st_b16(dst, v.x & 0xffffu); st_b16(dst + LDP, v.x >> 16); st_b16(dst + 2 * LDP, v.y & 0xffffu); st_b16(dst + 3 * LDP, v.y >> 16);
            st_b16(dst + 4 * LDP, v.z & 0xffffu); st_b16(dst + 5 * LDP, v.z >> 16); st_b16(dst + 6 * LDP, v.w & 0xffffu); st_b16(dst + 7 * LDP, v.w >> 16); }
        __syncthreads();
        f32x4 G[8];
#pragma unroll
        for (int jt = 0; jt < 8; ++jt) G[jt] = (f32x4){0.f, 0.f, 0.f, 0.f};
#pragma unroll
        for (int ks = 0; ks < 4; ++ks) { const bf16x8 af = ld_frag(Cm, 16 * wave + l15, ks * 32 + 8 * quad, LDP);
#pragma unroll
            for (int jt = 0; jt < 8; ++jt) G[jt] = MFMA16(af, ld_frag(Bm, 16 * jt + l15, ks * 32 + 8 * quad, LDP), G[jt]); }
        __syncthreads();
        for (int idx = tid; idx < 2 * 64 * 16; idx += NTHR) { const int d = idx >> 10, pp = (idx >> 4) & 63, n8 = (idx & 15) * 8;
            const int cs = scan_chunk_of(d, cn);
            *(LAS u32x4*)(Bm + (d * 64 + pp) * LDP + n8 * 2) = *(const u32x4*)(HIN + ((size_t)(d * NCH + cs) * 8 + h) * 8192 + pp * 128 + n8); }
        __syncthreads();
        f32x4 Y[4];
#pragma unroll
        for (int pt = 0; pt < 4; ++pt) Y[pt] = (f32x4){0.f, 0.f, 0.f, 0.f};
#pragma unroll
        for (int d = 0; d < 2; ++d) {
            const LAS float* ac = sm + d * 128; const LAS float* dv = sm + 256 + d * 128;
            float ai[4];
#pragma unroll
            for (int r = 0; r < 4; ++r) ai[r] = ac[16 * wave + 4 * quad + r];
#pragma unroll
            for (int jt = 0; jt < 8; ++jt) { const int j = 16 * jt + l15; const float aj = ac[j], dj = dv[j];
#pragma unroll
                for (int r = 0; r < 4; ++r) { const int i = 16 * wave + 4 * quad + r; const bool valid = (d == 0) ? (j <= i) : (j >= i);
                    const float w = valid ? G[jt][r] * expf(ai[r] - aj) * dj : 0.f;
                    st_b16(Wm + i * LDP + 2 * j, f2bf(w)); } }
            LDS_FENCE();
            f32x4 Y2[4];
#pragma unroll
            for (int pt = 0; pt < 4; ++pt) Y2[pt] = (f32x4){0.f, 0.f, 0.f, 0.f};
#pragma unroll
            for (int ks = 0; ks < 4; ++ks) { const bf16x8 wf = ld_frag(Wm, 16 * wave + l15, ks * 32 + 8 * quad, LDP), cf = ld_frag(Cm, 16 * wave + l15, ks * 32 + 8 * quad, LDP);
#pragma unroll
                for (int pt = 0; pt < 4; ++pt) { Y[pt] = MFMA16(wf, ld_frag(XT, 16 * pt + l15, ks * 32 + 8 * quad, LDP), Y[pt]);
                    Y2[pt] = MFMA16(cf, ld_frag(Bm + d * 64 * LDP, 16 * pt + l15, ks * 32 + 8 * quad, LDP), Y2[pt]); } }
#pragma unroll
            for (int r = 0; r < 4; ++r) { const float ea = expf(ai[r]);
#pragma unroll
                for (int pt = 0; pt < 4; ++pt) Y[pt][r] += ea * Y2[pt][r]; }
            LDS_FENCE();
        }
#pragma unroll
        for (int pt = 0; pt < 4; ++pt)
#pragma unroll
            for (int r = 0; r < 4; ++r) YS[(size_t)(r0 + 16 * wave + 4 * quad + r) * 512 + h * 64 + 16 * pt + l15] = (bf16)f2bf(Y[pt][r]);
    }
}

__device__ __forceinline__ void ssd_gated_norm(const P& p, int l, const bf16* YS) {
    const int gw = p.bid * NWAVES + p.wave, NGW = p.G * NWAVES, lane = p.lane;
    for (int row = gw; row < T; row += NGW) {
        const int ch = lane * 8;
        const float dsk = p.ssd_d[l * 8 + (ch >> 6)];
        const u32x4 yv = *(const u32x4*)(YS + (size_t)row * 512 + ch);
        const u32x4 xs = *(const u32x4*)(p.CV + (size_t)row * 1024 + ch), zz = *(const u32x4*)(p.PROJ + (size_t)row * PJ + Z0 + ch);
        float v[8];
        v[0] = (bflo(yv.x) + dsk * bflo(xs.x)) * silu_f(bflo(zz.x)); v[1] = (bfhi(yv.x) + dsk * bfhi(xs.x)) * silu_f(bfhi(zz.x));
        v[2] = (bflo(yv.y) + dsk * bflo(xs.y)) * silu_f(bflo(zz.y)); v[3] = (bfhi(yv.y) + dsk * bfhi(xs.y)) * silu_f(bfhi(zz.y));
        v[4] = (bflo(yv.z) + dsk * bflo(xs.z)) * silu_f(bflo(zz.z)); v[5] = (bfhi(yv.z) + dsk * bfhi(xs.z)) * silu_f(bfhi(zz.z));
        v[6] = (bflo(yv.w) + dsk * bflo(xs.w)) * silu_f(bflo(zz.w)); v[7] = (bfhi(yv.w) + dsk * bfhi(xs.w)) * silu_f(bfhi(zz.w));
        float ss = 0.f;
#pragma unroll
        for (int i = 0; i < 8; ++i) ss += v[i] * v[i];
        const float rstd = rsqrtf(wsum(ss) * (1.f / 512.f) + EPS);
        const float* ng = p.ssd_norm_g + (size_t)l * 512 + ch;
        const f32x4 g0 = *(const f32x4*)ng, g1 = *(const f32x4*)(ng + 4);
        u32x4 o; o.x = pk2(v[0] * rstd * g0[0], v[1] * rstd * g0[1]); o.y = pk2(v[2] * rstd * g0[2], v[3] * rstd * g0[3]);
        o.z = pk2(v[4] * rstd * g1[0], v[5] * rstd * g1[1]); o.w = pk2(v[6] * rstd * g1[2], v[7] * rstd * g1[3]);
        *(u32x4*)(p.Y3 + ((size_t)T + row) * 512 + ch) = o;
    }
}

__device__ __forceinline__ void attention_mfma(const P& p, int l, LAS unsigned char* lds, int u_begin, int u_end, int u_first, int u_stride) {
    LAS unsigned char* Kt = lds;
    LAS unsigned char* VT = lds + 64 * LDQ;
    LAS unsigned char* Pw = lds + 2 * 64 * LDQ + p.wave * 64 * LDQ;
    const int tid = p.tid, lane = p.lane, wave = p.wave, quad = lane >> 4, l15 = lane & 15;
    const float C2 = 0.125f * 1.4426950408889634f;
    for (int u = u_begin + u_first; u < u_end; u += u_stride) {
        const int qb = u >> 1, kvh = u & 1, hq = kvh * 4 + (wave >> 1);
        const bool isc = qb < 2; const int nb = qb - 2;
        const int qrow0 = 128 * qb + 64 * (wave & 1);
        bf16x8 Qf[4][2];
#pragma unroll
        for (int qt = 0; qt < 4; ++qt)
#pragma unroll
            for (int ks = 0; ks < 2; ++ks) Qf[qt][ks] = *(const bf16x8*)(p.PROJ + (size_t)(qrow0 + 16 * qt + l15) * PJ + Q0 + hq * 64 + ks * 32 + 8 * quad);
        f32x4 O[4][4];
#pragma unroll
        for (int a = 0; a < 4; ++a)
#pragma unroll
            for (int b = 0; b < 4; ++b) O[a][b] = (f32x4){0.f, 0.f, 0.f, 0.f};
        float mrow[4], lrow[4];
        const float sk = p.sink[l * 8 + hq] * 1.4426950408889634f;
#pragma unroll
        for (int qt = 0; qt < 4; ++qt) { mrow[qt] = sk; lrow[qt] = 1.f; }
        const int ntile = isc ? 4 : 10;
        for (int ti = 0; ti < ntile; ++ti) {
            int krow0; bool local;
            if (isc || ti >= 6) { krow0 = 64 * (isc ? ti : ti - 6); local = false; }
            else { krow0 = NCTX + 128 * (nb - 1) + 64 * ti; local = true; }
            if (local && (krow0 < NCTX || krow0 >= T)) continue;
            __syncthreads();
            { const int key = tid >> 3, pc = tid & 7;
              const bf16* src = p.PROJ + (size_t)(krow0 + key) * PJ + kvh * 64 + pc * 8;
              *(LAS u32x4*)(Kt + key * LDQ + pc * 16) = *(const u32x4*)(src + K0);
              const u32x4 v = *(const u32x4*)(src + V0);
              LAS unsigned char* dst = VT + (pc * 8) * LDQ + 2 * key;
              st_b16(dst, v.x & 0xffffu); st_b16(dst + LDQ, v.x >> 16); st_b16(dst + 2 * LDQ, v.y & 0xffffu); st_b16(dst + 3 * LDQ, v.y >> 16);
              st_b16(dst + 4 * LDQ, v.z & 0xffffu); st_b16(dst + 5 * LDQ, v.z >> 16); st_b16(dst + 6 * LDQ, v.w & 0xffffu); st_b16(dst + 7 * LDQ, v.w >> 16); }
            __syncthreads();
            f32x4 S[4][4];
#pragma unroll
            for (int a = 0; a < 4; ++a)
#pragma unroll
                for (int b = 0; b < 4; ++b) S[a][b] = (f32x4){0.f, 0.f, 0.f, 0.f};
#pragma unroll
            for (int ks = 0; ks < 2; ++ks)
#pragma unroll
                for (int kt = 0; kt < 4; ++kt) { const bf16x8 kf = ld_frag(Kt, 16 * kt + l15, ks * 32 + 8 * quad, LDQ);
#pragma unroll
                    for (int qt = 0; qt < 4; ++qt) S[kt][qt] = MFMA16(kf, Qf[qt][ks], S[kt][qt]); }
#pragma unroll
            for (int qt = 0; qt < 4; ++qt) {
                const int tq = qrow0 + 16 * qt + l15;
                float mx = -1e30f;
#pragma unroll
                for (int kt = 0; kt < 4; ++kt)
#pragma unroll
                    for (int r = 0; r < 4; ++r) { const int tk = krow0 + 16 * kt + 4 * quad + r; const int df = tq - tk;
                        const bool ok = !local || (df <= 128 && df >= -128);
                        const float s = ok ? S[kt][qt][r] * C2 : -1e30f; S[kt][qt][r] = s; mx = fmaxf(mx, s); }
                mx = fmaxf(mx, __shfl_xor(mx, 16)); mx = fmaxf(mx, __shfl_xor(mx, 32));
                const float mn = fmaxf(mrow[qt], mx), alpha = exp2f(mrow[qt] - mn);
                float ls = 0.f;
#pragma unroll
                for (int kt = 0; kt < 4; ++kt) { float e0 = exp2f(S[kt][qt][0] - mn), e1 = exp2f(S[kt][qt][1] - mn), e2 = exp2f(S[kt][qt][2] - mn), e3 = exp2f(S[kt][qt][3] - mn);
                    ls += (e0 + e1) + (e2 + e3);
                    u32x2 w; w.x = pk2(e0, e1); w.y = pk2(e2, e3);
                    *(LAS u32x2*)(Pw + (16 * qt + l15) * LDQ + (16 * kt + 4 * quad) * 2) = w; }
                ls += __shfl_xor(ls, 16); ls += __shfl_xor(ls, 32);
                lrow[qt] = lrow[qt] * alpha + ls; mrow[qt] = mn;
#pragma unroll
                for (int dt = 0; dt < 4; ++dt) O[dt][qt] *= alpha;
            }
            LDS_FENCE();
#pragma unroll
            for (int ks = 0; ks < 2; ++ks) {
                bf16x8 pf[4];
#pragma unroll
                for (int qt = 0; qt < 4; ++qt) pf[qt] = ld_frag(Pw, 16 * qt + l15, ks * 32 + 8 * quad, LDQ);
#pragma unroll
                for (int dt = 0; dt < 4; ++dt) { const bf16x8 vf = ld_frag(VT, 16 * dt + l15, ks * 32 + 8 * quad, LDQ);
#pragma unroll
                    for (int qt = 0; qt < 4; ++qt) O[dt][qt] = MFMA16(vf, pf[qt], O[dt][qt]); }
            }
            LDS_FENCE();
        }
#pragma unroll
        for (int qt = 0; qt < 4; ++qt) { const float inv = 1.f / lrow[qt];
            bf16* orow = p.Y3 + ((size_t)2 * T + qrow0 + 16 * qt + l15) * 512 + hq * 64;
#pragma unroll
            for (int dt = 0; dt < 4; ++dt) { u32x2 w; w.x = pk2(O[dt][qt][0] * inv, O[dt][qt][1] * inv); w.y = pk2(O[dt][qt][2] * inv, O[dt][qt][3] * inv);
                *(u32x2*)(orow + 16 * dt + 4 * quad) = w; } }
    }
}

constexpr size_t S5BB_ELEMS = (size_t)2 * 32 * 128 * 32, S5CC_ELEMS = (size_t)2 * 32 * 16 * 128;
__device__ __forceinline__ void s5_tables(const P& p, int l, bf16* BB, bf16* CC, float* AB) {
    for (int e = p.bid * NTHR + p.tid; e < 2 * 32 * 64; e += p.G * NTHR) {
        const int d = e >> 11, g = (e >> 6) & 31, pq = e & 63, dg = d * 32 + g;
        S5Lane s; s5_lane_params(p, l, d, g, pq, s, true);
        AB[(size_t)e * 2] = s.abr; AB[(size_t)e * 2 + 1] = s.abi;
        u32x4* br = (u32x4*)(BB + ((size_t)dg * 128 + pq) * 32); u32x4* bi = (u32x4*)(BB + ((size_t)dg * 128 + 64 + pq) * 32);
        u32x4 w;
        w.x = pk2(s.bbr[0], s.bbr[1]); w.y = pk2(s.bbr[2], s.bbr[3]); w.z = pk2(s.bbr[4], s.bbr[5]); w.w = pk2(s.bbr[6], s.bbr[7]); br[0] = w;
        w.x = pk2(s.bbr[8], s.bbr[9]); w.y = pk2(s.bbr[10], s.bbr[11]); w.z = pk2(s.bbr[12], s.bbr[13]); w.w = pk2(s.bbr[14], s.bbr[15]); br[1] = w;
        w.x = pk2(s.bbi[0], s.bbi[1]); w.y = pk2(s.bbi[2], s.bbi[3]); w.z = pk2(s.bbi[4], s.bbi[5]); w.w = pk2(s.bbi[6], s.bbi[7]); bi[0] = w;
        w.x = pk2(s.bbi[8], s.bbi[9]); w.y = pk2(s.bbi[10], s.bbi[11]); w.z = pk2(s.bbi[12], s.bbi[13]); w.w = pk2(s.bbi[14], s.bbi[15]); bi[1] = w;
        const u32x4 z = (u32x4){0u, 0u, 0u, 0u}; br[2] = z; br[3] = z; bi[2] = z; bi[3] = z;
        const size_t ci = ((size_t)(l * 2 + d) * 32 + g) * 16;
#pragma unroll
        for (int k = 0; k < 16; ++k) { CC[((size_t)dg * 16 + k) * 128 + pq] = (bf16)f2bf(p.c_re[(ci + k) * 64 + pq]); CC[((size_t)dg * 16 + k) * 128 + 64 + pq] = (bf16)f2bf(-p.c_im[(ci + k) * 64 + pq]); }
    }
}
constexpr int S5_WREG = 4096 + 16 * 132 * 4 + 16 * LDP;
template <bool READOUT> __device__ __forceinline__ void s5_chunk_dir(int d, const bf16* BBdg, const bf16* CCdg, float abr, float abi, LAS unsigned char* wreg, int lane, float& hr, float& hi, f32x4 (&yacc)[8]) {
    const int quad = lane >> 4, l15 = lane & 15;
    LAS unsigned char* ub = wreg; LAS float* BuW = (LAS float*)(wreg + 4096); LAS unsigned char* Hw = wreg + 4096 + 16 * 132 * 4;
    bf16x8 BBf[8], CCf[4];
#pragma unroll
    for (int pt = 0; pt < 8; ++pt) BBf[pt] = *(const bf16x8*)(BBdg + (size_t)(16 * pt + l15) * 32 + 8 * quad);
    if (READOUT) {
#pragma unroll
        for (int ks = 0; ks < 4; ++ks) CCf[ks] = *(const bf16x8*)(CCdg + (size_t)l15 * 128 + ks * 32 + 8 * quad);
    }
#pragma unroll (READOUT ? 8 : 1)
    for (int ss = 0; ss < 8; ++ss) {
        const int sc = d ? 7 - ss : ss;
        bf16x8 uf = (bf16x8){0, 0, 0, 0, 0, 0, 0, 0};
        if (quad < 2) uf = *(const LAS bf16x8*)(ub + (16 * sc + l15) * 32 + quad * 16);
#pragma unroll
        for (int pt = 0; pt < 8; ++pt) { const f32x4 Dp = MFMA16(uf, BBf[pt], ((f32x4){0.f, 0.f, 0.f, 0.f}));
#pragma unroll
            for (int r = 0; r < 4; ++r) BuW[(4 * quad + r) * 132 + 16 * pt + l15] = Dp[r]; }
        LDS_FENCE();
#pragma unroll
        for (int st = 0; st < 16; ++st) { const int tl = d ? 15 - st : st;
            const float br = BuW[tl * 132 + lane], bi = BuW[tl * 132 + 64 + lane];
            const float nr = abr * hr - abi * hi + br, ni = abr * hi + abi * hr + bi; hr = nr; hi = ni;
            if (READOUT) { st_b16(Hw + tl * LDP + 2 * lane, f2bf(hr)); st_b16(Hw + tl * LDP + 128 + 2 * lane, f2bf(hi)); } }
        if (READOUT) {
            LDS_FENCE();
#pragma unroll
            for (int ks = 0; ks < 4; ++ks) yacc[sc] = MFMA16(ld_frag(Hw, l15, ks * 32 + 8 * quad, LDP), CCf[ks], yacc[sc]);
        }
        LDS_FENCE();
    }
}
__device__ __forceinline__ void s5_local_states(const P& p, LAS unsigned char* lds, const bf16* BB, const float* AB) {
    LAS unsigned char* wreg = lds + p.wave * S5_WREG;
    const int gw = p.bid * NWAVES + p.wave, NGW = p.G * NWAVES, lane = p.lane;
    for (int it = gw; it < 2 * 32 * NCH; it += NGW) {
        const int d = it / (32 * NCH), c = (it % (32 * NCH)) >> 5, g = it & 31, dg = d * 32 + g;
        s5_stage_u(p, chunk_r0(d, c), g, wreg, lane);
        float hr = 0.f, hi = 0.f; f32x4 dummy[8];
        const float abr = AB[((size_t)dg * 64 + lane) * 2], abi = AB[((size_t)dg * 64 + lane) * 2 + 1];
        if (d == 0) s5_chunk_dir<false>(0, BB + (size_t)dg * 128 * 32, nullptr, abr, abi, wreg, lane, hr, hi, dummy);
        else s5_chunk_dir<false>(1, BB + (size_t)dg * 128 * 32, nullptr, abr, abi, wreg, lane, hr, hi, dummy);
        float* E = p.S5E + ((size_t)dg * NCH + c) * 128;
        E[lane] = hr; E[64 + lane] = hi;
    }
}
__device__ __forceinline__ void s5_outputs(const P& p, int l, LAS unsigned char* lds, const bf16* BB, const bf16* CC, const float* AB) {
    LAS unsigned char* wreg = lds + p.wave * S5_WREG;
    const int gw = p.bid * NWAVES + p.wave, NGW = p.G * NWAVES, lane = p.lane, quad = lane >> 4, l15 = lane & 15;
    for (int it = gw; it < 32 * NCH; it += NGW) {
        const int cn = it >> 5, g = it & 31, r0 = 128 * cn;
        s5_stage_u(p, r0, g, wreg, lane);
        f32x4 yacc[8];
#pragma unroll
        for (int i = 0; i < 8; ++i) yacc[i] = (f32x4){0.f, 0.f, 0.f, 0.f};
#pragma unroll
        for (int d = 0; d < 2; ++d) { const int dg = d * 32 + g, cs = scan_chunk_of(d, cn);
            const float* Hn = p.S5H + ((size_t)dg * NCH + cs) * 128;
            float hr = Hn[lane], hi = Hn[64 + lane];
            s5_chunk_dir<true>(d, BB + (size_t)dg * 128 * 32, CC + (size_t)dg * 16 * 128, AB[((size_t)dg * 64 + lane) * 2], AB[((size_t)dg * 64 + lane) * 2 + 1], wreg, lane, hr, hi, yacc); }
        const float dsk = p.s5_d[(size_t)l * 512 + g * 16 + l15];
#pragma unroll
        for (int sc = 0; sc < 8; ++sc)
#pragma unroll
            for (int r = 0; r < 4; ++r) { const int t = 16 * sc + 4 * quad + r;
                const float u = bf2f(*(const LAS unsigned short*)(wreg + t * 32 + 2 * l15));
                p.SA[(size_t)(r0 + t) * 512 + g * 16 + l15] = (bf16)f2bf(gelu_tanh_f(yacc[sc][r] + dsk * u)); }
        LDS_FENCE();
    }
}

#ifndef SKIPMASK
#define SKIPMASK 0
#endif
struct Args { const float* in[33]; float* out; unsigned char* ws; int ph_lo, ph_hi; };
static_assert(sizeof(Args) == 35 * 8 + 8, "no padding");

__global__ void __launch_bounds__(NTHR, 2) fwd_kernel(Args args) {
    extern __shared__ __attribute__((aligned(16))) unsigned char lds_raw[];
    LAS unsigned char* lds = (LAS unsigned char*)lds_raw;
    const int tid_ = threadIdx.x;
    if (tid_ == 0) {
        LAS unsigned long long* tab = (LAS unsigned long long*)(lds + PTAB_OFF);
#pragma unroll
        for (int k = 0; k < 33; ++k) tab[k] = (unsigned long long)args.in[k];
        tab[33] = (unsigned long long)args.out; tab[34] = (unsigned long long)args.ws;
    }
    volatile LAS unsigned* MISC = (volatile LAS unsigned*)(lds + MISC_OFF);
    if (tid_ < 64) MISC[tid_] = 0u;
    __syncthreads();
    XcdBarrier bar; bar.bar = (unsigned*)(args.ws + WS_CTL) + CW_BAR; bar.x = 0; bar.st = nullptr;
    if (!MK_PER_PHASE) bar = xcd_barrier_post((unsigned*)(args.ws + WS_CTL) + CW_BAR, MISC + 8);

    const int lo = args.ph_lo, hi = args.ph_hi;
#define IN(k) (lo <= (k) && (k) < hi)
#define SEAM(k) do { if (!MK_PER_PHASE && (k) + 1 < hi) xcd_barrier(bar); } while (0)

    if (IN(0)) { P p; build_P(p, lds); phase_mod(p, lds); SEAM(0); }

#ifndef REPMASK
#define REPMASK 0
#endif
#define PHASE(k, ...) if (!((SKIPMASK >> (k)) & 1) && IN(pb + (k))) { for (int rep_ = 0; rep_ <= ((REPMASK >> (k)) & 1); ++rep_) { P p; build_P(p, lds); __VA_ARGS__; \
        if (rep_ < ((REPMASK >> (k)) & 1)) xcd_barrier(bar); } SEAM(pb + (k)); }
    for (int l = 0; l < DEPTH; ++l) {
        const int pb = 1 + NPH_LAYER * l;
        const bool cx = l < DEPTH - 1;
        unsigned char* wsb; { unsigned tb_ = (unsigned)(size_t)(lds + PTAB_OFF); asm volatile("" : "+v"(tb_)); wsb = (unsigned char*)ld_tab((volatile LAS unsigned*)(size_t)tb_, 34); }
        PHASE(0, convert_weights(p, l, lds); s5_tables(p, l, (bf16*)(wsb + WS_S5BB), (bf16*)(wsb + WS_S5CC), (float*)(wsb + WS_S5AB)); __syncthreads(); if (rep_ == 0) row_pass<0>(p, l, lds))
        PHASE(1, pg8::Gemm g{p.H, p.WIN, T, PJ, D}; pg8::StaticOrder S; S.init(T, PJ, p.G, p.bid); pg8::EpiStoreBf16 E{p.PROJ, PJ};
            pg8::gemm_phase<pg8::EpiStoreBf16, pg8::StaticOrder, false>(lds, g, S, E, nullptr))
        PHASE(2, phase_premix(p, l, lds, rep_ == 0); s5_local_states(p, lds, (const bf16*)(wsb + WS_S5BB), (const float*)(wsb + WS_S5AB)))
        PHASE(3, ssd_states(p, l, lds, (float*)(wsb + WS_SST), (float*)(wsb + WS_DEC)); __syncthreads(); attention_mfma(p, l, lds, 4, 2 * NCH, p.bid, p.G))
        PHASE(4, if (cx && p.bid >= p.G - 4) attention_mfma(p, l, lds, 0, 4, p.bid - (p.G - 4), 4);
            scan_carries(p, l, (const float*)(wsb + WS_SST), (const float*)(wsb + WS_DEC), (bf16*)(wsb + WS_HIN)))
        PHASE(5, ssd_outputs(p, l, lds, (const bf16*)(wsb + WS_HIN), (bf16*)(wsb + WS_YS)); __syncthreads(); s5_outputs(p, l, lds, (const bf16*)(wsb + WS_S5BB), (const bf16*)(wsb + WS_S5CC), (const float*)(wsb + WS_S5AB)))
        PHASE(6, pg8::Gemm g{p.SA, p.WGLU, T, 512, 512}; pg8::RowOffOrder S; S.init(cx ? T : NLAT, 512, p.G, p.bid, cx ? 0 : 1); pg8::EpiGlu E{p.SA, p.b_glu + (size_t)l * 512, p.Y3};
            pg8::gemm_phase<pg8::EpiGlu, pg8::RowOffOrder, false>(lds, g, S, E, nullptr); ssd_gated_norm(p, l, (const bf16*)(wsb + WS_YS)))
        PHASE(7, pg8::Gemm g{p.Y3, p.WBR, 3 * T, 3072, 512}; pg8::MergeOrder S{p.G, p.bid, cx ? 0 : 1}; pg8::EpiMerge E{p.PROJ, p.PM, p.MB};
            pg8::gemm_phase<pg8::EpiMerge, pg8::MergeOrder, false>(lds, g, S, E, nullptr))
        PHASE(8, pg8::Gemm g{p.MB, p.WOUT, T, D, D}; pg8::RowOffOrder S; S.init(cx ? T : NLAT, D, p.G, p.bid, cx ? 0 : 1);
            pg8::EpiResid E{p.XL, p.XC, p.MOD + (size_t)(l * 2 + 0) * 6144 + 2 * D, p.MOD + (size_t)(l * 2 + 1) * 6144 + 2 * D};
            pg8::gemm_phase<pg8::EpiResid, pg8::RowOffOrder, false>(lds, g, S, E, nullptr))
        PHASE(9, row_pass<1>(p, l, lds, cx))
        PHASE(10, phase_select(p, lds, cx))
        PHASE(11, phase_gather(p, cx))
        PHASE(12, pg8::Gemm g{p.XE, p.WUP, NE * ESLOTS, NE * 2048, D}; pg8::ExpertOrder S{p.G, p.bid, 8, cx ? 9 : 8}; pg8::EpiSwiGlu E{p.HID};
            pg8::gemm_phase<pg8::EpiSwiGlu, pg8::ExpertOrder, false>(lds, g, S, E, nullptr))
        PHASE(13, pg8::Gemm g{p.HID, p.WDN, NE * ESLOTS, NE * 1024, D}; pg8::ExpertOrder S{p.G, p.bid, 4, cx ? 9 : 8}; pg8::EpiDown E{p.YE, p.GSEL};
            pg8::gemm_phase<pg8::EpiDown, pg8::ExpertOrder, false>(lds, g, S, E, nullptr))
    }
    if (IN(NPHASES - 1)) { P p; build_P(p, lds); row_pass<2>(p, 0, lds); }
#undef IN
#undef SEAM
}

extern "C" void kernel_launch(void* const* d_in, const int* in_sizes, int n_in, void* d_out, int out_size, void* d_ws, size_t ws_size, hipStream_t stream) {
    static int grid = 0;
    if (grid == 0) {
        if (n_in != 33 || out_size != NLAT * D || ws_size < WS_END) { fprintf(stderr, "kernel_launch: unexpected shapes: n_in %d out %d ws %zu (need %zu)\n", n_in, out_size, ws_size, (size_t)WS_END); grid = -1; return; }
        int dev = 0, cus = 0, per_cu = 0;
        if (hipGetDevice(&dev) != hipSuccess || hipDeviceGetAttribute(&cus, hipDeviceAttributeMultiprocessorCount, dev) != hipSuccess) { grid = -1; return; }
        if (hipFuncSetAttribute((const void*)fwd_kernel, hipFuncAttributeMaxDynamicSharedMemorySize, LDS_BYTES) != hipSuccess) { fprintf(stderr, "kernel_launch: hipFuncSetAttribute failed\n"); grid = -1; return; }
        if (hipOccupancyMaxActiveBlocksPerMultiprocessor(&per_cu, (const void*)fwd_kernel, NTHR, LDS_BYTES) != hipSuccess || per_cu < 1) { fprintf(stderr, "kernel_launch: occupancy query says %d\n", per_cu); (void)hipGetLastError(); }
        grid = cus;
    }
    if (grid < 0) return;
    (void)hipMemsetAsync((char*)d_ws + WS_CTL, 0, CTL_BYTES, stream);
    Args a{};
    for (int i = 0; i < 33; ++i) a.in[i] = (const float*)d_in[i];
    a.out = (float*)d_out; a.ws = (unsigned char*)d_ws;
#if MK_PER_PHASE
    for (int ph = 0; ph < NPHASES; ++ph) { a.ph_lo = ph; a.ph_hi = ph + 1; hipLaunchKernelGGL(fwd_kernel, dim3(grid), dim3(NTHR), LDS_BYTES, stream, a); }
#else
    a.ph_lo = 0; a.ph_hi = NPHASES;
    hipLaunchKernelGGL(fwd_kernel, dim3(grid), dim3(NTHR), LDS_BYTES, stream, a);
#endif
}
```

```cpp
#include <hip/hip_runtime.h>
#include <cstdio>
#include <cstdint>

#ifndef MK_PER_PHASE
#define MK_PER_PHASE 0
#endif

namespace pg8 {
#define PG8_LAS __attribute__((address_space(3)))
typedef unsigned short bf16_t;
typedef short bf16x8 __attribute__((ext_vector_type(8)));
typedef float f32x4 __attribute__((ext_vector_type(4)));
typedef unsigned u32x4 __attribute__((ext_vector_type(4)));
constexpr int BM = 256, BK = 64, HALF = 128, HTB = HALF * BK * 2  , STAGE_BYTES = 8 * HTB, NXCD = 8, WGM = 8;

__host__ __device__ __forceinline__ int lds_byte(int r, int c) { const int st = (r >> 4) * 2 + (c >> 5), rr = r & 15, cc = c & 31, ob = rr * 64 + cc * 2; return st * 1024 + (ob ^ (((ob >> 9) & 1) << 5)); }
__host__ __device__ __forceinline__ void stage_rc(int b, int& R, int& C) { const int st = b / 1024, sb = b % 1024, swz = sb ^ (((sb >> 9) & 1) << 5); R = (st >> 1) * 16 + swz / 64; C = (st & 1) * 32 + (swz % 64) / 2; }
__host__ __device__ __forceinline__ int perm32(int rho) { const int n = rho >> 4, i = rho & 15; return 8 * (i >> 2) + 4 * n + (i & 3); }

struct Unit { int pm, pn; };
struct Gemm { const bf16_t* A; const bf16_t* Bt; int M, N, K; };

struct StaticOrder {
    int nM, nN, nwg, G, c;
    __host__ __device__ void init(int M, int N, int G_, int c_) { nM = M / BM; nN = N / BM; nwg = nM * nN; G = G_; c = c_; }
    __host__ __device__ bool next(int i, Unit& u) const {
        const long L = (long)i * G + c; if (L >= nwg) return false;
        int wgid = (int)L; { const int q = nwg / NXCD, r = nwg % NXCD, xcd = wgid % NXCD, off = wgid / NXCD; wgid = (xcd < r ? xcd * (q + 1) : r * (q + 1) + (xcd - r) * q) + off; }
        const int nig = WGM * nN, gid = wgid / nig, fm = gid * WGM, gsz = (nM - fm) < WGM ? (nM - fm) : WGM;
        u.pm = fm + ((wgid % nig) % gsz); u.pn = (wgid % nig) / gsz; return true;
    }
    __device__ __forceinline__ void a_ready(const Unit&) const {}
    __device__ __forceinline__ void done(const Unit&) const {}
};
__device__ __forceinline__ unsigned cvt_pk_bf16(float lo, float hi) { unsigned r; asm volatile("v_cvt_pk_bf16_f32 %0, %1, %2" : "=v"(r) : "v"(lo), "v"(hi)); return r; }
template <class Epi, class Sched, bool STAMP = false>
__device__ __forceinline__ void gemm_phase(PG8_LAS unsigned char* lds, const Gemm g, const Sched& S, const Epi& E, unsigned long long* stamps) {
    int tid_l = threadIdx.x; asm volatile("" : "+v"(tid_l));
    const int tid = tid_l, wid = __builtin_amdgcn_readfirstlane(tid >> 6), lane = tid & 63, wr = wid >> 2, wc = wid & 3, fr = lane & 15, fq = lane >> 4;
    const int K = g.K, nt = K / BK;
    int ts_lo = 0, ts_hi = 0, nts = 0; const unsigned long long rt_entry = STAMP ? (unsigned long long)wall_clock64() : 0ull;
#define PG8_STAMP() do { if (STAMP && wid == 0 && nts < 64) { const unsigned long long _c = (unsigned long long)clock64(); \
        ts_lo = (lane == nts) ? (int)(unsigned)_c : ts_lo; ts_hi = (lane == nts) ? (int)(unsigned)(_c >> 32) : ts_hi; ++nts; } } while (0)
    PG8_STAMP();
    unsigned voffA[2], voffB[2];
#pragma unroll
    for (int i = 0; i < 2; ++i) { int R, C; stage_rc(tid * 16 + i * 8192, R, C); const int Rb = Epi::PERM ? ((R & ~31) + perm32(R & 31)) : R;
        voffA[i] = (unsigned)(R * K + C) * 2u; voffB[i] = (unsigned)(Rb * K + C) * 2u; }
    const size_t kstep = (size_t)(BK * 2);
    const size_t hstep = (size_t)HALF * K * 2;
    const size_t tstep = 2 * hstep;
    const unsigned ldsw = (unsigned)wid * 1024u;
    const int aoff = lds_byte(wr * 64 + fr, fq * 8), boff = lds_byte(wc * 32 + fr, fq * 8);
#define PG8_SA(b, h) (((b) * 2 + (h)) * HTB)
#define PG8_SB(b, h) ((4 + (b) * 2 + (h)) * HTB)
#define PG8_STAGE(bufoff, gbase, voff) do { _Pragma("unroll") for (int _i = 0; _i < 2; ++_i) \
        __builtin_amdgcn_global_load_lds((const unsigned*)((const char*)(gbase) + (voff)[_i]), (PG8_LAS unsigned*)(lds + (bufoff) + ldsw + _i * 8192), 16, 0, 0); } while (0)
#define PG8_LDA(dst, b, h) do { _Pragma("unroll") for (int m = 0; m < 4; ++m) _Pragma("unroll") for (int k = 0; k < 2; ++k) dst[m][k] = *(const PG8_LAS bf16x8*)(lds + PG8_SA(b, h) + aoff + m * 2048 + k * 1024); } while (0)
#define PG8_LDB(dst, b, h) do { _Pragma("unroll") for (int n = 0; n < 2; ++n) _Pragma("unroll") for (int k = 0; k < 2; ++k) dst[n][k] = *(const PG8_LAS bf16x8*)(lds + PG8_SB(b, h) + boff + n * 2048 + k * 1024); } while (0)
#define PG8_MMA(ai, bj, At, Bt) do { __builtin_amdgcn_s_setprio(1); _Pragma("unroll") for (int m = 0; m < 4; ++m) _Pragma("unroll") for (int n = 0; n < 2; ++n) _Pragma("unroll") for (int k = 0; k < 2; ++k) \
        acc[ai][bj][m][n] = __builtin_amdgcn_mfma_f32_16x16x32_bf16(Bt[n][k], At[m][k], acc[ai][bj][m][n], 0, 0, 0); __builtin_amdgcn_s_setprio(0); } while (0)
#define PG8_WAIT_V(n) asm volatile("s_waitcnt vmcnt(" #n ")" ::: "memory")
#define PG8_WAIT_L(n) asm volatile("s_waitcnt lgkmcnt(" #n ")" ::: "memory")
#define PG8_BAR __builtin_amdgcn_s_barrier()
#define PG8_SCHED __builtin_amdgcn_sched_barrier(0)
    Unit cur, nxt; int ui = 0;
    if (!S.next(0, cur)) return;
    f32x4 acc[2][2][4][2];
#pragma unroll
    for (int a = 0; a < 2; ++a)
#pragma unroll
        for (int b = 0; b < 2; ++b)
#pragma unroll
            for (int m = 0; m < 4; ++m)
#pragma unroll
                for (int n = 0; n < 2; ++n) acc[a][b][m][n] = (f32x4){0.f, 0.f, 0.f, 0.f};
    bf16x8 At[4][2], B0[2][2], B1[2][2];
    const char* cA = (const char*)g.A + (size_t)cur.pm * tstep; const char* cB = (const char*)g.Bt + (size_t)cur.pn * tstep;
    S.a_ready(cur);
    PG8_STAGE(PG8_SB(0, 0), cB, voffB); PG8_STAGE(PG8_SA(0, 0), cA, voffA); PG8_STAGE(PG8_SB(0, 1), cB + hstep, voffB); PG8_STAGE(PG8_SA(0, 1), cA + hstep, voffA);
    if (wr == 1) PG8_BAR;
    PG8_WAIT_V(4); PG8_BAR;
    PG8_STAGE(PG8_SB(1, 0), cB + kstep, voffB); PG8_STAGE(PG8_SA(1, 0), cA + kstep, voffA); PG8_STAGE(PG8_SB(1, 1), cB + hstep + kstep, voffB);
    PG8_WAIT_V(6); PG8_BAR;
    PG8_STAMP();
    for (;;) {
        const bool has_next = S.next(ui + 1, nxt);
        const char* nA = has_next ? (const char*)g.A + (size_t)nxt.pm * tstep : cA; const char* nB = has_next ? (const char*)g.Bt + (size_t)nxt.pn * tstep : cB;
        for (int t = 0; t < nt; t += 2) {
            const bool last = (t == nt - 2);
            const char* a1 = cA + (size_t)(t + 1) * kstep;
            const char* a2 = last ? nA : cA + (size_t)(t + 2) * kstep; const char* b2 = last ? nB : cB + (size_t)(t + 2) * kstep;
            const char* a3 = a2 + kstep; const char* b3 = b2 + kstep;
            if (last && has_next) S.a_ready(nxt);
            if constexpr (Epi::MIDHOOK) { if (t == 8 || t == 16) E.mid(acc, cur, t >> 3, wr, wc, fr, fq); }
            PG8_LDB(B0, 0, 0); PG8_SCHED; PG8_LDA(At, 0, 0); PG8_STAGE(PG8_SA(1, 1), a1 + hstep, voffA);
            PG8_WAIT_L(8); PG8_BAR; PG8_WAIT_L(0); PG8_MMA(0, 0, At, B0); PG8_BAR; PG8_SCHED;
            PG8_LDB(B1, 0, 1); PG8_STAGE(PG8_SB(0, 0), b2, voffB);
            PG8_BAR; PG8_WAIT_L(0); PG8_MMA(0, 1, At, B1); PG8_BAR;
            PG8_LDA(At, 0, 1); PG8_STAGE(PG8_SA(0, 0), a2, voffA);
            PG8_BAR; PG8_WAIT_L(0); PG8_MMA(1, 0, At, B0); PG8_BAR; PG8_SCHED;
            PG8_STAGE(PG8_SB(0, 1), b2 + hstep, voffB);
            PG8_WAIT_V(6); PG8_BAR; PG8_MMA(1, 1, At, B1); PG8_BAR;
            PG8_LDB(B0, 1, 0); PG8_SCHED; PG8_LDA(At, 1, 0); PG8_STAGE(PG8_SA(0, 1), a2 + hstep, voffA);
            PG8_WAIT_L(8); PG8_BAR; PG8_WAIT_L(0); PG8_MMA(0, 0, At, B0); PG8_BAR; PG8_SCHED;
            PG8_LDB(B1, 1, 1); PG8_STAGE(PG8_SB(1, 0), b3, voffB);
            PG8_BAR; PG8_WAIT_L(0); PG8_MMA(0, 1, At, B1); PG8_BAR;
            PG8_LDA(At, 1, 1); PG8_STAGE(PG8_SA(1, 0), a3, voffA);
            PG8_BAR; PG8_WAIT_L(0); PG8_MMA(1, 0, At, B0); PG8_BAR; PG8_SCHED;
            PG8_STAGE(PG8_SB(1, 1), b3 + hstep, voffB);
            PG8_WAIT_V(6); PG8_BAR; PG8_MMA(1, 1, At, B1); PG8_BAR;
        }
        PG8_STAMP();
        if constexpr (!Epi::AFTER_DRAIN) { E(acc, cur, wr, wc, fr, fq); S.done(cur); }
        PG8_STAMP();
        if (!has_next) break;
#pragma unroll
        for (int a = 0; a < 2; ++a)
#pragma unroll
            for (int b = 0; b < 2; ++b)
#pragma unroll
                for (int m = 0; m < 4; ++m)
#pragma unroll
                    for (int n = 0; n < 2; ++n) acc[a][b][m][n] = (f32x4){0.f, 0.f, 0.f, 0.f};
        cur = nxt; cA = nA; cB = nB; ++ui;
    }
    PG8_WAIT_V(0);
    if (wr == 0) PG8_BAR;
    PG8_BAR;
    if constexpr (Epi::AFTER_DRAIN) { E.fused(acc, cur, wr, wc, fr, fq, lds, wid, lane); S.done(cur); }
    PG8_STAMP();
    if (STAMP && wid == 0) { stamps[lane] = lane < nts ? (((unsigned long long)(unsigned)ts_hi << 32) | (unsigned)ts_lo) : 0ull;
        if (lane == 62) stamps[62] = rt_entry; if (lane == 63) stamps[63] = (unsigned long long)wall_clock64(); }
#undef PG8_STAMP
#undef PG8_SA
#undef PG8_SB
#undef PG8_STAGE
#undef PG8_LDA
#undef PG8_LDB
#undef PG8_MMA
#undef PG8_WAIT_V
#undef PG8_WAIT_L
#undef PG8_BAR
#undef PG8_SCHED
}
}

#define GAS __attribute__((address_space(1)))
#define LAS __attribute__((address_space(3)))
typedef unsigned short bf16;
typedef float f32x4 __attribute__((ext_vector_type(4)));
typedef unsigned u32x4 __attribute__((ext_vector_type(4)));
typedef unsigned u32x2 __attribute__((ext_vector_type(2)));

constexpr int D = 1024, NLAT = 16384, NCTX = 256, T = NLAT + NCTX, DEPTH = 4;
constexpr int IN_W = 5904, PJ = 5888;
constexpr int U0 = 0, Z0 = 512, XB0 = 1024, Q0 = 2048, K0 = 2560, V0 = 2688, GT0 = 2816;
constexpr int NE = 16, ESLOTS = 2304, CAP_L = 2048, CAP_C = 32;
constexpr int NCH = 130;
constexpr float EPS = 1e-6f;
constexpr int NWAVES = 8, NTHR = 512;
constexpr int LDS_BYTES = 155648;
constexpr int MISC_OFF = LDS_BYTES - 1024 + 512;
constexpr int NPH_LAYER = 14, NPHASES = 1 + DEPTH * NPH_LAYER + 1;

constexpr size_t al256(size_t x) { return (x + 255) & ~(size_t)255; }
constexpr size_t WS_CTL = 0, CTL_BYTES = 1u << 20;
constexpr size_t WS_MOD = WS_CTL + CTL_BYTES;
constexpr size_t WS_XC = al256(WS_MOD + (size_t)DEPTH * 2 * 6144 * 4);
constexpr size_t WS_WIN = al256(WS_XC + (size_t)NCTX * D * 4);
constexpr size_t WS_WGLU = al256(WS_WIN + (size_t)PJ * D * 2);
constexpr size_t WS_WBR = al256(WS_WGLU + (size_t)512 * 512 * 2);
constexpr size_t WS_WOUT = al256(WS_WBR + (size_t)3 * 1024 * 512 * 2);
constexpr size_t WS_WUP = al256(WS_WOUT + (size_t)1024 * 1024 * 2);
constexpr size_t WS_WDN = al256(WS_WUP + (size_t)NE * 2048 * 1024 * 2);
constexpr size_t WS_H = al256(WS_WDN + (size_t)NE * 1024 * 1024 * 2);
constexpr size_t WS_PROJ = al256(WS_H + (size_t)T * D * 2);
constexpr size_t WS_XE = WS_PROJ;
constexpr size_t WS_HID = al256(WS_XE + (size_t)NE * ESLOTS * D * 2);
constexpr size_t WS_DT = al256(WS_PROJ + (size_t)T * PJ * 2);
constexpr size_t WS_CV = al256(WS_DT + (size_t)T * 16 * 4);
constexpr size_t WS_S5E = al256(WS_CV + (size_t)T * 1024 * 2);
constexpr size_t WS_S5H = al256(WS_S5E + (size_t)2 * 32 * NCH * 128 * 4);
constexpr size_t WS_YD = al256(WS_S5H + (size_t)2 * 32 * NCH * 128 * 4);
constexpr size_t WS_SA = al256(WS_YD + (size_t)2 * T * 512 * 4);
constexpr size_t WS_Y3 = al256(WS_SA + (size_t)T * 512 * 2);
constexpr size_t WS_PM = al256(WS_Y3 + (size_t)3 * T * 512 * 2);
constexpr size_t WS_MB = al256(WS_PM + (size_t)T * D * 4);
constexpr size_t WS_YE = WS_PM;
constexpr size_t WS_AFFT = al256(WS_MB + (size_t)T * D * 2);
constexpr size_t WS_IDX = al256(WS_AFFT + (size_t)NE * T * 4);
constexpr size_t WS_GSEL = al256(WS_IDX + (size_t)NE * ESLOTS * 4);
constexpr size_t WS_INV = al256(WS_GSEL + (size_t)NE * ESLOTS * 4);
constexpr size_t WS_DEC = al256(WS_INV + (size_t)T * 16 * 4);
constexpr size_t WS_S5BB = al256(WS_DEC + (size_t)2 * NCH * 8 * 4);
constexpr size_t WS_S5CC = al256(WS_S5BB + (size_t)2 * 32 * 128 * 32 * 2);
constexpr size_t WS_S5AB = al256(WS_S5CC + (size_t)2 * 32 * 16 * 128 * 2);
constexpr size_t WS_END = al256(WS_S5AB + (size_t)2 * 32 * 64 * 2 * 4);
constexpr size_t WS_SST = WS_YD;
constexpr size_t WS_HIN = WS_PM;
constexpr size_t WS_YS = al256(WS_HIN + (size_t)2 * NCH * 8 * 8192 * 2);
static_assert(WS_YS + (size_t)T * 512 * 2 <= WS_AFFT, "HIN|YS overlay fits PM|MB");
static_assert(WS_HID + (size_t)NE * ESLOTS * D * 2 <= WS_DT, "XE|HID overlay fits PROJ");
static_assert(WS_YE + (size_t)NE * ESLOTS * D * 2 <= WS_AFFT, "YE overlay fits PM|MB");
static_assert(WS_END < (size_t)1000 * 1024 * 1024, "workspace");
constexpr int CW_BAR = 4096;

__device__ __forceinline__ float bf2f(unsigned b) { return __uint_as_float(b << 16); }
__device__ __forceinline__ float bflo(unsigned w) { return __uint_as_float(w << 16); }
__device__ __forceinline__ float bfhi(unsigned w) { return __uint_as_float(w & 0xffff0000u); }
__device__ __forceinline__ unsigned f2bf(float f) { unsigned u = __float_as_uint(f); u += 0x7FFFu + ((u >> 16) & 1u); return u >> 16; }
__device__ __forceinline__ unsigned pk2(float lo, float hi) { return f2bf(lo) | (f2bf(hi) << 16); }
__device__ __forceinline__ float wsum(float v) {
#pragma unroll
    for (int o = 1; o < 64; o <<= 1) v += __shfl_xor(v, o);
    return v;
}
__device__ __forceinline__ float wmaxf(float v) {
#pragma unroll
    for (int o = 1; o < 64; o <<= 1) v = fmaxf(v, __shfl_xor(v, o));
    return v;
}
__device__ __forceinline__ float silu_f(float x) { return x / (1.f + expf(-x)); }
__device__ __forceinline__ float sigmoid_f(float x) { return 1.f / (1.f + expf(-x)); }
__device__ __forceinline__ float softplus_f(float x) { return x > 20.f ? x : log1pf(expf(x)); }
__device__ __forceinline__ float gelu_tanh_f(float x) { const float u = 0.7978845608028654f * (x + 0.044715f * x * x * x); return 0.5f * x * (1.f + tanhf(u)); }
#define LDS_FENCE() asm volatile("s_waitcnt lgkmcnt(0)" ::: "memory")
__device__ __forceinline__ int scan_row(int d, int s) { return d == 0 ? s : (s < NCTX ? (NCTX - 1 - s) : (T + NCTX - 1 - s)); }

namespace pg8 {
struct EpiStoreBf16 {
    static constexpr bool PERM = true, AFTER_DRAIN = false, MIDHOOK = false;
    bf16_t* O; int ldc; int sig_tile;
    __device__ __forceinline__ void operator()(const f32x4 (&acc)[2][2][4][2], const Unit& u, int wr, int wc, int fr, int fq) const {
        const int row0 = u.pm * BM + wr * 64 + fr, col0 = u.pn * BM + wc * 32 + 8 * fq; const bool sg = u.pn >= sig_tile;
#pragma unroll
        for (int ai = 0; ai < 2; ++ai)
#pragma unroll
            for (int m = 0; m < 4; ++m) { bf16_t* rowp = O + (size_t)(row0 + ai * HALF + m * 16) * ldc + col0;
#pragma unroll
                for (int bj = 0; bj < 2; ++bj) { f32x4 v0 = acc[ai][bj][m][0], v1 = acc[ai][bj][m][1];
                    if (sg) {
#pragma unroll
                        for (int q = 0; q < 4; ++q) { v0[q] = __builtin_amdgcn_rcpf(1.f + __expf(-v0[q])); v1[q] = __builtin_amdgcn_rcpf(1.f + __expf(-v1[q])); } }
                    u32x4 w; w.x = cvt_pk_bf16(v0[0], v0[1]); w.y = cvt_pk_bf16(v0[2], v0[3]); w.z = cvt_pk_bf16(v1[0], v1[1]); w.w = cvt_pk_bf16(v1[2], v1[3]);
                    *(u32x4*)(rowp + bj * HALF) = w; } }
    }
};
struct EpiGlu {
    static constexpr bool PERM = true, AFTER_DRAIN = false, MIDHOOK = false;
    const bf16_t* A; const float* bias; bf16_t* O;
    __device__ __forceinline__ void operator()(const f32x4 (&acc)[2][2][4][2], const Unit& u, int wr, int wc, int fr, int fq) const {
        const int row0 = u.pm * BM + wr * 64 + fr, col0 = u.pn * BM + wc * 32 + 8 * fq;
#pragma unroll
        for (int ai = 0; ai < 2; ++ai)
#pragma unroll
            for (int m = 0; m < 4; ++m) { const size_t ro = (size_t)(row0 + ai * HALF + m * 16) * 512 + col0;
#pragma unroll
                for (int bj = 0; bj < 2; ++bj) { const f32x4 v0 = acc[ai][bj][m][0], v1 = acc[ai][bj][m][1];
                    const u32x4 a = *(const u32x4*)(A + ro + bj * HALF);
                    const f32x4 b0 = *(const f32x4*)(bias + col0 + bj * HALF), b1 = *(const f32x4*)(bias + col0 + bj * HALF + 4);
                    float o[8];
                    o[0] = bflo(a.x) * sigmoid_f(v0[0] + b0[0]); o[1] = bfhi(a.x) * sigmoid_f(v0[1] + b0[1]);
                    o[2] = bflo(a.y) * sigmoid_f(v0[2] + b0[2]); o[3] = bfhi(a.y) * sigmoid_f(v0[3] + b0[3]);
                    o[4] = bflo(a.z) * sigmoid_f(v1[0] + b1[0]); o[5] = bfhi(a.z) * sigmoid_f(v1[1] + b1[1]);
                    o[6] = bflo(a.w) * sigmoid_f(v1[2] + b1[2]); o[7] = bfhi(a.w) * sigmoid_f(v1[3] + b1[3]);
                    u32x4 w; w.x = cvt_pk_bf16(o[0], o[1]); w.y = cvt_pk_bf16(o[2], o[3]); w.z = cvt_pk_bf16(o[4], o[5]); w.w = cvt_pk_bf16(o[6], o[7]);
                    *(u32x4*)(O + (size_t)(row0 + ai * HALF + m * 16) * 1536 + col0 + bj * HALF) = w; } }
    }
};
struct RowOffOrder {
    StaticOrder b; int off;
    __device__ __forceinline__ void init(int M, int N, int G, int c, int off_) { b.init(M, N, G, c); off = off_; }
    __device__ __forceinline__ bool next(int i, Unit& u) const { if (!b.next(i, u)) return false; u.pm += off; return true; }
    __device__ __forceinline__ void a_ready(const Unit&) const {}
    __device__ __forceinline__ void done(const Unit&) const {}
};
struct EpiMerge {
    static constexpr bool PERM = true, AFTER_DRAIN = false, MIDHOOK = true;
    const bf16_t* proj; bf16_t* MB;
    __device__ __forceinline__ void mid(f32x4 (&acc)[2][2][4][2], const Unit& u, int seg, int wr, int wc, int fr, int fq) const {
        const unsigned base = (unsigned)((u.pm * BM + wr * 64 + fr) * PJ + GT0 + (seg - 1) * 1024 + u.pn * BM + wc * 32 + 8 * fq) * 2u;
        const char* pb = (const char*)proj;
#pragma unroll
        for (int ai = 0; ai < 2; ++ai)
#pragma unroll
            for (int m = 0; m < 4; ++m) {
                u32x4 ga[2], gb[2];
#pragma unroll
                for (int bj = 0; bj < 2; ++bj) { const unsigned o = base + (unsigned)(((ai * HALF + m * 16) * PJ + bj * HALF) * 2);
                    ga[bj] = *(const u32x4*)(pb + o); gb[bj] = *(const u32x4*)(pb + o + 2048u); }
#pragma unroll
                for (int bj = 0; bj < 2; ++bj) { const u32x4 a = ga[bj], b = gb[bj];
                    f32x4& v0 = acc[ai][bj][m][0]; f32x4& v1 = acc[ai][bj][m][1];
                    v0[0] *= bflo(a.x) * __builtin_amdgcn_rcpf(bflo(b.x)); v0[1] *= bfhi(a.x) * __builtin_amdgcn_rcpf(bfhi(b.x));
                    v0[2] *= bflo(a.y) * __builtin_amdgcn_rcpf(bflo(b.y)); v0[3] *= bfhi(a.y) * __builtin_amdgcn_rcpf(bfhi(b.y));
                    v1[0] *= bflo(a.z) * __builtin_amdgcn_rcpf(bflo(b.z)); v1[1] *= bfhi(a.z) * __builtin_amdgcn_rcpf(bfhi(b.z));
                    v1[2] *= bflo(a.w) * __builtin_amdgcn_rcpf(bflo(b.w)); v1[3] *= bfhi(a.w) * __builtin_amdgcn_rcpf(bfhi(b.w)); }
                if (m & 1) asm volatile("" ::: "memory");
            }
    }
    __device__ __forceinline__ void operator()(const f32x4 (&acc)[2][2][4][2], const Unit& u, int wr, int wc, int fr, int fq) const {
        const int row0 = u.pm * BM + wr * 64 + fr, col0 = u.pn * BM + wc * 32 + 8 * fq;
#pragma unroll
        for (int ai = 0; ai < 2; ++ai)
#pragma unroll
            for (int m = 0; m < 4; ++m) { const int row = row0 + ai * HALF + m * 16;
#pragma unroll
                for (int bj = 0; bj < 2; ++bj) { const f32x4 v0 = acc[ai][bj][m][0], v1 = acc[ai][bj][m][1]; const int col = col0 + bj * HALF;
                    const u32x4 g = *(const u32x4*)(proj + (size_t)row * PJ + GT0 + 2048 + col);
                    u32x4 w; w.x = cvt_pk_bf16(bflo(g.x) * v0[0], bfhi(g.x) * v0[1]); w.y = cvt_pk_bf16(bflo(g.y) * v0[2], bfhi(g.y) * v0[3]);
                    w.z = cvt_pk_bf16(bflo(g.z) * v1[0], bfhi(g.z) * v1[1]); w.w = cvt_pk_bf16(bflo(g.w) * v1[2], bfhi(g.w) * v1[3]);
                    *(u32x4*)(MB + (size_t)row * 1024 + col) = w; } }
    }
};
struct EpiResid {
    static constexpr bool PERM = false, AFTER_DRAIN = false, MIDHOOK = false;
    float* XL; float* XC; const float* g_lat; const float* g_ctx;
    __device__ __forceinline__ void operator()(const f32x4 (&acc)[2][2][4][2], const Unit& u, int wr, int wc, int fr, int fq) const {
        const bool isc = (u.pm == 0);
        float* base = isc ? XC : (XL - (size_t)NCTX * D); const float* gv = isc ? g_ctx : g_lat;
        const int row0 = u.pm * BM + wr * 64 + fr, col0 = u.pn * BM + wc * 32 + 4 * fq;
#pragma unroll
        for (int ai = 0; ai < 2; ++ai)
#pragma unroll
            for (int m = 0; m < 4; ++m) { float* rowp = base + (size_t)(row0 + ai * HALF + m * 16) * D + col0;
#pragma unroll
                for (int bj = 0; bj < 2; ++bj)
#pragma unroll
                    for (int n = 0; n < 2; ++n) { float* pp = rowp + bj * HALF + n * 16; const f32x4 g = *(const f32x4*)(gv + col0 + bj * HALF + n * 16);
                        f32x4 x = *(const f32x4*)pp; x += g * acc[ai][bj][m][n]; *(f32x4*)pp = x; } }
    }
};
struct ExpertOrder {
    int G, c, nnt, nmt;
    __device__ __forceinline__ bool next(int i, Unit& u) const { const int L = i * G + c; if (L >= NE * nmt * nnt) return false; const int e = L / (nmt * nnt), rem = L % (nmt * nnt); u.pm = e * 9 + rem % nmt; u.pn = e * nnt + rem / nmt; return true; }
    __device__ __forceinline__ void a_ready(const Unit&) const {}
    __device__ __forceinline__ void done(const Unit&) const {}
};
struct EpiSwiGlu {
    static constexpr bool PERM = true, AFTER_DRAIN = false, MIDHOOK = false;
    bf16_t* HID;
    __device__ __forceinline__ void operator()(const f32x4 (&acc)[2][2][4][2], const Unit& u, int wr, int wc, int fr, int fq) const {
        const int row0 = u.pm * BM + wr * 64 + fr, col0 = (u.pn & 7) * 128 + wc * 32 + 8 * fq;
#pragma unroll
        for (int ai = 0; ai < 2; ++ai)
#pragma unroll
            for (int m = 0; m < 4; ++m) { const f32x4 g0 = acc[ai][0][m][0], g1 = acc[ai][0][m][1], u0 = acc[ai][1][m][0], u1 = acc[ai][1][m][1];
                u32x4 w;
                w.x = cvt_pk_bf16(silu_f(g0[0]) * u0[0], silu_f(g0[1]) * u0[1]); w.y = cvt_pk_bf16(silu_f(g0[2]) * u0[2], silu_f(g0[3]) * u0[3]);
                w.z = cvt_pk_bf16(silu_f(g1[0]) * u1[0], silu_f(g1[1]) * u1[1]); w.w = cvt_pk_bf16(silu_f(g1[2]) * u1[2], silu_f(g1[3]) * u1[3]);
                *(u32x4*)(HID + (size_t)(row0 + ai * HALF + m * 16) * 1024 + col0) = w; }
    }
};
struct EpiDown {
    static constexpr bool PERM = true, AFTER_DRAIN = false, MIDHOOK = false;
    bf16_t* YE; const float* gsel;
    __device__ __forceinline__ void operator()(const f32x4 (&acc)[2][2][4][2], const Unit& u, int wr, int wc, int fr, int fq) const {
        const int row0 = u.pm * BM + wr * 64 + fr, col0 = (u.pn & 3) * BM + wc * 32 + 8 * fq;
#pragma unroll
        for (int ai = 0; ai < 2; ++ai)
#pragma unroll
            for (int m = 0; m < 4; ++m) { const int row = row0 + ai * HALF + m * 16; const float gs = gsel[row];
#pragma unroll
                for (int bj = 0; bj < 2; ++bj) { const f32x4 v0 = acc[ai][bj][m][0] * gs, v1 = acc[ai][bj][m][1] * gs;
                    u32x4 w; w.x = cvt_pk_bf16(v0[0], v0[1]); w.y = cvt_pk_bf16(v0[2], v0[3]); w.z = cvt_pk_bf16(v1[0], v1[1]); w.w = cvt_pk_bf16(v1[2], v1[3]);
                    *(u32x4*)(YE + (size_t)row * 1024 + col0 + bj * HALF) = w; } }
    }
};
}
#define XB_TMO      128
#define XB_XCNT(j)  (256  + 64 * (j))
#define XB_XSUB(j)  (1280 + 64 * (j))
#define XB_XGEN(j)  (2304 + 64 * (j))
#define XB_TOP      3328
#define XB_TOPGEN   3392
#define XCD_BAR_WORDS 3456
#define XB_SPIN_CAP (1u << 18)
#define LAS __attribute__((address_space(3)))

__device__ __forceinline__ unsigned xb_ld(unsigned* p)              { return __hip_atomic_load(p, __ATOMIC_RELAXED, __HIP_MEMORY_SCOPE_AGENT); }
__device__ __forceinline__ unsigned xb_add(unsigned* p, unsigned v) { return __hip_atomic_fetch_add(p, v, __ATOMIC_RELAXED, __HIP_MEMORY_SCOPE_AGENT); }
__device__ __forceinline__ unsigned xb_xcc_id() { return (unsigned)__builtin_amdgcn_s_getreg((3 << 11) | 20) & 0xFu; }
#define XB_SPIN(cond, bar) do { unsigned _sp = 0; while (cond) { __builtin_amdgcn_s_sleep(1); \
    if ((++_sp & 255u) == 0u) { if (xb_ld(&(bar)[XB_TMO])) break; if (_sp > XB_SPIN_CAP) { atomicAdd(&(bar)[XB_TMO], 1u); break; } } } } while (0)

struct XcdBarrier {
    unsigned* bar; unsigned x;
    volatile LAS unsigned* st;
};

__device__ __forceinline__ XcdBarrier xcd_barrier_post(unsigned* bar, volatile LAS unsigned* st) {
    XcdBarrier b; b.bar = bar; b.x = xb_xcc_id(); b.st = st;
    if (threadIdx.x == 0) (void)xb_add(&bar[XB_XCNT(b.x)], 1u);
    return b;
}
__device__ __forceinline__ void xcd_barrier_complete(unsigned* bar, unsigned x, unsigned& nloc, unsigned& nx) {
    const unsigned G = gridDim.x * gridDim.y * gridDim.z;
    unsigned sum, cnt, mine, sp = 0u;
    for (;;) {
        sum = 0u; cnt = 0u; mine = 0u;
#pragma unroll
        for (unsigned j = 0; j < 16; ++j) { const unsigned c = xb_ld(&bar[XB_XCNT(j)]); sum += c; cnt += (c > 0u) ? 1u : 0u; mine = (j == x) ? c : mine; }
        if (sum == G) break;
        __builtin_amdgcn_s_sleep(1);
        if ((++sp & 255u) == 0u) { if (xb_ld(&bar[XB_TMO])) break; if (sp > XB_SPIN_CAP) { atomicAdd(&bar[XB_TMO], 1u); break; } }
    }
    nloc = mine > 0u ? mine : 1u; nx = cnt > 0u ? cnt : 1u;
}

__device__ __forceinline__ void xcd_barrier(const XcdBarrier& b) {
    asm volatile("s_waitcnt vmcnt(0)" ::: "memory");
    __syncthreads();
    if (threadIdx.x == 0) {
        unsigned* bar = b.bar;
        __builtin_amdgcn_s_waitcnt(0);
        unsigned nloc = b.st[0], nx = b.st[1];
        if (nloc == 0u) { xcd_barrier_complete(bar, b.x, nloc, nx); b.st[0] = nloc; b.st[1] = nx; }
        const unsigned old = xb_add(&bar[XB_XSUB(b.x)], 1u);
        const unsigned gen = old / nloc;
        if (old + 1u == (gen + 1u) * nloc) {
            __builtin_amdgcn_fence(__ATOMIC_RELEASE, "agent");
            asm volatile("s_waitcnt vmcnt(0)" ::: "memory");
            const unsigned og = xb_add(&bar[XB_TOP], 1u);
            const unsigned tg = og / nx;
            if (og + 1u == (tg + 1u) * nx) xb_add(&bar[XB_TOPGEN], 1u);
            else XB_SPIN(xb_ld(&bar[XB_TOPGEN]) == tg, bar);
            __builtin_amdgcn_fence(__ATOMIC_ACQUIRE, "agent");
            xb_add(&bar[XB_XGEN(b.x)], 1u);
            asm volatile("s_waitcnt vmcnt(0)" ::: "memory");
        } else {
            XB_SPIN(xb_ld(&bar[XB_XGEN(b.x)]) == gen, bar);
            __builtin_amdgcn_fence(__ATOMIC_ACQUIRE, "agent");
            asm volatile("s_waitcnt vmcnt(0)" ::: "memory");
        }
    }
    __syncthreads();
}


struct P {
    const float *x, *c, *ctx, *c_ctx, *w_mod, *b_mod, *norm1_g, *norm2_g, *w_in, *lam_re, *lam_im, *log_dt, *b_re, *b_im, *c_re, *c_im, *s5_d, *w_glu, *b_glu,
        *conv_w, *conv_b, *a_log, *dt_bias, *ssd_d, *ssd_norm_g, *sink, *w_branch, *w_out, *w_router, *w_eg, *w_eu, *w_ed, *final_g;
    float* XL;
    float *MOD, *XC, *DT, *S5E, *S5H, *YD, *PM, *AFFT, *GSEL;
    bf16 *WIN, *WGLU, *WBR, *WOUT, *WUP, *WDN, *H, *PROJ, *XE, *HID, *CV, *SA, *Y3, *MB, *YE;
    int *IDX, *INV;
    int tid, lane, wave, bid, G;
};


constexpr int PTAB_OFF = LDS_BYTES - 1024;
__device__ __forceinline__ unsigned long long ld_tab(volatile LAS unsigned* t, int k) {
    const unsigned lo = __builtin_amdgcn_readfirstlane(t[2 * k]), hi = __builtin_amdgcn_readfirstlane(t[2 * k + 1]);
    return ((unsigned long long)hi << 32) | lo;
}
__device__ __forceinline__ void build_P(P& p, LAS unsigned char* lds) {
    int tid_l = threadIdx.x, bid_l = blockIdx.x, g_l = gridDim.x;
    asm volatile("" : "+v"(tid_l), "+s"(bid_l), "+s"(g_l));
    p.tid = tid_l; p.lane = p.tid & 63; p.wave = __builtin_amdgcn_readfirstlane(p.tid >> 6); p.bid = bid_l; p.G = g_l;
    unsigned tbase = (unsigned)(size_t)(lds + PTAB_OFF); asm volatile("" : "+v"(tbase));
    volatile LAS unsigned* tb = (volatile LAS unsigned*)(size_t)tbase;
#define INP(k) ((const float*)ld_tab(tb, k))
    p.x = INP(0); p.c = INP(1); p.ctx = INP(2); p.c_ctx = INP(3); p.w_mod = INP(4); p.b_mod = INP(5); p.norm1_g = INP(6); p.norm2_g = INP(7);
    p.w_in = INP(8); p.lam_re = INP(9); p.lam_im = INP(10); p.log_dt = INP(11); p.b_re = INP(12); p.b_im = INP(13); p.c_re = INP(14); p.c_im = INP(15);
    p.s5_d = INP(16); p.w_glu = INP(17); p.b_glu = INP(18); p.conv_w = INP(19); p.conv_b = INP(20); p.a_log = INP(21); p.dt_bias = INP(22); p.ssd_d = INP(23);
    p.ssd_norm_g = INP(24); p.sink = INP(25); p.w_branch = INP(26); p.w_out = INP(27); p.w_router = INP(28); p.w_eg = INP(29); p.w_eu = INP(30); p.w_ed = INP(31);
    p.final_g = INP(32);
#undef INP
    p.XL = (float*)ld_tab(tb, 33);
    unsigned char* ws = (unsigned char*)ld_tab(tb, 34);
    p.MOD = (float*)(ws + WS_MOD); p.XC = (float*)(ws + WS_XC); p.DT = (float*)(ws + WS_DT); p.S5E = (float*)(ws + WS_S5E); p.S5H = (float*)(ws + WS_S5H); p.YD = (float*)(ws + WS_YD);
    p.PM = (float*)(ws + WS_PM); p.AFFT = (float*)(ws + WS_AFFT); p.GSEL = (float*)(ws + WS_GSEL);
    p.WIN = (bf16*)(ws + WS_WIN); p.WGLU = (bf16*)(ws + WS_WGLU); p.WBR = (bf16*)(ws + WS_WBR); p.WOUT = (bf16*)(ws + WS_WOUT); p.WUP = (bf16*)(ws + WS_WUP); p.WDN = (bf16*)(ws + WS_WDN);
    p.H = (bf16*)(ws + WS_H); p.PROJ = (bf16*)(ws + WS_PROJ); p.XE = (bf16*)(ws + WS_XE); p.HID = (bf16*)(ws + WS_HID); p.CV = (bf16*)(ws + WS_CV); p.SA = (bf16*)(ws + WS_SA);
    p.Y3 = (bf16*)(ws + WS_Y3); p.MB = (bf16*)(ws + WS_MB); p.YE = (bf16*)(ws + WS_YE);
    p.IDX = (int*)(ws + WS_IDX); p.INV = (int*)(ws + WS_INV);
}
__device__ __forceinline__ void phase_mod(const P& p, LAS unsigned char* lds) {
    LAS float* sc = (LAS float*)lds;
    LAS float* part = sc + 2048;
    for (int i = p.tid; i < 1024; i += NTHR) { sc[i] = silu_f(p.c[i]); sc[1024 + i] = silu_f(p.c_ctx[i]); }
    __syncthreads();
    for (int it = p.bid; it < DEPTH * 48; it += p.G) {
        const int l = it / 48, cb = it % 48, c0 = cb * 128 + 2 * p.lane;
        const float* W = p.w_mod + (size_t)l * 1024 * 6144 + c0;
        float a00 = 0.f, a01 = 0.f, a10 = 0.f, a11 = 0.f;
        const int kb = p.wave * 128;
#pragma unroll 8
        for (int k = kb; k < kb + 128; ++k) { const float2 w = *(const float2*)(W + (size_t)k * 6144); const float s0 = sc[k], s1 = sc[1024 + k];
            a00 += s0 * w.x; a01 += s0 * w.y; a10 += s1 * w.x; a11 += s1 * w.y; }
        part[(p.wave * 2 + 0) * 128 + 2 * p.lane] = a00; part[(p.wave * 2 + 0) * 128 + 2 * p.lane + 1] = a01;
        part[(p.wave * 2 + 1) * 128 + 2 * p.lane] = a10; part[(p.wave * 2 + 1) * 128 + 2 * p.lane + 1] = a11;
        __syncthreads();
        if (p.tid < 256) { const int s = p.tid >> 7, col = p.tid & 127; float r = p.b_mod[l * 6144 + cb * 128 + col];
#pragma unroll
            for (int w = 0; w < 8; ++w) r += part[(w * 2 + s) * 128 + col];
            p.MOD[(size_t)(l * 2 + s) * 6144 + cb * 128 + col] = r; }
        __syncthreads();
    }
}

__device__ __forceinline__ void tr_item(const float* src, int ldw, int K, bf16* dst, int kb, LAS float* scr, int lane) {
    const int k0 = 64 * kb, kr = lane >> 4, nq = lane & 15;
    f32x4 v[16];
#pragma unroll
    for (int i = 0; i < 16; ++i) v[i] = *(const f32x4*)(src + (size_t)(k0 + 4 * i + kr) * ldw + 4 * nq);
#pragma unroll
    for (int i = 0; i < 16; ++i) { const int k = 4 * i + kr, c = (k >> 3) & 7; *(LAS f32x4*)(scr + k * 64 + 4 * (nq ^ c)) = v[i]; }
    LDS_FENCE();
    const int c = lane & 7;
#pragma unroll
    for (int j = 0; j < 8; ++j) { const int n = (lane >> 3) + 8 * j; const LAS float* s = scr + (8 * c) * 64 + (n ^ (c << 2));
        u32x4 o; o.x = pk2(s[0 * 64], s[1 * 64]); o.y = pk2(s[2 * 64], s[3 * 64]); o.z = pk2(s[4 * 64], s[5 * 64]); o.w = pk2(s[6 * 64], s[7 * 64]);
        *(u32x4*)(dst + (size_t)n * K + k0 + 8 * c) = o; }
    LDS_FENCE();
}
__device__ __forceinline__ void convert_weights(const P& p, int l, LAS unsigned char* lds) {
    LAS float* scr = (LAS float*)(lds + p.wave * 16384);
    const int gw = p.bid * NWAVES + p.wave, NGW = p.G * NWAVES;
    constexpr int I_A = 32 * 16, I_B = 60 * 16, I_GLU = 8 * 8, I_BR = 3 * 16 * 8, I_OUT = 16 * 16, I_E = 16 * 16 * 16;
    constexpr int NIT = I_A + I_B + I_GLU + I_BR + I_OUT + 3 * I_E;
    const float* win = p.w_in + (size_t)l * 1024 * IN_W;
    for (int it = gw; it < NIT; it += NGW) {
        int r = it;
        if (r < I_A) { const int nb = r >> 4, kb = r & 15; tr_item(win + 64 * nb, IN_W, 1024, p.WIN + (size_t)(64 * nb) * 1024, kb, scr, p.lane); continue; } r -= I_A;
        if (r < I_B) { const int nb = r >> 4, kb = r & 15; tr_item(win + 2064 + 64 * nb, IN_W, 1024, p.WIN + (size_t)(2048 + 64 * nb) * 1024, kb, scr, p.lane); continue; } r -= I_B;
        if (r < I_GLU) { const int nb = r >> 3, kb = r & 7; tr_item(p.w_glu + (size_t)l * 512 * 512 + 64 * nb, 512, 512, p.WGLU + (size_t)(64 * nb) * 512, kb, scr, p.lane); continue; } r -= I_GLU;
        if (r < I_BR) { const int kk = r >> 7, nb = (r >> 3) & 15, kb = r & 7;
            tr_item(p.w_branch + ((size_t)l * 3 + kk) * 512 * 1024 + 64 * nb, 1024, 1536, p.WBR + (size_t)(64 * nb) * 1536 + kk * 512, kb, scr, p.lane); continue; } r -= I_BR;
        if (r < I_OUT) { const int nb = r >> 4, kb = r & 15; tr_item(p.w_out + (size_t)l * 1024 * 1024 + 64 * nb, 1024, 1024, p.WOUT + (size_t)(64 * nb) * 1024, kb, scr, p.lane); continue; } r -= I_OUT;
        const int which = r / I_E; r -= which * I_E;
        const int e = r >> 8, nb = (r >> 4) & 15, kb = r & 15;
        const size_t eo = ((size_t)l * NE + e) * 1024 * 1024;
        if (which == 0) tr_item(p.w_eg + eo + 64 * nb, 1024, 1024, p.WUP + (size_t)(e * 2048 + 256 * (nb >> 1) + 64 * (nb & 1)) * 1024, kb, scr, p.lane);
        else if (which == 1) tr_item(p.w_eu + eo + 64 * nb, 1024, 1024, p.WUP + (size_t)(e * 2048 + 256 * (nb >> 1) + 128 + 64 * (nb & 1)) * 1024, kb, scr, p.lane);
        else tr_item(p.w_ed + eo + 64 * nb, 1024, 1024, p.WDN + (size_t)(e * 1024 + 64 * nb) * 1024, kb, scr, p.lane);
    }
}

template <int MODE> __device__ __forceinline__ void row_pass(const P& p, int l, LAS unsigned char* lds, bool with_ctx = true) {
    LAS float* W16 = (LAS float*)lds;
    if (MODE != 2) {
        const float* src = (MODE == 0) ? (p.w_in + (size_t)l * 1024 * IN_W + 2048) : (p.w_router + (size_t)l * 1024 * 16);
        const int ld = (MODE == 0) ? IN_W : 16;
        for (int i = p.tid; i < 1024 * 16; i += NTHR) { const int k = i >> 4, j = i & 15; W16[k * 20 + j] = src[(size_t)k * ld + j]; }
        __syncthreads();
    }
    const int gw = p.bid * NWAVES + p.wave, NGW = p.G * NWAVES, lane = p.lane;
    for (int row = gw + ((MODE == 2 || !with_ctx) ? NCTX : 0); row < T; row += NGW) {
        const bool isc = row < NCTX;
        float* xrow = isc ? (p.XC + (size_t)row * D) : (p.XL + (size_t)(row - NCTX) * D);
        float v[16];
        if (MODE == 0 && l == 0) { const float* s = isc ? (p.ctx + (size_t)row * D) : (p.x + (size_t)(row - NCTX) * D);
#pragma unroll
            for (int i = 0; i < 16; ++i) v[i] = s[lane + 64 * i];
        } else {
#pragma unroll
            for (int i = 0; i < 16; ++i) v[i] = xrow[lane + 64 * i];
        }
        if ((MODE == 0 && l > 0) || MODE == 2) {
            const int lp = (MODE == 2) ? (DEPTH - 1) : (l - 1);
            const float* g2 = p.MOD + (size_t)(lp * 2 + (isc ? 1 : 0)) * 6144 + 5 * D;
            float s[16];
#pragma unroll
            for (int i = 0; i < 16; ++i) s[i] = 0.f;
            for (int e = 0; e < NE; ++e) { const int slot = p.INV[(size_t)row * 16 + e];
                if (slot >= 0) { const bf16* yr = p.YE + ((size_t)e * ESLOTS + slot) * D;
#pragma unroll
                    for (int i = 0; i < 16; ++i) s[i] += bf2f(yr[lane + 64 * i]); } }
#pragma unroll
            for (int i = 0; i < 16; ++i) v[i] += g2[lane + 64 * i] * s[i];
        }
        if (MODE == 0) {
#pragma unroll
            for (int i = 0; i < 16; ++i) xrow[lane + 64 * i] = v[i];
        }
        float ss = 0.f;
#pragma unroll
        for (int i = 0; i < 16; ++i) ss += v[i] * v[i];
        const float rstd = rsqrtf(wsum(ss) * (1.f / D) + EPS);
        if (MODE == 2) {
#pragma unroll
            for (int i = 0; i < 16; ++i) xrow[lane + 64 * i] = v[i] * rstd * p.final_g[lane + 64 * i];
            continue;
        }
        const float* gam = (MODE == 0 ? p.norm1_g : p.norm2_g) + (size_t)l * D;
        const float* md = p.MOD + (size_t)(l * 2 + (isc ? 1 : 0)) * 6144 + (MODE == 0 ? 0 : 3 * D);
        bf16* hrow = p.H + (size_t)row * D;
        float acc[16];
#pragma unroll
        for (int j = 0; j < 16; ++j) acc[j] = 0.f;
#pragma unroll
        for (int i = 0; i < 16; ++i) { const int k = lane + 64 * i;
            const float hv = v[i] * rstd * gam[k] * (1.f + md[D + k]) + md[k];
            hrow[k] = (bf16)f2bf(hv);
            const LAS f32x4* wr = (const LAS f32x4*)(W16 + k * 20);
            const f32x4 w0 = wr[0], w1 = wr[1], w2 = wr[2], w3 = wr[3];
            acc[0] += hv * w0[0]; acc[1] += hv * w0[1]; acc[2] += hv * w0[2]; acc[3] += hv * w0[3];
            acc[4] += hv * w1[0]; acc[5] += hv * w1[1]; acc[6] += hv * w1[2]; acc[7] += hv * w1[3];
            acc[8] += hv * w2[0]; acc[9] += hv * w2[1]; acc[10] += hv * w2[2]; acc[11] += hv * w2[3];
            acc[12] += hv * w3[0]; acc[13] += hv * w3[1]; acc[14] += hv * w3[2]; acc[15] += hv * w3[3];
            if ((i & 1) == 1) asm volatile("" ::: "memory"); }
#pragma unroll
        for (int j = 0; j < 16; ++j) acc[j] = wsum(acc[j]);
        if (MODE == 0) {
            float mine = 0.f;
#pragma unroll
            for (int j = 0; j < 16; ++j) mine = (lane == j) ? acc[j] : mine;
            if (lane < 16) p.DT[(size_t)row * 16 + lane] = softplus_f(mine + p.dt_bias[l * 16 + lane]);
        } else {
            float mx = acc[0];
#pragma unroll
            for (int j = 1; j < 16; ++j) mx = fmaxf(mx, acc[j]);
            float sum = 0.f, mine = 0.f;
#pragma unroll
            for (int j = 0; j < 16; ++j) { const float e = expf(acc[j] - mx); sum += e; mine = (lane == j) ? e : mine; }
            if (lane < 16) p.AFFT[(size_t)lane * T + row] = mine / sum;
        }
    }
}

struct S5Lane { float abr, abi; float bbr[16], bbi[16]; };
__device__ __forceinline__ void s5_lane_params(const P& p, int l, int d, int g, int lane, S5Lane& o, bool withB) {
    const size_t gi = ((size_t)(l * 2 + d) * 32 + g);
    const float lr = p.lam_re[gi * 64 + lane], li = p.lam_im[gi * 64 + lane], dt = expf(p.log_dt[gi]);
    const float mag = expf(lr * dt); float sn, cs; sincosf(li * dt, &sn, &cs);
    o.abr = mag * cs; o.abi = mag * sn;
    if (withB) {
        const float den = lr * lr + li * li;
        const float fr = ((o.abr - 1.f) * lr + o.abi * li) / den, fi = (o.abi * lr - (o.abr - 1.f) * li) / den;
        const f32x4* br = (const f32x4*)(p.b_re + (gi * 64 + lane) * 16); const f32x4* bi = (const f32x4*)(p.b_im + (gi * 64 + lane) * 16);
#pragma unroll
        for (int q = 0; q < 4; ++q) { const f32x4 r4 = br[q], i4 = bi[q];
#pragma unroll
            for (int j = 0; j < 4; ++j) { o.bbr[4 * q + j] = fr * r4[j] - fi * i4[j]; o.bbi[4 * q + j] = fr * i4[j] + fi * r4[j]; } }
    }
}
__device__ __forceinline__ void s5_stage_u(const P& p, int r0, int g, LAS unsigned char* ub, int lane) {
#pragma unroll
    for (int j = 0; j < 4; ++j) { const int q = lane + 64 * j, i = q >> 1, half = q & 1;
        const u32x4 w = *(const u32x4*)(p.PROJ + (size_t)(r0 + i) * PJ + U0 + g * 16 + half * 8);
        *(LAS u32x4*)(ub + i * 32 + half * 16) = w; }
    LDS_FENCE();
}
__device__ __forceinline__ void s5_step(const S5Lane& s, const LAS unsigned char* ub, int i, float& hr, float& hi) {
    const u32x4 a = *(const LAS u32x4*)(ub + i * 32), b = *(const LAS u32x4*)(ub + i * 32 + 16);
    float u[16];
    u[0] = bflo(a.x); u[1] = bfhi(a.x); u[2] = bflo(a.y); u[3] = bfhi(a.y); u[4] = bflo(a.z); u[5] = bfhi(a.z); u[6] = bflo(a.w); u[7] = bfhi(a.w);
    u[8] = bflo(b.x); u[9] = bfhi(b.x); u[10] = bflo(b.y); u[11] = bfhi(b.y); u[12] = bflo(b.z); u[13] = bfhi(b.z); u[14] = bflo(b.w); u[15] = bfhi(b.w);
    float br = 0.f, bi = 0.f;
#pragma unroll
    for (int k = 0; k < 16; ++k) { br += s.bbr[k] * u[k]; bi += s.bbi[k] * u[k]; }
    const float nr = s.abr * hr - s.abi * hi + br, ni = s.abr * hi + s.abi * hr + bi;
    hr = nr; hi = ni;
}

__device__ __forceinline__ void phase_premix(const P& p, int l, LAS unsigned char* lds, bool do_rope) {
    const float* cw = p.conv_w + (size_t)l * 5 * 1024; const float* cb = p.conv_b + (size_t)l * 1024;
    for (int idx = p.bid * NTHR + p.tid; idx < T * 128; idx += p.G * NTHR) {
        const int row = idx >> 7, c8 = (idx & 127) * 8;
        const int lo = row < NCTX ? 0 : NCTX, hi = row < NCTX ? NCTX : T;
        float a[8];
        { const f32x4 b0 = *(const f32x4*)(cb + c8), b1 = *(const f32x4*)(cb + c8 + 4);
          a[0] = b0[0]; a[1] = b0[1]; a[2] = b0[2]; a[3] = b0[3]; a[4] = b1[0]; a[5] = b1[1]; a[6] = b1[2]; a[7] = b1[3]; }
#pragma unroll
        for (int j = 0; j < 5; ++j) { const int r = row + j - 2;
            if (r >= lo && r < hi) { const u32x4 xv = *(const u32x4*)(p.PROJ + (size_t)r * PJ + XB0 + c8);
                const f32x4 w0 = *(const f32x4*)(cw + j * 1024 + c8), w1 = *(const f32x4*)(cw + j * 1024 + c8 + 4);
                a[0] += w0[0] * bflo(xv.x); a[1] += w0[1] * bfhi(xv.x); a[2] += w0[2] * bflo(xv.y); a[3] += w0[3] * bfhi(xv.y);
                a[4] += w1[0] * bflo(xv.z); a[5] += w1[1] * bfhi(xv.z); a[6] += w1[2] * bflo(xv.w); a[7] += w1[3] * bfhi(xv.w); } }
        u32x4 o; o.x = pk2(silu_f(a[0]), silu_f(a[1])); o.y = pk2(silu_f(a[2]), silu_f(a[3])); o.z = pk2(silu_f(a[4]), silu_f(a[5])); o.w = pk2(silu_f(a[6]), silu_f(a[7]));
        *(u32x4*)(p.CV + (size_t)row * 1024 + c8) = o;
    }
    if (do_rope) for (int idx = p.bid * NTHR + p.tid; idx < NLAT * 160; idx += p.G * NTHR) {
        const int i = idx & 15, hh = (idx >> 4) % 10, t = idx / 160;
        bf16* base = p.PROJ + (size_t)(NCTX + t) * PJ + (hh < 8 ? Q0 + hh * 64 : K0 + (hh - 8) * 64);
        const float inv = exp2f(-(float)i * 0.83048202372184058696f);
        const float ar = (float)(t >> 6) * inv, ac = (float)(t & 63) * inv;
        float sr, cr, sc, cc; sincosf(ar, &sr, &cr); sincosf(ac, &sc, &cc);
        { const float x1 = bf2f(base[i]), x2 = bf2f(base[16 + i]); base[i] = (bf16)f2bf(x1 * cr - x2 * sr); base[16 + i] = (bf16)f2bf(x2 * cr + x1 * sr); }
        { const float x1 = bf2f(base[32 + i]), x2 = bf2f(base[48 + i]); base[32 + i] = (bf16)f2bf(x1 * cc - x2 * sc); base[48 + i] = (bf16)f2bf(x2 * cc + x1 * sc); }
    }
}

__device__ __forceinline__ void ssd_scan_naive(const P& p, int l) {
    for (int it = p.bid * 4 + p.wave; it < 1024; it += p.G * 4) {
        const int d = it >> 9, hd = (it >> 6) & 7, pp = it & 63, grp = hd >> 2;
        const float a = -expf(p.a_log[l * 16 + d * 8 + hd]);
        const int colB = 512 + grp * 128 + p.lane, colC = 768 + grp * 128 + p.lane, colX = hd * 64 + pp, dcol = d * 8 + hd;
        float h0 = 0.f, h1 = 0.f;
        for (int s0 = 0; s0 < T; s0 += 8) {
            unsigned b0[8], b1[8], c0[8], c1[8], xx[8]; float dtv[8]; int rr[8];
#pragma unroll
            for (int j = 0; j < 8; ++j) { const int r = scan_row(d, s0 + j); rr[j] = r; const bf16* cv = p.CV + (size_t)r * 1024;
                b0[j] = cv[colB]; b1[j] = cv[colB + 64]; c0[j] = cv[colC]; c1[j] = cv[colC + 64]; xx[j] = cv[colX]; dtv[j] = p.DT[(size_t)r * 16 + dcol]; }
#pragma unroll
            for (int j = 0; j < 8; ++j) { const float dec = expf(dtv[j] * a), dx = dtv[j] * bf2f(xx[j]);
                h0 = dec * h0 + dx * bf2f(b0[j]); h1 = dec * h1 + dx * bf2f(b1[j]);
                const float y = wsum(bf2f(c0[j]) * h0 + bf2f(c1[j]) * h1);
                if (p.lane == 0) p.YD[((size_t)d * T + rr[j]) * 512 + colX] = y; }
        }
    }
}
__device__ __forceinline__ void s5_carry_scan(const P& p, int l, int aw, int NAW) {
    for (int it = aw; it < 64; it += NAW) {
        const int d = it >> 5, g = it & 31;
        S5Lane s; s5_lane_params(p, l, d, g, p.lane, s, false);
        float ar = s.abr, ai = s.abi;
#pragma unroll
        for (int q = 0; q < 7; ++q) { const float nr = ar * ar - ai * ai, ni = 2.f * ar * ai; ar = nr; ai = ni; }
        float hr = 0.f, hi = 0.f;
        const float* E = p.S5E + (size_t)(d * 32 + g) * NCH * 128; float* Hn = p.S5H + (size_t)(d * 32 + g) * NCH * 128;
        for (int c = 0; c < NCH; ++c) { Hn[c * 128 + p.lane] = hr; Hn[c * 128 + 64 + p.lane] = hi;
            const float er = E[c * 128 + p.lane], ei = E[c * 128 + 64 + p.lane];
            const float nr = ar * hr - ai * hi + er, ni = ar * hi + ai * hr + ei; hr = nr; hi = ni; }
    }
}
__device__ __forceinline__ void attention_naive(const P& p, int l, int aw, int NAW, LAS float* pbuf) {
    const int lane = p.lane;
    for (int it = aw; it < T * 8; it += NAW) {
        const int row = it >> 3, hq = it & 7, kvh = hq >> 2;
        const bool isc = row < NCTX; const int t = row - NCTX;
        const int jlo = isc ? 0 : (t - 128 < 0 ? 0 : t - 128), jhi = isc ? -1 : (t + 128 > NLAT - 1 ? NLAT - 1 : t + 128);
        const int nloc = jhi - jlo + 1, nk = nloc + NCTX;
        const float sink = p.sink[l * 8 + hq];
        float q[64];
        { const u32x4* qp = (const u32x4*)(p.PROJ + (size_t)row * PJ + Q0 + hq * 64);
#pragma unroll
          for (int c = 0; c < 8; ++c) { const u32x4 w = qp[c]; q[8 * c] = bflo(w.x); q[8 * c + 1] = bfhi(w.x); q[8 * c + 2] = bflo(w.y); q[8 * c + 3] = bfhi(w.y);
              q[8 * c + 4] = bflo(w.z); q[8 * c + 5] = bfhi(w.z); q[8 * c + 6] = bflo(w.w); q[8 * c + 7] = bfhi(w.w); } }
        float sc[9]; float mx = sink;
#pragma unroll
        for (int i = 0; i < 9; ++i) { const int kk = lane + 64 * i; float s = -INFINITY;
            if (kk < nk) { const int krow = kk < nloc ? NCTX + jlo + kk : kk - nloc;
                const u32x4* kp = (const u32x4*)(p.PROJ + (size_t)krow * PJ + K0 + kvh * 64); float dot = 0.f;
#pragma unroll
                for (int c = 0; c < 8; ++c) { const u32x4 w = kp[c];
                    dot += q[8 * c] * bflo(w.x) + q[8 * c + 1] * bfhi(w.x) + q[8 * c + 2] * bflo(w.y) + q[8 * c + 3] * bfhi(w.y)
                         + q[8 * c + 4] * bflo(w.z) + q[8 * c + 5] * bfhi(w.z) + q[8 * c + 6] * bflo(w.w) + q[8 * c + 7] * bfhi(w.w); }
                s = dot * 0.125f; }
            sc[i] = s; mx = fmaxf(mx, s); }
        mx = wmaxf(mx);
        float sum = 0.f;
#pragma unroll
        for (int i = 0; i < 9; ++i) { const int kk = lane + 64 * i; const float e = (kk < nk) ? expf(sc[i] - mx) : 0.f; pbuf[kk] = e; sum += e; }
        const float den = wsum(sum) + expf(sink - mx);
        LDS_FENCE();
        float o = 0.f;
        const bf16* vb = p.PROJ + V0 + kvh * 64 + lane;
#pragma unroll 4
        for (int kk = 0; kk < nk; ++kk) { const int vrow = kk < nloc ? NCTX + jlo + kk : kk - nloc; o += pbuf[kk] * bf2f(vb[(size_t)vrow * PJ]); }
        p.Y3[((size_t)2 * T + row) * 512 + hq * 64 + lane] = (bf16)f2bf(o / den);
        LDS_FENCE();
    }
}

__device__ __forceinline__ void phase_postmix(const P& p, int l, LAS unsigned char* lds) {
    constexpr int CSH_BYTES = 2 * 2 * 16 * 68 * 4, WREG = 16640;
    LAS float* Csh = (LAS float*)lds;
    LAS unsigned char* wreg = lds + CSH_BYTES + p.wave * WREG;
    LAS unsigned char* ub = wreg;
    LAS float* Hb = (LAS float*)(wreg + 4096);
    LAS float* Yb = (LAS float*)(wreg + 4096 + 4224);
    const int lane = p.lane;
    for (int it = p.bid; it < 32 * 17; it += p.G) {
        const int g = it / 17, chunk = (it % 17) * 8 + p.wave;
        __syncthreads();
        for (int i = p.tid; i < 2 * 2 * 16 * 64; i += NTHR) { const int pq = i & 63, k = (i >> 6) & 15, ri = (i >> 10) & 1, d = i >> 11;
            const float* src = ri ? p.c_im : p.c_re; Csh[((d * 2 + ri) * 16 + k) * 68 + pq] = src[(((size_t)(l * 2 + d) * 32 + g) * 16 + k) * 64 + pq]; }
        __syncthreads();
        if (chunk < NCH) {
            const int r0 = 128 * chunk;
            s5_stage_u(p, r0, g, ub, lane);
            for (int d = 0; d < 2; ++d) {
                S5Lane s; s5_lane_params(p, l, d, g, lane, s, true);
                const int cs = (d == 0) ? chunk : (chunk < 2 ? 1 - chunk : NCH + 1 - chunk);
                const float* Hn = p.S5H + ((size_t)(d * 32 + g) * NCH + cs) * 128;
                float hr = Hn[lane], hi = Hn[64 + lane];
                const LAS float* Cr = Csh + (d * 2 + 0) * 16 * 68; const LAS float* Ci = Csh + (d * 2 + 1) * 16 * 68;
                for (int sub = 0; sub < 16; ++sub) {
#pragma unroll
                    for (int j = 0; j < 8; ++j) { const int is = sub * 8 + j; s5_step(s, ub, d == 0 ? is : 127 - is, hr, hi); Hb[j * 132 + lane] = hr; Hb[j * 132 + 64 + lane] = hi; }
                    LDS_FENCE();
#pragma unroll
                    for (int m = 0; m < 2; ++m) { const int o = lane + 64 * m, j = o >> 4, k = o & 15; float y = 0.f;
#pragma unroll
                        for (int q = 0; q < 16; ++q) { const f32x4 cr = *(const LAS f32x4*)(Cr + k * 68 + 4 * q), ci = *(const LAS f32x4*)(Ci + k * 68 + 4 * q);
                            const f32x4 xr = *(const LAS f32x4*)(Hb + j * 132 + 4 * q), xi = *(const LAS f32x4*)(Hb + j * 132 + 64 + 4 * q);
                            y += cr[0] * xr[0] + cr[1] * xr[1] + cr[2] * xr[2] + cr[3] * xr[3] - ci[0] * xi[0] - ci[1] * xi[1] - ci[2] * xi[2] - ci[3] * xi[3]; }
                        const int is = sub * 8 + j, i = (d == 0) ? is : 127 - is;
                        if (d == 0) Yb[i * 16 + k] = y; else Yb[i * 16 + k] += y; }
                    LDS_FENCE();
                }
            }
            const float* dsk = p.s5_d + (size_t)l * 512 + g * 16;
#pragma unroll
            for (int m = 0; m < 2; ++m) { const int i = lane + 64 * m;
                const u32x4 ua = *(const LAS u32x4*)(ub + i * 32), ubv = *(const LAS u32x4*)(ub + i * 32 + 16);
                float u[16];
                u[0] = bflo(ua.x); u[1] = bfhi(ua.x); u[2] = bflo(ua.y); u[3] = bfhi(ua.y); u[4] = bflo(ua.z); u[5] = bfhi(ua.z); u[6] = bflo(ua.w); u[7] = bfhi(ua.w);
                u[8] = bflo(ubv.x); u[9] = bfhi(ubv.x); u[10] = bflo(ubv.y); u[11] = bfhi(ubv.y); u[12] = bflo(ubv.z); u[13] = bfhi(ubv.z); u[14] = bflo(ubv.w); u[15] = bfhi(ubv.w);
                float a[16];
#pragma unroll
                for (int k = 0; k < 16; ++k) a[k] = gelu_tanh_f(Yb[i * 16 + k] + dsk[k] * u[k]);
                u32x4 o0, o1; o0.x = pk2(a[0], a[1]); o0.y = pk2(a[2], a[3]); o0.z = pk2(a[4], a[5]); o0.w = pk2(a[6], a[7]);
                o1.x = pk2(a[8], a[9]); o1.y = pk2(a[10], a[11]); o1.z = pk2(a[12], a[13]); o1.w = pk2(a[14], a[15]);
                bf16* dst = p.SA + (size_t)(r0 + i) * 512 + g * 16;
                *(u32x4*)dst = o0; *(u32x4*)(dst + 8) = o1; }
            LDS_FENCE();
        }
    }
}

__device__ __forceinline__ void phase_select(const P& p, LAS unsigned char* lds, bool with_ctx) {
    LAS unsigned* keys = (LAS unsigned*)lds;
    LAS unsigned* hist = keys + 16384;
    LAS unsigned* misc = hist + 256;
    const int tid = p.tid, lane = p.lane, wave = p.wave;
    for (int it = p.bid; it < (with_ctx ? 32 : 16); it += p.G) {
        const int set = it >> 4, e = it & 15;
        const int n = set ? NCTX : NLAT, cap = set ? CAP_C : CAP_L, row0 = set ? 0 : NCTX, slot0 = set ? CAP_L : 0;
        const float* src = p.AFFT + (size_t)e * T + row0;
        __syncthreads();
        for (int i = tid; i < n; i += NTHR) keys[i] = __float_as_uint(src[i]);
        unsigned prefix = 0u, mask = 0u, need = (unsigned)cap;
        for (int pass = 3; pass >= 0; --pass) {
            if (tid < 256) hist[tid] = 0u;
            __syncthreads();
            for (int i = tid; i < n; i += NTHR) { const unsigned k = keys[i]; if ((k & mask) == prefix) __hip_atomic_fetch_add(&hist[(k >> (8 * pass)) & 255u], 1u, __ATOMIC_RELAXED, __HIP_MEMORY_SCOPE_WORKGROUP); }
            __syncthreads();
            if (wave == 0) {
                const unsigned h0 = hist[4 * lane], h1 = hist[4 * lane + 1], h2 = hist[4 * lane + 2], h3 = hist[4 * lane + 3];
                const unsigned c = h0 + h1 + h2 + h3; unsigned S = c;
#pragma unroll
                for (int o = 1; o < 64; o <<= 1) { const unsigned t = __shfl_down(S, o); if (lane + o < 64) S += t; }
                const unsigned Snext = S - c;
                if (S >= need && Snext < need) { unsigned rem = need - Snext; unsigned bin;
                    if (h3 >= rem) bin = 3; else { rem -= h3; if (h2 >= rem) bin = 2; else { rem -= h2; if (h1 >= rem) bin = 1; else { rem -= h1; bin = 0; } } }
                    misc[0] = 4 * lane + bin; misc[1] = rem; }
            }
            __syncthreads();
            prefix |= misc[0] << (8 * pass); mask |= 0xFFu << (8 * pass); need = misc[1];
            __syncthreads();
        }
        unsigned selbase = 0u, eqbase = 0u;
        for (int base = 0; base < n; base += NTHR) {
            const int i = base + tid; const bool valid = i < n; const unsigned k = valid ? keys[i] : 0u;
            const bool eq = valid && k == prefix, gt = valid && k > prefix;
            const unsigned long long lt = (1ull << lane) - 1ull;
            const unsigned long long be = __ballot(eq);
            if (lane == 0) misc[8 + wave] = (unsigned)__popcll(be);
            __syncthreads();
            unsigned woff = 0u, tot = 0u;
#pragma unroll
            for (int w = 0; w < 8; ++w) { const unsigned v = misc[8 + w]; woff += (w < wave) ? v : 0u; tot += v; }
            const unsigned eqrank = eqbase + woff + (unsigned)__popcll(be & lt);
            const bool sel = gt || (eq && eqrank < need);
            const unsigned long long bs = __ballot(sel);
            if (lane == 0) misc[16 + wave] = (unsigned)__popcll(bs);
            __syncthreads();
            unsigned woff2 = 0u, tot2 = 0u;
#pragma unroll
            for (int w = 0; w < 8; ++w) { const unsigned v = misc[16 + w]; woff2 += (w < wave) ? v : 0u; tot2 += v; }
            if (valid) { const int row = row0 + i;
                if (sel) { const int slot = slot0 + (int)(selbase + woff2 + (unsigned)__popcll(bs & lt));
                    p.IDX[e * ESLOTS + slot] = row; p.GSEL[e * ESLOTS + slot] = __uint_as_float(k); p.INV[(size_t)row * 16 + e] = slot; }
                else p.INV[(size_t)row * 16 + e] = -1; }
            selbase += tot2; eqbase += tot;
            __syncthreads();
        }
    }
}
__device__ __forceinline__ void phase_gather(const P& p, bool with_ctx) {
    const int gw = p.bid * NWAVES + p.wave, NGW = p.G * NWAVES, lane = p.lane;
    for (int idx = gw; idx < NE * ESLOTS; idx += NGW) {
        const int slot = idx % ESLOTS; const bool valid = slot < CAP_L + (with_ctx ? CAP_C : 0);
        u32x4 a = (u32x4){0u, 0u, 0u, 0u}, b = a;
        if (valid) { const int row = p.IDX[idx]; const u32x4* s = (const u32x4*)(p.H + (size_t)row * D); a = s[lane]; b = s[64 + lane]; }
        else if (lane == 0) p.GSEL[idx] = 0.f;
        u32x4* dst = (u32x4*)(p.XE + (size_t)idx * D); dst[lane] = a; dst[64 + lane] = b;
    }
}

typedef short bf16x8 __attribute__((ext_vector_type(8)));
#define MFMA16(a, b, c) __builtin_amdgcn_mfma_f32_16x16x32_bf16((a), (b), (c), 0, 0, 0)
constexpr int LDP = 272;
constexpr int LDQ = 144;
__device__ __forceinline__ bf16x8 ld_frag(const LAS unsigned char* base, int row, int kcol, int ldb) { return *(const LAS bf16x8*)(base + row * ldb + kcol * 2); }
__device__ __forceinline__ void st_b16(LAS unsigned char* p, unsigned v) { *(LAS unsigned short*)p = (unsigned short)v; }
__device__ __forceinline__ float wscan_incl(float v, int lane) {
#pragma unroll
    for (int o = 1; o < 64; o <<= 1) { const float t = __shfl_up(v, o); if (lane >= o) v += t; }
    return v;
}
__device__ __forceinline__ int chunk_r0(int d, int cs) { return d == 0 ? 128 * cs : (cs < 2 ? 128 * (1 - cs) : 128 * (NCH + 1 - cs)); }
__device__ __forceinline__ int scan_chunk_of(int d, int cn) { return d == 0 ? cn : (cn < 2 ? 1 - cn : NCH + 1 - cn); }

__device__ __forceinline__ void ssd_acum(const float* DT, int r0, int d, int col, float a, int lane, LAS float* acum, LAS float* dtv, float& total) {
    const int j0 = d == 0 ? lane : 127 - lane, j1 = d == 0 ? 64 + lane : 63 - lane;
    const float dt0 = DT[(size_t)(r0 + j0) * 16 + col], dt1 = DT[(size_t)(r0 + j1) * 16 + col];
    const float s0 = wscan_incl(dt0 * a, lane); const float t0 = __shfl(s0, 63);
    const float s1 = wscan_incl(dt1 * a, lane) + t0; total = __shfl(s1, 63);
    acum[j0] = s0; acum[j1] = s1; dtv[j0] = dt0; dtv[j1] = dt1;
}

__device__ __forceinline__ void ssd_states(const P& p, int l, LAS unsigned char* lds, float* SST, float* DEC) {
    LAS unsigned char* BT = lds;
    LAS unsigned char* XW = lds + 128 * LDP;
    LAS float* wj = (LAS float*)(lds + 128 * LDP + 4 * 64 * LDP);
    const int tid = p.tid, lane = p.lane, wave = p.wave, quad = lane >> 4, l15 = lane & 15;
    for (int u = p.bid; u < 2 * NCH * 2; u += p.G) {
        const int d = u / (2 * NCH), cs = (u % (2 * NCH)) >> 1, g = u & 1;
        const int r0 = chunk_r0(d, cs);
        __syncthreads();
        if (wave < 4) { const int h = g * 4 + wave; const float a = -expf(p.a_log[l * 16 + d * 8 + h]); float total;
            LAS float* ac = wj + 512 + wave * 128; LAS float* dv = wj + 1024 + wave * 128;
            ssd_acum(p.DT, r0, d, d * 8 + h, a, lane, ac, dv, total);
            LDS_FENCE();
            wj[wave * 128 + lane] = expf(total - ac[lane]) * dv[lane]; wj[wave * 128 + 64 + lane] = expf(total - ac[64 + lane]) * dv[64 + lane];
            if (lane == 0) DEC[(d * NCH + cs) * 8 + h] = expf(total); }
        __syncthreads();
        for (int idx = tid; idx < 128 * 16; idx += NTHR) { const int j = idx >> 4, n8 = (idx & 15) * 8;
            const u32x4 v = *(const u32x4*)(p.CV + (size_t)(r0 + j) * 1024 + 512 + g * 128 + n8);
            LAS unsigned char* dst = BT + n8 * LDP + 2 * j;
            st_b16(dst, v.x & 0xffffu); st_b16(dst + LDP, v.x >> 16); st_b16(dst + 2 * LDP, v.y & 0xffffu); st_b16(dst + 3 * LDP, v.y >> 16);
            st_b16(dst + 4 * LDP, v.z & 0xffffu); st_b16(dst + 5 * LDP, v.z >> 16); st_b16(dst + 6 * LDP, v.w & 0xffffu); st_b16(dst + 7 * LDP, v.w >> 16); }
        for (int idx = tid; idx < 128 * 32; idx += NTHR) { const int j = idx >> 5, c8 = (idx & 31) * 8, hh = c8 >> 6, p8 = c8 & 63;
            const u32x4 v = *(const u32x4*)(p.CV + (size_t)(r0 + j) * 1024 + g * 256 + c8); const float w = wj[hh * 128 + j];
            LAS unsigned char* dst = XW + (hh * 64 + p8) * LDP + 2 * j;
            st_b16(dst, f2bf(bflo(v.x) * w)); st_b16(dst + LDP, f2bf(bfhi(v.x) * w)); st_b16(dst + 2 * LDP, f2bf(bflo(v.y) * w)); st_b16(dst + 3 * LDP, f2bf(bfhi(v.y) * w));
            st_b16(dst + 4 * LDP, f2bf(bflo(v.z) * w)); st_b16(dst + 5 * LDP, f2bf(bfhi(v.z) * w)); st_b16(dst + 6 * LDP, f2bf(bflo(v.w) * w)); st_b16(dst + 7 * LDP, f2bf(bfhi(v.w) * w)); }
        __syncthreads();
        const int hh = wave >> 1, ph = wave & 1;
        f32x4 acc[2][8];
#pragma unroll
        for (int a = 0; a < 2; ++a)
#pragma unroll
            for (int b = 0; b < 8; ++b) acc[a][b] = (f32x4){0.f, 0.f, 0.f, 0.f};
#pragma unroll
        for (int ks = 0; ks < 4; ++ks) {
            bf16x8 af[2];
#pragma unroll
            for (int pt = 0; pt < 2; ++pt) af[pt] = ld_frag(XW + hh * 64 * LDP, ph * 32 + pt * 16 + l15, ks * 32 + 8 * quad, LDP);
#pragma unroll
            for (int nt = 0; nt < 8; ++nt) { const bf16x8 bfr = ld_frag(BT, nt * 16 + l15, ks * 32 + 8 * quad, LDP);
#pragma unroll
                for (int pt = 0; pt < 2; ++pt) acc[pt][nt] = MFMA16(af[pt], bfr, acc[pt][nt]); }
        }
        float* S = SST + ((size_t)(d * NCH + cs) * 8 + g * 4 + hh) * 8192;
#pragma unroll
        for (int pt = 0; pt < 2; ++pt)
#pragma unroll
            for (int nt = 0; nt < 8; ++nt)
#pragma unroll
                for (int r = 0; r < 4; ++r) S[(ph * 32 + pt * 16 + 4 * quad + r) * 128 + nt * 16 + l15] = acc[pt][nt][r];
    }
}

__device__ __forceinline__ void scan_carries(const P& p, int l, const float* SST, const float* DEC, bf16* HIN) {
    for (int e = p.bid * NTHR + p.tid; e < 2 * 8 * 8192; e += p.G * NTHR) {
        const int d = e >> 16, h = (e >> 13) & 7, pn = e & 8191;
        float hs = 0.f;
        for (int c0 = 0; c0 < NCH; c0 += 10) {
            float s[10], dc[10];
#pragma unroll
            for (int j = 0; j < 10; ++j) { const size_t ci = (size_t)(d * NCH + c0 + j) * 8 + h; s[j] = SST[ci * 8192 + pn]; dc[j] = DEC[ci]; }
#pragma unroll
            for (int j = 0; j < 10; ++j) { const size_t ci = (size_t)(d * NCH + c0 + j) * 8 + h; HIN[ci * 8192 + pn] = (bf16)f2bf(hs); hs = hs * dc[j] + s[j]; }
        }
    }
    for (int e = p.bid * NTHR + p.tid; e < 2 * 32 * 64; e += p.G * NTHR) {
        const int d = e >> 11, g = (e >> 6) & 31, pq = e & 63;
        S5Lane s; s5_lane_params(p, l, d, g, pq, s, false);
        float ar = s.abr, ai = s.abi;
#pragma unroll
        for (int q = 0; q < 7; ++q) { const float nr = ar * ar - ai * ai, ni = 2.f * ar * ai; ar = nr; ai = ni; }
        float hr = 0.f, hi = 0.f;
        const float* E = p.S5E + (size_t)(d * 32 + g) * NCH * 128 + pq; float* Hn = p.S5H + (size_t)(d * 32 + g) * NCH * 128 + pq;
        for (int c0 = 0; c0 < NCH; c0 += 10) {
            float er[10], ei[10];
#pragma unroll
            for (int j = 0; j < 10; ++j) { er[j] = E[(c0 + j) * 128]; ei[j] = E[(c0 + j) * 128 + 64]; }
#pragma unroll
            for (int j = 0; j < 10; ++j) { Hn[(c0 + j) * 128] = hr; Hn[(c0 + j) * 128 + 64] = hi;
                const float nr = ar * hr - ai * hi + er[j], ni = ar * hi + ai * hr + ei[j]; hr = nr; hi = ni; }
        }
    }
}

__device__ __forceinline__ void ssd_outputs(const P& p, int l, LAS unsigned char* lds, const bf16* HIN, bf16* YS) {
    LAS unsigned char* Cm = lds;
    LAS unsigned char* Bm = lds + 128 * LDP;
    LAS unsigned char* XT = lds + 2 * 128 * LDP;
    LAS unsigned char* Wm = lds + 2 * 128 * LDP + 64 * LDP;
    LAS float* sm = (LAS float*)(lds + 3 * 128 * LDP + 64 * LDP);
    const int tid = p.tid, lane = p.lane, wave = p.wave, quad = lane >> 4, l15 = lane & 15;
    for (int u = p.bid; u < NCH * 8; u += p.G) {
        const int cn = u >> 3, h = u & 7, g = h >> 2, r0 = 128 * cn;
        __syncthreads();
        if (wave < 2) { const int d = wave; const float a = -expf(p.a_log[l * 16 + d * 8 + h]); float total;
            ssd_acum(p.DT, r0, d, d * 8 + h, a, lane, sm + d * 128, sm + 256 + d * 128, total); }
        for (int idx = tid; idx < 128 * 16; idx += NTHR) { const int j = idx >> 4, n8 = (idx & 15) * 8;
            const bf16* src = p.CV + (size_t)(r0 + j) * 1024 + g * 128 + n8;
            *(LAS u32x4*)(Bm + j * LDP + n8 * 2) = *(const u32x4*)(src + 512); *(LAS u32x4*)(Cm + j * LDP + n8 * 2) = *(const u32x4*)(src + 768); }
        for (int idx = tid; idx < 128 * 8; idx += NTHR) { const int j = idx >> 3, p8 = (idx & 7) * 8;
            const u32x4 v = *(const u32x4*)(p.CV + (size_t)(r0 + j) * 1024 + h * 64 + p8);
            LAS unsigned char* dst = XT + p8 * LDP + 2 * j;
            st_b16(dst, v.x & 0xffffu); st_b16(dst + LDP, v.x >> 16); st_b16(dst + 2 * LDP, v.y & 0xffffu); st_b16(dst + 3 * LDP, v.y >> 16);
            st_b16(dst + 4 * LDP, v.z & 0xffffu); st_b16(dst + 5 * LDP, v.z >> 16); st_b16(dst + 6 * LDP, v.w & 0xffffu); st_b16(dst + 7 * LDP, v.w >> 16); }
        __syncthreads();
        f32x4 G[8];
#pragma unroll
        for (int jt = 0; jt < 8; ++jt) G[jt] = (f32x4){0.f, 0.f, 0.f, 0.f};
#pragma unroll
        for (int ks = 0; ks < 4; ++ks) { const bf16x8 af = ld_frag(Cm, 16 * wave + l15, ks * 32 + 8 * quad, LDP);
#pragma unroll
            for (int jt = 0; jt < 8; ++jt) G[jt] = MFMA16(af, ld_frag(Bm, 16 * jt + l15, ks * 32 + 8 * quad, LDP), G[jt]); }
        __syncthreads();
        for (int idx = tid; idx < 2 * 64 * 16; idx += NTHR) { const int d = idx >> 10, pp = (idx >> 4) & 63, n8 = (idx & 15) * 8;
            const int cs = scan_chunk_of(d, cn);
            *(LAS u32x4*)(Bm + (d * 64 + pp) * LDP + n8 * 2) = *(const u32x4*)(HIN + ((size_t)(d * NCH + cs) * 8 + h) * 8192 + pp * 128 + n8); }
        __syncthreads();
        f32x4 Y[4];
#pragma unroll
        for (int pt = 0; pt < 4; ++pt) Y[pt] = (f32x4){0.f, 0.f, 0.f, 0.f};
#pragma unroll
        for (int d = 0; d < 2; ++d) {
            const LAS float* ac = sm + d * 128; const LAS float* dv = sm + 256 + d * 128;
            float ai[4];
#pragma unroll
            for (int r = 0; r < 4; ++r) ai[r] = ac[16 * wave + 4 * quad + r];
#pragma unroll
            for (int jt = 0; jt < 8; ++jt) { const int j = 16 * jt + l15; const float aj = ac[j], dj = dv[j];
#pragma unroll
                for (int r = 0; r < 4; ++r) { const int i = 16 * wave + 4 * quad + r; const bool valid = (d == 0) ? (j <= i) : (j >= i);
                    const float w = valid ? G[jt][r] * expf(ai[r] - aj) * dj : 0.f;
                    st_b16(Wm + i * LDP + 2 * j, f2bf(w)); } }
            LDS_FENCE();
            f32x4 Y2[4];
#pragma unroll
            for (int pt = 0; pt < 4; ++pt) Y2[pt] = (f32x4){0.f, 0.f, 0.f, 0.f};
#pragma unroll
            for (int ks = 0; ks < 4; ++ks) { const bf16x8 wf = ld_frag(Wm, 16 * wave + l15, ks * 32 + 8 * quad, LDP), cf = ld_frag(Cm, 16 * wave + l15, ks * 32 + 8 * quad, LDP);
#pragma unroll
                for (int pt = 0; pt < 4; ++pt) { Y[pt] = MFMA16(wf, ld_frag(XT, 16 * pt + l15, ks * 32 + 8 * quad, LDP), Y[pt]);
                    Y2[pt] = MFMA16(cf, ld_frag(Bm + d * 64 * LDP, 16 * pt + l15, ks * 32 + 8 * quad, LDP), Y2[pt]); } }
#pragma unroll
            for (int r = 0; r < 4; ++r) { const float ea = expf(ai[r]);
#pragma unroll
                for (int pt = 0; pt < 4; ++pt) Y[pt][r] += ea * Y2[pt][r]; }
            LDS_FENCE();
        }
#pragma unroll
        for (int pt = 0; pt < 4; ++pt)
#pragma unroll
            for (int r = 0; r < 4; ++r) YS[(size_t)(r0 + 16 * wave + 4 * quad + r) * 512 + h * 64 + 16 * pt + l15] = (bf16)f2bf(Y[pt][r]);
    }
}

__device__ __forceinline__ void ssd_gated_norm(const P& p, int l, const bf16* YS) {
    const int gw = p.bid * NWAVES + p.wave, NGW = p.G * NWAVES, lane = p.lane;
    for (int row = gw; row < T; row += NGW) {
        const int ch = lane * 8;
        const float dsk = p.ssd_d[l * 8 + (ch >> 6)];
        const u32x4 yv = *(const u32x4*)(YS + (size_t)row * 512 + ch);
        const u32x4 xs = *(const u32x4*)(p.CV + (size_t)row * 1024 + ch), zz = *(const u32x4*)(p.PROJ + (size_t)row * PJ + Z0 + ch);
        float v[8];
        v[0] = (bflo(yv.x) + dsk * bflo(xs.x)) * silu_f(bflo(zz.x)); v[1] = (bfhi(yv.x) + dsk * bfhi(xs.x)) * silu_f(bfhi(zz.x));
        v[2] = (bflo(yv.y) + dsk * bflo(xs.y)) * silu_f(bflo(zz.y)); v[3] = (bfhi(yv.y) + dsk * bfhi(xs.y)) * silu_f(bfhi(zz.y));
        v[4] = (bflo(yv.z) + dsk * bflo(xs.z)) * silu_f(bflo(zz.z)); v[5] = (bfhi(yv.z) + dsk * bfhi(xs.z)) * silu_f(bfhi(zz.z));
        v[6] = (bflo(yv.w) + dsk * bflo(xs.w)) * silu_f(bflo(zz.w)); v[7] = (bfhi(yv.w) + dsk * bfhi(xs.w)) * silu_f(bfhi(zz.w));
        float ss = 0.f;
#pragma unroll
        for (int i = 0; i < 8; ++i) ss += v[i] * v[i];
        const float rstd = rsqrtf(wsum(ss) * (1.f / 512.f) + EPS);
        const float* ng = p.ssd_norm_g + (size_t)l * 512 + ch;
        const f32x4 g0 = *(const f32x4*)ng, g1 = *(const f32x4*)(ng + 4);
        u32x4 o; o.x = pk2(v[0] * rstd * g0[0], v[1] * rstd * g0[1]); o.y = pk2(v[2] * rstd * g0[2], v[3] * rstd * g0[3]);
        o.z = pk2(v[4] * rstd * g1[0], v[5] * rstd * g1[1]); o.w = pk2(v[6] * rstd * g1[2], v[7] * rstd * g1[3]);
        *(u32x4*)(p.Y3 + (size_t)row * 1536 + 512 + ch) = o;
    }
}

__device__ __forceinline__ void attention_mfma(const P& p, int l, LAS unsigned char* lds, int u_begin, int u_end, int u_first, int u_stride) {
    LAS unsigned char* Kt = lds;
    LAS unsigned char* VT = lds + 64 * LDQ;
    LAS unsigned char* Pw = lds + 2 * 64 * LDQ + p.wave * 64 * LDQ;
    const int tid = p.tid, lane = p.lane, wave = p.wave, quad = lane >> 4, l15 = lane & 15;
    const float C2 = 0.125f * 1.4426950408889634f;
    for (int u = u_begin + u_first; u < u_end; u += u_stride) {
        const int qb = u >> 1, kvh = u & 1, hq = kvh * 4 + (wave >> 1);
        const bool isc = qb < 2; const int nb = qb - 2;
        const int qrow0 = 128 * qb + 64 * (wave & 1);
        bf16x8 Qf[4][2];
#pragma unroll
        for (int qt = 0; qt < 4; ++qt)
#pragma unroll
            for (int ks = 0; ks < 2; ++ks) Qf[qt][ks] = *(const bf16x8*)(p.PROJ + (size_t)(qrow0 + 16 * qt + l15) * PJ + Q0 + hq * 64 + ks * 32 + 8 * quad);
        f32x4 O[4][4];
#pragma unroll
        for (int a = 0; a < 4; ++a)
#pragma unroll
            for (int b = 0; b < 4; ++b) O[a][b] = (f32x4){0.f, 0.f, 0.f, 0.f};
        float mrow[4], lrow[4];
        const float sk = p.sink[l * 8 + hq] * 1.4426950408889634f;
#pragma unroll
        for (int qt = 0; qt < 4; ++qt) { mrow[qt] = sk; lrow[qt] = 1.f; }
        const int ntile = isc ? 4 : 10;
        for (int ti = 0; ti < ntile; ++ti) {
            int krow0; bool local;
            if (isc || ti >= 6) { krow0 = 64 * (isc ? ti : ti - 6); local = false; }
            else { krow0 = NCTX + 128 * (nb - 1) + 64 * ti; local = true; }
            if (local && (krow0 < NCTX || krow0 >= T)) continue;
            __syncthreads();
            { const int key = tid >> 3, pc = tid & 7;
              const bf16* src = p.PROJ + (size_t)(krow0 + key) * PJ + kvh * 64 + pc * 8;
              *(LAS u32x4*)(Kt + key * LDQ + pc * 16) = *(const u32x4*)(src + K0);
              const u32x4 v = *(const u32x4*)(src + V0);
              LAS unsigned char* dst = VT + (pc * 8) * LDQ + 2 * key;
              st_b16(dst, v.x & 0xffffu); st_b16(dst + LDQ, v.x >> 16); st_b16(dst + 2 * LDQ, v.y & 0xffffu); st_b16(dst + 3 * LDQ, v.y >> 16);
              st_b16(dst + 4 * LDQ, v.z & 0xffffu); st_b16(dst + 5 * LDQ, v.z >> 16); st_b16(dst + 6 * LDQ, v.w & 0xffffu); st_b16(dst + 7 * LDQ, v.w >> 16); }
            __syncthreads();
            f32x4 S[4][4];
#pragma unroll
            for (int a = 0; a < 4; ++a)
#pragma unroll
                for (int b = 0; b < 4; ++b) S[a][b] = (f32x4){0.f, 0.f, 0.f, 0.f};
#pragma unroll
            for (int ks = 0; ks < 2; ++ks)
#pragma unroll
                for (int kt = 0; kt < 4; ++kt) { const bf16x8 kf = ld_frag(Kt, 16 * kt + l15, ks * 32 + 8 * quad, LDQ);
#pragma unroll
                    for (int qt = 0; qt < 4; ++qt) S[kt][qt] = MFMA16(kf, Qf[qt][ks], S[kt][qt]); }
#pragma unroll
            for (int qt = 0; qt < 4; ++qt) {
                const int tq = qrow0 + 16 * qt + l15;
                float mx = -1e30f;
#pragma unroll
                for (int kt = 0; kt < 4; ++kt)
#pragma unroll
                    for (int r = 0; r < 4; ++r) { const int tk = krow0 + 16 * kt + 4 * quad + r; const int df = tq - tk;
                        const bool ok = !local || (df <= 128 && df >= -128);
                        const float s = ok ? S[kt][qt][r] * C2 : -1e30f; S[kt][qt][r] = s; mx = fmaxf(mx, s); }
                mx = fmaxf(mx, __shfl_xor(mx, 16)); mx = fmaxf(mx, __shfl_xor(mx, 32));
                const float mn = fmaxf(mrow[qt], mx), alpha = exp2f(mrow[qt] - mn);
                float ls = 0.f;
#pragma unroll
                for (int kt = 0; kt < 4; ++kt) { float e0 = exp2f(S[kt][qt][0] - mn), e1 = exp2f(S[kt][qt][1] - mn), e2 = exp2f(S[kt][qt][2] - mn), e3 = exp2f(S[kt][qt][3] - mn);
                    ls += (e0 + e1) + (e2 + e3);
                    u32x2 w; w.x = pk2(e0, e1); w.y = pk2(e2, e3);
                    *(LAS u32x2*)(Pw + (16 * qt + l15) * LDQ + (16 * kt + 4 * quad) * 2) = w; }
                ls += __shfl_xor(ls, 16); ls += __shfl_xor(ls, 32);
                lrow[qt] = lrow[qt] * alpha + ls; mrow[qt] = mn;
#pragma unroll
                for (int dt = 0; dt < 4; ++dt) O[dt][qt] *= alpha;
            }
            LDS_FENCE();
#pragma unroll
            for (int ks = 0; ks < 2; ++ks) {
                bf16x8 pf[4];
#pragma unroll
                for (int qt = 0; qt < 4; ++qt) pf[qt] = ld_frag(Pw, 16 * qt + l15, ks * 32 + 8 * quad, LDQ);
#pragma unroll
                for (int dt = 0; dt < 4; ++dt) { const bf16x8 vf = ld_frag(VT, 16 * dt + l15, ks * 32 + 8 * quad, LDQ);
#pragma unroll
                    for (int qt = 0; qt < 4; ++qt) O[dt][qt] = MFMA16(vf, pf[qt], O[dt][qt]); }
            }
            LDS_FENCE();
        }
#pragma unroll
        for (int qt = 0; qt < 4; ++qt) { const float inv = 1.f / lrow[qt];
            bf16* orow = p.Y3 + (size_t)(qrow0 + 16 * qt + l15) * 1536 + 1024 + hq * 64;
#pragma unroll
            for (int dt = 0; dt < 4; ++dt) { u32x2 w; w.x = pk2(O[dt][qt][0] * inv, O[dt][qt][1] * inv); w.y = pk2(O[dt][qt][2] * inv, O[dt][qt][3] * inv);
                *(u32x2*)(orow + 16 * dt + 4 * quad) = w; } }
    }
}

constexpr size_t S5BB_ELEMS = (size_t)2 * 32 * 128 * 32, S5CC_ELEMS = (size_t)2 * 32 * 16 * 128;
__device__ __forceinline__ void s5_tables(const P& p, int l, bf16* BB, bf16* CC, float* AB) {
    for (int e = p.bid * NTHR + p.tid; e < 2 * 32 * 64; e += p.G * NTHR) {
        const int d = e >> 11, g = (e >> 6) & 31, pq = e & 63, dg = d * 32 + g;
        S5Lane s; s5_lane_params(p, l, d, g, pq, s, true);
        AB[(size_t)e * 2] = s.abr; AB[(size_t)e * 2 + 1] = s.abi;
        u32x4* br = (u32x4*)(BB + ((size_t)dg * 128 + pq) * 32); u32x4* bi = (u32x4*)(BB + ((size_t)dg * 128 + 64 + pq) * 32);
        u32x4 w;
        w.x = pk2(s.bbr[0], s.bbr[1]); w.y = pk2(s.bbr[2], s.bbr[3]); w.z = pk2(s.bbr[4], s.bbr[5]); w.w = pk2(s.bbr[6], s.bbr[7]); br[0] = w;
        w.x = pk2(s.bbr[8], s.bbr[9]); w.y = pk2(s.bbr[10], s.bbr[11]); w.z = pk2(s.bbr[12], s.bbr[13]); w.w = pk2(s.bbr[14], s.bbr[15]); br[1] = w;
        w.x = pk2(s.bbi[0], s.bbi[1]); w.y = pk2(s.bbi[2], s.bbi[3]); w.z = pk2(s.bbi[4], s.bbi[5]); w.w = pk2(s.bbi[6], s.bbi[7]); bi[0] = w;
        w.x = pk2(s.bbi[8], s.bbi[9]); w.y = pk2(s.bbi[10], s.bbi[11]); w.z = pk2(s.bbi[12], s.bbi[13]); w.w = pk2(s.bbi[14], s.bbi[15]); bi[1] = w;
        const u32x4 z = (u32x4){0u, 0u, 0u, 0u}; br[2] = z; br[3] = z; bi[2] = z; bi[3] = z;
        const size_t ci = ((size_t)(l * 2 + d) * 32 + g) * 16;
#pragma unroll
        for (int k = 0; k < 16; ++k) { CC[((size_t)dg * 16 + k) * 128 + pq] = (bf16)f2bf(p.c_re[(ci + k) * 64 + pq]); CC[((size_t)dg * 16 + k) * 128 + 64 + pq] = (bf16)f2bf(-p.c_im[(ci + k) * 64 + pq]); }
    }
}
constexpr int S5_WREG = 4096 + 16 * 132 * 4 + 16 * LDP;
template <bool READOUT> __device__ __forceinline__ void s5_chunk_dir(int d, const bf16* BBdg, const bf16* CCdg, float abr, float abi, LAS unsigned char* wreg, int lane, float& hr, float& hi, f32x4 (&yacc)[8]) {
    const int quad = lane >> 4, l15 = lane & 15;
    LAS unsigned char* ub = wreg; LAS float* BuW = (LAS float*)(wreg + 4096); LAS unsigned char* Hw = wreg + 4096 + 16 * 132 * 4;
    bf16x8 BBf[8], CCf[4];
#pragma unroll
    for (int pt = 0; pt < 8; ++pt) BBf[pt] = *(const bf16x8*)(BBdg + (size_t)(16 * pt + l15) * 32 + 8 * quad);
    if (READOUT) {
#pragma unroll
        for (int ks = 0; ks < 4; ++ks) CCf[ks] = *(const bf16x8*)(CCdg + (size_t)l15 * 128 + ks * 32 + 8 * quad);
    }
#pragma unroll (READOUT ? 8 : 1)
    for (int ss = 0; ss < 8; ++ss) {
        const int sc = d ? 7 - ss : ss;
        bf16x8 uf = (bf16x8){0, 0, 0, 0, 0, 0, 0, 0};
        if (quad < 2) uf = *(const LAS bf16x8*)(ub + (16 * sc + l15) * 32 + quad * 16);
#pragma unroll
        for (int pt = 0; pt < 8; ++pt) { const f32x4 Dp = MFMA16(uf, BBf[pt], ((f32x4){0.f, 0.f, 0.f, 0.f}));
#pragma unroll
            for (int r = 0; r < 4; ++r) BuW[(4 * quad + r) * 132 + 16 * pt + l15] = Dp[r]; }
        LDS_FENCE();
#pragma unroll
        for (int st = 0; st < 16; ++st) { const int tl = d ? 15 - st : st;
            const float br = BuW[tl * 132 + lane], bi = BuW[tl * 132 + 64 + lane];
            const float nr = abr * hr - abi * hi + br, ni = abr * hi + abi * hr + bi; hr = nr; hi = ni;
            if (READOUT) { st_b16(Hw + tl * LDP + 2 * lane, f2bf(hr)); st_b16(Hw + tl * LDP + 128 + 2 * lane, f2bf(hi)); } }
        if (READOUT) {
            LDS_FENCE();
#pragma unroll
            for (int ks = 0; ks < 4; ++ks) yacc[sc] = MFMA16(ld_frag(Hw, l15, ks * 32 + 8 * quad, LDP), CCf[ks], yacc[sc]);
        }
        LDS_FENCE();
    }
}
__device__ __forceinline__ void s5_local_states(const P& p, LAS unsigned char* lds, const bf16* BB, const float* AB) {
    LAS unsigned char* wreg = lds + p.wave * S5_WREG;
    const int gw = p.bid * NWAVES + p.wave, NGW = p.G * NWAVES, lane = p.lane;
    for (int it = gw; it < 2 * 32 * NCH; it += NGW) {
        const int d = it / (32 * NCH), c = (it % (32 * NCH)) >> 5, g = it & 31, dg = d * 32 + g;
        s5_stage_u(p, chunk_r0(d, c), g, wreg, lane);
        float hr = 0.f, hi = 0.f; f32x4 dummy[8];
        const float abr = AB[((size_t)dg * 64 + lane) * 2], abi = AB[((size_t)dg * 64 + lane) * 2 + 1];
        if (d == 0) s5_chunk_dir<false>(0, BB + (size_t)dg * 128 * 32, nullptr, abr, abi, wreg, lane, hr, hi, dummy);
        else s5_chunk_dir<false>(1, BB + (size_t)dg * 128 * 32, nullptr, abr, abi, wreg, lane, hr, hi, dummy);
        float* E = p.S5E + ((size_t)dg * NCH + c) * 128;
        E[lane] = hr; E[64 + lane] = hi;
    }
}
__device__ __forceinline__ void s5_outputs(const P& p, int l, LAS unsigned char* lds, const bf16* BB, const bf16* CC, const float* AB) {
    LAS unsigned char* wreg = lds + p.wave * S5_WREG;
    const int gw = p.bid * NWAVES + p.wave, NGW = p.G * NWAVES, lane = p.lane, quad = lane >> 4, l15 = lane & 15;
    for (int it = gw; it < 32 * NCH; it += NGW) {
        const int cn = it >> 5, g = it & 31, r0 = 128 * cn;
        s5_stage_u(p, r0, g, wreg, lane);
        f32x4 yacc[8];
#pragma unroll
        for (int i = 0; i < 8; ++i) yacc[i] = (f32x4){0.f, 0.f, 0.f, 0.f};
#pragma unroll
        for (int d = 0; d < 2; ++d) { const int dg = d * 32 + g, cs = scan_chunk_of(d, cn);
            const float* Hn = p.S5H + ((size_t)dg * NCH + cs) * 128;
            float hr = Hn[lane], hi = Hn[64 + lane];
            s5_chunk_dir<true>(d, BB + (size_t)dg * 128 * 32, CC + (size_t)dg * 16 * 128, AB[((size_t)dg * 64 + lane) * 2], AB[((size_t)dg * 64 + lane) * 2 + 1], wreg, lane, hr, hi, yacc); }
        const float dsk = p.s5_d[(size_t)l * 512 + g * 16 + l15];
#pragma unroll
        for (int sc = 0; sc < 8; ++sc)
#pragma unroll
            for (int r = 0; r < 4; ++r) { const int t = 16 * sc + 4 * quad + r;
                const float u = bf2f(*(const LAS unsigned short*)(wreg + t * 32 + 2 * l15));
                p.SA[(size_t)(r0 + t) * 512 + g * 16 + l15] = (bf16)f2bf(gelu_tanh_f(yacc[sc][r] + dsk * u)); }
        LDS_FENCE();
    }
}

#ifndef SKIPMASK
#define SKIPMASK 0
#endif
struct Args { const float* in[33]; float* out; unsigned char* ws; int ph_lo, ph_hi; };
static_assert(sizeof(Args) == 35 * 8 + 8, "no padding");

__global__ void __launch_bounds__(NTHR, 2) fwd_kernel(Args args) {
    extern __shared__ __attribute__((aligned(16))) unsigned char lds_raw[];
    LAS unsigned char* lds = (LAS unsigned char*)lds_raw;
    const int tid_ = threadIdx.x;
    if (tid_ == 0) {
        LAS unsigned long long* tab = (LAS unsigned long long*)(lds + PTAB_OFF);
#pragma unroll
        for (int k = 0; k < 33; ++k) tab[k] = (unsigned long long)args.in[k];
        tab[33] = (unsigned long long)args.out; tab[34] = (unsigned long long)args.ws;
    }
    volatile LAS unsigned* MISC = (volatile LAS unsigned*)(lds + MISC_OFF);
    if (tid_ < 64) MISC[tid_] = 0u;
    __syncthreads();
    XcdBarrier bar; bar.bar = (unsigned*)(args.ws + WS_CTL) + CW_BAR; bar.x = 0; bar.st = nullptr;
    if (!MK_PER_PHASE) bar = xcd_barrier_post((unsigned*)(args.ws + WS_CTL) + CW_BAR, MISC + 8);

    const int lo = args.ph_lo, hi = args.ph_hi;
#define IN(k) (lo <= (k) && (k) < hi)
#define SEAM(k) do { if (!MK_PER_PHASE && (k) + 1 < hi) xcd_barrier(bar); } while (0)

    if (IN(0)) { P p; build_P(p, lds); phase_mod(p, lds); SEAM(0); }

#ifndef REPMASK
#define REPMASK 0
#endif
#define PHASE(k, ...) if (!((SKIPMASK >> (k)) & 1) && IN(pb + (k))) { for (int rep_ = 0; rep_ <= ((REPMASK >> (k)) & 1); ++rep_) { P p; build_P(p, lds); __VA_ARGS__; \
        if (rep_ < ((REPMASK >> (k)) & 1)) xcd_barrier(bar); } SEAM(pb + (k)); }
    for (int l = 0; l < DEPTH; ++l) {
        const int pb = 1 + NPH_LAYER * l;
        const bool cx = l < DEPTH - 1;
        unsigned char* wsb; { unsigned tb_ = (unsigned)(size_t)(lds + PTAB_OFF); asm volatile("" : "+v"(tb_)); wsb = (unsigned char*)ld_tab((volatile LAS unsigned*)(size_t)tb_, 34); }
        PHASE(0, convert_weights(p, l, lds); s5_tables(p, l, (bf16*)(wsb + WS_S5BB), (bf16*)(wsb + WS_S5CC), (float*)(wsb + WS_S5AB)); __syncthreads(); if (rep_ == 0) row_pass<0>(p, l, lds))
        PHASE(1, pg8::Gemm g{p.H, p.WIN, T, PJ, D}; pg8::StaticOrder S; S.init(T, PJ, p.G, p.bid); pg8::EpiStoreBf16 E{p.PROJ, PJ, GT0 / 256};
            pg8::gemm_phase<pg8::EpiStoreBf16, pg8::StaticOrder, false>(lds, g, S, E, nullptr))
        PHASE(2, phase_premix(p, l, lds, rep_ == 0); s5_local_states(p, lds, (const bf16*)(wsb + WS_S5BB), (const float*)(wsb + WS_S5AB)))
        PHASE(3, ssd_states(p, l, lds, (float*)(wsb + WS_SST), (float*)(wsb + WS_DEC)); __syncthreads(); attention_mfma(p, l, lds, 4, 2 * NCH, p.bid, p.G))
        PHASE(4, if (cx && p.bid >= p.G - 4) attention_mfma(p, l, lds, 0, 4, p.bid - (p.G - 4), 4);
            scan_carries(p, l, (const float*)(wsb + WS_SST), (const float*)(wsb + WS_DEC), (bf16*)(wsb + WS_HIN)))
        PHASE(5, ssd_outputs(p, l, lds, (const bf16*)(wsb + WS_HIN), (bf16*)(wsb + WS_YS)); __syncthreads(); s5_outputs(p, l, lds, (const bf16*)(wsb + WS_S5BB), (const bf16*)(wsb + WS_S5CC), (const float*)(wsb + WS_S5AB)))
        PHASE(6, pg8::Gemm g{p.SA, p.WGLU, T, 512, 512}; pg8::RowOffOrder S; S.init(cx ? T : NLAT, 512, p.G, p.bid, cx ? 0 : 1); pg8::EpiGlu E{p.SA, p.b_glu + (size_t)l * 512, p.Y3};
            pg8::gemm_phase<pg8::EpiGlu, pg8::RowOffOrder, false>(lds, g, S, E, nullptr); ssd_gated_norm(p, l, (const bf16*)(wsb + WS_YS)))
        PHASE(7, pg8::Gemm g{p.Y3, p.WBR, T, D, 1536}; pg8::RowOffOrder S; S.init(cx ? T : NLAT, D, p.G, p.bid, cx ? 0 : 1); pg8::EpiMerge E{p.PROJ, p.MB};
            pg8::gemm_phase<pg8::EpiMerge, pg8::RowOffOrder, false>(lds, g, S, E, nullptr))
        PHASE(8, pg8::Gemm g{p.MB, p.WOUT, T, D, D}; pg8::RowOffOrder S; S.init(cx ? T : NLAT, D, p.G, p.bid, cx ? 0 : 1);
            pg8::EpiResid E{p.XL, p.XC, p.MOD + (size_t)(l * 2 + 0) * 6144 + 2 * D, p.MOD + (size_t)(l * 2 + 1) * 6144 + 2 * D};
            pg8::gemm_phase<pg8::EpiResid, pg8::RowOffOrder, false>(lds, g, S, E, nullptr))
        PHASE(9, row_pass<1>(p, l, lds, cx))
        PHASE(10, phase_select(p, lds, cx))
        PHASE(11, phase_gather(p, cx))
        PHASE(12, pg8::Gemm g{p.XE, p.WUP, NE * ESLOTS, NE * 2048, D}; pg8::ExpertOrder S{p.G, p.bid, 8, cx ? 9 : 8}; pg8::EpiSwiGlu E{p.HID};
            pg8::gemm_phase<pg8::EpiSwiGlu, pg8::ExpertOrder, false>(lds, g, S, E, nullptr))
        PHASE(13, pg8::Gemm g{p.HID, p.WDN, NE * ESLOTS, NE * 1024, D}; pg8::ExpertOrder S{p.G, p.bid, 4, cx ? 9 : 8}; pg8::EpiDown E{p.YE, p.GSEL};
            pg8::gemm_phase<pg8::EpiDown, pg8::ExpertOrder, false>(lds, g, S, E, nullptr))
    }
    if (IN(NPHASES - 1)) { P p; build_P(p, lds); row_pass<2>(p, 0, lds); }
#undef IN
#undef SEAM
}

extern "C" void kernel_launch(void* const* d_in, const int* in_sizes, int n_in, void* d_out, int out_size, void* d_ws, size_t ws_size, hipStream_t stream) {
    static int grid = 0;
    if (grid == 0) {
        if (n_in != 33 || out_size != NLAT * D || ws_size < WS_END) { fprintf(stderr, "kernel_launch: unexpected shapes: n_in %d out %d ws %zu (need %zu)\n", n_in, out_size, ws_size, (size_t)WS_END); grid = -1; return; }
        int dev = 0, cus = 0, per_cu = 0;
        if (hipGetDevice(&dev) != hipSuccess || hipDeviceGetAttribute(&cus, hipDeviceAttributeMultiprocessorCount, dev) != hipSuccess) { grid = -1; return; }
        if (hipFuncSetAttribute((const void*)fwd_kernel, hipFuncAttributeMaxDynamicSharedMemorySize, LDS_BYTES) != hipSuccess) { fprintf(stderr, "kernel_launch: hipFuncSetAttribute failed\n"); grid = -1; return; }
        if (hipOccupancyMaxActiveBlocksPerMultiprocessor(&per_cu, (const void*)fwd_kernel, NTHR, LDS_BYTES) != hipSuccess || per_cu < 1) { fprintf(stderr, "kernel_launch: occupancy query says %d\n", per_cu); (void)hipGetLastError(); }
        grid = cus;
    }
    if (grid < 0) return;
    (void)hipMemsetAsync((char*)d_ws + WS_CTL, 0, CTL_BYTES, stream);
    Args a{};
    for (int i = 0; i < 33; ++i) a.in[i] = (const float*)d_in[i];
    a.out = (float*)d_out; a.ws = (unsigned char*)d_ws;
#if MK_PER_PHASE
    for (int ph = 0; ph < NPHASES; ++ph) { a.ph_lo = ph; a.ph_hi = ph + 1; hipLaunchKernelGGL(fwd_kernel, dim3(grid), dim3(NTHR), LDS_BYTES, stream, a); }
#else
    a.ph_lo = 0; a.ph_hi = NPHASES;
    hipLaunchKernelGGL(fwd_kernel, dim3(grid), dim3(NTHR), LDS_BYTES, stream, a);
#endif
}
```

```cpp
#include <hip/hip_runtime.h>
#include <cstdio>
#include <cstdint>

#ifndef MK_PER_PHASE
#define MK_PER_PHASE 0
#endif

namespace pg8 {
#define PG8_LAS __attribute__((address_space(3)))
typedef unsigned short bf16_t;
typedef short bf16x8 __attribute__((ext_vector_type(8)));
typedef float f32x4 __attribute__((ext_vector_type(4)));
typedef unsigned u32x4 __attribute__((ext_vector_type(4)));
constexpr int BM = 256, BK = 64, HALF = 128, HTB = HALF * BK * 2  , STAGE_BYTES = 8 * HTB, NXCD = 8, WGM = 8;

__host__ __device__ __forceinline__ int lds_byte(int r, int c) { const int st = (r >> 4) * 2 + (c >> 5), rr = r & 15, cc = c & 31, ob = rr * 64 + cc * 2; return st * 1024 + (ob ^ (((ob >> 9) & 1) << 5)); }
__host__ __device__ __forceinline__ void stage_rc(int b, int& R, int& C) { const int st = b / 1024, sb = b % 1024, swz = sb ^ (((sb >> 9) & 1) << 5); R = (st >> 1) * 16 + swz / 64; C = (st & 1) * 32 + (swz % 64) / 2; }
__host__ __device__ __forceinline__ int perm32(int rho) { const int n = rho >> 4, i = rho & 15; return 8 * (i >> 2) + 4 * n + (i & 3); }

struct Unit { int pm, pn; };
struct Gemm { const bf16_t* A; const bf16_t* Bt; int M, N, K; };

struct StaticOrder {
    int nM, nN, nwg, G, c;
    __host__ __device__ void init(int M, int N, int G_, int c_) { nM = M / BM; nN = N / BM; nwg = nM * nN; G = G_; c = c_; }
    __host__ __device__ bool next(int i, Unit& u) const {
        const long L = (long)i * G + c; if (L >= nwg) return false;
        int wgid = (int)L; { const int q = nwg / NXCD, r = nwg % NXCD, xcd = wgid % NXCD, off = wgid / NXCD; wgid = (xcd < r ? xcd * (q + 1) : r * (q + 1) + (xcd - r) * q) + off; }
        const int nig = WGM * nN, gid = wgid / nig, fm = gid * WGM, gsz = (nM - fm) < WGM ? (nM - fm) : WGM;
        u.pm = fm + ((wgid % nig) % gsz); u.pn = (wgid % nig) / gsz; return true;
    }
    __device__ __forceinline__ void a_ready(const Unit&) const {}
    __device__ __forceinline__ void done(const Unit&) const {}
};
__device__ __forceinline__ unsigned cvt_pk_bf16(float lo, float hi) { unsigned r; asm volatile("v_cvt_pk_bf16_f32 %0, %1, %2" : "=v"(r) : "v"(lo), "v"(hi)); return r; }
template <class Epi, class Sched, bool STAMP = false>
__device__ __forceinline__ void gemm_phase(PG8_LAS unsigned char* lds, const Gemm g, const Sched& S, const Epi& E, unsigned long long* stamps) {
    int tid_l = threadIdx.x; asm volatile("" : "+v"(tid_l));
    const int tid = tid_l, wid = __builtin_amdgcn_readfirstlane(tid >> 6), lane = tid & 63, wr = wid >> 2, wc = wid & 3, fr = lane & 15, fq = lane >> 4;
    const int K = g.K, nt = K / BK;
    int ts_lo = 0, ts_hi = 0, nts = 0; const unsigned long long rt_entry = STAMP ? (unsigned long long)wall_clock64() : 0ull;
#define PG8_STAMP() do { if (STAMP && wid == 0 && nts < 64) { const unsigned long long _c = (unsigned long long)clock64(); \
        ts_lo = (lane == nts) ? (int)(unsigned)_c : ts_lo; ts_hi = (lane == nts) ? (int)(unsigned)(_c >> 32) : ts_hi; ++nts; } } while (0)
    PG8_STAMP();
    unsigned voffA[2], voffB[2];
#pragma unroll
    for (int i = 0; i < 2; ++i) { int R, C; stage_rc(tid * 16 + i * 8192, R, C); const int Rb = Epi::PERM ? ((R & ~31) + perm32(R & 31)) : R;
        voffA[i] = (unsigned)(R * K + C) * 2u; voffB[i] = (unsigned)(Rb * K + C) * 2u; }
    const size_t kstep = (size_t)(BK * 2);
    const size_t hstep = (size_t)HALF * K * 2;
    const size_t tstep = 2 * hstep;
    const unsigned ldsw = (unsigned)wid * 1024u;
    const int aoff = lds_byte(wr * 64 + fr, fq * 8), boff = lds_byte(wc * 32 + fr, fq * 8);
#define PG8_SA(b, h) (((b) * 2 + (h)) * HTB)
#define PG8_SB(b, h) ((4 + (b) * 2 + (h)) * HTB)
#define PG8_STAGE(bufoff, gbase, voff) do { _Pragma("unroll") for (int _i = 0; _i < 2; ++_i) \
        __builtin_amdgcn_global_load_lds((const unsigned*)((const char*)(gbase) + (voff)[_i]), (PG8_LAS unsigned*)(lds + (bufoff) + ldsw + _i * 8192), 16, 0, 0); } while (0)
#define PG8_LDA(dst, b, h) do { _Pragma("unroll") for (int m = 0; m < 4; ++m) _Pragma("unroll") for (int k = 0; k < 2; ++k) dst[m][k] = *(const PG8_LAS bf16x8*)(lds + PG8_SA(b, h) + aoff + m * 2048 + k * 1024); } while (0)
#define PG8_LDB(dst, b, h) do { _Pragma("unroll") for (int n = 0; n < 2; ++n) _Pragma("unroll") for (int k = 0; k < 2; ++k) dst[n][k] = *(const PG8_LAS bf16x8*)(lds + PG8_SB(b, h) + boff + n * 2048 + k * 1024); } while (0)
#define PG8_MMA(ai, bj, At, Bt) do { __builtin_amdgcn_s_setprio(1); _Pragma("unroll") for (int m = 0; m < 4; ++m) _Pragma("unroll") for (int n = 0; n < 2; ++n) _Pragma("unroll") for (int k = 0; k < 2; ++k) \
        acc[ai][bj][m][n] = __builtin_amdgcn_mfma_f32_16x16x32_bf16(Bt[n][k], At[m][k], acc[ai][bj][m][n], 0, 0, 0); __builtin_amdgcn_s_setprio(0); } while (0)
#define PG8_WAIT_V(n) asm volatile("s_waitcnt vmcnt(" #n ")" ::: "memory")
#define PG8_WAIT_L(n) asm volatile("s_waitcnt lgkmcnt(" #n ")" ::: "memory")
#define PG8_BAR __builtin_amdgcn_s_barrier()
#define PG8_SCHED __builtin_amdgcn_sched_barrier(0)
    Unit cur, nxt; int ui = 0;
    if (!S.next(0, cur)) return;
    f32x4 acc[2][2][4][2];
#pragma unroll
    for (int a = 0; a < 2; ++a)
#pragma unroll
        for (int b = 0; b < 2; ++b)
#pragma unroll
            for (int m = 0; m < 4; ++m)
#pragma unroll
                for (int n = 0; n < 2; ++n) acc[a][b][m][n] = (f32x4){0.f, 0.f, 0.f, 0.f};
    bf16x8 At[4][2], B0[2][2], B1[2][2];
    const char* cA = (const char*)g.A + (size_t)cur.pm * tstep; const char* cB = (const char*)g.Bt + (size_t)cur.pn * tstep;
    S.a_ready(cur);
    PG8_STAGE(PG8_SB(0, 0), cB, voffB); PG8_STAGE(PG8_SA(0, 0), cA, voffA); PG8_STAGE(PG8_SB(0, 1), cB + hstep, voffB); PG8_STAGE(PG8_SA(0, 1), cA + hstep, voffA);
    if (wr == 1) PG8_BAR;
    PG8_WAIT_V(4); PG8_BAR;
    PG8_STAGE(PG8_SB(1, 0), cB + kstep, voffB); PG8_STAGE(PG8_SA(1, 0), cA + kstep, voffA); PG8_STAGE(PG8_SB(1, 1), cB + hstep + kstep, voffB);
    PG8_WAIT_V(6); PG8_BAR;
    PG8_STAMP();
    for (;;) {
        const bool has_next = S.next(ui + 1, nxt);
        const char* nA = has_next ? (const char*)g.A + (size_t)nxt.pm * tstep : cA; const char* nB = has_next ? (const char*)g.Bt + (size_t)nxt.pn * tstep : cB;
        for (int t = 0; t < nt; t += 2) {
            const bool last = (t == nt - 2);
            const char* a1 = cA + (size_t)(t + 1) * kstep;
            const char* a2 = last ? nA : cA + (size_t)(t + 2) * kstep; const char* b2 = last ? nB : cB + (size_t)(t + 2) * kstep;
            const char* a3 = a2 + kstep; const char* b3 = b2 + kstep;
            if (last && has_next) S.a_ready(nxt);
            if constexpr (Epi::MIDHOOK) { if (t == 8 || t == 16) E.mid(acc, cur, t >> 3, wr, wc, fr, fq); }
            PG8_LDB(B0, 0, 0); PG8_SCHED; PG8_LDA(At, 0, 0); PG8_STAGE(PG8_SA(1, 1), a1 + hstep, voffA);
            PG8_WAIT_L(8); PG8_BAR; PG8_WAIT_L(0); PG8_MMA(0, 0, At, B0); PG8_BAR; PG8_SCHED;
            PG8_LDB(B1, 0, 1); PG8_STAGE(PG8_SB(0, 0), b2, voffB);
            PG8_BAR; PG8_WAIT_L(0); PG8_MMA(0, 1, At, B1); PG8_BAR;
            PG8_LDA(At, 0, 1); PG8_STAGE(PG8_SA(0, 0), a2, voffA);
            PG8_BAR; PG8_WAIT_L(0); PG8_MMA(1, 0, At, B0); PG8_BAR; PG8_SCHED;
            PG8_STAGE(PG8_SB(0, 1), b2 + hstep, voffB);
            PG8_WAIT_V(6); PG8_BAR; PG8_MMA(1, 1, At, B1); PG8_BAR;
            PG8_LDB(B0, 1, 0); PG8_SCHED; PG8_LDA(At, 1, 0); PG8_STAGE(PG8_SA(0, 1), a2 + hstep, voffA);
            PG8_WAIT_L(8); PG8_BAR; PG8_WAIT_L(0); PG8_MMA(0, 0, At, B0); PG8_BAR; PG8_SCHED;
            PG8_LDB(B1, 1, 1); PG8_STAGE(PG8_SB(1, 0), b3, voffB);
            PG8_BAR; PG8_WAIT_L(0); PG8_MMA(0, 1, At, B1); PG8_BAR;
            PG8_LDA(At, 1, 1); PG8_STAGE(PG8_SA(1, 0), a3, voffA);
            PG8_BAR; PG8_WAIT_L(0); PG8_MMA(1, 0, At, B0); PG8_BAR; PG8_SCHED;
            PG8_STAGE(PG8_SB(1, 1), b3 + hstep, voffB);
            PG8_WAIT_V(6); PG8_BAR; PG8_MMA(1, 1, At, B1); PG8_BAR;
        }
        PG8_STAMP();
        if constexpr (!Epi::AFTER_DRAIN) { E(acc, cur, wr, wc, fr, fq); S.done(cur); }
        PG8_STAMP();
        if (!has_next) break;
#pragma unroll
        for (int a = 0; a < 2; ++a)
#pragma unroll
            for (int b = 0; b < 2; ++b)
#pragma unroll
                for (int m = 0; m < 4; ++m)
#pragma unroll
                    for (int n = 0; n < 2; ++n) acc[a][b][m][n] = (f32x4){0.f, 0.f, 0.f, 0.f};
        cur = nxt; cA = nA; cB = nB; ++ui;
    }
    PG8_WAIT_V(0);
    if (wr == 0) PG8_BAR;
    PG8_BAR;
    if constexpr (Epi::AFTER_DRAIN) { E.fused(acc, cur, wr, wc, fr, fq, lds, wid, lane); S.done(cur); }
    PG8_STAMP();
    if (STAMP && wid == 0) { stamps[lane] = lane < nts ? (((unsigned long long)(unsigned)ts_hi << 32) | (unsigned)ts_lo) : 0ull;
        if (lane == 62) stamps[62] = rt_entry; if (lane == 63) stamps[63] = (unsigned long long)wall_clock64(); }
#undef PG8_STAMP
#undef PG8_SA
#undef PG8_SB
#undef PG8_STAGE
#undef PG8_LDA
#undef PG8_LDB
#undef PG8_MMA
#undef PG8_WAIT_V
#undef PG8_WAIT_L
#undef PG8_BAR
#undef PG8_SCHED
}
}

#define GAS __attribute__((address_space(1)))
#define LAS __attribute__((address_space(3)))
typedef unsigned short bf16;
typedef float f32x4 __attribute__((ext_vector_type(4)));
typedef unsigned u32x4 __attribute__((ext_vector_type(4)));
typedef unsigned u32x2 __attribute__((ext_vector_type(2)));

constexpr int D = 1024, NLAT = 16384, NCTX = 256, T = NLAT + NCTX, DEPTH = 4;
constexpr int IN_W = 5904, PJ = 5888;
constexpr int U0 = 0, Z0 = 512, XB0 = 1024, Q0 = 2048, K0 = 2560, V0 = 2688, GT0 = 2816;
constexpr int NE = 16, ESLOTS = 2304, CAP_L = 2048, CAP_C = 32;
constexpr int NCH = 130;
constexpr float EPS = 1e-6f;
constexpr int NWAVES = 8, NTHR = 512;
constexpr int LDS_BYTES = 155648;
constexpr int MISC_OFF = LDS_BYTES - 1024 + 512;
constexpr int NPH_LAYER = 14, NPHASES = 1 + DEPTH * NPH_LAYER + 1;

constexpr size_t al256(size_t x) { return (x + 255) & ~(size_t)255; }
constexpr size_t WS_CTL = 0, CTL_BYTES = 1u << 20;
constexpr size_t WS_MOD = WS_CTL + CTL_BYTES;
constexpr size_t WS_XC = al256(WS_MOD + (size_t)DEPTH * 2 * 6144 * 4);
constexpr size_t WS_WIN = al256(WS_XC + (size_t)NCTX * D * 4);
constexpr size_t WS_WGLU = al256(WS_WIN + (size_t)PJ * D * 2);
constexpr size_t WS_WBR = al256(WS_WGLU + (size_t)512 * 512 * 2);
constexpr size_t WS_WOUT = al256(WS_WBR + (size_t)3 * 1024 * 512 * 2);
constexpr size_t WS_WUP = al256(WS_WOUT + (size_t)1024 * 1024 * 2);
constexpr size_t WS_WDN = al256(WS_WUP + (size_t)NE * 2048 * 1024 * 2);
constexpr size_t WS_H = al256(WS_WDN + (size_t)NE * 1024 * 1024 * 2);
constexpr size_t WS_PROJ = al256(WS_H + (size_t)T * D * 2);
constexpr size_t WS_XE = WS_PROJ;
constexpr size_t WS_HID = al256(WS_XE + (size_t)NE * ESLOTS * D * 2);
constexpr size_t WS_DT = al256(WS_PROJ + (size_t)T * PJ * 2);
constexpr size_t WS_CV = al256(WS_DT + (size_t)T * 16 * 4);
constexpr size_t WS_S5E = al256(WS_CV + (size_t)T * 1024 * 2);
constexpr size_t WS_S5H = al256(WS_S5E + (size_t)2 * 32 * NCH * 128 * 4);
constexpr size_t WS_YD = al256(WS_S5H + (size_t)2 * 32 * NCH * 128 * 4);
constexpr size_t WS_SA = al256(WS_YD + (size_t)2 * T * 512 * 4);
constexpr size_t WS_Y3 = al256(WS_SA + (size_t)T * 512 * 2);
constexpr size_t WS_PM = al256(WS_Y3 + (size_t)3 * T * 512 * 2);
constexpr size_t WS_MB = al256(WS_PM + (size_t)T * D * 4);
constexpr size_t WS_YE = WS_PM;
constexpr size_t WS_AFFT = al256(WS_MB + (size_t)T * D * 2);
constexpr size_t WS_IDX = al256(WS_AFFT + (size_t)NE * T * 4);
constexpr size_t WS_GSEL = al256(WS_IDX + (size_t)NE * ESLOTS * 4);
constexpr size_t WS_INV = al256(WS_GSEL + (size_t)NE * ESLOTS * 4);
constexpr size_t WS_DEC = al256(WS_INV + (size_t)T * 16 * 4);
constexpr size_t WS_S5BB = al256(WS_DEC + (size_t)2 * NCH * 8 * 4);
constexpr size_t WS_S5CC = al256(WS_S5BB + (size_t)2 * 32 * 128 * 32 * 2);
constexpr size_t WS_S5AB = al256(WS_S5CC + (size_t)2 * 32 * 16 * 128 * 2);
constexpr size_t WS_END = al256(WS_S5AB + (size_t)2 * 32 * 64 * 2 * 4);
constexpr size_t WS_SST = WS_YD;
constexpr size_t WS_HIN = WS_PM;
constexpr size_t WS_YS = al256(WS_HIN + (size_t)2 * NCH * 8 * 8192 * 2);
static_assert(WS_YS + (size_t)T * 512 * 2 <= WS_AFFT, "HIN|YS overlay fits PM|MB");
static_assert(WS_HID + (size_t)NE * ESLOTS * D * 2 <= WS_DT, "XE|HID overlay fits PROJ");
static_assert(WS_YE + (size_t)NE * ESLOTS * D * 2 <= WS_AFFT, "YE overlay fits PM|MB");
static_assert(WS_END < (size_t)1000 * 1024 * 1024, "workspace");
constexpr int CW_BAR = 4096;

__device__ __forceinline__ float bf2f(unsigned b) { return __uint_as_float(b << 16); }
__device__ __forceinline__ float bflo(unsigned w) { return __uint_as_float(w << 16); }
__device__ __forceinline__ float bfhi(unsigned w) { return __uint_as_float(w & 0xffff0000u); }
typedef float f32x2_c __attribute__((ext_vector_type(2)));
typedef __bf16 bf16x2_c __attribute__((ext_vector_type(2)));
__device__ __forceinline__ unsigned pk2(float lo, float hi) { f32x2_c v; v[0] = lo; v[1] = hi; return __builtin_bit_cast(unsigned, __builtin_convertvector(v, bf16x2_c)); }
__device__ __forceinline__ unsigned f2bf(float f) { return pk2(f, 0.f) & 0xffffu; }
__device__ __forceinline__ float wsum(float v) {
#pragma unroll
    for (int o = 1; o < 64; o <<= 1) v += __shfl_xor(v, o);
    return v;
}
__device__ __forceinline__ float wmaxf(float v) {
#pragma unroll
    for (int o = 1; o < 64; o <<= 1) v = fmaxf(v, __shfl_xor(v, o));
    return v;
}
__device__ __forceinline__ float silu_f(float x) { return x / (1.f + expf(-x)); }
__device__ __forceinline__ float sigmoid_f(float x) { return 1.f / (1.f + expf(-x)); }
__device__ __forceinline__ float softplus_f(float x) { return x > 20.f ? x : log1pf(expf(x)); }
__device__ __forceinline__ float gelu_tanh_f(float x) { const float u = 0.7978845608028654f * (x + 0.044715f * x * x * x); return 0.5f * x * (1.f + tanhf(u)); }
#define LDS_FENCE() asm volatile("s_waitcnt lgkmcnt(0)" ::: "memory")
__device__ __forceinline__ int scan_row(int d, int s) { return d == 0 ? s : (s < NCTX ? (NCTX - 1 - s) : (T + NCTX - 1 - s)); }

namespace pg8 {
struct EpiStoreBf16 {
    static constexpr bool PERM = true, AFTER_DRAIN = false, MIDHOOK = false;
    bf16_t* O; int ldc; int sig_tile;
    __device__ __forceinline__ void operator()(const f32x4 (&acc)[2][2][4][2], const Unit& u, int wr, int wc, int fr, int fq) const {
        const int row0 = u.pm * BM + wr * 64 + fr, col0 = u.pn * BM + wc * 32 + 8 * fq; const bool sg = u.pn >= sig_tile;
#pragma unroll
        for (int ai = 0; ai < 2; ++ai)
#pragma unroll
            for (int m = 0; m < 4; ++m) { bf16_t* rowp = O + (size_t)(row0 + ai * HALF + m * 16) * ldc + col0;
#pragma unroll
                for (int bj = 0; bj < 2; ++bj) { f32x4 v0 = acc[ai][bj][m][0], v1 = acc[ai][bj][m][1];
                    if (sg) {
#pragma unroll
                        for (int q = 0; q < 4; ++q) { v0[q] = __builtin_amdgcn_rcpf(1.f + __expf(-v0[q])); v1[q] = __builtin_amdgcn_rcpf(1.f + __expf(-v1[q])); } }
                    u32x4 w; w.x = cvt_pk_bf16(v0[0], v0[1]); w.y = cvt_pk_bf16(v0[2], v0[3]); w.z = cvt_pk_bf16(v1[0], v1[1]); w.w = cvt_pk_bf16(v1[2], v1[3]);
                    *(u32x4*)(rowp + bj * HALF) = w; } }
    }
};
struct EpiGlu {
    static constexpr bool PERM = true, AFTER_DRAIN = false, MIDHOOK = false;
    const bf16_t* A; const float* bias; bf16_t* O;
    __device__ __forceinline__ void operator()(const f32x4 (&acc)[2][2][4][2], const Unit& u, int wr, int wc, int fr, int fq) const {
        const int row0 = u.pm * BM + wr * 64 + fr, col0 = u.pn * BM + wc * 32 + 8 * fq;
#pragma unroll
        for (int ai = 0; ai < 2; ++ai)
#pragma unroll
            for (int m = 0; m < 4; ++m) { const size_t ro = (size_t)(row0 + ai * HALF + m * 16) * 512 + col0;
#pragma unroll
                for (int bj = 0; bj < 2; ++bj) { const f32x4 v0 = acc[ai][bj][m][0], v1 = acc[ai][bj][m][1];
                    const u32x4 a = *(const u32x4*)(A + ro + bj * HALF);
                    const f32x4 b0 = *(const f32x4*)(bias + col0 + bj * HALF), b1 = *(const f32x4*)(bias + col0 + bj * HALF + 4);
                    float o[8];
                    o[0] = bflo(a.x) * sigmoid_f(v0[0] + b0[0]); o[1] = bfhi(a.x) * sigmoid_f(v0[1] + b0[1]);
                    o[2] = bflo(a.y) * sigmoid_f(v0[2] + b0[2]); o[3] = bfhi(a.y) * sigmoid_f(v0[3] + b0[3]);
                    o[4] = bflo(a.z) * sigmoid_f(v1[0] + b1[0]); o[5] = bfhi(a.z) * sigmoid_f(v1[1] + b1[1]);
                    o[6] = bflo(a.w) * sigmoid_f(v1[2] + b1[2]); o[7] = bfhi(a.w) * sigmoid_f(v1[3] + b1[3]);
                    u32x4 w; w.x = cvt_pk_bf16(o[0], o[1]); w.y = cvt_pk_bf16(o[2], o[3]); w.z = cvt_pk_bf16(o[4], o[5]); w.w = cvt_pk_bf16(o[6], o[7]);
                    *(u32x4*)(O + (size_t)(row0 + ai * HALF + m * 16) * 1536 + col0 + bj * HALF) = w; } }
    }
};
struct RowOffOrder {
    StaticOrder b; int off;
    __device__ __forceinline__ void init(int M, int N, int G, int c, int off_) { b.init(M, N, G, c); off = off_; }
    __device__ __forceinline__ bool next(int i, Unit& u) const { if (!b.next(i, u)) return false; u.pm += off; return true; }
    __device__ __forceinline__ void a_ready(const Unit&) const {}
    __device__ __forceinline__ void done(const Unit&) const {}
};
struct EpiMerge {
    static constexpr bool PERM = true, AFTER_DRAIN = false, MIDHOOK = true;
    const bf16_t* proj; bf16_t* MB;
    __device__ __forceinline__ void mid(f32x4 (&acc)[2][2][4][2], const Unit& u, int seg, int wr, int wc, int fr, int fq) const {
        const unsigned base = (unsigned)((u.pm * BM + wr * 64 + fr) * PJ + GT0 + (seg - 1) * 1024 + u.pn * BM + wc * 32 + 8 * fq) * 2u;
        const char* pb = (const char*)proj;
#pragma unroll
        for (int ai = 0; ai < 2; ++ai)
#pragma unroll
            for (int m = 0; m < 4; ++m) {
                u32x4 ga[2], gb[2];
#pragma unroll
                for (int bj = 0; bj < 2; ++bj) { const unsigned o = base + (unsigned)(((ai * HALF + m * 16) * PJ + bj * HALF) * 2);
                    ga[bj] = *(const u32x4*)(pb + o); gb[bj] = *(const u32x4*)(pb + o + 2048u); }
#pragma unroll
                for (int bj = 0; bj < 2; ++bj) { const u32x4 a = ga[bj], b = gb[bj];
                    f32x4& v0 = acc[ai][bj][m][0]; f32x4& v1 = acc[ai][bj][m][1];
                    v0[0] *= bflo(a.x) * __builtin_amdgcn_rcpf(bflo(b.x)); v0[1] *= bfhi(a.x) * __builtin_amdgcn_rcpf(bfhi(b.x));
                    v0[2] *= bflo(a.y) * __builtin_amdgcn_rcpf(bflo(b.y)); v0[3] *= bfhi(a.y) * __builtin_amdgcn_rcpf(bfhi(b.y));
                    v1[0] *= bflo(a.z) * __builtin_amdgcn_rcpf(bflo(b.z)); v1[1] *= bfhi(a.z) * __builtin_amdgcn_rcpf(bfhi(b.z));
                    v1[2] *= bflo(a.w) * __builtin_amdgcn_rcpf(bflo(b.w)); v1[3] *= bfhi(a.w) * __builtin_amdgcn_rcpf(bfhi(b.w)); }
                if (m & 1) asm volatile("" ::: "memory");
            }
    }
    __device__ __forceinline__ void operator()(const f32x4 (&acc)[2][2][4][2], const Unit& u, int wr, int wc, int fr, int fq) const {
        const int row0 = u.pm * BM + wr * 64 + fr, col0 = u.pn * BM + wc * 32 + 8 * fq;
#pragma unroll
        for (int ai = 0; ai < 2; ++ai)
#pragma unroll
            for (int m = 0; m < 4; ++m) { const int row = row0 + ai * HALF + m * 16;
#pragma unroll
                for (int bj = 0; bj < 2; ++bj) { const f32x4 v0 = acc[ai][bj][m][0], v1 = acc[ai][bj][m][1]; const int col = col0 + bj * HALF;
                    const u32x4 g = *(const u32x4*)(proj + (size_t)row * PJ + GT0 + 2048 + col);
                    u32x4 w; w.x = cvt_pk_bf16(bflo(g.x) * v0[0], bfhi(g.x) * v0[1]); w.y = cvt_pk_bf16(bflo(g.y) * v0[2], bfhi(g.y) * v0[3]);
                    w.z = cvt_pk_bf16(bflo(g.z) * v1[0], bfhi(g.z) * v1[1]); w.w = cvt_pk_bf16(bflo(g.w) * v1[2], bfhi(g.w) * v1[3]);
                    *(u32x4*)(MB + (size_t)row * 1024 + col) = w; } }
    }
};
struct EpiResid {
    static constexpr bool PERM = false, AFTER_DRAIN = false, MIDHOOK = false;
    float* XL; float* XC; const float* g_lat; const float* g_ctx;
    __device__ __forceinline__ void operator()(const f32x4 (&acc)[2][2][4][2], const Unit& u, int wr, int wc, int fr, int fq) const {
        const bool isc = (u.pm == 0);
        float* base = isc ? XC : (XL - (size_t)NCTX * D); const float* gv = isc ? g_ctx : g_lat;
        const int row0 = u.pm * BM + wr * 64 + fr, col0 = u.pn * BM + wc * 32 + 4 * fq;
#pragma unroll
        for (int ai = 0; ai < 2; ++ai)
#pragma unroll
            for (int m = 0; m < 4; ++m) { float* rowp = base + (size_t)(row0 + ai * HALF + m * 16) * D + col0;
#pragma unroll
                for (int bj = 0; bj < 2; ++bj)
#pragma unroll
                    for (int n = 0; n < 2; ++n) { float* pp = rowp + bj * HALF + n * 16; const f32x4 g = *(const f32x4*)(gv + col0 + bj * HALF + n * 16);
                        f32x4 x = *(const f32x4*)pp; x += g * acc[ai][bj][m][n]; *(f32x4*)pp = x; } }
    }
};
struct ExpertOrder {
    int G, c, nnt, nmt;
    __device__ __forceinline__ bool next(int i, Unit& u) const { const int L = i * G + c; if (L >= NE * nmt * nnt) return false; const int e = L / (nmt * nnt), rem = L % (nmt * nnt); u.pm = e * 9 + rem % nmt; u.pn = e * nnt + rem / nmt; return true; }
    __device__ __forceinline__ void a_ready(const Unit&) const {}
    __device__ __forceinline__ void done(const Unit&) const {}
};
struct EpiSwiGlu {
    static constexpr bool PERM = true, AFTER_DRAIN = false, MIDHOOK = false;
    bf16_t* HID;
    __device__ __forceinline__ void operator()(const f32x4 (&acc)[2][2][4][2], const Unit& u, int wr, int wc, int fr, int fq) const {
        const int row0 = u.pm * BM + wr * 64 + fr, col0 = (u.pn & 7) * 128 + wc * 32 + 8 * fq;
#pragma unroll
        for (int ai = 0; ai < 2; ++ai)
#pragma unroll
            for (int m = 0; m < 4; ++m) { const f32x4 g0 = acc[ai][0][m][0], g1 = acc[ai][0][m][1], u0 = acc[ai][1][m][0], u1 = acc[ai][1][m][1];
                u32x4 w;
                w.x = cvt_pk_bf16(silu_f(g0[0]) * u0[0], silu_f(g0[1]) * u0[1]); w.y = cvt_pk_bf16(silu_f(g0[2]) * u0[2], silu_f(g0[3]) * u0[3]);
                w.z = cvt_pk_bf16(silu_f(g1[0]) * u1[0], silu_f(g1[1]) * u1[1]); w.w = cvt_pk_bf16(silu_f(g1[2]) * u1[2], silu_f(g1[3]) * u1[3]);
                *(u32x4*)(HID + (size_t)(row0 + ai * HALF + m * 16) * 1024 + col0) = w; }
    }
};
struct EpiDown {
    static constexpr bool PERM = true, AFTER_DRAIN = false, MIDHOOK = false;
    bf16_t* YE; const float* gsel;
    __device__ __forceinline__ void operator()(const f32x4 (&acc)[2][2][4][2], const Unit& u, int wr, int wc, int fr, int fq) const {
        const int row0 = u.pm * BM + wr * 64 + fr, col0 = (u.pn & 3) * BM + wc * 32 + 8 * fq;
#pragma unroll
        for (int ai = 0; ai < 2; ++ai)
#pragma unroll
            for (int m = 0; m < 4; ++m) { const int row = row0 + ai * HALF + m * 16; const float gs = gsel[row];
#pragma unroll
                for (int bj = 0; bj < 2; ++bj) { const f32x4 v0 = acc[ai][bj][m][0] * gs, v1 = acc[ai][bj][m][1] * gs;
                    u32x4 w; w.x = cvt_pk_bf16(v0[0], v0[1]); w.y = cvt_pk_bf16(v0[2], v0[3]); w.z = cvt_pk_bf16(v1[0], v1[1]); w.w = cvt_pk_bf16(v1[2], v1[3]);
                    *(u32x4*)(YE + (size_t)row * 1024 + col0 + bj * HALF) = w; } }
    }
};
}
#define XB_TMO      128
#define XB_XCNT(j)  (256  + 64 * (j))
#define XB_XSUB(j)  (1280 + 64 * (j))
#define XB_XGEN(j)  (2304 + 64 * (j))
#define XB_TOP      3328
#define XB_TOPGEN   3392
#define XCD_BAR_WORDS 3456
#define XB_SPIN_CAP (1u << 18)
#define LAS __attribute__((address_space(3)))

__device__ __forceinline__ unsigned xb_ld(unsigned* p)              { return __hip_atomic_load(p, __ATOMIC_RELAXED, __HIP_MEMORY_SCOPE_AGENT); }
__device__ __forceinline__ unsigned xb_add(unsigned* p, unsigned v) { return __hip_atomic_fetch_add(p, v, __ATOMIC_RELAXED, __HIP_MEMORY_SCOPE_AGENT); }
__device__ __forceinline__ unsigned xb_xcc_id() { return (unsigned)__builtin_amdgcn_s_getreg((3 << 11) | 20) & 0xFu; }
#define XB_SPIN(cond, bar) do { unsigned _sp = 0; while (cond) { __builtin_amdgcn_s_sleep(1); \
    if ((++_sp & 255u) == 0u) { if (xb_ld(&(bar)[XB_TMO])) break; if (_sp > XB_SPIN_CAP) { atomicAdd(&(bar)[XB_TMO], 1u); break; } } } } while (0)

struct XcdBarrier {
    unsigned* bar; unsigned x;
    volatile LAS unsigned* st;
};

__device__ __forceinline__ XcdBarrier xcd_barrier_post(unsigned* bar, volatile LAS unsigned* st) {
    XcdBarrier b; b.bar = bar; b.x = xb_xcc_id(); b.st = st;
    if (threadIdx.x == 0) (void)xb_add(&bar[XB_XCNT(b.x)], 1u);
    return b;
}
__device__ __forceinline__ void xcd_barrier_complete(unsigned* bar, unsigned x, unsigned& nloc, unsigned& nx) {
    const unsigned G = gridDim.x * gridDim.y * gridDim.z;
    unsigned sum, cnt, mine, sp = 0u;
    for (;;) {
        sum = 0u; cnt = 0u; mine = 0u;
#pragma unroll
        for (unsigned j = 0; j < 16; ++j) { const unsigned c = xb_ld(&bar[XB_XCNT(j)]); sum += c; cnt += (c > 0u) ? 1u : 0u; mine = (j == x) ? c : mine; }
        if (sum == G) break;
        __builtin_amdgcn_s_sleep(1);
        if ((++sp & 255u) == 0u) { if (xb_ld(&bar[XB_TMO])) break; if (sp > XB_SPIN_CAP) { atomicAdd(&bar[XB_TMO], 1u); break; } }
    }
    nloc = mine > 0u ? mine : 1u; nx = cnt > 0u ? cnt : 1u;
}

__device__ __forceinline__ void xcd_barrier(const XcdBarrier& b) {
    asm volatile("s_waitcnt vmcnt(0)" ::: "memory");
    __syncthreads();
    if (threadIdx.x == 0) {
        unsigned* bar = b.bar;
        __builtin_amdgcn_s_waitcnt(0);
        unsigned nloc = b.st[0], nx = b.st[1];
        if (nloc == 0u) { xcd_barrier_complete(bar, b.x, nloc, nx); b.st[0] = nloc; b.st[1] = nx; }
        const unsigned old = xb_add(&bar[XB_XSUB(b.x)], 1u);
        const unsigned gen = old / nloc;
        if (old + 1u == (gen + 1u) * nloc) {
            __builtin_amdgcn_fence(__ATOMIC_RELEASE, "agent");
            asm volatile("s_waitcnt vmcnt(0)" ::: "memory");
            const unsigned og = xb_add(&bar[XB_TOP], 1u);
            const unsigned tg = og / nx;
            if (og + 1u == (tg + 1u) * nx) xb_add(&bar[XB_TOPGEN], 1u);
            else XB_SPIN(xb_ld(&bar[XB_TOPGEN]) == tg, bar);
            __builtin_amdgcn_fence(__ATOMIC_ACQUIRE, "agent");
            xb_add(&bar[XB_XGEN(b.x)], 1u);
            asm volatile("s_waitcnt vmcnt(0)" ::: "memory");
        } else {
            XB_SPIN(xb_ld(&bar[XB_XGEN(b.x)]) == gen, bar);
            __builtin_amdgcn_fence(__ATOMIC_ACQUIRE, "agent");
            asm volatile("s_waitcnt vmcnt(0)" ::: "memory");
        }
    }
    __syncthreads();
}


struct P {
    const float *x, *c, *ctx, *c_ctx, *w_mod, *b_mod, *norm1_g, *norm2_g, *w_in, *lam_re, *lam_im, *log_dt, *b_re, *b_im, *c_re, *c_im, *s5_d, *w_glu, *b_glu,
        *conv_w, *conv_b, *a_log, *dt_bias, *ssd_d, *ssd_norm_g, *sink, *w_branch, *w_out, *w_router, *w_eg, *w_eu, *w_ed, *final_g;
    float* XL;
    float *MOD, *XC, *DT, *S5E, *S5H, *YD, *PM, *AFFT, *GSEL;
    bf16 *WIN, *WGLU, *WBR, *WOUT, *WUP, *WDN, *H, *PROJ, *XE, *HID, *CV, *SA, *Y3, *MB, *YE;
    int *IDX, *INV;
    int tid, lane, wave, bid, G;
};


constexpr int PTAB_OFF = LDS_BYTES - 1024;
__device__ __forceinline__ unsigned long long ld_tab(volatile LAS unsigned* t, int k) {
    const unsigned lo = __builtin_amdgcn_readfirstlane(t[2 * k]), hi = __builtin_amdgcn_readfirstlane(t[2 * k + 1]);
    return ((unsigned long long)hi << 32) | lo;
}
__device__ __forceinline__ void build_P(P& p, LAS unsigned char* lds) {
    int tid_l = threadIdx.x, bid_l = blockIdx.x, g_l = gridDim.x;
    asm volatile("" : "+v"(tid_l), "+s"(bid_l), "+s"(g_l));
    p.tid = tid_l; p.lane = p.tid & 63; p.wave = __builtin_amdgcn_readfirstlane(p.tid >> 6); p.bid = bid_l; p.G = g_l;
    unsigned tbase = (unsigned)(size_t)(lds + PTAB_OFF); asm volatile("" : "+v"(tbase));
    volatile LAS unsigned* tb = (volatile LAS unsigned*)(size_t)tbase;
#define INP(k) ((const float*)ld_tab(tb, k))
    p.x = INP(0); p.c = INP(1); p.ctx = INP(2); p.c_ctx = INP(3); p.w_mod = INP(4); p.b_mod = INP(5); p.norm1_g = INP(6); p.norm2_g = INP(7);
    p.w_in = INP(8); p.lam_re = INP(9); p.lam_im = INP(10); p.log_dt = INP(11); p.b_re = INP(12); p.b_im = INP(13); p.c_re = INP(14); p.c_im = INP(15);
    p.s5_d = INP(16); p.w_glu = INP(17); p.b_glu = INP(18); p.conv_w = INP(19); p.conv_b = INP(20); p.a_log = INP(21); p.dt_bias = INP(22); p.ssd_d = INP(23);
    p.ssd_norm_g = INP(24); p.sink = INP(25); p.w_branch = INP(26); p.w_out = INP(27); p.w_router = INP(28); p.w_eg = INP(29); p.w_eu = INP(30); p.w_ed = INP(31);
    p.final_g = INP(32);
#undef INP
    p.XL = (float*)ld_tab(tb, 33);
    unsigned char* ws = (unsigned char*)ld_tab(tb, 34);
    p.MOD = (float*)(ws + WS_MOD); p.XC = (float*)(ws + WS_XC); p.DT = (float*)(ws + WS_DT); p.S5E = (float*)(ws + WS_S5E); p.S5H = (float*)(ws + WS_S5H); p.YD = (float*)(ws + WS_YD);
    p.PM = (float*)(ws + WS_PM); p.AFFT = (float*)(ws + WS_AFFT); p.GSEL = (float*)(ws + WS_GSEL);
    p.WIN = (bf16*)(ws + WS_WIN); p.WGLU = (bf16*)(ws + WS_WGLU); p.WBR = (bf16*)(ws + WS_WBR); p.WOUT = (bf16*)(ws + WS_WOUT); p.WUP = (bf16*)(ws + WS_WUP); p.WDN = (bf16*)(ws + WS_WDN);
    p.H = (bf16*)(ws + WS_H); p.PROJ = (bf16*)(ws + WS_PROJ); p.XE = (bf16*)(ws + WS_XE); p.HID = (bf16*)(ws + WS_HID); p.CV = (bf16*)(ws + WS_CV); p.SA = (bf16*)(ws + WS_SA);
    p.Y3 = (bf16*)(ws + WS_Y3); p.MB = (bf16*)(ws + WS_MB); p.YE = (bf16*)(ws + WS_YE);
    p.IDX = (int*)(ws + WS_IDX); p.INV = (int*)(ws + WS_INV);
}
__device__ __forceinline__ void phase_mod(const P& p, LAS unsigned char* lds) {
    LAS float* sc = (LAS float*)lds;
    LAS float* part = sc + 2048;
    for (int i = p.tid; i < 1024; i += NTHR) { sc[i] = silu_f(p.c[i]); sc[1024 + i] = silu_f(p.c_ctx[i]); }
    __syncthreads();
    for (int it = p.bid; it < DEPTH * 48; it += p.G) {
        const int l = it / 48, cb = it % 48, c0 = cb * 128 + 2 * p.lane;
        const float* W = p.w_mod + (size_t)l * 1024 * 6144 + c0;
        float a00 = 0.f, a01 = 0.f, a10 = 0.f, a11 = 0.f;
        const int kb = p.wave * 128;
#pragma unroll 8
        for (int k = kb; k < kb + 128; ++k) { const float2 w = *(const float2*)(W + (size_t)k * 6144); const float s0 = sc[k], s1 = sc[1024 + k];
            a00 += s0 * w.x; a01 += s0 * w.y; a10 += s1 * w.x; a11 += s1 * w.y; }
        part[(p.wave * 2 + 0) * 128 + 2 * p.lane] = a00; part[(p.wave * 2 + 0) * 128 + 2 * p.lane + 1] = a01;
        part[(p.wave * 2 + 1) * 128 + 2 * p.lane] = a10; part[(p.wave * 2 + 1) * 128 + 2 * p.lane + 1] = a11;
        __syncthreads();
        if (p.tid < 256) { const int s = p.tid >> 7, col = p.tid & 127; float r = p.b_mod[l * 6144 + cb * 128 + col];
#pragma unroll
            for (int w = 0; w < 8; ++w) r += part[(w * 2 + s) * 128 + col];
            p.MOD[(size_t)(l * 2 + s) * 6144 + cb * 128 + col] = r; }
        __syncthreads();
    }
}

__device__ __forceinline__ void tr_item(const float* src, int ldw, int K, bf16* dst, int kb, LAS float* scr, int lane) {
    const int k0 = 64 * kb, kr = lane >> 4, nq = lane & 15;
    f32x4 v[16];
#pragma unroll
    for (int i = 0; i < 16; ++i) v[i] = *(const f32x4*)(src + (size_t)(k0 + 4 * i + kr) * ldw + 4 * nq);
#pragma unroll
    for (int i = 0; i < 16; ++i) { const int k = 4 * i + kr, c = (k >> 3) & 7; *(LAS f32x4*)(scr + k * 64 + 4 * (nq ^ c)) = v[i]; }
    LDS_FENCE();
    const int c = lane & 7;
#pragma unroll
    for (int j = 0; j < 8; ++j) { const int n = (lane >> 3) + 8 * j; const LAS float* s = scr + (8 * c) * 64 + (n ^ (c << 2));
        u32x4 o; o.x = pk2(s[0 * 64], s[1 * 64]); o.y = pk2(s[2 * 64], s[3 * 64]); o.z = pk2(s[4 * 64], s[5 * 64]); o.w = pk2(s[6 * 64], s[7 * 64]);
        *(u32x4*)(dst + (size_t)n * K + k0 + 8 * c) = o; }
    LDS_FENCE();
}
__device__ __forceinline__ void convert_weights(const P& p, int l, LAS unsigned char* lds) {
    LAS float* scr = (LAS float*)(lds + p.wave * 16384);
    const int gw = p.bid * NWAVES + p.wave, NGW = p.G * NWAVES;
    constexpr int I_A = 32 * 16, I_B = 60 * 16, I_GLU = 8 * 8, I_BR = 3 * 16 * 8, I_OUT = 16 * 16, I_E = 16 * 16 * 16;
    constexpr int NIT = I_A + I_B + I_GLU + I_BR + I_OUT + 3 * I_E;
    const float* win = p.w_in + (size_t)l * 1024 * IN_W;
    for (int it = gw; it < NIT; it += NGW) {
        int r = it;
        if (r < I_A) { const int nb = r >> 4, kb = r & 15; tr_item(win + 64 * nb, IN_W, 1024, p.WIN + (size_t)(64 * nb) * 1024, kb, scr, p.lane); continue; } r -= I_A;
        if (r < I_B) { const int nb = r >> 4, kb = r & 15; tr_item(win + 2064 + 64 * nb, IN_W, 1024, p.WIN + (size_t)(2048 + 64 * nb) * 1024, kb, scr, p.lane); continue; } r -= I_B;
        if (r < I_GLU) { const int nb = r >> 3, kb = r & 7; tr_item(p.w_glu + (size_t)l * 512 * 512 + 64 * nb, 512, 512, p.WGLU + (size_t)(64 * nb) * 512, kb, scr, p.lane); continue; } r -= I_GLU;
        if (r < I_BR) { const int kk = r >> 7, nb = (r >> 3) & 15, kb = r & 7;
            tr_item(p.w_branch + ((size_t)l * 3 + kk) * 512 * 1024 + 64 * nb, 1024, 1536, p.WBR + (size_t)(64 * nb) * 1536 + kk * 512, kb, scr, p.lane); continue; } r -= I_BR;
        if (r < I_OUT) { const int nb = r >> 4, kb = r & 15; tr_item(p.w_out + (size_t)l * 1024 * 1024 + 64 * nb, 1024, 1024, p.WOUT + (size_t)(64 * nb) * 1024, kb, scr, p.lane); continue; } r -= I_OUT;
        const int which = r / I_E; r -= which * I_E;
        const int e = r >> 8, nb = (r >> 4) & 15, kb = r & 15;
        const size_t eo = ((size_t)l * NE + e) * 1024 * 1024;
        if (which == 0) tr_item(p.w_eg + eo + 64 * nb, 1024, 1024, p.WUP + (size_t)(e * 2048 + 256 * (nb >> 1) + 64 * (nb & 1)) * 1024, kb, scr, p.lane);
        else if (which == 1) tr_item(p.w_eu + eo + 64 * nb, 1024, 1024, p.WUP + (size_t)(e * 2048 + 256 * (nb >> 1) + 128 + 64 * (nb & 1)) * 1024, kb, scr, p.lane);
        else tr_item(p.w_ed + eo + 64 * nb, 1024, 1024, p.WDN + (size_t)(e * 1024 + 64 * nb) * 1024, kb, scr, p.lane);
    }
}

template <int MODE> __device__ __forceinline__ void row_pass(const P& p, int l, LAS unsigned char* lds, bool with_ctx = true) {
    LAS float* W16 = (LAS float*)lds;
    if (MODE != 2) {
        const float* src = (MODE == 0) ? (p.w_in + (size_t)l * 1024 * IN_W + 2048) : (p.w_router + (size_t)l * 1024 * 16);
        const int ld = (MODE == 0) ? IN_W : 16;
        for (int i = p.tid; i < 1024 * 16; i += NTHR) { const int k = i >> 4, j = i & 15; W16[k * 20 + j] = src[(size_t)k * ld + j]; }
        __syncthreads();
    }
    const int gw = p.bid * NWAVES + p.wave, NGW = p.G * NWAVES, lane = p.lane;
    for (int row = gw + ((MODE == 2 || !with_ctx) ? NCTX : 0); row < T; row += NGW) {
        const bool isc = row < NCTX;
        float* xrow = isc ? (p.XC + (size_t)row * D) : (p.XL + (size_t)(row - NCTX) * D);
        float v[16];
        if (MODE == 0 && l == 0) { const float* s = isc ? (p.ctx + (size_t)row * D) : (p.x + (size_t)(row - NCTX) * D);
#pragma unroll
            for (int i = 0; i < 16; ++i) v[i] = s[lane + 64 * i];
        } else {
#pragma unroll
            for (int i = 0; i < 16; ++i) v[i] = xrow[lane + 64 * i];
        }
        if ((MODE == 0 && l > 0) || MODE == 2) {
            const int lp = (MODE == 2) ? (DEPTH - 1) : (l - 1);
            const float* g2 = p.MOD + (size_t)(lp * 2 + (isc ? 1 : 0)) * 6144 + 5 * D;
            float s[16];
#pragma unroll
            for (int i = 0; i < 16; ++i) s[i] = 0.f;
            for (int e = 0; e < NE; ++e) { const int slot = p.INV[(size_t)row * 16 + e];
                if (slot >= 0) { const bf16* yr = p.YE + ((size_t)e * ESLOTS + slot) * D;
#pragma unroll
                    for (int i = 0; i < 16; ++i) s[i] += bf2f(yr[lane + 64 * i]); } }
#pragma unroll
            for (int i = 0; i < 16; ++i) v[i] += g2[lane + 64 * i] * s[i];
        }
        if (MODE == 0) {
#pragma unroll
            for (int i = 0; i < 16; ++i) xrow[lane + 64 * i] = v[i];
        }
        float ss = 0.f;
#pragma unroll
        for (int i = 0; i < 16; ++i) ss += v[i] * v[i];
        const float rstd = rsqrtf(wsum(ss) * (1.f / D) + EPS);
        if (MODE == 2) {
#pragma unroll
            for (int i = 0; i < 16; ++i) xrow[lane + 64 * i] = v[i] * rstd * p.final_g[lane + 64 * i];
            continue;
        }
        const float* gam = (MODE == 0 ? p.norm1_g : p.norm2_g) + (size_t)l * D;
        const float* md = p.MOD + (size_t)(l * 2 + (isc ? 1 : 0)) * 6144 + (MODE == 0 ? 0 : 3 * D);
        bf16* hrow = p.H + (size_t)row * D;
        float acc[16];
#pragma unroll
        for (int j = 0; j < 16; ++j) acc[j] = 0.f;
#pragma unroll
        for (int i = 0; i < 16; ++i) { const int k = lane + 64 * i;
            const float hv = v[i] * rstd * gam[k] * (1.f + md[D + k]) + md[k];
            hrow[k] = (bf16)f2bf(hv);
            const LAS f32x4* wr = (const LAS f32x4*)(W16 + k * 20);
            const f32x4 w0 = wr[0], w1 = wr[1], w2 = wr[2], w3 = wr[3];
            acc[0] += hv * w0[0]; acc[1] += hv * w0[1]; acc[2] += hv * w0[2]; acc[3] += hv * w0[3];
            acc[4] += hv * w1[0]; acc[5] += hv * w1[1]; acc[6] += hv * w1[2]; acc[7] += hv * w1[3];
            acc[8] += hv * w2[0]; acc[9] += hv * w2[1]; acc[10] += hv * w2[2]; acc[11] += hv * w2[3];
            acc[12] += hv * w3[0]; acc[13] += hv * w3[1]; acc[14] += hv * w3[2]; acc[15] += hv * w3[3];
            if ((i & 1) == 1) asm volatile("" ::: "memory"); }
#pragma unroll
        for (int j = 0; j < 16; ++j) acc[j] = wsum(acc[j]);
        if (MODE == 0) {
            float mine = 0.f;
#pragma unroll
            for (int j = 0; j < 16; ++j) mine = (lane == j) ? acc[j] : mine;
            if (lane < 16) p.DT[(size_t)row * 16 + lane] = softplus_f(mine + p.dt_bias[l * 16 + lane]);
        } else {
            float mx = acc[0];
#pragma unroll
            for (int j = 1; j < 16; ++j) mx = fmaxf(mx, acc[j]);
            float sum = 0.f, mine = 0.f;
#pragma unroll
            for (int j = 0; j < 16; ++j) { const float e = expf(acc[j] - mx); sum += e; mine = (lane == j) ? e : mine; }
            if (lane < 16) p.AFFT[(size_t)lane * T + row] = mine / sum;
        }
    }
}

struct S5Lane { float abr, abi; float bbr[16], bbi[16]; };
__device__ __forceinline__ void s5_lane_params(const P& p, int l, int d, int g, int lane, S5Lane& o, bool withB) {
    const size_t gi = ((size_t)(l * 2 + d) * 32 + g);
    const float lr = p.lam_re[gi * 64 + lane], li = p.lam_im[gi * 64 + lane], dt = expf(p.log_dt[gi]);
    const float mag = expf(lr * dt); float sn, cs; sincosf(li * dt, &sn, &cs);
    o.abr = mag * cs; o.abi = mag * sn;
    if (withB) {
        const float den = lr * lr + li * li;
        const float fr = ((o.abr - 1.f) * lr + o.abi * li) / den, fi = (o.abi * lr - (o.abr - 1.f) * li) / den;
        const f32x4* br = (const f32x4*)(p.b_re + (gi * 64 + lane) * 16); const f32x4* bi = (const f32x4*)(p.b_im + (gi * 64 + lane) * 16);
#pragma unroll
        for (int q = 0; q < 4; ++q) { const f32x4 r4 = br[q], i4 = bi[q];
#pragma unroll
            for (int j = 0; j < 4; ++j) { o.bbr[4 * q + j] = fr * r4[j] - fi * i4[j]; o.bbi[4 * q + j] = fr * i4[j] + fi * r4[j]; } }
    }
}
__device__ __forceinline__ void s5_stage_u(const P& p, int r0, int g, LAS unsigned char* ub, int lane) {
#pragma unroll
    for (int j = 0; j < 4; ++j) { const int q = lane + 64 * j, i = q >> 1, half = q & 1;
        const u32x4 w = *(const u32x4*)(p.PROJ + (size_t)(r0 + i) * PJ + U0 + g * 16 + half * 8);
        *(LAS u32x4*)(ub + i * 32 + half * 16) = w; }
    LDS_FENCE();
}
__device__ __forceinline__ void s5_step(const S5Lane& s, const LAS unsigned char* ub, int i, float& hr, float& hi) {
    const u32x4 a = *(const LAS u32x4*)(ub + i * 32), b = *(const LAS u32x4*)(ub + i * 32 + 16);
    float u[16];
    u[0] = bflo(a.x); u[1] = bfhi(a.x); u[2] = bflo(a.y); u[3] = bfhi(a.y); u[4] = bflo(a.z); u[5] = bfhi(a.z); u[6] = bflo(a.w); u[7] = bfhi(a.w);
    u[8] = bflo(b.x); u[9] = bfhi(b.x); u[10] = bflo(b.y); u[11] = bfhi(b.y); u[12] = bflo(b.z); u[13] = bfhi(b.z); u[14] = bflo(b.w); u[15] = bfhi(b.w);
    float br = 0.f, bi = 0.f;
#pragma unroll
    for (int k = 0; k < 16; ++k) { br += s.bbr[k] * u[k]; bi += s.bbi[k] * u[k]; }
    const float nr = s.abr * hr - s.abi * hi + br, ni = s.abr * hi + s.abi * hr + bi;
    hr = nr; hi = ni;
}

__device__ __forceinline__ void phase_premix(const P& p, int l, LAS unsigned char* lds, bool do_rope) {
    const float* cw = p.conv_w + (size_t)l * 5 * 1024; const float* cb = p.conv_b + (size_t)l * 1024;
    for (int idx = p.bid * NTHR + p.tid; idx < T * 128; idx += p.G * NTHR) {
        const int row = idx >> 7, c8 = (idx & 127) * 8;
        const int lo = row < NCTX ? 0 : NCTX, hi = row < NCTX ? NCTX : T;
        float a[8];
        { const f32x4 b0 = *(const f32x4*)(cb + c8), b1 = *(const f32x4*)(cb + c8 + 4);
          a[0] = b0[0]; a[1] = b0[1]; a[2] = b0[2]; a[3] = b0[3]; a[4] = b1[0]; a[5] = b1[1]; a[6] = b1[2]; a[7] = b1[3]; }
#pragma unroll
        for (int j = 0; j < 5; ++j) { const int r = row + j - 2;
            if (r >= lo && r < hi) { const u32x4 xv = *(const u32x4*)(p.PROJ + (size_t)r * PJ + XB0 + c8);
                const f32x4 w0 = *(const f32x4*)(cw + j * 1024 + c8), w1 = *(const f32x4*)(cw + j * 1024 + c8 + 4);
                a[0] += w0[0] * bflo(xv.x); a[1] += w0[1] * bfhi(xv.x); a[2] += w0[2] * bflo(xv.y); a[3] += w0[3] * bfhi(xv.y);
                a[4] += w1[0] * bflo(xv.z); a[5] += w1[1] * bfhi(xv.z); a[6] += w1[2] * bflo(xv.w); a[7] += w1[3] * bfhi(xv.w); } }
        u32x4 o; o.x = pk2(silu_f(a[0]), silu_f(a[1])); o.y = pk2(silu_f(a[2]), silu_f(a[3])); o.z = pk2(silu_f(a[4]), silu_f(a[5])); o.w = pk2(silu_f(a[6]), silu_f(a[7]));
        *(u32x4*)(p.CV + (size_t)row * 1024 + c8) = o;
    }
    if (do_rope) for (int idx = p.bid * NTHR + p.tid; idx < NLAT * 160; idx += p.G * NTHR) {
        const int i = idx & 15, hh = (idx >> 4) % 10, t = idx / 160;
        bf16* base = p.PROJ + (size_t)(NCTX + t) * PJ + (hh < 8 ? Q0 + hh * 64 : K0 + (hh - 8) * 64);
        const float inv = exp2f(-(float)i * 0.83048202372184058696f);
        const float ar = (float)(t >> 6) * inv, ac = (float)(t & 63) * inv;
        float sr, cr, sc, cc; sincosf(ar, &sr, &cr); sincosf(ac, &sc, &cc);
        { const float x1 = bf2f(base[i]), x2 = bf2f(base[16 + i]); base[i] = (bf16)f2bf(x1 * cr - x2 * sr); base[16 + i] = (bf16)f2bf(x2 * cr + x1 * sr); }
        { const float x1 = bf2f(base[32 + i]), x2 = bf2f(base[48 + i]); base[32 + i] = (bf16)f2bf(x1 * cc - x2 * sc); base[48 + i] = (bf16)f2bf(x2 * cc + x1 * sc); }
    }
}

__device__ __forceinline__ void ssd_scan_naive(const P& p, int l) {
    for (int it = p.bid * 4 + p.wave; it < 1024; it += p.G * 4) {
        const int d = it >> 9, hd = (it >> 6) & 7, pp = it & 63, grp = hd >> 2;
        const float a = -expf(p.a_log[l * 16 + d * 8 + hd]);
        const int colB = 512 + grp * 128 + p.lane, colC = 768 + grp * 128 + p.lane, colX = hd * 64 + pp, dcol = d * 8 + hd;
        float h0 = 0.f, h1 = 0.f;
        for (int s0 = 0; s0 < T; s0 += 8) {
            unsigned b0[8], b1[8], c0[8], c1[8], xx[8]; float dtv[8]; int rr[8];
#pragma unroll
            for (int j = 0; j < 8; ++j) { const int r = scan_row(d, s0 + j); rr[j] = r; const bf16* cv = p.CV + (size_t)r * 1024;
                b0[j] = cv[colB]; b1[j] = cv[colB + 64]; c0[j] = cv[colC]; c1[j] = cv[colC + 64]; xx[j] = cv[colX]; dtv[j] = p.DT[(size_t)r * 16 + dcol]; }
#pragma unroll
            for (int j = 0; j < 8; ++j) { const float dec = expf(dtv[j] * a), dx = dtv[j] * bf2f(xx[j]);
                h0 = dec * h0 + dx * bf2f(b0[j]); h1 = dec * h1 + dx * bf2f(b1[j]);
                const float y = wsum(bf2f(c0[j]) * h0 + bf2f(c1[j]) * h1);
                if (p.lane == 0) p.YD[((size_t)d * T + rr[j]) * 512 + colX] = y; }
        }
    }
}
__device__ __forceinline__ void s5_carry_scan(const P& p, int l, int aw, int NAW) {
    for (int it = aw; it < 64; it += NAW) {
        const int d = it >> 5, g = it & 31;
        S5Lane s; s5_lane_params(p, l, d, g, p.lane, s, false);
        float ar = s.abr, ai = s.abi;
#pragma unroll
        for (int q = 0; q < 7; ++q) { const float nr = ar * ar - ai * ai, ni = 2.f * ar * ai; ar = nr; ai = ni; }
        float hr = 0.f, hi = 0.f;
        const float* E = p.S5E + (size_t)(d * 32 + g) * NCH * 128; float* Hn = p.S5H + (size_t)(d * 32 + g) * NCH * 128;
        for (int c = 0; c < NCH; ++c) { Hn[c * 128 + p.lane] = hr; Hn[c * 128 + 64 + p.lane] = hi;
            const float er = E[c * 128 + p.lane], ei = E[c * 128 + 64 + p.lane];
            const float nr = ar * hr - ai * hi + er, ni = ar * hi + ai * hr + ei; hr = nr; hi = ni; }
    }
}
__device__ __forceinline__ void attention_naive(const P& p, int l, int aw, int NAW, LAS float* pbuf) {
    const int lane = p.lane;
    for (int it = aw; it < T * 8; it += NAW) {
        const int row = it >> 3, hq = it & 7, kvh = hq >> 2;
        const bool isc = row < NCTX; const int t = row - NCTX;
        const int jlo = isc ? 0 : (t - 128 < 0 ? 0 : t - 128), jhi = isc ? -1 : (t + 128 > NLAT - 1 ? NLAT - 1 : t + 128);
        const int nloc = jhi - jlo + 1, nk = nloc + NCTX;
        const float sink = p.sink[l * 8 + hq];
        float q[64];
        { const u32x4* qp = (const u32x4*)(p.PROJ + (size_t)row * PJ + Q0 + hq * 64);
#pragma unroll
          for (int c = 0; c < 8; ++c) { const u32x4 w = qp[c]; q[8 * c] = bflo(w.x); q[8 * c + 1] = bfhi(w.x); q[8 * c + 2] = bflo(w.y); q[8 * c + 3] = bfhi(w.y);
              q[8 * c + 4] = bflo(w.z); q[8 * c + 5] = bfhi(w.z); q[8 * c + 6] = bflo(w.w); q[8 * c + 7] = bfhi(w.w); } }
        float sc[9]; float mx = sink;
#pragma unroll
        for (int i = 0; i < 9; ++i) { const int kk = lane + 64 * i; float s = -INFINITY;
            if (kk < nk) { const int krow = kk < nloc ? NCTX + jlo + kk : kk - nloc;
                const u32x4* kp = (const u32x4*)(p.PROJ + (size_t)krow * PJ + K0 + kvh * 64); float dot = 0.f;
#pragma unroll
                for (int c = 0; c < 8; ++c) { const u32x4 w = kp[c];
                    dot += q[8 * c] * bflo(w.x) + q[8 * c + 1] * bfhi(w.x) + q[8 * c + 2] * bflo(w.y) + q[8 * c + 3] * bfhi(w.y)
                         + q[8 * c + 4] * bflo(w.z) + q[8 * c + 5] * bfhi(w.z) + q[8 * c + 6] * bflo(w.w) + q[8 * c + 7] * bfhi(w.w); }
                s = dot * 0.125f; }
            sc[i] = s; mx = fmaxf(mx, s); }
        mx = wmaxf(mx);
        float sum = 0.f;
#pragma unroll
        for (int i = 0; i < 9; ++i) { const int kk = lane + 64 * i; const float e = (kk < nk) ? expf(sc[i] - mx) : 0.f; pbuf[kk] = e; sum += e; }
        const float den = wsum(sum) + expf(sink - mx);
        LDS_FENCE();
        float o = 0.f;
        const bf16* vb = p.PROJ + V0 + kvh * 64 + lane;
#pragma unroll 4
        for (int kk = 0; kk < nk; ++kk) { const int vrow = kk < nloc ? NCTX + jlo + kk : kk - nloc; o += pbuf[kk] * bf2f(vb[(size_t)vrow * PJ]); }
        p.Y3[((size_t)2 * T + row) * 512 + hq * 64 + lane] = (bf16)f2bf(o / den);
        LDS_FENCE();
    }
}

__device__ __forceinline__ void phase_postmix(const P& p, int l, LAS unsigned char* lds) {
    constexpr int CSH_BYTES = 2 * 2 * 16 * 68 * 4, WREG = 16640;
    LAS float* Csh = (LAS float*)lds;
    LAS unsigned char* wreg = lds + CSH_BYTES + p.wave * WREG;
    LAS unsigned char* ub = wreg;
    LAS float* Hb = (LAS float*)(wreg + 4096);
    LAS float* Yb = (LAS float*)(wreg + 4096 + 4224);
    const int lane = p.lane;
    for (int it = p.bid; it < 32 * 17; it += p.G) {
        const int g = it / 17, chunk = (it % 17) * 8 + p.wave;
        __syncthreads();
        for (int i = p.tid; i < 2 * 2 * 16 * 64; i += NTHR) { const int pq = i & 63, k = (i >> 6) & 15, ri = (i >> 10) & 1, d = i >> 11;
            const float* src = ri ? p.c_im : p.c_re; Csh[((d * 2 + ri) * 16 + k) * 68 + pq] = src[(((size_t)(l * 2 + d) * 32 + g) * 16 + k) * 64 + pq]; }
        __syncthreads();
        if (chunk < NCH) {
            const int r0 = 128 * chunk;
            s5_stage_u(p, r0, g, ub, lane);
            for (int d = 0; d < 2; ++d) {
                S5Lane s; s5_lane_params(p, l, d, g, lane, s, true);
                const int cs = (d == 0) ? chunk : (chunk < 2 ? 1 - chunk : NCH + 1 - chunk);
                const float* Hn = p.S5H + ((size_t)(d * 32 + g) * NCH + cs) * 128;
                float hr = Hn[lane], hi = Hn[64 + lane];
                const LAS float* Cr = Csh + (d * 2 + 0) * 16 * 68; const LAS float* Ci = Csh + (d * 2 + 1) * 16 * 68;
                for (int sub = 0; sub < 16; ++sub) {
#pragma unroll
                    for (int j = 0; j < 8; ++j) { const int is = sub * 8 + j; s5_step(s, ub, d == 0 ? is : 127 - is, hr, hi); Hb[j * 132 + lane] = hr; Hb[j * 132 + 64 + lane] = hi; }
                    LDS_FENCE();
#pragma unroll
                    for (int m = 0; m < 2; ++m) { const int o = lane + 64 * m, j = o >> 4, k = o & 15; float y = 0.f;
#pragma unroll
                        for (int q = 0; q < 16; ++q) { const f32x4 cr = *(const LAS f32x4*)(Cr + k * 68 + 4 * q), ci = *(const LAS f32x4*)(Ci + k * 68 + 4 * q);
                            const f32x4 xr = *(const LAS f32x4*)(Hb + j * 132 + 4 * q), xi = *(const LAS f32x4*)(Hb + j * 132 + 64 + 4 * q);
                            y += cr[0] * xr[0] + cr[1] * xr[1] + cr[2] * xr[2] + cr[3] * xr[3] - ci[0] * xi[0] - ci[1] * xi[1] - ci[2] * xi[2] - ci[3] * xi[3]; }
                        const int is = sub * 8 + j, i = (d == 0) ? is : 127 - is;
                        if (d == 0) Yb[i * 16 + k] = y; else Yb[i * 16 + k] += y; }
                    LDS_FENCE();
                }
            }
            const float* dsk = p.s5_d + (size_t)l * 512 + g * 16;
#pragma unroll
            for (int m = 0; m < 2; ++m) { const int i = lane + 64 * m;
                const u32x4 ua = *(const LAS u32x4*)(ub + i * 32), ubv = *(const LAS u32x4*)(ub + i * 32 + 16);
                float u[16];
                u[0] = bflo(ua.x); u[1] = bfhi(ua.x); u[2] = bflo(ua.y); u[3] = bfhi(ua.y); u[4] = bflo(ua.z); u[5] = bfhi(ua.z); u[6] = bflo(ua.w); u[7] = bfhi(ua.w);
                u[8] = bflo(ubv.x); u[9] = bfhi(ubv.x); u[10] = bflo(ubv.y); u[11] = bfhi(ubv.y); u[12] = bflo(ubv.z); u[13] = bfhi(ubv.z); u[14] = bflo(ubv.w); u[15] = bfhi(ubv.w);
                float a[16];
#pragma unroll
                for (int k = 0; k < 16; ++k) a[k] = gelu_tanh_f(Yb[i * 16 + k] + dsk[k] * u[k]);
                u32x4 o0, o1; o0.x = pk2(a[0], a[1]); o0.y = pk2(a[2], a[3]); o0.z = pk2(a[4], a[5]); o0.w = pk2(a[6], a[7]);
                o1.x = pk2(a[8], a[9]); o1.y = pk2(a[10], a[11]); o1.z = pk2(a[12], a[13]); o1.w = pk2(a[14], a[15]);
                bf16* dst = p.SA + (size_t)(r0 + i) * 512 + g * 16;
                *(u32x4*)dst = o0; *(u32x4*)(dst + 8) = o1; }
            LDS_FENCE();
        }
    }
}

__device__ __forceinline__ void phase_select(const P& p, LAS unsigned char* lds, bool with_ctx) {
    LAS unsigned* keys = (LAS unsigned*)lds;
    LAS unsigned* hist = keys + 16384;
    LAS unsigned* misc = hist + 256;
    const int tid = p.tid, lane = p.lane, wave = p.wave;
    for (int it = p.bid; it < (with_ctx ? 32 : 16); it += p.G) {
        const int set = it >> 4, e = it & 15;
        const int n = set ? NCTX : NLAT, cap = set ? CAP_C : CAP_L, row0 = set ? 0 : NCTX, slot0 = set ? CAP_L : 0;
        const float* src = p.AFFT + (size_t)e * T + row0;
        __syncthreads();
        for (int i = tid; i < n; i += NTHR) keys[i] = __float_as_uint(src[i]);
        unsigned prefix = 0u, mask = 0u, need = (unsigned)cap;
        for (int pass = 3; pass >= 0; --pass) {
            if (tid < 256) hist[tid] = 0u;
            __syncthreads();
            for (int i = tid; i < n; i += NTHR) { const unsigned k = keys[i]; if ((k & mask) == prefix) __hip_atomic_fetch_add(&hist[(k >> (8 * pass)) & 255u], 1u, __ATOMIC_RELAXED, __HIP_MEMORY_SCOPE_WORKGROUP); }
            __syncthreads();
            if (wave == 0) {
                const unsigned h0 = hist[4 * lane], h1 = hist[4 * lane + 1], h2 = hist[4 * lane + 2], h3 = hist[4 * lane + 3];
                const unsigned c = h0 + h1 + h2 + h3; unsigned S = c;
#pragma unroll
                for (int o = 1; o < 64; o <<= 1) { const unsigned t = __shfl_down(S, o); if (lane + o < 64) S += t; }
                const unsigned Snext = S - c;
                if (S >= need && Snext < need) { unsigned rem = need - Snext; unsigned bin;
                    if (h3 >= rem) bin = 3; else { rem -= h3; if (h2 >= rem) bin = 2; else { rem -= h2; if (h1 >= rem) bin = 1; else { rem -= h1; bin = 0; } } }
                    misc[0] = 4 * lane + bin; misc[1] = rem; }
            }
            __syncthreads();
            prefix |= misc[0] << (8 * pass); mask |= 0xFFu << (8 * pass); need = misc[1];
            __syncthreads();
        }
        unsigned selbase = 0u, eqbase = 0u;
        for (int base = 0; base < n; base += NTHR) {
            const int i = base + tid; const bool valid = i < n; const unsigned k = valid ? keys[i] : 0u;
            const bool eq = valid && k == prefix, gt = valid && k > prefix;
            const unsigned long long lt = (1ull << lane) - 1ull;
            const unsigned long long be = __ballot(eq);
            if (lane == 0) misc[8 + wave] = (unsigned)__popcll(be);
            __syncthreads();
            unsigned woff = 0u, tot = 0u;
#pragma unroll
            for (int w = 0; w < 8; ++w) { const unsigned v = misc[8 + w]; woff += (w < wave) ? v : 0u; tot += v; }
            const unsigned eqrank = eqbase + woff + (unsigned)__popcll(be & lt);
            const bool sel = gt || (eq && eqrank < need);
            const unsigned long long bs = __ballot(sel);
            if (lane == 0) misc[16 + wave] = (unsigned)__popcll(bs);
            __syncthreads();
            unsigned woff2 = 0u, tot2 = 0u;
#pragma unroll
            for (int w = 0; w < 8; ++w) { const unsigned v = misc[16 + w]; woff2 += (w < wave) ? v : 0u; tot2 += v; }
            if (valid) { const int row = row0 + i;
                if (sel) { const int slot = slot0 + (int)(selbase + woff2 + (unsigned)__popcll(bs & lt));
                    p.IDX[e * ESLOTS + slot] = row; p.GSEL[e * ESLOTS + slot] = __uint_as_float(k); p.INV[(size_t)row * 16 + e] = slot; }
                else p.INV[(size_t)row * 16 + e] = -1; }
            selbase += tot2; eqbase += tot;
            __syncthreads();
        }
    }
}
__device__ __forceinline__ void phase_gather(const P& p, bool with_ctx) {
    const int gw = p.bid * NWAVES + p.wave, NGW = p.G * NWAVES, lane = p.lane;
    for (int idx = gw; idx < NE * ESLOTS; idx += NGW) {
        const int slot = idx % ESLOTS; const bool valid = slot < CAP_L + (with_ctx ? CAP_C : 0);
        u32x4 a = (u32x4){0u, 0u, 0u, 0u}, b = a;
        if (valid) { const int row = p.IDX[idx]; const u32x4* s = (const u32x4*)(p.H + (size_t)row * D); a = s[lane]; b = s[64 + lane]; }
        else if (lane == 0) p.GSEL[idx] = 0.f;
        u32x4* dst = (u32x4*)(p.XE + (size_t)idx * D); dst[lane] = a; dst[64 + lane] = b;
    }
}

typedef short bf16x8 __attribute__((ext_vector_type(8)));
#define MFMA16(a, b, c) __builtin_amdgcn_mfma_f32_16x16x32_bf16((a), (b), (c), 0, 0, 0)
constexpr int LDP = 272;
constexpr int LDQ = 144;
__device__ __forceinline__ bf16x8 ld_frag(const LAS unsigned char* base, int row, int kcol, int ldb) { return *(const LAS bf16x8*)(base + row * ldb + kcol * 2); }
__device__ __forceinline__ void st_b16(LAS unsigned char* p, unsigned v) { *(LAS unsigned short*)p = (unsigned short)v; }
__device__ __forceinline__ float wscan_incl(float v, int lane) {
#pragma unroll
    for (int o = 1; o < 64; o <<= 1) { const float t = __shfl_up(v, o); if (lane >= o) v += t; }
    return v;
}
__device__ __forceinline__ int chunk_r0(int d, int cs) { return d == 0 ? 128 * cs : (cs < 2 ? 128 * (1 - cs) : 128 * (NCH + 1 - cs)); }
__device__ __forceinline__ int scan_chunk_of(int d, int cn) { return d == 0 ? cn : (cn < 2 ? 1 - cn : NCH + 1 - cn); }

__device__ __forceinline__ void ssd_acum(const float* DT, int r0, int d, int col, float a, int lane, LAS float* acum, LAS float* dtv, float& total) {
    const int j0 = d == 0 ? lane : 127 - lane, j1 = d == 0 ? 64 + lane : 63 - lane;
    const float dt0 = DT[(size_t)(r0 + j0) * 16 + col], dt1 = DT[(size_t)(r0 + j1) * 16 + col];
    const float s0 = wscan_incl(dt0 * a, lane); const float t0 = __shfl(s0, 63);
    const float s1 = wscan_incl(dt1 * a, lane) + t0; total = __shfl(s1, 63);
    acum[j0] = s0; acum[j1] = s1; dtv[j0] = dt0; dtv[j1] = dt1;
}

__device__ __forceinline__ void ssd_states(const P& p, int l, LAS unsigned char* lds, float* SST, float* DEC) {
    LAS unsigned char* BT = lds;
    LAS unsigned char* XW = lds + 128 * LDP;
    LAS float* wj = (LAS float*)(lds + 128 * LDP + 4 * 64 * LDP);
    const int tid = p.tid, lane = p.lane, wave = p.wave, quad = lane >> 4, l15 = lane & 15;
    for (int u = p.bid; u < 2 * NCH * 2; u += p.G) {
        const int d = u / (2 * NCH), cs = (u % (2 * NCH)) >> 1, g = u & 1;
        const int r0 = chunk_r0(d, cs);
        __syncthreads();
        if (wave < 4) { const int h = g * 4 + wave; const float a = -expf(p.a_log[l * 16 + d * 8 + h]); float total;
            LAS float* ac = wj + 512 + wave * 128; LAS float* dv = wj + 1024 + wave * 128;
            ssd_acum(p.DT, r0, d, d * 8 + h, a, lane, ac, dv, total);
            LDS_FENCE();
            wj[wave * 128 + lane] = expf(total - ac[lane]) * dv[lane]; wj[wave * 128 + 64 + lane] = expf(total - ac[64 + lane]) * dv[64 + lane];
            if (lane == 0) DEC[(d * NCH + cs) * 8 + h] = expf(total); }
        __syncthreads();
        for (int idx = tid; idx < 128 * 16; idx += NTHR) { const int j = idx >> 4, n8 = (idx & 15) * 8;
            const u32x4 v = *(const u32x4*)(p.CV + (size_t)(r0 + j) * 1024 + 512 + g * 128 + n8);
            LAS unsigned char* dst = BT + n8 * LDP + 2 * j;
            st_b16(dst, v.x & 0xffffu); st_b16(dst + LDP, v.x >> 16); st_b16(dst + 2 * LDP, v.y & 0xffffu); st_b16(dst + 3 * LDP, v.y >> 16);
            st_b16(dst + 4 * LDP, v.z & 0xffffu); st_b16(dst + 5 * LDP, v.z >> 16); st_b16(dst + 6 * LDP, v.w & 0xffffu); st_b16(dst + 7 * LDP, v.w >> 16); }
        for (int idx = tid; idx < 128 * 32; idx += NTHR) { const int j = idx >> 5, c8 = (idx & 31) * 8, hh = c8 >> 6, p8 = c8 & 63;
            const u32x4 v = *(const u32x4*)(p.CV + (size_t)(r0 + j) * 1024 + g * 256 + c8); const float w = wj[hh * 128 + j];
            LAS unsigned char* dst = XW + (hh * 64 + p8) * LDP + 2 * j;
            st_b16(dst, f2bf(bflo(v.x) * w)); st_b16(dst + LDP, f2bf(bfhi(v.x) * w)); st_b16(dst + 2 * LDP, f2bf(bflo(v.y) * w)); st_b16(dst + 3 * LDP, f2bf(bfhi(v.y) * w));
            st_b16(dst + 4 * LDP, f2bf(bflo(v.z) * w)); st_b16(dst + 5 * LDP, f2bf(bfhi(v.z) * w)); st_b16(dst + 6 * LDP, f2bf(bflo(v.w) * w)); st_b16(dst + 7 * LDP, f2bf(bfhi(v.w) * w)); }
        __syncthreads();
        const int hh = wave >> 1, ph = wave & 1;
        f32x4 acc[2][8];
#pragma unroll
        for (int a = 0; a < 2; ++a)
#pragma unroll
            for (int b = 0; b < 8; ++b) acc[a][b] = (f32x4){0.f, 0.f, 0.f, 0.f};
#pragma unroll
        for (int ks = 0; ks < 4; ++ks) {
            bf16x8 af[2];
#pragma unroll
            for (int pt = 0; pt < 2; ++pt) af[pt] = ld_frag(XW + hh * 64 * LDP, ph * 32 + pt * 16 + l15, ks * 32 + 8 * quad, LDP);
#pragma unroll
            for (int nt = 0; nt < 8; ++nt) { const bf16x8 bfr = ld_frag(BT, nt * 16 + l15, ks * 32 + 8 * quad, LDP);
#pragma unroll
                for (int pt = 0; pt < 2; ++pt) acc[pt][nt] = MFMA16(af[pt], bfr, acc[pt][nt]); }
        }
        float* S = SST + ((size_t)(d * NCH + cs) * 8 + g * 4 + hh) * 8192;
#pragma unroll
        for (int pt = 0; pt < 2; ++pt)
#pragma unroll
            for (int nt = 0; nt < 8; ++nt)
#pragma unroll
                for (int r = 0; r < 4; ++r) S[(ph * 32 + pt * 16 + 4 * quad + r) * 128 + nt * 16 + l15] = acc[pt][nt][r];
    }
}

__device__ __forceinline__ void scan_carries(const P& p, int l, const float* SST, const float* DEC, bf16* HIN) {
    for (int e = p.bid * NTHR + p.tid; e < 2 * 8 * 8192; e += p.G * NTHR) {
        const int d = e >> 16, h = (e >> 13) & 7, pn = e & 8191;
        float hs = 0.f;
        for (int c0 = 0; c0 < NCH; c0 += 10) {
            float s[10], dc[10];
#pragma unroll
            for (int j = 0; j < 10; ++j) { const size_t ci = (size_t)(d * NCH + c0 + j) * 8 + h; s[j] = SST[ci * 8192 + pn]; dc[j] = DEC[ci]; }
#pragma unroll
            for (int j = 0; j < 10; ++j) { const size_t ci = (size_t)(d * NCH + c0 + j) * 8 + h; HIN[ci * 8192 + pn] = (bf16)f2bf(hs); hs = hs * dc[j] + s[j]; }
        }
    }
    for (int e = p.bid * NTHR + p.tid; e < 2 * 32 * 64; e += p.G * NTHR) {
        const int d = e >> 11, g = (e >> 6) & 31, pq = e & 63;
        S5Lane s; s5_lane_params(p, l, d, g, pq, s, false);
        float ar = s.abr, ai = s.abi;
#pragma unroll
        for (int q = 0; q < 7; ++q) { const float nr = ar * ar - ai * ai, ni = 2.f * ar * ai; ar = nr; ai = ni; }
        float hr = 0.f, hi = 0.f;
        const float* E = p.S5E + (size_t)(d * 32 + g) * NCH * 128 + pq; float* Hn = p.S5H + (size_t)(d * 32 + g) * NCH * 128 + pq;
        for (int c0 = 0; c0 < NCH; c0 += 10) {
            float er[10], ei[10];
#pragma unroll
            for (int j = 0; j < 10; ++j) { er[j] = E[(c0 + j) * 128]; ei[j] = E[(c0 + j) * 128 + 64]; }
#pragma unroll
            for (int j = 0; j < 10; ++j) { Hn[(c0 + j) * 128] = hr; Hn[(c0 + j) * 128 + 64] = hi;
                const float nr = ar * hr - ai * hi + er[j], ni = ar * hi + ai * hr + ei[j]; hr = nr; hi = ni; }
        }
    }
}

__device__ __forceinline__ void ssd_outputs(const P& p, int l, LAS unsigned char* lds, const bf16* HIN, const float* SST, bf16* YS, int u_begin, int u_end, int first, int stride) {
    LAS unsigned char* Cm = lds;
    LAS unsigned char* Bm = lds + 128 * LDP;
    LAS unsigned char* XT = lds + 2 * 128 * LDP;
    LAS unsigned char* Wm = lds + 2 * 128 * LDP + 64 * LDP;
    LAS float* sm = (LAS float*)(lds + 3 * 128 * LDP + 64 * LDP);
    const int tid = p.tid, lane = p.lane, wave = p.wave, quad = lane >> 4, l15 = lane & 15;
    for (int u = u_begin + first; u < u_end; u += stride) {
        const int cn = u >> 3, h = u & 7, g = h >> 2, r0 = 128 * cn;
        __syncthreads();
        if (wave < 2) { const int d = wave; const float a = -expf(p.a_log[l * 16 + d * 8 + h]); float total;
            ssd_acum(p.DT, r0, d, d * 8 + h, a, lane, sm + d * 128, sm + 256 + d * 128, total); }
        for (int idx = tid; idx < 128 * 16; idx += NTHR) { const int j = idx >> 4, n8 = (idx & 15) * 8;
            const bf16* src = p.CV + (size_t)(r0 + j) * 1024 + g * 128 + n8;
            *(LAS u32x4*)(Bm + j * LDP + n8 * 2) = *(const u32x4*)(src + 512); *(LAS u32x4*)(Cm + j * LDP + n8 * 2) = *(const u32x4*)(src + 768); }
        for (int idx = tid; idx < 128 * 8; idx += NTHR) { const int j = idx >> 3, p8 = (idx & 7) * 8;
            const u32x4 v = *(const u32x4*)(p.CV + (size_t)(r0 + j) * 1024 + h * 64 + p8);
            LAS unsigned char* dst = XT + p8 * LDP + 2 * j;
            st_b16(dst, v.x & 0xffffu); st_b16(dst + LDP, v.x >> 16); st_b16(dst + 2 * LDP, v.y & 0xffffu); st_b16(dst + 3 * LDP, v.y >> 16);
            st_b16(dst + 4 * LDP, v.z & 0xffffu); st_b16(dst + 5 * LDP, v.z >> 16); st_b16(dst + 6 * LDP, v.w & 0xffffu); st_b16(dst + 7 * LDP, v.w >> 16); }
        __syncthreads();
        f32x4 G[8];
#pragma unroll
        for (int jt = 0; jt < 8; ++jt) G[jt] = (f32x4){0.f, 0.f, 0.f, 0.f};
#pragma unroll
        for (int ks = 0; ks < 4; ++ks) { const bf16x8 af = ld_frag(Cm, 16 * wave + l15, ks * 32 + 8 * quad, LDP);
#pragma unroll
            for (int jt = 0; jt < 8; ++jt) G[jt] = MFMA16(af, ld_frag(Bm, 16 * jt + l15, ks * 32 + 8 * quad, LDP), G[jt]); }
        __syncthreads();
        for (int idx = tid; idx < 2 * 64 * 16; idx += NTHR) { const int d = idx >> 10, pp = (idx >> 4) & 63, n8 = (idx & 15) * 8;
            const int cs = scan_chunk_of(d, cn);
            u32x4 w;
            if (cn >= 2) w = *(const u32x4*)(HIN + ((size_t)(d * NCH + cs) * 8 + h) * 8192 + pp * 128 + n8);
            else if (cs == 0) w = (u32x4){0u, 0u, 0u, 0u};
            else { const float* s = SST + ((size_t)(d * NCH) * 8 + h) * 8192 + pp * 128 + n8; const f32x4 s0 = *(const f32x4*)s, s1 = *(const f32x4*)(s + 4);
                w.x = pk2(s0[0], s0[1]); w.y = pk2(s0[2], s0[3]); w.z = pk2(s1[0], s1[1]); w.w = pk2(s1[2], s1[3]); }
            *(LAS u32x4*)(Bm + (d * 64 + pp) * LDP + n8 * 2) = w; }
        __syncthreads();
        f32x4 Y[4];
#pragma unroll
        for (int pt = 0; pt < 4; ++pt) Y[pt] = (f32x4){0.f, 0.f, 0.f, 0.f};
#pragma unroll
        for (int d = 0; d < 2; ++d) {
            const LAS float* ac = sm + d * 128; const LAS float* dv = sm + 256 + d * 128;
            float ai[4];
#pragma unroll
            for (int r = 0; r < 4; ++r) ai[r] = ac[16 * wave + 4 * quad + r];
#pragma unroll
            for (int jt = 0; jt < 8; ++jt) { const int j = 16 * jt + l15; const float aj = ac[j], dj = dv[j];
#pragma unroll
                for (int r = 0; r < 4; ++r) { const int i = 16 * wave + 4 * quad + r; const bool valid = (d == 0) ? (j <= i) : (j >= i);
                    const float w = valid ? G[jt][r] * expf(ai[r] - aj) * dj : 0.f;
                    st_b16(Wm + i * LDP + 2 * j, f2bf(w)); } }
            LDS_FENCE();
            f32x4 Y2[4];
#pragma unroll
            for (int pt = 0; pt < 4; ++pt) Y2[pt] = (f32x4){0.f, 0.f, 0.f, 0.f};
#pragma unroll
            for (int ks = 0; ks < 4; ++ks) { const bf16x8 wf = ld_frag(Wm, 16 * wave + l15, ks * 32 + 8 * quad, LDP), cf = ld_frag(Cm, 16 * wave + l15, ks * 32 + 8 * quad, LDP);
#pragma unroll
                for (int pt = 0; pt < 4; ++pt) { Y[pt] = MFMA16(wf, ld_frag(XT, 16 * pt + l15, ks * 32 + 8 * quad, LDP), Y[pt]);
                    Y2[pt] = MFMA16(cf, ld_frag(Bm + d * 64 * LDP, 16 * pt + l15, ks * 32 + 8 * quad, LDP), Y2[pt]); } }
#pragma unroll
            for (int r = 0; r < 4; ++r) { const float ea = expf(ai[r]);
#pragma unroll
                for (int pt = 0; pt < 4; ++pt) Y[pt][r] += ea * Y2[pt][r]; }
            LDS_FENCE();
        }
#pragma unroll
        for (int pt = 0; pt < 4; ++pt)
#pragma unroll
            for (int r = 0; r < 4; ++r) YS[(size_t)(r0 + 16 * wave + 4 * quad + r) * 512 + h * 64 + 16 * pt + l15] = (bf16)f2bf(Y[pt][r]);
    }
}

__device__ __forceinline__ void ssd_gated_norm(const P& p, int l, const bf16* YS) {
    const int gw = p.bid * NWAVES + p.wave, NGW = p.G * NWAVES, lane = p.lane;
    for (int row = gw; row < T; row += NGW) {
        const int ch = lane * 8;
        const float dsk = p.ssd_d[l * 8 + (ch >> 6)];
        const u32x4 yv = *(const u32x4*)(YS + (size_t)row * 512 + ch);
        const u32x4 xs = *(const u32x4*)(p.CV + (size_t)row * 1024 + ch), zz = *(const u32x4*)(p.PROJ + (size_t)row * PJ + Z0 + ch);
        float v[8];
        v[0] = (bflo(yv.x) + dsk * bflo(xs.x)) * silu_f(bflo(zz.x)); v[1] = (bfhi(yv.x) + dsk * bfhi(xs.x)) * silu_f(bfhi(zz.x));
        v[2] = (bflo(yv.y) + dsk * bflo(xs.y)) * silu_f(bflo(zz.y)); v[3] = (bfhi(yv.y) + dsk * bfhi(xs.y)) * silu_f(bfhi(zz.y));
        v[4] = (bflo(yv.z) + dsk * bflo(xs.z)) * silu_f(bflo(zz.z)); v[5] = (bfhi(yv.z) + dsk * bfhi(xs.z)) * silu_f(bfhi(zz.z));
        v[6] = (bflo(yv.w) + dsk * bflo(xs.w)) * silu_f(bflo(zz.w)); v[7] = (bfhi(yv.w) + dsk * bfhi(xs.w)) * silu_f(bfhi(zz.w));
        float ss = 0.f;
#pragma unroll
        for (int i = 0; i < 8; ++i) ss += v[i] * v[i];
        const float rstd = rsqrtf(wsum(ss) * (1.f / 512.f) + EPS);
        const float* ng = p.ssd_norm_g + (size_t)l * 512 + ch;
        const f32x4 g0 = *(const f32x4*)ng, g1 = *(const f32x4*)(ng + 4);
        u32x4 o; o.x = pk2(v[0] * rstd * g0[0], v[1] * rstd * g0[1]); o.y = pk2(v[2] * rstd * g0[2], v[3] * rstd * g0[3]);
        o.z = pk2(v[4] * rstd * g1[0], v[5] * rstd * g1[1]); o.w = pk2(v[6] * rstd * g1[2], v[7] * rstd * g1[3]);
        *(u32x4*)(p.Y3 + (size_t)row * 1536 + 512 + ch) = o;
    }
}

__device__ __forceinline__ void attention_mfma(const P& p, int l, LAS unsigned char* lds, int u_begin, int u_end, int u_first, int u_stride) {
    LAS unsigned char* Kt = lds;
    LAS unsigned char* VT = lds + 64 * LDQ;
    LAS unsigned char* Pw = lds + 2 * 64 * LDQ + p.wave * 64 * LDQ;
    const int tid = p.tid, lane = p.lane, wave = p.wave, quad = lane >> 4, l15 = lane & 15;
    const float C2 = 0.125f * 1.4426950408889634f;
    for (int u = u_begin + u_first; u < u_end; u += u_stride) {
        const int qb = u >> 1, kvh = u & 1, hq = kvh * 4 + (wave >> 1);
        const bool isc = qb < 2; const int nb = qb - 2;
        const int qrow0 = 128 * qb + 64 * (wave & 1);
        bf16x8 Qf[4][2];
#pragma unroll
        for (int qt = 0; qt < 4; ++qt)
#pragma unroll
            for (int ks = 0; ks < 2; ++ks) Qf[qt][ks] = *(const bf16x8*)(p.PROJ + (size_t)(qrow0 + 16 * qt + l15) * PJ + Q0 + hq * 64 + ks * 32 + 8 * quad);
        f32x4 O[4][4];
#pragma unroll
        for (int a = 0; a < 4; ++a)
#pragma unroll
            for (int b = 0; b < 4; ++b) O[a][b] = (f32x4){0.f, 0.f, 0.f, 0.f};
        float mrow[4], lrow[4];
        const float sk = p.sink[l * 8 + hq] * 1.4426950408889634f;
#pragma unroll
        for (int qt = 0; qt < 4; ++qt) { mrow[qt] = sk; lrow[qt] = 1.f; }
        const int ntile = isc ? 4 : 10;
        for (int ti = 0; ti < ntile; ++ti) {
            int krow0; bool local;
            if (isc || ti >= 6) { krow0 = 64 * (isc ? ti : ti - 6); local = false; }
            else { krow0 = NCTX + 128 * (nb - 1) + 64 * ti; local = true; }
            if (local && (krow0 < NCTX || krow0 >= T)) continue;
            __syncthreads();
            { const int key = tid >> 3, pc = tid & 7;
              const bf16* src = p.PROJ + (size_t)(krow0 + key) * PJ + kvh * 64 + pc * 8;
              *(LAS u32x4*)(Kt + key * LDQ + pc * 16) = *(const u32x4*)(src + K0);
              const u32x4 v = *(const u32x4*)(src + V0);
              LAS unsigned char* dst = VT + (pc * 8) * LDQ + 2 * key;
              st_b16(dst, v.x & 0xffffu); st_b16(dst + LDQ, v.x >> 16); st_b16(dst + 2 * LDQ, v.y & 0xffffu); st_b16(dst + 3 * LDQ, v.y >> 16);
              st_b16(dst + 4 * LDQ, v.z & 0xffffu); st_b16(dst + 5 * LDQ, v.z >> 16); st_b16(dst + 6 * LDQ, v.w & 0xffffu); st_b16(dst + 7 * LDQ, v.w >> 16); }
            __syncthreads();
            f32x4 S[4][4];
#pragma unroll
            for (int a = 0; a < 4; ++a)
#pragma unroll
                for (int b = 0; b < 4; ++b) S[a][b] = (f32x4){0.f, 0.f, 0.f, 0.f};
#pragma unroll
            for (int ks = 0; ks < 2; ++ks)
#pragma unroll
                for (int kt = 0; kt < 4; ++kt) { const bf16x8 kf = ld_frag(Kt, 16 * kt + l15, ks * 32 + 8 * quad, LDQ);
#pragma unroll
                    for (int qt = 0; qt < 4; ++qt) S[kt][qt] = MFMA16(kf, Qf[qt][ks], S[kt][qt]); }
#pragma unroll
            for (int qt = 0; qt < 4; ++qt) {
                const int tq = qrow0 + 16 * qt + l15;
                float mx = -1e30f;
#pragma unroll
                for (int kt = 0; kt < 4; ++kt)
#pragma unroll
                    for (int r = 0; r < 4; ++r) { const int tk = krow0 + 16 * kt + 4 * quad + r; const int df = tq - tk;
                        const bool ok = !local || (df <= 128 && df >= -128);
                        const float s = ok ? S[kt][qt][r] * C2 : -1e30f; S[kt][qt][r] = s; mx = fmaxf(mx, s); }
                mx = fmaxf(mx, __shfl_xor(mx, 16)); mx = fmaxf(mx, __shfl_xor(mx, 32));
                const float mn = fmaxf(mrow[qt], mx), alpha = exp2f(mrow[qt] - mn);
                float ls = 0.f;
#pragma unroll
                for (int kt = 0; kt < 4; ++kt) { float e0 = exp2f(S[kt][qt][0] - mn), e1 = exp2f(S[kt][qt][1] - mn), e2 = exp2f(S[kt][qt][2] - mn), e3 = exp2f(S[kt][qt][3] - mn);
                    ls += (e0 + e1) + (e2 + e3);
                    u32x2 w; w.x = pk2(e0, e1); w.y = pk2(e2, e3);
                    *(LAS u32x2*)(Pw + (16 * qt + l15) * LDQ + (16 * kt + 4 * quad) * 2) = w; }
                ls += __shfl_xor(ls, 16); ls += __shfl_xor(ls, 32);
                lrow[qt] = lrow[qt] * alpha + ls; mrow[qt] = mn;
#pragma unroll
                for (int dt = 0; dt < 4; ++dt) O[dt][qt] *= alpha;
            }
            LDS_FENCE();
#pragma unroll
            for (int ks = 0; ks < 2; ++ks) {
                bf16x8 pf[4];
#pragma unroll
                for (int qt = 0; qt < 4; ++qt) pf[qt] = ld_frag(Pw, 16 * qt + l15, ks * 32 + 8 * quad, LDQ);
#pragma unroll
                for (int dt = 0; dt < 4; ++dt) { const bf16x8 vf = ld_frag(VT, 16 * dt + l15, ks * 32 + 8 * quad, LDQ);
#pragma unroll
                    for (int qt = 0; qt < 4; ++qt) O[dt][qt] = MFMA16(vf, pf[qt], O[dt][qt]); }
            }
            LDS_FENCE();
        }
#pragma unroll
        for (int qt = 0; qt < 4; ++qt) { const float inv = 1.f / lrow[qt];
            bf16* orow = p.Y3 + (size_t)(qrow0 + 16 * qt + l15) * 1536 + 1024 + hq * 64;
#pragma unroll
            for (int dt = 0; dt < 4; ++dt) { u32x2 w; w.x = pk2(O[dt][qt][0] * inv, O[dt][qt][1] * inv); w.y = pk2(O[dt][qt][2] * inv, O[dt][qt][3] * inv);
                *(u32x2*)(orow + 16 * dt + 4 * quad) = w; } }
    }
}

#ifndef S5_INTERLEAVE
#define S5_INTERLEAVE 2
#endif
constexpr size_t S5BB_ELEMS = (size_t)2 * 32 * 128 * 32, S5CC_ELEMS = (size_t)2 * 32 * 16 * 128;
__device__ __forceinline__ void s5_tables(const P& p, int l, bf16* BB, bf16* CC, float* AB) {
    for (int e = p.bid * NTHR + p.tid; e < 2 * 32 * 64; e += p.G * NTHR) {
        const int d = e >> 11, g = (e >> 6) & 31, pq = e & 63, dg = d * 32 + g;
        S5Lane s; s5_lane_params(p, l, d, g, pq, s, true);
        AB[(size_t)e * 2] = s.abr; AB[(size_t)e * 2 + 1] = s.abi;
        #if S5_INTERLEAVE
        u32x4* br = (u32x4*)(BB + ((size_t)dg * 128 + 2 * pq) * 32); u32x4* bi = (u32x4*)(BB + ((size_t)dg * 128 + 2 * pq + 1) * 32);
#else
        u32x4* br = (u32x4*)(BB + ((size_t)dg * 128 + pq) * 32); u32x4* bi = (u32x4*)(BB + ((size_t)dg * 128 + 64 + pq) * 32);
#endif
        u32x4 w;
        w.x = pk2(s.bbr[0], s.bbr[1]); w.y = pk2(s.bbr[2], s.bbr[3]); w.z = pk2(s.bbr[4], s.bbr[5]); w.w = pk2(s.bbr[6], s.bbr[7]); br[0] = w;
        w.x = pk2(s.bbr[8], s.bbr[9]); w.y = pk2(s.bbr[10], s.bbr[11]); w.z = pk2(s.bbr[12], s.bbr[13]); w.w = pk2(s.bbr[14], s.bbr[15]); br[1] = w;
        w.x = pk2(s.bbi[0], s.bbi[1]); w.y = pk2(s.bbi[2], s.bbi[3]); w.z = pk2(s.bbi[4], s.bbi[5]); w.w = pk2(s.bbi[6], s.bbi[7]); bi[0] = w;
        w.x = pk2(s.bbi[8], s.bbi[9]); w.y = pk2(s.bbi[10], s.bbi[11]); w.z = pk2(s.bbi[12], s.bbi[13]); w.w = pk2(s.bbi[14], s.bbi[15]); bi[1] = w;
        const u32x4 z = (u32x4){0u, 0u, 0u, 0u}; br[2] = z; br[3] = z; bi[2] = z; bi[3] = z;
        const size_t ci = ((size_t)(l * 2 + d) * 32 + g) * 16;
#pragma unroll
        for (int k = 0; k < 16; ++k) {
#if S5_INTERLEAVE
            *(unsigned*)(CC + ((size_t)dg * 16 + k) * 128 + 2 * pq) = pk2(p.c_re[(ci + k) * 64 + pq], -p.c_im[(ci + k) * 64 + pq]);
#else
            CC[((size_t)dg * 16 + k) * 128 + pq] = (bf16)f2bf(p.c_re[(ci + k) * 64 + pq]); CC[((size_t)dg * 16 + k) * 128 + 64 + pq] = (bf16)f2bf(-p.c_im[(ci + k) * 64 + pq]);
#endif
        }
    }
}
constexpr int S5_WREG = 4096 + 16 * 132 * 4 + 16 * LDP;
template <bool READOUT> __device__ __forceinline__ void s5_chunk_dir(int d, const bf16* BBdg, const bf16* CCdg, float abr, float abi, LAS unsigned char* wreg, int lane, float& hr, float& hi, f32x4 (&yacc)[8]) {
    const int quad = lane >> 4, l15 = lane & 15;
    LAS unsigned char* ub = wreg; LAS float* BuW = (LAS float*)(wreg + 4096); LAS unsigned char* Hw = wreg + 4096 + 16 * 132 * 4;
    bf16x8 BBf[8], CCf[4];
#pragma unroll
    for (int pt = 0; pt < 8; ++pt) BBf[pt] = *(const bf16x8*)(BBdg + (size_t)(16 * pt + l15) * 32 + 8 * quad);
    if (READOUT) {
#pragma unroll
        for (int ks = 0; ks < 4; ++ks) CCf[ks] = *(const bf16x8*)(CCdg + (size_t)l15 * 128 + ks * 32 + 8 * quad);
    }
#pragma unroll (READOUT ? 8 : 1)
    for (int ss = 0; ss < 8; ++ss) {
        const int sc = d ? 7 - ss : ss;
        bf16x8 uf = (bf16x8){0, 0, 0, 0, 0, 0, 0, 0};
        if (quad < 2) uf = *(const LAS bf16x8*)(ub + (16 * sc + l15) * 32 + quad * 16);
#pragma unroll
        for (int pt = 0; pt < 8; ++pt) { const f32x4 Dp = MFMA16(uf, BBf[pt], ((f32x4){0.f, 0.f, 0.f, 0.f}));
#pragma unroll
            for (int r = 0; r < 4; ++r) BuW[(4 * quad + r) * 132 + 16 * pt + l15] = Dp[r]; }
        LDS_FENCE();
#pragma unroll
        for (int st = 0; st < 16; ++st) { const int tl = d ? 15 - st : st;
#if S5_INTERLEAVE == 1
            typedef float f32x2_t __attribute__((ext_vector_type(2)));
            const f32x2_t bu = *(const LAS f32x2_t*)(BuW + tl * 132 + 2 * lane);
            const float nr = abr * hr - abi * hi + bu[0], ni = abr * hi + abi * hr + bu[1]; hr = nr; hi = ni;
            if (READOUT) *(LAS unsigned*)(Hw + tl * LDP + 4 * lane) = pk2(hr, hi); }
#elif S5_INTERLEAVE == 2
            const float br = BuW[tl * 132 + 2 * lane], bi = BuW[tl * 132 + 2 * lane + 1];
            const float nr = abr * hr - abi * hi + br, ni = abr * hi + abi * hr + bi; hr = nr; hi = ni;
            if (READOUT) *(LAS unsigned*)(Hw + tl * LDP + 4 * lane) = pk2(hr, hi); }
#else
            const float br = BuW[tl * 132 + lane], bi = BuW[tl * 132 + 64 + lane];
            const float nr = abr * hr - abi * hi + br, ni = abr * hi + abi * hr + bi; hr = nr; hi = ni;
            if (READOUT) { st_b16(Hw + tl * LDP + 2 * lane, f2bf(hr)); st_b16(Hw + tl * LDP + 128 + 2 * lane, f2bf(hi)); } }
#endif
        if (READOUT) {
            LDS_FENCE();
#pragma unroll
            for (int ks = 0; ks < 4; ++ks) yacc[sc] = MFMA16(ld_frag(Hw, l15, ks * 32 + 8 * quad, LDP), CCf[ks], yacc[sc]);
        }
        LDS_FENCE();
    }
}
__device__ __forceinline__ void s5_local_states(const P& p, LAS unsigned char* lds, const bf16* BB, const float* AB) {
    LAS unsigned char* wreg = lds + p.wave * S5_WREG;
    const int gw = p.bid * NWAVES + p.wave, NGW = p.G * NWAVES, lane = p.lane;
    for (int it = gw; it < 2 * 32 * NCH; it += NGW) {
        const int d = it / (32 * NCH), c = (it % (32 * NCH)) >> 5, g = it & 31, dg = d * 32 + g;
        s5_stage_u(p, chunk_r0(d, c), g, wreg, lane);
        float hr = 0.f, hi = 0.f; f32x4 dummy[8];
        const float abr = AB[((size_t)dg * 64 + lane) * 2], abi = AB[((size_t)dg * 64 + lane) * 2 + 1];
        if (d == 0) s5_chunk_dir<false>(0, BB + (size_t)dg * 128 * 32, nullptr, abr, abi, wreg, lane, hr, hi, dummy);
        else s5_chunk_dir<false>(1, BB + (size_t)dg * 128 * 32, nullptr, abr, abi, wreg, lane, hr, hi, dummy);
        float* E = p.S5E + ((size_t)dg * NCH + c) * 128;
        E[lane] = hr; E[64 + lane] = hi;
    }
}
__device__ __forceinline__ void s5_outputs(const P& p, int l, LAS unsigned char* lds, const bf16* BB, const bf16* CC, const float* AB, int it_begin, int it_end, int first, int stride) {
    LAS unsigned char* wreg = lds + p.wave * S5_WREG;
    const int lane = p.lane, quad = lane >> 4, l15 = lane & 15;
    for (int it = it_begin + first; it < it_end; it += stride) {
        const int cn = it >> 5, g = it & 31, r0 = 128 * cn;
        s5_stage_u(p, r0, g, wreg, lane);
        f32x4 yacc[8];
#pragma unroll
        for (int i = 0; i < 8; ++i) yacc[i] = (f32x4){0.f, 0.f, 0.f, 0.f};
#pragma unroll
        for (int d = 0; d < 2; ++d) { const int dg = d * 32 + g, cs = scan_chunk_of(d, cn);
            const float* Hn = (cn < 2) ? (p.S5E + (size_t)dg * NCH * 128) : (p.S5H + ((size_t)dg * NCH + cs) * 128);
            float hr = Hn[lane], hi = Hn[64 + lane];
            if (cs == 0) { hr = 0.f; hi = 0.f; }
            s5_chunk_dir<true>(d, BB + (size_t)dg * 128 * 32, CC + (size_t)dg * 16 * 128, AB[((size_t)dg * 64 + lane) * 2], AB[((size_t)dg * 64 + lane) * 2 + 1], wreg, lane, hr, hi, yacc); }
        const float dsk = p.s5_d[(size_t)l * 512 + g * 16 + l15];
#pragma unroll
        for (int sc = 0; sc < 8; ++sc)
#pragma unroll
            for (int r = 0; r < 4; ++r) { const int t = 16 * sc + 4 * quad + r;
                const float u = bf2f(*(const LAS unsigned short*)(wreg + t * 32 + 2 * l15));
                p.SA[(size_t)(r0 + t) * 512 + g * 16 + l15] = (bf16)f2bf(gelu_tanh_f(yacc[sc][r] + dsk * u)); }
        LDS_FENCE();
    }
}

#ifndef SKIPMASK
#define SKIPMASK 0
#endif
struct Args { const float* in[33]; float* out; unsigned char* ws; int ph_lo, ph_hi; };
static_assert(sizeof(Args) == 35 * 8 + 8, "no padding");

__global__ void __launch_bounds__(NTHR, 2) fwd_kernel(Args args) {
    extern __shared__ __attribute__((aligned(16))) unsigned char lds_raw[];
    LAS unsigned char* lds = (LAS unsigned char*)lds_raw;
    const int tid_ = threadIdx.x;
    if (tid_ == 0) {
        LAS unsigned long long* tab = (LAS unsigned long long*)(lds + PTAB_OFF);
#pragma unroll
        for (int k = 0; k < 33; ++k) tab[k] = (unsigned long long)args.in[k];
        tab[33] = (unsigned long long)args.out; tab[34] = (unsigned long long)args.ws;
    }
    volatile LAS unsigned* MISC = (volatile LAS unsigned*)(lds + MISC_OFF);
    if (tid_ < 64) MISC[tid_] = 0u;
    __syncthreads();
    XcdBarrier bar; bar.bar = (unsigned*)(args.ws + WS_CTL) + CW_BAR; bar.x = 0; bar.st = nullptr;
    if (!MK_PER_PHASE) bar = xcd_barrier_post((unsigned*)(args.ws + WS_CTL) + CW_BAR, MISC + 8);

    const int lo = args.ph_lo, hi = args.ph_hi;
#define IN(k) (lo <= (k) && (k) < hi)
#define SEAM(k) do { if (!MK_PER_PHASE && (k) + 1 < hi) xcd_barrier(bar); } while (0)

    if (IN(0)) { P p; build_P(p, lds); phase_mod(p, lds); SEAM(0); }

#ifndef REPMASK
#define REPMASK 0
#endif
#define PHASE(k, ...) if (!((SKIPMASK >> (k)) & 1) && IN(pb + (k))) { for (int rep_ = 0; rep_ <= ((REPMASK >> (k)) & 1); ++rep_) { P p; build_P(p, lds); __VA_ARGS__; \
        if (rep_ < ((REPMASK >> (k)) & 1)) xcd_barrier(bar); } SEAM(pb + (k)); }
    for (int l = 0; l < DEPTH; ++l) {
        const int pb = 1 + NPH_LAYER * l;
        const bool cx = l < DEPTH - 1;
        unsigned char* wsb; { unsigned tb_ = (unsigned)(size_t)(lds + PTAB_OFF); asm volatile("" : "+v"(tb_)); wsb = (unsigned char*)ld_tab((volatile LAS unsigned*)(size_t)tb_, 34); }
        PHASE(0, convert_weights(p, l, lds); s5_tables(p, l, (bf16*)(wsb + WS_S5BB), (bf16*)(wsb + WS_S5CC), (float*)(wsb + WS_S5AB)); __syncthreads(); if (rep_ == 0) row_pass<0>(p, l, lds))
        PHASE(1, pg8::Gemm g{p.H, p.WIN, T, PJ, D}; pg8::StaticOrder S; S.init(T, PJ, p.G, p.bid); pg8::EpiStoreBf16 E{p.PROJ, PJ, GT0 / 256};
            pg8::gemm_phase<pg8::EpiStoreBf16, pg8::StaticOrder, false>(lds, g, S, E, nullptr))
        PHASE(2, phase_premix(p, l, lds, rep_ == 0); s5_local_states(p, lds, (const bf16*)(wsb + WS_S5BB), (const float*)(wsb + WS_S5AB)))
        PHASE(3, ssd_states(p, l, lds, (float*)(wsb + WS_SST), (float*)(wsb + WS_DEC)); __syncthreads(); attention_mfma(p, l, lds, 4, 2 * NCH, p.bid, p.G))
        PHASE(4, if (cx) { if (p.bid >= p.G - 4) attention_mfma(p, l, lds, 0, 4, p.bid - (p.G - 4), 4);
                else if (p.bid >= p.G - 20) ssd_outputs(p, l, lds, (const bf16*)(wsb + WS_HIN), (const float*)(wsb + WS_SST), (bf16*)(wsb + WS_YS), 0, 16, p.bid - (p.G - 20), 16);
                else if (p.bid >= p.G - 28) s5_outputs(p, l, lds, (const bf16*)(wsb + WS_S5BB), (const bf16*)(wsb + WS_S5CC), (const float*)(wsb + WS_S5AB), 0, 64, (p.bid - (p.G - 28)) * NWAVES + p.wave, 64); }
            scan_carries(p, l, (const float*)(wsb + WS_SST), (const float*)(wsb + WS_DEC), (bf16*)(wsb + WS_HIN)))
        PHASE(5, ssd_outputs(p, l, lds, (const bf16*)(wsb + WS_HIN), (const float*)(wsb + WS_SST), (bf16*)(wsb + WS_YS), 16, NCH * 8, p.bid, p.G); __syncthreads();
            s5_outputs(p, l, lds, (const bf16*)(wsb + WS_S5BB), (const bf16*)(wsb + WS_S5CC), (const float*)(wsb + WS_S5AB), 64, 32 * NCH, p.bid * NWAVES + p.wave, p.G * NWAVES))
        PHASE(6, pg8::Gemm g{p.SA, p.WGLU, T, 512, 512}; pg8::RowOffOrder S; S.init(cx ? T : NLAT, 512, p.G, p.bid, cx ? 0 : 1); pg8::EpiGlu E{p.SA, p.b_glu + (size_t)l * 512, p.Y3};
            pg8::gemm_phase<pg8::EpiGlu, pg8::RowOffOrder, false>(lds, g, S, E, nullptr); ssd_gated_norm(p, l, (const bf16*)(wsb + WS_YS)))
        PHASE(7, pg8::Gemm g{p.Y3, p.WBR, T, D, 1536}; pg8::RowOffOrder S; S.init(cx ? T : NLAT, D, p.G, p.bid, cx ? 0 : 1); pg8::EpiMerge E{p.PROJ, p.MB};
            pg8::gemm_phase<pg8::EpiMerge, pg8::RowOffOrder, false>(lds, g, S, E, nullptr))
        PHASE(8, pg8::Gemm g{p.MB, p.WOUT, T, D, D}; pg8::RowOffOrder S; S.init(cx ? T : NLAT, D, p.G, p.bid, cx ? 0 : 1);
            pg8::EpiResid E{p.XL, p.XC, p.MOD + (size_t)(l * 2 + 0) * 6144 + 2 * D, p.MOD + (size_t)(l * 2 + 1) * 6144 + 2 * D};
            pg8::gemm_phase<pg8::EpiResid, pg8::RowOffOrder, false>(lds, g, S, E, nullptr))
        PHASE(9, row_pass<1>(p, l, lds, cx))
        PHASE(10, phase_select(p, lds, cx))
        PHASE(11, phase_gather(p, cx))
        PHASE(12, pg8::Gemm g{p.XE, p.WUP, NE * ESLOTS, NE * 2048, D}; pg8::ExpertOrder S{p.G, p.bid, 8, cx ? 9 : 8}; pg8::EpiSwiGlu E{p.HID};
            pg8::gemm_phase<pg8::EpiSwiGlu, pg8::ExpertOrder, false>(lds, g, S, E, nullptr))
        PHASE(13, pg8::Gemm g{p.HID, p.WDN, NE * ESLOTS, NE * 1024, D}; pg8::ExpertOrder S{p.G, p.bid, 4, cx ? 9 : 8}; pg8::EpiDown E{p.YE, p.GSEL};
            pg8::gemm_phase<pg8::EpiDown, pg8::ExpertOrder, false>(lds, g, S, E, nullptr))
    }
    if (IN(NPHASES - 1)) { P p; build_P(p, lds); row_pass<2>(p, 0, lds); }
#undef IN
#undef SEAM
}

extern "C" void kernel_launch(void* const* d_in, const int* in_sizes, int n_in, void* d_out, int out_size, void* d_ws, size_t ws_size, hipStream_t stream) {
    static int grid = 0;
    if (grid == 0) {
        if (n_in != 33 || out_size != NLAT * D || ws_size < WS_END) { fprintf(stderr, "kernel_launch: unexpected shapes: n_in %d out %d ws %zu (need %zu)\n", n_in, out_size, ws_size, (size_t)WS_END); grid = -1; return; }
        int dev = 0, cus = 0, per_cu = 0;
        if (hipGetDevice(&dev) != hipSuccess || hipDeviceGetAttribute(&cus, hipDeviceAttributeMultiprocessorCount, dev) != hipSuccess) { grid = -1; return; }
        if (hipFuncSetAttribute((const void*)fwd_kernel, hipFuncAttributeMaxDynamicSharedMemorySize, LDS_BYTES) != hipSuccess) { fprintf(stderr, "kernel_launch: hipFuncSetAttribute failed\n"); grid = -1; return; }
        if (hipOccupancyMaxActiveBlocksPerMultiprocessor(&per_cu, (const void*)fwd_kernel, NTHR, LDS_BYTES) != hipSuccess || per_cu < 1) { fprintf(stderr, "kernel_launch: occupancy query says %d\n", per_cu); (void)hipGetLastError(); }
        grid = cus;
    }
    if (grid < 0) return;
    (void)hipMemsetAsync((char*)d_ws + WS_CTL, 0, CTL_BYTES, stream);
    Args a{};
    for (int i = 0; i < 33; ++i) a.in[i] = (const float*)d_in[i];
    a.out = (float*)d_out; a.ws = (unsigned char*)d_ws;
#if MK_PER_PHASE
    for (int ph = 0; ph < NPHASES; ++ph) { a.ph_lo = ph; a.ph_hi = ph + 1; hipLaunchKernelGGL(fwd_kernel, dim3(grid), dim3(NTHR), LDS_BYTES, stream, a); }
#else
    a.ph_lo = 0; a.ph_hi = NPHASES;
    hipLaunchKernelGGL(fwd_kernel, dim3(grid), dim3(NTHR), LDS_BYTES, stream, a);
#endif
}
```

```cpp
#include <hip/hip_runtime.h>
#include <cstdio>
#include <cstdint>

#ifndef MK_PER_PHASE
#define MK_PER_PHASE 0
#endif

namespace pg8 {
#define PG8_LAS __attribute__((address_space(3)))
typedef unsigned short bf16_t;
typedef short bf16x8 __attribute__((ext_vector_type(8)));
typedef float f32x4 __attribute__((ext_vector_type(4)));
typedef unsigned u32x4 __attribute__((ext_vector_type(4)));
constexpr int BM = 256, BK = 64, HALF = 128, HTB = HALF * BK * 2  , STAGE_BYTES = 8 * HTB, NXCD = 8, WGM = 8;

__host__ __device__ __forceinline__ int lds_byte(int r, int c) { const int st = (r >> 4) * 2 + (c >> 5), rr = r & 15, cc = c & 31, ob = rr * 64 + cc * 2; return st * 1024 + (ob ^ (((ob >> 9) & 1) << 5)); }
__host__ __device__ __forceinline__ void stage_rc(int b, int& R, int& C) { const int st = b / 1024, sb = b % 1024, swz = sb ^ (((sb >> 9) & 1) << 5); R = (st >> 1) * 16 + swz / 64; C = (st & 1) * 32 + (swz % 64) / 2; }
__host__ __device__ __forceinline__ int perm32(int rho) { const int n = rho >> 4, i = rho & 15; return 8 * (i >> 2) + 4 * n + (i & 3); }

struct Unit { int pm, pn; };
struct Gemm { const bf16_t* A; const bf16_t* Bt; int M, N, K; };

struct StaticOrder {
    int nM, nN, nwg, G, c;
    __host__ __device__ void init(int M, int N, int G_, int c_) { nM = M / BM; nN = N / BM; nwg = nM * nN; G = G_; c = c_; }
    __host__ __device__ bool next(int i, Unit& u) const {
        const long L = (long)i * G + c; if (L >= nwg) return false;
        int wgid = (int)L; { const int q = nwg / NXCD, r = nwg % NXCD, xcd = wgid % NXCD, off = wgid / NXCD; wgid = (xcd < r ? xcd * (q + 1) : r * (q + 1) + (xcd - r) * q) + off; }
        const int nig = WGM * nN, gid = wgid / nig, fm = gid * WGM, gsz = (nM - fm) < WGM ? (nM - fm) : WGM;
        u.pm = fm + ((wgid % nig) % gsz); u.pn = (wgid % nig) / gsz; return true;
    }
    __device__ __forceinline__ void a_ready(const Unit&) const {}
    __device__ __forceinline__ void done(const Unit&) const {}
};
__device__ __forceinline__ unsigned cvt_pk_bf16(float lo, float hi) { unsigned r; asm volatile("v_cvt_pk_bf16_f32 %0, %1, %2" : "=v"(r) : "v"(lo), "v"(hi)); return r; }
template <class Epi, class Sched, bool STAMP = false>
__device__ __forceinline__ void gemm_phase(PG8_LAS unsigned char* lds, const Gemm g, const Sched& S, const Epi& E, unsigned long long* stamps) {
    int tid_l = threadIdx.x; asm volatile("" : "+v"(tid_l));
    const int tid = tid_l, wid = __builtin_amdgcn_readfirstlane(tid >> 6), lane = tid & 63, wr = wid >> 2, wc = wid & 3, fr = lane & 15, fq = lane >> 4;
    const int K = g.K, nt = K / BK;
    int ts_lo = 0, ts_hi = 0, nts = 0; const unsigned long long rt_entry = STAMP ? (unsigned long long)wall_clock64() : 0ull;
#define PG8_STAMP() do { if (STAMP && wid == 0 && nts < 64) { const unsigned long long _c = (unsigned long long)clock64(); \
        ts_lo = (lane == nts) ? (int)(unsigned)_c : ts_lo; ts_hi = (lane == nts) ? (int)(unsigned)(_c >> 32) : ts_hi; ++nts; } } while (0)
    PG8_STAMP();
    unsigned voffA[2], voffB[2];
#pragma unroll
    for (int i = 0; i < 2; ++i) { int R, C; stage_rc(tid * 16 + i * 8192, R, C); const int Rb = Epi::PERM ? ((R & ~31) + perm32(R & 31)) : R;
        voffA[i] = (unsigned)(R * K + C) * 2u; voffB[i] = (unsigned)(Rb * K + C) * 2u; }
    const size_t kstep = (size_t)(BK * 2);
    const size_t hstep = (size_t)HALF * K * 2;
    const size_t tstep = 2 * hstep;
    const unsigned ldsw = (unsigned)wid * 1024u;
    const int aoff = lds_byte(wr * 64 + fr, fq * 8), boff = lds_byte(wc * 32 + fr, fq * 8);
#define PG8_SA(b, h) (((b) * 2 + (h)) * HTB)
#define PG8_SB(b, h) ((4 + (b) * 2 + (h)) * HTB)
#define PG8_STAGE(bufoff, gbase, voff) do { _Pragma("unroll") for (int _i = 0; _i < 2; ++_i) \
        __builtin_amdgcn_global_load_lds((const unsigned*)((const char*)(gbase) + (voff)[_i]), (PG8_LAS unsigned*)(lds + (bufoff) + ldsw + _i * 8192), 16, 0, 0); } while (0)
#define PG8_LDA(dst, b, h) do { _Pragma("unroll") for (int m = 0; m < 4; ++m) _Pragma("unroll") for (int k = 0; k < 2; ++k) dst[m][k] = *(const PG8_LAS bf16x8*)(lds + PG8_SA(b, h) + aoff + m * 2048 + k * 1024); } while (0)
#define PG8_LDB(dst, b, h) do { _Pragma("unroll") for (int n = 0; n < 2; ++n) _Pragma("unroll") for (int k = 0; k < 2; ++k) dst[n][k] = *(const PG8_LAS bf16x8*)(lds + PG8_SB(b, h) + boff + n * 2048 + k * 1024); } while (0)
#define PG8_MMA(ai, bj, At, Bt) do { __builtin_amdgcn_s_setprio(1); _Pragma("unroll") for (int m = 0; m < 4; ++m) _Pragma("unroll") for (int n = 0; n < 2; ++n) _Pragma("unroll") for (int k = 0; k < 2; ++k) \
        acc[ai][bj][m][n] = __builtin_amdgcn_mfma_f32_16x16x32_bf16(Bt[n][k], At[m][k], acc[ai][bj][m][n], 0, 0, 0); __builtin_amdgcn_s_setprio(0); } while (0)
#define PG8_WAIT_V(n) asm volatile("s_waitcnt vmcnt(" #n ")" ::: "memory")
#define PG8_WAIT_L(n) asm volatile("s_waitcnt lgkmcnt(" #n ")" ::: "memory")
#define PG8_BAR __builtin_amdgcn_s_barrier()
#define PG8_SCHED __builtin_amdgcn_sched_barrier(0)
    Unit cur, nxt; int ui = 0;
    if (!S.next(0, cur)) return;
    f32x4 acc[2][2][4][2];
#pragma unroll
    for (int a = 0; a < 2; ++a)
#pragma unroll
        for (int b = 0; b < 2; ++b)
#pragma unroll
            for (int m = 0; m < 4; ++m)
#pragma unroll
                for (int n = 0; n < 2; ++n) acc[a][b][m][n] = (f32x4){0.f, 0.f, 0.f, 0.f};
    bf16x8 At[4][2], B0[2][2], B1[2][2];
    const char* cA = (const char*)g.A + (size_t)cur.pm * tstep; const char* cB = (const char*)g.Bt + (size_t)cur.pn * tstep;
    S.a_ready(cur);
    PG8_STAGE(PG8_SB(0, 0), cB, voffB); PG8_STAGE(PG8_SA(0, 0), cA, voffA); PG8_STAGE(PG8_SB(0, 1), cB + hstep, voffB); PG8_STAGE(PG8_SA(0, 1), cA + hstep, voffA);
    if (wr == 1) PG8_BAR;
    PG8_WAIT_V(4); PG8_BAR;
    PG8_STAGE(PG8_SB(1, 0), cB + kstep, voffB); PG8_STAGE(PG8_SA(1, 0), cA + kstep, voffA); PG8_STAGE(PG8_SB(1, 1), cB + hstep + kstep, voffB);
    PG8_WAIT_V(6); PG8_BAR;
    PG8_STAMP();
    for (;;) {
        const bool has_next = S.next(ui + 1, nxt);
        const char* nA = has_next ? (const char*)g.A + (size_t)nxt.pm * tstep : cA; const char* nB = has_next ? (const char*)g.Bt + (size_t)nxt.pn * tstep : cB;
        for (int t = 0; t < nt; t += 2) {
            const bool last = (t == nt - 2);
            const char* a1 = cA + (size_t)(t + 1) * kstep;
            const char* a2 = last ? nA : cA + (size_t)(t + 2) * kstep; const char* b2 = last ? nB : cB + (size_t)(t + 2) * kstep;
            const char* a3 = a2 + kstep; const char* b3 = b2 + kstep;
            if (last && has_next) S.a_ready(nxt);
            if constexpr (Epi::MIDHOOK) { if (t == 8 || t == 16) E.mid(acc, cur, t >> 3, wr, wc, fr, fq); }
            PG8_LDB(B0, 0, 0); PG8_SCHED; PG8_LDA(At, 0, 0); PG8_STAGE(PG8_SA(1, 1), a1 + hstep, voffA);
            PG8_WAIT_L(8); PG8_BAR; PG8_WAIT_L(0); PG8_MMA(0, 0, At, B0); PG8_BAR; PG8_SCHED;
            PG8_LDB(B1, 0, 1); PG8_STAGE(PG8_SB(0, 0), b2, voffB);
            PG8_BAR; PG8_WAIT_L(0); PG8_MMA(0, 1, At, B1); PG8_BAR;
            PG8_LDA(At, 0, 1); PG8_STAGE(PG8_SA(0, 0), a2, voffA);
            PG8_BAR; PG8_WAIT_L(0); PG8_MMA(1, 0, At, B0); PG8_BAR; PG8_SCHED;
            PG8_STAGE(PG8_SB(0, 1), b2 + hstep, voffB);
            PG8_WAIT_V(6); PG8_BAR; PG8_MMA(1, 1, At, B1); PG8_BAR;
            PG8_LDB(B0, 1, 0); PG8_SCHED; PG8_LDA(At, 1, 0); PG8_STAGE(PG8_SA(0, 1), a2 + hstep, voffA);
            PG8_WAIT_L(8); PG8_BAR; PG8_WAIT_L(0); PG8_MMA(0, 0, At, B0); PG8_BAR; PG8_SCHED;
            PG8_LDB(B1, 1, 1); PG8_STAGE(PG8_SB(1, 0), b3, voffB);
            PG8_BAR; PG8_WAIT_L(0); PG8_MMA(0, 1, At, B1); PG8_BAR;
            PG8_LDA(At, 1, 1); PG8_STAGE(PG8_SA(1, 0), a3, voffA);
            PG8_BAR; PG8_WAIT_L(0); PG8_MMA(1, 0, At, B0); PG8_BAR; PG8_SCHED;
            PG8_STAGE(PG8_SB(1, 1), b3 + hstep, voffB);
            PG8_WAIT_V(6); PG8_BAR; PG8_MMA(1, 1, At, B1); PG8_BAR;
        }
        PG8_STAMP();
        if constexpr (!Epi::AFTER_DRAIN) { E(acc, cur, wr, wc, fr, fq); S.done(cur); }
        PG8_STAMP();
        if (!has_next) break;
#pragma unroll
        for (int a = 0; a < 2; ++a)
#pragma unroll
            for (int b = 0; b < 2; ++b)
#pragma unroll
                for (int m = 0; m < 4; ++m)
#pragma unroll
                    for (int n = 0; n < 2; ++n) acc[a][b][m][n] = (f32x4){0.f, 0.f, 0.f, 0.f};
        cur = nxt; cA = nA; cB = nB; ++ui;
    }
    PG8_WAIT_V(0);
    if (wr == 0) PG8_BAR;
    PG8_BAR;
    if constexpr (Epi::AFTER_DRAIN) { E.fused(acc, cur, wr, wc, fr, fq, lds, wid, lane); S.done(cur); }
    PG8_STAMP();
    if (STAMP && wid == 0) { stamps[lane] = lane < nts ? (((unsigned long long)(unsigned)ts_hi << 32) | (unsigned)ts_lo) : 0ull;
        if (lane == 62) stamps[62] = rt_entry; if (lane == 63) stamps[63] = (unsigned long long)wall_clock64(); }
#undef PG8_STAMP
#undef PG8_SA
#undef PG8_SB
#undef PG8_STAGE
#undef PG8_LDA
#undef PG8_LDB
#undef PG8_MMA
#undef PG8_WAIT_V
#undef PG8_WAIT_L
#undef PG8_BAR
#undef PG8_SCHED
}
}

#define GAS __attribute__((address_space(1)))
#define LAS __attribute__((address_space(3)))
typedef unsigned short bf16;
typedef float f32x4 __attribute__((ext_vector_type(4)));
typedef unsigned u32x4 __attribute__((ext_vector_type(4)));
typedef unsigned u32x2 __attribute__((ext_vector_type(2)));

constexpr int D = 1024, NLAT = 16384, NCTX = 256, T = NLAT + NCTX, DEPTH = 4;
constexpr int IN_W = 5904, PJ = 5888;
constexpr int U0 = 0, Z0 = 512, XB0 = 1024, Q0 = 2048, K0 = 2560, V0 = 2688, GT0 = 2816;
constexpr int NE = 16, ESLOTS = 2304, CAP_L = 2048, CAP_C = 32;
constexpr int NCH = 130;
constexpr float EPS = 1e-6f;
constexpr int NWAVES = 8, NTHR = 512;
constexpr int LDS_BYTES = 155648;
constexpr int MISC_OFF = LDS_BYTES - 1024 + 512;
constexpr int NPH_LAYER = 14, NPHASES = 1 + DEPTH * NPH_LAYER + 1;

constexpr size_t al256(size_t x) { return (x + 255) & ~(size_t)255; }
constexpr size_t WS_CTL = 0, CTL_BYTES = 1u << 20;
constexpr size_t WS_MOD = WS_CTL + CTL_BYTES;
constexpr size_t WS_XC = al256(WS_MOD + (size_t)DEPTH * 2 * 6144 * 4);
constexpr size_t WS_WIN = al256(WS_XC + (size_t)NCTX * D * 4);
constexpr size_t WS_WGLU = al256(WS_WIN + (size_t)PJ * D * 2);
constexpr size_t WS_WBR = al256(WS_WGLU + (size_t)512 * 512 * 2);
constexpr size_t WS_WOUT = al256(WS_WBR + (size_t)3 * 1024 * 512 * 2);
constexpr size_t WS_WUP = al256(WS_WOUT + (size_t)1024 * 1024 * 2);
constexpr size_t WS_WDN = al256(WS_WUP + (size_t)NE * 2048 * 1024 * 2);
constexpr size_t WS_H = al256(WS_WDN + (size_t)NE * 1024 * 1024 * 2);
constexpr size_t WS_PROJ = al256(WS_H + (size_t)T * D * 2);
constexpr size_t WS_XE = WS_PROJ;
constexpr size_t WS_HID = al256(WS_XE + (size_t)NE * ESLOTS * D * 2);
constexpr size_t WS_DT = al256(WS_PROJ + (size_t)T * PJ * 2);
constexpr size_t WS_CV = al256(WS_DT + (size_t)T * 16 * 4);
constexpr size_t WS_S5E = al256(WS_CV + (size_t)T * 1024 * 2);
constexpr size_t WS_S5H = al256(WS_S5E + (size_t)2 * 32 * NCH * 128 * 4);
constexpr size_t WS_YD = al256(WS_S5H + (size_t)2 * 32 * NCH * 128 * 4);
constexpr size_t WS_SA = al256(WS_YD + (size_t)2 * T * 512 * 4);
constexpr size_t WS_Y3 = al256(WS_SA + (size_t)T * 512 * 2);
constexpr size_t WS_PM = al256(WS_Y3 + (size_t)3 * T * 512 * 2);
constexpr size_t WS_MB = al256(WS_PM + (size_t)T * D * 4);
constexpr size_t WS_YE = WS_PM;
constexpr size_t WS_AFFT = al256(WS_MB + (size_t)T * D * 2);
constexpr size_t WS_IDX = al256(WS_AFFT + (size_t)NE * T * 4);
constexpr size_t WS_GSEL = al256(WS_IDX + (size_t)NE * ESLOTS * 4);
constexpr size_t WS_INV = al256(WS_GSEL + (size_t)NE * ESLOTS * 4);
constexpr size_t WS_DEC = al256(WS_INV + (size_t)T * 16 * 4);
constexpr size_t WS_S5BB = al256(WS_DEC + (size_t)2 * NCH * 8 * 4);
constexpr size_t WS_S5CC = al256(WS_S5BB + (size_t)2 * 32 * 128 * 32 * 2);
constexpr size_t WS_S5AB = al256(WS_S5CC + (size_t)2 * 32 * 16 * 128 * 2);
constexpr size_t WS_ROPE = al256(WS_S5AB + (size_t)2 * 32 * 64 * 2 * 4);
constexpr size_t WS_END = al256(WS_ROPE + (size_t)2 * 256 * 16 * 4);
constexpr size_t WS_SST = WS_YD;
constexpr size_t WS_HIN = WS_PM;
constexpr size_t WS_YS = al256(WS_HIN + (size_t)2 * NCH * 8 * 8192 * 2);
static_assert(WS_YS + (size_t)T * 512 * 2 <= WS_AFFT, "HIN|YS overlay fits PM|MB");
static_assert(WS_HID + (size_t)NE * ESLOTS * D * 2 <= WS_DT, "XE|HID overlay fits PROJ");
static_assert(WS_YE + (size_t)NE * ESLOTS * D * 2 <= WS_AFFT, "YE overlay fits PM|MB");
static_assert(WS_END < (size_t)1000 * 1024 * 1024, "workspace");
constexpr int CW_BAR = 4096;

__device__ __forceinline__ float bf2f(unsigned b) { return __uint_as_float(b << 16); }
__device__ __forceinline__ float bflo(unsigned w) { return __uint_as_float(w << 16); }
__device__ __forceinline__ float bfhi(unsigned w) { return __uint_as_float(w & 0xffff0000u); }
typedef float f32x2_c __attribute__((ext_vector_type(2)));
typedef __bf16 bf16x2_c __attribute__((ext_vector_type(2)));
__device__ __forceinline__ unsigned pk2(float lo, float hi) { f32x2_c v; v[0] = lo; v[1] = hi; return __builtin_bit_cast(unsigned, __builtin_convertvector(v, bf16x2_c)); }
__device__ __forceinline__ unsigned f2bf(float f) { return pk2(f, 0.f) & 0xffffu; }
__device__ __forceinline__ float wsum(float v) {
#pragma unroll
    for (int o = 1; o < 64; o <<= 1) v += __shfl_xor(v, o);
    return v;
}
__device__ __forceinline__ float wmaxf(float v) {
#pragma unroll
    for (int o = 1; o < 64; o <<= 1) v = fmaxf(v, __shfl_xor(v, o));
    return v;
}
__device__ __forceinline__ float silu_f(float x) { return x * __builtin_amdgcn_rcpf(1.f + __expf(-x)); }
__device__ __forceinline__ float sigmoid_f(float x) { return __builtin_amdgcn_rcpf(1.f + __expf(-x)); }
__device__ __forceinline__ float softplus_f(float x) { return x > 20.f ? x : log1pf(expf(x)); }
__device__ __forceinline__ float gelu_tanh_f(float x) { const float u = 0.7978845608028654f * (x + 0.044715f * x * x * x); return x * __builtin_amdgcn_rcpf(1.f + __expf(-2.f * u)); }
#define LDS_FENCE() asm volatile("s_waitcnt lgkmcnt(0)" ::: "memory")
__device__ __forceinline__ int scan_row(int d, int s) { return d == 0 ? s : (s < NCTX ? (NCTX - 1 - s) : (T + NCTX - 1 - s)); }

namespace pg8 {
struct EpiStoreBf16 {
    static constexpr bool PERM = true, AFTER_DRAIN = false, MIDHOOK = false;
    bf16_t* O; int ldc; int sig_tile; const float* rope;
    __device__ __forceinline__ void operator()(const f32x4 (&acc)[2][2][4][2], const Unit& u, int wr, int wc, int fr, int fq) const {
        const int row0 = u.pm * BM + wr * 64 + fr, col0 = u.pn * BM + wc * 32 + 8 * fq; const bool sg = u.pn >= sig_tile;
        const bool rq = rope != nullptr && u.pm >= 1 && (u.pn == Q0 / 256 || u.pn == Q0 / 256 + 1), rk = rope != nullptr && u.pm >= 1 && u.pn == K0 / 256;
#pragma unroll
        for (int ai = 0; ai < 2; ++ai)
#pragma unroll
            for (int m = 0; m < 4; ++m) { const int row = row0 + ai * HALF + m * 16; bf16_t* rowp = O + (size_t)row * ldc + col0;
#pragma unroll
                for (int bj = 0; bj < 2; ++bj) { f32x4 v0 = acc[ai][bj][m][0], v1 = acc[ai][bj][m][1];
                    if (sg) {
#pragma unroll
                        for (int q = 0; q < 4; ++q) { v0[q] = __builtin_amdgcn_rcpf(1.f + __expf(-v0[q])); v1[q] = __builtin_amdgcn_rcpf(1.f + __expf(-v1[q])); } }
                    if (rq || (rk && bj == 0)) {
                        const int t = row - NCTX, idx = (wc & 1) ? (t & 63) : (t >> 6);
                        const float* cp = rope + idx * 16 + 8 * (fq & 1);
                        const f32x4 c0 = *(const f32x4*)cp, c1 = *(const f32x4*)(cp + 4), s0 = *(const f32x4*)(cp + 4096), s1 = *(const f32x4*)(cp + 4100);
                        const float sgn = (fq & 2) ? 1.f : -1.f;
#pragma unroll
                        for (int q = 0; q < 4; ++q) { const float p0 = __shfl_xor(v0[q], 32), p1 = __shfl_xor(v1[q], 32);
                            v0[q] = v0[q] * c0[q] + sgn * p0 * s0[q]; v1[q] = v1[q] * c1[q] + sgn * p1 * s1[q]; } }
                    u32x4 w; w.x = cvt_pk_bf16(v0[0], v0[1]); w.y = cvt_pk_bf16(v0[2], v0[3]); w.z = cvt_pk_bf16(v1[0], v1[1]); w.w = cvt_pk_bf16(v1[2], v1[3]);
                    *(u32x4*)(rowp + bj * HALF) = w; } }
    }
};
struct EpiGlu {
    static constexpr bool PERM = true, AFTER_DRAIN = false, MIDHOOK = false;
    const bf16_t* A; const float* bias; bf16_t* O;
    __device__ __forceinline__ void operator()(const f32x4 (&acc)[2][2][4][2], const Unit& u, int wr, int wc, int fr, int fq) const {
        const int row0 = u.pm * BM + wr * 64 + fr, col0 = u.pn * BM + wc * 32 + 8 * fq;
#pragma unroll
        for (int ai = 0; ai < 2; ++ai)
#pragma unroll
            for (int m = 0; m < 4; ++m) { const size_t ro = (size_t)(row0 + ai * HALF + m * 16) * 512 + col0;
#pragma unroll
                for (int bj = 0; bj < 2; ++bj) { const f32x4 v0 = acc[ai][bj][m][0], v1 = acc[ai][bj][m][1];
                    const u32x4 a = *(const u32x4*)(A + ro + bj * HALF);
                    const f32x4 b0 = *(const f32x4*)(bias + col0 + bj * HALF), b1 = *(const f32x4*)(bias + col0 + bj * HALF + 4);
                    float o[8];
                    o[0] = bflo(a.x) * sigmoid_f(v0[0] + b0[0]); o[1] = bfhi(a.x) * sigmoid_f(v0[1] + b0[1]);
                    o[2] = bflo(a.y) * sigmoid_f(v0[2] + b0[2]); o[3] = bfhi(a.y) * sigmoid_f(v0[3] + b0[3]);
                    o[4] = bflo(a.z) * sigmoid_f(v1[0] + b1[0]); o[5] = bfhi(a.z) * sigmoid_f(v1[1] + b1[1]);
                    o[6] = bflo(a.w) * sigmoid_f(v1[2] + b1[2]); o[7] = bfhi(a.w) * sigmoid_f(v1[3] + b1[3]);
                    u32x4 w; w.x = cvt_pk_bf16(o[0], o[1]); w.y = cvt_pk_bf16(o[2], o[3]); w.z = cvt_pk_bf16(o[4], o[5]); w.w = cvt_pk_bf16(o[6], o[7]);
                    *(u32x4*)(O + (size_t)(row0 + ai * HALF + m * 16) * 1536 + col0 + bj * HALF) = w; } }
    }
};
struct RowOffOrder {
    StaticOrder b; int off;
    __device__ __forceinline__ void init(int M, int N, int G, int c, int off_) { b.init(M, N, G, c); off = off_; }
    __device__ __forceinline__ bool next(int i, Unit& u) const { if (!b.next(i, u)) return false; u.pm += off; return true; }
    __device__ __forceinline__ void a_ready(const Unit&) const {}
    __device__ __forceinline__ void done(const Unit&) const {}
};
struct EpiMerge {
    static constexpr bool PERM = true, AFTER_DRAIN = false, MIDHOOK = true;
    const bf16_t* proj; bf16_t* MB;
    __device__ __forceinline__ void mid(f32x4 (&acc)[2][2][4][2], const Unit& u, int seg, int wr, int wc, int fr, int fq) const {
        const unsigned base = (unsigned)((u.pm * BM + wr * 64 + fr) * PJ + GT0 + (seg - 1) * 1024 + u.pn * BM + wc * 32 + 8 * fq) * 2u;
        const char* pb = (const char*)proj;
#pragma unroll
        for (int ai = 0; ai < 2; ++ai)
#pragma unroll
            for (int m = 0; m < 4; ++m) {
                u32x4 ga[2], gb[2];
#pragma unroll
                for (int bj = 0; bj < 2; ++bj) { const unsigned o = base + (unsigned)(((ai * HALF + m * 16) * PJ + bj * HALF) * 2);
                    ga[bj] = *(const u32x4*)(pb + o); gb[bj] = *(const u32x4*)(pb + o + 2048u); }
#pragma unroll
                for (int bj = 0; bj < 2; ++bj) { const u32x4 a = ga[bj], b = gb[bj];
                    f32x4& v0 = acc[ai][bj][m][0]; f32x4& v1 = acc[ai][bj][m][1];
                    v0[0] *= bflo(a.x) * __builtin_amdgcn_rcpf(bflo(b.x)); v0[1] *= bfhi(a.x) * __builtin_amdgcn_rcpf(bfhi(b.x));
                    v0[2] *= bflo(a.y) * __builtin_amdgcn_rcpf(bflo(b.y)); v0[3] *= bfhi(a.y) * __builtin_amdgcn_rcpf(bfhi(b.y));
                    v1[0] *= bflo(a.z) * __builtin_amdgcn_rcpf(bflo(b.z)); v1[1] *= bfhi(a.z) * __builtin_amdgcn_rcpf(bfhi(b.z));
                    v1[2] *= bflo(a.w) * __builtin_amdgcn_rcpf(bflo(b.w)); v1[3] *= bfhi(a.w) * __builtin_amdgcn_rcpf(bfhi(b.w)); }
                if (m & 1) asm volatile("" ::: "memory");
            }
    }
    __device__ __forceinline__ void operator()(const f32x4 (&acc)[2][2][4][2], const Unit& u, int wr, int wc, int fr, int fq) const {
        const int row0 = u.pm * BM + wr * 64 + fr, col0 = u.pn * BM + wc * 32 + 8 * fq;
#pragma unroll
        for (int ai = 0; ai < 2; ++ai)
#pragma unroll
            for (int m = 0; m < 4; ++m) { const int row = row0 + ai * HALF + m * 16;
#pragma unroll
                for (int bj = 0; bj < 2; ++bj) { const f32x4 v0 = acc[ai][bj][m][0], v1 = acc[ai][bj][m][1]; const int col = col0 + bj * HALF;
                    const u32x4 g = *(const u32x4*)(proj + (size_t)row * PJ + GT0 + 2048 + col);
                    u32x4 w; w.x = cvt_pk_bf16(bflo(g.x) * v0[0], bfhi(g.x) * v0[1]); w.y = cvt_pk_bf16(bflo(g.y) * v0[2], bfhi(g.y) * v0[3]);
                    w.z = cvt_pk_bf16(bflo(g.z) * v1[0], bfhi(g.z) * v1[1]); w.w = cvt_pk_bf16(bflo(g.w) * v1[2], bfhi(g.w) * v1[3]);
                    *(u32x4*)(MB + (size_t)row * 1024 + col) = w; } }
    }
};
struct EpiResid {
    static constexpr bool PERM = false, AFTER_DRAIN = false, MIDHOOK = false;
    float* XL; float* XC; const float* g_lat; const float* g_ctx;
    __device__ __forceinline__ void operator()(const f32x4 (&acc)[2][2][4][2], const Unit& u, int wr, int wc, int fr, int fq) const {
        const bool isc = (u.pm == 0);
        float* base = isc ? XC : (XL - (size_t)NCTX * D); const float* gv = isc ? g_ctx : g_lat;
        const int row0 = u.pm * BM + wr * 64 + fr, col0 = u.pn * BM + wc * 32 + 4 * fq;
#pragma unroll
        for (int ai = 0; ai < 2; ++ai)
#pragma unroll
            for (int m = 0; m < 4; ++m) { float* rowp = base + (size_t)(row0 + ai * HALF + m * 16) * D + col0;
#pragma unroll
                for (int bj = 0; bj < 2; ++bj)
#pragma unroll
                    for (int n = 0; n < 2; ++n) { float* pp = rowp + bj * HALF + n * 16; const f32x4 g = *(const f32x4*)(gv + col0 + bj * HALF + n * 16);
                        f32x4 x = *(const f32x4*)pp; x += g * acc[ai][bj][m][n]; *(f32x4*)pp = x; } }
    }
};
struct ExpertOrder {
    int G, c, nnt, nmt;
    __device__ __forceinline__ bool next(int i, Unit& u) const { const int L = i * G + c; if (L >= NE * nmt * nnt) return false; const int e = L / (nmt * nnt), rem = L % (nmt * nnt); u.pm = e * 9 + rem % nmt; u.pn = e * nnt + rem / nmt; return true; }
    __device__ __forceinline__ void a_ready(const Unit&) const {}
    __device__ __forceinline__ void done(const Unit&) const {}
};
struct EpiSwiGlu {
    static constexpr bool PERM = true, AFTER_DRAIN = false, MIDHOOK = false;
    bf16_t* HID;
    __device__ __forceinline__ void operator()(const f32x4 (&acc)[2][2][4][2], const Unit& u, int wr, int wc, int fr, int fq) const {
        const int row0 = u.pm * BM + wr * 64 + fr, col0 = (u.pn & 7) * 128 + wc * 32 + 8 * fq;
#pragma unroll
        for (int ai = 0; ai < 2; ++ai)
#pragma unroll
            for (int m = 0; m < 4; ++m) { const f32x4 g0 = acc[ai][0][m][0], g1 = acc[ai][0][m][1], u0 = acc[ai][1][m][0], u1 = acc[ai][1][m][1];
                u32x4 w;
                w.x = cvt_pk_bf16(silu_f(g0[0]) * u0[0], silu_f(g0[1]) * u0[1]); w.y = cvt_pk_bf16(silu_f(g0[2]) * u0[2], silu_f(g0[3]) * u0[3]);
                w.z = cvt_pk_bf16(silu_f(g1[0]) * u1[0], silu_f(g1[1]) * u1[1]); w.w = cvt_pk_bf16(silu_f(g1[2]) * u1[2], silu_f(g1[3]) * u1[3]);
                *(u32x4*)(HID + (size_t)(row0 + ai * HALF + m * 16) * 1024 + col0) = w; }
    }
};
struct EpiDown {
    static constexpr bool PERM = true, AFTER_DRAIN = false, MIDHOOK = false;
    bf16_t* YE; const float* gsel;
    __device__ __forceinline__ void operator()(const f32x4 (&acc)[2][2][4][2], const Unit& u, int wr, int wc, int fr, int fq) const {
        const int row0 = u.pm * BM + wr * 64 + fr, col0 = (u.pn & 3) * BM + wc * 32 + 8 * fq;
#pragma unroll
        for (int ai = 0; ai < 2; ++ai)
#pragma unroll
            for (int m = 0; m < 4; ++m) { const int row = row0 + ai * HALF + m * 16; const float gs = gsel[row];
#pragma unroll
                for (int bj = 0; bj < 2; ++bj) { const f32x4 v0 = acc[ai][bj][m][0] * gs, v1 = acc[ai][bj][m][1] * gs;
                    u32x4 w; w.x = cvt_pk_bf16(v0[0], v0[1]); w.y = cvt_pk_bf16(v0[2], v0[3]); w.z = cvt_pk_bf16(v1[0], v1[1]); w.w = cvt_pk_bf16(v1[2], v1[3]);
                    *(u32x4*)(YE + (size_t)row * 1024 + col0 + bj * HALF) = w; } }
    }
};
}
#define XB_TMO      128
#define XB_XCNT(j)  (256  + 64 * (j))
#define XB_XSUB(j)  (1280 + 64 * (j))
#define XB_XGEN(j)  (2304 + 64 * (j))
#define XB_TOP      3328
#define XB_TOPGEN   3392
#define XCD_BAR_WORDS 3456
#define XB_SPIN_CAP (1u << 18)
#define LAS __attribute__((address_space(3)))

__device__ __forceinline__ unsigned xb_ld(unsigned* p)              { return __hip_atomic_load(p, __ATOMIC_RELAXED, __HIP_MEMORY_SCOPE_AGENT); }
__device__ __forceinline__ unsigned xb_add(unsigned* p, unsigned v) { return __hip_atomic_fetch_add(p, v, __ATOMIC_RELAXED, __HIP_MEMORY_SCOPE_AGENT); }
__device__ __forceinline__ unsigned xb_xcc_id() { return (unsigned)__builtin_amdgcn_s_getreg((3 << 11) | 20) & 0xFu; }
#define XB_SPIN(cond, bar) do { unsigned _sp = 0; while (cond) { __builtin_amdgcn_s_sleep(1); \
    if ((++_sp & 255u) == 0u) { if (xb_ld(&(bar)[XB_TMO])) break; if (_sp > XB_SPIN_CAP) { atomicAdd(&(bar)[XB_TMO], 1u); break; } } } } while (0)

struct XcdBarrier {
    unsigned* bar; unsigned x;
    volatile LAS unsigned* st;
};

__device__ __forceinline__ XcdBarrier xcd_barrier_post(unsigned* bar, volatile LAS unsigned* st) {
    XcdBarrier b; b.bar = bar; b.x = xb_xcc_id(); b.st = st;
    if (threadIdx.x == 0) (void)xb_add(&bar[XB_XCNT(b.x)], 1u);
    return b;
}
__device__ __forceinline__ void xcd_barrier_complete(unsigned* bar, unsigned x, unsigned& nloc, unsigned& nx) {
    const unsigned G = gridDim.x * gridDim.y * gridDim.z;
    unsigned sum, cnt, mine, sp = 0u;
    for (;;) {
        sum = 0u; cnt = 0u; mine = 0u;
#pragma unroll
        for (unsigned j = 0; j < 16; ++j) { const unsigned c = xb_ld(&bar[XB_XCNT(j)]); sum += c; cnt += (c > 0u) ? 1u : 0u; mine = (j == x) ? c : mine; }
        if (sum == G) break;
        __builtin_amdgcn_s_sleep(1);
        if ((++sp & 255u) == 0u) { if (xb_ld(&bar[XB_TMO])) break; if (sp > XB_SPIN_CAP) { atomicAdd(&bar[XB_TMO], 1u); break; } }
    }
    nloc = mine > 0u ? mine : 1u; nx = cnt > 0u ? cnt : 1u;
}

__device__ __forceinline__ void xcd_barrier(const XcdBarrier& b) {
    asm volatile("s_waitcnt vmcnt(0)" ::: "memory");
    __syncthreads();
    if (threadIdx.x == 0) {
        unsigned* bar = b.bar;
        __builtin_amdgcn_s_waitcnt(0);
        unsigned nloc = b.st[0], nx = b.st[1];
        if (nloc == 0u) { xcd_barrier_complete(bar, b.x, nloc, nx); b.st[0] = nloc; b.st[1] = nx; }
        const unsigned old = xb_add(&bar[XB_XSUB(b.x)], 1u);
        const unsigned gen = old / nloc;
        if (old + 1u == (gen + 1u) * nloc) {
            __builtin_amdgcn_fence(__ATOMIC_RELEASE, "agent");
            asm volatile("s_waitcnt vmcnt(0)" ::: "memory");
            const unsigned og = xb_add(&bar[XB_TOP], 1u);
            const unsigned tg = og / nx;
            if (og + 1u == (tg + 1u) * nx) xb_add(&bar[XB_TOPGEN], 1u);
            else XB_SPIN(xb_ld(&bar[XB_TOPGEN]) == tg, bar);
            __builtin_amdgcn_fence(__ATOMIC_ACQUIRE, "agent");
            xb_add(&bar[XB_XGEN(b.x)], 1u);
            asm volatile("s_waitcnt vmcnt(0)" ::: "memory");
        } else {
            XB_SPIN(xb_ld(&bar[XB_XGEN(b.x)]) == gen, bar);
            __builtin_amdgcn_fence(__ATOMIC_ACQUIRE, "agent");
            asm volatile("s_waitcnt vmcnt(0)" ::: "memory");
        }
    }
    __syncthreads();
}


struct P {
    const float *x, *c, *ctx, *c_ctx, *w_mod, *b_mod, *norm1_g, *norm2_g, *w_in, *lam_re, *lam_im, *log_dt, *b_re, *b_im, *c_re, *c_im, *s5_d, *w_glu, *b_glu,
        *conv_w, *conv_b, *a_log, *dt_bias, *ssd_d, *ssd_norm_g, *sink, *w_branch, *w_out, *w_router, *w_eg, *w_eu, *w_ed, *final_g;
    float* XL;
    float *MOD, *XC, *DT, *S5E, *S5H, *YD, *PM, *AFFT, *GSEL;
    bf16 *WIN, *WGLU, *WBR, *WOUT, *WUP, *WDN, *H, *PROJ, *XE, *HID, *CV, *SA, *Y3, *MB, *YE;
    int *IDX, *INV;
    int tid, lane, wave, bid, G;
};


constexpr int PTAB_OFF = LDS_BYTES - 1024;
__device__ __forceinline__ unsigned long long ld_tab(volatile LAS unsigned* t, int k) {
    const unsigned lo = __builtin_amdgcn_readfirstlane(t[2 * k]), hi = __builtin_amdgcn_readfirstlane(t[2 * k + 1]);
    return ((unsigned long long)hi << 32) | lo;
}
__device__ __forceinline__ void build_P(P& p, LAS unsigned char* lds) {
    int tid_l = threadIdx.x, bid_l = blockIdx.x, g_l = gridDim.x;
    asm volatile("" : "+v"(tid_l), "+s"(bid_l), "+s"(g_l));
    p.tid = tid_l; p.lane = p.tid & 63; p.wave = __builtin_amdgcn_readfirstlane(p.tid >> 6); p.bid = bid_l; p.G = g_l;
    unsigned tbase = (unsigned)(size_t)(lds + PTAB_OFF); asm volatile("" : "+v"(tbase));
    volatile LAS unsigned* tb = (volatile LAS unsigned*)(size_t)tbase;
#define INP(k) ((const float*)ld_tab(tb, k))
    p.x = INP(0); p.c = INP(1); p.ctx = INP(2); p.c_ctx = INP(3); p.w_mod = INP(4); p.b_mod = INP(5); p.norm1_g = INP(6); p.norm2_g = INP(7);
    p.w_in = INP(8); p.lam_re = INP(9); p.lam_im = INP(10); p.log_dt = INP(11); p.b_re = INP(12); p.b_im = INP(13); p.c_re = INP(14); p.c_im = INP(15);
    p.s5_d = INP(16); p.w_glu = INP(17); p.b_glu = INP(18); p.conv_w = INP(19); p.conv_b = INP(20); p.a_log = INP(21); p.dt_bias = INP(22); p.ssd_d = INP(23);
    p.ssd_norm_g = INP(24); p.sink = INP(25); p.w_branch = INP(26); p.w_out = INP(27); p.w_router = INP(28); p.w_eg = INP(29); p.w_eu = INP(30); p.w_ed = INP(31);
    p.final_g = INP(32);
#undef INP
    p.XL = (float*)ld_tab(tb, 33);
    unsigned char* ws = (unsigned char*)ld_tab(tb, 34);
    p.MOD = (float*)(ws + WS_MOD); p.XC = (float*)(ws + WS_XC); p.DT = (float*)(ws + WS_DT); p.S5E = (float*)(ws + WS_S5E); p.S5H = (float*)(ws + WS_S5H); p.YD = (float*)(ws + WS_YD);
    p.PM = (float*)(ws + WS_PM); p.AFFT = (float*)(ws + WS_AFFT); p.GSEL = (float*)(ws + WS_GSEL);
    p.WIN = (bf16*)(ws + WS_WIN); p.WGLU = (bf16*)(ws + WS_WGLU); p.WBR = (bf16*)(ws + WS_WBR); p.WOUT = (bf16*)(ws + WS_WOUT); p.WUP = (bf16*)(ws + WS_WUP); p.WDN = (bf16*)(ws + WS_WDN);
    p.H = (bf16*)(ws + WS_H); p.PROJ = (bf16*)(ws + WS_PROJ); p.XE = (bf16*)(ws + WS_XE); p.HID = (bf16*)(ws + WS_HID); p.CV = (bf16*)(ws + WS_CV); p.SA = (bf16*)(ws + WS_SA);
    p.Y3 = (bf16*)(ws + WS_Y3); p.MB = (bf16*)(ws + WS_MB); p.YE = (bf16*)(ws + WS_YE);
    p.IDX = (int*)(ws + WS_IDX); p.INV = (int*)(ws + WS_INV);
}
__device__ __forceinline__ void phase_mod(const P& p, LAS unsigned char* lds, float* ropet) {
    for (int i = p.bid * NTHR + p.tid; i < 256 * 16; i += p.G * NTHR) { const float inv = exp2f(-(float)(i & 15) * 0.83048202372184058696f);
        float sn, cs; sincosf((float)(i >> 4) * inv, &sn, &cs); ropet[i] = cs; ropet[4096 + i] = sn; }
    LAS float* sc = (LAS float*)lds;
    LAS float* part = sc + 2048;
    for (int i = p.tid; i < 1024; i += NTHR) { sc[i] = silu_f(p.c[i]); sc[1024 + i] = silu_f(p.c_ctx[i]); }
    __syncthreads();
    for (int it = p.bid; it < DEPTH * 48; it += p.G) {
        const int l = it / 48, cb = it % 48, c0 = cb * 128 + 2 * p.lane;
        const float* W = p.w_mod + (size_t)l * 1024 * 6144 + c0;
        float a00 = 0.f, a01 = 0.f, a10 = 0.f, a11 = 0.f;
        const int kb = p.wave * 128;
#pragma unroll 8
        for (int k = kb; k < kb + 128; ++k) { const float2 w = *(const float2*)(W + (size_t)k * 6144); const float s0 = sc[k], s1 = sc[1024 + k];
            a00 += s0 * w.x; a01 += s0 * w.y; a10 += s1 * w.x; a11 += s1 * w.y; }
        part[(p.wave * 2 + 0) * 128 + 2 * p.lane] = a00; part[(p.wave * 2 + 0) * 128 + 2 * p.lane + 1] = a01;
        part[(p.wave * 2 + 1) * 128 + 2 * p.lane] = a10; part[(p.wave * 2 + 1) * 128 + 2 * p.lane + 1] = a11;
        __syncthreads();
        if (p.tid < 256) { const int s = p.tid >> 7, col = p.tid & 127; float r = p.b_mod[l * 6144 + cb * 128 + col];
#pragma unroll
            for (int w = 0; w < 8; ++w) r += part[(w * 2 + s) * 128 + col];
            p.MOD[(size_t)(l * 2 + s) * 6144 + cb * 128 + col] = r; }
        __syncthreads();
    }
}

__device__ __forceinline__ void tr_item(const float* src, int ldw, int K, bf16* dst, int kb, LAS float* scr, int lane) {
    const int k0 = 64 * kb, kr = lane >> 4, nq = lane & 15;
    f32x4 v[16];
#pragma unroll
    for (int i = 0; i < 16; ++i) v[i] = *(const f32x4*)(src + (size_t)(k0 + 4 * i + kr) * ldw + 4 * nq);
#pragma unroll
    for (int i = 0; i < 16; ++i) { const int k = 4 * i + kr, c = (k >> 3) & 7; *(LAS f32x4*)(scr + k * 64 + 4 * (nq ^ c)) = v[i]; }
    LDS_FENCE();
    const int c = lane & 7;
#pragma unroll
    for (int j = 0; j < 8; ++j) { const int n = (lane >> 3) + 8 * j; const LAS float* s = scr + (8 * c) * 64 + (n ^ (c << 2));
        u32x4 o; o.x = pk2(s[0 * 64], s[1 * 64]); o.y = pk2(s[2 * 64], s[3 * 64]); o.z = pk2(s[4 * 64], s[5 * 64]); o.w = pk2(s[6 * 64], s[7 * 64]);
        *(u32x4*)(dst + (size_t)n * K + k0 + 8 * c) = o; }
    LDS_FENCE();
}
__device__ __forceinline__ void convert_weights(const P& p, int l, LAS unsigned char* lds) {
    LAS float* scr = (LAS float*)(lds + p.wave * 16384);
    const int gw = p.bid * NWAVES + p.wave, NGW = p.G * NWAVES;
    constexpr int I_A = 32 * 16, I_B = 60 * 16, I_GLU = 8 * 8, I_BR = 3 * 16 * 8, I_OUT = 16 * 16, I_E = 16 * 16 * 16;
    constexpr int NIT = I_A + I_B + I_GLU + I_BR + I_OUT + 3 * I_E;
    const float* win = p.w_in + (size_t)l * 1024 * IN_W;
    for (int it = gw; it < NIT; it += NGW) {
        int r = it;
        if (r < I_A) { const int nb = r >> 4, kb = r & 15; tr_item(win + 64 * nb, IN_W, 1024, p.WIN + (size_t)(64 * nb) * 1024, kb, scr, p.lane); continue; } r -= I_A;
        if (r < I_B) { const int nb = r >> 4, kb = r & 15; tr_item(win + 2064 + 64 * nb, IN_W, 1024, p.WIN + (size_t)(2048 + 64 * nb) * 1024, kb, scr, p.lane); continue; } r -= I_B;
        if (r < I_GLU) { const int nb = r >> 3, kb = r & 7; tr_item(p.w_glu + (size_t)l * 512 * 512 + 64 * nb, 512, 512, p.WGLU + (size_t)(64 * nb) * 512, kb, scr, p.lane); continue; } r -= I_GLU;
        if (r < I_BR) { const int kk = r >> 7, nb = (r >> 3) & 15, kb = r & 7;
            tr_item(p.w_branch + ((size_t)l * 3 + kk) * 512 * 1024 + 64 * nb, 1024, 1536, p.WBR + (size_t)(64 * nb) * 1536 + kk * 512, kb, scr, p.lane); continue; } r -= I_BR;
        if (r < I_OUT) { const int nb = r >> 4, kb = r & 15; tr_item(p.w_out + (size_t)l * 1024 * 1024 + 64 * nb, 1024, 1024, p.WOUT + (size_t)(64 * nb) * 1024, kb, scr, p.lane); continue; } r -= I_OUT;
        const int which = r / I_E; r -= which * I_E;
        const int e = r >> 8, nb = (r >> 4) & 15, kb = r & 15;
        const size_t eo = ((size_t)l * NE + e) * 1024 * 1024;
        if (which == 0) tr_item(p.w_eg + eo + 64 * nb, 1024, 1024, p.WUP + (size_t)(e * 2048 + 256 * (nb >> 1) + 64 * (nb & 1)) * 1024, kb, scr, p.lane);
        else if (which == 1) tr_item(p.w_eu + eo + 64 * nb, 1024, 1024, p.WUP + (size_t)(e * 2048 + 256 * (nb >> 1) + 128 + 64 * (nb & 1)) * 1024, kb, scr, p.lane);
        else tr_item(p.w_ed + eo + 64 * nb, 1024, 1024, p.WDN + (size_t)(e * 1024 + 64 * nb) * 1024, kb, scr, p.lane);
    }
}

template <int MODE> __device__ __forceinline__ void row_pass(const P& p, int l, LAS unsigned char* lds, bool with_ctx = true) {
    LAS float* W16 = (LAS float*)lds;
    if (MODE != 2) {
        const float* src = (MODE == 0) ? (p.w_in + (size_t)l * 1024 * IN_W + 2048) : (p.w_router + (size_t)l * 1024 * 16);
        const int ld = (MODE == 0) ? IN_W : 16;
        for (int i = p.tid; i < 1024 * 16; i += NTHR) { const int k = i >> 4, j = i & 15; W16[k * 20 + j] = src[(size_t)k * ld + j]; }
        __syncthreads();
    }
    const int gw = p.bid * NWAVES + p.wave, NGW = p.G * NWAVES, lane = p.lane;
    for (int row = gw + ((MODE == 2 || !with_ctx) ? NCTX : 0); row < T; row += NGW) {
        const bool isc = row < NCTX;
        float* xrow = isc ? (p.XC + (size_t)row * D) : (p.XL + (size_t)(row - NCTX) * D);
        float v[16];
        if (MODE == 0 && l == 0) { const float* s = isc ? (p.ctx + (size_t)row * D) : (p.x + (size_t)(row - NCTX) * D);
#pragma unroll
            for (int i = 0; i < 16; ++i) v[i] = s[lane + 64 * i];
        } else {
#pragma unroll
            for (int i = 0; i < 16; ++i) v[i] = xrow[lane + 64 * i];
        }
        if ((MODE == 0 && l > 0) || MODE == 2) {
            const int lp = (MODE == 2) ? (DEPTH - 1) : (l - 1);
            const float* g2 = p.MOD + (size_t)(lp * 2 + (isc ? 1 : 0)) * 6144 + 5 * D;
            float s[16];
#pragma unroll
            for (int i = 0; i < 16; ++i) s[i] = 0.f;
            for (int e = 0; e < NE; ++e) { const int slot = p.INV[(size_t)row * 16 + e];
                if (slot >= 0) { const bf16* yr = p.YE + ((size_t)e * ESLOTS + slot) * D;
#pragma unroll
                    for (int i = 0; i < 16; ++i) s[i] += bf2f(yr[lane + 64 * i]); } }
#pragma unroll
            for (int i = 0; i < 16; ++i) v[i] += g2[lane + 64 * i] * s[i];
        }
        if (MODE == 0) {
#pragma unroll
            for (int i = 0; i < 16; ++i) xrow[lane + 64 * i] = v[i];
        }
        float ss = 0.f;
#pragma unroll
        for (int i = 0; i < 16; ++i) ss += v[i] * v[i];
        const float rstd = rsqrtf(wsum(ss) * (1.f / D) + EPS);
        if (MODE == 2) {
#pragma unroll
            for (int i = 0; i < 16; ++i) xrow[lane + 64 * i] = v[i] * rstd * p.final_g[lane + 64 * i];
            continue;
        }
        const float* gam = (MODE == 0 ? p.norm1_g : p.norm2_g) + (size_t)l * D;
        const float* md = p.MOD + (size_t)(l * 2 + (isc ? 1 : 0)) * 6144 + (MODE == 0 ? 0 : 3 * D);
        bf16* hrow = p.H + (size_t)row * D;
        float acc[16];
#pragma unroll
        for (int j = 0; j < 16; ++j) acc[j] = 0.f;
#pragma unroll
        for (int i = 0; i < 16; ++i) { const int k = lane + 64 * i;
            const float hv = v[i] * rstd * gam[k] * (1.f + md[D + k]) + md[k];
            hrow[k] = (bf16)f2bf(hv);
            const LAS f32x4* wr = (const LAS f32x4*)(W16 + k * 20);
            const f32x4 w0 = wr[0], w1 = wr[1], w2 = wr[2], w3 = wr[3];
            acc[0] += hv * w0[0]; acc[1] += hv * w0[1]; acc[2] += hv * w0[2]; acc[3] += hv * w0[3];
            acc[4] += hv * w1[0]; acc[5] += hv * w1[1]; acc[6] += hv * w1[2]; acc[7] += hv * w1[3];
            acc[8] += hv * w2[0]; acc[9] += hv * w2[1]; acc[10] += hv * w2[2]; acc[11] += hv * w2[3];
            acc[12] += hv * w3[0]; acc[13] += hv * w3[1]; acc[14] += hv * w3[2]; acc[15] += hv * w3[3];
            if ((i & 1) == 1) asm volatile("" ::: "memory"); }
#pragma unroll
        for (int j = 0; j < 16; ++j) acc[j] = wsum(acc[j]);
        if (MODE == 0) {
            float mine = 0.f;
#pragma unroll
            for (int j = 0; j < 16; ++j) mine = (lane == j) ? acc[j] : mine;
            if (lane < 16) p.DT[(size_t)row * 16 + lane] = softplus_f(mine + p.dt_bias[l * 16 + lane]);
        } else {
            float mx = acc[0];
#pragma unroll
            for (int j = 1; j < 16; ++j) mx = fmaxf(mx, acc[j]);
            float sum = 0.f, mine = 0.f;
#pragma unroll
            for (int j = 0; j < 16; ++j) { const float e = expf(acc[j] - mx); sum += e; mine = (lane == j) ? e : mine; }
            if (lane < 16) p.AFFT[(size_t)lane * T + row] = mine / sum;
        }
    }
}

struct S5Lane { float abr, abi; float bbr[16], bbi[16]; };
__device__ __forceinline__ void s5_lane_params(const P& p, int l, int d, int g, int lane, S5Lane& o, bool withB) {
    const size_t gi = ((size_t)(l * 2 + d) * 32 + g);
    const float lr = p.lam_re[gi * 64 + lane], li = p.lam_im[gi * 64 + lane], dt = expf(p.log_dt[gi]);
    const float mag = expf(lr * dt); float sn, cs; sincosf(li * dt, &sn, &cs);
    o.abr = mag * cs; o.abi = mag * sn;
    if (withB) {
        const float den = lr * lr + li * li;
        const float fr = ((o.abr - 1.f) * lr + o.abi * li) / den, fi = (o.abi * lr - (o.abr - 1.f) * li) / den;
        const f32x4* br = (const f32x4*)(p.b_re + (gi * 64 + lane) * 16); const f32x4* bi = (const f32x4*)(p.b_im + (gi * 64 + lane) * 16);
#pragma unroll
        for (int q = 0; q < 4; ++q) { const f32x4 r4 = br[q], i4 = bi[q];
#pragma unroll
            for (int j = 0; j < 4; ++j) { o.bbr[4 * q + j] = fr * r4[j] - fi * i4[j]; o.bbi[4 * q + j] = fr * i4[j] + fi * r4[j]; } }
    }
}
__device__ __forceinline__ void s5_stage_u(const P& p, int r0, int g, LAS unsigned char* ub, int lane) {
#pragma unroll
    for (int j = 0; j < 4; ++j) { const int q = lane + 64 * j, i = q >> 1, half = q & 1;
        const u32x4 w = *(const u32x4*)(p.PROJ + (size_t)(r0 + i) * PJ + U0 + g * 16 + half * 8);
        *(LAS u32x4*)(ub + i * 32 + half * 16) = w; }
    LDS_FENCE();
}
__device__ __forceinline__ void s5_step(const S5Lane& s, const LAS unsigned char* ub, int i, float& hr, float& hi) {
    const u32x4 a = *(const LAS u32x4*)(ub + i * 32), b = *(const LAS u32x4*)(ub + i * 32 + 16);
    float u[16];
    u[0] = bflo(a.x); u[1] = bfhi(a.x); u[2] = bflo(a.y); u[3] = bfhi(a.y); u[4] = bflo(a.z); u[5] = bfhi(a.z); u[6] = bflo(a.w); u[7] = bfhi(a.w);
    u[8] = bflo(b.x); u[9] = bfhi(b.x); u[10] = bflo(b.y); u[11] = bfhi(b.y); u[12] = bflo(b.z); u[13] = bfhi(b.z); u[14] = bflo(b.w); u[15] = bfhi(b.w);
    float br = 0.f, bi = 0.f;
#pragma unroll
    for (int k = 0; k < 16; ++k) { br += s.bbr[k] * u[k]; bi += s.bbi[k] * u[k]; }
    const float nr = s.abr * hr - s.abi * hi + br, ni = s.abr * hi + s.abi * hr + bi;
    hr = nr; hi = ni;
}

__device__ __forceinline__ void phase_premix(const P& p, int l, LAS unsigned char* lds) {
    const float* cw = p.conv_w + (size_t)l * 5 * 1024; const float* cb = p.conv_b + (size_t)l * 1024;
    for (int idx = p.bid * NTHR + p.tid; idx < T * 128; idx += p.G * NTHR) {
        const int row = idx >> 7, c8 = (idx & 127) * 8;
        const int lo = row < NCTX ? 0 : NCTX, hi = row < NCTX ? NCTX : T;
        float a[8];
        { const f32x4 b0 = *(const f32x4*)(cb + c8), b1 = *(const f32x4*)(cb + c8 + 4);
          a[0] = b0[0]; a[1] = b0[1]; a[2] = b0[2]; a[3] = b0[3]; a[4] = b1[0]; a[5] = b1[1]; a[6] = b1[2]; a[7] = b1[3]; }
#pragma unroll
        for (int j = 0; j < 5; ++j) { const int r = row + j - 2;
            if (r >= lo && r < hi) { const u32x4 xv = *(const u32x4*)(p.PROJ + (size_t)r * PJ + XB0 + c8);
                const f32x4 w0 = *(const f32x4*)(cw + j * 1024 + c8), w1 = *(const f32x4*)(cw + j * 1024 + c8 + 4);
                a[0] += w0[0] * bflo(xv.x); a[1] += w0[1] * bfhi(xv.x); a[2] += w0[2] * bflo(xv.y); a[3] += w0[3] * bfhi(xv.y);
                a[4] += w1[0] * bflo(xv.z); a[5] += w1[1] * bfhi(xv.z); a[6] += w1[2] * bflo(xv.w); a[7] += w1[3] * bfhi(xv.w); } }
        u32x4 o; o.x = pk2(silu_f(a[0]), silu_f(a[1])); o.y = pk2(silu_f(a[2]), silu_f(a[3])); o.z = pk2(silu_f(a[4]), silu_f(a[5])); o.w = pk2(silu_f(a[6]), silu_f(a[7]));
        *(u32x4*)(p.CV + (size_t)row * 1024 + c8) = o;
    }

}

__device__ __forceinline__ void ssd_scan_naive(const P& p, int l) {
    for (int it = p.bid * 4 + p.wave; it < 1024; it += p.G * 4) {
        const int d = it >> 9, hd = (it >> 6) & 7, pp = it & 63, grp = hd >> 2;
        const float a = -expf(p.a_log[l * 16 + d * 8 + hd]);
        const int colB = 512 + grp * 128 + p.lane, colC = 768 + grp * 128 + p.lane, colX = hd * 64 + pp, dcol = d * 8 + hd;
        float h0 = 0.f, h1 = 0.f;
        for (int s0 = 0; s0 < T; s0 += 8) {
            unsigned b0[8], b1[8], c0[8], c1[8], xx[8]; float dtv[8]; int rr[8];
#pragma unroll
            for (int j = 0; j < 8; ++j) { const int r = scan_row(d, s0 + j); rr[j] = r; const bf16* cv = p.CV + (size_t)r * 1024;
                b0[j] = cv[colB]; b1[j] = cv[colB + 64]; c0[j] = cv[colC]; c1[j] = cv[colC + 64]; xx[j] = cv[colX]; dtv[j] = p.DT[(size_t)r * 16 + dcol]; }
#pragma unroll
            for (int j = 0; j < 8; ++j) { const float dec = expf(dtv[j] * a), dx = dtv[j] * bf2f(xx[j]);
                h0 = dec * h0 + dx * bf2f(b0[j]); h1 = dec * h1 + dx * bf2f(b1[j]);
                const float y = wsum(bf2f(c0[j]) * h0 + bf2f(c1[j]) * h1);
                if (p.lane == 0) p.YD[((size_t)d * T + rr[j]) * 512 + colX] = y; }
        }
    }
}
__device__ __forceinline__ void s5_carry_scan(const P& p, int l, int aw, int NAW) {
    for (int it = aw; it < 64; it += NAW) {
        const int d = it >> 5, g = it & 31;
        S5Lane s; s5_lane_params(p, l, d, g, p.lane, s, false);
        float ar = s.abr, ai = s.abi;
#pragma unroll
        for (int q = 0; q < 7; ++q) { const float nr = ar * ar - ai * ai, ni = 2.f * ar * ai; ar = nr; ai = ni; }
        float hr = 0.f, hi = 0.f;
        const float* E = p.S5E + (size_t)(d * 32 + g) * NCH * 128; float* Hn = p.S5H + (size_t)(d * 32 + g) * NCH * 128;
        for (int c = 0; c < NCH; ++c) { Hn[c * 128 + p.lane] = hr; Hn[c * 128 + 64 + p.lane] = hi;
            const float er = E[c * 128 + p.lane], ei = E[c * 128 + 64 + p.lane];
            const float nr = ar * hr - ai * hi + er, ni = ar * hi + ai * hr + ei; hr = nr; hi = ni; }
    }
}
__device__ __forceinline__ void attention_naive(const P& p, int l, int aw, int NAW, LAS float* pbuf) {
    const int lane = p.lane;
    for (int it = aw; it < T * 8; it += NAW) {
        const int row = it >> 3, hq = it & 7, kvh = hq >> 2;
        const bool isc = row < NCTX; const int t = row - NCTX;
        const int jlo = isc ? 0 : (t - 128 < 0 ? 0 : t - 128), jhi = isc ? -1 : (t + 128 > NLAT - 1 ? NLAT - 1 : t + 128);
        const int nloc = jhi - jlo + 1, nk = nloc + NCTX;
        const float sink = p.sink[l * 8 + hq];
        float q[64];
        { const u32x4* qp = (const u32x4*)(p.PROJ + (size_t)row * PJ + Q0 + hq * 64);
#pragma unroll
          for (int c = 0; c < 8; ++c) { const u32x4 w = qp[c]; q[8 * c] = bflo(w.x); q[8 * c + 1] = bfhi(w.x); q[8 * c + 2] = bflo(w.y); q[8 * c + 3] = bfhi(w.y);
              q[8 * c + 4] = bflo(w.z); q[8 * c + 5] = bfhi(w.z); q[8 * c + 6] = bflo(w.w); q[8 * c + 7] = bfhi(w.w); } }
        float sc[9]; float mx = sink;
#pragma unroll
        for (int i = 0; i < 9; ++i) { const int kk = lane + 64 * i; float s = -INFINITY;
            if (kk < nk) { const int krow = kk < nloc ? NCTX + jlo + kk : kk - nloc;
                const u32x4* kp = (const u32x4*)(p.PROJ + (size_t)krow * PJ + K0 + kvh * 64); float dot = 0.f;
#pragma unroll
                for (int c = 0; c < 8; ++c) { const u32x4 w = kp[c];
                    dot += q[8 * c] * bflo(w.x) + q[8 * c + 1] * bfhi(w.x) + q[8 * c + 2] * bflo(w.y) + q[8 * c + 3] * bfhi(w.y)
                         + q[8 * c + 4] * bflo(w.z) + q[8 * c + 5] * bfhi(w.z) + q[8 * c + 6] * bflo(w.w) + q[8 * c + 7] * bfhi(w.w); }
                s = dot * 0.125f; }
            sc[i] = s; mx = fmaxf(mx, s); }
        mx = wmaxf(mx);
        float sum = 0.f;
#pragma unroll
        for (int i = 0; i < 9; ++i) { const int kk = lane + 64 * i; const float e = (kk < nk) ? expf(sc[i] - mx) : 0.f; pbuf[kk] = e; sum += e; }
        const float den = wsum(sum) + expf(sink - mx);
        LDS_FENCE();
        float o = 0.f;
        const bf16* vb = p.PROJ + V0 + kvh * 64 + lane;
#pragma unroll 4
        for (int kk = 0; kk < nk; ++kk) { const int vrow = kk < nloc ? NCTX + jlo + kk : kk - nloc; o += pbuf[kk] * bf2f(vb[(size_t)vrow * PJ]); }
        p.Y3[((size_t)2 * T + row) * 512 + hq * 64 + lane] = (bf16)f2bf(o / den);
        LDS_FENCE();
    }
}

__device__ __forceinline__ void phase_postmix(const P& p, int l, LAS unsigned char* lds) {
    constexpr int CSH_BYTES = 2 * 2 * 16 * 68 * 4, WREG = 16640;
    LAS float* Csh = (LAS float*)lds;
    LAS unsigned char* wreg = lds + CSH_BYTES + p.wave * WREG;
    LAS unsigned char* ub = wreg;
    LAS float* Hb = (LAS float*)(wreg + 4096);
    LAS float* Yb = (LAS float*)(wreg + 4096 + 4224);
    const int lane = p.lane;
    for (int it = p.bid; it < 32 * 17; it += p.G) {
        const int g = it / 17, chunk = (it % 17) * 8 + p.wave;
        __syncthreads();
        for (int i = p.tid; i < 2 * 2 * 16 * 64; i += NTHR) { const int pq = i & 63, k = (i >> 6) & 15, ri = (i >> 10) & 1, d = i >> 11;
            const float* src = ri ? p.c_im : p.c_re; Csh[((d * 2 + ri) * 16 + k) * 68 + pq] = src[(((size_t)(l * 2 + d) * 32 + g) * 16 + k) * 64 + pq]; }
        __syncthreads();
        if (chunk < NCH) {
            const int r0 = 128 * chunk;
            s5_stage_u(p, r0, g, ub, lane);
            for (int d = 0; d < 2; ++d) {
                S5Lane s; s5_lane_params(p, l, d, g, lane, s, true);
                const int cs = (d == 0) ? chunk : (chunk < 2 ? 1 - chunk : NCH + 1 - chunk);
                const float* Hn = p.S5H + ((size_t)(d * 32 + g) * NCH + cs) * 128;
                float hr = Hn[lane], hi = Hn[64 + lane];
                const LAS float* Cr = Csh + (d * 2 + 0) * 16 * 68; const LAS float* Ci = Csh + (d * 2 + 1) * 16 * 68;
                for (int sub = 0; sub < 16; ++sub) {
#pragma unroll
                    for (int j = 0; j < 8; ++j) { const int is = sub * 8 + j; s5_step(s, ub, d == 0 ? is : 127 - is, hr, hi); Hb[j * 132 + lane] = hr; Hb[j * 132 + 64 + lane] = hi; }
                    LDS_FENCE();
#pragma unroll
                    for (int m = 0; m < 2; ++m) { const int o = lane + 64 * m, j = o >> 4, k = o & 15; float y = 0.f;
#pragma unroll
                        for (int q = 0; q < 16; ++q) { const f32x4 cr = *(const LAS f32x4*)(Cr + k * 68 + 4 * q), ci = *(const LAS f32x4*)(Ci + k * 68 + 4 * q);
                            const f32x4 xr = *(const LAS f32x4*)(Hb + j * 132 + 4 * q), xi = *(const LAS f32x4*)(Hb + j * 132 + 64 + 4 * q);
                            y += cr[0] * xr[0] + cr[1] * xr[1] + cr[2] * xr[2] + cr[3] * xr[3] - ci[0] * xi[0] - ci[1] * xi[1] - ci[2] * xi[2] - ci[3] * xi[3]; }
                        const int is = sub * 8 + j, i = (d == 0) ? is : 127 - is;
                        if (d == 0) Yb[i * 16 + k] = y; else Yb[i * 16 + k] += y; }
                    LDS_FENCE();
                }
            }
            const float* dsk = p.s5_d + (size_t)l * 512 + g * 16;
#pragma unroll
            for (int m = 0; m < 2; ++m) { const int i = lane + 64 * m;
                const u32x4 ua = *(const LAS u32x4*)(ub + i * 32), ubv = *(const LAS u32x4*)(ub + i * 32 + 16);
                float u[16];
                u[0] = bflo(ua.x); u[1] = bfhi(ua.x); u[2] = bflo(ua.y); u[3] = bfhi(ua.y); u[4] = bflo(ua.z); u[5] = bfhi(ua.z); u[6] = bflo(ua.w); u[7] = bfhi(ua.w);
                u[8] = bflo(ubv.x); u[9] = bfhi(ubv.x); u[10] = bflo(ubv.y); u[11] = bfhi(ubv.y); u[12] = bflo(ubv.z); u[13] = bfhi(ubv.z); u[14] = bflo(ubv.w); u[15] = bfhi(ubv.w);
                float a[16];
#pragma unroll
                for (int k = 0; k < 16; ++k) a[k] = gelu_tanh_f(Yb[i * 16 + k] + dsk[k] * u[k]);
                u32x4 o0, o1; o0.x = pk2(a[0], a[1]); o0.y = pk2(a[2], a[3]); o0.z = pk2(a[4], a[5]); o0.w = pk2(a[6], a[7]);
                o1.x = pk2(a[8], a[9]); o1.y = pk2(a[10], a[11]); o1.z = pk2(a[12], a[13]); o1.w = pk2(a[14], a[15]);
                bf16* dst = p.SA + (size_t)(r0 + i) * 512 + g * 16;
                *(u32x4*)dst = o0; *(u32x4*)(dst + 8) = o1; }
            LDS_FENCE();
        }
    }
}

__device__ __forceinline__ void phase_select(const P& p, LAS unsigned char* lds, bool with_ctx) {
    LAS unsigned* keys = (LAS unsigned*)lds;
    LAS unsigned* hist = keys + 16384;
    LAS unsigned* misc = hist + 256;
    const int tid = p.tid, lane = p.lane, wave = p.wave;
    for (int it = p.bid; it < (with_ctx ? 32 : 16); it += p.G) {
        const int set = it >> 4, e = it & 15;
        const int n = set ? NCTX : NLAT, cap = set ? CAP_C : CAP_L, row0 = set ? 0 : NCTX, slot0 = set ? CAP_L : 0;
        const float* src = p.AFFT + (size_t)e * T + row0;
        __syncthreads();
        for (int i = tid; i < n; i += NTHR) keys[i] = __float_as_uint(src[i]);
        unsigned prefix = 0u, mask = 0u, need = (unsigned)cap;
        for (int pass = 3; pass >= 0; --pass) {
            if (tid < 256) hist[tid] = 0u;
            __syncthreads();
            for (int i = tid; i < n; i += NTHR) { const unsigned k = keys[i]; if ((k & mask) == prefix) __hip_atomic_fetch_add(&hist[(k >> (8 * pass)) & 255u], 1u, __ATOMIC_RELAXED, __HIP_MEMORY_SCOPE_WORKGROUP); }
            __syncthreads();
            if (wave == 0) {
                const unsigned h0 = hist[4 * lane], h1 = hist[4 * lane + 1], h2 = hist[4 * lane + 2], h3 = hist[4 * lane + 3];
                const unsigned c = h0 + h1 + h2 + h3; unsigned S = c;
#pragma unroll
                for (int o = 1; o < 64; o <<= 1) { const unsigned t = __shfl_down(S, o); if (lane + o < 64) S += t; }
                const unsigned Snext = S - c;
                if (S >= need && Snext < need) { unsigned rem = need - Snext; unsigned bin;
                    if (h3 >= rem) bin = 3; else { rem -= h3; if (h2 >= rem) bin = 2; else { rem -= h2; if (h1 >= rem) bin = 1; else { rem -= h1; bin = 0; } } }
                    misc[0] = 4 * lane + bin; misc[1] = rem; }
            }
            __syncthreads();
            prefix |= misc[0] << (8 * pass); mask |= 0xFFu << (8 * pass); need = misc[1];
            __syncthreads();
        }
        unsigned selbase = 0u, eqbase = 0u;
        for (int base = 0; base < n; base += NTHR) {
            const int i = base + tid; const bool valid = i < n; const unsigned k = valid ? keys[i] : 0u;
            const bool eq = valid && k == prefix, gt = valid && k > prefix;
            const unsigned long long lt = (1ull << lane) - 1ull;
            const unsigned long long be = __ballot(eq);
            if (lane == 0) misc[8 + wave] = (unsigned)__popcll(be);
            __syncthreads();
            unsigned woff = 0u, tot = 0u;
#pragma unroll
            for (int w = 0; w < 8; ++w) { const unsigned v = misc[8 + w]; woff += (w < wave) ? v : 0u; tot += v; }
            const unsigned eqrank = eqbase + woff + (unsigned)__popcll(be & lt);
            const bool sel = gt || (eq && eqrank < need);
            const unsigned long long bs = __ballot(sel);
            if (lane == 0) misc[16 + wave] = (unsigned)__popcll(bs);
            __syncthreads();
            unsigned woff2 = 0u, tot2 = 0u;
#pragma unroll
            for (int w = 0; w < 8; ++w) { const unsigned v = misc[16 + w]; woff2 += (w < wave) ? v : 0u; tot2 += v; }
            if (valid) { const int row = row0 + i;
                if (sel) { const int slot = slot0 + (int)(selbase + woff2 + (unsigned)__popcll(bs & lt));
                    p.IDX[e * ESLOTS + slot] = row; p.GSEL[e * ESLOTS + slot] = __uint_as_float(k); p.INV[(size_t)row * 16 + e] = slot; }
                else p.INV[(size_t)row * 16 + e] = -1; }
            selbase += tot2; eqbase += tot;
            __syncthreads();
        }
    }
}
__device__ __forceinline__ void phase_gather(const P& p, bool with_ctx) {
    const int gw = p.bid * NWAVES + p.wave, NGW = p.G * NWAVES, lane = p.lane;
    for (int idx = gw; idx < NE * ESLOTS; idx += NGW) {
        const int slot = idx % ESLOTS; const bool valid = slot < CAP_L + (with_ctx ? CAP_C : 0);
        u32x4 a = (u32x4){0u, 0u, 0u, 0u}, b = a;
        if (valid) { const int row = p.IDX[idx]; const u32x4* s = (const u32x4*)(p.H + (size_t)row * D); a = s[lane]; b = s[64 + lane]; }
        else if (lane == 0) p.GSEL[idx] = 0.f;
        u32x4* dst = (u32x4*)(p.XE + (size_t)idx * D); dst[lane] = a; dst[64 + lane] = b;
    }
}

typedef short bf16x8 __attribute__((ext_vector_type(8)));
#define MFMA16(a, b, c) __builtin_amdgcn_mfma_f32_16x16x32_bf16((a), (b), (c), 0, 0, 0)
constexpr int LDP = 272;
constexpr int LDQ = 144;
__device__ __forceinline__ bf16x8 ld_frag(const LAS unsigned char* base, int row, int kcol, int ldb) { return *(const LAS bf16x8*)(base + row * ldb + kcol * 2); }
__device__ __forceinline__ void st_b16(LAS unsigned char* p, unsigned v) { *(LAS unsigned short*)p = (unsigned short)v; }
__device__ __forceinline__ float wscan_incl(float v, int lane) {
#pragma unroll
    for (int o = 1; o < 64; o <<= 1) { const float t = __shfl_up(v, o); if (lane >= o) v += t; }
    return v;
}
__device__ __forceinline__ int chunk_r0(int d, int cs) { return d == 0 ? 128 * cs : (cs < 2 ? 128 * (1 - cs) : 128 * (NCH + 1 - cs)); }
__device__ __forceinline__ int scan_chunk_of(int d, int cn) { return d == 0 ? cn : (cn < 2 ? 1 - cn : NCH + 1 - cn); }

__device__ __forceinline__ void ssd_acum(const float* DT, int r0, int d, int col, float a, int lane, LAS float* acum, LAS float* dtv, float& total) {
    const int j0 = d == 0 ? lane : 127 - lane, j1 = d == 0 ? 64 + lane : 63 - lane;
    const float dt0 = DT[(size_t)(r0 + j0) * 16 + col], dt1 = DT[(size_t)(r0 + j1) * 16 + col];
    const float s0 = wscan_incl(dt0 * a, lane); const float t0 = __shfl(s0, 63);
    const float s1 = wscan_incl(dt1 * a, lane) + t0; total = __shfl(s1, 63);
    acum[j0] = s0; acum[j1] = s1; dtv[j0] = dt0; dtv[j1] = dt1;
}

__device__ __forceinline__ void ssd_states(const P& p, int l, LAS unsigned char* lds, float* SST, float* DEC) {
    LAS unsigned char* BT = lds;
    LAS unsigned char* XW = lds + 128 * LDP;
    LAS float* wj = (LAS float*)(lds + 128 * LDP + 4 * 64 * LDP);
    const int tid = p.tid, lane = p.lane, wave = p.wave, quad = lane >> 4, l15 = lane & 15;
    for (int u = p.bid; u < 2 * NCH * 2; u += p.G) {
        const int d = u / (2 * NCH), cs = (u % (2 * NCH)) >> 1, g = u & 1;
        const int r0 = chunk_r0(d, cs);
        __syncthreads();
        if (wave < 4) { const int h = g * 4 + wave; const float a = -expf(p.a_log[l * 16 + d * 8 + h]); float total;
            LAS float* ac = wj + 512 + wave * 128; LAS float* dv = wj + 1024 + wave * 128;
            ssd_acum(p.DT, r0, d, d * 8 + h, a, lane, ac, dv, total);
            LDS_FENCE();
            wj[wave * 128 + lane] = __expf(total - ac[lane]) * dv[lane]; wj[wave * 128 + 64 + lane] = __expf(total - ac[64 + lane]) * dv[64 + lane];
            if (lane == 0) DEC[(d * NCH + cs) * 8 + h] = expf(total); }
        __syncthreads();
        for (int idx = tid; idx < 128 * 16; idx += NTHR) { const int j = idx >> 4, n8 = (idx & 15) * 8;
            const u32x4 v = *(const u32x4*)(p.CV + (size_t)(r0 + j) * 1024 + 512 + g * 128 + n8);
            LAS unsigned char* dst = BT + n8 * LDP + 2 * j;
            st_b16(dst, v.x & 0xffffu); st_b16(dst + LDP, v.x >> 16); st_b16(dst + 2 * LDP, v.y & 0xffffu); st_b16(dst + 3 * LDP, v.y >> 16);
            st_b16(dst + 4 * LDP, v.z & 0xffffu); st_b16(dst + 5 * LDP, v.z >> 16); st_b16(dst + 6 * LDP, v.w & 0xffffu); st_b16(dst + 7 * LDP, v.w >> 16); }
        for (int idx = tid; idx < 128 * 32; idx += NTHR) { const int j = idx >> 5, c8 = (idx & 31) * 8, hh = c8 >> 6, p8 = c8 & 63;
            const u32x4 v = *(const u32x4*)(p.CV + (size_t)(r0 + j) * 1024 + g * 256 + c8); const float w = wj[hh * 128 + j];
            LAS unsigned char* dst = XW + (hh * 64 + p8) * LDP + 2 * j;
            st_b16(dst, f2bf(bflo(v.x) * w)); st_b16(dst + LDP, f2bf(bfhi(v.x) * w)); st_b16(dst + 2 * LDP, f2bf(bflo(v.y) * w)); st_b16(dst + 3 * LDP, f2bf(bfhi(v.y) * w));
            st_b16(dst + 4 * LDP, f2bf(bflo(v.z) * w)); st_b16(dst + 5 * LDP, f2bf(bfhi(v.z) * w)); st_b16(dst + 6 * LDP, f2bf(bflo(v.w) * w)); st_b16(dst + 7 * LDP, f2bf(bfhi(v.w) * w)); }
        __syncthreads();
        const int hh = wave >> 1, ph = wave & 1;
        f32x4 acc[2][8];
#pragma unroll
        for (int a = 0; a < 2; ++a)
#pragma unroll
            for (int b = 0; b < 8; ++b) acc[a][b] = (f32x4){0.f, 0.f, 0.f, 0.f};
#pragma unroll
        for (int ks = 0; ks < 4; ++ks) {
            bf16x8 af[2];
#pragma unroll
            for (int pt = 0; pt < 2; ++pt) af[pt] = ld_frag(XW + hh * 64 * LDP, ph * 32 + pt * 16 + l15, ks * 32 + 8 * quad, LDP);
#pragma unroll
            for (int nt = 0; nt < 8; ++nt) { const bf16x8 bfr = ld_frag(BT, nt * 16 + l15, ks * 32 + 8 * quad, LDP);
#pragma unroll
                for (int pt = 0; pt < 2; ++pt) acc[pt][nt] = MFMA16(af[pt], bfr, acc[pt][nt]); }
        }
        float* S = SST + ((size_t)(d * NCH + cs) * 8 + g * 4 + hh) * 8192;
#pragma unroll
        for (int pt = 0; pt < 2; ++pt)
#pragma unroll
            for (int nt = 0; nt < 8; ++nt)
#pragma unroll
                for (int r = 0; r < 4; ++r) S[(ph * 32 + pt * 16 + 4 * quad + r) * 128 + nt * 16 + l15] = acc[pt][nt][r];
    }
}

__device__ __forceinline__ void scan_carries(const P& p, int l, const float* SST, const float* DEC, bf16* HIN) {
    for (int e = p.bid * NTHR + p.tid; e < 2 * 8 * 8192; e += p.G * NTHR) {
        const int d = e >> 16, h = (e >> 13) & 7, pn = e & 8191;
        float hs = 0.f;
        for (int c0 = 0; c0 < NCH; c0 += 10) {
            float s[10], dc[10];
#pragma unroll
            for (int j = 0; j < 10; ++j) { const size_t ci = (size_t)(d * NCH + c0 + j) * 8 + h; s[j] = SST[ci * 8192 + pn]; dc[j] = DEC[ci]; }
#pragma unroll
            for (int j = 0; j < 10; ++j) { const size_t ci = (size_t)(d * NCH + c0 + j) * 8 + h; HIN[ci * 8192 + pn] = (bf16)f2bf(hs); hs = hs * dc[j] + s[j]; }
        }
    }
    for (int e = p.bid * NTHR + p.tid; e < 2 * 32 * 64; e += p.G * NTHR) {
        const int d = e >> 11, g = (e >> 6) & 31, pq = e & 63;
        S5Lane s; s5_lane_params(p, l, d, g, pq, s, false);
        float ar = s.abr, ai = s.abi;
#pragma unroll
        for (int q = 0; q < 7; ++q) { const float nr = ar * ar - ai * ai, ni = 2.f * ar * ai; ar = nr; ai = ni; }
        float hr = 0.f, hi = 0.f;
        const float* E = p.S5E + (size_t)(d * 32 + g) * NCH * 128 + pq; float* Hn = p.S5H + (size_t)(d * 32 + g) * NCH * 128 + pq;
        for (int c0 = 0; c0 < NCH; c0 += 10) {
            float er[10], ei[10];
#pragma unroll
            for (int j = 0; j < 10; ++j) { er[j] = E[(c0 + j) * 128]; ei[j] = E[(c0 + j) * 128 + 64]; }
#pragma unroll
            for (int j = 0; j < 10; ++j) { Hn[(c0 + j) * 128] = hr; Hn[(c0 + j) * 128 + 64] = hi;
                const float nr = ar * hr - ai * hi + er[j], ni = ar * hi + ai * hr + ei[j]; hr = nr; hi = ni; }
        }
    }
}

__device__ __forceinline__ void ssd_outputs(const P& p, int l, LAS unsigned char* lds, const bf16* HIN, const float* SST, bf16* YS, int u_begin, int u_end, int first, int stride) {
    LAS unsigned char* Cm = lds;
    LAS unsigned char* Bm = lds + 128 * LDP;
    LAS unsigned char* XT = lds + 2 * 128 * LDP;
    LAS unsigned char* Wm = lds + 2 * 128 * LDP + 64 * LDP;
    LAS float* sm = (LAS float*)(lds + 3 * 128 * LDP + 64 * LDP);
    const int tid = p.tid, lane = p.lane, wave = p.wave, quad = lane >> 4, l15 = lane & 15;
    for (int u = u_begin + first; u < u_end; u += stride) {
        const int cn = u >> 3, h = u & 7, g = h >> 2, r0 = 128 * cn;
        __syncthreads();
        if (wave < 2) { const int d = wave; const float a = -expf(p.a_log[l * 16 + d * 8 + h]); float total;
            ssd_acum(p.DT, r0, d, d * 8 + h, a, lane, sm + d * 128, sm + 256 + d * 128, total); }
        for (int idx = tid; idx < 128 * 16; idx += NTHR) { const int j = idx >> 4, n8 = (idx & 15) * 8;
            const bf16* src = p.CV + (size_t)(r0 + j) * 1024 + g * 128 + n8;
            *(LAS u32x4*)(Bm + j * LDP + n8 * 2) = *(const u32x4*)(src + 512); *(LAS u32x4*)(Cm + j * LDP + n8 * 2) = *(const u32x4*)(src + 768); }
        for (int idx = tid; idx < 128 * 8; idx += NTHR) { const int j = idx >> 3, p8 = (idx & 7) * 8;
            const u32x4 v = *(const u32x4*)(p.CV + (size_t)(r0 + j) * 1024 + h * 64 + p8);
            LAS unsigned char* dst = XT + p8 * LDP + 2 * j;
            st_b16(dst, v.x & 0xffffu); st_b16(dst + LDP, v.x >> 16); st_b16(dst + 2 * LDP, v.y & 0xffffu); st_b16(dst + 3 * LDP, v.y >> 16);
            st_b16(dst + 4 * LDP, v.z & 0xffffu); st_b16(dst + 5 * LDP, v.z >> 16); st_b16(dst + 6 * LDP, v.w & 0xffffu); st_b16(dst + 7 * LDP, v.w >> 16); }
        __syncthreads();
        f32x4 G[8];
#pragma unroll
        for (int jt = 0; jt < 8; ++jt) G[jt] = (f32x4){0.f, 0.f, 0.f, 0.f};
#pragma unroll
        for (int ks = 0; ks < 4; ++ks) { const bf16x8 af = ld_frag(Cm, 16 * wave + l15, ks * 32 + 8 * quad, LDP);
#pragma unroll
            for (int jt = 0; jt < 8; ++jt) G[jt] = MFMA16(af, ld_frag(Bm, 16 * jt + l15, ks * 32 + 8 * quad, LDP), G[jt]); }
        __syncthreads();
        for (int idx = tid; idx < 2 * 64 * 16; idx += NTHR) { const int d = idx >> 10, pp = (idx >> 4) & 63, n8 = (idx & 15) * 8;
            const int cs = scan_chunk_of(d, cn);
            u32x4 w;
            if (cn >= 2) w = *(const u32x4*)(HIN + ((size_t)(d * NCH + cs) * 8 + h) * 8192 + pp * 128 + n8);
            else if (cs == 0) w = (u32x4){0u, 0u, 0u, 0u};
            else { const float* s = SST + ((size_t)(d * NCH) * 8 + h) * 8192 + pp * 128 + n8; const f32x4 s0 = *(const f32x4*)s, s1 = *(const f32x4*)(s + 4);
                w.x = pk2(s0[0], s0[1]); w.y = pk2(s0[2], s0[3]); w.z = pk2(s1[0], s1[1]); w.w = pk2(s1[2], s1[3]); }
            *(LAS u32x4*)(Bm + (d * 64 + pp) * LDP + n8 * 2) = w; }
        __syncthreads();
        f32x4 Y[4];
#pragma unroll
        for (int pt = 0; pt < 4; ++pt) Y[pt] = (f32x4){0.f, 0.f, 0.f, 0.f};
#pragma unroll
        for (int d = 0; d < 2; ++d) {
            const LAS float* ac = sm + d * 128; const LAS float* dv = sm + 256 + d * 128;
            float ai[4];
#pragma unroll
            for (int r = 0; r < 4; ++r) ai[r] = ac[16 * wave + 4 * quad + r];
#pragma unroll
            for (int jt = 0; jt < 8; ++jt) { const int j = 16 * jt + l15; const float aj = ac[j], dj = dv[j];
#pragma unroll
                for (int r = 0; r < 4; ++r) { const int i = 16 * wave + 4 * quad + r; const bool valid = (d == 0) ? (j <= i) : (j >= i);
                    const float w = valid ? G[jt][r] * __expf(ai[r] - aj) * dj : 0.f;
                    st_b16(Wm + i * LDP + 2 * j, f2bf(w)); } }
            LDS_FENCE();
            f32x4 Y2[4];
#pragma unroll
            for (int pt = 0; pt < 4; ++pt) Y2[pt] = (f32x4){0.f, 0.f, 0.f, 0.f};
#pragma unroll
            for (int ks = 0; ks < 4; ++ks) { const bf16x8 wf = ld_frag(Wm, 16 * wave + l15, ks * 32 + 8 * quad, LDP), cf = ld_frag(Cm, 16 * wave + l15, ks * 32 + 8 * quad, LDP);
#pragma unroll
                for (int pt = 0; pt < 4; ++pt) { Y[pt] = MFMA16(wf, ld_frag(XT, 16 * pt + l15, ks * 32 + 8 * quad, LDP), Y[pt]);
                    Y2[pt] = MFMA16(cf, ld_frag(Bm + d * 64 * LDP, 16 * pt + l15, ks * 32 + 8 * quad, LDP), Y2[pt]); } }
#pragma unroll
            for (int r = 0; r < 4; ++r) { const float ea = __expf(ai[r]);
#pragma unroll
                for (int pt = 0; pt < 4; ++pt) Y[pt][r] += ea * Y2[pt][r]; }
            LDS_FENCE();
        }
#pragma unroll
        for (int pt = 0; pt < 4; ++pt)
#pragma unroll
            for (int r = 0; r < 4; ++r) YS[(size_t)(r0 + 16 * wave + 4 * quad + r) * 512 + h * 64 + 16 * pt + l15] = (bf16)f2bf(Y[pt][r]);
    }
}

__device__ __forceinline__ void ssd_gated_norm(const P& p, int l, const bf16* YS) {
    const int gw = p.bid * NWAVES + p.wave, NGW = p.G * NWAVES, lane = p.lane;
    for (int row = gw; row < T; row += NGW) {
        const int ch = lane * 8;
        const float dsk = p.ssd_d[l * 8 + (ch >> 6)];
        const u32x4 yv = *(const u32x4*)(YS + (size_t)row * 512 + ch);
        const u32x4 xs = *(const u32x4*)(p.CV + (size_t)row * 1024 + ch), zz = *(const u32x4*)(p.PROJ + (size_t)row * PJ + Z0 + ch);
        float v[8];
        v[0] = (bflo(yv.x) + dsk * bflo(xs.x)) * silu_f(bflo(zz.x)); v[1] = (bfhi(yv.x) + dsk * bfhi(xs.x)) * silu_f(bfhi(zz.x));
        v[2] = (bflo(yv.y) + dsk * bflo(xs.y)) * silu_f(bflo(zz.y)); v[3] = (bfhi(yv.y) + dsk * bfhi(xs.y)) * silu_f(bfhi(zz.y));
        v[4] = (bflo(yv.z) + dsk * bflo(xs.z)) * silu_f(bflo(zz.z)); v[5] = (bfhi(yv.z) + dsk * bfhi(xs.z)) * silu_f(bfhi(zz.z));
        v[6] = (bflo(yv.w) + dsk * bflo(xs.w)) * silu_f(bflo(zz.w)); v[7] = (bfhi(yv.w) + dsk * bfhi(xs.w)) * silu_f(bfhi(zz.w));
        float ss = 0.f;
#pragma unroll
        for (int i = 0; i < 8; ++i) ss += v[i] * v[i];
        const float rstd = rsqrtf(wsum(ss) * (1.f / 512.f) + EPS);
        const float* ng = p.ssd_norm_g + (size_t)l * 512 + ch;
        const f32x4 g0 = *(const f32x4*)ng, g1 = *(const f32x4*)(ng + 4);
        u32x4 o; o.x = pk2(v[0] * rstd * g0[0], v[1] * rstd * g0[1]); o.y = pk2(v[2] * rstd * g0[2], v[3] * rstd * g0[3]);
        o.z = pk2(v[4] * rstd * g1[0], v[5] * rstd * g1[1]); o.w = pk2(v[6] * rstd * g1[2], v[7] * rstd * g1[3]);
        *(u32x4*)(p.Y3 + (size_t)row * 1536 + 512 + ch) = o;
    }
}

__device__ __forceinline__ void attention_mfma(const P& p, int l, LAS unsigned char* lds, int u_begin, int u_end, int u_first, int u_stride) {
    LAS unsigned char* Kt = lds;
    LAS unsigned char* VT = lds + 64 * LDQ;
    LAS unsigned char* Pw = lds + 2 * 64 * LDQ + p.wave * 64 * LDQ;
    const int tid = p.tid, lane = p.lane, wave = p.wave, quad = lane >> 4, l15 = lane & 15;
    const float C2 = 0.125f * 1.4426950408889634f;
    for (int u = u_begin + u_first; u < u_end; u += u_stride) {
        const int qb = u >> 1, kvh = u & 1, hq = kvh * 4 + (wave >> 1);
        const bool isc = qb < 2; const int nb = qb - 2;
        const int qrow0 = 128 * qb + 64 * (wave & 1);
        bf16x8 Qf[4][2];
#pragma unroll
        for (int qt = 0; qt < 4; ++qt)
#pragma unroll
            for (int ks = 0; ks < 2; ++ks) Qf[qt][ks] = *(const bf16x8*)(p.PROJ + (size_t)(qrow0 + 16 * qt + l15) * PJ + Q0 + hq * 64 + ks * 32 + 8 * quad);
        f32x4 O[4][4];
#pragma unroll
        for (int a = 0; a < 4; ++a)
#pragma unroll
            for (int b = 0; b < 4; ++b) O[a][b] = (f32x4){0.f, 0.f, 0.f, 0.f};
        float mrow[4], lrow[4];
        const float sk = p.sink[l * 8 + hq] * 1.4426950408889634f;
#pragma unroll
        for (int qt = 0; qt < 4; ++qt) { mrow[qt] = sk; lrow[qt] = 1.f; }
        const int ntile = isc ? 4 : 10;
        for (int ti = 0; ti < ntile; ++ti) {
            int krow0; bool local;
            if (isc || ti >= 6) { krow0 = 64 * (isc ? ti : ti - 6); local = false; }
            else { krow0 = NCTX + 128 * (nb - 1) + 64 * ti; local = true; }
            if (local && (krow0 < NCTX || krow0 >= T)) continue;
            __syncthreads();
            { const int key = tid >> 3, pc = tid & 7;
              const bf16* src = p.PROJ + (size_t)(krow0 + key) * PJ + kvh * 64 + pc * 8;
              *(LAS u32x4*)(Kt + key * LDQ + pc * 16) = *(const u32x4*)(src + K0);
              const u32x4 v = *(const u32x4*)(src + V0);
              LAS unsigned char* dst = VT + (pc * 8) * LDQ + 2 * key;
              st_b16(dst, v.x & 0xffffu); st_b16(dst + LDQ, v.x >> 16); st_b16(dst + 2 * LDQ, v.y & 0xffffu); st_b16(dst + 3 * LDQ, v.y >> 16);
              st_b16(dst + 4 * LDQ, v.z & 0xffffu); st_b16(dst + 5 * LDQ, v.z >> 16); st_b16(dst + 6 * LDQ, v.w & 0xffffu); st_b16(dst + 7 * LDQ, v.w >> 16); }
            __syncthreads();
            f32x4 S[4][4];
#pragma unroll
            for (int a = 0; a < 4; ++a)
#pragma unroll
                for (int b = 0; b < 4; ++b) S[a][b] = (f32x4){0.f, 0.f, 0.f, 0.f};
#pragma unroll
            for (int ks = 0; ks < 2; ++ks)
#pragma unroll
                for (int kt = 0; kt < 4; ++kt) { const bf16x8 kf = ld_frag(Kt, 16 * kt + l15, ks * 32 + 8 * quad, LDQ);
#pragma unroll
                    for (int qt = 0; qt < 4; ++qt) S[kt][qt] = MFMA16(kf, Qf[qt][ks], S[kt][qt]); }
#pragma unroll
            for (int qt = 0; qt < 4; ++qt) {
                const int tq = qrow0 + 16 * qt + l15;
                float mx = -1e30f;
#pragma unroll
                for (int kt = 0; kt < 4; ++kt)
#pragma unroll
                    for (int r = 0; r < 4; ++r) { const int tk = krow0 + 16 * kt + 4 * quad + r; const int df = tq - tk;
                        const bool ok = !local || (df <= 128 && df >= -128);
                        const float s = ok ? S[kt][qt][r] * C2 : -1e30f; S[kt][qt][r] = s; mx = fmaxf(mx, s); }
                mx = fmaxf(mx, __shfl_xor(mx, 16)); mx = fmaxf(mx, __shfl_xor(mx, 32));
                const float mn = fmaxf(mrow[qt], mx), alpha = exp2f(mrow[qt] - mn);
                float ls = 0.f;
#pragma unroll
                for (int kt = 0; kt < 4; ++kt) { float e0 = exp2f(S[kt][qt][0] - mn), e1 = exp2f(S[kt][qt][1] - mn), e2 = exp2f(S[kt][qt][2] - mn), e3 = exp2f(S[kt][qt][3] - mn);
                    ls += (e0 + e1) + (e2 + e3);
                    u32x2 w; w.x = pk2(e0, e1); w.y = pk2(e2, e3);
                    *(LAS u32x2*)(Pw + (16 * qt + l15) * LDQ + (16 * kt + 4 * quad) * 2) = w; }
                ls += __shfl_xor(ls, 16); ls += __shfl_xor(ls, 32);
                lrow[qt] = lrow[qt] * alpha + ls; mrow[qt] = mn;
#pragma unroll
                for (int dt = 0; dt < 4; ++dt) O[dt][qt] *= alpha;
            }
            LDS_FENCE();
#pragma unroll
            for (int ks = 0; ks < 2; ++ks) {
                bf16x8 pf[4];
#pragma unroll
                for (int qt = 0; qt < 4; ++qt) pf[qt] = ld_frag(Pw, 16 * qt + l15, ks * 32 + 8 * quad, LDQ);
#pragma unroll
                for (int dt = 0; dt < 4; ++dt) { const bf16x8 vf = ld_frag(VT, 16 * dt + l15, ks * 32 + 8 * quad, LDQ);
#pragma unroll
                    for (int qt = 0; qt < 4; ++qt) O[dt][qt] = MFMA16(vf, pf[qt], O[dt][qt]); }
            }
            LDS_FENCE();
        }
#pragma unroll
        for (int qt = 0; qt < 4; ++qt) { const float inv = 1.f / lrow[qt];
            bf16* orow = p.Y3 + (size_t)(qrow0 + 16 * qt + l15) * 1536 + 1024 + hq * 64;
#pragma unroll
            for (int dt = 0; dt < 4; ++dt) { u32x2 w; w.x = pk2(O[dt][qt][0] * inv, O[dt][qt][1] * inv); w.y = pk2(O[dt][qt][2] * inv, O[dt][qt][3] * inv);
                *(u32x2*)(orow + 16 * dt + 4 * quad) = w; } }
    }
}

#ifndef S5_INTERLEAVE
#define S5_INTERLEAVE 2
#endif
constexpr size_t S5BB_ELEMS = (size_t)2 * 32 * 128 * 32, S5CC_ELEMS = (size_t)2 * 32 * 16 * 128;
__device__ __forceinline__ void s5_tables(const P& p, int l, bf16* BB, bf16* CC, float* AB) {
    for (int e = p.bid * NTHR + p.tid; e < 2 * 32 * 64; e += p.G * NTHR) {
        const int d = e >> 11, g = (e >> 6) & 31, pq = e & 63, dg = d * 32 + g;
        S5Lane s; s5_lane_params(p, l, d, g, pq, s, true);
        AB[(size_t)e * 2] = s.abr; AB[(size_t)e * 2 + 1] = s.abi;
        #if S5_INTERLEAVE
        u32x4* br = (u32x4*)(BB + ((size_t)dg * 128 + 2 * pq) * 32); u32x4* bi = (u32x4*)(BB + ((size_t)dg * 128 + 2 * pq + 1) * 32);
#else
        u32x4* br = (u32x4*)(BB + ((size_t)dg * 128 + pq) * 32); u32x4* bi = (u32x4*)(BB + ((size_t)dg * 128 + 64 + pq) * 32);
#endif
        u32x4 w;
        w.x = pk2(s.bbr[0], s.bbr[1]); w.y = pk2(s.bbr[2], s.bbr[3]); w.z = pk2(s.bbr[4], s.bbr[5]); w.w = pk2(s.bbr[6], s.bbr[7]); br[0] = w;
        w.x = pk2(s.bbr[8], s.bbr[9]); w.y = pk2(s.bbr[10], s.bbr[11]); w.z = pk2(s.bbr[12], s.bbr[13]); w.w = pk2(s.bbr[14], s.bbr[15]); br[1] = w;
        w.x = pk2(s.bbi[0], s.bbi[1]); w.y = pk2(s.bbi[2], s.bbi[3]); w.z = pk2(s.bbi[4], s.bbi[5]); w.w = pk2(s.bbi[6], s.bbi[7]); bi[0] = w;
        w.x = pk2(s.bbi[8], s.bbi[9]); w.y = pk2(s.bbi[10], s.bbi[11]); w.z = pk2(s.bbi[12], s.bbi[13]); w.w = pk2(s.bbi[14], s.bbi[15]); bi[1] = w;
        const u32x4 z = (u32x4){0u, 0u, 0u, 0u}; br[2] = z; br[3] = z; bi[2] = z; bi[3] = z;
        const size_t ci = ((size_t)(l * 2 + d) * 32 + g) * 16;
#pragma unroll
        for (int k = 0; k < 16; ++k) {
#if S5_INTERLEAVE
            *(unsigned*)(CC + ((size_t)dg * 16 + k) * 128 + 2 * pq) = pk2(p.c_re[(ci + k) * 64 + pq], -p.c_im[(ci + k) * 64 + pq]);
#else
            CC[((size_t)dg * 16 + k) * 128 + pq] = (bf16)f2bf(p.c_re[(ci + k) * 64 + pq]); CC[((size_t)dg * 16 + k) * 128 + 64 + pq] = (bf16)f2bf(-p.c_im[(ci + k) * 64 + pq]);
#endif
        }
    }
}
constexpr int S5_WREG = 4096 + 16 * 132 * 4 + 16 * LDP;
template <bool READOUT> __device__ __forceinline__ void s5_chunk_dir(int d, const bf16* BBdg, const bf16* CCdg, float abr, float abi, LAS unsigned char* wreg, int lane, float& hr, float& hi, f32x4 (&yacc)[8]) {
    const int quad = lane >> 4, l15 = lane & 15;
    LAS unsigned char* ub = wreg; LAS float* BuW = (LAS float*)(wreg + 4096); LAS unsigned char* Hw = wreg + 4096 + 16 * 132 * 4;
    bf16x8 BBf[8], CCf[4];
#pragma unroll
    for (int pt = 0; pt < 8; ++pt) BBf[pt] = *(const bf16x8*)(BBdg + (size_t)(16 * pt + l15) * 32 + 8 * quad);
    if (READOUT) {
#pragma unroll
        for (int ks = 0; ks < 4; ++ks) CCf[ks] = *(const bf16x8*)(CCdg + (size_t)l15 * 128 + ks * 32 + 8 * quad);
    }
#pragma unroll (READOUT ? 8 : 1)
    for (int ss = 0; ss < 8; ++ss) {
        const int sc = d ? 7 - ss : ss;
        bf16x8 uf = (bf16x8){0, 0, 0, 0, 0, 0, 0, 0};
        if (quad < 2) uf = *(const LAS bf16x8*)(ub + (16 * sc + l15) * 32 + quad * 16);
#pragma unroll
        for (int pt = 0; pt < 8; ++pt) { const f32x4 Dp = MFMA16(uf, BBf[pt], ((f32x4){0.f, 0.f, 0.f, 0.f}));
#pragma unroll
            for (int r = 0; r < 4; ++r) BuW[(4 * quad + r) * 132 + 16 * pt + l15] = Dp[r]; }
        LDS_FENCE();
#pragma unroll
        for (int st = 0; st < 16; ++st) { const int tl = d ? 15 - st : st;
#if S5_INTERLEAVE == 1
            typedef float f32x2_t __attribute__((ext_vector_type(2)));
            const f32x2_t bu = *(const LAS f32x2_t*)(BuW + tl * 132 + 2 * lane);
            const float nr = abr * hr - abi * hi + bu[0], ni = abr * hi + abi * hr + bu[1]; hr = nr; hi = ni;
            if (READOUT) *(LAS unsigned*)(Hw + tl * LDP + 4 * lane) = pk2(hr, hi); }
#elif S5_INTERLEAVE == 2
            const float br = BuW[tl * 132 + 2 * lane], bi = BuW[tl * 132 + 2 * lane + 1];
            const float nr = abr * hr - abi * hi + br, ni = abr * hi + abi * hr + bi; hr = nr; hi = ni;
            if (READOUT) *(LAS unsigned*)(Hw + tl * LDP + 4 * lane) = pk2(hr, hi); }
#else
            const float br = BuW[tl * 132 + lane], bi = BuW[tl * 132 + 64 + lane];
            const float nr = abr * hr - abi * hi + br, ni = abr * hi + abi * hr + bi; hr = nr; hi = ni;
            if (READOUT) { st_b16(Hw + tl * LDP + 2 * lane, f2bf(hr)); st_b16(Hw + tl * LDP + 128 + 2 * lane, f2bf(hi)); } }
#endif
        if (READOUT) {
            LDS_FENCE();
#pragma unroll
            for (int ks = 0; ks < 4; ++ks) yacc[sc] = MFMA16(ld_frag(Hw, l15, ks * 32 + 8 * quad, LDP), CCf[ks], yacc[sc]);
        }
        LDS_FENCE();
    }
}
__device__ __forceinline__ void s5_local_states(const P& p, LAS unsigned char* lds, const bf16* BB, const float* AB) {
    LAS unsigned char* wreg = lds + p.wave * S5_WREG;
    const int gw = p.bid * NWAVES + p.wave, NGW = p.G * NWAVES, lane = p.lane;
    for (int it = gw; it < 2 * 32 * NCH; it += NGW) {
        const int d = it / (32 * NCH), c = (it % (32 * NCH)) >> 5, g = it & 31, dg = d * 32 + g;
        s5_stage_u(p, chunk_r0(d, c), g, wreg, lane);
        float hr = 0.f, hi = 0.f; f32x4 dummy[8];
        const float abr = AB[((size_t)dg * 64 + lane) * 2], abi = AB[((size_t)dg * 64 + lane) * 2 + 1];
        if (d == 0) s5_chunk_dir<false>(0, BB + (size_t)dg * 128 * 32, nullptr, abr, abi, wreg, lane, hr, hi, dummy);
        else s5_chunk_dir<false>(1, BB + (size_t)dg * 128 * 32, nullptr, abr, abi, wreg, lane, hr, hi, dummy);
        float* E = p.S5E + ((size_t)dg * NCH + c) * 128;
        E[lane] = hr; E[64 + lane] = hi;
    }
}
__device__ __forceinline__ void s5_outputs(const P& p, int l, LAS unsigned char* lds, const bf16* BB, const bf16* CC, const float* AB, int it_begin, int it_end, int first, int stride) {
    LAS unsigned char* wreg = lds + p.wave * S5_WREG;
    const int lane = p.lane, quad = lane >> 4, l15 = lane & 15;
    for (int it = it_begin + first; it < it_end; it += stride) {
        const int cn = it >> 5, g = it & 31, r0 = 128 * cn;
        s5_stage_u(p, r0, g, wreg, lane);
        f32x4 yacc[8];
#pragma unroll
        for (int i = 0; i < 8; ++i) yacc[i] = (f32x4){0.f, 0.f, 0.f, 0.f};
#pragma unroll
        for (int d = 0; d < 2; ++d) { const int dg = d * 32 + g, cs = scan_chunk_of(d, cn);
            const float* Hn = (cn < 2) ? (p.S5E + (size_t)dg * NCH * 128) : (p.S5H + ((size_t)dg * NCH + cs) * 128);
            float hr = Hn[lane], hi = Hn[64 + lane];
            if (cs == 0) { hr = 0.f; hi = 0.f; }
            s5_chunk_dir<true>(d, BB + (size_t)dg * 128 * 32, CC + (size_t)dg * 16 * 128, AB[((size_t)dg * 64 + lane) * 2], AB[((size_t)dg * 64 + lane) * 2 + 1], wreg, lane, hr, hi, yacc); }
        const float dsk = p.s5_d[(size_t)l * 512 + g * 16 + l15];
#pragma unroll
        for (int sc = 0; sc < 8; ++sc)
#pragma unroll
            for (int r = 0; r < 4; ++r) { const int t = 16 * sc + 4 * quad + r;
                const float u = bf2f(*(const LAS unsigned short*)(wreg + t * 32 + 2 * l15));
                p.SA[(size_t)(r0 + t) * 512 + g * 16 + l15] = (bf16)f2bf(gelu_tanh_f(yacc[sc][r] + dsk * u)); }
        LDS_FENCE();
    }
}

#ifndef SKIPMASK
#define SKIPMASK 0
#endif
struct Args { const float* in[33]; float* out; unsigned char* ws; int ph_lo, ph_hi; };
static_assert(sizeof(Args) == 35 * 8 + 8, "no padding");

__global__ void __launch_bounds__(NTHR, 2) fwd_kernel(Args args) {
    extern __shared__ __attribute__((aligned(16))) unsigned char lds_raw[];
    LAS unsigned char* lds = (LAS unsigned char*)lds_raw;
    const int tid_ = threadIdx.x;
    if (tid_ == 0) {
        LAS unsigned long long* tab = (LAS unsigned long long*)(lds + PTAB_OFF);
#pragma unroll
        for (int k = 0; k < 33; ++k) tab[k] = (unsigned long long)args.in[k];
        tab[33] = (unsigned long long)args.out; tab[34] = (unsigned long long)args.ws;
    }
    volatile LAS unsigned* MISC = (volatile LAS unsigned*)(lds + MISC_OFF);
    if (tid_ < 64) MISC[tid_] = 0u;
    __syncthreads();
    XcdBarrier bar; bar.bar = (unsigned*)(args.ws + WS_CTL) + CW_BAR; bar.x = 0; bar.st = nullptr;
    if (!MK_PER_PHASE) bar = xcd_barrier_post((unsigned*)(args.ws + WS_CTL) + CW_BAR, MISC + 8);

    const int lo = args.ph_lo, hi = args.ph_hi;
#define IN(k) (lo <= (k) && (k) < hi)
#define SEAM(k) do { if (!MK_PER_PHASE && (k) + 1 < hi) xcd_barrier(bar); } while (0)

    if (IN(0)) { P p; build_P(p, lds); phase_mod(p, lds, (float*)(args.ws + WS_ROPE)); SEAM(0); }

#ifndef REPMASK
#define REPMASK 0
#endif
#define PHASE(k, ...) if (!((SKIPMASK >> (k)) & 1) && IN(pb + (k))) { for (int rep_ = 0; rep_ <= ((REPMASK >> (k)) & 1); ++rep_) { P p; build_P(p, lds); __VA_ARGS__; \
        if (rep_ < ((REPMASK >> (k)) & 1)) xcd_barrier(bar); } SEAM(pb + (k)); }
    for (int l = 0; l < DEPTH; ++l) {
        const int pb = 1 + NPH_LAYER * l;
        const bool cx = l < DEPTH - 1;
        unsigned char* wsb; { unsigned tb_ = (unsigned)(size_t)(lds + PTAB_OFF); asm volatile("" : "+v"(tb_)); wsb = (unsigned char*)ld_tab((volatile LAS unsigned*)(size_t)tb_, 34); }
        PHASE(0, convert_weights(p, l, lds); s5_tables(p, l, (bf16*)(wsb + WS_S5BB), (bf16*)(wsb + WS_S5CC), (float*)(wsb + WS_S5AB)); __syncthreads(); if (rep_ == 0) row_pass<0>(p, l, lds))
        PHASE(1, pg8::Gemm g{p.H, p.WIN, T, PJ, D}; pg8::StaticOrder S; S.init(T, PJ, p.G, p.bid); pg8::EpiStoreBf16 E{p.PROJ, PJ, GT0 / 256, (const float*)(wsb + WS_ROPE)};
            pg8::gemm_phase<pg8::EpiStoreBf16, pg8::StaticOrder, false>(lds, g, S, E, nullptr))
        PHASE(2, phase_premix(p, l, lds); s5_local_states(p, lds, (const bf16*)(wsb + WS_S5BB), (const float*)(wsb + WS_S5AB)))
        PHASE(3, ssd_states(p, l, lds, (float*)(wsb + WS_SST), (float*)(wsb + WS_DEC)); __syncthreads(); attention_mfma(p, l, lds, 4, 2 * NCH, p.bid, p.G))
        PHASE(4, if (cx) { if (p.bid >= p.G - 4) attention_mfma(p, l, lds, 0, 4, p.bid - (p.G - 4), 4);
                else if (p.bid >= p.G - 20) ssd_outputs(p, l, lds, (const bf16*)(wsb + WS_HIN), (const float*)(wsb + WS_SST), (bf16*)(wsb + WS_YS), 0, 16, p.bid - (p.G - 20), 16);
                else if (p.bid >= p.G - 28) s5_outputs(p, l, lds, (const bf16*)(wsb + WS_S5BB), (const bf16*)(wsb + WS_S5CC), (const float*)(wsb + WS_S5AB), 0, 64, (p.bid - (p.G - 28)) * NWAVES + p.wave, 64); }
            scan_carries(p, l, (const float*)(wsb + WS_SST), (const float*)(wsb + WS_DEC), (bf16*)(wsb + WS_HIN)))
        PHASE(5, ssd_outputs(p, l, lds, (const bf16*)(wsb + WS_HIN), (const float*)(wsb + WS_SST), (bf16*)(wsb + WS_YS), 16, NCH * 8, p.bid, p.G); __syncthreads();
            s5_outputs(p, l, lds, (const bf16*)(wsb + WS_S5BB), (const bf16*)(wsb + WS_S5CC), (const float*)(wsb + WS_S5AB), 64, 32 * NCH, p.bid * NWAVES + p.wave, p.G * NWAVES))
        PHASE(6, pg8::Gemm g{p.SA, p.WGLU, T, 512, 512}; pg8::RowOffOrder S; S.init(cx ? T : NLAT, 512, p.G, p.bid, cx ? 0 : 1); pg8::EpiGlu E{p.SA, p.b_glu + (size_t)l * 512, p.Y3};
            pg8::gemm_phase<pg8::EpiGlu, pg8::RowOffOrder, false>(lds, g, S, E, nullptr); ssd_gated_norm(p, l, (const bf16*)(wsb + WS_YS)))
        PHASE(7, pg8::Gemm g{p.Y3, p.WBR, T, D, 1536}; pg8::RowOffOrder S; S.init(cx ? T : NLAT, D, p.G, p.bid, cx ? 0 : 1); pg8::EpiMerge E{p.PROJ, p.MB};
            pg8::gemm_phase<pg8::EpiMerge, pg8::RowOffOrder, false>(lds, g, S, E, nullptr))
        PHASE(8, pg8::Gemm g{p.MB, p.WOUT, T, D, D}; pg8::RowOffOrder S; S.init(cx ? T : NLAT, D, p.G, p.bid, cx ? 0 : 1);
            pg8::EpiResid E{p.XL, p.XC, p.MOD + (size_t)(l * 2 + 0) * 6144 + 2 * D, p.MOD + (size_t)(l * 2 + 1) * 6144 + 2 * D};
            pg8::gemm_phase<pg8::EpiResid, pg8::RowOffOrder, false>(lds, g, S, E, nullptr))
        PHASE(9, row_pass<1>(p, l, lds, cx))
        PHASE(10, phase_select(p, lds, cx))
        PHASE(11, phase_gather(p, cx))
        PHASE(12, pg8::Gemm g{p.XE, p.WUP, NE * ESLOTS, NE * 2048, D}; pg8::ExpertOrder S{p.G, p.bid, 8, cx ? 9 : 8}; pg8::EpiSwiGlu E{p.HID};
            pg8::gemm_phase<pg8::EpiSwiGlu, pg8::ExpertOrder, false>(lds, g, S, E, nullptr))
        PHASE(13, pg8::Gemm g{p.HID, p.WDN, NE * ESLOTS, NE * 1024, D}; pg8::ExpertOrder S{p.G, p.bid, 4, cx ? 9 : 8}; pg8::EpiDown E{p.YE, p.GSEL};
            pg8::gemm_phase<pg8::EpiDown, pg8::ExpertOrder, false>(lds, g, S, E, nullptr))
    }
    if (IN(NPHASES - 1)) { P p; build_P(p, lds); row_pass<2>(p, 0, lds); }
#undef IN
#undef SEAM
}

extern "C" void kernel_launch(void* const* d_in, const int* in_sizes, int n_in, void* d_out, int out_size, void* d_ws, size_t ws_size, hipStream_t stream) {
    static int grid = 0;
    if (grid == 0) {
        if (n_in != 33 || out_size != NLAT * D || ws_size < WS_END) { fprintf(stderr, "kernel_launch: unexpected shapes: n_in %d out %d ws %zu (need %zu)\n", n_in, out_size, ws_size, (size_t)WS_END); grid = -1; return; }
        int dev = 0, cus = 0, per_cu = 0;
        if (hipGetDevice(&dev) != hipSuccess || hipDeviceGetAttribute(&cus, hipDeviceAttributeMultiprocessorCount, dev) != hipSuccess) { grid = -1; return; }
        if (hipFuncSetAttribute((const void*)fwd_kernel, hipFuncAttributeMaxDynamicSharedMemorySize, LDS_BYTES) != hipSuccess) { fprintf(stderr, "kernel_launch: hipFuncSetAttribute failed\n"); grid = -1; return; }
        if (hipOccupancyMaxActiveBlocksPerMultiprocessor(&per_cu, (const void*)fwd_kernel, NTHR, LDS_BYTES) != hipSuccess || per_cu < 1) { fprintf(stderr, "kernel_launch: occupancy query says %d\n", per_cu); (void)hipGetLastError(); }
        grid = cus;
    }
    if (grid < 0) return;
    (void)hipMemsetAsync((char*)d_ws + WS_CTL, 0, CTL_BYTES, stream);
    Args a{};
    for (int i = 0; i < 33; ++i) a.in[i] = (const float*)d_in[i];
    a.out = (float*)d_out; a.ws = (unsigned char*)d_ws;
#if MK_PER_PHASE
    for (int ph = 0; ph < NPHASES; ++ph) { a.ph_lo = ph; a.ph_hi = ph + 1; hipLaunchKernelGGL(fwd_kernel, dim3(grid), dim3(NTHR), LDS_BYTES, stream, a); }
#else
    a.ph_lo = 0; a.ph_hi = NPHASES;
    hipLaunchKernelGGL(fwd_kernel, dim3(grid), dim3(NTHR), LDS_BYTES, stream, a);
#endif
}
```

```cpp
#include <hip/hip_runtime.h>
#include <cstdio>
#include <cstdint>

#ifndef MK_PER_PHASE
#define MK_PER_PHASE 0
#endif

namespace pg8 {
#define PG8_LAS __attribute__((address_space(3)))
typedef unsigned short bf16_t;
typedef short bf16x8 __attribute__((ext_vector_type(8)));
typedef float f32x4 __attribute__((ext_vector_type(4)));
typedef unsigned u32x4 __attribute__((ext_vector_type(4)));
constexpr int BM = 256, BK = 64, HALF = 128, HTB = HALF * BK * 2  , STAGE_BYTES = 8 * HTB, NXCD = 8, WGM = 8;

__host__ __device__ __forceinline__ int lds_byte(int r, int c) { const int st = (r >> 4) * 2 + (c >> 5), rr = r & 15, cc = c & 31, ob = rr * 64 + cc * 2; return st * 1024 + (ob ^ (((ob >> 9) & 1) << 5)); }
__host__ __device__ __forceinline__ void stage_rc(int b, int& R, int& C) { const int st = b / 1024, sb = b % 1024, swz = sb ^ (((sb >> 9) & 1) << 5); R = (st >> 1) * 16 + swz / 64; C = (st & 1) * 32 + (swz % 64) / 2; }
__host__ __device__ __forceinline__ int perm32(int rho) { const int n = rho >> 4, i = rho & 15; return 8 * (i >> 2) + 4 * n + (i & 3); }

struct Unit { int pm, pn; };
struct Gemm { const bf16_t* A; const bf16_t* Bt; int M, N, K; };

struct StaticOrder {
    int nM, nN, nwg, G, c;
    __host__ __device__ void init(int M, int N, int G_, int c_) { nM = M / BM; nN = N / BM; nwg = nM * nN; G = G_; c = c_; }
    __host__ __device__ bool next(int i, Unit& u) const {
        const long L = (long)i * G + c; if (L >= nwg) return false;
        int wgid = (int)L; { const int q = nwg / NXCD, r = nwg % NXCD, xcd = wgid % NXCD, off = wgid / NXCD; wgid = (xcd < r ? xcd * (q + 1) : r * (q + 1) + (xcd - r) * q) + off; }
        const int nig = WGM * nN, gid = wgid / nig, fm = gid * WGM, gsz = (nM - fm) < WGM ? (nM - fm) : WGM;
        u.pm = fm + ((wgid % nig) % gsz); u.pn = (wgid % nig) / gsz; return true;
    }
    __device__ __forceinline__ void a_ready(const Unit&) const {}
    __device__ __forceinline__ void done(const Unit&) const {}
};
__device__ __forceinline__ unsigned cvt_pk_bf16(float lo, float hi) { unsigned r; asm volatile("v_cvt_pk_bf16_f32 %0, %1, %2" : "=v"(r) : "v"(lo), "v"(hi)); return r; }
template <class Epi, class Sched, bool STAMP = false>
__device__ __forceinline__ void gemm_phase(PG8_LAS unsigned char* lds, const Gemm g, const Sched& S, const Epi& E, unsigned long long* stamps) {
    int tid_l = threadIdx.x; asm volatile("" : "+v"(tid_l));
    const int tid = tid_l, wid = __builtin_amdgcn_readfirstlane(tid >> 6), lane = tid & 63, wr = wid >> 2, wc = wid & 3, fr = lane & 15, fq = lane >> 4;
    const int K = g.K, nt = K / BK;
    int ts_lo = 0, ts_hi = 0, nts = 0; const unsigned long long rt_entry = STAMP ? (unsigned long long)wall_clock64() : 0ull;
#define PG8_STAMP() do { if (STAMP && wid == 0 && nts < 64) { const unsigned long long _c = (unsigned long long)clock64(); \
        ts_lo = (lane == nts) ? (int)(unsigned)_c : ts_lo; ts_hi = (lane == nts) ? (int)(unsigned)(_c >> 32) : ts_hi; ++nts; } } while (0)
    PG8_STAMP();
    unsigned voffA[2], voffB[2];
#pragma unroll
    for (int i = 0; i < 2; ++i) { int R, C; stage_rc(tid * 16 + i * 8192, R, C); const int Rb = Epi::PERM ? ((R & ~31) + perm32(R & 31)) : R;
        voffA[i] = (unsigned)(R * K + C) * 2u; voffB[i] = (unsigned)(Rb * K + C) * 2u; }
    const size_t kstep = (size_t)(BK * 2);
    const size_t hstep = (size_t)HALF * K * 2;
    const size_t tstep = 2 * hstep;
    const unsigned ldsw = (unsigned)wid * 1024u;
    const int aoff = lds_byte(wr * 64 + fr, fq * 8), boff = lds_byte(wc * 32 + fr, fq * 8);
#define PG8_SA(b, h) (((b) * 2 + (h)) * HTB)
#define PG8_SB(b, h) ((4 + (b) * 2 + (h)) * HTB)
#define PG8_STAGE(bufoff, gbase, voff) do { _Pragma("unroll") for (int _i = 0; _i < 2; ++_i) \
        __builtin_amdgcn_global_load_lds((const unsigned*)((const char*)(gbase) + (voff)[_i]), (PG8_LAS unsigned*)(lds + (bufoff) + ldsw + _i * 8192), 16, 0, 0); } while (0)
#define PG8_LDA(dst, b, h) do { _Pragma("unroll") for (int m = 0; m < 4; ++m) _Pragma("unroll") for (int k = 0; k < 2; ++k) dst[m][k] = *(const PG8_LAS bf16x8*)(lds + PG8_SA(b, h) + aoff + m * 2048 + k * 1024); } while (0)
#define PG8_LDB(dst, b, h) do { _Pragma("unroll") for (int n = 0; n < 2; ++n) _Pragma("unroll") for (int k = 0; k < 2; ++k) dst[n][k] = *(const PG8_LAS bf16x8*)(lds + PG8_SB(b, h) + boff + n * 2048 + k * 1024); } while (0)
#define PG8_MMA(ai, bj, At, Bt) do { __builtin_amdgcn_s_setprio(1); _Pragma("unroll") for (int m = 0; m < 4; ++m) _Pragma("unroll") for (int n = 0; n < 2; ++n) _Pragma("unroll") for (int k = 0; k < 2; ++k) \
        acc[ai][bj][m][n] = __builtin_amdgcn_mfma_f32_16x16x32_bf16(Bt[n][k], At[m][k], acc[ai][bj][m][n], 0, 0, 0); __builtin_amdgcn_s_setprio(0); } while (0)
#define PG8_WAIT_V(n) asm volatile("s_waitcnt vmcnt(" #n ")" ::: "memory")
#define PG8_WAIT_L(n) asm volatile("s_waitcnt lgkmcnt(" #n ")" ::: "memory")
#define PG8_BAR __builtin_amdgcn_s_barrier()
#define PG8_SCHED __builtin_amdgcn_sched_barrier(0)
    Unit cur, nxt; int ui = 0;
    if (!S.next(0, cur)) return;
    f32x4 acc[2][2][4][2];
#pragma unroll
    for (int a = 0; a < 2; ++a)
#pragma unroll
        for (int b = 0; b < 2; ++b)
#pragma unroll
            for (int m = 0; m < 4; ++m)
#pragma unroll
                for (int n = 0; n < 2; ++n) acc[a][b][m][n] = (f32x4){0.f, 0.f, 0.f, 0.f};
    bf16x8 At[4][2], B0[2][2], B1[2][2];
    const char* cA = (const char*)g.A + (size_t)cur.pm * tstep; const char* cB = (const char*)g.Bt + (size_t)cur.pn * tstep;
    S.a_ready(cur);
    PG8_STAGE(PG8_SB(0, 0), cB, voffB); PG8_STAGE(PG8_SA(0, 0), cA, voffA); PG8_STAGE(PG8_SB(0, 1), cB + hstep, voffB); PG8_STAGE(PG8_SA(0, 1), cA + hstep, voffA);
    if (wr == 1) PG8_BAR;
    PG8_WAIT_V(4); PG8_BAR;
    PG8_STAGE(PG8_SB(1, 0), cB + kstep, voffB); PG8_STAGE(PG8_SA(1, 0), cA + kstep, voffA); PG8_STAGE(PG8_SB(1, 1), cB + hstep + kstep, voffB);
    PG8_WAIT_V(6); PG8_BAR;
    PG8_STAMP();
    for (;;) {
        const bool has_next = S.next(ui + 1, nxt);
        const char* nA = has_next ? (const char*)g.A + (size_t)nxt.pm * tstep : cA; const char* nB = has_next ? (const char*)g.Bt + (size_t)nxt.pn * tstep : cB;
        for (int t = 0; t < nt; t += 2) {
            const bool last = (t == nt - 2);
            const char* a1 = cA + (size_t)(t + 1) * kstep;
            const char* a2 = last ? nA : cA + (size_t)(t + 2) * kstep; const char* b2 = last ? nB : cB + (size_t)(t + 2) * kstep;
            const char* a3 = a2 + kstep; const char* b3 = b2 + kstep;
            if (last && has_next) S.a_ready(nxt);
            if constexpr (Epi::MIDHOOK) { if (t == 8 || t == 16) E.mid(acc, cur, t >> 3, wr, wc, fr, fq); }
            PG8_LDB(B0, 0, 0); PG8_SCHED; PG8_LDA(At, 0, 0); PG8_STAGE(PG8_SA(1, 1), a1 + hstep, voffA);
            PG8_WAIT_L(8); PG8_BAR; PG8_WAIT_L(0); PG8_MMA(0, 0, At, B0); PG8_BAR; PG8_SCHED;
            PG8_LDB(B1, 0, 1); PG8_STAGE(PG8_SB(0, 0), b2, voffB);
            PG8_BAR; PG8_WAIT_L(0); PG8_MMA(0, 1, At, B1); PG8_BAR;
            PG8_LDA(At, 0, 1); PG8_STAGE(PG8_SA(0, 0), a2, voffA);
            PG8_BAR; PG8_WAIT_L(0); PG8_MMA(1, 0, At, B0); PG8_BAR; PG8_SCHED;
            PG8_STAGE(PG8_SB(0, 1), b2 + hstep, voffB);
            PG8_WAIT_V(6); PG8_BAR; PG8_MMA(1, 1, At, B1); PG8_BAR;
            PG8_LDB(B0, 1, 0); PG8_SCHED; PG8_LDA(At, 1, 0); PG8_STAGE(PG8_SA(0, 1), a2 + hstep, voffA);
            PG8_WAIT_L(8); PG8_BAR; PG8_WAIT_L(0); PG8_MMA(0, 0, At, B0); PG8_BAR; PG8_SCHED;
            PG8_LDB(B1, 1, 1); PG8_STAGE(PG8_SB(1, 0), b3, voffB);
            PG8_BAR; PG8_WAIT_L(0); PG8_MMA(0, 1, At, B1); PG8_BAR;
            PG8_LDA(At, 1, 1); PG8_STAGE(PG8_SA(1, 0), a3, voffA);
            PG8_BAR; PG8_WAIT_L(0); PG8_MMA(1, 0, At, B0); PG8_BAR; PG8_SCHED;
            PG8_STAGE(PG8_SB(1, 1), b3 + hstep, voffB);
            PG8_WAIT_V(6); PG8_BAR; PG8_MMA(1, 1, At, B1); PG8_BAR;
        }
        PG8_STAMP();
        if constexpr (!Epi::AFTER_DRAIN) { E(acc, cur, wr, wc, fr, fq); S.done(cur); }
        PG8_STAMP();
        if (!has_next) break;
#pragma unroll
        for (int a = 0; a < 2; ++a)
#pragma unroll
            for (int b = 0; b < 2; ++b)
#pragma unroll
                for (int m = 0; m < 4; ++m)
#pragma unroll
                    for (int n = 0; n < 2; ++n) acc[a][b][m][n] = (f32x4){0.f, 0.f, 0.f, 0.f};
        cur = nxt; cA = nA; cB = nB; ++ui;
    }
    PG8_WAIT_V(0);
    if (wr == 0) PG8_BAR;
    PG8_BAR;
    if constexpr (Epi::AFTER_DRAIN) { E.fused(acc, cur, wr, wc, fr, fq, lds, wid, lane); S.done(cur); }
    PG8_STAMP();
    if (STAMP && wid == 0) { stamps[lane] = lane < nts ? (((unsigned long long)(unsigned)ts_hi << 32) | (unsigned)ts_lo) : 0ull;
        if (lane == 62) stamps[62] = rt_entry; if (lane == 63) stamps[63] = (unsigned long long)wall_clock64(); }
#undef PG8_STAMP
#undef PG8_SA
#undef PG8_SB
#undef PG8_STAGE
#undef PG8_LDA
#undef PG8_LDB
#undef PG8_MMA
#undef PG8_WAIT_V
#undef PG8_WAIT_L
#undef PG8_BAR
#undef PG8_SCHED
}
}

#define GAS __attribute__((address_space(1)))
#define LAS __attribute__((address_space(3)))
typedef unsigned short bf16;
typedef float f32x4 __attribute__((ext_vector_type(4)));
typedef unsigned u32x4 __attribute__((ext_vector_type(4)));
typedef unsigned u32x2 __attribute__((ext_vector_type(2)));

constexpr int D = 1024, NLAT = 16384, NCTX = 256, T = NLAT + NCTX, DEPTH = 4;
constexpr int IN_W = 5904, PJ = 5888;
constexpr int U0 = 0, Z0 = 512, XB0 = 1024, Q0 = 2048, K0 = 2560, V0 = 2688, GT0 = 2816;
constexpr int NE = 16, ESLOTS = 2304, CAP_L = 2048, CAP_C = 32;
constexpr int NCH = 130;
constexpr float EPS = 1e-6f;
constexpr int NWAVES = 8, NTHR = 512;
constexpr int LDS_BYTES = 155648;
constexpr int MISC_OFF = LDS_BYTES - 1024 + 512;
constexpr int NPH_LAYER = 14, NPHASES = 1 + DEPTH * NPH_LAYER + 1;

constexpr size_t al256(size_t x) { return (x + 255) & ~(size_t)255; }
constexpr size_t WS_CTL = 0, CTL_BYTES = 1u << 20;
constexpr size_t WS_MOD = WS_CTL + CTL_BYTES;
constexpr size_t WS_XC = al256(WS_MOD + (size_t)DEPTH * 2 * 6144 * 4);
constexpr size_t WS_WIN = al256(WS_XC + (size_t)NCTX * D * 4);
constexpr size_t WS_WGLU = al256(WS_WIN + (size_t)PJ * D * 2);
constexpr size_t WS_WBR = al256(WS_WGLU + (size_t)512 * 512 * 2);
constexpr size_t WS_WOUT = al256(WS_WBR + (size_t)3 * 1024 * 512 * 2);
constexpr size_t WS_WUP = al256(WS_WOUT + (size_t)1024 * 1024 * 2);
constexpr size_t WS_WDN = al256(WS_WUP + (size_t)NE * 2048 * 1024 * 2);
constexpr size_t WS_H = al256(WS_WDN + (size_t)NE * 1024 * 1024 * 2);
constexpr size_t WS_PROJ = al256(WS_H + (size_t)T * D * 2);
constexpr size_t WS_XE = WS_PROJ;
constexpr size_t WS_HID = al256(WS_XE + (size_t)NE * ESLOTS * D * 2);
constexpr size_t WS_DT = al256(WS_PROJ + (size_t)T * PJ * 2);
constexpr size_t WS_CV = al256(WS_DT + (size_t)T * 16 * 4);
constexpr size_t WS_S5E = al256(WS_CV + (size_t)T * 1024 * 2);
constexpr size_t WS_S5H = al256(WS_S5E + (size_t)2 * 32 * NCH * 128 * 4);
constexpr size_t WS_YD = al256(WS_S5H + (size_t)2 * 32 * NCH * 128 * 4);
constexpr size_t WS_SA = al256(WS_YD + (size_t)2 * T * 512 * 4);
constexpr size_t WS_Y3 = al256(WS_SA + (size_t)T * 512 * 2);
constexpr size_t WS_PM = al256(WS_Y3 + (size_t)3 * T * 512 * 2);
constexpr size_t WS_MB = al256(WS_PM + (size_t)T * D * 4);
constexpr size_t WS_YE = WS_PM;
constexpr size_t WS_AFFT = al256(WS_MB + (size_t)T * D * 2);
constexpr size_t WS_IDX = al256(WS_AFFT + (size_t)NE * T * 4);
constexpr size_t WS_GSEL = al256(WS_IDX + (size_t)NE * ESLOTS * 4);
constexpr size_t WS_INV = al256(WS_GSEL + (size_t)NE * ESLOTS * 4);
constexpr size_t WS_DEC = al256(WS_INV + (size_t)T * 16 * 4);
constexpr size_t WS_S5BB = al256(WS_DEC + (size_t)2 * NCH * 8 * 4);
constexpr size_t WS_S5CC = al256(WS_S5BB + (size_t)2 * 32 * 128 * 32 * 2);
constexpr size_t WS_S5AB = al256(WS_S5CC + (size_t)2 * 32 * 16 * 128 * 2);
constexpr size_t WS_ROPE = al256(WS_S5AB + (size_t)2 * 32 * 64 * 2 * 4);
constexpr size_t WS_END = al256(WS_ROPE + (size_t)2 * 256 * 16 * 4);
constexpr size_t WS_SST = WS_YD;
constexpr size_t WS_HIN = WS_PM;
constexpr size_t WS_YS = al256(WS_HIN + (size_t)2 * NCH * 8 * 8192 * 2);
static_assert(WS_YS + (size_t)T * 512 * 2 <= WS_AFFT, "HIN|YS overlay fits PM|MB");
static_assert(WS_HID + (size_t)NE * ESLOTS * D * 2 <= WS_DT, "XE|HID overlay fits PROJ");
static_assert(WS_YE + (size_t)NE * ESLOTS * D * 2 <= WS_AFFT, "YE overlay fits PM|MB");
static_assert(WS_END < (size_t)1000 * 1024 * 1024, "workspace");
constexpr int CW_BAR = 4096;

__device__ __forceinline__ float bf2f(unsigned b) { return __uint_as_float(b << 16); }
__device__ __forceinline__ float bflo(unsigned w) { return __uint_as_float(w << 16); }
__device__ __forceinline__ float bfhi(unsigned w) { return __uint_as_float(w & 0xffff0000u); }
typedef float f32x2_c __attribute__((ext_vector_type(2)));
typedef __bf16 bf16x2_c __attribute__((ext_vector_type(2)));
__device__ __forceinline__ unsigned pk2(float lo, float hi) { f32x2_c v; v[0] = lo; v[1] = hi; return __builtin_bit_cast(unsigned, __builtin_convertvector(v, bf16x2_c)); }
__device__ __forceinline__ unsigned f2bf(float f) { return pk2(f, 0.f) & 0xffffu; }
__device__ __forceinline__ float wsum(float v) {
#pragma unroll
    for (int o = 1; o < 64; o <<= 1) v += __shfl_xor(v, o);
    return v;
}
__device__ __forceinline__ float wmaxf(float v) {
#pragma unroll
    for (int o = 1; o < 64; o <<= 1) v = fmaxf(v, __shfl_xor(v, o));
    return v;
}
__device__ __forceinline__ float silu_f(float x) { return x * __builtin_amdgcn_rcpf(1.f + __expf(-x)); }
__device__ __forceinline__ float sigmoid_f(float x) { return __builtin_amdgcn_rcpf(1.f + __expf(-x)); }
__device__ __forceinline__ float softplus_f(float x) { return x > 20.f ? x : log1pf(expf(x)); }
__device__ __forceinline__ float gelu_tanh_f(float x) { const float u = 0.7978845608028654f * (x + 0.044715f * x * x * x); return x * __builtin_amdgcn_rcpf(1.f + __expf(-2.f * u)); }
#define LDS_FENCE() asm volatile("s_waitcnt lgkmcnt(0)" ::: "memory")
__device__ __forceinline__ int scan_row(int d, int s) { return d == 0 ? s : (s < NCTX ? (NCTX - 1 - s) : (T + NCTX - 1 - s)); }

namespace pg8 {
struct EpiStoreBf16 {
    static constexpr bool PERM = true, AFTER_DRAIN = false, MIDHOOK = false;
    bf16_t* O; int ldc; int sig_tile; const float* rope;
    __device__ __forceinline__ void operator()(const f32x4 (&acc)[2][2][4][2], const Unit& u, int wr, int wc, int fr, int fq) const {
        const int row0 = u.pm * BM + wr * 64 + fr, col0 = u.pn * BM + wc * 32 + 8 * fq; const bool sg = u.pn >= sig_tile;
        const bool rq = rope != nullptr && u.pm >= 1 && (u.pn == Q0 / 256 || u.pn == Q0 / 256 + 1), rk = rope != nullptr && u.pm >= 1 && u.pn == K0 / 256;
#pragma unroll
        for (int ai = 0; ai < 2; ++ai)
#pragma unroll
            for (int m = 0; m < 4; ++m) { const int row = row0 + ai * HALF + m * 16; bf16_t* rowp = O + (size_t)row * ldc + col0;
#pragma unroll
                for (int bj = 0; bj < 2; ++bj) { f32x4 v0 = acc[ai][bj][m][0], v1 = acc[ai][bj][m][1];
                    if (sg) {
#pragma unroll
                        for (int q = 0; q < 4; ++q) { v0[q] = __builtin_amdgcn_rcpf(1.f + __expf(-v0[q])); v1[q] = __builtin_amdgcn_rcpf(1.f + __expf(-v1[q])); } }
                    if (rq || (rk && bj == 0)) {
                        const int t = row - NCTX, idx = (wc & 1) ? (t & 63) : (t >> 6);
                        const float* cp = rope + idx * 16 + 8 * (fq & 1);
                        const f32x4 c0 = *(const f32x4*)cp, c1 = *(const f32x4*)(cp + 4), s0 = *(const f32x4*)(cp + 4096), s1 = *(const f32x4*)(cp + 4100);
                        const float sgn = (fq & 2) ? 1.f : -1.f;
#pragma unroll
                        for (int q = 0; q < 4; ++q) { const float p0 = __shfl_xor(v0[q], 32), p1 = __shfl_xor(v1[q], 32);
                            v0[q] = v0[q] * c0[q] + sgn * p0 * s0[q]; v1[q] = v1[q] * c1[q] + sgn * p1 * s1[q]; } }
                    u32x4 w; w.x = cvt_pk_bf16(v0[0], v0[1]); w.y = cvt_pk_bf16(v0[2], v0[3]); w.z = cvt_pk_bf16(v1[0], v1[1]); w.w = cvt_pk_bf16(v1[2], v1[3]);
                    *(u32x4*)(rowp + bj * HALF) = w; } }
    }
};
struct EpiGlu {
    static constexpr bool PERM = true, AFTER_DRAIN = false, MIDHOOK = false;
    const bf16_t* A; const float* bias; bf16_t* O;
    __device__ __forceinline__ void operator()(const f32x4 (&acc)[2][2][4][2], const Unit& u, int wr, int wc, int fr, int fq) const {
        const int row0 = u.pm * BM + wr * 64 + fr, col0 = u.pn * BM + wc * 32 + 8 * fq;
#pragma unroll
        for (int ai = 0; ai < 2; ++ai)
#pragma unroll
            for (int m = 0; m < 4; ++m) { const size_t ro = (size_t)(row0 + ai * HALF + m * 16) * 512 + col0;
#pragma unroll
                for (int bj = 0; bj < 2; ++bj) { const f32x4 v0 = acc[ai][bj][m][0], v1 = acc[ai][bj][m][1];
                    const u32x4 a = *(const u32x4*)(A + ro + bj * HALF);
                    const f32x4 b0 = *(const f32x4*)(bias + col0 + bj * HALF), b1 = *(const f32x4*)(bias + col0 + bj * HALF + 4);
                    float o[8];
                    o[0] = bflo(a.x) * sigmoid_f(v0[0] + b0[0]); o[1] = bfhi(a.x) * sigmoid_f(v0[1] + b0[1]);
                    o[2] = bflo(a.y) * sigmoid_f(v0[2] + b0[2]); o[3] = bfhi(a.y) * sigmoid_f(v0[3] + b0[3]);
                    o[4] = bflo(a.z) * sigmoid_f(v1[0] + b1[0]); o[5] = bfhi(a.z) * sigmoid_f(v1[1] + b1[1]);
                    o[6] = bflo(a.w) * sigmoid_f(v1[2] + b1[2]); o[7] = bfhi(a.w) * sigmoid_f(v1[3] + b1[3]);
                    u32x4 w; w.x = cvt_pk_bf16(o[0], o[1]); w.y = cvt_pk_bf16(o[2], o[3]); w.z = cvt_pk_bf16(o[4], o[5]); w.w = cvt_pk_bf16(o[6], o[7]);
                    *(u32x4*)(O + (size_t)(row0 + ai * HALF + m * 16) * 1536 + col0 + bj * HALF) = w; } }
    }
};
struct RowOffOrder {
    StaticOrder b; int off;
    __device__ __forceinline__ void init(int M, int N, int G, int c, int off_) { b.init(M, N, G, c); off = off_; }
    __device__ __forceinline__ bool next(int i, Unit& u) const { if (!b.next(i, u)) return false; u.pm += off; return true; }
    __device__ __forceinline__ void a_ready(const Unit&) const {}
    __device__ __forceinline__ void done(const Unit&) const {}
};
struct EpiMerge {
    static constexpr bool PERM = true, AFTER_DRAIN = false, MIDHOOK = true;
    const bf16_t* proj; bf16_t* MB;
    __device__ __forceinline__ void mid(f32x4 (&acc)[2][2][4][2], const Unit& u, int seg, int wr, int wc, int fr, int fq) const {
        const unsigned base = (unsigned)((u.pm * BM + wr * 64 + fr) * PJ + GT0 + (seg - 1) * 1024 + u.pn * BM + wc * 32 + 8 * fq) * 2u;
        const char* pb = (const char*)proj;
#pragma unroll
        for (int ai = 0; ai < 2; ++ai)
#pragma unroll
            for (int m = 0; m < 4; ++m) {
                u32x4 ga[2], gb[2];
#pragma unroll
                for (int bj = 0; bj < 2; ++bj) { const unsigned o = base + (unsigned)(((ai * HALF + m * 16) * PJ + bj * HALF) * 2);
                    ga[bj] = *(const u32x4*)(pb + o); gb[bj] = *(const u32x4*)(pb + o + 2048u); }
#pragma unroll
                for (int bj = 0; bj < 2; ++bj) { const u32x4 a = ga[bj], b = gb[bj];
                    f32x4& v0 = acc[ai][bj][m][0]; f32x4& v1 = acc[ai][bj][m][1];
                    v0[0] *= bflo(a.x) * __builtin_amdgcn_rcpf(bflo(b.x)); v0[1] *= bfhi(a.x) * __builtin_amdgcn_rcpf(bfhi(b.x));
                    v0[2] *= bflo(a.y) * __builtin_amdgcn_rcpf(bflo(b.y)); v0[3] *= bfhi(a.y) * __builtin_amdgcn_rcpf(bfhi(b.y));
                    v1[0] *= bflo(a.z) * __builtin_amdgcn_rcpf(bflo(b.z)); v1[1] *= bfhi(a.z) * __builtin_amdgcn_rcpf(bfhi(b.z));
                    v1[2] *= bflo(a.w) * __builtin_amdgcn_rcpf(bflo(b.w)); v1[3] *= bfhi(a.w) * __builtin_amdgcn_rcpf(bfhi(b.w)); }
                if (m & 1) asm volatile("" ::: "memory");
            }
    }
    __device__ __forceinline__ void operator()(const f32x4 (&acc)[2][2][4][2], const Unit& u, int wr, int wc, int fr, int fq) const {
        const int row0 = u.pm * BM + wr * 64 + fr, col0 = u.pn * BM + wc * 32 + 8 * fq;
#pragma unroll
        for (int ai = 0; ai < 2; ++ai)
#pragma unroll
            for (int m = 0; m < 4; ++m) { const int row = row0 + ai * HALF + m * 16;
#pragma unroll
                for (int bj = 0; bj < 2; ++bj) { const f32x4 v0 = acc[ai][bj][m][0], v1 = acc[ai][bj][m][1]; const int col = col0 + bj * HALF;
                    const u32x4 g = *(const u32x4*)(proj + (size_t)row * PJ + GT0 + 2048 + col);
                    u32x4 w; w.x = cvt_pk_bf16(bflo(g.x) * v0[0], bfhi(g.x) * v0[1]); w.y = cvt_pk_bf16(bflo(g.y) * v0[2], bfhi(g.y) * v0[3]);
                    w.z = cvt_pk_bf16(bflo(g.z) * v1[0], bfhi(g.z) * v1[1]); w.w = cvt_pk_bf16(bflo(g.w) * v1[2], bfhi(g.w) * v1[3]);
                    *(u32x4*)(MB + (size_t)row * 1024 + col) = w; } }
    }
};
struct EpiResid {
    static constexpr bool PERM = false, AFTER_DRAIN = false, MIDHOOK = false;
    float* XL; float* XC; const float* g_lat; const float* g_ctx;
    __device__ __forceinline__ void operator()(const f32x4 (&acc)[2][2][4][2], const Unit& u, int wr, int wc, int fr, int fq) const {
        const bool isc = (u.pm == 0);
        float* base = isc ? XC : (XL - (size_t)NCTX * D); const float* gv = isc ? g_ctx : g_lat;
        const int row0 = u.pm * BM + wr * 64 + fr, col0 = u.pn * BM + wc * 32 + 4 * fq;
#pragma unroll
        for (int ai = 0; ai < 2; ++ai)
#pragma unroll
            for (int m = 0; m < 4; ++m) { float* rowp = base + (size_t)(row0 + ai * HALF + m * 16) * D + col0;
#pragma unroll
                for (int bj = 0; bj < 2; ++bj)
#pragma unroll
                    for (int n = 0; n < 2; ++n) { float* pp = rowp + bj * HALF + n * 16; const f32x4 g = *(const f32x4*)(gv + col0 + bj * HALF + n * 16);
                        f32x4 x = *(const f32x4*)pp; x += g * acc[ai][bj][m][n]; *(f32x4*)pp = x; } }
    }
};
struct ExpertOrder {
    int G, c, nnt, nmt;
    __device__ __forceinline__ bool next(int i, Unit& u) const { const int L = i * G + c; if (L >= NE * nmt * nnt) return false; const int e = L / (nmt * nnt), rem = L % (nmt * nnt); u.pm = e * 9 + rem % nmt; u.pn = e * nnt + rem / nmt; return true; }
    __device__ __forceinline__ void a_ready(const Unit&) const {}
    __device__ __forceinline__ void done(const Unit&) const {}
};
struct EpiSwiGlu {
    static constexpr bool PERM = true, AFTER_DRAIN = false, MIDHOOK = false;
    bf16_t* HID;
    __device__ __forceinline__ void operator()(const f32x4 (&acc)[2][2][4][2], const Unit& u, int wr, int wc, int fr, int fq) const {
        const int row0 = u.pm * BM + wr * 64 + fr, col0 = (u.pn & 7) * 128 + wc * 32 + 8 * fq;
#pragma unroll
        for (int ai = 0; ai < 2; ++ai)
#pragma unroll
            for (int m = 0; m < 4; ++m) { const f32x4 g0 = acc[ai][0][m][0], g1 = acc[ai][0][m][1], u0 = acc[ai][1][m][0], u1 = acc[ai][1][m][1];
                u32x4 w;
                w.x = cvt_pk_bf16(silu_f(g0[0]) * u0[0], silu_f(g0[1]) * u0[1]); w.y = cvt_pk_bf16(silu_f(g0[2]) * u0[2], silu_f(g0[3]) * u0[3]);
                w.z = cvt_pk_bf16(silu_f(g1[0]) * u1[0], silu_f(g1[1]) * u1[1]); w.w = cvt_pk_bf16(silu_f(g1[2]) * u1[2], silu_f(g1[3]) * u1[3]);
                *(u32x4*)(HID + (size_t)(row0 + ai * HALF + m * 16) * 1024 + col0) = w; }
    }
};
struct EpiDown {
    static constexpr bool PERM = true, AFTER_DRAIN = false, MIDHOOK = false;
    bf16_t* YE; const float* gsel;
    __device__ __forceinline__ void operator()(const f32x4 (&acc)[2][2][4][2], const Unit& u, int wr, int wc, int fr, int fq) const {
        const int row0 = u.pm * BM + wr * 64 + fr, col0 = (u.pn & 3) * BM + wc * 32 + 8 * fq;
#pragma unroll
        for (int ai = 0; ai < 2; ++ai)
#pragma unroll
            for (int m = 0; m < 4; ++m) { const int row = row0 + ai * HALF + m * 16; const float gs = gsel[row];
#pragma unroll
                for (int bj = 0; bj < 2; ++bj) { const f32x4 v0 = acc[ai][bj][m][0] * gs, v1 = acc[ai][bj][m][1] * gs;
                    u32x4 w; w.x = cvt_pk_bf16(v0[0], v0[1]); w.y = cvt_pk_bf16(v0[2], v0[3]); w.z = cvt_pk_bf16(v1[0], v1[1]); w.w = cvt_pk_bf16(v1[2], v1[3]);
                    *(u32x4*)(YE + (size_t)row * 1024 + col0 + bj * HALF) = w; } }
    }
};
}
#define XB_TMO      128
#define XB_XCNT(j)  (256  + 64 * (j))
#define XB_XSUB(j)  (1280 + 64 * (j))
#define XB_XGEN(j)  (2304 + 64 * (j))
#define XB_TOP      3328
#define XB_TOPGEN   3392
#define XCD_BAR_WORDS 3456
#define XB_SPIN_CAP (1u << 18)
#define LAS __attribute__((address_space(3)))

__device__ __forceinline__ unsigned xb_ld(unsigned* p)              { return __hip_atomic_load(p, __ATOMIC_RELAXED, __HIP_MEMORY_SCOPE_AGENT); }
__device__ __forceinline__ unsigned xb_add(unsigned* p, unsigned v) { return __hip_atomic_fetch_add(p, v, __ATOMIC_RELAXED, __HIP_MEMORY_SCOPE_AGENT); }
__device__ __forceinline__ unsigned xb_xcc_id() { return (unsigned)__builtin_amdgcn_s_getreg((3 << 11) | 20) & 0xFu; }
#define XB_SPIN(cond, bar) do { unsigned _sp = 0; while (cond) { __builtin_amdgcn_s_sleep(1); \
    if ((++_sp & 255u) == 0u) { if (xb_ld(&(bar)[XB_TMO])) break; if (_sp > XB_SPIN_CAP) { atomicAdd(&(bar)[XB_TMO], 1u); break; } } } } while (0)

struct XcdBarrier {
    unsigned* bar; unsigned x;
    volatile LAS unsigned* st;
};

__device__ __forceinline__ XcdBarrier xcd_barrier_post(unsigned* bar, volatile LAS unsigned* st) {
    XcdBarrier b; b.bar = bar; b.x = xb_xcc_id(); b.st = st;
    if (threadIdx.x == 0) (void)xb_add(&bar[XB_XCNT(b.x)], 1u);
    return b;
}
__device__ __forceinline__ void xcd_barrier_complete(unsigned* bar, unsigned x, unsigned& nloc, unsigned& nx) {
    const unsigned G = gridDim.x * gridDim.y * gridDim.z;
    unsigned sum, cnt, mine, sp = 0u;
    for (;;) {
        sum = 0u; cnt = 0u; mine = 0u;
#pragma unroll
        for (unsigned j = 0; j < 16; ++j) { const unsigned c = xb_ld(&bar[XB_XCNT(j)]); sum += c; cnt += (c > 0u) ? 1u : 0u; mine = (j == x) ? c : mine; }
        if (sum == G) break;
        __builtin_amdgcn_s_sleep(1);
        if ((++sp & 255u) == 0u) { if (xb_ld(&bar[XB_TMO])) break; if (sp > XB_SPIN_CAP) { atomicAdd(&bar[XB_TMO], 1u); break; } }
    }
    nloc = mine > 0u ? mine : 1u; nx = cnt > 0u ? cnt : 1u;
}

__device__ __forceinline__ void xcd_barrier(const XcdBarrier& b) {
    asm volatile("s_waitcnt vmcnt(0)" ::: "memory");
    __syncthreads();
    if (threadIdx.x == 0) {
        unsigned* bar = b.bar;
        __builtin_amdgcn_s_waitcnt(0);
        unsigned nloc = b.st[0], nx = b.st[1];
        if (nloc == 0u) { xcd_barrier_complete(bar, b.x, nloc, nx); b.st[0] = nloc; b.st[1] = nx; }
        const unsigned old = xb_add(&bar[XB_XSUB(b.x)], 1u);
        const unsigned gen = old / nloc;
        if (old + 1u == (gen + 1u) * nloc) {
            __builtin_amdgcn_fence(__ATOMIC_RELEASE, "agent");
            asm volatile("s_waitcnt vmcnt(0)" ::: "memory");
            const unsigned og = xb_add(&bar[XB_TOP], 1u);
            const unsigned tg = og / nx;
            if (og + 1u == (tg + 1u) * nx) xb_add(&bar[XB_TOPGEN], 1u);
            else XB_SPIN(xb_ld(&bar[XB_TOPGEN]) == tg, bar);
            __builtin_amdgcn_fence(__ATOMIC_ACQUIRE, "agent");
            xb_add(&bar[XB_XGEN(b.x)], 1u);
            asm volatile("s_waitcnt vmcnt(0)" ::: "memory");
        } else {
            XB_SPIN(xb_ld(&bar[XB_XGEN(b.x)]) == gen, bar);
            __builtin_amdgcn_fence(__ATOMIC_ACQUIRE, "agent");
            asm volatile("s_waitcnt vmcnt(0)" ::: "memory");
        }
    }
    __syncthreads();
}


struct P {
    const float *x, *c, *ctx, *c_ctx, *w_mod, *b_mod, *norm1_g, *norm2_g, *w_in, *lam_re, *lam_im, *log_dt, *b_re, *b_im, *c_re, *c_im, *s5_d, *w_glu, *b_glu,
        *conv_w, *conv_b, *a_log, *dt_bias, *ssd_d, *ssd_norm_g, *sink, *w_branch, *w_out, *w_router, *w_eg, *w_eu, *w_ed, *final_g;
    float* XL;
    float *MOD, *XC, *DT, *S5E, *S5H, *YD, *PM, *AFFT, *GSEL;
    bf16 *WIN, *WGLU, *WBR, *WOUT, *WUP, *WDN, *H, *PROJ, *XE, *HID, *CV, *SA, *Y3, *MB, *YE;
    int *IDX, *INV;
    int tid, lane, wave, bid, G;
};


constexpr int PTAB_OFF = LDS_BYTES - 1024;
__device__ __forceinline__ unsigned long long ld_tab(volatile LAS unsigned* t, int k) {
    const unsigned lo = __builtin_amdgcn_readfirstlane(t[2 * k]), hi = __builtin_amdgcn_readfirstlane(t[2 * k + 1]);
    return ((unsigned long long)hi << 32) | lo;
}
__device__ __forceinline__ void build_P(P& p, LAS unsigned char* lds) {
    int tid_l = threadIdx.x, bid_l = blockIdx.x, g_l = gridDim.x;
    asm volatile("" : "+v"(tid_l), "+s"(bid_l), "+s"(g_l));
    p.tid = tid_l; p.lane = p.tid & 63; p.wave = __builtin_amdgcn_readfirstlane(p.tid >> 6); p.bid = bid_l; p.G = g_l;
    unsigned tbase = (unsigned)(size_t)(lds + PTAB_OFF); asm volatile("" : "+v"(tbase));
    volatile LAS unsigned* tb = (volatile LAS unsigned*)(size_t)tbase;
#define INP(k) ((const float*)ld_tab(tb, k))
    p.x = INP(0); p.c = INP(1); p.ctx = INP(2); p.c_ctx = INP(3); p.w_mod = INP(4); p.b_mod = INP(5); p.norm1_g = INP(6); p.norm2_g = INP(7);
    p.w_in = INP(8); p.lam_re = INP(9); p.lam_im = INP(10); p.log_dt = INP(11); p.b_re = INP(12); p.b_im = INP(13); p.c_re = INP(14); p.c_im = INP(15);
    p.s5_d = INP(16); p.w_glu = INP(17); p.b_glu = INP(18); p.conv_w = INP(19); p.conv_b = INP(20); p.a_log = INP(21); p.dt_bias = INP(22); p.ssd_d = INP(23);
    p.ssd_norm_g = INP(24); p.sink = INP(25); p.w_branch = INP(26); p.w_out = INP(27); p.w_router = INP(28); p.w_eg = INP(29); p.w_eu = INP(30); p.w_ed = INP(31);
    p.final_g = INP(32);
#undef INP
    p.XL = (float*)ld_tab(tb, 33);
    unsigned char* ws = (unsigned char*)ld_tab(tb, 34);
    p.MOD = (float*)(ws + WS_MOD); p.XC = (float*)(ws + WS_XC); p.DT = (float*)(ws + WS_DT); p.S5E = (float*)(ws + WS_S5E); p.S5H = (float*)(ws + WS_S5H); p.YD = (float*)(ws + WS_YD);
    p.PM = (float*)(ws + WS_PM); p.AFFT = (float*)(ws + WS_AFFT); p.GSEL = (float*)(ws + WS_GSEL);
    p.WIN = (bf16*)(ws + WS_WIN); p.WGLU = (bf16*)(ws + WS_WGLU); p.WBR = (bf16*)(ws + WS_WBR); p.WOUT = (bf16*)(ws + WS_WOUT); p.WUP = (bf16*)(ws + WS_WUP); p.WDN = (bf16*)(ws + WS_WDN);
    p.H = (bf16*)(ws + WS_H); p.PROJ = (bf16*)(ws + WS_PROJ); p.XE = (bf16*)(ws + WS_XE); p.HID = (bf16*)(ws + WS_HID); p.CV = (bf16*)(ws + WS_CV); p.SA = (bf16*)(ws + WS_SA);
    p.Y3 = (bf16*)(ws + WS_Y3); p.MB = (bf16*)(ws + WS_MB); p.YE = (bf16*)(ws + WS_YE);
    p.IDX = (int*)(ws + WS_IDX); p.INV = (int*)(ws + WS_INV);
}
__device__ __forceinline__ void phase_mod(const P& p, LAS unsigned char* lds, float* ropet) {
    for (int i = p.bid * NTHR + p.tid; i < 256 * 16; i += p.G * NTHR) { const float inv = exp2f(-(float)(i & 15) * 0.83048202372184058696f);
        float sn, cs; sincosf((float)(i >> 4) * inv, &sn, &cs); ropet[i] = cs; ropet[4096 + i] = sn; }
    LAS float* sc = (LAS float*)lds;
    LAS float* part = sc + 2048;
    for (int i = p.tid; i < 1024; i += NTHR) { sc[i] = silu_f(p.c[i]); sc[1024 + i] = silu_f(p.c_ctx[i]); }
    __syncthreads();
    for (int it = p.bid; it < DEPTH * 48; it += p.G) {
        const int l = it / 48, cb = it % 48, c0 = cb * 128 + 2 * p.lane;
        const float* W = p.w_mod + (size_t)l * 1024 * 6144 + c0;
        float a00 = 0.f, a01 = 0.f, a10 = 0.f, a11 = 0.f;
        const int kb = p.wave * 128;
#pragma unroll 8
        for (int k = kb; k < kb + 128; ++k) { const float2 w = *(const float2*)(W + (size_t)k * 6144); const float s0 = sc[k], s1 = sc[1024 + k];
            a00 += s0 * w.x; a01 += s0 * w.y; a10 += s1 * w.x; a11 += s1 * w.y; }
        part[(p.wave * 2 + 0) * 128 + 2 * p.lane] = a00; part[(p.wave * 2 + 0) * 128 + 2 * p.lane + 1] = a01;
        part[(p.wave * 2 + 1) * 128 + 2 * p.lane] = a10; part[(p.wave * 2 + 1) * 128 + 2 * p.lane + 1] = a11;
        __syncthreads();
        if (p.tid < 256) { const int s = p.tid >> 7, col = p.tid & 127; float r = p.b_mod[l * 6144 + cb * 128 + col];
#pragma unroll
            for (int w = 0; w < 8; ++w) r += part[(w * 2 + s) * 128 + col];
            p.MOD[(size_t)(l * 2 + s) * 6144 + cb * 128 + col] = r; }
        __syncthreads();
    }
}

__device__ __forceinline__ void tr_item(const float* src, int ldw, int K, bf16* dst, int kb, LAS float* scr, int lane) {
    const int k0 = 64 * kb, kr = lane >> 4, nq = lane & 15;
    f32x4 v[16];
#pragma unroll
    for (int i = 0; i < 16; ++i) v[i] = *(const f32x4*)(src + (size_t)(k0 + 4 * i + kr) * ldw + 4 * nq);
#pragma unroll
    for (int i = 0; i < 16; ++i) { const int k = 4 * i + kr, c = (k >> 3) & 7; *(LAS f32x4*)(scr + k * 64 + 4 * (nq ^ c)) = v[i]; }
    LDS_FENCE();
    const int c = lane & 7;
#pragma unroll
    for (int j = 0; j < 8; ++j) { const int n = (lane >> 3) + 8 * j; const LAS float* s = scr + (8 * c) * 64 + (n ^ (c << 2));
        u32x4 o; o.x = pk2(s[0 * 64], s[1 * 64]); o.y = pk2(s[2 * 64], s[3 * 64]); o.z = pk2(s[4 * 64], s[5 * 64]); o.w = pk2(s[6 * 64], s[7 * 64]);
        *(u32x4*)(dst + (size_t)n * K + k0 + 8 * c) = o; }
    LDS_FENCE();
}
__device__ __forceinline__ void convert_weights(const P& p, int l, LAS unsigned char* lds) {
    LAS float* scr = (LAS float*)(lds + p.wave * 16384);
    const int gw = p.bid * NWAVES + p.wave, NGW = p.G * NWAVES;
    constexpr int I_A = 32 * 16, I_B = 60 * 16, I_GLU = 8 * 8, I_BR = 3 * 16 * 8, I_OUT = 16 * 16, I_E = 16 * 16 * 16;
    constexpr int NIT = I_A + I_B + I_GLU + I_BR + I_OUT + 3 * I_E;
    const float* win = p.w_in + (size_t)l * 1024 * IN_W;
    for (int it = gw; it < NIT; it += NGW) {
        int r = it;
        if (r < I_A) { const int nb = r >> 4, kb = r & 15; tr_item(win + 64 * nb, IN_W, 1024, p.WIN + (size_t)(64 * nb) * 1024, kb, scr, p.lane); continue; } r -= I_A;
        if (r < I_B) { const int nb = r >> 4, kb = r & 15; tr_item(win + 2064 + 64 * nb, IN_W, 1024, p.WIN + (size_t)(2048 + 64 * nb) * 1024, kb, scr, p.lane); continue; } r -= I_B;
        if (r < I_GLU) { const int nb = r >> 3, kb = r & 7; tr_item(p.w_glu + (size_t)l * 512 * 512 + 64 * nb, 512, 512, p.WGLU + (size_t)(64 * nb) * 512, kb, scr, p.lane); continue; } r -= I_GLU;
        if (r < I_BR) { const int kk = r >> 7, nb = (r >> 3) & 15, kb = r & 7;
            tr_item(p.w_branch + ((size_t)l * 3 + kk) * 512 * 1024 + 64 * nb, 1024, 1536, p.WBR + (size_t)(64 * nb) * 1536 + kk * 512, kb, scr, p.lane); continue; } r -= I_BR;
        if (r < I_OUT) { const int nb = r >> 4, kb = r & 15; tr_item(p.w_out + (size_t)l * 1024 * 1024 + 64 * nb, 1024, 1024, p.WOUT + (size_t)(64 * nb) * 1024, kb, scr, p.lane); continue; } r -= I_OUT;
        const int which = r / I_E; r -= which * I_E;
        const int e = r >> 8, nb = (r >> 4) & 15, kb = r & 15;
        const size_t eo = ((size_t)l * NE + e) * 1024 * 1024;
        if (which == 0) tr_item(p.w_eg + eo + 64 * nb, 1024, 1024, p.WUP + (size_t)(e * 2048 + 256 * (nb >> 1) + 64 * (nb & 1)) * 1024, kb, scr, p.lane);
        else if (which == 1) tr_item(p.w_eu + eo + 64 * nb, 1024, 1024, p.WUP + (size_t)(e * 2048 + 256 * (nb >> 1) + 128 + 64 * (nb & 1)) * 1024, kb, scr, p.lane);
        else tr_item(p.w_ed + eo + 64 * nb, 1024, 1024, p.WDN + (size_t)(e * 1024 + 64 * nb) * 1024, kb, scr, p.lane);
    }
}

__device__ __forceinline__ float reduce16(float (&a)[16], int lane) {
    float b[8], c[4], d[2];
#pragma unroll
    for (int j = 0; j < 8; ++j) { const bool hi = lane & 32; const float send = hi ? a[j] : a[j + 8], keep = hi ? a[j + 8] : a[j]; b[j] = keep + __shfl_xor(send, 32); }
#pragma unroll
    for (int j = 0; j < 4; ++j) { const bool hi = lane & 16; const float send = hi ? b[j] : b[j + 4], keep = hi ? b[j + 4] : b[j]; c[j] = keep + __shfl_xor(send, 16); }
#pragma unroll
    for (int j = 0; j < 2; ++j) { const bool hi = lane & 8; const float send = hi ? c[j] : c[j + 2], keep = hi ? c[j + 2] : c[j]; d[j] = keep + __shfl_xor(send, 8); }
    const bool hi = lane & 4; const float send = hi ? d[0] : d[1], keep = hi ? d[1] : d[0];
    float r = keep + __shfl_xor(send, 4);
    r += __shfl_xor(r, 2); r += __shfl_xor(r, 1);
    return r;
}
template <int MODE> __device__ __forceinline__ void row_pass(const P& p, int l, LAS unsigned char* lds, bool with_ctx = true) {
    LAS float* W16 = (LAS float*)lds;
    if (MODE != 2) {
        const float* src = (MODE == 0) ? (p.w_in + (size_t)l * 1024 * IN_W + 2048) : (p.w_router + (size_t)l * 1024 * 16);
        const int ld = (MODE == 0) ? IN_W : 16;
        for (int i = p.tid; i < 1024 * 16; i += NTHR) { const int k = i >> 4, j = i & 15; const int rr = (k & 7) * 128 + ((k >> 3) & 63) + 64 * (k >> 9); W16[rr * 20 + j] = src[(size_t)k * ld + j]; }
        __syncthreads();
    }
    const int gw = p.bid * NWAVES + p.wave, NGW = p.G * NWAVES, lane = p.lane;
    for (int row = gw + ((MODE == 2 || !with_ctx) ? NCTX : 0); row < T; row += NGW) {
        const bool isc = row < NCTX;
        float* xrow = isc ? (p.XC + (size_t)row * D) : (p.XL + (size_t)(row - NCTX) * D);
        float v[16];
        { const float* s = (MODE == 0 && l == 0) ? (isc ? (p.ctx + (size_t)row * D) : (p.x + (size_t)(row - NCTX) * D)) : xrow;
#pragma unroll
          for (int i = 0; i < 2; ++i) { const f32x4 a = *(const f32x4*)(s + 512 * i + 8 * lane), b = *(const f32x4*)(s + 512 * i + 8 * lane + 4);
              v[8 * i] = a[0]; v[8 * i + 1] = a[1]; v[8 * i + 2] = a[2]; v[8 * i + 3] = a[3]; v[8 * i + 4] = b[0]; v[8 * i + 5] = b[1]; v[8 * i + 6] = b[2]; v[8 * i + 7] = b[3]; } }
        if ((MODE == 0 && l > 0) || MODE == 2) {
            const int lp = (MODE == 2) ? (DEPTH - 1) : (l - 1);
            const float* g2 = p.MOD + (size_t)(lp * 2 + (isc ? 1 : 0)) * 6144 + 5 * D;
            float s[16];
#pragma unroll
            for (int i = 0; i < 16; ++i) s[i] = 0.f;
            for (int e = 0; e < NE; ++e) { const int slot = p.INV[(size_t)row * 16 + e];
                if (slot >= 0) { const bf16* yr = p.YE + ((size_t)e * ESLOTS + slot) * D;
#pragma unroll
                    for (int i = 0; i < 2; ++i) { const u32x4 w = *(const u32x4*)(yr + 512 * i + 8 * lane);
                        s[8 * i] += bflo(w.x); s[8 * i + 1] += bfhi(w.x); s[8 * i + 2] += bflo(w.y); s[8 * i + 3] += bfhi(w.y);
                        s[8 * i + 4] += bflo(w.z); s[8 * i + 5] += bfhi(w.z); s[8 * i + 6] += bflo(w.w); s[8 * i + 7] += bfhi(w.w); } } }
#pragma unroll
            for (int i = 0; i < 2; ++i) { const f32x4 a = *(const f32x4*)(g2 + 512 * i + 8 * lane), b = *(const f32x4*)(g2 + 512 * i + 8 * lane + 4);
#pragma unroll
                for (int q = 0; q < 4; ++q) { v[8 * i + q] += a[q] * s[8 * i + q]; v[8 * i + 4 + q] += b[q] * s[8 * i + 4 + q]; } }
        }
        if (MODE == 0) {
#pragma unroll
            for (int i = 0; i < 2; ++i) { *(f32x4*)(xrow + 512 * i + 8 * lane) = (f32x4){v[8 * i], v[8 * i + 1], v[8 * i + 2], v[8 * i + 3]};
                *(f32x4*)(xrow + 512 * i + 8 * lane + 4) = (f32x4){v[8 * i + 4], v[8 * i + 5], v[8 * i + 6], v[8 * i + 7]}; }
        }
        float ss = 0.f;
#pragma unroll
        for (int i = 0; i < 16; ++i) ss += v[i] * v[i];
        const float rstd = rsqrtf(wsum(ss) * (1.f / D) + EPS);
        if (MODE == 2) {
#pragma unroll
            for (int i = 0; i < 2; ++i) { const f32x4 a = *(const f32x4*)(p.final_g + 512 * i + 8 * lane), b = *(const f32x4*)(p.final_g + 512 * i + 8 * lane + 4);
                *(f32x4*)(xrow + 512 * i + 8 * lane) = (f32x4){v[8 * i] * rstd * a[0], v[8 * i + 1] * rstd * a[1], v[8 * i + 2] * rstd * a[2], v[8 * i + 3] * rstd * a[3]};
                *(f32x4*)(xrow + 512 * i + 8 * lane + 4) = (f32x4){v[8 * i + 4] * rstd * b[0], v[8 * i + 5] * rstd * b[1], v[8 * i + 6] * rstd * b[2], v[8 * i + 7] * rstd * b[3]}; }
            continue;
        }
        const float* gam = (MODE == 0 ? p.norm1_g : p.norm2_g) + (size_t)l * D;
        const float* md = p.MOD + (size_t)(l * 2 + (isc ? 1 : 0)) * 6144 + (MODE == 0 ? 0 : 3 * D);
        bf16* hrow = p.H + (size_t)row * D;
        float acc[16];
#pragma unroll
        for (int j = 0; j < 16; ++j) acc[j] = 0.f;
#pragma unroll
        for (int i = 0; i < 2; ++i) {
            float hv[8];
            { const int k0 = 512 * i + 8 * lane;
              const f32x4 ga = *(const f32x4*)(gam + k0), gb = *(const f32x4*)(gam + k0 + 4), sa = *(const f32x4*)(md + D + k0), sb = *(const f32x4*)(md + D + k0 + 4), ha = *(const f32x4*)(md + k0), hb = *(const f32x4*)(md + k0 + 4);
#pragma unroll
              for (int q = 0; q < 4; ++q) { hv[q] = v[8 * i + q] * rstd * ga[q] * (1.f + sa[q]) + ha[q]; hv[4 + q] = v[8 * i + 4 + q] * rstd * gb[q] * (1.f + sb[q]) + hb[q]; }
              u32x4 o; o.x = pk2(hv[0], hv[1]); o.y = pk2(hv[2], hv[3]); o.z = pk2(hv[4], hv[5]); o.w = pk2(hv[6], hv[7]);
              *(u32x4*)(hrow + k0) = o; }
#pragma unroll
            for (int j = 0; j < 8; ++j) { const LAS f32x4* wr = (const LAS f32x4*)(W16 + (j * 128 + lane + 64 * i) * 20);
                const f32x4 w0 = wr[0], w1 = wr[1], w2 = wr[2], w3 = wr[3]; const float h = hv[j];
                acc[0] += h * w0[0]; acc[1] += h * w0[1]; acc[2] += h * w0[2]; acc[3] += h * w0[3];
                acc[4] += h * w1[0]; acc[5] += h * w1[1]; acc[6] += h * w1[2]; acc[7] += h * w1[3];
                acc[8] += h * w2[0]; acc[9] += h * w2[1]; acc[10] += h * w2[2]; acc[11] += h * w2[3];
                acc[12] += h * w3[0]; acc[13] += h * w3[1]; acc[14] += h * w3[2]; acc[15] += h * w3[3];
                if (j & 1) asm volatile("" ::: "memory"); }
        }
        const float tot = reduce16(acc, lane);
        const int col = ((lane >> 5) & 1) * 8 + ((lane >> 4) & 1) * 4 + ((lane >> 3) & 1) * 2 + ((lane >> 2) & 1);
        if (MODE == 0) {
            if ((lane & 3) == 0) p.DT[(size_t)row * 16 + col] = softplus_f(tot + p.dt_bias[l * 16 + col]);
        } else {
            float mx = tot;
            mx = fmaxf(mx, __shfl_xor(mx, 4)); mx = fmaxf(mx, __shfl_xor(mx, 8)); mx = fmaxf(mx, __shfl_xor(mx, 16)); mx = fmaxf(mx, __shfl_xor(mx, 32));
            const float e = expf(tot - mx); float sum = e;
            sum += __shfl_xor(sum, 4); sum += __shfl_xor(sum, 8); sum += __shfl_xor(sum, 16); sum += __shfl_xor(sum, 32);
            if ((lane & 3) == 0) p.AFFT[(size_t)col * T + row] = e / sum;
        }
    }
}

struct S5Lane { float abr, abi; float bbr[16], bbi[16]; };
__device__ __forceinline__ void s5_lane_params(const P& p, int l, int d, int g, int lane, S5Lane& o, bool withB) {
    const size_t gi = ((size_t)(l * 2 + d) * 32 + g);
    const float lr = p.lam_re[gi * 64 + lane], li = p.lam_im[gi * 64 + lane], dt = expf(p.log_dt[gi]);
    const float mag = expf(lr * dt); float sn, cs; sincosf(li * dt, &sn, &cs);
    o.abr = mag * cs; o.abi = mag * sn;
    if (withB) {
        const float den = lr * lr + li * li;
        const float fr = ((o.abr - 1.f) * lr + o.abi * li) / den, fi = (o.abi * lr - (o.abr - 1.f) * li) / den;
        const f32x4* br = (const f32x4*)(p.b_re + (gi * 64 + lane) * 16); const f32x4* bi = (const f32x4*)(p.b_im + (gi * 64 + lane) * 16);
#pragma unroll
        for (int q = 0; q < 4; ++q) { const f32x4 r4 = br[q], i4 = bi[q];
#pragma unroll
            for (int j = 0; j < 4; ++j) { o.bbr[4 * q + j] = fr * r4[j] - fi * i4[j]; o.bbi[4 * q + j] = fr * i4[j] + fi * r4[j]; } }
    }
}
__device__ __forceinline__ void s5_stage_u(const P& p, int r0, int g, LAS unsigned char* ub, int lane) {
#pragma unroll
    for (int j = 0; j < 4; ++j) { const int q = lane + 64 * j, i = q >> 1, half = q & 1;
        const u32x4 w = *(const u32x4*)(p.PROJ + (size_t)(r0 + i) * PJ + U0 + g * 16 + half * 8);
        *(LAS u32x4*)(ub + i * 32 + half * 16) = w; }
    LDS_FENCE();
}
__device__ __forceinline__ void s5_step(const S5Lane& s, const LAS unsigned char* ub, int i, float& hr, float& hi) {
    const u32x4 a = *(const LAS u32x4*)(ub + i * 32), b = *(const LAS u32x4*)(ub + i * 32 + 16);
    float u[16];
    u[0] = bflo(a.x); u[1] = bfhi(a.x); u[2] = bflo(a.y); u[3] = bfhi(a.y); u[4] = bflo(a.z); u[5] = bfhi(a.z); u[6] = bflo(a.w); u[7] = bfhi(a.w);
    u[8] = bflo(b.x); u[9] = bfhi(b.x); u[10] = bflo(b.y); u[11] = bfhi(b.y); u[12] = bflo(b.z); u[13] = bfhi(b.z); u[14] = bflo(b.w); u[15] = bfhi(b.w);
    float br = 0.f, bi = 0.f;
#pragma unroll
    for (int k = 0; k < 16; ++k) { br += s.bbr[k] * u[k]; bi += s.bbi[k] * u[k]; }
    const float nr = s.abr * hr - s.abi * hi + br, ni = s.abr * hi + s.abi * hr + bi;
    hr = nr; hi = ni;
}

__device__ __forceinline__ void phase_premix(const P& p, int l, LAS unsigned char* lds) {
    const float* cw = p.conv_w + (size_t)l * 5 * 1024; const float* cb = p.conv_b + (size_t)l * 1024;
    for (int idx = p.bid * NTHR + p.tid; idx < T * 128; idx += p.G * NTHR) {
        const int row = idx >> 7, c8 = (idx & 127) * 8;
        const int lo = row < NCTX ? 0 : NCTX, hi = row < NCTX ? NCTX : T;
        float a[8];
        { const f32x4 b0 = *(const f32x4*)(cb + c8), b1 = *(const f32x4*)(cb + c8 + 4);
          a[0] = b0[0]; a[1] = b0[1]; a[2] = b0[2]; a[3] = b0[3]; a[4] = b1[0]; a[5] = b1[1]; a[6] = b1[2]; a[7] = b1[3]; }
#pragma unroll
        for (int j = 0; j < 5; ++j) { const int r = row + j - 2;
            if (r >= lo && r < hi) { const u32x4 xv = *(const u32x4*)(p.PROJ + (size_t)r * PJ + XB0 + c8);
                const f32x4 w0 = *(const f32x4*)(cw + j * 1024 + c8), w1 = *(const f32x4*)(cw + j * 1024 + c8 + 4);
                a[0] += w0[0] * bflo(xv.x); a[1] += w0[1] * bfhi(xv.x); a[2] += w0[2] * bflo(xv.y); a[3] += w0[3] * bfhi(xv.y);
                a[4] += w1[0] * bflo(xv.z); a[5] += w1[1] * bfhi(xv.z); a[6] += w1[2] * bflo(xv.w); a[7] += w1[3] * bfhi(xv.w); } }
        u32x4 o; o.x = pk2(silu_f(a[0]), silu_f(a[1])); o.y = pk2(silu_f(a[2]), silu_f(a[3])); o.z = pk2(silu_f(a[4]), silu_f(a[5])); o.w = pk2(silu_f(a[6]), silu_f(a[7]));
        *(u32x4*)(p.CV + (size_t)row * 1024 + c8) = o;
    }

}

__device__ __forceinline__ void ssd_scan_naive(const P& p, int l) {
    for (int it = p.bid * 4 + p.wave; it < 1024; it += p.G * 4) {
        const int d = it >> 9, hd = (it >> 6) & 7, pp = it & 63, grp = hd >> 2;
        const float a = -expf(p.a_log[l * 16 + d * 8 + hd]);
        const int colB = 512 + grp * 128 + p.lane, colC = 768 + grp * 128 + p.lane, colX = hd * 64 + pp, dcol = d * 8 + hd;
        float h0 = 0.f, h1 = 0.f;
        for (int s0 = 0; s0 < T; s0 += 8) {
            unsigned b0[8], b1[8], c0[8], c1[8], xx[8]; float dtv[8]; int rr[8];
#pragma unroll
            for (int j = 0; j < 8; ++j) { const int r = scan_row(d, s0 + j); rr[j] = r; const bf16* cv = p.CV + (size_t)r * 1024;
                b0[j] = cv[colB]; b1[j] = cv[colB + 64]; c0[j] = cv[colC]; c1[j] = cv[colC + 64]; xx[j] = cv[colX]; dtv[j] = p.DT[(size_t)r * 16 + dcol]; }
#pragma unroll
            for (int j = 0; j < 8; ++j) { const float dec = expf(dtv[j] * a), dx = dtv[j] * bf2f(xx[j]);
                h0 = dec * h0 + dx * bf2f(b0[j]); h1 = dec * h1 + dx * bf2f(b1[j]);
                const float y = wsum(bf2f(c0[j]) * h0 + bf2f(c1[j]) * h1);
                if (p.lane == 0) p.YD[((size_t)d * T + rr[j]) * 512 + colX] = y; }
        }
    }
}
__device__ __forceinline__ void s5_carry_scan(const P& p, int l, int aw, int NAW) {
    for (int it = aw; it < 64; it += NAW) {
        const int d = it >> 5, g = it & 31;
        S5Lane s; s5_lane_params(p, l, d, g, p.lane, s, false);
        float ar = s.abr, ai = s.abi;
#pragma unroll
        for (int q = 0; q < 7; ++q) { const float nr = ar * ar - ai * ai, ni = 2.f * ar * ai; ar = nr; ai = ni; }
        float hr = 0.f, hi = 0.f;
        const float* E = p.S5E + (size_t)(d * 32 + g) * NCH * 128; float* Hn = p.S5H + (size_t)(d * 32 + g) * NCH * 128;
        for (int c = 0; c < NCH; ++c) { Hn[c * 128 + p.lane] = hr; Hn[c * 128 + 64 + p.lane] = hi;
            const float er = E[c * 128 + p.lane], ei = E[c * 128 + 64 + p.lane];
            const float nr = ar * hr - ai * hi + er, ni = ar * hi + ai * hr + ei; hr = nr; hi = ni; }
    }
}
__device__ __forceinline__ void attention_naive(const P& p, int l, int aw, int NAW, LAS float* pbuf) {
    const int lane = p.lane;
    for (int it = aw; it < T * 8; it += NAW) {
        const int row = it >> 3, hq = it & 7, kvh = hq >> 2;
        const bool isc = row < NCTX; const int t = row - NCTX;
        const int jlo = isc ? 0 : (t - 128 < 0 ? 0 : t - 128), jhi = isc ? -1 : (t + 128 > NLAT - 1 ? NLAT - 1 : t + 128);
        const int nloc = jhi - jlo + 1, nk = nloc + NCTX;
        const float sink = p.sink[l * 8 + hq];
        float q[64];
        { const u32x4* qp = (const u32x4*)(p.PROJ + (size_t)row * PJ + Q0 + hq * 64);
#pragma unroll
          for (int c = 0; c < 8; ++c) { const u32x4 w = qp[c]; q[8 * c] = bflo(w.x); q[8 * c + 1] = bfhi(w.x); q[8 * c + 2] = bflo(w.y); q[8 * c + 3] = bfhi(w.y);
              q[8 * c + 4] = bflo(w.z); q[8 * c + 5] = bfhi(w.z); q[8 * c + 6] = bflo(w.w); q[8 * c + 7] = bfhi(w.w); } }
        float sc[9]; float mx = sink;
#pragma unroll
        for (int i = 0; i < 9; ++i) { const int kk = lane + 64 * i; float s = -INFINITY;
            if (kk < nk) { const int krow = kk < nloc ? NCTX + jlo + kk : kk - nloc;
                const u32x4* kp = (const u32x4*)(p.PROJ + (size_t)krow * PJ + K0 + kvh * 64); float dot = 0.f;
#pragma unroll
                for (int c = 0; c < 8; ++c) { const u32x4 w = kp[c];
                    dot += q[8 * c] * bflo(w.x) + q[8 * c + 1] * bfhi(w.x) + q[8 * c + 2] * bflo(w.y) + q[8 * c + 3] * bfhi(w.y)
                         + q[8 * c + 4] * bflo(w.z) + q[8 * c + 5] * bfhi(w.z) + q[8 * c + 6] * bflo(w.w) + q[8 * c + 7] * bfhi(w.w); }
                s = dot * 0.125f; }
            sc[i] = s; mx = fmaxf(mx, s); }
        mx = wmaxf(mx);
        float sum = 0.f;
#pragma unroll
        for (int i = 0; i < 9; ++i) { const int kk = lane + 64 * i; const float e = (kk < nk) ? expf(sc[i] - mx) : 0.f; pbuf[kk] = e; sum += e; }
        const float den = wsum(sum) + expf(sink - mx);
        LDS_FENCE();
        float o = 0.f;
        const bf16* vb = p.PROJ + V0 + kvh * 64 + lane;
#pragma unroll 4
        for (int kk = 0; kk < nk; ++kk) { const int vrow = kk < nloc ? NCTX + jlo + kk : kk - nloc; o += pbuf[kk] * bf2f(vb[(size_t)vrow * PJ]); }
        p.Y3[((size_t)2 * T + row) * 512 + hq * 64 + lane] = (bf16)f2bf(o / den);
        LDS_FENCE();
    }
}

__device__ __forceinline__ void phase_postmix(const P& p, int l, LAS unsigned char* lds) {
    constexpr int CSH_BYTES = 2 * 2 * 16 * 68 * 4, WREG = 16640;
    LAS float* Csh = (LAS float*)lds;
    LAS unsigned char* wreg = lds + CSH_BYTES + p.wave * WREG;
    LAS unsigned char* ub = wreg;
    LAS float* Hb = (LAS float*)(wreg + 4096);
    LAS float* Yb = (LAS float*)(wreg + 4096 + 4224);
    const int lane = p.lane;
    for (int it = p.bid; it < 32 * 17; it += p.G) {
        const int g = it / 17, chunk = (it % 17) * 8 + p.wave;
        __syncthreads();
        for (int i = p.tid; i < 2 * 2 * 16 * 64; i += NTHR) { const int pq = i & 63, k = (i >> 6) & 15, ri = (i >> 10) & 1, d = i >> 11;
            const float* src = ri ? p.c_im : p.c_re; Csh[((d * 2 + ri) * 16 + k) * 68 + pq] = src[(((size_t)(l * 2 + d) * 32 + g) * 16 + k) * 64 + pq]; }
        __syncthreads();
        if (chunk < NCH) {
            const int r0 = 128 * chunk;
            s5_stage_u(p, r0, g, ub, lane);
            for (int d = 0; d < 2; ++d) {
                S5Lane s; s5_lane_params(p, l, d, g, lane, s, true);
                const int cs = (d == 0) ? chunk : (chunk < 2 ? 1 - chunk : NCH + 1 - chunk);
                const float* Hn = p.S5H + ((size_t)(d * 32 + g) * NCH + cs) * 128;
                float hr = Hn[lane], hi = Hn[64 + lane];
                const LAS float* Cr = Csh + (d * 2 + 0) * 16 * 68; const LAS float* Ci = Csh + (d * 2 + 1) * 16 * 68;
                for (int sub = 0; sub < 16; ++sub) {
#pragma unroll
                    for (int j = 0; j < 8; ++j) { const int is = sub * 8 + j; s5_step(s, ub, d == 0 ? is : 127 - is, hr, hi); Hb[j * 132 + lane] = hr; Hb[j * 132 + 64 + lane] = hi; }
                    LDS_FENCE();
#pragma unroll
                    for (int m = 0; m < 2; ++m) { const int o = lane + 64 * m, j = o >> 4, k = o & 15; float y = 0.f;
#pragma unroll
                        for (int q = 0; q < 16; ++q) { const f32x4 cr = *(const LAS f32x4*)(Cr + k * 68 + 4 * q), ci = *(const LAS f32x4*)(Ci + k * 68 + 4 * q);
                            const f32x4 xr = *(const LAS f32x4*)(Hb + j * 132 + 4 * q), xi = *(const LAS f32x4*)(Hb + j * 132 + 64 + 4 * q);
                            y += cr[0] * xr[0] + cr[1] * xr[1] + cr[2] * xr[2] + cr[3] * xr[3] - ci[0] * xi[0] - ci[1] * xi[1] - ci[2] * xi[2] - ci[3] * xi[3]; }
                        const int is = sub * 8 + j, i = (d == 0) ? is : 127 - is;
                        if (d == 0) Yb[i * 16 + k] = y; else Yb[i * 16 + k] += y; }
                    LDS_FENCE();
                }
            }
            const float* dsk = p.s5_d + (size_t)l * 512 + g * 16;
#pragma unroll
            for (int m = 0; m < 2; ++m) { const int i = lane + 64 * m;
                const u32x4 ua = *(const LAS u32x4*)(ub + i * 32), ubv = *(const LAS u32x4*)(ub + i * 32 + 16);
                float u[16];
                u[0] = bflo(ua.x); u[1] = bfhi(ua.x); u[2] = bflo(ua.y); u[3] = bfhi(ua.y); u[4] = bflo(ua.z); u[5] = bfhi(ua.z); u[6] = bflo(ua.w); u[7] = bfhi(ua.w);
                u[8] = bflo(ubv.x); u[9] = bfhi(ubv.x); u[10] = bflo(ubv.y); u[11] = bfhi(ubv.y); u[12] = bflo(ubv.z); u[13] = bfhi(ubv.z); u[14] = bflo(ubv.w); u[15] = bfhi(ubv.w);
                float a[16];
#pragma unroll
                for (int k = 0; k < 16; ++k) a[k] = gelu_tanh_f(Yb[i * 16 + k] + dsk[k] * u[k]);
                u32x4 o0, o1; o0.x = pk2(a[0], a[1]); o0.y = pk2(a[2], a[3]); o0.z = pk2(a[4], a[5]); o0.w = pk2(a[6], a[7]);
                o1.x = pk2(a[8], a[9]); o1.y = pk2(a[10], a[11]); o1.z = pk2(a[12], a[13]); o1.w = pk2(a[14], a[15]);
                bf16* dst = p.SA + (size_t)(r0 + i) * 512 + g * 16;
                *(u32x4*)dst = o0; *(u32x4*)(dst + 8) = o1; }
            LDS_FENCE();
        }
    }
}

__device__ __forceinline__ void phase_select(const P& p, LAS unsigned char* lds, bool with_ctx) {
    LAS unsigned* keys = (LAS unsigned*)lds;
    LAS unsigned* hist = keys + 16384;
    LAS unsigned* misc = hist + 256;
    const int tid = p.tid, lane = p.lane, wave = p.wave;
    for (int it = p.bid; it < (with_ctx ? 32 : 16); it += p.G) {
        const int set = it >> 4, e = it & 15;
        const int n = set ? NCTX : NLAT, cap = set ? CAP_C : CAP_L, row0 = set ? 0 : NCTX, slot0 = set ? CAP_L : 0;
        const float* src = p.AFFT + (size_t)e * T + row0;
        __syncthreads();
        for (int i = tid; i < n; i += NTHR) keys[i] = __float_as_uint(src[i]);
        unsigned prefix = 0u, mask = 0u, need = (unsigned)cap;
        for (int pass = 3; pass >= 0; --pass) {
            if (tid < 256) hist[tid] = 0u;
            __syncthreads();
            for (int i = tid; i < n; i += NTHR) { const unsigned k = keys[i]; if ((k & mask) == prefix) __hip_atomic_fetch_add(&hist[(k >> (8 * pass)) & 255u], 1u, __ATOMIC_RELAXED, __HIP_MEMORY_SCOPE_WORKGROUP); }
            __syncthreads();
            if (wave == 0) {
                const unsigned h0 = hist[4 * lane], h1 = hist[4 * lane + 1], h2 = hist[4 * lane + 2], h3 = hist[4 * lane + 3];
                const unsigned c = h0 + h1 + h2 + h3; unsigned S = c;
#pragma unroll
                for (int o = 1; o < 64; o <<= 1) { const unsigned t = __shfl_down(S, o); if (lane + o < 64) S += t; }
                const unsigned Snext = S - c;
                if (S >= need && Snext < need) { unsigned rem = need - Snext; unsigned bin;
                    if (h3 >= rem) bin = 3; else { rem -= h3; if (h2 >= rem) bin = 2; else { rem -= h2; if (h1 >= rem) bin = 1; else { rem -= h1; bin = 0; } } }
                    misc[0] = 4 * lane + bin; misc[1] = rem; }
            }
            __syncthreads();
            prefix |= misc[0] << (8 * pass); mask |= 0xFFu << (8 * pass); need = misc[1];
            __syncthreads();
        }
        unsigned selbase = 0u, eqbase = 0u;
        for (int base = 0; base < n; base += NTHR) {
            const int i = base + tid; const bool valid = i < n; const unsigned k = valid ? keys[i] : 0u;
            const bool eq = valid && k == prefix, gt = valid && k > prefix;
            const unsigned long long lt = (1ull << lane) - 1ull;
            const unsigned long long be = __ballot(eq);
            if (lane == 0) misc[8 + wave] = (unsigned)__popcll(be);
            __syncthreads();
            unsigned woff = 0u, tot = 0u;
#pragma unroll
            for (int w = 0; w < 8; ++w) { const unsigned v = misc[8 + w]; woff += (w < wave) ? v : 0u; tot += v; }
            const unsigned eqrank = eqbase + woff + (unsigned)__popcll(be & lt);
            const bool sel = gt || (eq && eqrank < need);
            const unsigned long long bs = __ballot(sel);
            if (lane == 0) misc[16 + wave] = (unsigned)__popcll(bs);
            __syncthreads();
            unsigned woff2 = 0u, tot2 = 0u;
#pragma unroll
            for (int w = 0; w < 8; ++w) { const unsigned v = misc[16 + w]; woff2 += (w < wave) ? v : 0u; tot2 += v; }
            if (valid) { const int row = row0 + i;
                if (sel) { const int slot = slot0 + (int)(selbase + woff2 + (unsigned)__popcll(bs & lt));
                    p.IDX[e * ESLOTS + slot] = row; p.GSEL[e * ESLOTS + slot] = __uint_as_float(k); p.INV[(size_t)row * 16 + e] = slot; }
                else p.INV[(size_t)row * 16 + e] = -1; }
            selbase += tot2; eqbase += tot;
            __syncthreads();
        }
    }
}
__device__ __forceinline__ void phase_gather(const P& p, bool with_ctx) {
    const int gw = p.bid * NWAVES + p.wave, NGW = p.G * NWAVES, lane = p.lane;
    for (int idx = gw; idx < NE * ESLOTS; idx += NGW) {
        const int slot = idx % ESLOTS; const bool valid = slot < CAP_L + (with_ctx ? CAP_C : 0);
        u32x4 a = (u32x4){0u, 0u, 0u, 0u}, b = a;
        if (valid) { const int row = p.IDX[idx]; const u32x4* s = (const u32x4*)(p.H + (size_t)row * D); a = s[lane]; b = s[64 + lane]; }
        else if (lane == 0) p.GSEL[idx] = 0.f;
        u32x4* dst = (u32x4*)(p.XE + (size_t)idx * D); dst[lane] = a; dst[64 + lane] = b;
    }
}

typedef short bf16x8 __attribute__((ext_vector_type(8)));
#define MFMA16(a, b, c) __builtin_amdgcn_mfma_f32_16x16x32_bf16((a), (b), (c), 0, 0, 0)
constexpr int LDP = 272;
constexpr int LDQ = 144;
__device__ __forceinline__ bf16x8 ld_frag(const LAS unsigned char* base, int row, int kcol, int ldb) { return *(const LAS bf16x8*)(base + row * ldb + kcol * 2); }
__device__ __forceinline__ void st_b16(LAS unsigned char* p, unsigned v) { *(LAS unsigned short*)p = (unsigned short)v; }
__device__ __forceinline__ float wscan_incl(float v, int lane) {
#pragma unroll
    for (int o = 1; o < 64; o <<= 1) { const float t = __shfl_up(v, o); if (lane >= o) v += t; }
    return v;
}
__device__ __forceinline__ int chunk_r0(int d, int cs) { return d == 0 ? 128 * cs : (cs < 2 ? 128 * (1 - cs) : 128 * (NCH + 1 - cs)); }
__device__ __forceinline__ int scan_chunk_of(int d, int cn) { return d == 0 ? cn : (cn < 2 ? 1 - cn : NCH + 1 - cn); }

__device__ __forceinline__ void ssd_acum(const float* DT, int r0, int d, int col, float a, int lane, LAS float* acum, LAS float* dtv, float& total) {
    const int j0 = d == 0 ? lane : 127 - lane, j1 = d == 0 ? 64 + lane : 63 - lane;
    const float dt0 = DT[(size_t)(r0 + j0) * 16 + col], dt1 = DT[(size_t)(r0 + j1) * 16 + col];
    const float s0 = wscan_incl(dt0 * a, lane); const float t0 = __shfl(s0, 63);
    const float s1 = wscan_incl(dt1 * a, lane) + t0; total = __shfl(s1, 63);
    acum[j0] = s0; acum[j1] = s1; dtv[j0] = dt0; dtv[j1] = dt1;
}

__device__ __forceinline__ void ssd_states(const P& p, int l, LAS unsigned char* lds, float* SST, float* DEC) {
    LAS unsigned char* BT = lds;
    LAS unsigned char* XW = lds + 128 * LDP;
    LAS float* wj = (LAS float*)(lds + 128 * LDP + 4 * 64 * LDP);
    const int tid = p.tid, lane = p.lane, wave = p.wave, quad = lane >> 4, l15 = lane & 15;
    for (int u = p.bid; u < 2 * NCH * 2; u += p.G) {
        const int d = u / (2 * NCH), cs = (u % (2 * NCH)) >> 1, g = u & 1;
        const int r0 = chunk_r0(d, cs);
        __syncthreads();
        if (wave < 4) { const int h = g * 4 + wave; const float a = -expf(p.a_log[l * 16 + d * 8 + h]); float total;
            LAS float* ac = wj + 512 + wave * 128; LAS float* dv = wj + 1024 + wave * 128;
            ssd_acum(p.DT, r0, d, d * 8 + h, a, lane, ac, dv, total);
            LDS_FENCE();
            wj[wave * 128 + lane] = __expf(total - ac[lane]) * dv[lane]; wj[wave * 128 + 64 + lane] = __expf(total - ac[64 + lane]) * dv[64 + lane];
            if (lane == 0) DEC[(d * NCH + cs) * 8 + h] = expf(total); }
        __syncthreads();
        for (int idx = tid; idx < 128 * 16; idx += NTHR) { const int j = idx >> 4, n8 = (idx & 15) * 8;
            const u32x4 v = *(const u32x4*)(p.CV + (size_t)(r0 + j) * 1024 + 512 + g * 128 + n8);
            LAS unsigned char* dst = BT + n8 * LDP + 2 * j;
            st_b16(dst, v.x & 0xffffu); st_b16(dst + LDP, v.x >> 16); st_b16(dst + 2 * LDP, v.y & 0xffffu); st_b16(dst + 3 * LDP, v.y >> 16);
            st_b16(dst + 4 * LDP, v.z & 0xffffu); st_b16(dst + 5 * LDP, v.z >> 16); st_b16(dst + 6 * LDP, v.w & 0xffffu); st_b16(dst + 7 * LDP, v.w >> 16); }
        for (int idx = tid; idx < 128 * 32; idx += NTHR) { const int j = idx >> 5, c8 = (idx & 31) * 8, hh = c8 >> 6, p8 = c8 & 63;
            const u32x4 v = *(const u32x4*)(p.CV + (size_t)(r0 + j) * 1024 + g * 256 + c8); const float w = wj[hh * 128 + j];
            LAS unsigned char* dst = XW + (hh * 64 + p8) * LDP + 2 * j;
            st_b16(dst, f2bf(bflo(v.x) * w)); st_b16(dst + LDP, f2bf(bfhi(v.x) * w)); st_b16(dst + 2 * LDP, f2bf(bflo(v.y) * w)); st_b16(dst + 3 * LDP, f2bf(bfhi(v.y) * w));
            st_b16(dst + 4 * LDP, f2bf(bflo(v.z) * w)); st_b16(dst + 5 * LDP, f2bf(bfhi(v.z) * w)); st_b16(dst + 6 * LDP, f2bf(bflo(v.w) * w)); st_b16(dst + 7 * LDP, f2bf(bfhi(v.w) * w)); }
        __syncthreads();
        const int hh = wave >> 1, ph = wave & 1;
        f32x4 acc[2][8];
#pragma unroll
        for (int a = 0; a < 2; ++a)
#pragma unroll
            for (int b = 0; b < 8; ++b) acc[a][b] = (f32x4){0.f, 0.f, 0.f, 0.f};
#pragma unroll
        for (int ks = 0; ks < 4; ++ks) {
            bf16x8 af[2];
#pragma unroll
            for (int pt = 0; pt < 2; ++pt) af[pt] = ld_frag(XW + hh * 64 * LDP, ph * 32 + pt * 16 + l15, ks * 32 + 8 * quad, LDP);
#pragma unroll
            for (int nt = 0; nt < 8; ++nt) { const bf16x8 bfr = ld_frag(BT, nt * 16 + l15, ks * 32 + 8 * quad, LDP);
#pragma unroll
                for (int pt = 0; pt < 2; ++pt) acc[pt][nt] = MFMA16(af[pt], bfr, acc[pt][nt]); }
        }
        float* S = SST + ((size_t)(d * NCH + cs) * 8 + g * 4 + hh) * 8192;
#pragma unroll
        for (int pt = 0; pt < 2; ++pt)
#pragma unroll
            for (int nt = 0; nt < 8; ++nt)
#pragma unroll
                for (int r = 0; r < 4; ++r) S[(ph * 32 + pt * 16 + 4 * quad + r) * 128 + nt * 16 + l15] = acc[pt][nt][r];
    }
}

__device__ __forceinline__ void scan_carries(const P& p, int l, const float* SST, const float* DEC, bf16* HIN) {
    for (int e = p.bid * NTHR + p.tid; e < 2 * 8 * 8192; e += p.G * NTHR) {
        const int d = e >> 16, h = (e >> 13) & 7, pn = e & 8191;
        float hs = 0.f;
        for (int c0 = 0; c0 < NCH; c0 += 10) {
            float s[10], dc[10];
#pragma unroll
            for (int j = 0; j < 10; ++j) { const size_t ci = (size_t)(d * NCH + c0 + j) * 8 + h; s[j] = SST[ci * 8192 + pn]; dc[j] = DEC[ci]; }
#pragma unroll
            for (int j = 0; j < 10; ++j) { const size_t ci = (size_t)(d * NCH + c0 + j) * 8 + h; HIN[ci * 8192 + pn] = (bf16)f2bf(hs); hs = hs * dc[j] + s[j]; }
        }
    }
    for (int e = p.bid * NTHR + p.tid; e < 2 * 32 * 64; e += p.G * NTHR) {
        const int d = e >> 11, g = (e >> 6) & 31, pq = e & 63;
        S5Lane s; s5_lane_params(p, l, d, g, pq, s, false);
        float ar = s.abr, ai = s.abi;
#pragma unroll
        for (int q = 0; q < 7; ++q) { const float nr = ar * ar - ai * ai, ni = 2.f * ar * ai; ar = nr; ai = ni; }
        float hr = 0.f, hi = 0.f;
        const float* E = p.S5E + (size_t)(d * 32 + g) * NCH * 128 + pq; float* Hn = p.S5H + (size_t)(d * 32 + g) * NCH * 128 + pq;
        for (int c0 = 0; c0 < NCH; c0 += 10) {
            float er[10], ei[10];
#pragma unroll
            for (int j = 0; j < 10; ++j) { er[j] = E[(c0 + j) * 128]; ei[j] = E[(c0 + j) * 128 + 64]; }
#pragma unroll
            for (int j = 0; j < 10; ++j) { Hn[(c0 + j) * 128] = hr; Hn[(c0 + j) * 128 + 64] = hi;
                const float nr = ar * hr - ai * hi + er[j], ni = ar * hi + ai * hr + ei[j]; hr = nr; hi = ni; }
        }
    }
}

__device__ __forceinline__ void ssd_outputs(const P& p, int l, LAS unsigned char* lds, const bf16* HIN, const float* SST, bf16* YS, int u_begin, int u_end, int first, int stride) {
    LAS unsigned char* Cm = lds;
    LAS unsigned char* Bm = lds + 128 * LDP;
    LAS unsigned char* XT = lds + 2 * 128 * LDP;
    LAS unsigned char* Wm = lds + 2 * 128 * LDP + 64 * LDP;
    LAS float* sm = (LAS float*)(lds + 3 * 128 * LDP + 64 * LDP);
    const int tid = p.tid, lane = p.lane, wave = p.wave, quad = lane >> 4, l15 = lane & 15;
    for (int u = u_begin + first; u < u_end; u += stride) {
        const int cn = u >> 3, h = u & 7, g = h >> 2, r0 = 128 * cn;
        __syncthreads();
        if (wave < 2) { const int d = wave; const float a = -expf(p.a_log[l * 16 + d * 8 + h]); float total;
            ssd_acum(p.DT, r0, d, d * 8 + h, a, lane, sm + d * 128, sm + 256 + d * 128, total); }
        for (int idx = tid; idx < 128 * 16; idx += NTHR) { const int j = idx >> 4, n8 = (idx & 15) * 8;
            const bf16* src = p.CV + (size_t)(r0 + j) * 1024 + g * 128 + n8;
            *(LAS u32x4*)(Bm + j * LDP + n8 * 2) = *(const u32x4*)(src + 512); *(LAS u32x4*)(Cm + j * LDP + n8 * 2) = *(const u32x4*)(src + 768); }
        for (int idx = tid; idx < 128 * 8; idx += NTHR) { const int j = idx >> 3, p8 = (idx & 7) * 8;
            const u32x4 v = *(const u32x4*)(p.CV + (size_t)(r0 + j) * 1024 + h * 64 + p8);
            LAS unsigned char* dst = XT + p8 * LDP + 2 * j;
            st_b16(dst, v.x & 0xffffu); st_b16(dst + LDP, v.x >> 16); st_b16(dst + 2 * LDP, v.y & 0xffffu); st_b16(dst + 3 * LDP, v.y >> 16);
            st_b16(dst + 4 * LDP, v.z & 0xffffu); st_b16(dst + 5 * LDP, v.z >> 16); st_b16(dst + 6 * LDP, v.w & 0xffffu); st_b16(dst + 7 * LDP, v.w >> 16); }
        __syncthreads();
        f32x4 G[8];
#pragma unroll
        for (int jt = 0; jt < 8; ++jt) G[jt] = (f32x4){0.f, 0.f, 0.f, 0.f};
#pragma unroll
        for (int ks = 0; ks < 4; ++ks) { const bf16x8 af = ld_frag(Cm, 16 * wave + l15, ks * 32 + 8 * quad, LDP);
#pragma unroll
            for (int jt = 0; jt < 8; ++jt) G[jt] = MFMA16(af, ld_frag(Bm, 16 * jt + l15, ks * 32 + 8 * quad, LDP), G[jt]); }
        __syncthreads();
        for (int idx = tid; idx < 2 * 64 * 16; idx += NTHR) { const int d = idx >> 10, pp = (idx >> 4) & 63, n8 = (idx & 15) * 8;
            const int cs = scan_chunk_of(d, cn);
            u32x4 w;
            if (cn >= 2) w = *(const u32x4*)(HIN + ((size_t)(d * NCH + cs) * 8 + h) * 8192 + pp * 128 + n8);
            else if (cs == 0) w = (u32x4){0u, 0u, 0u, 0u};
            else { const float* s = SST + ((size_t)(d * NCH) * 8 + h) * 8192 + pp * 128 + n8; const f32x4 s0 = *(const f32x4*)s, s1 = *(const f32x4*)(s + 4);
                w.x = pk2(s0[0], s0[1]); w.y = pk2(s0[2], s0[3]); w.z = pk2(s1[0], s1[1]); w.w = pk2(s1[2], s1[3]); }
            *(LAS u32x4*)(Bm + (d * 64 + pp) * LDP + n8 * 2) = w; }
        __syncthreads();
        f32x4 Y[4];
#pragma unroll
        for (int pt = 0; pt < 4; ++pt) Y[pt] = (f32x4){0.f, 0.f, 0.f, 0.f};
#pragma unroll
        for (int d = 0; d < 2; ++d) {
            const LAS float* ac = sm + d * 128; const LAS float* dv = sm + 256 + d * 128;
            float ai[4];
#pragma unroll
            for (int r = 0; r < 4; ++r) ai[r] = ac[16 * wave + 4 * quad + r];
#pragma unroll
            for (int jt = 0; jt < 8; ++jt) { const int j = 16 * jt + l15; const float aj = ac[j], dj = dv[j];
#pragma unroll
                for (int r = 0; r < 4; ++r) { const int i = 16 * wave + 4 * quad + r; const bool valid = (d == 0) ? (j <= i) : (j >= i);
                    const float w = valid ? G[jt][r] * __expf(ai[r] - aj) * dj : 0.f;
                    st_b16(Wm + i * LDP + 2 * j, f2bf(w)); } }
            LDS_FENCE();
            f32x4 Y2[4];
#pragma unroll
            for (int pt = 0; pt < 4; ++pt) Y2[pt] = (f32x4){0.f, 0.f, 0.f, 0.f};
#pragma unroll
            for (int ks = 0; ks < 4; ++ks) { const bf16x8 wf = ld_frag(Wm, 16 * wave + l15, ks * 32 + 8 * quad, LDP), cf = ld_frag(Cm, 16 * wave + l15, ks * 32 + 8 * quad, LDP);
#pragma unroll
                for (int pt = 0; pt < 4; ++pt) { Y[pt] = MFMA16(wf, ld_frag(XT, 16 * pt + l15, ks * 32 + 8 * quad, LDP), Y[pt]);
                    Y2[pt] = MFMA16(cf, ld_frag(Bm + d * 64 * LDP, 16 * pt + l15, ks * 32 + 8 * quad, LDP), Y2[pt]); } }
#pragma unroll
            for (int r = 0; r < 4; ++r) { const float ea = __expf(ai[r]);
#pragma unroll
                for (int pt = 0; pt < 4; ++pt) Y[pt][r] += ea * Y2[pt][r]; }
            LDS_FENCE();
        }
#pragma unroll
        for (int pt = 0; pt < 4; ++pt)
#pragma unroll
            for (int r = 0; r < 4; ++r) YS[(size_t)(r0 + 16 * wave + 4 * quad + r) * 512 + h * 64 + 16 * pt + l15] = (bf16)f2bf(Y[pt][r]);
    }
}

__device__ __forceinline__ void ssd_gated_norm(const P& p, int l, const bf16* YS) {
    const int gw = p.bid * NWAVES + p.wave, NGW = p.G * NWAVES, lane = p.lane;
    for (int row = gw; row < T; row += NGW) {
        const int ch = lane * 8;
        const float dsk = p.ssd_d[l * 8 + (ch >> 6)];
        const u32x4 yv = *(const u32x4*)(YS + (size_t)row * 512 + ch);
        const u32x4 xs = *(const u32x4*)(p.CV + (size_t)row * 1024 + ch), zz = *(const u32x4*)(p.PROJ + (size_t)row * PJ + Z0 + ch);
        float v[8];
        v[0] = (bflo(yv.x) + dsk * bflo(xs.x)) * silu_f(bflo(zz.x)); v[1] = (bfhi(yv.x) + dsk * bfhi(xs.x)) * silu_f(bfhi(zz.x));
        v[2] = (bflo(yv.y) + dsk * bflo(xs.y)) * silu_f(bflo(zz.y)); v[3] = (bfhi(yv.y) + dsk * bfhi(xs.y)) * silu_f(bfhi(zz.y));
        v[4] = (bflo(yv.z) + dsk * bflo(xs.z)) * silu_f(bflo(zz.z)); v[5] = (bfhi(yv.z) + dsk * bfhi(xs.z)) * silu_f(bfhi(zz.z));
        v[6] = (bflo(yv.w) + dsk * bflo(xs.w)) * silu_f(bflo(zz.w)); v[7] = (bfhi(yv.w) + dsk * bfhi(xs.w)) * silu_f(bfhi(zz.w));
        float ss = 0.f;
#pragma unroll
        for (int i = 0; i < 8; ++i) ss += v[i] * v[i];
        const float rstd = rsqrtf(wsum(ss) * (1.f / 512.f) + EPS);
        const float* ng = p.ssd_norm_g + (size_t)l * 512 + ch;
        const f32x4 g0 = *(const f32x4*)ng, g1 = *(const f32x4*)(ng + 4);
        u32x4 o; o.x = pk2(v[0] * rstd * g0[0], v[1] * rstd * g0[1]); o.y = pk2(v[2] * rstd * g0[2], v[3] * rstd * g0[3]);
        o.z = pk2(v[4] * rstd * g1[0], v[5] * rstd * g1[1]); o.w = pk2(v[6] * rstd * g1[2], v[7] * rstd * g1[3]);
        *(u32x4*)(p.Y3 + (size_t)row * 1536 + 512 + ch) = o;
    }
}

__device__ __forceinline__ void attention_mfma(const P& p, int l, LAS unsigned char* lds, int u_begin, int u_end, int u_first, int u_stride) {
    LAS unsigned char* Kt = lds;
    LAS unsigned char* VT = lds + 64 * LDQ;
    LAS unsigned char* Pw = lds + 2 * 64 * LDQ + p.wave * 64 * LDQ;
    const int tid = p.tid, lane = p.lane, wave = p.wave, quad = lane >> 4, l15 = lane & 15;
    const float C2 = 0.125f * 1.4426950408889634f;
    for (int u = u_begin + u_first; u < u_end; u += u_stride) {
        const int qb = u >> 1, kvh = u & 1, hq = kvh * 4 + (wave >> 1);
        const bool isc = qb < 2; const int nb = qb - 2;
        const int qrow0 = 128 * qb + 64 * (wave & 1);
        bf16x8 Qf[4][2];
#pragma unroll
        for (int qt = 0; qt < 4; ++qt)
#pragma unroll
            for (int ks = 0; ks < 2; ++ks) Qf[qt][ks] = *(const bf16x8*)(p.PROJ + (size_t)(qrow0 + 16 * qt + l15) * PJ + Q0 + hq * 64 + ks * 32 + 8 * quad);
        f32x4 O[4][4];
#pragma unroll
        for (int a = 0; a < 4; ++a)
#pragma unroll
            for (int b = 0; b < 4; ++b) O[a][b] = (f32x4){0.f, 0.f, 0.f, 0.f};
        float mrow[4], lrow[4];
        const float sk = p.sink[l * 8 + hq] * 1.4426950408889634f;
#pragma unroll
        for (int qt = 0; qt < 4; ++qt) { mrow[qt] = sk; lrow[qt] = 1.f; }
        const int ntile = isc ? 4 : 10;
        for (int ti = 0; ti < ntile; ++ti) {
            int krow0; bool local;
            if (isc || ti >= 6) { krow0 = 64 * (isc ? ti : ti - 6); local = false; }
            else { krow0 = NCTX + 128 * (nb - 1) + 64 * ti; local = true; }
            if (local && (krow0 < NCTX || krow0 >= T)) continue;
            __syncthreads();
            { const int key = tid >> 3, pc = tid & 7;
              const bf16* src = p.PROJ + (size_t)(krow0 + key) * PJ + kvh * 64 + pc * 8;
              *(LAS u32x4*)(Kt + key * LDQ + pc * 16) = *(const u32x4*)(src + K0);
              const u32x4 v = *(const u32x4*)(src + V0);
              LAS unsigned char* dst = VT + (pc * 8) * LDQ + 2 * key;
              st_b16(dst, v.x & 0xffffu); st_b16(dst + LDQ, v.x >> 16); st_b16(dst + 2 * LDQ, v.y & 0xffffu); st_b16(dst + 3 * LDQ, v.y >> 16);
              st_b16(dst + 4 * LDQ, v.z & 0xffffu); st_b16(dst + 5 * LDQ, v.z >> 16); st_b16(dst + 6 * LDQ, v.w & 0xffffu); st_b16(dst + 7 * LDQ, v.w >> 16); }
            __syncthreads();
            f32x4 S[4][4];
#pragma unroll
            for (int a = 0; a < 4; ++a)
#pragma unroll
                for (int b = 0; b < 4; ++b) S[a][b] = (f32x4){0.f, 0.f, 0.f, 0.f};
#pragma unroll
            for (int ks = 0; ks < 2; ++ks)
#pragma unroll
                for (int kt = 0; kt < 4; ++kt) { const bf16x8 kf = ld_frag(Kt, 16 * kt + l15, ks * 32 + 8 * quad, LDQ);
#pragma unroll
                    for (int qt = 0; qt < 4; ++qt) S[kt][qt] = MFMA16(kf, Qf[qt][ks], S[kt][qt]); }
#pragma unroll
            for (int qt = 0; qt < 4; ++qt) {
                const int tq = qrow0 + 16 * qt + l15;
                float mx = -1e30f;
#pragma unroll
                for (int kt = 0; kt < 4; ++kt)
#pragma unroll
                    for (int r = 0; r < 4; ++r) { const int tk = krow0 + 16 * kt + 4 * quad + r; const int df = tq - tk;
                        const bool ok = !local || (df <= 128 && df >= -128);
                        const float s = ok ? S[kt][qt][r] * C2 : -1e30f; S[kt][qt][r] = s; mx = fmaxf(mx, s); }
                mx = fmaxf(mx, __shfl_xor(mx, 16)); mx = fmaxf(mx, __shfl_xor(mx, 32));
                const float mn = fmaxf(mrow[qt], mx), alpha = exp2f(mrow[qt] - mn);
                float ls = 0.f;
#pragma unroll
                for (int kt = 0; kt < 4; ++kt) { float e0 = exp2f(S[kt][qt][0] - mn), e1 = exp2f(S[kt][qt][1] - mn), e2 = exp2f(S[kt][qt][2] - mn), e3 = exp2f(S[kt][qt][3] - mn);
                    ls += (e0 + e1) + (e2 + e3);
                    u32x2 w; w.x = pk2(e0, e1); w.y = pk2(e2, e3);
                    *(LAS u32x2*)(Pw + (16 * qt + l15) * LDQ + (16 * kt + 4 * quad) * 2) = w; }
                ls += __shfl_xor(ls, 16); ls += __shfl_xor(ls, 32);
                lrow[qt] = lrow[qt] * alpha + ls; mrow[qt] = mn;
#pragma unroll
                for (int dt = 0; dt < 4; ++dt) O[dt][qt] *= alpha;
            }
            LDS_FENCE();
#pragma unroll
            for (int ks = 0; ks < 2; ++ks) {
                bf16x8 pf[4];
#pragma unroll
                for (int qt = 0; qt < 4; ++qt) pf[qt] = ld_frag(Pw, 16 * qt + l15, ks * 32 + 8 * quad, LDQ);
#pragma unroll
                for (int dt = 0; dt < 4; ++dt) { const bf16x8 vf = ld_frag(VT, 16 * dt + l15, ks * 32 + 8 * quad, LDQ);
#pragma unroll
                    for (int qt = 0; qt < 4; ++qt) O[dt][qt] = MFMA16(vf, pf[qt], O[dt][qt]); }
            }
            LDS_FENCE();
        }
#pragma unroll
        for (int qt = 0; qt < 4; ++qt) { const float inv = 1.f / lrow[qt];
            bf16* orow = p.Y3 + (size_t)(qrow0 + 16 * qt + l15) * 1536 + 1024 + hq * 64;
#pragma unroll
            for (int dt = 0; dt < 4; ++dt) { u32x2 w; w.x = pk2(O[dt][qt][0] * inv, O[dt][qt][1] * inv); w.y = pk2(O[dt][qt][2] * inv, O[dt][qt][3] * inv);
                *(u32x2*)(orow + 16 * dt + 4 * quad) = w; } }
    }
}

#ifndef S5_INTERLEAVE
#define S5_INTERLEAVE 2
#endif
constexpr size_t S5BB_ELEMS = (size_t)2 * 32 * 128 * 32, S5CC_ELEMS = (size_t)2 * 32 * 16 * 128;
__device__ __forceinline__ void s5_tables(const P& p, int l, bf16* BB, bf16* CC, float* AB) {
    for (int e = p.bid * NTHR + p.tid; e < 2 * 32 * 64; e += p.G * NTHR) {
        const int d = e >> 11, g = (e >> 6) & 31, pq = e & 63, dg = d * 32 + g;
        S5Lane s; s5_lane_params(p, l, d, g, pq, s, true);
        AB[(size_t)e * 2] = s.abr; AB[(size_t)e * 2 + 1] = s.abi;
        #if S5_INTERLEAVE
        u32x4* br = (u32x4*)(BB + ((size_t)dg * 128 + 2 * pq) * 32); u32x4* bi = (u32x4*)(BB + ((size_t)dg * 128 + 2 * pq + 1) * 32);
#else
        u32x4* br = (u32x4*)(BB + ((size_t)dg * 128 + pq) * 32); u32x4* bi = (u32x4*)(BB + ((size_t)dg * 128 + 64 + pq) * 32);
#endif
        u32x4 w;
        w.x = pk2(s.bbr[0], s.bbr[1]); w.y = pk2(s.bbr[2], s.bbr[3]); w.z = pk2(s.bbr[4], s.bbr[5]); w.w = pk2(s.bbr[6], s.bbr[7]); br[0] = w;
        w.x = pk2(s.bbr[8], s.bbr[9]); w.y = pk2(s.bbr[10], s.bbr[11]); w.z = pk2(s.bbr[12], s.bbr[13]); w.w = pk2(s.bbr[14], s.bbr[15]); br[1] = w;
        w.x = pk2(s.bbi[0], s.bbi[1]); w.y = pk2(s.bbi[2], s.bbi[3]); w.z = pk2(s.bbi[4], s.bbi[5]); w.w = pk2(s.bbi[6], s.bbi[7]); bi[0] = w;
        w.x = pk2(s.bbi[8], s.bbi[9]); w.y = pk2(s.bbi[10], s.bbi[11]); w.z = pk2(s.bbi[12], s.bbi[13]); w.w = pk2(s.bbi[14], s.bbi[15]); bi[1] = w;
        const u32x4 z = (u32x4){0u, 0u, 0u, 0u}; br[2] = z; br[3] = z; bi[2] = z; bi[3] = z;
        const size_t ci = ((size_t)(l * 2 + d) * 32 + g) * 16;
#pragma unroll
        for (int k = 0; k < 16; ++k) {
#if S5_INTERLEAVE
            *(unsigned*)(CC + ((size_t)dg * 16 + k) * 128 + 2 * pq) = pk2(p.c_re[(ci + k) * 64 + pq], -p.c_im[(ci + k) * 64 + pq]);
#else
            CC[((size_t)dg * 16 + k) * 128 + pq] = (bf16)f2bf(p.c_re[(ci + k) * 64 + pq]); CC[((size_t)dg * 16 + k) * 128 + 64 + pq] = (bf16)f2bf(-p.c_im[(ci + k) * 64 + pq]);
#endif
        }
    }
}
constexpr int S5_WREG = 4096 + 16 * 132 * 4 + 16 * LDP;
template <bool READOUT> __device__ __forceinline__ void s5_chunk_dir(int d, const bf16* BBdg, const bf16* CCdg, float abr, float abi, LAS unsigned char* wreg, int lane, float& hr, float& hi, f32x4 (&yacc)[8]) {
    const int quad = lane >> 4, l15 = lane & 15;
    LAS unsigned char* ub = wreg; LAS float* BuW = (LAS float*)(wreg + 4096); LAS unsigned char* Hw = wreg + 4096 + 16 * 132 * 4;
    bf16x8 BBf[8], CCf[4];
#pragma unroll
    for (int pt = 0; pt < 8; ++pt) BBf[pt] = *(const bf16x8*)(BBdg + (size_t)(16 * pt + l15) * 32 + 8 * quad);
    if (READOUT) {
#pragma unroll
        for (int ks = 0; ks < 4; ++ks) CCf[ks] = *(const bf16x8*)(CCdg + (size_t)l15 * 128 + ks * 32 + 8 * quad);
    }
#pragma unroll (READOUT ? 8 : 1)
    for (int ss = 0; ss < 8; ++ss) {
        const int sc = d ? 7 - ss : ss;
        bf16x8 uf = (bf16x8){0, 0, 0, 0, 0, 0, 0, 0};
        if (quad < 2) uf = *(const LAS bf16x8*)(ub + (16 * sc + l15) * 32 + quad * 16);
#pragma unroll
        for (int pt = 0; pt < 8; ++pt) { const f32x4 Dp = MFMA16(uf, BBf[pt], ((f32x4){0.f, 0.f, 0.f, 0.f}));
#pragma unroll
            for (int r = 0; r < 4; ++r) BuW[(4 * quad + r) * 132 + 16 * pt + l15] = Dp[r]; }
        LDS_FENCE();
#pragma unroll
        for (int st = 0; st < 16; ++st) { const int tl = d ? 15 - st : st;
#if S5_INTERLEAVE == 1
            typedef float f32x2_t __attribute__((ext_vector_type(2)));
            const f32x2_t bu = *(const LAS f32x2_t*)(BuW + tl * 132 + 2 * lane);
            const float nr = abr * hr - abi * hi + bu[0], ni = abr * hi + abi * hr + bu[1]; hr = nr; hi = ni;
            if (READOUT) *(LAS unsigned*)(Hw + tl * LDP + 4 * lane) = pk2(hr, hi); }
#elif S5_INTERLEAVE == 2
            const float br = BuW[tl * 132 + 2 * lane], bi = BuW[tl * 132 + 2 * lane + 1];
            const float nr = abr * hr - abi * hi + br, ni = abr * hi + abi * hr + bi; hr = nr; hi = ni;
            if (READOUT) *(LAS unsigned*)(Hw + tl * LDP + 4 * lane) = pk2(hr, hi); }
#else
            const float br = BuW[tl * 132 + lane], bi = BuW[tl * 132 + 64 + lane];
            const float nr = abr * hr - abi * hi + br, ni = abr * hi + abi * hr + bi; hr = nr; hi = ni;
            if (READOUT) { st_b16(Hw + tl * LDP + 2 * lane, f2bf(hr)); st_b16(Hw + tl * LDP + 128 + 2 * lane, f2bf(hi)); } }
#endif
        if (READOUT) {
            LDS_FENCE();
#pragma unroll
            for (int ks = 0; ks < 4; ++ks) yacc[sc] = MFMA16(ld_frag(Hw, l15, ks * 32 + 8 * quad, LDP), CCf[ks], yacc[sc]);
        }
        LDS_FENCE();
    }
}
__device__ __forceinline__ void s5_local_states(const P& p, LAS unsigned char* lds, const bf16* BB, const float* AB) {
    LAS unsigned char* wreg = lds + p.wave * S5_WREG;
    const int gw = p.bid * NWAVES + p.wave, NGW = p.G * NWAVES, lane = p.lane;
    for (int it = gw; it < 2 * 32 * NCH; it += NGW) {
        const int d = it / (32 * NCH), c = (it % (32 * NCH)) >> 5, g = it & 31, dg = d * 32 + g;
        s5_stage_u(p, chunk_r0(d, c), g, wreg, lane);
        float hr = 0.f, hi = 0.f; f32x4 dummy[8];
        const float abr = AB[((size_t)dg * 64 + lane) * 2], abi = AB[((size_t)dg * 64 + lane) * 2 + 1];
        if (d == 0) s5_chunk_dir<false>(0, BB + (size_t)dg * 128 * 32, nullptr, abr, abi, wreg, lane, hr, hi, dummy);
        else s5_chunk_dir<false>(1, BB + (size_t)dg * 128 * 32, nullptr, abr, abi, wreg, lane, hr, hi, dummy);
        float* E = p.S5E + ((size_t)dg * NCH + c) * 128;
        E[lane] = hr; E[64 + lane] = hi;
    }
}
__device__ __forceinline__ void s5_outputs(const P& p, int l, LAS unsigned char* lds, const bf16* BB, const bf16* CC, const float* AB, int it_begin, int it_end, int first, int stride) {
    LAS unsigned char* wreg = lds + p.wave * S5_WREG;
    const int lane = p.lane, quad = lane >> 4, l15 = lane & 15;
    for (int it = it_begin + first; it < it_end; it += stride) {
        const int cn = it >> 5, g = it & 31, r0 = 128 * cn;
        s5_stage_u(p, r0, g, wreg, lane);
        f32x4 yacc[8];
#pragma unroll
        for (int i = 0; i < 8; ++i) yacc[i] = (f32x4){0.f, 0.f, 0.f, 0.f};
#pragma unroll
        for (int d = 0; d < 2; ++d) { const int dg = d * 32 + g, cs = scan_chunk_of(d, cn);
            const float* Hn = (cn < 2) ? (p.S5E + (size_t)dg * NCH * 128) : (p.S5H + ((size_t)dg * NCH + cs) * 128);
            float hr = Hn[lane], hi = Hn[64 + lane];
            if (cs == 0) { hr = 0.f; hi = 0.f; }
            s5_chunk_dir<true>(d, BB + (size_t)dg * 128 * 32, CC + (size_t)dg * 16 * 128, AB[((size_t)dg * 64 + lane) * 2], AB[((size_t)dg * 64 + lane) * 2 + 1], wreg, lane, hr, hi, yacc); }
        const float dsk = p.s5_d[(size_t)l * 512 + g * 16 + l15];
#pragma unroll
        for (int sc = 0; sc < 8; ++sc)
#pragma unroll
            for (int r = 0; r < 4; ++r) { const int t = 16 * sc + 4 * quad + r;
                const float u = bf2f(*(const LAS unsigned short*)(wreg + t * 32 + 2 * l15));
                p.SA[(size_t)(r0 + t) * 512 + g * 16 + l15] = (bf16)f2bf(gelu_tanh_f(yacc[sc][r] + dsk * u)); }
        LDS_FENCE();
    }
}

#ifndef SKIPMASK
#define SKIPMASK 0
#endif
struct Args { const float* in[33]; float* out; unsigned char* ws; int ph_lo, ph_hi; };
static_assert(sizeof(Args) == 35 * 8 + 8, "no padding");

__global__ void __launch_bounds__(NTHR, 2) fwd_kernel(Args args) {
    extern __shared__ __attribute__((aligned(16))) unsigned char lds_raw[];
    LAS unsigned char* lds = (LAS unsigned char*)lds_raw;
    const int tid_ = threadIdx.x;
    if (tid_ == 0) {
        LAS unsigned long long* tab = (LAS unsigned long long*)(lds + PTAB_OFF);
#pragma unroll
        for (int k = 0; k < 33; ++k) tab[k] = (unsigned long long)args.in[k];
        tab[33] = (unsigned long long)args.out; tab[34] = (unsigned long long)args.ws;
    }
    volatile LAS unsigned* MISC = (volatile LAS unsigned*)(lds + MISC_OFF);
    if (tid_ < 64) MISC[tid_] = 0u;
    __syncthreads();
    XcdBarrier bar; bar.bar = (unsigned*)(args.ws + WS_CTL) + CW_BAR; bar.x = 0; bar.st = nullptr;
    if (!MK_PER_PHASE) bar = xcd_barrier_post((unsigned*)(args.ws + WS_CTL) + CW_BAR, MISC + 8);

    const int lo = args.ph_lo, hi = args.ph_hi;
#define IN(k) (lo <= (k) && (k) < hi)
#define SEAM(k) do { if (!MK_PER_PHASE && (k) + 1 < hi) xcd_barrier(bar); } while (0)

    if (IN(0)) { P p; build_P(p, lds); phase_mod(p, lds, (float*)(args.ws + WS_ROPE)); SEAM(0); }

#ifndef REPMASK
#define REPMASK 0
#endif
#define PHASE(k, ...) if (!((SKIPMASK >> (k)) & 1) && IN(pb + (k))) { for (int rep_ = 0; rep_ <= ((REPMASK >> (k)) & 1); ++rep_) { P p; build_P(p, lds); __VA_ARGS__; \
        if (rep_ < ((REPMASK >> (k)) & 1)) xcd_barrier(bar); } SEAM(pb + (k)); }
    for (int l = 0; l < DEPTH; ++l) {
        const int pb = 1 + NPH_LAYER * l;
        const bool cx = l < DEPTH - 1;
        unsigned char* wsb; { unsigned tb_ = (unsigned)(size_t)(lds + PTAB_OFF); asm volatile("" : "+v"(tb_)); wsb = (unsigned char*)ld_tab((volatile LAS unsigned*)(size_t)tb_, 34); }
        PHASE(0, convert_weights(p, l, lds); s5_tables(p, l, (bf16*)(wsb + WS_S5BB), (bf16*)(wsb + WS_S5CC), (float*)(wsb + WS_S5AB)); __syncthreads(); if (rep_ == 0) row_pass<0>(p, l, lds))
        PHASE(1, pg8::Gemm g{p.H, p.WIN, T, PJ, D}; pg8::StaticOrder S; S.init(T, PJ, p.G, p.bid); pg8::EpiStoreBf16 E{p.PROJ, PJ, GT0 / 256, (const float*)(wsb + WS_ROPE)};
            pg8::gemm_phase<pg8::EpiStoreBf16, pg8::StaticOrder, false>(lds, g, S, E, nullptr))
        PHASE(2, phase_premix(p, l, lds); s5_local_states(p, lds, (const bf16*)(wsb + WS_S5BB), (const float*)(wsb + WS_S5AB)))
        PHASE(3, ssd_states(p, l, lds, (float*)(wsb + WS_SST), (float*)(wsb + WS_DEC)); __syncthreads(); attention_mfma(p, l, lds, 4, 2 * NCH, p.bid, p.G))
        PHASE(4, if (cx) { if (p.bid >= p.G - 4) attention_mfma(p, l, lds, 0, 4, p.bid - (p.G - 4), 4);
                else if (p.bid >= p.G - 20) ssd_outputs(p, l, lds, (const bf16*)(wsb + WS_HIN), (const float*)(wsb + WS_SST), (bf16*)(wsb + WS_YS), 0, 16, p.bid - (p.G - 20), 16);
                else if (p.bid >= p.G - 28) s5_outputs(p, l, lds, (const bf16*)(wsb + WS_S5BB), (const bf16*)(wsb + WS_S5CC), (const float*)(wsb + WS_S5AB), 0, 64, (p.bid - (p.G - 28)) * NWAVES + p.wave, 64); }
            scan_carries(p, l, (const float*)(wsb + WS_SST), (const float*)(wsb + WS_DEC), (bf16*)(wsb + WS_HIN)))
        PHASE(5, ssd_outputs(p, l, lds, (const bf16*)(wsb + WS_HIN), (const float*)(wsb + WS_SST), (bf16*)(wsb + WS_YS), 16, NCH * 8, p.bid, p.G); __syncthreads();
            s5_outputs(p, l, lds, (const bf16*)(wsb + WS_S5BB), (const bf16*)(wsb + WS_S5CC), (const float*)(wsb + WS_S5AB), 64, 32 * NCH, p.bid * NWAVES + p.wave, p.G * NWAVES))
        PHASE(6, pg8::Gemm g{p.SA, p.WGLU, T, 512, 512}; pg8::RowOffOrder S; S.init(cx ? T : NLAT, 512, p.G, p.bid, cx ? 0 : 1); pg8::EpiGlu E{p.SA, p.b_glu + (size_t)l * 512, p.Y3};
            pg8::gemm_phase<pg8::EpiGlu, pg8::RowOffOrder, false>(lds, g, S, E, nullptr); ssd_gated_norm(p, l, (const bf16*)(wsb + WS_YS)))
        PHASE(7, pg8::Gemm g{p.Y3, p.WBR, T, D, 1536}; pg8::RowOffOrder S; S.init(cx ? T : NLAT, D, p.G, p.bid, cx ? 0 : 1); pg8::EpiMerge E{p.PROJ, p.MB};
            pg8::gemm_phase<pg8::EpiMerge, pg8::RowOffOrder, false>(lds, g, S, E, nullptr))
        PHASE(8, pg8::Gemm g{p.MB, p.WOUT, T, D, D}; pg8::RowOffOrder S; S.init(cx ? T : NLAT, D, p.G, p.bid, cx ? 0 : 1);
            pg8::EpiResid E{p.XL, p.XC, p.MOD + (size_t)(l * 2 + 0) * 6144 + 2 * D, p.MOD + (size_t)(l * 2 + 1) * 6144 + 2 * D};
            pg8::gemm_phase<pg8::EpiResid, pg8::RowOffOrder, false>(lds, g, S, E, nullptr))
        PHASE(9, row_pass<1>(p, l, lds, cx))
        PHASE(10, phase_select(p, lds, cx))
        PHASE(11, phase_gather(p, cx))
        PHASE(12, pg8::Gemm g{p.XE, p.WUP, NE * ESLOTS, NE * 2048, D}; pg8::ExpertOrder S{p.G, p.bid, 8, cx ? 9 : 8}; pg8::EpiSwiGlu E{p.HID};
            pg8::gemm_phase<pg8::EpiSwiGlu, pg8::ExpertOrder, false>(lds, g, S, E, nullptr))
        PHASE(13, pg8::Gemm g{p.HID, p.WDN, NE * ESLOTS, NE * 1024, D}; pg8::ExpertOrder S{p.G, p.bid, 4, cx ? 9 : 8}; pg8::EpiDown E{p.YE, p.GSEL};
            pg8::gemm_phase<pg8::EpiDown, pg8::ExpertOrder, false>(lds, g, S, E, nullptr))
    }
    if (IN(NPHASES - 1)) { P p; build_P(p, lds); row_pass<2>(p, 0, lds); }
#undef IN
#undef SEAM
}

extern "C" void kernel_launch(void* const* d_in, const int* in_sizes, int n_in, void* d_out, int out_size, void* d_ws, size_t ws_size, hipStream_t stream) {
    static int grid = 0;
    if (grid == 0) {
        if (n_in != 33 || out_size != NLAT * D || ws_size < WS_END) { fprintf(stderr, "kernel_launch: unexpected shapes: n_in %d out %d ws %zu (need %zu)\n", n_in, out_size, ws_size, (size_t)WS_END); grid = -1; return; }
        int dev = 0, cus = 0, per_cu = 0;
        if (hipGetDevice(&dev) != hipSuccess || hipDeviceGetAttribute(&cus, hipDeviceAttributeMultiprocessorCount, dev) != hipSuccess) { grid = -1; return; }
        if (hipFuncSetAttribute((const void*)fwd_kernel, hipFuncAttributeMaxDynamicSharedMemorySize, LDS_BYTES) != hipSuccess) { fprintf(stderr, "kernel_launch: hipFuncSetAttribute failed\n"); grid = -1; return; }
        if (hipOccupancyMaxActiveBlocksPerMultiprocessor(&per_cu, (const void*)fwd_kernel, NTHR, LDS_BYTES) != hipSuccess || per_cu < 1) { fprintf(stderr, "kernel_launch: occupancy query says %d\n", per_cu); (void)hipGetLastError(); }
        grid = cus;
    }
    if (grid < 0) return;
    (void)hipMemsetAsync((char*)d_ws + WS_CTL, 0, CTL_BYTES, stream);
    Args a{};
    for (int i = 0; i < 33; ++i) a.in[i] = (const float*)d_in[i];
    a.out = (float*)d_out; a.ws = (unsigned char*)d_ws;
#if MK_PER_PHASE
    for (int ph = 0; ph < NPHASES; ++ph) { a.ph_lo = ph; a.ph_hi = ph + 1; hipLaunchKernelGGL(fwd_kernel, dim3(grid), dim3(NTHR), LDS_BYTES, stream, a); }
#else
    a.ph_lo = 0; a.ph_hi = NPHASES;
    hipLaunchKernelGGL(fwd_kernel, dim3(grid), dim3(NTHR), LDS_BYTES, stream, a);
#endif
}
```

```cpp
#include <hip/hip_runtime.h>
#include <cstdio>
#include <cstdint>

#ifndef MK_PER_PHASE
#define MK_PER_PHASE 0
#endif

namespace pg8 {
#define PG8_LAS __attribute__((address_space(3)))
typedef unsigned short bf16_t;
typedef short bf16x8 __attribute__((ext_vector_type(8)));
typedef float f32x4 __attribute__((ext_vector_type(4)));
typedef unsigned u32x4 __attribute__((ext_vector_type(4)));
constexpr int BM = 256, BK = 64, HALF = 128, HTB = HALF * BK * 2  , STAGE_BYTES = 8 * HTB, NXCD = 8, WGM = 8;

__host__ __device__ __forceinline__ int lds_byte(int r, int c) { const int st = (r >> 4) * 2 + (c >> 5), rr = r & 15, cc = c & 31, ob = rr * 64 + cc * 2; return st * 1024 + (ob ^ (((ob >> 9) & 1) << 5)); }
__host__ __device__ __forceinline__ void stage_rc(int b, int& R, int& C) { const int st = b / 1024, sb = b % 1024, swz = sb ^ (((sb >> 9) & 1) << 5); R = (st >> 1) * 16 + swz / 64; C = (st & 1) * 32 + (swz % 64) / 2; }
__host__ __device__ __forceinline__ int perm32(int rho) { const int n = rho >> 4, i = rho & 15; return 8 * (i >> 2) + 4 * n + (i & 3); }

struct Unit { int pm, pn; };
struct Gemm { const bf16_t* A; const bf16_t* Bt; int M, N, K; };

struct StaticOrder {
    int nM, nN, nwg, G, c;
    __host__ __device__ void init(int M, int N, int G_, int c_) { nM = M / BM; nN = N / BM; nwg = nM * nN; G = G_; c = c_; }
    __host__ __device__ bool next(int i, Unit& u) const {
        const long L = (long)i * G + c; if (L >= nwg) return false;
        int wgid = (int)L; { const int q = nwg / NXCD, r = nwg % NXCD, xcd = wgid % NXCD, off = wgid / NXCD; wgid = (xcd < r ? xcd * (q + 1) : r * (q + 1) + (xcd - r) * q) + off; }
        const int nig = WGM * nN, gid = wgid / nig, fm = gid * WGM, gsz = (nM - fm) < WGM ? (nM - fm) : WGM;
        u.pm = fm + ((wgid % nig) % gsz); u.pn = (wgid % nig) / gsz; return true;
    }
    __device__ __forceinline__ void a_ready(const Unit&) const {}
    __device__ __forceinline__ void done(const Unit&) const {}
};
__device__ __forceinline__ unsigned cvt_pk_bf16(float lo, float hi) { unsigned r; asm volatile("v_cvt_pk_bf16_f32 %0, %1, %2" : "=v"(r) : "v"(lo), "v"(hi)); return r; }
template <class Epi, class Sched, bool STAMP = false>
__device__ __forceinline__ void gemm_phase(PG8_LAS unsigned char* lds, const Gemm g, const Sched& S, const Epi& E, unsigned long long* stamps) {
    int tid_l = threadIdx.x; asm volatile("" : "+v"(tid_l));
    const int tid = tid_l, wid = __builtin_amdgcn_readfirstlane(tid >> 6), lane = tid & 63, wr = wid >> 2, wc = wid & 3, fr = lane & 15, fq = lane >> 4;
    const int K = g.K, nt = K / BK;
    int ts_lo = 0, ts_hi = 0, nts = 0; const unsigned long long rt_entry = STAMP ? (unsigned long long)wall_clock64() : 0ull;
#define PG8_STAMP() do { if (STAMP && wid == 0 && nts < 64) { const unsigned long long _c = (unsigned long long)clock64(); \
        ts_lo = (lane == nts) ? (int)(unsigned)_c : ts_lo; ts_hi = (lane == nts) ? (int)(unsigned)(_c >> 32) : ts_hi; ++nts; } } while (0)
    PG8_STAMP();
    unsigned voffA[2], voffB[2];
#pragma unroll
    for (int i = 0; i < 2; ++i) { int R, C; stage_rc(tid * 16 + i * 8192, R, C); const int Rb = Epi::PERM ? ((R & ~31) + perm32(R & 31)) : R;
        voffA[i] = (unsigned)(R * K + C) * 2u; voffB[i] = (unsigned)(Rb * K + C) * 2u; }
    const size_t kstep = (size_t)(BK * 2);
    const size_t hstep = (size_t)HALF * K * 2;
    const size_t tstep = 2 * hstep;
    const unsigned ldsw = (unsigned)wid * 1024u;
    const int aoff = lds_byte(wr * 64 + fr, fq * 8), boff = lds_byte(wc * 32 + fr, fq * 8);
#define PG8_SA(b, h) (((b) * 2 + (h)) * HTB)
#define PG8_SB(b, h) ((4 + (b) * 2 + (h)) * HTB)
#define PG8_STAGE(bufoff, gbase, voff) do { _Pragma("unroll") for (int _i = 0; _i < 2; ++_i) \
        __builtin_amdgcn_global_load_lds((const unsigned*)((const char*)(gbase) + (voff)[_i]), (PG8_LAS unsigned*)(lds + (bufoff) + ldsw + _i * 8192), 16, 0, 0); } while (0)
#define PG8_LDA(dst, b, h) do { _Pragma("unroll") for (int m = 0; m < 4; ++m) _Pragma("unroll") for (int k = 0; k < 2; ++k) dst[m][k] = *(const PG8_LAS bf16x8*)(lds + PG8_SA(b, h) + aoff + m * 2048 + k * 1024); } while (0)
#define PG8_LDB(dst, b, h) do { _Pragma("unroll") for (int n = 0; n < 2; ++n) _Pragma("unroll") for (int k = 0; k < 2; ++k) dst[n][k] = *(const PG8_LAS bf16x8*)(lds + PG8_SB(b, h) + boff + n * 2048 + k * 1024); } while (0)
#define PG8_MMA(ai, bj, At, Bt) do { __builtin_amdgcn_s_setprio(1); _Pragma("unroll") for (int m = 0; m < 4; ++m) _Pragma("unroll") for (int n = 0; n < 2; ++n) _Pragma("unroll") for (int k = 0; k < 2; ++k) \
        acc[ai][bj][m][n] = __builtin_amdgcn_mfma_f32_16x16x32_bf16(Bt[n][k], At[m][k], acc[ai][bj][m][n], 0, 0, 0); __builtin_amdgcn_s_setprio(0); } while (0)
#define PG8_WAIT_V(n) asm volatile("s_waitcnt vmcnt(" #n ")" ::: "memory")
#define PG8_WAIT_L(n) asm volatile("s_waitcnt lgkmcnt(" #n ")" ::: "memory")
#define PG8_BAR __builtin_amdgcn_s_barrier()
#define PG8_SCHED __builtin_amdgcn_sched_barrier(0)
    Unit cur, nxt; int ui = 0;
    if (!S.next(0, cur)) return;
    f32x4 acc[2][2][4][2];
#pragma unroll
    for (int a = 0; a < 2; ++a)
#pragma unroll
        for (int b = 0; b < 2; ++b)
#pragma unroll
            for (int m = 0; m < 4; ++m)
#pragma unroll
                for (int n = 0; n < 2; ++n) acc[a][b][m][n] = (f32x4){0.f, 0.f, 0.f, 0.f};
    bf16x8 At[4][2], B0[2][2], B1[2][2];
    const char* cA = (const char*)g.A + (size_t)cur.pm * tstep; const char* cB = (const char*)g.Bt + (size_t)cur.pn * tstep;
    S.a_ready(cur);
    PG8_STAGE(PG8_SB(0, 0), cB, voffB); PG8_STAGE(PG8_SA(0, 0), cA, voffA); PG8_STAGE(PG8_SB(0, 1), cB + hstep, voffB); PG8_STAGE(PG8_SA(0, 1), cA + hstep, voffA);
    if (wr == 1) PG8_BAR;
    PG8_WAIT_V(4); PG8_BAR;
    PG8_STAGE(PG8_SB(1, 0), cB + kstep, voffB); PG8_STAGE(PG8_SA(1, 0), cA + kstep, voffA); PG8_STAGE(PG8_SB(1, 1), cB + hstep + kstep, voffB);
    PG8_WAIT_V(6); PG8_BAR;
    PG8_STAMP();
    for (;;) {
        const bool has_next = S.next(ui + 1, nxt);
        const char* nA = has_next ? (const char*)g.A + (size_t)nxt.pm * tstep : cA; const char* nB = has_next ? (const char*)g.Bt + (size_t)nxt.pn * tstep : cB;
        for (int t = 0; t < nt; t += 2) {
            const bool last = (t == nt - 2);
            const char* a1 = cA + (size_t)(t + 1) * kstep;
            const char* a2 = last ? nA : cA + (size_t)(t + 2) * kstep; const char* b2 = last ? nB : cB + (size_t)(t + 2) * kstep;
            const char* a3 = a2 + kstep; const char* b3 = b2 + kstep;
            if (last && has_next) S.a_ready(nxt);
            if constexpr (Epi::MIDHOOK) { if (t == 8 || t == 16) E.mid(acc, cur, t >> 3, wr, wc, fr, fq); }
            PG8_LDB(B0, 0, 0); PG8_SCHED; PG8_LDA(At, 0, 0); PG8_STAGE(PG8_SA(1, 1), a1 + hstep, voffA);
            PG8_WAIT_L(8); PG8_BAR; PG8_WAIT_L(0); PG8_MMA(0, 0, At, B0); PG8_BAR; PG8_SCHED;
            PG8_LDB(B1, 0, 1); PG8_STAGE(PG8_SB(0, 0), b2, voffB);
            PG8_BAR; PG8_WAIT_L(0); PG8_MMA(0, 1, At, B1); PG8_BAR;
            PG8_LDA(At, 0, 1); PG8_STAGE(PG8_SA(0, 0), a2, voffA);
            PG8_BAR; PG8_WAIT_L(0); PG8_MMA(1, 0, At, B0); PG8_BAR; PG8_SCHED;
            PG8_STAGE(PG8_SB(0, 1), b2 + hstep, voffB);
            PG8_WAIT_V(6); PG8_BAR; PG8_MMA(1, 1, At, B1); PG8_BAR;
            PG8_LDB(B0, 1, 0); PG8_SCHED; PG8_LDA(At, 1, 0); PG8_STAGE(PG8_SA(0, 1), a2 + hstep, voffA);
            PG8_WAIT_L(8); PG8_BAR; PG8_WAIT_L(0); PG8_MMA(0, 0, At, B0); PG8_BAR; PG8_SCHED;
            PG8_LDB(B1, 1, 1); PG8_STAGE(PG8_SB(1, 0), b3, voffB);
            PG8_BAR; PG8_WAIT_L(0); PG8_MMA(0, 1, At, B1); PG8_BAR;
            PG8_LDA(At, 1, 1); PG8_STAGE(PG8_SA(1, 0), a3, voffA);
            PG8_BAR; PG8_WAIT_L(0); PG8_MMA(1, 0, At, B0); PG8_BAR; PG8_SCHED;
            PG8_STAGE(PG8_SB(1, 1), b3 + hstep, voffB);
            PG8_WAIT_V(6); PG8_BAR; PG8_MMA(1, 1, At, B1); PG8_BAR;
        }
        PG8_STAMP();
        if constexpr (!Epi::AFTER_DRAIN) { E(acc, cur, wr, wc, fr, fq); S.done(cur); }
        PG8_STAMP();
        if (!has_next) break;
#pragma unroll
        for (int a = 0; a < 2; ++a)
#pragma unroll
            for (int b = 0; b < 2; ++b)
#pragma unroll
                for (int m = 0; m < 4; ++m)
#pragma unroll
                    for (int n = 0; n < 2; ++n) acc[a][b][m][n] = (f32x4){0.f, 0.f, 0.f, 0.f};
        cur = nxt; cA = nA; cB = nB; ++ui;
    }
    PG8_WAIT_V(0);
    if (wr == 0) PG8_BAR;
    PG8_BAR;
    if constexpr (Epi::AFTER_DRAIN) { E.fused(acc, cur, wr, wc, fr, fq, lds, wid, lane); S.done(cur); }
    PG8_STAMP();
    if (STAMP && wid == 0) { stamps[lane] = lane < nts ? (((unsigned long long)(unsigned)ts_hi << 32) | (unsigned)ts_lo) : 0ull;
        if (lane == 62) stamps[62] = rt_entry; if (lane == 63) stamps[63] = (unsigned long long)wall_clock64(); }
#undef PG8_STAMP
#undef PG8_SA
#undef PG8_SB
#undef PG8_STAGE
#undef PG8_LDA
#undef PG8_LDB
#undef PG8_MMA
#undef PG8_WAIT_V
#undef PG8_WAIT_L
#undef PG8_BAR
#undef PG8_SCHED
}
}

#define GAS __attribute__((address_space(1)))
#define LAS __attribute__((address_space(3)))
typedef unsigned short bf16;
typedef float f32x4 __attribute__((ext_vector_type(4)));
typedef unsigned u32x4 __attribute__((ext_vector_type(4)));
typedef unsigned u32x2 __attribute__((ext_vector_type(2)));

constexpr int D = 1024, NLAT = 16384, NCTX = 256, T = NLAT + NCTX, DEPTH = 4;
constexpr int IN_W = 5904, PJ = 5888;
constexpr int U0 = 0, Z0 = 512, XB0 = 1024, Q0 = 2048, K0 = 2560, V0 = 2688, GT0 = 2816;
constexpr int NE = 16, ESLOTS = 2304, CAP_L = 2048, CAP_C = 32;
constexpr int NCH = 130;
constexpr float EPS = 1e-6f;
constexpr int NWAVES = 8, NTHR = 512;
constexpr int LDS_BYTES = 155648;
constexpr int MISC_OFF = LDS_BYTES - 1024 + 512;
constexpr int NPH_LAYER = 14, NPHASES = 1 + DEPTH * NPH_LAYER + 1;

constexpr size_t al256(size_t x) { return (x + 255) & ~(size_t)255; }
constexpr size_t WS_CTL = 0, CTL_BYTES = 1u << 20;
constexpr size_t WS_MOD = WS_CTL + CTL_BYTES;
constexpr size_t WS_XC = al256(WS_MOD + (size_t)DEPTH * 2 * 6144 * 4);
constexpr size_t WS_WIN = al256(WS_XC + (size_t)NCTX * D * 4);
constexpr size_t WS_WGLU = al256(WS_WIN + (size_t)PJ * D * 2);
constexpr size_t WS_WBR = al256(WS_WGLU + (size_t)512 * 512 * 2);
constexpr size_t WS_WOUT = al256(WS_WBR + (size_t)3 * 1024 * 512 * 2);
constexpr size_t WS_WUP = al256(WS_WOUT + (size_t)1024 * 1024 * 2);
constexpr size_t WS_WDN = al256(WS_WUP + (size_t)NE * 2048 * 1024 * 2);
constexpr size_t WS_H = al256(WS_WDN + (size_t)NE * 1024 * 1024 * 2);
constexpr size_t WS_PROJ = al256(WS_H + (size_t)T * D * 2);
constexpr size_t WS_XE = WS_PROJ;
constexpr size_t WS_HID = al256(WS_XE + (size_t)NE * ESLOTS * D * 2);
constexpr size_t WS_DT = al256(WS_PROJ + (size_t)T * PJ * 2);
constexpr size_t WS_CV = al256(WS_DT + (size_t)T * 16 * 4);
constexpr size_t WS_S5E = al256(WS_CV + (size_t)T * 1024 * 2);
constexpr size_t WS_S5H = al256(WS_S5E + (size_t)2 * 32 * NCH * 128 * 4);
constexpr size_t WS_YD = al256(WS_S5H + (size_t)2 * 32 * NCH * 128 * 4);
constexpr size_t WS_SA = al256(WS_YD + (size_t)2 * T * 512 * 4);
constexpr size_t WS_Y3 = al256(WS_SA + (size_t)T * 512 * 2);
constexpr size_t WS_PM = al256(WS_Y3 + (size_t)3 * T * 512 * 2);
constexpr size_t WS_MB = al256(WS_PM + (size_t)T * D * 4);
constexpr size_t WS_YE = WS_PM;
constexpr size_t WS_AFFT = al256(WS_MB + (size_t)T * D * 2);
constexpr size_t WS_IDX = al256(WS_AFFT + (size_t)NE * T * 4);
constexpr size_t WS_GSEL = al256(WS_IDX + (size_t)NE * ESLOTS * 4);
constexpr size_t WS_INV = al256(WS_GSEL + (size_t)NE * ESLOTS * 4);
constexpr size_t WS_DEC = al256(WS_INV + (size_t)T * 16 * 4);
constexpr size_t WS_S5BB = al256(WS_DEC + (size_t)2 * NCH * 8 * 4);
constexpr size_t WS_S5CC = al256(WS_S5BB + (size_t)2 * 32 * 128 * 32 * 2);
constexpr size_t WS_S5AB = al256(WS_S5CC + (size_t)2 * 32 * 16 * 128 * 2);
constexpr size_t WS_ROPE = al256(WS_S5AB + (size_t)2 * 32 * 64 * 2 * 4);
constexpr size_t WS_W2 = al256(WS_ROPE + (size_t)2 * 256 * 16 * 4);
constexpr size_t WBUF_BYTES = WS_H - WS_WIN;
constexpr size_t WS_END = al256(WS_W2 + WBUF_BYTES);
constexpr size_t WS_SST = WS_YD;
constexpr size_t WS_HIN = WS_PM;
constexpr size_t WS_YS = al256(WS_HIN + (size_t)2 * NCH * 8 * 8192 * 2);
static_assert(WS_YS + (size_t)T * 512 * 2 <= WS_AFFT, "HIN|YS overlay fits PM|MB");
static_assert(WS_HID + (size_t)NE * ESLOTS * D * 2 <= WS_DT, "XE|HID overlay fits PROJ");
static_assert(WS_YE + (size_t)NE * ESLOTS * D * 2 <= WS_AFFT, "YE overlay fits PM|MB");
static_assert(WS_END < (size_t)1000 * 1024 * 1024, "workspace");
constexpr int CW_BAR = 4096;

__device__ __forceinline__ float bf2f(unsigned b) { return __uint_as_float(b << 16); }
__device__ __forceinline__ float bflo(unsigned w) { return __uint_as_float(w << 16); }
__device__ __forceinline__ float bfhi(unsigned w) { return __uint_as_float(w & 0xffff0000u); }
typedef float f32x2_c __attribute__((ext_vector_type(2)));
typedef __bf16 bf16x2_c __attribute__((ext_vector_type(2)));
__device__ __forceinline__ unsigned pk2(float lo, float hi) { f32x2_c v; v[0] = lo; v[1] = hi; return __builtin_bit_cast(unsigned, __builtin_convertvector(v, bf16x2_c)); }
__device__ __forceinline__ unsigned f2bf(float f) { return pk2(f, 0.f) & 0xffffu; }
__device__ __forceinline__ float wsum(float v) {
#pragma unroll
    for (int o = 1; o < 64; o <<= 1) v += __shfl_xor(v, o);
    return v;
}
__device__ __forceinline__ float wmaxf(float v) {
#pragma unroll
    for (int o = 1; o < 64; o <<= 1) v = fmaxf(v, __shfl_xor(v, o));
    return v;
}
__device__ __forceinline__ float silu_f(float x) { return x * __builtin_amdgcn_rcpf(1.f + __expf(-x)); }
__device__ __forceinline__ float sigmoid_f(float x) { return __builtin_amdgcn_rcpf(1.f + __expf(-x)); }
__device__ __forceinline__ float softplus_f(float x) { return x > 20.f ? x : log1pf(expf(x)); }
__device__ __forceinline__ float gelu_tanh_f(float x) { const float u = 0.7978845608028654f * (x + 0.044715f * x * x * x); return x * __builtin_amdgcn_rcpf(1.f + __expf(-2.f * u)); }
#define LDS_FENCE() asm volatile("s_waitcnt lgkmcnt(0)" ::: "memory")
__device__ __forceinline__ int scan_row(int d, int s) { return d == 0 ? s : (s < NCTX ? (NCTX - 1 - s) : (T + NCTX - 1 - s)); }

namespace pg8 {
struct EpiStoreBf16 {
    static constexpr bool PERM = true, AFTER_DRAIN = false, MIDHOOK = false;
    bf16_t* O; int ldc; int sig_tile; const float* rope;
    __device__ __forceinline__ void operator()(const f32x4 (&acc)[2][2][4][2], const Unit& u, int wr, int wc, int fr, int fq) const {
        const int row0 = u.pm * BM + wr * 64 + fr, col0 = u.pn * BM + wc * 32 + 8 * fq; const bool sg = u.pn >= sig_tile;
        const bool rq = rope != nullptr && u.pm >= 1 && (u.pn == Q0 / 256 || u.pn == Q0 / 256 + 1), rk = rope != nullptr && u.pm >= 1 && u.pn == K0 / 256;
#pragma unroll
        for (int ai = 0; ai < 2; ++ai)
#pragma unroll
            for (int m = 0; m < 4; ++m) { const int row = row0 + ai * HALF + m * 16; bf16_t* rowp = O + (size_t)row * ldc + col0;
#pragma unroll
                for (int bj = 0; bj < 2; ++bj) { f32x4 v0 = acc[ai][bj][m][0], v1 = acc[ai][bj][m][1];
                    if (sg) {
#pragma unroll
                        for (int q = 0; q < 4; ++q) { v0[q] = __builtin_amdgcn_rcpf(1.f + __expf(-v0[q])); v1[q] = __builtin_amdgcn_rcpf(1.f + __expf(-v1[q])); } }
                    if (rq || (rk && bj == 0)) {
                        const int t = row - NCTX, idx = (wc & 1) ? (t & 63) : (t >> 6);
                        const float* cp = rope + idx * 16 + 8 * (fq & 1);
                        const f32x4 c0 = *(const f32x4*)cp, c1 = *(const f32x4*)(cp + 4), s0 = *(const f32x4*)(cp + 4096), s1 = *(const f32x4*)(cp + 4100);
                        const float sgn = (fq & 2) ? 1.f : -1.f;
#pragma unroll
                        for (int q = 0; q < 4; ++q) { const float p0 = __shfl_xor(v0[q], 32), p1 = __shfl_xor(v1[q], 32);
                            v0[q] = v0[q] * c0[q] + sgn * p0 * s0[q]; v1[q] = v1[q] * c1[q] + sgn * p1 * s1[q]; } }
                    u32x4 w; w.x = cvt_pk_bf16(v0[0], v0[1]); w.y = cvt_pk_bf16(v0[2], v0[3]); w.z = cvt_pk_bf16(v1[0], v1[1]); w.w = cvt_pk_bf16(v1[2], v1[3]);
                    *(u32x4*)(rowp + bj * HALF) = w; } }
    }
};
struct EpiGlu {
    static constexpr bool PERM = true, AFTER_DRAIN = false, MIDHOOK = false;
    const bf16_t* A; const float* bias; bf16_t* O;
    __device__ __forceinline__ void operator()(const f32x4 (&acc)[2][2][4][2], const Unit& u, int wr, int wc, int fr, int fq) const {
        const int row0 = u.pm * BM + wr * 64 + fr, col0 = u.pn * BM + wc * 32 + 8 * fq;
#pragma unroll
        for (int ai = 0; ai < 2; ++ai)
#pragma unroll
            for (int m = 0; m < 4; ++m) { const size_t ro = (size_t)(row0 + ai * HALF + m * 16) * 512 + col0;
#pragma unroll
                for (int bj = 0; bj < 2; ++bj) { const f32x4 v0 = acc[ai][bj][m][0], v1 = acc[ai][bj][m][1];
                    const u32x4 a = *(const u32x4*)(A + ro + bj * HALF);
                    const f32x4 b0 = *(const f32x4*)(bias + col0 + bj * HALF), b1 = *(const f32x4*)(bias + col0 + bj * HALF + 4);
                    float o[8];
                    o[0] = bflo(a.x) * sigmoid_f(v0[0] + b0[0]); o[1] = bfhi(a.x) * sigmoid_f(v0[1] + b0[1]);
                    o[2] = bflo(a.y) * sigmoid_f(v0[2] + b0[2]); o[3] = bfhi(a.y) * sigmoid_f(v0[3] + b0[3]);
                    o[4] = bflo(a.z) * sigmoid_f(v1[0] + b1[0]); o[5] = bfhi(a.z) * sigmoid_f(v1[1] + b1[1]);
                    o[6] = bflo(a.w) * sigmoid_f(v1[2] + b1[2]); o[7] = bfhi(a.w) * sigmoid_f(v1[3] + b1[3]);
                    u32x4 w; w.x = cvt_pk_bf16(o[0], o[1]); w.y = cvt_pk_bf16(o[2], o[3]); w.z = cvt_pk_bf16(o[4], o[5]); w.w = cvt_pk_bf16(o[6], o[7]);
                    *(u32x4*)(O + (size_t)(row0 + ai * HALF + m * 16) * 1536 + col0 + bj * HALF) = w; } }
    }
};
struct RowOffOrder {
    StaticOrder b; int off;
    __device__ __forceinline__ void init(int M, int N, int G, int c, int off_) { b.init(M, N, G, c); off = off_; }
    __device__ __forceinline__ bool next(int i, Unit& u) const { if (!b.next(i, u)) return false; u.pm += off; return true; }
    __device__ __forceinline__ void a_ready(const Unit&) const {}
    __device__ __forceinline__ void done(const Unit&) const {}
};
struct EpiMerge {
    static constexpr bool PERM = true, AFTER_DRAIN = false, MIDHOOK = true;
    const bf16_t* proj; bf16_t* MB;
    __device__ __forceinline__ void mid(f32x4 (&acc)[2][2][4][2], const Unit& u, int seg, int wr, int wc, int fr, int fq) const {
        const unsigned base = (unsigned)((u.pm * BM + wr * 64 + fr) * PJ + GT0 + (seg - 1) * 1024 + u.pn * BM + wc * 32 + 8 * fq) * 2u;
        const char* pb = (const char*)proj;
#pragma unroll
        for (int ai = 0; ai < 2; ++ai)
#pragma unroll
            for (int m = 0; m < 4; ++m) {
                u32x4 ga[2], gb[2];
#pragma unroll
                for (int bj = 0; bj < 2; ++bj) { const unsigned o = base + (unsigned)(((ai * HALF + m * 16) * PJ + bj * HALF) * 2);
                    ga[bj] = *(const u32x4*)(pb + o); gb[bj] = *(const u32x4*)(pb + o + 2048u); }
#pragma unroll
                for (int bj = 0; bj < 2; ++bj) { const u32x4 a = ga[bj], b = gb[bj];
                    f32x4& v0 = acc[ai][bj][m][0]; f32x4& v1 = acc[ai][bj][m][1];
                    v0[0] *= bflo(a.x) * __builtin_amdgcn_rcpf(bflo(b.x)); v0[1] *= bfhi(a.x) * __builtin_amdgcn_rcpf(bfhi(b.x));
                    v0[2] *= bflo(a.y) * __builtin_amdgcn_rcpf(bflo(b.y)); v0[3] *= bfhi(a.y) * __builtin_amdgcn_rcpf(bfhi(b.y));
                    v1[0] *= bflo(a.z) * __builtin_amdgcn_rcpf(bflo(b.z)); v1[1] *= bfhi(a.z) * __builtin_amdgcn_rcpf(bfhi(b.z));
                    v1[2] *= bflo(a.w) * __builtin_amdgcn_rcpf(bflo(b.w)); v1[3] *= bfhi(a.w) * __builtin_amdgcn_rcpf(bfhi(b.w)); }
                if (m & 1) asm volatile("" ::: "memory");
            }
    }
    __device__ __forceinline__ void operator()(const f32x4 (&acc)[2][2][4][2], const Unit& u, int wr, int wc, int fr, int fq) const {
        const int row0 = u.pm * BM + wr * 64 + fr, col0 = u.pn * BM + wc * 32 + 8 * fq;
#pragma unroll
        for (int ai = 0; ai < 2; ++ai)
#pragma unroll
            for (int m = 0; m < 4; ++m) { const int row = row0 + ai * HALF + m * 16;
#pragma unroll
                for (int bj = 0; bj < 2; ++bj) { const f32x4 v0 = acc[ai][bj][m][0], v1 = acc[ai][bj][m][1]; const int col = col0 + bj * HALF;
                    const u32x4 g = *(const u32x4*)(proj + (size_t)row * PJ + GT0 + 2048 + col);
                    u32x4 w; w.x = cvt_pk_bf16(bflo(g.x) * v0[0], bfhi(g.x) * v0[1]); w.y = cvt_pk_bf16(bflo(g.y) * v0[2], bfhi(g.y) * v0[3]);
                    w.z = cvt_pk_bf16(bflo(g.z) * v1[0], bfhi(g.z) * v1[1]); w.w = cvt_pk_bf16(bflo(g.w) * v1[2], bfhi(g.w) * v1[3]);
                    *(u32x4*)(MB + (size_t)row * 1024 + col) = w; } }
    }
};
struct EpiResid {
    static constexpr bool PERM = false, AFTER_DRAIN = false, MIDHOOK = false;
    float* XL; float* XC; const float* g_lat; const float* g_ctx;
    __device__ __forceinline__ void operator()(const f32x4 (&acc)[2][2][4][2], const Unit& u, int wr, int wc, int fr, int fq) const {
        const bool isc = (u.pm == 0);
        float* base = isc ? XC : (XL - (size_t)NCTX * D); const float* gv = isc ? g_ctx : g_lat;
        const int row0 = u.pm * BM + wr * 64 + fr, col0 = u.pn * BM + wc * 32 + 4 * fq;
#pragma unroll
        for (int ai = 0; ai < 2; ++ai)
#pragma unroll
            for (int m = 0; m < 4; ++m) { float* rowp = base + (size_t)(row0 + ai * HALF + m * 16) * D + col0;
#pragma unroll
                for (int bj = 0; bj < 2; ++bj)
#pragma unroll
                    for (int n = 0; n < 2; ++n) { float* pp = rowp + bj * HALF + n * 16; const f32x4 g = *(const f32x4*)(gv + col0 + bj * HALF + n * 16);
                        f32x4 x = *(const f32x4*)pp; x += g * acc[ai][bj][m][n]; *(f32x4*)pp = x; } }
    }
};
struct ExpertOrder {
    int G, c, nnt, nmt;
    __device__ __forceinline__ bool next(int i, Unit& u) const { const int L = i * G + c; if (L >= NE * nmt * nnt) return false; const int e = L / (nmt * nnt), rem = L % (nmt * nnt); u.pm = e * 9 + rem % nmt; u.pn = e * nnt + rem / nmt; return true; }
    __device__ __forceinline__ void a_ready(const Unit&) const {}
    __device__ __forceinline__ void done(const Unit&) const {}
};
struct EpiSwiGlu {
    static constexpr bool PERM = true, AFTER_DRAIN = false, MIDHOOK = false;
    bf16_t* HID;
    __device__ __forceinline__ void operator()(const f32x4 (&acc)[2][2][4][2], const Unit& u, int wr, int wc, int fr, int fq) const {
        const int row0 = u.pm * BM + wr * 64 + fr, col0 = (u.pn & 7) * 128 + wc * 32 + 8 * fq;
#pragma unroll
        for (int ai = 0; ai < 2; ++ai)
#pragma unroll
            for (int m = 0; m < 4; ++m) { const f32x4 g0 = acc[ai][0][m][0], g1 = acc[ai][0][m][1], u0 = acc[ai][1][m][0], u1 = acc[ai][1][m][1];
                u32x4 w;
                w.x = cvt_pk_bf16(silu_f(g0[0]) * u0[0], silu_f(g0[1]) * u0[1]); w.y = cvt_pk_bf16(silu_f(g0[2]) * u0[2], silu_f(g0[3]) * u0[3]);
                w.z = cvt_pk_bf16(silu_f(g1[0]) * u1[0], silu_f(g1[1]) * u1[1]); w.w = cvt_pk_bf16(silu_f(g1[2]) * u1[2], silu_f(g1[3]) * u1[3]);
                *(u32x4*)(HID + (size_t)(row0 + ai * HALF + m * 16) * 1024 + col0) = w; }
    }
};
struct EpiDown {
    static constexpr bool PERM = true, AFTER_DRAIN = false, MIDHOOK = false;
    bf16_t* YE; const float* gsel;
    __device__ __forceinline__ void operator()(const f32x4 (&acc)[2][2][4][2], const Unit& u, int wr, int wc, int fr, int fq) const {
        const int row0 = u.pm * BM + wr * 64 + fr, col0 = (u.pn & 3) * BM + wc * 32 + 8 * fq;
#pragma unroll
        for (int ai = 0; ai < 2; ++ai)
#pragma unroll
            for (int m = 0; m < 4; ++m) { const int row = row0 + ai * HALF + m * 16; const float gs = gsel[row];
#pragma unroll
                for (int bj = 0; bj < 2; ++bj) { const f32x4 v0 = acc[ai][bj][m][0] * gs, v1 = acc[ai][bj][m][1] * gs;
                    u32x4 w; w.x = cvt_pk_bf16(v0[0], v0[1]); w.y = cvt_pk_bf16(v0[2], v0[3]); w.z = cvt_pk_bf16(v1[0], v1[1]); w.w = cvt_pk_bf16(v1[2], v1[3]);
                    *(u32x4*)(YE + (size_t)row * 1024 + col0 + bj * HALF) = w; } }
    }
};
}
#define XB_TMO      128
#define XB_XCNT(j)  (256  + 64 * (j))
#define XB_XSUB(j)  (1280 + 64 * (j))
#define XB_XGEN(j)  (2304 + 64 * (j))
#define XB_TOP      3328
#define XB_TOPGEN   3392
#define XCD_BAR_WORDS 3456
#define XB_SPIN_CAP (1u << 18)
#define LAS __attribute__((address_space(3)))

__device__ __forceinline__ unsigned xb_ld(unsigned* p)              { return __hip_atomic_load(p, __ATOMIC_RELAXED, __HIP_MEMORY_SCOPE_AGENT); }
__device__ __forceinline__ unsigned xb_add(unsigned* p, unsigned v) { return __hip_atomic_fetch_add(p, v, __ATOMIC_RELAXED, __HIP_MEMORY_SCOPE_AGENT); }
__device__ __forceinline__ unsigned xb_xcc_id() { return (unsigned)__builtin_amdgcn_s_getreg((3 << 11) | 20) & 0xFu; }
#define XB_SPIN(cond, bar) do { unsigned _sp = 0; while (cond) { __builtin_amdgcn_s_sleep(1); \
    if ((++_sp & 255u) == 0u) { if (xb_ld(&(bar)[XB_TMO])) break; if (_sp > XB_SPIN_CAP) { atomicAdd(&(bar)[XB_TMO], 1u); break; } } } } while (0)

struct XcdBarrier {
    unsigned* bar; unsigned x;
    volatile LAS unsigned* st;
};

__device__ __forceinline__ XcdBarrier xcd_barrier_post(unsigned* bar, volatile LAS unsigned* st) {
    XcdBarrier b; b.bar = bar; b.x = xb_xcc_id(); b.st = st;
    if (threadIdx.x == 0) (void)xb_add(&bar[XB_XCNT(b.x)], 1u);
    return b;
}
__device__ __forceinline__ void xcd_barrier_complete(unsigned* bar, unsigned x, unsigned& nloc, unsigned& nx) {
    const unsigned G = gridDim.x * gridDim.y * gridDim.z;
    unsigned sum, cnt, mine, sp = 0u;
    for (;;) {
        sum = 0u; cnt = 0u; mine = 0u;
#pragma unroll
        for (unsigned j = 0; j < 16; ++j) { const unsigned c = xb_ld(&bar[XB_XCNT(j)]); sum += c; cnt += (c > 0u) ? 1u : 0u; mine = (j == x) ? c : mine; }
        if (sum == G) break;
        __builtin_amdgcn_s_sleep(1);
        if ((++sp & 255u) == 0u) { if (xb_ld(&bar[XB_TMO])) break; if (sp > XB_SPIN_CAP) { atomicAdd(&bar[XB_TMO], 1u); break; } }
    }
    nloc = mine > 0u ? mine : 1u; nx = cnt > 0u ? cnt : 1u;
}

__device__ __forceinline__ void xcd_barrier(const XcdBarrier& b) {
    asm volatile("s_waitcnt vmcnt(0)" ::: "memory");
    __syncthreads();
    if (threadIdx.x == 0) {
        unsigned* bar = b.bar;
        __builtin_amdgcn_s_waitcnt(0);
        unsigned nloc = b.st[0], nx = b.st[1];
        if (nloc == 0u) { xcd_barrier_complete(bar, b.x, nloc, nx); b.st[0] = nloc; b.st[1] = nx; }
        const unsigned old = xb_add(&bar[XB_XSUB(b.x)], 1u);
        const unsigned gen = old / nloc;
        if (old + 1u == (gen + 1u) * nloc) {
            __builtin_amdgcn_fence(__ATOMIC_RELEASE, "agent");
            asm volatile("s_waitcnt vmcnt(0)" ::: "memory");
            const unsigned og = xb_add(&bar[XB_TOP], 1u);
            const unsigned tg = og / nx;
            if (og + 1u == (tg + 1u) * nx) xb_add(&bar[XB_TOPGEN], 1u);
            else XB_SPIN(xb_ld(&bar[XB_TOPGEN]) == tg, bar);
            __builtin_amdgcn_fence(__ATOMIC_ACQUIRE, "agent");
            xb_add(&bar[XB_XGEN(b.x)], 1u);
            asm volatile("s_waitcnt vmcnt(0)" ::: "memory");
        } else {
            XB_SPIN(xb_ld(&bar[XB_XGEN(b.x)]) == gen, bar);
            __builtin_amdgcn_fence(__ATOMIC_ACQUIRE, "agent");
            asm volatile("s_waitcnt vmcnt(0)" ::: "memory");
        }
    }
    __syncthreads();
}


struct P {
    const float *x, *c, *ctx, *c_ctx, *w_mod, *b_mod, *norm1_g, *norm2_g, *w_in, *lam_re, *lam_im, *log_dt, *b_re, *b_im, *c_re, *c_im, *s5_d, *w_glu, *b_glu,
        *conv_w, *conv_b, *a_log, *dt_bias, *ssd_d, *ssd_norm_g, *sink, *w_branch, *w_out, *w_router, *w_eg, *w_eu, *w_ed, *final_g;
    float* XL;
    float *MOD, *XC, *DT, *S5E, *S5H, *YD, *PM, *AFFT, *GSEL;
    bf16 *WIN, *WGLU, *WBR, *WOUT, *WUP, *WDN, *H, *PROJ, *XE, *HID, *CV, *SA, *Y3, *MB, *YE;
    int *IDX, *INV;
    int tid, lane, wave, bid, G;
};


constexpr int PTAB_OFF = LDS_BYTES - 1024;
__device__ __forceinline__ unsigned long long ld_tab(volatile LAS unsigned* t, int k) {
    const unsigned lo = __builtin_amdgcn_readfirstlane(t[2 * k]), hi = __builtin_amdgcn_readfirstlane(t[2 * k + 1]);
    return ((unsigned long long)hi << 32) | lo;
}
__device__ __forceinline__ void build_P(P& p, LAS unsigned char* lds, int wset = 0) {
    int tid_l = threadIdx.x, bid_l = blockIdx.x, g_l = gridDim.x;
    asm volatile("" : "+v"(tid_l), "+s"(bid_l), "+s"(g_l));
    p.tid = tid_l; p.lane = p.tid & 63; p.wave = __builtin_amdgcn_readfirstlane(p.tid >> 6); p.bid = bid_l; p.G = g_l;
    unsigned tbase = (unsigned)(size_t)(lds + PTAB_OFF); asm volatile("" : "+v"(tbase));
    volatile LAS unsigned* tb = (volatile LAS unsigned*)(size_t)tbase;
#define INP(k) ((const float*)ld_tab(tb, k))
    p.x = INP(0); p.c = INP(1); p.ctx = INP(2); p.c_ctx = INP(3); p.w_mod = INP(4); p.b_mod = INP(5); p.norm1_g = INP(6); p.norm2_g = INP(7);
    p.w_in = INP(8); p.lam_re = INP(9); p.lam_im = INP(10); p.log_dt = INP(11); p.b_re = INP(12); p.b_im = INP(13); p.c_re = INP(14); p.c_im = INP(15);
    p.s5_d = INP(16); p.w_glu = INP(17); p.b_glu = INP(18); p.conv_w = INP(19); p.conv_b = INP(20); p.a_log = INP(21); p.dt_bias = INP(22); p.ssd_d = INP(23);
    p.ssd_norm_g = INP(24); p.sink = INP(25); p.w_branch = INP(26); p.w_out = INP(27); p.w_router = INP(28); p.w_eg = INP(29); p.w_eu = INP(30); p.w_ed = INP(31);
    p.final_g = INP(32);
#undef INP
    p.XL = (float*)ld_tab(tb, 33);
    unsigned char* ws = (unsigned char*)ld_tab(tb, 34);
    p.MOD = (float*)(ws + WS_MOD); p.XC = (float*)(ws + WS_XC); p.DT = (float*)(ws + WS_DT); p.S5E = (float*)(ws + WS_S5E); p.S5H = (float*)(ws + WS_S5H); p.YD = (float*)(ws + WS_YD);
    p.PM = (float*)(ws + WS_PM); p.AFFT = (float*)(ws + WS_AFFT); p.GSEL = (float*)(ws + WS_GSEL);
    { unsigned char* wb = ws + (wset ? (WS_W2 - WS_WIN) : 0);
      p.WIN = (bf16*)(wb + WS_WIN); p.WGLU = (bf16*)(wb + WS_WGLU); p.WBR = (bf16*)(wb + WS_WBR); p.WOUT = (bf16*)(wb + WS_WOUT); p.WUP = (bf16*)(wb + WS_WUP); p.WDN = (bf16*)(wb + WS_WDN); }
    p.H = (bf16*)(ws + WS_H); p.PROJ = (bf16*)(ws + WS_PROJ); p.XE = (bf16*)(ws + WS_XE); p.HID = (bf16*)(ws + WS_HID); p.CV = (bf16*)(ws + WS_CV); p.SA = (bf16*)(ws + WS_SA);
    p.Y3 = (bf16*)(ws + WS_Y3); p.MB = (bf16*)(ws + WS_MB); p.YE = (bf16*)(ws + WS_YE);
    p.IDX = (int*)(ws + WS_IDX); p.INV = (int*)(ws + WS_INV);
}
__device__ __forceinline__ void phase_mod(const P& p, LAS unsigned char* lds, float* ropet) {
    for (int i = p.bid * NTHR + p.tid; i < 256 * 16; i += p.G * NTHR) { const float inv = exp2f(-(float)(i & 15) * 0.83048202372184058696f);
        float sn, cs; sincosf((float)(i >> 4) * inv, &sn, &cs); ropet[i] = cs; ropet[4096 + i] = sn; }
    LAS float* sc = (LAS float*)lds;
    LAS float* part = sc + 2048;
    for (int i = p.tid; i < 1024; i += NTHR) { sc[i] = silu_f(p.c[i]); sc[1024 + i] = silu_f(p.c_ctx[i]); }
    __syncthreads();
    for (int it = p.bid; it < DEPTH * 48; it += p.G) {
        const int l = it / 48, cb = it % 48, c0 = cb * 128 + 2 * p.lane;
        const float* W = p.w_mod + (size_t)l * 1024 * 6144 + c0;
        float a00 = 0.f, a01 = 0.f, a10 = 0.f, a11 = 0.f;
        const int kb = p.wave * 128;
#pragma unroll 8
        for (int k = kb; k < kb + 128; ++k) { const float2 w = *(const float2*)(W + (size_t)k * 6144); const float s0 = sc[k], s1 = sc[1024 + k];
            a00 += s0 * w.x; a01 += s0 * w.y; a10 += s1 * w.x; a11 += s1 * w.y; }
        part[(p.wave * 2 + 0) * 128 + 2 * p.lane] = a00; part[(p.wave * 2 + 0) * 128 + 2 * p.lane + 1] = a01;
        part[(p.wave * 2 + 1) * 128 + 2 * p.lane] = a10; part[(p.wave * 2 + 1) * 128 + 2 * p.lane + 1] = a11;
        __syncthreads();
        if (p.tid < 256) { const int s = p.tid >> 7, col = p.tid & 127; float r = p.b_mod[l * 6144 + cb * 128 + col];
#pragma unroll
            for (int w = 0; w < 8; ++w) r += part[(w * 2 + s) * 128 + col];
            p.MOD[(size_t)(l * 2 + s) * 6144 + cb * 128 + col] = r; }
        __syncthreads();
    }
}

__device__ __forceinline__ void tr_item(const float* src, int ldw, int K, bf16* dst, int kb, LAS float* scr, int lane) {
    const int k0 = 64 * kb, kr = lane >> 4, nq = lane & 15;
    f32x4 v[16];
#pragma unroll
    for (int i = 0; i < 16; ++i) v[i] = *(const f32x4*)(src + (size_t)(k0 + 4 * i + kr) * ldw + 4 * nq);
#pragma unroll
    for (int i = 0; i < 16; ++i) { const int k = 4 * i + kr, c = (k >> 3) & 7; *(LAS f32x4*)(scr + k * 64 + 4 * (nq ^ c)) = v[i]; }
    LDS_FENCE();
    const int c = lane & 7;
#pragma unroll
    for (int j = 0; j < 8; ++j) { const int n = (lane >> 3) + 8 * j; const LAS float* s = scr + (8 * c) * 64 + (n ^ (c << 2));
        u32x4 o; o.x = pk2(s[0 * 64], s[1 * 64]); o.y = pk2(s[2 * 64], s[3 * 64]); o.z = pk2(s[4 * 64], s[5 * 64]); o.w = pk2(s[6 * 64], s[7 * 64]);
        *(u32x4*)(dst + (size_t)n * K + k0 + 8 * c) = o; }
    LDS_FENCE();
}
__device__ __forceinline__ void convert_weights(const P& p, int l, LAS unsigned char* lds, int gw, int NGW) {
    LAS float* scr = (LAS float*)(lds + p.wave * 16384);
    constexpr int I_A = 32 * 16, I_B = 60 * 16, I_GLU = 8 * 8, I_BR = 3 * 16 * 8, I_OUT = 16 * 16, I_E = 16 * 16 * 16;
    constexpr int NIT = I_A + I_B + I_GLU + I_BR + I_OUT + 3 * I_E;
    const float* win = p.w_in + (size_t)l * 1024 * IN_W;
    for (int it = gw; it < NIT; it += NGW) {
        int r = it;
        if (r < I_A) { const int nb = r >> 4, kb = r & 15; tr_item(win + 64 * nb, IN_W, 1024, p.WIN + (size_t)(64 * nb) * 1024, kb, scr, p.lane); continue; } r -= I_A;
        if (r < I_B) { const int nb = r >> 4, kb = r & 15; tr_item(win + 2064 + 64 * nb, IN_W, 1024, p.WIN + (size_t)(2048 + 64 * nb) * 1024, kb, scr, p.lane); continue; } r -= I_B;
        if (r < I_GLU) { const int nb = r >> 3, kb = r & 7; tr_item(p.w_glu + (size_t)l * 512 * 512 + 64 * nb, 512, 512, p.WGLU + (size_t)(64 * nb) * 512, kb, scr, p.lane); continue; } r -= I_GLU;
        if (r < I_BR) { const int kk = r >> 7, nb = (r >> 3) & 15, kb = r & 7;
            tr_item(p.w_branch + ((size_t)l * 3 + kk) * 512 * 1024 + 64 * nb, 1024, 1536, p.WBR + (size_t)(64 * nb) * 1536 + kk * 512, kb, scr, p.lane); continue; } r -= I_BR;
        if (r < I_OUT) { const int nb = r >> 4, kb = r & 15; tr_item(p.w_out + (size_t)l * 1024 * 1024 + 64 * nb, 1024, 1024, p.WOUT + (size_t)(64 * nb) * 1024, kb, scr, p.lane); continue; } r -= I_OUT;
        const int which = r / I_E; r -= which * I_E;
        const int e = r >> 8, nb = (r >> 4) & 15, kb = r & 15;
        const size_t eo = ((size_t)l * NE + e) * 1024 * 1024;
        if (which == 0) tr_item(p.w_eg + eo + 64 * nb, 1024, 1024, p.WUP + (size_t)(e * 2048 + 256 * (nb >> 1) + 64 * (nb & 1)) * 1024, kb, scr, p.lane);
        else if (which == 1) tr_item(p.w_eu + eo + 64 * nb, 1024, 1024, p.WUP + (size_t)(e * 2048 + 256 * (nb >> 1) + 128 + 64 * (nb & 1)) * 1024, kb, scr, p.lane);
        else tr_item(p.w_ed + eo + 64 * nb, 1024, 1024, p.WDN + (size_t)(e * 1024 + 64 * nb) * 1024, kb, scr, p.lane);
    }
}

__device__ __forceinline__ float reduce16(float (&a)[16], int lane) {
    float b[8], c[4], d[2];
#pragma unroll
    for (int j = 0; j < 8; ++j) { const bool hi = lane & 32; const float send = hi ? a[j] : a[j + 8], keep = hi ? a[j + 8] : a[j]; b[j] = keep + __shfl_xor(send, 32); }
#pragma unroll
    for (int j = 0; j < 4; ++j) { const bool hi = lane & 16; const float send = hi ? b[j] : b[j + 4], keep = hi ? b[j + 4] : b[j]; c[j] = keep + __shfl_xor(send, 16); }
#pragma unroll
    for (int j = 0; j < 2; ++j) { const bool hi = lane & 8; const float send = hi ? c[j] : c[j + 2], keep = hi ? c[j + 2] : c[j]; d[j] = keep + __shfl_xor(send, 8); }
    const bool hi = lane & 4; const float send = hi ? d[0] : d[1], keep = hi ? d[1] : d[0];
    float r = keep + __shfl_xor(send, 4);
    r += __shfl_xor(r, 2); r += __shfl_xor(r, 1);
    return r;
}
template <int MODE> __device__ __forceinline__ void row_pass(const P& p, int l, LAS unsigned char* lds, bool with_ctx = true) {
    LAS float* W16 = (LAS float*)lds;
    if (MODE != 2) {
        const float* src = (MODE == 0) ? (p.w_in + (size_t)l * 1024 * IN_W + 2048) : (p.w_router + (size_t)l * 1024 * 16);
        const int ld = (MODE == 0) ? IN_W : 16;
        for (int i = p.tid; i < 1024 * 16; i += NTHR) { const int k = i >> 4, j = i & 15; const int rr = (k & 7) * 128 + ((k >> 3) & 63) + 64 * (k >> 9); W16[rr * 20 + j] = src[(size_t)k * ld + j]; }
        __syncthreads();
    }
    const int gw = p.bid * NWAVES + p.wave, NGW = p.G * NWAVES, lane = p.lane;
    for (int row = gw + ((MODE == 2 || !with_ctx) ? NCTX : 0); row < T; row += NGW) {
        const bool isc = row < NCTX;
        float* xrow = isc ? (p.XC + (size_t)row * D) : (p.XL + (size_t)(row - NCTX) * D);
        float v[16];
        { const float* s = (MODE == 0 && l == 0) ? (isc ? (p.ctx + (size_t)row * D) : (p.x + (size_t)(row - NCTX) * D)) : xrow;
#pragma unroll
          for (int i = 0; i < 2; ++i) { const f32x4 a = *(const f32x4*)(s + 512 * i + 8 * lane), b = *(const f32x4*)(s + 512 * i + 8 * lane + 4);
              v[8 * i] = a[0]; v[8 * i + 1] = a[1]; v[8 * i + 2] = a[2]; v[8 * i + 3] = a[3]; v[8 * i + 4] = b[0]; v[8 * i + 5] = b[1]; v[8 * i + 6] = b[2]; v[8 * i + 7] = b[3]; } }
        if ((MODE == 0 && l > 0) || MODE == 2) {
            const int lp = (MODE == 2) ? (DEPTH - 1) : (l - 1);
            const float* g2 = p.MOD + (size_t)(lp * 2 + (isc ? 1 : 0)) * 6144 + 5 * D;
            float s[16];
#pragma unroll
            for (int i = 0; i < 16; ++i) s[i] = 0.f;
            for (int e = 0; e < NE; ++e) { const int slot = p.INV[(size_t)row * 16 + e];
                if (slot >= 0) { const bf16* yr = p.YE + ((size_t)e * ESLOTS + slot) * D;
#pragma unroll
                    for (int i = 0; i < 2; ++i) { const u32x4 w = *(const u32x4*)(yr + 512 * i + 8 * lane);
                        s[8 * i] += bflo(w.x); s[8 * i + 1] += bfhi(w.x); s[8 * i + 2] += bflo(w.y); s[8 * i + 3] += bfhi(w.y);
                        s[8 * i + 4] += bflo(w.z); s[8 * i + 5] += bfhi(w.z); s[8 * i + 6] += bflo(w.w); s[8 * i + 7] += bfhi(w.w); } } }
#pragma unroll
            for (int i = 0; i < 2; ++i) { const f32x4 a = *(const f32x4*)(g2 + 512 * i + 8 * lane), b = *(const f32x4*)(g2 + 512 * i + 8 * lane + 4);
#pragma unroll
                for (int q = 0; q < 4; ++q) { v[8 * i + q] += a[q] * s[8 * i + q]; v[8 * i + 4 + q] += b[q] * s[8 * i + 4 + q]; } }
        }
        if (MODE == 0) {
#pragma unroll
            for (int i = 0; i < 2; ++i) { *(f32x4*)(xrow + 512 * i + 8 * lane) = (f32x4){v[8 * i], v[8 * i + 1], v[8 * i + 2], v[8 * i + 3]};
                *(f32x4*)(xrow + 512 * i + 8 * lane + 4) = (f32x4){v[8 * i + 4], v[8 * i + 5], v[8 * i + 6], v[8 * i + 7]}; }
        }
        float ss = 0.f;
#pragma unroll
        for (int i = 0; i < 16; ++i) ss += v[i] * v[i];
        const float rstd = rsqrtf(wsum(ss) * (1.f / D) + EPS);
        if (MODE == 2) {
#pragma unroll
            for (int i = 0; i < 2; ++i) { const f32x4 a = *(const f32x4*)(p.final_g + 512 * i + 8 * lane), b = *(const f32x4*)(p.final_g + 512 * i + 8 * lane + 4);
                *(f32x4*)(xrow + 512 * i + 8 * lane) = (f32x4){v[8 * i] * rstd * a[0], v[8 * i + 1] * rstd * a[1], v[8 * i + 2] * rstd * a[2], v[8 * i + 3] * rstd * a[3]};
                *(f32x4*)(xrow + 512 * i + 8 * lane + 4) = (f32x4){v[8 * i + 4] * rstd * b[0], v[8 * i + 5] * rstd * b[1], v[8 * i + 6] * rstd * b[2], v[8 * i + 7] * rstd * b[3]}; }
            continue;
        }
        const float* gam = (MODE == 0 ? p.norm1_g : p.norm2_g) + (size_t)l * D;
        const float* md = p.MOD + (size_t)(l * 2 + (isc ? 1 : 0)) * 6144 + (MODE == 0 ? 0 : 3 * D);
        bf16* hrow = p.H + (size_t)row * D;
        float acc[16];
#pragma unroll
        for (int j = 0; j < 16; ++j) acc[j] = 0.f;
#pragma unroll
        for (int i = 0; i < 2; ++i) {
            float hv[8];
            { const int k0 = 512 * i + 8 * lane;
              const f32x4 ga = *(const f32x4*)(gam + k0), gb = *(const f32x4*)(gam + k0 + 4), sa = *(const f32x4*)(md + D + k0), sb = *(const f32x4*)(md + D + k0 + 4), ha = *(const f32x4*)(md + k0), hb = *(const f32x4*)(md + k0 + 4);
#pragma unroll
              for (int q = 0; q < 4; ++q) { hv[q] = v[8 * i + q] * rstd * ga[q] * (1.f + sa[q]) + ha[q]; hv[4 + q] = v[8 * i + 4 + q] * rstd * gb[q] * (1.f + sb[q]) + hb[q]; }
              u32x4 o; o.x = pk2(hv[0], hv[1]); o.y = pk2(hv[2], hv[3]); o.z = pk2(hv[4], hv[5]); o.w = pk2(hv[6], hv[7]);
              *(u32x4*)(hrow + k0) = o; }
#pragma unroll
            for (int j = 0; j < 8; ++j) { const LAS f32x4* wr = (const LAS f32x4*)(W16 + (j * 128 + lane + 64 * i) * 20);
                const f32x4 w0 = wr[0], w1 = wr[1], w2 = wr[2], w3 = wr[3]; const float h = hv[j];
                acc[0] += h * w0[0]; acc[1] += h * w0[1]; acc[2] += h * w0[2]; acc[3] += h * w0[3];
                acc[4] += h * w1[0]; acc[5] += h * w1[1]; acc[6] += h * w1[2]; acc[7] += h * w1[3];
                acc[8] += h * w2[0]; acc[9] += h * w2[1]; acc[10] += h * w2[2]; acc[11] += h * w2[3];
                acc[12] += h * w3[0]; acc[13] += h * w3[1]; acc[14] += h * w3[2]; acc[15] += h * w3[3];
                if (j & 1) asm volatile("" ::: "memory"); }
        }
        const float tot = reduce16(acc, lane);
        const int col = ((lane >> 5) & 1) * 8 + ((lane >> 4) & 1) * 4 + ((lane >> 3) & 1) * 2 + ((lane >> 2) & 1);
        if (MODE == 0) {
            if ((lane & 3) == 0) p.DT[(size_t)row * 16 + col] = softplus_f(tot + p.dt_bias[l * 16 + col]);
        } else {
            float mx = tot;
            mx = fmaxf(mx, __shfl_xor(mx, 4)); mx = fmaxf(mx, __shfl_xor(mx, 8)); mx = fmaxf(mx, __shfl_xor(mx, 16)); mx = fmaxf(mx, __shfl_xor(mx, 32));
            const float e = expf(tot - mx); float sum = e;
            sum += __shfl_xor(sum, 4); sum += __shfl_xor(sum, 8); sum += __shfl_xor(sum, 16); sum += __shfl_xor(sum, 32);
            if ((lane & 3) == 0) p.AFFT[(size_t)col * T + row] = e / sum;
        }
    }
}

struct S5Lane { float abr, abi; float bbr[16], bbi[16]; };
__device__ __forceinline__ void s5_lane_params(const P& p, int l, int d, int g, int lane, S5Lane& o, bool withB) {
    const size_t gi = ((size_t)(l * 2 + d) * 32 + g);
    const float lr = p.lam_re[gi * 64 + lane], li = p.lam_im[gi * 64 + lane], dt = expf(p.log_dt[gi]);
    const float mag = expf(lr * dt); float sn, cs; sincosf(li * dt, &sn, &cs);
    o.abr = mag * cs; o.abi = mag * sn;
    if (withB) {
        const float den = lr * lr + li * li;
        const float fr = ((o.abr - 1.f) * lr + o.abi * li) / den, fi = (o.abi * lr - (o.abr - 1.f) * li) / den;
        const f32x4* br = (const f32x4*)(p.b_re + (gi * 64 + lane) * 16); const f32x4* bi = (const f32x4*)(p.b_im + (gi * 64 + lane) * 16);
#pragma unroll
        for (int q = 0; q < 4; ++q) { const f32x4 r4 = br[q], i4 = bi[q];
#pragma unroll
            for (int j = 0; j < 4; ++j) { o.bbr[4 * q + j] = fr * r4[j] - fi * i4[j]; o.bbi[4 * q + j] = fr * i4[j] + fi * r4[j]; } }
    }
}
__device__ __forceinline__ void s5_stage_u(const P& p, int r0, int g, LAS unsigned char* ub, int lane) {
#pragma unroll
    for (int j = 0; j < 4; ++j) { const int q = lane + 64 * j, i = q >> 1, half = q & 1;
        const u32x4 w = *(const u32x4*)(p.PROJ + (size_t)(r0 + i) * PJ + U0 + g * 16 + half * 8);
        *(LAS u32x4*)(ub + i * 32 + half * 16) = w; }
    LDS_FENCE();
}
__device__ __forceinline__ void s5_step(const S5Lane& s, const LAS unsigned char* ub, int i, float& hr, float& hi) {
    const u32x4 a = *(const LAS u32x4*)(ub + i * 32), b = *(const LAS u32x4*)(ub + i * 32 + 16);
    float u[16];
    u[0] = bflo(a.x); u[1] = bfhi(a.x); u[2] = bflo(a.y); u[3] = bfhi(a.y); u[4] = bflo(a.z); u[5] = bfhi(a.z); u[6] = bflo(a.w); u[7] = bfhi(a.w);
    u[8] = bflo(b.x); u[9] = bfhi(b.x); u[10] = bflo(b.y); u[11] = bfhi(b.y); u[12] = bflo(b.z); u[13] = bfhi(b.z); u[14] = bflo(b.w); u[15] = bfhi(b.w);
    float br = 0.f, bi = 0.f;
#pragma unroll
    for (int k = 0; k < 16; ++k) { br += s.bbr[k] * u[k]; bi += s.bbi[k] * u[k]; }
    const float nr = s.abr * hr - s.abi * hi + br, ni = s.abr * hi + s.abi * hr + bi;
    hr = nr; hi = ni;
}

__device__ __forceinline__ void phase_premix(const P& p, int l, LAS unsigned char* lds) {
    const float* cw = p.conv_w + (size_t)l * 5 * 1024; const float* cb = p.conv_b + (size_t)l * 1024;
    for (int idx = p.bid * NTHR + p.tid; idx < T * 128; idx += p.G * NTHR) {
        const int row = idx >> 7, c8 = (idx & 127) * 8;
        const int lo = row < NCTX ? 0 : NCTX, hi = row < NCTX ? NCTX : T;
        float a[8];
        { const f32x4 b0 = *(const f32x4*)(cb + c8), b1 = *(const f32x4*)(cb + c8 + 4);
          a[0] = b0[0]; a[1] = b0[1]; a[2] = b0[2]; a[3] = b0[3]; a[4] = b1[0]; a[5] = b1[1]; a[6] = b1[2]; a[7] = b1[3]; }
#pragma unroll
        for (int j = 0; j < 5; ++j) { const int r = row + j - 2;
            if (r >= lo && r < hi) { const u32x4 xv = *(const u32x4*)(p.PROJ + (size_t)r * PJ + XB0 + c8);
                const f32x4 w0 = *(const f32x4*)(cw + j * 1024 + c8), w1 = *(const f32x4*)(cw + j * 1024 + c8 + 4);
                a[0] += w0[0] * bflo(xv.x); a[1] += w0[1] * bfhi(xv.x); a[2] += w0[2] * bflo(xv.y); a[3] += w0[3] * bfhi(xv.y);
                a[4] += w1[0] * bflo(xv.z); a[5] += w1[1] * bfhi(xv.z); a[6] += w1[2] * bflo(xv.w); a[7] += w1[3] * bfhi(xv.w); } }
        u32x4 o; o.x = pk2(silu_f(a[0]), silu_f(a[1])); o.y = pk2(silu_f(a[2]), silu_f(a[3])); o.z = pk2(silu_f(a[4]), silu_f(a[5])); o.w = pk2(silu_f(a[6]), silu_f(a[7]));
        *(u32x4*)(p.CV + (size_t)row * 1024 + c8) = o;
    }

}

__device__ __forceinline__ void ssd_scan_naive(const P& p, int l) {
    for (int it = p.bid * 4 + p.wave; it < 1024; it += p.G * 4) {
        const int d = it >> 9, hd = (it >> 6) & 7, pp = it & 63, grp = hd >> 2;
        const float a = -expf(p.a_log[l * 16 + d * 8 + hd]);
        const int colB = 512 + grp * 128 + p.lane, colC = 768 + grp * 128 + p.lane, colX = hd * 64 + pp, dcol = d * 8 + hd;
        float h0 = 0.f, h1 = 0.f;
        for (int s0 = 0; s0 < T; s0 += 8) {
            unsigned b0[8], b1[8], c0[8], c1[8], xx[8]; float dtv[8]; int rr[8];
#pragma unroll
            for (int j = 0; j < 8; ++j) { const int r = scan_row(d, s0 + j); rr[j] = r; const bf16* cv = p.CV + (size_t)r * 1024;
                b0[j] = cv[colB]; b1[j] = cv[colB + 64]; c0[j] = cv[colC]; c1[j] = cv[colC + 64]; xx[j] = cv[colX]; dtv[j] = p.DT[(size_t)r * 16 + dcol]; }
#pragma unroll
            for (int j = 0; j < 8; ++j) { const float dec = expf(dtv[j] * a), dx = dtv[j] * bf2f(xx[j]);
                h0 = dec * h0 + dx * bf2f(b0[j]); h1 = dec * h1 + dx * bf2f(b1[j]);
                const float y = wsum(bf2f(c0[j]) * h0 + bf2f(c1[j]) * h1);
                if (p.lane == 0) p.YD[((size_t)d * T + rr[j]) * 512 + colX] = y; }
        }
    }
}
__device__ __forceinline__ void s5_carry_scan(const P& p, int l, int aw, int NAW) {
    for (int it = aw; it < 64; it += NAW) {
        const int d = it >> 5, g = it & 31;
        S5Lane s; s5_lane_params(p, l, d, g, p.lane, s, false);
        float ar = s.abr, ai = s.abi;
#pragma unroll
        for (int q = 0; q < 7; ++q) { const float nr = ar * ar - ai * ai, ni = 2.f * ar * ai; ar = nr; ai = ni; }
        float hr = 0.f, hi = 0.f;
        const float* E = p.S5E + (size_t)(d * 32 + g) * NCH * 128; float* Hn = p.S5H + (size_t)(d * 32 + g) * NCH * 128;
        for (int c = 0; c < NCH; ++c) { Hn[c * 128 + p.lane] = hr; Hn[c * 128 + 64 + p.lane] = hi;
            const float er = E[c * 128 + p.lane], ei = E[c * 128 + 64 + p.lane];
            const float nr = ar * hr - ai * hi + er, ni = ar * hi + ai * hr + ei; hr = nr; hi = ni; }
    }
}
__device__ __forceinline__ void attention_naive(const P& p, int l, int aw, int NAW, LAS float* pbuf) {
    const int lane = p.lane;
    for (int it = aw; it < T * 8; it += NAW) {
        const int row = it >> 3, hq = it & 7, kvh = hq >> 2;
        const bool isc = row < NCTX; const int t = row - NCTX;
        const int jlo = isc ? 0 : (t - 128 < 0 ? 0 : t - 128), jhi = isc ? -1 : (t + 128 > NLAT - 1 ? NLAT - 1 : t + 128);
        const int nloc = jhi - jlo + 1, nk = nloc + NCTX;
        const float sink = p.sink[l * 8 + hq];
        float q[64];
        { const u32x4* qp = (const u32x4*)(p.PROJ + (size_t)row * PJ + Q0 + hq * 64);
#pragma unroll
          for (int c = 0; c < 8; ++c) { const u32x4 w = qp[c]; q[8 * c] = bflo(w.x); q[8 * c + 1] = bfhi(w.x); q[8 * c + 2] = bflo(w.y); q[8 * c + 3] = bfhi(w.y);
              q[8 * c + 4] = bflo(w.z); q[8 * c + 5] = bfhi(w.z); q[8 * c + 6] = bflo(w.w); q[8 * c + 7] = bfhi(w.w); } }
        float sc[9]; float mx = sink;
#pragma unroll
        for (int i = 0; i < 9; ++i) { const int kk = lane + 64 * i; float s = -INFINITY;
            if (kk < nk) { const int krow = kk < nloc ? NCTX + jlo + kk : kk - nloc;
                const u32x4* kp = (const u32x4*)(p.PROJ + (size_t)krow * PJ + K0 + kvh * 64); float dot = 0.f;
#pragma unroll
                for (int c = 0; c < 8; ++c) { const u32x4 w = kp[c];
                    dot += q[8 * c] * bflo(w.x) + q[8 * c + 1] * bfhi(w.x) + q[8 * c + 2] * bflo(w.y) + q[8 * c + 3] * bfhi(w.y)
                         + q[8 * c + 4] * bflo(w.z) + q[8 * c + 5] * bfhi(w.z) + q[8 * c + 6] * bflo(w.w) + q[8 * c + 7] * bfhi(w.w); }
                s = dot * 0.125f; }
            sc[i] = s; mx = fmaxf(mx, s); }
        mx = wmaxf(mx);
        float sum = 0.f;
#pragma unroll
        for (int i = 0; i < 9; ++i) { const int kk = lane + 64 * i; const float e = (kk < nk) ? expf(sc[i] - mx) : 0.f; pbuf[kk] = e; sum += e; }
        const float den = wsum(sum) + expf(sink - mx);
        LDS_FENCE();
        float o = 0.f;
        const bf16* vb = p.PROJ + V0 + kvh * 64 + lane;
#pragma unroll 4
        for (int kk = 0; kk < nk; ++kk) { const int vrow = kk < nloc ? NCTX + jlo + kk : kk - nloc; o += pbuf[kk] * bf2f(vb[(size_t)vrow * PJ]); }
        p.Y3[((size_t)2 * T + row) * 512 + hq * 64 + lane] = (bf16)f2bf(o / den);
        LDS_FENCE();
    }
}

__device__ __forceinline__ void phase_postmix(const P& p, int l, LAS unsigned char* lds) {
    constexpr int CSH_BYTES = 2 * 2 * 16 * 68 * 4, WREG = 16640;
    LAS float* Csh = (LAS float*)lds;
    LAS unsigned char* wreg = lds + CSH_BYTES + p.wave * WREG;
    LAS unsigned char* ub = wreg;
    LAS float* Hb = (LAS float*)(wreg + 4096);
    LAS float* Yb = (LAS float*)(wreg + 4096 + 4224);
    const int lane = p.lane;
    for (int it = p.bid; it < 32 * 17; it += p.G) {
        const int g = it / 17, chunk = (it % 17) * 8 + p.wave;
        __syncthreads();
        for (int i = p.tid; i < 2 * 2 * 16 * 64; i += NTHR) { const int pq = i & 63, k = (i >> 6) & 15, ri = (i >> 10) & 1, d = i >> 11;
            const float* src = ri ? p.c_im : p.c_re; Csh[((d * 2 + ri) * 16 + k) * 68 + pq] = src[(((size_t)(l * 2 + d) * 32 + g) * 16 + k) * 64 + pq]; }
        __syncthreads();
        if (chunk < NCH) {
            const int r0 = 128 * chunk;
            s5_stage_u(p, r0, g, ub, lane);
            for (int d = 0; d < 2; ++d) {
                S5Lane s; s5_lane_params(p, l, d, g, lane, s, true);
                const int cs = (d == 0) ? chunk : (chunk < 2 ? 1 - chunk : NCH + 1 - chunk);
                const float* Hn = p.S5H + ((size_t)(d * 32 + g) * NCH + cs) * 128;
                float hr = Hn[lane], hi = Hn[64 + lane];
                const LAS float* Cr = Csh + (d * 2 + 0) * 16 * 68; const LAS float* Ci = Csh + (d * 2 + 1) * 16 * 68;
                for (int sub = 0; sub < 16; ++sub) {
#pragma unroll
                    for (int j = 0; j < 8; ++j) { const int is = sub * 8 + j; s5_step(s, ub, d == 0 ? is : 127 - is, hr, hi); Hb[j * 132 + lane] = hr; Hb[j * 132 + 64 + lane] = hi; }
                    LDS_FENCE();
#pragma unroll
                    for (int m = 0; m < 2; ++m) { const int o = lane + 64 * m, j = o >> 4, k = o & 15; float y = 0.f;
#pragma unroll
                        for (int q = 0; q < 16; ++q) { const f32x4 cr = *(const LAS f32x4*)(Cr + k * 68 + 4 * q), ci = *(const LAS f32x4*)(Ci + k * 68 + 4 * q);
                            const f32x4 xr = *(const LAS f32x4*)(Hb + j * 132 + 4 * q), xi = *(const LAS f32x4*)(Hb + j * 132 + 64 + 4 * q);
                            y += cr[0] * xr[0] + cr[1] * xr[1] + cr[2] * xr[2] + cr[3] * xr[3] - ci[0] * xi[0] - ci[1] * xi[1] - ci[2] * xi[2] - ci[3] * xi[3]; }
                        const int is = sub * 8 + j, i = (d == 0) ? is : 127 - is;
                        if (d == 0) Yb[i * 16 + k] = y; else Yb[i * 16 + k] += y; }
                    LDS_FENCE();
                }
            }
            const float* dsk = p.s5_d + (size_t)l * 512 + g * 16;
#pragma unroll
            for (int m = 0; m < 2; ++m) { const int i = lane + 64 * m;
                const u32x4 ua = *(const LAS u32x4*)(ub + i * 32), ubv = *(const LAS u32x4*)(ub + i * 32 + 16);
                float u[16];
                u[0] = bflo(ua.x); u[1] = bfhi(ua.x); u[2] = bflo(ua.y); u[3] = bfhi(ua.y); u[4] = bflo(ua.z); u[5] = bfhi(ua.z); u[6] = bflo(ua.w); u[7] = bfhi(ua.w);
                u[8] = bflo(ubv.x); u[9] = bfhi(ubv.x); u[10] = bflo(ubv.y); u[11] = bfhi(ubv.y); u[12] = bflo(ubv.z); u[13] = bfhi(ubv.z); u[14] = bflo(ubv.w); u[15] = bfhi(ubv.w);
                float a[16];
#pragma unroll
                for (int k = 0; k < 16; ++k) a[k] = gelu_tanh_f(Yb[i * 16 + k] + dsk[k] * u[k]);
                u32x4 o0, o1; o0.x = pk2(a[0], a[1]); o0.y = pk2(a[2], a[3]); o0.z = pk2(a[4], a[5]); o0.w = pk2(a[6], a[7]);
                o1.x = pk2(a[8], a[9]); o1.y = pk2(a[10], a[11]); o1.z = pk2(a[12], a[13]); o1.w = pk2(a[14], a[15]);
                bf16* dst = p.SA + (size_t)(r0 + i) * 512 + g * 16;
                *(u32x4*)dst = o0; *(u32x4*)(dst + 8) = o1; }
            LDS_FENCE();
        }
    }
}

__device__ __forceinline__ void phase_select(const P& p, LAS unsigned char* lds, bool with_ctx) {
    LAS unsigned* keys = (LAS unsigned*)lds;
    LAS unsigned* hist = keys + 16384;
    LAS unsigned* misc = hist + 256;
    const int tid = p.tid, lane = p.lane, wave = p.wave;
    for (int it = p.bid; it < (with_ctx ? 32 : 16); it += p.G) {
        const int set = it >> 4, e = it & 15;
        const int n = set ? NCTX : NLAT, cap = set ? CAP_C : CAP_L, row0 = set ? 0 : NCTX, slot0 = set ? CAP_L : 0;
        const float* src = p.AFFT + (size_t)e * T + row0;
        __syncthreads();
        for (int i = tid; i < n; i += NTHR) keys[i] = __float_as_uint(src[i]);
        unsigned prefix = 0u, mask = 0u, need = (unsigned)cap;
        for (int pass = 3; pass >= 0; --pass) {
            if (tid < 256) hist[tid] = 0u;
            __syncthreads();
            for (int i = tid; i < n; i += NTHR) { const unsigned k = keys[i]; if ((k & mask) == prefix) __hip_atomic_fetch_add(&hist[(k >> (8 * pass)) & 255u], 1u, __ATOMIC_RELAXED, __HIP_MEMORY_SCOPE_WORKGROUP); }
            __syncthreads();
            if (wave == 0) {
                const unsigned h0 = hist[4 * lane], h1 = hist[4 * lane + 1], h2 = hist[4 * lane + 2], h3 = hist[4 * lane + 3];
                const unsigned c = h0 + h1 + h2 + h3; unsigned S = c;
#pragma unroll
                for (int o = 1; o < 64; o <<= 1) { const unsigned t = __shfl_down(S, o); if (lane + o < 64) S += t; }
                const unsigned Snext = S - c;
                if (S >= need && Snext < need) { unsigned rem = need - Snext; unsigned bin;
                    if (h3 >= rem) bin = 3; else { rem -= h3; if (h2 >= rem) bin = 2; else { rem -= h2; if (h1 >= rem) bin = 1; else { rem -= h1; bin = 0; } } }
                    misc[0] = 4 * lane + bin; misc[1] = rem; }
            }
            __syncthreads();
            prefix |= misc[0] << (8 * pass); mask |= 0xFFu << (8 * pass); need = misc[1];
            __syncthreads();
        }
        unsigned selbase = 0u, eqbase = 0u;
        for (int base = 0; base < n; base += NTHR) {
            const int i = base + tid; const bool valid = i < n; const unsigned k = valid ? keys[i] : 0u;
            const bool eq = valid && k == prefix, gt = valid && k > prefix;
            const unsigned long long lt = (1ull << lane) - 1ull;
            const unsigned long long be = __ballot(eq);
            if (lane == 0) misc[8 + wave] = (unsigned)__popcll(be);
            __syncthreads();
            unsigned woff = 0u, tot = 0u;
#pragma unroll
            for (int w = 0; w < 8; ++w) { const unsigned v = misc[8 + w]; woff += (w < wave) ? v : 0u; tot += v; }
            const unsigned eqrank = eqbase + woff + (unsigned)__popcll(be & lt);
            const bool sel = gt || (eq && eqrank < need);
            const unsigned long long bs = __ballot(sel);
            if (lane == 0) misc[16 + wave] = (unsigned)__popcll(bs);
            __syncthreads();
            unsigned woff2 = 0u, tot2 = 0u;
#pragma unroll
            for (int w = 0; w < 8; ++w) { const unsigned v = misc[16 + w]; woff2 += (w < wave) ? v : 0u; tot2 += v; }
            if (valid) { const int row = row0 + i;
                if (sel) { const int slot = slot0 + (int)(selbase + woff2 + (unsigned)__popcll(bs & lt));
                    p.IDX[e * ESLOTS + slot] = row; p.GSEL[e * ESLOTS + slot] = __uint_as_float(k); p.INV[(size_t)row * 16 + e] = slot; }
                else p.INV[(size_t)row * 16 + e] = -1; }
            selbase += tot2; eqbase += tot;
            __syncthreads();
        }
    }
}
__device__ __forceinline__ void phase_gather(const P& p, bool with_ctx) {
    const int gw = p.bid * NWAVES + p.wave, NGW = p.G * NWAVES, lane = p.lane;
    for (int idx = gw; idx < NE * ESLOTS; idx += NGW) {
        const int slot = idx % ESLOTS; const bool valid = slot < CAP_L + (with_ctx ? CAP_C : 0);
        u32x4 a = (u32x4){0u, 0u, 0u, 0u}, b = a;
        if (valid) { const int row = p.IDX[idx]; const u32x4* s = (const u32x4*)(p.H + (size_t)row * D); a = s[lane]; b = s[64 + lane]; }
        else if (lane == 0) p.GSEL[idx] = 0.f;
        u32x4* dst = (u32x4*)(p.XE + (size_t)idx * D); dst[lane] = a; dst[64 + lane] = b;
    }
}

typedef short bf16x8 __attribute__((ext_vector_type(8)));
#define MFMA16(a, b, c) __builtin_amdgcn_mfma_f32_16x16x32_bf16((a), (b), (c), 0, 0, 0)
constexpr int LDP = 272;
constexpr int LDQ = 144;
__device__ __forceinline__ bf16x8 ld_frag(const LAS unsigned char* base, int row, int kcol, int ldb) { return *(const LAS bf16x8*)(base + row * ldb + kcol * 2); }
__device__ __forceinline__ void st_b16(LAS unsigned char* p, unsigned v) { *(LAS unsigned short*)p = (unsigned short)v; }
__device__ __forceinline__ float wscan_incl(float v, int lane) {
#pragma unroll
    for (int o = 1; o < 64; o <<= 1) { const float t = __shfl_up(v, o); if (lane >= o) v += t; }
    return v;
}
__device__ __forceinline__ int chunk_r0(int d, int cs) { return d == 0 ? 128 * cs : (cs < 2 ? 128 * (1 - cs) : 128 * (NCH + 1 - cs)); }
__device__ __forceinline__ int scan_chunk_of(int d, int cn) { return d == 0 ? cn : (cn < 2 ? 1 - cn : NCH + 1 - cn); }

__device__ __forceinline__ void ssd_acum(const float* DT, int r0, int d, int col, float a, int lane, LAS float* acum, LAS float* dtv, float& total) {
    const int j0 = d == 0 ? lane : 127 - lane, j1 = d == 0 ? 64 + lane : 63 - lane;
    const float dt0 = DT[(size_t)(r0 + j0) * 16 + col], dt1 = DT[(size_t)(r0 + j1) * 16 + col];
    const float s0 = wscan_incl(dt0 * a, lane); const float t0 = __shfl(s0, 63);
    const float s1 = wscan_incl(dt1 * a, lane) + t0; total = __shfl(s1, 63);
    acum[j0] = s0; acum[j1] = s1; dtv[j0] = dt0; dtv[j1] = dt1;
}

__device__ __forceinline__ void ssd_states(const P& p, int l, LAS unsigned char* lds, float* SST, float* DEC) {
    LAS unsigned char* BT = lds;
    LAS unsigned char* XW = lds + 128 * LDP;
    LAS float* wj = (LAS float*)(lds + 128 * LDP + 4 * 64 * LDP);
    const int tid = p.tid, lane = p.lane, wave = p.wave, quad = lane >> 4, l15 = lane & 15;
    for (int u = p.bid; u < 2 * NCH * 2; u += p.G) {
        const int d = u / (2 * NCH), cs = (u % (2 * NCH)) >> 1, g = u & 1;
        const int r0 = chunk_r0(d, cs);
        __syncthreads();
        if (wave < 4) { const int h = g * 4 + wave; const float a = -expf(p.a_log[l * 16 + d * 8 + h]); float total;
            LAS float* ac = wj + 512 + wave * 128; LAS float* dv = wj + 1024 + wave * 128;
            ssd_acum(p.DT, r0, d, d * 8 + h, a, lane, ac, dv, total);
            LDS_FENCE();
            wj[wave * 128 + lane] = __expf(total - ac[lane]) * dv[lane]; wj[wave * 128 + 64 + lane] = __expf(total - ac[64 + lane]) * dv[64 + lane];
            if (lane == 0) DEC[(d * NCH + cs) * 8 + h] = expf(total); }
        __syncthreads();
        for (int idx = tid; idx < 128 * 16; idx += NTHR) { const int j = idx >> 4, n8 = (idx & 15) * 8;
            const u32x4 v = *(const u32x4*)(p.CV + (size_t)(r0 + j) * 1024 + 512 + g * 128 + n8);
            LAS unsigned char* dst = BT + n8 * LDP + 2 * j;
            st_b16(dst, v.x & 0xffffu); st_b16(dst + LDP, v.x >> 16); st_b16(dst + 2 * LDP, v.y & 0xffffu); st_b16(dst + 3 * LDP, v.y >> 16);
            st_b16(dst + 4 * LDP, v.z & 0xffffu); st_b16(dst + 5 * LDP, v.z >> 16); st_b16(dst + 6 * LDP, v.w & 0xffffu); st_b16(dst + 7 * LDP, v.w >> 16); }
        for (int idx = tid; idx < 128 * 32; idx += NTHR) { const int j = idx >> 5, c8 = (idx & 31) * 8, hh = c8 >> 6, p8 = c8 & 63;
            const u32x4 v = *(const u32x4*)(p.CV + (size_t)(r0 + j) * 1024 + g * 256 + c8); const float w = wj[hh * 128 + j];
            LAS unsigned char* dst = XW + (hh * 64 + p8) * LDP + 2 * j;
            st_b16(dst, f2bf(bflo(v.x) * w)); st_b16(dst + LDP, f2bf(bfhi(v.x) * w)); st_b16(dst + 2 * LDP, f2bf(bflo(v.y) * w)); st_b16(dst + 3 * LDP, f2bf(bfhi(v.y) * w));
            st_b16(dst + 4 * LDP, f2bf(bflo(v.z) * w)); st_b16(dst + 5 * LDP, f2bf(bfhi(v.z) * w)); st_b16(dst + 6 * LDP, f2bf(bflo(v.w) * w)); st_b16(dst + 7 * LDP, f2bf(bfhi(v.w) * w)); }
        __syncthreads();
        const int hh = wave >> 1, ph = wave & 1;
        f32x4 acc[2][8];
#pragma unroll
        for (int a = 0; a < 2; ++a)
#pragma unroll
            for (int b = 0; b < 8; ++b) acc[a][b] = (f32x4){0.f, 0.f, 0.f, 0.f};
#pragma unroll
        for (int ks = 0; ks < 4; ++ks) {
            bf16x8 af[2];
#pragma unroll
            for (int pt = 0; pt < 2; ++pt) af[pt] = ld_frag(XW + hh * 64 * LDP, ph * 32 + pt * 16 + l15, ks * 32 + 8 * quad, LDP);
#pragma unroll
            for (int nt = 0; nt < 8; ++nt) { const bf16x8 bfr = ld_frag(BT, nt * 16 + l15, ks * 32 + 8 * quad, LDP);
#pragma unroll
                for (int pt = 0; pt < 2; ++pt) acc[pt][nt] = MFMA16(af[pt], bfr, acc[pt][nt]); }
        }
        float* S = SST + ((size_t)(d * NCH + cs) * 8 + g * 4 + hh) * 8192;
#pragma unroll
        for (int pt = 0; pt < 2; ++pt)
#pragma unroll
            for (int nt = 0; nt < 8; ++nt)
#pragma unroll
                for (int r = 0; r < 4; ++r) S[(ph * 32 + pt * 16 + 4 * quad + r) * 128 + nt * 16 + l15] = acc[pt][nt][r];
    }
}

__device__ __forceinline__ void scan_carries(const P& p, int l, const float* SST, const float* DEC, bf16* HIN) {
    for (int e = p.bid * NTHR + p.tid; e < 2 * 8 * 8192; e += p.G * NTHR) {
        const int d = e >> 16, h = (e >> 13) & 7, pn = e & 8191;
        float hs = 0.f;
        for (int c0 = 0; c0 < NCH; c0 += 10) {
            float s[10], dc[10];
#pragma unroll
            for (int j = 0; j < 10; ++j) { const size_t ci = (size_t)(d * NCH + c0 + j) * 8 + h; s[j] = SST[ci * 8192 + pn]; dc[j] = DEC[ci]; }
#pragma unroll
            for (int j = 0; j < 10; ++j) { const size_t ci = (size_t)(d * NCH + c0 + j) * 8 + h; HIN[ci * 8192 + pn] = (bf16)f2bf(hs); hs = hs * dc[j] + s[j]; }
        }
    }
    for (int e = p.bid * NTHR + p.tid; e < 2 * 32 * 64; e += p.G * NTHR) {
        const int d = e >> 11, g = (e >> 6) & 31, pq = e & 63;
        S5Lane s; s5_lane_params(p, l, d, g, pq, s, false);
        float ar = s.abr, ai = s.abi;
#pragma unroll
        for (int q = 0; q < 7; ++q) { const float nr = ar * ar - ai * ai, ni = 2.f * ar * ai; ar = nr; ai = ni; }
        float hr = 0.f, hi = 0.f;
        const float* E = p.S5E + (size_t)(d * 32 + g) * NCH * 128 + pq; float* Hn = p.S5H + (size_t)(d * 32 + g) * NCH * 128 + pq;
        for (int c0 = 0; c0 < NCH; c0 += 10) {
            float er[10], ei[10];
#pragma unroll
            for (int j = 0; j < 10; ++j) { er[j] = E[(c0 + j) * 128]; ei[j] = E[(c0 + j) * 128 + 64]; }
#pragma unroll
            for (int j = 0; j < 10; ++j) { Hn[(c0 + j) * 128] = hr; Hn[(c0 + j) * 128 + 64] = hi;
                const float nr = ar * hr - ai * hi + er[j], ni = ar * hi + ai * hr + ei[j]; hr = nr; hi = ni; }
        }
    }
}

__device__ __forceinline__ void ssd_outputs(const P& p, int l, LAS unsigned char* lds, const bf16* HIN, const float* SST, bf16* YS, int u_begin, int u_end, int first, int stride) {
    LAS unsigned char* Cm = lds;
    LAS unsigned char* Bm = lds + 128 * LDP;
    LAS unsigned char* XT = lds + 2 * 128 * LDP;
    LAS unsigned char* Wm = lds + 2 * 128 * LDP + 64 * LDP;
    LAS float* sm = (LAS float*)(lds + 3 * 128 * LDP + 64 * LDP);
    const int tid = p.tid, lane = p.lane, wave = p.wave, quad = lane >> 4, l15 = lane & 15;
    for (int u = u_begin + first; u < u_end; u += stride) {
        const int cn = u >> 3, h = u & 7, g = h >> 2, r0 = 128 * cn;
        __syncthreads();
        if (wave < 2) { const int d = wave; const float a = -expf(p.a_log[l * 16 + d * 8 + h]); float total;
            ssd_acum(p.DT, r0, d, d * 8 + h, a, lane, sm + d * 128, sm + 256 + d * 128, total); }
        for (int idx = tid; idx < 128 * 16; idx += NTHR) { const int j = idx >> 4, n8 = (idx & 15) * 8;
            const bf16* src = p.CV + (size_t)(r0 + j) * 1024 + g * 128 + n8;
            *(LAS u32x4*)(Bm + j * LDP + n8 * 2) = *(const u32x4*)(src + 512); *(LAS u32x4*)(Cm + j * LDP + n8 * 2) = *(const u32x4*)(src + 768); }
        for (int idx = tid; idx < 128 * 8; idx += NTHR) { const int j = idx >> 3, p8 = (idx & 7) * 8;
            const u32x4 v = *(const u32x4*)(p.CV + (size_t)(r0 + j) * 1024 + h * 64 + p8);
            LAS unsigned char* dst = XT + p8 * LDP + 2 * j;
            st_b16(dst, v.x & 0xffffu); st_b16(dst + LDP, v.x >> 16); st_b16(dst + 2 * LDP, v.y & 0xffffu); st_b16(dst + 3 * LDP, v.y >> 16);
            st_b16(dst + 4 * LDP, v.z & 0xffffu); st_b16(dst + 5 * LDP, v.z >> 16); st_b16(dst + 6 * LDP, v.w & 0xffffu); st_b16(dst + 7 * LDP, v.w >> 16); }
        __syncthreads();
        f32x4 G[8];
#pragma unroll
        for (int jt = 0; jt < 8; ++jt) G[jt] = (f32x4){0.f, 0.f, 0.f, 0.f};
#pragma unroll
        for (int ks = 0; ks < 4; ++ks) { const bf16x8 af = ld_frag(Cm, 16 * wave + l15, ks * 32 + 8 * quad, LDP);
#pragma unroll
            for (int jt = 0; jt < 8; ++jt) G[jt] = MFMA16(af, ld_frag(Bm, 16 * jt + l15, ks * 32 + 8 * quad, LDP), G[jt]); }
        __syncthreads();
        for (int idx = tid; idx < 2 * 64 * 16; idx += NTHR) { const int d = idx >> 10, pp = (idx >> 4) & 63, n8 = (idx & 15) * 8;
            const int cs = scan_chunk_of(d, cn);
            u32x4 w;
            if (cn >= 2) w = *(const u32x4*)(HIN + ((size_t)(d * NCH + cs) * 8 + h) * 8192 + pp * 128 + n8);
            else if (cs == 0) w = (u32x4){0u, 0u, 0u, 0u};
            else { const float* s = SST + ((size_t)(d * NCH) * 8 + h) * 8192 + pp * 128 + n8; const f32x4 s0 = *(const f32x4*)s, s1 = *(const f32x4*)(s + 4);
                w.x = pk2(s0[0], s0[1]); w.y = pk2(s0[2], s0[3]); w.z = pk2(s1[0], s1[1]); w.w = pk2(s1[2], s1[3]); }
            *(LAS u32x4*)(Bm + (d * 64 + pp) * LDP + n8 * 2) = w; }
        __syncthreads();
        f32x4 Y[4];
#pragma unroll
        for (int pt = 0; pt < 4; ++pt) Y[pt] = (f32x4){0.f, 0.f, 0.f, 0.f};
#pragma unroll
        for (int d = 0; d < 2; ++d) {
            const LAS float* ac = sm + d * 128; const LAS float* dv = sm + 256 + d * 128;
            float ai[4];
#pragma unroll
            for (int r = 0; r < 4; ++r) ai[r] = ac[16 * wave + 4 * quad + r];
#pragma unroll
            for (int jt = 0; jt < 8; ++jt) { const int j = 16 * jt + l15; const float aj = ac[j], dj = dv[j];
#pragma unroll
                for (int r = 0; r < 4; ++r) { const int i = 16 * wave + 4 * quad + r; const bool valid = (d == 0) ? (j <= i) : (j >= i);
                    const float w = valid ? G[jt][r] * __expf(ai[r] - aj) * dj : 0.f;
                    st_b16(Wm + i * LDP + 2 * j, f2bf(w)); } }
            LDS_FENCE();
            f32x4 Y2[4];
#pragma unroll
            for (int pt = 0; pt < 4; ++pt) Y2[pt] = (f32x4){0.f, 0.f, 0.f, 0.f};
#pragma unroll
            for (int ks = 0; ks < 4; ++ks) { const bf16x8 wf = ld_frag(Wm, 16 * wave + l15, ks * 32 + 8 * quad, LDP), cf = ld_frag(Cm, 16 * wave + l15, ks * 32 + 8 * quad, LDP);
#pragma unroll
                for (int pt = 0; pt < 4; ++pt) { Y[pt] = MFMA16(wf, ld_frag(XT, 16 * pt + l15, ks * 32 + 8 * quad, LDP), Y[pt]);
                    Y2[pt] = MFMA16(cf, ld_frag(Bm + d * 64 * LDP, 16 * pt + l15, ks * 32 + 8 * quad, LDP), Y2[pt]); } }
#pragma unroll
            for (int r = 0; r < 4; ++r) { const float ea = __expf(ai[r]);
#pragma unroll
                for (int pt = 0; pt < 4; ++pt) Y[pt][r] += ea * Y2[pt][r]; }
            LDS_FENCE();
        }
#pragma unroll
        for (int pt = 0; pt < 4; ++pt)
#pragma unroll
            for (int r = 0; r < 4; ++r) YS[(size_t)(r0 + 16 * wave + 4 * quad + r) * 512 + h * 64 + 16 * pt + l15] = (bf16)f2bf(Y[pt][r]);
    }
}

__device__ __forceinline__ void ssd_gated_norm(const P& p, int l, const bf16* YS) {
    const int gw = p.bid * NWAVES + p.wave, NGW = p.G * NWAVES, lane = p.lane;
    for (int row = gw; row < T; row += NGW) {
        const int ch = lane * 8;
        const float dsk = p.ssd_d[l * 8 + (ch >> 6)];
        const u32x4 yv = *(const u32x4*)(YS + (size_t)row * 512 + ch);
        const u32x4 xs = *(const u32x4*)(p.CV + (size_t)row * 1024 + ch), zz = *(const u32x4*)(p.PROJ + (size_t)row * PJ + Z0 + ch);
        float v[8];
        v[0] = (bflo(yv.x) + dsk * bflo(xs.x)) * silu_f(bflo(zz.x)); v[1] = (bfhi(yv.x) + dsk * bfhi(xs.x)) * silu_f(bfhi(zz.x));
        v[2] = (bflo(yv.y) + dsk * bflo(xs.y)) * silu_f(bflo(zz.y)); v[3] = (bfhi(yv.y) + dsk * bfhi(xs.y)) * silu_f(bfhi(zz.y));
        v[4] = (bflo(yv.z) + dsk * bflo(xs.z)) * silu_f(bflo(zz.z)); v[5] = (bfhi(yv.z) + dsk * bfhi(xs.z)) * silu_f(bfhi(zz.z));
        v[6] = (bflo(yv.w) + dsk * bflo(xs.w)) * silu_f(bflo(zz.w)); v[7] = (bfhi(yv.w) + dsk * bfhi(xs.w)) * silu_f(bfhi(zz.w));
        float ss = 0.f;
#pragma unroll
        for (int i = 0; i < 8; ++i) ss += v[i] * v[i];
        const float rstd = rsqrtf(wsum(ss) * (1.f / 512.f) + EPS);
        const float* ng = p.ssd_norm_g + (size_t)l * 512 + ch;
        const f32x4 g0 = *(const f32x4*)ng, g1 = *(const f32x4*)(ng + 4);
        u32x4 o; o.x = pk2(v[0] * rstd * g0[0], v[1] * rstd * g0[1]); o.y = pk2(v[2] * rstd * g0[2], v[3] * rstd * g0[3]);
        o.z = pk2(v[4] * rstd * g1[0], v[5] * rstd * g1[1]); o.w = pk2(v[6] * rstd * g1[2], v[7] * rstd * g1[3]);
        *(u32x4*)(p.Y3 + (size_t)row * 1536 + 512 + ch) = o;
    }
}

__device__ __forceinline__ void attention_mfma(const P& p, int l, LAS unsigned char* lds, int u_begin, int u_end, int u_first, int u_stride) {
    LAS unsigned char* Kt = lds;
    LAS unsigned char* VT = lds + 64 * LDQ;
    LAS unsigned char* Pw = lds + 2 * 64 * LDQ + p.wave * 64 * LDQ;
    const int tid = p.tid, lane = p.lane, wave = p.wave, quad = lane >> 4, l15 = lane & 15;
    const float C2 = 0.125f * 1.4426950408889634f;
    for (int u = u_begin + u_first; u < u_end; u += u_stride) {
        const int qb = u >> 1, kvh = u & 1, hq = kvh * 4 + (wave >> 1);
        const bool isc = qb < 2; const int nb = qb - 2;
        const int qrow0 = 128 * qb + 64 * (wave & 1);
        bf16x8 Qf[4][2];
#pragma unroll
        for (int qt = 0; qt < 4; ++qt)
#pragma unroll
            for (int ks = 0; ks < 2; ++ks) Qf[qt][ks] = *(const bf16x8*)(p.PROJ + (size_t)(qrow0 + 16 * qt + l15) * PJ + Q0 + hq * 64 + ks * 32 + 8 * quad);
        f32x4 O[4][4];
#pragma unroll
        for (int a = 0; a < 4; ++a)
#pragma unroll
            for (int b = 0; b < 4; ++b) O[a][b] = (f32x4){0.f, 0.f, 0.f, 0.f};
        float mrow[4], lrow[4];
        const float sk = p.sink[l * 8 + hq] * 1.4426950408889634f;
#pragma unroll
        for (int qt = 0; qt < 4; ++qt) { mrow[qt] = sk; lrow[qt] = 1.f; }
        const int ntile = isc ? 4 : 10;
        for (int ti = 0; ti < ntile; ++ti) {
            int krow0; bool local;
            if (isc || ti >= 6) { krow0 = 64 * (isc ? ti : ti - 6); local = false; }
            else { krow0 = NCTX + 128 * (nb - 1) + 64 * ti; local = true; }
            if (local && (krow0 < NCTX || krow0 >= T)) continue;
            __syncthreads();
            { const int key = tid >> 3, pc = tid & 7;
              const bf16* src = p.PROJ + (size_t)(krow0 + key) * PJ + kvh * 64 + pc * 8;
              *(LAS u32x4*)(Kt + key * LDQ + pc * 16) = *(const u32x4*)(src + K0);
              const u32x4 v = *(const u32x4*)(src + V0);
              LAS unsigned char* dst = VT + (pc * 8) * LDQ + 2 * key;
              st_b16(dst, v.x & 0xffffu); st_b16(dst + LDQ, v.x >> 16); st_b16(dst + 2 * LDQ, v.y & 0xffffu); st_b16(dst + 3 * LDQ, v.y >> 16);
              st_b16(dst + 4 * LDQ, v.z & 0xffffu); st_b16(dst + 5 * LDQ, v.z >> 16); st_b16(dst + 6 * LDQ, v.w & 0xffffu); st_b16(dst + 7 * LDQ, v.w >> 16); }
            __syncthreads();
            f32x4 S[4][4];
#pragma unroll
            for (int a = 0; a < 4; ++a)
#pragma unroll
                for (int b = 0; b < 4; ++b) S[a][b] = (f32x4){0.f, 0.f, 0.f, 0.f};
#pragma unroll
            for (int ks = 0; ks < 2; ++ks)
#pragma unroll
                for (int kt = 0; kt < 4; ++kt) { const bf16x8 kf = ld_frag(Kt, 16 * kt + l15, ks * 32 + 8 * quad, LDQ);
#pragma unroll
                    for (int qt = 0; qt < 4; ++qt) S[kt][qt] = MFMA16(kf, Qf[qt][ks], S[kt][qt]); }
#pragma unroll
            for (int qt = 0; qt < 4; ++qt) {
                const int tq = qrow0 + 16 * qt + l15;
                float mx = -1e30f;
#pragma unroll
                for (int kt = 0; kt < 4; ++kt)
#pragma unroll
                    for (int r = 0; r < 4; ++r) { const int tk = krow0 + 16 * kt + 4 * quad + r; const int df = tq - tk;
                        const bool ok = !local || (df <= 128 && df >= -128);
                        const float s = ok ? S[kt][qt][r] * C2 : -1e30f; S[kt][qt][r] = s; mx = fmaxf(mx, s); }
                mx = fmaxf(mx, __shfl_xor(mx, 16)); mx = fmaxf(mx, __shfl_xor(mx, 32));
                const float mn = fmaxf(mrow[qt], mx), alpha = exp2f(mrow[qt] - mn);
                float ls = 0.f;
#pragma unroll
                for (int kt = 0; kt < 4; ++kt) { float e0 = exp2f(S[kt][qt][0] - mn), e1 = exp2f(S[kt][qt][1] - mn), e2 = exp2f(S[kt][qt][2] - mn), e3 = exp2f(S[kt][qt][3] - mn);
                    ls += (e0 + e1) + (e2 + e3);
                    u32x2 w; w.x = pk2(e0, e1); w.y = pk2(e2, e3);
                    *(LAS u32x2*)(Pw + (16 * qt + l15) * LDQ + (16 * kt + 4 * quad) * 2) = w; }
                ls += __shfl_xor(ls, 16); ls += __shfl_xor(ls, 32);
                lrow[qt] = lrow[qt] * alpha + ls; mrow[qt] = mn;
#pragma unroll
                for (int dt = 0; dt < 4; ++dt) O[dt][qt] *= alpha;
            }
            LDS_FENCE();
#pragma unroll
            for (int ks = 0; ks < 2; ++ks) {
                bf16x8 pf[4];
#pragma unroll
                for (int qt = 0; qt < 4; ++qt) pf[qt] = ld_frag(Pw, 16 * qt + l15, ks * 32 + 8 * quad, LDQ);
#pragma unroll
                for (int dt = 0; dt < 4; ++dt) { const bf16x8 vf = ld_frag(VT, 16 * dt + l15, ks * 32 + 8 * quad, LDQ);
#pragma unroll
                    for (int qt = 0; qt < 4; ++qt) O[dt][qt] = MFMA16(vf, pf[qt], O[dt][qt]); }
            }
            LDS_FENCE();
        }
#pragma unroll
        for (int qt = 0; qt < 4; ++qt) { const float inv = 1.f / lrow[qt];
            bf16* orow = p.Y3 + (size_t)(qrow0 + 16 * qt + l15) * 1536 + 1024 + hq * 64;
#pragma unroll
            for (int dt = 0; dt < 4; ++dt) { u32x2 w; w.x = pk2(O[dt][qt][0] * inv, O[dt][qt][1] * inv); w.y = pk2(O[dt][qt][2] * inv, O[dt][qt][3] * inv);
                *(u32x2*)(orow + 16 * dt + 4 * quad) = w; } }
    }
}

#ifndef S5_INTERLEAVE
#define S5_INTERLEAVE 2
#endif
constexpr size_t S5BB_ELEMS = (size_t)2 * 32 * 128 * 32, S5CC_ELEMS = (size_t)2 * 32 * 16 * 128;
__device__ __forceinline__ void s5_tables(const P& p, int l, bf16* BB, bf16* CC, float* AB) {
    for (int e = p.bid * NTHR + p.tid; e < 2 * 32 * 64; e += p.G * NTHR) {
        const int d = e >> 11, g = (e >> 6) & 31, pq = e & 63, dg = d * 32 + g;
        S5Lane s; s5_lane_params(p, l, d, g, pq, s, true);
        AB[(size_t)e * 2] = s.abr; AB[(size_t)e * 2 + 1] = s.abi;
        #if S5_INTERLEAVE
        u32x4* br = (u32x4*)(BB + ((size_t)dg * 128 + 2 * pq) * 32); u32x4* bi = (u32x4*)(BB + ((size_t)dg * 128 + 2 * pq + 1) * 32);
#else
        u32x4* br = (u32x4*)(BB + ((size_t)dg * 128 + pq) * 32); u32x4* bi = (u32x4*)(BB + ((size_t)dg * 128 + 64 + pq) * 32);
#endif
        u32x4 w;
        w.x = pk2(s.bbr[0], s.bbr[1]); w.y = pk2(s.bbr[2], s.bbr[3]); w.z = pk2(s.bbr[4], s.bbr[5]); w.w = pk2(s.bbr[6], s.bbr[7]); br[0] = w;
        w.x = pk2(s.bbr[8], s.bbr[9]); w.y = pk2(s.bbr[10], s.bbr[11]); w.z = pk2(s.bbr[12], s.bbr[13]); w.w = pk2(s.bbr[14], s.bbr[15]); br[1] = w;
        w.x = pk2(s.bbi[0], s.bbi[1]); w.y = pk2(s.bbi[2], s.bbi[3]); w.z = pk2(s.bbi[4], s.bbi[5]); w.w = pk2(s.bbi[6], s.bbi[7]); bi[0] = w;
        w.x = pk2(s.bbi[8], s.bbi[9]); w.y = pk2(s.bbi[10], s.bbi[11]); w.z = pk2(s.bbi[12], s.bbi[13]); w.w = pk2(s.bbi[14], s.bbi[15]); bi[1] = w;
        const u32x4 z = (u32x4){0u, 0u, 0u, 0u}; br[2] = z; br[3] = z; bi[2] = z; bi[3] = z;
        const size_t ci = ((size_t)(l * 2 + d) * 32 + g) * 16;
#pragma unroll
        for (int k = 0; k < 16; ++k) {
#if S5_INTERLEAVE
            *(unsigned*)(CC + ((size_t)dg * 16 + k) * 128 + 2 * pq) = pk2(p.c_re[(ci + k) * 64 + pq], -p.c_im[(ci + k) * 64 + pq]);
#else
            CC[((size_t)dg * 16 + k) * 128 + pq] = (bf16)f2bf(p.c_re[(ci + k) * 64 + pq]); CC[((size_t)dg * 16 + k) * 128 + 64 + pq] = (bf16)f2bf(-p.c_im[(ci + k) * 64 + pq]);
#endif
        }
    }
}
constexpr int S5_WREG = 4096 + 16 * 132 * 4 + 16 * LDP;
template <bool READOUT> __device__ __forceinline__ void s5_chunk_dir(int d, const bf16* BBdg, const bf16* CCdg, float abr, float abi, LAS unsigned char* wreg, int lane, float& hr, float& hi, f32x4 (&yacc)[8]) {
    const int quad = lane >> 4, l15 = lane & 15;
    LAS unsigned char* ub = wreg; LAS float* BuW = (LAS float*)(wreg + 4096); LAS unsigned char* Hw = wreg + 4096 + 16 * 132 * 4;
    bf16x8 BBf[8], CCf[4];
#pragma unroll
    for (int pt = 0; pt < 8; ++pt) BBf[pt] = *(const bf16x8*)(BBdg + (size_t)(16 * pt + l15) * 32 + 8 * quad);
    if (READOUT) {
#pragma unroll
        for (int ks = 0; ks < 4; ++ks) CCf[ks] = *(const bf16x8*)(CCdg + (size_t)l15 * 128 + ks * 32 + 8 * quad);
    }
#pragma unroll (READOUT ? 8 : 1)
    for (int ss = 0; ss < 8; ++ss) {
        const int sc = d ? 7 - ss : ss;
        bf16x8 uf = (bf16x8){0, 0, 0, 0, 0, 0, 0, 0};
        if (quad < 2) uf = *(const LAS bf16x8*)(ub + (16 * sc + l15) * 32 + quad * 16);
#pragma unroll
        for (int pt = 0; pt < 8; ++pt) { const f32x4 Dp = MFMA16(uf, BBf[pt], ((f32x4){0.f, 0.f, 0.f, 0.f}));
#pragma unroll
            for (int r = 0; r < 4; ++r) BuW[(4 * quad + r) * 132 + 16 * pt + l15] = Dp[r]; }
        LDS_FENCE();
#pragma unroll
        for (int st = 0; st < 16; ++st) { const int tl = d ? 15 - st : st;
#if S5_INTERLEAVE == 1
            typedef float f32x2_t __attribute__((ext_vector_type(2)));
            const f32x2_t bu = *(const LAS f32x2_t*)(BuW + tl * 132 + 2 * lane);
            const float nr = abr * hr - abi * hi + bu[0], ni = abr * hi + abi * hr + bu[1]; hr = nr; hi = ni;
            if (READOUT) *(LAS unsigned*)(Hw + tl * LDP + 4 * lane) = pk2(hr, hi); }
#elif S5_INTERLEAVE == 2
            const float br = BuW[tl * 132 + 2 * lane], bi = BuW[tl * 132 + 2 * lane + 1];
            const float nr = abr * hr - abi * hi + br, ni = abr * hi + abi * hr + bi; hr = nr; hi = ni;
            if (READOUT) *(LAS unsigned*)(Hw + tl * LDP + 4 * lane) = pk2(hr, hi); }
#else
            const float br = BuW[tl * 132 + lane], bi = BuW[tl * 132 + 64 + lane];
            const float nr = abr * hr - abi * hi + br, ni = abr * hi + abi * hr + bi; hr = nr; hi = ni;
            if (READOUT) { st_b16(Hw + tl * LDP + 2 * lane, f2bf(hr)); st_b16(Hw + tl * LDP + 128 + 2 * lane, f2bf(hi)); } }
#endif
        if (READOUT) {
            LDS_FENCE();
#pragma unroll
            for (int ks = 0; ks < 4; ++ks) yacc[sc] = MFMA16(ld_frag(Hw, l15, ks * 32 + 8 * quad, LDP), CCf[ks], yacc[sc]);
        }
        LDS_FENCE();
    }
}
__device__ __forceinline__ void s5_local_states(const P& p, LAS unsigned char* lds, const bf16* BB, const float* AB) {
    LAS unsigned char* wreg = lds + p.wave * S5_WREG;
    const int gw = p.bid * NWAVES + p.wave, NGW = p.G * NWAVES, lane = p.lane;
    for (int it = gw; it < 2 * 32 * NCH; it += NGW) {
        const int d = it / (32 * NCH), c = (it % (32 * NCH)) >> 5, g = it & 31, dg = d * 32 + g;
        s5_stage_u(p, chunk_r0(d, c), g, wreg, lane);
        float hr = 0.f, hi = 0.f; f32x4 dummy[8];
        const float abr = AB[((size_t)dg * 64 + lane) * 2], abi = AB[((size_t)dg * 64 + lane) * 2 + 1];
        if (d == 0) s5_chunk_dir<false>(0, BB + (size_t)dg * 128 * 32, nullptr, abr, abi, wreg, lane, hr, hi, dummy);
        else s5_chunk_dir<false>(1, BB + (size_t)dg * 128 * 32, nullptr, abr, abi, wreg, lane, hr, hi, dummy);
        float* E = p.S5E + ((size_t)dg * NCH + c) * 128;
        E[lane] = hr; E[64 + lane] = hi;
    }
}
__device__ __forceinline__ void s5_outputs(const P& p, int l, LAS unsigned char* lds, const bf16* BB, const bf16* CC, const float* AB, int it_begin, int it_end, int first, int stride) {
    LAS unsigned char* wreg = lds + p.wave * S5_WREG;
    const int lane = p.lane, quad = lane >> 4, l15 = lane & 15;
    for (int it = it_begin + first; it < it_end; it += stride) {
        const int cn = it >> 5, g = it & 31, r0 = 128 * cn;
        s5_stage_u(p, r0, g, wreg, lane);
        f32x4 yacc[8];
#pragma unroll
        for (int i = 0; i < 8; ++i) yacc[i] = (f32x4){0.f, 0.f, 0.f, 0.f};
#pragma unroll
        for (int d = 0; d < 2; ++d) { const int dg = d * 32 + g, cs = scan_chunk_of(d, cn);
            const float* Hn = (cn < 2) ? (p.S5E + (size_t)dg * NCH * 128) : (p.S5H + ((size_t)dg * NCH + cs) * 128);
            float hr = Hn[lane], hi = Hn[64 + lane];
            if (cs == 0) { hr = 0.f; hi = 0.f; }
            s5_chunk_dir<true>(d, BB + (size_t)dg * 128 * 32, CC + (size_t)dg * 16 * 128, AB[((size_t)dg * 64 + lane) * 2], AB[((size_t)dg * 64 + lane) * 2 + 1], wreg, lane, hr, hi, yacc); }
        const float dsk = p.s5_d[(size_t)l * 512 + g * 16 + l15];
#pragma unroll
        for (int sc = 0; sc < 8; ++sc)
#pragma unroll
            for (int r = 0; r < 4; ++r) { const int t = 16 * sc + 4 * quad + r;
                const float u = bf2f(*(const LAS unsigned short*)(wreg + t * 32 + 2 * l15));
                p.SA[(size_t)(r0 + t) * 512 + g * 16 + l15] = (bf16)f2bf(gelu_tanh_f(yacc[sc][r] + dsk * u)); }
        LDS_FENCE();
    }
}

#ifndef SKIPMASK
#define SKIPMASK 0
#endif
struct Args { const float* in[33]; float* out; unsigned char* ws; int ph_lo, ph_hi; };
static_assert(sizeof(Args) == 35 * 8 + 8, "no padding");

__global__ void __launch_bounds__(NTHR, 2) fwd_kernel(Args args) {
    extern __shared__ __attribute__((aligned(16))) unsigned char lds_raw[];
    LAS unsigned char* lds = (LAS unsigned char*)lds_raw;
    const int tid_ = threadIdx.x;
    if (tid_ == 0) {
        LAS unsigned long long* tab = (LAS unsigned long long*)(lds + PTAB_OFF);
#pragma unroll
        for (int k = 0; k < 33; ++k) tab[k] = (unsigned long long)args.in[k];
        tab[33] = (unsigned long long)args.out; tab[34] = (unsigned long long)args.ws;
    }
    volatile LAS unsigned* MISC = (volatile LAS unsigned*)(lds + MISC_OFF);
    if (tid_ < 64) MISC[tid_] = 0u;
    __syncthreads();
    XcdBarrier bar; bar.bar = (unsigned*)(args.ws + WS_CTL) + CW_BAR; bar.x = 0; bar.st = nullptr;
    if (!MK_PER_PHASE) bar = xcd_barrier_post((unsigned*)(args.ws + WS_CTL) + CW_BAR, MISC + 8);

    const int lo = args.ph_lo, hi = args.ph_hi;
#define IN(k) (lo <= (k) && (k) < hi)
#define SEAM(k) do { if (!MK_PER_PHASE && (k) + 1 < hi) xcd_barrier(bar); } while (0)

    if (IN(0)) { P p; build_P(p, lds); phase_mod(p, lds, (float*)(args.ws + WS_ROPE)); SEAM(0); }

#ifndef REPMASK
#define REPMASK 0
#endif
#define PHASE(k, ...) if (!((SKIPMASK >> (k)) & 1) && IN(pb + (k))) { for (int rep_ = 0; rep_ <= ((REPMASK >> (k)) & 1); ++rep_) { P p; build_P(p, lds, l & 1); __VA_ARGS__; \
        if (rep_ < ((REPMASK >> (k)) & 1)) xcd_barrier(bar); } SEAM(pb + (k)); }
    for (int l = 0; l < DEPTH; ++l) {
        const int pb = 1 + NPH_LAYER * l;
        const bool cx = l < DEPTH - 1;
        unsigned char* wsb; { unsigned tb_ = (unsigned)(size_t)(lds + PTAB_OFF); asm volatile("" : "+v"(tb_)); wsb = (unsigned char*)ld_tab((volatile LAS unsigned*)(size_t)tb_, 34); }
        PHASE(0, if (l == 0) convert_weights(p, l, lds, p.bid * NWAVES + p.wave, p.G * NWAVES); s5_tables(p, l, (bf16*)(wsb + WS_S5BB), (bf16*)(wsb + WS_S5CC), (float*)(wsb + WS_S5AB)); __syncthreads(); if (rep_ == 0) row_pass<0>(p, l, lds))
        PHASE(1, pg8::Gemm g{p.H, p.WIN, T, PJ, D}; pg8::StaticOrder S; S.init(T, PJ, p.G, p.bid); pg8::EpiStoreBf16 E{p.PROJ, PJ, GT0 / 256, (const float*)(wsb + WS_ROPE)};
            pg8::gemm_phase<pg8::EpiStoreBf16, pg8::StaticOrder, false>(lds, g, S, E, nullptr))
        PHASE(2, phase_premix(p, l, lds); s5_local_states(p, lds, (const bf16*)(wsb + WS_S5BB), (const float*)(wsb + WS_S5AB)))
        PHASE(3, ssd_states(p, l, lds, (float*)(wsb + WS_SST), (float*)(wsb + WS_DEC)); __syncthreads(); attention_mfma(p, l, lds, 4, 2 * NCH, p.bid, p.G))
        PHASE(4, if (cx) { if (p.bid >= p.G - 4) attention_mfma(p, l, lds, 0, 4, p.bid - (p.G - 4), 4);
                else if (p.bid >= p.G - 20) ssd_outputs(p, l, lds, (const bf16*)(wsb + WS_HIN), (const float*)(wsb + WS_SST), (bf16*)(wsb + WS_YS), 0, 16, p.bid - (p.G - 20), 16);
                else if (p.bid >= p.G - 28) s5_outputs(p, l, lds, (const bf16*)(wsb + WS_S5BB), (const bf16*)(wsb + WS_S5CC), (const float*)(wsb + WS_S5AB), 0, 64, (p.bid - (p.G - 28)) * NWAVES + p.wave, 64); }
            scan_carries(p, l, (const float*)(wsb + WS_SST), (const float*)(wsb + WS_DEC), (bf16*)(wsb + WS_HIN)))
        PHASE(5, ssd_outputs(p, l, lds, (const bf16*)(wsb + WS_HIN), (const float*)(wsb + WS_SST), (bf16*)(wsb + WS_YS), 16, NCH * 8, p.bid, p.G); __syncthreads();
            s5_outputs(p, l, lds, (const bf16*)(wsb + WS_S5BB), (const bf16*)(wsb + WS_S5CC), (const float*)(wsb + WS_S5AB), 64, 32 * NCH, p.bid * NWAVES + p.wave, p.G * NWAVES))
        PHASE(6, pg8::Gemm g{p.SA, p.WGLU, T, 512, 512}; pg8::RowOffOrder S; S.init(cx ? T : NLAT, 512, p.G, p.bid, cx ? 0 : 1); pg8::EpiGlu E{p.SA, p.b_glu + (size_t)l * 512, p.Y3};
            pg8::gemm_phase<pg8::EpiGlu, pg8::RowOffOrder, false>(lds, g, S, E, nullptr); ssd_gated_norm(p, l, (const bf16*)(wsb + WS_YS)))
        PHASE(7, pg8::Gemm g{p.Y3, p.WBR, T, D, 1536}; pg8::RowOffOrder S; S.init(cx ? T : NLAT, D, p.G, p.bid, cx ? 0 : 1); pg8::EpiMerge E{p.PROJ, p.MB};
            pg8::gemm_phase<pg8::EpiMerge, pg8::RowOffOrder, false>(lds, g, S, E, nullptr))
        PHASE(8, pg8::Gemm g{p.MB, p.WOUT, T, D, D}; pg8::RowOffOrder S; S.init(cx ? T : NLAT, D, p.G, p.bid, cx ? 0 : 1);
            pg8::EpiResid E{p.XL, p.XC, p.MOD + (size_t)(l * 2 + 0) * 6144 + 2 * D, p.MOD + (size_t)(l * 2 + 1) * 6144 + 2 * D};
            pg8::gemm_phase<pg8::EpiResid, pg8::RowOffOrder, false>(lds, g, S, E, nullptr))
        PHASE(9, row_pass<1>(p, l, lds, cx))
        PHASE(10, { const int nsel = cx ? 32 : 16; if (p.bid < nsel) phase_select(p, lds, cx);
            else if (l + 1 < DEPTH) { P q; build_P(q, lds, (l + 1) & 1); convert_weights(q, l + 1, lds, (p.bid - nsel) * NWAVES + p.wave, (p.G - nsel) * NWAVES); } })
        PHASE(11, phase_gather(p, cx))
        PHASE(12, pg8::Gemm g{p.XE, p.WUP, NE * ESLOTS, NE * 2048, D}; pg8::ExpertOrder S{p.G, p.bid, 8, cx ? 9 : 8}; pg8::EpiSwiGlu E{p.HID};
            pg8::gemm_phase<pg8::EpiSwiGlu, pg8::ExpertOrder, false>(lds, g, S, E, nullptr))
        PHASE(13, pg8::Gemm g{p.HID, p.WDN, NE * ESLOTS, NE * 1024, D}; pg8::ExpertOrder S{p.G, p.bid, 4, cx ? 9 : 8}; pg8::EpiDown E{p.YE, p.GSEL};
            pg8::gemm_phase<pg8::EpiDown, pg8::ExpertOrder, false>(lds, g, S, E, nullptr))
    }
    if (IN(NPHASES - 1)) { P p; build_P(p, lds); row_pass<2>(p, 0, lds); }
#undef IN
#undef SEAM
}

extern "C" void kernel_launch(void* const* d_in, const int* in_sizes, int n_in, void* d_out, int out_size, void* d_ws, size_t ws_size, hipStream_t stream) {
    static int grid = 0;
    if (grid == 0) {
        if (n_in != 33 || out_size != NLAT * D || ws_size < WS_END) { fprintf(stderr, "kernel_launch: unexpected shapes: n_in %d out %d ws %zu (need %zu)\n", n_in, out_size, ws_size, (size_t)WS_END); grid = -1; return; }
        int dev = 0, cus = 0, per_cu = 0;
        if (hipGetDevice(&dev) != hipSuccess || hipDeviceGetAttribute(&cus, hipDeviceAttributeMultiprocessorCount, dev) != hipSuccess) { grid = -1; return; }
        if (hipFuncSetAttribute((const void*)fwd_kernel, hipFuncAttributeMaxDynamicSharedMemorySize, LDS_BYTES) != hipSuccess) { fprintf(stderr, "kernel_launch: hipFuncSetAttribute failed\n"); grid = -1; return; }
        if (hipOccupancyMaxActiveBlocksPerMultiprocessor(&per_cu, (const void*)fwd_kernel, NTHR, LDS_BYTES) != hipSuccess || per_cu < 1) { fprintf(stderr, "kernel_launch: occupancy query says %d\n", per_cu); (void)hipGetLastError(); }
        grid = cus;
    }
    if (grid < 0) return;
    (void)hipMemsetAsync((char*)d_ws + WS_CTL, 0, CTL_BYTES, stream);
    Args a{};
    for (int i = 0; i < 33; ++i) a.in[i] = (const float*)d_in[i];
    a.out = (float*)d_out; a.ws = (unsigned char*)d_ws;
#if MK_PER_PHASE
    for (int ph = 0; ph < NPHASES; ++ph) { a.ph_lo = ph; a.ph_hi = ph + 1; hipLaunchKernelGGL(fwd_kernel, dim3(grid), dim3(NTHR), LDS_BYTES, stream, a); }
#else
    a.ph_lo = 0; a.ph_hi = NPHASES;
    hipLaunchKernelGGL(fwd_kernel, dim3(grid), dim3(NTHR), LDS_BYTES, stream, a);
#endif
}
```

```cpp
#include <hip/hip_runtime.h>
#include <cstdio>
#include <cstdint>

#ifndef MK_PER_PHASE
#define MK_PER_PHASE 0
#endif

namespace pg8 {
#define PG8_LAS __attribute__((address_space(3)))
typedef unsigned short bf16_t;
typedef short bf16x8 __attribute__((ext_vector_type(8)));
typedef float f32x4 __attribute__((ext_vector_type(4)));
typedef unsigned u32x4 __attribute__((ext_vector_type(4)));
constexpr int BM = 256, BK = 64, HALF = 128, HTB = HALF * BK * 2  , STAGE_BYTES = 8 * HTB, NXCD = 8, WGM = 8;

__host__ __device__ __forceinline__ int lds_byte(int r, int c) { const int st = (r >> 4) * 2 + (c >> 5), rr = r & 15, cc = c & 31, ob = rr * 64 + cc * 2; return st * 1024 + (ob ^ (((ob >> 9) & 1) << 5)); }
__host__ __device__ __forceinline__ void stage_rc(int b, int& R, int& C) { const int st = b / 1024, sb = b % 1024, swz = sb ^ (((sb >> 9) & 1) << 5); R = (st >> 1) * 16 + swz / 64; C = (st & 1) * 32 + (swz % 64) / 2; }
__host__ __device__ __forceinline__ int perm32(int rho) { const int n = rho >> 4, i = rho & 15; return 8 * (i >> 2) + 4 * n + (i & 3); }

struct Unit { int pm, pn; };
struct Gemm { const bf16_t* A; const bf16_t* Bt; int M, N, K; };

struct StaticOrder {
    int nM, nN, nwg, G, c;
    __host__ __device__ void init(int M, int N, int G_, int c_) { nM = M / BM; nN = N / BM; nwg = nM * nN; G = G_; c = c_; }
    __host__ __device__ bool next(int i, Unit& u) const {
        const long L = (long)i * G + c; if (L >= nwg) return false;
        int wgid = (int)L; { const int q = nwg / NXCD, r = nwg % NXCD, xcd = wgid % NXCD, off = wgid / NXCD; wgid = (xcd < r ? xcd * (q + 1) : r * (q + 1) + (xcd - r) * q) + off; }
        const int nig = WGM * nN, gid = wgid / nig, fm = gid * WGM, gsz = (nM - fm) < WGM ? (nM - fm) : WGM;
        u.pm = fm + ((wgid % nig) % gsz); u.pn = (wgid % nig) / gsz; return true;
    }
    __device__ __forceinline__ void a_ready(const Unit&) const {}
    __device__ __forceinline__ void done(const Unit&) const {}
};
__device__ __forceinline__ unsigned cvt_pk_bf16(float lo, float hi) { unsigned r; asm volatile("v_cvt_pk_bf16_f32 %0, %1, %2" : "=v"(r) : "v"(lo), "v"(hi)); return r; }
template <class Epi, class Sched, bool STAMP = false>
__device__ __forceinline__ void gemm_phase(PG8_LAS unsigned char* lds, const Gemm g, const Sched& S, const Epi& E, unsigned long long* stamps) {
    int tid_l = threadIdx.x; asm volatile("" : "+v"(tid_l));
    const int tid = tid_l, wid = __builtin_amdgcn_readfirstlane(tid >> 6), lane = tid & 63, wr = wid >> 2, wc = wid & 3, fr = lane & 15, fq = lane >> 4;
    const int K = g.K, nt = K / BK;
    int ts_lo = 0, ts_hi = 0, nts = 0; const unsigned long long rt_entry = STAMP ? (unsigned long long)wall_clock64() : 0ull;
#define PG8_STAMP() do { if (STAMP && wid == 0 && nts < 64) { const unsigned long long _c = (unsigned long long)clock64(); \
        ts_lo = (lane == nts) ? (int)(unsigned)_c : ts_lo; ts_hi = (lane == nts) ? (int)(unsigned)(_c >> 32) : ts_hi; ++nts; } } while (0)
    PG8_STAMP();
    unsigned voffA[2], voffB[2];
#pragma unroll
    for (int i = 0; i < 2; ++i) { int R, C; stage_rc(tid * 16 + i * 8192, R, C); const int Rb = Epi::PERM ? ((R & ~31) + perm32(R & 31)) : R;
        voffA[i] = (unsigned)(R * K + C) * 2u; voffB[i] = (unsigned)(Rb * K + C) * 2u; }
    const size_t kstep = (size_t)(BK * 2);
    const size_t hstep = (size_t)HALF * K * 2;
    const size_t tstep = 2 * hstep;
    const unsigned ldsw = (unsigned)wid * 1024u;
    const int aoff = lds_byte(wr * 64 + fr, fq * 8), boff = lds_byte(wc * 32 + fr, fq * 8);
#define PG8_SA(b, h) (((b) * 2 + (h)) * HTB)
#define PG8_SB(b, h) ((4 + (b) * 2 + (h)) * HTB)
#define PG8_STAGE(bufoff, gbase, voff) do { _Pragma("unroll") for (int _i = 0; _i < 2; ++_i) \
        __builtin_amdgcn_global_load_lds((const unsigned*)((const char*)(gbase) + (voff)[_i]), (PG8_LAS unsigned*)(lds + (bufoff) + ldsw + _i * 8192), 16, 0, 0); } while (0)
#define PG8_LDA(dst, b, h) do { _Pragma("unroll") for (int m = 0; m < 4; ++m) _Pragma("unroll") for (int k = 0; k < 2; ++k) dst[m][k] = *(const PG8_LAS bf16x8*)(lds + PG8_SA(b, h) + aoff + m * 2048 + k * 1024); } while (0)
#define PG8_LDB(dst, b, h) do { _Pragma("unroll") for (int n = 0; n < 2; ++n) _Pragma("unroll") for (int k = 0; k < 2; ++k) dst[n][k] = *(const PG8_LAS bf16x8*)(lds + PG8_SB(b, h) + boff + n * 2048 + k * 1024); } while (0)
#define PG8_MMA(ai, bj, At, Bt) do { __builtin_amdgcn_s_setprio(1); _Pragma("unroll") for (int m = 0; m < 4; ++m) _Pragma("unroll") for (int n = 0; n < 2; ++n) _Pragma("unroll") for (int k = 0; k < 2; ++k) \
        acc[ai][bj][m][n] = __builtin_amdgcn_mfma_f32_16x16x32_bf16(Bt[n][k], At[m][k], acc[ai][bj][m][n], 0, 0, 0); __builtin_amdgcn_s_setprio(0); } while (0)
#define PG8_WAIT_V(n) asm volatile("s_waitcnt vmcnt(" #n ")" ::: "memory")
#define PG8_WAIT_L(n) asm volatile("s_waitcnt lgkmcnt(" #n ")" ::: "memory")
#define PG8_BAR __builtin_amdgcn_s_barrier()
#define PG8_SCHED __builtin_amdgcn_sched_barrier(0)
    Unit cur, nxt; int ui = 0;
    if (!S.next(0, cur)) return;
    f32x4 acc[2][2][4][2];
#pragma unroll
    for (int a = 0; a < 2; ++a)
#pragma unroll
        for (int b = 0; b < 2; ++b)
#pragma unroll
            for (int m = 0; m < 4; ++m)
#pragma unroll
                for (int n = 0; n < 2; ++n) acc[a][b][m][n] = (f32x4){0.f, 0.f, 0.f, 0.f};
    bf16x8 At[4][2], B0[2][2], B1[2][2];
    const char* cA = (const char*)g.A + (size_t)cur.pm * tstep; const char* cB = (const char*)g.Bt + (size_t)cur.pn * tstep;
    S.a_ready(cur);
    PG8_STAGE(PG8_SB(0, 0), cB, voffB); PG8_STAGE(PG8_SA(0, 0), cA, voffA); PG8_STAGE(PG8_SB(0, 1), cB + hstep, voffB); PG8_STAGE(PG8_SA(0, 1), cA + hstep, voffA);
    if (wr == 1) PG8_BAR;
    PG8_WAIT_V(4); PG8_BAR;
    PG8_STAGE(PG8_SB(1, 0), cB + kstep, voffB); PG8_STAGE(PG8_SA(1, 0), cA + kstep, voffA); PG8_STAGE(PG8_SB(1, 1), cB + hstep + kstep, voffB);
    PG8_WAIT_V(6); PG8_BAR;
    PG8_STAMP();
    for (;;) {
        const bool has_next = S.next(ui + 1, nxt);
        const char* nA = has_next ? (const char*)g.A + (size_t)nxt.pm * tstep : cA; const char* nB = has_next ? (const char*)g.Bt + (size_t)nxt.pn * tstep : cB;
        for (int t = 0; t < nt; t += 2) {
            const bool last = (t == nt - 2);
            const char* a1 = cA + (size_t)(t + 1) * kstep;
            const char* a2 = last ? nA : cA + (size_t)(t + 2) * kstep; const char* b2 = last ? nB : cB + (size_t)(t + 2) * kstep;
            const char* a3 = a2 + kstep; const char* b3 = b2 + kstep;
            if (last && has_next) S.a_ready(nxt);
            if constexpr (Epi::MIDHOOK) { if (t == 8 || t == 16) E.mid(acc, cur, t >> 3, wr, wc, fr, fq); }
            PG8_LDB(B0, 0, 0); PG8_SCHED; PG8_LDA(At, 0, 0); PG8_STAGE(PG8_SA(1, 1), a1 + hstep, voffA);
            PG8_WAIT_L(8); PG8_BAR; PG8_WAIT_L(0); PG8_MMA(0, 0, At, B0); PG8_BAR; PG8_SCHED;
            PG8_LDB(B1, 0, 1); PG8_STAGE(PG8_SB(0, 0), b2, voffB);
            PG8_BAR; PG8_WAIT_L(0); PG8_MMA(0, 1, At, B1); PG8_BAR;
            PG8_LDA(At, 0, 1); PG8_STAGE(PG8_SA(0, 0), a2, voffA);
            PG8_BAR; PG8_WAIT_L(0); PG8_MMA(1, 0, At, B0); PG8_BAR; PG8_SCHED;
            PG8_STAGE(PG8_SB(0, 1), b2 + hstep, voffB);
            PG8_WAIT_V(6); PG8_BAR; PG8_MMA(1, 1, At, B1); PG8_BAR;
            PG8_LDB(B0, 1, 0); PG8_SCHED; PG8_LDA(At, 1, 0); PG8_STAGE(PG8_SA(0, 1), a2 + hstep, voffA);
            PG8_WAIT_L(8); PG8_BAR; PG8_WAIT_L(0); PG8_MMA(0, 0, At, B0); PG8_BAR; PG8_SCHED;
            PG8_LDB(B1, 1, 1); PG8_STAGE(PG8_SB(1, 0), b3, voffB);
            PG8_BAR; PG8_WAIT_L(0); PG8_MMA(0, 1, At, B1); PG8_BAR;
            PG8_LDA(At, 1, 1); PG8_STAGE(PG8_SA(1, 0), a3, voffA);
            PG8_BAR; PG8_WAIT_L(0); PG8_MMA(1, 0, At, B0); PG8_BAR; PG8_SCHED;
            PG8_STAGE(PG8_SB(1, 1), b3 + hstep, voffB);
            PG8_WAIT_V(6); PG8_BAR; PG8_MMA(1, 1, At, B1); PG8_BAR;
        }
        PG8_STAMP();
        if constexpr (!Epi::AFTER_DRAIN) { E(acc, cur, wr, wc, fr, fq); S.done(cur); }
        PG8_STAMP();
        if (!has_next) break;
#pragma unroll
        for (int a = 0; a < 2; ++a)
#pragma unroll
            for (int b = 0; b < 2; ++b)
#pragma unroll
                for (int m = 0; m < 4; ++m)
#pragma unroll
                    for (int n = 0; n < 2; ++n) acc[a][b][m][n] = (f32x4){0.f, 0.f, 0.f, 0.f};
        cur = nxt; cA = nA; cB = nB; ++ui;
    }
    PG8_WAIT_V(0);
    if (wr == 0) PG8_BAR;
    PG8_BAR;
    if constexpr (Epi::AFTER_DRAIN) { E.fused(acc, cur, wr, wc, fr, fq, lds, wid, lane); S.done(cur); }
    PG8_STAMP();
    if (STAMP && wid == 0) { stamps[lane] = lane < nts ? (((unsigned long long)(unsigned)ts_hi << 32) | (unsigned)ts_lo) : 0ull;
        if (lane == 62) stamps[62] = rt_entry; if (lane == 63) stamps[63] = (unsigned long long)wall_clock64(); }
#undef PG8_STAMP
#undef PG8_SA
#undef PG8_SB
#undef PG8_STAGE
#undef PG8_LDA
#undef PG8_LDB
#undef PG8_MMA
#undef PG8_WAIT_V
#undef PG8_WAIT_L
#undef PG8_BAR
#undef PG8_SCHED
}
}

#define GAS __attribute__((address_space(1)))
#define LAS __attribute__((address_space(3)))
typedef unsigned short bf16;
typedef float f32x4 __attribute__((ext_vector_type(4)));
typedef unsigned u32x4 __attribute__((ext_vector_type(4)));
typedef unsigned u32x2 __attribute__((ext_vector_type(2)));

constexpr int D = 1024, NLAT = 16384, NCTX = 256, T = NLAT + NCTX, DEPTH = 4;
constexpr int IN_W = 5904, PJ = 5888;
constexpr int U0 = 0, Z0 = 512, XB0 = 1024, Q0 = 2048, K0 = 2560, V0 = 2688, GT0 = 2816;
constexpr int NE = 16, ESLOTS = 2304, CAP_L = 2048, CAP_C = 32;
constexpr int NCH = 130;
constexpr float EPS = 1e-6f;
constexpr int NWAVES = 8, NTHR = 512;
constexpr int LDS_BYTES = 155648;
constexpr int MISC_OFF = LDS_BYTES - 1024 + 512;
constexpr int NPH_LAYER = 14, NPHASES = 1 + DEPTH * NPH_LAYER + 1;

constexpr size_t al256(size_t x) { return (x + 255) & ~(size_t)255; }
constexpr size_t WS_CTL = 0, CTL_BYTES = 1u << 20;
constexpr size_t WS_MOD = WS_CTL + CTL_BYTES;
constexpr size_t WS_XC = al256(WS_MOD + (size_t)DEPTH * 2 * 6144 * 4);
constexpr size_t WS_WIN = al256(WS_XC + (size_t)NCTX * D * 4);
constexpr size_t WS_WGLU = al256(WS_WIN + (size_t)PJ * D * 2);
constexpr size_t WS_WBR = al256(WS_WGLU + (size_t)512 * 512 * 2);
constexpr size_t WS_WOUT = al256(WS_WBR + (size_t)3 * 1024 * 512 * 2);
constexpr size_t WS_WUP = al256(WS_WOUT + (size_t)1024 * 1024 * 2);
constexpr size_t WS_WDN = al256(WS_WUP + (size_t)NE * 2048 * 1024 * 2);
constexpr size_t WS_H = al256(WS_WDN + (size_t)NE * 1024 * 1024 * 2);
constexpr size_t WS_PROJ = al256(WS_H + (size_t)T * D * 2);
constexpr size_t WS_XE = WS_PROJ;
constexpr size_t WS_HID = al256(WS_XE + (size_t)NE * ESLOTS * D * 2);
constexpr size_t WS_DT = al256(WS_PROJ + (size_t)T * PJ * 2);
constexpr size_t WS_CV = al256(WS_DT + (size_t)T * 16 * 4);
constexpr size_t WS_S5E = al256(WS_CV + (size_t)T * 1024 * 2);
constexpr size_t WS_S5H = al256(WS_S5E + (size_t)2 * 32 * NCH * 128 * 4);
constexpr size_t WS_YD = al256(WS_S5H + (size_t)2 * 32 * NCH * 128 * 4);
constexpr size_t WS_SA = al256(WS_YD + (size_t)2 * T * 512 * 4);
constexpr size_t WS_Y3 = al256(WS_SA + (size_t)T * 512 * 2);
constexpr size_t WS_PM = al256(WS_Y3 + (size_t)3 * T * 512 * 2);
constexpr size_t WS_MB = al256(WS_PM + (size_t)T * D * 4);
constexpr size_t WS_YE = WS_PM;
constexpr size_t WS_AFFT = al256(WS_MB + (size_t)T * D * 2);
constexpr size_t WS_IDX = al256(WS_AFFT + (size_t)NE * T * 4);
constexpr size_t WS_GSEL = al256(WS_IDX + (size_t)NE * ESLOTS * 4);
constexpr size_t WS_INV = al256(WS_GSEL + (size_t)NE * ESLOTS * 4);
constexpr size_t WS_DEC = al256(WS_INV + (size_t)T * 16 * 4);
constexpr size_t WS_S5BB = al256(WS_DEC + (size_t)2 * NCH * 8 * 4);
constexpr size_t WS_S5CC = al256(WS_S5BB + (size_t)2 * 32 * 128 * 32 * 2);
constexpr size_t WS_S5AB = al256(WS_S5CC + (size_t)2 * 32 * 16 * 128 * 2);
constexpr size_t WS_ROPE = al256(WS_S5AB + (size_t)2 * 32 * 64 * 2 * 4);
constexpr size_t WS_W2 = al256(WS_ROPE + (size_t)2 * 256 * 16 * 4);
constexpr size_t WBUF_BYTES = WS_H - WS_WIN;
constexpr size_t WS_END = al256(WS_W2 + WBUF_BYTES);
constexpr size_t WS_SST = WS_YD;
constexpr size_t WS_HIN = WS_PM;
constexpr size_t WS_YS = al256(WS_HIN + (size_t)2 * NCH * 8 * 8192 * 2);
static_assert(WS_YS + (size_t)T * 512 * 2 <= WS_AFFT, "HIN|YS overlay fits PM|MB");
static_assert(WS_HID + (size_t)NE * ESLOTS * D * 2 <= WS_DT, "XE|HID overlay fits PROJ");
static_assert(WS_YE + (size_t)NE * ESLOTS * D * 2 <= WS_AFFT, "YE overlay fits PM|MB");
static_assert(WS_END < (size_t)1000 * 1024 * 1024, "workspace");
constexpr int CW_BAR = 4096;

__device__ __forceinline__ float bf2f(unsigned b) { return __uint_as_float(b << 16); }
__device__ __forceinline__ float bflo(unsigned w) { return __uint_as_float(w << 16); }
__device__ __forceinline__ float bfhi(unsigned w) { return __uint_as_float(w & 0xffff0000u); }
typedef float f32x2_c __attribute__((ext_vector_type(2)));
typedef __bf16 bf16x2_c __attribute__((ext_vector_type(2)));
__device__ __forceinline__ unsigned pk2(float lo, float hi) { f32x2_c v; v[0] = lo; v[1] = hi; return __builtin_bit_cast(unsigned, __builtin_convertvector(v, bf16x2_c)); }
__device__ __forceinline__ unsigned f2bf(float f) { return pk2(f, 0.f) & 0xffffu; }
__device__ __forceinline__ float wsum(float v) {
#pragma unroll
    for (int o = 1; o < 64; o <<= 1) v += __shfl_xor(v, o);
    return v;
}
__device__ __forceinline__ float wmaxf(float v) {
#pragma unroll
    for (int o = 1; o < 64; o <<= 1) v = fmaxf(v, __shfl_xor(v, o));
    return v;
}
__device__ __forceinline__ float silu_f(float x) { return x * __builtin_amdgcn_rcpf(1.f + __expf(-x)); }
__device__ __forceinline__ float sigmoid_f(float x) { return __builtin_amdgcn_rcpf(1.f + __expf(-x)); }
__device__ __forceinline__ float softplus_f(float x) { return x > 20.f ? x : log1pf(expf(x)); }
__device__ __forceinline__ float gelu_tanh_f(float x) { const float u = 0.7978845608028654f * (x + 0.044715f * x * x * x); return x * __builtin_amdgcn_rcpf(1.f + __expf(-2.f * u)); }
#define LDS_FENCE() asm volatile("s_waitcnt lgkmcnt(0)" ::: "memory")
__device__ __forceinline__ int scan_row(int d, int s) { return d == 0 ? s : (s < NCTX ? (NCTX - 1 - s) : (T + NCTX - 1 - s)); }

namespace pg8 {
struct EpiStoreBf16 {
    static constexpr bool PERM = true, AFTER_DRAIN = false, MIDHOOK = false;
    bf16_t* O; int ldc; int sig_tile; const float* rope;
    __device__ __forceinline__ void operator()(const f32x4 (&acc)[2][2][4][2], const Unit& u, int wr, int wc, int fr, int fq) const {
        const int row0 = u.pm * BM + wr * 64 + fr, col0 = u.pn * BM + wc * 32 + 8 * fq; const bool sg = u.pn >= sig_tile;
        const bool rq = rope != nullptr && u.pm >= 1 && (u.pn == Q0 / 256 || u.pn == Q0 / 256 + 1), rk = rope != nullptr && u.pm >= 1 && u.pn == K0 / 256;
#pragma unroll
        for (int ai = 0; ai < 2; ++ai)
#pragma unroll
            for (int m = 0; m < 4; ++m) { const int row = row0 + ai * HALF + m * 16; bf16_t* rowp = O + (size_t)row * ldc + col0;
#pragma unroll
                for (int bj = 0; bj < 2; ++bj) { f32x4 v0 = acc[ai][bj][m][0], v1 = acc[ai][bj][m][1];
                    if (sg) {
#pragma unroll
                        for (int q = 0; q < 4; ++q) { v0[q] = __builtin_amdgcn_rcpf(1.f + __expf(-v0[q])); v1[q] = __builtin_amdgcn_rcpf(1.f + __expf(-v1[q])); } }
                    if (rq || (rk && bj == 0)) {
                        const int t = row - NCTX, idx = (wc & 1) ? (t & 63) : (t >> 6);
                        const float* cp = rope + idx * 16 + 8 * (fq & 1);
                        const f32x4 c0 = *(const f32x4*)cp, c1 = *(const f32x4*)(cp + 4), s0 = *(const f32x4*)(cp + 4096), s1 = *(const f32x4*)(cp + 4100);
                        const float sgn = (fq & 2) ? 1.f : -1.f;
#pragma unroll
                        for (int q = 0; q < 4; ++q) { const float p0 = __shfl_xor(v0[q], 32), p1 = __shfl_xor(v1[q], 32);
                            v0[q] = v0[q] * c0[q] + sgn * p0 * s0[q]; v1[q] = v1[q] * c1[q] + sgn * p1 * s1[q]; } }
                    u32x4 w; w.x = cvt_pk_bf16(v0[0], v0[1]); w.y = cvt_pk_bf16(v0[2], v0[3]); w.z = cvt_pk_bf16(v1[0], v1[1]); w.w = cvt_pk_bf16(v1[2], v1[3]);
                    *(u32x4*)(rowp + bj * HALF) = w; } }
    }
};
struct EpiGlu {
    static constexpr bool PERM = true, AFTER_DRAIN = false, MIDHOOK = false;
    const bf16_t* A; const float* bias; bf16_t* O;
    __device__ __forceinline__ void operator()(const f32x4 (&acc)[2][2][4][2], const Unit& u, int wr, int wc, int fr, int fq) const {
        const int row0 = u.pm * BM + wr * 64 + fr, col0 = u.pn * BM + wc * 32 + 8 * fq;
#pragma unroll
        for (int ai = 0; ai < 2; ++ai)
#pragma unroll
            for (int m = 0; m < 4; ++m) { const size_t ro = (size_t)(row0 + ai * HALF + m * 16) * 512 + col0;
#pragma unroll
                for (int bj = 0; bj < 2; ++bj) { const f32x4 v0 = acc[ai][bj][m][0], v1 = acc[ai][bj][m][1];
                    const u32x4 a = *(const u32x4*)(A + ro + bj * HALF);
                    const f32x4 b0 = *(const f32x4*)(bias + col0 + bj * HALF), b1 = *(const f32x4*)(bias + col0 + bj * HALF + 4);
                    float o[8];
                    o[0] = bflo(a.x) * sigmoid_f(v0[0] + b0[0]); o[1] = bfhi(a.x) * sigmoid_f(v0[1] + b0[1]);
                    o[2] = bflo(a.y) * sigmoid_f(v0[2] + b0[2]); o[3] = bfhi(a.y) * sigmoid_f(v0[3] + b0[3]);
                    o[4] = bflo(a.z) * sigmoid_f(v1[0] + b1[0]); o[5] = bfhi(a.z) * sigmoid_f(v1[1] + b1[1]);
                    o[6] = bflo(a.w) * sigmoid_f(v1[2] + b1[2]); o[7] = bfhi(a.w) * sigmoid_f(v1[3] + b1[3]);
                    u32x4 w; w.x = cvt_pk_bf16(o[0], o[1]); w.y = cvt_pk_bf16(o[2], o[3]); w.z = cvt_pk_bf16(o[4], o[5]); w.w = cvt_pk_bf16(o[6], o[7]);
                    *(u32x4*)(O + (size_t)(row0 + ai * HALF + m * 16) * 1536 + col0 + bj * HALF) = w; } }
    }
};
struct RowOffOrder {
    StaticOrder b; int off;
    __device__ __forceinline__ void init(int M, int N, int G, int c, int off_) { b.init(M, N, G, c); off = off_; }
    __device__ __forceinline__ bool next(int i, Unit& u) const { if (!b.next(i, u)) return false; u.pm += off; return true; }
    __device__ __forceinline__ void a_ready(const Unit&) const {}
    __device__ __forceinline__ void done(const Unit&) const {}
};
struct EpiMerge {
    static constexpr bool PERM = true, AFTER_DRAIN = false, MIDHOOK = true;
    const bf16_t* proj; bf16_t* MB;
    __device__ __forceinline__ void mid(f32x4 (&acc)[2][2][4][2], const Unit& u, int seg, int wr, int wc, int fr, int fq) const {
        const unsigned base = (unsigned)((u.pm * BM + wr * 64 + fr) * PJ + GT0 + (seg - 1) * 1024 + u.pn * BM + wc * 32 + 8 * fq) * 2u;
        const char* pb = (const char*)proj;
#pragma unroll
        for (int ai = 0; ai < 2; ++ai)
#pragma unroll
            for (int m = 0; m < 4; ++m) {
                u32x4 ga[2], gb[2];
#pragma unroll
                for (int bj = 0; bj < 2; ++bj) { const unsigned o = base + (unsigned)(((ai * HALF + m * 16) * PJ + bj * HALF) * 2);
                    ga[bj] = *(const u32x4*)(pb + o); gb[bj] = *(const u32x4*)(pb + o + 2048u); }
#pragma unroll
                for (int bj = 0; bj < 2; ++bj) { const u32x4 a = ga[bj], b = gb[bj];
                    f32x4& v0 = acc[ai][bj][m][0]; f32x4& v1 = acc[ai][bj][m][1];
                    v0[0] *= bflo(a.x) * __builtin_amdgcn_rcpf(bflo(b.x)); v0[1] *= bfhi(a.x) * __builtin_amdgcn_rcpf(bfhi(b.x));
                    v0[2] *= bflo(a.y) * __builtin_amdgcn_rcpf(bflo(b.y)); v0[3] *= bfhi(a.y) * __builtin_amdgcn_rcpf(bfhi(b.y));
                    v1[0] *= bflo(a.z) * __builtin_amdgcn_rcpf(bflo(b.z)); v1[1] *= bfhi(a.z) * __builtin_amdgcn_rcpf(bfhi(b.z));
                    v1[2] *= bflo(a.w) * __builtin_amdgcn_rcpf(bflo(b.w)); v1[3] *= bfhi(a.w) * __builtin_amdgcn_rcpf(bfhi(b.w)); }
                if (m & 1) asm volatile("" ::: "memory");
            }
    }
    __device__ __forceinline__ void operator()(const f32x4 (&acc)[2][2][4][2], const Unit& u, int wr, int wc, int fr, int fq) const {
        const int row0 = u.pm * BM + wr * 64 + fr, col0 = u.pn * BM + wc * 32 + 8 * fq;
#pragma unroll
        for (int ai = 0; ai < 2; ++ai)
#pragma unroll
            for (int m = 0; m < 4; ++m) { const int row = row0 + ai * HALF + m * 16;
#pragma unroll
                for (int bj = 0; bj < 2; ++bj) { const f32x4 v0 = acc[ai][bj][m][0], v1 = acc[ai][bj][m][1]; const int col = col0 + bj * HALF;
                    const u32x4 g = *(const u32x4*)(proj + (size_t)row * PJ + GT0 + 2048 + col);
                    u32x4 w; w.x = cvt_pk_bf16(bflo(g.x) * v0[0], bfhi(g.x) * v0[1]); w.y = cvt_pk_bf16(bflo(g.y) * v0[2], bfhi(g.y) * v0[3]);
                    w.z = cvt_pk_bf16(bflo(g.z) * v1[0], bfhi(g.z) * v1[1]); w.w = cvt_pk_bf16(bflo(g.w) * v1[2], bfhi(g.w) * v1[3]);
                    *(u32x4*)(MB + (size_t)row * 1024 + col) = w; } }
    }
};
struct EpiResid {
    static constexpr bool PERM = false, AFTER_DRAIN = false, MIDHOOK = false;
    float* XL; float* XC; const float* g_lat; const float* g_ctx;
    __device__ __forceinline__ void operator()(const f32x4 (&acc)[2][2][4][2], const Unit& u, int wr, int wc, int fr, int fq) const {
        const bool isc = (u.pm == 0);
        float* base = isc ? XC : (XL - (size_t)NCTX * D); const float* gv = isc ? g_ctx : g_lat;
        const int row0 = u.pm * BM + wr * 64 + fr, col0 = u.pn * BM + wc * 32 + 4 * fq;
#pragma unroll
        for (int ai = 0; ai < 2; ++ai)
#pragma unroll
            for (int m = 0; m < 4; ++m) { float* rowp = base + (size_t)(row0 + ai * HALF + m * 16) * D + col0;
#pragma unroll
                for (int bj = 0; bj < 2; ++bj)
#pragma unroll
                    for (int n = 0; n < 2; ++n) { float* pp = rowp + bj * HALF + n * 16; const f32x4 g = *(const f32x4*)(gv + col0 + bj * HALF + n * 16);
                        f32x4 x = *(const f32x4*)pp; x += g * acc[ai][bj][m][n]; *(f32x4*)pp = x; } }
    }
};
struct ExpertOrder {
    int G, c, nnt, nmt;
    __device__ __forceinline__ bool next(int i, Unit& u) const { const int L = i * G + c; if (L >= NE * nmt * nnt) return false; const int e = L / (nmt * nnt), rem = L % (nmt * nnt); u.pm = e * 9 + rem % nmt; u.pn = e * nnt + rem / nmt; return true; }
    __device__ __forceinline__ void a_ready(const Unit&) const {}
    __device__ __forceinline__ void done(const Unit&) const {}
};
struct EpiSwiGlu {
    static constexpr bool PERM = true, AFTER_DRAIN = false, MIDHOOK = false;
    bf16_t* HID;
    __device__ __forceinline__ void operator()(const f32x4 (&acc)[2][2][4][2], const Unit& u, int wr, int wc, int fr, int fq) const {
        const int row0 = u.pm * BM + wr * 64 + fr, col0 = (u.pn & 7) * 128 + wc * 32 + 8 * fq;
#pragma unroll
        for (int ai = 0; ai < 2; ++ai)
#pragma unroll
            for (int m = 0; m < 4; ++m) { const f32x4 g0 = acc[ai][0][m][0], g1 = acc[ai][0][m][1], u0 = acc[ai][1][m][0], u1 = acc[ai][1][m][1];
                u32x4 w;
                w.x = cvt_pk_bf16(silu_f(g0[0]) * u0[0], silu_f(g0[1]) * u0[1]); w.y = cvt_pk_bf16(silu_f(g0[2]) * u0[2], silu_f(g0[3]) * u0[3]);
                w.z = cvt_pk_bf16(silu_f(g1[0]) * u1[0], silu_f(g1[1]) * u1[1]); w.w = cvt_pk_bf16(silu_f(g1[2]) * u1[2], silu_f(g1[3]) * u1[3]);
                *(u32x4*)(HID + (size_t)(row0 + ai * HALF + m * 16) * 1024 + col0) = w; }
    }
};
struct EpiDown {
    static constexpr bool PERM = true, AFTER_DRAIN = false, MIDHOOK = false;
    bf16_t* YE; const float* gsel;
    __device__ __forceinline__ void operator()(const f32x4 (&acc)[2][2][4][2], const Unit& u, int wr, int wc, int fr, int fq) const {
        const int row0 = u.pm * BM + wr * 64 + fr, col0 = (u.pn & 3) * BM + wc * 32 + 8 * fq;
#pragma unroll
        for (int ai = 0; ai < 2; ++ai)
#pragma unroll
            for (int m = 0; m < 4; ++m) { const int row = row0 + ai * HALF + m * 16; const float gs = gsel[row];
#pragma unroll
                for (int bj = 0; bj < 2; ++bj) { const f32x4 v0 = acc[ai][bj][m][0] * gs, v1 = acc[ai][bj][m][1] * gs;
                    u32x4 w; w.x = cvt_pk_bf16(v0[0], v0[1]); w.y = cvt_pk_bf16(v0[2], v0[3]); w.z = cvt_pk_bf16(v1[0], v1[1]); w.w = cvt_pk_bf16(v1[2], v1[3]);
                    *(u32x4*)(YE + (size_t)row * 1024 + col0 + bj * HALF) = w; } }
    }
};
}
#define XB_TMO      128
#define XB_XCNT(j)  (256  + 64 * (j))
#define XB_XSUB(j)  (1280 + 64 * (j))
#define XB_XGEN(j)  (2304 + 64 * (j))
#define XB_TOP      3328
#define XB_TOPGEN   3392
#define XCD_BAR_WORDS 3456
#define XB_SPIN_CAP (1u << 18)
#define LAS __attribute__((address_space(3)))

__device__ __forceinline__ unsigned xb_ld(unsigned* p)              { return __hip_atomic_load(p, __ATOMIC_RELAXED, __HIP_MEMORY_SCOPE_AGENT); }
__device__ __forceinline__ unsigned xb_add(unsigned* p, unsigned v) { return __hip_atomic_fetch_add(p, v, __ATOMIC_RELAXED, __HIP_MEMORY_SCOPE_AGENT); }
__device__ __forceinline__ unsigned xb_xcc_id() { return (unsigned)__builtin_amdgcn_s_getreg((3 << 11) | 20) & 0xFu; }
#define XB_SPIN(cond, bar) do { unsigned _sp = 0; while (cond) { __builtin_amdgcn_s_sleep(1); \
    if ((++_sp & 255u) == 0u) { if (xb_ld(&(bar)[XB_TMO])) break; if (_sp > XB_SPIN_CAP) { atomicAdd(&(bar)[XB_TMO], 1u); break; } } } } while (0)

struct XcdBarrier {
    unsigned* bar; unsigned x;
    volatile LAS unsigned* st;
};

__device__ __forceinline__ XcdBarrier xcd_barrier_post(unsigned* bar, volatile LAS unsigned* st) {
    XcdBarrier b; b.bar = bar; b.x = xb_xcc_id(); b.st = st;
    if (threadIdx.x == 0) (void)xb_add(&bar[XB_XCNT(b.x)], 1u);
    return b;
}
__device__ __forceinline__ void xcd_barrier_complete(unsigned* bar, unsigned x, unsigned& nloc, unsigned& nx) {
    const unsigned G = gridDim.x * gridDim.y * gridDim.z;
    unsigned sum, cnt, mine, sp = 0u;
    for (;;) {
        sum = 0u; cnt = 0u; mine = 0u;
#pragma unroll
        for (unsigned j = 0; j < 16; ++j) { const unsigned c = xb_ld(&bar[XB_XCNT(j)]); sum += c; cnt += (c > 0u) ? 1u : 0u; mine = (j == x) ? c : mine; }
        if (sum == G) break;
        __builtin_amdgcn_s_sleep(1);
        if ((++sp & 255u) == 0u) { if (xb_ld(&bar[XB_TMO])) break; if (sp > XB_SPIN_CAP) { atomicAdd(&bar[XB_TMO], 1u); break; } }
    }
    nloc = mine > 0u ? mine : 1u; nx = cnt > 0u ? cnt : 1u;
}

__device__ __forceinline__ void xcd_barrier(const XcdBarrier& b) {
    asm volatile("s_waitcnt vmcnt(0)" ::: "memory");
    __syncthreads();
    if (threadIdx.x == 0) {
        unsigned* bar = b.bar;
        __builtin_amdgcn_s_waitcnt(0);
        unsigned nloc = b.st[0], nx = b.st[1];
        if (nloc == 0u) { xcd_barrier_complete(bar, b.x, nloc, nx); b.st[0] = nloc; b.st[1] = nx; }
        const unsigned old = xb_add(&bar[XB_XSUB(b.x)], 1u);
        const unsigned gen = old / nloc;
        if (old + 1u == (gen + 1u) * nloc) {
            __builtin_amdgcn_fence(__ATOMIC_RELEASE, "agent");
            asm volatile("s_waitcnt vmcnt(0)" ::: "memory");
            const unsigned og = xb_add(&bar[XB_TOP], 1u);
            const unsigned tg = og / nx;
            if (og + 1u == (tg + 1u) * nx) xb_add(&bar[XB_TOPGEN], 1u);
            else XB_SPIN(xb_ld(&bar[XB_TOPGEN]) == tg, bar);
            __builtin_amdgcn_fence(__ATOMIC_ACQUIRE, "agent");
            xb_add(&bar[XB_XGEN(b.x)], 1u);
            asm volatile("s_waitcnt vmcnt(0)" ::: "memory");
        } else {
            XB_SPIN(xb_ld(&bar[XB_XGEN(b.x)]) == gen, bar);
            __builtin_amdgcn_fence(__ATOMIC_ACQUIRE, "agent");
            asm volatile("s_waitcnt vmcnt(0)" ::: "memory");
        }
    }
    __syncthreads();
}


struct P {
    const float *x, *c, *ctx, *c_ctx, *w_mod, *b_mod, *norm1_g, *norm2_g, *w_in, *lam_re, *lam_im, *log_dt, *b_re, *b_im, *c_re, *c_im, *s5_d, *w_glu, *b_glu,
        *conv_w, *conv_b, *a_log, *dt_bias, *ssd_d, *ssd_norm_g, *sink, *w_branch, *w_out, *w_router, *w_eg, *w_eu, *w_ed, *final_g;
    float* XL;
    float *MOD, *XC, *DT, *S5E, *S5H, *YD, *PM, *AFFT, *GSEL;
    bf16 *WIN, *WGLU, *WBR, *WOUT, *WUP, *WDN, *H, *PROJ, *XE, *HID, *CV, *SA, *Y3, *MB, *YE;
    int *IDX, *INV;
    int tid, lane, wave, bid, G;
};


constexpr int PTAB_OFF = LDS_BYTES - 1024;
__device__ __forceinline__ unsigned long long ld_tab(volatile LAS unsigned* t, int k) {
    const unsigned lo = __builtin_amdgcn_readfirstlane(t[2 * k]), hi = __builtin_amdgcn_readfirstlane(t[2 * k + 1]);
    return ((unsigned long long)hi << 32) | lo;
}
__device__ __forceinline__ void build_P(P& p, LAS unsigned char* lds, int wset = 0) {
    int tid_l = threadIdx.x, bid_l = blockIdx.x, g_l = gridDim.x;
    asm volatile("" : "+v"(tid_l), "+s"(bid_l), "+s"(g_l));
    p.tid = tid_l; p.lane = p.tid & 63; p.wave = __builtin_amdgcn_readfirstlane(p.tid >> 6); p.bid = bid_l; p.G = g_l;
    unsigned tbase = (unsigned)(size_t)(lds + PTAB_OFF); asm volatile("" : "+v"(tbase));
    volatile LAS unsigned* tb = (volatile LAS unsigned*)(size_t)tbase;
#define INP(k) ((const float*)ld_tab(tb, k))
    p.x = INP(0); p.c = INP(1); p.ctx = INP(2); p.c_ctx = INP(3); p.w_mod = INP(4); p.b_mod = INP(5); p.norm1_g = INP(6); p.norm2_g = INP(7);
    p.w_in = INP(8); p.lam_re = INP(9); p.lam_im = INP(10); p.log_dt = INP(11); p.b_re = INP(12); p.b_im = INP(13); p.c_re = INP(14); p.c_im = INP(15);
    p.s5_d = INP(16); p.w_glu = INP(17); p.b_glu = INP(18); p.conv_w = INP(19); p.conv_b = INP(20); p.a_log = INP(21); p.dt_bias = INP(22); p.ssd_d = INP(23);
    p.ssd_norm_g = INP(24); p.sink = INP(25); p.w_branch = INP(26); p.w_out = INP(27); p.w_router = INP(28); p.w_eg = INP(29); p.w_eu = INP(30); p.w_ed = INP(31);
    p.final_g = INP(32);
#undef INP
    p.XL = (float*)ld_tab(tb, 33);
    unsigned char* ws = (unsigned char*)ld_tab(tb, 34);
    p.MOD = (float*)(ws + WS_MOD); p.XC = (float*)(ws + WS_XC); p.DT = (float*)(ws + WS_DT); p.S5E = (float*)(ws + WS_S5E); p.S5H = (float*)(ws + WS_S5H); p.YD = (float*)(ws + WS_YD);
    p.PM = (float*)(ws + WS_PM); p.AFFT = (float*)(ws + WS_AFFT); p.GSEL = (float*)(ws + WS_GSEL);
    { unsigned char* wb = ws + (wset ? (WS_W2 - WS_WIN) : 0);
      p.WIN = (bf16*)(wb + WS_WIN); p.WGLU = (bf16*)(wb + WS_WGLU); p.WBR = (bf16*)(wb + WS_WBR); p.WOUT = (bf16*)(wb + WS_WOUT); p.WUP = (bf16*)(wb + WS_WUP); p.WDN = (bf16*)(wb + WS_WDN); }
    p.H = (bf16*)(ws + WS_H); p.PROJ = (bf16*)(ws + WS_PROJ); p.XE = (bf16*)(ws + WS_XE); p.HID = (bf16*)(ws + WS_HID); p.CV = (bf16*)(ws + WS_CV); p.SA = (bf16*)(ws + WS_SA);
    p.Y3 = (bf16*)(ws + WS_Y3); p.MB = (bf16*)(ws + WS_MB); p.YE = (bf16*)(ws + WS_YE);
    p.IDX = (int*)(ws + WS_IDX); p.INV = (int*)(ws + WS_INV);
}
__device__ __forceinline__ void phase_mod(const P& p, LAS unsigned char* lds, float* ropet) {
    for (int i = p.bid * NTHR + p.tid; i < 256 * 16; i += p.G * NTHR) { const float inv = exp2f(-(float)(i & 15) * 0.83048202372184058696f);
        float sn, cs; sincosf((float)(i >> 4) * inv, &sn, &cs); ropet[i] = cs; ropet[4096 + i] = sn; }
    LAS float* sc = (LAS float*)lds;
    LAS float* part = sc + 2048;
    for (int i = p.tid; i < 1024; i += NTHR) { sc[i] = silu_f(p.c[i]); sc[1024 + i] = silu_f(p.c_ctx[i]); }
    __syncthreads();
    for (int it = p.bid; it < DEPTH * 48; it += p.G) {
        const int l = it / 48, cb = it % 48, c0 = cb * 128 + 2 * p.lane;
        const float* W = p.w_mod + (size_t)l * 1024 * 6144 + c0;
        float a00 = 0.f, a01 = 0.f, a10 = 0.f, a11 = 0.f;
        const int kb = p.wave * 128;
#pragma unroll 8
        for (int k = kb; k < kb + 128; ++k) { const float2 w = *(const float2*)(W + (size_t)k * 6144); const float s0 = sc[k], s1 = sc[1024 + k];
            a00 += s0 * w.x; a01 += s0 * w.y; a10 += s1 * w.x; a11 += s1 * w.y; }
        part[(p.wave * 2 + 0) * 128 + 2 * p.lane] = a00; part[(p.wave * 2 + 0) * 128 + 2 * p.lane + 1] = a01;
        part[(p.wave * 2 + 1) * 128 + 2 * p.lane] = a10; part[(p.wave * 2 + 1) * 128 + 2 * p.lane + 1] = a11;
        __syncthreads();
        if (p.tid < 256) { const int s = p.tid >> 7, col = p.tid & 127; float r = p.b_mod[l * 6144 + cb * 128 + col];
#pragma unroll
            for (int w = 0; w < 8; ++w) r += part[(w * 2 + s) * 128 + col];
            p.MOD[(size_t)(l * 2 + s) * 6144 + cb * 128 + col] = r; }
        __syncthreads();
    }
}

__device__ __forceinline__ void tr_item(const float* src, int ldw, int K, bf16* dst, int kb, LAS float* scr, int lane) {
    const int k0 = 64 * kb, kr = lane >> 4, nq = lane & 15;
    f32x4 v[16];
#pragma unroll
    for (int i = 0; i < 16; ++i) v[i] = *(const f32x4*)(src + (size_t)(k0 + 4 * i + kr) * ldw + 4 * nq);
#pragma unroll
    for (int i = 0; i < 16; ++i) { const int k = 4 * i + kr, c = (k >> 3) & 7; *(LAS f32x4*)(scr + k * 64 + 4 * (nq ^ c)) = v[i]; }
    LDS_FENCE();
    const int c = lane & 7;
#pragma unroll
    for (int j = 0; j < 8; ++j) { const int n = (lane >> 3) + 8 * j; const LAS float* s = scr + (8 * c) * 64 + (n ^ (c << 2));
        u32x4 o; o.x = pk2(s[0 * 64], s[1 * 64]); o.y = pk2(s[2 * 64], s[3 * 64]); o.z = pk2(s[4 * 64], s[5 * 64]); o.w = pk2(s[6 * 64], s[7 * 64]);
        *(u32x4*)(dst + (size_t)n * K + k0 + 8 * c) = o; }
    LDS_FENCE();
}
__device__ __forceinline__ void convert_weights(const P& p, int l, LAS unsigned char* lds, int gw, int NGW) {
    LAS float* scr = (LAS float*)(lds + p.wave * 16384);
    constexpr int I_A = 32 * 16, I_B = 60 * 16, I_GLU = 8 * 8, I_BR = 3 * 16 * 8, I_OUT = 16 * 16, I_E = 16 * 16 * 16;
    constexpr int NIT = I_A + I_B + I_GLU + I_BR + I_OUT + 3 * I_E;
    const float* win = p.w_in + (size_t)l * 1024 * IN_W;
    for (int it = gw; it < NIT; it += NGW) {
        int r = it;
        if (r < I_A) { const int nb = r >> 4, kb = r & 15; tr_item(win + 64 * nb, IN_W, 1024, p.WIN + (size_t)(64 * nb) * 1024, kb, scr, p.lane); continue; } r -= I_A;
        if (r < I_B) { const int nb = r >> 4, kb = r & 15; tr_item(win + 2064 + 64 * nb, IN_W, 1024, p.WIN + (size_t)(2048 + 64 * nb) * 1024, kb, scr, p.lane); continue; } r -= I_B;
        if (r < I_GLU) { const int nb = r >> 3, kb = r & 7; tr_item(p.w_glu + (size_t)l * 512 * 512 + 64 * nb, 512, 512, p.WGLU + (size_t)(64 * nb) * 512, kb, scr, p.lane); continue; } r -= I_GLU;
        if (r < I_BR) { const int kk = r >> 7, nb = (r >> 3) & 15, kb = r & 7;
            tr_item(p.w_branch + ((size_t)l * 3 + kk) * 512 * 1024 + 64 * nb, 1024, 1536, p.WBR + (size_t)(64 * nb) * 1536 + kk * 512, kb, scr, p.lane); continue; } r -= I_BR;
        if (r < I_OUT) { const int nb = r >> 4, kb = r & 15; tr_item(p.w_out + (size_t)l * 1024 * 1024 + 64 * nb, 1024, 1024, p.WOUT + (size_t)(64 * nb) * 1024, kb, scr, p.lane); continue; } r -= I_OUT;
        const int which = r / I_E; r -= which * I_E;
        const int e = r >> 8, nb = (r >> 4) & 15, kb = r & 15;
        const size_t eo = ((size_t)l * NE + e) * 1024 * 1024;
        if (which == 0) tr_item(p.w_eg + eo + 64 * nb, 1024, 1024, p.WUP + (size_t)(e * 2048 + 256 * (nb >> 1) + 64 * (nb & 1)) * 1024, kb, scr, p.lane);
        else if (which == 1) tr_item(p.w_eu + eo + 64 * nb, 1024, 1024, p.WUP + (size_t)(e * 2048 + 256 * (nb >> 1) + 128 + 64 * (nb & 1)) * 1024, kb, scr, p.lane);
        else tr_item(p.w_ed + eo + 64 * nb, 1024, 1024, p.WDN + (size_t)(e * 1024 + 64 * nb) * 1024, kb, scr, p.lane);
    }
}

__device__ __forceinline__ float reduce16(float (&a)[16], int lane) {
    float b[8], c[4], d[2];
#pragma unroll
    for (int j = 0; j < 8; ++j) { const bool hi = lane & 32; const float send = hi ? a[j] : a[j + 8], keep = hi ? a[j + 8] : a[j]; b[j] = keep + __shfl_xor(send, 32); }
#pragma unroll
    for (int j = 0; j < 4; ++j) { const bool hi = lane & 16; const float send = hi ? b[j] : b[j + 4], keep = hi ? b[j + 4] : b[j]; c[j] = keep + __shfl_xor(send, 16); }
#pragma unroll
    for (int j = 0; j < 2; ++j) { const bool hi = lane & 8; const float send = hi ? c[j] : c[j + 2], keep = hi ? c[j + 2] : c[j]; d[j] = keep + __shfl_xor(send, 8); }
    const bool hi = lane & 4; const float send = hi ? d[0] : d[1], keep = hi ? d[1] : d[0];
    float r = keep + __shfl_xor(send, 4);
    r += __shfl_xor(r, 2); r += __shfl_xor(r, 1);
    return r;
}
template <int MODE> __device__ __forceinline__ void row_pass(const P& p, int l, LAS unsigned char* lds, bool with_ctx = true) {
    LAS float* W16 = (LAS float*)lds;
    if (MODE != 2) {
        const float* src = (MODE == 0) ? (p.w_in + (size_t)l * 1024 * IN_W + 2048) : (p.w_router + (size_t)l * 1024 * 16);
        const int ld = (MODE == 0) ? IN_W : 16;
        for (int i = p.tid; i < 1024 * 16; i += NTHR) { const int k = i >> 4, j = i & 15; const int rr = (k & 7) * 128 + ((k >> 3) & 63) + 64 * (k >> 9); W16[rr * 20 + j] = src[(size_t)k * ld + j]; }
        __syncthreads();
    }
    const int gw = p.bid * NWAVES + p.wave, NGW = p.G * NWAVES, lane = p.lane;
    for (int row = gw + ((MODE == 2 || !with_ctx) ? NCTX : 0); row < T; row += NGW) {
        const bool isc = row < NCTX;
        float* xrow = isc ? (p.XC + (size_t)row * D) : (p.XL + (size_t)(row - NCTX) * D);
        float v[16];
        { const float* s = (MODE == 0 && l == 0) ? (isc ? (p.ctx + (size_t)row * D) : (p.x + (size_t)(row - NCTX) * D)) : xrow;
#pragma unroll
          for (int i = 0; i < 2; ++i) { const f32x4 a = *(const f32x4*)(s + 512 * i + 8 * lane), b = *(const f32x4*)(s + 512 * i + 8 * lane + 4);
              v[8 * i] = a[0]; v[8 * i + 1] = a[1]; v[8 * i + 2] = a[2]; v[8 * i + 3] = a[3]; v[8 * i + 4] = b[0]; v[8 * i + 5] = b[1]; v[8 * i + 6] = b[2]; v[8 * i + 7] = b[3]; } }
        if ((MODE == 0 && l > 0) || MODE == 2) {
            const int lp = (MODE == 2) ? (DEPTH - 1) : (l - 1);
            const float* g2 = p.MOD + (size_t)(lp * 2 + (isc ? 1 : 0)) * 6144 + 5 * D;
            float s[16];
#pragma unroll
            for (int i = 0; i < 16; ++i) s[i] = 0.f;
            for (int e = 0; e < NE; ++e) { const int slot = p.INV[(size_t)row * 16 + e];
                if (slot >= 0) { const bf16* yr = p.YE + ((size_t)e * ESLOTS + slot) * D;
#pragma unroll
                    for (int i = 0; i < 2; ++i) { const u32x4 w = *(const u32x4*)(yr + 512 * i + 8 * lane);
                        s[8 * i] += bflo(w.x); s[8 * i + 1] += bfhi(w.x); s[8 * i + 2] += bflo(w.y); s[8 * i + 3] += bfhi(w.y);
                        s[8 * i + 4] += bflo(w.z); s[8 * i + 5] += bfhi(w.z); s[8 * i + 6] += bflo(w.w); s[8 * i + 7] += bfhi(w.w); } } }
#pragma unroll
            for (int i = 0; i < 2; ++i) { const f32x4 a = *(const f32x4*)(g2 + 512 * i + 8 * lane), b = *(const f32x4*)(g2 + 512 * i + 8 * lane + 4);
#pragma unroll
                for (int q = 0; q < 4; ++q) { v[8 * i + q] += a[q] * s[8 * i + q]; v[8 * i + 4 + q] += b[q] * s[8 * i + 4 + q]; } }
        }
        if (MODE == 0) {
#pragma unroll
            for (int i = 0; i < 2; ++i) { *(f32x4*)(xrow + 512 * i + 8 * lane) = (f32x4){v[8 * i], v[8 * i + 1], v[8 * i + 2], v[8 * i + 3]};
                *(f32x4*)(xrow + 512 * i + 8 * lane + 4) = (f32x4){v[8 * i + 4], v[8 * i + 5], v[8 * i + 6], v[8 * i + 7]}; }
        }
        float ss = 0.f;
#pragma unroll
        for (int i = 0; i < 16; ++i) ss += v[i] * v[i];
        const float rstd = rsqrtf(wsum(ss) * (1.f / D) + EPS);
        if (MODE == 2) {
#pragma unroll
            for (int i = 0; i < 2; ++i) { const f32x4 a = *(const f32x4*)(p.final_g + 512 * i + 8 * lane), b = *(const f32x4*)(p.final_g + 512 * i + 8 * lane + 4);
                *(f32x4*)(xrow + 512 * i + 8 * lane) = (f32x4){v[8 * i] * rstd * a[0], v[8 * i + 1] * rstd * a[1], v[8 * i + 2] * rstd * a[2], v[8 * i + 3] * rstd * a[3]};
                *(f32x4*)(xrow + 512 * i + 8 * lane + 4) = (f32x4){v[8 * i + 4] * rstd * b[0], v[8 * i + 5] * rstd * b[1], v[8 * i + 6] * rstd * b[2], v[8 * i + 7] * rstd * b[3]}; }
            continue;
        }
        const float* gam = (MODE == 0 ? p.norm1_g : p.norm2_g) + (size_t)l * D;
        const float* md = p.MOD + (size_t)(l * 2 + (isc ? 1 : 0)) * 6144 + (MODE == 0 ? 0 : 3 * D);
        bf16* hrow = p.H + (size_t)row * D;
        float acc[16];
#pragma unroll
        for (int j = 0; j < 16; ++j) acc[j] = 0.f;
#pragma unroll
        for (int i = 0; i < 2; ++i) {
            float hv[8];
            { const int k0 = 512 * i + 8 * lane;
              const f32x4 ga = *(const f32x4*)(gam + k0), gb = *(const f32x4*)(gam + k0 + 4), sa = *(const f32x4*)(md + D + k0), sb = *(const f32x4*)(md + D + k0 + 4), ha = *(const f32x4*)(md + k0), hb = *(const f32x4*)(md + k0 + 4);
#pragma unroll
              for (int q = 0; q < 4; ++q) { hv[q] = v[8 * i + q] * rstd * ga[q] * (1.f + sa[q]) + ha[q]; hv[4 + q] = v[8 * i + 4 + q] * rstd * gb[q] * (1.f + sb[q]) + hb[q]; }
              u32x4 o; o.x = pk2(hv[0], hv[1]); o.y = pk2(hv[2], hv[3]); o.z = pk2(hv[4], hv[5]); o.w = pk2(hv[6], hv[7]);
              *(u32x4*)(hrow + k0) = o; }
#pragma unroll
            for (int j = 0; j < 8; ++j) { const LAS f32x4* wr = (const LAS f32x4*)(W16 + (j * 128 + lane + 64 * i) * 20);
                const f32x4 w0 = wr[0], w1 = wr[1], w2 = wr[2], w3 = wr[3]; const float h = hv[j];
                acc[0] += h * w0[0]; acc[1] += h * w0[1]; acc[2] += h * w0[2]; acc[3] += h * w0[3];
                acc[4] += h * w1[0]; acc[5] += h * w1[1]; acc[6] += h * w1[2]; acc[7] += h * w1[3];
                acc[8] += h * w2[0]; acc[9] += h * w2[1]; acc[10] += h * w2[2]; acc[11] += h * w2[3];
                acc[12] += h * w3[0]; acc[13] += h * w3[1]; acc[14] += h * w3[2]; acc[15] += h * w3[3];
                if (j & 1) asm volatile("" ::: "memory"); }
        }
        const float tot = reduce16(acc, lane);
        const int col = ((lane >> 5) & 1) * 8 + ((lane >> 4) & 1) * 4 + ((lane >> 3) & 1) * 2 + ((lane >> 2) & 1);
        if (MODE == 0) {
            if ((lane & 3) == 0) p.DT[(size_t)row * 16 + col] = softplus_f(tot + p.dt_bias[l * 16 + col]);
        } else {
            float mx = tot;
            mx = fmaxf(mx, __shfl_xor(mx, 4)); mx = fmaxf(mx, __shfl_xor(mx, 8)); mx = fmaxf(mx, __shfl_xor(mx, 16)); mx = fmaxf(mx, __shfl_xor(mx, 32));
            const float e = expf(tot - mx); float sum = e;
            sum += __shfl_xor(sum, 4); sum += __shfl_xor(sum, 8); sum += __shfl_xor(sum, 16); sum += __shfl_xor(sum, 32);
            if ((lane & 3) == 0) p.AFFT[(size_t)col * T + row] = e / sum;
        }
    }
}

struct S5Lane { float abr, abi; float bbr[16], bbi[16]; };
__device__ __forceinline__ void s5_lane_params(const P& p, int l, int d, int g, int lane, S5Lane& o, bool withB) {
    const size_t gi = ((size_t)(l * 2 + d) * 32 + g);
    const float lr = p.lam_re[gi * 64 + lane], li = p.lam_im[gi * 64 + lane], dt = expf(p.log_dt[gi]);
    const float mag = expf(lr * dt); float sn, cs; sincosf(li * dt, &sn, &cs);
    o.abr = mag * cs; o.abi = mag * sn;
    if (withB) {
        const float den = lr * lr + li * li;
        const float fr = ((o.abr - 1.f) * lr + o.abi * li) / den, fi = (o.abi * lr - (o.abr - 1.f) * li) / den;
        const f32x4* br = (const f32x4*)(p.b_re + (gi * 64 + lane) * 16); const f32x4* bi = (const f32x4*)(p.b_im + (gi * 64 + lane) * 16);
#pragma unroll
        for (int q = 0; q < 4; ++q) { const f32x4 r4 = br[q], i4 = bi[q];
#pragma unroll
            for (int j = 0; j < 4; ++j) { o.bbr[4 * q + j] = fr * r4[j] - fi * i4[j]; o.bbi[4 * q + j] = fr * i4[j] + fi * r4[j]; } }
    }
}
__device__ __forceinline__ void s5_stage_u(const P& p, int r0, int g, LAS unsigned char* ub, int lane) {
#pragma unroll
    for (int j = 0; j < 4; ++j) { const int q = lane + 64 * j, i = q >> 1, half = q & 1;
        const u32x4 w = *(const u32x4*)(p.PROJ + (size_t)(r0 + i) * PJ + U0 + g * 16 + half * 8);
        *(LAS u32x4*)(ub + i * 32 + half * 16) = w; }
    LDS_FENCE();
}
__device__ __forceinline__ void s5_step(const S5Lane& s, const LAS unsigned char* ub, int i, float& hr, float& hi) {
    const u32x4 a = *(const LAS u32x4*)(ub + i * 32), b = *(const LAS u32x4*)(ub + i * 32 + 16);
    float u[16];
    u[0] = bflo(a.x); u[1] = bfhi(a.x); u[2] = bflo(a.y); u[3] = bfhi(a.y); u[4] = bflo(a.z); u[5] = bfhi(a.z); u[6] = bflo(a.w); u[7] = bfhi(a.w);
    u[8] = bflo(b.x); u[9] = bfhi(b.x); u[10] = bflo(b.y); u[11] = bfhi(b.y); u[12] = bflo(b.z); u[13] = bfhi(b.z); u[14] = bflo(b.w); u[15] = bfhi(b.w);
    float br = 0.f, bi = 0.f;
#pragma unroll
    for (int k = 0; k < 16; ++k) { br += s.bbr[k] * u[k]; bi += s.bbi[k] * u[k]; }
    const float nr = s.abr * hr - s.abi * hi + br, ni = s.abr * hi + s.abi * hr + bi;
    hr = nr; hi = ni;
}

__device__ __forceinline__ void phase_premix(const P& p, int l, LAS unsigned char* lds) {
    const float* cw = p.conv_w + (size_t)l * 5 * 1024; const float* cb = p.conv_b + (size_t)l * 1024;
    for (int idx = p.bid * NTHR + p.tid; idx < T * 128; idx += p.G * NTHR) {
        const int row = idx >> 7, c8 = (idx & 127) * 8;
        const int lo = row < NCTX ? 0 : NCTX, hi = row < NCTX ? NCTX : T;
        float a[8];
        { const f32x4 b0 = *(const f32x4*)(cb + c8), b1 = *(const f32x4*)(cb + c8 + 4);
          a[0] = b0[0]; a[1] = b0[1]; a[2] = b0[2]; a[3] = b0[3]; a[4] = b1[0]; a[5] = b1[1]; a[6] = b1[2]; a[7] = b1[3]; }
#pragma unroll
        for (int j = 0; j < 5; ++j) { const int r = row + j - 2;
            if (r >= lo && r < hi) { const u32x4 xv = *(const u32x4*)(p.PROJ + (size_t)r * PJ + XB0 + c8);
                const f32x4 w0 = *(const f32x4*)(cw + j * 1024 + c8), w1 = *(const f32x4*)(cw + j * 1024 + c8 + 4);
                a[0] += w0[0] * bflo(xv.x); a[1] += w0[1] * bfhi(xv.x); a[2] += w0[2] * bflo(xv.y); a[3] += w0[3] * bfhi(xv.y);
                a[4] += w1[0] * bflo(xv.z); a[5] += w1[1] * bfhi(xv.z); a[6] += w1[2] * bflo(xv.w); a[7] += w1[3] * bfhi(xv.w); } }
        u32x4 o; o.x = pk2(silu_f(a[0]), silu_f(a[1])); o.y = pk2(silu_f(a[2]), silu_f(a[3])); o.z = pk2(silu_f(a[4]), silu_f(a[5])); o.w = pk2(silu_f(a[6]), silu_f(a[7]));
        *(u32x4*)(p.CV + (size_t)row * 1024 + c8) = o;
    }

}

__device__ __forceinline__ void ssd_scan_naive(const P& p, int l) {
    for (int it = p.bid * 4 + p.wave; it < 1024; it += p.G * 4) {
        const int d = it >> 9, hd = (it >> 6) & 7, pp = it & 63, grp = hd >> 2;
        const float a = -expf(p.a_log[l * 16 + d * 8 + hd]);
        const int colB = 512 + grp * 128 + p.lane, colC = 768 + grp * 128 + p.lane, colX = hd * 64 + pp, dcol = d * 8 + hd;
        float h0 = 0.f, h1 = 0.f;
        for (int s0 = 0; s0 < T; s0 += 8) {
            unsigned b0[8], b1[8], c0[8], c1[8], xx[8]; float dtv[8]; int rr[8];
#pragma unroll
            for (int j = 0; j < 8; ++j) { const int r = scan_row(d, s0 + j); rr[j] = r; const bf16* cv = p.CV + (size_t)r * 1024;
                b0[j] = cv[colB]; b1[j] = cv[colB + 64]; c0[j] = cv[colC]; c1[j] = cv[colC + 64]; xx[j] = cv[colX]; dtv[j] = p.DT[(size_t)r * 16 + dcol]; }
#pragma unroll
            for (int j = 0; j < 8; ++j) { const float dec = expf(dtv[j] * a), dx = dtv[j] * bf2f(xx[j]);
                h0 = dec * h0 + dx * bf2f(b0[j]); h1 = dec * h1 + dx * bf2f(b1[j]);
                const float y = wsum(bf2f(c0[j]) * h0 + bf2f(c1[j]) * h1);
                if (p.lane == 0) p.YD[((size_t)d * T + rr[j]) * 512 + colX] = y; }
        }
    }
}
__device__ __forceinline__ void s5_carry_scan(const P& p, int l, int aw, int NAW) {
    for (int it = aw; it < 64; it += NAW) {
        const int d = it >> 5, g = it & 31;
        S5Lane s; s5_lane_params(p, l, d, g, p.lane, s, false);
        float ar = s.abr, ai = s.abi;
#pragma unroll
        for (int q = 0; q < 7; ++q) { const float nr = ar * ar - ai * ai, ni = 2.f * ar * ai; ar = nr; ai = ni; }
        float hr = 0.f, hi = 0.f;
        const float* E = p.S5E + (size_t)(d * 32 + g) * NCH * 128; float* Hn = p.S5H + (size_t)(d * 32 + g) * NCH * 128;
        for (int c = 0; c < NCH; ++c) { Hn[c * 128 + p.lane] = hr; Hn[c * 128 + 64 + p.lane] = hi;
            const float er = E[c * 128 + p.lane], ei = E[c * 128 + 64 + p.lane];
            const float nr = ar * hr - ai * hi + er, ni = ar * hi + ai * hr + ei; hr = nr; hi = ni; }
    }
}
__device__ __forceinline__ void attention_naive(const P& p, int l, int aw, int NAW, LAS float* pbuf) {
    const int lane = p.lane;
    for (int it = aw; it < T * 8; it += NAW) {
        const int row = it >> 3, hq = it & 7, kvh = hq >> 2;
        const bool isc = row < NCTX; const int t = row - NCTX;
        const int jlo = isc ? 0 : (t - 128 < 0 ? 0 : t - 128), jhi = isc ? -1 : (t + 128 > NLAT - 1 ? NLAT - 1 : t + 128);
        const int nloc = jhi - jlo + 1, nk = nloc + NCTX;
        const float sink = p.sink[l * 8 + hq];
        float q[64];
        { const u32x4* qp = (const u32x4*)(p.PROJ + (size_t)row * PJ + Q0 + hq * 64);
#pragma unroll
          for (int c = 0; c < 8; ++c) { const u32x4 w = qp[c]; q[8 * c] = bflo(w.x); q[8 * c + 1] = bfhi(w.x); q[8 * c + 2] = bflo(w.y); q[8 * c + 3] = bfhi(w.y);
              q[8 * c + 4] = bflo(w.z); q[8 * c + 5] = bfhi(w.z); q[8 * c + 6] = bflo(w.w); q[8 * c + 7] = bfhi(w.w); } }
        float sc[9]; float mx = sink;
#pragma unroll
        for (int i = 0; i < 9; ++i) { const int kk = lane + 64 * i; float s = -INFINITY;
            if (kk < nk) { const int krow = kk < nloc ? NCTX + jlo + kk : kk - nloc;
                const u32x4* kp = (const u32x4*)(p.PROJ + (size_t)krow * PJ + K0 + kvh * 64); float dot = 0.f;
#pragma unroll
                for (int c = 0; c < 8; ++c) { const u32x4 w = kp[c];
                    dot += q[8 * c] * bflo(w.x) + q[8 * c + 1] * bfhi(w.x) + q[8 * c + 2] * bflo(w.y) + q[8 * c + 3] * bfhi(w.y)
                         + q[8 * c + 4] * bflo(w.z) + q[8 * c + 5] * bfhi(w.z) + q[8 * c + 6] * bflo(w.w) + q[8 * c + 7] * bfhi(w.w); }
                s = dot * 0.125f; }
            sc[i] = s; mx = fmaxf(mx, s); }
        mx = wmaxf(mx);
        float sum = 0.f;
#pragma unroll
        for (int i = 0; i < 9; ++i) { const int kk = lane + 64 * i; const float e = (kk < nk) ? expf(sc[i] - mx) : 0.f; pbuf[kk] = e; sum += e; }
        const float den = wsum(sum) + expf(sink - mx);
        LDS_FENCE();
        float o = 0.f;
        const bf16* vb = p.PROJ + V0 + kvh * 64 + lane;
#pragma unroll 4
        for (int kk = 0; kk < nk; ++kk) { const int vrow = kk < nloc ? NCTX + jlo + kk : kk - nloc; o += pbuf[kk] * bf2f(vb[(size_t)vrow * PJ]); }
        p.Y3[((size_t)2 * T + row) * 512 + hq * 64 + lane] = (bf16)f2bf(o / den);
        LDS_FENCE();
    }
}

__device__ __forceinline__ void phase_postmix(const P& p, int l, LAS unsigned char* lds) {
    constexpr int CSH_BYTES = 2 * 2 * 16 * 68 * 4, WREG = 16640;
    LAS float* Csh = (LAS float*)lds;
    LAS unsigned char* wreg = lds + CSH_BYTES + p.wave * WREG;
    LAS unsigned char* ub = wreg;
    LAS float* Hb = (LAS float*)(wreg + 4096);
    LAS float* Yb = (LAS float*)(wreg + 4096 + 4224);
    const int lane = p.lane;
    for (int it = p.bid; it < 32 * 17; it += p.G) {
        const int g = it / 17, chunk = (it % 17) * 8 + p.wave;
        __syncthreads();
        for (int i = p.tid; i < 2 * 2 * 16 * 64; i += NTHR) { const int pq = i & 63, k = (i >> 6) & 15, ri = (i >> 10) & 1, d = i >> 11;
            const float* src = ri ? p.c_im : p.c_re; Csh[((d * 2 + ri) * 16 + k) * 68 + pq] = src[(((size_t)(l * 2 + d) * 32 + g) * 16 + k) * 64 + pq]; }
        __syncthreads();
        if (chunk < NCH) {
            const int r0 = 128 * chunk;
            s5_stage_u(p, r0, g, ub, lane);
            for (int d = 0; d < 2; ++d) {
                S5Lane s; s5_lane_params(p, l, d, g, lane, s, true);
                const int cs = (d == 0) ? chunk : (chunk < 2 ? 1 - chunk : NCH + 1 - chunk);
                const float* Hn = p.S5H + ((size_t)(d * 32 + g) * NCH + cs) * 128;
                float hr = Hn[lane], hi = Hn[64 + lane];
                const LAS float* Cr = Csh + (d * 2 + 0) * 16 * 68; const LAS float* Ci = Csh + (d * 2 + 1) * 16 * 68;
                for (int sub = 0; sub < 16; ++sub) {
#pragma unroll
                    for (int j = 0; j < 8; ++j) { const int is = sub * 8 + j; s5_step(s, ub, d == 0 ? is : 127 - is, hr, hi); Hb[j * 132 + lane] = hr; Hb[j * 132 + 64 + lane] = hi; }
                    LDS_FENCE();
#pragma unroll
                    for (int m = 0; m < 2; ++m) { const int o = lane + 64 * m, j = o >> 4, k = o & 15; float y = 0.f;
#pragma unroll
                        for (int q = 0; q < 16; ++q) { const f32x4 cr = *(const LAS f32x4*)(Cr + k * 68 + 4 * q), ci = *(const LAS f32x4*)(Ci + k * 68 + 4 * q);
                            const f32x4 xr = *(const LAS f32x4*)(Hb + j * 132 + 4 * q), xi = *(const LAS f32x4*)(Hb + j * 132 + 64 + 4 * q);
                            y += cr[0] * xr[0] + cr[1] * xr[1] + cr[2] * xr[2] + cr[3] * xr[3] - ci[0] * xi[0] - ci[1] * xi[1] - ci[2] * xi[2] - ci[3] * xi[3]; }
                        const int is = sub * 8 + j, i = (d == 0) ? is : 127 - is;
                        if (d == 0) Yb[i * 16 + k] = y; else Yb[i * 16 + k] += y; }
                    LDS_FENCE();
                }
            }
            const float* dsk = p.s5_d + (size_t)l * 512 + g * 16;
#pragma unroll
            for (int m = 0; m < 2; ++m) { const int i = lane + 64 * m;
                const u32x4 ua = *(const LAS u32x4*)(ub + i * 32), ubv = *(const LAS u32x4*)(ub + i * 32 + 16);
                float u[16];
                u[0] = bflo(ua.x); u[1] = bfhi(ua.x); u[2] = bflo(ua.y); u[3] = bfhi(ua.y); u[4] = bflo(ua.z); u[5] = bfhi(ua.z); u[6] = bflo(ua.w); u[7] = bfhi(ua.w);
                u[8] = bflo(ubv.x); u[9] = bfhi(ubv.x); u[10] = bflo(ubv.y); u[11] = bfhi(ubv.y); u[12] = bflo(ubv.z); u[13] = bfhi(ubv.z); u[14] = bflo(ubv.w); u[15] = bfhi(ubv.w);
                float a[16];
#pragma unroll
                for (int k = 0; k < 16; ++k) a[k] = gelu_tanh_f(Yb[i * 16 + k] + dsk[k] * u[k]);
                u32x4 o0, o1; o0.x = pk2(a[0], a[1]); o0.y = pk2(a[2], a[3]); o0.z = pk2(a[4], a[5]); o0.w = pk2(a[6], a[7]);
                o1.x = pk2(a[8], a[9]); o1.y = pk2(a[10], a[11]); o1.z = pk2(a[12], a[13]); o1.w = pk2(a[14], a[15]);
                bf16* dst = p.SA + (size_t)(r0 + i) * 512 + g * 16;
                *(u32x4*)dst = o0; *(u32x4*)(dst + 8) = o1; }
            LDS_FENCE();
        }
    }
}

__device__ __forceinline__ void phase_select(const P& p, LAS unsigned char* lds, bool with_ctx) {
    LAS unsigned* keys = (LAS unsigned*)lds;
    LAS unsigned* hist = keys + 16384;
    LAS unsigned* misc = hist + 256;
    const int tid = p.tid, lane = p.lane, wave = p.wave;
    for (int it = p.bid; it < (with_ctx ? 32 : 16); it += p.G) {
        const int set = it >> 4, e = it & 15;
        const int n = set ? NCTX : NLAT, cap = set ? CAP_C : CAP_L, row0 = set ? 0 : NCTX, slot0 = set ? CAP_L : 0;
        const float* src = p.AFFT + (size_t)e * T + row0;
        __syncthreads();
        for (int i = tid; i < n; i += NTHR) keys[i] = __float_as_uint(src[i]);
        unsigned prefix = 0u, mask = 0u, need = (unsigned)cap;
        for (int pass = 3; pass >= 0; --pass) {
            if (tid < 256) hist[tid] = 0u;
            __syncthreads();
            for (int i = tid; i < n; i += NTHR) { const unsigned k = keys[i]; if ((k & mask) == prefix) __hip_atomic_fetch_add(&hist[(k >> (8 * pass)) & 255u], 1u, __ATOMIC_RELAXED, __HIP_MEMORY_SCOPE_WORKGROUP); }
            __syncthreads();
            if (wave == 0) {
                const unsigned h0 = hist[4 * lane], h1 = hist[4 * lane + 1], h2 = hist[4 * lane + 2], h3 = hist[4 * lane + 3];
                const unsigned c = h0 + h1 + h2 + h3; unsigned S = c;
#pragma unroll
                for (int o = 1; o < 64; o <<= 1) { const unsigned t = __shfl_down(S, o); if (lane + o < 64) S += t; }
                const unsigned Snext = S - c;
                if (S >= need && Snext < need) { unsigned rem = need - Snext; unsigned bin;
                    if (h3 >= rem) bin = 3; else { rem -= h3; if (h2 >= rem) bin = 2; else { rem -= h2; if (h1 >= rem) bin = 1; else { rem -= h1; bin = 0; } } }
                    misc[0] = 4 * lane + bin; misc[1] = rem; }
            }
            __syncthreads();
            prefix |= misc[0] << (8 * pass); mask |= 0xFFu << (8 * pass); need = misc[1];
            __syncthreads();
        }
        unsigned selbase = 0u, eqbase = 0u;
        for (int base = 0; base < n; base += NTHR) {
            const int i = base + tid; const bool valid = i < n; const unsigned k = valid ? keys[i] : 0u;
            const bool eq = valid && k == prefix, gt = valid && k > prefix;
            const unsigned long long lt = (1ull << lane) - 1ull;
            const unsigned long long be = __ballot(eq);
            if (lane == 0) misc[8 + wave] = (unsigned)__popcll(be);
            __syncthreads();
            unsigned woff = 0u, tot = 0u;
#pragma unroll
            for (int w = 0; w < 8; ++w) { const unsigned v = misc[8 + w]; woff += (w < wave) ? v : 0u; tot += v; }
            const unsigned eqrank = eqbase + woff + (unsigned)__popcll(be & lt);
            const bool sel = gt || (eq && eqrank < need);
            const unsigned long long bs = __ballot(sel);
            if (lane == 0) misc[16 + wave] = (unsigned)__popcll(bs);
            __syncthreads();
            unsigned woff2 = 0u, tot2 = 0u;
#pragma unroll
            for (int w = 0; w < 8; ++w) { const unsigned v = misc[16 + w]; woff2 += (w < wave) ? v : 0u; tot2 += v; }
            if (valid) { const int row = row0 + i;
                if (sel) { const int slot = slot0 + (int)(selbase + woff2 + (unsigned)__popcll(bs & lt));
                    p.IDX[e * ESLOTS + slot] = row; p.GSEL[e * ESLOTS + slot] = __uint_as_float(k); p.INV[(size_t)row * 16 + e] = slot; }
                else p.INV[(size_t)row * 16 + e] = -1; }
            selbase += tot2; eqbase += tot;
            __syncthreads();
        }
    }
}
__device__ __forceinline__ void phase_gather(const P& p, bool with_ctx) {
    const int gw = p.bid * NWAVES + p.wave, NGW = p.G * NWAVES, lane = p.lane;
    for (int idx = gw; idx < NE * ESLOTS; idx += NGW) {
        const int slot = idx % ESLOTS; const bool valid = slot < CAP_L + (with_ctx ? CAP_C : 0);
        u32x4 a = (u32x4){0u, 0u, 0u, 0u}, b = a;
        if (valid) { const int row = p.IDX[idx]; const u32x4* s = (const u32x4*)(p.H + (size_t)row * D); a = s[lane]; b = s[64 + lane]; }
        else if (lane == 0) p.GSEL[idx] = 0.f;
        u32x4* dst = (u32x4*)(p.XE + (size_t)idx * D); dst[lane] = a; dst[64 + lane] = b;
    }
}

typedef short bf16x8 __attribute__((ext_vector_type(8)));
#define MFMA16(a, b, c) __builtin_amdgcn_mfma_f32_16x16x32_bf16((a), (b), (c), 0, 0, 0)
constexpr int LDP = 272;
constexpr int LDQ = 144;
__device__ __forceinline__ bf16x8 ld_frag(const LAS unsigned char* base, int row, int kcol, int ldb) { return *(const LAS bf16x8*)(base + row * ldb + kcol * 2); }
typedef short s16x4_t __attribute__((ext_vector_type(4)));
__device__ __forceinline__ bf16x8 tr_frag(const LAS unsigned char* img, int k0, int col0, int sb, int lane) {
    const int g = lane >> 4, q = (lane & 15) >> 2, pp = lane & 3;
    const LAS unsigned char* a = img + (k0 + 8 * g + q) * sb + (col0 + 4 * pp) * 2;
    const s16x4_t r0 = __builtin_amdgcn_ds_read_tr16_b64_v4i16((LAS s16x4_t*)a), r1 = __builtin_amdgcn_ds_read_tr16_b64_v4i16((LAS s16x4_t*)(a + 4 * sb));
    return (bf16x8){r0[0], r0[1], r0[2], r0[3], r1[0], r1[1], r1[2], r1[3]};
}
constexpr int SB64 = 144, SB128 = 304, SB256 = 560;
__device__ __forceinline__ void st_b16(LAS unsigned char* p, unsigned v) { *(LAS unsigned short*)p = (unsigned short)v; }
__device__ __forceinline__ float wscan_incl(float v, int lane) {
#pragma unroll
    for (int o = 1; o < 64; o <<= 1) { const float t = __shfl_up(v, o); if (lane >= o) v += t; }
    return v;
}
__device__ __forceinline__ int chunk_r0(int d, int cs) { return d == 0 ? 128 * cs : (cs < 2 ? 128 * (1 - cs) : 128 * (NCH + 1 - cs)); }
__device__ __forceinline__ int scan_chunk_of(int d, int cn) { return d == 0 ? cn : (cn < 2 ? 1 - cn : NCH + 1 - cn); }

__device__ __forceinline__ void ssd_acum(const float* DT, int r0, int d, int col, float a, int lane, LAS float* acum, LAS float* dtv, float& total) {
    const int j0 = d == 0 ? lane : 127 - lane, j1 = d == 0 ? 64 + lane : 63 - lane;
    const float dt0 = DT[(size_t)(r0 + j0) * 16 + col], dt1 = DT[(size_t)(r0 + j1) * 16 + col];
    const float s0 = wscan_incl(dt0 * a, lane); const float t0 = __shfl(s0, 63);
    const float s1 = wscan_incl(dt1 * a, lane) + t0; total = __shfl(s1, 63);
    acum[j0] = s0; acum[j1] = s1; dtv[j0] = dt0; dtv[j1] = dt1;
}

__device__ __forceinline__ void ssd_states(const P& p, int l, LAS unsigned char* lds, float* SST, float* DEC) {
    LAS unsigned char* Bi = lds;
    LAS unsigned char* Xi = lds + 128 * SB128;
    LAS float* wj = (LAS float*)(lds + 128 * SB128 + 128 * SB256);
    const int tid = p.tid, lane = p.lane, wave = p.wave, quad = lane >> 4, l15 = lane & 15;
    for (int u = p.bid; u < 2 * NCH * 2; u += p.G) {
        const int d = u / (2 * NCH), cs = (u % (2 * NCH)) >> 1, g = u & 1;
        const int r0 = chunk_r0(d, cs);
        __syncthreads();
        if (wave < 4) { const int h = g * 4 + wave; const float a = -expf(p.a_log[l * 16 + d * 8 + h]); float total;
            LAS float* ac = wj + 512 + wave * 128; LAS float* dv = wj + 1024 + wave * 128;
            ssd_acum(p.DT, r0, d, d * 8 + h, a, lane, ac, dv, total);
            LDS_FENCE();
            wj[wave * 128 + lane] = __expf(total - ac[lane]) * dv[lane]; wj[wave * 128 + 64 + lane] = __expf(total - ac[64 + lane]) * dv[64 + lane];
            if (lane == 0) DEC[(d * NCH + cs) * 8 + h] = expf(total); }
        for (int idx = tid; idx < 128 * 16; idx += NTHR) { const int j = idx >> 4, n8 = (idx & 15) * 8;
            *(LAS u32x4*)(Bi + j * SB128 + n8 * 2) = *(const u32x4*)(p.CV + (size_t)(r0 + j) * 1024 + 512 + g * 128 + n8); }
        __syncthreads();
        for (int idx = tid; idx < 128 * 32; idx += NTHR) { const int j = idx >> 5, c8 = (idx & 31) * 8;
            const u32x4 v = *(const u32x4*)(p.CV + (size_t)(r0 + j) * 1024 + g * 256 + c8); const float w = wj[(c8 >> 6) * 128 + j];
            u32x4 o; o.x = pk2(bflo(v.x) * w, bfhi(v.x) * w); o.y = pk2(bflo(v.y) * w, bfhi(v.y) * w); o.z = pk2(bflo(v.z) * w, bfhi(v.z) * w); o.w = pk2(bflo(v.w) * w, bfhi(v.w) * w);
            *(LAS u32x4*)(Xi + j * SB256 + c8 * 2) = o; }
        __syncthreads();
        const int hh = wave >> 1, ph = wave & 1;
        f32x4 acc[2][8];
#pragma unroll
        for (int a = 0; a < 2; ++a)
#pragma unroll
            for (int b = 0; b < 8; ++b) acc[a][b] = (f32x4){0.f, 0.f, 0.f, 0.f};
#pragma unroll
        for (int ks = 0; ks < 4; ++ks) {
            bf16x8 af[2];
#pragma unroll
            for (int pt = 0; pt < 2; ++pt) af[pt] = tr_frag(Xi, 32 * ks, hh * 64 + ph * 32 + pt * 16, SB256, lane);
#pragma unroll
            for (int nt = 0; nt < 8; ++nt) { const bf16x8 bfr = tr_frag(Bi, 32 * ks, nt * 16, SB128, lane);
#pragma unroll
                for (int pt = 0; pt < 2; ++pt) acc[pt][nt] = MFMA16(af[pt], bfr, acc[pt][nt]); }
        }
        float* S = SST + ((size_t)(d * NCH + cs) * 8 + g * 4 + hh) * 8192;
#pragma unroll
        for (int pt = 0; pt < 2; ++pt)
#pragma unroll
            for (int nt = 0; nt < 8; ++nt)
#pragma unroll
                for (int r = 0; r < 4; ++r) S[(ph * 32 + pt * 16 + 4 * quad + r) * 128 + nt * 16 + l15] = acc[pt][nt][r];
    }
}

__device__ __forceinline__ void scan_carries(const P& p, int l, const float* SST, const float* DEC, bf16* HIN) {
    for (int e = p.bid * NTHR + p.tid; e < 2 * 8 * 8192; e += p.G * NTHR) {
        const int d = e >> 16, h = (e >> 13) & 7, pn = e & 8191;
        float hs = 0.f;
        for (int c0 = 0; c0 < NCH; c0 += 10) {
            float s[10], dc[10];
#pragma unroll
            for (int j = 0; j < 10; ++j) { const size_t ci = (size_t)(d * NCH + c0 + j) * 8 + h; s[j] = SST[ci * 8192 + pn]; dc[j] = DEC[ci]; }
#pragma unroll
            for (int j = 0; j < 10; ++j) { const size_t ci = (size_t)(d * NCH + c0 + j) * 8 + h; HIN[ci * 8192 + pn] = (bf16)f2bf(hs); hs = hs * dc[j] + s[j]; }
        }
    }
    for (int e = p.bid * NTHR + p.tid; e < 2 * 32 * 64; e += p.G * NTHR) {
        const int d = e >> 11, g = (e >> 6) & 31, pq = e & 63;
        S5Lane s; s5_lane_params(p, l, d, g, pq, s, false);
        float ar = s.abr, ai = s.abi;
#pragma unroll
        for (int q = 0; q < 7; ++q) { const float nr = ar * ar - ai * ai, ni = 2.f * ar * ai; ar = nr; ai = ni; }
        float hr = 0.f, hi = 0.f;
        const float* E = p.S5E + (size_t)(d * 32 + g) * NCH * 128 + pq; float* Hn = p.S5H + (size_t)(d * 32 + g) * NCH * 128 + pq;
        for (int c0 = 0; c0 < NCH; c0 += 10) {
            float er[10], ei[10];
#pragma unroll
            for (int j = 0; j < 10; ++j) { er[j] = E[(c0 + j) * 128]; ei[j] = E[(c0 + j) * 128 + 64]; }
#pragma unroll
            for (int j = 0; j < 10; ++j) { Hn[(c0 + j) * 128] = hr; Hn[(c0 + j) * 128 + 64] = hi;
                const float nr = ar * hr - ai * hi + er[j], ni = ar * hi + ai * hr + ei[j]; hr = nr; hi = ni; }
        }
    }
}

__device__ __forceinline__ void ssd_outputs(const P& p, int l, LAS unsigned char* lds, const bf16* HIN, const float* SST, bf16* YS, int u_begin, int u_end, int first, int stride) {
    LAS unsigned char* Cm = lds;
    LAS unsigned char* Bm = lds + 128 * LDP;
    LAS unsigned char* XT = lds + 2 * 128 * LDP;
    LAS unsigned char* Wm = lds + 2 * 128 * LDP + 128 * SB64;
    LAS float* sm = (LAS float*)(lds + 3 * 128 * LDP + 128 * SB64);
    const int tid = p.tid, lane = p.lane, wave = p.wave, quad = lane >> 4, l15 = lane & 15;
    for (int u = u_begin + first; u < u_end; u += stride) {
        const int cn = u >> 3, h = u & 7, g = h >> 2, r0 = 128 * cn;
        __syncthreads();
        if (wave < 2) { const int d = wave; const float a = -expf(p.a_log[l * 16 + d * 8 + h]); float total;
            ssd_acum(p.DT, r0, d, d * 8 + h, a, lane, sm + d * 128, sm + 256 + d * 128, total); }
        for (int idx = tid; idx < 128 * 16; idx += NTHR) { const int j = idx >> 4, n8 = (idx & 15) * 8;
            const bf16* src = p.CV + (size_t)(r0 + j) * 1024 + g * 128 + n8;
            *(LAS u32x4*)(Bm + j * LDP + n8 * 2) = *(const u32x4*)(src + 512); *(LAS u32x4*)(Cm + j * LDP + n8 * 2) = *(const u32x4*)(src + 768); }
        for (int idx = tid; idx < 128 * 8; idx += NTHR) { const int j = idx >> 3, p8 = (idx & 7) * 8;
            *(LAS u32x4*)(XT + j * SB64 + p8 * 2) = *(const u32x4*)(p.CV + (size_t)(r0 + j) * 1024 + h * 64 + p8); }
        __syncthreads();
        f32x4 G[8];
#pragma unroll
        for (int jt = 0; jt < 8; ++jt) G[jt] = (f32x4){0.f, 0.f, 0.f, 0.f};
#pragma unroll
        for (int ks = 0; ks < 4; ++ks) { const bf16x8 af = ld_frag(Cm, 16 * wave + l15, ks * 32 + 8 * quad, LDP);
#pragma unroll
            for (int jt = 0; jt < 8; ++jt) G[jt] = MFMA16(af, ld_frag(Bm, 16 * jt + l15, ks * 32 + 8 * quad, LDP), G[jt]); }
        __syncthreads();
        for (int idx = tid; idx < 2 * 64 * 16; idx += NTHR) { const int d = idx >> 10, pp = (idx >> 4) & 63, n8 = (idx & 15) * 8;
            const int cs = scan_chunk_of(d, cn);
            u32x4 w;
            if (cn >= 2) w = *(const u32x4*)(HIN + ((size_t)(d * NCH + cs) * 8 + h) * 8192 + pp * 128 + n8);
            else if (cs == 0) w = (u32x4){0u, 0u, 0u, 0u};
            else { const float* s = SST + ((size_t)(d * NCH) * 8 + h) * 8192 + pp * 128 + n8; const f32x4 s0 = *(const f32x4*)s, s1 = *(const f32x4*)(s + 4);
                w.x = pk2(s0[0], s0[1]); w.y = pk2(s0[2], s0[3]); w.z = pk2(s1[0], s1[1]); w.w = pk2(s1[2], s1[3]); }
            *(LAS u32x4*)(Bm + (d * 64 + pp) * LDP + n8 * 2) = w; }
        __syncthreads();
        f32x4 Y[4];
#pragma unroll
        for (int pt = 0; pt < 4; ++pt) Y[pt] = (f32x4){0.f, 0.f, 0.f, 0.f};
#pragma unroll
        for (int d = 0; d < 2; ++d) {
            const LAS float* ac = sm + d * 128; const LAS float* dv = sm + 256 + d * 128;
            float ai[4];
#pragma unroll
            for (int r = 0; r < 4; ++r) ai[r] = ac[16 * wave + 4 * quad + r];
#pragma unroll
            for (int jt = 0; jt < 8; ++jt) { const int j = 16 * jt + l15; const float aj = ac[j], dj = dv[j];
#pragma unroll
                for (int r = 0; r < 4; ++r) { const int i = 16 * wave + 4 * quad + r; const bool valid = (d == 0) ? (j <= i) : (j >= i);
                    const float w = valid ? G[jt][r] * __expf(ai[r] - aj) * dj : 0.f;
                    st_b16(Wm + i * LDP + 2 * j, f2bf(w)); } }
            LDS_FENCE();
            f32x4 Y2[4];
#pragma unroll
            for (int pt = 0; pt < 4; ++pt) Y2[pt] = (f32x4){0.f, 0.f, 0.f, 0.f};
#pragma unroll
            for (int ks = 0; ks < 4; ++ks) { const bf16x8 wf = ld_frag(Wm, 16 * wave + l15, ks * 32 + 8 * quad, LDP), cf = ld_frag(Cm, 16 * wave + l15, ks * 32 + 8 * quad, LDP);
#pragma unroll
                for (int pt = 0; pt < 4; ++pt) { Y[pt] = MFMA16(wf, tr_frag(XT, 32 * ks, 16 * pt, SB64, lane), Y[pt]);
                    Y2[pt] = MFMA16(cf, ld_frag(Bm + d * 64 * LDP, 16 * pt + l15, ks * 32 + 8 * quad, LDP), Y2[pt]); } }
#pragma unroll
            for (int r = 0; r < 4; ++r) { const float ea = __expf(ai[r]);
#pragma unroll
                for (int pt = 0; pt < 4; ++pt) Y[pt][r] += ea * Y2[pt][r]; }
            LDS_FENCE();
        }
#pragma unroll
        for (int pt = 0; pt < 4; ++pt)
#pragma unroll
            for (int r = 0; r < 4; ++r) YS[(size_t)(r0 + 16 * wave + 4 * quad + r) * 512 + h * 64 + 16 * pt + l15] = (bf16)f2bf(Y[pt][r]);
    }
}

__device__ __forceinline__ void ssd_gated_norm(const P& p, int l, const bf16* YS) {
    const int gw = p.bid * NWAVES + p.wave, NGW = p.G * NWAVES, lane = p.lane;
    for (int row = gw; row < T; row += NGW) {
        const int ch = lane * 8;
        const float dsk = p.ssd_d[l * 8 + (ch >> 6)];
        const u32x4 yv = *(const u32x4*)(YS + (size_t)row * 512 + ch);
        const u32x4 xs = *(const u32x4*)(p.CV + (size_t)row * 1024 + ch), zz = *(const u32x4*)(p.PROJ + (size_t)row * PJ + Z0 + ch);
        float v[8];
        v[0] = (bflo(yv.x) + dsk * bflo(xs.x)) * silu_f(bflo(zz.x)); v[1] = (bfhi(yv.x) + dsk * bfhi(xs.x)) * silu_f(bfhi(zz.x));
        v[2] = (bflo(yv.y) + dsk * bflo(xs.y)) * silu_f(bflo(zz.y)); v[3] = (bfhi(yv.y) + dsk * bfhi(xs.y)) * silu_f(bfhi(zz.y));
        v[4] = (bflo(yv.z) + dsk * bflo(xs.z)) * silu_f(bflo(zz.z)); v[5] = (bfhi(yv.z) + dsk * bfhi(xs.z)) * silu_f(bfhi(zz.z));
        v[6] = (bflo(yv.w) + dsk * bflo(xs.w)) * silu_f(bflo(zz.w)); v[7] = (bfhi(yv.w) + dsk * bfhi(xs.w)) * silu_f(bfhi(zz.w));
        float ss = 0.f;
#pragma unroll
        for (int i = 0; i < 8; ++i) ss += v[i] * v[i];
        const float rstd = rsqrtf(wsum(ss) * (1.f / 512.f) + EPS);
        const float* ng = p.ssd_norm_g + (size_t)l * 512 + ch;
        const f32x4 g0 = *(const f32x4*)ng, g1 = *(const f32x4*)(ng + 4);
        u32x4 o; o.x = pk2(v[0] * rstd * g0[0], v[1] * rstd * g0[1]); o.y = pk2(v[2] * rstd * g0[2], v[3] * rstd * g0[3]);
        o.z = pk2(v[4] * rstd * g1[0], v[5] * rstd * g1[1]); o.w = pk2(v[6] * rstd * g1[2], v[7] * rstd * g1[3]);
        *(u32x4*)(p.Y3 + (size_t)row * 1536 + 512 + ch) = o;
    }
}

__device__ __forceinline__ void attention_mfma(const P& p, int l, LAS unsigned char* lds, int u_begin, int u_end, int u_first, int u_stride) {
    LAS unsigned char* Kt = lds;
    LAS unsigned char* VT = lds + 64 * LDQ;
    LAS unsigned char* Pw = lds + 2 * 64 * LDQ + p.wave * 64 * LDQ;
    const int tid = p.tid, lane = p.lane, wave = p.wave, quad = lane >> 4, l15 = lane & 15;
    const float C2 = 0.125f * 1.4426950408889634f;
    for (int u = u_begin + u_first; u < u_end; u += u_stride) {
        const int qb = u >> 1, kvh = u & 1, hq = kvh * 4 + (wave >> 1);
        const bool isc = qb < 2; const int nb = qb - 2;
        const int qrow0 = 128 * qb + 64 * (wave & 1);
        bf16x8 Qf[4][2];
#pragma unroll
        for (int qt = 0; qt < 4; ++qt)
#pragma unroll
            for (int ks = 0; ks < 2; ++ks) Qf[qt][ks] = *(const bf16x8*)(p.PROJ + (size_t)(qrow0 + 16 * qt + l15) * PJ + Q0 + hq * 64 + ks * 32 + 8 * quad);
        f32x4 O[4][4];
#pragma unroll
        for (int a = 0; a < 4; ++a)
#pragma unroll
            for (int b = 0; b < 4; ++b) O[a][b] = (f32x4){0.f, 0.f, 0.f, 0.f};
        float mrow[4], lrow[4];
        const float sk = p.sink[l * 8 + hq] * 1.4426950408889634f;
#pragma unroll
        for (int qt = 0; qt < 4; ++qt) { mrow[qt] = sk; lrow[qt] = 1.f; }
        const int ntile = isc ? 4 : 10;
#define ATT_VALID(ti_) (isc || (ti_) >= 6 || ((NCTX + 128 * (nb - 1) + 64 * (ti_)) >= NCTX && (NCTX + 128 * (nb - 1) + 64 * (ti_)) < T))
#define ATT_KROW0(ti_) ((isc || (ti_) >= 6) ? 64 * (isc ? (ti_) : (ti_) - 6) : NCTX + 128 * (nb - 1) + 64 * (ti_))
        int ti = 0; while (!ATT_VALID(ti)) ++ti;
        u32x4 kreg, vreg;
        { const bf16* src = p.PROJ + (size_t)(ATT_KROW0(ti) + (tid >> 3)) * PJ + kvh * 64 + (tid & 7) * 8; kreg = *(const u32x4*)(src + K0); vreg = *(const u32x4*)(src + V0); }
        while (ti < ntile) {
            const int krow0 = ATT_KROW0(ti); const bool local = !(isc || ti >= 6);
            int tn = ti + 1; while (tn < ntile && !ATT_VALID(tn)) ++tn;
            __syncthreads();
            { const int key = tid >> 3, pc = tid & 7;
              *(LAS u32x4*)(Kt + key * LDQ + pc * 16) = kreg;
              *(LAS u32x4*)(VT + key * SB64 + pc * 16) = vreg; }
            __syncthreads();
            if (tn < ntile) { const bf16* src = p.PROJ + (size_t)(ATT_KROW0(tn) + (tid >> 3)) * PJ + kvh * 64 + (tid & 7) * 8; kreg = *(const u32x4*)(src + K0); vreg = *(const u32x4*)(src + V0); }
            const bool need_mask = local && (ti < 2 || ti > 3);
#pragma unroll
            for (int qt = 0; qt < 4; ++qt) {
                f32x4 S[4][1];
#pragma unroll
                for (int kt = 0; kt < 4; ++kt) S[kt][0] = (f32x4){0.f, 0.f, 0.f, 0.f};
#pragma unroll
                for (int ks = 0; ks < 2; ++ks)
#pragma unroll
                    for (int kt = 0; kt < 4; ++kt) S[kt][0] = MFMA16(ld_frag(Kt, 16 * kt + l15, ks * 32 + 8 * quad, LDQ), Qf[qt][ks], S[kt][0]);
                const int tq = qrow0 + 16 * qt + l15;
                float mx = -1e30f;
                if (need_mask) {
#pragma unroll
                    for (int kt = 0; kt < 4; ++kt)
#pragma unroll
                        for (int r = 0; r < 4; ++r) { const int df = tq - (krow0 + 16 * kt + 4 * quad + r);
                            const float s = (df <= 128 && df >= -128) ? S[kt][0][r] : -1e30f; S[kt][0][r] = s; mx = fmaxf(mx, s); }
                } else {
#pragma unroll
                    for (int kt = 0; kt < 4; ++kt) mx = fmaxf(fmaxf(mx, fmaxf(S[kt][0][0], S[kt][0][1])), fmaxf(S[kt][0][2], S[kt][0][3]));
                }
                mx = fmaxf(mx, __shfl_xor(mx, 16)); mx = fmaxf(mx, __shfl_xor(mx, 32));
                const float mn = fmaxf(mrow[qt], mx * C2), alpha = __builtin_amdgcn_exp2f(mrow[qt] - mn);
                float ls = 0.f;
#pragma unroll
                for (int kt = 0; kt < 4; ++kt) { const float e0 = __builtin_amdgcn_exp2f(S[kt][0][0] * C2 - mn), e1 = __builtin_amdgcn_exp2f(S[kt][0][1] * C2 - mn),
                                                              e2 = __builtin_amdgcn_exp2f(S[kt][0][2] * C2 - mn), e3 = __builtin_amdgcn_exp2f(S[kt][0][3] * C2 - mn);
                    ls += (e0 + e1) + (e2 + e3);
                    u32x2 w; w.x = pk2(e0, e1); w.y = pk2(e2, e3);
                    *(LAS u32x2*)(Pw + (16 * qt + l15) * LDQ + (16 * kt + 4 * quad) * 2) = w; }
                ls += __shfl_xor(ls, 16); ls += __shfl_xor(ls, 32);
                lrow[qt] = lrow[qt] * alpha + ls; mrow[qt] = mn;
#pragma unroll
                for (int dt = 0; dt < 4; ++dt) O[dt][qt] *= alpha;
            }
            LDS_FENCE();
#pragma unroll
            for (int ks = 0; ks < 2; ++ks) {
                bf16x8 pf[4];
#pragma unroll
                for (int qt = 0; qt < 4; ++qt) pf[qt] = ld_frag(Pw, 16 * qt + l15, ks * 32 + 8 * quad, LDQ);
#pragma unroll
                for (int dt = 0; dt < 4; ++dt) { const bf16x8 vf = tr_frag(VT, 32 * ks, 16 * dt, SB64, lane);
#pragma unroll
                    for (int qt = 0; qt < 4; ++qt) O[dt][qt] = MFMA16(vf, pf[qt], O[dt][qt]); }
            }
            LDS_FENCE();
            ti = tn;
        }
#undef ATT_VALID
#undef ATT_KROW0
#pragma unroll
        for (int qt = 0; qt < 4; ++qt) { const float inv = 1.f / lrow[qt];
            bf16* orow = p.Y3 + (size_t)(qrow0 + 16 * qt + l15) * 1536 + 1024 + hq * 64;
#pragma unroll
            for (int dt = 0; dt < 4; ++dt) { u32x2 w; w.x = pk2(O[dt][qt][0] * inv, O[dt][qt][1] * inv); w.y = pk2(O[dt][qt][2] * inv, O[dt][qt][3] * inv);
                *(u32x2*)(orow + 16 * dt + 4 * quad) = w; } }
    }
}

#ifndef S5_INTERLEAVE
#define S5_INTERLEAVE 2
#endif
constexpr size_t S5BB_ELEMS = (size_t)2 * 32 * 128 * 32, S5CC_ELEMS = (size_t)2 * 32 * 16 * 128;
__device__ __forceinline__ void s5_tables(const P& p, int l, bf16* BB, bf16* CC, float* AB) {
    for (int e = p.bid * NTHR + p.tid; e < 2 * 32 * 64; e += p.G * NTHR) {
        const int d = e >> 11, g = (e >> 6) & 31, pq = e & 63, dg = d * 32 + g;
        S5Lane s; s5_lane_params(p, l, d, g, pq, s, true);
        AB[(size_t)e * 2] = s.abr; AB[(size_t)e * 2 + 1] = s.abi;
        #if S5_INTERLEAVE
        u32x4* br = (u32x4*)(BB + ((size_t)dg * 128 + 2 * pq) * 32); u32x4* bi = (u32x4*)(BB + ((size_t)dg * 128 + 2 * pq + 1) * 32);
#else
        u32x4* br = (u32x4*)(BB + ((size_t)dg * 128 + pq) * 32); u32x4* bi = (u32x4*)(BB + ((size_t)dg * 128 + 64 + pq) * 32);
#endif
        u32x4 w;
        w.x = pk2(s.bbr[0], s.bbr[1]); w.y = pk2(s.bbr[2], s.bbr[3]); w.z = pk2(s.bbr[4], s.bbr[5]); w.w = pk2(s.bbr[6], s.bbr[7]); br[0] = w;
        w.x = pk2(s.bbr[8], s.bbr[9]); w.y = pk2(s.bbr[10], s.bbr[11]); w.z = pk2(s.bbr[12], s.bbr[13]); w.w = pk2(s.bbr[14], s.bbr[15]); br[1] = w;
        w.x = pk2(s.bbi[0], s.bbi[1]); w.y = pk2(s.bbi[2], s.bbi[3]); w.z = pk2(s.bbi[4], s.bbi[5]); w.w = pk2(s.bbi[6], s.bbi[7]); bi[0] = w;
        w.x = pk2(s.bbi[8], s.bbi[9]); w.y = pk2(s.bbi[10], s.bbi[11]); w.z = pk2(s.bbi[12], s.bbi[13]); w.w = pk2(s.bbi[14], s.bbi[15]); bi[1] = w;
        const u32x4 z = (u32x4){0u, 0u, 0u, 0u}; br[2] = z; br[3] = z; bi[2] = z; bi[3] = z;
        const size_t ci = ((size_t)(l * 2 + d) * 32 + g) * 16;
#pragma unroll
        for (int k = 0; k < 16; ++k) {
#if S5_INTERLEAVE
            *(unsigned*)(CC + ((size_t)dg * 16 + k) * 128 + 2 * pq) = pk2(p.c_re[(ci + k) * 64 + pq], -p.c_im[(ci + k) * 64 + pq]);
#else
            CC[((size_t)dg * 16 + k) * 128 + pq] = (bf16)f2bf(p.c_re[(ci + k) * 64 + pq]); CC[((size_t)dg * 16 + k) * 128 + 64 + pq] = (bf16)f2bf(-p.c_im[(ci + k) * 64 + pq]);
#endif
        }
    }
}
constexpr int S5_WREG = 4096 + 16 * 132 * 4 + 16 * LDP;
template <bool READOUT> __device__ __forceinline__ void s5_chunk_dir(int d, const bf16* BBdg, const bf16* CCdg, float abr, float abi, LAS unsigned char* wreg, int lane, float& hr, float& hi, f32x4 (&yacc)[8]) {
    const int quad = lane >> 4, l15 = lane & 15;
    LAS unsigned char* ub = wreg; LAS float* BuW = (LAS float*)(wreg + 4096); LAS unsigned char* Hw = wreg + 4096 + 16 * 132 * 4;
    bf16x8 BBf[8], CCf[4];
#pragma unroll
    for (int pt = 0; pt < 8; ++pt) BBf[pt] = *(const bf16x8*)(BBdg + (size_t)(16 * pt + l15) * 32 + 8 * quad);
    if (READOUT) {
#pragma unroll
        for (int ks = 0; ks < 4; ++ks) CCf[ks] = *(const bf16x8*)(CCdg + (size_t)l15 * 128 + ks * 32 + 8 * quad);
    }
#pragma unroll (READOUT ? 8 : 1)
    for (int ss = 0; ss < 8; ++ss) {
        const int sc = d ? 7 - ss : ss;
        bf16x8 uf = (bf16x8){0, 0, 0, 0, 0, 0, 0, 0};
        if (quad < 2) uf = *(const LAS bf16x8*)(ub + (16 * sc + l15) * 32 + quad * 16);
#pragma unroll
        for (int pt = 0; pt < 8; ++pt) { const f32x4 Dp = MFMA16(uf, BBf[pt], ((f32x4){0.f, 0.f, 0.f, 0.f}));
#pragma unroll
            for (int r = 0; r < 4; ++r) BuW[(4 * quad + r) * 132 + 16 * pt + l15] = Dp[r]; }
        LDS_FENCE();
#pragma unroll
        for (int st = 0; st < 16; ++st) { const int tl = d ? 15 - st : st;
#if S5_INTERLEAVE == 1
            typedef float f32x2_t __attribute__((ext_vector_type(2)));
            const f32x2_t bu = *(const LAS f32x2_t*)(BuW + tl * 132 + 2 * lane);
            const float nr = abr * hr - abi * hi + bu[0], ni = abr * hi + abi * hr + bu[1]; hr = nr; hi = ni;
            if (READOUT) *(LAS unsigned*)(Hw + tl * LDP + 4 * lane) = pk2(hr, hi); }
#elif S5_INTERLEAVE == 2
            const float br = BuW[tl * 132 + 2 * lane], bi = BuW[tl * 132 + 2 * lane + 1];
            const float nr = abr * hr - abi * hi + br, ni = abr * hi + abi * hr + bi; hr = nr; hi = ni;
            if (READOUT) *(LAS unsigned*)(Hw + tl * LDP + 4 * lane) = pk2(hr, hi); }
#else
            const float br = BuW[tl * 132 + lane], bi = BuW[tl * 132 + 64 + lane];
            const float nr = abr * hr - abi * hi + br, ni = abr * hi + abi * hr + bi; hr = nr; hi = ni;
            if (READOUT) { st_b16(Hw + tl * LDP + 2 * lane, f2bf(hr)); st_b16(Hw + tl * LDP + 128 + 2 * lane, f2bf(hi)); } }
#endif
        if (READOUT) {
            LDS_FENCE();
#pragma unroll
            for (int ks = 0; ks < 4; ++ks) yacc[sc] = MFMA16(ld_frag(Hw, l15, ks * 32 + 8 * quad, LDP), CCf[ks], yacc[sc]);
        }
        LDS_FENCE();
    }
}
__device__ __forceinline__ void s5_local_states(const P& p, LAS unsigned char* lds, const bf16* BB, const float* AB) {
    LAS unsigned char* wreg = lds + p.wave * S5_WREG;
    const int gw = p.bid * NWAVES + p.wave, NGW = p.G * NWAVES, lane = p.lane;
    for (int it = gw; it < 2 * 32 * NCH; it += NGW) {
        const int d = it / (32 * NCH), c = (it % (32 * NCH)) >> 5, g = it & 31, dg = d * 32 + g;
        s5_stage_u(p, chunk_r0(d, c), g, wreg, lane);
        float hr = 0.f, hi = 0.f; f32x4 dummy[8];
        const float abr = AB[((size_t)dg * 64 + lane) * 2], abi = AB[((size_t)dg * 64 + lane) * 2 + 1];
        if (d == 0) s5_chunk_dir<false>(0, BB + (size_t)dg * 128 * 32, nullptr, abr, abi, wreg, lane, hr, hi, dummy);
        else s5_chunk_dir<false>(1, BB + (size_t)dg * 128 * 32, nullptr, abr, abi, wreg, lane, hr, hi, dummy);
        float* E = p.S5E + ((size_t)dg * NCH + c) * 128;
        E[lane] = hr; E[64 + lane] = hi;
    }
}
__device__ __forceinline__ void s5_outputs(const P& p, int l, LAS unsigned char* lds, const bf16* BB, const bf16* CC, const float* AB, int it_begin, int it_end, int first, int stride) {
    LAS unsigned char* wreg = lds + p.wave * S5_WREG;
    const int lane = p.lane, quad = lane >> 4, l15 = lane & 15;
    for (int it = it_begin + first; it < it_end; it += stride) {
        const int cn = it >> 5, g = it & 31, r0 = 128 * cn;
        s5_stage_u(p, r0, g, wreg, lane);
        f32x4 yacc[8];
#pragma unroll
        for (int i = 0; i < 8; ++i) yacc[i] = (f32x4){0.f, 0.f, 0.f, 0.f};
#pragma unroll
        for (int d = 0; d < 2; ++d) { const int dg = d * 32 + g, cs = scan_chunk_of(d, cn);
            const float* Hn = (cn < 2) ? (p.S5E + (size_t)dg * NCH * 128) : (p.S5H + ((size_t)dg * NCH + cs) * 128);
            float hr = Hn[lane], hi = Hn[64 + lane];
            if (cs == 0) { hr = 0.f; hi = 0.f; }
            s5_chunk_dir<true>(d, BB + (size_t)dg * 128 * 32, CC + (size_t)dg * 16 * 128, AB[((size_t)dg * 64 + lane) * 2], AB[((size_t)dg * 64 + lane) * 2 + 1], wreg, lane, hr, hi, yacc); }
        const float dsk = p.s5_d[(size_t)l * 512 + g * 16 + l15];
#pragma unroll
        for (int sc = 0; sc < 8; ++sc)
#pragma unroll
            for (int r = 0; r < 4; ++r) { const int t = 16 * sc + 4 * quad + r;
                const float u = bf2f(*(const LAS unsigned short*)(wreg + t * 32 + 2 * l15));
                p.SA[(size_t)(r0 + t) * 512 + g * 16 + l15] = (bf16)f2bf(gelu_tanh_f(yacc[sc][r] + dsk * u)); }
        LDS_FENCE();
    }
}

#ifndef SKIPMASK
#define SKIPMASK 0
#endif
struct Args { const float* in[33]; float* out; unsigned char* ws; int ph_lo, ph_hi; };
static_assert(sizeof(Args) == 35 * 8 + 8, "no padding");

__global__ void __launch_bounds__(NTHR, 2) fwd_kernel(Args args) {
    extern __shared__ __attribute__((aligned(16))) unsigned char lds_raw[];
    LAS unsigned char* lds = (LAS unsigned char*)lds_raw;
    const int tid_ = threadIdx.x;
    if (tid_ == 0) {
        LAS unsigned long long* tab = (LAS unsigned long long*)(lds + PTAB_OFF);
#pragma unroll
        for (int k = 0; k < 33; ++k) tab[k] = (unsigned long long)args.in[k];
        tab[33] = (unsigned long long)args.out; tab[34] = (unsigned long long)args.ws;
    }
    volatile LAS unsigned* MISC = (volatile LAS unsigned*)(lds + MISC_OFF);
    if (tid_ < 64) MISC[tid_] = 0u;
    __syncthreads();
    XcdBarrier bar; bar.bar = (unsigned*)(args.ws + WS_CTL) + CW_BAR; bar.x = 0; bar.st = nullptr;
    if (!MK_PER_PHASE) bar = xcd_barrier_post((unsigned*)(args.ws + WS_CTL) + CW_BAR, MISC + 8);

    const int lo = args.ph_lo, hi = args.ph_hi;
#define IN(k) (lo <= (k) && (k) < hi)
#define SEAM(k) do { if (!MK_PER_PHASE && (k) + 1 < hi) xcd_barrier(bar); } while (0)

    if (IN(0)) { P p; build_P(p, lds); phase_mod(p, lds, (float*)(args.ws + WS_ROPE)); SEAM(0); }

#ifndef REPSUB
#define REPSUB 0
#endif
#define RSUB(b, ...) for (int r2_ = 0; r2_ <= ((REPSUB >> (b)) & 1); ++r2_) { __VA_ARGS__; __syncthreads(); }
#ifndef REPMASK
#define REPMASK 0
#endif
#define PHASE(k, ...) if (!((SKIPMASK >> (k)) & 1) && IN(pb + (k))) { for (int rep_ = 0; rep_ <= ((REPMASK >> (k)) & 1); ++rep_) { P p; build_P(p, lds, l & 1); __VA_ARGS__; \
        if (rep_ < ((REPMASK >> (k)) & 1)) xcd_barrier(bar); } SEAM(pb + (k)); }
    for (int l = 0; l < DEPTH; ++l) {
        const int pb = 1 + NPH_LAYER * l;
        const bool cx = l < DEPTH - 1;
        unsigned char* wsb; { unsigned tb_ = (unsigned)(size_t)(lds + PTAB_OFF); asm volatile("" : "+v"(tb_)); wsb = (unsigned char*)ld_tab((volatile LAS unsigned*)(size_t)tb_, 34); }
        PHASE(0, if (l == 0) convert_weights(p, l, lds, p.bid * NWAVES + p.wave, p.G * NWAVES); s5_tables(p, l, (bf16*)(wsb + WS_S5BB), (bf16*)(wsb + WS_S5CC), (float*)(wsb + WS_S5AB)); __syncthreads(); if (rep_ == 0) row_pass<0>(p, l, lds))
        PHASE(1, pg8::Gemm g{p.H, p.WIN, T, PJ, D}; pg8::StaticOrder S; S.init(T, PJ, p.G, p.bid); pg8::EpiStoreBf16 E{p.PROJ, PJ, GT0 / 256, (const float*)(wsb + WS_ROPE)};
            pg8::gemm_phase<pg8::EpiStoreBf16, pg8::StaticOrder, false>(lds, g, S, E, nullptr))
        PHASE(2, RSUB(2, phase_premix(p, l, lds)) RSUB(3, s5_local_states(p, lds, (const bf16*)(wsb + WS_S5BB), (const float*)(wsb + WS_S5AB))))
        PHASE(3, RSUB(0, ssd_states(p, l, lds, (float*)(wsb + WS_SST), (float*)(wsb + WS_DEC))) RSUB(1, attention_mfma(p, l, lds, 4, 2 * NCH, p.bid, p.G)))
        PHASE(4, if (cx) { if (p.bid >= p.G - 4) attention_mfma(p, l, lds, 0, 4, p.bid - (p.G - 4), 4);
                else if (p.bid >= p.G - 20) ssd_outputs(p, l, lds, (const bf16*)(wsb + WS_HIN), (const float*)(wsb + WS_SST), (bf16*)(wsb + WS_YS), 0, 16, p.bid - (p.G - 20), 16);
                else if (p.bid >= p.G - 28) s5_outputs(p, l, lds, (const bf16*)(wsb + WS_S5BB), (const bf16*)(wsb + WS_S5CC), (const float*)(wsb + WS_S5AB), 0, 64, (p.bid - (p.G - 28)) * NWAVES + p.wave, 64); }
            scan_carries(p, l, (const float*)(wsb + WS_SST), (const float*)(wsb + WS_DEC), (bf16*)(wsb + WS_HIN)))
        PHASE(5, RSUB(4, ssd_outputs(p, l, lds, (const bf16*)(wsb + WS_HIN), (const float*)(wsb + WS_SST), (bf16*)(wsb + WS_YS), 16, NCH * 8, p.bid, p.G))
            RSUB(5, s5_outputs(p, l, lds, (const bf16*)(wsb + WS_S5BB), (const bf16*)(wsb + WS_S5CC), (const float*)(wsb + WS_S5AB), 64, 32 * NCH, p.bid * NWAVES + p.wave, p.G * NWAVES)))
        PHASE(6, pg8::Gemm g{p.SA, p.WGLU, T, 512, 512}; pg8::RowOffOrder S; S.init(cx ? T : NLAT, 512, p.G, p.bid, cx ? 0 : 1); pg8::EpiGlu E{p.SA, p.b_glu + (size_t)l * 512, p.Y3};
            pg8::gemm_phase<pg8::EpiGlu, pg8::RowOffOrder, false>(lds, g, S, E, nullptr); ssd_gated_norm(p, l, (const bf16*)(wsb + WS_YS)))
        PHASE(7, pg8::Gemm g{p.Y3, p.WBR, T, D, 1536}; pg8::RowOffOrder S; S.init(cx ? T : NLAT, D, p.G, p.bid, cx ? 0 : 1); pg8::EpiMerge E{p.PROJ, p.MB};
            pg8::gemm_phase<pg8::EpiMerge, pg8::RowOffOrder, false>(lds, g, S, E, nullptr))
        PHASE(8, pg8::Gemm g{p.MB, p.WOUT, T, D, D}; pg8::RowOffOrder S; S.init(cx ? T : NLAT, D, p.G, p.bid, cx ? 0 : 1);
            pg8::EpiResid E{p.XL, p.XC, p.MOD + (size_t)(l * 2 + 0) * 6144 + 2 * D, p.MOD + (size_t)(l * 2 + 1) * 6144 + 2 * D};
            pg8::gemm_phase<pg8::EpiResid, pg8::RowOffOrder, false>(lds, g, S, E, nullptr))
        PHASE(9, row_pass<1>(p, l, lds, cx))
        PHASE(10, { const int nsel = cx ? 32 : 16; if (p.bid < nsel) phase_select(p, lds, cx);
            else if (l + 1 < DEPTH) { P q; build_P(q, lds, (l + 1) & 1); convert_weights(q, l + 1, lds, (p.bid - nsel) * NWAVES + p.wave, (p.G - nsel) * NWAVES); } })
        PHASE(11, phase_gather(p, cx))
        PHASE(12, pg8::Gemm g{p.XE, p.WUP, NE * ESLOTS, NE * 2048, D}; pg8::ExpertOrder S{p.G, p.bid, 8, cx ? 9 : 8}; pg8::EpiSwiGlu E{p.HID};
            pg8::gemm_phase<pg8::EpiSwiGlu, pg8::ExpertOrder, false>(lds, g, S, E, nullptr))
        PHASE(13, pg8::Gemm g{p.HID, p.WDN, NE * ESLOTS, NE * 1024, D}; pg8::ExpertOrder S{p.G, p.bid, 4, cx ? 9 : 8}; pg8::EpiDown E{p.YE, p.GSEL};
            pg8::gemm_phase<pg8::EpiDown, pg8::ExpertOrder, false>(lds, g, S, E, nullptr))
    }
    if (IN(NPHASES - 1)) { P p; build_P(p, lds); row_pass<2>(p, 0, lds); }
#undef IN
#undef SEAM
}

extern "C" void kernel_launch(void* const* d_in, const int* in_sizes, int n_in, void* d_out, int out_size, void* d_ws, size_t ws_size, hipStream_t stream) {
    static int grid = 0;
    if (grid == 0) {
        if (n_in != 33 || out_size != NLAT * D || ws_size < WS_END) { fprintf(stderr, "kernel_launch: unexpected shapes: n_in %d out %d ws %zu (need %zu)\n", n_in, out_size, ws_size, (size_t)WS_END); grid = -1; return; }
        int dev = 0, cus = 0, per_cu = 0;
        if (hipGetDevice(&dev) != hipSuccess || hipDeviceGetAttribute(&cus, hipDeviceAttributeMultiprocessorCount, dev) != hipSuccess) { grid = -1; return; }
        if (hipFuncSetAttribute((const void*)fwd_kernel, hipFuncAttributeMaxDynamicSharedMemorySize, LDS_BYTES) != hipSuccess) { fprintf(stderr, "kernel_launch: hipFuncSetAttribute failed\n"); grid = -1; return; }
        if (hipOccupancyMaxActiveBlocksPerMultiprocessor(&per_cu, (const void*)fwd_kernel, NTHR, LDS_BYTES) != hipSuccess || per_cu < 1) { fprintf(stderr, "kernel_launch: occupancy query says %d\n", per_cu); (void)hipGetLastError(); }
        grid = cus;
    }
    if (grid < 0) return;
    (void)hipMemsetAsync((char*)d_ws + WS_CTL, 0, CTL_BYTES, stream);
    Args a{};
    for (int i = 0; i < 33; ++i) a.in[i] = (const float*)d_in[i];
    a.out = (float*)d_out; a.ws = (unsigned char*)d_ws;
#if MK_PER_PHASE
    for (int ph = 0; ph < NPHASES; ++ph) { a.ph_lo = ph; a.ph_hi = ph + 1; hipLaunchKernelGGL(fwd_kernel, dim3(grid), dim3(NTHR), LDS_BYTES, stream, a); }
#else
    a.ph_lo = 0; a.ph_hi = NPHASES;
    hipLaunchKernelGGL(fwd_kernel, dim3(grid), dim3(NTHR), LDS_BYTES, stream, a);
#endif
}
```

```cpp
#include <hip/hip_runtime.h>
#include <cstdio>
#include <cstdint>

#ifndef MK_PER_PHASE
#define MK_PER_PHASE 0
#endif

namespace pg8 {
#define PG8_LAS __attribute__((address_space(3)))
typedef unsigned short bf16_t;
typedef short bf16x8 __attribute__((ext_vector_type(8)));
typedef float f32x4 __attribute__((ext_vector_type(4)));
typedef unsigned u32x4 __attribute__((ext_vector_type(4)));
constexpr int BM = 256, BK = 64, HALF = 128, HTB = HALF * BK * 2  , STAGE_BYTES = 8 * HTB, NXCD = 8, WGM = 8;

__host__ __device__ __forceinline__ int lds_byte(int r, int c) { const int st = (r >> 4) * 2 + (c >> 5), rr = r & 15, cc = c & 31, ob = rr * 64 + cc * 2; return st * 1024 + (ob ^ (((ob >> 9) & 1) << 5)); }
__host__ __device__ __forceinline__ void stage_rc(int b, int& R, int& C) { const int st = b / 1024, sb = b % 1024, swz = sb ^ (((sb >> 9) & 1) << 5); R = (st >> 1) * 16 + swz / 64; C = (st & 1) * 32 + (swz % 64) / 2; }
__host__ __device__ __forceinline__ int perm32(int rho) { const int n = rho >> 4, i = rho & 15; return 8 * (i >> 2) + 4 * n + (i & 3); }

struct Unit { int pm, pn; };
struct Gemm { const bf16_t* A; const bf16_t* Bt; int M, N, K; };

struct StaticOrder {
    int nM, nN, nwg, G, c;
    __host__ __device__ void init(int M, int N, int G_, int c_) { nM = M / BM; nN = N / BM; nwg = nM * nN; G = G_; c = c_; }
    __host__ __device__ bool next(int i, Unit& u) const {
        const long L = (long)i * G + c; if (L >= nwg) return false;
        int wgid = (int)L; { const int q = nwg / NXCD, r = nwg % NXCD, xcd = wgid % NXCD, off = wgid / NXCD; wgid = (xcd < r ? xcd * (q + 1) : r * (q + 1) + (xcd - r) * q) + off; }
        const int nig = WGM * nN, gid = wgid / nig, fm = gid * WGM, gsz = (nM - fm) < WGM ? (nM - fm) : WGM;
        u.pm = fm + ((wgid % nig) % gsz); u.pn = (wgid % nig) / gsz; return true;
    }
    __device__ __forceinline__ void a_ready(const Unit&) const {}
    __device__ __forceinline__ void done(const Unit&) const {}
};
__device__ __forceinline__ unsigned cvt_pk_bf16(float lo, float hi) { unsigned r; asm volatile("v_cvt_pk_bf16_f32 %0, %1, %2" : "=v"(r) : "v"(lo), "v"(hi)); return r; }
template <class Epi, class Sched, bool STAMP = false>
__device__ __forceinline__ void gemm_phase(PG8_LAS unsigned char* lds, const Gemm g, const Sched& S, const Epi& E, unsigned long long* stamps) {
    int tid_l = threadIdx.x; asm volatile("" : "+v"(tid_l));
    const int tid = tid_l, wid = __builtin_amdgcn_readfirstlane(tid >> 6), lane = tid & 63, wr = wid >> 2, wc = wid & 3, fr = lane & 15, fq = lane >> 4;
    const int K = g.K, nt = K / BK;
    int ts_lo = 0, ts_hi = 0, nts = 0; const unsigned long long rt_entry = STAMP ? (unsigned long long)wall_clock64() : 0ull;
#define PG8_STAMP() do { if (STAMP && wid == 0 && nts < 64) { const unsigned long long _c = (unsigned long long)clock64(); \
        ts_lo = (lane == nts) ? (int)(unsigned)_c : ts_lo; ts_hi = (lane == nts) ? (int)(unsigned)(_c >> 32) : ts_hi; ++nts; } } while (0)
    PG8_STAMP();
    unsigned voffA[2], voffB[2];
#pragma unroll
    for (int i = 0; i < 2; ++i) { int R, C; stage_rc(tid * 16 + i * 8192, R, C); const int Rb = Epi::PERM ? ((R & ~31) + perm32(R & 31)) : R;
        voffA[i] = (unsigned)(R * K + C) * 2u; voffB[i] = (unsigned)(Rb * K + C) * 2u; }
    const size_t kstep = (size_t)(BK * 2);
    const size_t hstep = (size_t)HALF * K * 2;
    const size_t tstep = 2 * hstep;
    const unsigned ldsw = (unsigned)wid * 1024u;
    const int aoff = lds_byte(wr * 64 + fr, fq * 8), boff = lds_byte(wc * 32 + fr, fq * 8);
#define PG8_SA(b, h) (((b) * 2 + (h)) * HTB)
#define PG8_SB(b, h) ((4 + (b) * 2 + (h)) * HTB)
#define PG8_STAGE(bufoff, gbase, voff) do { _Pragma("unroll") for (int _i = 0; _i < 2; ++_i) \
        __builtin_amdgcn_global_load_lds((const unsigned*)((const char*)(gbase) + (voff)[_i]), (PG8_LAS unsigned*)(lds + (bufoff) + ldsw + _i * 8192), 16, 0, 0); } while (0)
#define PG8_LDA(dst, b, h) do { _Pragma("unroll") for (int m = 0; m < 4; ++m) _Pragma("unroll") for (int k = 0; k < 2; ++k) dst[m][k] = *(const PG8_LAS bf16x8*)(lds + PG8_SA(b, h) + aoff + m * 2048 + k * 1024); } while (0)
#define PG8_LDB(dst, b, h) do { _Pragma("unroll") for (int n = 0; n < 2; ++n) _Pragma("unroll") for (int k = 0; k < 2; ++k) dst[n][k] = *(const PG8_LAS bf16x8*)(lds + PG8_SB(b, h) + boff + n * 2048 + k * 1024); } while (0)
#define PG8_MMA(ai, bj, At, Bt) do { __builtin_amdgcn_s_setprio(1); _Pragma("unroll") for (int m = 0; m < 4; ++m) _Pragma("unroll") for (int n = 0; n < 2; ++n) _Pragma("unroll") for (int k = 0; k < 2; ++k) \
        acc[ai][bj][m][n] = __builtin_amdgcn_mfma_f32_16x16x32_bf16(Bt[n][k], At[m][k], acc[ai][bj][m][n], 0, 0, 0); __builtin_amdgcn_s_setprio(0); } while (0)
#define PG8_WAIT_V(n) asm volatile("s_waitcnt vmcnt(" #n ")" ::: "memory")
#define PG8_WAIT_L(n) asm volatile("s_waitcnt lgkmcnt(" #n ")" ::: "memory")
#define PG8_BAR __builtin_amdgcn_s_barrier()
#define PG8_SCHED __builtin_amdgcn_sched_barrier(0)
    Unit cur, nxt; int ui = 0;
    if (!S.next(0, cur)) return;
    f32x4 acc[2][2][4][2];
#pragma unroll
    for (int a = 0; a < 2; ++a)
#pragma unroll
        for (int b = 0; b < 2; ++b)
#pragma unroll
            for (int m = 0; m < 4; ++m)
#pragma unroll
                for (int n = 0; n < 2; ++n) acc[a][b][m][n] = (f32x4){0.f, 0.f, 0.f, 0.f};
    bf16x8 At[4][2], B0[2][2], B1[2][2];
    const char* cA = (const char*)g.A + (size_t)cur.pm * tstep; const char* cB = (const char*)g.Bt + (size_t)cur.pn * tstep;
    S.a_ready(cur);
    PG8_STAGE(PG8_SB(0, 0), cB, voffB); PG8_STAGE(PG8_SA(0, 0), cA, voffA); PG8_STAGE(PG8_SB(0, 1), cB + hstep, voffB); PG8_STAGE(PG8_SA(0, 1), cA + hstep, voffA);
    if (wr == 1) PG8_BAR;
    PG8_WAIT_V(4); PG8_BAR;
    PG8_STAGE(PG8_SB(1, 0), cB + kstep, voffB); PG8_STAGE(PG8_SA(1, 0), cA + kstep, voffA); PG8_STAGE(PG8_SB(1, 1), cB + hstep + kstep, voffB);
    PG8_WAIT_V(6); PG8_BAR;
    PG8_STAMP();
    for (;;) {
        const bool has_next = S.next(ui + 1, nxt);
        const char* nA = has_next ? (const char*)g.A + (size_t)nxt.pm * tstep : cA; const char* nB = has_next ? (const char*)g.Bt + (size_t)nxt.pn * tstep : cB;
        for (int t = 0; t < nt; t += 2) {
            const bool last = (t == nt - 2);
            const char* a1 = cA + (size_t)(t + 1) * kstep;
            const char* a2 = last ? nA : cA + (size_t)(t + 2) * kstep; const char* b2 = last ? nB : cB + (size_t)(t + 2) * kstep;
            const char* a3 = a2 + kstep; const char* b3 = b2 + kstep;
            if (last && has_next) S.a_ready(nxt);
            if constexpr (Epi::MIDHOOK) { if (t == 8 || t == 16) E.mid(acc, cur, t >> 3, wr, wc, fr, fq); }
            PG8_LDB(B0, 0, 0); PG8_SCHED; PG8_LDA(At, 0, 0); PG8_STAGE(PG8_SA(1, 1), a1 + hstep, voffA);
            PG8_WAIT_L(8); PG8_BAR; PG8_WAIT_L(0); PG8_MMA(0, 0, At, B0); PG8_BAR; PG8_SCHED;
            PG8_LDB(B1, 0, 1); PG8_STAGE(PG8_SB(0, 0), b2, voffB);
            PG8_BAR; PG8_WAIT_L(0); PG8_MMA(0, 1, At, B1); PG8_BAR;
            PG8_LDA(At, 0, 1); PG8_STAGE(PG8_SA(0, 0), a2, voffA);
            PG8_BAR; PG8_WAIT_L(0); PG8_MMA(1, 0, At, B0); PG8_BAR; PG8_SCHED;
            PG8_STAGE(PG8_SB(0, 1), b2 + hstep, voffB);
            PG8_WAIT_V(6); PG8_BAR; PG8_MMA(1, 1, At, B1); PG8_BAR;
            PG8_LDB(B0, 1, 0); PG8_SCHED; PG8_LDA(At, 1, 0); PG8_STAGE(PG8_SA(0, 1), a2 + hstep, voffA);
            PG8_WAIT_L(8); PG8_BAR; PG8_WAIT_L(0); PG8_MMA(0, 0, At, B0); PG8_BAR; PG8_SCHED;
            PG8_LDB(B1, 1, 1); PG8_STAGE(PG8_SB(1, 0), b3, voffB);
            PG8_BAR; PG8_WAIT_L(0); PG8_MMA(0, 1, At, B1); PG8_BAR;
            PG8_LDA(At, 1, 1); PG8_STAGE(PG8_SA(1, 0), a3, voffA);
            PG8_BAR; PG8_WAIT_L(0); PG8_MMA(1, 0, At, B0); PG8_BAR; PG8_SCHED;
            PG8_STAGE(PG8_SB(1, 1), b3 + hstep, voffB);
            PG8_WAIT_V(6); PG8_BAR; PG8_MMA(1, 1, At, B1); PG8_BAR;
        }
        PG8_STAMP();
        if constexpr (!Epi::AFTER_DRAIN) { E(acc, cur, wr, wc, fr, fq); S.done(cur); }
        PG8_STAMP();
        if (!has_next) break;
#pragma unroll
        for (int a = 0; a < 2; ++a)
#pragma unroll
            for (int b = 0; b < 2; ++b)
#pragma unroll
                for (int m = 0; m < 4; ++m)
#pragma unroll
                    for (int n = 0; n < 2; ++n) acc[a][b][m][n] = (f32x4){0.f, 0.f, 0.f, 0.f};
        cur = nxt; cA = nA; cB = nB; ++ui;
    }
    PG8_WAIT_V(0);
    if (wr == 0) PG8_BAR;
    PG8_BAR;
    if constexpr (Epi::AFTER_DRAIN) { E.fused(acc, cur, wr, wc, fr, fq, lds, wid, lane); S.done(cur); }
    PG8_STAMP();
    if (STAMP && wid == 0) { stamps[lane] = lane < nts ? (((unsigned long long)(unsigned)ts_hi << 32) | (unsigned)ts_lo) : 0ull;
        if (lane == 62) stamps[62] = rt_entry; if (lane == 63) stamps[63] = (unsigned long long)wall_clock64(); }
#undef PG8_STAMP
#undef PG8_SA
#undef PG8_SB
#undef PG8_STAGE
#undef PG8_LDA
#undef PG8_LDB
#undef PG8_MMA
#undef PG8_WAIT_V
#undef PG8_WAIT_L
#undef PG8_BAR
#undef PG8_SCHED
}
}

#define GAS __attribute__((address_space(1)))
#define LAS __attribute__((address_space(3)))
typedef unsigned short bf16;
typedef float f32x4 __attribute__((ext_vector_type(4)));
typedef unsigned u32x4 __attribute__((ext_vector_type(4)));
typedef unsigned u32x2 __attribute__((ext_vector_type(2)));

constexpr int D = 1024, NLAT = 16384, NCTX = 256, T = NLAT + NCTX, DEPTH = 4;
constexpr int IN_W = 5904, PJ = 5888;
constexpr int U0 = 0, Z0 = 512, XB0 = 1024, Q0 = 2048, K0 = 2560, V0 = 2688, GT0 = 2816;
constexpr int NE = 16, ESLOTS = 2304, CAP_L = 2048, CAP_C = 32;
constexpr int NCH = 130;
constexpr float EPS = 1e-6f;
constexpr int NWAVES = 8, NTHR = 512;
constexpr int LDS_BYTES = 155648;
constexpr int MISC_OFF = LDS_BYTES - 1024 + 512;
constexpr int NPH_LAYER = 14, NPHASES = 1 + DEPTH * NPH_LAYER + 1;

constexpr size_t al256(size_t x) { return (x + 255) & ~(size_t)255; }
constexpr size_t WS_CTL = 0, CTL_BYTES = 1u << 20;
constexpr size_t WS_MOD = WS_CTL + CTL_BYTES;
constexpr size_t WS_XC = al256(WS_MOD + (size_t)DEPTH * 2 * 6144 * 4);
constexpr size_t WS_WIN = al256(WS_XC + (size_t)NCTX * D * 4);
constexpr size_t WS_WGLU = al256(WS_WIN + (size_t)PJ * D * 2);
constexpr size_t WS_WBR = al256(WS_WGLU + (size_t)512 * 512 * 2);
constexpr size_t WS_WOUT = al256(WS_WBR + (size_t)3 * 1024 * 512 * 2);
constexpr size_t WS_WUP = al256(WS_WOUT + (size_t)1024 * 1024 * 2);
constexpr size_t WS_WDN = al256(WS_WUP + (size_t)NE * 2048 * 1024 * 2);
constexpr size_t WS_H = al256(WS_WDN + (size_t)NE * 1024 * 1024 * 2);
constexpr size_t WS_PROJ = al256(WS_H + (size_t)T * D * 2);
constexpr size_t WS_XE = WS_PROJ;
constexpr size_t WS_HID = al256(WS_XE + (size_t)NE * ESLOTS * D * 2);
constexpr size_t WS_DT = al256(WS_PROJ + (size_t)T * PJ * 2);
constexpr size_t WS_CV = al256(WS_DT + (size_t)T * 16 * 4);
constexpr size_t WS_S5E = al256(WS_CV + (size_t)T * 1024 * 2);
constexpr size_t WS_S5H = al256(WS_S5E + (size_t)2 * 32 * NCH * 128 * 4);
constexpr size_t WS_YD = al256(WS_S5H + (size_t)2 * 32 * NCH * 128 * 4);
constexpr size_t WS_SA = al256(WS_YD + (size_t)2 * T * 512 * 4);
constexpr size_t WS_Y3 = al256(WS_SA + (size_t)T * 512 * 2);
constexpr size_t WS_PM = al256(WS_Y3 + (size_t)3 * T * 512 * 2);
constexpr size_t WS_MB = al256(WS_PM + (size_t)T * D * 4);
constexpr size_t WS_YE = WS_PM;
constexpr size_t WS_AFFT = al256(WS_MB + (size_t)T * D * 2);
constexpr size_t WS_IDX = al256(WS_AFFT + (size_t)NE * T * 4);
constexpr size_t WS_GSEL = al256(WS_IDX + (size_t)NE * ESLOTS * 4);
constexpr size_t WS_INV = al256(WS_GSEL + (size_t)NE * ESLOTS * 4);
constexpr size_t WS_DEC = al256(WS_INV + (size_t)T * 16 * 4);
constexpr size_t WS_S5BB = al256(WS_DEC + (size_t)2 * NCH * 8 * 4);
constexpr size_t WS_S5CC = al256(WS_S5BB + (size_t)2 * 32 * 128 * 32 * 2);
constexpr size_t WS_S5AB = al256(WS_S5CC + (size_t)2 * 32 * 16 * 128 * 2);
constexpr size_t WS_ROPE = al256(WS_S5AB + (size_t)2 * 32 * 64 * 2 * 4);
constexpr size_t WS_W2 = al256(WS_ROPE + (size_t)2 * 256 * 16 * 4);
constexpr size_t WBUF_BYTES = WS_H - WS_WIN;
constexpr size_t WS_END = al256(WS_W2 + WBUF_BYTES);
constexpr size_t WS_SST = WS_YD;
constexpr size_t WS_HIN = WS_PM;
constexpr size_t WS_YS = al256(WS_HIN + (size_t)2 * NCH * 8 * 8192 * 2);
static_assert(WS_YS + (size_t)T * 512 * 2 <= WS_AFFT, "HIN|YS overlay fits PM|MB");
static_assert(WS_HID + (size_t)NE * ESLOTS * D * 2 <= WS_DT, "XE|HID overlay fits PROJ");
static_assert(WS_YE + (size_t)NE * ESLOTS * D * 2 <= WS_AFFT, "YE overlay fits PM|MB");
static_assert(WS_END < (size_t)1000 * 1024 * 1024, "workspace");
constexpr int CW_BAR = 4096;

__device__ __forceinline__ float bf2f(unsigned b) { return __uint_as_float(b << 16); }
__device__ __forceinline__ float bflo(unsigned w) { return __uint_as_float(w << 16); }
__device__ __forceinline__ float bfhi(unsigned w) { return __uint_as_float(w & 0xffff0000u); }
typedef float f32x2_c __attribute__((ext_vector_type(2)));
typedef __bf16 bf16x2_c __attribute__((ext_vector_type(2)));
__device__ __forceinline__ unsigned pk2(float lo, float hi) { f32x2_c v; v[0] = lo; v[1] = hi; return __builtin_bit_cast(unsigned, __builtin_convertvector(v, bf16x2_c)); }
__device__ __forceinline__ unsigned f2bf(float f) { return pk2(f, 0.f) & 0xffffu; }
__device__ __forceinline__ float wsum(float v) {
#pragma unroll
    for (int o = 1; o < 64; o <<= 1) v += __shfl_xor(v, o);
    return v;
}
__device__ __forceinline__ float wmaxf(float v) {
#pragma unroll
    for (int o = 1; o < 64; o <<= 1) v = fmaxf(v, __shfl_xor(v, o));
    return v;
}
__device__ __forceinline__ float silu_f(float x) { return x * __builtin_amdgcn_rcpf(1.f + __expf(-x)); }
__device__ __forceinline__ float sigmoid_f(float x) { return __builtin_amdgcn_rcpf(1.f + __expf(-x)); }
__device__ __forceinline__ float softplus_f(float x) { return x > 20.f ? x : log1pf(expf(x)); }
__device__ __forceinline__ float gelu_tanh_f(float x) { const float u = 0.7978845608028654f * (x + 0.044715f * x * x * x); return x * __builtin_amdgcn_rcpf(1.f + __expf(-2.f * u)); }
#define LDS_FENCE() asm volatile("s_waitcnt lgkmcnt(0)" ::: "memory")
__device__ __forceinline__ int scan_row(int d, int s) { return d == 0 ? s : (s < NCTX ? (NCTX - 1 - s) : (T + NCTX - 1 - s)); }

namespace pg8 {
struct EpiStoreBf16 {
    static constexpr bool PERM = true, AFTER_DRAIN = false, MIDHOOK = false;
    bf16_t* O; int ldc; int sig_tile; const float* rope;
    __device__ __forceinline__ void operator()(const f32x4 (&acc)[2][2][4][2], const Unit& u, int wr, int wc, int fr, int fq) const {
        const int row0 = u.pm * BM + wr * 64 + fr, col0 = u.pn * BM + wc * 32 + 8 * fq; const bool sg = u.pn >= sig_tile;
        const bool rq = rope != nullptr && u.pm >= 1 && (u.pn == Q0 / 256 || u.pn == Q0 / 256 + 1), rk = rope != nullptr && u.pm >= 1 && u.pn == K0 / 256;
#pragma unroll
        for (int ai = 0; ai < 2; ++ai)
#pragma unroll
            for (int m = 0; m < 4; ++m) { const int row = row0 + ai * HALF + m * 16; bf16_t* rowp = O + (size_t)row * ldc + col0;
#pragma unroll
                for (int bj = 0; bj < 2; ++bj) { f32x4 v0 = acc[ai][bj][m][0], v1 = acc[ai][bj][m][1];
                    if (sg) {
#pragma unroll
                        for (int q = 0; q < 4; ++q) { v0[q] = __builtin_amdgcn_rcpf(1.f + __expf(-v0[q])); v1[q] = __builtin_amdgcn_rcpf(1.f + __expf(-v1[q])); } }
                    if (rq || (rk && bj == 0)) {
                        const int t = row - NCTX, idx = (wc & 1) ? (t & 63) : (t >> 6);
                        const float* cp = rope + idx * 16 + 8 * (fq & 1);
                        const f32x4 c0 = *(const f32x4*)cp, c1 = *(const f32x4*)(cp + 4), s0 = *(const f32x4*)(cp + 4096), s1 = *(const f32x4*)(cp + 4100);
                        const float sgn = (fq & 2) ? 1.f : -1.f;
#pragma unroll
                        for (int q = 0; q < 4; ++q) { const float p0 = __shfl_xor(v0[q], 32), p1 = __shfl_xor(v1[q], 32);
                            v0[q] = v0[q] * c0[q] + sgn * p0 * s0[q]; v1[q] = v1[q] * c1[q] + sgn * p1 * s1[q]; } }
                    u32x4 w; w.x = cvt_pk_bf16(v0[0], v0[1]); w.y = cvt_pk_bf16(v0[2], v0[3]); w.z = cvt_pk_bf16(v1[0], v1[1]); w.w = cvt_pk_bf16(v1[2], v1[3]);
                    *(u32x4*)(rowp + bj * HALF) = w; } }
    }
};
struct EpiGlu {
    static constexpr bool PERM = true, AFTER_DRAIN = false, MIDHOOK = false;
    const bf16_t* A; const float* bias; bf16_t* O;
    __device__ __forceinline__ void operator()(const f32x4 (&acc)[2][2][4][2], const Unit& u, int wr, int wc, int fr, int fq) const {
        const int row0 = u.pm * BM + wr * 64 + fr, col0 = u.pn * BM + wc * 32 + 8 * fq;
#pragma unroll
        for (int ai = 0; ai < 2; ++ai)
#pragma unroll
            for (int m = 0; m < 4; ++m) { const size_t ro = (size_t)(row0 + ai * HALF + m * 16) * 512 + col0;
#pragma unroll
                for (int bj = 0; bj < 2; ++bj) { const f32x4 v0 = acc[ai][bj][m][0], v1 = acc[ai][bj][m][1];
                    const u32x4 a = *(const u32x4*)(A + ro + bj * HALF);
                    const f32x4 b0 = *(const f32x4*)(bias + col0 + bj * HALF), b1 = *(const f32x4*)(bias + col0 + bj * HALF + 4);
                    float o[8];
                    o[0] = bflo(a.x) * sigmoid_f(v0[0] + b0[0]); o[1] = bfhi(a.x) * sigmoid_f(v0[1] + b0[1]);
                    o[2] = bflo(a.y) * sigmoid_f(v0[2] + b0[2]); o[3] = bfhi(a.y) * sigmoid_f(v0[3] + b0[3]);
                    o[4] = bflo(a.z) * sigmoid_f(v1[0] + b1[0]); o[5] = bfhi(a.z) * sigmoid_f(v1[1] + b1[1]);
                    o[6] = bflo(a.w) * sigmoid_f(v1[2] + b1[2]); o[7] = bfhi(a.w) * sigmoid_f(v1[3] + b1[3]);
                    u32x4 w; w.x = cvt_pk_bf16(o[0], o[1]); w.y = cvt_pk_bf16(o[2], o[3]); w.z = cvt_pk_bf16(o[4], o[5]); w.w = cvt_pk_bf16(o[6], o[7]);
                    *(u32x4*)(O + (size_t)(row0 + ai * HALF + m * 16) * 1536 + col0 + bj * HALF) = w; } }
    }
};
struct RowOffOrder {
    StaticOrder b; int off;
    __device__ __forceinline__ void init(int M, int N, int G, int c, int off_) { b.init(M, N, G, c); off = off_; }
    __device__ __forceinline__ bool next(int i, Unit& u) const { if (!b.next(i, u)) return false; u.pm += off; return true; }
    __device__ __forceinline__ void a_ready(const Unit&) const {}
    __device__ __forceinline__ void done(const Unit&) const {}
};
struct EpiMerge {
    static constexpr bool PERM = true, AFTER_DRAIN = false, MIDHOOK = true;
    const bf16_t* proj; bf16_t* MB;
    __device__ __forceinline__ void mid(f32x4 (&acc)[2][2][4][2], const Unit& u, int seg, int wr, int wc, int fr, int fq) const {
        const unsigned base = (unsigned)((u.pm * BM + wr * 64 + fr) * PJ + GT0 + (seg - 1) * 1024 + u.pn * BM + wc * 32 + 8 * fq) * 2u;
        const char* pb = (const char*)proj;
#pragma unroll
        for (int ai = 0; ai < 2; ++ai)
#pragma unroll
            for (int m = 0; m < 4; ++m) {
                u32x4 ga[2], gb[2];
#pragma unroll
                for (int bj = 0; bj < 2; ++bj) { const unsigned o = base + (unsigned)(((ai * HALF + m * 16) * PJ + bj * HALF) * 2);
                    ga[bj] = *(const u32x4*)(pb + o); gb[bj] = *(const u32x4*)(pb + o + 2048u); }
#pragma unroll
                for (int bj = 0; bj < 2; ++bj) { const u32x4 a = ga[bj], b = gb[bj];
                    f32x4& v0 = acc[ai][bj][m][0]; f32x4& v1 = acc[ai][bj][m][1];
                    v0[0] *= bflo(a.x) * __builtin_amdgcn_rcpf(bflo(b.x)); v0[1] *= bfhi(a.x) * __builtin_amdgcn_rcpf(bfhi(b.x));
                    v0[2] *= bflo(a.y) * __builtin_amdgcn_rcpf(bflo(b.y)); v0[3] *= bfhi(a.y) * __builtin_amdgcn_rcpf(bfhi(b.y));
                    v1[0] *= bflo(a.z) * __builtin_amdgcn_rcpf(bflo(b.z)); v1[1] *= bfhi(a.z) * __builtin_amdgcn_rcpf(bfhi(b.z));
                    v1[2] *= bflo(a.w) * __builtin_amdgcn_rcpf(bflo(b.w)); v1[3] *= bfhi(a.w) * __builtin_amdgcn_rcpf(bfhi(b.w)); }
                if (m & 1) asm volatile("" ::: "memory");
            }
    }
    __device__ __forceinline__ void operator()(const f32x4 (&acc)[2][2][4][2], const Unit& u, int wr, int wc, int fr, int fq) const {
        const int row0 = u.pm * BM + wr * 64 + fr, col0 = u.pn * BM + wc * 32 + 8 * fq;
#pragma unroll
        for (int ai = 0; ai < 2; ++ai)
#pragma unroll
            for (int m = 0; m < 4; ++m) { const int row = row0 + ai * HALF + m * 16;
#pragma unroll
                for (int bj = 0; bj < 2; ++bj) { const f32x4 v0 = acc[ai][bj][m][0], v1 = acc[ai][bj][m][1]; const int col = col0 + bj * HALF;
                    const u32x4 g = *(const u32x4*)(proj + (size_t)row * PJ + GT0 + 2048 + col);
                    u32x4 w; w.x = cvt_pk_bf16(bflo(g.x) * v0[0], bfhi(g.x) * v0[1]); w.y = cvt_pk_bf16(bflo(g.y) * v0[2], bfhi(g.y) * v0[3]);
                    w.z = cvt_pk_bf16(bflo(g.z) * v1[0], bfhi(g.z) * v1[1]); w.w = cvt_pk_bf16(bflo(g.w) * v1[2], bfhi(g.w) * v1[3]);
                    *(u32x4*)(MB + (size_t)row * 1024 + col) = w; } }
    }
};
struct EpiResid {
    static constexpr bool PERM = false, AFTER_DRAIN = false, MIDHOOK = false;
    float* XL; float* XC; const float* g_lat; const float* g_ctx;
    __device__ __forceinline__ void operator()(const f32x4 (&acc)[2][2][4][2], const Unit& u, int wr, int wc, int fr, int fq) const {
        const bool isc = (u.pm == 0);
        float* base = isc ? XC : (XL - (size_t)NCTX * D); const float* gv = isc ? g_ctx : g_lat;
        const int row0 = u.pm * BM + wr * 64 + fr, col0 = u.pn * BM + wc * 32 + 4 * fq;
#pragma unroll
        for (int ai = 0; ai < 2; ++ai)
#pragma unroll
            for (int m = 0; m < 4; ++m) { float* rowp = base + (size_t)(row0 + ai * HALF + m * 16) * D + col0;
#pragma unroll
                for (int bj = 0; bj < 2; ++bj)
#pragma unroll
                    for (int n = 0; n < 2; ++n) { float* pp = rowp + bj * HALF + n * 16; const f32x4 g = *(const f32x4*)(gv + col0 + bj * HALF + n * 16);
                        f32x4 x = *(const f32x4*)pp; x += g * acc[ai][bj][m][n]; *(f32x4*)pp = x; } }
    }
};
struct ExpertOrder {
    int G, c, nnt, nmt;
    __device__ __forceinline__ bool next(int i, Unit& u) const { const int L = i * G + c; if (L >= NE * nmt * nnt) return false; const int e = L / (nmt * nnt), rem = L % (nmt * nnt); u.pm = e * 9 + rem % nmt; u.pn = e * nnt + rem / nmt; return true; }
    __device__ __forceinline__ void a_ready(const Unit&) const {}
    __device__ __forceinline__ void done(const Unit&) const {}
};
struct EpiSwiGlu {
    static constexpr bool PERM = true, AFTER_DRAIN = false, MIDHOOK = false;
    bf16_t* HID;
    __device__ __forceinline__ void operator()(const f32x4 (&acc)[2][2][4][2], const Unit& u, int wr, int wc, int fr, int fq) const {
        const int row0 = u.pm * BM + wr * 64 + fr, col0 = (u.pn & 7) * 128 + wc * 32 + 8 * fq;
#pragma unroll
        for (int ai = 0; ai < 2; ++ai)
#pragma unroll
            for (int m = 0; m < 4; ++m) { const f32x4 g0 = acc[ai][0][m][0], g1 = acc[ai][0][m][1], u0 = acc[ai][1][m][0], u1 = acc[ai][1][m][1];
                u32x4 w;
                w.x = cvt_pk_bf16(silu_f(g0[0]) * u0[0], silu_f(g0[1]) * u0[1]); w.y = cvt_pk_bf16(silu_f(g0[2]) * u0[2], silu_f(g0[3]) * u0[3]);
                w.z = cvt_pk_bf16(silu_f(g1[0]) * u1[0], silu_f(g1[1]) * u1[1]); w.w = cvt_pk_bf16(silu_f(g1[2]) * u1[2], silu_f(g1[3]) * u1[3]);
                *(u32x4*)(HID + (size_t)(row0 + ai * HALF + m * 16) * 1024 + col0) = w; }
    }
};
struct EpiDown {
    static constexpr bool PERM = true, AFTER_DRAIN = false, MIDHOOK = false;
    bf16_t* YE; const float* gsel;
    __device__ __forceinline__ void operator()(const f32x4 (&acc)[2][2][4][2], const Unit& u, int wr, int wc, int fr, int fq) const {
        const int row0 = u.pm * BM + wr * 64 + fr, col0 = (u.pn & 3) * BM + wc * 32 + 8 * fq;
#pragma unroll
        for (int ai = 0; ai < 2; ++ai)
#pragma unroll
            for (int m = 0; m < 4; ++m) { const int row = row0 + ai * HALF + m * 16; const float gs = gsel[row];
#pragma unroll
                for (int bj = 0; bj < 2; ++bj) { const f32x4 v0 = acc[ai][bj][m][0] * gs, v1 = acc[ai][bj][m][1] * gs;
                    u32x4 w; w.x = cvt_pk_bf16(v0[0], v0[1]); w.y = cvt_pk_bf16(v0[2], v0[3]); w.z = cvt_pk_bf16(v1[0], v1[1]); w.w = cvt_pk_bf16(v1[2], v1[3]);
                    *(u32x4*)(YE + (size_t)row * 1024 + col0 + bj * HALF) = w; } }
    }
};
}
#define XB_TMO      128
#define XB_XCNT(j)  (256  + 64 * (j))
#define XB_XSUB(j)  (1280 + 64 * (j))
#define XB_XGEN(j)  (2304 + 64 * (j))
#define XB_TOP      3328
#define XB_TOPGEN   3392
#define XCD_BAR_WORDS 3456
#define XB_SPIN_CAP (1u << 18)
#define LAS __attribute__((address_space(3)))

__device__ __forceinline__ unsigned xb_ld(unsigned* p)              { return __hip_atomic_load(p, __ATOMIC_RELAXED, __HIP_MEMORY_SCOPE_AGENT); }
__device__ __forceinline__ unsigned xb_add(unsigned* p, unsigned v) { return __hip_atomic_fetch_add(p, v, __ATOMIC_RELAXED, __HIP_MEMORY_SCOPE_AGENT); }
__device__ __forceinline__ unsigned xb_xcc_id() { return (unsigned)__builtin_amdgcn_s_getreg((3 << 11) | 20) & 0xFu; }
#define XB_SPIN(cond, bar) do { unsigned _sp = 0; while (cond) { __builtin_amdgcn_s_sleep(1); \
    if ((++_sp & 255u) == 0u) { if (xb_ld(&(bar)[XB_TMO])) break; if (_sp > XB_SPIN_CAP) { atomicAdd(&(bar)[XB_TMO], 1u); break; } } } } while (0)

struct XcdBarrier {
    unsigned* bar; unsigned x;
    volatile LAS unsigned* st;
};

__device__ __forceinline__ XcdBarrier xcd_barrier_post(unsigned* bar, volatile LAS unsigned* st) {
    XcdBarrier b; b.bar = bar; b.x = xb_xcc_id(); b.st = st;
    if (threadIdx.x == 0) (void)xb_add(&bar[XB_XCNT(b.x)], 1u);
    return b;
}
__device__ __forceinline__ void xcd_barrier_complete(unsigned* bar, unsigned x, unsigned& nloc, unsigned& nx) {
    const unsigned G = gridDim.x * gridDim.y * gridDim.z;
    unsigned sum, cnt, mine, sp = 0u;
    for (;;) {
        sum = 0u; cnt = 0u; mine = 0u;
#pragma unroll
        for (unsigned j = 0; j < 16; ++j) { const unsigned c = xb_ld(&bar[XB_XCNT(j)]); sum += c; cnt += (c > 0u) ? 1u : 0u; mine = (j == x) ? c : mine; }
        if (sum == G) break;
        __builtin_amdgcn_s_sleep(1);
        if ((++sp & 255u) == 0u) { if (xb_ld(&bar[XB_TMO])) break; if (sp > XB_SPIN_CAP) { atomicAdd(&bar[XB_TMO], 1u); break; } }
    }
    nloc = mine > 0u ? mine : 1u; nx = cnt > 0u ? cnt : 1u;
}

__device__ __forceinline__ void xcd_barrier(const XcdBarrier& b) {
    asm volatile("s_waitcnt vmcnt(0)" ::: "memory");
    __syncthreads();
    if (threadIdx.x == 0) {
        unsigned* bar = b.bar;
        __builtin_amdgcn_s_waitcnt(0);
        unsigned nloc = b.st[0], nx = b.st[1];
        if (nloc == 0u) { xcd_barrier_complete(bar, b.x, nloc, nx); b.st[0] = nloc; b.st[1] = nx; }
        const unsigned old = xb_add(&bar[XB_XSUB(b.x)], 1u);
        const unsigned gen = old / nloc;
        if (old + 1u == (gen + 1u) * nloc) {
            __builtin_amdgcn_fence(__ATOMIC_RELEASE, "agent");
            asm volatile("s_waitcnt vmcnt(0)" ::: "memory");
            const unsigned og = xb_add(&bar[XB_TOP], 1u);
            const unsigned tg = og / nx;
            if (og + 1u == (tg + 1u) * nx) xb_add(&bar[XB_TOPGEN], 1u);
            else XB_SPIN(xb_ld(&bar[XB_TOPGEN]) == tg, bar);
            __builtin_amdgcn_fence(__ATOMIC_ACQUIRE, "agent");
            xb_add(&bar[XB_XGEN(b.x)], 1u);
            asm volatile("s_waitcnt vmcnt(0)" ::: "memory");
        } else {
            XB_SPIN(xb_ld(&bar[XB_XGEN(b.x)]) == gen, bar);
            __builtin_amdgcn_fence(__ATOMIC_ACQUIRE, "agent");
            asm volatile("s_waitcnt vmcnt(0)" ::: "memory");
        }
    }
    __syncthreads();
}


struct P {
    const float *x, *c, *ctx, *c_ctx, *w_mod, *b_mod, *norm1_g, *norm2_g, *w_in, *lam_re, *lam_im, *log_dt, *b_re, *b_im, *c_re, *c_im, *s5_d, *w_glu, *b_glu,
        *conv_w, *conv_b, *a_log, *dt_bias, *ssd_d, *ssd_norm_g, *sink, *w_branch, *w_out, *w_router, *w_eg, *w_eu, *w_ed, *final_g;
    float* XL;
    float *MOD, *XC, *DT, *S5E, *S5H, *YD, *PM, *AFFT, *GSEL;
    bf16 *WIN, *WGLU, *WBR, *WOUT, *WUP, *WDN, *H, *PROJ, *XE, *HID, *CV, *SA, *Y3, *MB, *YE;
    int *IDX, *INV;
    int tid, lane, wave, bid, G;
};


constexpr int PTAB_OFF = LDS_BYTES - 1024;
__device__ __forceinline__ unsigned long long ld_tab(volatile LAS unsigned* t, int k) {
    const unsigned lo = __builtin_amdgcn_readfirstlane(t[2 * k]), hi = __builtin_amdgcn_readfirstlane(t[2 * k + 1]);
    return ((unsigned long long)hi << 32) | lo;
}
__device__ __forceinline__ void build_P(P& p, LAS unsigned char* lds, int wset = 0) {
    int tid_l = threadIdx.x, bid_l = blockIdx.x, g_l = gridDim.x;
    asm volatile("" : "+v"(tid_l), "+s"(bid_l), "+s"(g_l));
    p.tid = tid_l; p.lane = p.tid & 63; p.wave = __builtin_amdgcn_readfirstlane(p.tid >> 6); p.bid = bid_l; p.G = g_l;
    unsigned tbase = (unsigned)(size_t)(lds + PTAB_OFF); asm volatile("" : "+v"(tbase));
    volatile LAS unsigned* tb = (volatile LAS unsigned*)(size_t)tbase;
#define INP(k) ((const float*)ld_tab(tb, k))
    p.x = INP(0); p.c = INP(1); p.ctx = INP(2); p.c_ctx = INP(3); p.w_mod = INP(4); p.b_mod = INP(5); p.norm1_g = INP(6); p.norm2_g = INP(7);
    p.w_in = INP(8); p.lam_re = INP(9); p.lam_im = INP(10); p.log_dt = INP(11); p.b_re = INP(12); p.b_im = INP(13); p.c_re = INP(14); p.c_im = INP(15);
    p.s5_d = INP(16); p.w_glu = INP(17); p.b_glu = INP(18); p.conv_w = INP(19); p.conv_b = INP(20); p.a_log = INP(21); p.dt_bias = INP(22); p.ssd_d = INP(23);
    p.ssd_norm_g = INP(24); p.sink = INP(25); p.w_branch = INP(26); p.w_out = INP(27); p.w_router = INP(28); p.w_eg = INP(29); p.w_eu = INP(30); p.w_ed = INP(31);
    p.final_g = INP(32);
#undef INP
    p.XL = (float*)ld_tab(tb, 33);
    unsigned char* ws = (unsigned char*)ld_tab(tb, 34);
    p.MOD = (float*)(ws + WS_MOD); p.XC = (float*)(ws + WS_XC); p.DT = (float*)(ws + WS_DT); p.S5E = (float*)(ws + WS_S5E); p.S5H = (float*)(ws + WS_S5H); p.YD = (float*)(ws + WS_YD);
    p.PM = (float*)(ws + WS_PM); p.AFFT = (float*)(ws + WS_AFFT); p.GSEL = (float*)(ws + WS_GSEL);
    { unsigned char* wb = ws + (wset ? (WS_W2 - WS_WIN) : 0);
      p.WIN = (bf16*)(wb + WS_WIN); p.WGLU = (bf16*)(wb + WS_WGLU); p.WBR = (bf16*)(wb + WS_WBR); p.WOUT = (bf16*)(wb + WS_WOUT); p.WUP = (bf16*)(wb + WS_WUP); p.WDN = (bf16*)(wb + WS_WDN); }
    p.H = (bf16*)(ws + WS_H); p.PROJ = (bf16*)(ws + WS_PROJ); p.XE = (bf16*)(ws + WS_XE); p.HID = (bf16*)(ws + WS_HID); p.CV = (bf16*)(ws + WS_CV); p.SA = (bf16*)(ws + WS_SA);
    p.Y3 = (bf16*)(ws + WS_Y3); p.MB = (bf16*)(ws + WS_MB); p.YE = (bf16*)(ws + WS_YE);
    p.IDX = (int*)(ws + WS_IDX); p.INV = (int*)(ws + WS_INV);
}
__device__ __forceinline__ void phase_mod(const P& p, LAS unsigned char* lds, float* ropet) {
    for (int i = p.bid * NTHR + p.tid; i < 256 * 16; i += p.G * NTHR) { const float inv = exp2f(-(float)(i & 15) * 0.83048202372184058696f);
        float sn, cs; sincosf((float)(i >> 4) * inv, &sn, &cs); ropet[i] = cs; ropet[4096 + i] = sn; }
    LAS float* sc = (LAS float*)lds;
    LAS float* part = sc + 2048;
    for (int i = p.tid; i < 1024; i += NTHR) { sc[i] = silu_f(p.c[i]); sc[1024 + i] = silu_f(p.c_ctx[i]); }
    __syncthreads();
    for (int it = p.bid; it < DEPTH * 48; it += p.G) {
        const int l = it / 48, cb = it % 48, c0 = cb * 128 + 2 * p.lane;
        const float* W = p.w_mod + (size_t)l * 1024 * 6144 + c0;
        float a00 = 0.f, a01 = 0.f, a10 = 0.f, a11 = 0.f;
        const int kb = p.wave * 128;
#pragma unroll 8
        for (int k = kb; k < kb + 128; ++k) { const float2 w = *(const float2*)(W + (size_t)k * 6144); const float s0 = sc[k], s1 = sc[1024 + k];
            a00 += s0 * w.x; a01 += s0 * w.y; a10 += s1 * w.x; a11 += s1 * w.y; }
        part[(p.wave * 2 + 0) * 128 + 2 * p.lane] = a00; part[(p.wave * 2 + 0) * 128 + 2 * p.lane + 1] = a01;
        part[(p.wave * 2 + 1) * 128 + 2 * p.lane] = a10; part[(p.wave * 2 + 1) * 128 + 2 * p.lane + 1] = a11;
        __syncthreads();
        if (p.tid < 256) { const int s = p.tid >> 7, col = p.tid & 127; float r = p.b_mod[l * 6144 + cb * 128 + col];
#pragma unroll
            for (int w = 0; w < 8; ++w) r += part[(w * 2 + s) * 128 + col];
            p.MOD[(size_t)(l * 2 + s) * 6144 + cb * 128 + col] = r; }
        __syncthreads();
    }
}

__device__ __forceinline__ void tr_item(const float* src, int ldw, int K, bf16* dst, int kb, LAS float* scr, int lane) {
    const int k0 = 64 * kb, kr = lane >> 4, nq = lane & 15;
    f32x4 v[16];
#pragma unroll
    for (int i = 0; i < 16; ++i) v[i] = *(const f32x4*)(src + (size_t)(k0 + 4 * i + kr) * ldw + 4 * nq);
#pragma unroll
    for (int i = 0; i < 16; ++i) { const int k = 4 * i + kr, c = (k >> 3) & 7; *(LAS f32x4*)(scr + k * 64 + 4 * (nq ^ c)) = v[i]; }
    LDS_FENCE();
    const int c = lane & 7;
#pragma unroll
    for (int j = 0; j < 8; ++j) { const int n = (lane >> 3) + 8 * j; const LAS float* s = scr + (8 * c) * 64 + (n ^ (c << 2));
        u32x4 o; o.x = pk2(s[0 * 64], s[1 * 64]); o.y = pk2(s[2 * 64], s[3 * 64]); o.z = pk2(s[4 * 64], s[5 * 64]); o.w = pk2(s[6 * 64], s[7 * 64]);
        *(u32x4*)(dst + (size_t)n * K + k0 + 8 * c) = o; }
    LDS_FENCE();
}
__device__ __forceinline__ void convert_weights(const P& p, int l, LAS unsigned char* lds, int gw, int NGW) {
    LAS float* scr = (LAS float*)(lds + p.wave * 16384);
    constexpr int I_A = 32 * 16, I_B = 60 * 16, I_GLU = 8 * 8, I_BR = 3 * 16 * 8, I_OUT = 16 * 16, I_E = 16 * 16 * 16;
    constexpr int NIT = I_A + I_B + I_GLU + I_BR + I_OUT + 3 * I_E;
    const float* win = p.w_in + (size_t)l * 1024 * IN_W;
    for (int it = gw; it < NIT; it += NGW) {
        int r = it;
        if (r < I_A) { const int nb = r >> 4, kb = r & 15; tr_item(win + 64 * nb, IN_W, 1024, p.WIN + (size_t)(64 * nb) * 1024, kb, scr, p.lane); continue; } r -= I_A;
        if (r < I_B) { const int nb = r >> 4, kb = r & 15; tr_item(win + 2064 + 64 * nb, IN_W, 1024, p.WIN + (size_t)(2048 + 64 * nb) * 1024, kb, scr, p.lane); continue; } r -= I_B;
        if (r < I_GLU) { const int nb = r >> 3, kb = r & 7; tr_item(p.w_glu + (size_t)l * 512 * 512 + 64 * nb, 512, 512, p.WGLU + (size_t)(64 * nb) * 512, kb, scr, p.lane); continue; } r -= I_GLU;
        if (r < I_BR) { const int kk = r >> 7, nb = (r >> 3) & 15, kb = r & 7;
            tr_item(p.w_branch + ((size_t)l * 3 + kk) * 512 * 1024 + 64 * nb, 1024, 1536, p.WBR + (size_t)(64 * nb) * 1536 + kk * 512, kb, scr, p.lane); continue; } r -= I_BR;
        if (r < I_OUT) { const int nb = r >> 4, kb = r & 15; tr_item(p.w_out + (size_t)l * 1024 * 1024 + 64 * nb, 1024, 1024, p.WOUT + (size_t)(64 * nb) * 1024, kb, scr, p.lane); continue; } r -= I_OUT;
        const int which = r / I_E; r -= which * I_E;
        const int e = r >> 8, nb = (r >> 4) & 15, kb = r & 15;
        const size_t eo = ((size_t)l * NE + e) * 1024 * 1024;
        if (which == 0) tr_item(p.w_eg + eo + 64 * nb, 1024, 1024, p.WUP + (size_t)(e * 2048 + 256 * (nb >> 1) + 64 * (nb & 1)) * 1024, kb, scr, p.lane);
        else if (which == 1) tr_item(p.w_eu + eo + 64 * nb, 1024, 1024, p.WUP + (size_t)(e * 2048 + 256 * (nb >> 1) + 128 + 64 * (nb & 1)) * 1024, kb, scr, p.lane);
        else tr_item(p.w_ed + eo + 64 * nb, 1024, 1024, p.WDN + (size_t)(e * 1024 + 64 * nb) * 1024, kb, scr, p.lane);
    }
}

__device__ __forceinline__ float reduce16(float (&a)[16], int lane) {
    float b[8], c[4], d[2];
#pragma unroll
    for (int j = 0; j < 8; ++j) { const bool hi = lane & 32; const float send = hi ? a[j] : a[j + 8], keep = hi ? a[j + 8] : a[j]; b[j] = keep + __shfl_xor(send, 32); }
#pragma unroll
    for (int j = 0; j < 4; ++j) { const bool hi = lane & 16; const float send = hi ? b[j] : b[j + 4], keep = hi ? b[j + 4] : b[j]; c[j] = keep + __shfl_xor(send, 16); }
#pragma unroll
    for (int j = 0; j < 2; ++j) { const bool hi = lane & 8; const float send = hi ? c[j] : c[j + 2], keep = hi ? c[j + 2] : c[j]; d[j] = keep + __shfl_xor(send, 8); }
    const bool hi = lane & 4; const float send = hi ? d[0] : d[1], keep = hi ? d[1] : d[0];
    float r = keep + __shfl_xor(send, 4);
    r += __shfl_xor(r, 2); r += __shfl_xor(r, 1);
    return r;
}
template <int MODE> __device__ __forceinline__ void row_pass(const P& p, int l, LAS unsigned char* lds, bool with_ctx = true, bool dry = false) {
    LAS float* W16 = (LAS float*)lds;
    if (MODE != 2) {
        const float* src = (MODE == 0) ? (p.w_in + (size_t)l * 1024 * IN_W + 2048) : (p.w_router + (size_t)l * 1024 * 16);
        const int ld = (MODE == 0) ? IN_W : 16;
        for (int i = p.tid; i < 1024 * 16; i += NTHR) { const int k = i >> 4, j = i & 15; const int rr = (k & 7) * 128 + ((k >> 3) & 63) + 64 * (k >> 9); W16[rr * 20 + j] = src[(size_t)k * ld + j]; }
        __syncthreads();
    }
    const int gw = p.bid * NWAVES + p.wave, NGW = p.G * NWAVES, lane = p.lane;
    for (int row = gw + ((MODE == 2 || !with_ctx) ? NCTX : 0); row < T; row += NGW) {
        const bool isc = row < NCTX;
        float* xrow = isc ? (p.XC + (size_t)row * D) : (p.XL + (size_t)(row - NCTX) * D);
        float v[16];
        { const float* s = (MODE == 0 && l == 0) ? (isc ? (p.ctx + (size_t)row * D) : (p.x + (size_t)(row - NCTX) * D)) : xrow;
#pragma unroll
          for (int i = 0; i < 2; ++i) { const f32x4 a = *(const f32x4*)(s + 512 * i + 8 * lane), b = *(const f32x4*)(s + 512 * i + 8 * lane + 4);
              v[8 * i] = a[0]; v[8 * i + 1] = a[1]; v[8 * i + 2] = a[2]; v[8 * i + 3] = a[3]; v[8 * i + 4] = b[0]; v[8 * i + 5] = b[1]; v[8 * i + 6] = b[2]; v[8 * i + 7] = b[3]; } }
        if ((MODE == 0 && l > 0) || MODE == 2) {
            const int lp = (MODE == 2) ? (DEPTH - 1) : (l - 1);
            const float* g2 = p.MOD + (size_t)(lp * 2 + (isc ? 1 : 0)) * 6144 + 5 * D;
            float s[16];
#pragma unroll
            for (int i = 0; i < 16; ++i) s[i] = 0.f;
            for (int e = 0; e < NE; ++e) { const int slot = p.INV[(size_t)row * 16 + e];
                if (slot >= 0) { const bf16* yr = p.YE + ((size_t)e * ESLOTS + slot) * D;
#pragma unroll
                    for (int i = 0; i < 2; ++i) { const u32x4 w = *(const u32x4*)(yr + 512 * i + 8 * lane);
                        s[8 * i] += bflo(w.x); s[8 * i + 1] += bfhi(w.x); s[8 * i + 2] += bflo(w.y); s[8 * i + 3] += bfhi(w.y);
                        s[8 * i + 4] += bflo(w.z); s[8 * i + 5] += bfhi(w.z); s[8 * i + 6] += bflo(w.w); s[8 * i + 7] += bfhi(w.w); } } }
#pragma unroll
            for (int i = 0; i < 2; ++i) { const f32x4 a = *(const f32x4*)(g2 + 512 * i + 8 * lane), b = *(const f32x4*)(g2 + 512 * i + 8 * lane + 4);
#pragma unroll
                for (int q = 0; q < 4; ++q) { v[8 * i + q] += a[q] * s[8 * i + q]; v[8 * i + 4 + q] += b[q] * s[8 * i + 4 + q]; } }
        }
        if (MODE == 0 && !dry) {
#pragma unroll
            for (int i = 0; i < 2; ++i) { *(f32x4*)(xrow + 512 * i + 8 * lane) = (f32x4){v[8 * i], v[8 * i + 1], v[8 * i + 2], v[8 * i + 3]};
                *(f32x4*)(xrow + 512 * i + 8 * lane + 4) = (f32x4){v[8 * i + 4], v[8 * i + 5], v[8 * i + 6], v[8 * i + 7]}; }
        }
        float ss = 0.f;
#pragma unroll
        for (int i = 0; i < 16; ++i) ss += v[i] * v[i];
        const float rstd = rsqrtf(wsum(ss) * (1.f / D) + EPS);
        if (MODE == 2) {
#pragma unroll
            for (int i = 0; i < 2; ++i) { const f32x4 a = *(const f32x4*)(p.final_g + 512 * i + 8 * lane), b = *(const f32x4*)(p.final_g + 512 * i + 8 * lane + 4);
                *(f32x4*)(xrow + 512 * i + 8 * lane) = (f32x4){v[8 * i] * rstd * a[0], v[8 * i + 1] * rstd * a[1], v[8 * i + 2] * rstd * a[2], v[8 * i + 3] * rstd * a[3]};
                *(f32x4*)(xrow + 512 * i + 8 * lane + 4) = (f32x4){v[8 * i + 4] * rstd * b[0], v[8 * i + 5] * rstd * b[1], v[8 * i + 6] * rstd * b[2], v[8 * i + 7] * rstd * b[3]}; }
            continue;
        }
        const float* gam = (MODE == 0 ? p.norm1_g : p.norm2_g) + (size_t)l * D;
        const float* md = p.MOD + (size_t)(l * 2 + (isc ? 1 : 0)) * 6144 + (MODE == 0 ? 0 : 3 * D);
        bf16* hrow = p.H + (size_t)row * D;
        float acc[16];
#pragma unroll
        for (int j = 0; j < 16; ++j) acc[j] = 0.f;
#pragma unroll
        for (int i = 0; i < 2; ++i) {
            float hv[8];
            { const int k0 = 512 * i + 8 * lane;
              const f32x4 ga = *(const f32x4*)(gam + k0), gb = *(const f32x4*)(gam + k0 + 4), sa = *(const f32x4*)(md + D + k0), sb = *(const f32x4*)(md + D + k0 + 4), ha = *(const f32x4*)(md + k0), hb = *(const f32x4*)(md + k0 + 4);
#pragma unroll
              for (int q = 0; q < 4; ++q) { hv[q] = v[8 * i + q] * rstd * ga[q] * (1.f + sa[q]) + ha[q]; hv[4 + q] = v[8 * i + 4 + q] * rstd * gb[q] * (1.f + sb[q]) + hb[q]; }
              u32x4 o; o.x = pk2(hv[0], hv[1]); o.y = pk2(hv[2], hv[3]); o.z = pk2(hv[4], hv[5]); o.w = pk2(hv[6], hv[7]);
              *(u32x4*)(hrow + k0) = o; }
#pragma unroll
            for (int j = 0; j < 8; ++j) { const LAS f32x4* wr = (const LAS f32x4*)(W16 + (j * 128 + lane + 64 * i) * 20);
                const f32x4 w0 = wr[0], w1 = wr[1], w2 = wr[2], w3 = wr[3]; const float h = hv[j];
                acc[0] += h * w0[0]; acc[1] += h * w0[1]; acc[2] += h * w0[2]; acc[3] += h * w0[3];
                acc[4] += h * w1[0]; acc[5] += h * w1[1]; acc[6] += h * w1[2]; acc[7] += h * w1[3];
                acc[8] += h * w2[0]; acc[9] += h * w2[1]; acc[10] += h * w2[2]; acc[11] += h * w2[3];
                acc[12] += h * w3[0]; acc[13] += h * w3[1]; acc[14] += h * w3[2]; acc[15] += h * w3[3];
                if (j & 1) asm volatile("" ::: "memory"); }
        }
        const float tot = reduce16(acc, lane);
        const int col = ((lane >> 5) & 1) * 8 + ((lane >> 4) & 1) * 4 + ((lane >> 3) & 1) * 2 + ((lane >> 2) & 1);
        if (MODE == 0) {
            if ((lane & 3) == 0) p.DT[(size_t)row * 16 + col] = softplus_f(tot + p.dt_bias[l * 16 + col]);
        } else {
            float mx = tot;
            mx = fmaxf(mx, __shfl_xor(mx, 4)); mx = fmaxf(mx, __shfl_xor(mx, 8)); mx = fmaxf(mx, __shfl_xor(mx, 16)); mx = fmaxf(mx, __shfl_xor(mx, 32));
            const float e = expf(tot - mx); float sum = e;
            sum += __shfl_xor(sum, 4); sum += __shfl_xor(sum, 8); sum += __shfl_xor(sum, 16); sum += __shfl_xor(sum, 32);
            if ((lane & 3) == 0) p.AFFT[(size_t)col * T + row] = e / sum;
        }
    }
}

struct S5Lane { float abr, abi; float bbr[16], bbi[16]; };
__device__ __forceinline__ void s5_lane_params(const P& p, int l, int d, int g, int lane, S5Lane& o, bool withB) {
    const size_t gi = ((size_t)(l * 2 + d) * 32 + g);
    const float lr = p.lam_re[gi * 64 + lane], li = p.lam_im[gi * 64 + lane], dt = expf(p.log_dt[gi]);
    const float mag = expf(lr * dt); float sn, cs; sincosf(li * dt, &sn, &cs);
    o.abr = mag * cs; o.abi = mag * sn;
    if (withB) {
        const float den = lr * lr + li * li;
        const float fr = ((o.abr - 1.f) * lr + o.abi * li) / den, fi = (o.abi * lr - (o.abr - 1.f) * li) / den;
        const f32x4* br = (const f32x4*)(p.b_re + (gi * 64 + lane) * 16); const f32x4* bi = (const f32x4*)(p.b_im + (gi * 64 + lane) * 16);
#pragma unroll
        for (int q = 0; q < 4; ++q) { const f32x4 r4 = br[q], i4 = bi[q];
#pragma unroll
            for (int j = 0; j < 4; ++j) { o.bbr[4 * q + j] = fr * r4[j] - fi * i4[j]; o.bbi[4 * q + j] = fr * i4[j] + fi * r4[j]; } }
    }
}
__device__ __forceinline__ void s5_stage_u(const P& p, int r0, int g, LAS unsigned char* ub, int lane) {
#pragma unroll
    for (int j = 0; j < 4; ++j) { const int q = lane + 64 * j, i = q >> 1, half = q & 1;
        const u32x4 w = *(const u32x4*)(p.PROJ + (size_t)(r0 + i) * PJ + U0 + g * 16 + half * 8);
        *(LAS u32x4*)(ub + i * 32 + half * 16) = w; }
    LDS_FENCE();
}
__device__ __forceinline__ void s5_step(const S5Lane& s, const LAS unsigned char* ub, int i, float& hr, float& hi) {
    const u32x4 a = *(const LAS u32x4*)(ub + i * 32), b = *(const LAS u32x4*)(ub + i * 32 + 16);
    float u[16];
    u[0] = bflo(a.x); u[1] = bfhi(a.x); u[2] = bflo(a.y); u[3] = bfhi(a.y); u[4] = bflo(a.z); u[5] = bfhi(a.z); u[6] = bflo(a.w); u[7] = bfhi(a.w);
    u[8] = bflo(b.x); u[9] = bfhi(b.x); u[10] = bflo(b.y); u[11] = bfhi(b.y); u[12] = bflo(b.z); u[13] = bfhi(b.z); u[14] = bflo(b.w); u[15] = bfhi(b.w);
    float br = 0.f, bi = 0.f;
#pragma unroll
    for (int k = 0; k < 16; ++k) { br += s.bbr[k] * u[k]; bi += s.bbi[k] * u[k]; }
    const float nr = s.abr * hr - s.abi * hi + br, ni = s.abr * hi + s.abi * hr + bi;
    hr = nr; hi = ni;
}

__device__ __forceinline__ void phase_premix(const P& p, int l, LAS unsigned char* lds) {
    const float* cw = p.conv_w + (size_t)l * 5 * 1024; const float* cb = p.conv_b + (size_t)l * 1024;
    for (int idx = p.bid * NTHR + p.tid; idx < T * 128; idx += p.G * NTHR) {
        const int row = idx >> 7, c8 = (idx & 127) * 8;
        const int lo = row < NCTX ? 0 : NCTX, hi = row < NCTX ? NCTX : T;
        float a[8];
        { const f32x4 b0 = *(const f32x4*)(cb + c8), b1 = *(const f32x4*)(cb + c8 + 4);
          a[0] = b0[0]; a[1] = b0[1]; a[2] = b0[2]; a[3] = b0[3]; a[4] = b1[0]; a[5] = b1[1]; a[6] = b1[2]; a[7] = b1[3]; }
#pragma unroll
        for (int j = 0; j < 5; ++j) { const int r = row + j - 2;
            if (r >= lo && r < hi) { const u32x4 xv = *(const u32x4*)(p.PROJ + (size_t)r * PJ + XB0 + c8);
                const f32x4 w0 = *(const f32x4*)(cw + j * 1024 + c8), w1 = *(const f32x4*)(cw + j * 1024 + c8 + 4);
                a[0] += w0[0] * bflo(xv.x); a[1] += w0[1] * bfhi(xv.x); a[2] += w0[2] * bflo(xv.y); a[3] += w0[3] * bfhi(xv.y);
                a[4] += w1[0] * bflo(xv.z); a[5] += w1[1] * bfhi(xv.z); a[6] += w1[2] * bflo(xv.w); a[7] += w1[3] * bfhi(xv.w); } }
        u32x4 o; o.x = pk2(silu_f(a[0]), silu_f(a[1])); o.y = pk2(silu_f(a[2]), silu_f(a[3])); o.z = pk2(silu_f(a[4]), silu_f(a[5])); o.w = pk2(silu_f(a[6]), silu_f(a[7]));
        *(u32x4*)(p.CV + (size_t)row * 1024 + c8) = o;
    }

}

__device__ __forceinline__ void ssd_scan_naive(const P& p, int l) {
    for (int it = p.bid * 4 + p.wave; it < 1024; it += p.G * 4) {
        const int d = it >> 9, hd = (it >> 6) & 7, pp = it & 63, grp = hd >> 2;
        const float a = -expf(p.a_log[l * 16 + d * 8 + hd]);
        const int colB = 512 + grp * 128 + p.lane, colC = 768 + grp * 128 + p.lane, colX = hd * 64 + pp, dcol = d * 8 + hd;
        float h0 = 0.f, h1 = 0.f;
        for (int s0 = 0; s0 < T; s0 += 8) {
            unsigned b0[8], b1[8], c0[8], c1[8], xx[8]; float dtv[8]; int rr[8];
#pragma unroll
            for (int j = 0; j < 8; ++j) { const int r = scan_row(d, s0 + j); rr[j] = r; const bf16* cv = p.CV + (size_t)r * 1024;
                b0[j] = cv[colB]; b1[j] = cv[colB + 64]; c0[j] = cv[colC]; c1[j] = cv[colC + 64]; xx[j] = cv[colX]; dtv[j] = p.DT[(size_t)r * 16 + dcol]; }
#pragma unroll
            for (int j = 0; j < 8; ++j) { const float dec = expf(dtv[j] * a), dx = dtv[j] * bf2f(xx[j]);
                h0 = dec * h0 + dx * bf2f(b0[j]); h1 = dec * h1 + dx * bf2f(b1[j]);
                const float y = wsum(bf2f(c0[j]) * h0 + bf2f(c1[j]) * h1);
                if (p.lane == 0) p.YD[((size_t)d * T + rr[j]) * 512 + colX] = y; }
        }
    }
}
__device__ __forceinline__ void s5_carry_scan(const P& p, int l, int aw, int NAW) {
    for (int it = aw; it < 64; it += NAW) {
        const int d = it >> 5, g = it & 31;
        S5Lane s; s5_lane_params(p, l, d, g, p.lane, s, false);
        float ar = s.abr, ai = s.abi;
#pragma unroll
        for (int q = 0; q < 7; ++q) { const float nr = ar * ar - ai * ai, ni = 2.f * ar * ai; ar = nr; ai = ni; }
        float hr = 0.f, hi = 0.f;
        const float* E = p.S5E + (size_t)(d * 32 + g) * NCH * 128; float* Hn = p.S5H + (size_t)(d * 32 + g) * NCH * 128;
        for (int c = 0; c < NCH; ++c) { Hn[c * 128 + p.lane] = hr; Hn[c * 128 + 64 + p.lane] = hi;
            const float er = E[c * 128 + p.lane], ei = E[c * 128 + 64 + p.lane];
            const float nr = ar * hr - ai * hi + er, ni = ar * hi + ai * hr + ei; hr = nr; hi = ni; }
    }
}
__device__ __forceinline__ void attention_naive(const P& p, int l, int aw, int NAW, LAS float* pbuf) {
    const int lane = p.lane;
    for (int it = aw; it < T * 8; it += NAW) {
        const int row = it >> 3, hq = it & 7, kvh = hq >> 2;
        const bool isc = row < NCTX; const int t = row - NCTX;
        const int jlo = isc ? 0 : (t - 128 < 0 ? 0 : t - 128), jhi = isc ? -1 : (t + 128 > NLAT - 1 ? NLAT - 1 : t + 128);
        const int nloc = jhi - jlo + 1, nk = nloc + NCTX;
        const float sink = p.sink[l * 8 + hq];
        float q[64];
        { const u32x4* qp = (const u32x4*)(p.PROJ + (size_t)row * PJ + Q0 + hq * 64);
#pragma unroll
          for (int c = 0; c < 8; ++c) { const u32x4 w = qp[c]; q[8 * c] = bflo(w.x); q[8 * c + 1] = bfhi(w.x); q[8 * c + 2] = bflo(w.y); q[8 * c + 3] = bfhi(w.y);
              q[8 * c + 4] = bflo(w.z); q[8 * c + 5] = bfhi(w.z); q[8 * c + 6] = bflo(w.w); q[8 * c + 7] = bfhi(w.w); } }
        float sc[9]; float mx = sink;
#pragma unroll
        for (int i = 0; i < 9; ++i) { const int kk = lane + 64 * i; float s = -INFINITY;
            if (kk < nk) { const int krow = kk < nloc ? NCTX + jlo + kk : kk - nloc;
                const u32x4* kp = (const u32x4*)(p.PROJ + (size_t)krow * PJ + K0 + kvh * 64); float dot = 0.f;
#pragma unroll
                for (int c = 0; c < 8; ++c) { const u32x4 w = kp[c];
                    dot += q[8 * c] * bflo(w.x) + q[8 * c + 1] * bfhi(w.x) + q[8 * c + 2] * bflo(w.y) + q[8 * c + 3] * bfhi(w.y)
                         + q[8 * c + 4] * bflo(w.z) + q[8 * c + 5] * bfhi(w.z) + q[8 * c + 6] * bflo(w.w) + q[8 * c + 7] * bfhi(w.w); }
                s = dot * 0.125f; }
            sc[i] = s; mx = fmaxf(mx, s); }
        mx = wmaxf(mx);
        float sum = 0.f;
#pragma unroll
        for (int i = 0; i < 9; ++i) { const int kk = lane + 64 * i; const float e = (kk < nk) ? expf(sc[i] - mx) : 0.f; pbuf[kk] = e; sum += e; }
        const float den = wsum(sum) + expf(sink - mx);
        LDS_FENCE();
        float o = 0.f;
        const bf16* vb = p.PROJ + V0 + kvh * 64 + lane;
#pragma unroll 4
        for (int kk = 0; kk < nk; ++kk) { const int vrow = kk < nloc ? NCTX + jlo + kk : kk - nloc; o += pbuf[kk] * bf2f(vb[(size_t)vrow * PJ]); }
        p.Y3[((size_t)2 * T + row) * 512 + hq * 64 + lane] = (bf16)f2bf(o / den);
        LDS_FENCE();
    }
}

__device__ __forceinline__ void phase_postmix(const P& p, int l, LAS unsigned char* lds) {
    constexpr int CSH_BYTES = 2 * 2 * 16 * 68 * 4, WREG = 16640;
    LAS float* Csh = (LAS float*)lds;
    LAS unsigned char* wreg = lds + CSH_BYTES + p.wave * WREG;
    LAS unsigned char* ub = wreg;
    LAS float* Hb = (LAS float*)(wreg + 4096);
    LAS float* Yb = (LAS float*)(wreg + 4096 + 4224);
    const int lane = p.lane;
    for (int it = p.bid; it < 32 * 17; it += p.G) {
        const int g = it / 17, chunk = (it % 17) * 8 + p.wave;
        __syncthreads();
        for (int i = p.tid; i < 2 * 2 * 16 * 64; i += NTHR) { const int pq = i & 63, k = (i >> 6) & 15, ri = (i >> 10) & 1, d = i >> 11;
            const float* src = ri ? p.c_im : p.c_re; Csh[((d * 2 + ri) * 16 + k) * 68 + pq] = src[(((size_t)(l * 2 + d) * 32 + g) * 16 + k) * 64 + pq]; }
        __syncthreads();
        if (chunk < NCH) {
            const int r0 = 128 * chunk;
            s5_stage_u(p, r0, g, ub, lane);
            for (int d = 0; d < 2; ++d) {
                S5Lane s; s5_lane_params(p, l, d, g, lane, s, true);
                const int cs = (d == 0) ? chunk : (chunk < 2 ? 1 - chunk : NCH + 1 - chunk);
                const float* Hn = p.S5H + ((size_t)(d * 32 + g) * NCH + cs) * 128;
                float hr = Hn[lane], hi = Hn[64 + lane];
                const LAS float* Cr = Csh + (d * 2 + 0) * 16 * 68; const LAS float* Ci = Csh + (d * 2 + 1) * 16 * 68;
                for (int sub = 0; sub < 16; ++sub) {
#pragma unroll
                    for (int j = 0; j < 8; ++j) { const int is = sub * 8 + j; s5_step(s, ub, d == 0 ? is : 127 - is, hr, hi); Hb[j * 132 + lane] = hr; Hb[j * 132 + 64 + lane] = hi; }
                    LDS_FENCE();
#pragma unroll
                    for (int m = 0; m < 2; ++m) { const int o = lane + 64 * m, j = o >> 4, k = o & 15; float y = 0.f;
#pragma unroll
                        for (int q = 0; q < 16; ++q) { const f32x4 cr = *(const LAS f32x4*)(Cr + k * 68 + 4 * q), ci = *(const LAS f32x4*)(Ci + k * 68 + 4 * q);
                            const f32x4 xr = *(const LAS f32x4*)(Hb + j * 132 + 4 * q), xi = *(const LAS f32x4*)(Hb + j * 132 + 64 + 4 * q);
                            y += cr[0] * xr[0] + cr[1] * xr[1] + cr[2] * xr[2] + cr[3] * xr[3] - ci[0] * xi[0] - ci[1] * xi[1] - ci[2] * xi[2] - ci[3] * xi[3]; }
                        const int is = sub * 8 + j, i = (d == 0) ? is : 127 - is;
                        if (d == 0) Yb[i * 16 + k] = y; else Yb[i * 16 + k] += y; }
                    LDS_FENCE();
                }
            }
            const float* dsk = p.s5_d + (size_t)l * 512 + g * 16;
#pragma unroll
            for (int m = 0; m < 2; ++m) { const int i = lane + 64 * m;
                const u32x4 ua = *(const LAS u32x4*)(ub + i * 32), ubv = *(const LAS u32x4*)(ub + i * 32 + 16);
                float u[16];
                u[0] = bflo(ua.x); u[1] = bfhi(ua.x); u[2] = bflo(ua.y); u[3] = bfhi(ua.y); u[4] = bflo(ua.z); u[5] = bfhi(ua.z); u[6] = bflo(ua.w); u[7] = bfhi(ua.w);
                u[8] = bflo(ubv.x); u[9] = bfhi(ubv.x); u[10] = bflo(ubv.y); u[11] = bfhi(ubv.y); u[12] = bflo(ubv.z); u[13] = bfhi(ubv.z); u[14] = bflo(ubv.w); u[15] = bfhi(ubv.w);
                float a[16];
#pragma unroll
                for (int k = 0; k < 16; ++k) a[k] = gelu_tanh_f(Yb[i * 16 + k] + dsk[k] * u[k]);
                u32x4 o0, o1; o0.x = pk2(a[0], a[1]); o0.y = pk2(a[2], a[3]); o0.z = pk2(a[4], a[5]); o0.w = pk2(a[6], a[7]);
                o1.x = pk2(a[8], a[9]); o1.y = pk2(a[10], a[11]); o1.z = pk2(a[12], a[13]); o1.w = pk2(a[14], a[15]);
                bf16* dst = p.SA + (size_t)(r0 + i) * 512 + g * 16;
                *(u32x4*)dst = o0; *(u32x4*)(dst + 8) = o1; }
            LDS_FENCE();
        }
    }
}

__device__ __forceinline__ void phase_select(const P& p, LAS unsigned char* lds, bool with_ctx) {
    LAS unsigned* keys = (LAS unsigned*)lds;
    LAS unsigned* hist = keys + 16384;
    LAS unsigned* misc = hist + 256;
    const int tid = p.tid, lane = p.lane, wave = p.wave;
    for (int it = p.bid; it < (with_ctx ? 32 : 16); it += p.G) {
        const int set = it >> 4, e = it & 15;
        const int n = set ? NCTX : NLAT, cap = set ? CAP_C : CAP_L, row0 = set ? 0 : NCTX, slot0 = set ? CAP_L : 0;
        const float* src = p.AFFT + (size_t)e * T + row0;
        __syncthreads();
        for (int i = tid; i < n; i += NTHR) keys[i] = __float_as_uint(src[i]);
        unsigned prefix = 0u, mask = 0u, need = (unsigned)cap;
        for (int pass = 3; pass >= 0; --pass) {
            if (tid < 256) hist[tid] = 0u;
            __syncthreads();
            for (int i = tid; i < n; i += NTHR) { const unsigned k = keys[i]; if ((k & mask) == prefix) __hip_atomic_fetch_add(&hist[(k >> (8 * pass)) & 255u], 1u, __ATOMIC_RELAXED, __HIP_MEMORY_SCOPE_WORKGROUP); }
            __syncthreads();
            if (wave == 0) {
                const unsigned h0 = hist[4 * lane], h1 = hist[4 * lane + 1], h2 = hist[4 * lane + 2], h3 = hist[4 * lane + 3];
                const unsigned c = h0 + h1 + h2 + h3; unsigned S = c;
#pragma unroll
                for (int o = 1; o < 64; o <<= 1) { const unsigned t = __shfl_down(S, o); if (lane + o < 64) S += t; }
                const unsigned Snext = S - c;
                if (S >= need && Snext < need) { unsigned rem = need - Snext; unsigned bin;
                    if (h3 >= rem) bin = 3; else { rem -= h3; if (h2 >= rem) bin = 2; else { rem -= h2; if (h1 >= rem) bin = 1; else { rem -= h1; bin = 0; } } }
                    misc[0] = 4 * lane + bin; misc[1] = rem; }
            }
            __syncthreads();
            prefix |= misc[0] << (8 * pass); mask |= 0xFFu << (8 * pass); need = misc[1];
            __syncthreads();
        }
        unsigned selbase = 0u, eqbase = 0u;
        for (int base = 0; base < n; base += NTHR) {
            const int i = base + tid; const bool valid = i < n; const unsigned k = valid ? keys[i] : 0u;
            const bool eq = valid && k == prefix, gt = valid && k > prefix;
            const unsigned long long lt = (1ull << lane) - 1ull;
            const unsigned long long be = __ballot(eq);
            if (lane == 0) misc[8 + wave] = (unsigned)__popcll(be);
            __syncthreads();
            unsigned woff = 0u, tot = 0u;
#pragma unroll
            for (int w = 0; w < 8; ++w) { const unsigned v = misc[8 + w]; woff += (w < wave) ? v : 0u; tot += v; }
            const unsigned eqrank = eqbase + woff + (unsigned)__popcll(be & lt);
            const bool sel = gt || (eq && eqrank < need);
            const unsigned long long bs = __ballot(sel);
            if (lane == 0) misc[16 + wave] = (unsigned)__popcll(bs);
            __syncthreads();
            unsigned woff2 = 0u, tot2 = 0u;
#pragma unroll
            for (int w = 0; w < 8; ++w) { const unsigned v = misc[16 + w]; woff2 += (w < wave) ? v : 0u; tot2 += v; }
            if (valid) { const int row = row0 + i;
                if (sel) { const int slot = slot0 + (int)(selbase + woff2 + (unsigned)__popcll(bs & lt));
                    p.IDX[e * ESLOTS + slot] = row; p.GSEL[e * ESLOTS + slot] = __uint_as_float(k); p.INV[(size_t)row * 16 + e] = slot; }
                else p.INV[(size_t)row * 16 + e] = -1; }
            selbase += tot2; eqbase += tot;
            __syncthreads();
        }
    }
}
__device__ __forceinline__ void phase_gather(const P& p, bool with_ctx) {
    const int gw = p.bid * NWAVES + p.wave, NGW = p.G * NWAVES, lane = p.lane;
    for (int idx = gw; idx < NE * ESLOTS; idx += NGW) {
        const int slot = idx % ESLOTS; const bool valid = slot < CAP_L + (with_ctx ? CAP_C : 0);
        u32x4 a = (u32x4){0u, 0u, 0u, 0u}, b = a;
        if (valid) { const int row = p.IDX[idx]; const u32x4* s = (const u32x4*)(p.H + (size_t)row * D); a = s[lane]; b = s[64 + lane]; }
        else if (lane == 0) p.GSEL[idx] = 0.f;
        u32x4* dst = (u32x4*)(p.XE + (size_t)idx * D); dst[lane] = a; dst[64 + lane] = b;
    }
}

typedef short bf16x8 __attribute__((ext_vector_type(8)));
#define MFMA16(a, b, c) __builtin_amdgcn_mfma_f32_16x16x32_bf16((a), (b), (c), 0, 0, 0)
constexpr int LDP = 272;
constexpr int LDQ = 144;
__device__ __forceinline__ bf16x8 ld_frag(const LAS unsigned char* base, int row, int kcol, int ldb) { return *(const LAS bf16x8*)(base + row * ldb + kcol * 2); }
typedef short s16x4_t __attribute__((ext_vector_type(4)));
__device__ __forceinline__ bf16x8 tr_frag(const LAS unsigned char* img, int k0, int col0, int sb, int lane) {
    const int g = lane >> 4, q = (lane & 15) >> 2, pp = lane & 3;
    const LAS unsigned char* a = img + (k0 + 8 * g + q) * sb + (col0 + 4 * pp) * 2;
    const s16x4_t r0 = __builtin_amdgcn_ds_read_tr16_b64_v4i16((LAS s16x4_t*)a), r1 = __builtin_amdgcn_ds_read_tr16_b64_v4i16((LAS s16x4_t*)(a + 4 * sb));
    return (bf16x8){r0[0], r0[1], r0[2], r0[3], r1[0], r1[1], r1[2], r1[3]};
}
constexpr int SB64 = 144, SB128 = 304, SB256 = 560;
__device__ __forceinline__ void st_b16(LAS unsigned char* p, unsigned v) { *(LAS unsigned short*)p = (unsigned short)v; }
__device__ __forceinline__ float wscan_incl(float v, int lane) {
#pragma unroll
    for (int o = 1; o < 64; o <<= 1) { const float t = __shfl_up(v, o); if (lane >= o) v += t; }
    return v;
}
__device__ __forceinline__ int chunk_r0(int d, int cs) { return d == 0 ? 128 * cs : (cs < 2 ? 128 * (1 - cs) : 128 * (NCH + 1 - cs)); }
__device__ __forceinline__ int scan_chunk_of(int d, int cn) { return d == 0 ? cn : (cn < 2 ? 1 - cn : NCH + 1 - cn); }

__device__ __forceinline__ void ssd_acum(const float* DT, int r0, int d, int col, float a, int lane, LAS float* acum, LAS float* dtv, float& total) {
    const int j0 = d == 0 ? lane : 127 - lane, j1 = d == 0 ? 64 + lane : 63 - lane;
    const float dt0 = DT[(size_t)(r0 + j0) * 16 + col], dt1 = DT[(size_t)(r0 + j1) * 16 + col];
    const float s0 = wscan_incl(dt0 * a, lane); const float t0 = __shfl(s0, 63);
    const float s1 = wscan_incl(dt1 * a, lane) + t0; total = __shfl(s1, 63);
    acum[j0] = s0; acum[j1] = s1; dtv[j0] = dt0; dtv[j1] = dt1;
}

__device__ __forceinline__ void ssd_states(const P& p, int l, LAS unsigned char* lds, float* SST, float* DEC) {
    LAS unsigned char* Bi = lds;
    LAS unsigned char* Xi = lds + 128 * SB128;
    LAS float* wj = (LAS float*)(lds + 128 * SB128 + 128 * SB256);
    const int tid = p.tid, lane = p.lane, wave = p.wave, quad = lane >> 4, l15 = lane & 15;
    for (int u = p.bid; u < 2 * NCH * 2; u += p.G) {
        const int d = u / (2 * NCH), cs = (u % (2 * NCH)) >> 1, g = u & 1;
        const int r0 = chunk_r0(d, cs);
        __syncthreads();
        if (wave < 4) { const int h = g * 4 + wave; const float a = -expf(p.a_log[l * 16 + d * 8 + h]); float total;
            LAS float* ac = wj + 512 + wave * 128; LAS float* dv = wj + 1024 + wave * 128;
            ssd_acum(p.DT, r0, d, d * 8 + h, a, lane, ac, dv, total);
            LDS_FENCE();
            wj[wave * 128 + lane] = __expf(total - ac[lane]) * dv[lane]; wj[wave * 128 + 64 + lane] = __expf(total - ac[64 + lane]) * dv[64 + lane];
            if (lane == 0) DEC[(d * NCH + cs) * 8 + h] = expf(total); }
        for (int idx = tid; idx < 128 * 16; idx += NTHR) { const int j = idx >> 4, n8 = (idx & 15) * 8;
            *(LAS u32x4*)(Bi + j * SB128 + n8 * 2) = *(const u32x4*)(p.CV + (size_t)(r0 + j) * 1024 + 512 + g * 128 + n8); }
        __syncthreads();
        for (int idx = tid; idx < 128 * 32; idx += NTHR) { const int j = idx >> 5, c8 = (idx & 31) * 8;
            const u32x4 v = *(const u32x4*)(p.CV + (size_t)(r0 + j) * 1024 + g * 256 + c8); const float w = wj[(c8 >> 6) * 128 + j];
            u32x4 o; o.x = pk2(bflo(v.x) * w, bfhi(v.x) * w); o.y = pk2(bflo(v.y) * w, bfhi(v.y) * w); o.z = pk2(bflo(v.z) * w, bfhi(v.z) * w); o.w = pk2(bflo(v.w) * w, bfhi(v.w) * w);
            *(LAS u32x4*)(Xi + j * SB256 + c8 * 2) = o; }
        __syncthreads();
        const int hh = wave >> 1, ph = wave & 1;
        f32x4 acc[2][8];
#pragma unroll
        for (int a = 0; a < 2; ++a)
#pragma unroll
            for (int b = 0; b < 8; ++b) acc[a][b] = (f32x4){0.f, 0.f, 0.f, 0.f};
#pragma unroll
        for (int ks = 0; ks < 4; ++ks) {
            bf16x8 af[2];
#pragma unroll
            for (int pt = 0; pt < 2; ++pt) af[pt] = tr_frag(Xi, 32 * ks, hh * 64 + ph * 32 + pt * 16, SB256, lane);
#pragma unroll
            for (int nt = 0; nt < 8; ++nt) { const bf16x8 bfr = tr_frag(Bi, 32 * ks, nt * 16, SB128, lane);
#pragma unroll
                for (int pt = 0; pt < 2; ++pt) acc[pt][nt] = MFMA16(af[pt], bfr, acc[pt][nt]); }
        }
        float* S = SST + ((size_t)(d * NCH + cs) * 8 + g * 4 + hh) * 8192;
#pragma unroll
        for (int pt = 0; pt < 2; ++pt)
#pragma unroll
            for (int nt = 0; nt < 8; ++nt)
#pragma unroll
                for (int r = 0; r < 4; ++r) S[(ph * 32 + pt * 16 + 4 * quad + r) * 128 + nt * 16 + l15] = acc[pt][nt][r];
    }
}

__device__ __forceinline__ void scan_carries(const P& p, int l, const float* SST, const float* DEC, bf16* HIN) {
    for (int e = p.bid * NTHR + p.tid; e < 2 * 8 * 8192; e += p.G * NTHR) {
        const int d = e >> 16, h = (e >> 13) & 7, pn = e & 8191;
        float hs = 0.f;
        for (int c0 = 0; c0 < NCH; c0 += 10) {
            float s[10], dc[10];
#pragma unroll
            for (int j = 0; j < 10; ++j) { const size_t ci = (size_t)(d * NCH + c0 + j) * 8 + h; s[j] = SST[ci * 8192 + pn]; dc[j] = DEC[ci]; }
#pragma unroll
            for (int j = 0; j < 10; ++j) { const size_t ci = (size_t)(d * NCH + c0 + j) * 8 + h; HIN[ci * 8192 + pn] = (bf16)f2bf(hs); hs = hs * dc[j] + s[j]; }
        }
    }
    for (int e = p.bid * NTHR + p.tid; e < 2 * 32 * 64; e += p.G * NTHR) {
        const int d = e >> 11, g = (e >> 6) & 31, pq = e & 63;
        S5Lane s; s5_lane_params(p, l, d, g, pq, s, false);
        float ar = s.abr, ai = s.abi;
#pragma unroll
        for (int q = 0; q < 7; ++q) { const float nr = ar * ar - ai * ai, ni = 2.f * ar * ai; ar = nr; ai = ni; }
        float hr = 0.f, hi = 0.f;
        const float* E = p.S5E + (size_t)(d * 32 + g) * NCH * 128 + pq; float* Hn = p.S5H + (size_t)(d * 32 + g) * NCH * 128 + pq;
        for (int c0 = 0; c0 < NCH; c0 += 10) {
            float er[10], ei[10];
#pragma unroll
            for (int j = 0; j < 10; ++j) { er[j] = E[(c0 + j) * 128]; ei[j] = E[(c0 + j) * 128 + 64]; }
#pragma unroll
            for (int j = 0; j < 10; ++j) { Hn[(c0 + j) * 128] = hr; Hn[(c0 + j) * 128 + 64] = hi;
                const float nr = ar * hr - ai * hi + er[j], ni = ar * hi + ai * hr + ei[j]; hr = nr; hi = ni; }
        }
    }
}

__device__ __forceinline__ void ssd_outputs(const P& p, int l, LAS unsigned char* lds, const bf16* HIN, const float* SST, bf16* YS, int u_begin, int u_end, int first, int stride) {
    LAS unsigned char* Cm = lds;
    LAS unsigned char* Bm = lds + 128 * LDP;
    LAS unsigned char* XT = lds + 2 * 128 * LDP;
    LAS unsigned char* Wm = lds + 2 * 128 * LDP + 128 * SB64;
    LAS float* sm = (LAS float*)(lds + 3 * 128 * LDP + 128 * SB64);
    const int tid = p.tid, lane = p.lane, wave = p.wave, quad = lane >> 4, l15 = lane & 15;
    for (int u = u_begin + first; u < u_end; u += stride) {
        const int cn = u >> 3, h = u & 7, g = h >> 2, r0 = 128 * cn;
        __syncthreads();
        if (wave < 2) { const int d = wave; const float a = -expf(p.a_log[l * 16 + d * 8 + h]); float total;
            ssd_acum(p.DT, r0, d, d * 8 + h, a, lane, sm + d * 128, sm + 256 + d * 128, total); }
        for (int idx = tid; idx < 128 * 16; idx += NTHR) { const int j = idx >> 4, n8 = (idx & 15) * 8;
            const bf16* src = p.CV + (size_t)(r0 + j) * 1024 + g * 128 + n8;
            *(LAS u32x4*)(Bm + j * LDP + n8 * 2) = *(const u32x4*)(src + 512); *(LAS u32x4*)(Cm + j * LDP + n8 * 2) = *(const u32x4*)(src + 768); }
        for (int idx = tid; idx < 128 * 8; idx += NTHR) { const int j = idx >> 3, p8 = (idx & 7) * 8;
            *(LAS u32x4*)(XT + j * SB64 + p8 * 2) = *(const u32x4*)(p.CV + (size_t)(r0 + j) * 1024 + h * 64 + p8); }
        __syncthreads();
        f32x4 G[8];
#pragma unroll
        for (int jt = 0; jt < 8; ++jt) G[jt] = (f32x4){0.f, 0.f, 0.f, 0.f};
#pragma unroll
        for (int ks = 0; ks < 4; ++ks) { const bf16x8 af = ld_frag(Cm, 16 * wave + l15, ks * 32 + 8 * quad, LDP);
#pragma unroll
            for (int jt = 0; jt < 8; ++jt) G[jt] = MFMA16(af, ld_frag(Bm, 16 * jt + l15, ks * 32 + 8 * quad, LDP), G[jt]); }
        __syncthreads();
        for (int idx = tid; idx < 2 * 64 * 16; idx += NTHR) { const int d = idx >> 10, pp = (idx >> 4) & 63, n8 = (idx & 15) * 8;
            const int cs = scan_chunk_of(d, cn);
            u32x4 w;
            if (cn >= 2) w = *(const u32x4*)(HIN + ((size_t)(d * NCH + cs) * 8 + h) * 8192 + pp * 128 + n8);
            else if (cs == 0) w = (u32x4){0u, 0u, 0u, 0u};
            else { const float* s = SST + ((size_t)(d * NCH) * 8 + h) * 8192 + pp * 128 + n8; const f32x4 s0 = *(const f32x4*)s, s1 = *(const f32x4*)(s + 4);
                w.x = pk2(s0[0], s0[1]); w.y = pk2(s0[2], s0[3]); w.z = pk2(s1[0], s1[1]); w.w = pk2(s1[2], s1[3]); }
            *(LAS u32x4*)(Bm + (d * 64 + pp) * LDP + n8 * 2) = w; }
        __syncthreads();
        f32x4 Y[4];
#pragma unroll
        for (int pt = 0; pt < 4; ++pt) Y[pt] = (f32x4){0.f, 0.f, 0.f, 0.f};
#pragma unroll
        for (int d = 0; d < 2; ++d) {
            const LAS float* ac = sm + d * 128; const LAS float* dv = sm + 256 + d * 128;
            float ai[4];
#pragma unroll
            for (int r = 0; r < 4; ++r) ai[r] = ac[16 * wave + 4 * quad + r];
#pragma unroll
            for (int jt = 0; jt < 8; ++jt) { const int j = 16 * jt + l15; const float aj = ac[j], dj = dv[j];
#pragma unroll
                for (int r = 0; r < 4; ++r) { const int i = 16 * wave + 4 * quad + r; const bool valid = (d == 0) ? (j <= i) : (j >= i);
                    const float w = valid ? G[jt][r] * __expf(ai[r] - aj) * dj : 0.f;
                    st_b16(Wm + i * LDP + 2 * j, f2bf(w)); } }
            LDS_FENCE();
            f32x4 Y2[4];
#pragma unroll
            for (int pt = 0; pt < 4; ++pt) Y2[pt] = (f32x4){0.f, 0.f, 0.f, 0.f};
#pragma unroll
            for (int ks = 0; ks < 4; ++ks) { const bf16x8 wf = ld_frag(Wm, 16 * wave + l15, ks * 32 + 8 * quad, LDP), cf = ld_frag(Cm, 16 * wave + l15, ks * 32 + 8 * quad, LDP);
#pragma unroll
                for (int pt = 0; pt < 4; ++pt) { Y[pt] = MFMA16(wf, tr_frag(XT, 32 * ks, 16 * pt, SB64, lane), Y[pt]);
                    Y2[pt] = MFMA16(cf, ld_frag(Bm + d * 64 * LDP, 16 * pt + l15, ks * 32 + 8 * quad, LDP), Y2[pt]); } }
#pragma unroll
            for (int r = 0; r < 4; ++r) { const float ea = __expf(ai[r]);
#pragma unroll
                for (int pt = 0; pt < 4; ++pt) Y[pt][r] += ea * Y2[pt][r]; }
            LDS_FENCE();
        }
#pragma unroll
        for (int pt = 0; pt < 4; ++pt)
#pragma unroll
            for (int r = 0; r < 4; ++r) YS[(size_t)(r0 + 16 * wave + 4 * quad + r) * 512 + h * 64 + 16 * pt + l15] = (bf16)f2bf(Y[pt][r]);
    }
}

__device__ __forceinline__ void ssd_gated_norm(const P& p, int l, const bf16* YS) {
    const int gw = p.bid * NWAVES + p.wave, NGW = p.G * NWAVES, lane = p.lane;
    for (int row = gw; row < T; row += NGW) {
        const int ch = lane * 8;
        const float dsk = p.ssd_d[l * 8 + (ch >> 6)];
        const u32x4 yv = *(const u32x4*)(YS + (size_t)row * 512 + ch);
        const u32x4 xs = *(const u32x4*)(p.CV + (size_t)row * 1024 + ch), zz = *(const u32x4*)(p.PROJ + (size_t)row * PJ + Z0 + ch);
        float v[8];
        v[0] = (bflo(yv.x) + dsk * bflo(xs.x)) * silu_f(bflo(zz.x)); v[1] = (bfhi(yv.x) + dsk * bfhi(xs.x)) * silu_f(bfhi(zz.x));
        v[2] = (bflo(yv.y) + dsk * bflo(xs.y)) * silu_f(bflo(zz.y)); v[3] = (bfhi(yv.y) + dsk * bfhi(xs.y)) * silu_f(bfhi(zz.y));
        v[4] = (bflo(yv.z) + dsk * bflo(xs.z)) * silu_f(bflo(zz.z)); v[5] = (bfhi(yv.z) + dsk * bfhi(xs.z)) * silu_f(bfhi(zz.z));
        v[6] = (bflo(yv.w) + dsk * bflo(xs.w)) * silu_f(bflo(zz.w)); v[7] = (bfhi(yv.w) + dsk * bfhi(xs.w)) * silu_f(bfhi(zz.w));
        float ss = 0.f;
#pragma unroll
        for (int i = 0; i < 8; ++i) ss += v[i] * v[i];
        const float rstd = rsqrtf(wsum(ss) * (1.f / 512.f) + EPS);
        const float* ng = p.ssd_norm_g + (size_t)l * 512 + ch;
        const f32x4 g0 = *(const f32x4*)ng, g1 = *(const f32x4*)(ng + 4);
        u32x4 o; o.x = pk2(v[0] * rstd * g0[0], v[1] * rstd * g0[1]); o.y = pk2(v[2] * rstd * g0[2], v[3] * rstd * g0[3]);
        o.z = pk2(v[4] * rstd * g1[0], v[5] * rstd * g1[1]); o.w = pk2(v[6] * rstd * g1[2], v[7] * rstd * g1[3]);
        *(u32x4*)(p.Y3 + (size_t)row * 1536 + 512 + ch) = o;
    }
}

__device__ __forceinline__ void attention_mfma(const P& p, int l, LAS unsigned char* lds, int u_begin, int u_end, int u_first, int u_stride) {
    LAS unsigned char* Kt = lds;
    LAS unsigned char* VT = lds + 64 * LDQ;
    LAS unsigned char* Pw = lds + 2 * 64 * LDQ + p.wave * 64 * LDQ;
    const int tid = p.tid, lane = p.lane, wave = p.wave, quad = lane >> 4, l15 = lane & 15;
    const float C2 = 0.125f * 1.4426950408889634f;
    for (int u = u_begin + u_first; u < u_end; u += u_stride) {
        const int qb = u >> 1, kvh = u & 1, hq = kvh * 4 + (wave >> 1);
        const bool isc = qb < 2; const int nb = qb - 2;
        const int qrow0 = 128 * qb + 64 * (wave & 1);
        bf16x8 Qf[4][2];
#pragma unroll
        for (int qt = 0; qt < 4; ++qt)
#pragma unroll
            for (int ks = 0; ks < 2; ++ks) Qf[qt][ks] = *(const bf16x8*)(p.PROJ + (size_t)(qrow0 + 16 * qt + l15) * PJ + Q0 + hq * 64 + ks * 32 + 8 * quad);
        f32x4 O[4][4];
#pragma unroll
        for (int a = 0; a < 4; ++a)
#pragma unroll
            for (int b = 0; b < 4; ++b) O[a][b] = (f32x4){0.f, 0.f, 0.f, 0.f};
        float mrow[4], lrow[4];
        const float sk = p.sink[l * 8 + hq] * 1.4426950408889634f;
#pragma unroll
        for (int qt = 0; qt < 4; ++qt) { mrow[qt] = sk; lrow[qt] = 1.f; }
        const int ntile = isc ? 4 : 10;
#define ATT_VALID(ti_) (isc || (ti_) >= 6 || ((NCTX + 128 * (nb - 1) + 64 * (ti_)) >= NCTX && (NCTX + 128 * (nb - 1) + 64 * (ti_)) < T))
#define ATT_KROW0(ti_) ((isc || (ti_) >= 6) ? 64 * (isc ? (ti_) : (ti_) - 6) : NCTX + 128 * (nb - 1) + 64 * (ti_))
        int ti = 0; while (!ATT_VALID(ti)) ++ti;
        u32x4 kreg, vreg;
        { const bf16* src = p.PROJ + (size_t)(ATT_KROW0(ti) + (tid >> 3)) * PJ + kvh * 64 + (tid & 7) * 8; kreg = *(const u32x4*)(src + K0); vreg = *(const u32x4*)(src + V0); }
        while (ti < ntile) {
            const int krow0 = ATT_KROW0(ti); const bool local = !(isc || ti >= 6);
            int tn = ti + 1; while (tn < ntile && !ATT_VALID(tn)) ++tn;
            __syncthreads();
            { const int key = tid >> 3, pc = tid & 7;
              *(LAS u32x4*)(Kt + key * LDQ + pc * 16) = kreg;
              *(LAS u32x4*)(VT + key * SB64 + pc * 16) = vreg; }
            __syncthreads();
            if (tn < ntile) { const bf16* src = p.PROJ + (size_t)(ATT_KROW0(tn) + (tid >> 3)) * PJ + kvh * 64 + (tid & 7) * 8; kreg = *(const u32x4*)(src + K0); vreg = *(const u32x4*)(src + V0); }
            const bool need_mask = local && (ti < 2 || ti > 3);
#pragma unroll
            for (int qt = 0; qt < 4; ++qt) {
                f32x4 S[4][1];
#pragma unroll
                for (int kt = 0; kt < 4; ++kt) S[kt][0] = (f32x4){0.f, 0.f, 0.f, 0.f};
#pragma unroll
                for (int ks = 0; ks < 2; ++ks)
#pragma unroll
                    for (int kt = 0; kt < 4; ++kt) S[kt][0] = MFMA16(ld_frag(Kt, 16 * kt + l15, ks * 32 + 8 * quad, LDQ), Qf[qt][ks], S[kt][0]);
                const int tq = qrow0 + 16 * qt + l15;
                float mx = -1e30f;
                if (need_mask) {
#pragma unroll
                    for (int kt = 0; kt < 4; ++kt)
#pragma unroll
                        for (int r = 0; r < 4; ++r) { const int df = tq - (krow0 + 16 * kt + 4 * quad + r);
                            const float s = (df <= 128 && df >= -128) ? S[kt][0][r] : -1e30f; S[kt][0][r] = s; mx = fmaxf(mx, s); }
                } else {
#pragma unroll
                    for (int kt = 0; kt < 4; ++kt) mx = fmaxf(fmaxf(mx, fmaxf(S[kt][0][0], S[kt][0][1])), fmaxf(S[kt][0][2], S[kt][0][3]));
                }
                mx = fmaxf(mx, __shfl_xor(mx, 16)); mx = fmaxf(mx, __shfl_xor(mx, 32));
                const float mn = fmaxf(mrow[qt], mx * C2), alpha = __builtin_amdgcn_exp2f(mrow[qt] - mn);
                float ls = 0.f;
#pragma unroll
                for (int kt = 0; kt < 4; ++kt) { const float e0 = __builtin_amdgcn_exp2f(S[kt][0][0] * C2 - mn), e1 = __builtin_amdgcn_exp2f(S[kt][0][1] * C2 - mn),
                                                              e2 = __builtin_amdgcn_exp2f(S[kt][0][2] * C2 - mn), e3 = __builtin_amdgcn_exp2f(S[kt][0][3] * C2 - mn);
                    ls += (e0 + e1) + (e2 + e3);
                    u32x2 w; w.x = pk2(e0, e1); w.y = pk2(e2, e3);
                    *(LAS u32x2*)(Pw + (16 * qt + l15) * LDQ + (16 * kt + 4 * quad) * 2) = w; }
                ls += __shfl_xor(ls, 16); ls += __shfl_xor(ls, 32);
                lrow[qt] = lrow[qt] * alpha + ls; mrow[qt] = mn;
#pragma unroll
                for (int dt = 0; dt < 4; ++dt) O[dt][qt] *= alpha;
            }
            LDS_FENCE();
#pragma unroll
            for (int ks = 0; ks < 2; ++ks) {
                bf16x8 pf[4];
#pragma unroll
                for (int qt = 0; qt < 4; ++qt) pf[qt] = ld_frag(Pw, 16 * qt + l15, ks * 32 + 8 * quad, LDQ);
#pragma unroll
                for (int dt = 0; dt < 4; ++dt) { const bf16x8 vf = tr_frag(VT, 32 * ks, 16 * dt, SB64, lane);
#pragma unroll
                    for (int qt = 0; qt < 4; ++qt) O[dt][qt] = MFMA16(vf, pf[qt], O[dt][qt]); }
            }
            LDS_FENCE();
            ti = tn;
        }
#undef ATT_VALID
#undef ATT_KROW0
#pragma unroll
        for (int qt = 0; qt < 4; ++qt) { const float inv = 1.f / lrow[qt];
            bf16* orow = p.Y3 + (size_t)(qrow0 + 16 * qt + l15) * 1536 + 1024 + hq * 64;
#pragma unroll
            for (int dt = 0; dt < 4; ++dt) { u32x2 w; w.x = pk2(O[dt][qt][0] * inv, O[dt][qt][1] * inv); w.y = pk2(O[dt][qt][2] * inv, O[dt][qt][3] * inv);
                *(u32x2*)(orow + 16 * dt + 4 * quad) = w; } }
    }
}

#ifndef S5_INTERLEAVE
#define S5_INTERLEAVE 2
#endif
constexpr size_t S5BB_ELEMS = (size_t)2 * 32 * 128 * 32, S5CC_ELEMS = (size_t)2 * 32 * 16 * 128;
__device__ __forceinline__ void s5_tables(const P& p, int l, bf16* BB, bf16* CC, float* AB) {
    for (int e = p.bid * NTHR + p.tid; e < 2 * 32 * 64; e += p.G * NTHR) {
        const int d = e >> 11, g = (e >> 6) & 31, pq = e & 63, dg = d * 32 + g;
        S5Lane s; s5_lane_params(p, l, d, g, pq, s, true);
        AB[(size_t)e * 2] = s.abr; AB[(size_t)e * 2 + 1] = s.abi;
        #if S5_INTERLEAVE
        u32x4* br = (u32x4*)(BB + ((size_t)dg * 128 + 2 * pq) * 32); u32x4* bi = (u32x4*)(BB + ((size_t)dg * 128 + 2 * pq + 1) * 32);
#else
        u32x4* br = (u32x4*)(BB + ((size_t)dg * 128 + pq) * 32); u32x4* bi = (u32x4*)(BB + ((size_t)dg * 128 + 64 + pq) * 32);
#endif
        u32x4 w;
        w.x = pk2(s.bbr[0], s.bbr[1]); w.y = pk2(s.bbr[2], s.bbr[3]); w.z = pk2(s.bbr[4], s.bbr[5]); w.w = pk2(s.bbr[6], s.bbr[7]); br[0] = w;
        w.x = pk2(s.bbr[8], s.bbr[9]); w.y = pk2(s.bbr[10], s.bbr[11]); w.z = pk2(s.bbr[12], s.bbr[13]); w.w = pk2(s.bbr[14], s.bbr[15]); br[1] = w;
        w.x = pk2(s.bbi[0], s.bbi[1]); w.y = pk2(s.bbi[2], s.bbi[3]); w.z = pk2(s.bbi[4], s.bbi[5]); w.w = pk2(s.bbi[6], s.bbi[7]); bi[0] = w;
        w.x = pk2(s.bbi[8], s.bbi[9]); w.y = pk2(s.bbi[10], s.bbi[11]); w.z = pk2(s.bbi[12], s.bbi[13]); w.w = pk2(s.bbi[14], s.bbi[15]); bi[1] = w;
        const u32x4 z = (u32x4){0u, 0u, 0u, 0u}; br[2] = z; br[3] = z; bi[2] = z; bi[3] = z;
        const size_t ci = ((size_t)(l * 2 + d) * 32 + g) * 16;
#pragma unroll
        for (int k = 0; k < 16; ++k) {
#if S5_INTERLEAVE
            *(unsigned*)(CC + ((size_t)dg * 16 + k) * 128 + 2 * pq) = pk2(p.c_re[(ci + k) * 64 + pq], -p.c_im[(ci + k) * 64 + pq]);
#else
            CC[((size_t)dg * 16 + k) * 128 + pq] = (bf16)f2bf(p.c_re[(ci + k) * 64 + pq]); CC[((size_t)dg * 16 + k) * 128 + 64 + pq] = (bf16)f2bf(-p.c_im[(ci + k) * 64 + pq]);
#endif
        }
    }
}
constexpr int S5_WREG = 4096 + 16 * 132 * 4 + 16 * LDP;
template <bool READOUT> __device__ __forceinline__ void s5_chunk_dir(int d, const bf16* BBdg, const bf16* CCdg, float abr, float abi, LAS unsigned char* wreg, int lane, float& hr, float& hi, f32x4 (&yacc)[8]) {
    const int quad = lane >> 4, l15 = lane & 15;
    LAS unsigned char* ub = wreg; LAS float* BuW = (LAS float*)(wreg + 4096); LAS unsigned char* Hw = wreg + 4096 + 16 * 132 * 4;
    bf16x8 BBf[8], CCf[4];
#pragma unroll
    for (int pt = 0; pt < 8; ++pt) BBf[pt] = *(const bf16x8*)(BBdg + (size_t)(16 * pt + l15) * 32 + 8 * quad);
    if (READOUT) {
#pragma unroll
        for (int ks = 0; ks < 4; ++ks) CCf[ks] = *(const bf16x8*)(CCdg + (size_t)l15 * 128 + ks * 32 + 8 * quad);
    }
#pragma unroll (READOUT ? 8 : 1)
    for (int ss = 0; ss < 8; ++ss) {
        const int sc = d ? 7 - ss : ss;
        bf16x8 uf = (bf16x8){0, 0, 0, 0, 0, 0, 0, 0};
        if (quad < 2) uf = *(const LAS bf16x8*)(ub + (16 * sc + l15) * 32 + quad * 16);
#pragma unroll
        for (int pt = 0; pt < 8; ++pt) { const f32x4 Dp = MFMA16(uf, BBf[pt], ((f32x4){0.f, 0.f, 0.f, 0.f}));
#pragma unroll
            for (int r = 0; r < 4; ++r) BuW[(4 * quad + r) * 132 + 16 * pt + l15] = Dp[r]; }
        LDS_FENCE();
#pragma unroll
        for (int st = 0; st < 16; ++st) { const int tl = d ? 15 - st : st;
#if S5_INTERLEAVE == 1
            typedef float f32x2_t __attribute__((ext_vector_type(2)));
            const f32x2_t bu = *(const LAS f32x2_t*)(BuW + tl * 132 + 2 * lane);
            const float nr = abr * hr - abi * hi + bu[0], ni = abr * hi + abi * hr + bu[1]; hr = nr; hi = ni;
            if (READOUT) *(LAS unsigned*)(Hw + tl * LDP + 4 * lane) = pk2(hr, hi); }
#elif S5_INTERLEAVE == 2
            const float br = BuW[tl * 132 + 2 * lane], bi = BuW[tl * 132 + 2 * lane + 1];
            const float nr = abr * hr - abi * hi + br, ni = abr * hi + abi * hr + bi; hr = nr; hi = ni;
            if (READOUT) *(LAS unsigned*)(Hw + tl * LDP + 4 * lane) = pk2(hr, hi); }
#else
            const float br = BuW[tl * 132 + lane], bi = BuW[tl * 132 + 64 + lane];
            const float nr = abr * hr - abi * hi + br, ni = abr * hi + abi * hr + bi; hr = nr; hi = ni;
            if (READOUT) { st_b16(Hw + tl * LDP + 2 * lane, f2bf(hr)); st_b16(Hw + tl * LDP + 128 + 2 * lane, f2bf(hi)); } }
#endif
        if (READOUT) {
            LDS_FENCE();
#pragma unroll
            for (int ks = 0; ks < 4; ++ks) yacc[sc] = MFMA16(ld_frag(Hw, l15, ks * 32 + 8 * quad, LDP), CCf[ks], yacc[sc]);
        }
        LDS_FENCE();
    }
}
__device__ __forceinline__ void s5_local_states(const P& p, LAS unsigned char* lds, const bf16* BB, const float* AB) {
    LAS unsigned char* wreg = lds + p.wave * S5_WREG;
    const int gw = p.bid * NWAVES + p.wave, NGW = p.G * NWAVES, lane = p.lane;
    for (int it = gw; it < 2 * 32 * NCH; it += NGW) {
        const int d = it / (32 * NCH), c = (it % (32 * NCH)) >> 5, g = it & 31, dg = d * 32 + g;
        s5_stage_u(p, chunk_r0(d, c), g, wreg, lane);
        float hr = 0.f, hi = 0.f; f32x4 dummy[8];
        const float abr = AB[((size_t)dg * 64 + lane) * 2], abi = AB[((size_t)dg * 64 + lane) * 2 + 1];
        if (d == 0) s5_chunk_dir<false>(0, BB + (size_t)dg * 128 * 32, nullptr, abr, abi, wreg, lane, hr, hi, dummy);
        else s5_chunk_dir<false>(1, BB + (size_t)dg * 128 * 32, nullptr, abr, abi, wreg, lane, hr, hi, dummy);
        float* E = p.S5E + ((size_t)dg * NCH + c) * 128;
        E[lane] = hr; E[64 + lane] = hi;
    }
}
__device__ __forceinline__ void s5_outputs(const P& p, int l, LAS unsigned char* lds, const bf16* BB, const bf16* CC, const float* AB, int it_begin, int it_end, int first, int stride) {
    LAS unsigned char* wreg = lds + p.wave * S5_WREG;
    const int lane = p.lane, quad = lane >> 4, l15 = lane & 15;
    for (int it = it_begin + first; it < it_end; it += stride) {
        const int cn = it >> 5, g = it & 31, r0 = 128 * cn;
        s5_stage_u(p, r0, g, wreg, lane);
        f32x4 yacc[8];
#pragma unroll
        for (int i = 0; i < 8; ++i) yacc[i] = (f32x4){0.f, 0.f, 0.f, 0.f};
#pragma unroll
        for (int d = 0; d < 2; ++d) { const int dg = d * 32 + g, cs = scan_chunk_of(d, cn);
            const float* Hn = (cn < 2) ? (p.S5E + (size_t)dg * NCH * 128) : (p.S5H + ((size_t)dg * NCH + cs) * 128);
            float hr = Hn[lane], hi = Hn[64 + lane];
            if (cs == 0) { hr = 0.f; hi = 0.f; }
            s5_chunk_dir<true>(d, BB + (size_t)dg * 128 * 32, CC + (size_t)dg * 16 * 128, AB[((size_t)dg * 64 + lane) * 2], AB[((size_t)dg * 64 + lane) * 2 + 1], wreg, lane, hr, hi, yacc); }
        const float dsk = p.s5_d[(size_t)l * 512 + g * 16 + l15];
#pragma unroll
        for (int sc = 0; sc < 8; ++sc)
#pragma unroll
            for (int r = 0; r < 4; ++r) { const int t = 16 * sc + 4 * quad + r;
                const float u = bf2f(*(const LAS unsigned short*)(wreg + t * 32 + 2 * l15));
                p.SA[(size_t)(r0 + t) * 512 + g * 16 + l15] = (bf16)f2bf(gelu_tanh_f(yacc[sc][r] + dsk * u)); }
        LDS_FENCE();
    }
}

template <int NT, class Epi>
__device__ __forceinline__ void small_gemm(const P& p, LAS unsigned char* lds, const bf16* A, int lda, const bf16* Bt, int ldb, int K, int kc_per_seg, const Epi& E) {
    LAS unsigned char* As = lds;
    LAS unsigned char* Bs = lds + 64 * LDP;
    const int tid = p.tid, lane = p.lane, wave = p.wave, quad = lane >> 4, l15 = lane & 15;
    f32x4 acc[NT][4], sum[NT][4];
#pragma unroll
    for (int a = 0; a < NT; ++a)
#pragma unroll
        for (int b = 0; b < 4; ++b) { acc[a][b] = (f32x4){0.f, 0.f, 0.f, 0.f}; sum[a][b] = (f32x4){0.f, 0.f, 0.f, 0.f}; }
    const int nch = K >> 7, prow = tid >> 4, pc = (tid & 15) * 8;
    u32x4 ra[2], rb[4 * NT];
#pragma unroll
    for (int i = 0; i < 2; ++i) ra[i] = *(const u32x4*)(A + (size_t)(prow + 32 * i) * lda + pc);
#pragma unroll
    for (int i = 0; i < 4 * NT; ++i) rb[i] = *(const u32x4*)(Bt + (size_t)(prow + 32 * i) * ldb + pc);
    for (int kc = 0; kc < nch; ++kc) {
        __syncthreads();
#pragma unroll
        for (int i = 0; i < 2; ++i) *(LAS u32x4*)(As + (prow + 32 * i) * LDP + pc * 2) = ra[i];
#pragma unroll
        for (int i = 0; i < 4 * NT; ++i) *(LAS u32x4*)(Bs + (prow + 32 * i) * LDP + pc * 2) = rb[i];
        __syncthreads();
        if (kc + 1 < nch) {
#pragma unroll
            for (int i = 0; i < 2; ++i) ra[i] = *(const u32x4*)(A + (size_t)(prow + 32 * i) * lda + (kc + 1) * 128 + pc);
#pragma unroll
            for (int i = 0; i < 4 * NT; ++i) rb[i] = *(const u32x4*)(Bt + (size_t)(prow + 32 * i) * ldb + (kc + 1) * 128 + pc);
        }
#pragma unroll
        for (int ks = 0; ks < 4; ++ks) {
            bf16x8 af[4];
#pragma unroll
            for (int mt = 0; mt < 4; ++mt) af[mt] = ld_frag(As, 16 * mt + l15, ks * 32 + 8 * quad, LDP);
#pragma unroll
            for (int nt = 0; nt < NT; ++nt) { const bf16x8 bfr = ld_frag(Bs, 128 * nt + 16 * wave + l15, ks * 32 + 8 * quad, LDP);
#pragma unroll
                for (int mt = 0; mt < 4; ++mt) acc[nt][mt] = MFMA16(af[mt], bfr, acc[nt][mt]); }
        }
        if ((kc + 1) % kc_per_seg == 0) E.seg(acc, sum, kc / kc_per_seg, wave, quad, l15);
    }
    E.fin(acc, sum, wave, quad, l15);
    __syncthreads();
}
struct SgMerge {
    const bf16* proj; bf16* MB; int rb, cc;
    __device__ __forceinline__ void seg(f32x4 (&acc)[1][4], f32x4 (&sum)[1][4], int s, int wave, int quad, int l15) const {
#pragma unroll
        for (int mt = 0; mt < 4; ++mt)
#pragma unroll
            for (int r = 0; r < 4; ++r) { const int row = rb * 64 + 16 * mt + 4 * quad + r, col = cc * 128 + 16 * wave + l15;
                sum[0][mt][r] += bf2f(proj[(size_t)row * PJ + GT0 + s * 1024 + col]) * acc[0][mt][r]; acc[0][mt][r] = 0.f; }
    }
    __device__ __forceinline__ void fin(f32x4 (&acc)[1][4], f32x4 (&sum)[1][4], int wave, int quad, int l15) const {
#pragma unroll
        for (int mt = 0; mt < 4; ++mt)
#pragma unroll
            for (int r = 0; r < 4; ++r) MB[(size_t)(rb * 64 + 16 * mt + 4 * quad + r) * 1024 + cc * 128 + 16 * wave + l15] = (bf16)f2bf(sum[0][mt][r]);
    }
};
struct SgResid {
    float* XC; const float* g; int rb, cc;
    __device__ __forceinline__ void seg(f32x4 (&)[1][4], f32x4 (&)[1][4], int, int, int, int) const {}
    __device__ __forceinline__ void fin(f32x4 (&acc)[1][4], f32x4 (&)[1][4], int wave, int quad, int l15) const {
        const int col = cc * 128 + 16 * wave + l15; const float gv = g[col];
#pragma unroll
        for (int mt = 0; mt < 4; ++mt)
#pragma unroll
            for (int r = 0; r < 4; ++r) { float* px = XC + (size_t)(rb * 64 + 16 * mt + 4 * quad + r) * 1024 + col; *px += gv * acc[0][mt][r]; }
    }
};
struct SgSwiGlu {
    bf16* HID; int row0, t;
    __device__ __forceinline__ void seg(f32x4 (&)[2][4], f32x4 (&)[2][4], int, int, int, int) const {}
    __device__ __forceinline__ void fin(f32x4 (&acc)[2][4], f32x4 (&)[2][4], int wave, int quad, int l15) const {
#pragma unroll
        for (int mt = 0; mt < 4; ++mt)
#pragma unroll
            for (int r = 0; r < 4; ++r) HID[(size_t)(row0 + 16 * mt + 4 * quad + r) * 1024 + 128 * t + 16 * wave + l15] = (bf16)f2bf(silu_f(acc[0][mt][r]) * acc[1][mt][r]);
    }
};
struct SgDown {
    bf16* YE; const float* gsel; int row0, cc;
    __device__ __forceinline__ void seg(f32x4 (&)[1][4], f32x4 (&)[1][4], int, int, int, int) const {}
    __device__ __forceinline__ void fin(f32x4 (&acc)[1][4], f32x4 (&)[1][4], int wave, int quad, int l15) const {
#pragma unroll
        for (int mt = 0; mt < 4; ++mt)
#pragma unroll
            for (int r = 0; r < 4; ++r) { const int row = row0 + 16 * mt + 4 * quad + r; YE[(size_t)row * 1024 + cc * 128 + 16 * wave + l15] = (bf16)f2bf(acc[0][mt][r] * gsel[row]); }
    }
};

#ifndef SKIPMASK
#define SKIPMASK 0
#endif
struct Args { const float* in[33]; float* out; unsigned char* ws; int ph_lo, ph_hi; };
static_assert(sizeof(Args) == 35 * 8 + 8, "no padding");

__global__ void __launch_bounds__(NTHR, 2) fwd_kernel(Args args) {
    extern __shared__ __attribute__((aligned(16))) unsigned char lds_raw[];
    LAS unsigned char* lds = (LAS unsigned char*)lds_raw;
    const int tid_ = threadIdx.x;
    if (tid_ == 0) {
        LAS unsigned long long* tab = (LAS unsigned long long*)(lds + PTAB_OFF);
#pragma unroll
        for (int k = 0; k < 33; ++k) tab[k] = (unsigned long long)args.in[k];
        tab[33] = (unsigned long long)args.out; tab[34] = (unsigned long long)args.ws;
    }
    volatile LAS unsigned* MISC = (volatile LAS unsigned*)(lds + MISC_OFF);
    if (tid_ < 64) MISC[tid_] = 0u;
    __syncthreads();
    XcdBarrier bar; bar.bar = (unsigned*)(args.ws + WS_CTL) + CW_BAR; bar.x = 0; bar.st = nullptr;
    if (!MK_PER_PHASE) bar = xcd_barrier_post((unsigned*)(args.ws + WS_CTL) + CW_BAR, MISC + 8);

    const int lo = args.ph_lo, hi = args.ph_hi;
#define IN(k) (lo <= (k) && (k) < hi)
#define SEAM(k) do { if (!MK_PER_PHASE && (k) + 1 < hi) xcd_barrier(bar); } while (0)

    if (IN(0)) { P p; build_P(p, lds, 0); phase_mod(p, lds, (float*)(args.ws + WS_ROPE)); __syncthreads(); convert_weights(p, 0, lds, p.bid * NWAVES + p.wave, p.G * NWAVES); SEAM(0); }

#ifndef REPSUB
#define REPSUB 0
#endif
#define RSUB(b, ...) for (int r2_ = 0; r2_ <= ((REPSUB >> (b)) & 1); ++r2_) { __VA_ARGS__; __syncthreads(); }
#ifndef REPMASK
#define REPMASK 0
#endif
#define PHASE(k, ...) if (!((SKIPMASK >> (k)) & 1) && IN(pb + (k))) { for (int rep_ = 0; rep_ <= ((REPMASK >> (k)) & 1); ++rep_) { P p; build_P(p, lds, l & 1); __VA_ARGS__; \
        if (rep_ < ((REPMASK >> (k)) & 1)) xcd_barrier(bar); } SEAM(pb + (k)); }
    for (int l = 0; l < DEPTH; ++l) {
        const int pb = 1 + NPH_LAYER * l;
        const bool cx = l < DEPTH - 1;
        unsigned char* wsb; { unsigned tb_ = (unsigned)(size_t)(lds + PTAB_OFF); asm volatile("" : "+v"(tb_)); wsb = (unsigned char*)ld_tab((volatile LAS unsigned*)(size_t)tb_, 34); }
        PHASE(0, s5_tables(p, l, (bf16*)(wsb + WS_S5BB), (bf16*)(wsb + WS_S5CC), (float*)(wsb + WS_S5AB)); __syncthreads(); row_pass<0>(p, l, lds, true, rep_ < ((REPMASK >> 0) & 1)))
        PHASE(1, pg8::Gemm g{p.H, p.WIN, T, PJ, D}; pg8::StaticOrder S; S.init(T, PJ, p.G, p.bid); pg8::EpiStoreBf16 E{p.PROJ, PJ, GT0 / 256, (const float*)(wsb + WS_ROPE)};
            pg8::gemm_phase<pg8::EpiStoreBf16, pg8::StaticOrder, false>(lds, g, S, E, nullptr))
        PHASE(2, RSUB(2, phase_premix(p, l, lds)) RSUB(3, s5_local_states(p, lds, (const bf16*)(wsb + WS_S5BB), (const float*)(wsb + WS_S5AB))))
        PHASE(3, RSUB(0, ssd_states(p, l, lds, (float*)(wsb + WS_SST), (float*)(wsb + WS_DEC))) RSUB(1, attention_mfma(p, l, lds, 4, 2 * NCH, p.bid, p.G)))
        PHASE(4, if (cx) { if (p.bid >= p.G - 4) attention_mfma(p, l, lds, 0, 4, p.bid - (p.G - 4), 4);
                else if (p.bid >= p.G - 20) ssd_outputs(p, l, lds, (const bf16*)(wsb + WS_HIN), (const float*)(wsb + WS_SST), (bf16*)(wsb + WS_YS), 0, 16, p.bid - (p.G - 20), 16);
                else if (p.bid >= p.G - 28) s5_outputs(p, l, lds, (const bf16*)(wsb + WS_S5BB), (const bf16*)(wsb + WS_S5CC), (const float*)(wsb + WS_S5AB), 0, 64, (p.bid - (p.G - 28)) * NWAVES + p.wave, 64); }
            scan_carries(p, l, (const float*)(wsb + WS_SST), (const float*)(wsb + WS_DEC), (bf16*)(wsb + WS_HIN)))
        PHASE(5, RSUB(4, ssd_outputs(p, l, lds, (const bf16*)(wsb + WS_HIN), (const float*)(wsb + WS_SST), (bf16*)(wsb + WS_YS), 16, NCH * 8, p.bid, p.G))
            RSUB(5, s5_outputs(p, l, lds, (const bf16*)(wsb + WS_S5BB), (const bf16*)(wsb + WS_S5CC), (const float*)(wsb + WS_S5AB), 64, 32 * NCH, p.bid * NWAVES + p.wave, p.G * NWAVES)))
        PHASE(6, pg8::Gemm g{p.SA, p.WGLU, T, 512, 512}; pg8::RowOffOrder S; S.init(cx ? T : NLAT, 512, p.G, p.bid, cx ? 0 : 1); pg8::EpiGlu E{p.SA, p.b_glu + (size_t)l * 512, p.Y3};
            pg8::gemm_phase<pg8::EpiGlu, pg8::RowOffOrder, false>(lds, g, S, E, nullptr); ssd_gated_norm(p, l, (const bf16*)(wsb + WS_YS)))
        PHASE(7, pg8::Gemm g{p.Y3, p.WBR, T, D, 1536}; pg8::RowOffOrder S; S.init(NLAT, D, p.G, p.bid, 1); pg8::EpiMerge E{p.PROJ, p.MB};
            pg8::gemm_phase<pg8::EpiMerge, pg8::RowOffOrder, false>(lds, g, S, E, nullptr);
            if (cx) for (int it = p.bid; it < 32; it += p.G) { const SgMerge e{p.PROJ, p.MB, it >> 3, it & 7};
                small_gemm<1, SgMerge>(p, lds, p.Y3 + (size_t)(it >> 3) * 64 * 1536, 1536, p.WBR + (size_t)(it & 7) * 128 * 1536, 1536, 1536, 4, e); })
        PHASE(8, pg8::Gemm g{p.MB, p.WOUT, T, D, D}; pg8::RowOffOrder S; S.init(NLAT, D, p.G, p.bid, 1);
            const bool dry8 = rep_ < ((REPMASK >> 8) & 1);
            pg8::EpiResid E{dry8 ? p.PM + (size_t)NCTX * D : p.XL, dry8 ? p.PM : p.XC, p.MOD + (size_t)(l * 2 + 0) * 6144 + 2 * D, p.MOD + (size_t)(l * 2 + 1) * 6144 + 2 * D};
            pg8::gemm_phase<pg8::EpiResid, pg8::RowOffOrder, false>(lds, g, S, E, nullptr);
            if (cx) for (int it = p.bid; it < 32; it += p.G) { const SgResid e{dry8 ? p.PM : p.XC, p.MOD + (size_t)(l * 2 + 1) * 6144 + 2 * D, it >> 3, it & 7};
                small_gemm<1, SgResid>(p, lds, p.MB + (size_t)(it >> 3) * 64 * 1024, 1024, p.WOUT + (size_t)(it & 7) * 128 * 1024, 1024, 1024, 8, e); })
        PHASE(9, row_pass<1>(p, l, lds, cx))
        PHASE(10, { const int nsel = cx ? 32 : 16; if (p.bid < nsel) phase_select(p, lds, cx);
            else if (l + 1 < DEPTH) { P q; build_P(q, lds, (l + 1) & 1); convert_weights(q, l + 1, lds, (p.bid - nsel) * NWAVES + p.wave, (p.G - nsel) * NWAVES); } })
        PHASE(11, phase_gather(p, cx))
        PHASE(12, pg8::Gemm g{p.XE, p.WUP, NE * ESLOTS, NE * 2048, D}; pg8::ExpertOrder S{p.G, p.bid, 8, 8}; pg8::EpiSwiGlu E{p.HID};
            pg8::gemm_phase<pg8::EpiSwiGlu, pg8::ExpertOrder, false>(lds, g, S, E, nullptr);
            if (cx) for (int it = p.bid; it < NE * 8; it += p.G) { const int e = it >> 3, t = it & 7; const SgSwiGlu ep{p.HID, e * ESLOTS + CAP_L, t};
                small_gemm<2, SgSwiGlu>(p, lds, p.XE + (size_t)(e * ESLOTS + CAP_L) * 1024, 1024, p.WUP + (size_t)(e * 2048 + 256 * t) * 1024, 1024, 1024, 8, ep); })
        PHASE(13, pg8::Gemm g{p.HID, p.WDN, NE * ESLOTS, NE * 1024, D}; pg8::ExpertOrder S{p.G, p.bid, 4, 8}; pg8::EpiDown E{p.YE, p.GSEL};
            pg8::gemm_phase<pg8::EpiDown, pg8::ExpertOrder, false>(lds, g, S, E, nullptr);
            if (cx) for (int it = p.bid; it < NE * 8; it += p.G) { const int e = it >> 3, cc = it & 7; const SgDown ep{p.YE, p.GSEL, e * ESLOTS + CAP_L, cc};
                small_gemm<1, SgDown>(p, lds, p.HID + (size_t)(e * ESLOTS + CAP_L) * 1024, 1024, p.WDN + (size_t)(e * 1024 + 128 * cc) * 1024, 1024, 1024, 8, ep); })
    }
    if (IN(NPHASES - 1)) { P p; build_P(p, lds); row_pass<2>(p, 0, lds); }
#undef IN
#undef SEAM
}

extern "C" void kernel_launch(void* const* d_in, const int* in_sizes, int n_in, void* d_out, int out_size, void* d_ws, size_t ws_size, hipStream_t stream) {
    static int grid = 0;
    if (grid == 0) {
        if (n_in != 33 || out_size != NLAT * D || ws_size < WS_END) { fprintf(stderr, "kernel_launch: unexpected shapes: n_in %d out %d ws %zu (need %zu)\n", n_in, out_size, ws_size, (size_t)WS_END); grid = -1; return; }
        int dev = 0, cus = 0, per_cu = 0;
        if (hipGetDevice(&dev) != hipSuccess || hipDeviceGetAttribute(&cus, hipDeviceAttributeMultiprocessorCount, dev) != hipSuccess) { grid = -1; return; }
        if (hipFuncSetAttribute((const void*)fwd_kernel, hipFuncAttributeMaxDynamicSharedMemorySize, LDS_BYTES) != hipSuccess) { fprintf(stderr, "kernel_launch: hipFuncSetAttribute failed\n"); grid = -1; return; }
        if (hipOccupancyMaxActiveBlocksPerMultiprocessor(&per_cu, (const void*)fwd_kernel, NTHR, LDS_BYTES) != hipSuccess || per_cu < 1) { fprintf(stderr, "kernel_launch: occupancy query says %d\n", per_cu); (void)hipGetLastError(); }
        grid = cus;
    }
    if (grid < 0) return;
    (void)hipMemsetAsync((char*)d_ws + WS_CTL, 0, CTL_BYTES, stream);
    Args a{};
    for (int i = 0; i < 33; ++i) a.in[i] = (const float*)d_in[i];
    a.out = (float*)d_out; a.ws = (unsigned char*)d_ws;
#if MK_PER_PHASE
    for (int ph = 0; ph < NPHASES; ++ph) { a.ph_lo = ph; a.ph_hi = ph + 1; hipLaunchKernelGGL(fwd_kernel, dim3(grid), dim3(NTHR), LDS_BYTES, stream, a); }
#else
    a.ph_lo = 0; a.ph_hi = NPHASES;
    hipLaunchKernelGGL(fwd_kernel, dim3(grid), dim3(NTHR), LDS_BYTES, stream, a);
#endif
}
```

```cpp
#include <hip/hip_runtime.h>
#include <cstdio>
#include <cstdint>

#ifndef MK_PER_PHASE
#define MK_PER_PHASE 0
#endif

namespace pg8 {
#define PG8_LAS __attribute__((address_space(3)))
typedef unsigned short bf16_t;
typedef short bf16x8 __attribute__((ext_vector_type(8)));
typedef float f32x4 __attribute__((ext_vector_type(4)));
typedef unsigned u32x4 __attribute__((ext_vector_type(4)));
constexpr int BM = 256, BK = 64, HALF = 128, HTB = HALF * BK * 2  , STAGE_BYTES = 8 * HTB, NXCD = 8, WGM = 8;

__host__ __device__ __forceinline__ int lds_byte(int r, int c) { const int st = (r >> 4) * 2 + (c >> 5), rr = r & 15, cc = c & 31, ob = rr * 64 + cc * 2; return st * 1024 + (ob ^ (((ob >> 9) & 1) << 5)); }
__host__ __device__ __forceinline__ void stage_rc(int b, int& R, int& C) { const int st = b / 1024, sb = b % 1024, swz = sb ^ (((sb >> 9) & 1) << 5); R = (st >> 1) * 16 + swz / 64; C = (st & 1) * 32 + (swz % 64) / 2; }
__host__ __device__ __forceinline__ int perm32(int rho) { const int n = rho >> 4, i = rho & 15; return 8 * (i >> 2) + 4 * n + (i & 3); }

struct Unit { int pm, pn; };
struct Gemm { const bf16_t* A; const bf16_t* Bt; int M, N, K; };

struct StaticOrder {
    static constexpr bool GATHER = false;
    int nM, nN, nwg, G, c;
    __host__ __device__ void init(int M, int N, int G_, int c_) { nM = M / BM; nN = N / BM; nwg = nM * nN; G = G_; c = c_; }
    __host__ __device__ bool next(int i, Unit& u) const {
        const long L = (long)i * G + c; if (L >= nwg) return false;
        int wgid = (int)L; { const int q = nwg / NXCD, r = nwg % NXCD, xcd = wgid % NXCD, off = wgid / NXCD; wgid = (xcd < r ? xcd * (q + 1) : r * (q + 1) + (xcd - r) * q) + off; }
        const int nig = WGM * nN, gid = wgid / nig, fm = gid * WGM, gsz = (nM - fm) < WGM ? (nM - fm) : WGM;
        u.pm = fm + ((wgid % nig) % gsz); u.pn = (wgid % nig) / gsz; return true;
    }
    __device__ __forceinline__ void a_ready(const Unit&) const {}
    __device__ __forceinline__ void done(const Unit&) const {}
};
__device__ __forceinline__ unsigned cvt_pk_bf16(float lo, float hi) { unsigned r; asm volatile("v_cvt_pk_bf16_f32 %0, %1, %2" : "=v"(r) : "v"(lo), "v"(hi)); return r; }
template <class Epi, class Sched, bool STAMP = false>
__device__ __forceinline__ void gemm_phase(PG8_LAS unsigned char* lds, const Gemm g, const Sched& S, const Epi& E, unsigned long long* stamps) {
    int tid_l = threadIdx.x; asm volatile("" : "+v"(tid_l));
    const int tid = tid_l, wid = __builtin_amdgcn_readfirstlane(tid >> 6), lane = tid & 63, wr = wid >> 2, wc = wid & 3, fr = lane & 15, fq = lane >> 4;
    const int K = g.K, nt = K / BK;
    int ts_lo = 0, ts_hi = 0, nts = 0; const unsigned long long rt_entry = STAMP ? (unsigned long long)wall_clock64() : 0ull;
#define PG8_STAMP() do { if (STAMP && wid == 0 && nts < 64) { const unsigned long long _c = (unsigned long long)clock64(); \
        ts_lo = (lane == nts) ? (int)(unsigned)_c : ts_lo; ts_hi = (lane == nts) ? (int)(unsigned)(_c >> 32) : ts_hi; ++nts; } } while (0)
    PG8_STAMP();
    unsigned voffA[2], voffB[2]; int rA[2], cAo[2];
#pragma unroll
    for (int i = 0; i < 2; ++i) { int R, C; stage_rc(tid * 16 + i * 8192, R, C); const int Rb = Epi::PERM ? ((R & ~31) + perm32(R & 31)) : R;
        voffA[i] = (unsigned)(R * K + C) * 2u; voffB[i] = (unsigned)(Rb * K + C) * 2u; rA[i] = R; cAo[i] = C; }
    const size_t kstep = (size_t)(BK * 2);
    const size_t hstep = (size_t)HALF * K * 2;
    const size_t tstep = 2 * hstep;
    const unsigned ldsw = (unsigned)wid * 1024u;
    const int aoff = lds_byte(wr * 64 + fr, fq * 8), boff = lds_byte(wc * 32 + fr, fq * 8);
#define PG8_SA(b, h) (((b) * 2 + (h)) * HTB)
#define PG8_SB(b, h) ((4 + (b) * 2 + (h)) * HTB)
#define PG8_STAGE(bufoff, gbase, voff) do { _Pragma("unroll") for (int _i = 0; _i < 2; ++_i) \
        __builtin_amdgcn_global_load_lds((const unsigned*)((const char*)(gbase) + (voff)[_i]), (PG8_LAS unsigned*)(lds + (bufoff) + ldsw + _i * 8192), 16, 0, 0); } while (0)
#define PG8_LDA(dst, b, h) do { _Pragma("unroll") for (int m = 0; m < 4; ++m) _Pragma("unroll") for (int k = 0; k < 2; ++k) dst[m][k] = *(const PG8_LAS bf16x8*)(lds + PG8_SA(b, h) + aoff + m * 2048 + k * 1024); } while (0)
#define PG8_LDB(dst, b, h) do { _Pragma("unroll") for (int n = 0; n < 2; ++n) _Pragma("unroll") for (int k = 0; k < 2; ++k) dst[n][k] = *(const PG8_LAS bf16x8*)(lds + PG8_SB(b, h) + boff + n * 2048 + k * 1024); } while (0)
#define PG8_MMA(ai, bj, At, Bt) do { __builtin_amdgcn_s_setprio(1); _Pragma("unroll") for (int m = 0; m < 4; ++m) _Pragma("unroll") for (int n = 0; n < 2; ++n) _Pragma("unroll") for (int k = 0; k < 2; ++k) \
        acc[ai][bj][m][n] = __builtin_amdgcn_mfma_f32_16x16x32_bf16(Bt[n][k], At[m][k], acc[ai][bj][m][n], 0, 0, 0); __builtin_amdgcn_s_setprio(0); } while (0)
#define PG8_WAIT_V(n) asm volatile("s_waitcnt vmcnt(" #n ")" ::: "memory")
#define PG8_WAIT_L(n) asm volatile("s_waitcnt lgkmcnt(" #n ")" ::: "memory")
#define PG8_BAR __builtin_amdgcn_s_barrier()
#define PG8_SCHED __builtin_amdgcn_sched_barrier(0)
    Unit cur, nxt; int ui = 0;
    if (!S.next(0, cur)) return;
    f32x4 acc[2][2][4][2];
#pragma unroll
    for (int a = 0; a < 2; ++a)
#pragma unroll
        for (int b = 0; b < 2; ++b)
#pragma unroll
            for (int m = 0; m < 4; ++m)
#pragma unroll
                for (int n = 0; n < 2; ++n) acc[a][b][m][n] = (f32x4){0.f, 0.f, 0.f, 0.f};
    bf16x8 At[4][2], B0[2][2], B1[2][2];
    unsigned vAc[2][2], vAn[2][2];
#pragma unroll
    for (int h = 0; h < 2; ++h)
#pragma unroll
        for (int i = 0; i < 2; ++i) { if constexpr (Sched::GATHER) vAc[h][i] = (unsigned)(S.arow(cur, h * HALF + rA[i]) * K + cAo[i]) * 2u; else vAc[h][i] = voffA[i] + (unsigned)(h * hstep);
            vAn[h][i] = vAc[h][i]; }
    if constexpr (Sched::GATHER) { asm volatile("s_waitcnt vmcnt(0)" ::: "memory"); }
    const char* cA = (const char*)g.A + (Sched::GATHER ? (size_t)0 : (size_t)cur.pm * tstep); const char* cB = (const char*)g.Bt + (size_t)cur.pn * tstep;
    S.a_ready(cur);
    PG8_STAGE(PG8_SB(0, 0), cB, voffB); PG8_STAGE(PG8_SA(0, 0), cA, vAc[0]); PG8_STAGE(PG8_SB(0, 1), cB + hstep, voffB); PG8_STAGE(PG8_SA(0, 1), cA, vAc[1]);
    if (wr == 1) PG8_BAR;
    PG8_WAIT_V(4); PG8_BAR;
    PG8_STAGE(PG8_SB(1, 0), cB + kstep, voffB); PG8_STAGE(PG8_SA(1, 0), cA + kstep, vAc[0]); PG8_STAGE(PG8_SB(1, 1), cB + hstep + kstep, voffB);
    PG8_WAIT_V(6); PG8_BAR;
    PG8_STAMP();
    for (;;) {
        const bool has_next = S.next(ui + 1, nxt);
        const char* nA = (has_next && !Sched::GATHER) ? (const char*)g.A + (size_t)nxt.pm * tstep : cA; const char* nB = has_next ? (const char*)g.Bt + (size_t)nxt.pn * tstep : cB;
        if constexpr (Sched::GATHER) { if (has_next) {
#pragma unroll
            for (int h = 0; h < 2; ++h)
#pragma unroll
                for (int i = 0; i < 2; ++i) vAn[h][i] = (unsigned)(S.arow(nxt, h * HALF + rA[i]) * K + cAo[i]) * 2u;
            asm volatile("s_waitcnt vmcnt(0)" ::: "memory"); } }
        for (int t = 0; t < nt; t += 2) {
            const bool last = (t == nt - 2);
            const char* a1 = cA + (size_t)(t + 1) * kstep;
            const char* a2 = last ? nA : cA + (size_t)(t + 2) * kstep; const char* b2 = last ? nB : cB + (size_t)(t + 2) * kstep;
            const char* a3 = a2 + kstep; const char* b3 = b2 + kstep;
            unsigned vs0[2], vs1[2];
#pragma unroll
            for (int i = 0; i < 2; ++i) { vs0[i] = last ? vAn[0][i] : vAc[0][i]; vs1[i] = last ? vAn[1][i] : vAc[1][i]; }
            if (last && has_next) S.a_ready(nxt);
            if constexpr (Epi::MIDHOOK) { if (t == 8 || t == 16) E.mid(acc, cur, t >> 3, wr, wc, fr, fq); }
            PG8_LDB(B0, 0, 0); PG8_SCHED; PG8_LDA(At, 0, 0); PG8_STAGE(PG8_SA(1, 1), a1, vAc[1]);
            PG8_WAIT_L(8); PG8_BAR; PG8_WAIT_L(0); PG8_MMA(0, 0, At, B0); PG8_BAR; PG8_SCHED;
            PG8_LDB(B1, 0, 1); PG8_STAGE(PG8_SB(0, 0), b2, voffB);
            PG8_BAR; PG8_WAIT_L(0); PG8_MMA(0, 1, At, B1); PG8_BAR;
            PG8_LDA(At, 0, 1); PG8_STAGE(PG8_SA(0, 0), a2, vs0);
            PG8_BAR; PG8_WAIT_L(0); PG8_MMA(1, 0, At, B0); PG8_BAR; PG8_SCHED;
            PG8_STAGE(PG8_SB(0, 1), b2 + hstep, voffB);
            PG8_WAIT_V(6); PG8_BAR; PG8_MMA(1, 1, At, B1); PG8_BAR;
            PG8_LDB(B0, 1, 0); PG8_SCHED; PG8_LDA(At, 1, 0); PG8_STAGE(PG8_SA(0, 1), a2, vs1);
            PG8_WAIT_L(8); PG8_BAR; PG8_WAIT_L(0); PG8_MMA(0, 0, At, B0); PG8_BAR; PG8_SCHED;
            PG8_LDB(B1, 1, 1); PG8_STAGE(PG8_SB(1, 0), b3, voffB);
            PG8_BAR; PG8_WAIT_L(0); PG8_MMA(0, 1, At, B1); PG8_BAR;
            PG8_LDA(At, 1, 1); PG8_STAGE(PG8_SA(1, 0), a3, vs0);
            PG8_BAR; PG8_WAIT_L(0); PG8_MMA(1, 0, At, B0); PG8_BAR; PG8_SCHED;
            PG8_STAGE(PG8_SB(1, 1), b3 + hstep, voffB);
            PG8_WAIT_V(6); PG8_BAR; PG8_MMA(1, 1, At, B1); PG8_BAR;
        }
        PG8_STAMP();
        if constexpr (!Epi::AFTER_DRAIN) { E(acc, cur, wr, wc, fr, fq); S.done(cur); }
        PG8_STAMP();
        if (!has_next) break;
#pragma unroll
        for (int a = 0; a < 2; ++a)
#pragma unroll
            for (int b = 0; b < 2; ++b)
#pragma unroll
                for (int m = 0; m < 4; ++m)
#pragma unroll
                    for (int n = 0; n < 2; ++n) acc[a][b][m][n] = (f32x4){0.f, 0.f, 0.f, 0.f};
        cur = nxt; cA = nA; cB = nB; ++ui;
#pragma unroll
        for (int h = 0; h < 2; ++h)
#pragma unroll
            for (int i = 0; i < 2; ++i) vAc[h][i] = vAn[h][i];
    }
    PG8_WAIT_V(0);
    if (wr == 0) PG8_BAR;
    PG8_BAR;
    if constexpr (Epi::AFTER_DRAIN) { E.fused(acc, cur, wr, wc, fr, fq, lds, wid, lane); S.done(cur); }
    PG8_STAMP();
    if (STAMP && wid == 0) { stamps[lane] = lane < nts ? (((unsigned long long)(unsigned)ts_hi << 32) | (unsigned)ts_lo) : 0ull;
        if (lane == 62) stamps[62] = rt_entry; if (lane == 63) stamps[63] = (unsigned long long)wall_clock64(); }
#undef PG8_STAMP
#undef PG8_SA
#undef PG8_SB
#undef PG8_STAGE
#undef PG8_LDA
#undef PG8_LDB
#undef PG8_MMA
#undef PG8_WAIT_V
#undef PG8_WAIT_L
#undef PG8_BAR
#undef PG8_SCHED
}
}

#define GAS __attribute__((address_space(1)))
#define LAS __attribute__((address_space(3)))
typedef unsigned short bf16;
typedef float f32x4 __attribute__((ext_vector_type(4)));
typedef unsigned u32x4 __attribute__((ext_vector_type(4)));
typedef unsigned u32x2 __attribute__((ext_vector_type(2)));

constexpr int D = 1024, NLAT = 16384, NCTX = 256, T = NLAT + NCTX, DEPTH = 4;
constexpr int IN_W = 5904, PJ = 5888;
constexpr int U0 = 0, Z0 = 512, XB0 = 1024, Q0 = 2048, K0 = 2560, V0 = 2688, GT0 = 2816;
constexpr int NE = 16, ESLOTS = 2304, CAP_L = 2048, CAP_C = 32;
constexpr int NCH = 130;
constexpr float EPS = 1e-6f;
constexpr int NWAVES = 8, NTHR = 512;
constexpr int LDS_BYTES = 155648;
constexpr int MISC_OFF = LDS_BYTES - 1024 + 512;
constexpr int NPH_LAYER = 14, NPHASES = 1 + DEPTH * NPH_LAYER + 1;

constexpr size_t al256(size_t x) { return (x + 255) & ~(size_t)255; }
constexpr size_t WS_CTL = 0, CTL_BYTES = 1u << 20;
constexpr size_t WS_MOD = WS_CTL + CTL_BYTES;
constexpr size_t WS_XC = al256(WS_MOD + (size_t)DEPTH * 2 * 6144 * 4);
constexpr size_t WS_WIN = al256(WS_XC + (size_t)NCTX * D * 4);
constexpr size_t WS_WGLU = al256(WS_WIN + (size_t)PJ * D * 2);
constexpr size_t WS_WBR = al256(WS_WGLU + (size_t)512 * 512 * 2);
constexpr size_t WS_WOUT = al256(WS_WBR + (size_t)3 * 1024 * 512 * 2);
constexpr size_t WS_WUP = al256(WS_WOUT + (size_t)1024 * 1024 * 2);
constexpr size_t WS_WDN = al256(WS_WUP + (size_t)NE * 2048 * 1024 * 2);
constexpr size_t WS_H = al256(WS_WDN + (size_t)NE * 1024 * 1024 * 2);
constexpr size_t WS_PROJ = al256(WS_H + (size_t)T * D * 2);
constexpr size_t WS_XE = WS_PROJ;
constexpr size_t WS_HID = al256(WS_XE + (size_t)NE * ESLOTS * D * 2);
constexpr size_t WS_DT = al256(WS_PROJ + (size_t)T * PJ * 2);
constexpr size_t WS_CV = al256(WS_DT + (size_t)T * 16 * 4);
constexpr size_t WS_S5E = al256(WS_CV + (size_t)T * 1024 * 2);
constexpr size_t WS_S5H = al256(WS_S5E + (size_t)2 * 32 * NCH * 128 * 4);
constexpr size_t WS_YD = al256(WS_S5H + (size_t)2 * 32 * NCH * 128 * 4);
constexpr size_t WS_SA = al256(WS_YD + (size_t)2 * T * 512 * 4);
constexpr size_t WS_Y3 = al256(WS_SA + (size_t)T * 512 * 2);
constexpr size_t WS_PM = al256(WS_Y3 + (size_t)3 * T * 512 * 2);
constexpr size_t WS_MB = al256(WS_PM + (size_t)T * D * 4);
constexpr size_t WS_YE = WS_PM;
constexpr size_t WS_AFFT = al256(WS_MB + (size_t)T * D * 2);
constexpr size_t WS_IDX = al256(WS_AFFT + (size_t)NE * T * 4);
constexpr size_t WS_GSEL = al256(WS_IDX + (size_t)NE * ESLOTS * 4);
constexpr size_t WS_INV = al256(WS_GSEL + (size_t)NE * ESLOTS * 4);
constexpr size_t WS_DEC = al256(WS_INV + (size_t)T * 16 * 4);
constexpr size_t WS_S5BB = al256(WS_DEC + (size_t)2 * NCH * 8 * 4);
constexpr size_t WS_S5CC = al256(WS_S5BB + (size_t)2 * 32 * 128 * 32 * 2);
constexpr size_t WS_S5AB = al256(WS_S5CC + (size_t)2 * 32 * 16 * 128 * 2);
constexpr size_t WS_ROPE = al256(WS_S5AB + (size_t)2 * 32 * 64 * 2 * 4);
constexpr size_t WS_W2 = al256(WS_ROPE + (size_t)2 * 256 * 16 * 4);
constexpr size_t WBUF_BYTES = WS_H - WS_WIN;
constexpr size_t WS_END = al256(WS_W2 + WBUF_BYTES);
constexpr size_t WS_SST = WS_YD;
constexpr size_t WS_HIN = WS_PM;
constexpr size_t WS_YS = al256(WS_HIN + (size_t)2 * NCH * 8 * 8192 * 2);
static_assert(WS_YS + (size_t)T * 512 * 2 <= WS_AFFT, "HIN|YS overlay fits PM|MB");
static_assert(WS_HID + (size_t)NE * ESLOTS * D * 2 <= WS_DT, "XE|HID overlay fits PROJ");
static_assert(WS_YE + (size_t)NE * ESLOTS * D * 2 <= WS_AFFT, "YE overlay fits PM|MB");
static_assert(WS_END < (size_t)1000 * 1024 * 1024, "workspace");
constexpr int CW_BAR = 4096;

__device__ __forceinline__ float bf2f(unsigned b) { return __uint_as_float(b << 16); }
__device__ __forceinline__ float bflo(unsigned w) { return __uint_as_float(w << 16); }
__device__ __forceinline__ float bfhi(unsigned w) { return __uint_as_float(w & 0xffff0000u); }
typedef float f32x2_c __attribute__((ext_vector_type(2)));
typedef __bf16 bf16x2_c __attribute__((ext_vector_type(2)));
__device__ __forceinline__ unsigned pk2(float lo, float hi) { f32x2_c v; v[0] = lo; v[1] = hi; return __builtin_bit_cast(unsigned, __builtin_convertvector(v, bf16x2_c)); }
__device__ __forceinline__ unsigned f2bf(float f) { return pk2(f, 0.f) & 0xffffu; }
__device__ __forceinline__ float wsum(float v) {
#pragma unroll
    for (int o = 1; o < 64; o <<= 1) v += __shfl_xor(v, o);
    return v;
}
__device__ __forceinline__ float wmaxf(float v) {
#pragma unroll
    for (int o = 1; o < 64; o <<= 1) v = fmaxf(v, __shfl_xor(v, o));
    return v;
}
__device__ __forceinline__ float silu_f(float x) { return x * __builtin_amdgcn_rcpf(1.f + __expf(-x)); }
__device__ __forceinline__ float sigmoid_f(float x) { return __builtin_amdgcn_rcpf(1.f + __expf(-x)); }
__device__ __forceinline__ float softplus_f(float x) { return x > 20.f ? x : log1pf(expf(x)); }
__device__ __forceinline__ float gelu_tanh_f(float x) { const float u = 0.7978845608028654f * (x + 0.044715f * x * x * x); return x * __builtin_amdgcn_rcpf(1.f + __expf(-2.f * u)); }
#define LDS_FENCE() asm volatile("s_waitcnt lgkmcnt(0)" ::: "memory")
__device__ __forceinline__ int scan_row(int d, int s) { return d == 0 ? s : (s < NCTX ? (NCTX - 1 - s) : (T + NCTX - 1 - s)); }

namespace pg8 {
struct EpiStoreBf16 {
    static constexpr bool PERM = true, AFTER_DRAIN = false, MIDHOOK = false;
    bf16_t* O; int ldc; int sig_tile; const float* rope;
    __device__ __forceinline__ void operator()(const f32x4 (&acc)[2][2][4][2], const Unit& u, int wr, int wc, int fr, int fq) const {
        const int row0 = u.pm * BM + wr * 64 + fr, col0 = u.pn * BM + wc * 32 + 8 * fq; const bool sg = u.pn >= sig_tile;
        const bool rq = rope != nullptr && u.pm >= 1 && (u.pn == Q0 / 256 || u.pn == Q0 / 256 + 1), rk = rope != nullptr && u.pm >= 1 && u.pn == K0 / 256;
#pragma unroll
        for (int ai = 0; ai < 2; ++ai)
#pragma unroll
            for (int m = 0; m < 4; ++m) { const int row = row0 + ai * HALF + m * 16; bf16_t* rowp = O + (size_t)row * ldc + col0;
#pragma unroll
                for (int bj = 0; bj < 2; ++bj) { f32x4 v0 = acc[ai][bj][m][0], v1 = acc[ai][bj][m][1];
                    if (sg) {
#pragma unroll
                        for (int q = 0; q < 4; ++q) { v0[q] = __builtin_amdgcn_rcpf(1.f + __expf(-v0[q])); v1[q] = __builtin_amdgcn_rcpf(1.f + __expf(-v1[q])); } }
                    if (rq || (rk && bj == 0)) {
                        const int t = row - NCTX, idx = (wc & 1) ? (t & 63) : (t >> 6);
                        const float* cp = rope + idx * 16 + 8 * (fq & 1);
                        const f32x4 c0 = *(const f32x4*)cp, c1 = *(const f32x4*)(cp + 4), s0 = *(const f32x4*)(cp + 4096), s1 = *(const f32x4*)(cp + 4100);
                        const float sgn = (fq & 2) ? 1.f : -1.f;
#pragma unroll
                        for (int q = 0; q < 4; ++q) { const float p0 = __shfl_xor(v0[q], 32), p1 = __shfl_xor(v1[q], 32);
                            v0[q] = v0[q] * c0[q] + sgn * p0 * s0[q]; v1[q] = v1[q] * c1[q] + sgn * p1 * s1[q]; } }
                    u32x4 w; w.x = cvt_pk_bf16(v0[0], v0[1]); w.y = cvt_pk_bf16(v0[2], v0[3]); w.z = cvt_pk_bf16(v1[0], v1[1]); w.w = cvt_pk_bf16(v1[2], v1[3]);
                    *(u32x4*)(rowp + bj * HALF) = w; } }
    }
};
struct EpiGlu {
    static constexpr bool PERM = true, AFTER_DRAIN = false, MIDHOOK = false;
    const bf16_t* A; const float* bias; bf16_t* O;
    __device__ __forceinline__ void operator()(const f32x4 (&acc)[2][2][4][2], const Unit& u, int wr, int wc, int fr, int fq) const {
        const int row0 = u.pm * BM + wr * 64 + fr, col0 = u.pn * BM + wc * 32 + 8 * fq;
#pragma unroll
        for (int ai = 0; ai < 2; ++ai)
#pragma unroll
            for (int m = 0; m < 4; ++m) { const size_t ro = (size_t)(row0 + ai * HALF + m * 16) * 512 + col0;
#pragma unroll
                for (int bj = 0; bj < 2; ++bj) { const f32x4 v0 = acc[ai][bj][m][0], v1 = acc[ai][bj][m][1];
                    const u32x4 a = *(const u32x4*)(A + ro + bj * HALF);
                    const f32x4 b0 = *(const f32x4*)(bias + col0 + bj * HALF), b1 = *(const f32x4*)(bias + col0 + bj * HALF + 4);
                    float o[8];
                    o[0] = bflo(a.x) * sigmoid_f(v0[0] + b0[0]); o[1] = bfhi(a.x) * sigmoid_f(v0[1] + b0[1]);
                    o[2] = bflo(a.y) * sigmoid_f(v0[2] + b0[2]); o[3] = bfhi(a.y) * sigmoid_f(v0[3] + b0[3]);
                    o[4] = bflo(a.z) * sigmoid_f(v1[0] + b1[0]); o[5] = bfhi(a.z) * sigmoid_f(v1[1] + b1[1]);
                    o[6] = bflo(a.w) * sigmoid_f(v1[2] + b1[2]); o[7] = bfhi(a.w) * sigmoid_f(v1[3] + b1[3]);
                    u32x4 w; w.x = cvt_pk_bf16(o[0], o[1]); w.y = cvt_pk_bf16(o[2], o[3]); w.z = cvt_pk_bf16(o[4], o[5]); w.w = cvt_pk_bf16(o[6], o[7]);
                    *(u32x4*)(O + (size_t)(row0 + ai * HALF + m * 16) * 1536 + col0 + bj * HALF) = w; } }
    }
};
struct RowOffOrder {
    static constexpr bool GATHER = false;
    StaticOrder b; int off;
    __device__ __forceinline__ void init(int M, int N, int G, int c, int off_) { b.init(M, N, G, c); off = off_; }
    __device__ __forceinline__ bool next(int i, Unit& u) const { if (!b.next(i, u)) return false; u.pm += off; return true; }
    __device__ __forceinline__ void a_ready(const Unit&) const {}
    __device__ __forceinline__ void done(const Unit&) const {}
};
struct EpiMerge {
    static constexpr bool PERM = true, AFTER_DRAIN = false, MIDHOOK = true;
    const bf16_t* proj; bf16_t* MB;
    __device__ __forceinline__ void mid(f32x4 (&acc)[2][2][4][2], const Unit& u, int seg, int wr, int wc, int fr, int fq) const {
        const unsigned base = (unsigned)((u.pm * BM + wr * 64 + fr) * PJ + GT0 + (seg - 1) * 1024 + u.pn * BM + wc * 32 + 8 * fq) * 2u;
        const char* pb = (const char*)proj;
#pragma unroll
        for (int ai = 0; ai < 2; ++ai)
#pragma unroll
            for (int m = 0; m < 4; ++m) {
                u32x4 ga[2], gb[2];
#pragma unroll
                for (int bj = 0; bj < 2; ++bj) { const unsigned o = base + (unsigned)(((ai * HALF + m * 16) * PJ + bj * HALF) * 2);
                    ga[bj] = *(const u32x4*)(pb + o); gb[bj] = *(const u32x4*)(pb + o + 2048u); }
#pragma unroll
                for (int bj = 0; bj < 2; ++bj) { const u32x4 a = ga[bj], b = gb[bj];
                    f32x4& v0 = acc[ai][bj][m][0]; f32x4& v1 = acc[ai][bj][m][1];
                    v0[0] *= bflo(a.x) * __builtin_amdgcn_rcpf(bflo(b.x)); v0[1] *= bfhi(a.x) * __builtin_amdgcn_rcpf(bfhi(b.x));
                    v0[2] *= bflo(a.y) * __builtin_amdgcn_rcpf(bflo(b.y)); v0[3] *= bfhi(a.y) * __builtin_amdgcn_rcpf(bfhi(b.y));
                    v1[0] *= bflo(a.z) * __builtin_amdgcn_rcpf(bflo(b.z)); v1[1] *= bfhi(a.z) * __builtin_amdgcn_rcpf(bfhi(b.z));
                    v1[2] *= bflo(a.w) * __builtin_amdgcn_rcpf(bflo(b.w)); v1[3] *= bfhi(a.w) * __builtin_amdgcn_rcpf(bfhi(b.w)); }
                if (m & 1) asm volatile("" ::: "memory");
            }
    }
    __device__ __forceinline__ void operator()(const f32x4 (&acc)[2][2][4][2], const Unit& u, int wr, int wc, int fr, int fq) const {
        const int row0 = u.pm * BM + wr * 64 + fr, col0 = u.pn * BM + wc * 32 + 8 * fq;
#pragma unroll
        for (int ai = 0; ai < 2; ++ai)
#pragma unroll
            for (int m = 0; m < 4; ++m) { const int row = row0 + ai * HALF + m * 16;
#pragma unroll
                for (int bj = 0; bj < 2; ++bj) { const f32x4 v0 = acc[ai][bj][m][0], v1 = acc[ai][bj][m][1]; const int col = col0 + bj * HALF;
                    const u32x4 g = *(const u32x4*)(proj + (size_t)row * PJ + GT0 + 2048 + col);
                    u32x4 w; w.x = cvt_pk_bf16(bflo(g.x) * v0[0], bfhi(g.x) * v0[1]); w.y = cvt_pk_bf16(bflo(g.y) * v0[2], bfhi(g.y) * v0[3]);
                    w.z = cvt_pk_bf16(bflo(g.z) * v1[0], bfhi(g.z) * v1[1]); w.w = cvt_pk_bf16(bflo(g.w) * v1[2], bfhi(g.w) * v1[3]);
                    *(u32x4*)(MB + (size_t)row * 1024 + col) = w; } }
    }
};
struct EpiResid {
    static constexpr bool PERM = false, AFTER_DRAIN = false, MIDHOOK = false;
    float* XL; float* XC; const float* g_lat; const float* g_ctx;
    __device__ __forceinline__ void operator()(const f32x4 (&acc)[2][2][4][2], const Unit& u, int wr, int wc, int fr, int fq) const {
        const bool isc = (u.pm == 0);
        float* base = isc ? XC : (XL - (size_t)NCTX * D); const float* gv = isc ? g_ctx : g_lat;
        const int row0 = u.pm * BM + wr * 64 + fr, col0 = u.pn * BM + wc * 32 + 4 * fq;
#pragma unroll
        for (int ai = 0; ai < 2; ++ai)
#pragma unroll
            for (int m = 0; m < 4; ++m) { float* rowp = base + (size_t)(row0 + ai * HALF + m * 16) * D + col0;
#pragma unroll
                for (int bj = 0; bj < 2; ++bj)
#pragma unroll
                    for (int n = 0; n < 2; ++n) { float* pp = rowp + bj * HALF + n * 16; const f32x4 g = *(const f32x4*)(gv + col0 + bj * HALF + n * 16);
                        f32x4 x = *(const f32x4*)pp; x += g * acc[ai][bj][m][n]; *(f32x4*)pp = x; } }
    }
};
template <bool GATHER_> struct ExpertOrderT {
    static constexpr bool GATHER = GATHER_;
    int G, c, nnt, nmt;
    const int* idx;
    __device__ __forceinline__ bool next(int i, Unit& u) const { const int L = i * G + c; if (L >= NE * nmt * nnt) return false; const int e = L / (nmt * nnt), rem = L % (nmt * nnt); u.pm = e * 9 + rem % nmt; u.pn = e * nnt + rem / nmt; return true; }
    __device__ __forceinline__ int arow(const Unit& u, int r) const { return idx[u.pm * 256 + r]; }
    __device__ __forceinline__ void a_ready(const Unit&) const {}
    __device__ __forceinline__ void done(const Unit&) const {}
};
struct EpiSwiGlu {
    static constexpr bool PERM = true, AFTER_DRAIN = false, MIDHOOK = false;
    bf16_t* HID;
    __device__ __forceinline__ void operator()(const f32x4 (&acc)[2][2][4][2], const Unit& u, int wr, int wc, int fr, int fq) const {
        const int row0 = u.pm * BM + wr * 64 + fr, col0 = (u.pn & 7) * 128 + wc * 32 + 8 * fq;
#pragma unroll
        for (int ai = 0; ai < 2; ++ai)
#pragma unroll
            for (int m = 0; m < 4; ++m) { const f32x4 g0 = acc[ai][0][m][0], g1 = acc[ai][0][m][1], u0 = acc[ai][1][m][0], u1 = acc[ai][1][m][1];
                u32x4 w;
                w.x = cvt_pk_bf16(silu_f(g0[0]) * u0[0], silu_f(g0[1]) * u0[1]); w.y = cvt_pk_bf16(silu_f(g0[2]) * u0[2], silu_f(g0[3]) * u0[3]);
                w.z = cvt_pk_bf16(silu_f(g1[0]) * u1[0], silu_f(g1[1]) * u1[1]); w.w = cvt_pk_bf16(silu_f(g1[2]) * u1[2], silu_f(g1[3]) * u1[3]);
                *(u32x4*)(HID + (size_t)(row0 + ai * HALF + m * 16) * 1024 + col0) = w; }
    }
};
struct EpiDown {
    static constexpr bool PERM = true, AFTER_DRAIN = false, MIDHOOK = false;
    bf16_t* YE; const float* gsel;
    __device__ __forceinline__ void operator()(const f32x4 (&acc)[2][2][4][2], const Unit& u, int wr, int wc, int fr, int fq) const {
        const int row0 = u.pm * BM + wr * 64 + fr, col0 = (u.pn & 3) * BM + wc * 32 + 8 * fq;
#pragma unroll
        for (int ai = 0; ai < 2; ++ai)
#pragma unroll
            for (int m = 0; m < 4; ++m) { const int row = row0 + ai * HALF + m * 16; const float gs = gsel[row];
#pragma unroll
                for (int bj = 0; bj < 2; ++bj) { const f32x4 v0 = acc[ai][bj][m][0] * gs, v1 = acc[ai][bj][m][1] * gs;
                    u32x4 w; w.x = cvt_pk_bf16(v0[0], v0[1]); w.y = cvt_pk_bf16(v0[2], v0[3]); w.z = cvt_pk_bf16(v1[0], v1[1]); w.w = cvt_pk_bf16(v1[2], v1[3]);
                    *(u32x4*)(YE + (size_t)row * 1024 + col0 + bj * HALF) = w; } }
    }
};
}
#define XB_TMO      128
#define XB_XCNT(j)  (256  + 64 * (j))
#define XB_XSUB(j)  (1280 + 64 * (j))
#define XB_XGEN(j)  (2304 + 64 * (j))
#define XB_TOP      3328
#define XB_TOPGEN   3392
#define XCD_BAR_WORDS 3456
#define XB_SPIN_CAP (1u << 18)
#define LAS __attribute__((address_space(3)))

__device__ __forceinline__ unsigned xb_ld(unsigned* p)              { return __hip_atomic_load(p, __ATOMIC_RELAXED, __HIP_MEMORY_SCOPE_AGENT); }
__device__ __forceinline__ unsigned xb_add(unsigned* p, unsigned v) { return __hip_atomic_fetch_add(p, v, __ATOMIC_RELAXED, __HIP_MEMORY_SCOPE_AGENT); }
__device__ __forceinline__ unsigned xb_xcc_id() { return (unsigned)__builtin_amdgcn_s_getreg((3 << 11) | 20) & 0xFu; }
#define XB_SPIN(cond, bar) do { unsigned _sp = 0; while (cond) { __builtin_amdgcn_s_sleep(1); \
    if ((++_sp & 255u) == 0u) { if (xb_ld(&(bar)[XB_TMO])) break; if (_sp > XB_SPIN_CAP) { atomicAdd(&(bar)[XB_TMO], 1u); break; } } } } while (0)

struct XcdBarrier {
    unsigned* bar; unsigned x;
    volatile LAS unsigned* st;
};

__device__ __forceinline__ XcdBarrier xcd_barrier_post(unsigned* bar, volatile LAS unsigned* st) {
    XcdBarrier b; b.bar = bar; b.x = xb_xcc_id(); b.st = st;
    if (threadIdx.x == 0) (void)xb_add(&bar[XB_XCNT(b.x)], 1u);
    return b;
}
__device__ __forceinline__ void xcd_barrier_complete(unsigned* bar, unsigned x, unsigned& nloc, unsigned& nx) {
    const unsigned G = gridDim.x * gridDim.y * gridDim.z;
    unsigned sum, cnt, mine, sp = 0u;
    for (;;) {
        sum = 0u; cnt = 0u; mine = 0u;
#pragma unroll
        for (unsigned j = 0; j < 16; ++j) { const unsigned c = xb_ld(&bar[XB_XCNT(j)]); sum += c; cnt += (c > 0u) ? 1u : 0u; mine = (j == x) ? c : mine; }
        if (sum == G) break;
        __builtin_amdgcn_s_sleep(1);
        if ((++sp & 255u) == 0u) { if (xb_ld(&bar[XB_TMO])) break; if (sp > XB_SPIN_CAP) { atomicAdd(&bar[XB_TMO], 1u); break; } }
    }
    nloc = mine > 0u ? mine : 1u; nx = cnt > 0u ? cnt : 1u;
}

__device__ __forceinline__ void xcd_barrier(const XcdBarrier& b) {
    asm volatile("s_waitcnt vmcnt(0)" ::: "memory");
    __syncthreads();
    if (threadIdx.x == 0) {
        unsigned* bar = b.bar;
        __builtin_amdgcn_s_waitcnt(0);
        unsigned nloc = b.st[0], nx = b.st[1];
        if (nloc == 0u) { xcd_barrier_complete(bar, b.x, nloc, nx); b.st[0] = nloc; b.st[1] = nx; }
        const unsigned old = xb_add(&bar[XB_XSUB(b.x)], 1u);
        const unsigned gen = old / nloc;
        if (old + 1u == (gen + 1u) * nloc) {
            __builtin_amdgcn_fence(__ATOMIC_RELEASE, "agent");
            asm volatile("s_waitcnt vmcnt(0)" ::: "memory");
            const unsigned og = xb_add(&bar[XB_TOP], 1u);
            const unsigned tg = og / nx;
            if (og + 1u == (tg + 1u) * nx) xb_add(&bar[XB_TOPGEN], 1u);
            else XB_SPIN(xb_ld(&bar[XB_TOPGEN]) == tg, bar);
            __builtin_amdgcn_fence(__ATOMIC_ACQUIRE, "agent");
            xb_add(&bar[XB_XGEN(b.x)], 1u);
            asm volatile("s_waitcnt vmcnt(0)" ::: "memory");
        } else {
            XB_SPIN(xb_ld(&bar[XB_XGEN(b.x)]) == gen, bar);
            __builtin_amdgcn_fence(__ATOMIC_ACQUIRE, "agent");
            asm volatile("s_waitcnt vmcnt(0)" ::: "memory");
        }
    }
    __syncthreads();
}


struct P {
    const float *x, *c, *ctx, *c_ctx, *w_mod, *b_mod, *norm1_g, *norm2_g, *w_in, *lam_re, *lam_im, *log_dt, *b_re, *b_im, *c_re, *c_im, *s5_d, *w_glu, *b_glu,
        *conv_w, *conv_b, *a_log, *dt_bias, *ssd_d, *ssd_norm_g, *sink, *w_branch, *w_out, *w_router, *w_eg, *w_eu, *w_ed, *final_g;
    float* XL;
    float *MOD, *XC, *DT, *S5E, *S5H, *YD, *PM, *AFFT, *GSEL;
    bf16 *WIN, *WGLU, *WBR, *WOUT, *WUP, *WDN, *H, *PROJ, *XE, *HID, *CV, *SA, *Y3, *MB, *YE;
    int *IDX, *INV;
    int tid, lane, wave, bid, G;
};


constexpr int PTAB_OFF = LDS_BYTES - 1024;
__device__ __forceinline__ unsigned long long ld_tab(volatile LAS unsigned* t, int k) {
    const unsigned lo = __builtin_amdgcn_readfirstlane(t[2 * k]), hi = __builtin_amdgcn_readfirstlane(t[2 * k + 1]);
    return ((unsigned long long)hi << 32) | lo;
}
__device__ __forceinline__ void build_P(P& p, LAS unsigned char* lds, int wset = 0) {
    int tid_l = threadIdx.x, bid_l = blockIdx.x, g_l = gridDim.x;
    asm volatile("" : "+v"(tid_l), "+s"(bid_l), "+s"(g_l));
    p.tid = tid_l; p.lane = p.tid & 63; p.wave = __builtin_amdgcn_readfirstlane(p.tid >> 6); p.bid = bid_l; p.G = g_l;
    unsigned tbase = (unsigned)(size_t)(lds + PTAB_OFF); asm volatile("" : "+v"(tbase));
    volatile LAS unsigned* tb = (volatile LAS unsigned*)(size_t)tbase;
#define INP(k) ((const float*)ld_tab(tb, k))
    p.x = INP(0); p.c = INP(1); p.ctx = INP(2); p.c_ctx = INP(3); p.w_mod = INP(4); p.b_mod = INP(5); p.norm1_g = INP(6); p.norm2_g = INP(7);
    p.w_in = INP(8); p.lam_re = INP(9); p.lam_im = INP(10); p.log_dt = INP(11); p.b_re = INP(12); p.b_im = INP(13); p.c_re = INP(14); p.c_im = INP(15);
    p.s5_d = INP(16); p.w_glu = INP(17); p.b_glu = INP(18); p.conv_w = INP(19); p.conv_b = INP(20); p.a_log = INP(21); p.dt_bias = INP(22); p.ssd_d = INP(23);
    p.ssd_norm_g = INP(24); p.sink = INP(25); p.w_branch = INP(26); p.w_out = INP(27); p.w_router = INP(28); p.w_eg = INP(29); p.w_eu = INP(30); p.w_ed = INP(31);
    p.final_g = INP(32);
#undef INP
    p.XL = (float*)ld_tab(tb, 33);
    unsigned char* ws = (unsigned char*)ld_tab(tb, 34);
    p.MOD = (float*)(ws + WS_MOD); p.XC = (float*)(ws + WS_XC); p.DT = (float*)(ws + WS_DT); p.S5E = (float*)(ws + WS_S5E); p.S5H = (float*)(ws + WS_S5H); p.YD = (float*)(ws + WS_YD);
    p.PM = (float*)(ws + WS_PM); p.AFFT = (float*)(ws + WS_AFFT); p.GSEL = (float*)(ws + WS_GSEL);
    { unsigned char* wb = ws + (wset ? (WS_W2 - WS_WIN) : 0);
      p.WIN = (bf16*)(wb + WS_WIN); p.WGLU = (bf16*)(wb + WS_WGLU); p.WBR = (bf16*)(wb + WS_WBR); p.WOUT = (bf16*)(wb + WS_WOUT); p.WUP = (bf16*)(wb + WS_WUP); p.WDN = (bf16*)(wb + WS_WDN); }
    p.H = (bf16*)(ws + WS_H); p.PROJ = (bf16*)(ws + WS_PROJ); p.XE = (bf16*)(ws + WS_XE); p.HID = (bf16*)(ws + WS_HID); p.CV = (bf16*)(ws + WS_CV); p.SA = (bf16*)(ws + WS_SA);
    p.Y3 = (bf16*)(ws + WS_Y3); p.MB = (bf16*)(ws + WS_MB); p.YE = (bf16*)(ws + WS_YE);
    p.IDX = (int*)(ws + WS_IDX); p.INV = (int*)(ws + WS_INV);
}
__device__ __forceinline__ void phase_mod(const P& p, LAS unsigned char* lds, float* ropet) {
    for (int i = p.bid * NTHR + p.tid; i < 256 * 16; i += p.G * NTHR) { const float inv = exp2f(-(float)(i & 15) * 0.83048202372184058696f);
        float sn, cs; sincosf((float)(i >> 4) * inv, &sn, &cs); ropet[i] = cs; ropet[4096 + i] = sn; }
    LAS float* sc = (LAS float*)lds;
    LAS float* part = sc + 2048;
    for (int i = p.tid; i < 1024; i += NTHR) { sc[i] = silu_f(p.c[i]); sc[1024 + i] = silu_f(p.c_ctx[i]); }
    __syncthreads();
    for (int it = p.bid; it < DEPTH * 48; it += p.G) {
        const int l = it / 48, cb = it % 48, c0 = cb * 128 + 2 * p.lane;
        const float* W = p.w_mod + (size_t)l * 1024 * 6144 + c0;
        float a00 = 0.f, a01 = 0.f, a10 = 0.f, a11 = 0.f;
        const int kb = p.wave * 128;
#pragma unroll 8
        for (int k = kb; k < kb + 128; ++k) { const float2 w = *(const float2*)(W + (size_t)k * 6144); const float s0 = sc[k], s1 = sc[1024 + k];
            a00 += s0 * w.x; a01 += s0 * w.y; a10 += s1 * w.x; a11 += s1 * w.y; }
        part[(p.wave * 2 + 0) * 128 + 2 * p.lane] = a00; part[(p.wave * 2 + 0) * 128 + 2 * p.lane + 1] = a01;
        part[(p.wave * 2 + 1) * 128 + 2 * p.lane] = a10; part[(p.wave * 2 + 1) * 128 + 2 * p.lane + 1] = a11;
        __syncthreads();
        if (p.tid < 256) { const int s = p.tid >> 7, col = p.tid & 127; float r = p.b_mod[l * 6144 + cb * 128 + col];
#pragma unroll
            for (int w = 0; w < 8; ++w) r += part[(w * 2 + s) * 128 + col];
            p.MOD[(size_t)(l * 2 + s) * 6144 + cb * 128 + col] = r; }
        __syncthreads();
    }
}

__device__ __forceinline__ void tr_item(const float* src, int ldw, int K, bf16* dst, int kb, LAS float* scr, int lane) {
    const int k0 = 64 * kb, kr = lane >> 4, nq = lane & 15;
    f32x4 v[16];
#pragma unroll
    for (int i = 0; i < 16; ++i) v[i] = *(const f32x4*)(src + (size_t)(k0 + 4 * i + kr) * ldw + 4 * nq);
#pragma unroll
    for (int i = 0; i < 16; ++i) { const int k = 4 * i + kr, c = (k >> 3) & 7; *(LAS f32x4*)(scr + k * 64 + 4 * (nq ^ c)) = v[i]; }
    LDS_FENCE();
    const int c = lane & 7;
#pragma unroll
    for (int j = 0; j < 8; ++j) { const int n = (lane >> 3) + 8 * j; const LAS float* s = scr + (8 * c) * 64 + (n ^ (c << 2));
        u32x4 o; o.x = pk2(s[0 * 64], s[1 * 64]); o.y = pk2(s[2 * 64], s[3 * 64]); o.z = pk2(s[4 * 64], s[5 * 64]); o.w = pk2(s[6 * 64], s[7 * 64]);
        *(u32x4*)(dst + (size_t)n * K + k0 + 8 * c) = o; }
    LDS_FENCE();
}
__device__ __forceinline__ void convert_weights(const P& p, int l, LAS unsigned char* lds, int gw, int NGW) {
    LAS float* scr = (LAS float*)(lds + p.wave * 16384);
    constexpr int I_A = 32 * 16, I_B = 60 * 16, I_GLU = 8 * 8, I_BR = 3 * 16 * 8, I_OUT = 16 * 16, I_E = 16 * 16 * 16;
    constexpr int NIT = I_A + I_B + I_GLU + I_BR + I_OUT + 3 * I_E;
    const float* win = p.w_in + (size_t)l * 1024 * IN_W;
    for (int it = gw; it < NIT; it += NGW) {
        int r = it;
        if (r < I_A) { const int nb = r >> 4, kb = r & 15; tr_item(win + 64 * nb, IN_W, 1024, p.WIN + (size_t)(64 * nb) * 1024, kb, scr, p.lane); continue; } r -= I_A;
        if (r < I_B) { const int nb = r >> 4, kb = r & 15; tr_item(win + 2064 + 64 * nb, IN_W, 1024, p.WIN + (size_t)(2048 + 64 * nb) * 1024, kb, scr, p.lane); continue; } r -= I_B;
        if (r < I_GLU) { const int nb = r >> 3, kb = r & 7; tr_item(p.w_glu + (size_t)l * 512 * 512 + 64 * nb, 512, 512, p.WGLU + (size_t)(64 * nb) * 512, kb, scr, p.lane); continue; } r -= I_GLU;
        if (r < I_BR) { const int kk = r >> 7, nb = (r >> 3) & 15, kb = r & 7;
            tr_item(p.w_branch + ((size_t)l * 3 + kk) * 512 * 1024 + 64 * nb, 1024, 1536, p.WBR + (size_t)(64 * nb) * 1536 + kk * 512, kb, scr, p.lane); continue; } r -= I_BR;
        if (r < I_OUT) { const int nb = r >> 4, kb = r & 15; tr_item(p.w_out + (size_t)l * 1024 * 1024 + 64 * nb, 1024, 1024, p.WOUT + (size_t)(64 * nb) * 1024, kb, scr, p.lane); continue; } r -= I_OUT;
        const int which = r / I_E; r -= which * I_E;
        const int e = r >> 8, nb = (r >> 4) & 15, kb = r & 15;
        const size_t eo = ((size_t)l * NE + e) * 1024 * 1024;
        if (which == 0) tr_item(p.w_eg + eo + 64 * nb, 1024, 1024, p.WUP + (size_t)(e * 2048 + 256 * (nb >> 1) + 64 * (nb & 1)) * 1024, kb, scr, p.lane);
        else if (which == 1) tr_item(p.w_eu + eo + 64 * nb, 1024, 1024, p.WUP + (size_t)(e * 2048 + 256 * (nb >> 1) + 128 + 64 * (nb & 1)) * 1024, kb, scr, p.lane);
        else tr_item(p.w_ed + eo + 64 * nb, 1024, 1024, p.WDN + (size_t)(e * 1024 + 64 * nb) * 1024, kb, scr, p.lane);
    }
}

__device__ __forceinline__ float reduce16(float (&a)[16], int lane) {
    float b[8], c[4], d[2];
#pragma unroll
    for (int j = 0; j < 8; ++j) { const bool hi = lane & 32; const float send = hi ? a[j] : a[j + 8], keep = hi ? a[j + 8] : a[j]; b[j] = keep + __shfl_xor(send, 32); }
#pragma unroll
    for (int j = 0; j < 4; ++j) { const bool hi = lane & 16; const float send = hi ? b[j] : b[j + 4], keep = hi ? b[j + 4] : b[j]; c[j] = keep + __shfl_xor(send, 16); }
#pragma unroll
    for (int j = 0; j < 2; ++j) { const bool hi = lane & 8; const float send = hi ? c[j] : c[j + 2], keep = hi ? c[j + 2] : c[j]; d[j] = keep + __shfl_xor(send, 8); }
    const bool hi = lane & 4; const float send = hi ? d[0] : d[1], keep = hi ? d[1] : d[0];
    float r = keep + __shfl_xor(send, 4);
    r += __shfl_xor(r, 2); r += __shfl_xor(r, 1);
    return r;
}
template <int MODE> __device__ __forceinline__ void row_pass(const P& p, int l, LAS unsigned char* lds, bool with_ctx = true, bool dry = false) {
    LAS float* W16 = (LAS float*)lds;
    if (MODE != 2) {
        const float* src = (MODE == 0) ? (p.w_in + (size_t)l * 1024 * IN_W + 2048) : (p.w_router + (size_t)l * 1024 * 16);
        const int ld = (MODE == 0) ? IN_W : 16;
        for (int i = p.tid; i < 1024 * 16; i += NTHR) { const int k = i >> 4, j = i & 15; const int rr = (k & 7) * 128 + ((k >> 3) & 63) + 64 * (k >> 9); W16[rr * 20 + j] = src[(size_t)k * ld + j]; }
        __syncthreads();
    }
    const int gw = p.bid * NWAVES + p.wave, NGW = p.G * NWAVES, lane = p.lane;
    for (int row = gw + ((MODE == 2 || !with_ctx) ? NCTX : 0); row < T; row += NGW) {
        const bool isc = row < NCTX;
        float* xrow = isc ? (p.XC + (size_t)row * D) : (p.XL + (size_t)(row - NCTX) * D);
        float v[16];
        { const float* s = (MODE == 0 && l == 0) ? (isc ? (p.ctx + (size_t)row * D) : (p.x + (size_t)(row - NCTX) * D)) : xrow;
#pragma unroll
          for (int i = 0; i < 2; ++i) { const f32x4 a = *(const f32x4*)(s + 512 * i + 8 * lane), b = *(const f32x4*)(s + 512 * i + 8 * lane + 4);
              v[8 * i] = a[0]; v[8 * i + 1] = a[1]; v[8 * i + 2] = a[2]; v[8 * i + 3] = a[3]; v[8 * i + 4] = b[0]; v[8 * i + 5] = b[1]; v[8 * i + 6] = b[2]; v[8 * i + 7] = b[3]; } }
        if ((MODE == 0 && l > 0) || MODE == 2) {
            const int lp = (MODE == 2) ? (DEPTH - 1) : (l - 1);
            const float* g2 = p.MOD + (size_t)(lp * 2 + (isc ? 1 : 0)) * 6144 + 5 * D;
            float s[16];
#pragma unroll
            for (int i = 0; i < 16; ++i) s[i] = 0.f;
            for (int e = 0; e < NE; ++e) { const int slot = p.INV[(size_t)row * 16 + e];
                if (slot >= 0) { const bf16* yr = p.YE + ((size_t)e * ESLOTS + slot) * D;
#pragma unroll
                    for (int i = 0; i < 2; ++i) { const u32x4 w = *(const u32x4*)(yr + 512 * i + 8 * lane);
                        s[8 * i] += bflo(w.x); s[8 * i + 1] += bfhi(w.x); s[8 * i + 2] += bflo(w.y); s[8 * i + 3] += bfhi(w.y);
                        s[8 * i + 4] += bflo(w.z); s[8 * i + 5] += bfhi(w.z); s[8 * i + 6] += bflo(w.w); s[8 * i + 7] += bfhi(w.w); } } }
#pragma unroll
            for (int i = 0; i < 2; ++i) { const f32x4 a = *(const f32x4*)(g2 + 512 * i + 8 * lane), b = *(const f32x4*)(g2 + 512 * i + 8 * lane + 4);
#pragma unroll
                for (int q = 0; q < 4; ++q) { v[8 * i + q] += a[q] * s[8 * i + q]; v[8 * i + 4 + q] += b[q] * s[8 * i + 4 + q]; } }
        }
        if (MODE == 0 && !dry) {
#pragma unroll
            for (int i = 0; i < 2; ++i) { *(f32x4*)(xrow + 512 * i + 8 * lane) = (f32x4){v[8 * i], v[8 * i + 1], v[8 * i + 2], v[8 * i + 3]};
                *(f32x4*)(xrow + 512 * i + 8 * lane + 4) = (f32x4){v[8 * i + 4], v[8 * i + 5], v[8 * i + 6], v[8 * i + 7]}; }
        }
        float ss = 0.f;
#pragma unroll
        for (int i = 0; i < 16; ++i) ss += v[i] * v[i];
        const float rstd = rsqrtf(wsum(ss) * (1.f / D) + EPS);
        if (MODE == 2) {
#pragma unroll
            for (int i = 0; i < 2; ++i) { const f32x4 a = *(const f32x4*)(p.final_g + 512 * i + 8 * lane), b = *(const f32x4*)(p.final_g + 512 * i + 8 * lane + 4);
                *(f32x4*)(xrow + 512 * i + 8 * lane) = (f32x4){v[8 * i] * rstd * a[0], v[8 * i + 1] * rstd * a[1], v[8 * i + 2] * rstd * a[2], v[8 * i + 3] * rstd * a[3]};
                *(f32x4*)(xrow + 512 * i + 8 * lane + 4) = (f32x4){v[8 * i + 4] * rstd * b[0], v[8 * i + 5] * rstd * b[1], v[8 * i + 6] * rstd * b[2], v[8 * i + 7] * rstd * b[3]}; }
            continue;
        }
        const float* gam = (MODE == 0 ? p.norm1_g : p.norm2_g) + (size_t)l * D;
        const float* md = p.MOD + (size_t)(l * 2 + (isc ? 1 : 0)) * 6144 + (MODE == 0 ? 0 : 3 * D);
        bf16* hrow = p.H + (size_t)row * D;
        float acc[16];
#pragma unroll
        for (int j = 0; j < 16; ++j) acc[j] = 0.f;
#pragma unroll
        for (int i = 0; i < 2; ++i) {
            float hv[8];
            { const int k0 = 512 * i + 8 * lane;
              const f32x4 ga = *(const f32x4*)(gam + k0), gb = *(const f32x4*)(gam + k0 + 4), sa = *(const f32x4*)(md + D + k0), sb = *(const f32x4*)(md + D + k0 + 4), ha = *(const f32x4*)(md + k0), hb = *(const f32x4*)(md + k0 + 4);
#pragma unroll
              for (int q = 0; q < 4; ++q) { hv[q] = v[8 * i + q] * rstd * ga[q] * (1.f + sa[q]) + ha[q]; hv[4 + q] = v[8 * i + 4 + q] * rstd * gb[q] * (1.f + sb[q]) + hb[q]; }
              u32x4 o; o.x = pk2(hv[0], hv[1]); o.y = pk2(hv[2], hv[3]); o.z = pk2(hv[4], hv[5]); o.w = pk2(hv[6], hv[7]);
              *(u32x4*)(hrow + k0) = o; }
#pragma unroll
            for (int j = 0; j < 8; ++j) { const LAS f32x4* wr = (const LAS f32x4*)(W16 + (j * 128 + lane + 64 * i) * 20);
                const f32x4 w0 = wr[0], w1 = wr[1], w2 = wr[2], w3 = wr[3]; const float h = hv[j];
                acc[0] += h * w0[0]; acc[1] += h * w0[1]; acc[2] += h * w0[2]; acc[3] += h * w0[3];
                acc[4] += h * w1[0]; acc[5] += h * w1[1]; acc[6] += h * w1[2]; acc[7] += h * w1[3];
                acc[8] += h * w2[0]; acc[9] += h * w2[1]; acc[10] += h * w2[2]; acc[11] += h * w2[3];
                acc[12] += h * w3[0]; acc[13] += h * w3[1]; acc[14] += h * w3[2]; acc[15] += h * w3[3];
                if (j & 1) asm volatile("" ::: "memory"); }
        }
        const float tot = reduce16(acc, lane);
        const int col = ((lane >> 5) & 1) * 8 + ((lane >> 4) & 1) * 4 + ((lane >> 3) & 1) * 2 + ((lane >> 2) & 1);
        if (MODE == 0) {
            if ((lane & 3) == 0) p.DT[(size_t)row * 16 + col] = softplus_f(tot + p.dt_bias[l * 16 + col]);
        } else {
            float mx = tot;
            mx = fmaxf(mx, __shfl_xor(mx, 4)); mx = fmaxf(mx, __shfl_xor(mx, 8)); mx = fmaxf(mx, __shfl_xor(mx, 16)); mx = fmaxf(mx, __shfl_xor(mx, 32));
            const float e = expf(tot - mx); float sum = e;
            sum += __shfl_xor(sum, 4); sum += __shfl_xor(sum, 8); sum += __shfl_xor(sum, 16); sum += __shfl_xor(sum, 32);
            if ((lane & 3) == 0) p.AFFT[(size_t)col * T + row] = e / sum;
        }
    }
}

struct S5Lane { float abr, abi; float bbr[16], bbi[16]; };
__device__ __forceinline__ void s5_lane_params(const P& p, int l, int d, int g, int lane, S5Lane& o, bool withB) {
    const size_t gi = ((size_t)(l * 2 + d) * 32 + g);
    const float lr = p.lam_re[gi * 64 + lane], li = p.lam_im[gi * 64 + lane], dt = expf(p.log_dt[gi]);
    const float mag = expf(lr * dt); float sn, cs; sincosf(li * dt, &sn, &cs);
    o.abr = mag * cs; o.abi = mag * sn;
    if (withB) {
        const float den = lr * lr + li * li;
        const float fr = ((o.abr - 1.f) * lr + o.abi * li) / den, fi = (o.abi * lr - (o.abr - 1.f) * li) / den;
        const f32x4* br = (const f32x4*)(p.b_re + (gi * 64 + lane) * 16); const f32x4* bi = (const f32x4*)(p.b_im + (gi * 64 + lane) * 16);
#pragma unroll
        for (int q = 0; q < 4; ++q) { const f32x4 r4 = br[q], i4 = bi[q];
#pragma unroll
            for (int j = 0; j < 4; ++j) { o.bbr[4 * q + j] = fr * r4[j] - fi * i4[j]; o.bbi[4 * q + j] = fr * i4[j] + fi * r4[j]; } }
    }
}
__device__ __forceinline__ void s5_stage_u(const P& p, int r0, int g, LAS unsigned char* ub, int lane) {
#pragma unroll
    for (int j = 0; j < 4; ++j) { const int q = lane + 64 * j, i = q >> 1, half = q & 1;
        const u32x4 w = *(const u32x4*)(p.PROJ + (size_t)(r0 + i) * PJ + U0 + g * 16 + half * 8);
        *(LAS u32x4*)(ub + i * 32 + half * 16) = w; }
    LDS_FENCE();
}
__device__ __forceinline__ void s5_step(const S5Lane& s, const LAS unsigned char* ub, int i, float& hr, float& hi) {
    const u32x4 a = *(const LAS u32x4*)(ub + i * 32), b = *(const LAS u32x4*)(ub + i * 32 + 16);
    float u[16];
    u[0] = bflo(a.x); u[1] = bfhi(a.x); u[2] = bflo(a.y); u[3] = bfhi(a.y); u[4] = bflo(a.z); u[5] = bfhi(a.z); u[6] = bflo(a.w); u[7] = bfhi(a.w);
    u[8] = bflo(b.x); u[9] = bfhi(b.x); u[10] = bflo(b.y); u[11] = bfhi(b.y); u[12] = bflo(b.z); u[13] = bfhi(b.z); u[14] = bflo(b.w); u[15] = bfhi(b.w);
    float br = 0.f, bi = 0.f;
#pragma unroll
    for (int k = 0; k < 16; ++k) { br += s.bbr[k] * u[k]; bi += s.bbi[k] * u[k]; }
    const float nr = s.abr * hr - s.abi * hi + br, ni = s.abr * hi + s.abi * hr + bi;
    hr = nr; hi = ni;
}

__device__ __forceinline__ void phase_premix(const P& p, int l, LAS unsigned char* lds) {
    const float* cw = p.conv_w + (size_t)l * 5 * 1024; const float* cb = p.conv_b + (size_t)l * 1024;
    for (int idx = p.bid * NTHR + p.tid; idx < T * 128; idx += p.G * NTHR) {
        const int row = idx >> 7, c8 = (idx & 127) * 8;
        const int lo = row < NCTX ? 0 : NCTX, hi = row < NCTX ? NCTX : T;
        float a[8];
        { const f32x4 b0 = *(const f32x4*)(cb + c8), b1 = *(const f32x4*)(cb + c8 + 4);
          a[0] = b0[0]; a[1] = b0[1]; a[2] = b0[2]; a[3] = b0[3]; a[4] = b1[0]; a[5] = b1[1]; a[6] = b1[2]; a[7] = b1[3]; }
#pragma unroll
        for (int j = 0; j < 5; ++j) { const int r = row + j - 2;
            if (r >= lo && r < hi) { const u32x4 xv = *(const u32x4*)(p.PROJ + (size_t)r * PJ + XB0 + c8);
                const f32x4 w0 = *(const f32x4*)(cw + j * 1024 + c8), w1 = *(const f32x4*)(cw + j * 1024 + c8 + 4);
                a[0] += w0[0] * bflo(xv.x); a[1] += w0[1] * bfhi(xv.x); a[2] += w0[2] * bflo(xv.y); a[3] += w0[3] * bfhi(xv.y);
                a[4] += w1[0] * bflo(xv.z); a[5] += w1[1] * bfhi(xv.z); a[6] += w1[2] * bflo(xv.w); a[7] += w1[3] * bfhi(xv.w); } }
        u32x4 o; o.x = pk2(silu_f(a[0]), silu_f(a[1])); o.y = pk2(silu_f(a[2]), silu_f(a[3])); o.z = pk2(silu_f(a[4]), silu_f(a[5])); o.w = pk2(silu_f(a[6]), silu_f(a[7]));
        *(u32x4*)(p.CV + (size_t)row * 1024 + c8) = o;
    }

}

__device__ __forceinline__ void ssd_scan_naive(const P& p, int l) {
    for (int it = p.bid * 4 + p.wave; it < 1024; it += p.G * 4) {
        const int d = it >> 9, hd = (it >> 6) & 7, pp = it & 63, grp = hd >> 2;
        const float a = -expf(p.a_log[l * 16 + d * 8 + hd]);
        const int colB = 512 + grp * 128 + p.lane, colC = 768 + grp * 128 + p.lane, colX = hd * 64 + pp, dcol = d * 8 + hd;
        float h0 = 0.f, h1 = 0.f;
        for (int s0 = 0; s0 < T; s0 += 8) {
            unsigned b0[8], b1[8], c0[8], c1[8], xx[8]; float dtv[8]; int rr[8];
#pragma unroll
            for (int j = 0; j < 8; ++j) { const int r = scan_row(d, s0 + j); rr[j] = r; const bf16* cv = p.CV + (size_t)r * 1024;
                b0[j] = cv[colB]; b1[j] = cv[colB + 64]; c0[j] = cv[colC]; c1[j] = cv[colC + 64]; xx[j] = cv[colX]; dtv[j] = p.DT[(size_t)r * 16 + dcol]; }
#pragma unroll
            for (int j = 0; j < 8; ++j) { const float dec = expf(dtv[j] * a), dx = dtv[j] * bf2f(xx[j]);
                h0 = dec * h0 + dx * bf2f(b0[j]); h1 = dec * h1 + dx * bf2f(b1[j]);
                const float y = wsum(bf2f(c0[j]) * h0 + bf2f(c1[j]) * h1);
                if (p.lane == 0) p.YD[((size_t)d * T + rr[j]) * 512 + colX] = y; }
        }
    }
}
__device__ __forceinline__ void s5_carry_scan(const P& p, int l, int aw, int NAW) {
    for (int it = aw; it < 64; it += NAW) {
        const int d = it >> 5, g = it & 31;
        S5Lane s; s5_lane_params(p, l, d, g, p.lane, s, false);
        float ar = s.abr, ai = s.abi;
#pragma unroll
        for (int q = 0; q < 7; ++q) { const float nr = ar * ar - ai * ai, ni = 2.f * ar * ai; ar = nr; ai = ni; }
        float hr = 0.f, hi = 0.f;
        const float* E = p.S5E + (size_t)(d * 32 + g) * NCH * 128; float* Hn = p.S5H + (size_t)(d * 32 + g) * NCH * 128;
        for (int c = 0; c < NCH; ++c) { Hn[c * 128 + p.lane] = hr; Hn[c * 128 + 64 + p.lane] = hi;
            const float er = E[c * 128 + p.lane], ei = E[c * 128 + 64 + p.lane];
            const float nr = ar * hr - ai * hi + er, ni = ar * hi + ai * hr + ei; hr = nr; hi = ni; }
    }
}
__device__ __forceinline__ void attention_naive(const P& p, int l, int aw, int NAW, LAS float* pbuf) {
    const int lane = p.lane;
    for (int it = aw; it < T * 8; it += NAW) {
        const int row = it >> 3, hq = it & 7, kvh = hq >> 2;
        const bool isc = row < NCTX; const int t = row - NCTX;
        const int jlo = isc ? 0 : (t - 128 < 0 ? 0 : t - 128), jhi = isc ? -1 : (t + 128 > NLAT - 1 ? NLAT - 1 : t + 128);
        const int nloc = jhi - jlo + 1, nk = nloc + NCTX;
        const float sink = p.sink[l * 8 + hq];
        float q[64];
        { const u32x4* qp = (const u32x4*)(p.PROJ + (size_t)row * PJ + Q0 + hq * 64);
#pragma unroll
          for (int c = 0; c < 8; ++c) { const u32x4 w = qp[c]; q[8 * c] = bflo(w.x); q[8 * c + 1] = bfhi(w.x); q[8 * c + 2] = bflo(w.y); q[8 * c + 3] = bfhi(w.y);
              q[8 * c + 4] = bflo(w.z); q[8 * c + 5] = bfhi(w.z); q[8 * c + 6] = bflo(w.w); q[8 * c + 7] = bfhi(w.w); } }
        float sc[9]; float mx = sink;
#pragma unroll
        for (int i = 0; i < 9; ++i) { const int kk = lane + 64 * i; float s = -INFINITY;
            if (kk < nk) { const int krow = kk < nloc ? NCTX + jlo + kk : kk - nloc;
                const u32x4* kp = (const u32x4*)(p.PROJ + (size_t)krow * PJ + K0 + kvh * 64); float dot = 0.f;
#pragma unroll
                for (int c = 0; c < 8; ++c) { const u32x4 w = kp[c];
                    dot += q[8 * c] * bflo(w.x) + q[8 * c + 1] * bfhi(w.x) + q[8 * c + 2] * bflo(w.y) + q[8 * c + 3] * bfhi(w.y)
                         + q[8 * c + 4] * bflo(w.z) + q[8 * c + 5] * bfhi(w.z) + q[8 * c + 6] * bflo(w.w) + q[8 * c + 7] * bfhi(w.w); }
                s = dot * 0.125f; }
            sc[i] = s; mx = fmaxf(mx, s); }
        mx = wmaxf(mx);
        float sum = 0.f;
#pragma unroll
        for (int i = 0; i < 9; ++i) { const int kk = lane + 64 * i; const float e = (kk < nk) ? expf(sc[i] - mx) : 0.f; pbuf[kk] = e; sum += e; }
        const float den = wsum(sum) + expf(sink - mx);
        LDS_FENCE();
        float o = 0.f;
        const bf16* vb = p.PROJ + V0 + kvh * 64 + lane;
#pragma unroll 4
        for (int kk = 0; kk < nk; ++kk) { const int vrow = kk < nloc ? NCTX + jlo + kk : kk - nloc; o += pbuf[kk] * bf2f(vb[(size_t)vrow * PJ]); }
        p.Y3[((size_t)2 * T + row) * 512 + hq * 64 + lane] = (bf16)f2bf(o / den);
        LDS_FENCE();
    }
}

__device__ __forceinline__ void phase_postmix(const P& p, int l, LAS unsigned char* lds) {
    constexpr int CSH_BYTES = 2 * 2 * 16 * 68 * 4, WREG = 16640;
    LAS float* Csh = (LAS float*)lds;
    LAS unsigned char* wreg = lds + CSH_BYTES + p.wave * WREG;
    LAS unsigned char* ub = wreg;
    LAS float* Hb = (LAS float*)(wreg + 4096);
    LAS float* Yb = (LAS float*)(wreg + 4096 + 4224);
    const int lane = p.lane;
    for (int it = p.bid; it < 32 * 17; it += p.G) {
        const int g = it / 17, chunk = (it % 17) * 8 + p.wave;
        __syncthreads();
        for (int i = p.tid; i < 2 * 2 * 16 * 64; i += NTHR) { const int pq = i & 63, k = (i >> 6) & 15, ri = (i >> 10) & 1, d = i >> 11;
            const float* src = ri ? p.c_im : p.c_re; Csh[((d * 2 + ri) * 16 + k) * 68 + pq] = src[(((size_t)(l * 2 + d) * 32 + g) * 16 + k) * 64 + pq]; }
        __syncthreads();
        if (chunk < NCH) {
            const int r0 = 128 * chunk;
            s5_stage_u(p, r0, g, ub, lane);
            for (int d = 0; d < 2; ++d) {
                S5Lane s; s5_lane_params(p, l, d, g, lane, s, true);
                const int cs = (d == 0) ? chunk : (chunk < 2 ? 1 - chunk : NCH + 1 - chunk);
                const float* Hn = p.S5H + ((size_t)(d * 32 + g) * NCH + cs) * 128;
                float hr = Hn[lane], hi = Hn[64 + lane];
                const LAS float* Cr = Csh + (d * 2 + 0) * 16 * 68; const LAS float* Ci = Csh + (d * 2 + 1) * 16 * 68;
                for (int sub = 0; sub < 16; ++sub) {
#pragma unroll
                    for (int j = 0; j < 8; ++j) { const int is = sub * 8 + j; s5_step(s, ub, d == 0 ? is : 127 - is, hr, hi); Hb[j * 132 + lane] = hr; Hb[j * 132 + 64 + lane] = hi; }
                    LDS_FENCE();
#pragma unroll
                    for (int m = 0; m < 2; ++m) { const int o = lane + 64 * m, j = o >> 4, k = o & 15; float y = 0.f;
#pragma unroll
                        for (int q = 0; q < 16; ++q) { const f32x4 cr = *(const LAS f32x4*)(Cr + k * 68 + 4 * q), ci = *(const LAS f32x4*)(Ci + k * 68 + 4 * q);
                            const f32x4 xr = *(const LAS f32x4*)(Hb + j * 132 + 4 * q), xi = *(const LAS f32x4*)(Hb + j * 132 + 64 + 4 * q);
                            y += cr[0] * xr[0] + cr[1] * xr[1] + cr[2] * xr[2] + cr[3] * xr[3] - ci[0] * xi[0] - ci[1] * xi[1] - ci[2] * xi[2] - ci[3] * xi[3]; }
                        const int is = sub * 8 + j, i = (d == 0) ? is : 127 - is;
                        if (d == 0) Yb[i * 16 + k] = y; else Yb[i * 16 + k] += y; }
                    LDS_FENCE();
                }
            }
            const float* dsk = p.s5_d + (size_t)l * 512 + g * 16;
#pragma unroll
            for (int m = 0; m < 2; ++m) { const int i = lane + 64 * m;
                const u32x4 ua = *(const LAS u32x4*)(ub + i * 32), ubv = *(const LAS u32x4*)(ub + i * 32 + 16);
                float u[16];
                u[0] = bflo(ua.x); u[1] = bfhi(ua.x); u[2] = bflo(ua.y); u[3] = bfhi(ua.y); u[4] = bflo(ua.z); u[5] = bfhi(ua.z); u[6] = bflo(ua.w); u[7] = bfhi(ua.w);
                u[8] = bflo(ubv.x); u[9] = bfhi(ubv.x); u[10] = bflo(ubv.y); u[11] = bfhi(ubv.y); u[12] = bflo(ubv.z); u[13] = bfhi(ubv.z); u[14] = bflo(ubv.w); u[15] = bfhi(ubv.w);
                float a[16];
#pragma unroll
                for (int k = 0; k < 16; ++k) a[k] = gelu_tanh_f(Yb[i * 16 + k] + dsk[k] * u[k]);
                u32x4 o0, o1; o0.x = pk2(a[0], a[1]); o0.y = pk2(a[2], a[3]); o0.z = pk2(a[4], a[5]); o0.w = pk2(a[6], a[7]);
                o1.x = pk2(a[8], a[9]); o1.y = pk2(a[10], a[11]); o1.z = pk2(a[12], a[13]); o1.w = pk2(a[14], a[15]);
                bf16* dst = p.SA + (size_t)(r0 + i) * 512 + g * 16;
                *(u32x4*)dst = o0; *(u32x4*)(dst + 8) = o1; }
            LDS_FENCE();
        }
    }
}

__device__ __forceinline__ void phase_select(const P& p, LAS unsigned char* lds, bool with_ctx) {
    LAS unsigned* keys = (LAS unsigned*)lds;
    LAS unsigned* hist = keys + 16384;
    LAS unsigned* misc = hist + 256;
    const int tid = p.tid, lane = p.lane, wave = p.wave;
    for (int it = p.bid; it < (with_ctx ? 32 : 16); it += p.G) {
        const int set = it >> 4, e = it & 15;
        const int n = set ? NCTX : NLAT, cap = set ? CAP_C : CAP_L, row0 = set ? 0 : NCTX, slot0 = set ? CAP_L : 0;
        const float* src = p.AFFT + (size_t)e * T + row0;
        __syncthreads();
        for (int i = tid; i < n; i += NTHR) keys[i] = __float_as_uint(src[i]);
        unsigned prefix = 0u, mask = 0u, need = (unsigned)cap;
        for (int pass = 3; pass >= 0; --pass) {
            if (tid < 256) hist[tid] = 0u;
            __syncthreads();
            for (int i = tid; i < n; i += NTHR) { const unsigned k = keys[i]; if ((k & mask) == prefix) __hip_atomic_fetch_add(&hist[(k >> (8 * pass)) & 255u], 1u, __ATOMIC_RELAXED, __HIP_MEMORY_SCOPE_WORKGROUP); }
            __syncthreads();
            if (wave == 0) {
                const unsigned h0 = hist[4 * lane], h1 = hist[4 * lane + 1], h2 = hist[4 * lane + 2], h3 = hist[4 * lane + 3];
                const unsigned c = h0 + h1 + h2 + h3; unsigned S = c;
#pragma unroll
                for (int o = 1; o < 64; o <<= 1) { const unsigned t = __shfl_down(S, o); if (lane + o < 64) S += t; }
                const unsigned Snext = S - c;
                if (S >= need && Snext < need) { unsigned rem = need - Snext; unsigned bin;
                    if (h3 >= rem) bin = 3; else { rem -= h3; if (h2 >= rem) bin = 2; else { rem -= h2; if (h1 >= rem) bin = 1; else { rem -= h1; bin = 0; } } }
                    misc[0] = 4 * lane + bin; misc[1] = rem; }
            }
            __syncthreads();
            prefix |= misc[0] << (8 * pass); mask |= 0xFFu << (8 * pass); need = misc[1];
            __syncthreads();
        }
        if (set == 0) for (int s = CAP_L + (with_ctx ? CAP_C : 0) + tid; s < ESLOTS; s += NTHR) { p.IDX[e * ESLOTS + s] = 0; p.GSEL[e * ESLOTS + s] = 0.f; }
        unsigned selbase = 0u, eqbase = 0u;
        for (int base = 0; base < n; base += NTHR) {
            const int i = base + tid; const bool valid = i < n; const unsigned k = valid ? keys[i] : 0u;
            const bool eq = valid && k == prefix, gt = valid && k > prefix;
            const unsigned long long lt = (1ull << lane) - 1ull;
            const unsigned long long be = __ballot(eq);
            if (lane == 0) misc[8 + wave] = (unsigned)__popcll(be);
            __syncthreads();
            unsigned woff = 0u, tot = 0u;
#pragma unroll
            for (int w = 0; w < 8; ++w) { const unsigned v = misc[8 + w]; woff += (w < wave) ? v : 0u; tot += v; }
            const unsigned eqrank = eqbase + woff + (unsigned)__popcll(be & lt);
            const bool sel = gt || (eq && eqrank < need);
            const unsigned long long bs = __ballot(sel);
            if (lane == 0) misc[16 + wave] = (unsigned)__popcll(bs);
            __syncthreads();
            unsigned woff2 = 0u, tot2 = 0u;
#pragma unroll
            for (int w = 0; w < 8; ++w) { const unsigned v = misc[16 + w]; woff2 += (w < wave) ? v : 0u; tot2 += v; }
            if (valid) { const int row = row0 + i;
                if (sel) { const int slot = slot0 + (int)(selbase + woff2 + (unsigned)__popcll(bs & lt));
                    p.IDX[e * ESLOTS + slot] = row; p.GSEL[e * ESLOTS + slot] = __uint_as_float(k); p.INV[(size_t)row * 16 + e] = slot; }
                else p.INV[(size_t)row * 16 + e] = -1; }
            selbase += tot2; eqbase += tot;
            __syncthreads();
        }
    }
}
__device__ __forceinline__ void phase_gather(const P& p, bool with_ctx) {
    const int gw = p.bid * NWAVES + p.wave, NGW = p.G * NWAVES, lane = p.lane;
    for (int idx = gw; idx < NE * ESLOTS; idx += NGW) {
        const int slot = idx % ESLOTS; const bool valid = slot < CAP_L + (with_ctx ? CAP_C : 0);
        u32x4 a = (u32x4){0u, 0u, 0u, 0u}, b = a;
        if (valid) { const int row = p.IDX[idx]; const u32x4* s = (const u32x4*)(p.H + (size_t)row * D); a = s[lane]; b = s[64 + lane]; }
        else if (lane == 0) p.GSEL[idx] = 0.f;
        u32x4* dst = (u32x4*)(p.XE + (size_t)idx * D); dst[lane] = a; dst[64 + lane] = b;
    }
}

typedef short bf16x8 __attribute__((ext_vector_type(8)));
#define MFMA16(a, b, c) __builtin_amdgcn_mfma_f32_16x16x32_bf16((a), (b), (c), 0, 0, 0)
constexpr int LDP = 272;
constexpr int LDQ = 144;
__device__ __forceinline__ bf16x8 ld_frag(const LAS unsigned char* base, int row, int kcol, int ldb) { return *(const LAS bf16x8*)(base + row * ldb + kcol * 2); }
typedef short s16x4_t __attribute__((ext_vector_type(4)));
__device__ __forceinline__ bf16x8 tr_frag(const LAS unsigned char* img, int k0, int col0, int sb, int lane) {
    const int g = lane >> 4, q = (lane & 15) >> 2, pp = lane & 3;
    const LAS unsigned char* a = img + (k0 + 8 * g + q) * sb + (col0 + 4 * pp) * 2;
    const s16x4_t r0 = __builtin_amdgcn_ds_read_tr16_b64_v4i16((LAS s16x4_t*)a), r1 = __builtin_amdgcn_ds_read_tr16_b64_v4i16((LAS s16x4_t*)(a + 4 * sb));
    return (bf16x8){r0[0], r0[1], r0[2], r0[3], r1[0], r1[1], r1[2], r1[3]};
}
constexpr int SB64 = 144, SB128 = 304, SB256 = 560;
__device__ __forceinline__ void st_b16(LAS unsigned char* p, unsigned v) { *(LAS unsigned short*)p = (unsigned short)v; }
__device__ __forceinline__ float wscan_incl(float v, int lane) {
#pragma unroll
    for (int o = 1; o < 64; o <<= 1) { const float t = __shfl_up(v, o); if (lane >= o) v += t; }
    return v;
}
__device__ __forceinline__ int chunk_r0(int d, int cs) { return d == 0 ? 128 * cs : (cs < 2 ? 128 * (1 - cs) : 128 * (NCH + 1 - cs)); }
__device__ __forceinline__ int scan_chunk_of(int d, int cn) { return d == 0 ? cn : (cn < 2 ? 1 - cn : NCH + 1 - cn); }

__device__ __forceinline__ void ssd_acum(const float* DT, int r0, int d, int col, float a, int lane, LAS float* acum, LAS float* dtv, float& total) {
    const int j0 = d == 0 ? lane : 127 - lane, j1 = d == 0 ? 64 + lane : 63 - lane;
    const float dt0 = DT[(size_t)(r0 + j0) * 16 + col], dt1 = DT[(size_t)(r0 + j1) * 16 + col];
    const float s0 = wscan_incl(dt0 * a, lane); const float t0 = __shfl(s0, 63);
    const float s1 = wscan_incl(dt1 * a, lane) + t0; total = __shfl(s1, 63);
    acum[j0] = s0; acum[j1] = s1; dtv[j0] = dt0; dtv[j1] = dt1;
}

__device__ __forceinline__ void ssd_states(const P& p, int l, LAS unsigned char* lds, float* SST, float* DEC) {
    LAS unsigned char* Bi = lds;
    LAS unsigned char* Xi = lds + 128 * SB128;
    LAS float* wj = (LAS float*)(lds + 128 * SB128 + 128 * SB256);
    const int tid = p.tid, lane = p.lane, wave = p.wave, quad = lane >> 4, l15 = lane & 15;
    for (int u = p.bid; u < 2 * NCH * 2; u += p.G) {
        const int d = u / (2 * NCH), cs = (u % (2 * NCH)) >> 1, g = u & 1;
        const int r0 = chunk_r0(d, cs);
        __syncthreads();
        if (wave < 4) { const int h = g * 4 + wave; const float a = -expf(p.a_log[l * 16 + d * 8 + h]); float total;
            LAS float* ac = wj + 512 + wave * 128; LAS float* dv = wj + 1024 + wave * 128;
            ssd_acum(p.DT, r0, d, d * 8 + h, a, lane, ac, dv, total);
            LDS_FENCE();
            wj[wave * 128 + lane] = __expf(total - ac[lane]) * dv[lane]; wj[wave * 128 + 64 + lane] = __expf(total - ac[64 + lane]) * dv[64 + lane];
            if (lane == 0) DEC[(d * NCH + cs) * 8 + h] = expf(total); }
        for (int idx = tid; idx < 128 * 16; idx += NTHR) { const int j = idx >> 4, n8 = (idx & 15) * 8;
            *(LAS u32x4*)(Bi + j * SB128 + n8 * 2) = *(const u32x4*)(p.CV + (size_t)(r0 + j) * 1024 + 512 + g * 128 + n8); }
        __syncthreads();
        for (int idx = tid; idx < 128 * 32; idx += NTHR) { const int j = idx >> 5, c8 = (idx & 31) * 8;
            const u32x4 v = *(const u32x4*)(p.CV + (size_t)(r0 + j) * 1024 + g * 256 + c8); const float w = wj[(c8 >> 6) * 128 + j];
            u32x4 o; o.x = pk2(bflo(v.x) * w, bfhi(v.x) * w); o.y = pk2(bflo(v.y) * w, bfhi(v.y) * w); o.z = pk2(bflo(v.z) * w, bfhi(v.z) * w); o.w = pk2(bflo(v.w) * w, bfhi(v.w) * w);
            *(LAS u32x4*)(Xi + j * SB256 + c8 * 2) = o; }
        __syncthreads();
        const int hh = wave >> 1, ph = wave & 1;
        f32x4 acc[2][8];
#pragma unroll
        for (int a = 0; a < 2; ++a)
#pragma unroll
            for (int b = 0; b < 8; ++b) acc[a][b] = (f32x4){0.f, 0.f, 0.f, 0.f};
#pragma unroll
        for (int ks = 0; ks < 4; ++ks) {
            bf16x8 af[2];
#pragma unroll
            for (int pt = 0; pt < 2; ++pt) af[pt] = tr_frag(Xi, 32 * ks, hh * 64 + ph * 32 + pt * 16, SB256, lane);
#pragma unroll
            for (int nt = 0; nt < 8; ++nt) { const bf16x8 bfr = tr_frag(Bi, 32 * ks, nt * 16, SB128, lane);
#pragma unroll
                for (int pt = 0; pt < 2; ++pt) acc[pt][nt] = MFMA16(af[pt], bfr, acc[pt][nt]); }
        }
        float* S = SST + ((size_t)(d * NCH + cs) * 8 + g * 4 + hh) * 8192;
#pragma unroll
        for (int pt = 0; pt < 2; ++pt)
#pragma unroll
            for (int nt = 0; nt < 8; ++nt)
#pragma unroll
                for (int r = 0; r < 4; ++r) S[(ph * 32 + pt * 16 + 4 * quad + r) * 128 + nt * 16 + l15] = acc[pt][nt][r];
    }
}

__device__ __forceinline__ void scan_carries(const P& p, int l, const float* SST, const float* DEC, bf16* HIN) {
    for (int e = p.bid * NTHR + p.tid; e < 2 * 8 * 8192; e += p.G * NTHR) {
        const int d = e >> 16, h = (e >> 13) & 7, pn = e & 8191;
        float hs = 0.f;
        for (int c0 = 0; c0 < NCH; c0 += 10) {
            float s[10], dc[10];
#pragma unroll
            for (int j = 0; j < 10; ++j) { const size_t ci = (size_t)(d * NCH + c0 + j) * 8 + h; s[j] = SST[ci * 8192 + pn]; dc[j] = DEC[ci]; }
#pragma unroll
            for (int j = 0; j < 10; ++j) { const size_t ci = (size_t)(d * NCH + c0 + j) * 8 + h; HIN[ci * 8192 + pn] = (bf16)f2bf(hs); hs = hs * dc[j] + s[j]; }
        }
    }
    for (int e = p.bid * NTHR + p.tid; e < 2 * 32 * 64; e += p.G * NTHR) {
        const int d = e >> 11, g = (e >> 6) & 31, pq = e & 63;
        S5Lane s; s5_lane_params(p, l, d, g, pq, s, false);
        float ar = s.abr, ai = s.abi;
#pragma unroll
        for (int q = 0; q < 7; ++q) { const float nr = ar * ar - ai * ai, ni = 2.f * ar * ai; ar = nr; ai = ni; }
        float hr = 0.f, hi = 0.f;
        const float* E = p.S5E + (size_t)(d * 32 + g) * NCH * 128 + pq; float* Hn = p.S5H + (size_t)(d * 32 + g) * NCH * 128 + pq;
        for (int c0 = 0; c0 < NCH; c0 += 10) {
            float er[10], ei[10];
#pragma unroll
            for (int j = 0; j < 10; ++j) { er[j] = E[(c0 + j) * 128]; ei[j] = E[(c0 + j) * 128 + 64]; }
#pragma unroll
            for (int j = 0; j < 10; ++j) { Hn[(c0 + j) * 128] = hr; Hn[(c0 + j) * 128 + 64] = hi;
                const float nr = ar * hr - ai * hi + er[j], ni = ar * hi + ai * hr + ei[j]; hr = nr; hi = ni; }
        }
    }
}

__device__ __forceinline__ void ssd_outputs(const P& p, int l, LAS unsigned char* lds, const bf16* HIN, const float* SST, bf16* YS, int u_begin, int u_end, int first, int stride) {
    LAS unsigned char* Cm = lds;
    LAS unsigned char* Bm = lds + 128 * LDP;
    LAS unsigned char* XT = lds + 2 * 128 * LDP;
    LAS unsigned char* Wm = lds + 2 * 128 * LDP + 128 * SB64;
    LAS float* sm = (LAS float*)(lds + 3 * 128 * LDP + 128 * SB64);
    const int tid = p.tid, lane = p.lane, wave = p.wave, quad = lane >> 4, l15 = lane & 15;
    for (int u = u_begin + first; u < u_end; u += stride) {
        const int cn = u >> 3, h = u & 7, g = h >> 2, r0 = 128 * cn;
        __syncthreads();
        if (wave < 2) { const int d = wave; const float a = -expf(p.a_log[l * 16 + d * 8 + h]); float total;
            ssd_acum(p.DT, r0, d, d * 8 + h, a, lane, sm + d * 128, sm + 256 + d * 128, total); }
        for (int idx = tid; idx < 128 * 16; idx += NTHR) { const int j = idx >> 4, n8 = (idx & 15) * 8;
            const bf16* src = p.CV + (size_t)(r0 + j) * 1024 + g * 128 + n8;
            *(LAS u32x4*)(Bm + j * LDP + n8 * 2) = *(const u32x4*)(src + 512); *(LAS u32x4*)(Cm + j * LDP + n8 * 2) = *(const u32x4*)(src + 768); }
        for (int idx = tid; idx < 128 * 8; idx += NTHR) { const int j = idx >> 3, p8 = (idx & 7) * 8;
            *(LAS u32x4*)(XT + j * SB64 + p8 * 2) = *(const u32x4*)(p.CV + (size_t)(r0 + j) * 1024 + h * 64 + p8); }
        __syncthreads();
        f32x4 G[8];
#pragma unroll
        for (int jt = 0; jt < 8; ++jt) G[jt] = (f32x4){0.f, 0.f, 0.f, 0.f};
#pragma unroll
        for (int ks = 0; ks < 4; ++ks) { const bf16x8 af = ld_frag(Cm, 16 * wave + l15, ks * 32 + 8 * quad, LDP);
#pragma unroll
            for (int jt = 0; jt < 8; ++jt) G[jt] = MFMA16(af, ld_frag(Bm, 16 * jt + l15, ks * 32 + 8 * quad, LDP), G[jt]); }
        __syncthreads();
        for (int idx = tid; idx < 2 * 64 * 16; idx += NTHR) { const int d = idx >> 10, pp = (idx >> 4) & 63, n8 = (idx & 15) * 8;
            const int cs = scan_chunk_of(d, cn);
            u32x4 w;
            if (cn >= 2) w = *(const u32x4*)(HIN + ((size_t)(d * NCH + cs) * 8 + h) * 8192 + pp * 128 + n8);
            else if (cs == 0) w = (u32x4){0u, 0u, 0u, 0u};
            else { const float* s = SST + ((size_t)(d * NCH) * 8 + h) * 8192 + pp * 128 + n8; const f32x4 s0 = *(const f32x4*)s, s1 = *(const f32x4*)(s + 4);
                w.x = pk2(s0[0], s0[1]); w.y = pk2(s0[2], s0[3]); w.z = pk2(s1[0], s1[1]); w.w = pk2(s1[2], s1[3]); }
            *(LAS u32x4*)(Bm + (d * 64 + pp) * LDP + n8 * 2) = w; }
        __syncthreads();
        f32x4 Y[4];
#pragma unroll
        for (int pt = 0; pt < 4; ++pt) Y[pt] = (f32x4){0.f, 0.f, 0.f, 0.f};
#pragma unroll
        for (int d = 0; d < 2; ++d) {
            const LAS float* ac = sm + d * 128; const LAS float* dv = sm + 256 + d * 128;
            float ai[4];
#pragma unroll
            for (int r = 0; r < 4; ++r) ai[r] = ac[16 * wave + 4 * quad + r];
#pragma unroll
            for (int jt = 0; jt < 8; ++jt) { const int j = 16 * jt + l15; const float aj = ac[j], dj = dv[j];
#pragma unroll
                for (int r = 0; r < 4; ++r) { const int i = 16 * wave + 4 * quad + r; const bool valid = (d == 0) ? (j <= i) : (j >= i);
                    const float w = valid ? G[jt][r] * __expf(ai[r] - aj) * dj : 0.f;
                    st_b16(Wm + i * LDP + 2 * j, f2bf(w)); } }
            LDS_FENCE();
            f32x4 Y2[4];
#pragma unroll
            for (int pt = 0; pt < 4; ++pt) Y2[pt] = (f32x4){0.f, 0.f, 0.f, 0.f};
#pragma unroll
            for (int ks = 0; ks < 4; ++ks) { const bf16x8 wf = ld_frag(Wm, 16 * wave + l15, ks * 32 + 8 * quad, LDP), cf = ld_frag(Cm, 16 * wave + l15, ks * 32 + 8 * quad, LDP);
#pragma unroll
                for (int pt = 0; pt < 4; ++pt) { Y[pt] = MFMA16(wf, tr_frag(XT, 32 * ks, 16 * pt, SB64, lane), Y[pt]);
                    Y2[pt] = MFMA16(cf, ld_frag(Bm + d * 64 * LDP, 16 * pt + l15, ks * 32 + 8 * quad, LDP), Y2[pt]); } }
#pragma unroll
            for (int r = 0; r < 4; ++r) { const float ea = __expf(ai[r]);
#pragma unroll
                for (int pt = 0; pt < 4; ++pt) Y[pt][r] += ea * Y2[pt][r]; }
            LDS_FENCE();
        }
#pragma unroll
        for (int pt = 0; pt < 4; ++pt)
#pragma unroll
            for (int r = 0; r < 4; ++r) YS[(size_t)(r0 + 16 * wave + 4 * quad + r) * 512 + h * 64 + 16 * pt + l15] = (bf16)f2bf(Y[pt][r]);
    }
}

__device__ __forceinline__ void ssd_gated_norm(const P& p, int l, const bf16* YS) {
    const int gw = p.bid * NWAVES + p.wave, NGW = p.G * NWAVES, lane = p.lane;
    for (int row = gw; row < T; row += NGW) {
        const int ch = lane * 8;
        const float dsk = p.ssd_d[l * 8 + (ch >> 6)];
        const u32x4 yv = *(const u32x4*)(YS + (size_t)row * 512 + ch);
        const u32x4 xs = *(const u32x4*)(p.CV + (size_t)row * 1024 + ch), zz = *(const u32x4*)(p.PROJ + (size_t)row * PJ + Z0 + ch);
        float v[8];
        v[0] = (bflo(yv.x) + dsk * bflo(xs.x)) * silu_f(bflo(zz.x)); v[1] = (bfhi(yv.x) + dsk * bfhi(xs.x)) * silu_f(bfhi(zz.x));
        v[2] = (bflo(yv.y) + dsk * bflo(xs.y)) * silu_f(bflo(zz.y)); v[3] = (bfhi(yv.y) + dsk * bfhi(xs.y)) * silu_f(bfhi(zz.y));
        v[4] = (bflo(yv.z) + dsk * bflo(xs.z)) * silu_f(bflo(zz.z)); v[5] = (bfhi(yv.z) + dsk * bfhi(xs.z)) * silu_f(bfhi(zz.z));
        v[6] = (bflo(yv.w) + dsk * bflo(xs.w)) * silu_f(bflo(zz.w)); v[7] = (bfhi(yv.w) + dsk * bfhi(xs.w)) * silu_f(bfhi(zz.w));
        float ss = 0.f;
#pragma unroll
        for (int i = 0; i < 8; ++i) ss += v[i] * v[i];
        const float rstd = rsqrtf(wsum(ss) * (1.f / 512.f) + EPS);
        const float* ng = p.ssd_norm_g + (size_t)l * 512 + ch;
        const f32x4 g0 = *(const f32x4*)ng, g1 = *(const f32x4*)(ng + 4);
        u32x4 o; o.x = pk2(v[0] * rstd * g0[0], v[1] * rstd * g0[1]); o.y = pk2(v[2] * rstd * g0[2], v[3] * rstd * g0[3]);
        o.z = pk2(v[4] * rstd * g1[0], v[5] * rstd * g1[1]); o.w = pk2(v[6] * rstd * g1[2], v[7] * rstd * g1[3]);
        *(u32x4*)(p.Y3 + (size_t)row * 1536 + 512 + ch) = o;
    }
}

__device__ __forceinline__ void attention_mfma(const P& p, int l, LAS unsigned char* lds, int u_begin, int u_end, int u_first, int u_stride) {
    LAS unsigned char* Kt = lds;
    LAS unsigned char* VT = lds + 64 * LDQ;
    LAS unsigned char* Pw = lds + 2 * 64 * LDQ + p.wave * 64 * LDQ;
    const int tid = p.tid, lane = p.lane, wave = p.wave, quad = lane >> 4, l15 = lane & 15;
    const float C2 = 0.125f * 1.4426950408889634f;
    for (int u = u_begin + u_first; u < u_end; u += u_stride) {
        const int qb = u >> 1, kvh = u & 1, hq = kvh * 4 + (wave >> 1);
        const bool isc = qb < 2; const int nb = qb - 2;
        const int qrow0 = 128 * qb + 64 * (wave & 1);
        bf16x8 Qf[4][2];
#pragma unroll
        for (int qt = 0; qt < 4; ++qt)
#pragma unroll
            for (int ks = 0; ks < 2; ++ks) Qf[qt][ks] = *(const bf16x8*)(p.PROJ + (size_t)(qrow0 + 16 * qt + l15) * PJ + Q0 + hq * 64 + ks * 32 + 8 * quad);
        f32x4 O[4][4];
#pragma unroll
        for (int a = 0; a < 4; ++a)
#pragma unroll
            for (int b = 0; b < 4; ++b) O[a][b] = (f32x4){0.f, 0.f, 0.f, 0.f};
        float mrow[4], lrow[4];
        const float sk = p.sink[l * 8 + hq] * 1.4426950408889634f;
#pragma unroll
        for (int qt = 0; qt < 4; ++qt) { mrow[qt] = sk; lrow[qt] = 1.f; }
        const int ntile = isc ? 4 : 10;
#define ATT_VALID(ti_) (isc || (ti_) >= 6 || ((NCTX + 128 * (nb - 1) + 64 * (ti_)) >= NCTX && (NCTX + 128 * (nb - 1) + 64 * (ti_)) < T))
#define ATT_KROW0(ti_) ((isc || (ti_) >= 6) ? 64 * (isc ? (ti_) : (ti_) - 6) : NCTX + 128 * (nb - 1) + 64 * (ti_))
        int ti = 0; while (!ATT_VALID(ti)) ++ti;
        u32x4 kreg, vreg;
        { const bf16* src = p.PROJ + (size_t)(ATT_KROW0(ti) + (tid >> 3)) * PJ + kvh * 64 + (tid & 7) * 8; kreg = *(const u32x4*)(src + K0); vreg = *(const u32x4*)(src + V0); }
        while (ti < ntile) {
            const int krow0 = ATT_KROW0(ti); const bool local = !(isc || ti >= 6);
            int tn = ti + 1; while (tn < ntile && !ATT_VALID(tn)) ++tn;
            __syncthreads();
            { const int key = tid >> 3, pc = tid & 7;
              *(LAS u32x4*)(Kt + key * LDQ + pc * 16) = kreg;
              *(LAS u32x4*)(VT + key * SB64 + pc * 16) = vreg; }
            __syncthreads();
            if (tn < ntile) { const bf16* src = p.PROJ + (size_t)(ATT_KROW0(tn) + (tid >> 3)) * PJ + kvh * 64 + (tid & 7) * 8; kreg = *(const u32x4*)(src + K0); vreg = *(const u32x4*)(src + V0); }
            const bool need_mask = local && (ti < 2 || ti > 3);
#pragma unroll
            for (int qt = 0; qt < 4; ++qt) {
                f32x4 S[4][1];
#pragma unroll
                for (int kt = 0; kt < 4; ++kt) S[kt][0] = (f32x4){0.f, 0.f, 0.f, 0.f};
#pragma unroll
                for (int ks = 0; ks < 2; ++ks)
#pragma unroll
                    for (int kt = 0; kt < 4; ++kt) S[kt][0] = MFMA16(ld_frag(Kt, 16 * kt + l15, ks * 32 + 8 * quad, LDQ), Qf[qt][ks], S[kt][0]);
                const int tq = qrow0 + 16 * qt + l15;
                float mx = -1e30f;
                if (need_mask) {
#pragma unroll
                    for (int kt = 0; kt < 4; ++kt)
#pragma unroll
                        for (int r = 0; r < 4; ++r) { const int df = tq - (krow0 + 16 * kt + 4 * quad + r);
                            const float s = (df <= 128 && df >= -128) ? S[kt][0][r] : -1e30f; S[kt][0][r] = s; mx = fmaxf(mx, s); }
                } else {
#pragma unroll
                    for (int kt = 0; kt < 4; ++kt) mx = fmaxf(fmaxf(mx, fmaxf(S[kt][0][0], S[kt][0][1])), fmaxf(S[kt][0][2], S[kt][0][3]));
                }
                mx = fmaxf(mx, __shfl_xor(mx, 16)); mx = fmaxf(mx, __shfl_xor(mx, 32));
                const float mn = fmaxf(mrow[qt], mx * C2), alpha = __builtin_amdgcn_exp2f(mrow[qt] - mn);
                float ls = 0.f;
#pragma unroll
                for (int kt = 0; kt < 4; ++kt) { const float e0 = __builtin_amdgcn_exp2f(S[kt][0][0] * C2 - mn), e1 = __builtin_amdgcn_exp2f(S[kt][0][1] * C2 - mn),
                                                              e2 = __builtin_amdgcn_exp2f(S[kt][0][2] * C2 - mn), e3 = __builtin_amdgcn_exp2f(S[kt][0][3] * C2 - mn);
                    ls += (e0 + e1) + (e2 + e3);
                    u32x2 w; w.x = pk2(e0, e1); w.y = pk2(e2, e3);
                    *(LAS u32x2*)(Pw + (16 * qt + l15) * LDQ + (16 * kt + 4 * quad) * 2) = w; }
                ls += __shfl_xor(ls, 16); ls += __shfl_xor(ls, 32);
                lrow[qt] = lrow[qt] * alpha + ls; mrow[qt] = mn;
#pragma unroll
                for (int dt = 0; dt < 4; ++dt) O[dt][qt] *= alpha;
            }
            LDS_FENCE();
#pragma unroll
            for (int ks = 0; ks < 2; ++ks) {
                bf16x8 pf[4];
#pragma unroll
                for (int qt = 0; qt < 4; ++qt) pf[qt] = ld_frag(Pw, 16 * qt + l15, ks * 32 + 8 * quad, LDQ);
#pragma unroll
                for (int dt = 0; dt < 4; ++dt) { const bf16x8 vf = tr_frag(VT, 32 * ks, 16 * dt, SB64, lane);
#pragma unroll
                    for (int qt = 0; qt < 4; ++qt) O[dt][qt] = MFMA16(vf, pf[qt], O[dt][qt]); }
            }
            LDS_FENCE();
            ti = tn;
        }
#undef ATT_VALID
#undef ATT_KROW0
#pragma unroll
        for (int qt = 0; qt < 4; ++qt) { const float inv = 1.f / lrow[qt];
            bf16* orow = p.Y3 + (size_t)(qrow0 + 16 * qt + l15) * 1536 + 1024 + hq * 64;
#pragma unroll
            for (int dt = 0; dt < 4; ++dt) { u32x2 w; w.x = pk2(O[dt][qt][0] * inv, O[dt][qt][1] * inv); w.y = pk2(O[dt][qt][2] * inv, O[dt][qt][3] * inv);
                *(u32x2*)(orow + 16 * dt + 4 * quad) = w; } }
    }
}

#ifndef S5_INTERLEAVE
#define S5_INTERLEAVE 2
#endif
constexpr size_t S5BB_ELEMS = (size_t)2 * 32 * 128 * 32, S5CC_ELEMS = (size_t)2 * 32 * 16 * 128;
__device__ __forceinline__ void s5_tables(const P& p, int l, bf16* BB, bf16* CC, float* AB) {
    for (int e = p.bid * NTHR + p.tid; e < 2 * 32 * 64; e += p.G * NTHR) {
        const int d = e >> 11, g = (e >> 6) & 31, pq = e & 63, dg = d * 32 + g;
        S5Lane s; s5_lane_params(p, l, d, g, pq, s, true);
        AB[(size_t)e * 2] = s.abr; AB[(size_t)e * 2 + 1] = s.abi;
        #if S5_INTERLEAVE
        u32x4* br = (u32x4*)(BB + ((size_t)dg * 128 + 2 * pq) * 32); u32x4* bi = (u32x4*)(BB + ((size_t)dg * 128 + 2 * pq + 1) * 32);
#else
        u32x4* br = (u32x4*)(BB + ((size_t)dg * 128 + pq) * 32); u32x4* bi = (u32x4*)(BB + ((size_t)dg * 128 + 64 + pq) * 32);
#endif
        u32x4 w;
        w.x = pk2(s.bbr[0], s.bbr[1]); w.y = pk2(s.bbr[2], s.bbr[3]); w.z = pk2(s.bbr[4], s.bbr[5]); w.w = pk2(s.bbr[6], s.bbr[7]); br[0] = w;
        w.x = pk2(s.bbr[8], s.bbr[9]); w.y = pk2(s.bbr[10], s.bbr[11]); w.z = pk2(s.bbr[12], s.bbr[13]); w.w = pk2(s.bbr[14], s.bbr[15]); br[1] = w;
        w.x = pk2(s.bbi[0], s.bbi[1]); w.y = pk2(s.bbi[2], s.bbi[3]); w.z = pk2(s.bbi[4], s.bbi[5]); w.w = pk2(s.bbi[6], s.bbi[7]); bi[0] = w;
        w.x = pk2(s.bbi[8], s.bbi[9]); w.y = pk2(s.bbi[10], s.bbi[11]); w.z = pk2(s.bbi[12], s.bbi[13]); w.w = pk2(s.bbi[14], s.bbi[15]); bi[1] = w;
        const u32x4 z = (u32x4){0u, 0u, 0u, 0u}; br[2] = z; br[3] = z; bi[2] = z; bi[3] = z;
        const size_t ci = ((size_t)(l * 2 + d) * 32 + g) * 16;
#pragma unroll
        for (int k = 0; k < 16; ++k) {
#if S5_INTERLEAVE
            *(unsigned*)(CC + ((size_t)dg * 16 + k) * 128 + 2 * pq) = pk2(p.c_re[(ci + k) * 64 + pq], -p.c_im[(ci + k) * 64 + pq]);
#else
            CC[((size_t)dg * 16 + k) * 128 + pq] = (bf16)f2bf(p.c_re[(ci + k) * 64 + pq]); CC[((size_t)dg * 16 + k) * 128 + 64 + pq] = (bf16)f2bf(-p.c_im[(ci + k) * 64 + pq]);
#endif
        }
    }
}
constexpr int S5_WREG = 4096 + 16 * 132 * 4 + 16 * LDP;
template <bool READOUT> __device__ __forceinline__ void s5_chunk_dir(int d, const bf16* BBdg, const bf16* CCdg, float abr, float abi, LAS unsigned char* wreg, int lane, float& hr, float& hi, f32x4 (&yacc)[8]) {
    const int quad = lane >> 4, l15 = lane & 15;
    LAS unsigned char* ub = wreg; LAS float* BuW = (LAS float*)(wreg + 4096); LAS unsigned char* Hw = wreg + 4096 + 16 * 132 * 4;
    bf16x8 BBf[8], CCf[4];
#pragma unroll
    for (int pt = 0; pt < 8; ++pt) BBf[pt] = *(const bf16x8*)(BBdg + (size_t)(16 * pt + l15) * 32 + 8 * quad);
    if (READOUT) {
#pragma unroll
        for (int ks = 0; ks < 4; ++ks) CCf[ks] = *(const bf16x8*)(CCdg + (size_t)l15 * 128 + ks * 32 + 8 * quad);
    }
#pragma unroll (READOUT ? 8 : 1)
    for (int ss = 0; ss < 8; ++ss) {
        const int sc = d ? 7 - ss : ss;
        bf16x8 uf = (bf16x8){0, 0, 0, 0, 0, 0, 0, 0};
        if (quad < 2) uf = *(const LAS bf16x8*)(ub + (16 * sc + l15) * 32 + quad * 16);
#pragma unroll
        for (int pt = 0; pt < 8; ++pt) { const f32x4 Dp = MFMA16(uf, BBf[pt], ((f32x4){0.f, 0.f, 0.f, 0.f}));
#pragma unroll
            for (int r = 0; r < 4; ++r) BuW[(4 * quad + r) * 132 + 16 * pt + l15] = Dp[r]; }
        LDS_FENCE();
#pragma unroll
        for (int st = 0; st < 16; ++st) { const int tl = d ? 15 - st : st;
#if S5_INTERLEAVE == 1
            typedef float f32x2_t __attribute__((ext_vector_type(2)));
            const f32x2_t bu = *(const LAS f32x2_t*)(BuW + tl * 132 + 2 * lane);
            const float nr = abr * hr - abi * hi + bu[0], ni = abr * hi + abi * hr + bu[1]; hr = nr; hi = ni;
            if (READOUT) *(LAS unsigned*)(Hw + tl * LDP + 4 * lane) = pk2(hr, hi); }
#elif S5_INTERLEAVE == 2
            const float br = BuW[tl * 132 + 2 * lane], bi = BuW[tl * 132 + 2 * lane + 1];
            const float nr = abr * hr - abi * hi + br, ni = abr * hi + abi * hr + bi; hr = nr; hi = ni;
            if (READOUT) *(LAS unsigned*)(Hw + tl * LDP + 4 * lane) = pk2(hr, hi); }
#else
            const float br = BuW[tl * 132 + lane], bi = BuW[tl * 132 + 64 + lane];
            const float nr = abr * hr - abi * hi + br, ni = abr * hi + abi * hr + bi; hr = nr; hi = ni;
            if (READOUT) { st_b16(Hw + tl * LDP + 2 * lane, f2bf(hr)); st_b16(Hw + tl * LDP + 128 + 2 * lane, f2bf(hi)); } }
#endif
        if (READOUT) {
            LDS_FENCE();
#pragma unroll
            for (int ks = 0; ks < 4; ++ks) yacc[sc] = MFMA16(ld_frag(Hw, l15, ks * 32 + 8 * quad, LDP), CCf[ks], yacc[sc]);
        }
        LDS_FENCE();
    }
}
__device__ __forceinline__ void s5_local_states(const P& p, LAS unsigned char* lds, const bf16* BB, const float* AB) {
    LAS unsigned char* wreg = lds + p.wave * S5_WREG;
    const int gw = p.bid * NWAVES + p.wave, NGW = p.G * NWAVES, lane = p.lane;
    for (int it = gw; it < 2 * 32 * NCH; it += NGW) {
        const int d = it / (32 * NCH), c = (it % (32 * NCH)) >> 5, g = it & 31, dg = d * 32 + g;
        s5_stage_u(p, chunk_r0(d, c), g, wreg, lane);
        float hr = 0.f, hi = 0.f; f32x4 dummy[8];
        const float abr = AB[((size_t)dg * 64 + lane) * 2], abi = AB[((size_t)dg * 64 + lane) * 2 + 1];
        if (d == 0) s5_chunk_dir<false>(0, BB + (size_t)dg * 128 * 32, nullptr, abr, abi, wreg, lane, hr, hi, dummy);
        else s5_chunk_dir<false>(1, BB + (size_t)dg * 128 * 32, nullptr, abr, abi, wreg, lane, hr, hi, dummy);
        float* E = p.S5E + ((size_t)dg * NCH + c) * 128;
        E[lane] = hr; E[64 + lane] = hi;
    }
}
__device__ __forceinline__ void s5_outputs(const P& p, int l, LAS unsigned char* lds, const bf16* BB, const bf16* CC, const float* AB, int it_begin, int it_end, int first, int stride) {
    LAS unsigned char* wreg = lds + p.wave * S5_WREG;
    const int lane = p.lane, quad = lane >> 4, l15 = lane & 15;
    for (int it = it_begin + first; it < it_end; it += stride) {
        const int cn = it >> 5, g = it & 31, r0 = 128 * cn;
        s5_stage_u(p, r0, g, wreg, lane);
        f32x4 yacc[8];
#pragma unroll
        for (int i = 0; i < 8; ++i) yacc[i] = (f32x4){0.f, 0.f, 0.f, 0.f};
#pragma unroll
        for (int d = 0; d < 2; ++d) { const int dg = d * 32 + g, cs = scan_chunk_of(d, cn);
            const float* Hn = (cn < 2) ? (p.S5E + (size_t)dg * NCH * 128) : (p.S5H + ((size_t)dg * NCH + cs) * 128);
            float hr = Hn[lane], hi = Hn[64 + lane];
            if (cs == 0) { hr = 0.f; hi = 0.f; }
            s5_chunk_dir<true>(d, BB + (size_t)dg * 128 * 32, CC + (size_t)dg * 16 * 128, AB[((size_t)dg * 64 + lane) * 2], AB[((size_t)dg * 64 + lane) * 2 + 1], wreg, lane, hr, hi, yacc); }
        const float dsk = p.s5_d[(size_t)l * 512 + g * 16 + l15];
#pragma unroll
        for (int sc = 0; sc < 8; ++sc)
#pragma unroll
            for (int r = 0; r < 4; ++r) { const int t = 16 * sc + 4 * quad + r;
                const float u = bf2f(*(const LAS unsigned short*)(wreg + t * 32 + 2 * l15));
                p.SA[(size_t)(r0 + t) * 512 + g * 16 + l15] = (bf16)f2bf(gelu_tanh_f(yacc[sc][r] + dsk * u)); }
        LDS_FENCE();
    }
}

template <int NT, class Epi>
__device__ __forceinline__ void small_gemm(const P& p, LAS unsigned char* lds, const bf16* A, int lda, const bf16* Bt, int ldb, int K, int kc_per_seg, const Epi& E, const int* aidx = nullptr) {
    LAS unsigned char* As = lds;
    LAS unsigned char* Bs = lds + 64 * LDP;
    const int tid = p.tid, lane = p.lane, wave = p.wave, quad = lane >> 4, l15 = lane & 15;
    f32x4 acc[NT][4], sum[NT][4];
#pragma unroll
    for (int a = 0; a < NT; ++a)
#pragma unroll
        for (int b = 0; b < 4; ++b) { acc[a][b] = (f32x4){0.f, 0.f, 0.f, 0.f}; sum[a][b] = (f32x4){0.f, 0.f, 0.f, 0.f}; }
    const int nch = K >> 7, prow = tid >> 4, pc = (tid & 15) * 8;
    u32x4 ra[2], rb[4 * NT]; int arow[2];
#pragma unroll
    for (int i = 0; i < 2; ++i) arow[i] = aidx ? aidx[prow + 32 * i] : prow + 32 * i;
#pragma unroll
    for (int i = 0; i < 2; ++i) ra[i] = *(const u32x4*)(A + (size_t)arow[i] * lda + pc);
#pragma unroll
    for (int i = 0; i < 4 * NT; ++i) rb[i] = *(const u32x4*)(Bt + (size_t)(prow + 32 * i) * ldb + pc);
    for (int kc = 0; kc < nch; ++kc) {
        __syncthreads();
#pragma unroll
        for (int i = 0; i < 2; ++i) *(LAS u32x4*)(As + (prow + 32 * i) * LDP + pc * 2) = ra[i];
#pragma unroll
        for (int i = 0; i < 4 * NT; ++i) *(LAS u32x4*)(Bs + (prow + 32 * i) * LDP + pc * 2) = rb[i];
        __syncthreads();
        if (kc + 1 < nch) {
#pragma unroll
            for (int i = 0; i < 2; ++i) ra[i] = *(const u32x4*)(A + (size_t)arow[i] * lda + (kc + 1) * 128 + pc);
#pragma unroll
            for (int i = 0; i < 4 * NT; ++i) rb[i] = *(const u32x4*)(Bt + (size_t)(prow + 32 * i) * ldb + (kc + 1) * 128 + pc);
        }
#pragma unroll
        for (int ks = 0; ks < 4; ++ks) {
            bf16x8 af[4];
#pragma unroll
            for (int mt = 0; mt < 4; ++mt) af[mt] = ld_frag(As, 16 * mt + l15, ks * 32 + 8 * quad, LDP);
#pragma unroll
            for (int nt = 0; nt < NT; ++nt) { const bf16x8 bfr = ld_frag(Bs, 128 * nt + 16 * wave + l15, ks * 32 + 8 * quad, LDP);
#pragma unroll
                for (int mt = 0; mt < 4; ++mt) acc[nt][mt] = MFMA16(af[mt], bfr, acc[nt][mt]); }
        }
        if ((kc + 1) % kc_per_seg == 0) E.seg(acc, sum, kc / kc_per_seg, wave, quad, l15);
    }
    E.fin(acc, sum, wave, quad, l15);
    __syncthreads();
}
struct SgMerge {
    const bf16* proj; bf16* MB; int rb, cc;
    __device__ __forceinline__ void seg(f32x4 (&acc)[1][4], f32x4 (&sum)[1][4], int s, int wave, int quad, int l15) const {
#pragma unroll
        for (int mt = 0; mt < 4; ++mt)
#pragma unroll
            for (int r = 0; r < 4; ++r) { const int row = rb * 64 + 16 * mt + 4 * quad + r, col = cc * 128 + 16 * wave + l15;
                sum[0][mt][r] += bf2f(proj[(size_t)row * PJ + GT0 + s * 1024 + col]) * acc[0][mt][r]; acc[0][mt][r] = 0.f; }
    }
    __device__ __forceinline__ void fin(f32x4 (&acc)[1][4], f32x4 (&sum)[1][4], int wave, int quad, int l15) const {
#pragma unroll
        for (int mt = 0; mt < 4; ++mt)
#pragma unroll
            for (int r = 0; r < 4; ++r) MB[(size_t)(rb * 64 + 16 * mt + 4 * quad + r) * 1024 + cc * 128 + 16 * wave + l15] = (bf16)f2bf(sum[0][mt][r]);
    }
};
struct SgResid {
    float* XC; const float* g; int rb, cc;
    __device__ __forceinline__ void seg(f32x4 (&)[1][4], f32x4 (&)[1][4], int, int, int, int) const {}
    __device__ __forceinline__ void fin(f32x4 (&acc)[1][4], f32x4 (&)[1][4], int wave, int quad, int l15) const {
        const int col = cc * 128 + 16 * wave + l15; const float gv = g[col];
#pragma unroll
        for (int mt = 0; mt < 4; ++mt)
#pragma unroll
            for (int r = 0; r < 4; ++r) { float* px = XC + (size_t)(rb * 64 + 16 * mt + 4 * quad + r) * 1024 + col; *px += gv * acc[0][mt][r]; }
    }
};
struct SgSwiGlu {
    bf16* HID; int row0, t;
    __device__ __forceinline__ void seg(f32x4 (&)[2][4], f32x4 (&)[2][4], int, int, int, int) const {}
    __device__ __forceinline__ void fin(f32x4 (&acc)[2][4], f32x4 (&)[2][4], int wave, int quad, int l15) const {
#pragma unroll
        for (int mt = 0; mt < 4; ++mt)
#pragma unroll
            for (int r = 0; r < 4; ++r) HID[(size_t)(row0 + 16 * mt + 4 * quad + r) * 1024 + 128 * t + 16 * wave + l15] = (bf16)f2bf(silu_f(acc[0][mt][r]) * acc[1][mt][r]);
    }
};
struct SgDown {
    bf16* YE; const float* gsel; int row0, cc;
    __device__ __forceinline__ void seg(f32x4 (&)[1][4], f32x4 (&)[1][4], int, int, int, int) const {}
    __device__ __forceinline__ void fin(f32x4 (&acc)[1][4], f32x4 (&)[1][4], int wave, int quad, int l15) const {
#pragma unroll
        for (int mt = 0; mt < 4; ++mt)
#pragma unroll
            for (int r = 0; r < 4; ++r) { const int row = row0 + 16 * mt + 4 * quad + r; YE[(size_t)row * 1024 + cc * 128 + 16 * wave + l15] = (bf16)f2bf(acc[0][mt][r] * gsel[row]); }
    }
};

#ifndef SKIPMASK
#define SKIPMASK 0
#endif
struct Args { const float* in[33]; float* out; unsigned char* ws; int ph_lo, ph_hi; };
static_assert(sizeof(Args) == 35 * 8 + 8, "no padding");

__global__ void __launch_bounds__(NTHR, 2) fwd_kernel(Args args) {
    extern __shared__ __attribute__((aligned(16))) unsigned char lds_raw[];
    LAS unsigned char* lds = (LAS unsigned char*)lds_raw;
    const int tid_ = threadIdx.x;
    if (tid_ == 0) {
        LAS unsigned long long* tab = (LAS unsigned long long*)(lds + PTAB_OFF);
#pragma unroll
        for (int k = 0; k < 33; ++k) tab[k] = (unsigned long long)args.in[k];
        tab[33] = (unsigned long long)args.out; tab[34] = (unsigned long long)args.ws;
    }
    volatile LAS unsigned* MISC = (volatile LAS unsigned*)(lds + MISC_OFF);
    if (tid_ < 64) MISC[tid_] = 0u;
    __syncthreads();
    XcdBarrier bar; bar.bar = (unsigned*)(args.ws + WS_CTL) + CW_BAR; bar.x = 0; bar.st = nullptr;
    if (!MK_PER_PHASE) bar = xcd_barrier_post((unsigned*)(args.ws + WS_CTL) + CW_BAR, MISC + 8);

    const int lo = args.ph_lo, hi = args.ph_hi;
#define IN(k) (lo <= (k) && (k) < hi)
#define SEAM(k) do { if (!MK_PER_PHASE && (k) + 1 < hi) xcd_barrier(bar); } while (0)

    if (IN(0)) { P p; build_P(p, lds, 0); phase_mod(p, lds, (float*)(args.ws + WS_ROPE)); __syncthreads(); convert_weights(p, 0, lds, p.bid * NWAVES + p.wave, p.G * NWAVES); SEAM(0); }

#ifndef REPSUB
#define REPSUB 0
#endif
#define RSUB(b, ...) for (int r2_ = 0; r2_ <= ((REPSUB >> (b)) & 1); ++r2_) { __VA_ARGS__; __syncthreads(); }
#ifndef REPMASK
#define REPMASK 0
#endif
#define PHASE(k, ...) if (!((SKIPMASK >> (k)) & 1) && IN(pb + (k))) { for (int rep_ = 0; rep_ <= ((REPMASK >> (k)) & 1); ++rep_) { P p; build_P(p, lds, l & 1); __VA_ARGS__; \
        if (rep_ < ((REPMASK >> (k)) & 1)) xcd_barrier(bar); } SEAM(pb + (k)); }
    for (int l = 0; l < DEPTH; ++l) {
        const int pb = 1 + NPH_LAYER * l;
        const bool cx = l < DEPTH - 1;
        unsigned char* wsb; { unsigned tb_ = (unsigned)(size_t)(lds + PTAB_OFF); asm volatile("" : "+v"(tb_)); wsb = (unsigned char*)ld_tab((volatile LAS unsigned*)(size_t)tb_, 34); }
        PHASE(0, s5_tables(p, l, (bf16*)(wsb + WS_S5BB), (bf16*)(wsb + WS_S5CC), (float*)(wsb + WS_S5AB)); __syncthreads(); row_pass<0>(p, l, lds, true, rep_ < ((REPMASK >> 0) & 1)))
        PHASE(1, pg8::Gemm g{p.H, p.WIN, T, PJ, D}; pg8::StaticOrder S; S.init(T, PJ, p.G, p.bid); pg8::EpiStoreBf16 E{p.PROJ, PJ, GT0 / 256, (const float*)(wsb + WS_ROPE)};
            pg8::gemm_phase<pg8::EpiStoreBf16, pg8::StaticOrder, false>(lds, g, S, E, nullptr))
        PHASE(2, RSUB(2, phase_premix(p, l, lds)) RSUB(3, s5_local_states(p, lds, (const bf16*)(wsb + WS_S5BB), (const float*)(wsb + WS_S5AB))))
        PHASE(3, RSUB(0, ssd_states(p, l, lds, (float*)(wsb + WS_SST), (float*)(wsb + WS_DEC))) RSUB(1, attention_mfma(p, l, lds, 4, 2 * NCH, p.bid, p.G)))
        PHASE(4, if (cx) { if (p.bid >= p.G - 4) attention_mfma(p, l, lds, 0, 4, p.bid - (p.G - 4), 4);
                else if (p.bid >= p.G - 20) ssd_outputs(p, l, lds, (const bf16*)(wsb + WS_HIN), (const float*)(wsb + WS_SST), (bf16*)(wsb + WS_YS), 0, 16, p.bid - (p.G - 20), 16);
                else if (p.bid >= p.G - 28) s5_outputs(p, l, lds, (const bf16*)(wsb + WS_S5BB), (const bf16*)(wsb + WS_S5CC), (const float*)(wsb + WS_S5AB), 0, 64, (p.bid - (p.G - 28)) * NWAVES + p.wave, 64); }
            scan_carries(p, l, (const float*)(wsb + WS_SST), (const float*)(wsb + WS_DEC), (bf16*)(wsb + WS_HIN)))
        PHASE(5, RSUB(4, ssd_outputs(p, l, lds, (const bf16*)(wsb + WS_HIN), (const float*)(wsb + WS_SST), (bf16*)(wsb + WS_YS), 16, NCH * 8, p.bid, p.G))
            RSUB(5, s5_outputs(p, l, lds, (const bf16*)(wsb + WS_S5BB), (const bf16*)(wsb + WS_S5CC), (const float*)(wsb + WS_S5AB), 64, 32 * NCH, p.bid * NWAVES + p.wave, p.G * NWAVES)))
        PHASE(6, pg8::Gemm g{p.SA, p.WGLU, T, 512, 512}; pg8::RowOffOrder S; S.init(cx ? T : NLAT, 512, p.G, p.bid, cx ? 0 : 1); pg8::EpiGlu E{p.SA, p.b_glu + (size_t)l * 512, p.Y3};
            pg8::gemm_phase<pg8::EpiGlu, pg8::RowOffOrder, false>(lds, g, S, E, nullptr); ssd_gated_norm(p, l, (const bf16*)(wsb + WS_YS)))
        PHASE(7, pg8::Gemm g{p.Y3, p.WBR, T, D, 1536}; pg8::RowOffOrder S; S.init(NLAT, D, p.G, p.bid, 1); pg8::EpiMerge E{p.PROJ, p.MB};
            pg8::gemm_phase<pg8::EpiMerge, pg8::RowOffOrder, false>(lds, g, S, E, nullptr);
            if (cx) for (int it = p.bid; it < 32; it += p.G) { const SgMerge e{p.PROJ, p.MB, it >> 3, it & 7};
                small_gemm<1, SgMerge>(p, lds, p.Y3 + (size_t)(it >> 3) * 64 * 1536, 1536, p.WBR + (size_t)(it & 7) * 128 * 1536, 1536, 1536, 4, e); })
        PHASE(8, pg8::Gemm g{p.MB, p.WOUT, T, D, D}; pg8::RowOffOrder S; S.init(NLAT, D, p.G, p.bid, 1);
            const bool dry8 = rep_ < ((REPMASK >> 8) & 1);
            pg8::EpiResid E{dry8 ? p.PM + (size_t)NCTX * D : p.XL, dry8 ? p.PM : p.XC, p.MOD + (size_t)(l * 2 + 0) * 6144 + 2 * D, p.MOD + (size_t)(l * 2 + 1) * 6144 + 2 * D};
            pg8::gemm_phase<pg8::EpiResid, pg8::RowOffOrder, false>(lds, g, S, E, nullptr);
            if (cx) for (int it = p.bid; it < 32; it += p.G) { const SgResid e{dry8 ? p.PM : p.XC, p.MOD + (size_t)(l * 2 + 1) * 6144 + 2 * D, it >> 3, it & 7};
                small_gemm<1, SgResid>(p, lds, p.MB + (size_t)(it >> 3) * 64 * 1024, 1024, p.WOUT + (size_t)(it & 7) * 128 * 1024, 1024, 1024, 8, e); })
        PHASE(9, row_pass<1>(p, l, lds, cx))
        PHASE(10, { const int nsel = cx ? 32 : 16; if (p.bid < nsel) phase_select(p, lds, cx);
            else if (l + 1 < DEPTH) { P q; build_P(q, lds, (l + 1) & 1); convert_weights(q, l + 1, lds, (p.bid - nsel) * NWAVES + p.wave, (p.G - nsel) * NWAVES); } })
        PHASE(12, pg8::Gemm g{p.H, p.WUP, NE * ESLOTS, NE * 2048, D}; pg8::ExpertOrderT<true> S{p.G, p.bid, 8, 8, p.IDX}; pg8::EpiSwiGlu E{p.HID};
            pg8::gemm_phase<pg8::EpiSwiGlu, pg8::ExpertOrderT<true>, false>(lds, g, S, E, nullptr);
            if (cx) for (int it = p.bid; it < NE * 8; it += p.G) { const int e = it >> 3, t = it & 7; const SgSwiGlu ep{p.HID, e * ESLOTS + CAP_L, t};
                small_gemm<2, SgSwiGlu>(p, lds, p.H, 1024, p.WUP + (size_t)(e * 2048 + 256 * t) * 1024, 1024, 1024, 8, ep, p.IDX + e * ESLOTS + CAP_L); })
        PHASE(13, pg8::Gemm g{p.HID, p.WDN, NE * ESLOTS, NE * 1024, D}; pg8::ExpertOrderT<false> S{p.G, p.bid, 4, 8, nullptr}; pg8::EpiDown E{p.YE, p.GSEL};
            pg8::gemm_phase<pg8::EpiDown, pg8::ExpertOrderT<false>, false>(lds, g, S, E, nullptr);
            if (cx) for (int it = p.bid; it < NE * 8; it += p.G) { const int e = it >> 3, cc = it & 7; const SgDown ep{p.YE, p.GSEL, e * ESLOTS + CAP_L, cc};
                small_gemm<1, SgDown>(p, lds, p.HID + (size_t)(e * ESLOTS + CAP_L) * 1024, 1024, p.WDN + (size_t)(e * 1024 + 128 * cc) * 1024, 1024, 1024, 8, ep); })
    }
    if (IN(NPHASES - 1)) { P p; build_P(p, lds); row_pass<2>(p, 0, lds); }
#undef IN
#undef SEAM
}

extern "C" void kernel_launch(void* const* d_in, const int* in_sizes, int n_in, void* d_out, int out_size, void* d_ws, size_t ws_size, hipStream_t stream) {
    static int grid = 0;
    if (grid == 0) {
        if (n_in != 33 || out_size != NLAT * D || ws_size < WS_END) { fprintf(stderr, "kernel_launch: unexpected shapes: n_in %d out %d ws %zu (need %zu)\n", n_in, out_size, ws_size, (size_t)WS_END); grid = -1; return; }
        int dev = 0, cus = 0, per_cu = 0;
        if (hipGetDevice(&dev) != hipSuccess || hipDeviceGetAttribute(&cus, hipDeviceAttributeMultiprocessorCount, dev) != hipSuccess) { grid = -1; return; }
        if (hipFuncSetAttribute((const void*)fwd_kernel, hipFuncAttributeMaxDynamicSharedMemorySize, LDS_BYTES) != hipSuccess) { fprintf(stderr, "kernel_launch: hipFuncSetAttribute failed\n"); grid = -1; return; }
        if (hipOccupancyMaxActiveBlocksPerMultiprocessor(&per_cu, (const void*)fwd_kernel, NTHR, LDS_BYTES) != hipSuccess || per_cu < 1) { fprintf(stderr, "kernel_launch: occupancy query says %d\n", per_cu); (void)hipGetLastError(); }
        grid = cus;
    }
    if (grid < 0) return;
    (void)hipMemsetAsync((char*)d_ws + WS_CTL, 0, CTL_BYTES, stream);
    Args a{};
    for (int i = 0; i < 33; ++i) a.in[i] = (const float*)d_in[i];
    a.out = (float*)d_out; a.ws = (unsigned char*)d_ws;
#if MK_PER_PHASE
    for (int ph = 0; ph < NPHASES; ++ph) { a.ph_lo = ph; a.ph_hi = ph + 1; hipLaunchKernelGGL(fwd_kernel, dim3(grid), dim3(NTHR), LDS_BYTES, stream, a); }
#else
    a.ph_lo = 0; a.ph_hi = NPHASES;
    hipLaunchKernelGGL(fwd_kernel, dim3(grid), dim3(NTHR), LDS_BYTES, stream, a);
#endif
}
```

```cpp
#include <hip/hip_runtime.h>
#include <cstdio>
#include <cstdint>

#ifndef MK_PER_PHASE
#define MK_PER_PHASE 0
#endif

namespace pg8 {
#define PG8_LAS __attribute__((address_space(3)))
typedef unsigned short bf16_t;
typedef short bf16x8 __attribute__((ext_vector_type(8)));
typedef float f32x4 __attribute__((ext_vector_type(4)));
typedef unsigned u32x4 __attribute__((ext_vector_type(4)));
constexpr int BM = 256, BK = 64, HALF = 128, HTB = HALF * BK * 2  , STAGE_BYTES = 8 * HTB, NXCD = 8, WGM = 8;

__host__ __device__ __forceinline__ int lds_byte(int r, int c) { const int st = (r >> 4) * 2 + (c >> 5), rr = r & 15, cc = c & 31, ob = rr * 64 + cc * 2; return st * 1024 + (ob ^ (((ob >> 9) & 1) << 5)); }
__host__ __device__ __forceinline__ void stage_rc(int b, int& R, int& C) { const int st = b / 1024, sb = b % 1024, swz = sb ^ (((sb >> 9) & 1) << 5); R = (st >> 1) * 16 + swz / 64; C = (st & 1) * 32 + (swz % 64) / 2; }
__host__ __device__ __forceinline__ int perm32(int rho) { const int n = rho >> 4, i = rho & 15; return 8 * (i >> 2) + 4 * n + (i & 3); }

struct Unit { int pm, pn; };
struct Gemm { const bf16_t* A; const bf16_t* Bt; int M, N, K; };

struct StaticOrder {
    static constexpr bool GATHER = false;
    int nM, nN, nwg, G, c;
    __host__ __device__ void init(int M, int N, int G_, int c_) { nM = M / BM; nN = N / BM; nwg = nM * nN; G = G_; c = c_; }
    __host__ __device__ bool next(int i, Unit& u) const {
        const long L = (long)i * G + c; if (L >= nwg) return false;
        int wgid = (int)L; { const int q = nwg / NXCD, r = nwg % NXCD, xcd = wgid % NXCD, off = wgid / NXCD; wgid = (xcd < r ? xcd * (q + 1) : r * (q + 1) + (xcd - r) * q) + off; }
        const int nig = WGM * nN, gid = wgid / nig, fm = gid * WGM, gsz = (nM - fm) < WGM ? (nM - fm) : WGM;
        u.pm = fm + ((wgid % nig) % gsz); u.pn = (wgid % nig) / gsz; return true;
    }
    __device__ __forceinline__ void a_ready(const Unit&) const {}
    __device__ __forceinline__ void done(const Unit&) const {}
};
__device__ __forceinline__ unsigned cvt_pk_bf16(float lo, float hi) { unsigned r; asm volatile("v_cvt_pk_bf16_f32 %0, %1, %2" : "=v"(r) : "v"(lo), "v"(hi)); return r; }
template <class Epi, class Sched, bool STAMP = false>
__device__ __forceinline__ void gemm_phase(PG8_LAS unsigned char* lds, const Gemm g, const Sched& S, const Epi& E, unsigned long long* stamps) {
    int tid_l = threadIdx.x; asm volatile("" : "+v"(tid_l));
    const int tid = tid_l, wid = __builtin_amdgcn_readfirstlane(tid >> 6), lane = tid & 63, wr = wid >> 2, wc = wid & 3, fr = lane & 15, fq = lane >> 4;
    const int K = g.K, nt = K / BK;
    int ts_lo = 0, ts_hi = 0, nts = 0; const unsigned long long rt_entry = STAMP ? (unsigned long long)wall_clock64() : 0ull;
#define PG8_STAMP() do { if (STAMP && wid == 0 && nts < 64) { const unsigned long long _c = (unsigned long long)clock64(); \
        ts_lo = (lane == nts) ? (int)(unsigned)_c : ts_lo; ts_hi = (lane == nts) ? (int)(unsigned)(_c >> 32) : ts_hi; ++nts; } } while (0)
    PG8_STAMP();
    unsigned voffA[2], voffB[2]; int rA[2], cAo[2];
#pragma unroll
    for (int i = 0; i < 2; ++i) { int R, C; stage_rc(tid * 16 + i * 8192, R, C); const int Rb = Epi::PERM ? ((R & ~31) + perm32(R & 31)) : R;
        voffA[i] = (unsigned)(R * K + C) * 2u; voffB[i] = (unsigned)(Rb * K + C) * 2u; rA[i] = R; cAo[i] = C; }
    const size_t kstep = (size_t)(BK * 2);
    const size_t hstep = (size_t)HALF * K * 2;
    const size_t tstep = 2 * hstep;
    const unsigned ldsw = (unsigned)wid * 1024u;
    const int aoff = lds_byte(wr * 64 + fr, fq * 8), boff = lds_byte(wc * 32 + fr, fq * 8);
#define PG8_SA(b, h) (((b) * 2 + (h)) * HTB)
#define PG8_SB(b, h) ((4 + (b) * 2 + (h)) * HTB)
#define PG8_STAGE(bufoff, gbase, voff) do { _Pragma("unroll") for (int _i = 0; _i < 2; ++_i) \
        __builtin_amdgcn_global_load_lds((const unsigned*)((const char*)(gbase) + (voff)[_i]), (PG8_LAS unsigned*)(lds + (bufoff) + ldsw + _i * 8192), 16, 0, 0); } while (0)
#define PG8_LDA(dst, b, h) do { _Pragma("unroll") for (int m = 0; m < 4; ++m) _Pragma("unroll") for (int k = 0; k < 2; ++k) dst[m][k] = *(const PG8_LAS bf16x8*)(lds + PG8_SA(b, h) + aoff + m * 2048 + k * 1024); } while (0)
#define PG8_LDB(dst, b, h) do { _Pragma("unroll") for (int n = 0; n < 2; ++n) _Pragma("unroll") for (int k = 0; k < 2; ++k) dst[n][k] = *(const PG8_LAS bf16x8*)(lds + PG8_SB(b, h) + boff + n * 2048 + k * 1024); } while (0)
#define PG8_MMA(ai, bj, At, Bt) do { __builtin_amdgcn_s_setprio(1); _Pragma("unroll") for (int m = 0; m < 4; ++m) _Pragma("unroll") for (int n = 0; n < 2; ++n) _Pragma("unroll") for (int k = 0; k < 2; ++k) \
        acc[ai][bj][m][n] = __builtin_amdgcn_mfma_f32_16x16x32_bf16(Bt[n][k], At[m][k], acc[ai][bj][m][n], 0, 0, 0); __builtin_amdgcn_s_setprio(0); } while (0)
#define PG8_WAIT_V(n) asm volatile("s_waitcnt vmcnt(" #n ")" ::: "memory")
#define PG8_WAIT_L(n) asm volatile("s_waitcnt lgkmcnt(" #n ")" ::: "memory")
#define PG8_BAR __builtin_amdgcn_s_barrier()
#define PG8_SCHED __builtin_amdgcn_sched_barrier(0)
    Unit cur, nxt; int ui = 0;
    if (!S.next(0, cur)) return;
    f32x4 acc[2][2][4][2];
#pragma unroll
    for (int a = 0; a < 2; ++a)
#pragma unroll
        for (int b = 0; b < 2; ++b)
#pragma unroll
            for (int m = 0; m < 4; ++m)
#pragma unroll
                for (int n = 0; n < 2; ++n) acc[a][b][m][n] = (f32x4){0.f, 0.f, 0.f, 0.f};
    bf16x8 At[4][2], B0[2][2], B1[2][2];
    unsigned vAc[2][2], vAn[2][2];
#pragma unroll
    for (int h = 0; h < 2; ++h)
#pragma unroll
        for (int i = 0; i < 2; ++i) { if constexpr (Sched::GATHER) vAc[h][i] = (unsigned)(S.arow(cur, h * HALF + rA[i]) * K + cAo[i]) * 2u; else vAc[h][i] = voffA[i] + (unsigned)(h * hstep);
            vAn[h][i] = vAc[h][i]; }
    if constexpr (Sched::GATHER) { asm volatile("s_waitcnt vmcnt(0)" ::: "memory"); }
    const char* cA = (const char*)g.A + (Sched::GATHER ? (size_t)0 : (size_t)cur.pm * tstep); const char* cB = (const char*)g.Bt + (size_t)cur.pn * tstep;
    S.a_ready(cur);
    PG8_STAGE(PG8_SB(0, 0), cB, voffB); PG8_STAGE(PG8_SA(0, 0), cA, vAc[0]); PG8_STAGE(PG8_SB(0, 1), cB + hstep, voffB); PG8_STAGE(PG8_SA(0, 1), cA, vAc[1]);
    if (wr == 1) PG8_BAR;
    PG8_WAIT_V(4); PG8_BAR;
    PG8_STAGE(PG8_SB(1, 0), cB + kstep, voffB); PG8_STAGE(PG8_SA(1, 0), cA + kstep, vAc[0]); PG8_STAGE(PG8_SB(1, 1), cB + hstep + kstep, voffB);
    PG8_WAIT_V(6); PG8_BAR;
    PG8_STAMP();
    for (;;) {
        const bool has_next = S.next(ui + 1, nxt);
        const char* nA = (has_next && !Sched::GATHER) ? (const char*)g.A + (size_t)nxt.pm * tstep : cA; const char* nB = has_next ? (const char*)g.Bt + (size_t)nxt.pn * tstep : cB;
        if constexpr (Sched::GATHER) { if (has_next) {
#pragma unroll
            for (int h = 0; h < 2; ++h)
#pragma unroll
                for (int i = 0; i < 2; ++i) vAn[h][i] = (unsigned)(S.arow(nxt, h * HALF + rA[i]) * K + cAo[i]) * 2u;
            asm volatile("s_waitcnt vmcnt(0)" ::: "memory"); } }
        for (int t = 0; t < nt; t += 2) {
            const bool last = (t == nt - 2);
            const char* a1 = cA + (size_t)(t + 1) * kstep;
            const char* a2 = last ? nA : cA + (size_t)(t + 2) * kstep; const char* b2 = last ? nB : cB + (size_t)(t + 2) * kstep;
            const char* a3 = a2 + kstep; const char* b3 = b2 + kstep;
            unsigned vs0[2], vs1[2];
#pragma unroll
            for (int i = 0; i < 2; ++i) { vs0[i] = last ? vAn[0][i] : vAc[0][i]; vs1[i] = last ? vAn[1][i] : vAc[1][i]; }
            if (last && has_next) S.a_ready(nxt);
            if constexpr (Epi::MIDHOOK) { if (t == 8 || t == 16) E.mid(acc, cur, t >> 3, wr, wc, fr, fq); }
            PG8_LDB(B0, 0, 0); PG8_SCHED; PG8_LDA(At, 0, 0); PG8_STAGE(PG8_SA(1, 1), a1, vAc[1]);
            PG8_WAIT_L(8); PG8_BAR; PG8_WAIT_L(0); PG8_MMA(0, 0, At, B0); PG8_BAR; PG8_SCHED;
            PG8_LDB(B1, 0, 1); PG8_STAGE(PG8_SB(0, 0), b2, voffB);
            PG8_BAR; PG8_WAIT_L(0); PG8_MMA(0, 1, At, B1); PG8_BAR;
            PG8_LDA(At, 0, 1); PG8_STAGE(PG8_SA(0, 0), a2, vs0);
            PG8_BAR; PG8_WAIT_L(0); PG8_MMA(1, 0, At, B0); PG8_BAR; PG8_SCHED;
            PG8_STAGE(PG8_SB(0, 1), b2 + hstep, voffB);
            PG8_WAIT_V(6); PG8_BAR; PG8_MMA(1, 1, At, B1); PG8_BAR;
            PG8_LDB(B0, 1, 0); PG8_SCHED; PG8_LDA(At, 1, 0); PG8_STAGE(PG8_SA(0, 1), a2, vs1);
            PG8_WAIT_L(8); PG8_BAR; PG8_WAIT_L(0); PG8_MMA(0, 0, At, B0); PG8_BAR; PG8_SCHED;
            PG8_LDB(B1, 1, 1); PG8_STAGE(PG8_SB(1, 0), b3, voffB);
            PG8_BAR; PG8_WAIT_L(0); PG8_MMA(0, 1, At, B1); PG8_BAR;
            PG8_LDA(At, 1, 1); PG8_STAGE(PG8_SA(1, 0), a3, vs0);
            PG8_BAR; PG8_WAIT_L(0); PG8_MMA(1, 0, At, B0); PG8_BAR; PG8_SCHED;
            PG8_STAGE(PG8_SB(1, 1), b3 + hstep, voffB);
            PG8_WAIT_V(6); PG8_BAR; PG8_MMA(1, 1, At, B1); PG8_BAR;
        }
        PG8_STAMP();
        if constexpr (!Epi::AFTER_DRAIN) { E(acc, cur, wr, wc, fr, fq); S.done(cur); }
        PG8_STAMP();
        if (!has_next) break;
#pragma unroll
        for (int a = 0; a < 2; ++a)
#pragma unroll
            for (int b = 0; b < 2; ++b)
#pragma unroll
                for (int m = 0; m < 4; ++m)
#pragma unroll
                    for (int n = 0; n < 2; ++n) acc[a][b][m][n] = (f32x4){0.f, 0.f, 0.f, 0.f};
        cur = nxt; cA = nA; cB = nB; ++ui;
#pragma unroll
        for (int h = 0; h < 2; ++h)
#pragma unroll
            for (int i = 0; i < 2; ++i) vAc[h][i] = vAn[h][i];
    }
    PG8_WAIT_V(0);
    if (wr == 0) PG8_BAR;
    PG8_BAR;
    if constexpr (Epi::AFTER_DRAIN) { E.fused(acc, cur, wr, wc, fr, fq, lds, wid, lane); S.done(cur); }
    PG8_STAMP();
    if (STAMP && wid == 0) { stamps[lane] = lane < nts ? (((unsigned long long)(unsigned)ts_hi << 32) | (unsigned)ts_lo) : 0ull;
        if (lane == 62) stamps[62] = rt_entry; if (lane == 63) stamps[63] = (unsigned long long)wall_clock64(); }
#undef PG8_STAMP
#undef PG8_SA
#undef PG8_SB
#undef PG8_STAGE
#undef PG8_LDA
#undef PG8_LDB
#undef PG8_MMA
#undef PG8_WAIT_V
#undef PG8_WAIT_L
#undef PG8_BAR
#undef PG8_SCHED
}
}

#define GAS __attribute__((address_space(1)))
#define LAS __attribute__((address_space(3)))
typedef unsigned short bf16;
typedef float f32x4 __attribute__((ext_vector_type(4)));
typedef unsigned u32x4 __attribute__((ext_vector_type(4)));
typedef unsigned u32x2 __attribute__((ext_vector_type(2)));

constexpr int D = 1024, NLAT = 16384, NCTX = 256, T = NLAT + NCTX, DEPTH = 4;
constexpr int IN_W = 5904, PJ = 5888;
constexpr int U0 = 0, Z0 = 512, XB0 = 1024, Q0 = 2048, K0 = 2560, V0 = 2688, GT0 = 2816;
constexpr int NE = 16, ESLOTS = 2304, CAP_L = 2048, CAP_C = 32;
constexpr int NCH = 130;
constexpr float EPS = 1e-6f;
constexpr int NWAVES = 8, NTHR = 512;
constexpr int LDS_BYTES = 155648;
constexpr int MISC_OFF = LDS_BYTES - 1024 + 512;
constexpr int NPH_LAYER = 14, NPHASES = 1 + DEPTH * NPH_LAYER + 1;

constexpr size_t al256(size_t x) { return (x + 255) & ~(size_t)255; }
constexpr size_t WS_CTL = 0, CTL_BYTES = 1u << 20;
constexpr size_t WS_MOD = WS_CTL + CTL_BYTES;
constexpr size_t WS_XC = al256(WS_MOD + (size_t)DEPTH * 2 * 6144 * 4);
constexpr size_t WS_WIN = al256(WS_XC + (size_t)NCTX * D * 4);
constexpr size_t WS_WGLU = al256(WS_WIN + (size_t)PJ * D * 2);
constexpr size_t WS_WBR = al256(WS_WGLU + (size_t)512 * 512 * 2);
constexpr size_t WS_WOUT = al256(WS_WBR + (size_t)3 * 1024 * 512 * 2);
constexpr size_t WS_WUP = al256(WS_WOUT + (size_t)1024 * 1024 * 2);
constexpr size_t WS_WDN = al256(WS_WUP + (size_t)NE * 2048 * 1024 * 2);
constexpr size_t WS_H = al256(WS_WDN + (size_t)NE * 1024 * 1024 * 2);
constexpr size_t WS_PROJ = al256(WS_H + (size_t)T * D * 2);
constexpr size_t WS_XE = WS_PROJ;
constexpr size_t WS_HID = al256(WS_XE + (size_t)NE * ESLOTS * D * 2);
constexpr size_t WS_DT = al256(WS_PROJ + (size_t)T * PJ * 2);
constexpr size_t WS_CV = al256(WS_DT + (size_t)T * 16 * 4);
constexpr size_t WS_S5E = al256(WS_CV + (size_t)T * 1024 * 2);
constexpr size_t WS_S5H = al256(WS_S5E + (size_t)2 * 32 * NCH * 128 * 4);
constexpr size_t WS_YD = al256(WS_S5H + (size_t)2 * 32 * NCH * 128 * 4);
constexpr size_t WS_SA = al256(WS_YD + (size_t)2 * T * 512 * 4);
constexpr size_t WS_Y3 = al256(WS_SA + (size_t)T * 512 * 2);
constexpr size_t WS_PM = al256(WS_Y3 + (size_t)3 * T * 512 * 2);
constexpr size_t WS_MB = al256(WS_PM + (size_t)T * D * 4);
constexpr size_t WS_YE = WS_PM;
constexpr size_t WS_AFFT = al256(WS_MB + (size_t)T * D * 2);
constexpr size_t WS_IDX = al256(WS_AFFT + (size_t)NE * T * 4);
constexpr size_t WS_GSEL = al256(WS_IDX + (size_t)NE * ESLOTS * 4);
constexpr size_t WS_INV = al256(WS_GSEL + (size_t)NE * ESLOTS * 4);
constexpr size_t WS_DEC = al256(WS_INV + (size_t)T * 16 * 4);
constexpr size_t WS_S5BB = al256(WS_DEC + (size_t)2 * NCH * 8 * 4);
constexpr size_t WS_S5CC = al256(WS_S5BB + (size_t)2 * 32 * 128 * 32 * 2);
constexpr size_t WS_S5AB = al256(WS_S5CC + (size_t)2 * 32 * 16 * 128 * 2);
constexpr size_t WS_ROPE = al256(WS_S5AB + (size_t)2 * 32 * 64 * 2 * 4);
constexpr size_t WS_W2 = al256(WS_ROPE + (size_t)2 * 256 * 16 * 4);
constexpr size_t WBUF_BYTES = WS_H - WS_WIN;
constexpr size_t WS_END = al256(WS_W2 + WBUF_BYTES);
constexpr size_t WS_SST = WS_YD;
constexpr size_t WS_HIN = WS_PM;
constexpr size_t WS_YS = al256(WS_HIN + (size_t)2 * NCH * 8 * 8192 * 2);
static_assert(WS_YS + (size_t)T * 512 * 2 <= WS_AFFT, "HIN|YS overlay fits PM|MB");
static_assert(WS_HID + (size_t)NE * ESLOTS * D * 2 <= WS_DT, "XE|HID overlay fits PROJ");
static_assert(WS_YE + (size_t)NE * ESLOTS * D * 2 <= WS_AFFT, "YE overlay fits PM|MB");
static_assert(WS_END < (size_t)1000 * 1024 * 1024, "workspace");
constexpr int CW_BAR = 4096;

__device__ __forceinline__ float bf2f(unsigned b) { return __uint_as_float(b << 16); }
__device__ __forceinline__ float bflo(unsigned w) { return __uint_as_float(w << 16); }
__device__ __forceinline__ float bfhi(unsigned w) { return __uint_as_float(w & 0xffff0000u); }
typedef float f32x2_c __attribute__((ext_vector_type(2)));
typedef __bf16 bf16x2_c __attribute__((ext_vector_type(2)));
__device__ __forceinline__ unsigned pk2(float lo, float hi) { f32x2_c v; v[0] = lo; v[1] = hi; return __builtin_bit_cast(unsigned, __builtin_convertvector(v, bf16x2_c)); }
__device__ __forceinline__ unsigned f2bf(float f) { return pk2(f, 0.f) & 0xffffu; }
__device__ __forceinline__ float wsum(float v) {
#pragma unroll
    for (int o = 1; o < 64; o <<= 1) v += __shfl_xor(v, o);
    return v;
}
__device__ __forceinline__ float wmaxf(float v) {
#pragma unroll
    for (int o = 1; o < 64; o <<= 1) v = fmaxf(v, __shfl_xor(v, o));
    return v;
}
__device__ __forceinline__ float silu_f(float x) { return x * __builtin_amdgcn_rcpf(1.f + __expf(-x)); }
__device__ __forceinline__ float sigmoid_f(float x) { return __builtin_amdgcn_rcpf(1.f + __expf(-x)); }
__device__ __forceinline__ float softplus_f(float x) { return x > 20.f ? x : log1pf(expf(x)); }
__device__ __forceinline__ float gelu_tanh_f(float x) { const float u = 0.7978845608028654f * (x + 0.044715f * x * x * x); return x * __builtin_amdgcn_rcpf(1.f + __expf(-2.f * u)); }
#define LDS_FENCE() asm volatile("s_waitcnt lgkmcnt(0)" ::: "memory")
__device__ __forceinline__ int scan_row(int d, int s) { return d == 0 ? s : (s < NCTX ? (NCTX - 1 - s) : (T + NCTX - 1 - s)); }

namespace pg8 {
struct EpiStoreBf16 {
    static constexpr bool PERM = true, AFTER_DRAIN = false, MIDHOOK = false;
    bf16_t* O; int ldc; int sig_tile; const float* rope;
    __device__ __forceinline__ void operator()(const f32x4 (&acc)[2][2][4][2], const Unit& u, int wr, int wc, int fr, int fq) const {
        const int row0 = u.pm * BM + wr * 64 + fr, col0 = u.pn * BM + wc * 32 + 8 * fq; const bool sg = u.pn >= sig_tile;
        const bool rq = rope != nullptr && u.pm >= 1 && (u.pn == Q0 / 256 || u.pn == Q0 / 256 + 1), rk = rope != nullptr && u.pm >= 1 && u.pn == K0 / 256;
#pragma unroll
        for (int ai = 0; ai < 2; ++ai)
#pragma unroll
            for (int m = 0; m < 4; ++m) { const int row = row0 + ai * HALF + m * 16; bf16_t* rowp = O + (size_t)row * ldc + col0;
#pragma unroll
                for (int bj = 0; bj < 2; ++bj) { f32x4 v0 = acc[ai][bj][m][0], v1 = acc[ai][bj][m][1];
                    if (sg) {
#pragma unroll
                        for (int q = 0; q < 4; ++q) { v0[q] = __builtin_amdgcn_rcpf(1.f + __expf(-v0[q])); v1[q] = __builtin_amdgcn_rcpf(1.f + __expf(-v1[q])); } }
                    if (rq || (rk && bj == 0)) {
                        const int t = row - NCTX, idx = (wc & 1) ? (t & 63) : (t >> 6);
                        const float* cp = rope + idx * 16 + 8 * (fq & 1);
                        const f32x4 c0 = *(const f32x4*)cp, c1 = *(const f32x4*)(cp + 4), s0 = *(const f32x4*)(cp + 4096), s1 = *(const f32x4*)(cp + 4100);
                        const float sgn = (fq & 2) ? 1.f : -1.f;
#pragma unroll
                        for (int q = 0; q < 4; ++q) { const float p0 = __shfl_xor(v0[q], 32), p1 = __shfl_xor(v1[q], 32);
                            v0[q] = v0[q] * c0[q] + sgn * p0 * s0[q]; v1[q] = v1[q] * c1[q] + sgn * p1 * s1[q]; } }
                    u32x4 w; w.x = cvt_pk_bf16(v0[0], v0[1]); w.y = cvt_pk_bf16(v0[2], v0[3]); w.z = cvt_pk_bf16(v1[0], v1[1]); w.w = cvt_pk_bf16(v1[2], v1[3]);
                    *(u32x4*)(rowp + bj * HALF) = w; } }
    }
};
struct EpiGlu {
    static constexpr bool PERM = true, AFTER_DRAIN = false, MIDHOOK = false;
    const bf16_t* A; const float* bias; bf16_t* O;
    __device__ __forceinline__ void operator()(const f32x4 (&acc)[2][2][4][2], const Unit& u, int wr, int wc, int fr, int fq) const {
        const int row0 = u.pm * BM + wr * 64 + fr, col0 = u.pn * BM + wc * 32 + 8 * fq;
#pragma unroll
        for (int ai = 0; ai < 2; ++ai)
#pragma unroll
            for (int m = 0; m < 4; ++m) { const size_t ro = (size_t)(row0 + ai * HALF + m * 16) * 512 + col0;
#pragma unroll
                for (int bj = 0; bj < 2; ++bj) { const f32x4 v0 = acc[ai][bj][m][0], v1 = acc[ai][bj][m][1];
                    const u32x4 a = *(const u32x4*)(A + ro + bj * HALF);
                    const f32x4 b0 = *(const f32x4*)(bias + col0 + bj * HALF), b1 = *(const f32x4*)(bias + col0 + bj * HALF + 4);
                    float o[8];
                    o[0] = bflo(a.x) * sigmoid_f(v0[0] + b0[0]); o[1] = bfhi(a.x) * sigmoid_f(v0[1] + b0[1]);
                    o[2] = bflo(a.y) * sigmoid_f(v0[2] + b0[2]); o[3] = bfhi(a.y) * sigmoid_f(v0[3] + b0[3]);
                    o[4] = bflo(a.z) * sigmoid_f(v1[0] + b1[0]); o[5] = bfhi(a.z) * sigmoid_f(v1[1] + b1[1]);
                    o[6] = bflo(a.w) * sigmoid_f(v1[2] + b1[2]); o[7] = bfhi(a.w) * sigmoid_f(v1[3] + b1[3]);
                    u32x4 w; w.x = cvt_pk_bf16(o[0], o[1]); w.y = cvt_pk_bf16(o[2], o[3]); w.z = cvt_pk_bf16(o[4], o[5]); w.w = cvt_pk_bf16(o[6], o[7]);
                    *(u32x4*)(O + (size_t)(row0 + ai * HALF + m * 16) * 1536 + col0 + bj * HALF) = w; } }
    }
};
struct RowOffOrder {
    static constexpr bool GATHER = false;
    StaticOrder b; int off;
    __device__ __forceinline__ void init(int M, int N, int G, int c, int off_) { b.init(M, N, G, c); off = off_; }
    __device__ __forceinline__ bool next(int i, Unit& u) const { if (!b.next(i, u)) return false; u.pm += off; return true; }
    __device__ __forceinline__ void a_ready(const Unit&) const {}
    __device__ __forceinline__ void done(const Unit&) const {}
};
struct EpiMerge {
    static constexpr bool PERM = true, AFTER_DRAIN = false, MIDHOOK = true;
    const bf16_t* proj; bf16_t* MB;
    __device__ __forceinline__ void mid(f32x4 (&acc)[2][2][4][2], const Unit& u, int seg, int wr, int wc, int fr, int fq) const {
        const unsigned base = (unsigned)((u.pm * BM + wr * 64 + fr) * PJ + GT0 + (seg - 1) * 1024 + u.pn * BM + wc * 32 + 8 * fq) * 2u;
        const char* pb = (const char*)proj;
#pragma unroll
        for (int ai = 0; ai < 2; ++ai)
#pragma unroll
            for (int m = 0; m < 4; ++m) {
                u32x4 ga[2], gb[2];
#pragma unroll
                for (int bj = 0; bj < 2; ++bj) { const unsigned o = base + (unsigned)(((ai * HALF + m * 16) * PJ + bj * HALF) * 2);
                    ga[bj] = *(const u32x4*)(pb + o); gb[bj] = *(const u32x4*)(pb + o + 2048u); }
#pragma unroll
                for (int bj = 0; bj < 2; ++bj) { const u32x4 a = ga[bj], b = gb[bj];
                    f32x4& v0 = acc[ai][bj][m][0]; f32x4& v1 = acc[ai][bj][m][1];
                    v0[0] *= bflo(a.x) * __builtin_amdgcn_rcpf(bflo(b.x)); v0[1] *= bfhi(a.x) * __builtin_amdgcn_rcpf(bfhi(b.x));
                    v0[2] *= bflo(a.y) * __builtin_amdgcn_rcpf(bflo(b.y)); v0[3] *= bfhi(a.y) * __builtin_amdgcn_rcpf(bfhi(b.y));
                    v1[0] *= bflo(a.z) * __builtin_amdgcn_rcpf(bflo(b.z)); v1[1] *= bfhi(a.z) * __builtin_amdgcn_rcpf(bfhi(b.z));
                    v1[2] *= bflo(a.w) * __builtin_amdgcn_rcpf(bflo(b.w)); v1[3] *= bfhi(a.w) * __builtin_amdgcn_rcpf(bfhi(b.w)); }
                if (m & 1) asm volatile("" ::: "memory");
            }
    }
    __device__ __forceinline__ void operator()(const f32x4 (&acc)[2][2][4][2], const Unit& u, int wr, int wc, int fr, int fq) const {
        const int row0 = u.pm * BM + wr * 64 + fr, col0 = u.pn * BM + wc * 32 + 8 * fq;
#pragma unroll
        for (int ai = 0; ai < 2; ++ai)
#pragma unroll
            for (int m = 0; m < 4; ++m) { const int row = row0 + ai * HALF + m * 16;
#pragma unroll
                for (int bj = 0; bj < 2; ++bj) { const f32x4 v0 = acc[ai][bj][m][0], v1 = acc[ai][bj][m][1]; const int col = col0 + bj * HALF;
                    const u32x4 g = *(const u32x4*)(proj + (size_t)row * PJ + GT0 + 2048 + col);
                    u32x4 w; w.x = cvt_pk_bf16(bflo(g.x) * v0[0], bfhi(g.x) * v0[1]); w.y = cvt_pk_bf16(bflo(g.y) * v0[2], bfhi(g.y) * v0[3]);
                    w.z = cvt_pk_bf16(bflo(g.z) * v1[0], bfhi(g.z) * v1[1]); w.w = cvt_pk_bf16(bflo(g.w) * v1[2], bfhi(g.w) * v1[3]);
                    *(u32x4*)(MB + (size_t)row * 1024 + col) = w; } }
    }
};
struct EpiResid {
    static constexpr bool PERM = false, AFTER_DRAIN = false, MIDHOOK = false;
    float* XL; float* XC; const float* g_lat; const float* g_ctx;
    __device__ __forceinline__ void operator()(const f32x4 (&acc)[2][2][4][2], const Unit& u, int wr, int wc, int fr, int fq) const {
        const bool isc = (u.pm == 0);
        float* base = isc ? XC : (XL - (size_t)NCTX * D); const float* gv = isc ? g_ctx : g_lat;
        const int row0 = u.pm * BM + wr * 64 + fr, col0 = u.pn * BM + wc * 32 + 4 * fq;
#pragma unroll
        for (int ai = 0; ai < 2; ++ai)
#pragma unroll
            for (int m = 0; m < 4; ++m) { float* rowp = base + (size_t)(row0 + ai * HALF + m * 16) * D + col0;
#pragma unroll
                for (int bj = 0; bj < 2; ++bj)
#pragma unroll
                    for (int n = 0; n < 2; ++n) { float* pp = rowp + bj * HALF + n * 16; const f32x4 g = *(const f32x4*)(gv + col0 + bj * HALF + n * 16);
                        f32x4 x = *(const f32x4*)pp; x += g * acc[ai][bj][m][n]; *(f32x4*)pp = x; } }
    }
};
template <bool GATHER_> struct ExpertOrderT {
    static constexpr bool GATHER = GATHER_;
    int G, c, nnt, nmt;
    const int* idx;
    __device__ __forceinline__ bool next(int i, Unit& u) const { const int cc = (G & 7) ? c : (c & 7) * (G >> 3) + (c >> 3);
        const int L = i * G + cc; if (L >= NE * nmt * nnt) return false; const int e = L / (nmt * nnt), rem = L % (nmt * nnt); u.pm = e * 9 + rem % nmt; u.pn = e * nnt + rem / nmt; return true; }
    __device__ __forceinline__ int arow(const Unit& u, int r) const { return idx[u.pm * 256 + r]; }
    __device__ __forceinline__ void a_ready(const Unit&) const {}
    __device__ __forceinline__ void done(const Unit&) const {}
};
struct EpiSwiGlu {
    static constexpr bool PERM = true, AFTER_DRAIN = false, MIDHOOK = false;
    bf16_t* HID;
    __device__ __forceinline__ void operator()(const f32x4 (&acc)[2][2][4][2], const Unit& u, int wr, int wc, int fr, int fq) const {
        const int row0 = u.pm * BM + wr * 64 + fr, col0 = (u.pn & 7) * 128 + wc * 32 + 8 * fq;
#pragma unroll
        for (int ai = 0; ai < 2; ++ai)
#pragma unroll
            for (int m = 0; m < 4; ++m) { const f32x4 g0 = acc[ai][0][m][0], g1 = acc[ai][0][m][1], u0 = acc[ai][1][m][0], u1 = acc[ai][1][m][1];
                u32x4 w;
                w.x = cvt_pk_bf16(silu_f(g0[0]) * u0[0], silu_f(g0[1]) * u0[1]); w.y = cvt_pk_bf16(silu_f(g0[2]) * u0[2], silu_f(g0[3]) * u0[3]);
                w.z = cvt_pk_bf16(silu_f(g1[0]) * u1[0], silu_f(g1[1]) * u1[1]); w.w = cvt_pk_bf16(silu_f(g1[2]) * u1[2], silu_f(g1[3]) * u1[3]);
                *(u32x4*)(HID + (size_t)(row0 + ai * HALF + m * 16) * 1024 + col0) = w; }
    }
};
struct EpiDown {
    static constexpr bool PERM = true, AFTER_DRAIN = false, MIDHOOK = false;
    bf16_t* YE; const float* gsel;
    __device__ __forceinline__ void operator()(const f32x4 (&acc)[2][2][4][2], const Unit& u, int wr, int wc, int fr, int fq) const {
        const int row0 = u.pm * BM + wr * 64 + fr, col0 = (u.pn & 3) * BM + wc * 32 + 8 * fq;
#pragma unroll
        for (int ai = 0; ai < 2; ++ai)
#pragma unroll
            for (int m = 0; m < 4; ++m) { const int row = row0 + ai * HALF + m * 16; const float gs = gsel[row];
#pragma unroll
                for (int bj = 0; bj < 2; ++bj) { const f32x4 v0 = acc[ai][bj][m][0] * gs, v1 = acc[ai][bj][m][1] * gs;
                    u32x4 w; w.x = cvt_pk_bf16(v0[0], v0[1]); w.y = cvt_pk_bf16(v0[2], v0[3]); w.z = cvt_pk_bf16(v1[0], v1[1]); w.w = cvt_pk_bf16(v1[2], v1[3]);
                    *(u32x4*)(YE + (size_t)row * 1024 + col0 + bj * HALF) = w; } }
    }
};
}
#define XB_TMO      128
#define XB_XCNT(j)  (256  + 64 * (j))
#define XB_XSUB(j)  (1280 + 64 * (j))
#define XB_XGEN(j)  (2304 + 64 * (j))
#define XB_TOP      3328
#define XB_TOPGEN   3392
#define XCD_BAR_WORDS 3456
#define XB_SPIN_CAP (1u << 18)
#define LAS __attribute__((address_space(3)))

__device__ __forceinline__ unsigned xb_ld(unsigned* p)              { return __hip_atomic_load(p, __ATOMIC_RELAXED, __HIP_MEMORY_SCOPE_AGENT); }
__device__ __forceinline__ unsigned xb_add(unsigned* p, unsigned v) { return __hip_atomic_fetch_add(p, v, __ATOMIC_RELAXED, __HIP_MEMORY_SCOPE_AGENT); }
__device__ __forceinline__ unsigned xb_xcc_id() { return (unsigned)__builtin_amdgcn_s_getreg((3 << 11) | 20) & 0xFu; }
#define XB_SPIN(cond, bar) do { unsigned _sp = 0; while (cond) { __builtin_amdgcn_s_sleep(1); \
    if ((++_sp & 255u) == 0u) { if (xb_ld(&(bar)[XB_TMO])) break; if (_sp > XB_SPIN_CAP) { atomicAdd(&(bar)[XB_TMO], 1u); break; } } } } while (0)

struct XcdBarrier {
    unsigned* bar; unsigned x;
    volatile LAS unsigned* st;
};

__device__ __forceinline__ XcdBarrier xcd_barrier_post(unsigned* bar, volatile LAS unsigned* st) {
    XcdBarrier b; b.bar = bar; b.x = xb_xcc_id(); b.st = st;
    if (threadIdx.x == 0) (void)xb_add(&bar[XB_XCNT(b.x)], 1u);
    return b;
}
__device__ __forceinline__ void xcd_barrier_complete(unsigned* bar, unsigned x, unsigned& nloc, unsigned& nx) {
    const unsigned G = gridDim.x * gridDim.y * gridDim.z;
    unsigned sum, cnt, mine, sp = 0u;
    for (;;) {
        sum = 0u; cnt = 0u; mine = 0u;
#pragma unroll
        for (unsigned j = 0; j < 16; ++j) { const unsigned c = xb_ld(&bar[XB_XCNT(j)]); sum += c; cnt += (c > 0u) ? 1u : 0u; mine = (j == x) ? c : mine; }
        if (sum == G) break;
        __builtin_amdgcn_s_sleep(1);
        if ((++sp & 255u) == 0u) { if (xb_ld(&bar[XB_TMO])) break; if (sp > XB_SPIN_CAP) { atomicAdd(&bar[XB_TMO], 1u); break; } }
    }
    nloc = mine > 0u ? mine : 1u; nx = cnt > 0u ? cnt : 1u;
}

__device__ __forceinline__ void xcd_barrier(const XcdBarrier& b) {
    asm volatile("s_waitcnt vmcnt(0)" ::: "memory");
    __syncthreads();
    if (threadIdx.x == 0) {
        unsigned* bar = b.bar;
        __builtin_amdgcn_s_waitcnt(0);
        unsigned nloc = b.st[0], nx = b.st[1];
        if (nloc == 0u) { xcd_barrier_complete(bar, b.x, nloc, nx); b.st[0] = nloc; b.st[1] = nx; }
        const unsigned old = xb_add(&bar[XB_XSUB(b.x)], 1u);
        const unsigned gen = old / nloc;
        if (old + 1u == (gen + 1u) * nloc) {
            __builtin_amdgcn_fence(__ATOMIC_RELEASE, "agent");
            asm volatile("s_waitcnt vmcnt(0)" ::: "memory");
            const unsigned og = xb_add(&bar[XB_TOP], 1u);
            const unsigned tg = og / nx;
            if (og + 1u == (tg + 1u) * nx) xb_add(&bar[XB_TOPGEN], 1u);
            else XB_SPIN(xb_ld(&bar[XB_TOPGEN]) == tg, bar);
            __builtin_amdgcn_fence(__ATOMIC_ACQUIRE, "agent");
            xb_add(&bar[XB_XGEN(b.x)], 1u);
            asm volatile("s_waitcnt vmcnt(0)" ::: "memory");
        } else {
            XB_SPIN(xb_ld(&bar[XB_XGEN(b.x)]) == gen, bar);
            __builtin_amdgcn_fence(__ATOMIC_ACQUIRE, "agent");
            asm volatile("s_waitcnt vmcnt(0)" ::: "memory");
        }
    }
    __syncthreads();
}


struct P {
    const float *x, *c, *ctx, *c_ctx, *w_mod, *b_mod, *norm1_g, *norm2_g, *w_in, *lam_re, *lam_im, *log_dt, *b_re, *b_im, *c_re, *c_im, *s5_d, *w_glu, *b_glu,
        *conv_w, *conv_b, *a_log, *dt_bias, *ssd_d, *ssd_norm_g, *sink, *w_branch, *w_out, *w_router, *w_eg, *w_eu, *w_ed, *final_g;
    float* XL;
    float *MOD, *XC, *DT, *S5E, *S5H, *YD, *PM, *AFFT, *GSEL;
    bf16 *WIN, *WGLU, *WBR, *WOUT, *WUP, *WDN, *H, *PROJ, *XE, *HID, *CV, *SA, *Y3, *MB, *YE;
    int *IDX, *INV;
    int tid, lane, wave, bid, G, vcu;
};


constexpr int PTAB_OFF = LDS_BYTES - 1024;
__device__ __forceinline__ unsigned long long ld_tab(volatile LAS unsigned* t, int k) {
    const unsigned lo = __builtin_amdgcn_readfirstlane(t[2 * k]), hi = __builtin_amdgcn_readfirstlane(t[2 * k + 1]);
    return ((unsigned long long)hi << 32) | lo;
}
__device__ __forceinline__ void build_P(P& p, LAS unsigned char* lds, int wset = 0) {
    int tid_l = threadIdx.x, bid_l = blockIdx.x, g_l = gridDim.x;
    asm volatile("" : "+v"(tid_l), "+s"(bid_l), "+s"(g_l));
    p.tid = tid_l; p.lane = p.tid & 63; p.wave = __builtin_amdgcn_readfirstlane(p.tid >> 6); p.bid = bid_l; p.G = g_l; p.vcu = (g_l & 7) ? bid_l : (bid_l & 7) * (g_l >> 3) + (bid_l >> 3);
    unsigned tbase = (unsigned)(size_t)(lds + PTAB_OFF); asm volatile("" : "+v"(tbase));
    volatile LAS unsigned* tb = (volatile LAS unsigned*)(size_t)tbase;
#define INP(k) ((const float*)ld_tab(tb, k))
    p.x = INP(0); p.c = INP(1); p.ctx = INP(2); p.c_ctx = INP(3); p.w_mod = INP(4); p.b_mod = INP(5); p.norm1_g = INP(6); p.norm2_g = INP(7);
    p.w_in = INP(8); p.lam_re = INP(9); p.lam_im = INP(10); p.log_dt = INP(11); p.b_re = INP(12); p.b_im = INP(13); p.c_re = INP(14); p.c_im = INP(15);
    p.s5_d = INP(16); p.w_glu = INP(17); p.b_glu = INP(18); p.conv_w = INP(19); p.conv_b = INP(20); p.a_log = INP(21); p.dt_bias = INP(22); p.ssd_d = INP(23);
    p.ssd_norm_g = INP(24); p.sink = INP(25); p.w_branch = INP(26); p.w_out = INP(27); p.w_router = INP(28); p.w_eg = INP(29); p.w_eu = INP(30); p.w_ed = INP(31);
    p.final_g = INP(32);
#undef INP
    p.XL = (float*)ld_tab(tb, 33);
    unsigned char* ws = (unsigned char*)ld_tab(tb, 34);
    p.MOD = (float*)(ws + WS_MOD); p.XC = (float*)(ws + WS_XC); p.DT = (float*)(ws + WS_DT); p.S5E = (float*)(ws + WS_S5E); p.S5H = (float*)(ws + WS_S5H); p.YD = (float*)(ws + WS_YD);
    p.PM = (float*)(ws + WS_PM); p.AFFT = (float*)(ws + WS_AFFT); p.GSEL = (float*)(ws + WS_GSEL);
    { unsigned char* wb = ws + (wset ? (WS_W2 - WS_WIN) : 0);
      p.WIN = (bf16*)(wb + WS_WIN); p.WGLU = (bf16*)(wb + WS_WGLU); p.WBR = (bf16*)(wb + WS_WBR); p.WOUT = (bf16*)(wb + WS_WOUT); p.WUP = (bf16*)(wb + WS_WUP); p.WDN = (bf16*)(wb + WS_WDN); }
    p.H = (bf16*)(ws + WS_H); p.PROJ = (bf16*)(ws + WS_PROJ); p.XE = (bf16*)(ws + WS_XE); p.HID = (bf16*)(ws + WS_HID); p.CV = (bf16*)(ws + WS_CV); p.SA = (bf16*)(ws + WS_SA);
    p.Y3 = (bf16*)(ws + WS_Y3); p.MB = (bf16*)(ws + WS_MB); p.YE = (bf16*)(ws + WS_YE);
    p.IDX = (int*)(ws + WS_IDX); p.INV = (int*)(ws + WS_INV);
}
__device__ __forceinline__ void phase_mod(const P& p, LAS unsigned char* lds, float* ropet) {
    for (int i = p.bid * NTHR + p.tid; i < 256 * 16; i += p.G * NTHR) { const float inv = exp2f(-(float)(i & 15) * 0.83048202372184058696f);
        float sn, cs; sincosf((float)(i >> 4) * inv, &sn, &cs); ropet[i] = cs; ropet[4096 + i] = sn; }
    LAS float* sc = (LAS float*)lds;
    LAS float* part = sc + 2048;
    for (int i = p.tid; i < 1024; i += NTHR) { sc[i] = silu_f(p.c[i]); sc[1024 + i] = silu_f(p.c_ctx[i]); }
    __syncthreads();
    for (int it = p.bid; it < DEPTH * 48; it += p.G) {
        const int l = it / 48, cb = it % 48, c0 = cb * 128 + 2 * p.lane;
        const float* W = p.w_mod + (size_t)l * 1024 * 6144 + c0;
        float a00 = 0.f, a01 = 0.f, a10 = 0.f, a11 = 0.f;
        const int kb = p.wave * 128;
#pragma unroll 8
        for (int k = kb; k < kb + 128; ++k) { const float2 w = *(const float2*)(W + (size_t)k * 6144); const float s0 = sc[k], s1 = sc[1024 + k];
            a00 += s0 * w.x; a01 += s0 * w.y; a10 += s1 * w.x; a11 += s1 * w.y; }
        part[(p.wave * 2 + 0) * 128 + 2 * p.lane] = a00; part[(p.wave * 2 + 0) * 128 + 2 * p.lane + 1] = a01;
        part[(p.wave * 2 + 1) * 128 + 2 * p.lane] = a10; part[(p.wave * 2 + 1) * 128 + 2 * p.lane + 1] = a11;
        __syncthreads();
        if (p.tid < 256) { const int s = p.tid >> 7, col = p.tid & 127; float r = p.b_mod[l * 6144 + cb * 128 + col];
#pragma unroll
            for (int w = 0; w < 8; ++w) r += part[(w * 2 + s) * 128 + col];
            p.MOD[(size_t)(l * 2 + s) * 6144 + cb * 128 + col] = r; }
        __syncthreads();
    }
}

__device__ __forceinline__ void tr_item(const float* src, int ldw, int K, bf16* dst, int kb, LAS float* scr, int lane) {
    const int k0 = 64 * kb, kr = lane >> 4, nq = lane & 15;
    f32x4 v[16];
#pragma unroll
    for (int i = 0; i < 16; ++i) v[i] = *(const f32x4*)(src + (size_t)(k0 + 4 * i + kr) * ldw + 4 * nq);
#pragma unroll
    for (int i = 0; i < 16; ++i) { const int k = 4 * i + kr, c = (k >> 3) & 7; *(LAS f32x4*)(scr + k * 64 + 4 * (nq ^ c)) = v[i]; }
    LDS_FENCE();
    const int c = lane & 7;
#pragma unroll
    for (int j = 0; j < 8; ++j) { const int n = (lane >> 3) + 8 * j; const LAS float* s = scr + (8 * c) * 64 + (n ^ (c << 2));
        u32x4 o; o.x = pk2(s[0 * 64], s[1 * 64]); o.y = pk2(s[2 * 64], s[3 * 64]); o.z = pk2(s[4 * 64], s[5 * 64]); o.w = pk2(s[6 * 64], s[7 * 64]);
        *(u32x4*)(dst + (size_t)n * K + k0 + 8 * c) = o; }
    LDS_FENCE();
}
__device__ __forceinline__ void convert_weights(const P& p, int l, LAS unsigned char* lds, int gw, int NGW) {
    LAS float* scr = (LAS float*)(lds + p.wave * 16384);
    constexpr int I_A = 32 * 16, I_B = 60 * 16, I_GLU = 8 * 8, I_BR = 3 * 16 * 8, I_OUT = 16 * 16, I_E = 16 * 16 * 16;
    constexpr int NIT = I_A + I_B + I_GLU + I_BR + I_OUT + 3 * I_E;
    const float* win = p.w_in + (size_t)l * 1024 * IN_W;
    for (int it = gw; it < NIT; it += NGW) {
        int r = it;
        if (r < I_A) { const int nb = r >> 4, kb = r & 15; tr_item(win + 64 * nb, IN_W, 1024, p.WIN + (size_t)(64 * nb) * 1024, kb, scr, p.lane); continue; } r -= I_A;
        if (r < I_B) { const int nb = r >> 4, kb = r & 15; tr_item(win + 2064 + 64 * nb, IN_W, 1024, p.WIN + (size_t)(2048 + 64 * nb) * 1024, kb, scr, p.lane); continue; } r -= I_B;
        if (r < I_GLU) { const int nb = r >> 3, kb = r & 7; tr_item(p.w_glu + (size_t)l * 512 * 512 + 64 * nb, 512, 512, p.WGLU + (size_t)(64 * nb) * 512, kb, scr, p.lane); continue; } r -= I_GLU;
        if (r < I_BR) { const int kk = r >> 7, nb = (r >> 3) & 15, kb = r & 7;
            tr_item(p.w_branch + ((size_t)l * 3 + kk) * 512 * 1024 + 64 * nb, 1024, 1536, p.WBR + (size_t)(64 * nb) * 1536 + kk * 512, kb, scr, p.lane); continue; } r -= I_BR;
        if (r < I_OUT) { const int nb = r >> 4, kb = r & 15; tr_item(p.w_out + (size_t)l * 1024 * 1024 + 64 * nb, 1024, 1024, p.WOUT + (size_t)(64 * nb) * 1024, kb, scr, p.lane); continue; } r -= I_OUT;
        const int which = r / I_E; r -= which * I_E;
        const int e = r >> 8, nb = (r >> 4) & 15, kb = r & 15;
        const size_t eo = ((size_t)l * NE + e) * 1024 * 1024;
        if (which == 0) tr_item(p.w_eg + eo + 64 * nb, 1024, 1024, p.WUP + (size_t)(e * 2048 + 256 * (nb >> 1) + 64 * (nb & 1)) * 1024, kb, scr, p.lane);
        else if (which == 1) tr_item(p.w_eu + eo + 64 * nb, 1024, 1024, p.WUP + (size_t)(e * 2048 + 256 * (nb >> 1) + 128 + 64 * (nb & 1)) * 1024, kb, scr, p.lane);
        else tr_item(p.w_ed + eo + 64 * nb, 1024, 1024, p.WDN + (size_t)(e * 1024 + 64 * nb) * 1024, kb, scr, p.lane);
    }
}

__device__ __forceinline__ float reduce16(float (&a)[16], int lane) {
    float b[8], c[4], d[2];
#pragma unroll
    for (int j = 0; j < 8; ++j) { const bool hi = lane & 32; const float send = hi ? a[j] : a[j + 8], keep = hi ? a[j + 8] : a[j]; b[j] = keep + __shfl_xor(send, 32); }
#pragma unroll
    for (int j = 0; j < 4; ++j) { const bool hi = lane & 16; const float send = hi ? b[j] : b[j + 4], keep = hi ? b[j + 4] : b[j]; c[j] = keep + __shfl_xor(send, 16); }
#pragma unroll
    for (int j = 0; j < 2; ++j) { const bool hi = lane & 8; const float send = hi ? c[j] : c[j + 2], keep = hi ? c[j + 2] : c[j]; d[j] = keep + __shfl_xor(send, 8); }
    const bool hi = lane & 4; const float send = hi ? d[0] : d[1], keep = hi ? d[1] : d[0];
    float r = keep + __shfl_xor(send, 4);
    r += __shfl_xor(r, 2); r += __shfl_xor(r, 1);
    return r;
}
template <int MODE> __device__ __forceinline__ void row_pass(const P& p, int l, LAS unsigned char* lds, bool with_ctx = true, bool dry = false) {
    LAS float* W16 = (LAS float*)lds;
    if (MODE != 2) {
        const float* src = (MODE == 0) ? (p.w_in + (size_t)l * 1024 * IN_W + 2048) : (p.w_router + (size_t)l * 1024 * 16);
        const int ld = (MODE == 0) ? IN_W : 16;
        for (int i = p.tid; i < 1024 * 16; i += NTHR) { const int k = i >> 4, j = i & 15; const int rr = (k & 7) * 128 + ((k >> 3) & 63) + 64 * (k >> 9); W16[rr * 20 + j] = src[(size_t)k * ld + j]; }
        __syncthreads();
    }
    const int gw = p.bid * NWAVES + p.wave, NGW = p.G * NWAVES, lane = p.lane;
    for (int row = gw + ((MODE == 2 || !with_ctx) ? NCTX : 0); row < T; row += NGW) {
        const bool isc = row < NCTX;
        float* xrow = isc ? (p.XC + (size_t)row * D) : (p.XL + (size_t)(row - NCTX) * D);
        float v[16];
        { const float* s = (MODE == 0 && l == 0) ? (isc ? (p.ctx + (size_t)row * D) : (p.x + (size_t)(row - NCTX) * D)) : xrow;
#pragma unroll
          for (int i = 0; i < 2; ++i) { const f32x4 a = *(const f32x4*)(s + 512 * i + 8 * lane), b = *(const f32x4*)(s + 512 * i + 8 * lane + 4);
              v[8 * i] = a[0]; v[8 * i + 1] = a[1]; v[8 * i + 2] = a[2]; v[8 * i + 3] = a[3]; v[8 * i + 4] = b[0]; v[8 * i + 5] = b[1]; v[8 * i + 6] = b[2]; v[8 * i + 7] = b[3]; } }
        if ((MODE == 0 && l > 0) || MODE == 2) {
            const int lp = (MODE == 2) ? (DEPTH - 1) : (l - 1);
            const float* g2 = p.MOD + (size_t)(lp * 2 + (isc ? 1 : 0)) * 6144 + 5 * D;
            float s[16];
#pragma unroll
            for (int i = 0; i < 16; ++i) s[i] = 0.f;
            for (int e = 0; e < NE; ++e) { const int slot = p.INV[(size_t)row * 16 + e];
                if (slot >= 0) { const bf16* yr = p.YE + ((size_t)e * ESLOTS + slot) * D;
#pragma unroll
                    for (int i = 0; i < 2; ++i) { const u32x4 w = *(const u32x4*)(yr + 512 * i + 8 * lane);
                        s[8 * i] += bflo(w.x); s[8 * i + 1] += bfhi(w.x); s[8 * i + 2] += bflo(w.y); s[8 * i + 3] += bfhi(w.y);
                        s[8 * i + 4] += bflo(w.z); s[8 * i + 5] += bfhi(w.z); s[8 * i + 6] += bflo(w.w); s[8 * i + 7] += bfhi(w.w); } } }
#pragma unroll
            for (int i = 0; i < 2; ++i) { const f32x4 a = *(const f32x4*)(g2 + 512 * i + 8 * lane), b = *(const f32x4*)(g2 + 512 * i + 8 * lane + 4);
#pragma unroll
                for (int q = 0; q < 4; ++q) { v[8 * i + q] += a[q] * s[8 * i + q]; v[8 * i + 4 + q] += b[q] * s[8 * i + 4 + q]; } }
        }
        if (MODE == 0 && !dry) {
#pragma unroll
            for (int i = 0; i < 2; ++i) { *(f32x4*)(xrow + 512 * i + 8 * lane) = (f32x4){v[8 * i], v[8 * i + 1], v[8 * i + 2], v[8 * i + 3]};
                *(f32x4*)(xrow + 512 * i + 8 * lane + 4) = (f32x4){v[8 * i + 4], v[8 * i + 5], v[8 * i + 6], v[8 * i + 7]}; }
        }
        float ss = 0.f;
#pragma unroll
        for (int i = 0; i < 16; ++i) ss += v[i] * v[i];
        const float rstd = rsqrtf(wsum(ss) * (1.f / D) + EPS);
        if (MODE == 2) {
#pragma unroll
            for (int i = 0; i < 2; ++i) { const f32x4 a = *(const f32x4*)(p.final_g + 512 * i + 8 * lane), b = *(const f32x4*)(p.final_g + 512 * i + 8 * lane + 4);
                *(f32x4*)(xrow + 512 * i + 8 * lane) = (f32x4){v[8 * i] * rstd * a[0], v[8 * i + 1] * rstd * a[1], v[8 * i + 2] * rstd * a[2], v[8 * i + 3] * rstd * a[3]};
                *(f32x4*)(xrow + 512 * i + 8 * lane + 4) = (f32x4){v[8 * i + 4] * rstd * b[0], v[8 * i + 5] * rstd * b[1], v[8 * i + 6] * rstd * b[2], v[8 * i + 7] * rstd * b[3]}; }
            continue;
        }
        const float* gam = (MODE == 0 ? p.norm1_g : p.norm2_g) + (size_t)l * D;
        const float* md = p.MOD + (size_t)(l * 2 + (isc ? 1 : 0)) * 6144 + (MODE == 0 ? 0 : 3 * D);
        bf16* hrow = p.H + (size_t)row * D;
        float acc[16];
#pragma unroll
        for (int j = 0; j < 16; ++j) acc[j] = 0.f;
#pragma unroll
        for (int i = 0; i < 2; ++i) {
            float hv[8];
            { const int k0 = 512 * i + 8 * lane;
              const f32x4 ga = *(const f32x4*)(gam + k0), gb = *(const f32x4*)(gam + k0 + 4), sa = *(const f32x4*)(md + D + k0), sb = *(const f32x4*)(md + D + k0 + 4), ha = *(const f32x4*)(md + k0), hb = *(const f32x4*)(md + k0 + 4);
#pragma unroll
              for (int q = 0; q < 4; ++q) { hv[q] = v[8 * i + q] * rstd * ga[q] * (1.f + sa[q]) + ha[q]; hv[4 + q] = v[8 * i + 4 + q] * rstd * gb[q] * (1.f + sb[q]) + hb[q]; }
              u32x4 o; o.x = pk2(hv[0], hv[1]); o.y = pk2(hv[2], hv[3]); o.z = pk2(hv[4], hv[5]); o.w = pk2(hv[6], hv[7]);
              *(u32x4*)(hrow + k0) = o; }
#pragma unroll
            for (int j = 0; j < 8; ++j) { const LAS f32x4* wr = (const LAS f32x4*)(W16 + (j * 128 + lane + 64 * i) * 20);
                const f32x4 w0 = wr[0], w1 = wr[1], w2 = wr[2], w3 = wr[3]; const float h = hv[j];
                acc[0] += h * w0[0]; acc[1] += h * w0[1]; acc[2] += h * w0[2]; acc[3] += h * w0[3];
                acc[4] += h * w1[0]; acc[5] += h * w1[1]; acc[6] += h * w1[2]; acc[7] += h * w1[3];
                acc[8] += h * w2[0]; acc[9] += h * w2[1]; acc[10] += h * w2[2]; acc[11] += h * w2[3];
                acc[12] += h * w3[0]; acc[13] += h * w3[1]; acc[14] += h * w3[2]; acc[15] += h * w3[3];
                if (j & 1) asm volatile("" ::: "memory"); }
        }
        const float tot = reduce16(acc, lane);
        const int col = ((lane >> 5) & 1) * 8 + ((lane >> 4) & 1) * 4 + ((lane >> 3) & 1) * 2 + ((lane >> 2) & 1);
        if (MODE == 0) {
            if ((lane & 3) == 0) p.DT[(size_t)row * 16 + col] = softplus_f(tot + p.dt_bias[l * 16 + col]);
        } else {
            float mx = tot;
            mx = fmaxf(mx, __shfl_xor(mx, 4)); mx = fmaxf(mx, __shfl_xor(mx, 8)); mx = fmaxf(mx, __shfl_xor(mx, 16)); mx = fmaxf(mx, __shfl_xor(mx, 32));
            const float e = expf(tot - mx); float sum = e;
            sum += __shfl_xor(sum, 4); sum += __shfl_xor(sum, 8); sum += __shfl_xor(sum, 16); sum += __shfl_xor(sum, 32);
            if ((lane & 3) == 0) p.AFFT[(size_t)col * T + row] = e / sum;
        }
    }
}

struct S5Lane { float abr, abi; float bbr[16], bbi[16]; };
__device__ __forceinline__ void s5_lane_params(const P& p, int l, int d, int g, int lane, S5Lane& o, bool withB) {
    const size_t gi = ((size_t)(l * 2 + d) * 32 + g);
    const float lr = p.lam_re[gi * 64 + lane], li = p.lam_im[gi * 64 + lane], dt = expf(p.log_dt[gi]);
    const float mag = expf(lr * dt); float sn, cs; sincosf(li * dt, &sn, &cs);
    o.abr = mag * cs; o.abi = mag * sn;
    if (withB) {
        const float den = lr * lr + li * li;
        const float fr = ((o.abr - 1.f) * lr + o.abi * li) / den, fi = (o.abi * lr - (o.abr - 1.f) * li) / den;
        const f32x4* br = (const f32x4*)(p.b_re + (gi * 64 + lane) * 16); const f32x4* bi = (const f32x4*)(p.b_im + (gi * 64 + lane) * 16);
#pragma unroll
        for (int q = 0; q < 4; ++q) { const f32x4 r4 = br[q], i4 = bi[q];
#pragma unroll
            for (int j = 0; j < 4; ++j) { o.bbr[4 * q + j] = fr * r4[j] - fi * i4[j]; o.bbi[4 * q + j] = fr * i4[j] + fi * r4[j]; } }
    }
}
__device__ __forceinline__ void s5_stage_u(const P& p, int r0, int g, LAS unsigned char* ub, int lane) {
#pragma unroll
    for (int j = 0; j < 4; ++j) { const int q = lane + 64 * j, i = q >> 1, half = q & 1;
        const u32x4 w = *(const u32x4*)(p.PROJ + (size_t)(r0 + i) * PJ + U0 + g * 16 + half * 8);
        *(LAS u32x4*)(ub + i * 32 + half * 16) = w; }
    LDS_FENCE();
}
__device__ __forceinline__ void s5_step(const S5Lane& s, const LAS unsigned char* ub, int i, float& hr, float& hi) {
    const u32x4 a = *(const LAS u32x4*)(ub + i * 32), b = *(const LAS u32x4*)(ub + i * 32 + 16);
    float u[16];
    u[0] = bflo(a.x); u[1] = bfhi(a.x); u[2] = bflo(a.y); u[3] = bfhi(a.y); u[4] = bflo(a.z); u[5] = bfhi(a.z); u[6] = bflo(a.w); u[7] = bfhi(a.w);
    u[8] = bflo(b.x); u[9] = bfhi(b.x); u[10] = bflo(b.y); u[11] = bfhi(b.y); u[12] = bflo(b.z); u[13] = bfhi(b.z); u[14] = bflo(b.w); u[15] = bfhi(b.w);
    float br = 0.f, bi = 0.f;
#pragma unroll
    for (int k = 0; k < 16; ++k) { br += s.bbr[k] * u[k]; bi += s.bbi[k] * u[k]; }
    const float nr = s.abr * hr - s.abi * hi + br, ni = s.abr * hi + s.abi * hr + bi;
    hr = nr; hi = ni;
}

__device__ __forceinline__ void phase_premix(const P& p, int l, LAS unsigned char* lds) {
    const float* cw = p.conv_w + (size_t)l * 5 * 1024; const float* cb = p.conv_b + (size_t)l * 1024;
    for (int idx = p.bid * NTHR + p.tid; idx < T * 128; idx += p.G * NTHR) {
        const int row = idx >> 7, c8 = (idx & 127) * 8;
        const int lo = row < NCTX ? 0 : NCTX, hi = row < NCTX ? NCTX : T;
        float a[8];
        { const f32x4 b0 = *(const f32x4*)(cb + c8), b1 = *(const f32x4*)(cb + c8 + 4);
          a[0] = b0[0]; a[1] = b0[1]; a[2] = b0[2]; a[3] = b0[3]; a[4] = b1[0]; a[5] = b1[1]; a[6] = b1[2]; a[7] = b1[3]; }
#pragma unroll
        for (int j = 0; j < 5; ++j) { const int r = row + j - 2;
            if (r >= lo && r < hi) { const u32x4 xv = *(const u32x4*)(p.PROJ + (size_t)r * PJ + XB0 + c8);
                const f32x4 w0 = *(const f32x4*)(cw + j * 1024 + c8), w1 = *(const f32x4*)(cw + j * 1024 + c8 + 4);
                a[0] += w0[0] * bflo(xv.x); a[1] += w0[1] * bfhi(xv.x); a[2] += w0[2] * bflo(xv.y); a[3] += w0[3] * bfhi(xv.y);
                a[4] += w1[0] * bflo(xv.z); a[5] += w1[1] * bfhi(xv.z); a[6] += w1[2] * bflo(xv.w); a[7] += w1[3] * bfhi(xv.w); } }
        u32x4 o; o.x = pk2(silu_f(a[0]), silu_f(a[1])); o.y = pk2(silu_f(a[2]), silu_f(a[3])); o.z = pk2(silu_f(a[4]), silu_f(a[5])); o.w = pk2(silu_f(a[6]), silu_f(a[7]));
        *(u32x4*)(p.CV + (size_t)row * 1024 + c8) = o;
    }

}

__device__ __forceinline__ void ssd_scan_naive(const P& p, int l) {
    for (int it = p.bid * 4 + p.wave; it < 1024; it += p.G * 4) {
        const int d = it >> 9, hd = (it >> 6) & 7, pp = it & 63, grp = hd >> 2;
        const float a = -expf(p.a_log[l * 16 + d * 8 + hd]);
        const int colB = 512 + grp * 128 + p.lane, colC = 768 + grp * 128 + p.lane, colX = hd * 64 + pp, dcol = d * 8 + hd;
        float h0 = 0.f, h1 = 0.f;
        for (int s0 = 0; s0 < T; s0 += 8) {
            unsigned b0[8], b1[8], c0[8], c1[8], xx[8]; float dtv[8]; int rr[8];
#pragma unroll
            for (int j = 0; j < 8; ++j) { const int r = scan_row(d, s0 + j); rr[j] = r; const bf16* cv = p.CV + (size_t)r * 1024;
                b0[j] = cv[colB]; b1[j] = cv[colB + 64]; c0[j] = cv[colC]; c1[j] = cv[colC + 64]; xx[j] = cv[colX]; dtv[j] = p.DT[(size_t)r * 16 + dcol]; }
#pragma unroll
            for (int j = 0; j < 8; ++j) { const float dec = expf(dtv[j] * a), dx = dtv[j] * bf2f(xx[j]);
                h0 = dec * h0 + dx * bf2f(b0[j]); h1 = dec * h1 + dx * bf2f(b1[j]);
                const float y = wsum(bf2f(c0[j]) * h0 + bf2f(c1[j]) * h1);
                if (p.lane == 0) p.YD[((size_t)d * T + rr[j]) * 512 + colX] = y; }
        }
    }
}
__device__ __forceinline__ void s5_carry_scan(const P& p, int l, int aw, int NAW) {
    for (int it = aw; it < 64; it += NAW) {
        const int d = it >> 5, g = it & 31;
        S5Lane s; s5_lane_params(p, l, d, g, p.lane, s, false);
        float ar = s.abr, ai = s.abi;
#pragma unroll
        for (int q = 0; q < 7; ++q) { const float nr = ar * ar - ai * ai, ni = 2.f * ar * ai; ar = nr; ai = ni; }
        float hr = 0.f, hi = 0.f;
        const float* E = p.S5E + (size_t)(d * 32 + g) * NCH * 128; float* Hn = p.S5H + (size_t)(d * 32 + g) * NCH * 128;
        for (int c = 0; c < NCH; ++c) { Hn[c * 128 + p.lane] = hr; Hn[c * 128 + 64 + p.lane] = hi;
            const float er = E[c * 128 + p.lane], ei = E[c * 128 + 64 + p.lane];
            const float nr = ar * hr - ai * hi + er, ni = ar * hi + ai * hr + ei; hr = nr; hi = ni; }
    }
}
__device__ __forceinline__ void attention_naive(const P& p, int l, int aw, int NAW, LAS float* pbuf) {
    const int lane = p.lane;
    for (int it = aw; it < T * 8; it += NAW) {
        const int row = it >> 3, hq = it & 7, kvh = hq >> 2;
        const bool isc = row < NCTX; const int t = row - NCTX;
        const int jlo = isc ? 0 : (t - 128 < 0 ? 0 : t - 128), jhi = isc ? -1 : (t + 128 > NLAT - 1 ? NLAT - 1 : t + 128);
        const int nloc = jhi - jlo + 1, nk = nloc + NCTX;
        const float sink = p.sink[l * 8 + hq];
        float q[64];
        { const u32x4* qp = (const u32x4*)(p.PROJ + (size_t)row * PJ + Q0 + hq * 64);
#pragma unroll
          for (int c = 0; c < 8; ++c) { const u32x4 w = qp[c]; q[8 * c] = bflo(w.x); q[8 * c + 1] = bfhi(w.x); q[8 * c + 2] = bflo(w.y); q[8 * c + 3] = bfhi(w.y);
              q[8 * c + 4] = bflo(w.z); q[8 * c + 5] = bfhi(w.z); q[8 * c + 6] = bflo(w.w); q[8 * c + 7] = bfhi(w.w); } }
        float sc[9]; float mx = sink;
#pragma unroll
        for (int i = 0; i < 9; ++i) { const int kk = lane + 64 * i; float s = -INFINITY;
            if (kk < nk) { const int krow = kk < nloc ? NCTX + jlo + kk : kk - nloc;
                const u32x4* kp = (const u32x4*)(p.PROJ + (size_t)krow * PJ + K0 + kvh * 64); float dot = 0.f;
#pragma unroll
                for (int c = 0; c < 8; ++c) { const u32x4 w = kp[c];
                    dot += q[8 * c] * bflo(w.x) + q[8 * c + 1] * bfhi(w.x) + q[8 * c + 2] * bflo(w.y) + q[8 * c + 3] * bfhi(w.y)
                         + q[8 * c + 4] * bflo(w.z) + q[8 * c + 5] * bfhi(w.z) + q[8 * c + 6] * bflo(w.w) + q[8 * c + 7] * bfhi(w.w); }
                s = dot * 0.125f; }
            sc[i] = s; mx = fmaxf(mx, s); }
        mx = wmaxf(mx);
        float sum = 0.f;
#pragma unroll
        for (int i = 0; i < 9; ++i) { const int kk = lane + 64 * i; const float e = (kk < nk) ? expf(sc[i] - mx) : 0.f; pbuf[kk] = e; sum += e; }
        const float den = wsum(sum) + expf(sink - mx);
        LDS_FENCE();
        float o = 0.f;
        const bf16* vb = p.PROJ + V0 + kvh * 64 + lane;
#pragma unroll 4
        for (int kk = 0; kk < nk; ++kk) { const int vrow = kk < nloc ? NCTX + jlo + kk : kk - nloc; o += pbuf[kk] * bf2f(vb[(size_t)vrow * PJ]); }
        p.Y3[((size_t)2 * T + row) * 512 + hq * 64 + lane] = (bf16)f2bf(o / den);
        LDS_FENCE();
    }
}

__device__ __forceinline__ void phase_postmix(const P& p, int l, LAS unsigned char* lds) {
    constexpr int CSH_BYTES = 2 * 2 * 16 * 68 * 4, WREG = 16640;
    LAS float* Csh = (LAS float*)lds;
    LAS unsigned char* wreg = lds + CSH_BYTES + p.wave * WREG;
    LAS unsigned char* ub = wreg;
    LAS float* Hb = (LAS float*)(wreg + 4096);
    LAS float* Yb = (LAS float*)(wreg + 4096 + 4224);
    const int lane = p.lane;
    for (int it = p.bid; it < 32 * 17; it += p.G) {
        const int g = it / 17, chunk = (it % 17) * 8 + p.wave;
        __syncthreads();
        for (int i = p.tid; i < 2 * 2 * 16 * 64; i += NTHR) { const int pq = i & 63, k = (i >> 6) & 15, ri = (i >> 10) & 1, d = i >> 11;
            const float* src = ri ? p.c_im : p.c_re; Csh[((d * 2 + ri) * 16 + k) * 68 + pq] = src[(((size_t)(l * 2 + d) * 32 + g) * 16 + k) * 64 + pq]; }
        __syncthreads();
        if (chunk < NCH) {
            const int r0 = 128 * chunk;
            s5_stage_u(p, r0, g, ub, lane);
            for (int d = 0; d < 2; ++d) {
                S5Lane s; s5_lane_params(p, l, d, g, lane, s, true);
                const int cs = (d == 0) ? chunk : (chunk < 2 ? 1 - chunk : NCH + 1 - chunk);
                const float* Hn = p.S5H + ((size_t)(d * 32 + g) * NCH + cs) * 128;
                float hr = Hn[lane], hi = Hn[64 + lane];
                const LAS float* Cr = Csh + (d * 2 + 0) * 16 * 68; const LAS float* Ci = Csh + (d * 2 + 1) * 16 * 68;
                for (int sub = 0; sub < 16; ++sub) {
#pragma unroll
                    for (int j = 0; j < 8; ++j) { const int is = sub * 8 + j; s5_step(s, ub, d == 0 ? is : 127 - is, hr, hi); Hb[j * 132 + lane] = hr; Hb[j * 132 + 64 + lane] = hi; }
                    LDS_FENCE();
#pragma unroll
                    for (int m = 0; m < 2; ++m) { const int o = lane + 64 * m, j = o >> 4, k = o & 15; float y = 0.f;
#pragma unroll
                        for (int q = 0; q < 16; ++q) { const f32x4 cr = *(const LAS f32x4*)(Cr + k * 68 + 4 * q), ci = *(const LAS f32x4*)(Ci + k * 68 + 4 * q);
                            const f32x4 xr = *(const LAS f32x4*)(Hb + j * 132 + 4 * q), xi = *(const LAS f32x4*)(Hb + j * 132 + 64 + 4 * q);
                            y += cr[0] * xr[0] + cr[1] * xr[1] + cr[2] * xr[2] + cr[3] * xr[3] - ci[0] * xi[0] - ci[1] * xi[1] - ci[2] * xi[2] - ci[3] * xi[3]; }
                        const int is = sub * 8 + j, i = (d == 0) ? is : 127 - is;
                        if (d == 0) Yb[i * 16 + k] = y; else Yb[i * 16 + k] += y; }
                    LDS_FENCE();
                }
            }
            const float* dsk = p.s5_d + (size_t)l * 512 + g * 16;
#pragma unroll
            for (int m = 0; m < 2; ++m) { const int i = lane + 64 * m;
                const u32x4 ua = *(const LAS u32x4*)(ub + i * 32), ubv = *(const LAS u32x4*)(ub + i * 32 + 16);
                float u[16];
                u[0] = bflo(ua.x); u[1] = bfhi(ua.x); u[2] = bflo(ua.y); u[3] = bfhi(ua.y); u[4] = bflo(ua.z); u[5] = bfhi(ua.z); u[6] = bflo(ua.w); u[7] = bfhi(ua.w);
                u[8] = bflo(ubv.x); u[9] = bfhi(ubv.x); u[10] = bflo(ubv.y); u[11] = bfhi(ubv.y); u[12] = bflo(ubv.z); u[13] = bfhi(ubv.z); u[14] = bflo(ubv.w); u[15] = bfhi(ubv.w);
                float a[16];
#pragma unroll
                for (int k = 0; k < 16; ++k) a[k] = gelu_tanh_f(Yb[i * 16 + k] + dsk[k] * u[k]);
                u32x4 o0, o1; o0.x = pk2(a[0], a[1]); o0.y = pk2(a[2], a[3]); o0.z = pk2(a[4], a[5]); o0.w = pk2(a[6], a[7]);
                o1.x = pk2(a[8], a[9]); o1.y = pk2(a[10], a[11]); o1.z = pk2(a[12], a[13]); o1.w = pk2(a[14], a[15]);
                bf16* dst = p.SA + (size_t)(r0 + i) * 512 + g * 16;
                *(u32x4*)dst = o0; *(u32x4*)(dst + 8) = o1; }
            LDS_FENCE();
        }
    }
}

__device__ __forceinline__ void phase_select(const P& p, LAS unsigned char* lds, bool with_ctx) {
    LAS unsigned* keys = (LAS unsigned*)lds;
    LAS unsigned* hist = keys + 16384;
    LAS unsigned* misc = hist + 256;
    const int tid = p.tid, lane = p.lane, wave = p.wave;
    for (int it = p.bid; it < (with_ctx ? 32 : 16); it += p.G) {
        const int set = it >> 4, e = it & 15;
        const int n = set ? NCTX : NLAT, cap = set ? CAP_C : CAP_L, row0 = set ? 0 : NCTX, slot0 = set ? CAP_L : 0;
        const float* src = p.AFFT + (size_t)e * T + row0;
        __syncthreads();
        for (int i = tid; i < n; i += NTHR) keys[i] = __float_as_uint(src[i]);
        unsigned prefix = 0u, mask = 0u, need = (unsigned)cap;
        for (int pass = 3; pass >= 0; --pass) {
            if (tid < 256) hist[tid] = 0u;
            __syncthreads();
            for (int i = tid; i < n; i += NTHR) { const unsigned k = keys[i]; if ((k & mask) == prefix) __hip_atomic_fetch_add(&hist[(k >> (8 * pass)) & 255u], 1u, __ATOMIC_RELAXED, __HIP_MEMORY_SCOPE_WORKGROUP); }
            __syncthreads();
            if (wave == 0) {
                const unsigned h0 = hist[4 * lane], h1 = hist[4 * lane + 1], h2 = hist[4 * lane + 2], h3 = hist[4 * lane + 3];
                const unsigned c = h0 + h1 + h2 + h3; unsigned S = c;
#pragma unroll
                for (int o = 1; o < 64; o <<= 1) { const unsigned t = __shfl_down(S, o); if (lane + o < 64) S += t; }
                const unsigned Snext = S - c;
                if (S >= need && Snext < need) { unsigned rem = need - Snext; unsigned bin;
                    if (h3 >= rem) bin = 3; else { rem -= h3; if (h2 >= rem) bin = 2; else { rem -= h2; if (h1 >= rem) bin = 1; else { rem -= h1; bin = 0; } } }
                    misc[0] = 4 * lane + bin; misc[1] = rem; }
            }
            __syncthreads();
            prefix |= misc[0] << (8 * pass); mask |= 0xFFu << (8 * pass); need = misc[1];
            __syncthreads();
        }
        if (set == 0) for (int s = CAP_L + (with_ctx ? CAP_C : 0) + tid; s < ESLOTS; s += NTHR) { p.IDX[e * ESLOTS + s] = 0; p.GSEL[e * ESLOTS + s] = 0.f; }
        unsigned selbase = 0u, eqbase = 0u;
        for (int base = 0; base < n; base += NTHR) {
            const int i = base + tid; const bool valid = i < n; const unsigned k = valid ? keys[i] : 0u;
            const bool eq = valid && k == prefix, gt = valid && k > prefix;
            const unsigned long long lt = (1ull << lane) - 1ull;
            const unsigned long long be = __ballot(eq);
            if (lane == 0) misc[8 + wave] = (unsigned)__popcll(be);
            __syncthreads();
            unsigned woff = 0u, tot = 0u;
#pragma unroll
            for (int w = 0; w < 8; ++w) { const unsigned v = misc[8 + w]; woff += (w < wave) ? v : 0u; tot += v; }
            const unsigned eqrank = eqbase + woff + (unsigned)__popcll(be & lt);
            const bool sel = gt || (eq && eqrank < need);
            const unsigned long long bs = __ballot(sel);
            if (lane == 0) misc[16 + wave] = (unsigned)__popcll(bs);
            __syncthreads();
            unsigned woff2 = 0u, tot2 = 0u;
#pragma unroll
            for (int w = 0; w < 8; ++w) { const unsigned v = misc[16 + w]; woff2 += (w < wave) ? v : 0u; tot2 += v; }
            if (valid) { const int row = row0 + i;
                if (sel) { const int slot = slot0 + (int)(selbase + woff2 + (unsigned)__popcll(bs & lt));
                    p.IDX[e * ESLOTS + slot] = row; p.GSEL[e * ESLOTS + slot] = __uint_as_float(k); p.INV[(size_t)row * 16 + e] = slot; }
                else p.INV[(size_t)row * 16 + e] = -1; }
            selbase += tot2; eqbase += tot;
            __syncthreads();
        }
    }
}
__device__ __forceinline__ void phase_gather(const P& p, bool with_ctx) {
    const int gw = p.bid * NWAVES + p.wave, NGW = p.G * NWAVES, lane = p.lane;
    for (int idx = gw; idx < NE * ESLOTS; idx += NGW) {
        const int slot = idx % ESLOTS; const bool valid = slot < CAP_L + (with_ctx ? CAP_C : 0);
        u32x4 a = (u32x4){0u, 0u, 0u, 0u}, b = a;
        if (valid) { const int row = p.IDX[idx]; const u32x4* s = (const u32x4*)(p.H + (size_t)row * D); a = s[lane]; b = s[64 + lane]; }
        else if (lane == 0) p.GSEL[idx] = 0.f;
        u32x4* dst = (u32x4*)(p.XE + (size_t)idx * D); dst[lane] = a; dst[64 + lane] = b;
    }
}

typedef short bf16x8 __attribute__((ext_vector_type(8)));
#define MFMA16(a, b, c) __builtin_amdgcn_mfma_f32_16x16x32_bf16((a), (b), (c), 0, 0, 0)
constexpr int LDP = 272;
constexpr int LDQ = 144;
__device__ __forceinline__ bf16x8 ld_frag(const LAS unsigned char* base, int row, int kcol, int ldb) { return *(const LAS bf16x8*)(base + row * ldb + kcol * 2); }
typedef short s16x4_t __attribute__((ext_vector_type(4)));
__device__ __forceinline__ bf16x8 tr_frag(const LAS unsigned char* img, int k0, int col0, int sb, int lane) {
    const int g = lane >> 4, q = (lane & 15) >> 2, pp = lane & 3;
    const LAS unsigned char* a = img + (k0 + 8 * g + q) * sb + (col0 + 4 * pp) * 2;
    const s16x4_t r0 = __builtin_amdgcn_ds_read_tr16_b64_v4i16((LAS s16x4_t*)a), r1 = __builtin_amdgcn_ds_read_tr16_b64_v4i16((LAS s16x4_t*)(a + 4 * sb));
    return (bf16x8){r0[0], r0[1], r0[2], r0[3], r1[0], r1[1], r1[2], r1[3]};
}
constexpr int SB64 = 144, SB128 = 304, SB256 = 560;
__device__ __forceinline__ void st_b16(LAS unsigned char* p, unsigned v) { *(LAS unsigned short*)p = (unsigned short)v; }
__device__ __forceinline__ float wscan_incl(float v, int lane) {
#pragma unroll
    for (int o = 1; o < 64; o <<= 1) { const float t = __shfl_up(v, o); if (lane >= o) v += t; }
    return v;
}
__device__ __forceinline__ int chunk_r0(int d, int cs) { return d == 0 ? 128 * cs : (cs < 2 ? 128 * (1 - cs) : 128 * (NCH + 1 - cs)); }
__device__ __forceinline__ int scan_chunk_of(int d, int cn) { return d == 0 ? cn : (cn < 2 ? 1 - cn : NCH + 1 - cn); }

__device__ __forceinline__ void ssd_acum(const float* DT, int r0, int d, int col, float a, int lane, LAS float* acum, LAS float* dtv, float& total) {
    const int j0 = d == 0 ? lane : 127 - lane, j1 = d == 0 ? 64 + lane : 63 - lane;
    const float dt0 = DT[(size_t)(r0 + j0) * 16 + col], dt1 = DT[(size_t)(r0 + j1) * 16 + col];
    const float s0 = wscan_incl(dt0 * a, lane); const float t0 = __shfl(s0, 63);
    const float s1 = wscan_incl(dt1 * a, lane) + t0; total = __shfl(s1, 63);
    acum[j0] = s0; acum[j1] = s1; dtv[j0] = dt0; dtv[j1] = dt1;
}

__device__ __forceinline__ void ssd_states(const P& p, int l, LAS unsigned char* lds, float* SST, float* DEC) {
    LAS unsigned char* Bi = lds;
    LAS unsigned char* Xi = lds + 128 * SB128;
    LAS float* wj = (LAS float*)(lds + 128 * SB128 + 128 * SB256);
    const int tid = p.tid, lane = p.lane, wave = p.wave, quad = lane >> 4, l15 = lane & 15;
    for (int u = p.vcu; u < 2 * NCH * 2; u += p.G) {
        const int d = u / (2 * NCH), cs = (u % (2 * NCH)) >> 1, g = u & 1;
        const int r0 = chunk_r0(d, cs);
        __syncthreads();
        if (wave < 4) { const int h = g * 4 + wave; const float a = -expf(p.a_log[l * 16 + d * 8 + h]); float total;
            LAS float* ac = wj + 512 + wave * 128; LAS float* dv = wj + 1024 + wave * 128;
            ssd_acum(p.DT, r0, d, d * 8 + h, a, lane, ac, dv, total);
            LDS_FENCE();
            wj[wave * 128 + lane] = __expf(total - ac[lane]) * dv[lane]; wj[wave * 128 + 64 + lane] = __expf(total - ac[64 + lane]) * dv[64 + lane];
            if (lane == 0) DEC[(d * NCH + cs) * 8 + h] = expf(total); }
        for (int idx = tid; idx < 128 * 16; idx += NTHR) { const int j = idx >> 4, n8 = (idx & 15) * 8;
            *(LAS u32x4*)(Bi + j * SB128 + n8 * 2) = *(const u32x4*)(p.CV + (size_t)(r0 + j) * 1024 + 512 + g * 128 + n8); }
        __syncthreads();
        for (int idx = tid; idx < 128 * 32; idx += NTHR) { const int j = idx >> 5, c8 = (idx & 31) * 8;
            const u32x4 v = *(const u32x4*)(p.CV + (size_t)(r0 + j) * 1024 + g * 256 + c8); const float w = wj[(c8 >> 6) * 128 + j];
            u32x4 o; o.x = pk2(bflo(v.x) * w, bfhi(v.x) * w); o.y = pk2(bflo(v.y) * w, bfhi(v.y) * w); o.z = pk2(bflo(v.z) * w, bfhi(v.z) * w); o.w = pk2(bflo(v.w) * w, bfhi(v.w) * w);
            *(LAS u32x4*)(Xi + j * SB256 + c8 * 2) = o; }
        __syncthreads();
        const int hh = wave >> 1, ph = wave & 1;
        f32x4 acc[2][8];
#pragma unroll
        for (int a = 0; a < 2; ++a)
#pragma unroll
            for (int b = 0; b < 8; ++b) acc[a][b] = (f32x4){0.f, 0.f, 0.f, 0.f};
#pragma unroll
        for (int ks = 0; ks < 4; ++ks) {
            bf16x8 af[2];
#pragma unroll
            for (int pt = 0; pt < 2; ++pt) af[pt] = tr_frag(Xi, 32 * ks, hh * 64 + ph * 32 + pt * 16, SB256, lane);
#pragma unroll
            for (int nt = 0; nt < 8; ++nt) { const bf16x8 bfr = tr_frag(Bi, 32 * ks, nt * 16, SB128, lane);
#pragma unroll
                for (int pt = 0; pt < 2; ++pt) acc[pt][nt] = MFMA16(af[pt], bfr, acc[pt][nt]); }
        }
        float* S = SST + ((size_t)(d * NCH + cs) * 8 + g * 4 + hh) * 8192;
#pragma unroll
        for (int pt = 0; pt < 2; ++pt)
#pragma unroll
            for (int nt = 0; nt < 8; ++nt)
#pragma unroll
                for (int r = 0; r < 4; ++r) S[(ph * 32 + pt * 16 + 4 * quad + r) * 128 + nt * 16 + l15] = acc[pt][nt][r];
    }
}

__device__ __forceinline__ void scan_carries(const P& p, int l, const float* SST, const float* DEC, bf16* HIN) {
    for (int e = p.bid * NTHR + p.tid; e < 2 * 8 * 8192; e += p.G * NTHR) {
        const int d = e >> 16, h = (e >> 13) & 7, pn = e & 8191;
        float hs = 0.f;
        for (int c0 = 0; c0 < NCH; c0 += 10) {
            float s[10], dc[10];
#pragma unroll
            for (int j = 0; j < 10; ++j) { const size_t ci = (size_t)(d * NCH + c0 + j) * 8 + h; s[j] = SST[ci * 8192 + pn]; dc[j] = DEC[ci]; }
#pragma unroll
            for (int j = 0; j < 10; ++j) { const size_t ci = (size_t)(d * NCH + c0 + j) * 8 + h; HIN[ci * 8192 + pn] = (bf16)f2bf(hs); hs = hs * dc[j] + s[j]; }
        }
    }
    for (int e = p.bid * NTHR + p.tid; e < 2 * 32 * 64; e += p.G * NTHR) {
        const int d = e >> 11, g = (e >> 6) & 31, pq = e & 63;
        S5Lane s; s5_lane_params(p, l, d, g, pq, s, false);
        float ar = s.abr, ai = s.abi;
#pragma unroll
        for (int q = 0; q < 7; ++q) { const float nr = ar * ar - ai * ai, ni = 2.f * ar * ai; ar = nr; ai = ni; }
        float hr = 0.f, hi = 0.f;
        const float* E = p.S5E + (size_t)(d * 32 + g) * NCH * 128 + pq; float* Hn = p.S5H + (size_t)(d * 32 + g) * NCH * 128 + pq;
        for (int c0 = 0; c0 < NCH; c0 += 10) {
            float er[10], ei[10];
#pragma unroll
            for (int j = 0; j < 10; ++j) { er[j] = E[(c0 + j) * 128]; ei[j] = E[(c0 + j) * 128 + 64]; }
#pragma unroll
            for (int j = 0; j < 10; ++j) { Hn[(c0 + j) * 128] = hr; Hn[(c0 + j) * 128 + 64] = hi;
                const float nr = ar * hr - ai * hi + er[j], ni = ar * hi + ai * hr + ei[j]; hr = nr; hi = ni; }
        }
    }
}

__device__ __forceinline__ void ssd_outputs(const P& p, int l, LAS unsigned char* lds, const bf16* HIN, const float* SST, bf16* YS, int u_begin, int u_end, int first, int stride) {
    LAS unsigned char* Cm = lds;
    LAS unsigned char* Bm = lds + 128 * LDP;
    LAS unsigned char* XT = lds + 2 * 128 * LDP;
    LAS unsigned char* Wm = lds + 2 * 128 * LDP + 128 * SB64;
    LAS float* sm = (LAS float*)(lds + 3 * 128 * LDP + 128 * SB64);
    const int tid = p.tid, lane = p.lane, wave = p.wave, quad = lane >> 4, l15 = lane & 15;
    for (int u = u_begin + first; u < u_end; u += stride) {
        const int cn = u >> 3, h = u & 7, g = h >> 2, r0 = 128 * cn;
        __syncthreads();
        if (wave < 2) { const int d = wave; const float a = -expf(p.a_log[l * 16 + d * 8 + h]); float total;
            ssd_acum(p.DT, r0, d, d * 8 + h, a, lane, sm + d * 128, sm + 256 + d * 128, total); }
        for (int idx = tid; idx < 128 * 16; idx += NTHR) { const int j = idx >> 4, n8 = (idx & 15) * 8;
            const bf16* src = p.CV + (size_t)(r0 + j) * 1024 + g * 128 + n8;
            *(LAS u32x4*)(Bm + j * LDP + n8 * 2) = *(const u32x4*)(src + 512); *(LAS u32x4*)(Cm + j * LDP + n8 * 2) = *(const u32x4*)(src + 768); }
        for (int idx = tid; idx < 128 * 8; idx += NTHR) { const int j = idx >> 3, p8 = (idx & 7) * 8;
            *(LAS u32x4*)(XT + j * SB64 + p8 * 2) = *(const u32x4*)(p.CV + (size_t)(r0 + j) * 1024 + h * 64 + p8); }
        __syncthreads();
        f32x4 G[8];
#pragma unroll
        for (int jt = 0; jt < 8; ++jt) G[jt] = (f32x4){0.f, 0.f, 0.f, 0.f};
#pragma unroll
        for (int ks = 0; ks < 4; ++ks) { const bf16x8 af = ld_frag(Cm, 16 * wave + l15, ks * 32 + 8 * quad, LDP);
#pragma unroll
            for (int jt = 0; jt < 8; ++jt) G[jt] = MFMA16(af, ld_frag(Bm, 16 * jt + l15, ks * 32 + 8 * quad, LDP), G[jt]); }
        __syncthreads();
        for (int idx = tid; idx < 2 * 64 * 16; idx += NTHR) { const int d = idx >> 10, pp = (idx >> 4) & 63, n8 = (idx & 15) * 8;
            const int cs = scan_chunk_of(d, cn);
            u32x4 w;
            if (cn >= 2) w = *(const u32x4*)(HIN + ((size_t)(d * NCH + cs) * 8 + h) * 8192 + pp * 128 + n8);
            else if (cs == 0) w = (u32x4){0u, 0u, 0u, 0u};
            else { const float* s = SST + ((size_t)(d * NCH) * 8 + h) * 8192 + pp * 128 + n8; const f32x4 s0 = *(const f32x4*)s, s1 = *(const f32x4*)(s + 4);
                w.x = pk2(s0[0], s0[1]); w.y = pk2(s0[2], s0[3]); w.z = pk2(s1[0], s1[1]); w.w = pk2(s1[2], s1[3]); }
            *(LAS u32x4*)(Bm + (d * 64 + pp) * LDP + n8 * 2) = w; }
        __syncthreads();
        f32x4 Y[4];
#pragma unroll
        for (int pt = 0; pt < 4; ++pt) Y[pt] = (f32x4){0.f, 0.f, 0.f, 0.f};
#pragma unroll
        for (int d = 0; d < 2; ++d) {
            const LAS float* ac = sm + d * 128; const LAS float* dv = sm + 256 + d * 128;
            float ai[4];
#pragma unroll
            for (int r = 0; r < 4; ++r) ai[r] = ac[16 * wave + 4 * quad + r];
#pragma unroll
            for (int jt = 0; jt < 8; ++jt) { const int j = 16 * jt + l15; const float aj = ac[j], dj = dv[j];
#pragma unroll
                for (int r = 0; r < 4; ++r) { const int i = 16 * wave + 4 * quad + r; const bool valid = (d == 0) ? (j <= i) : (j >= i);
                    const float w = valid ? G[jt][r] * __expf(ai[r] - aj) * dj : 0.f;
                    st_b16(Wm + i * LDP + 2 * j, f2bf(w)); } }
            LDS_FENCE();
            f32x4 Y2[4];
#pragma unroll
            for (int pt = 0; pt < 4; ++pt) Y2[pt] = (f32x4){0.f, 0.f, 0.f, 0.f};
#pragma unroll
            for (int ks = 0; ks < 4; ++ks) { const bf16x8 wf = ld_frag(Wm, 16 * wave + l15, ks * 32 + 8 * quad, LDP), cf = ld_frag(Cm, 16 * wave + l15, ks * 32 + 8 * quad, LDP);
#pragma unroll
                for (int pt = 0; pt < 4; ++pt) { Y[pt] = MFMA16(wf, tr_frag(XT, 32 * ks, 16 * pt, SB64, lane), Y[pt]);
                    Y2[pt] = MFMA16(cf, ld_frag(Bm + d * 64 * LDP, 16 * pt + l15, ks * 32 + 8 * quad, LDP), Y2[pt]); } }
#pragma unroll
            for (int r = 0; r < 4; ++r) { const float ea = __expf(ai[r]);
#pragma unroll
                for (int pt = 0; pt < 4; ++pt) Y[pt][r] += ea * Y2[pt][r]; }
            LDS_FENCE();
        }
#pragma unroll
        for (int pt = 0; pt < 4; ++pt)
#pragma unroll
            for (int r = 0; r < 4; ++r) YS[(size_t)(r0 + 16 * wave + 4 * quad + r) * 512 + h * 64 + 16 * pt + l15] = (bf16)f2bf(Y[pt][r]);
    }
}

__device__ __forceinline__ void ssd_gated_norm(const P& p, int l, const bf16* YS) {
    const int gw = p.bid * NWAVES + p.wave, NGW = p.G * NWAVES, lane = p.lane;
    for (int row = gw; row < T; row += NGW) {
        const int ch = lane * 8;
        const float dsk = p.ssd_d[l * 8 + (ch >> 6)];
        const u32x4 yv = *(const u32x4*)(YS + (size_t)row * 512 + ch);
        const u32x4 xs = *(const u32x4*)(p.CV + (size_t)row * 1024 + ch), zz = *(const u32x4*)(p.PROJ + (size_t)row * PJ + Z0 + ch);
        float v[8];
        v[0] = (bflo(yv.x) + dsk * bflo(xs.x)) * silu_f(bflo(zz.x)); v[1] = (bfhi(yv.x) + dsk * bfhi(xs.x)) * silu_f(bfhi(zz.x));
        v[2] = (bflo(yv.y) + dsk * bflo(xs.y)) * silu_f(bflo(zz.y)); v[3] = (bfhi(yv.y) + dsk * bfhi(xs.y)) * silu_f(bfhi(zz.y));
        v[4] = (bflo(yv.z) + dsk * bflo(xs.z)) * silu_f(bflo(zz.z)); v[5] = (bfhi(yv.z) + dsk * bfhi(xs.z)) * silu_f(bfhi(zz.z));
        v[6] = (bflo(yv.w) + dsk * bflo(xs.w)) * silu_f(bflo(zz.w)); v[7] = (bfhi(yv.w) + dsk * bfhi(xs.w)) * silu_f(bfhi(zz.w));
        float ss = 0.f;
#pragma unroll
        for (int i = 0; i < 8; ++i) ss += v[i] * v[i];
        const float rstd = rsqrtf(wsum(ss) * (1.f / 512.f) + EPS);
        const float* ng = p.ssd_norm_g + (size_t)l * 512 + ch;
        const f32x4 g0 = *(const f32x4*)ng, g1 = *(const f32x4*)(ng + 4);
        u32x4 o; o.x = pk2(v[0] * rstd * g0[0], v[1] * rstd * g0[1]); o.y = pk2(v[2] * rstd * g0[2], v[3] * rstd * g0[3]);
        o.z = pk2(v[4] * rstd * g1[0], v[5] * rstd * g1[1]); o.w = pk2(v[6] * rstd * g1[2], v[7] * rstd * g1[3]);
        *(u32x4*)(p.Y3 + (size_t)row * 1536 + 512 + ch) = o;
    }
}

__device__ __forceinline__ void attention_mfma(const P& p, int l, LAS unsigned char* lds, int u_begin, int u_end, int u_first, int u_stride) {
    LAS unsigned char* Kt = lds;
    LAS unsigned char* VT = lds + 64 * LDQ;
    LAS unsigned char* Pw = lds + 2 * 64 * LDQ + p.wave * 64 * LDQ;
    const int tid = p.tid, lane = p.lane, wave = p.wave, quad = lane >> 4, l15 = lane & 15;
    const float C2 = 0.125f * 1.4426950408889634f;
    for (int u = u_begin + u_first; u < u_end; u += u_stride) {
        const int qb = u >> 1, kvh = u & 1, hq = kvh * 4 + (wave >> 1);
        const bool isc = qb < 2; const int nb = qb - 2;
        const int qrow0 = 128 * qb + 64 * (wave & 1);
        bf16x8 Qf[4][2];
#pragma unroll
        for (int qt = 0; qt < 4; ++qt)
#pragma unroll
            for (int ks = 0; ks < 2; ++ks) Qf[qt][ks] = *(const bf16x8*)(p.PROJ + (size_t)(qrow0 + 16 * qt + l15) * PJ + Q0 + hq * 64 + ks * 32 + 8 * quad);
        f32x4 O[4][4];
#pragma unroll
        for (int a = 0; a < 4; ++a)
#pragma unroll
            for (int b = 0; b < 4; ++b) O[a][b] = (f32x4){0.f, 0.f, 0.f, 0.f};
        float mrow[4], lrow[4];
        const float sk = p.sink[l * 8 + hq] * 1.4426950408889634f;
#pragma unroll
        for (int qt = 0; qt < 4; ++qt) { mrow[qt] = sk; lrow[qt] = 1.f; }
        const int ntile = isc ? 4 : 10;
#define ATT_VALID(ti_) (isc || (ti_) >= 6 || ((NCTX + 128 * (nb - 1) + 64 * (ti_)) >= NCTX && (NCTX + 128 * (nb - 1) + 64 * (ti_)) < T))
#define ATT_KROW0(ti_) ((isc || (ti_) >= 6) ? 64 * (isc ? (ti_) : (ti_) - 6) : NCTX + 128 * (nb - 1) + 64 * (ti_))
        int ti = 0; while (!ATT_VALID(ti)) ++ti;
        u32x4 kreg, vreg;
        { const bf16* src = p.PROJ + (size_t)(ATT_KROW0(ti) + (tid >> 3)) * PJ + kvh * 64 + (tid & 7) * 8; kreg = *(const u32x4*)(src + K0); vreg = *(const u32x4*)(src + V0); }
        while (ti < ntile) {
            const int krow0 = ATT_KROW0(ti); const bool local = !(isc || ti >= 6);
            int tn = ti + 1; while (tn < ntile && !ATT_VALID(tn)) ++tn;
            __syncthreads();
            { const int key = tid >> 3, pc = tid & 7;
              *(LAS u32x4*)(Kt + key * LDQ + pc * 16) = kreg;
              *(LAS u32x4*)(VT + key * SB64 + pc * 16) = vreg; }
            __syncthreads();
            if (tn < ntile) { const bf16* src = p.PROJ + (size_t)(ATT_KROW0(tn) + (tid >> 3)) * PJ + kvh * 64 + (tid & 7) * 8; kreg = *(const u32x4*)(src + K0); vreg = *(const u32x4*)(src + V0); }
            const bool need_mask = local && (ti < 2 || ti > 3);
#pragma unroll
            for (int qt = 0; qt < 4; ++qt) {
                f32x4 S[4][1];
#pragma unroll
                for (int kt = 0; kt < 4; ++kt) S[kt][0] = (f32x4){0.f, 0.f, 0.f, 0.f};
#pragma unroll
                for (int ks = 0; ks < 2; ++ks)
#pragma unroll
                    for (int kt = 0; kt < 4; ++kt) S[kt][0] = MFMA16(ld_frag(Kt, 16 * kt + l15, ks * 32 + 8 * quad, LDQ), Qf[qt][ks], S[kt][0]);
                const int tq = qrow0 + 16 * qt + l15;
                float mx = -1e30f;
                if (need_mask) {
#pragma unroll
                    for (int kt = 0; kt < 4; ++kt)
#pragma unroll
                        for (int r = 0; r < 4; ++r) { const int df = tq - (krow0 + 16 * kt + 4 * quad + r);
                            const float s = (df <= 128 && df >= -128) ? S[kt][0][r] : -1e30f; S[kt][0][r] = s; mx = fmaxf(mx, s); }
                } else {
#pragma unroll
                    for (int kt = 0; kt < 4; ++kt) mx = fmaxf(fmaxf(mx, fmaxf(S[kt][0][0], S[kt][0][1])), fmaxf(S[kt][0][2], S[kt][0][3]));
                }
                mx = fmaxf(mx, __shfl_xor(mx, 16)); mx = fmaxf(mx, __shfl_xor(mx, 32));
                const float mn = fmaxf(mrow[qt], mx * C2), alpha = __builtin_amdgcn_exp2f(mrow[qt] - mn);
                float ls = 0.f;
#pragma unroll
                for (int kt = 0; kt < 4; ++kt) { const float e0 = __builtin_amdgcn_exp2f(S[kt][0][0] * C2 - mn), e1 = __builtin_amdgcn_exp2f(S[kt][0][1] * C2 - mn),
                                                              e2 = __builtin_amdgcn_exp2f(S[kt][0][2] * C2 - mn), e3 = __builtin_amdgcn_exp2f(S[kt][0][3] * C2 - mn);
                    ls += (e0 + e1) + (e2 + e3);
                    u32x2 w; w.x = pk2(e0, e1); w.y = pk2(e2, e3);
                    *(LAS u32x2*)(Pw + (16 * qt + l15) * LDQ + (16 * kt + 4 * quad) * 2) = w; }
                ls += __shfl_xor(ls, 16); ls += __shfl_xor(ls, 32);
                lrow[qt] = lrow[qt] * alpha + ls; mrow[qt] = mn;
#pragma unroll
                for (int dt = 0; dt < 4; ++dt) O[dt][qt] *= alpha;
            }
            LDS_FENCE();
#pragma unroll
            for (int ks = 0; ks < 2; ++ks) {
                bf16x8 pf[4];
#pragma unroll
                for (int qt = 0; qt < 4; ++qt) pf[qt] = ld_frag(Pw, 16 * qt + l15, ks * 32 + 8 * quad, LDQ);
#pragma unroll
                for (int dt = 0; dt < 4; ++dt) { const bf16x8 vf = tr_frag(VT, 32 * ks, 16 * dt, SB64, lane);
#pragma unroll
                    for (int qt = 0; qt < 4; ++qt) O[dt][qt] = MFMA16(vf, pf[qt], O[dt][qt]); }
            }
            LDS_FENCE();
            ti = tn;
        }
#undef ATT_VALID
#undef ATT_KROW0
#pragma unroll
        for (int qt = 0; qt < 4; ++qt) { const float inv = 1.f / lrow[qt];
            bf16* orow = p.Y3 + (size_t)(qrow0 + 16 * qt + l15) * 1536 + 1024 + hq * 64;
#pragma unroll
            for (int dt = 0; dt < 4; ++dt) { u32x2 w; w.x = pk2(O[dt][qt][0] * inv, O[dt][qt][1] * inv); w.y = pk2(O[dt][qt][2] * inv, O[dt][qt][3] * inv);
                *(u32x2*)(orow + 16 * dt + 4 * quad) = w; } }
    }
}

#ifndef S5_INTERLEAVE
#define S5_INTERLEAVE 2
#endif
constexpr size_t S5BB_ELEMS = (size_t)2 * 32 * 128 * 32, S5CC_ELEMS = (size_t)2 * 32 * 16 * 128;
__device__ __forceinline__ void s5_tables(const P& p, int l, bf16* BB, bf16* CC, float* AB) {
    for (int e = p.bid * NTHR + p.tid; e < 2 * 32 * 64; e += p.G * NTHR) {
        const int d = e >> 11, g = (e >> 6) & 31, pq = e & 63, dg = d * 32 + g;
        S5Lane s; s5_lane_params(p, l, d, g, pq, s, true);
        AB[(size_t)e * 2] = s.abr; AB[(size_t)e * 2 + 1] = s.abi;
        #if S5_INTERLEAVE
        u32x4* br = (u32x4*)(BB + ((size_t)dg * 128 + 2 * pq) * 32); u32x4* bi = (u32x4*)(BB + ((size_t)dg * 128 + 2 * pq + 1) * 32);
#else
        u32x4* br = (u32x4*)(BB + ((size_t)dg * 128 + pq) * 32); u32x4* bi = (u32x4*)(BB + ((size_t)dg * 128 + 64 + pq) * 32);
#endif
        u32x4 w;
        w.x = pk2(s.bbr[0], s.bbr[1]); w.y = pk2(s.bbr[2], s.bbr[3]); w.z = pk2(s.bbr[4], s.bbr[5]); w.w = pk2(s.bbr[6], s.bbr[7]); br[0] = w;
        w.x = pk2(s.bbr[8], s.bbr[9]); w.y = pk2(s.bbr[10], s.bbr[11]); w.z = pk2(s.bbr[12], s.bbr[13]); w.w = pk2(s.bbr[14], s.bbr[15]); br[1] = w;
        w.x = pk2(s.bbi[0], s.bbi[1]); w.y = pk2(s.bbi[2], s.bbi[3]); w.z = pk2(s.bbi[4], s.bbi[5]); w.w = pk2(s.bbi[6], s.bbi[7]); bi[0] = w;
        w.x = pk2(s.bbi[8], s.bbi[9]); w.y = pk2(s.bbi[10], s.bbi[11]); w.z = pk2(s.bbi[12], s.bbi[13]); w.w = pk2(s.bbi[14], s.bbi[15]); bi[1] = w;
        const u32x4 z = (u32x4){0u, 0u, 0u, 0u}; br[2] = z; br[3] = z; bi[2] = z; bi[3] = z;
        const size_t ci = ((size_t)(l * 2 + d) * 32 + g) * 16;
#pragma unroll
        for (int k = 0; k < 16; ++k) {
#if S5_INTERLEAVE
            *(unsigned*)(CC + ((size_t)dg * 16 + k) * 128 + 2 * pq) = pk2(p.c_re[(ci + k) * 64 + pq], -p.c_im[(ci + k) * 64 + pq]);
#else
            CC[((size_t)dg * 16 + k) * 128 + pq] = (bf16)f2bf(p.c_re[(ci + k) * 64 + pq]); CC[((size_t)dg * 16 + k) * 128 + 64 + pq] = (bf16)f2bf(-p.c_im[(ci + k) * 64 + pq]);
#endif
        }
    }
}
constexpr int S5_WREG = 4096 + 16 * 132 * 4 + 16 * LDP;
template <bool READOUT> __device__ __forceinline__ void s5_chunk_dir(int d, const bf16* BBdg, const bf16* CCdg, float abr, float abi, LAS unsigned char* wreg, int lane, float& hr, float& hi, f32x4 (&yacc)[8]) {
    const int quad = lane >> 4, l15 = lane & 15;
    LAS unsigned char* ub = wreg; LAS float* BuW = (LAS float*)(wreg + 4096); LAS unsigned char* Hw = wreg + 4096 + 16 * 132 * 4;
    bf16x8 BBf[8], CCf[4];
#pragma unroll
    for (int pt = 0; pt < 8; ++pt) BBf[pt] = *(const bf16x8*)(BBdg + (size_t)(16 * pt + l15) * 32 + 8 * quad);
    if (READOUT) {
#pragma unroll
        for (int ks = 0; ks < 4; ++ks) CCf[ks] = *(const bf16x8*)(CCdg + (size_t)l15 * 128 + ks * 32 + 8 * quad);
    }
#pragma unroll (READOUT ? 8 : 1)
    for (int ss = 0; ss < 8; ++ss) {
        const int sc = d ? 7 - ss : ss;
        bf16x8 uf = (bf16x8){0, 0, 0, 0, 0, 0, 0, 0};
        if (quad < 2) uf = *(const LAS bf16x8*)(ub + (16 * sc + l15) * 32 + quad * 16);
#pragma unroll
        for (int pt = 0; pt < 8; ++pt) { const f32x4 Dp = MFMA16(uf, BBf[pt], ((f32x4){0.f, 0.f, 0.f, 0.f}));
#pragma unroll
            for (int r = 0; r < 4; ++r) BuW[(4 * quad + r) * 132 + 16 * pt + l15] = Dp[r]; }
        LDS_FENCE();
#pragma unroll
        for (int st = 0; st < 16; ++st) { const int tl = d ? 15 - st : st;
#if S5_INTERLEAVE == 1
            typedef float f32x2_t __attribute__((ext_vector_type(2)));
            const f32x2_t bu = *(const LAS f32x2_t*)(BuW + tl * 132 + 2 * lane);
            const float nr = abr * hr - abi * hi + bu[0], ni = abr * hi + abi * hr + bu[1]; hr = nr; hi = ni;
            if (READOUT) *(LAS unsigned*)(Hw + tl * LDP + 4 * lane) = pk2(hr, hi); }
#elif S5_INTERLEAVE == 2
            const float br = BuW[tl * 132 + 2 * lane], bi = BuW[tl * 132 + 2 * lane + 1];
            const float nr = abr * hr - abi * hi + br, ni = abr * hi + abi * hr + bi; hr = nr; hi = ni;
            if (READOUT) *(LAS unsigned*)(Hw + tl * LDP + 4 * lane) = pk2(hr, hi); }
#else
            const float br = BuW[tl * 132 + lane], bi = BuW[tl * 132 + 64 + lane];
            const float nr = abr * hr - abi * hi + br, ni = abr * hi + abi * hr + bi; hr = nr; hi = ni;
            if (READOUT) { st_b16(Hw + tl * LDP + 2 * lane, f2bf(hr)); st_b16(Hw + tl * LDP + 128 + 2 * lane, f2bf(hi)); } }
#endif
        if (READOUT) {
            LDS_FENCE();
#pragma unroll
            for (int ks = 0; ks < 4; ++ks) yacc[sc] = MFMA16(ld_frag(Hw, l15, ks * 32 + 8 * quad, LDP), CCf[ks], yacc[sc]);
        }
        LDS_FENCE();
    }
}
__device__ __forceinline__ void s5_local_states(const P& p, LAS unsigned char* lds, const bf16* BB, const float* AB) {
    LAS unsigned char* wreg = lds + p.wave * S5_WREG;
    const int gw = p.vcu * NWAVES + p.wave, NGW = p.G * NWAVES, lane = p.lane;
    for (int it = gw; it < 2 * 32 * NCH; it += NGW) {
        const int d = it / (32 * NCH), c = (it % (32 * NCH)) >> 5, g = it & 31, dg = d * 32 + g;
        s5_stage_u(p, chunk_r0(d, c), g, wreg, lane);
        float hr = 0.f, hi = 0.f; f32x4 dummy[8];
        const float abr = AB[((size_t)dg * 64 + lane) * 2], abi = AB[((size_t)dg * 64 + lane) * 2 + 1];
        if (d == 0) s5_chunk_dir<false>(0, BB + (size_t)dg * 128 * 32, nullptr, abr, abi, wreg, lane, hr, hi, dummy);
        else s5_chunk_dir<false>(1, BB + (size_t)dg * 128 * 32, nullptr, abr, abi, wreg, lane, hr, hi, dummy);
        float* E = p.S5E + ((size_t)dg * NCH + c) * 128;
        E[lane] = hr; E[64 + lane] = hi;
    }
}
__device__ __forceinline__ void s5_outputs(const P& p, int l, LAS unsigned char* lds, const bf16* BB, const bf16* CC, const float* AB, int it_begin, int it_end, int first, int stride) {
    LAS unsigned char* wreg = lds + p.wave * S5_WREG;
    const int lane = p.lane, quad = lane >> 4, l15 = lane & 15;
    for (int it = it_begin + first; it < it_end; it += stride) {
        const int cn = it >> 5, g = it & 31, r0 = 128 * cn;
        s5_stage_u(p, r0, g, wreg, lane);
        f32x4 yacc[8];
#pragma unroll
        for (int i = 0; i < 8; ++i) yacc[i] = (f32x4){0.f, 0.f, 0.f, 0.f};
#pragma unroll
        for (int d = 0; d < 2; ++d) { const int dg = d * 32 + g, cs = scan_chunk_of(d, cn);
            const float* Hn = (cn < 2) ? (p.S5E + (size_t)dg * NCH * 128) : (p.S5H + ((size_t)dg * NCH + cs) * 128);
            float hr = Hn[lane], hi = Hn[64 + lane];
            if (cs == 0) { hr = 0.f; hi = 0.f; }
            s5_chunk_dir<true>(d, BB + (size_t)dg * 128 * 32, CC + (size_t)dg * 16 * 128, AB[((size_t)dg * 64 + lane) * 2], AB[((size_t)dg * 64 + lane) * 2 + 1], wreg, lane, hr, hi, yacc); }
        const float dsk = p.s5_d[(size_t)l * 512 + g * 16 + l15];
#pragma unroll
        for (int sc = 0; sc < 8; ++sc)
#pragma unroll
            for (int r = 0; r < 4; ++r) { const int t = 16 * sc + 4 * quad + r;
                const float u = bf2f(*(const LAS unsigned short*)(wreg + t * 32 + 2 * l15));
                p.SA[(size_t)(r0 + t) * 512 + g * 16 + l15] = (bf16)f2bf(gelu_tanh_f(yacc[sc][r] + dsk * u)); }
        LDS_FENCE();
    }
}

template <int NT, class Epi>
__device__ __forceinline__ void small_gemm(const P& p, LAS unsigned char* lds, const bf16* A, int lda, const bf16* Bt, int ldb, int K, int kc_per_seg, const Epi& E, const int* aidx = nullptr) {
    LAS unsigned char* As = lds;
    LAS unsigned char* Bs = lds + 64 * LDP;
    const int tid = p.tid, lane = p.lane, wave = p.wave, quad = lane >> 4, l15 = lane & 15;
    f32x4 acc[NT][4], sum[NT][4];
#pragma unroll
    for (int a = 0; a < NT; ++a)
#pragma unroll
        for (int b = 0; b < 4; ++b) { acc[a][b] = (f32x4){0.f, 0.f, 0.f, 0.f}; sum[a][b] = (f32x4){0.f, 0.f, 0.f, 0.f}; }
    const int nch = K >> 7, prow = tid >> 4, pc = (tid & 15) * 8;
    u32x4 ra[2], rb[4 * NT]; int arow[2];
#pragma unroll
    for (int i = 0; i < 2; ++i) arow[i] = aidx ? aidx[prow + 32 * i] : prow + 32 * i;
#pragma unroll
    for (int i = 0; i < 2; ++i) ra[i] = *(const u32x4*)(A + (size_t)arow[i] * lda + pc);
#pragma unroll
    for (int i = 0; i < 4 * NT; ++i) rb[i] = *(const u32x4*)(Bt + (size_t)(prow + 32 * i) * ldb + pc);
    for (int kc = 0; kc < nch; ++kc) {
        __syncthreads();
#pragma unroll
        for (int i = 0; i < 2; ++i) *(LAS u32x4*)(As + (prow + 32 * i) * LDP + pc * 2) = ra[i];
#pragma unroll
        for (int i = 0; i < 4 * NT; ++i) *(LAS u32x4*)(Bs + (prow + 32 * i) * LDP + pc * 2) = rb[i];
        __syncthreads();
        if (kc + 1 < nch) {
#pragma unroll
            for (int i = 0; i < 2; ++i) ra[i] = *(const u32x4*)(A + (size_t)arow[i] * lda + (kc + 1) * 128 + pc);
#pragma unroll
            for (int i = 0; i < 4 * NT; ++i) rb[i] = *(const u32x4*)(Bt + (size_t)(prow + 32 * i) * ldb + (kc + 1) * 128 + pc);
        }
#pragma unroll
        for (int ks = 0; ks < 4; ++ks) {
            bf16x8 af[4];
#pragma unroll
            for (int mt = 0; mt < 4; ++mt) af[mt] = ld_frag(As, 16 * mt + l15, ks * 32 + 8 * quad, LDP);
#pragma unroll
            for (int nt = 0; nt < NT; ++nt) { const bf16x8 bfr = ld_frag(Bs, 128 * nt + 16 * wave + l15, ks * 32 + 8 * quad, LDP);
#pragma unroll
                for (int mt = 0; mt < 4; ++mt) acc[nt][mt] = MFMA16(af[mt], bfr, acc[nt][mt]); }
        }
        if ((kc + 1) % kc_per_seg == 0) E.seg(acc, sum, kc / kc_per_seg, wave, quad, l15);
    }
    E.fin(acc, sum, wave, quad, l15);
    __syncthreads();
}
struct SgMerge {
    const bf16* proj; bf16* MB; int rb, cc;
    __device__ __forceinline__ void seg(f32x4 (&acc)[1][4], f32x4 (&sum)[1][4], int s, int wave, int quad, int l15) const {
#pragma unroll
        for (int mt = 0; mt < 4; ++mt)
#pragma unroll
            for (int r = 0; r < 4; ++r) { const int row = rb * 64 + 16 * mt + 4 * quad + r, col = cc * 128 + 16 * wave + l15;
                sum[0][mt][r] += bf2f(proj[(size_t)row * PJ + GT0 + s * 1024 + col]) * acc[0][mt][r]; acc[0][mt][r] = 0.f; }
    }
    __device__ __forceinline__ void fin(f32x4 (&acc)[1][4], f32x4 (&sum)[1][4], int wave, int quad, int l15) const {
#pragma unroll
        for (int mt = 0; mt < 4; ++mt)
#pragma unroll
            for (int r = 0; r < 4; ++r) MB[(size_t)(rb * 64 + 16 * mt + 4 * quad + r) * 1024 + cc * 128 + 16 * wave + l15] = (bf16)f2bf(sum[0][mt][r]);
    }
};
struct SgResid {
    float* XC; const float* g; int rb, cc;
    __device__ __forceinline__ void seg(f32x4 (&)[1][4], f32x4 (&)[1][4], int, int, int, int) const {}
    __device__ __forceinline__ void fin(f32x4 (&acc)[1][4], f32x4 (&)[1][4], int wave, int quad, int l15) const {
        const int col = cc * 128 + 16 * wave + l15; const float gv = g[col];
#pragma unroll
        for (int mt = 0; mt < 4; ++mt)
#pragma unroll
            for (int r = 0; r < 4; ++r) { float* px = XC + (size_t)(rb * 64 + 16 * mt + 4 * quad + r) * 1024 + col; *px += gv * acc[0][mt][r]; }
    }
};
struct SgSwiGlu {
    bf16* HID; int row0, t;
    __device__ __forceinline__ void seg(f32x4 (&)[2][4], f32x4 (&)[2][4], int, int, int, int) const {}
    __device__ __forceinline__ void fin(f32x4 (&acc)[2][4], f32x4 (&)[2][4], int wave, int quad, int l15) const {
#pragma unroll
        for (int mt = 0; mt < 4; ++mt)
#pragma unroll
            for (int r = 0; r < 4; ++r) HID[(size_t)(row0 + 16 * mt + 4 * quad + r) * 1024 + 128 * t + 16 * wave + l15] = (bf16)f2bf(silu_f(acc[0][mt][r]) * acc[1][mt][r]);
    }
};
struct SgDown {
    bf16* YE; const float* gsel; int row0, cc;
    __device__ __forceinline__ void seg(f32x4 (&)[1][4], f32x4 (&)[1][4], int, int, int, int) const {}
    __device__ __forceinline__ void fin(f32x4 (&acc)[1][4], f32x4 (&)[1][4], int wave, int quad, int l15) const {
#pragma unroll
        for (int mt = 0; mt < 4; ++mt)
#pragma unroll
            for (int r = 0; r < 4; ++r) { const int row = row0 + 16 * mt + 4 * quad + r; YE[(size_t)row * 1024 + cc * 128 + 16 * wave + l15] = (bf16)f2bf(acc[0][mt][r] * gsel[row]); }
    }
};

#ifndef SKIPMASK
#define SKIPMASK 0
#endif
struct Args { const float* in[33]; float* out; unsigned char* ws; int ph_lo, ph_hi; };
static_assert(sizeof(Args) == 35 * 8 + 8, "no padding");

__global__ void __launch_bounds__(NTHR, 2) fwd_kernel(Args args) {
    extern __shared__ __attribute__((aligned(16))) unsigned char lds_raw[];
    LAS unsigned char* lds = (LAS unsigned char*)lds_raw;
    const int tid_ = threadIdx.x;
    if (tid_ == 0) {
        LAS unsigned long long* tab = (LAS unsigned long long*)(lds + PTAB_OFF);
#pragma unroll
        for (int k = 0; k < 33; ++k) tab[k] = (unsigned long long)args.in[k];
        tab[33] = (unsigned long long)args.out; tab[34] = (unsigned long long)args.ws;
    }
    volatile LAS unsigned* MISC = (volatile LAS unsigned*)(lds + MISC_OFF);
    if (tid_ < 64) MISC[tid_] = 0u;
    __syncthreads();
    XcdBarrier bar; bar.bar = (unsigned*)(args.ws + WS_CTL) + CW_BAR; bar.x = 0; bar.st = nullptr;
    if (!MK_PER_PHASE) bar = xcd_barrier_post((unsigned*)(args.ws + WS_CTL) + CW_BAR, MISC + 8);

    const int lo = args.ph_lo, hi = args.ph_hi;
#define IN(k) (lo <= (k) && (k) < hi)
#define SEAM(k) do { if (!MK_PER_PHASE && (k) + 1 < hi) xcd_barrier(bar); } while (0)

    if (IN(0)) { P p; build_P(p, lds, 0); phase_mod(p, lds, (float*)(args.ws + WS_ROPE)); __syncthreads(); convert_weights(p, 0, lds, p.bid * NWAVES + p.wave, p.G * NWAVES); SEAM(0); }

#ifndef REPSUB
#define REPSUB 0
#endif
#define RSUB(b, ...) for (int r2_ = 0; r2_ <= ((REPSUB >> (b)) & 1); ++r2_) { __VA_ARGS__; __syncthreads(); }
#ifndef REPMASK
#define REPMASK 0
#endif
#define PHASE(k, ...) if (!((SKIPMASK >> (k)) & 1) && IN(pb + (k))) { for (int rep_ = 0; rep_ <= ((REPMASK >> (k)) & 1); ++rep_) { P p; build_P(p, lds, l & 1); __VA_ARGS__; \
        if (rep_ < ((REPMASK >> (k)) & 1)) xcd_barrier(bar); } SEAM(pb + (k)); }
    for (int l = 0; l < DEPTH; ++l) {
        const int pb = 1 + NPH_LAYER * l;
        const bool cx = l < DEPTH - 1;
        unsigned char* wsb; { unsigned tb_ = (unsigned)(size_t)(lds + PTAB_OFF); asm volatile("" : "+v"(tb_)); wsb = (unsigned char*)ld_tab((volatile LAS unsigned*)(size_t)tb_, 34); }
        PHASE(0, s5_tables(p, l, (bf16*)(wsb + WS_S5BB), (bf16*)(wsb + WS_S5CC), (float*)(wsb + WS_S5AB)); __syncthreads(); row_pass<0>(p, l, lds, true, rep_ < ((REPMASK >> 0) & 1)))
        PHASE(1, pg8::Gemm g{p.H, p.WIN, T, PJ, D}; pg8::StaticOrder S; S.init(T, PJ, p.G, p.bid); pg8::EpiStoreBf16 E{p.PROJ, PJ, GT0 / 256, (const float*)(wsb + WS_ROPE)};
            pg8::gemm_phase<pg8::EpiStoreBf16, pg8::StaticOrder, false>(lds, g, S, E, nullptr))
        PHASE(2, RSUB(2, phase_premix(p, l, lds)) RSUB(3, s5_local_states(p, lds, (const bf16*)(wsb + WS_S5BB), (const float*)(wsb + WS_S5AB))))
        PHASE(3, RSUB(0, ssd_states(p, l, lds, (float*)(wsb + WS_SST), (float*)(wsb + WS_DEC))) RSUB(1, attention_mfma(p, l, lds, 4, 2 * NCH, p.vcu, p.G)))
        PHASE(4, if (cx) { if (p.bid >= p.G - 4) attention_mfma(p, l, lds, 0, 4, p.bid - (p.G - 4), 4);
                else if (p.bid >= p.G - 20) ssd_outputs(p, l, lds, (const bf16*)(wsb + WS_HIN), (const float*)(wsb + WS_SST), (bf16*)(wsb + WS_YS), 0, 16, p.bid - (p.G - 20), 16);
                else if (p.bid >= p.G - 28) s5_outputs(p, l, lds, (const bf16*)(wsb + WS_S5BB), (const bf16*)(wsb + WS_S5CC), (const float*)(wsb + WS_S5AB), 0, 64, (p.bid - (p.G - 28)) * NWAVES + p.wave, 64); }
            scan_carries(p, l, (const float*)(wsb + WS_SST), (const float*)(wsb + WS_DEC), (bf16*)(wsb + WS_HIN)))
        PHASE(5, RSUB(4, ssd_outputs(p, l, lds, (const bf16*)(wsb + WS_HIN), (const float*)(wsb + WS_SST), (bf16*)(wsb + WS_YS), 16, NCH * 8, p.vcu, p.G))
            RSUB(5, s5_outputs(p, l, lds, (const bf16*)(wsb + WS_S5BB), (const bf16*)(wsb + WS_S5CC), (const float*)(wsb + WS_S5AB), 64, 32 * NCH, p.vcu * NWAVES + p.wave, p.G * NWAVES)))
        PHASE(6, pg8::Gemm g{p.SA, p.WGLU, T, 512, 512}; pg8::RowOffOrder S; S.init(cx ? T : NLAT, 512, p.G, p.bid, cx ? 0 : 1); pg8::EpiGlu E{p.SA, p.b_glu + (size_t)l * 512, p.Y3};
            pg8::gemm_phase<pg8::EpiGlu, pg8::RowOffOrder, false>(lds, g, S, E, nullptr); ssd_gated_norm(p, l, (const bf16*)(wsb + WS_YS)))
        PHASE(7, pg8::Gemm g{p.Y3, p.WBR, T, D, 1536}; pg8::RowOffOrder S; S.init(NLAT, D, p.G, p.bid, 1); pg8::EpiMerge E{p.PROJ, p.MB};
            pg8::gemm_phase<pg8::EpiMerge, pg8::RowOffOrder, false>(lds, g, S, E, nullptr);
            if (cx) for (int it = p.bid; it < 32; it += p.G) { const SgMerge e{p.PROJ, p.MB, it >> 3, it & 7};
                small_gemm<1, SgMerge>(p, lds, p.Y3 + (size_t)(it >> 3) * 64 * 1536, 1536, p.WBR + (size_t)(it & 7) * 128 * 1536, 1536, 1536, 4, e); })
        PHASE(8, pg8::Gemm g{p.MB, p.WOUT, T, D, D}; pg8::RowOffOrder S; S.init(NLAT, D, p.G, p.bid, 1);
            const bool dry8 = rep_ < ((REPMASK >> 8) & 1);
            pg8::EpiResid E{dry8 ? p.PM + (size_t)NCTX * D : p.XL, dry8 ? p.PM : p.XC, p.MOD + (size_t)(l * 2 + 0) * 6144 + 2 * D, p.MOD + (size_t)(l * 2 + 1) * 6144 + 2 * D};
            pg8::gemm_phase<pg8::EpiResid, pg8::RowOffOrder, false>(lds, g, S, E, nullptr);
            if (cx) for (int it = p.bid; it < 32; it += p.G) { const SgResid e{dry8 ? p.PM : p.XC, p.MOD + (size_t)(l * 2 + 1) * 6144 + 2 * D, it >> 3, it & 7};
                small_gemm<1, SgResid>(p, lds, p.MB + (size_t)(it >> 3) * 64 * 1024, 1024, p.WOUT + (size_t)(it & 7) * 128 * 1024, 1024, 1024, 8, e); })
        PHASE(9, row_pass<1>(p, l, lds, cx))
        PHASE(10, { const int nsel = cx ? 32 : 16; if (p.bid < nsel) phase_select(p, lds, cx);
            else if (l + 1 < DEPTH) { P q; build_P(q, lds, (l + 1) & 1); convert_weights(q, l + 1, lds, (p.bid - nsel) * NWAVES + p.wave, (p.G - nsel) * NWAVES); } })
        PHASE(12, pg8::Gemm g{p.H, p.WUP, NE * ESLOTS, NE * 2048, D}; pg8::ExpertOrderT<true> S{p.G, p.bid, 8, 8, p.IDX}; pg8::EpiSwiGlu E{p.HID};
            pg8::gemm_phase<pg8::EpiSwiGlu, pg8::ExpertOrderT<true>, false>(lds, g, S, E, nullptr);
            if (cx) for (int it = p.bid; it < NE * 8; it += p.G) { const int e = it >> 3, t = it & 7; const SgSwiGlu ep{p.HID, e * ESLOTS + CAP_L, t};
                small_gemm<2, SgSwiGlu>(p, lds, p.H, 1024, p.WUP + (size_t)(e * 2048 + 256 * t) * 1024, 1024, 1024, 8, ep, p.IDX + e * ESLOTS + CAP_L); })
        PHASE(13, pg8::Gemm g{p.HID, p.WDN, NE * ESLOTS, NE * 1024, D}; pg8::ExpertOrderT<false> S{p.G, p.bid, 4, 8, nullptr}; pg8::EpiDown E{p.YE, p.GSEL};
            pg8::gemm_phase<pg8::EpiDown, pg8::ExpertOrderT<false>, false>(lds, g, S, E, nullptr);
            if (cx) for (int it = p.bid; it < NE * 8; it += p.G) { const int e = it >> 3, cc = it & 7; const SgDown ep{p.YE, p.GSEL, e * ESLOTS + CAP_L, cc};
                small_gemm<1, SgDown>(p, lds, p.HID + (size_t)(e * ESLOTS + CAP_L) * 1024, 1024, p.WDN + (size_t)(e * 1024 + 128 * cc) * 1024, 1024, 1024, 8, ep); })
    }
    if (IN(NPHASES - 1)) { P p; build_P(p, lds); row_pass<2>(p, 0, lds); }
#undef IN
#undef SEAM
}

extern "C" void kernel_launch(void* const* d_in, const int* in_sizes, int n_in, void* d_out, int out_size, void* d_ws, size_t ws_size, hipStream_t stream) {
    static int grid = 0;
    if (grid == 0) {
        if (n_in != 33 || out_size != NLAT * D || ws_size < WS_END) { fprintf(stderr, "kernel_launch: unexpected shapes: n_in %d out %d ws %zu (need %zu)\n", n_in, out_size, ws_size, (size_t)WS_END); grid = -1; return; }
        int dev = 0, cus = 0, per_cu = 0;
        if (hipGetDevice(&dev) != hipSuccess || hipDeviceGetAttribute(&cus, hipDeviceAttributeMultiprocessorCount, dev) != hipSuccess) { grid = -1; return; }
        if (hipFuncSetAttribute((const void*)fwd_kernel, hipFuncAttributeMaxDynamicSharedMemorySize, LDS_BYTES) != hipSuccess) { fprintf(stderr, "kernel_launch: hipFuncSetAttribute failed\n"); grid = -1; return; }
        if (hipOccupancyMaxActiveBlocksPerMultiprocessor(&per_cu, (const void*)fwd_kernel, NTHR, LDS_BYTES) != hipSuccess || per_cu < 1) { fprintf(stderr, "kernel_launch: occupancy query says %d\n", per_cu); (void)hipGetLastError(); }
        grid = cus;
    }
    if (grid < 0) return;
    (void)hipMemsetAsync((char*)d_ws + WS_CTL, 0, CTL_BYTES, stream);
    Args a{};
    for (int i = 0; i < 33; ++i) a.in[i] = (const float*)d_in[i];
    a.out = (float*)d_out; a.ws = (unsigned char*)d_ws;
#if MK_PER_PHASE
    for (int ph = 0; ph < NPHASES; ++ph) { a.ph_lo = ph; a.ph_hi = ph + 1; hipLaunchKernelGGL(fwd_kernel, dim3(grid), dim3(NTHR), LDS_BYTES, stream, a); }
#else
    a.ph_lo = 0; a.ph_hi = NPHASES;
    hipLaunchKernelGGL(fwd_kernel, dim3(grid), dim3(NTHR), LDS_BYTES, stream, a);
#endif
}
```

```cpp
#include <hip/hip_runtime.h>
#include <cstdio>
#include <cstdint>

#ifndef MK_PER_PHASE
#define MK_PER_PHASE 0
#endif

namespace pg8 {
#define PG8_LAS __attribute__((address_space(3)))
typedef unsigned short bf16_t;
typedef short bf16x8 __attribute__((ext_vector_type(8)));
typedef float f32x4 __attribute__((ext_vector_type(4)));
typedef unsigned u32x4 __attribute__((ext_vector_type(4)));
constexpr int BM = 256, BK = 64, HALF = 128, HTB = HALF * BK * 2  , STAGE_BYTES = 8 * HTB, NXCD = 8, WGM = 8;

__host__ __device__ __forceinline__ int lds_byte(int r, int c) { const int st = (r >> 4) * 2 + (c >> 5), rr = r & 15, cc = c & 31, ob = rr * 64 + cc * 2; return st * 1024 + (ob ^ (((ob >> 9) & 1) << 5)); }
__host__ __device__ __forceinline__ void stage_rc(int b, int& R, int& C) { const int st = b / 1024, sb = b % 1024, swz = sb ^ (((sb >> 9) & 1) << 5); R = (st >> 1) * 16 + swz / 64; C = (st & 1) * 32 + (swz % 64) / 2; }
__host__ __device__ __forceinline__ int perm32(int rho) { const int n = rho >> 4, i = rho & 15; return 8 * (i >> 2) + 4 * n + (i & 3); }

struct Unit { int pm, pn; };
struct Gemm { const bf16_t __attribute__((address_space(1)))* A; const bf16_t __attribute__((address_space(1)))* Bt; int M, N, K; };

struct StaticOrder {
    static constexpr bool GATHER = false;
    int nM, nN, nwg, G, c;
    __host__ __device__ void init(int M, int N, int G_, int c_) { nM = M / BM; nN = N / BM; nwg = nM * nN; G = G_; c = c_; }
    __host__ __device__ bool next(int i, Unit& u) const {
        const long L = (long)i * G + c; if (L >= nwg) return false;
        int wgid = (int)L; { const int q = nwg / NXCD, r = nwg % NXCD, xcd = wgid % NXCD, off = wgid / NXCD; wgid = (xcd < r ? xcd * (q + 1) : r * (q + 1) + (xcd - r) * q) + off; }
        const int nig = WGM * nN, gid = wgid / nig, fm = gid * WGM, gsz = (nM - fm) < WGM ? (nM - fm) : WGM;
        u.pm = fm + ((wgid % nig) % gsz); u.pn = (wgid % nig) / gsz; return true;
    }
    __device__ __forceinline__ void a_ready(const Unit&) const {}
    __device__ __forceinline__ void done(const Unit&) const {}
};
__device__ __forceinline__ int tid_of(int wave_s) { int w = wave_s; asm volatile("" : "+s"(w)); return w * 64 + (int)__builtin_amdgcn_mbcnt_hi(~0u, __builtin_amdgcn_mbcnt_lo(~0u, 0u)); }
__device__ __forceinline__ unsigned cvt_pk_bf16(float lo, float hi) { unsigned r; asm volatile("v_cvt_pk_bf16_f32 %0, %1, %2" : "=v"(r) : "v"(lo), "v"(hi)); return r; }
template <class Epi, class Sched, bool STAMP = false>
__device__ __forceinline__ void gemm_phase(PG8_LAS unsigned char* lds, const Gemm g, const Sched& S, const Epi& E, unsigned long long* stamps, int wave_s) {
    int tid_l = tid_of(wave_s); asm volatile("" : "+v"(tid_l));
    const int tid = tid_l, wid = __builtin_amdgcn_readfirstlane(tid >> 6), lane = tid & 63, wr = wid >> 2, wc = wid & 3, fr = lane & 15, fq = lane >> 4;
    const int K = g.K, nt = K / BK;
    int ts_lo = 0, ts_hi = 0, nts = 0; const unsigned long long rt_entry = STAMP ? (unsigned long long)wall_clock64() : 0ull;
#define PG8_STAMP() do { if (STAMP && wid == 0 && nts < 64) { const unsigned long long _c = (unsigned long long)clock64(); \
        ts_lo = (lane == nts) ? (int)(unsigned)_c : ts_lo; ts_hi = (lane == nts) ? (int)(unsigned)(_c >> 32) : ts_hi; ++nts; } } while (0)
    PG8_STAMP();
    unsigned voffA[2], voffB[2]; int rA[2], cAo[2];
#pragma unroll
    for (int i = 0; i < 2; ++i) { int R, C; stage_rc(tid * 16 + i * 8192, R, C); const int Rb = Epi::PERM ? ((R & ~31) + perm32(R & 31)) : R;
        voffA[i] = (unsigned)(R * K + C) * 2u; voffB[i] = (unsigned)(Rb * K + C) * 2u; rA[i] = R; cAo[i] = C; }
    const size_t kstep = (size_t)(BK * 2);
    const size_t hstep = (size_t)HALF * K * 2;
    const size_t tstep = 2 * hstep;
    const unsigned ldsw = (unsigned)wid * 1024u;
    const int aoff = lds_byte(wr * 64 + fr, fq * 8), boff = lds_byte(wc * 32 + fr, fq * 8);
#define PG8_SA(b, h) (((b) * 2 + (h)) * HTB)
#define PG8_SB(b, h) ((4 + (b) * 2 + (h)) * HTB)
#define PG8_STAGE(bufoff, gbase, voff) do { _Pragma("unroll") for (int _i = 0; _i < 2; ++_i) \
        __builtin_amdgcn_global_load_lds((const unsigned*)((const char*)(gbase) + (voff)[_i]), (PG8_LAS unsigned*)(lds + (bufoff) + ldsw + _i * 8192), 16, 0, 0); } while (0)
#define PG8_LDA(dst, b, h) do { _Pragma("unroll") for (int m = 0; m < 4; ++m) _Pragma("unroll") for (int k = 0; k < 2; ++k) dst[m][k] = *(const PG8_LAS bf16x8*)(lds + PG8_SA(b, h) + aoff + m * 2048 + k * 1024); } while (0)
#define PG8_LDB(dst, b, h) do { _Pragma("unroll") for (int n = 0; n < 2; ++n) _Pragma("unroll") for (int k = 0; k < 2; ++k) dst[n][k] = *(const PG8_LAS bf16x8*)(lds + PG8_SB(b, h) + boff + n * 2048 + k * 1024); } while (0)
#define PG8_MMA(ai, bj, At, Bt) do { __builtin_amdgcn_s_setprio(1); _Pragma("unroll") for (int m = 0; m < 4; ++m) _Pragma("unroll") for (int n = 0; n < 2; ++n) _Pragma("unroll") for (int k = 0; k < 2; ++k) \
        acc[ai][bj][m][n] = __builtin_amdgcn_mfma_f32_16x16x32_bf16(Bt[n][k], At[m][k], acc[ai][bj][m][n], 0, 0, 0); __builtin_amdgcn_s_setprio(0); } while (0)
#define PG8_WAIT_V(n) asm volatile("s_waitcnt vmcnt(" #n ")" ::: "memory")
#define PG8_WAIT_L(n) asm volatile("s_waitcnt lgkmcnt(" #n ")" ::: "memory")
#define PG8_BAR __builtin_amdgcn_s_barrier()
#define PG8_SCHED __builtin_amdgcn_sched_barrier(0)
    Unit cur, nxt; int ui = 0;
    if (!S.next(0, cur)) return;
    f32x4 acc[2][2][4][2];
#pragma unroll
    for (int a = 0; a < 2; ++a)
#pragma unroll
        for (int b = 0; b < 2; ++b)
#pragma unroll
            for (int m = 0; m < 4; ++m)
#pragma unroll
                for (int n = 0; n < 2; ++n) acc[a][b][m][n] = (f32x4){0.f, 0.f, 0.f, 0.f};
    bf16x8 At[4][2], B0[2][2], B1[2][2];
    unsigned vAc[2][2], vAn[2][2];
#pragma unroll
    for (int h = 0; h < 2; ++h)
#pragma unroll
        for (int i = 0; i < 2; ++i) { if constexpr (Sched::GATHER) vAc[h][i] = (unsigned)S.arow(cur, h * HALF + rA[i]); else vAc[h][i] = voffA[i] + (unsigned)(h * hstep); }
    if constexpr (Sched::GATHER) { __builtin_amdgcn_sched_barrier(0);
#pragma unroll
        for (int h = 0; h < 2; ++h)
#pragma unroll
            for (int i = 0; i < 2; ++i) vAc[h][i] = (vAc[h][i] * (unsigned)K + (unsigned)cAo[i]) * 2u; }
#pragma unroll
    for (int h = 0; h < 2; ++h)
#pragma unroll
        for (int i = 0; i < 2; ++i) vAn[h][i] = vAc[h][i];
    if constexpr (Sched::GATHER) { asm volatile("s_waitcnt vmcnt(0)" ::: "memory"); }
    const char* cA = (const char*)g.A + (Sched::GATHER ? (size_t)0 : (size_t)cur.pm * tstep); const char* cB = (const char*)g.Bt + (size_t)cur.pn * tstep;
    S.a_ready(cur);
    PG8_STAGE(PG8_SB(0, 0), cB, voffB); PG8_STAGE(PG8_SA(0, 0), cA, vAc[0]); PG8_STAGE(PG8_SB(0, 1), cB + hstep, voffB); PG8_STAGE(PG8_SA(0, 1), cA, vAc[1]);
    if (wr == 1) PG8_BAR;
    PG8_WAIT_V(4); PG8_BAR;
    PG8_STAGE(PG8_SB(1, 0), cB + kstep, voffB); PG8_STAGE(PG8_SA(1, 0), cA + kstep, vAc[0]); PG8_STAGE(PG8_SB(1, 1), cB + hstep + kstep, voffB);
    PG8_WAIT_V(6); PG8_BAR;
    PG8_STAMP();
    for (;;) {
        const bool has_next = S.next(ui + 1, nxt);
        const char* nA = (has_next && !Sched::GATHER) ? (const char*)g.A + (size_t)nxt.pm * tstep : cA; const char* nB = has_next ? (const char*)g.Bt + (size_t)nxt.pn * tstep : cB;
        if constexpr (Sched::GATHER) { if (has_next) {
#pragma unroll
            for (int h = 0; h < 2; ++h)
#pragma unroll
                for (int i = 0; i < 2; ++i) vAn[h][i] = (unsigned)S.arow(nxt, h * HALF + rA[i]); } }
        for (int t = 0; t < nt; t += 2) {
            const bool last = (t == nt - 2);
            const char* a1 = cA + (size_t)(t + 1) * kstep;
            const char* a2 = last ? nA : cA + (size_t)(t + 2) * kstep; const char* b2 = last ? nB : cB + (size_t)(t + 2) * kstep;
            const char* a3 = a2 + kstep; const char* b3 = b2 + kstep;
            unsigned vs0[2], vs1[2];
#pragma unroll
            for (int i = 0; i < 2; ++i) { vs0[i] = vAc[0][i]; vs1[i] = vAc[1][i]; }
            if (last) { asm volatile("" ::: "memory");
#pragma unroll
                for (int i = 0; i < 2; ++i) { if constexpr (Sched::GATHER) { if (has_next) { vAn[0][i] = (vAn[0][i] * (unsigned)K + (unsigned)cAo[i]) * 2u; vAn[1][i] = (vAn[1][i] * (unsigned)K + (unsigned)cAo[i]) * 2u; } }
                    vs0[i] = vAn[0][i]; vs1[i] = vAn[1][i]; } }
            if (last && has_next) S.a_ready(nxt);
            if constexpr (Epi::MIDHOOK) { if (t == 8 || t == 16) E.mid(acc, cur, t >> 3, wr, wc, fr, fq); }
            PG8_LDB(B0, 0, 0); PG8_SCHED; PG8_LDA(At, 0, 0); PG8_STAGE(PG8_SA(1, 1), a1, vAc[1]);
            PG8_WAIT_L(8); PG8_BAR; PG8_WAIT_L(0); PG8_MMA(0, 0, At, B0); PG8_BAR; PG8_SCHED;
            PG8_LDB(B1, 0, 1); PG8_STAGE(PG8_SB(0, 0), b2, voffB);
            PG8_BAR; PG8_WAIT_L(0); PG8_MMA(0, 1, At, B1); PG8_BAR;
            PG8_LDA(At, 0, 1); PG8_STAGE(PG8_SA(0, 0), a2, vs0);
            PG8_BAR; PG8_WAIT_L(0); PG8_MMA(1, 0, At, B0); PG8_BAR; PG8_SCHED;
            PG8_STAGE(PG8_SB(0, 1), b2 + hstep, voffB);
            PG8_WAIT_V(6); PG8_BAR; PG8_MMA(1, 1, At, B1); PG8_BAR;
            PG8_LDB(B0, 1, 0); PG8_SCHED; PG8_LDA(At, 1, 0); PG8_STAGE(PG8_SA(0, 1), a2, vs1);
            PG8_WAIT_L(8); PG8_BAR; PG8_WAIT_L(0); PG8_MMA(0, 0, At, B0); PG8_BAR; PG8_SCHED;
            PG8_LDB(B1, 1, 1); PG8_STAGE(PG8_SB(1, 0), b3, voffB);
            PG8_BAR; PG8_WAIT_L(0); PG8_MMA(0, 1, At, B1); PG8_BAR;
            PG8_LDA(At, 1, 1); PG8_STAGE(PG8_SA(1, 0), a3, vs0);
            PG8_BAR; PG8_WAIT_L(0); PG8_MMA(1, 0, At, B0); PG8_BAR; PG8_SCHED;
            PG8_STAGE(PG8_SB(1, 1), b3 + hstep, voffB);
            PG8_WAIT_V(6); PG8_BAR; PG8_MMA(1, 1, At, B1); PG8_BAR;
        }
        PG8_STAMP();
        if constexpr (!Epi::AFTER_DRAIN) { E(acc, cur, wr, wc, fr, fq); S.done(cur); }
        PG8_STAMP();
        if (!has_next) break;
#pragma unroll
        for (int a = 0; a < 2; ++a)
#pragma unroll
            for (int b = 0; b < 2; ++b)
#pragma unroll
                for (int m = 0; m < 4; ++m)
#pragma unroll
                    for (int n = 0; n < 2; ++n) acc[a][b][m][n] = (f32x4){0.f, 0.f, 0.f, 0.f};
        cur = nxt; cA = nA; cB = nB; ++ui;
#pragma unroll
        for (int h = 0; h < 2; ++h)
#pragma unroll
            for (int i = 0; i < 2; ++i) vAc[h][i] = vAn[h][i];
    }
    PG8_WAIT_V(0);
    if (wr == 0) PG8_BAR;
    PG8_BAR;
    if constexpr (Epi::AFTER_DRAIN) { E.fused(acc, cur, wr, wc, fr, fq, lds, wid, lane); S.done(cur); }
    PG8_STAMP();
    if (STAMP && wid == 0) { stamps[lane] = lane < nts ? (((unsigned long long)(unsigned)ts_hi << 32) | (unsigned)ts_lo) : 0ull;
        if (lane == 62) stamps[62] = rt_entry; if (lane == 63) stamps[63] = (unsigned long long)wall_clock64(); }
#undef PG8_STAMP
#undef PG8_SA
#undef PG8_SB
#undef PG8_STAGE
#undef PG8_LDA
#undef PG8_LDB
#undef PG8_MMA
#undef PG8_WAIT_V
#undef PG8_WAIT_L
#undef PG8_BAR
#undef PG8_SCHED
}
}

#define GAS __attribute__((address_space(1)))
#define LAS __attribute__((address_space(3)))
typedef unsigned short bf16;
typedef float f32x4 __attribute__((ext_vector_type(4)));
typedef unsigned u32x4 __attribute__((ext_vector_type(4)));
typedef unsigned u32x2 __attribute__((ext_vector_type(2)));

constexpr int D = 1024, NLAT = 16384, NCTX = 256, T = NLAT + NCTX, DEPTH = 4;
constexpr int IN_W = 5904, PJ = 5888;
constexpr int U0 = 0, Z0 = 512, XB0 = 1024, Q0 = 2048, K0 = 2560, V0 = 2688, GT0 = 2816;
constexpr int NE = 16, ESLOTS = 2304, CAP_L = 2048, CAP_C = 32;
constexpr int NCH = 130;
constexpr float EPS = 1e-6f;
constexpr int NWAVES = 8, NTHR = 512;
constexpr int LDS_BYTES = 155648;
constexpr int MISC_OFF = LDS_BYTES - 1024 + 512;
constexpr int NPH_LAYER = 14, NPHASES = 1 + DEPTH * NPH_LAYER + 1;

constexpr size_t al256(size_t x) { return (x + 255) & ~(size_t)255; }
constexpr size_t WS_CTL = 0, CTL_BYTES = 1u << 20;
constexpr size_t WS_MOD = WS_CTL + CTL_BYTES;
constexpr size_t WS_XC = al256(WS_MOD + (size_t)DEPTH * 2 * 6144 * 4);
constexpr size_t WS_WIN = al256(WS_XC + (size_t)NCTX * D * 4);
constexpr size_t WS_WGLU = al256(WS_WIN + (size_t)PJ * D * 2);
constexpr size_t WS_WBR = al256(WS_WGLU + (size_t)512 * 512 * 2);
constexpr size_t WS_WOUT = al256(WS_WBR + (size_t)3 * 1024 * 512 * 2);
constexpr size_t WS_WUP = al256(WS_WOUT + (size_t)1024 * 1024 * 2);
constexpr size_t WS_WDN = al256(WS_WUP + (size_t)NE * 2048 * 1024 * 2);
constexpr size_t WS_H = al256(WS_WDN + (size_t)NE * 1024 * 1024 * 2);
constexpr size_t WS_PROJ = al256(WS_H + (size_t)T * D * 2);
constexpr size_t WS_XE = WS_PROJ;
constexpr size_t WS_HID = al256(WS_XE + (size_t)NE * ESLOTS * D * 2);
constexpr size_t WS_DT = al256(WS_PROJ + (size_t)T * PJ * 2);
constexpr size_t WS_CV = al256(WS_DT + (size_t)T * 16 * 4);
constexpr size_t WS_S5E = al256(WS_CV + (size_t)T * 1024 * 2);
constexpr size_t WS_S5H = al256(WS_S5E + (size_t)2 * 32 * NCH * 128 * 4);
constexpr size_t WS_YD = al256(WS_S5H + (size_t)2 * 32 * NCH * 128 * 4);
constexpr size_t WS_SA = al256(WS_YD + (size_t)2 * T * 512 * 4);
constexpr size_t WS_Y3 = al256(WS_SA + (size_t)T * 512 * 2);
constexpr size_t WS_PM = al256(WS_Y3 + (size_t)3 * T * 512 * 2);
constexpr size_t WS_MB = al256(WS_PM + (size_t)T * D * 4);
constexpr size_t WS_YE = WS_PM;
constexpr size_t WS_AFFT = al256(WS_MB + (size_t)T * D * 2);
constexpr size_t WS_IDX = al256(WS_AFFT + (size_t)NE * T * 4);
constexpr size_t WS_GSEL = al256(WS_IDX + (size_t)NE * ESLOTS * 4);
constexpr size_t WS_INV = al256(WS_GSEL + (size_t)NE * ESLOTS * 4);
constexpr size_t WS_DEC = al256(WS_INV + (size_t)T * 16 * 4);
constexpr size_t WS_S5BB = al256(WS_DEC + (size_t)2 * NCH * 8 * 4);
constexpr size_t WS_S5CC = al256(WS_S5BB + (size_t)2 * 32 * 128 * 32 * 2);
constexpr size_t WS_S5AB = al256(WS_S5CC + (size_t)2 * 32 * 16 * 128 * 2);
constexpr size_t WS_ROPE = al256(WS_S5AB + (size_t)2 * 32 * 64 * 2 * 4);
constexpr size_t WS_W2 = al256(WS_ROPE + (size_t)2 * 256 * 16 * 4);
constexpr size_t WBUF_BYTES = WS_H - WS_WIN;
constexpr size_t WS_END = al256(WS_W2 + WBUF_BYTES);
constexpr size_t WS_SST = WS_YD;
constexpr size_t WS_HIN = WS_PM;
constexpr size_t WS_YS = al256(WS_HIN + (size_t)2 * NCH * 8 * 8192 * 2);
static_assert(WS_YS + (size_t)T * 512 * 2 <= WS_AFFT, "HIN|YS overlay fits PM|MB");
static_assert(WS_HID + (size_t)NE * ESLOTS * D * 2 <= WS_DT, "XE|HID overlay fits PROJ");
static_assert(WS_YE + (size_t)NE * ESLOTS * D * 2 <= WS_AFFT, "YE overlay fits PM|MB");
static_assert(WS_END < (size_t)1000 * 1024 * 1024, "workspace");
constexpr int CW_BAR = 4096;

__device__ __forceinline__ float bf2f(unsigned b) { return __uint_as_float(b << 16); }
__device__ __forceinline__ float bflo(unsigned w) { return __uint_as_float(w << 16); }
__device__ __forceinline__ float bfhi(unsigned w) { return __uint_as_float(w & 0xffff0000u); }
typedef float f32x2_c __attribute__((ext_vector_type(2)));
typedef __bf16 bf16x2_c __attribute__((ext_vector_type(2)));
__device__ __forceinline__ unsigned pk2(float lo, float hi) { f32x2_c v; v[0] = lo; v[1] = hi; return __builtin_bit_cast(unsigned, __builtin_convertvector(v, bf16x2_c)); }
__device__ __forceinline__ unsigned f2bf(float f) { return pk2(f, 0.f) & 0xffffu; }
__device__ __forceinline__ float wsum(float v) {
#pragma unroll
    for (int o = 1; o < 64; o <<= 1) v += __shfl_xor(v, o);
    return v;
}
__device__ __forceinline__ float wmaxf(float v) {
#pragma unroll
    for (int o = 1; o < 64; o <<= 1) v = fmaxf(v, __shfl_xor(v, o));
    return v;
}
__device__ __forceinline__ float silu_f(float x) { return x * __builtin_amdgcn_rcpf(1.f + __expf(-x)); }
__device__ __forceinline__ float sigmoid_f(float x) { return __builtin_amdgcn_rcpf(1.f + __expf(-x)); }
__device__ __forceinline__ float softplus_f(float x) { return fmaxf(x, 0.f) + __logf(1.f + __expf(-fabsf(x))); }
__device__ __forceinline__ float gelu_tanh_f(float x) { const float u = 0.7978845608028654f * (x + 0.044715f * x * x * x); return x * __builtin_amdgcn_rcpf(1.f + __expf(-2.f * u)); }
#define LDS_FENCE() asm volatile("s_waitcnt lgkmcnt(0)" ::: "memory")
__device__ __forceinline__ int scan_row(int d, int s) { return d == 0 ? s : (s < NCTX ? (NCTX - 1 - s) : (T + NCTX - 1 - s)); }

namespace pg8 {
struct EpiStoreBf16 {
    static constexpr bool PERM = true, AFTER_DRAIN = false, MIDHOOK = false;
    bf16_t GAS* O; int ldc; int sig_tile; const float GAS* rope;
    __device__ __forceinline__ void operator()(const f32x4 (&acc)[2][2][4][2], const Unit& u, int wr, int wc, int fr, int fq) const {
        const int row0 = u.pm * BM + wr * 64 + fr, col0 = u.pn * BM + wc * 32 + 8 * fq; const bool sg = u.pn >= sig_tile;
        const bool rq = rope != nullptr && u.pm >= 1 && (u.pn == Q0 / 256 || u.pn == Q0 / 256 + 1), rk = rope != nullptr && u.pm >= 1 && u.pn == K0 / 256;
#pragma unroll
        for (int ai = 0; ai < 2; ++ai)
#pragma unroll
            for (int m = 0; m < 4; ++m) { const int row = row0 + ai * HALF + m * 16; bf16_t GAS* rowp = O + (size_t)row * ldc + col0;
#pragma unroll
                for (int bj = 0; bj < 2; ++bj) { f32x4 v0 = acc[ai][bj][m][0], v1 = acc[ai][bj][m][1];
                    if (sg) {
#pragma unroll
                        for (int q = 0; q < 4; ++q) { v0[q] = __builtin_amdgcn_rcpf(1.f + __expf(-v0[q])); v1[q] = __builtin_amdgcn_rcpf(1.f + __expf(-v1[q])); } }
                    if (rq || (rk && bj == 0)) {
                        const int t = row - NCTX, idx = (wc & 1) ? (t & 63) : (t >> 6);
                        const float GAS* cp = rope + idx * 16 + 8 * (fq & 1);
                        const f32x4 c0 = *(const f32x4 GAS*)cp, c1 = *(const f32x4 GAS*)(cp + 4), s0 = *(const f32x4 GAS*)(cp + 4096), s1 = *(const f32x4 GAS*)(cp + 4100);
                        const float sgn = (fq & 2) ? 1.f : -1.f;
#pragma unroll
                        for (int q = 0; q < 4; ++q) { const float p0 = __shfl_xor(v0[q], 32), p1 = __shfl_xor(v1[q], 32);
                            v0[q] = v0[q] * c0[q] + sgn * p0 * s0[q]; v1[q] = v1[q] * c1[q] + sgn * p1 * s1[q]; } }
                    u32x4 w; w.x = cvt_pk_bf16(v0[0], v0[1]); w.y = cvt_pk_bf16(v0[2], v0[3]); w.z = cvt_pk_bf16(v1[0], v1[1]); w.w = cvt_pk_bf16(v1[2], v1[3]);
                    if (sg) __builtin_nontemporal_store(w, (u32x4 GAS*)(rowp + bj * HALF));
                    else *(u32x4 GAS*)(rowp + bj * HALF) = w; } }
    }
};
struct EpiGlu {
    static constexpr bool PERM = true, AFTER_DRAIN = false, MIDHOOK = false;
    const bf16_t GAS* A; const float GAS* bias; bf16_t GAS* O;
    __device__ __forceinline__ void operator()(const f32x4 (&acc)[2][2][4][2], const Unit& u, int wr, int wc, int fr, int fq) const {
        const int row0 = u.pm * BM + wr * 64 + fr, col0 = u.pn * BM + wc * 32 + 8 * fq;
        f32x4 bq[2][2];
#pragma unroll
        for (int bj = 0; bj < 2; ++bj) { bq[bj][0] = *(const f32x4 GAS*)(bias + col0 + bj * HALF); bq[bj][1] = *(const f32x4 GAS*)(bias + col0 + bj * HALF + 4); }
#pragma unroll
        for (int ai = 0; ai < 2; ++ai) {
            u32x4 aa[4][2];
#pragma unroll
            for (int m = 0; m < 4; ++m)
#pragma unroll
                for (int bj = 0; bj < 2; ++bj) aa[m][bj] = *(const u32x4 GAS*)(A + (size_t)(row0 + ai * HALF + m * 16) * 512 + col0 + bj * HALF);
#pragma unroll
            for (int m = 0; m < 4; ++m) {
#pragma unroll
                for (int bj = 0; bj < 2; ++bj) { const f32x4 v0 = acc[ai][bj][m][0], v1 = acc[ai][bj][m][1];
                    const u32x4 a = aa[m][bj];
                    const f32x4 b0 = bq[bj][0], b1 = bq[bj][1];
                    float o[8];
                    o[0] = bflo(a.x) * sigmoid_f(v0[0] + b0[0]); o[1] = bfhi(a.x) * sigmoid_f(v0[1] + b0[1]);
                    o[2] = bflo(a.y) * sigmoid_f(v0[2] + b0[2]); o[3] = bfhi(a.y) * sigmoid_f(v0[3] + b0[3]);
                    o[4] = bflo(a.z) * sigmoid_f(v1[0] + b1[0]); o[5] = bfhi(a.z) * sigmoid_f(v1[1] + b1[1]);
                    o[6] = bflo(a.w) * sigmoid_f(v1[2] + b1[2]); o[7] = bfhi(a.w) * sigmoid_f(v1[3] + b1[3]);
                    u32x4 w; w.x = cvt_pk_bf16(o[0], o[1]); w.y = cvt_pk_bf16(o[2], o[3]); w.z = cvt_pk_bf16(o[4], o[5]); w.w = cvt_pk_bf16(o[6], o[7]);
                    *(u32x4 GAS*)(O + (size_t)(row0 + ai * HALF + m * 16) * 1536 + col0 + bj * HALF) = w; } } }
    }
};
struct RowOffOrder {
    static constexpr bool GATHER = false;
    StaticOrder b; int off;
    __device__ __forceinline__ void init(int M, int N, int G, int c, int off_) { b.init(M, N, G, c); off = off_; }
    __device__ __forceinline__ bool next(int i, Unit& u) const { if (!b.next(i, u)) return false; u.pm += off; return true; }
    __device__ __forceinline__ void a_ready(const Unit&) const {}
    __device__ __forceinline__ void done(const Unit&) const {}
};
struct EpiMerge {
    static constexpr bool PERM = true, AFTER_DRAIN = false, MIDHOOK = true;
    const bf16_t GAS* proj; bf16_t GAS* MB;
    __device__ __forceinline__ void mid(f32x4 (&acc)[2][2][4][2], const Unit& u, int seg, int wr, int wc, int fr, int fq) const {
        const unsigned base = (unsigned)((u.pm * BM + wr * 64 + fr) * PJ + GT0 + (seg - 1) * 1024 + u.pn * BM + wc * 32 + 8 * fq) * 2u;
        const char GAS* pb = (const char GAS*)proj;
        u32x4 ga[2][2], gb[2][2];
#define MG_LOAD(s_, k_) { _Pragma("unroll") for (int bj = 0; bj < 2; ++bj) { const unsigned o = base + (unsigned)(((((k_) >> 2) * HALF + ((k_) & 3) * 16) * PJ + bj * HALF) * 2); \
            ga[s_][bj] = *(const u32x4 GAS*)(pb + o); gb[s_][bj] = *(const u32x4 GAS*)(pb + o + 2048u); } }
        MG_LOAD(0, 0)
#pragma unroll
        for (int k = 0; k < 8; ++k) { const int ai = k >> 2, m = k & 3, sl = k & 1;
            if (k + 1 < 8) { if (sl == 0) MG_LOAD(1, k + 1) else MG_LOAD(0, k + 1) }
            __builtin_amdgcn_sched_barrier(0);
#pragma unroll
            for (int bj = 0; bj < 2; ++bj) { const u32x4 a = ga[sl][bj], b = gb[sl][bj];
                f32x4& v0 = acc[ai][bj][m][0]; f32x4& v1 = acc[ai][bj][m][1];
                v0[0] *= bflo(a.x) * __builtin_amdgcn_rcpf(bflo(b.x)); v0[1] *= bfhi(a.x) * __builtin_amdgcn_rcpf(bfhi(b.x));
                v0[2] *= bflo(a.y) * __builtin_amdgcn_rcpf(bflo(b.y)); v0[3] *= bfhi(a.y) * __builtin_amdgcn_rcpf(bfhi(b.y));
                v1[0] *= bflo(a.z) * __builtin_amdgcn_rcpf(bflo(b.z)); v1[1] *= bfhi(a.z) * __builtin_amdgcn_rcpf(bfhi(b.z));
                v1[2] *= bflo(a.w) * __builtin_amdgcn_rcpf(bflo(b.w)); v1[3] *= bfhi(a.w) * __builtin_amdgcn_rcpf(bfhi(b.w)); }
            __builtin_amdgcn_sched_barrier(0);
        }
#undef MG_LOAD
    }
    __device__ __forceinline__ void operator()(const f32x4 (&acc)[2][2][4][2], const Unit& u, int wr, int wc, int fr, int fq) const {
        const int row0 = u.pm * BM + wr * 64 + fr, col0 = u.pn * BM + wc * 32 + 8 * fq;
#pragma unroll
        for (int ai = 0; ai < 2; ++ai) {
            u32x4 gg[4][2];
#pragma unroll
            for (int m = 0; m < 4; ++m)
#pragma unroll
                for (int bj = 0; bj < 2; ++bj) gg[m][bj] = *(const u32x4 GAS*)(proj + (size_t)(row0 + ai * HALF + m * 16) * PJ + GT0 + 2048 + col0 + bj * HALF);
#pragma unroll
            for (int m = 0; m < 4; ++m) { const int row = row0 + ai * HALF + m * 16;
#pragma unroll
                for (int bj = 0; bj < 2; ++bj) { const f32x4 v0 = acc[ai][bj][m][0], v1 = acc[ai][bj][m][1]; const int col = col0 + bj * HALF; const u32x4 g = gg[m][bj];
                    u32x4 w; w.x = cvt_pk_bf16(bflo(g.x) * v0[0], bfhi(g.x) * v0[1]); w.y = cvt_pk_bf16(bflo(g.y) * v0[2], bfhi(g.y) * v0[3]);
                    w.z = cvt_pk_bf16(bflo(g.z) * v1[0], bfhi(g.z) * v1[1]); w.w = cvt_pk_bf16(bflo(g.w) * v1[2], bfhi(g.w) * v1[3]);
                    *(u32x4 GAS*)(MB + (size_t)row * 1024 + col) = w; } } }
    }
};
struct EpiResid {
    static constexpr bool PERM = false, AFTER_DRAIN = false, MIDHOOK = false;
    float GAS* XL; float GAS* XC; const float GAS* g_lat; const float GAS* g_ctx;
    __device__ __forceinline__ void operator()(const f32x4 (&acc)[2][2][4][2], const Unit& u, int wr, int wc, int fr, int fq) const {
        const bool isc = (u.pm == 0);
        float GAS* base = isc ? XC : (XL - (size_t)NCTX * D); const float GAS* gv = isc ? g_ctx : g_lat;
        const int row0 = u.pm * BM + wr * 64 + fr, col0 = u.pn * BM + wc * 32 + 4 * fq;
        f32x4 gq[2][2];
#pragma unroll
        for (int bj = 0; bj < 2; ++bj)
#pragma unroll
            for (int n = 0; n < 2; ++n) gq[bj][n] = *(const f32x4 GAS*)(gv + col0 + bj * HALF + n * 16);
#pragma unroll
        for (int ai = 0; ai < 2; ++ai)
#pragma unroll
            for (int mp = 0; mp < 2; ++mp) {
                f32x4 xs[2][2][2];
#pragma unroll
                for (int mm = 0; mm < 2; ++mm) { const float GAS* rowp = base + (size_t)(row0 + ai * HALF + (2 * mp + mm) * 16) * D + col0;
#pragma unroll
                    for (int bj = 0; bj < 2; ++bj)
#pragma unroll
                        for (int n = 0; n < 2; ++n) xs[mm][bj][n] = *(const f32x4 GAS*)(rowp + bj * HALF + n * 16); }
#pragma unroll
                for (int mm = 0; mm < 2; ++mm) { float GAS* rowp = base + (size_t)(row0 + ai * HALF + (2 * mp + mm) * 16) * D + col0;
#pragma unroll
                    for (int bj = 0; bj < 2; ++bj)
#pragma unroll
                        for (int n = 0; n < 2; ++n) { f32x4 x = xs[mm][bj][n]; x += gq[bj][n] * acc[ai][bj][2 * mp + mm][n]; *(f32x4 GAS*)(rowp + bj * HALF + n * 16) = x; } }
            }
    }
};
template <bool GATHER_> struct ExpertOrderT {
    static constexpr bool GATHER = GATHER_;
    int G, c, nnt, nmt;
    const int GAS* idx;
    __device__ __forceinline__ bool next(int i, Unit& u) const { const int cc = (G & 7) ? c : (c & 7) * (G >> 3) + (c >> 3);
        const int L = i * G + cc; if (L >= NE * nmt * nnt) return false; const int e = L / (nmt * nnt), rem = L % (nmt * nnt); u.pm = e * 9 + rem % nmt; u.pn = e * nnt + rem / nmt; return true; }
    __device__ __forceinline__ int arow(const Unit& u, int r) const { return idx[u.pm * 256 + r]; }
    __device__ __forceinline__ void a_ready(const Unit&) const {}
    __device__ __forceinline__ void done(const Unit&) const {}
};
struct EpiSwiGlu {
    static constexpr bool PERM = true, AFTER_DRAIN = false, MIDHOOK = false;
    bf16_t GAS* HID;
    __device__ __forceinline__ void operator()(const f32x4 (&acc)[2][2][4][2], const Unit& u, int wr, int wc, int fr, int fq) const {
        const int row0 = u.pm * BM + wr * 64 + fr, col0 = (u.pn & 7) * 128 + wc * 32 + 8 * fq;
#pragma unroll
        for (int ai = 0; ai < 2; ++ai)
#pragma unroll
            for (int m = 0; m < 4; ++m) { const f32x4 g0 = acc[ai][0][m][0], g1 = acc[ai][0][m][1], u0 = acc[ai][1][m][0], u1 = acc[ai][1][m][1];
                u32x4 w;
                w.x = cvt_pk_bf16(silu_f(g0[0]) * u0[0], silu_f(g0[1]) * u0[1]); w.y = cvt_pk_bf16(silu_f(g0[2]) * u0[2], silu_f(g0[3]) * u0[3]);
                w.z = cvt_pk_bf16(silu_f(g1[0]) * u1[0], silu_f(g1[1]) * u1[1]); w.w = cvt_pk_bf16(silu_f(g1[2]) * u1[2], silu_f(g1[3]) * u1[3]);
                *(u32x4 GAS*)(HID + (size_t)(row0 + ai * HALF + m * 16) * 1024 + col0) = w; }
    }
};
struct EpiDown {
    static constexpr bool PERM = true, AFTER_DRAIN = false, MIDHOOK = false;
    bf16_t GAS* YE; const float GAS* gsel;
    __device__ __forceinline__ void operator()(const f32x4 (&acc)[2][2][4][2], const Unit& u, int wr, int wc, int fr, int fq) const {
        const int row0 = u.pm * BM + wr * 64 + fr, col0 = (u.pn & 3) * BM + wc * 32 + 8 * fq;
        float gsv[2][4];
#pragma unroll
        for (int ai = 0; ai < 2; ++ai)
#pragma unroll
            for (int m = 0; m < 4; ++m) gsv[ai][m] = gsel[row0 + ai * HALF + m * 16];
#pragma unroll
        for (int ai = 0; ai < 2; ++ai)
#pragma unroll
            for (int m = 0; m < 4; ++m) { const int row = row0 + ai * HALF + m * 16; const float gs = gsv[ai][m];
#pragma unroll
                for (int bj = 0; bj < 2; ++bj) { const f32x4 v0 = acc[ai][bj][m][0] * gs, v1 = acc[ai][bj][m][1] * gs;
                    u32x4 w; w.x = cvt_pk_bf16(v0[0], v0[1]); w.y = cvt_pk_bf16(v0[2], v0[3]); w.z = cvt_pk_bf16(v1[0], v1[1]); w.w = cvt_pk_bf16(v1[2], v1[3]);
                    *(u32x4 GAS*)(YE + (size_t)row * 1024 + col0 + bj * HALF) = w; } }
    }
};
}
#define XB_TMO      128
#define XB_XCNT(j)  (256  + 64 * (j))
#define XB_XSUB(j)  (1280 + 64 * (j))
#define XB_XGEN(j)  (2304 + 64 * (j))
#define XB_TOP      3328
#define XB_TOPGEN   3392
#define XCD_BAR_WORDS 3456
#define XB_SPIN_CAP (1u << 18)

__device__ __forceinline__ unsigned xb_ld(unsigned GAS* p)              { return __hip_atomic_load(p, __ATOMIC_RELAXED, __HIP_MEMORY_SCOPE_AGENT); }
__device__ __forceinline__ unsigned xb_add(unsigned GAS* p, unsigned v) { return __hip_atomic_fetch_add(p, v, __ATOMIC_RELAXED, __HIP_MEMORY_SCOPE_AGENT); }
__device__ __forceinline__ unsigned xb_xcc_id() { return (unsigned)__builtin_amdgcn_s_getreg((3 << 11) | 20) & 0xFu; }
#define XB_SPIN(cond, bar) do { unsigned _sp = 0; while (cond) { __builtin_amdgcn_s_sleep(1); \
    if ((++_sp & 255u) == 0u) { if (xb_ld(&(bar)[XB_TMO])) break; if (_sp > XB_SPIN_CAP) { (void)xb_add(&(bar)[XB_TMO], 1u); break; } } } } while (0)

struct XcdBarrier {
    unsigned GAS* bar; unsigned x;
    volatile LAS unsigned* st;
};

__device__ __forceinline__ XcdBarrier xcd_barrier_post(unsigned GAS* bar, volatile LAS unsigned* st) {
    XcdBarrier b; b.bar = bar; b.x = xb_xcc_id(); b.st = st;
    if (threadIdx.x == 0) (void)xb_add(&bar[XB_XCNT(b.x)], 1u);
    return b;
}
__device__ __forceinline__ void xcd_barrier_complete(unsigned GAS* bar, unsigned x, unsigned& nloc, unsigned& nx) {
    const unsigned G = gridDim.x * gridDim.y * gridDim.z;
    unsigned sum, cnt, mine, sp = 0u;
    for (;;) {
        sum = 0u; cnt = 0u; mine = 0u;
#pragma unroll
        for (unsigned j = 0; j < 16; ++j) { const unsigned c = xb_ld(&bar[XB_XCNT(j)]); sum += c; cnt += (c > 0u) ? 1u : 0u; mine = (j == x) ? c : mine; }
        if (sum == G) break;
        __builtin_amdgcn_s_sleep(1);
        if ((++sp & 255u) == 0u) { if (xb_ld(&bar[XB_TMO])) break; if (sp > XB_SPIN_CAP) { (void)xb_add(&bar[XB_TMO], 1u); break; } }
    }
    nloc = mine > 0u ? mine : 1u; nx = cnt > 0u ? cnt : 1u;
}

__device__ __forceinline__ void xcd_barrier(const XcdBarrier& b, int wave_s) {
    asm volatile("s_waitcnt vmcnt(0)" ::: "memory");
    __syncthreads();
    if (pg8::tid_of(wave_s) == 0) {
        unsigned long long bar_u = (unsigned long long)b.bar; unsigned bx_ = b.x; asm volatile("" : "+s"(bar_u), "+s"(bx_));
        unsigned GAS* bar = (unsigned GAS*)bar_u;
        __builtin_amdgcn_s_waitcnt(0);
        unsigned nloc = b.st[0], nx = b.st[1];
        if (nloc == 0u) { xcd_barrier_complete(bar, bx_, nloc, nx); b.st[0] = nloc; b.st[1] = nx; }
        const unsigned old = xb_add(&bar[XB_XSUB(bx_)], 1u);
        const unsigned gen = old / nloc;
        if (old + 1u == (gen + 1u) * nloc) {
            __builtin_amdgcn_fence(__ATOMIC_RELEASE, "agent");
            asm volatile("s_waitcnt vmcnt(0)" ::: "memory");
            const unsigned og = xb_add(&bar[XB_TOP], 1u);
            const unsigned tg = og / nx;
            if (og + 1u == (tg + 1u) * nx) xb_add(&bar[XB_TOPGEN], 1u);
            else XB_SPIN(xb_ld(&bar[XB_TOPGEN]) == tg, bar);
            __builtin_amdgcn_fence(__ATOMIC_ACQUIRE, "agent");
            xb_add(&bar[XB_XGEN(bx_)], 1u);
            asm volatile("s_waitcnt vmcnt(0)" ::: "memory");
        } else {
            XB_SPIN(xb_ld(&bar[XB_XGEN(bx_)]) == gen, bar);
            __builtin_amdgcn_fence(__ATOMIC_ACQUIRE, "agent");
            asm volatile("s_waitcnt vmcnt(0)" ::: "memory");
        }
    }
    __syncthreads();
}


struct P {
    const float GAS*x, *c, *ctx, *c_ctx, *w_mod, *b_mod, *norm1_g, *norm2_g, *w_in, *lam_re, *lam_im, *log_dt, *b_re, *b_im, *c_re, *c_im, *s5_d, *w_glu, *b_glu,
        *conv_w, *conv_b, *a_log, *dt_bias, *ssd_d, *ssd_norm_g, *sink, *w_branch, *w_out, *w_router, *w_eg, *w_eu, *w_ed, *final_g;
    float GAS* XL;
    float GAS*MOD, *XC, *DT, *S5E, *S5H, *YD, *PM, *AFFT, *GSEL;
    bf16 GAS*WIN, *WGLU, *WBR, *WOUT, *WUP, *WDN, *H, *PROJ, *XE, *HID, *CV, *SA, *Y3, *MB, *YE;
    int GAS*IDX, *INV;
    int tid, lane, wave, bid, G, vcu;
};


constexpr int PTAB_OFF = LDS_BYTES - 1024;
__device__ __forceinline__ unsigned long long ld_tab(volatile LAS unsigned* t, int k) {
    const unsigned lo = __builtin_amdgcn_readfirstlane(t[2 * k]), hi = __builtin_amdgcn_readfirstlane(t[2 * k + 1]);
    return ((unsigned long long)hi << 32) | lo;
}
__device__ __forceinline__ void build_P(P& p, LAS unsigned char* lds, int wset, int wave_s) {
    int tid_l = pg8::tid_of(wave_s), bid_l = blockIdx.x, g_l = gridDim.x;
    asm volatile("" : "+v"(tid_l), "+s"(bid_l), "+s"(g_l));
    p.tid = tid_l; p.lane = p.tid & 63; p.wave = __builtin_amdgcn_readfirstlane(p.tid >> 6); p.bid = bid_l; p.G = g_l; p.vcu = (g_l & 7) ? bid_l : (bid_l & 7) * (g_l >> 3) + (bid_l >> 3);
    unsigned tbase = (unsigned)(size_t)(lds + PTAB_OFF); asm volatile("" : "+s"(tbase));
    volatile LAS unsigned* tb = (volatile LAS unsigned*)(size_t)tbase;
#define INP(k) ((const float GAS*)ld_tab(tb, k))
    p.x = INP(0); p.c = INP(1); p.ctx = INP(2); p.c_ctx = INP(3); p.w_mod = INP(4); p.b_mod = INP(5); p.norm1_g = INP(6); p.norm2_g = INP(7);
    p.w_in = INP(8); p.lam_re = INP(9); p.lam_im = INP(10); p.log_dt = INP(11); p.b_re = INP(12); p.b_im = INP(13); p.c_re = INP(14); p.c_im = INP(15);
    p.s5_d = INP(16); p.w_glu = INP(17); p.b_glu = INP(18); p.conv_w = INP(19); p.conv_b = INP(20); p.a_log = INP(21); p.dt_bias = INP(22); p.ssd_d = INP(23);
    p.ssd_norm_g = INP(24); p.sink = INP(25); p.w_branch = INP(26); p.w_out = INP(27); p.w_router = INP(28); p.w_eg = INP(29); p.w_eu = INP(30); p.w_ed = INP(31);
    p.final_g = INP(32);
#undef INP
    p.XL = (float GAS*)ld_tab(tb, 33);
    unsigned char GAS* ws = (unsigned char GAS*)ld_tab(tb, 34);
    p.MOD = (float GAS*)(ws + WS_MOD); p.XC = (float GAS*)(ws + WS_XC); p.DT = (float GAS*)(ws + WS_DT); p.S5E = (float GAS*)(ws + WS_S5E); p.S5H = (float GAS*)(ws + WS_S5H); p.YD = (float GAS*)(ws + WS_YD);
    p.PM = (float GAS*)(ws + WS_PM); p.AFFT = (float GAS*)(ws + WS_AFFT); p.GSEL = (float GAS*)(ws + WS_GSEL);
    { unsigned char GAS* wb = ws + (wset ? (WS_W2 - WS_WIN) : 0);
      p.WIN = (bf16 GAS*)(wb + WS_WIN); p.WGLU = (bf16 GAS*)(wb + WS_WGLU); p.WBR = (bf16 GAS*)(wb + WS_WBR); p.WOUT = (bf16 GAS*)(wb + WS_WOUT); p.WUP = (bf16 GAS*)(wb + WS_WUP); p.WDN = (bf16 GAS*)(wb + WS_WDN); }
    p.H = (bf16 GAS*)(ws + WS_H); p.PROJ = (bf16 GAS*)(ws + WS_PROJ); p.XE = (bf16 GAS*)(ws + WS_XE); p.HID = (bf16 GAS*)(ws + WS_HID); p.CV = (bf16 GAS*)(ws + WS_CV); p.SA = (bf16 GAS*)(ws + WS_SA);
    p.Y3 = (bf16 GAS*)(ws + WS_Y3); p.MB = (bf16 GAS*)(ws + WS_MB); p.YE = (bf16 GAS*)(ws + WS_YE);
    p.IDX = (int GAS*)(ws + WS_IDX); p.INV = (int GAS*)(ws + WS_INV);
}
__device__ __forceinline__ void phase_mod(const P& p, LAS unsigned char* lds, float GAS* ropet) {
    for (int i = p.bid * NTHR + p.tid; i < 256 * 16; i += p.G * NTHR) { const float inv = exp2f(-(float)(i & 15) * 0.83048202372184058696f);
        float sn, cs; sincosf((float)(i >> 4) * inv, &sn, &cs); ropet[i] = cs; ropet[4096 + i] = sn; }
    LAS float* sc = (LAS float*)lds;
    LAS float* part = sc + 2048;
    for (int i = p.tid; i < 1024; i += NTHR) { sc[i] = silu_f(p.c[i]); sc[1024 + i] = silu_f(p.c_ctx[i]); }
    __syncthreads();
    for (int it = p.bid; it < DEPTH * 48; it += p.G) {
        const int l = it / 48, cb = it % 48, c0 = cb * 128 + 2 * p.lane;
        const float GAS* W = p.w_mod + (size_t)l * 1024 * 6144 + c0;
        float a00 = 0.f, a01 = 0.f, a10 = 0.f, a11 = 0.f;
        const int kb = p.wave * 128;
#pragma unroll 8
        for (int k = kb; k < kb + 128; ++k) { const f32x2_c w = __builtin_nontemporal_load((const f32x2_c GAS*)(W + (size_t)k * 6144)); const float s0 = sc[k], s1 = sc[1024 + k];
            a00 += s0 * w.x; a01 += s0 * w.y; a10 += s1 * w.x; a11 += s1 * w.y; }
        part[(p.wave * 2 + 0) * 128 + 2 * p.lane] = a00; part[(p.wave * 2 + 0) * 128 + 2 * p.lane + 1] = a01;
        part[(p.wave * 2 + 1) * 128 + 2 * p.lane] = a10; part[(p.wave * 2 + 1) * 128 + 2 * p.lane + 1] = a11;
        __syncthreads();
        if (p.tid < 256) { const int s = p.tid >> 7, col = p.tid & 127; float r = p.b_mod[l * 6144 + cb * 128 + col];
#pragma unroll
            for (int w = 0; w < 8; ++w) r += part[(w * 2 + s) * 128 + col];
            p.MOD[(size_t)(l * 2 + s) * 6144 + cb * 128 + col] = r; }
        __syncthreads();
    }
}

__device__ __forceinline__ void tr_item(const float GAS* src, int ldw, int K, bf16 GAS* dst, int kb, LAS float* scr, int lane) {
    const int k0 = 64 * kb, kr = lane >> 4, nq = lane & 15;
    f32x4 v[16];
#pragma unroll
    for (int i = 0; i < 16; ++i) v[i] = __builtin_nontemporal_load((const f32x4 GAS*)(src + (size_t)(k0 + 4 * i + kr) * ldw + 4 * nq));
#pragma unroll
    for (int i = 0; i < 16; ++i) { const int k = 4 * i + kr, c = (k >> 3) & 7; *(LAS f32x4*)(scr + k * 64 + 4 * (nq ^ c)) = v[i]; }
    LDS_FENCE();
    const int c = lane & 7;
#pragma unroll
    for (int j = 0; j < 8; ++j) { const int n = (lane >> 3) + 8 * j; const LAS float* s = scr + (8 * c) * 64 + (n ^ (c << 2));
        u32x4 o; o.x = pk2(s[0 * 64], s[1 * 64]); o.y = pk2(s[2 * 64], s[3 * 64]); o.z = pk2(s[4 * 64], s[5 * 64]); o.w = pk2(s[6 * 64], s[7 * 64]);
        *(u32x4 GAS*)(dst + (size_t)n * K + k0 + 8 * c) = o; }
    LDS_FENCE();
}
constexpr int CVT_NE = 32 * 16 + 60 * 16 + 8 * 8 + 3 * 16 * 8 + 16 * 16, CVT_ALL = CVT_NE + 3 * 16 * 16 * 16;
__device__ __forceinline__ void convert_weights(const P& p, int l, int lx, LAS unsigned char* lds, int gw, int NGW, int it_lo, int it_hi) {
    LAS float* scr = (LAS float*)(lds + p.wave * 16384);
    constexpr int I_A = 32 * 16, I_B = 60 * 16, I_GLU = 8 * 8, I_BR = 3 * 16 * 8, I_OUT = 16 * 16, I_E = 16 * 16 * 16;
    constexpr int NIT = I_A + I_B + I_GLU + I_BR + I_OUT + 3 * I_E;
    const float GAS* win = p.w_in + (size_t)l * 1024 * IN_W;
    for (int it = it_lo + gw; it < it_hi; it += NGW) {
        int r = it;
        if (r < I_A) { const int nb = r >> 4, kb = r & 15; tr_item(win + 64 * nb, IN_W, 1024, p.WIN + (size_t)(64 * nb) * 1024, kb, scr, p.lane); continue; } r -= I_A;
        if (r < I_B) { const int nb = r >> 4, kb = r & 15; tr_item(win + 2064 + 64 * nb, IN_W, 1024, p.WIN + (size_t)(2048 + 64 * nb) * 1024, kb, scr, p.lane); continue; } r -= I_B;
        if (r < I_GLU) { const int nb = r >> 3, kb = r & 7; tr_item(p.w_glu + (size_t)l * 512 * 512 + 64 * nb, 512, 512, p.WGLU + (size_t)(64 * nb) * 512, kb, scr, p.lane); continue; } r -= I_GLU;
        if (r < I_BR) { const int kk = r >> 7, nb = (r >> 3) & 15, kb = r & 7;
            tr_item(p.w_branch + ((size_t)l * 3 + kk) * 512 * 1024 + 64 * nb, 1024, 1536, p.WBR + (size_t)(64 * nb) * 1536 + kk * 512, kb, scr, p.lane); continue; } r -= I_BR;
        if (r < I_OUT) { const int nb = r >> 4, kb = r & 15; tr_item(p.w_out + (size_t)l * 1024 * 1024 + 64 * nb, 1024, 1024, p.WOUT + (size_t)(64 * nb) * 1024, kb, scr, p.lane); continue; } r -= I_OUT;
        const int which = r / I_E; r -= which * I_E;
        const int e = r >> 8, nb = (r >> 4) & 15, kb = r & 15;
        const size_t eo = ((size_t)lx * NE + e) * 1024 * 1024;
        if (which == 0) tr_item(p.w_eg + eo + 64 * nb, 1024, 1024, p.WUP + (size_t)(e * 2048 + 256 * (nb >> 1) + 64 * (nb & 1)) * 1024, kb, scr, p.lane);
        else if (which == 1) tr_item(p.w_eu + eo + 64 * nb, 1024, 1024, p.WUP + (size_t)(e * 2048 + 256 * (nb >> 1) + 128 + 64 * (nb & 1)) * 1024, kb, scr, p.lane);
        else tr_item(p.w_ed + eo + 64 * nb, 1024, 1024, p.WDN + (size_t)(e * 1024 + 64 * nb) * 1024, kb, scr, p.lane);
    }
}

__device__ __forceinline__ float reduce16(float (&a)[16], int lane) {
    float b[8], c[4], d[2];
#pragma unroll
    for (int j = 0; j < 8; ++j) { const bool hi = lane & 32; const float send = hi ? a[j] : a[j + 8], keep = hi ? a[j + 8] : a[j]; b[j] = keep + __shfl_xor(send, 32); }
#pragma unroll
    for (int j = 0; j < 4; ++j) { const bool hi = lane & 16; const float send = hi ? b[j] : b[j + 4], keep = hi ? b[j + 4] : b[j]; c[j] = keep + __shfl_xor(send, 16); }
#pragma unroll
    for (int j = 0; j < 2; ++j) { const bool hi = lane & 8; const float send = hi ? c[j] : c[j + 2], keep = hi ? c[j + 2] : c[j]; d[j] = keep + __shfl_xor(send, 8); }
    const bool hi = lane & 4; const float send = hi ? d[0] : d[1], keep = hi ? d[1] : d[0];
    float r = keep + __shfl_xor(send, 4);
    r += __shfl_xor(r, 2); r += __shfl_xor(r, 1);
    return r;
}
template <int MODE> __device__ __forceinline__ void row_pass(const P& p, int l, LAS unsigned char* lds, bool with_ctx = true, bool dry = false) {
    LAS float* W16 = (LAS float*)lds;
    if (MODE != 2) {
        const float GAS* src = (MODE == 0) ? (p.w_in + (size_t)l * 1024 * IN_W + 2048) : (p.w_router + (size_t)l * 1024 * 16);
        const int ld = (MODE == 0) ? IN_W : 16;
        f32x4 wv[2][4];
#pragma unroll
        for (int q = 0; q < 2; ++q)
#pragma unroll
            for (int c = 0; c < 4; ++c) wv[q][c] = *(const f32x4 GAS*)(src + (size_t)(2 * p.tid + q) * ld + 4 * c);
#pragma unroll
        for (int q = 0; q < 2; ++q) { const int k = 2 * p.tid + q, rr = (k & 7) * 128 + ((k >> 3) & 63) + 64 * (k >> 9);
#pragma unroll
            for (int c = 0; c < 4; ++c) *(LAS f32x4*)(W16 + rr * 20 + 4 * c) = wv[q][c]; }
        __syncthreads();
    }
    const int gw = p.bid * NWAVES + p.wave, NGW = p.G * NWAVES, lane = p.lane;
    const bool comb = (MODE == 0 && l > 0) || MODE == 2;
    const int rbeg = gw + ((MODE == 2 || !with_ctx) ? NCTX : 0);
    f32x4 xn[4]; int slotn = -1;
#define RP_SRC(r_) ((MODE == 0 && l == 0) ? ((r_) < NCTX ? (p.ctx + (size_t)(r_) * D) : (p.x + (size_t)((r_) - NCTX) * D)) : ((r_) < NCTX ? (p.XC + (size_t)(r_) * D) : (p.XL + (size_t)((r_) - NCTX) * D)))
#define RP_LOAD(r_) { const float GAS* s_ = RP_SRC(r_); xn[0] = *(const f32x4 GAS*)(s_ + 8 * lane); xn[1] = *(const f32x4 GAS*)(s_ + 8 * lane + 4); xn[2] = *(const f32x4 GAS*)(s_ + 512 + 8 * lane); xn[3] = *(const f32x4 GAS*)(s_ + 512 + 8 * lane + 4); \
        if (comb) slotn = p.INV[(size_t)(r_) * 16 + (lane & 15)]; }
    f32x4 gs[4], hs[4]; bool cur_isc = rbeg < NCTX;
#define RP_MOD(isc_) if (MODE != 2) { const float GAS* gam_ = (MODE == 0 ? p.norm1_g : p.norm2_g) + (size_t)l * D; const float GAS* md_ = p.MOD + (size_t)(l * 2 + ((isc_) ? 1 : 0)) * 6144 + (MODE == 0 ? 0 : 3 * D); \
        _Pragma("unroll") for (int i_ = 0; i_ < 4; ++i_) { const int k_ = 512 * (i_ >> 1) + 8 * lane + 4 * (i_ & 1); const f32x4 g_ = *(const f32x4 GAS*)(gam_ + k_), s_ = *(const f32x4 GAS*)(md_ + D + k_); \
            gs[i_] = g_ * (1.f + s_); hs[i_] = *(const f32x4 GAS*)(md_ + k_); } }
    RP_MOD(cur_isc)
    if (rbeg < T) RP_LOAD(rbeg)
    for (int row = rbeg; row < T; row += NGW) {
        const bool isc = row < NCTX;
        if (isc != cur_isc) { RP_MOD(isc) cur_isc = isc; }
        float GAS* xrow = isc ? (p.XC + (size_t)row * D) : (p.XL + (size_t)(row - NCTX) * D);
        float v[16];
#pragma unroll
        for (int i = 0; i < 4; ++i) { v[4 * i] = xn[i][0]; v[4 * i + 1] = xn[i][1]; v[4 * i + 2] = xn[i][2]; v[4 * i + 3] = xn[i][3]; }
        const int myslot = slotn;
        { const int rnx = (row + NGW < T) ? row + NGW : row; RP_LOAD(rnx) }
        if (comb) {
            const int lp = (MODE == 2) ? (DEPTH - 1) : (l - 1);
            const float GAS* g2 = p.MOD + (size_t)(lp * 2 + (isc ? 1 : 0)) * 6144 + 5 * D;
            float s[16];
#pragma unroll
            for (int i = 0; i < 16; ++i) s[i] = 0.f;
            unsigned bal = (unsigned)(__ballot(myslot >= 0) & 0xFFFFull);
            while (bal) {
                const int e0 = __builtin_ctz(bal); bal &= bal - 1u;
                const bool two = bal != 0u; const int e1 = two ? __builtin_ctz(bal) : e0; if (two) bal &= bal - 1u;
                const int s0 = __builtin_amdgcn_readlane(myslot, e0), s1 = __builtin_amdgcn_readlane(myslot, e1);
                const bf16 GAS* y0 = p.YE + ((size_t)e0 * ESLOTS + s0) * D; const bf16 GAS* y1 = p.YE + ((size_t)e1 * ESLOTS + s1) * D;
                u32x4 w0[2], w1[2];
#pragma unroll
                for (int i = 0; i < 2; ++i) { w0[i] = __builtin_nontemporal_load((const u32x4 GAS*)(y0 + 512 * i + 8 * lane)); w1[i] = __builtin_nontemporal_load((const u32x4 GAS*)(y1 + 512 * i + 8 * lane)); }
#pragma unroll
                for (int i = 0; i < 2; ++i) { const u32x4 w = w0[i];
                    s[8 * i] += bflo(w.x); s[8 * i + 1] += bfhi(w.x); s[8 * i + 2] += bflo(w.y); s[8 * i + 3] += bfhi(w.y);
                    s[8 * i + 4] += bflo(w.z); s[8 * i + 5] += bfhi(w.z); s[8 * i + 6] += bflo(w.w); s[8 * i + 7] += bfhi(w.w); }
                if (two) {
#pragma unroll
                    for (int i = 0; i < 2; ++i) { const u32x4 w = w1[i];
                        s[8 * i] += bflo(w.x); s[8 * i + 1] += bfhi(w.x); s[8 * i + 2] += bflo(w.y); s[8 * i + 3] += bfhi(w.y);
                        s[8 * i + 4] += bflo(w.z); s[8 * i + 5] += bfhi(w.z); s[8 * i + 6] += bflo(w.w); s[8 * i + 7] += bfhi(w.w); } }
            }
#pragma unroll
            for (int i = 0; i < 2; ++i) { const f32x4 a = *(const f32x4 GAS*)(g2 + 512 * i + 8 * lane), b = *(const f32x4 GAS*)(g2 + 512 * i + 8 * lane + 4);
#pragma unroll
                for (int q = 0; q < 4; ++q) { v[8 * i + q] += a[q] * s[8 * i + q]; v[8 * i + 4 + q] += b[q] * s[8 * i + 4 + q]; } }
        }
        if (MODE == 0 && !dry) {
#pragma unroll
            for (int i = 0; i < 2; ++i) { *(f32x4 GAS*)(xrow + 512 * i + 8 * lane) = (f32x4){v[8 * i], v[8 * i + 1], v[8 * i + 2], v[8 * i + 3]};
                *(f32x4 GAS*)(xrow + 512 * i + 8 * lane + 4) = (f32x4){v[8 * i + 4], v[8 * i + 5], v[8 * i + 6], v[8 * i + 7]}; }
        }
        float ss = 0.f;
#pragma unroll
        for (int i = 0; i < 16; ++i) ss += v[i] * v[i];
        const float rstd = rsqrtf(wsum(ss) * (1.f / D) + EPS);
        if (MODE == 2) {
#pragma unroll
            for (int i = 0; i < 2; ++i) { const f32x4 a = *(const f32x4 GAS*)(p.final_g + 512 * i + 8 * lane), b = *(const f32x4 GAS*)(p.final_g + 512 * i + 8 * lane + 4);
                __builtin_nontemporal_store((f32x4){v[8 * i] * rstd * a[0], v[8 * i + 1] * rstd * a[1], v[8 * i + 2] * rstd * a[2], v[8 * i + 3] * rstd * a[3]}, (f32x4 GAS*)(xrow + 512 * i + 8 * lane));
                __builtin_nontemporal_store((f32x4){v[8 * i + 4] * rstd * b[0], v[8 * i + 5] * rstd * b[1], v[8 * i + 6] * rstd * b[2], v[8 * i + 7] * rstd * b[3]}, (f32x4 GAS*)(xrow + 512 * i + 8 * lane + 4)); }
            continue;
        }
        bf16 GAS* hrow = p.H + (size_t)row * D;
        float acc[16];
#pragma unroll
        for (int j = 0; j < 16; ++j) acc[j] = 0.f;
#pragma unroll
        for (int i = 0; i < 2; ++i) {
            float hv[8];
            { const int k0 = 512 * i + 8 * lane;
#pragma unroll
              for (int q = 0; q < 4; ++q) { hv[q] = v[8 * i + q] * rstd * gs[2 * i][q] + hs[2 * i][q]; hv[4 + q] = v[8 * i + 4 + q] * rstd * gs[2 * i + 1][q] + hs[2 * i + 1][q]; }
              u32x4 o; o.x = pk2(hv[0], hv[1]); o.y = pk2(hv[2], hv[3]); o.z = pk2(hv[4], hv[5]); o.w = pk2(hv[6], hv[7]);
              *(u32x4 GAS*)(hrow + k0) = o; }
#pragma unroll
            for (int j = 0; j < 8; ++j) { const LAS f32x4* wr = (const LAS f32x4*)(W16 + (j * 128 + lane + 64 * i) * 20);
                const f32x4 w0 = wr[0], w1 = wr[1], w2 = wr[2], w3 = wr[3]; const float h = hv[j];
                acc[0] += h * w0[0]; acc[1] += h * w0[1]; acc[2] += h * w0[2]; acc[3] += h * w0[3];
                acc[4] += h * w1[0]; acc[5] += h * w1[1]; acc[6] += h * w1[2]; acc[7] += h * w1[3];
                acc[8] += h * w2[0]; acc[9] += h * w2[1]; acc[10] += h * w2[2]; acc[11] += h * w2[3];
                acc[12] += h * w3[0]; acc[13] += h * w3[1]; acc[14] += h * w3[2]; acc[15] += h * w3[3];
                if (j & 1) asm volatile("" ::: "memory"); }
        }
        const float tot = reduce16(acc, lane);
        const int col = ((lane >> 5) & 1) * 8 + ((lane >> 4) & 1) * 4 + ((lane >> 3) & 1) * 2 + ((lane >> 2) & 1);
        if (MODE == 0) {
            if ((lane & 3) == 0) p.DT[(size_t)row * 16 + col] = softplus_f(tot + p.dt_bias[l * 16 + col]);
        } else {
            float mx = tot;
            mx = fmaxf(mx, __shfl_xor(mx, 4)); mx = fmaxf(mx, __shfl_xor(mx, 8)); mx = fmaxf(mx, __shfl_xor(mx, 16)); mx = fmaxf(mx, __shfl_xor(mx, 32));
            const float e = expf(tot - mx); float sum = e;
            sum += __shfl_xor(sum, 4); sum += __shfl_xor(sum, 8); sum += __shfl_xor(sum, 16); sum += __shfl_xor(sum, 32);
            if ((lane & 3) == 0) p.AFFT[(size_t)col * T + row] = e / sum;
        }
    }
}

#undef RP_SRC
#undef RP_LOAD
#undef RP_MOD
struct S5Lane { float abr, abi; float bbr[16], bbi[16]; };
__device__ __forceinline__ void s5_lane_params(const P& p, int l, int d, int g, int lane, S5Lane& o, bool withB) {
    const size_t gi = ((size_t)(l * 2 + d) * 32 + g);
    const float lr = p.lam_re[gi * 64 + lane], li = p.lam_im[gi * 64 + lane], dt = expf(p.log_dt[gi]);
    const float mag = expf(lr * dt); float sn, cs; sincosf(li * dt, &sn, &cs);
    o.abr = mag * cs; o.abi = mag * sn;
    if (withB) {
        const float den = lr * lr + li * li;
        const float fr = ((o.abr - 1.f) * lr + o.abi * li) / den, fi = (o.abi * lr - (o.abr - 1.f) * li) / den;
        const f32x4 GAS* br = (const f32x4 GAS*)(p.b_re + (gi * 64 + lane) * 16); const f32x4 GAS* bi = (const f32x4 GAS*)(p.b_im + (gi * 64 + lane) * 16);
#pragma unroll
        for (int q = 0; q < 4; ++q) { const f32x4 r4 = br[q], i4 = bi[q];
#pragma unroll
            for (int j = 0; j < 4; ++j) { o.bbr[4 * q + j] = fr * r4[j] - fi * i4[j]; o.bbi[4 * q + j] = fr * i4[j] + fi * r4[j]; } }
    }
}
__device__ __forceinline__ void s5_stage_u(const P& p, int r0, int g, LAS unsigned char* ub, int lane) {
    u32x4 w[4];
#pragma unroll
    for (int j = 0; j < 4; ++j) { const int q = lane + 64 * j, i = q >> 1, half = q & 1; w[j] = *(const u32x4 GAS*)(p.PROJ + (size_t)(r0 + i) * PJ + U0 + g * 16 + half * 8); }
    __builtin_amdgcn_sched_barrier(0);
#pragma unroll
    for (int j = 0; j < 4; ++j) { const int q = lane + 64 * j, i = q >> 1, half = q & 1; *(LAS u32x4*)(ub + i * 32 + half * 16) = w[j]; }
    LDS_FENCE();
}


__device__ __forceinline__ void phase_premix(const P& p, int l, LAS unsigned char* lds) {
    const int c8 = (p.tid & 127) * 8;
    const float GAS* cw = p.conv_w + (size_t)l * 5 * 1024 + c8; const float GAS* cb = p.conv_b + (size_t)l * 1024 + c8;
    float w[5][8], bias[8];
#pragma unroll
    for (int j = 0; j < 5; ++j) { const f32x4 w0 = *(const f32x4 GAS*)(cw + j * 1024), w1 = *(const f32x4 GAS*)(cw + j * 1024 + 4);
        w[j][0] = w0[0]; w[j][1] = w0[1]; w[j][2] = w0[2]; w[j][3] = w0[3]; w[j][4] = w1[0]; w[j][5] = w1[1]; w[j][6] = w1[2]; w[j][7] = w1[3]; }
    { const f32x4 b0 = *(const f32x4 GAS*)cb, b1 = *(const f32x4 GAS*)(cb + 4); bias[0] = b0[0]; bias[1] = b0[1]; bias[2] = b0[2]; bias[3] = b0[3]; bias[4] = b1[0]; bias[5] = b1[1]; bias[6] = b1[2]; bias[7] = b1[3]; }
    for (int rg = p.bid * 4 + (p.tid >> 7); rg < T / 4; rg += p.G * 4) {
        const int row0 = 4 * rg, lo = row0 < NCTX ? 0 : NCTX, hi = row0 < NCTX ? NCTX : T;
        u32x4 xv[8];
#pragma unroll
        for (int q = 0; q < 8; ++q) { const int r = row0 + q - 2; xv[q] = (r >= lo && r < hi) ? *(const u32x4 GAS*)(p.PROJ + (size_t)r * PJ + XB0 + c8) : (u32x4){0u, 0u, 0u, 0u}; }
#pragma unroll
        for (int t = 0; t < 4; ++t) {
            float a[8];
#pragma unroll
            for (int q = 0; q < 8; ++q) a[q] = bias[q];
#pragma unroll
            for (int j = 0; j < 5; ++j) { const u32x4 v = xv[t + j];
                a[0] += w[j][0] * bflo(v.x); a[1] += w[j][1] * bfhi(v.x); a[2] += w[j][2] * bflo(v.y); a[3] += w[j][3] * bfhi(v.y);
                a[4] += w[j][4] * bflo(v.z); a[5] += w[j][5] * bfhi(v.z); a[6] += w[j][6] * bflo(v.w); a[7] += w[j][7] * bfhi(v.w); }
            u32x4 o; o.x = pk2(silu_f(a[0]), silu_f(a[1])); o.y = pk2(silu_f(a[2]), silu_f(a[3])); o.z = pk2(silu_f(a[4]), silu_f(a[5])); o.w = pk2(silu_f(a[6]), silu_f(a[7]));
            *(u32x4 GAS*)(p.CV + (size_t)(row0 + t) * 1024 + c8) = o; }
    }
}


__device__ __forceinline__ void phase_select(const P& p, LAS unsigned char* lds, bool with_ctx) {
    LAS unsigned* keys = (LAS unsigned*)lds;
    LAS unsigned* hist = keys + 16384;
    LAS unsigned* misc = hist + 256;
    const int tid = p.tid, lane = p.lane, wave = p.wave;
    for (int it = p.bid; it < (with_ctx ? 32 : 16); it += p.G) {
        const int set = it >> 4, e = it & 15;
        const int n = set ? NCTX : NLAT, cap = set ? CAP_C : CAP_L, row0 = set ? 0 : NCTX, slot0 = set ? CAP_L : 0;
        const float GAS* src = p.AFFT + (size_t)e * T + row0;
        __syncthreads();
        { unsigned kv[32];
#pragma unroll
          for (int j = 0; j < 32; ++j) { const int i = tid + NTHR * j; kv[j] = (i < n) ? __float_as_uint(src[i]) : 0u; }
          __builtin_amdgcn_sched_barrier(0);
#pragma unroll
          for (int j = 0; j < 32; ++j) { const int i = tid + NTHR * j; if (i < n) keys[i] = kv[j]; } }
        unsigned prefix = 0u, mask = 0u, need = (unsigned)cap;
        for (int pass = 3; pass >= 0; --pass) {
            if (tid < 256) hist[tid] = 0u;
            __syncthreads();
            for (int i = tid; i < n; i += NTHR) { const unsigned k = keys[i]; if ((k & mask) == prefix) __hip_atomic_fetch_add(&hist[(k >> (8 * pass)) & 255u], 1u, __ATOMIC_RELAXED, __HIP_MEMORY_SCOPE_WORKGROUP); }
            __syncthreads();
            if (wave == 0) {
                const unsigned h0 = hist[4 * lane], h1 = hist[4 * lane + 1], h2 = hist[4 * lane + 2], h3 = hist[4 * lane + 3];
                const unsigned c = h0 + h1 + h2 + h3; unsigned S = c;
#pragma unroll
                for (int o = 1; o < 64; o <<= 1) { const unsigned t = __shfl_down(S, o); if (lane + o < 64) S += t; }
                const unsigned Snext = S - c;
                if (S >= need && Snext < need) { unsigned rem = need - Snext; unsigned bin;
                    if (h3 >= rem) bin = 3; else { rem -= h3; if (h2 >= rem) bin = 2; else { rem -= h2; if (h1 >= rem) bin = 1; else { rem -= h1; bin = 0; } } }
                    misc[0] = 4 * lane + bin; misc[1] = rem; }
            }
            __syncthreads();
            prefix |= misc[0] << (8 * pass); mask |= 0xFFu << (8 * pass); need = misc[1];
            __syncthreads();
        }
        if (set == 0) for (int s = CAP_L + (with_ctx ? CAP_C : 0) + tid; s < ESLOTS; s += NTHR) { p.IDX[e * ESLOTS + s] = 0; p.GSEL[e * ESLOTS + s] = 0.f; }
        unsigned selbase = 0u, eqbase = 0u;
        for (int base = 0; base < n; base += NTHR) {
            const int i = base + tid; const bool valid = i < n; const unsigned k = valid ? keys[i] : 0u;
            const bool eq = valid && k == prefix, gt = valid && k > prefix;
            const unsigned long long lt = (1ull << lane) - 1ull;
            const unsigned long long be = __ballot(eq);
            if (lane == 0) misc[8 + wave] = (unsigned)__popcll(be);
            __syncthreads();
            unsigned woff = 0u, tot = 0u;
#pragma unroll
            for (int w = 0; w < 8; ++w) { const unsigned v = misc[8 + w]; woff += (w < wave) ? v : 0u; tot += v; }
            const unsigned eqrank = eqbase + woff + (unsigned)__popcll(be & lt);
            const bool sel = gt || (eq && eqrank < need);
            const unsigned long long bs = __ballot(sel);
            if (lane == 0) misc[16 + wave] = (unsigned)__popcll(bs);
            __syncthreads();
            unsigned woff2 = 0u, tot2 = 0u;
#pragma unroll
            for (int w = 0; w < 8; ++w) { const unsigned v = misc[16 + w]; woff2 += (w < wave) ? v : 0u; tot2 += v; }
            if (valid) { const int row = row0 + i;
                if (sel) { const int slot = slot0 + (int)(selbase + woff2 + (unsigned)__popcll(bs & lt));
                    p.IDX[e * ESLOTS + slot] = row; p.GSEL[e * ESLOTS + slot] = __uint_as_float(k); p.INV[(size_t)row * 16 + e] = slot; }
                else p.INV[(size_t)row * 16 + e] = -1; }
            selbase += tot2; eqbase += tot;
            __syncthreads();
        }
    }
}


typedef short bf16x8 __attribute__((ext_vector_type(8)));
#define MFMA16(a, b, c) __builtin_amdgcn_mfma_f32_16x16x32_bf16((a), (b), (c), 0, 0, 0)
constexpr int LDP = 272;
constexpr int LDQ = 144;
__device__ __forceinline__ bf16x8 ld_frag(const LAS unsigned char* base, int row, int kcol, int ldb) { return *(const LAS bf16x8*)(base + row * ldb + kcol * 2); }
typedef short s16x4_t __attribute__((ext_vector_type(4)));
__device__ __forceinline__ bf16x8 tr_frag(const LAS unsigned char* img, int k0, int col0, int sb, int lane) {
    const int g = lane >> 4, q = (lane & 15) >> 2, pp = lane & 3;
    const LAS unsigned char* a = img + (k0 + 8 * g + q) * sb + (col0 + 4 * pp) * 2;
    const s16x4_t r0 = __builtin_amdgcn_ds_read_tr16_b64_v4i16((LAS s16x4_t*)a), r1 = __builtin_amdgcn_ds_read_tr16_b64_v4i16((LAS s16x4_t*)(a + 4 * sb));
    return (bf16x8){r0[0], r0[1], r0[2], r0[3], r1[0], r1[1], r1[2], r1[3]};
}
__device__ __forceinline__ bf16x8 tr_frag_perm(const LAS unsigned char* img, int k0, int col0, int sb, int lane) {
    const int g = lane >> 4, q = (lane & 15) >> 2, pp = lane & 3;
    const LAS unsigned char* a = img + (k0 + 4 * g + q) * sb + (col0 + 4 * pp) * 2;
    const s16x4_t r0 = __builtin_amdgcn_ds_read_tr16_b64_v4i16((LAS s16x4_t*)a), r1 = __builtin_amdgcn_ds_read_tr16_b64_v4i16((LAS s16x4_t*)(a + 16 * sb));
    return (bf16x8){r0[0], r0[1], r0[2], r0[3], r1[0], r1[1], r1[2], r1[3]};
}
constexpr int SB64 = 144, SB128 = 304, SB256 = 560;
__device__ __forceinline__ void st_b16(LAS unsigned char* p, unsigned v) { *(LAS unsigned short*)p = (unsigned short)v; }
__device__ __forceinline__ float wscan_incl(float v, int lane) {
#pragma unroll
    for (int o = 1; o < 64; o <<= 1) { const float t = __shfl_up(v, o); if (lane >= o) v += t; }
    return v;
}
__device__ __forceinline__ int chunk_r0(int d, int cs) { return d == 0 ? 128 * cs : (cs < 2 ? 128 * (1 - cs) : 128 * (NCH + 1 - cs)); }
__device__ __forceinline__ int scan_chunk_of(int d, int cn) { return d == 0 ? cn : (cn < 2 ? 1 - cn : NCH + 1 - cn); }

__device__ __forceinline__ void ssd_acum(const float GAS* DT, int r0, int d, int col, float a, int lane, LAS float* acum, LAS float* dtv, float& total) {
    const int j0 = d == 0 ? lane : 127 - lane, j1 = d == 0 ? 64 + lane : 63 - lane;
    const float dt0 = DT[(size_t)(r0 + j0) * 16 + col], dt1 = DT[(size_t)(r0 + j1) * 16 + col];
    const float s0 = wscan_incl(dt0 * a, lane); const float t0 = __shfl(s0, 63);
    const float s1 = wscan_incl(dt1 * a, lane) + t0; total = __shfl(s1, 63);
    acum[j0] = s0; acum[j1] = s1; dtv[j0] = dt0; dtv[j1] = dt1;
}


__device__ __forceinline__ void ssd_states(const P& p, int l, LAS unsigned char* lds, bf16 GAS* SST, float GAS* DEC) {
    LAS unsigned char* Bi = lds;
    LAS unsigned char* Xi = lds + 128 * SB128;
    LAS float* wj = (LAS float*)(lds + 128 * SB128 + 128 * SB256);
    const int tid = p.tid, lane = p.lane, wave = p.wave, quad = lane >> 4, l15 = lane & 15;
    u32x4 rbv[4], rxv[8];
#define SS_LOAD(u_) { const int d_ = (u_) / (2 * NCH), cs_ = ((u_) % (2 * NCH)) >> 1, g_ = (u_) & 1, r0_ = chunk_r0(d_, cs_); \
        _Pragma("unroll") for (int i_ = 0; i_ < 4; ++i_) { const int idx = tid + NTHR * i_, j = idx >> 4, n8 = (idx & 15) * 8; rbv[i_] = *(const u32x4 GAS*)(p.CV + (size_t)(r0_ + j) * 1024 + 512 + g_ * 128 + n8); } \
        _Pragma("unroll") for (int i_ = 0; i_ < 8; ++i_) { const int idx = tid + NTHR * i_, j = idx >> 5, c8 = (idx & 31) * 8; rxv[i_] = *(const u32x4 GAS*)(p.CV + (size_t)(r0_ + j) * 1024 + g_ * 256 + c8); } }
    if (p.vcu < 2 * NCH * 2) SS_LOAD(p.vcu)
    for (int u = p.vcu; u < 2 * NCH * 2; u += p.G) {
        const int d = u / (2 * NCH), cs = (u % (2 * NCH)) >> 1, g = u & 1;
        const int r0 = chunk_r0(d, cs);
        __syncthreads();
        if (wave < 4) { const int h = g * 4 + wave; const float a = -expf(p.a_log[l * 16 + d * 8 + h]); float total;
            LAS float* ac = wj + 512 + wave * 128; LAS float* dv = wj + 1024 + wave * 128;
            ssd_acum(p.DT, r0, d, d * 8 + h, a, lane, ac, dv, total);
            LDS_FENCE();
            wj[wave * 128 + lane] = __expf(total - ac[lane]) * dv[lane]; wj[wave * 128 + 64 + lane] = __expf(total - ac[64 + lane]) * dv[64 + lane];
            if (lane == 0) DEC[(d * NCH + cs) * 8 + h] = expf(total); }
#pragma unroll
        for (int i = 0; i < 4; ++i) { const int idx = tid + NTHR * i, j = idx >> 4, n8 = (idx & 15) * 8; *(LAS u32x4*)(Bi + j * SB128 + n8 * 2) = rbv[i]; }
        __syncthreads();
#pragma unroll
        for (int i = 0; i < 8; ++i) { const int idx = tid + NTHR * i, j = idx >> 5, c8 = (idx & 31) * 8;
            const u32x4 v = rxv[i]; const float w = wj[(c8 >> 6) * 128 + j];
            u32x4 o; o.x = pk2(bflo(v.x) * w, bfhi(v.x) * w); o.y = pk2(bflo(v.y) * w, bfhi(v.y) * w); o.z = pk2(bflo(v.z) * w, bfhi(v.z) * w); o.w = pk2(bflo(v.w) * w, bfhi(v.w) * w);
            *(LAS u32x4*)(Xi + j * SB256 + c8 * 2) = o; }
        __syncthreads();
        if (u + p.G < 2 * NCH * 2) SS_LOAD(u + p.G)
        const int hh = wave >> 1, ph = wave & 1;
        f32x4 acc[2][8];
#pragma unroll
        for (int a = 0; a < 2; ++a)
#pragma unroll
            for (int b = 0; b < 8; ++b) acc[a][b] = (f32x4){0.f, 0.f, 0.f, 0.f};
#pragma unroll
        for (int ks = 0; ks < 4; ++ks) {
            bf16x8 af[2];
#pragma unroll
            for (int pt = 0; pt < 2; ++pt) af[pt] = tr_frag(Xi, 32 * ks, hh * 64 + ph * 32 + pt * 16, SB256, lane);
#pragma unroll
            for (int nt = 0; nt < 8; ++nt) { const bf16x8 bfr = tr_frag(Bi, 32 * ks, nt * 16, SB128, lane);
#pragma unroll
                for (int pt = 0; pt < 2; ++pt) acc[pt][nt] = MFMA16(af[pt], bfr, acc[pt][nt]); }
        }
        bf16 GAS* S = SST + ((size_t)(d * NCH + cs) * 8 + g * 4 + hh) * 8192;
#pragma unroll
        for (int pt = 0; pt < 2; ++pt)
#pragma unroll
            for (int nt = 0; nt < 8; ++nt)
#pragma unroll
                for (int r = 0; r < 4; ++r) S[(ph * 32 + pt * 16 + 4 * quad + r) * 128 + nt * 16 + l15] = (bf16)f2bf(acc[pt][nt][r]);
    }
}

#undef SS_LOAD
__device__ __forceinline__ void scan_carries(const P& p, int l, LAS unsigned char* lds, const bf16 GAS* SST, const float GAS* DEC, bf16 GAS* HIN) {
    LAS float* dcl = (LAS float*)lds;
    for (int e = p.bid * NTHR + p.tid; e < 2 * 8 * 8192; e += p.G * NTHR) {
        const int d = e >> 16, h = (e >> 13) & 7, pn = e & 8191;
        __syncthreads();
        if (p.tid < NCH) dcl[p.tid] = DEC[(size_t)(d * NCH + p.tid) * 8 + h];
        __syncthreads();
        float hs = 0.f;
        unsigned sa[26], sb[26];
        constexpr size_t CST = (size_t)8 * 8192;
        const bf16 GAS* sp = SST + ((size_t)(d * NCH) * 8 + h) * 8192 + pn; bf16 GAS* hp = HIN + ((size_t)(d * NCH) * 8 + h) * 8192 + pn; int cb = 0;
#define SC_LOAD(arr_) { _Pragma("unroll") for (int j = 0; j < 26; ++j) arr_[j] = sp[(size_t)j * CST]; sp += 26 * CST; __builtin_amdgcn_sched_barrier(0); }
#define SC_FOLD(arr_) { _Pragma("unroll") for (int j = 0; j < 26; ++j) { hp[(size_t)j * CST] = (bf16)f2bf(hs); hs = hs * dcl[cb + j] + bf2f(arr_[j]); } hp += 26 * CST; cb += 26; __builtin_amdgcn_sched_barrier(0); }
        SC_LOAD(sa)
#pragma unroll 1
        for (int b = 0; b < 2; ++b) { SC_LOAD(sb) SC_FOLD(sa) SC_LOAD(sa) SC_FOLD(sb) }
        SC_FOLD(sa)
#undef SC_LOAD
#undef SC_FOLD
    }
    for (int e = p.bid * NTHR + p.tid; e < 2 * 32 * 64; e += p.G * NTHR) {
        const int d = e >> 11, g = (e >> 6) & 31, pq = e & 63;
        S5Lane s; s5_lane_params(p, l, d, g, pq, s, false);
        float ar = s.abr, ai = s.abi;
#pragma unroll
        for (int q = 0; q < 7; ++q) { const float nr = ar * ar - ai * ai, ni = 2.f * ar * ai; ar = nr; ai = ni; }
        float hr = 0.f, hi = 0.f;
        const float GAS* E = p.S5E + (size_t)(d * 32 + g) * NCH * 128 + pq; float GAS* Hn = p.S5H + (size_t)(d * 32 + g) * NCH * 128 + pq;
        for (int c0 = 0; c0 < NCH; c0 += 26) {
            float er[26], ei[26];
#pragma unroll
            for (int j = 0; j < 26; ++j) { er[j] = E[(c0 + j) * 128]; ei[j] = E[(c0 + j) * 128 + 64]; }
#pragma unroll
            for (int j = 0; j < 26; ++j) { Hn[(c0 + j) * 128] = hr; Hn[(c0 + j) * 128 + 64] = hi;
                const float nr = ar * hr - ai * hi + er[j], ni = ar * hi + ai * hr + ei[j]; hr = nr; hi = ni; }
        }
    }
}

__device__ __forceinline__ void ssd_outputs(const P& p, int l, LAS unsigned char* lds, const bf16 GAS* HIN, const bf16 GAS* SST, bf16 GAS* YS, int u_begin, int u_end, int first, int stride) {
    LAS unsigned char* Cm = lds;
    LAS unsigned char* Bm = lds + 128 * LDP;
    LAS unsigned char* XT = lds + 2 * 128 * LDP;
    LAS unsigned char* Wm = lds + 2 * 128 * LDP + 128 * SB64;
    LAS float* sm = (LAS float*)(lds + 3 * 128 * LDP + 128 * SB64);
    const int tid = p.tid, lane = p.lane, wave = p.wave, quad = lane >> 4, l15 = lane & 15;
    u32x4 rb[4], rc[4], rx[2], rh[4];
#define SO_LOAD(u_) { const int cn_ = (u_) >> 3, h_ = (u_) & 7, g_ = h_ >> 2, r0_ = 128 * cn_; \
        _Pragma("unroll") for (int i_ = 0; i_ < 4; ++i_) { const int idx = tid + NTHR * i_, d_ = idx >> 10, pp = (idx >> 4) & 63, n8 = (idx & 15) * 8; const int cs_ = scan_chunk_of(d_, cn_); \
            if (cn_ >= 2) rh[i_] = *(const u32x4 GAS*)(HIN + ((size_t)(d_ * NCH + cs_) * 8 + h_) * 8192 + pp * 128 + n8); \
            else if (cs_ == 0) rh[i_] = (u32x4){0u, 0u, 0u, 0u}; \
            else rh[i_] = *(const u32x4 GAS*)(SST + ((size_t)(d_ * NCH) * 8 + h_) * 8192 + pp * 128 + n8); } \
        _Pragma("unroll") for (int i_ = 0; i_ < 4; ++i_) { const int idx = tid + NTHR * i_, j = idx >> 4, n8 = (idx & 15) * 8; const bf16 GAS* src = p.CV + (size_t)(r0_ + j) * 1024 + g_ * 128 + n8; \
            rb[i_] = *(const u32x4 GAS*)(src + 512); rc[i_] = *(const u32x4 GAS*)(src + 768); } \
        _Pragma("unroll") for (int i_ = 0; i_ < 2; ++i_) { const int idx = tid + NTHR * i_, j = idx >> 3, p8 = (idx & 7) * 8; rx[i_] = *(const u32x4 GAS*)(p.CV + (size_t)(r0_ + j) * 1024 + h_ * 64 + p8); } }
    if (u_begin + first < u_end) SO_LOAD(u_begin + first)
    for (int u = u_begin + first; u < u_end; u += stride) {
        const int cn = u >> 3, h = u & 7, g = h >> 2, r0 = 128 * cn;
        __syncthreads();
        if (wave < 2) { const int d = wave; const float a = -expf(p.a_log[l * 16 + d * 8 + h]); float total;
            ssd_acum(p.DT, r0, d, d * 8 + h, a, lane, sm + d * 128, sm + 256 + d * 128, total); }
#pragma unroll
        for (int i = 0; i < 4; ++i) { const int idx = tid + NTHR * i, j = idx >> 4, n8 = (idx & 15) * 8; *(LAS u32x4*)(Bm + j * LDP + n8 * 2) = rb[i]; *(LAS u32x4*)(Cm + j * LDP + n8 * 2) = rc[i]; }
#pragma unroll
        for (int i = 0; i < 2; ++i) { const int idx = tid + NTHR * i, j = idx >> 3, p8 = (idx & 7) * 8; *(LAS u32x4*)(XT + j * SB64 + p8 * 2) = rx[i]; }
        __syncthreads();
        f32x4 G[8];
#pragma unroll
        for (int jt = 0; jt < 8; ++jt) G[jt] = (f32x4){0.f, 0.f, 0.f, 0.f};
#pragma unroll
        for (int ks = 0; ks < 4; ++ks) { const bf16x8 cfr = ld_frag(Cm, 16 * wave + l15, ks * 32 + 8 * quad, LDP);
#pragma unroll
            for (int jt = 0; jt < 8; ++jt) G[jt] = MFMA16(ld_frag(Bm, 16 * jt + l15, ks * 32 + 8 * quad, LDP), cfr, G[jt]); }
        __syncthreads();
#pragma unroll
        for (int i = 0; i < 4; ++i) { const int idx = tid + NTHR * i, d = idx >> 10, pp = (idx >> 4) & 63, n8 = (idx & 15) * 8;
            *(LAS u32x4*)(Bm + (d * 64 + pp) * LDP + n8 * 2) = rh[i]; }
        __syncthreads();
        if (u + stride < u_end) SO_LOAD(u + stride)
        f32x4 Y[4];
#pragma unroll
        for (int pt = 0; pt < 4; ++pt) Y[pt] = (f32x4){0.f, 0.f, 0.f, 0.f};
#pragma unroll 1
        for (int d = 0; d < 2; ++d) {
            const LAS float* ac = sm + d * 128; const LAS float* dv = sm + 256 + d * 128;
            float ai[4];
#pragma unroll
            for (int r = 0; r < 4; ++r) ai[r] = ac[16 * wave + 4 * quad + r];
            const int il = 16 * wave + l15; const float ail = ac[il];
            const int dm = -d; int u0 = (il - 4 * quad) ^ dm; asm volatile("" : "+v"(u0));
            f32x4 Y2[4];
#pragma unroll
            for (int pt = 0; pt < 4; ++pt) Y2[pt] = (f32x4){0.f, 0.f, 0.f, 0.f};
#pragma unroll
            for (int ks = 0; ks < 4; ++ks) {
                float wv[8];
#pragma unroll
                for (int hf = 0; hf < 2; ++hf) { const int jt = 2 * ks + hf, j0 = 16 * jt + 4 * quad;
                    const f32x4 aj = *(const LAS f32x4*)(ac + j0), dj = *(const LAS f32x4*)(dv + j0);
#pragma unroll
                    for (int r = 0; r < 4; ++r) { const bool valid = ((16 * jt + r) ^ dm) <= u0;
                        wv[4 * hf + r] = valid ? G[jt][r] * __expf(ail - aj[r]) * dj[r] : 0.f; } }
                u32x4 wp; wp.x = pk2(wv[0], wv[1]); wp.y = pk2(wv[2], wv[3]); wp.z = pk2(wv[4], wv[5]); wp.w = pk2(wv[6], wv[7]);
                const bf16x8 wf = __builtin_bit_cast(bf16x8, wp), cf = ld_frag(Cm, 16 * wave + l15, ks * 32 + 8 * quad, LDP);
#pragma unroll
                for (int pt = 0; pt < 4; ++pt) { Y[pt] = MFMA16(wf, tr_frag_perm(XT, 32 * ks, 16 * pt, SB64, lane), Y[pt]);
                    Y2[pt] = MFMA16(cf, ld_frag(Bm + d * 64 * LDP, 16 * pt + l15, ks * 32 + 8 * quad, LDP), Y2[pt]); } }
#pragma unroll
            for (int r = 0; r < 4; ++r) { const float ea = __expf(ai[r]);
#pragma unroll
                for (int pt = 0; pt < 4; ++pt) Y[pt][r] += ea * Y2[pt][r]; }
        }
#pragma unroll
        for (int pt = 0; pt < 4; ++pt)
#pragma unroll
            for (int r = 0; r < 4; ++r) YS[(size_t)(r0 + 16 * wave + 4 * quad + r) * 512 + h * 64 + 16 * pt + l15] = (bf16)f2bf(Y[pt][r]);
    }
}

#undef SO_LOAD
__device__ __forceinline__ void ssd_gated_norm(const P& p, int l, const bf16 GAS* YS, int ntile) {
    const int lane = p.lane;
    const int nfree = p.G - ntile, NV = (4 * nfree + ntile) * NWAVES;
    const int reps = (p.bid < ntile) ? 1 : 4;
    const int vbase = (p.bid < ntile) ? (4 * nfree + p.bid) * NWAVES + p.wave : (p.bid - ntile) * 4 * NWAVES + p.wave;
    for (int rp = 0; rp < reps; ++rp) {
    const int gw = vbase + rp * NWAVES, NGW = NV;
    const int ch = lane * 8;
    const float dsk = p.ssd_d[l * 8 + (ch >> 6)];
    u32x4 yn = (u32x4){0u, 0u, 0u, 0u}, xn = yn, zn = yn;
    if (gw < T) { yn = *(const u32x4 GAS*)(YS + (size_t)gw * 512 + ch); xn = *(const u32x4 GAS*)(p.CV + (size_t)gw * 1024 + ch); zn = *(const u32x4 GAS*)(p.PROJ + (size_t)gw * PJ + Z0 + ch); }
    for (int row = gw; row < T; row += NGW) {
        const u32x4 yv = yn, xs = xn, zz = zn;
        if (row + NGW < T) { const size_t rn = (size_t)row + NGW;
            yn = *(const u32x4 GAS*)(YS + rn * 512 + ch); xn = *(const u32x4 GAS*)(p.CV + rn * 1024 + ch); zn = *(const u32x4 GAS*)(p.PROJ + rn * PJ + Z0 + ch); }
        float v[8];
        v[0] = (bflo(yv.x) + dsk * bflo(xs.x)) * silu_f(bflo(zz.x)); v[1] = (bfhi(yv.x) + dsk * bfhi(xs.x)) * silu_f(bfhi(zz.x));
        v[2] = (bflo(yv.y) + dsk * bflo(xs.y)) * silu_f(bflo(zz.y)); v[3] = (bfhi(yv.y) + dsk * bfhi(xs.y)) * silu_f(bfhi(zz.y));
        v[4] = (bflo(yv.z) + dsk * bflo(xs.z)) * silu_f(bflo(zz.z)); v[5] = (bfhi(yv.z) + dsk * bfhi(xs.z)) * silu_f(bfhi(zz.z));
        v[6] = (bflo(yv.w) + dsk * bflo(xs.w)) * silu_f(bflo(zz.w)); v[7] = (bfhi(yv.w) + dsk * bfhi(xs.w)) * silu_f(bfhi(zz.w));
        float ss = 0.f;
#pragma unroll
        for (int i = 0; i < 8; ++i) ss += v[i] * v[i];
        const float rstd = rsqrtf(wsum(ss) * (1.f / 512.f) + EPS);
        const float GAS* ng = p.ssd_norm_g + (size_t)l * 512 + ch;
        const f32x4 g0 = *(const f32x4 GAS*)ng, g1 = *(const f32x4 GAS*)(ng + 4);
        u32x4 o; o.x = pk2(v[0] * rstd * g0[0], v[1] * rstd * g0[1]); o.y = pk2(v[2] * rstd * g0[2], v[3] * rstd * g0[3]);
        o.z = pk2(v[4] * rstd * g1[0], v[5] * rstd * g1[1]); o.w = pk2(v[6] * rstd * g1[2], v[7] * rstd * g1[3]);
        *(u32x4 GAS*)(p.Y3 + (size_t)row * 1536 + 512 + ch) = o;
    }
    }
}

__device__ __forceinline__ void attention_mfma(const P& p, int l, LAS unsigned char* lds, int u_begin, int u_end, int u_first, int u_stride) {
    const int tid = p.tid, lane = p.lane, wave = p.wave, quad = lane >> 4, l15 = lane & 15;
    const float C2 = 0.125f * 1.4426950408889634f;
    for (int u = u_begin + u_first; u < u_end; u += u_stride) {
        const int qb = u >> 1, kvh = u & 1, hq = kvh * 4 + (wave >> 1);
        const bool isc = qb < 2; const int nb = qb - 2;
        const int qrow0 = 128 * qb + 64 * (wave & 1);
        LAS unsigned char* Qs = lds + 4 * 64 * LDQ + wave * 64 * LDQ;
        { u32x4 qv[8];
#pragma unroll
          for (int i = 0; i < 8; ++i) { const int rr = 8 * i + (lane >> 3), pc = lane & 7; qv[i] = *(const u32x4 GAS*)(p.PROJ + (size_t)(qrow0 + rr) * PJ + Q0 + hq * 64 + pc * 8); }
          __builtin_amdgcn_sched_barrier(0);
#pragma unroll
          for (int i = 0; i < 8; ++i) { const int rr = 8 * i + (lane >> 3), pc = lane & 7; *(LAS u32x4*)(Qs + rr * LDQ + pc * 16) = qv[i]; } }
        LDS_FENCE();
        f32x4 O[4][4];
#pragma unroll
        for (int a = 0; a < 4; ++a)
#pragma unroll
            for (int b = 0; b < 4; ++b) O[a][b] = (f32x4){0.f, 0.f, 0.f, 0.f};
        float mrow[4], lrow[4];
        const float sk = p.sink[l * 8 + hq] * 1.4426950408889634f;
#pragma unroll
        for (int qt = 0; qt < 4; ++qt) { mrow[qt] = sk; lrow[qt] = 1.f; }
        const int ntile = isc ? 4 : 10;
#define ATT_VALID(ti_) (isc || (ti_) >= 6 || ((NCTX + 128 * (nb - 1) + 64 * (ti_)) >= NCTX && (NCTX + 128 * (nb - 1) + 64 * (ti_)) < T))
#define ATT_KROW0(ti_) ((isc || (ti_) >= 6) ? 64 * (isc ? (ti_) : (ti_) - 6) : NCTX + 128 * (nb - 1) + 64 * (ti_))
#define ATT_LOAD(ti_) { const bf16 GAS* src = p.PROJ + (size_t)(ATT_KROW0(ti_) + (tid >> 3)) * PJ + kvh * 64 + (tid & 7) * 8; kreg = *(const u32x4 GAS*)(src + K0); vreg = *(const u32x4 GAS*)(src + V0); }
#define ATT_STORE(b_) { *(LAS u32x4*)(lds + (b_) * 2 * 64 * LDQ + (tid >> 3) * LDQ + (tid & 7) * 16) = kreg; *(LAS u32x4*)(lds + (b_) * 2 * 64 * LDQ + 64 * LDQ + (tid >> 3) * SB64 + (tid & 7) * 16) = vreg; }
        int ti = 0; while (!ATT_VALID(ti)) ++ti;
        u32x4 kreg, vreg;
        ATT_LOAD(ti);
        __syncthreads();
        ATT_STORE(0);
        { int t1 = ti + 1; while (t1 < ntile && !ATT_VALID(t1)) ++t1; if (t1 < ntile) ATT_LOAD(t1); }
        __syncthreads();
        int buf = 0;
        while (ti < ntile) {
            const int krow0 = ATT_KROW0(ti); const bool local = !(isc || ti >= 6);
            int tn = ti + 1; while (tn < ntile && !ATT_VALID(tn)) ++tn;
            const LAS unsigned char* Kt = lds + buf * 2 * 64 * LDQ; const LAS unsigned char* VT = Kt + 64 * LDQ;
            const bool need_mask = local && (ti < 2 || ti > 3);
            int kr0 = krow0; asm volatile("" : "+s"(kr0));
#pragma unroll
            for (int qt = 0; qt < 4; ++qt) {
                bf16x8 pf[2];
                f32x4 S[4];
#pragma unroll
                for (int kt = 0; kt < 4; ++kt) S[kt] = (f32x4){0.f, 0.f, 0.f, 0.f};
#pragma unroll
                for (int ks = 0; ks < 2; ++ks)
                    { const bf16x8 qf = ld_frag(Qs, 16 * qt + l15, ks * 32 + 8 * quad, LDQ);
#pragma unroll
                    for (int kt = 0; kt < 4; ++kt) S[kt] = MFMA16(ld_frag(Kt, 16 * kt + l15, ks * 32 + 8 * quad, LDQ), qf, S[kt]); }
                const int tq = qrow0 + 16 * qt + l15;
                float mx = -1e30f;
                if (need_mask) {
                    const int e0 = tq - kr0 - 4 * quad + 128;
#pragma unroll
                    for (int kt = 0; kt < 4; ++kt)
#pragma unroll
                        for (int r = 0; r < 4; ++r) { const float s = ((unsigned)(e0 - (16 * kt + r)) <= 256u) ? S[kt][r] : -1e30f; S[kt][r] = s; mx = fmaxf(mx, s); }
                } else {
#pragma unroll
                    for (int kt = 0; kt < 4; ++kt) mx = fmaxf(fmaxf(mx, fmaxf(S[kt][0], S[kt][1])), fmaxf(S[kt][2], S[kt][3]));
                }
                mx = fmaxf(mx, __shfl_xor(mx, 16)); mx = fmaxf(mx, __shfl_xor(mx, 32));
                const float mn = fmaxf(mrow[qt], mx * C2), alpha = __builtin_amdgcn_exp2f(mrow[qt] - mn);
                float ls = 0.f; u32x4 pw[2];
#pragma unroll
                for (int kt = 0; kt < 4; ++kt) { const float e0 = __builtin_amdgcn_exp2f(S[kt][0] * C2 - mn), e1 = __builtin_amdgcn_exp2f(S[kt][1] * C2 - mn),
                                                              e2 = __builtin_amdgcn_exp2f(S[kt][2] * C2 - mn), e3 = __builtin_amdgcn_exp2f(S[kt][3] * C2 - mn);
                    ls += (e0 + e1) + (e2 + e3);
                    if (kt & 1) { pw[kt >> 1].z = pk2(e0, e1); pw[kt >> 1].w = pk2(e2, e3); } else { pw[kt >> 1].x = pk2(e0, e1); pw[kt >> 1].y = pk2(e2, e3); } }
                pf[0] = __builtin_bit_cast(bf16x8, pw[0]); pf[1] = __builtin_bit_cast(bf16x8, pw[1]);
                ls += __shfl_xor(ls, 16); ls += __shfl_xor(ls, 32);
                lrow[qt] = lrow[qt] * alpha + ls; mrow[qt] = mn;
#pragma unroll
                for (int dt = 0; dt < 4; ++dt) O[dt][qt] *= alpha;
#pragma unroll
                for (int ks = 0; ks < 2; ++ks)
#pragma unroll
                    for (int dt = 0; dt < 4; ++dt) O[dt][qt] = MFMA16(tr_frag_perm(VT, 32 * ks, 16 * dt, SB64, lane), pf[ks], O[dt][qt]);
                asm volatile("" ::: "memory");
            }
            if (tn < ntile) { ATT_STORE(buf ^ 1); int t2 = tn + 1; while (t2 < ntile && !ATT_VALID(t2)) ++t2; if (t2 < ntile) ATT_LOAD(t2); }
            __syncthreads();
            buf ^= 1; ti = tn;
        }
#undef ATT_LOAD
#undef ATT_STORE
#undef ATT_VALID
#undef ATT_KROW0
#pragma unroll
        for (int qt = 0; qt < 4; ++qt) { const float inv = 1.f / lrow[qt];
            bf16 GAS* orow = p.Y3 + (size_t)(qrow0 + 16 * qt + l15) * 1536 + 1024 + hq * 64;
#pragma unroll
            for (int dt = 0; dt < 4; ++dt) { u32x2 w; w.x = pk2(O[dt][qt][0] * inv, O[dt][qt][1] * inv); w.y = pk2(O[dt][qt][2] * inv, O[dt][qt][3] * inv);
                *(u32x2 GAS*)(orow + 16 * dt + 4 * quad) = w; } }
    }
}

#ifndef S5_INTERLEAVE
#define S5_INTERLEAVE 2
#endif
constexpr size_t S5BB_ELEMS = (size_t)2 * 32 * 128 * 32, S5CC_ELEMS = (size_t)2 * 32 * 16 * 128;
__device__ __forceinline__ void s5_tables(const P& p, int l, bf16 GAS* BB, bf16 GAS* CC, float GAS* AB) {
    for (int e = p.bid * NTHR + p.tid; e < 2 * 32 * 64; e += p.G * NTHR) {
        const int d = e >> 11, g = (e >> 6) & 31, pq = e & 63, dg = d * 32 + g;
        S5Lane s; s5_lane_params(p, l, d, g, pq, s, true);
        AB[(size_t)e * 2] = s.abr; AB[(size_t)e * 2 + 1] = s.abi;
                u32x4 GAS* br = (u32x4 GAS*)(BB + ((size_t)dg * 128 + 2 * pq) * 32); u32x4 GAS* bi = (u32x4 GAS*)(BB + ((size_t)dg * 128 + 2 * pq + 1) * 32);
        u32x4 w;
        w.x = pk2(s.bbr[0], s.bbr[1]); w.y = pk2(s.bbr[2], s.bbr[3]); w.z = pk2(s.bbr[4], s.bbr[5]); w.w = pk2(s.bbr[6], s.bbr[7]); br[0] = w;
        w.x = pk2(s.bbr[8], s.bbr[9]); w.y = pk2(s.bbr[10], s.bbr[11]); w.z = pk2(s.bbr[12], s.bbr[13]); w.w = pk2(s.bbr[14], s.bbr[15]); br[1] = w;
        w.x = pk2(s.bbi[0], s.bbi[1]); w.y = pk2(s.bbi[2], s.bbi[3]); w.z = pk2(s.bbi[4], s.bbi[5]); w.w = pk2(s.bbi[6], s.bbi[7]); bi[0] = w;
        w.x = pk2(s.bbi[8], s.bbi[9]); w.y = pk2(s.bbi[10], s.bbi[11]); w.z = pk2(s.bbi[12], s.bbi[13]); w.w = pk2(s.bbi[14], s.bbi[15]); bi[1] = w;
        const u32x4 z = (u32x4){0u, 0u, 0u, 0u}; br[2] = z; br[3] = z; bi[2] = z; bi[3] = z;
        const size_t ci = ((size_t)(l * 2 + d) * 32 + g) * 16;
#pragma unroll
        for (int k = 0; k < 16; ++k) {
#if S5_INTERLEAVE
            *(unsigned GAS*)(CC + ((size_t)dg * 16 + k) * 128 + 2 * pq) = pk2(p.c_re[(ci + k) * 64 + pq], -p.c_im[(ci + k) * 64 + pq]);
#else
            CC[((size_t)dg * 16 + k) * 128 + pq] = (bf16)f2bf(p.c_re[(ci + k) * 64 + pq]); CC[((size_t)dg * 16 + k) * 128 + 64 + pq] = (bf16)f2bf(-p.c_im[(ci + k) * 64 + pq]);
#endif
        }
    }
}
constexpr int S5_WREG = 4096 + 16 * 132 * 4 + 16 * LDP;
template <bool READOUT> __device__ __forceinline__ void s5_chunk_dir(int d, const bf16 GAS* BBdg, const bf16 GAS* CCdg, float abr, float abi, LAS unsigned char* wreg, int lane, float& hr, float& hi, f32x4 (&yacc)[8]) {
    const int quad = lane >> 4, l15 = lane & 15;
    LAS unsigned char* ub = wreg; LAS float* BuW = (LAS float*)(wreg + 4096); LAS unsigned char* Hw = wreg + 4096 + 16 * 132 * 4;
    bf16x8 BBf[8], CCf[4];
#pragma unroll
    for (int pt = 0; pt < 8; ++pt) BBf[pt] = *(const bf16x8 GAS*)(BBdg + (size_t)(16 * pt + l15) * 32 + 8 * quad);
    if (READOUT) {
#pragma unroll
        for (int ks = 0; ks < 4; ++ks) CCf[ks] = *(const bf16x8 GAS*)(CCdg + (size_t)l15 * 128 + ks * 32 + 8 * quad);
    }
#pragma unroll (READOUT ? 8 : 1)
    for (int ss = 0; ss < 8; ++ss) {
        const int sc = d ? 7 - ss : ss;
        bf16x8 uf = (bf16x8){0, 0, 0, 0, 0, 0, 0, 0};
        if (quad < 2) uf = *(const LAS bf16x8*)(ub + (16 * sc + l15) * 32 + quad * 16);
#pragma unroll
        for (int pt = 0; pt < 8; ++pt) { const f32x4 Dp = MFMA16(uf, BBf[pt], ((f32x4){0.f, 0.f, 0.f, 0.f}));
#pragma unroll
            for (int r = 0; r < 4; ++r) BuW[(4 * quad + r) * 132 + 16 * pt + l15] = Dp[r]; }
        LDS_FENCE();
#pragma unroll
        for (int st = 0; st < 16; ++st) { const int tl = d ? 15 - st : st;
#if S5_INTERLEAVE == 1
            typedef float f32x2_t __attribute__((ext_vector_type(2)));
            const f32x2_t bu = *(const LAS f32x2_t*)(BuW + tl * 132 + 2 * lane);
            const float nr = abr * hr - abi * hi + bu[0], ni = abr * hi + abi * hr + bu[1]; hr = nr; hi = ni;
            if (READOUT) *(LAS unsigned*)(Hw + tl * LDP + 4 * lane) = pk2(hr, hi); }
#elif S5_INTERLEAVE == 2
            const float br = BuW[tl * 132 + 2 * lane], bi = BuW[tl * 132 + 2 * lane + 1];
            const float nr = abr * hr - abi * hi + br, ni = abr * hi + abi * hr + bi; hr = nr; hi = ni;
            if (READOUT) *(LAS unsigned*)(Hw + tl * LDP + 4 * lane) = pk2(hr, hi); }
#else
            const float br = BuW[tl * 132 + lane], bi = BuW[tl * 132 + 64 + lane];
            const float nr = abr * hr - abi * hi + br, ni = abr * hi + abi * hr + bi; hr = nr; hi = ni;
            if (READOUT) { st_b16(Hw + tl * LDP + 2 * lane, f2bf(hr)); st_b16(Hw + tl * LDP + 128 + 2 * lane, f2bf(hi)); } }
#endif
        if (READOUT) {
            LDS_FENCE();
#pragma unroll
            for (int ks = 0; ks < 4; ++ks) yacc[sc] = MFMA16(ld_frag(Hw, l15, ks * 32 + 8 * quad, LDP), CCf[ks], yacc[sc]);
        }
        LDS_FENCE();
    }
}
__device__ __forceinline__ void s5_local_states(const P& p, LAS unsigned char* lds, const bf16 GAS* BB, const float GAS* AB, bool ctx_part, int gw, int NGW) {
    LAS unsigned char* wreg = lds + p.wave * S5_WREG;
    const int lane = p.lane;
    const int nit = ctx_part ? 2 * 2 * 32 : 2 * (NCH - 2) * 32;
    for (int it = gw; it < nit; it += NGW) {
        const int d = ctx_part ? (it >> 6) : it / (32 * (NCH - 2)), c = ctx_part ? ((it >> 5) & 1) : 2 + ((it % (32 * (NCH - 2))) >> 5), g = it & 31, dg = d * 32 + g;
        s5_stage_u(p, chunk_r0(d, c), g, wreg, lane);
        float hr = 0.f, hi = 0.f; f32x4 dummy[8];
        const float abr = AB[((size_t)dg * 64 + lane) * 2], abi = AB[((size_t)dg * 64 + lane) * 2 + 1];
        if (d == 0) s5_chunk_dir<false>(0, BB + (size_t)dg * 128 * 32, nullptr, abr, abi, wreg, lane, hr, hi, dummy);
        else s5_chunk_dir<false>(1, BB + (size_t)dg * 128 * 32, nullptr, abr, abi, wreg, lane, hr, hi, dummy);
        float GAS* E = p.S5E + ((size_t)dg * NCH + c) * 128;
        E[lane] = hr; E[64 + lane] = hi;
    }
}
__device__ __forceinline__ void s5_outputs(const P& p, int l, LAS unsigned char* lds, const bf16 GAS* BB, const bf16 GAS* CC, const float GAS* AB, int it_begin, int it_end, int first, int stride) {
    LAS unsigned char* wreg = lds + p.wave * S5_WREG;
    const int lane = p.lane, quad = lane >> 4, l15 = lane & 15;
    for (int it = it_begin + first; it < it_end; it += stride) {
        const int cn = it >> 5, g = it & 31, r0 = 128 * cn;
        s5_stage_u(p, r0, g, wreg, lane);
        f32x4 yacc[8];
#pragma unroll
        for (int i = 0; i < 8; ++i) yacc[i] = (f32x4){0.f, 0.f, 0.f, 0.f};
#pragma unroll
        for (int d = 0; d < 2; ++d) { const int dg = d * 32 + g, cs = scan_chunk_of(d, cn);
            const float GAS* Hn = (cn < 2) ? (p.S5E + (size_t)dg * NCH * 128) : (p.S5H + ((size_t)dg * NCH + cs) * 128);
            float hr = Hn[lane], hi = Hn[64 + lane];
            if (cs == 0) { hr = 0.f; hi = 0.f; }
            s5_chunk_dir<true>(d, BB + (size_t)dg * 128 * 32, CC + (size_t)dg * 16 * 128, AB[((size_t)dg * 64 + lane) * 2], AB[((size_t)dg * 64 + lane) * 2 + 1], wreg, lane, hr, hi, yacc); }
        const float dsk = p.s5_d[(size_t)l * 512 + g * 16 + l15];
#pragma unroll
        for (int sc = 0; sc < 8; ++sc)
#pragma unroll
            for (int r = 0; r < 4; ++r) { const int t = 16 * sc + 4 * quad + r;
                const float u = bf2f(*(const LAS unsigned short*)(wreg + t * 32 + 2 * l15));
                p.SA[(size_t)(r0 + t) * 512 + g * 16 + l15] = (bf16)f2bf(gelu_tanh_f(yacc[sc][r] + dsk * u)); }
        LDS_FENCE();
    }
}

template <int NT, class Epi>
__device__ __forceinline__ void small_gemm(const P& p, LAS unsigned char* lds, const bf16 GAS* A, int lda, const bf16 GAS* Bt, int ldb, int K, int kc_per_seg, const Epi& E, const int GAS* aidx = nullptr) {
    LAS unsigned char* As = lds;
    LAS unsigned char* Bs = lds + 64 * LDP;
    const int tid = p.tid, lane = p.lane, wave = p.wave, quad = lane >> 4, l15 = lane & 15;
    f32x4 acc[NT][4], sum[NT][4];
#pragma unroll
    for (int a = 0; a < NT; ++a)
#pragma unroll
        for (int b = 0; b < 4; ++b) { acc[a][b] = (f32x4){0.f, 0.f, 0.f, 0.f}; sum[a][b] = (f32x4){0.f, 0.f, 0.f, 0.f}; }
    const int nch = K >> 7, prow = tid >> 4, pc = (tid & 15) * 8;
    constexpr int PD = (NT == 1) ? 3 : 2;
    u32x4 ra[PD][2], rb[PD][4 * NT]; int arow[2];
#pragma unroll
    for (int i = 0; i < 2; ++i) arow[i] = aidx ? aidx[prow + 32 * i] : prow + 32 * i;
#define SG_LOAD(s_, kc_) { _Pragma("unroll") for (int i = 0; i < 2; ++i) ra[s_][i] = *(const u32x4 GAS*)(A + (size_t)arow[i] * lda + (kc_) * 128 + pc); \
        _Pragma("unroll") for (int i = 0; i < 4 * NT; ++i) rb[s_][i] = *(const u32x4 GAS*)(Bt + (size_t)(prow + 32 * i) * ldb + (kc_) * 128 + pc); }
#pragma unroll
    for (int s0 = 0; s0 < PD - 1; ++s0) SG_LOAD(s0, s0)
    for (int kc0 = 0; kc0 < nch; kc0 += PD) {
#pragma unroll
        for (int s0 = 0; s0 < PD; ++s0) { const int kc = kc0 + s0; if (kc >= nch) break;
            __syncthreads();
#pragma unroll
            for (int i = 0; i < 2; ++i) *(LAS u32x4*)(As + (prow + 32 * i) * LDP + pc * 2) = ra[s0][i];
#pragma unroll
            for (int i = 0; i < 4 * NT; ++i) *(LAS u32x4*)(Bs + (prow + 32 * i) * LDP + pc * 2) = rb[s0][i];
            __syncthreads();
            if (kc + PD - 1 < nch) SG_LOAD((s0 + PD - 1) % PD, kc + PD - 1)
#pragma unroll
            for (int ks = 0; ks < 4; ++ks) {
                bf16x8 af[4];
#pragma unroll
                for (int mt = 0; mt < 4; ++mt) af[mt] = ld_frag(As, 16 * mt + l15, ks * 32 + 8 * quad, LDP);
#pragma unroll
                for (int nt = 0; nt < NT; ++nt) { const bf16x8 bfr = ld_frag(Bs, 128 * nt + 16 * wave + l15, ks * 32 + 8 * quad, LDP);
#pragma unroll
                    for (int mt = 0; mt < 4; ++mt) acc[nt][mt] = MFMA16(af[mt], bfr, acc[nt][mt]); }
            }
            if ((kc + 1) % kc_per_seg == 0) E.seg(acc, sum, kc / kc_per_seg, wave, quad, l15);
        }
    }
#undef SG_LOAD
    E.fin(acc, sum, wave, quad, l15);
    __syncthreads();
}
struct SgMerge {
    const bf16 GAS* proj; bf16 GAS* MB; int rb, cc;
    __device__ __forceinline__ void seg(f32x4 (&acc)[1][4], f32x4 (&sum)[1][4], int s, int wave, int quad, int l15) const {
        unsigned gr[4][4];
#pragma unroll
        for (int mt = 0; mt < 4; ++mt)
#pragma unroll
            for (int r = 0; r < 4; ++r) { const int row = rb * 64 + 16 * mt + 4 * quad + r, col = cc * 128 + 16 * wave + l15; gr[mt][r] = proj[(size_t)row * PJ + GT0 + s * 1024 + col]; }
        __builtin_amdgcn_sched_barrier(0);
#pragma unroll
        for (int mt = 0; mt < 4; ++mt)
#pragma unroll
            for (int r = 0; r < 4; ++r) { sum[0][mt][r] += bf2f(gr[mt][r]) * acc[0][mt][r]; acc[0][mt][r] = 0.f; }
    }
    __device__ __forceinline__ void fin(f32x4 (&acc)[1][4], f32x4 (&sum)[1][4], int wave, int quad, int l15) const {
#pragma unroll
        for (int mt = 0; mt < 4; ++mt)
#pragma unroll
            for (int r = 0; r < 4; ++r) MB[(size_t)(rb * 64 + 16 * mt + 4 * quad + r) * 1024 + cc * 128 + 16 * wave + l15] = (bf16)f2bf(sum[0][mt][r]);
    }
};
struct SgResid {
    float GAS* XC; const float GAS* g; int rb, cc;
    __device__ __forceinline__ void seg(f32x4 (&)[1][4], f32x4 (&)[1][4], int, int, int, int) const {}
    __device__ __forceinline__ void fin(f32x4 (&acc)[1][4], f32x4 (&)[1][4], int wave, int quad, int l15) const {
        const int col = cc * 128 + 16 * wave + l15; const float gv = g[col];
        float xv[4][4];
#pragma unroll
        for (int mt = 0; mt < 4; ++mt)
#pragma unroll
            for (int r = 0; r < 4; ++r) xv[mt][r] = XC[(size_t)(rb * 64 + 16 * mt + 4 * quad + r) * 1024 + col];
#pragma unroll
        for (int mt = 0; mt < 4; ++mt)
#pragma unroll
            for (int r = 0; r < 4; ++r) XC[(size_t)(rb * 64 + 16 * mt + 4 * quad + r) * 1024 + col] = xv[mt][r] + gv * acc[0][mt][r];
    }
};
struct SgSwiGlu {
    bf16 GAS* HID; int row0, t;
    __device__ __forceinline__ void seg(f32x4 (&)[2][4], f32x4 (&)[2][4], int, int, int, int) const {}
    __device__ __forceinline__ void fin(f32x4 (&acc)[2][4], f32x4 (&)[2][4], int wave, int quad, int l15) const {
#pragma unroll
        for (int mt = 0; mt < 4; ++mt)
#pragma unroll
            for (int r = 0; r < 4; ++r) HID[(size_t)(row0 + 16 * mt + 4 * quad + r) * 1024 + 128 * t + 16 * wave + l15] = (bf16)f2bf(silu_f(acc[0][mt][r]) * acc[1][mt][r]);
    }
};
struct SgDown {
    bf16 GAS* YE; const float GAS* gsel; int row0, cc;
    __device__ __forceinline__ void seg(f32x4 (&)[1][4], f32x4 (&)[1][4], int, int, int, int) const {}
    __device__ __forceinline__ void fin(f32x4 (&acc)[1][4], f32x4 (&)[1][4], int wave, int quad, int l15) const {
        float gq[4][4];
#pragma unroll
        for (int mt = 0; mt < 4; ++mt)
#pragma unroll
            for (int r = 0; r < 4; ++r) gq[mt][r] = gsel[row0 + 16 * mt + 4 * quad + r];
#pragma unroll
        for (int mt = 0; mt < 4; ++mt)
#pragma unroll
            for (int r = 0; r < 4; ++r) { const int row = row0 + 16 * mt + 4 * quad + r; YE[(size_t)row * 1024 + cc * 128 + 16 * wave + l15] = (bf16)f2bf(acc[0][mt][r] * gq[mt][r]); }
    }
};

#ifndef SKIPMASK
#define SKIPMASK 0
#endif
struct Args { const float* in[33]; float* out; unsigned char* ws; int ph_lo, ph_hi; };
static_assert(sizeof(Args) == 35 * 8 + 8, "no padding");

__global__ void __launch_bounds__(NTHR, 2) fwd_kernel(Args args) {
    extern __shared__ __attribute__((aligned(16))) unsigned char lds_raw[];
    LAS unsigned char* lds = (LAS unsigned char*)lds_raw;
    const int tid_ = threadIdx.x;
    const int wave_s = __builtin_amdgcn_readfirstlane(tid_ >> 6);
    if (tid_ == 0) {
        LAS unsigned long long* tab = (LAS unsigned long long*)(lds + PTAB_OFF);
#pragma unroll
        for (int k = 0; k < 33; ++k) tab[k] = (unsigned long long)args.in[k];
        tab[33] = (unsigned long long)args.out; tab[34] = (unsigned long long)args.ws;
    }
    volatile LAS unsigned* MISC = (volatile LAS unsigned*)(lds + MISC_OFF);
    if (tid_ < 64) MISC[tid_] = 0u;
    __syncthreads();
    XcdBarrier bar; bar.bar = (unsigned GAS*)(args.ws + WS_CTL) + CW_BAR; bar.x = 0; bar.st = nullptr;
    if (!MK_PER_PHASE) bar = xcd_barrier_post((unsigned GAS*)(args.ws + WS_CTL) + CW_BAR, MISC + 8);

    const int lo = args.ph_lo, hi = args.ph_hi;
#define IN(k) (lo <= (k) && (k) < hi)
#define SEAM(k) do { if (!MK_PER_PHASE && (k) + 1 < hi) xcd_barrier(bar, wave_s); } while (0)

    if (IN(0)) { P p; build_P(p, lds, 0, wave_s); phase_mod(p, lds, (float GAS*)(args.ws + WS_ROPE)); __syncthreads(); convert_weights(p, 0, 0, lds, p.bid * NWAVES + p.wave, p.G * NWAVES, 0, CVT_NE); SEAM(0); }

#ifndef REPSUB
#define REPSUB 0
#endif
#define RSUB(b, ...) for (int r2_ = 0; r2_ <= ((REPSUB >> (b)) & 1); ++r2_) { __VA_ARGS__; __syncthreads(); }
#ifndef REPMASK
#define REPMASK 0
#endif
#define PHASE(k, ...) if (!((SKIPMASK >> (k)) & 1) && IN(pb + (k))) { for (int rep_ = 0; rep_ <= ((REPMASK >> (k)) & 1); ++rep_) { P p; build_P(p, lds, l & 1, wave_s); __VA_ARGS__; \
        if (rep_ < ((REPMASK >> (k)) & 1)) xcd_barrier(bar, wave_s); } SEAM(pb + (k)); }
    for (int l = 0; l < DEPTH; ++l) {
        const int pb = 1 + NPH_LAYER * l;
        const bool cx = l < DEPTH - 1;
        unsigned char GAS* wsb; { unsigned tb_ = (unsigned)(size_t)(lds + PTAB_OFF); asm volatile("" : "+s"(tb_)); wsb = (unsigned char GAS*)ld_tab((volatile LAS unsigned*)(size_t)tb_, 34); }
        PHASE(0, s5_tables(p, l, (bf16 GAS*)(wsb + WS_S5BB), (bf16 GAS*)(wsb + WS_S5CC), (float GAS*)(wsb + WS_S5AB)); __syncthreads(); row_pass<0>(p, l, lds, true, rep_ < ((REPMASK >> 0) & 1)))
        PHASE(1, pg8::Gemm g{p.H, p.WIN, T, PJ, D}; pg8::StaticOrder S; S.init(T, PJ, p.G, p.bid); pg8::EpiStoreBf16 E{p.PROJ, PJ, GT0 / 256, (const float GAS*)(wsb + WS_ROPE)};
            pg8::gemm_phase<pg8::EpiStoreBf16, pg8::StaticOrder, false>(lds, g, S, E, nullptr, p.wave))
        PHASE(2, RSUB(2, phase_premix(p, l, lds)) RSUB(3, s5_local_states(p, lds, (const bf16 GAS*)(wsb + WS_S5BB), (const float GAS*)(wsb + WS_S5AB), false, p.vcu * NWAVES + p.wave, p.G * NWAVES)))
        PHASE(3, { const int lo5 = (p.G >= 24) ? 8 : 0, nw5 = (p.G >= 24) ? 16 : p.G;
              if (p.vcu >= lo5 && p.vcu < lo5 + nw5) s5_local_states(p, lds, (const bf16 GAS*)(wsb + WS_S5BB), (const float GAS*)(wsb + WS_S5AB), true, (p.vcu - lo5) * NWAVES + p.wave, nw5 * NWAVES);
              __syncthreads(); }
            RSUB(0, ssd_states(p, l, lds, (bf16 GAS*)(wsb + WS_SST), (float GAS*)(wsb + WS_DEC))) RSUB(1, attention_mfma(p, l, lds, 4, 2 * NCH, p.vcu, p.G)))
        PHASE(4, if (cx) { if (p.bid >= p.G - 4) attention_mfma(p, l, lds, 0, 4, p.bid - (p.G - 4), 4);
                else if (p.bid >= p.G - 20) ssd_outputs(p, l, lds, (const bf16 GAS*)(wsb + WS_HIN), (const bf16 GAS*)(wsb + WS_SST), (bf16 GAS*)(wsb + WS_YS), 0, 16, p.bid - (p.G - 20), 16);
                else if (p.bid >= p.G - 28) s5_outputs(p, l, lds, (const bf16 GAS*)(wsb + WS_S5BB), (const bf16 GAS*)(wsb + WS_S5CC), (const float GAS*)(wsb + WS_S5AB), 0, 64, (p.bid - (p.G - 28)) * NWAVES + p.wave, 64); }
            scan_carries(p, l, lds, (const bf16 GAS*)(wsb + WS_SST), (const float GAS*)(wsb + WS_DEC), (bf16 GAS*)(wsb + WS_HIN)))
        PHASE(5, RSUB(4, ssd_outputs(p, l, lds, (const bf16 GAS*)(wsb + WS_HIN), (const bf16 GAS*)(wsb + WS_SST), (bf16 GAS*)(wsb + WS_YS), 16, NCH * 8, p.vcu, p.G))
            RSUB(5, s5_outputs(p, l, lds, (const bf16 GAS*)(wsb + WS_S5BB), (const bf16 GAS*)(wsb + WS_S5CC), (const float GAS*)(wsb + WS_S5AB), 64, 32 * NCH, p.vcu * NWAVES + p.wave, p.G * NWAVES)))
        PHASE(6, pg8::Gemm g{p.SA, p.WGLU, T, 512, 512}; pg8::RowOffOrder S; S.init(cx ? T : NLAT, 512, p.G, p.bid, cx ? 0 : 1); pg8::EpiGlu E{p.SA, p.b_glu + (size_t)l * 512, p.Y3};
            pg8::gemm_phase<pg8::EpiGlu, pg8::RowOffOrder, false>(lds, g, S, E, nullptr, p.wave); ssd_gated_norm(p, l, (const bf16 GAS*)(wsb + WS_YS), (cx ? T : NLAT) / 256 * 2 < p.G ? (cx ? T : NLAT) / 256 * 2 : p.G))
        PHASE(7, pg8::Gemm g{p.Y3, p.WBR, T, D, 1536}; pg8::RowOffOrder S; S.init(NLAT, D, p.G, p.bid, 1); pg8::EpiMerge E{p.PROJ, p.MB};
            pg8::gemm_phase<pg8::EpiMerge, pg8::RowOffOrder, false>(lds, g, S, E, nullptr, p.wave);
            if (cx) for (int it = p.bid; it < 32; it += p.G) { const SgMerge e{p.PROJ, p.MB, it >> 3, it & 7};
                small_gemm<1, SgMerge>(p, lds, p.Y3 + (size_t)(it >> 3) * 64 * 1536, 1536, p.WBR + (size_t)(it & 7) * 128 * 1536, 1536, 1536, 4, e); })
        PHASE(8, pg8::Gemm g{p.MB, p.WOUT, T, D, D}; pg8::RowOffOrder S; S.init(NLAT, D, p.G, p.bid, 1);
            const bool dry8 = rep_ < ((REPMASK >> 8) & 1);
            pg8::EpiResid E{dry8 ? p.PM + (size_t)NCTX * D : p.XL, dry8 ? p.PM : p.XC, p.MOD + (size_t)(l * 2 + 0) * 6144 + 2 * D, p.MOD + (size_t)(l * 2 + 1) * 6144 + 2 * D};
            pg8::gemm_phase<pg8::EpiResid, pg8::RowOffOrder, false>(lds, g, S, E, nullptr, p.wave);
            if (cx) for (int it = p.bid; it < 32; it += p.G) { const SgResid e{dry8 ? p.PM : p.XC, p.MOD + (size_t)(l * 2 + 1) * 6144 + 2 * D, it >> 3, it & 7};
                small_gemm<1, SgResid>(p, lds, p.MB + (size_t)(it >> 3) * 64 * 1024, 1024, p.WOUT + (size_t)(it & 7) * 128 * 1024, 1024, 1024, 8, e); })
        PHASE(9, row_pass<1>(p, l, lds, cx))
        PHASE(10, { const int nsel = cx ? 32 : 16; if (p.bid < nsel) phase_select(p, lds, cx);
            else { P q; build_P(q, lds, (l + 1) & 1, wave_s); q.WUP = p.WUP; q.WDN = p.WDN;
                convert_weights(q, l + 1, l, lds, (p.bid - nsel) * NWAVES + p.wave, (p.G - nsel) * NWAVES, (l + 1 < DEPTH) ? 0 : CVT_NE, CVT_ALL); } })
        PHASE(12, pg8::Gemm g{p.H, p.WUP, NE * ESLOTS, NE * 2048, D}; pg8::ExpertOrderT<true> S{p.G, p.bid, 8, 8, p.IDX}; pg8::EpiSwiGlu E{p.HID};
            pg8::gemm_phase<pg8::EpiSwiGlu, pg8::ExpertOrderT<true>, false>(lds, g, S, E, nullptr, p.wave);
            if (cx) for (int it = p.bid; it < NE * 8; it += p.G) { const int e = it >> 3, t = it & 7; const SgSwiGlu ep{p.HID, e * ESLOTS + CAP_L, t};
                small_gemm<2, SgSwiGlu>(p, lds, p.H, 1024, p.WUP + (size_t)(e * 2048 + 256 * t) * 1024, 1024, 1024, 8, ep, p.IDX + e * ESLOTS + CAP_L); })
        PHASE(13, pg8::Gemm g{p.HID, p.WDN, NE * ESLOTS, NE * 1024, D}; pg8::ExpertOrderT<false> S{p.G, p.bid, 4, 8, nullptr}; pg8::EpiDown E{p.YE, p.GSEL};
            pg8::gemm_phase<pg8::EpiDown, pg8::ExpertOrderT<false>, false>(lds, g, S, E, nullptr, p.wave);
            if (cx) for (int it = p.bid; it < NE * 8; it += p.G) { const int e = it >> 3, cc = it & 7; const SgDown ep{p.YE, p.GSEL, e * ESLOTS + CAP_L, cc};
                small_gemm<1, SgDown>(p, lds, p.HID + (size_t)(e * ESLOTS + CAP_L) * 1024, 1024, p.WDN + (size_t)(e * 1024 + 128 * cc) * 1024, 1024, 1024, 8, ep); })
    }
    if (IN(NPHASES - 1)) { P p; build_P(p, lds, 0, wave_s); row_pass<2>(p, 0, lds); }
#undef IN
#undef SEAM
}

extern "C" void kernel_launch(void* const* d_in, const int* in_sizes, int n_in, void* d_out, int out_size, void* d_ws, size_t ws_size, hipStream_t stream) {
    static int grid = 0;
    if (grid == 0) {
        if (n_in != 33 || out_size != NLAT * D || ws_size < WS_END) { fprintf(stderr, "kernel_launch: unexpected shapes: n_in %d out %d ws %zu (need %zu)\n", n_in, out_size, ws_size, (size_t)WS_END); grid = -1; return; }
        int dev = 0, cus = 0, per_cu = 0;
        if (hipGetDevice(&dev) != hipSuccess || hipDeviceGetAttribute(&cus, hipDeviceAttributeMultiprocessorCount, dev) != hipSuccess) { grid = -1; return; }
        if (hipFuncSetAttribute((const void*)fwd_kernel, hipFuncAttributeMaxDynamicSharedMemorySize, LDS_BYTES) != hipSuccess) { fprintf(stderr, "kernel_launch: hipFuncSetAttribute failed\n"); grid = -1; return; }
        if (hipOccupancyMaxActiveBlocksPerMultiprocessor(&per_cu, (const void*)fwd_kernel, NTHR, LDS_BYTES) != hipSuccess || per_cu < 1) { fprintf(stderr, "kernel_launch: occupancy query says %d\n", per_cu); (void)hipGetLastError(); }
        grid = cus;
    }
    if (grid < 0) return;
    (void)hipMemsetAsync((char*)d_ws + WS_CTL, 0, CTL_BYTES, stream);
    Args a{};
    for (int i = 0; i < 33; ++i) a.in[i] = (const float*)d_in[i];
    a.out = (float*)d_out; a.ws = (unsigned char*)d_ws;
#if MK_PER_PHASE
    for (int ph = 0; ph < NPHASES; ++ph) { a.ph_lo = ph; a.ph_hi = ph + 1; hipLaunchKernelGGL(fwd_kernel, dim3(grid), dim3(NTHR), LDS_BYTES, stream, a); }
#else
    a.ph_lo = 0; a.ph_hi = NPHASES;
    hipLaunchKernelGGL(fwd_kernel, dim3(grid), dim3(NTHR), LDS_BYTES, stream, a);
#endif
}
```

```cpp
#include <hip/hip_runtime.h>
#include <cstdio>
#include <cstdint>

#ifndef MK_PER_PHASE
#define MK_PER_PHASE 0
#endif

namespace pg8 {
#define PG8_LAS __attribute__((address_space(3)))
typedef unsigned short bf16_t;
typedef short bf16x8 __attribute__((ext_vector_type(8)));
typedef float f32x4 __attribute__((ext_vector_type(4)));
typedef unsigned u32x4 __attribute__((ext_vector_type(4)));
constexpr int BM = 256, BK = 64, HALF = 128, HTB = HALF * BK * 2  , STAGE_BYTES = 8 * HTB, NXCD = 8, WGM = 8;

__host__ __device__ __forceinline__ int lds_byte(int r, int c) { const int st = (r >> 4) * 2 + (c >> 5), rr = r & 15, cc = c & 31, ob = rr * 64 + cc * 2; return st * 1024 + (ob ^ (((ob >> 9) & 1) << 5)); }
__host__ __device__ __forceinline__ void stage_rc(int b, int& R, int& C) { const int st = b / 1024, sb = b % 1024, swz = sb ^ (((sb >> 9) & 1) << 5); R = (st >> 1) * 16 + swz / 64; C = (st & 1) * 32 + (swz % 64) / 2; }
__host__ __device__ __forceinline__ int perm32(int rho) { const int n = rho >> 4, i = rho & 15; return 8 * (i >> 2) + 4 * n + (i & 3); }

struct Unit { int pm, pn; };
struct Gemm { const bf16_t __attribute__((address_space(1)))* A; const bf16_t __attribute__((address_space(1)))* Bt; int M, N, K; };

struct StaticOrder {
    static constexpr bool GATHER = false;
    int nM, nN, nwg, G, c;
    __host__ __device__ void init(int M, int N, int G_, int c_) { nM = M / BM; nN = N / BM; nwg = nM * nN; G = G_; c = c_; }
    __host__ __device__ bool next(int i, Unit& u) const {
        const long L = (long)i * G + c; if (L >= nwg) return false;
        int wgid = (int)L; { const int q = nwg / NXCD, r = nwg % NXCD, xcd = wgid % NXCD, off = wgid / NXCD; wgid = (xcd < r ? xcd * (q + 1) : r * (q + 1) + (xcd - r) * q) + off; }
        const int nig = WGM * nN, gid = wgid / nig, fm = gid * WGM, gsz = (nM - fm) < WGM ? (nM - fm) : WGM;
        u.pm = fm + ((wgid % nig) % gsz); u.pn = (wgid % nig) / gsz; return true;
    }
    __device__ __forceinline__ void a_ready(const Unit&) const {}
    __device__ __forceinline__ void done(const Unit&) const {}
};
__device__ __forceinline__ int tid_of(int wave_s) { int w = wave_s; asm volatile("" : "+s"(w)); return w * 64 + (int)__builtin_amdgcn_mbcnt_hi(~0u, __builtin_amdgcn_mbcnt_lo(~0u, 0u)); }
__device__ __forceinline__ unsigned cvt_pk_bf16(float lo, float hi) { unsigned r; asm volatile("v_cvt_pk_bf16_f32 %0, %1, %2" : "=v"(r) : "v"(lo), "v"(hi)); return r; }
template <class Epi, class Sched, bool STAMP = false>
__device__ __forceinline__ void gemm_phase(PG8_LAS unsigned char* lds, const Gemm g, const Sched& S, const Epi& E, unsigned long long* stamps, int wave_s) {
    int tid_l = tid_of(wave_s); asm volatile("" : "+v"(tid_l));
    const int tid = tid_l, wid = __builtin_amdgcn_readfirstlane(tid >> 6), lane = tid & 63, wr = wid >> 2, wc = wid & 3, fr = lane & 15, fq = lane >> 4;
    const int K = g.K, nt = K / BK;
    int ts_lo = 0, ts_hi = 0, nts = 0; const unsigned long long rt_entry = STAMP ? (unsigned long long)wall_clock64() : 0ull;
#define PG8_STAMP() do { if (STAMP && wid == 0 && nts < 64) { const unsigned long long _c = (unsigned long long)clock64(); \
        ts_lo = (lane == nts) ? (int)(unsigned)_c : ts_lo; ts_hi = (lane == nts) ? (int)(unsigned)(_c >> 32) : ts_hi; ++nts; } } while (0)
    PG8_STAMP();
    unsigned voffA[2], voffB[2]; int rA[2], cAo[2];
#pragma unroll
    for (int i = 0; i < 2; ++i) { int R, C; stage_rc(tid * 16 + i * 8192, R, C); const int Rb = Epi::PERM ? ((R & ~31) + perm32(R & 31)) : R;
        voffA[i] = (unsigned)(R * K + C) * 2u; voffB[i] = (unsigned)(Rb * K + C) * 2u; rA[i] = R; cAo[i] = C; }
    const size_t kstep = (size_t)(BK * 2);
    const size_t hstep = (size_t)HALF * K * 2;
    const size_t tstep = 2 * hstep;
    const unsigned ldsw = (unsigned)wid * 1024u;
    const int aoff = lds_byte(wr * 64 + fr, fq * 8), boff = lds_byte(wc * 32 + fr, fq * 8);
#define PG8_SA(b, h) (((b) * 2 + (h)) * HTB)
#define PG8_SB(b, h) ((4 + (b) * 2 + (h)) * HTB)
#define PG8_STAGE(bufoff, gbase, voff) do { _Pragma("unroll") for (int _i = 0; _i < 2; ++_i) \
        __builtin_amdgcn_global_load_lds((const unsigned*)((const char*)(gbase) + (voff)[_i]), (PG8_LAS unsigned*)(lds + (bufoff) + ldsw + _i * 8192), 16, 0, 0); } while (0)
#define PG8_LDA(dst, b, h) do { _Pragma("unroll") for (int m = 0; m < 4; ++m) _Pragma("unroll") for (int k = 0; k < 2; ++k) dst[m][k] = *(const PG8_LAS bf16x8*)(lds + PG8_SA(b, h) + aoff + m * 2048 + k * 1024); } while (0)
#define PG8_LDB(dst, b, h) do { _Pragma("unroll") for (int n = 0; n < 2; ++n) _Pragma("unroll") for (int k = 0; k < 2; ++k) dst[n][k] = *(const PG8_LAS bf16x8*)(lds + PG8_SB(b, h) + boff + n * 2048 + k * 1024); } while (0)
#define PG8_MMA(ai, bj, At, Bt) do { __builtin_amdgcn_s_setprio(1); _Pragma("unroll") for (int m = 0; m < 4; ++m) _Pragma("unroll") for (int n = 0; n < 2; ++n) _Pragma("unroll") for (int k = 0; k < 2; ++k) \
        acc[ai][bj][m][n] = __builtin_amdgcn_mfma_f32_16x16x32_bf16(Bt[n][k], At[m][k], acc[ai][bj][m][n], 0, 0, 0); __builtin_amdgcn_s_setprio(0); } while (0)
#define PG8_WAIT_V(n) asm volatile("s_waitcnt vmcnt(" #n ")" ::: "memory")
#define PG8_WAIT_L(n) asm volatile("s_waitcnt lgkmcnt(" #n ")" ::: "memory")
#define PG8_BAR __builtin_amdgcn_s_barrier()
#define PG8_SCHED __builtin_amdgcn_sched_barrier(0)
    Unit cur, nxt; int ui = 0;
    if (!S.next(0, cur)) return;
    f32x4 acc[2][2][4][2];
#pragma unroll
    for (int a = 0; a < 2; ++a)
#pragma unroll
        for (int b = 0; b < 2; ++b)
#pragma unroll
            for (int m = 0; m < 4; ++m)
#pragma unroll
                for (int n = 0; n < 2; ++n) acc[a][b][m][n] = (f32x4){0.f, 0.f, 0.f, 0.f};
    bf16x8 At[4][2], B0[2][2], B1[2][2];
    unsigned vAc[2][2], vAn[2][2];
#pragma unroll
    for (int h = 0; h < 2; ++h)
#pragma unroll
        for (int i = 0; i < 2; ++i) { if constexpr (Sched::GATHER) vAc[h][i] = (unsigned)S.arow(cur, h * HALF + rA[i]); else vAc[h][i] = voffA[i] + (unsigned)(h * hstep); }
    if constexpr (Sched::GATHER) { __builtin_amdgcn_sched_barrier(0);
#pragma unroll
        for (int h = 0; h < 2; ++h)
#pragma unroll
            for (int i = 0; i < 2; ++i) vAc[h][i] = (vAc[h][i] * (unsigned)K + (unsigned)cAo[i]) * 2u; }
#pragma unroll
    for (int h = 0; h < 2; ++h)
#pragma unroll
        for (int i = 0; i < 2; ++i) vAn[h][i] = vAc[h][i];
    if constexpr (Sched::GATHER) { asm volatile("s_waitcnt vmcnt(0)" ::: "memory"); }
    const char* cA = (const char*)g.A + (Sched::GATHER ? (size_t)0 : (size_t)cur.pm * tstep); const char* cB = (const char*)g.Bt + (size_t)cur.pn * tstep;
    S.a_ready(cur);
    PG8_STAGE(PG8_SB(0, 0), cB, voffB); PG8_STAGE(PG8_SA(0, 0), cA, vAc[0]); PG8_STAGE(PG8_SB(0, 1), cB + hstep, voffB); PG8_STAGE(PG8_SA(0, 1), cA, vAc[1]);
    if (wr == 1) PG8_BAR;
    PG8_WAIT_V(4); PG8_BAR;
    PG8_STAGE(PG8_SB(1, 0), cB + kstep, voffB); PG8_STAGE(PG8_SA(1, 0), cA + kstep, vAc[0]); PG8_STAGE(PG8_SB(1, 1), cB + hstep + kstep, voffB);
    PG8_WAIT_V(6); PG8_BAR;
    PG8_STAMP();
    for (;;) {
        const bool has_next = S.next(ui + 1, nxt);
        const char* nA = (has_next && !Sched::GATHER) ? (const char*)g.A + (size_t)nxt.pm * tstep : cA; const char* nB = has_next ? (const char*)g.Bt + (size_t)nxt.pn * tstep : cB;
        if constexpr (Sched::GATHER) { if (has_next) {
#pragma unroll
            for (int h = 0; h < 2; ++h)
#pragma unroll
                for (int i = 0; i < 2; ++i) vAn[h][i] = (unsigned)S.arow(nxt, h * HALF + rA[i]); } }
        for (int t = 0; t < nt; t += 2) {
            const bool last = (t == nt - 2);
            const char* a1 = cA + (size_t)(t + 1) * kstep;
            const char* a2 = last ? nA : cA + (size_t)(t + 2) * kstep; const char* b2 = last ? nB : cB + (size_t)(t + 2) * kstep;
            const char* a3 = a2 + kstep; const char* b3 = b2 + kstep;
            unsigned vs0[2], vs1[2];
#pragma unroll
            for (int i = 0; i < 2; ++i) { vs0[i] = vAc[0][i]; vs1[i] = vAc[1][i]; }
            if (last) { asm volatile("" ::: "memory");
#pragma unroll
                for (int i = 0; i < 2; ++i) { if constexpr (Sched::GATHER) { if (has_next) { vAn[0][i] = (vAn[0][i] * (unsigned)K + (unsigned)cAo[i]) * 2u; vAn[1][i] = (vAn[1][i] * (unsigned)K + (unsigned)cAo[i]) * 2u; } }
                    vs0[i] = vAn[0][i]; vs1[i] = vAn[1][i]; } }
            if (last && has_next) S.a_ready(nxt);
            if constexpr (Epi::MIDHOOK) { if (t == 8 || t == 16) E.mid(acc, cur, t >> 3, wr, wc, fr, fq); }
            PG8_LDB(B0, 0, 0); PG8_SCHED; PG8_LDA(At, 0, 0); PG8_STAGE(PG8_SA(1, 1), a1, vAc[1]);
            PG8_WAIT_L(8); PG8_BAR; PG8_WAIT_L(0); PG8_MMA(0, 0, At, B0); PG8_BAR; PG8_SCHED;
            PG8_LDB(B1, 0, 1); PG8_STAGE(PG8_SB(0, 0), b2, voffB);
            PG8_BAR; PG8_WAIT_L(0); PG8_MMA(0, 1, At, B1); PG8_BAR;
            PG8_LDA(At, 0, 1); PG8_STAGE(PG8_SA(0, 0), a2, vs0);
            PG8_BAR; PG8_WAIT_L(0); PG8_MMA(1, 0, At, B0); PG8_BAR; PG8_SCHED;
            PG8_STAGE(PG8_SB(0, 1), b2 + hstep, voffB);
            PG8_WAIT_V(6); PG8_BAR; PG8_MMA(1, 1, At, B1); PG8_BAR;
            PG8_LDB(B0, 1, 0); PG8_SCHED; PG8_LDA(At, 1, 0); PG8_STAGE(PG8_SA(0, 1), a2, vs1);
            PG8_WAIT_L(8); PG8_BAR; PG8_WAIT_L(0); PG8_MMA(0, 0, At, B0); PG8_BAR; PG8_SCHED;
            PG8_LDB(B1, 1, 1); PG8_STAGE(PG8_SB(1, 0), b3, voffB);
            PG8_BAR; PG8_WAIT_L(0); PG8_MMA(0, 1, At, B1); PG8_BAR;
            PG8_LDA(At, 1, 1); PG8_STAGE(PG8_SA(1, 0), a3, vs0);
            PG8_BAR; PG8_WAIT_L(0); PG8_MMA(1, 0, At, B0); PG8_BAR; PG8_SCHED;
            PG8_STAGE(PG8_SB(1, 1), b3 + hstep, voffB);
            PG8_WAIT_V(6); PG8_BAR; PG8_MMA(1, 1, At, B1); PG8_BAR;
        }
        PG8_STAMP();
        if constexpr (!Epi::AFTER_DRAIN) { E(acc, cur, wr, wc, fr, fq); S.done(cur); }
        PG8_STAMP();
        if (!has_next) break;
#pragma unroll
        for (int a = 0; a < 2; ++a)
#pragma unroll
            for (int b = 0; b < 2; ++b)
#pragma unroll
                for (int m = 0; m < 4; ++m)
#pragma unroll
                    for (int n = 0; n < 2; ++n) acc[a][b][m][n] = (f32x4){0.f, 0.f, 0.f, 0.f};
        cur = nxt; cA = nA; cB = nB; ++ui;
#pragma unroll
        for (int h = 0; h < 2; ++h)
#pragma unroll
            for (int i = 0; i < 2; ++i) vAc[h][i] = vAn[h][i];
    }
    PG8_WAIT_V(0);
    if (wr == 0) PG8_BAR;
    PG8_BAR;
    if constexpr (Epi::AFTER_DRAIN) { E.fused(acc, cur, wr, wc, fr, fq, lds, wid, lane); S.done(cur); }
    PG8_STAMP();
    if (STAMP && wid == 0) { stamps[lane] = lane < nts ? (((unsigned long long)(unsigned)ts_hi << 32) | (unsigned)ts_lo) : 0ull;
        if (lane == 62) stamps[62] = rt_entry; if (lane == 63) stamps[63] = (unsigned long long)wall_clock64(); }
#undef PG8_STAMP
#undef PG8_SA
#undef PG8_SB
#undef PG8_STAGE
#undef PG8_LDA
#undef PG8_LDB
#undef PG8_MMA
#undef PG8_WAIT_V
#undef PG8_WAIT_L
#undef PG8_BAR
#undef PG8_SCHED
}
}

#define GAS __attribute__((address_space(1)))
#define LAS __attribute__((address_space(3)))
typedef unsigned short bf16;
typedef float f32x4 __attribute__((ext_vector_type(4)));
typedef unsigned u32x4 __attribute__((ext_vector_type(4)));
typedef unsigned u32x2 __attribute__((ext_vector_type(2)));

constexpr int D = 1024, NLAT = 16384, NCTX = 256, T = NLAT + NCTX, DEPTH = 4;
constexpr int IN_W = 5904, PJ = 5888;
constexpr int U0 = 0, Z0 = 512, XB0 = 1024, Q0 = 2048, K0 = 2560, V0 = 2688, GT0 = 2816;
constexpr int NE = 16, ESLOTS = 2304, CAP_L = 2048, CAP_C = 32;
constexpr int NCH = 130;
constexpr float EPS = 1e-6f;
constexpr int NWAVES = 8, NTHR = 512;
constexpr int LDS_BYTES = 155648;
constexpr int MISC_OFF = LDS_BYTES - 1024 + 512;
constexpr int NPH_LAYER = 14, NPHASES = 1 + DEPTH * NPH_LAYER + 1;

constexpr size_t al256(size_t x) { return (x + 255) & ~(size_t)255; }
constexpr size_t WS_CTL = 0, CTL_BYTES = 1u << 20;
constexpr size_t WS_MOD = WS_CTL + CTL_BYTES;
constexpr size_t WS_XC = al256(WS_MOD + (size_t)DEPTH * 2 * 6144 * 4);
constexpr size_t WS_WIN = al256(WS_XC + (size_t)NCTX * D * 4);
constexpr size_t WS_WGLU = al256(WS_WIN + (size_t)PJ * D * 2);
constexpr size_t WS_WBR = al256(WS_WGLU + (size_t)512 * 512 * 2);
constexpr size_t WS_WOUT = al256(WS_WBR + (size_t)3 * 1024 * 512 * 2);
constexpr size_t WS_WUP = al256(WS_WOUT + (size_t)1024 * 1024 * 2);
constexpr size_t WS_WDN = al256(WS_WUP + (size_t)NE * 2048 * 1024 * 2);
constexpr size_t WS_H = al256(WS_WDN + (size_t)NE * 1024 * 1024 * 2);
constexpr size_t WS_PROJ = al256(WS_H + (size_t)T * D * 2);
constexpr size_t WS_XE = WS_PROJ;
constexpr size_t WS_HID = al256(WS_XE + (size_t)NE * ESLOTS * D * 2);
constexpr size_t WS_DT = al256(WS_PROJ + (size_t)T * PJ * 2);
constexpr size_t WS_CV = al256(WS_DT + (size_t)T * 16 * 4);
constexpr size_t WS_S5E = al256(WS_CV + (size_t)T * 1024 * 2);
constexpr size_t WS_S5H = al256(WS_S5E + (size_t)2 * 32 * NCH * 128 * 4);
constexpr size_t WS_YD = al256(WS_S5H + (size_t)2 * 32 * NCH * 128 * 4);
constexpr size_t WS_SA = al256(WS_YD + (size_t)2 * T * 512 * 4);
constexpr size_t WS_Y3 = al256(WS_SA + (size_t)T * 512 * 2);
constexpr size_t WS_PM = al256(WS_Y3 + (size_t)3 * T * 512 * 2);
constexpr size_t WS_MB = al256(WS_PM + (size_t)T * D * 4);
constexpr size_t WS_YE = WS_PM;
constexpr size_t WS_AFFT = al256(WS_MB + (size_t)T * D * 2);
constexpr size_t WS_IDX = al256(WS_AFFT + (size_t)NE * T * 4);
constexpr size_t WS_GSEL = al256(WS_IDX + (size_t)NE * ESLOTS * 4);
constexpr size_t WS_INV = al256(WS_GSEL + (size_t)NE * ESLOTS * 4);
constexpr size_t WS_DEC = al256(WS_INV + (size_t)T * 16 * 4);
constexpr size_t WS_S5BB = al256(WS_DEC + (size_t)2 * NCH * 8 * 4);
constexpr size_t WS_S5CC = al256(WS_S5BB + (size_t)2 * 32 * 128 * 32 * 2);
constexpr size_t WS_S5AB = al256(WS_S5CC + (size_t)2 * 32 * 16 * 128 * 2);
constexpr size_t WS_ROPE = al256(WS_S5AB + (size_t)2 * 32 * 64 * 2 * 4);
constexpr size_t WS_W2 = al256(WS_ROPE + (size_t)2 * 256 * 16 * 4);
constexpr size_t WBUF_BYTES = WS_H - WS_WIN;
constexpr size_t WS_END = al256(WS_W2 + WBUF_BYTES);
constexpr size_t WS_SST = WS_YD;
constexpr size_t WS_HIN = WS_PM;
constexpr size_t WS_YS = al256(WS_HIN + (size_t)2 * NCH * 8 * 8192 * 2);
static_assert(WS_YS + (size_t)T * 512 * 2 <= WS_AFFT, "HIN|YS overlay fits PM|MB");
static_assert(WS_HID + (size_t)NE * ESLOTS * D * 2 <= WS_DT, "XE|HID overlay fits PROJ");
static_assert(WS_YE + (size_t)NE * ESLOTS * D * 2 <= WS_AFFT, "YE overlay fits PM|MB");
static_assert(WS_END < (size_t)1000 * 1024 * 1024, "workspace");
constexpr int CW_BAR = 4096;

__device__ __forceinline__ float bf2f(unsigned b) { return __uint_as_float(b << 16); }
__device__ __forceinline__ float bflo(unsigned w) { return __uint_as_float(w << 16); }
__device__ __forceinline__ float bfhi(unsigned w) { return __uint_as_float(w & 0xffff0000u); }
typedef float f32x2_c __attribute__((ext_vector_type(2)));
typedef __bf16 bf16x2_c __attribute__((ext_vector_type(2)));
__device__ __forceinline__ unsigned pk2(float lo, float hi) { f32x2_c v; v[0] = lo; v[1] = hi; return __builtin_bit_cast(unsigned, __builtin_convertvector(v, bf16x2_c)); }
__device__ __forceinline__ unsigned f2bf(float f) { return pk2(f, 0.f) & 0xffffu; }
__device__ __forceinline__ float wsum(float v) {
#pragma unroll
    for (int o = 1; o < 64; o <<= 1) v += __shfl_xor(v, o);
    return v;
}
__device__ __forceinline__ float wmaxf(float v) {
#pragma unroll
    for (int o = 1; o < 64; o <<= 1) v = fmaxf(v, __shfl_xor(v, o));
    return v;
}
__device__ __forceinline__ float silu_f(float x) { return x * __builtin_amdgcn_rcpf(1.f + __expf(-x)); }
__device__ __forceinline__ float sigmoid_f(float x) { return __builtin_amdgcn_rcpf(1.f + __expf(-x)); }
__device__ __forceinline__ float softplus_f(float x) { return fmaxf(x, 0.f) + __logf(1.f + __expf(-fabsf(x))); }
__device__ __forceinline__ float gelu_tanh_f(float x) { const float u = 0.7978845608028654f * (x + 0.044715f * x * x * x); return x * __builtin_amdgcn_rcpf(1.f + __expf(-2.f * u)); }
#define LDS_FENCE() asm volatile("s_waitcnt lgkmcnt(0)" ::: "memory")
__device__ __forceinline__ int scan_row(int d, int s) { return d == 0 ? s : (s < NCTX ? (NCTX - 1 - s) : (T + NCTX - 1 - s)); }

namespace pg8 {
struct EpiStoreBf16 {
    static constexpr bool PERM = true, AFTER_DRAIN = false, MIDHOOK = false;
    bf16_t GAS* O; int ldc; int sig_tile; const float GAS* rope;
    __device__ __forceinline__ void operator()(const f32x4 (&acc)[2][2][4][2], const Unit& u, int wr, int wc, int fr, int fq) const {
        const int row0 = u.pm * BM + wr * 64 + fr, col0 = u.pn * BM + wc * 32 + 8 * fq; const bool sg = u.pn >= sig_tile;
        const bool rq = rope != nullptr && u.pm >= 1 && (u.pn == Q0 / 256 || u.pn == Q0 / 256 + 1), rk = rope != nullptr && u.pm >= 1 && u.pn == K0 / 256;
#pragma unroll
        for (int ai = 0; ai < 2; ++ai)
#pragma unroll
            for (int m = 0; m < 4; ++m) { const int row = row0 + ai * HALF + m * 16; bf16_t GAS* rowp = O + (size_t)row * ldc + col0;
#pragma unroll
                for (int bj = 0; bj < 2; ++bj) { f32x4 v0 = acc[ai][bj][m][0], v1 = acc[ai][bj][m][1];
                    if (sg) {
#pragma unroll
                        for (int q = 0; q < 4; ++q) { v0[q] = __builtin_amdgcn_rcpf(1.f + __expf(-v0[q])); v1[q] = __builtin_amdgcn_rcpf(1.f + __expf(-v1[q])); } }
                    if (rq || (rk && bj == 0)) {
                        const int t = row - NCTX, idx = (wc & 1) ? (t & 63) : (t >> 6);
                        const float GAS* cp = rope + idx * 16 + 8 * (fq & 1);
                        const f32x4 c0 = *(const f32x4 GAS*)cp, c1 = *(const f32x4 GAS*)(cp + 4), s0 = *(const f32x4 GAS*)(cp + 4096), s1 = *(const f32x4 GAS*)(cp + 4100);
                        const float sgn = (fq & 2) ? 1.f : -1.f;
#pragma unroll
                        for (int q = 0; q < 4; ++q) { const float p0 = __shfl_xor(v0[q], 32), p1 = __shfl_xor(v1[q], 32);
                            v0[q] = v0[q] * c0[q] + sgn * p0 * s0[q]; v1[q] = v1[q] * c1[q] + sgn * p1 * s1[q]; } }
                    u32x4 w; w.x = cvt_pk_bf16(v0[0], v0[1]); w.y = cvt_pk_bf16(v0[2], v0[3]); w.z = cvt_pk_bf16(v1[0], v1[1]); w.w = cvt_pk_bf16(v1[2], v1[3]);
                    if (sg) __builtin_nontemporal_store(w, (u32x4 GAS*)(rowp + bj * HALF));
                    else *(u32x4 GAS*)(rowp + bj * HALF) = w; } }
    }
};
struct EpiGlu {
    static constexpr bool PERM = true, AFTER_DRAIN = false, MIDHOOK = false;
    const bf16_t GAS* A; const float GAS* bias; bf16_t GAS* O;
    __device__ __forceinline__ void operator()(const f32x4 (&acc)[2][2][4][2], const Unit& u, int wr, int wc, int fr, int fq) const {
        const int row0 = u.pm * BM + wr * 64 + fr, col0 = u.pn * BM + wc * 32 + 8 * fq;
        f32x4 bq[2][2];
#pragma unroll
        for (int bj = 0; bj < 2; ++bj) { bq[bj][0] = *(const f32x4 GAS*)(bias + col0 + bj * HALF); bq[bj][1] = *(const f32x4 GAS*)(bias + col0 + bj * HALF + 4); }
#pragma unroll
        for (int ai = 0; ai < 2; ++ai) {
            u32x4 aa[4][2];
#pragma unroll
            for (int m = 0; m < 4; ++m)
#pragma unroll
                for (int bj = 0; bj < 2; ++bj) aa[m][bj] = *(const u32x4 GAS*)(A + (size_t)(row0 + ai * HALF + m * 16) * 512 + col0 + bj * HALF);
#pragma unroll
            for (int m = 0; m < 4; ++m) {
#pragma unroll
                for (int bj = 0; bj < 2; ++bj) { const f32x4 v0 = acc[ai][bj][m][0], v1 = acc[ai][bj][m][1];
                    const u32x4 a = aa[m][bj];
                    const f32x4 b0 = bq[bj][0], b1 = bq[bj][1];
                    float o[8];
                    o[0] = bflo(a.x) * sigmoid_f(v0[0] + b0[0]); o[1] = bfhi(a.x) * sigmoid_f(v0[1] + b0[1]);
                    o[2] = bflo(a.y) * sigmoid_f(v0[2] + b0[2]); o[3] = bfhi(a.y) * sigmoid_f(v0[3] + b0[3]);
                    o[4] = bflo(a.z) * sigmoid_f(v1[0] + b1[0]); o[5] = bfhi(a.z) * sigmoid_f(v1[1] + b1[1]);
                    o[6] = bflo(a.w) * sigmoid_f(v1[2] + b1[2]); o[7] = bfhi(a.w) * sigmoid_f(v1[3] + b1[3]);
                    u32x4 w; w.x = cvt_pk_bf16(o[0], o[1]); w.y = cvt_pk_bf16(o[2], o[3]); w.z = cvt_pk_bf16(o[4], o[5]); w.w = cvt_pk_bf16(o[6], o[7]);
                    *(u32x4 GAS*)(O + (size_t)(row0 + ai * HALF + m * 16) * 1536 + col0 + bj * HALF) = w; } } }
    }
};
struct RowOffOrder {
    static constexpr bool GATHER = false;
    StaticOrder b; int off;
    __device__ __forceinline__ void init(int M, int N, int G, int c, int off_) { b.init(M, N, G, c); off = off_; }
    __device__ __forceinline__ bool next(int i, Unit& u) const { if (!b.next(i, u)) return false; u.pm += off; return true; }
    __device__ __forceinline__ void a_ready(const Unit&) const {}
    __device__ __forceinline__ void done(const Unit&) const {}
};
struct EpiMerge {
    static constexpr bool PERM = true, AFTER_DRAIN = false, MIDHOOK = true;
    const bf16_t GAS* proj; bf16_t GAS* MB;
    __device__ __forceinline__ void mid(f32x4 (&acc)[2][2][4][2], const Unit& u, int seg, int wr, int wc, int fr, int fq) const {
        const unsigned base = (unsigned)((u.pm * BM + wr * 64 + fr) * PJ + GT0 + (seg - 1) * 1024 + u.pn * BM + wc * 32 + 8 * fq) * 2u;
        const char GAS* pb = (const char GAS*)proj;
        u32x4 ga[2][2], gb[2][2];
#define MG_LOAD(s_, k_) { _Pragma("unroll") for (int bj = 0; bj < 2; ++bj) { const unsigned o = base + (unsigned)(((((k_) >> 2) * HALF + ((k_) & 3) * 16) * PJ + bj * HALF) * 2); \
            ga[s_][bj] = *(const u32x4 GAS*)(pb + o); gb[s_][bj] = *(const u32x4 GAS*)(pb + o + 2048u); } }
        MG_LOAD(0, 0)
#pragma unroll
        for (int k = 0; k < 8; ++k) { const int ai = k >> 2, m = k & 3, sl = k & 1;
            if (k + 1 < 8) { if (sl == 0) MG_LOAD(1, k + 1) else MG_LOAD(0, k + 1) }
            __builtin_amdgcn_sched_barrier(0);
#pragma unroll
            for (int bj = 0; bj < 2; ++bj) { const u32x4 a = ga[sl][bj], b = gb[sl][bj];
                f32x4& v0 = acc[ai][bj][m][0]; f32x4& v1 = acc[ai][bj][m][1];
                v0[0] *= bflo(a.x) * __builtin_amdgcn_rcpf(bflo(b.x)); v0[1] *= bfhi(a.x) * __builtin_amdgcn_rcpf(bfhi(b.x));
                v0[2] *= bflo(a.y) * __builtin_amdgcn_rcpf(bflo(b.y)); v0[3] *= bfhi(a.y) * __builtin_amdgcn_rcpf(bfhi(b.y));
                v1[0] *= bflo(a.z) * __builtin_amdgcn_rcpf(bflo(b.z)); v1[1] *= bfhi(a.z) * __builtin_amdgcn_rcpf(bfhi(b.z));
                v1[2] *= bflo(a.w) * __builtin_amdgcn_rcpf(bflo(b.w)); v1[3] *= bfhi(a.w) * __builtin_amdgcn_rcpf(bfhi(b.w)); }
            __builtin_amdgcn_sched_barrier(0);
        }
#undef MG_LOAD
    }
    __device__ __forceinline__ void operator()(const f32x4 (&acc)[2][2][4][2], const Unit& u, int wr, int wc, int fr, int fq) const {
        const int row0 = u.pm * BM + wr * 64 + fr, col0 = u.pn * BM + wc * 32 + 8 * fq;
#pragma unroll
        for (int ai = 0; ai < 2; ++ai) {
            u32x4 gg[4][2];
#pragma unroll
            for (int m = 0; m < 4; ++m)
#pragma unroll
                for (int bj = 0; bj < 2; ++bj) gg[m][bj] = *(const u32x4 GAS*)(proj + (size_t)(row0 + ai * HALF + m * 16) * PJ + GT0 + 2048 + col0 + bj * HALF);
#pragma unroll
            for (int m = 0; m < 4; ++m) { const int row = row0 + ai * HALF + m * 16;
#pragma unroll
                for (int bj = 0; bj < 2; ++bj) { const f32x4 v0 = acc[ai][bj][m][0], v1 = acc[ai][bj][m][1]; const int col = col0 + bj * HALF; const u32x4 g = gg[m][bj];
                    u32x4 w; w.x = cvt_pk_bf16(bflo(g.x) * v0[0], bfhi(g.x) * v0[1]); w.y = cvt_pk_bf16(bflo(g.y) * v0[2], bfhi(g.y) * v0[3]);
                    w.z = cvt_pk_bf16(bflo(g.z) * v1[0], bfhi(g.z) * v1[1]); w.w = cvt_pk_bf16(bflo(g.w) * v1[2], bfhi(g.w) * v1[3]);
                    *(u32x4 GAS*)(MB + (size_t)row * 1024 + col) = w; } } }
    }
};
struct EpiResid {
    static constexpr bool PERM = false, AFTER_DRAIN = false, MIDHOOK = false;
    float GAS* XL; float GAS* XC; const float GAS* g_lat; const float GAS* g_ctx;
    __device__ __forceinline__ void operator()(const f32x4 (&acc)[2][2][4][2], const Unit& u, int wr, int wc, int fr, int fq) const {
        const bool isc = (u.pm == 0);
        float GAS* base = isc ? XC : (XL - (size_t)NCTX * D); const float GAS* gv = isc ? g_ctx : g_lat;
        const int row0 = u.pm * BM + wr * 64 + fr, col0 = u.pn * BM + wc * 32 + 4 * fq;
        f32x4 gq[2][2];
#pragma unroll
        for (int bj = 0; bj < 2; ++bj)
#pragma unroll
            for (int n = 0; n < 2; ++n) gq[bj][n] = *(const f32x4 GAS*)(gv + col0 + bj * HALF + n * 16);
#pragma unroll
        for (int ai = 0; ai < 2; ++ai)
#pragma unroll
            for (int mp = 0; mp < 2; ++mp) {
                f32x4 xs[2][2][2];
#pragma unroll
                for (int mm = 0; mm < 2; ++mm) { const float GAS* rowp = base + (size_t)(row0 + ai * HALF + (2 * mp + mm) * 16) * D + col0;
#pragma unroll
                    for (int bj = 0; bj < 2; ++bj)
#pragma unroll
                        for (int n = 0; n < 2; ++n) xs[mm][bj][n] = *(const f32x4 GAS*)(rowp + bj * HALF + n * 16); }
#pragma unroll
                for (int mm = 0; mm < 2; ++mm) { float GAS* rowp = base + (size_t)(row0 + ai * HALF + (2 * mp + mm) * 16) * D + col0;
#pragma unroll
                    for (int bj = 0; bj < 2; ++bj)
#pragma unroll
                        for (int n = 0; n < 2; ++n) { f32x4 x = xs[mm][bj][n]; x += gq[bj][n] * acc[ai][bj][2 * mp + mm][n]; *(f32x4 GAS*)(rowp + bj * HALF + n * 16) = x; } }
            }
    }
};
template <bool GATHER_> struct ExpertOrderT {
    static constexpr bool GATHER = GATHER_;
    int G, c, nnt, nmt;
    const int GAS* idx;
    __device__ __forceinline__ bool next(int i, Unit& u) const { const int cc = (G & 7) ? c : (c & 7) * (G >> 3) + (c >> 3);
        const int L = i * G + cc; if (L >= NE * nmt * nnt) return false; const int e = L / (nmt * nnt), rem = L % (nmt * nnt); u.pm = e * 9 + rem % nmt; u.pn = e * nnt + rem / nmt; return true; }
    __device__ __forceinline__ int arow(const Unit& u, int r) const { return idx[u.pm * 256 + r]; }
    __device__ __forceinline__ void a_ready(const Unit&) const {}
    __device__ __forceinline__ void done(const Unit&) const {}
};
struct EpiSwiGlu {
    static constexpr bool PERM = true, AFTER_DRAIN = false, MIDHOOK = false;
    bf16_t GAS* HID;
    __device__ __forceinline__ void operator()(const f32x4 (&acc)[2][2][4][2], const Unit& u, int wr, int wc, int fr, int fq) const {
        const int row0 = u.pm * BM + wr * 64 + fr, col0 = (u.pn & 7) * 128 + wc * 32 + 8 * fq;
#pragma unroll
        for (int ai = 0; ai < 2; ++ai)
#pragma unroll
            for (int m = 0; m < 4; ++m) { const f32x4 g0 = acc[ai][0][m][0], g1 = acc[ai][0][m][1], u0 = acc[ai][1][m][0], u1 = acc[ai][1][m][1];
                u32x4 w;
                w.x = cvt_pk_bf16(silu_f(g0[0]) * u0[0], silu_f(g0[1]) * u0[1]); w.y = cvt_pk_bf16(silu_f(g0[2]) * u0[2], silu_f(g0[3]) * u0[3]);
                w.z = cvt_pk_bf16(silu_f(g1[0]) * u1[0], silu_f(g1[1]) * u1[1]); w.w = cvt_pk_bf16(silu_f(g1[2]) * u1[2], silu_f(g1[3]) * u1[3]);
                *(u32x4 GAS*)(HID + (size_t)(row0 + ai * HALF + m * 16) * 1024 + col0) = w; }
    }
};
struct EpiDown {
    static constexpr bool PERM = true, AFTER_DRAIN = false, MIDHOOK = false;
    bf16_t GAS* YE; const float GAS* gsel;
    __device__ __forceinline__ void operator()(const f32x4 (&acc)[2][2][4][2], const Unit& u, int wr, int wc, int fr, int fq) const {
        const int row0 = u.pm * BM + wr * 64 + fr, col0 = (u.pn & 3) * BM + wc * 32 + 8 * fq;
        float gsv[2][4];
#pragma unroll
        for (int ai = 0; ai < 2; ++ai)
#pragma unroll
            for (int m = 0; m < 4; ++m) gsv[ai][m] = gsel[row0 + ai * HALF + m * 16];
#pragma unroll
        for (int ai = 0; ai < 2; ++ai)
#pragma unroll
            for (int m = 0; m < 4; ++m) { const int row = row0 + ai * HALF + m * 16; const float gs = gsv[ai][m];
#pragma unroll
                for (int bj = 0; bj < 2; ++bj) { const f32x4 v0 = acc[ai][bj][m][0] * gs, v1 = acc[ai][bj][m][1] * gs;
                    u32x4 w; w.x = cvt_pk_bf16(v0[0], v0[1]); w.y = cvt_pk_bf16(v0[2], v0[3]); w.z = cvt_pk_bf16(v1[0], v1[1]); w.w = cvt_pk_bf16(v1[2], v1[3]);
                    *(u32x4 GAS*)(YE + (size_t)row * 1024 + col0 + bj * HALF) = w; } }
    }
};
}
#define XB_TMO      128
#define XB_XCNT(j)  (256  + 64 * (j))
#define XB_XSUB(j)  (1280 + 64 * (j))
#define XB_XGEN(j)  (2304 + 64 * (j))
#define XB_TOP      3328
#define XB_TOPGEN   3392
#define XCD_BAR_WORDS 3456
#define XB_SPIN_CAP (1u << 18)

__device__ __forceinline__ unsigned xb_ld(unsigned GAS* p)              { return __hip_atomic_load(p, __ATOMIC_RELAXED, __HIP_MEMORY_SCOPE_AGENT); }
__device__ __forceinline__ unsigned xb_add(unsigned GAS* p, unsigned v) { return __hip_atomic_fetch_add(p, v, __ATOMIC_RELAXED, __HIP_MEMORY_SCOPE_AGENT); }
__device__ __forceinline__ unsigned xb_xcc_id() { return (unsigned)__builtin_amdgcn_s_getreg((3 << 11) | 20) & 0xFu; }
#define XB_SPIN(cond, bar) do { unsigned _sp = 0; while (cond) { __builtin_amdgcn_s_sleep(1); \
    if ((++_sp & 255u) == 0u) { if (xb_ld(&(bar)[XB_TMO])) break; if (_sp > XB_SPIN_CAP) { (void)xb_add(&(bar)[XB_TMO], 1u); break; } } } } while (0)

struct XcdBarrier {
    unsigned GAS* bar; unsigned x;
    volatile LAS unsigned* st;
};

__device__ __forceinline__ XcdBarrier xcd_barrier_post(unsigned GAS* bar, volatile LAS unsigned* st) {
    XcdBarrier b; b.bar = bar; b.x = xb_xcc_id(); b.st = st;
    if (threadIdx.x == 0) (void)xb_add(&bar[XB_XCNT(b.x)], 1u);
    return b;
}
__device__ __forceinline__ void xcd_barrier_complete(unsigned GAS* bar, unsigned x, unsigned& nloc, unsigned& nx) {
    const unsigned G = gridDim.x * gridDim.y * gridDim.z;
    unsigned sum, cnt, mine, sp = 0u;
    for (;;) {
        sum = 0u; cnt = 0u; mine = 0u;
#pragma unroll
        for (unsigned j = 0; j < 16; ++j) { const unsigned c = xb_ld(&bar[XB_XCNT(j)]); sum += c; cnt += (c > 0u) ? 1u : 0u; mine = (j == x) ? c : mine; }
        if (sum == G) break;
        __builtin_amdgcn_s_sleep(1);
        if ((++sp & 255u) == 0u) { if (xb_ld(&bar[XB_TMO])) break; if (sp > XB_SPIN_CAP) { (void)xb_add(&bar[XB_TMO], 1u); break; } }
    }
    nloc = mine > 0u ? mine : 1u; nx = cnt > 0u ? cnt : 1u;
}

__device__ __forceinline__ void xcd_barrier(const XcdBarrier& b, int wave_s) {
    asm volatile("s_waitcnt vmcnt(0)" ::: "memory");
    __syncthreads();
    if (pg8::tid_of(wave_s) == 0) {
        unsigned long long bar_u = (unsigned long long)b.bar; unsigned bx_ = b.x; asm volatile("" : "+s"(bar_u), "+s"(bx_));
        unsigned GAS* bar = (unsigned GAS*)bar_u;
        __builtin_amdgcn_s_waitcnt(0);
        unsigned nloc = b.st[0], nx = b.st[1];
        if (nloc == 0u) { xcd_barrier_complete(bar, bx_, nloc, nx); b.st[0] = nloc; b.st[1] = nx; }
        const unsigned old = xb_add(&bar[XB_XSUB(bx_)], 1u);
        const unsigned gen = old / nloc;
        if (old + 1u == (gen + 1u) * nloc) {
            __builtin_amdgcn_fence(__ATOMIC_RELEASE, "agent");
            asm volatile("s_waitcnt vmcnt(0)" ::: "memory");
            const unsigned og = xb_add(&bar[XB_TOP], 1u);
            const unsigned tg = og / nx;
            if (og + 1u == (tg + 1u) * nx) xb_add(&bar[XB_TOPGEN], 1u);
            else XB_SPIN(xb_ld(&bar[XB_TOPGEN]) == tg, bar);
            __builtin_amdgcn_fence(__ATOMIC_ACQUIRE, "agent");
            xb_add(&bar[XB_XGEN(bx_)], 1u);
            asm volatile("s_waitcnt vmcnt(0)" ::: "memory");
        } else {
            XB_SPIN(xb_ld(&bar[XB_XGEN(bx_)]) == gen, bar);
            __builtin_amdgcn_fence(__ATOMIC_ACQUIRE, "agent");
            asm volatile("s_waitcnt vmcnt(0)" ::: "memory");
        }
    }
    __syncthreads();
}


struct P {
    const float GAS*x, *c, *ctx, *c_ctx, *w_mod, *b_mod, *norm1_g, *norm2_g, *w_in, *lam_re, *lam_im, *log_dt, *b_re, *b_im, *c_re, *c_im, *s5_d, *w_glu, *b_glu,
        *conv_w, *conv_b, *a_log, *dt_bias, *ssd_d, *ssd_norm_g, *sink, *w_branch, *w_out, *w_router, *w_eg, *w_eu, *w_ed, *final_g;
    float GAS* XL;
    float GAS*MOD, *XC, *DT, *S5E, *S5H, *YD, *PM, *AFFT, *GSEL;
    bf16 GAS*WIN, *WGLU, *WBR, *WOUT, *WUP, *WDN, *H, *PROJ, *XE, *HID, *CV, *SA, *Y3, *MB, *YE;
    int GAS*IDX, *INV;
    int tid, lane, wave, bid, G, vcu;
};


constexpr int PTAB_OFF = LDS_BYTES - 1024;
__device__ __forceinline__ unsigned long long ld_tab(volatile LAS unsigned* t, int k) {
    const unsigned lo = __builtin_amdgcn_readfirstlane(t[2 * k]), hi = __builtin_amdgcn_readfirstlane(t[2 * k + 1]);
    return ((unsigned long long)hi << 32) | lo;
}
__device__ __forceinline__ void build_P(P& p, LAS unsigned char* lds, int wset, int wave_s) {
    int tid_l = pg8::tid_of(wave_s), bid_l = blockIdx.x, g_l = gridDim.x;
    asm volatile("" : "+v"(tid_l), "+s"(bid_l), "+s"(g_l));
    p.tid = tid_l; p.lane = p.tid & 63; p.wave = __builtin_amdgcn_readfirstlane(p.tid >> 6); p.bid = bid_l; p.G = g_l; p.vcu = (g_l & 7) ? bid_l : (bid_l & 7) * (g_l >> 3) + (bid_l >> 3);
    unsigned tbase = (unsigned)(size_t)(lds + PTAB_OFF); asm volatile("" : "+s"(tbase));
    volatile LAS unsigned* tb = (volatile LAS unsigned*)(size_t)tbase;
#define INP(k) ((const float GAS*)ld_tab(tb, k))
    p.x = INP(0); p.c = INP(1); p.ctx = INP(2); p.c_ctx = INP(3); p.w_mod = INP(4); p.b_mod = INP(5); p.norm1_g = INP(6); p.norm2_g = INP(7);
    p.w_in = INP(8); p.lam_re = INP(9); p.lam_im = INP(10); p.log_dt = INP(11); p.b_re = INP(12); p.b_im = INP(13); p.c_re = INP(14); p.c_im = INP(15);
    p.s5_d = INP(16); p.w_glu = INP(17); p.b_glu = INP(18); p.conv_w = INP(19); p.conv_b = INP(20); p.a_log = INP(21); p.dt_bias = INP(22); p.ssd_d = INP(23);
    p.ssd_norm_g = INP(24); p.sink = INP(25); p.w_branch = INP(26); p.w_out = INP(27); p.w_router = INP(28); p.w_eg = INP(29); p.w_eu = INP(30); p.w_ed = INP(31);
    p.final_g = INP(32);
#undef INP
    p.XL = (float GAS*)ld_tab(tb, 33);
    unsigned char GAS* ws = (unsigned char GAS*)ld_tab(tb, 34);
    p.MOD = (float GAS*)(ws + WS_MOD); p.XC = (float GAS*)(ws + WS_XC); p.DT = (float GAS*)(ws + WS_DT); p.S5E = (float GAS*)(ws + WS_S5E); p.S5H = (float GAS*)(ws + WS_S5H); p.YD = (float GAS*)(ws + WS_YD);
    p.PM = (float GAS*)(ws + WS_PM); p.AFFT = (float GAS*)(ws + WS_AFFT); p.GSEL = (float GAS*)(ws + WS_GSEL);
    { unsigned char GAS* wb = ws + (wset ? (WS_W2 - WS_WIN) : 0);
      p.WIN = (bf16 GAS*)(wb + WS_WIN); p.WGLU = (bf16 GAS*)(wb + WS_WGLU); p.WBR = (bf16 GAS*)(wb + WS_WBR); p.WOUT = (bf16 GAS*)(wb + WS_WOUT); p.WUP = (bf16 GAS*)(wb + WS_WUP); p.WDN = (bf16 GAS*)(wb + WS_WDN); }
    p.H = (bf16 GAS*)(ws + WS_H); p.PROJ = (bf16 GAS*)(ws + WS_PROJ); p.XE = (bf16 GAS*)(ws + WS_XE); p.HID = (bf16 GAS*)(ws + WS_HID); p.CV = (bf16 GAS*)(ws + WS_CV); p.SA = (bf16 GAS*)(ws + WS_SA);
    p.Y3 = (bf16 GAS*)(ws + WS_Y3); p.MB = (bf16 GAS*)(ws + WS_MB); p.YE = (bf16 GAS*)(ws + WS_YE);
    p.IDX = (int GAS*)(ws + WS_IDX); p.INV = (int GAS*)(ws + WS_INV);
}
__device__ __forceinline__ void phase_mod(const P& p, LAS unsigned char* lds, float GAS* ropet) {
    for (int i = p.bid * NTHR + p.tid; i < 256 * 16; i += p.G * NTHR) { const float inv = exp2f(-(float)(i & 15) * 0.83048202372184058696f);
        float sn, cs; sincosf((float)(i >> 4) * inv, &sn, &cs); ropet[i] = cs; ropet[4096 + i] = sn; }
    LAS float* sc = (LAS float*)lds;
    LAS float* part = sc + 2048;
    for (int i = p.tid; i < 1024; i += NTHR) { sc[i] = silu_f(p.c[i]); sc[1024 + i] = silu_f(p.c_ctx[i]); }
    __syncthreads();
    for (int it = p.bid; it < DEPTH * 48; it += p.G) {
        const int l = it / 48, cb = it % 48, c0 = cb * 128 + 2 * p.lane;
        const float GAS* W = p.w_mod + (size_t)l * 1024 * 6144 + c0;
        float a00 = 0.f, a01 = 0.f, a10 = 0.f, a11 = 0.f;
        const int kb = p.wave * 128;
#pragma unroll 8
        for (int k = kb; k < kb + 128; ++k) { const f32x2_c w = __builtin_nontemporal_load((const f32x2_c GAS*)(W + (size_t)k * 6144)); const float s0 = sc[k], s1 = sc[1024 + k];
            a00 += s0 * w.x; a01 += s0 * w.y; a10 += s1 * w.x; a11 += s1 * w.y; }
        part[(p.wave * 2 + 0) * 128 + 2 * p.lane] = a00; part[(p.wave * 2 + 0) * 128 + 2 * p.lane + 1] = a01;
        part[(p.wave * 2 + 1) * 128 + 2 * p.lane] = a10; part[(p.wave * 2 + 1) * 128 + 2 * p.lane + 1] = a11;
        __syncthreads();
        if (p.tid < 256) { const int s = p.tid >> 7, col = p.tid & 127; float r = p.b_mod[l * 6144 + cb * 128 + col];
#pragma unroll
            for (int w = 0; w < 8; ++w) r += part[(w * 2 + s) * 128 + col];
            p.MOD[(size_t)(l * 2 + s) * 6144 + cb * 128 + col] = r; }
        __syncthreads();
    }
}

__device__ __forceinline__ void tr_item(const float GAS* src, int ldw, int K, bf16 GAS* dst, int kb, LAS float* scr, int lane, bool nt = false) {
    const int k0 = 64 * kb, kr = lane >> 4, nq = lane & 15;
    f32x4 v[16];
#pragma unroll
    for (int i = 0; i < 16; ++i) v[i] = __builtin_nontemporal_load((const f32x4 GAS*)(src + (size_t)(k0 + 4 * i + kr) * ldw + 4 * nq));
#pragma unroll
    for (int i = 0; i < 16; ++i) { const int k = 4 * i + kr, c = (k >> 3) & 7; *(LAS f32x4*)(scr + k * 64 + 4 * (nq ^ c)) = v[i]; }
    LDS_FENCE();
    const int c = lane & 7;
#pragma unroll
    for (int j = 0; j < 8; ++j) { const int n = (lane >> 3) + 8 * j; const LAS float* s = scr + (8 * c) * 64 + (n ^ (c << 2));
        u32x4 o; o.x = pk2(s[0 * 64], s[1 * 64]); o.y = pk2(s[2 * 64], s[3 * 64]); o.z = pk2(s[4 * 64], s[5 * 64]); o.w = pk2(s[6 * 64], s[7 * 64]);
        if (nt) __builtin_nontemporal_store(o, (u32x4 GAS*)(dst + (size_t)n * K + k0 + 8 * c)); else *(u32x4 GAS*)(dst + (size_t)n * K + k0 + 8 * c) = o; }
    LDS_FENCE();
}
constexpr int CVT_NE = 32 * 16 + 60 * 16 + 8 * 8 + 3 * 16 * 8 + 16 * 16, CVT_ALL = CVT_NE + 3 * 16 * 16 * 16;
__device__ __forceinline__ void convert_weights(const P& p, int l, int lx, LAS unsigned char* lds, int gw, int NGW, int it_lo, int it_hi, bool pnt = false) {
    LAS float* scr = (LAS float*)(lds + p.wave * 16384);
    constexpr int I_A = 32 * 16, I_B = 60 * 16, I_GLU = 8 * 8, I_BR = 3 * 16 * 8, I_OUT = 16 * 16, I_E = 16 * 16 * 16;
    constexpr int NIT = I_A + I_B + I_GLU + I_BR + I_OUT + 3 * I_E;
    const float GAS* win = p.w_in + (size_t)l * 1024 * IN_W;
    for (int it = it_lo + gw; it < it_hi; it += NGW) {
        int r = it;
        if (r < I_A) { const int nb = r >> 4, kb = r & 15; tr_item(win + 64 * nb, IN_W, 1024, p.WIN + (size_t)(64 * nb) * 1024, kb, scr, p.lane, pnt); continue; } r -= I_A;
        if (r < I_B) { const int nb = r >> 4, kb = r & 15; tr_item(win + 2064 + 64 * nb, IN_W, 1024, p.WIN + (size_t)(2048 + 64 * nb) * 1024, kb, scr, p.lane, pnt); continue; } r -= I_B;
        if (r < I_GLU) { const int nb = r >> 3, kb = r & 7; tr_item(p.w_glu + (size_t)l * 512 * 512 + 64 * nb, 512, 512, p.WGLU + (size_t)(64 * nb) * 512, kb, scr, p.lane, pnt); continue; } r -= I_GLU;
        if (r < I_BR) { const int kk = r >> 7, nb = (r >> 3) & 15, kb = r & 7;
            tr_item(p.w_branch + ((size_t)l * 3 + kk) * 512 * 1024 + 64 * nb, 1024, 1536, p.WBR + (size_t)(64 * nb) * 1536 + kk * 512, kb, scr, p.lane, pnt); continue; } r -= I_BR;
        if (r < I_OUT) { const int nb = r >> 4, kb = r & 15; tr_item(p.w_out + (size_t)l * 1024 * 1024 + 64 * nb, 1024, 1024, p.WOUT + (size_t)(64 * nb) * 1024, kb, scr, p.lane, pnt); continue; } r -= I_OUT;
        const int which = r / I_E; r -= which * I_E;
        const int e = r >> 8, nb = (r >> 4) & 15, kb = r & 15;
        const size_t eo = ((size_t)lx * NE + e) * 1024 * 1024;
        if (which == 0) tr_item(p.w_eg + eo + 64 * nb, 1024, 1024, p.WUP + (size_t)(e * 2048 + 256 * (nb >> 1) + 64 * (nb & 1)) * 1024, kb, scr, p.lane);
        else if (which == 1) tr_item(p.w_eu + eo + 64 * nb, 1024, 1024, p.WUP + (size_t)(e * 2048 + 256 * (nb >> 1) + 128 + 64 * (nb & 1)) * 1024, kb, scr, p.lane);
        else tr_item(p.w_ed + eo + 64 * nb, 1024, 1024, p.WDN + (size_t)(e * 1024 + 64 * nb) * 1024, kb, scr, p.lane);
    }
}

__device__ __forceinline__ float reduce16(float (&a)[16], int lane) {
    float b[8], c[4], d[2];
#pragma unroll
    for (int j = 0; j < 8; ++j) { const bool hi = lane & 32; const float send = hi ? a[j] : a[j + 8], keep = hi ? a[j + 8] : a[j]; b[j] = keep + __shfl_xor(send, 32); }
#pragma unroll
    for (int j = 0; j < 4; ++j) { const bool hi = lane & 16; const float send = hi ? b[j] : b[j + 4], keep = hi ? b[j + 4] : b[j]; c[j] = keep + __shfl_xor(send, 16); }
#pragma unroll
    for (int j = 0; j < 2; ++j) { const bool hi = lane & 8; const float send = hi ? c[j] : c[j + 2], keep = hi ? c[j + 2] : c[j]; d[j] = keep + __shfl_xor(send, 8); }
    const bool hi = lane & 4; const float send = hi ? d[0] : d[1], keep = hi ? d[1] : d[0];
    float r = keep + __shfl_xor(send, 4);
    r += __shfl_xor(r, 2); r += __shfl_xor(r, 1);
    return r;
}
template <int MODE> __device__ __forceinline__ void row_pass(const P& p, int l, LAS unsigned char* lds, bool with_ctx = true, bool dry = false) {
    LAS float* W16 = (LAS float*)lds;
    if (MODE != 2) {
        const float GAS* src = (MODE == 0) ? (p.w_in + (size_t)l * 1024 * IN_W + 2048) : (p.w_router + (size_t)l * 1024 * 16);
        const int ld = (MODE == 0) ? IN_W : 16;
        f32x4 wv[2][4];
#pragma unroll
        for (int q = 0; q < 2; ++q)
#pragma unroll
            for (int c = 0; c < 4; ++c) wv[q][c] = *(const f32x4 GAS*)(src + (size_t)(2 * p.tid + q) * ld + 4 * c);
#pragma unroll
        for (int q = 0; q < 2; ++q) { const int k = 2 * p.tid + q, rr = (k & 7) * 128 + ((k >> 3) & 63) + 64 * (k >> 9);
#pragma unroll
            for (int c = 0; c < 4; ++c) *(LAS f32x4*)(W16 + rr * 20 + 4 * c) = wv[q][c]; }
        __syncthreads();
    }
    const int gw = p.bid * NWAVES + p.wave, NGW = p.G * NWAVES, lane = p.lane;
    const bool comb = (MODE == 0 && l > 0) || MODE == 2;
    const int rbeg = gw + ((MODE == 2 || !with_ctx) ? NCTX : 0);
    f32x4 xn[4]; int slotn = -1;
#define RP_SRC(r_) ((MODE == 0 && l == 0) ? ((r_) < NCTX ? (p.ctx + (size_t)(r_) * D) : (p.x + (size_t)((r_) - NCTX) * D)) : ((r_) < NCTX ? (p.XC + (size_t)(r_) * D) : (p.XL + (size_t)((r_) - NCTX) * D)))
#define RP_LOAD(r_) { const float GAS* s_ = RP_SRC(r_); xn[0] = *(const f32x4 GAS*)(s_ + 8 * lane); xn[1] = *(const f32x4 GAS*)(s_ + 8 * lane + 4); xn[2] = *(const f32x4 GAS*)(s_ + 512 + 8 * lane); xn[3] = *(const f32x4 GAS*)(s_ + 512 + 8 * lane + 4); \
        if (comb) slotn = p.INV[(size_t)(r_) * 16 + (lane & 15)]; }
    f32x4 gs[4], hs[4]; bool cur_isc = rbeg < NCTX;
#define RP_MOD(isc_) if (MODE != 2) { const float GAS* gam_ = (MODE == 0 ? p.norm1_g : p.norm2_g) + (size_t)l * D; const float GAS* md_ = p.MOD + (size_t)(l * 2 + ((isc_) ? 1 : 0)) * 6144 + (MODE == 0 ? 0 : 3 * D); \
        _Pragma("unroll") for (int i_ = 0; i_ < 4; ++i_) { const int k_ = 512 * (i_ >> 1) + 8 * lane + 4 * (i_ & 1); const f32x4 g_ = *(const f32x4 GAS*)(gam_ + k_), s_ = *(const f32x4 GAS*)(md_ + D + k_); \
            gs[i_] = g_ * (1.f + s_); hs[i_] = *(const f32x4 GAS*)(md_ + k_); } }
    RP_MOD(cur_isc)
    if (rbeg < T) RP_LOAD(rbeg)
    for (int row = rbeg; row < T; row += NGW) {
        const bool isc = row < NCTX;
        if (isc != cur_isc) { RP_MOD(isc) cur_isc = isc; }
        float GAS* xrow = isc ? (p.XC + (size_t)row * D) : (p.XL + (size_t)(row - NCTX) * D);
        float v[16];
#pragma unroll
        for (int i = 0; i < 4; ++i) { v[4 * i] = xn[i][0]; v[4 * i + 1] = xn[i][1]; v[4 * i + 2] = xn[i][2]; v[4 * i + 3] = xn[i][3]; }
        const int myslot = slotn;
        { const int rnx = (row + NGW < T) ? row + NGW : row; RP_LOAD(rnx) }
        if (comb) {
            const int lp = (MODE == 2) ? (DEPTH - 1) : (l - 1);
            const float GAS* g2 = p.MOD + (size_t)(lp * 2 + (isc ? 1 : 0)) * 6144 + 5 * D;
            float s[16];
#pragma unroll
            for (int i = 0; i < 16; ++i) s[i] = 0.f;
            unsigned bal = (unsigned)(__ballot(myslot >= 0) & 0xFFFFull);
            while (bal) {
                const int e0 = __builtin_ctz(bal); bal &= bal - 1u;
                const bool two = bal != 0u; const int e1 = two ? __builtin_ctz(bal) : e0; if (two) bal &= bal - 1u;
                const int s0 = __builtin_amdgcn_readlane(myslot, e0), s1 = __builtin_amdgcn_readlane(myslot, e1);
                const bf16 GAS* y0 = p.YE + ((size_t)e0 * ESLOTS + s0) * D; const bf16 GAS* y1 = p.YE + ((size_t)e1 * ESLOTS + s1) * D;
                u32x4 w0[2], w1[2];
#pragma unroll
                for (int i = 0; i < 2; ++i) { w0[i] = __builtin_nontemporal_load((const u32x4 GAS*)(y0 + 512 * i + 8 * lane)); w1[i] = __builtin_nontemporal_load((const u32x4 GAS*)(y1 + 512 * i + 8 * lane)); }
#pragma unroll
                for (int i = 0; i < 2; ++i) { const u32x4 w = w0[i];
                    s[8 * i] += bflo(w.x); s[8 * i + 1] += bfhi(w.x); s[8 * i + 2] += bflo(w.y); s[8 * i + 3] += bfhi(w.y);
                    s[8 * i + 4] += bflo(w.z); s[8 * i + 5] += bfhi(w.z); s[8 * i + 6] += bflo(w.w); s[8 * i + 7] += bfhi(w.w); }
                if (two) {
#pragma unroll
                    for (int i = 0; i < 2; ++i) { const u32x4 w = w1[i];
                        s[8 * i] += bflo(w.x); s[8 * i + 1] += bfhi(w.x); s[8 * i + 2] += bflo(w.y); s[8 * i + 3] += bfhi(w.y);
                        s[8 * i + 4] += bflo(w.z); s[8 * i + 5] += bfhi(w.z); s[8 * i + 6] += bflo(w.w); s[8 * i + 7] += bfhi(w.w); } }
            }
#pragma unroll
            for (int i = 0; i < 2; ++i) { const f32x4 a = *(const f32x4 GAS*)(g2 + 512 * i + 8 * lane), b = *(const f32x4 GAS*)(g2 + 512 * i + 8 * lane + 4);
#pragma unroll
                for (int q = 0; q < 4; ++q) { v[8 * i + q] += a[q] * s[8 * i + q]; v[8 * i + 4 + q] += b[q] * s[8 * i + 4 + q]; } }
        }
        if (MODE == 0 && !dry) {
#pragma unroll
            for (int i = 0; i < 2; ++i) { *(f32x4 GAS*)(xrow + 512 * i + 8 * lane) = (f32x4){v[8 * i], v[8 * i + 1], v[8 * i + 2], v[8 * i + 3]};
                *(f32x4 GAS*)(xrow + 512 * i + 8 * lane + 4) = (f32x4){v[8 * i + 4], v[8 * i + 5], v[8 * i + 6], v[8 * i + 7]}; }
        }
        float ss = 0.f;
#pragma unroll
        for (int i = 0; i < 16; ++i) ss += v[i] * v[i];
        const float rstd = rsqrtf(wsum(ss) * (1.f / D) + EPS);
        if (MODE == 2) {
#pragma unroll
            for (int i = 0; i < 2; ++i) { const f32x4 a = *(const f32x4 GAS*)(p.final_g + 512 * i + 8 * lane), b = *(const f32x4 GAS*)(p.final_g + 512 * i + 8 * lane + 4);
                __builtin_nontemporal_store((f32x4){v[8 * i] * rstd * a[0], v[8 * i + 1] * rstd * a[1], v[8 * i + 2] * rstd * a[2], v[8 * i + 3] * rstd * a[3]}, (f32x4 GAS*)(xrow + 512 * i + 8 * lane));
                __builtin_nontemporal_store((f32x4){v[8 * i + 4] * rstd * b[0], v[8 * i + 5] * rstd * b[1], v[8 * i + 6] * rstd * b[2], v[8 * i + 7] * rstd * b[3]}, (f32x4 GAS*)(xrow + 512 * i + 8 * lane + 4)); }
            continue;
        }
        bf16 GAS* hrow = p.H + (size_t)row * D;
        float acc[16];
#pragma unroll
        for (int j = 0; j < 16; ++j) acc[j] = 0.f;
#pragma unroll
        for (int i = 0; i < 2; ++i) {
            float hv[8];
            { const int k0 = 512 * i + 8 * lane;
#pragma unroll
              for (int q = 0; q < 4; ++q) { hv[q] = v[8 * i + q] * rstd * gs[2 * i][q] + hs[2 * i][q]; hv[4 + q] = v[8 * i + 4 + q] * rstd * gs[2 * i + 1][q] + hs[2 * i + 1][q]; }
              u32x4 o; o.x = pk2(hv[0], hv[1]); o.y = pk2(hv[2], hv[3]); o.z = pk2(hv[4], hv[5]); o.w = pk2(hv[6], hv[7]);
              *(u32x4 GAS*)(hrow + k0) = o; }
#pragma unroll
            for (int j = 0; j < 8; ++j) { const LAS f32x4* wr = (const LAS f32x4*)(W16 + (j * 128 + lane + 64 * i) * 20);
                const f32x4 w0 = wr[0], w1 = wr[1], w2 = wr[2], w3 = wr[3]; const float h = hv[j];
                acc[0] += h * w0[0]; acc[1] += h * w0[1]; acc[2] += h * w0[2]; acc[3] += h * w0[3];
                acc[4] += h * w1[0]; acc[5] += h * w1[1]; acc[6] += h * w1[2]; acc[7] += h * w1[3];
                acc[8] += h * w2[0]; acc[9] += h * w2[1]; acc[10] += h * w2[2]; acc[11] += h * w2[3];
                acc[12] += h * w3[0]; acc[13] += h * w3[1]; acc[14] += h * w3[2]; acc[15] += h * w3[3];
                if (j & 1) asm volatile("" ::: "memory"); }
        }
        const float tot = reduce16(acc, lane);
        const int col = ((lane >> 5) & 1) * 8 + ((lane >> 4) & 1) * 4 + ((lane >> 3) & 1) * 2 + ((lane >> 2) & 1);
        if (MODE == 0) {
            if ((lane & 3) == 0) p.DT[(size_t)row * 16 + col] = softplus_f(tot + p.dt_bias[l * 16 + col]);
        } else {
            float mx = tot;
            mx = fmaxf(mx, __shfl_xor(mx, 4)); mx = fmaxf(mx, __shfl_xor(mx, 8)); mx = fmaxf(mx, __shfl_xor(mx, 16)); mx = fmaxf(mx, __shfl_xor(mx, 32));
            const float e = expf(tot - mx); float sum = e;
            sum += __shfl_xor(sum, 4); sum += __shfl_xor(sum, 8); sum += __shfl_xor(sum, 16); sum += __shfl_xor(sum, 32);
            if ((lane & 3) == 0) p.AFFT[(size_t)col * T + row] = e / sum;
        }
    }
}

#undef RP_SRC
#undef RP_LOAD
#undef RP_MOD
struct S5Lane { float abr, abi; float bbr[16], bbi[16]; };
__device__ __forceinline__ void s5_lane_params(const P& p, int l, int d, int g, int lane, S5Lane& o, bool withB) {
    const size_t gi = ((size_t)(l * 2 + d) * 32 + g);
    const float lr = p.lam_re[gi * 64 + lane], li = p.lam_im[gi * 64 + lane], dt = expf(p.log_dt[gi]);
    const float mag = expf(lr * dt); float sn, cs; sincosf(li * dt, &sn, &cs);
    o.abr = mag * cs; o.abi = mag * sn;
    if (withB) {
        const float den = lr * lr + li * li;
        const float fr = ((o.abr - 1.f) * lr + o.abi * li) / den, fi = (o.abi * lr - (o.abr - 1.f) * li) / den;
        const f32x4 GAS* br = (const f32x4 GAS*)(p.b_re + (gi * 64 + lane) * 16); const f32x4 GAS* bi = (const f32x4 GAS*)(p.b_im + (gi * 64 + lane) * 16);
#pragma unroll
        for (int q = 0; q < 4; ++q) { const f32x4 r4 = br[q], i4 = bi[q];
#pragma unroll
            for (int j = 0; j < 4; ++j) { o.bbr[4 * q + j] = fr * r4[j] - fi * i4[j]; o.bbi[4 * q + j] = fr * i4[j] + fi * r4[j]; } }
    }
}
__device__ __forceinline__ void s5_stage_u(const P& p, int r0, int g, LAS unsigned char* ub, int lane) {
    u32x4 w[4];
#pragma unroll
    for (int j = 0; j < 4; ++j) { const int q = lane + 64 * j, i = q >> 1, half = q & 1; w[j] = *(const u32x4 GAS*)(p.PROJ + (size_t)(r0 + i) * PJ + U0 + g * 16 + half * 8); }
    __builtin_amdgcn_sched_barrier(0);
#pragma unroll
    for (int j = 0; j < 4; ++j) { const int q = lane + 64 * j, i = q >> 1, half = q & 1; *(LAS u32x4*)(ub + i * 32 + half * 16) = w[j]; }
    LDS_FENCE();
}


__device__ __forceinline__ void phase_premix(const P& p, int l, LAS unsigned char* lds) {
    const int c8 = (p.tid & 127) * 8;
    const float GAS* cw = p.conv_w + (size_t)l * 5 * 1024 + c8; const float GAS* cb = p.conv_b + (size_t)l * 1024 + c8;
    float w[5][8], bias[8];
#pragma unroll
    for (int j = 0; j < 5; ++j) { const f32x4 w0 = *(const f32x4 GAS*)(cw + j * 1024), w1 = *(const f32x4 GAS*)(cw + j * 1024 + 4);
        w[j][0] = w0[0]; w[j][1] = w0[1]; w[j][2] = w0[2]; w[j][3] = w0[3]; w[j][4] = w1[0]; w[j][5] = w1[1]; w[j][6] = w1[2]; w[j][7] = w1[3]; }
    { const f32x4 b0 = *(const f32x4 GAS*)cb, b1 = *(const f32x4 GAS*)(cb + 4); bias[0] = b0[0]; bias[1] = b0[1]; bias[2] = b0[2]; bias[3] = b0[3]; bias[4] = b1[0]; bias[5] = b1[1]; bias[6] = b1[2]; bias[7] = b1[3]; }
    for (int rg = p.bid * 4 + (p.tid >> 7); rg < T / 4; rg += p.G * 4) {
        const int row0 = 4 * rg, lo = row0 < NCTX ? 0 : NCTX, hi = row0 < NCTX ? NCTX : T;
        u32x4 xv[8];
#pragma unroll
        for (int q = 0; q < 8; ++q) { const int r = row0 + q - 2; xv[q] = (r >= lo && r < hi) ? *(const u32x4 GAS*)(p.PROJ + (size_t)r * PJ + XB0 + c8) : (u32x4){0u, 0u, 0u, 0u}; }
#pragma unroll
        for (int t = 0; t < 4; ++t) {
            float a[8];
#pragma unroll
            for (int q = 0; q < 8; ++q) a[q] = bias[q];
#pragma unroll
            for (int j = 0; j < 5; ++j) { const u32x4 v = xv[t + j];
                a[0] += w[j][0] * bflo(v.x); a[1] += w[j][1] * bfhi(v.x); a[2] += w[j][2] * bflo(v.y); a[3] += w[j][3] * bfhi(v.y);
                a[4] += w[j][4] * bflo(v.z); a[5] += w[j][5] * bfhi(v.z); a[6] += w[j][6] * bflo(v.w); a[7] += w[j][7] * bfhi(v.w); }
            u32x4 o; o.x = pk2(silu_f(a[0]), silu_f(a[1])); o.y = pk2(silu_f(a[2]), silu_f(a[3])); o.z = pk2(silu_f(a[4]), silu_f(a[5])); o.w = pk2(silu_f(a[6]), silu_f(a[7]));
            *(u32x4 GAS*)(p.CV + (size_t)(row0 + t) * 1024 + c8) = o; }
    }
}


__device__ __forceinline__ void phase_select(const P& p, LAS unsigned char* lds, bool with_ctx) {
    LAS unsigned* keys = (LAS unsigned*)lds;
    LAS unsigned* hist = keys + 16384;
    LAS unsigned* misc = hist + 256;
    const int tid = p.tid, lane = p.lane, wave = p.wave;
    for (int it = p.bid; it < (with_ctx ? 32 : 16); it += p.G) {
        const int set = it >> 4, e = it & 15;
        const int n = set ? NCTX : NLAT, cap = set ? CAP_C : CAP_L, row0 = set ? 0 : NCTX, slot0 = set ? CAP_L : 0;
        const float GAS* src = p.AFFT + (size_t)e * T + row0;
        __syncthreads();
        { unsigned kv[32];
#pragma unroll
          for (int j = 0; j < 32; ++j) { const int i = tid + NTHR * j; kv[j] = (i < n) ? __float_as_uint(src[i]) : 0u; }
          __builtin_amdgcn_sched_barrier(0);
#pragma unroll
          for (int j = 0; j < 32; ++j) { const int i = tid + NTHR * j; if (i < n) keys[i] = kv[j]; } }
        unsigned prefix = 0u, mask = 0u, need = (unsigned)cap;
        for (int pass = 3; pass >= 0; --pass) {
            if (tid < 256) hist[tid] = 0u;
            __syncthreads();
            for (int i = tid; i < n; i += NTHR) { const unsigned k = keys[i]; if ((k & mask) == prefix) __hip_atomic_fetch_add(&hist[(k >> (8 * pass)) & 255u], 1u, __ATOMIC_RELAXED, __HIP_MEMORY_SCOPE_WORKGROUP); }
            __syncthreads();
            if (wave == 0) {
                const unsigned h0 = hist[4 * lane], h1 = hist[4 * lane + 1], h2 = hist[4 * lane + 2], h3 = hist[4 * lane + 3];
                const unsigned c = h0 + h1 + h2 + h3; unsigned S = c;
#pragma unroll
                for (int o = 1; o < 64; o <<= 1) { const unsigned t = __shfl_down(S, o); if (lane + o < 64) S += t; }
                const unsigned Snext = S - c;
                if (S >= need && Snext < need) { unsigned rem = need - Snext; unsigned bin;
                    if (h3 >= rem) bin = 3; else { rem -= h3; if (h2 >= rem) bin = 2; else { rem -= h2; if (h1 >= rem) bin = 1; else { rem -= h1; bin = 0; } } }
                    misc[0] = 4 * lane + bin; misc[1] = rem; }
            }
            __syncthreads();
            prefix |= misc[0] << (8 * pass); mask |= 0xFFu << (8 * pass); need = misc[1];
            __syncthreads();
        }
        if (set == 0) for (int s = CAP_L + (with_ctx ? CAP_C : 0) + tid; s < ESLOTS; s += NTHR) { p.IDX[e * ESLOTS + s] = 0; p.GSEL[e * ESLOTS + s] = 0.f; }
        unsigned selbase = 0u, eqbase = 0u;
        for (int base = 0; base < n; base += NTHR) {
            const int i = base + tid; const bool valid = i < n; const unsigned k = valid ? keys[i] : 0u;
            const bool eq = valid && k == prefix, gt = valid && k > prefix;
            const unsigned long long lt = (1ull << lane) - 1ull;
            const unsigned long long be = __ballot(eq);
            if (lane == 0) misc[8 + wave] = (unsigned)__popcll(be);
            __syncthreads();
            unsigned woff = 0u, tot = 0u;
#pragma unroll
            for (int w = 0; w < 8; ++w) { const unsigned v = misc[8 + w]; woff += (w < wave) ? v : 0u; tot += v; }
            const unsigned eqrank = eqbase + woff + (unsigned)__popcll(be & lt);
            const bool sel = gt || (eq && eqrank < need);
            const unsigned long long bs = __ballot(sel);
            if (lane == 0) misc[16 + wave] = (unsigned)__popcll(bs);
            __syncthreads();
            unsigned woff2 = 0u, tot2 = 0u;
#pragma unroll
            for (int w = 0; w < 8; ++w) { const unsigned v = misc[16 + w]; woff2 += (w < wave) ? v : 0u; tot2 += v; }
            if (valid) { const int row = row0 + i;
                if (sel) { const int slot = slot0 + (int)(selbase + woff2 + (unsigned)__popcll(bs & lt));
                    p.IDX[e * ESLOTS + slot] = row; p.GSEL[e * ESLOTS + slot] = __uint_as_float(k); p.INV[(size_t)row * 16 + e] = slot; }
                else p.INV[(size_t)row * 16 + e] = -1; }
            selbase += tot2; eqbase += tot;
            __syncthreads();
        }
    }
}


typedef short bf16x8 __attribute__((ext_vector_type(8)));
#define MFMA16(a, b, c) __builtin_amdgcn_mfma_f32_16x16x32_bf16((a), (b), (c), 0, 0, 0)
constexpr int LDP = 272;
constexpr int LDQ = 144;
__device__ __forceinline__ bf16x8 ld_frag(const LAS unsigned char* base, int row, int kcol, int ldb) { return *(const LAS bf16x8*)(base + row * ldb + kcol * 2); }
typedef short s16x4_t __attribute__((ext_vector_type(4)));
__device__ __forceinline__ bf16x8 tr_frag(const LAS unsigned char* img, int k0, int col0, int sb, int lane) {
    const int g = lane >> 4, q = (lane & 15) >> 2, pp = lane & 3;
    const LAS unsigned char* a = img + (k0 + 8 * g + q) * sb + (col0 + 4 * pp) * 2;
    const s16x4_t r0 = __builtin_amdgcn_ds_read_tr16_b64_v4i16((LAS s16x4_t*)a), r1 = __builtin_amdgcn_ds_read_tr16_b64_v4i16((LAS s16x4_t*)(a + 4 * sb));
    return (bf16x8){r0[0], r0[1], r0[2], r0[3], r1[0], r1[1], r1[2], r1[3]};
}
__device__ __forceinline__ bf16x8 tr_frag_perm(const LAS unsigned char* img, int k0, int col0, int sb, int lane) {
    const int g = lane >> 4, q = (lane & 15) >> 2, pp = lane & 3;
    const LAS unsigned char* a = img + (k0 + 4 * g + q) * sb + (col0 + 4 * pp) * 2;
    const s16x4_t r0 = __builtin_amdgcn_ds_read_tr16_b64_v4i16((LAS s16x4_t*)a), r1 = __builtin_amdgcn_ds_read_tr16_b64_v4i16((LAS s16x4_t*)(a + 16 * sb));
    return (bf16x8){r0[0], r0[1], r0[2], r0[3], r1[0], r1[1], r1[2], r1[3]};
}
constexpr int SB64 = 144, SB128 = 304, SB256 = 560;
__device__ __forceinline__ void st_b16(LAS unsigned char* p, unsigned v) { *(LAS unsigned short*)p = (unsigned short)v; }
__device__ __forceinline__ float wscan_incl(float v, int lane) {
#pragma unroll
    for (int o = 1; o < 64; o <<= 1) { const float t = __shfl_up(v, o); if (lane >= o) v += t; }
    return v;
}
__device__ __forceinline__ int chunk_r0(int d, int cs) { return d == 0 ? 128 * cs : (cs < 2 ? 128 * (1 - cs) : 128 * (NCH + 1 - cs)); }
__device__ __forceinline__ int scan_chunk_of(int d, int cn) { return d == 0 ? cn : (cn < 2 ? 1 - cn : NCH + 1 - cn); }

__device__ __forceinline__ void ssd_acum(const float GAS* DT, int r0, int d, int col, float a, int lane, LAS float* acum, LAS float* dtv, float& total) {
    const int j0 = d == 0 ? lane : 127 - lane, j1 = d == 0 ? 64 + lane : 63 - lane;
    const float dt0 = DT[(size_t)(r0 + j0) * 16 + col], dt1 = DT[(size_t)(r0 + j1) * 16 + col];
    const float s0 = wscan_incl(dt0 * a, lane); const float t0 = __shfl(s0, 63);
    const float s1 = wscan_incl(dt1 * a, lane) + t0; total = __shfl(s1, 63);
    acum[j0] = s0; acum[j1] = s1; dtv[j0] = dt0; dtv[j1] = dt1;
}


__device__ __forceinline__ void ssd_states(const P& p, int l, LAS unsigned char* lds, bf16 GAS* SST, float GAS* DEC) {
    LAS unsigned char* Bi = lds;
    LAS unsigned char* Xi = lds + 128 * SB128;
    LAS float* wj = (LAS float*)(lds + 128 * SB128 + 128 * SB256);
    const int tid = p.tid, lane = p.lane, wave = p.wave, quad = lane >> 4, l15 = lane & 15;
    u32x4 rbv[4], rxv[8];
#define SS_LOAD(u_) { const int d_ = (u_) / (2 * NCH), cs_ = ((u_) % (2 * NCH)) >> 1, g_ = (u_) & 1, r0_ = chunk_r0(d_, cs_); \
        _Pragma("unroll") for (int i_ = 0; i_ < 4; ++i_) { const int idx = tid + NTHR * i_, j = idx >> 4, n8 = (idx & 15) * 8; rbv[i_] = *(const u32x4 GAS*)(p.CV + (size_t)(r0_ + j) * 1024 + 512 + g_ * 128 + n8); } \
        _Pragma("unroll") for (int i_ = 0; i_ < 8; ++i_) { const int idx = tid + NTHR * i_, j = idx >> 5, c8 = (idx & 31) * 8; rxv[i_] = *(const u32x4 GAS*)(p.CV + (size_t)(r0_ + j) * 1024 + g_ * 256 + c8); } }
    if (p.vcu < 2 * NCH * 2) SS_LOAD(p.vcu)
    for (int u = p.vcu; u < 2 * NCH * 2; u += p.G) {
        const int d = u / (2 * NCH), cs = (u % (2 * NCH)) >> 1, g = u & 1;
        const int r0 = chunk_r0(d, cs);
        __syncthreads();
        if (wave < 4) { const int h = g * 4 + wave; const float a = -expf(p.a_log[l * 16 + d * 8 + h]); float total;
            LAS float* ac = wj + 512 + wave * 128; LAS float* dv = wj + 1024 + wave * 128;
            ssd_acum(p.DT, r0, d, d * 8 + h, a, lane, ac, dv, total);
            LDS_FENCE();
            wj[wave * 128 + lane] = __expf(total - ac[lane]) * dv[lane]; wj[wave * 128 + 64 + lane] = __expf(total - ac[64 + lane]) * dv[64 + lane];
            if (lane == 0) DEC[(d * NCH + cs) * 8 + h] = expf(total); }
#pragma unroll
        for (int i = 0; i < 4; ++i) { const int idx = tid + NTHR * i, j = idx >> 4, n8 = (idx & 15) * 8; *(LAS u32x4*)(Bi + j * SB128 + n8 * 2) = rbv[i]; }
        __syncthreads();
#pragma unroll
        for (int i = 0; i < 8; ++i) { const int idx = tid + NTHR * i, j = idx >> 5, c8 = (idx & 31) * 8;
            const u32x4 v = rxv[i]; const float w = wj[(c8 >> 6) * 128 + j];
            u32x4 o; o.x = pk2(bflo(v.x) * w, bfhi(v.x) * w); o.y = pk2(bflo(v.y) * w, bfhi(v.y) * w); o.z = pk2(bflo(v.z) * w, bfhi(v.z) * w); o.w = pk2(bflo(v.w) * w, bfhi(v.w) * w);
            *(LAS u32x4*)(Xi + j * SB256 + c8 * 2) = o; }
        __syncthreads();
        if (u + p.G < 2 * NCH * 2) SS_LOAD(u + p.G)
        const int hh = wave >> 1, ph = wave & 1;
        f32x4 acc[2][8];
#pragma unroll
        for (int a = 0; a < 2; ++a)
#pragma unroll
            for (int b = 0; b < 8; ++b) acc[a][b] = (f32x4){0.f, 0.f, 0.f, 0.f};
#pragma unroll
        for (int ks = 0; ks < 4; ++ks) {
            bf16x8 af[2];
#pragma unroll
            for (int pt = 0; pt < 2; ++pt) af[pt] = tr_frag(Xi, 32 * ks, hh * 64 + ph * 32 + pt * 16, SB256, lane);
#pragma unroll
            for (int nt = 0; nt < 8; ++nt) { const bf16x8 bfr = tr_frag(Bi, 32 * ks, nt * 16, SB128, lane);
#pragma unroll
                for (int pt = 0; pt < 2; ++pt) acc[pt][nt] = MFMA16(af[pt], bfr, acc[pt][nt]); }
        }
        bf16 GAS* S = SST + ((size_t)(d * NCH + cs) * 8 + g * 4 + hh) * 8192;
#pragma unroll
        for (int pt = 0; pt < 2; ++pt)
#pragma unroll
            for (int nt = 0; nt < 8; ++nt)
#pragma unroll
                for (int r = 0; r < 4; ++r) S[(ph * 32 + pt * 16 + 4 * quad + r) * 128 + nt * 16 + l15] = (bf16)f2bf(acc[pt][nt][r]);
    }
}

#undef SS_LOAD
__device__ __forceinline__ void scan_carries(const P& p, int l, LAS unsigned char* lds, const bf16 GAS* SST, const float GAS* DEC, bf16 GAS* HIN) {
    LAS float* dcl = (LAS float*)lds;
    for (int e = p.bid * NTHR + p.tid; e < 2 * 8 * 8192; e += p.G * NTHR) {
        const int d = e >> 16, h = (e >> 13) & 7, pn = e & 8191;
        __syncthreads();
        if (p.tid < NCH) dcl[p.tid] = DEC[(size_t)(d * NCH + p.tid) * 8 + h];
        __syncthreads();
        float hs = 0.f;
        unsigned sa[26], sb[26];
        constexpr size_t CST = (size_t)8 * 8192;
        const bf16 GAS* sp = SST + ((size_t)(d * NCH) * 8 + h) * 8192 + pn; bf16 GAS* hp = HIN + ((size_t)(d * NCH) * 8 + h) * 8192 + pn; int cb = 0;
#define SC_LOAD(arr_) { _Pragma("unroll") for (int j = 0; j < 26; ++j) arr_[j] = sp[(size_t)j * CST]; sp += 26 * CST; __builtin_amdgcn_sched_barrier(0); }
#define SC_FOLD(arr_) { _Pragma("unroll") for (int j = 0; j < 26; ++j) { hp[(size_t)j * CST] = (bf16)f2bf(hs); hs = hs * dcl[cb + j] + bf2f(arr_[j]); } hp += 26 * CST; cb += 26; __builtin_amdgcn_sched_barrier(0); }
        SC_LOAD(sa)
#pragma unroll 1
        for (int b = 0; b < 2; ++b) { SC_LOAD(sb) SC_FOLD(sa) SC_LOAD(sa) SC_FOLD(sb) }
        SC_FOLD(sa)
#undef SC_LOAD
#undef SC_FOLD
    }
    for (int e = p.bid * NTHR + p.tid; e < 2 * 32 * 64; e += p.G * NTHR) {
        const int d = e >> 11, g = (e >> 6) & 31, pq = e & 63;
        S5Lane s; s5_lane_params(p, l, d, g, pq, s, false);
        float ar = s.abr, ai = s.abi;
#pragma unroll
        for (int q = 0; q < 7; ++q) { const float nr = ar * ar - ai * ai, ni = 2.f * ar * ai; ar = nr; ai = ni; }
        float hr = 0.f, hi = 0.f;
        const float GAS* E = p.S5E + (size_t)(d * 32 + g) * NCH * 128 + pq; float GAS* Hn = p.S5H + (size_t)(d * 32 + g) * NCH * 128 + pq;
        for (int c0 = 0; c0 < NCH; c0 += 26) {
            float er[26], ei[26];
#pragma unroll
            for (int j = 0; j < 26; ++j) { er[j] = E[(c0 + j) * 128]; ei[j] = E[(c0 + j) * 128 + 64]; }
#pragma unroll
            for (int j = 0; j < 26; ++j) { Hn[(c0 + j) * 128] = hr; Hn[(c0 + j) * 128 + 64] = hi;
                const float nr = ar * hr - ai * hi + er[j], ni = ar * hi + ai * hr + ei[j]; hr = nr; hi = ni; }
        }
    }
}

__device__ __forceinline__ void ssd_outputs(const P& p, int l, LAS unsigned char* lds, const bf16 GAS* HIN, const bf16 GAS* SST, bf16 GAS* YS, int u_begin, int u_end, int first, int stride) {
    LAS unsigned char* Cm = lds;
    LAS unsigned char* Bm = lds + 128 * LDP;
    LAS unsigned char* XT = lds + 2 * 128 * LDP;
    LAS unsigned char* Wm = lds + 2 * 128 * LDP + 128 * SB64;
    LAS float* sm = (LAS float*)(lds + 3 * 128 * LDP + 128 * SB64);
    const int tid = p.tid, lane = p.lane, wave = p.wave, quad = lane >> 4, l15 = lane & 15;
    u32x4 rb[4], rc[4], rx[2], rh[4];
#define SO_LOAD(u_) { const int cn_ = (u_) >> 3, h_ = (u_) & 7, g_ = h_ >> 2, r0_ = 128 * cn_; \
        _Pragma("unroll") for (int i_ = 0; i_ < 4; ++i_) { const int idx = tid + NTHR * i_, d_ = idx >> 10, pp = (idx >> 4) & 63, n8 = (idx & 15) * 8; const int cs_ = scan_chunk_of(d_, cn_); \
            if (cn_ >= 2) rh[i_] = *(const u32x4 GAS*)(HIN + ((size_t)(d_ * NCH + cs_) * 8 + h_) * 8192 + pp * 128 + n8); \
            else if (cs_ == 0) rh[i_] = (u32x4){0u, 0u, 0u, 0u}; \
            else rh[i_] = *(const u32x4 GAS*)(SST + ((size_t)(d_ * NCH) * 8 + h_) * 8192 + pp * 128 + n8); } \
        _Pragma("unroll") for (int i_ = 0; i_ < 4; ++i_) { const int idx = tid + NTHR * i_, j = idx >> 4, n8 = (idx & 15) * 8; const bf16 GAS* src = p.CV + (size_t)(r0_ + j) * 1024 + g_ * 128 + n8; \
            rb[i_] = *(const u32x4 GAS*)(src + 512); rc[i_] = *(const u32x4 GAS*)(src + 768); } \
        _Pragma("unroll") for (int i_ = 0; i_ < 2; ++i_) { const int idx = tid + NTHR * i_, j = idx >> 3, p8 = (idx & 7) * 8; rx[i_] = *(const u32x4 GAS*)(p.CV + (size_t)(r0_ + j) * 1024 + h_ * 64 + p8); } }
    if (u_begin + first < u_end) SO_LOAD(u_begin + first)
    for (int u = u_begin + first; u < u_end; u += stride) {
        const int cn = u >> 3, h = u & 7, g = h >> 2, r0 = 128 * cn;
        __syncthreads();
        if (wave < 2) { const int d = wave; const float a = -expf(p.a_log[l * 16 + d * 8 + h]); float total;
            ssd_acum(p.DT, r0, d, d * 8 + h, a, lane, sm + d * 128, sm + 256 + d * 128, total); }
#pragma unroll
        for (int i = 0; i < 4; ++i) { const int idx = tid + NTHR * i, j = idx >> 4, n8 = (idx & 15) * 8; *(LAS u32x4*)(Bm + j * LDP + n8 * 2) = rb[i]; *(LAS u32x4*)(Cm + j * LDP + n8 * 2) = rc[i]; }
#pragma unroll
        for (int i = 0; i < 2; ++i) { const int idx = tid + NTHR * i, j = idx >> 3, p8 = (idx & 7) * 8; *(LAS u32x4*)(XT + j * SB64 + p8 * 2) = rx[i]; }
        __syncthreads();
        f32x4 G[8];
#pragma unroll
        for (int jt = 0; jt < 8; ++jt) G[jt] = (f32x4){0.f, 0.f, 0.f, 0.f};
#pragma unroll
        for (int ks = 0; ks < 4; ++ks) { const bf16x8 cfr = ld_frag(Cm, 16 * wave + l15, ks * 32 + 8 * quad, LDP);
#pragma unroll
            for (int jt = 0; jt < 8; ++jt) G[jt] = MFMA16(ld_frag(Bm, 16 * jt + l15, ks * 32 + 8 * quad, LDP), cfr, G[jt]); }
        __syncthreads();
#pragma unroll
        for (int i = 0; i < 4; ++i) { const int idx = tid + NTHR * i, d = idx >> 10, pp = (idx >> 4) & 63, n8 = (idx & 15) * 8;
            *(LAS u32x4*)(Bm + (d * 64 + pp) * LDP + n8 * 2) = rh[i]; }
        __syncthreads();
        if (u + stride < u_end) SO_LOAD(u + stride)
        f32x4 Y[4];
#pragma unroll
        for (int pt = 0; pt < 4; ++pt) Y[pt] = (f32x4){0.f, 0.f, 0.f, 0.f};
#pragma unroll 1
        for (int d = 0; d < 2; ++d) {
            const LAS float* ac = sm + d * 128; const LAS float* dv = sm + 256 + d * 128;
            float ai[4];
#pragma unroll
            for (int r = 0; r < 4; ++r) ai[r] = ac[16 * wave + 4 * quad + r];
            const int il = 16 * wave + l15; const float ail = ac[il];
            const int dm = -d; int u0 = (il - 4 * quad) ^ dm; asm volatile("" : "+v"(u0));
            f32x4 Y2[4];
#pragma unroll
            for (int pt = 0; pt < 4; ++pt) Y2[pt] = (f32x4){0.f, 0.f, 0.f, 0.f};
#pragma unroll
            for (int ks = 0; ks < 4; ++ks) {
                float wv[8];
#pragma unroll
                for (int hf = 0; hf < 2; ++hf) { const int jt = 2 * ks + hf, j0 = 16 * jt + 4 * quad;
                    const f32x4 aj = *(const LAS f32x4*)(ac + j0), dj = *(const LAS f32x4*)(dv + j0);
#pragma unroll
                    for (int r = 0; r < 4; ++r) { const bool valid = ((16 * jt + r) ^ dm) <= u0;
                        wv[4 * hf + r] = valid ? G[jt][r] * __expf(ail - aj[r]) * dj[r] : 0.f; } }
                u32x4 wp; wp.x = pk2(wv[0], wv[1]); wp.y = pk2(wv[2], wv[3]); wp.z = pk2(wv[4], wv[5]); wp.w = pk2(wv[6], wv[7]);
                const bf16x8 wf = __builtin_bit_cast(bf16x8, wp), cf = ld_frag(Cm, 16 * wave + l15, ks * 32 + 8 * quad, LDP);
#pragma unroll
                for (int pt = 0; pt < 4; ++pt) { Y[pt] = MFMA16(wf, tr_frag_perm(XT, 32 * ks, 16 * pt, SB64, lane), Y[pt]);
                    Y2[pt] = MFMA16(cf, ld_frag(Bm + d * 64 * LDP, 16 * pt + l15, ks * 32 + 8 * quad, LDP), Y2[pt]); } }
#pragma unroll
            for (int r = 0; r < 4; ++r) { const float ea = __expf(ai[r]);
#pragma unroll
                for (int pt = 0; pt < 4; ++pt) Y[pt][r] += ea * Y2[pt][r]; }
        }
#pragma unroll
        for (int pt = 0; pt < 4; ++pt)
#pragma unroll
            for (int r = 0; r < 4; ++r) YS[(size_t)(r0 + 16 * wave + 4 * quad + r) * 512 + h * 64 + 16 * pt + l15] = (bf16)f2bf(Y[pt][r]);
    }
}

#undef SO_LOAD
__device__ __forceinline__ void ssd_gated_norm(const P& p, int l, const bf16 GAS* YS, int ntile) {
    const int lane = p.lane;
    const int nfree = p.G - ntile, NV = (4 * nfree + ntile) * NWAVES;
    const int reps = (p.bid < ntile) ? 1 : 4;
    const int vbase = (p.bid < ntile) ? (4 * nfree + p.bid) * NWAVES + p.wave : (p.bid - ntile) * 4 * NWAVES + p.wave;
    for (int rp = 0; rp < reps; ++rp) {
    const int gw = vbase + rp * NWAVES, NGW = NV;
    const int ch = lane * 8;
    const float dsk = p.ssd_d[l * 8 + (ch >> 6)];
    u32x4 yn = (u32x4){0u, 0u, 0u, 0u}, xn = yn, zn = yn;
    if (gw < T) { yn = *(const u32x4 GAS*)(YS + (size_t)gw * 512 + ch); xn = *(const u32x4 GAS*)(p.CV + (size_t)gw * 1024 + ch); zn = *(const u32x4 GAS*)(p.PROJ + (size_t)gw * PJ + Z0 + ch); }
    for (int row = gw; row < T; row += NGW) {
        const u32x4 yv = yn, xs = xn, zz = zn;
        if (row + NGW < T) { const size_t rn = (size_t)row + NGW;
            yn = *(const u32x4 GAS*)(YS + rn * 512 + ch); xn = *(const u32x4 GAS*)(p.CV + rn * 1024 + ch); zn = *(const u32x4 GAS*)(p.PROJ + rn * PJ + Z0 + ch); }
        float v[8];
        v[0] = (bflo(yv.x) + dsk * bflo(xs.x)) * silu_f(bflo(zz.x)); v[1] = (bfhi(yv.x) + dsk * bfhi(xs.x)) * silu_f(bfhi(zz.x));
        v[2] = (bflo(yv.y) + dsk * bflo(xs.y)) * silu_f(bflo(zz.y)); v[3] = (bfhi(yv.y) + dsk * bfhi(xs.y)) * silu_f(bfhi(zz.y));
        v[4] = (bflo(yv.z) + dsk * bflo(xs.z)) * silu_f(bflo(zz.z)); v[5] = (bfhi(yv.z) + dsk * bfhi(xs.z)) * silu_f(bfhi(zz.z));
        v[6] = (bflo(yv.w) + dsk * bflo(xs.w)) * silu_f(bflo(zz.w)); v[7] = (bfhi(yv.w) + dsk * bfhi(xs.w)) * silu_f(bfhi(zz.w));
        float ss = 0.f;
#pragma unroll
        for (int i = 0; i < 8; ++i) ss += v[i] * v[i];
        const float rstd = rsqrtf(wsum(ss) * (1.f / 512.f) + EPS);
        const float GAS* ng = p.ssd_norm_g + (size_t)l * 512 + ch;
        const f32x4 g0 = *(const f32x4 GAS*)ng, g1 = *(const f32x4 GAS*)(ng + 4);
        u32x4 o; o.x = pk2(v[0] * rstd * g0[0], v[1] * rstd * g0[1]); o.y = pk2(v[2] * rstd * g0[2], v[3] * rstd * g0[3]);
        o.z = pk2(v[4] * rstd * g1[0], v[5] * rstd * g1[1]); o.w = pk2(v[6] * rstd * g1[2], v[7] * rstd * g1[3]);
        *(u32x4 GAS*)(p.Y3 + (size_t)row * 1536 + 512 + ch) = o;
    }
    }
}

__device__ __forceinline__ void attention_mfma(const P& p, int l, LAS unsigned char* lds, int u_begin, int u_end, int u_first, int u_stride) {
    const int tid = p.tid, lane = p.lane, wave = p.wave, quad = lane >> 4, l15 = lane & 15;
    const float C2 = 0.125f * 1.4426950408889634f;
    for (int u = u_begin + u_first; u < u_end; u += u_stride) {
        const int qb = u >> 1, kvh = u & 1, hq = kvh * 4 + (wave >> 1);
        const bool isc = qb < 2; const int nb = qb - 2;
        const int qrow0 = 128 * qb + 64 * (wave & 1);
        LAS unsigned char* Qs = lds + 4 * 64 * LDQ + wave * 64 * LDQ;
        { u32x4 qv[8];
#pragma unroll
          for (int i = 0; i < 8; ++i) { const int rr = 8 * i + (lane >> 3), pc = lane & 7; qv[i] = *(const u32x4 GAS*)(p.PROJ + (size_t)(qrow0 + rr) * PJ + Q0 + hq * 64 + pc * 8); }
          __builtin_amdgcn_sched_barrier(0);
#pragma unroll
          for (int i = 0; i < 8; ++i) { const int rr = 8 * i + (lane >> 3), pc = lane & 7; *(LAS u32x4*)(Qs + rr * LDQ + pc * 16) = qv[i]; } }
        LDS_FENCE();
        f32x4 O[4][4];
#pragma unroll
        for (int a = 0; a < 4; ++a)
#pragma unroll
            for (int b = 0; b < 4; ++b) O[a][b] = (f32x4){0.f, 0.f, 0.f, 0.f};
        float mrow[4], lrow[4];
        const float sk = p.sink[l * 8 + hq] * 1.4426950408889634f;
#pragma unroll
        for (int qt = 0; qt < 4; ++qt) { mrow[qt] = sk; lrow[qt] = 1.f; }
        const int ntile = isc ? 4 : 10;
#define ATT_VALID(ti_) (isc || (ti_) >= 6 || ((NCTX + 128 * (nb - 1) + 64 * (ti_)) >= NCTX && (NCTX + 128 * (nb - 1) + 64 * (ti_)) < T))
#define ATT_KROW0(ti_) ((isc || (ti_) >= 6) ? 64 * (isc ? (ti_) : (ti_) - 6) : NCTX + 128 * (nb - 1) + 64 * (ti_))
#define ATT_LOAD(ti_) { const bf16 GAS* src = p.PROJ + (size_t)(ATT_KROW0(ti_) + (tid >> 3)) * PJ + kvh * 64 + (tid & 7) * 8; kreg = *(const u32x4 GAS*)(src + K0); vreg = *(const u32x4 GAS*)(src + V0); }
#define ATT_STORE(b_) { *(LAS u32x4*)(lds + (b_) * 2 * 64 * LDQ + (tid >> 3) * LDQ + (tid & 7) * 16) = kreg; *(LAS u32x4*)(lds + (b_) * 2 * 64 * LDQ + 64 * LDQ + (tid >> 3) * SB64 + (tid & 7) * 16) = vreg; }
        int ti = 0; while (!ATT_VALID(ti)) ++ti;
        u32x4 kreg, vreg;
        ATT_LOAD(ti);
        __syncthreads();
        ATT_STORE(0);
        { int t1 = ti + 1; while (t1 < ntile && !ATT_VALID(t1)) ++t1; if (t1 < ntile) ATT_LOAD(t1); }
        __syncthreads();
        int buf = 0;
        while (ti < ntile) {
            const int krow0 = ATT_KROW0(ti); const bool local = !(isc || ti >= 6);
            int tn = ti + 1; while (tn < ntile && !ATT_VALID(tn)) ++tn;
            const LAS unsigned char* Kt = lds + buf * 2 * 64 * LDQ; const LAS unsigned char* VT = Kt + 64 * LDQ;
            const bool need_mask = local && (ti < 2 || ti > 3);
            int kr0 = krow0; asm volatile("" : "+s"(kr0));
#pragma unroll
            for (int qt = 0; qt < 4; ++qt) {
                bf16x8 pf[2];
                f32x4 S[4];
#pragma unroll
                for (int kt = 0; kt < 4; ++kt) S[kt] = (f32x4){0.f, 0.f, 0.f, 0.f};
#pragma unroll
                for (int ks = 0; ks < 2; ++ks)
                    { const bf16x8 qf = ld_frag(Qs, 16 * qt + l15, ks * 32 + 8 * quad, LDQ);
#pragma unroll
                    for (int kt = 0; kt < 4; ++kt) S[kt] = MFMA16(ld_frag(Kt, 16 * kt + l15, ks * 32 + 8 * quad, LDQ), qf, S[kt]); }
                const int tq = qrow0 + 16 * qt + l15;
                float mx = -1e30f;
                if (need_mask) {
                    const int e0 = tq - kr0 - 4 * quad + 128;
#pragma unroll
                    for (int kt = 0; kt < 4; ++kt)
#pragma unroll
                        for (int r = 0; r < 4; ++r) { const float s = ((unsigned)(e0 - (16 * kt + r)) <= 256u) ? S[kt][r] : -1e30f; S[kt][r] = s; mx = fmaxf(mx, s); }
                } else {
#pragma unroll
                    for (int kt = 0; kt < 4; ++kt) mx = fmaxf(fmaxf(mx, fmaxf(S[kt][0], S[kt][1])), fmaxf(S[kt][2], S[kt][3]));
                }
                mx = fmaxf(mx, __shfl_xor(mx, 16)); mx = fmaxf(mx, __shfl_xor(mx, 32));
                const float mn = fmaxf(mrow[qt], mx * C2), alpha = __builtin_amdgcn_exp2f(mrow[qt] - mn);
                float ls = 0.f; u32x4 pw[2];
#pragma unroll
                for (int kt = 0; kt < 4; ++kt) { const float e0 = __builtin_amdgcn_exp2f(S[kt][0] * C2 - mn), e1 = __builtin_amdgcn_exp2f(S[kt][1] * C2 - mn),
                                                              e2 = __builtin_amdgcn_exp2f(S[kt][2] * C2 - mn), e3 = __builtin_amdgcn_exp2f(S[kt][3] * C2 - mn);
                    ls += (e0 + e1) + (e2 + e3);
                    if (kt & 1) { pw[kt >> 1].z = pk2(e0, e1); pw[kt >> 1].w = pk2(e2, e3); } else { pw[kt >> 1].x = pk2(e0, e1); pw[kt >> 1].y = pk2(e2, e3); } }
                pf[0] = __builtin_bit_cast(bf16x8, pw[0]); pf[1] = __builtin_bit_cast(bf16x8, pw[1]);
                ls += __shfl_xor(ls, 16); ls += __shfl_xor(ls, 32);
                lrow[qt] = lrow[qt] * alpha + ls; mrow[qt] = mn;
#pragma unroll
                for (int dt = 0; dt < 4; ++dt) O[dt][qt] *= alpha;
#pragma unroll
                for (int ks = 0; ks < 2; ++ks)
#pragma unroll
                    for (int dt = 0; dt < 4; ++dt) O[dt][qt] = MFMA16(tr_frag_perm(VT, 32 * ks, 16 * dt, SB64, lane), pf[ks], O[dt][qt]);
                asm volatile("" ::: "memory");
            }
            if (tn < ntile) { ATT_STORE(buf ^ 1); int t2 = tn + 1; while (t2 < ntile && !ATT_VALID(t2)) ++t2; if (t2 < ntile) ATT_LOAD(t2); }
            __syncthreads();
            buf ^= 1; ti = tn;
        }
#undef ATT_LOAD
#undef ATT_STORE
#undef ATT_VALID
#undef ATT_KROW0
#pragma unroll
        for (int qt = 0; qt < 4; ++qt) { const float inv = 1.f / lrow[qt];
            bf16 GAS* orow = p.Y3 + (size_t)(qrow0 + 16 * qt + l15) * 1536 + 1024 + hq * 64;
#pragma unroll
            for (int dt = 0; dt < 4; ++dt) { u32x2 w; w.x = pk2(O[dt][qt][0] * inv, O[dt][qt][1] * inv); w.y = pk2(O[dt][qt][2] * inv, O[dt][qt][3] * inv);
                *(u32x2 GAS*)(orow + 16 * dt + 4 * quad) = w; } }
    }
}

#ifndef S5_INTERLEAVE
#define S5_INTERLEAVE 2
#endif
constexpr size_t S5BB_ELEMS = (size_t)2 * 32 * 128 * 32, S5CC_ELEMS = (size_t)2 * 32 * 16 * 128;
__device__ __forceinline__ void s5_tables(const P& p, int l, bf16 GAS* BB, bf16 GAS* CC, float GAS* AB) {
    for (int e = p.bid * NTHR + p.tid; e < 2 * 32 * 64; e += p.G * NTHR) {
        const int d = e >> 11, g = (e >> 6) & 31, pq = e & 63, dg = d * 32 + g;
        S5Lane s; s5_lane_params(p, l, d, g, pq, s, true);
        AB[(size_t)e * 2] = s.abr; AB[(size_t)e * 2 + 1] = s.abi;
                u32x4 GAS* br = (u32x4 GAS*)(BB + ((size_t)dg * 128 + 2 * pq) * 32); u32x4 GAS* bi = (u32x4 GAS*)(BB + ((size_t)dg * 128 + 2 * pq + 1) * 32);
        u32x4 w;
        w.x = pk2(s.bbr[0], s.bbr[1]); w.y = pk2(s.bbr[2], s.bbr[3]); w.z = pk2(s.bbr[4], s.bbr[5]); w.w = pk2(s.bbr[6], s.bbr[7]); br[0] = w;
        w.x = pk2(s.bbr[8], s.bbr[9]); w.y = pk2(s.bbr[10], s.bbr[11]); w.z = pk2(s.bbr[12], s.bbr[13]); w.w = pk2(s.bbr[14], s.bbr[15]); br[1] = w;
        w.x = pk2(s.bbi[0], s.bbi[1]); w.y = pk2(s.bbi[2], s.bbi[3]); w.z = pk2(s.bbi[4], s.bbi[5]); w.w = pk2(s.bbi[6], s.bbi[7]); bi[0] = w;
        w.x = pk2(s.bbi[8], s.bbi[9]); w.y = pk2(s.bbi[10], s.bbi[11]); w.z = pk2(s.bbi[12], s.bbi[13]); w.w = pk2(s.bbi[14], s.bbi[15]); bi[1] = w;
        const u32x4 z = (u32x4){0u, 0u, 0u, 0u}; br[2] = z; br[3] = z; bi[2] = z; bi[3] = z;
        const size_t ci = ((size_t)(l * 2 + d) * 32 + g) * 16;
#pragma unroll
        for (int k = 0; k < 16; ++k) {
#if S5_INTERLEAVE
            *(unsigned GAS*)(CC + ((size_t)dg * 16 + k) * 128 + 2 * pq) = pk2(p.c_re[(ci + k) * 64 + pq], -p.c_im[(ci + k) * 64 + pq]);
#else
            CC[((size_t)dg * 16 + k) * 128 + pq] = (bf16)f2bf(p.c_re[(ci + k) * 64 + pq]); CC[((size_t)dg * 16 + k) * 128 + 64 + pq] = (bf16)f2bf(-p.c_im[(ci + k) * 64 + pq]);
#endif
        }
    }
}
constexpr int S5_WREG = 4096 + 16 * 132 * 4 + 16 * LDP;
template <bool READOUT> __device__ __forceinline__ void s5_chunk_dir(int d, const bf16 GAS* BBdg, const bf16 GAS* CCdg, float abr, float abi, LAS unsigned char* wreg, int lane, float& hr, float& hi, f32x4 (&yacc)[8]) {
    const int quad = lane >> 4, l15 = lane & 15;
    LAS unsigned char* ub = wreg; LAS float* BuW = (LAS float*)(wreg + 4096); LAS unsigned char* Hw = wreg + 4096 + 16 * 132 * 4;
    bf16x8 BBf[8], CCf[4];
#pragma unroll
    for (int pt = 0; pt < 8; ++pt) BBf[pt] = *(const bf16x8 GAS*)(BBdg + (size_t)(16 * pt + l15) * 32 + 8 * quad);
    if (READOUT) {
#pragma unroll
        for (int ks = 0; ks < 4; ++ks) CCf[ks] = *(const bf16x8 GAS*)(CCdg + (size_t)l15 * 128 + ks * 32 + 8 * quad);
    }
#pragma unroll (READOUT ? 8 : 1)
    for (int ss = 0; ss < 8; ++ss) {
        const int sc = d ? 7 - ss : ss;
        bf16x8 uf = (bf16x8){0, 0, 0, 0, 0, 0, 0, 0};
        if (quad < 2) uf = *(const LAS bf16x8*)(ub + (16 * sc + l15) * 32 + quad * 16);
#pragma unroll
        for (int pt = 0; pt < 8; ++pt) { const f32x4 Dp = MFMA16(uf, BBf[pt], ((f32x4){0.f, 0.f, 0.f, 0.f}));
#pragma unroll
            for (int r = 0; r < 4; ++r) BuW[(4 * quad + r) * 132 + 16 * pt + l15] = Dp[r]; }
        LDS_FENCE();
#pragma unroll
        for (int st = 0; st < 16; ++st) { const int tl = d ? 15 - st : st;
#if S5_INTERLEAVE == 1
            typedef float f32x2_t __attribute__((ext_vector_type(2)));
            const f32x2_t bu = *(const LAS f32x2_t*)(BuW + tl * 132 + 2 * lane);
            const float nr = abr * hr - abi * hi + bu[0], ni = abr * hi + abi * hr + bu[1]; hr = nr; hi = ni;
            if (READOUT) *(LAS unsigned*)(Hw + tl * LDP + 4 * lane) = pk2(hr, hi); }
#elif S5_INTERLEAVE == 2
            const float br = BuW[tl * 132 + 2 * lane], bi = BuW[tl * 132 + 2 * lane + 1];
            const float nr = abr * hr - abi * hi + br, ni = abr * hi + abi * hr + bi; hr = nr; hi = ni;
            if (READOUT) *(LAS unsigned*)(Hw + tl * LDP + 4 * lane) = pk2(hr, hi); }
#else
            const float br = BuW[tl * 132 + lane], bi = BuW[tl * 132 + 64 + lane];
            const float nr = abr * hr - abi * hi + br, ni = abr * hi + abi * hr + bi; hr = nr; hi = ni;
            if (READOUT) { st_b16(Hw + tl * LDP + 2 * lane, f2bf(hr)); st_b16(Hw + tl * LDP + 128 + 2 * lane, f2bf(hi)); } }
#endif
        if (READOUT) {
            LDS_FENCE();
#pragma unroll
            for (int ks = 0; ks < 4; ++ks) yacc[sc] = MFMA16(ld_frag(Hw, l15, ks * 32 + 8 * quad, LDP), CCf[ks], yacc[sc]);
        }
        LDS_FENCE();
    }
}
__device__ __forceinline__ void s5_local_states(const P& p, LAS unsigned char* lds, const bf16 GAS* BB, const float GAS* AB, bool ctx_part, int gw, int NGW) {
    LAS unsigned char* wreg = lds + p.wave * S5_WREG;
    const int lane = p.lane;
    const int nit = ctx_part ? 2 * 2 * 32 : 2 * (NCH - 2) * 32;
    for (int it = gw; it < nit; it += NGW) {
        const int d = ctx_part ? (it >> 6) : it / (32 * (NCH - 2)), c = ctx_part ? ((it >> 5) & 1) : 2 + ((it % (32 * (NCH - 2))) >> 5), g = it & 31, dg = d * 32 + g;
        s5_stage_u(p, chunk_r0(d, c), g, wreg, lane);
        float hr = 0.f, hi = 0.f; f32x4 dummy[8];
        const float abr = AB[((size_t)dg * 64 + lane) * 2], abi = AB[((size_t)dg * 64 + lane) * 2 + 1];
        if (d == 0) s5_chunk_dir<false>(0, BB + (size_t)dg * 128 * 32, nullptr, abr, abi, wreg, lane, hr, hi, dummy);
        else s5_chunk_dir<false>(1, BB + (size_t)dg * 128 * 32, nullptr, abr, abi, wreg, lane, hr, hi, dummy);
        float GAS* E = p.S5E + ((size_t)dg * NCH + c) * 128;
        E[lane] = hr; E[64 + lane] = hi;
    }
}
__device__ __forceinline__ void s5_outputs(const P& p, int l, LAS unsigned char* lds, const bf16 GAS* BB, const bf16 GAS* CC, const float GAS* AB, int it_begin, int it_end, int first, int stride) {
    LAS unsigned char* wreg = lds + p.wave * S5_WREG;
    const int lane = p.lane, quad = lane >> 4, l15 = lane & 15;
    for (int it = it_begin + first; it < it_end; it += stride) {
        const int cn = it >> 5, g = it & 31, r0 = 128 * cn;
        s5_stage_u(p, r0, g, wreg, lane);
        f32x4 yacc[8];
#pragma unroll
        for (int i = 0; i < 8; ++i) yacc[i] = (f32x4){0.f, 0.f, 0.f, 0.f};
#pragma unroll
        for (int d = 0; d < 2; ++d) { const int dg = d * 32 + g, cs = scan_chunk_of(d, cn);
            const float GAS* Hn = (cn < 2) ? (p.S5E + (size_t)dg * NCH * 128) : (p.S5H + ((size_t)dg * NCH + cs) * 128);
            float hr = Hn[lane], hi = Hn[64 + lane];
            if (cs == 0) { hr = 0.f; hi = 0.f; }
            s5_chunk_dir<true>(d, BB + (size_t)dg * 128 * 32, CC + (size_t)dg * 16 * 128, AB[((size_t)dg * 64 + lane) * 2], AB[((size_t)dg * 64 + lane) * 2 + 1], wreg, lane, hr, hi, yacc); }
        const float dsk = p.s5_d[(size_t)l * 512 + g * 16 + l15];
#pragma unroll
        for (int sc = 0; sc < 8; ++sc)
#pragma unroll
            for (int r = 0; r < 4; ++r) { const int t = 16 * sc + 4 * quad + r;
                const float u = bf2f(*(const LAS unsigned short*)(wreg + t * 32 + 2 * l15));
                p.SA[(size_t)(r0 + t) * 512 + g * 16 + l15] = (bf16)f2bf(gelu_tanh_f(yacc[sc][r] + dsk * u)); }
        LDS_FENCE();
    }
}

template <int NT, class Epi>
__device__ __forceinline__ void small_gemm(const P& p, LAS unsigned char* lds, const bf16 GAS* A, int lda, const bf16 GAS* Bt, int ldb, int K, int kc_per_seg, const Epi& E, const int GAS* aidx = nullptr) {
    LAS unsigned char* As = lds;
    LAS unsigned char* Bs = lds + 64 * LDP;
    const int tid = p.tid, lane = p.lane, wave = p.wave, quad = lane >> 4, l15 = lane & 15;
    f32x4 acc[NT][4], sum[NT][4];
#pragma unroll
    for (int a = 0; a < NT; ++a)
#pragma unroll
        for (int b = 0; b < 4; ++b) { acc[a][b] = (f32x4){0.f, 0.f, 0.f, 0.f}; sum[a][b] = (f32x4){0.f, 0.f, 0.f, 0.f}; }
    const int nch = K >> 7, prow = tid >> 4, pc = (tid & 15) * 8;
    constexpr int PD = (NT == 1) ? 3 : 2;
    u32x4 ra[PD][2], rb[PD][4 * NT]; int arow[2];
#pragma unroll
    for (int i = 0; i < 2; ++i) arow[i] = aidx ? aidx[prow + 32 * i] : prow + 32 * i;
#define SG_LOAD(s_, kc_) { _Pragma("unroll") for (int i = 0; i < 2; ++i) ra[s_][i] = *(const u32x4 GAS*)(A + (size_t)arow[i] * lda + (kc_) * 128 + pc); \
        _Pragma("unroll") for (int i = 0; i < 4 * NT; ++i) rb[s_][i] = *(const u32x4 GAS*)(Bt + (size_t)(prow + 32 * i) * ldb + (kc_) * 128 + pc); }
#pragma unroll
    for (int s0 = 0; s0 < PD - 1; ++s0) SG_LOAD(s0, s0)
    for (int kc0 = 0; kc0 < nch; kc0 += PD) {
#pragma unroll
        for (int s0 = 0; s0 < PD; ++s0) { const int kc = kc0 + s0; if (kc >= nch) break;
            __syncthreads();
#pragma unroll
            for (int i = 0; i < 2; ++i) *(LAS u32x4*)(As + (prow + 32 * i) * LDP + pc * 2) = ra[s0][i];
#pragma unroll
            for (int i = 0; i < 4 * NT; ++i) *(LAS u32x4*)(Bs + (prow + 32 * i) * LDP + pc * 2) = rb[s0][i];
            __syncthreads();
            if (kc + PD - 1 < nch) SG_LOAD((s0 + PD - 1) % PD, kc + PD - 1)
#pragma unroll
            for (int ks = 0; ks < 4; ++ks) {
                bf16x8 af[4];
#pragma unroll
                for (int mt = 0; mt < 4; ++mt) af[mt] = ld_frag(As, 16 * mt + l15, ks * 32 + 8 * quad, LDP);
#pragma unroll
                for (int nt = 0; nt < NT; ++nt) { const bf16x8 bfr = ld_frag(Bs, 128 * nt + 16 * wave + l15, ks * 32 + 8 * quad, LDP);
#pragma unroll
                    for (int mt = 0; mt < 4; ++mt) acc[nt][mt] = MFMA16(af[mt], bfr, acc[nt][mt]); }
            }
            if ((kc + 1) % kc_per_seg == 0) E.seg(acc, sum, kc / kc_per_seg, wave, quad, l15);
        }
    }
#undef SG_LOAD
    E.fin(acc, sum, wave, quad, l15);
    __syncthreads();
}
struct SgMerge {
    const bf16 GAS* proj; bf16 GAS* MB; int rb, cc;
    __device__ __forceinline__ void seg(f32x4 (&acc)[1][4], f32x4 (&sum)[1][4], int s, int wave, int quad, int l15) const {
        unsigned gr[4][4];
#pragma unroll
        for (int mt = 0; mt < 4; ++mt)
#pragma unroll
            for (int r = 0; r < 4; ++r) { const int row = rb * 64 + 16 * mt + 4 * quad + r, col = cc * 128 + 16 * wave + l15; gr[mt][r] = proj[(size_t)row * PJ + GT0 + s * 1024 + col]; }
        __builtin_amdgcn_sched_barrier(0);
#pragma unroll
        for (int mt = 0; mt < 4; ++mt)
#pragma unroll
            for (int r = 0; r < 4; ++r) { sum[0][mt][r] += bf2f(gr[mt][r]) * acc[0][mt][r]; acc[0][mt][r] = 0.f; }
    }
    __device__ __forceinline__ void fin(f32x4 (&acc)[1][4], f32x4 (&sum)[1][4], int wave, int quad, int l15) const {
#pragma unroll
        for (int mt = 0; mt < 4; ++mt)
#pragma unroll
            for (int r = 0; r < 4; ++r) MB[(size_t)(rb * 64 + 16 * mt + 4 * quad + r) * 1024 + cc * 128 + 16 * wave + l15] = (bf16)f2bf(sum[0][mt][r]);
    }
};
struct SgResid {
    float GAS* XC; const float GAS* g; int rb, cc;
    __device__ __forceinline__ void seg(f32x4 (&)[1][4], f32x4 (&)[1][4], int, int, int, int) const {}
    __device__ __forceinline__ void fin(f32x4 (&acc)[1][4], f32x4 (&)[1][4], int wave, int quad, int l15) const {
        const int col = cc * 128 + 16 * wave + l15; const float gv = g[col];
        float xv[4][4];
#pragma unroll
        for (int mt = 0; mt < 4; ++mt)
#pragma unroll
            for (int r = 0; r < 4; ++r) xv[mt][r] = XC[(size_t)(rb * 64 + 16 * mt + 4 * quad + r) * 1024 + col];
#pragma unroll
        for (int mt = 0; mt < 4; ++mt)
#pragma unroll
            for (int r = 0; r < 4; ++r) XC[(size_t)(rb * 64 + 16 * mt + 4 * quad + r) * 1024 + col] = xv[mt][r] + gv * acc[0][mt][r];
    }
};
struct SgSwiGlu {
    bf16 GAS* HID; int row0, t;
    __device__ __forceinline__ void seg(f32x4 (&)[2][4], f32x4 (&)[2][4], int, int, int, int) const {}
    __device__ __forceinline__ void fin(f32x4 (&acc)[2][4], f32x4 (&)[2][4], int wave, int quad, int l15) const {
#pragma unroll
        for (int mt = 0; mt < 4; ++mt)
#pragma unroll
            for (int r = 0; r < 4; ++r) HID[(size_t)(row0 + 16 * mt + 4 * quad + r) * 1024 + 128 * t + 16 * wave + l15] = (bf16)f2bf(silu_f(acc[0][mt][r]) * acc[1][mt][r]);
    }
};
struct SgDown {
    bf16 GAS* YE; const float GAS* gsel; int row0, cc;
    __device__ __forceinline__ void seg(f32x4 (&)[1][4], f32x4 (&)[1][4], int, int, int, int) const {}
    __device__ __forceinline__ void fin(f32x4 (&acc)[1][4], f32x4 (&)[1][4], int wave, int quad, int l15) const {
        float gq[4][4];
#pragma unroll
        for (int mt = 0; mt < 4; ++mt)
#pragma unroll
            for (int r = 0; r < 4; ++r) gq[mt][r] = gsel[row0 + 16 * mt + 4 * quad + r];
#pragma unroll
        for (int mt = 0; mt < 4; ++mt)
#pragma unroll
            for (int r = 0; r < 4; ++r) { const int row = row0 + 16 * mt + 4 * quad + r; YE[(size_t)row * 1024 + cc * 128 + 16 * wave + l15] = (bf16)f2bf(acc[0][mt][r] * gq[mt][r]); }
    }
};

#ifndef SKIPMASK
#define SKIPMASK 0
#endif
struct Args { const float* in[33]; float* out; unsigned char* ws; int ph_lo, ph_hi; };
static_assert(sizeof(Args) == 35 * 8 + 8, "no padding");

__global__ void __launch_bounds__(NTHR, 2) fwd_kernel(Args args) {
    extern __shared__ __attribute__((aligned(16))) unsigned char lds_raw[];
    LAS unsigned char* lds = (LAS unsigned char*)lds_raw;
    const int tid_ = threadIdx.x;
    const int wave_s = __builtin_amdgcn_readfirstlane(tid_ >> 6);
    if (tid_ == 0) {
        LAS unsigned long long* tab = (LAS unsigned long long*)(lds + PTAB_OFF);
#pragma unroll
        for (int k = 0; k < 33; ++k) tab[k] = (unsigned long long)args.in[k];
        tab[33] = (unsigned long long)args.out; tab[34] = (unsigned long long)args.ws;
    }
    volatile LAS unsigned* MISC = (volatile LAS unsigned*)(lds + MISC_OFF);
    if (tid_ < 64) MISC[tid_] = 0u;
    __syncthreads();
    XcdBarrier bar; bar.bar = (unsigned GAS*)(args.ws + WS_CTL) + CW_BAR; bar.x = 0; bar.st = nullptr;
    if (!MK_PER_PHASE) bar = xcd_barrier_post((unsigned GAS*)(args.ws + WS_CTL) + CW_BAR, MISC + 8);

    const int lo = args.ph_lo, hi = args.ph_hi;
#define IN(k) (lo <= (k) && (k) < hi)
#define SEAM(k) do { if (!MK_PER_PHASE && (k) + 1 < hi) xcd_barrier(bar, wave_s); } while (0)

    if (IN(0)) { P p; build_P(p, lds, 0, wave_s); phase_mod(p, lds, (float GAS*)(args.ws + WS_ROPE)); __syncthreads(); convert_weights(p, 0, 0, lds, p.bid * NWAVES + p.wave, p.G * NWAVES, 0, CVT_NE); SEAM(0); }

#ifndef REPSUB
#define REPSUB 0
#endif
#define RSUB(b, ...) for (int r2_ = 0; r2_ <= ((REPSUB >> (b)) & 1); ++r2_) { __VA_ARGS__; __syncthreads(); }
#ifndef REPMASK
#define REPMASK 0
#endif
#define PHASE(k, ...) if (!((SKIPMASK >> (k)) & 1) && IN(pb + (k))) { for (int rep_ = 0; rep_ <= ((REPMASK >> (k)) & 1); ++rep_) { P p; build_P(p, lds, l & 1, wave_s); __VA_ARGS__; \
        if (rep_ < ((REPMASK >> (k)) & 1)) xcd_barrier(bar, wave_s); } SEAM(pb + (k)); }
    for (int l = 0; l < DEPTH; ++l) {
        const int pb = 1 + NPH_LAYER * l;
        const bool cx = l < DEPTH - 1;
        unsigned char GAS* wsb; { unsigned tb_ = (unsigned)(size_t)(lds + PTAB_OFF); asm volatile("" : "+s"(tb_)); wsb = (unsigned char GAS*)ld_tab((volatile LAS unsigned*)(size_t)tb_, 34); }
        PHASE(0, s5_tables(p, l, (bf16 GAS*)(wsb + WS_S5BB), (bf16 GAS*)(wsb + WS_S5CC), (float GAS*)(wsb + WS_S5AB)); __syncthreads(); row_pass<0>(p, l, lds, true, rep_ < ((REPMASK >> 0) & 1)))
        PHASE(1, pg8::Gemm g{p.H, p.WIN, T, PJ, D}; pg8::StaticOrder S; S.init(T, PJ, p.G, p.bid); pg8::EpiStoreBf16 E{p.PROJ, PJ, GT0 / 256, (const float GAS*)(wsb + WS_ROPE)};
            pg8::gemm_phase<pg8::EpiStoreBf16, pg8::StaticOrder, false>(lds, g, S, E, nullptr, p.wave))
        PHASE(2, RSUB(2, phase_premix(p, l, lds)) RSUB(3, s5_local_states(p, lds, (const bf16 GAS*)(wsb + WS_S5BB), (const float GAS*)(wsb + WS_S5AB), false, p.vcu * NWAVES + p.wave, p.G * NWAVES)))
        PHASE(3, { const int lo5 = (p.G >= 24) ? 8 : 0, nw5 = (p.G >= 24) ? 16 : p.G;
              if (p.vcu >= lo5 && p.vcu < lo5 + nw5) s5_local_states(p, lds, (const bf16 GAS*)(wsb + WS_S5BB), (const float GAS*)(wsb + WS_S5AB), true, (p.vcu - lo5) * NWAVES + p.wave, nw5 * NWAVES);
              __syncthreads(); }
            RSUB(0, ssd_states(p, l, lds, (bf16 GAS*)(wsb + WS_SST), (float GAS*)(wsb + WS_DEC))) RSUB(1, attention_mfma(p, l, lds, 4, 2 * NCH, p.vcu, p.G)))
        PHASE(4, if (cx) { if (p.bid >= p.G - 4) attention_mfma(p, l, lds, 0, 4, p.bid - (p.G - 4), 4);
                else if (p.bid >= p.G - 20) ssd_outputs(p, l, lds, (const bf16 GAS*)(wsb + WS_HIN), (const bf16 GAS*)(wsb + WS_SST), (bf16 GAS*)(wsb + WS_YS), 0, 16, p.bid - (p.G - 20), 16);
                else if (p.bid >= p.G - 28) s5_outputs(p, l, lds, (const bf16 GAS*)(wsb + WS_S5BB), (const bf16 GAS*)(wsb + WS_S5CC), (const float GAS*)(wsb + WS_S5AB), 0, 64, (p.bid - (p.G - 28)) * NWAVES + p.wave, 64); }
            scan_carries(p, l, lds, (const bf16 GAS*)(wsb + WS_SST), (const float GAS*)(wsb + WS_DEC), (bf16 GAS*)(wsb + WS_HIN)))
        PHASE(5, RSUB(4, ssd_outputs(p, l, lds, (const bf16 GAS*)(wsb + WS_HIN), (const bf16 GAS*)(wsb + WS_SST), (bf16 GAS*)(wsb + WS_YS), 16, NCH * 8, p.vcu, p.G))
            RSUB(5, s5_outputs(p, l, lds, (const bf16 GAS*)(wsb + WS_S5BB), (const bf16 GAS*)(wsb + WS_S5CC), (const float GAS*)(wsb + WS_S5AB), 64, 32 * NCH, p.vcu * NWAVES + p.wave, p.G * NWAVES)))
        PHASE(6, pg8::Gemm g{p.SA, p.WGLU, T, 512, 512}; pg8::RowOffOrder S; S.init(cx ? T : NLAT, 512, p.G, p.bid, cx ? 0 : 1); pg8::EpiGlu E{p.SA, p.b_glu + (size_t)l * 512, p.Y3};
            pg8::gemm_phase<pg8::EpiGlu, pg8::RowOffOrder, false>(lds, g, S, E, nullptr, p.wave); ssd_gated_norm(p, l, (const bf16 GAS*)(wsb + WS_YS), (cx ? T : NLAT) / 256 * 2 < p.G ? (cx ? T : NLAT) / 256 * 2 : p.G))
        PHASE(7, pg8::Gemm g{p.Y3, p.WBR, T, D, 1536}; pg8::RowOffOrder S; S.init(NLAT, D, p.G, p.bid, 1); pg8::EpiMerge E{p.PROJ, p.MB};
            pg8::gemm_phase<pg8::EpiMerge, pg8::RowOffOrder, false>(lds, g, S, E, nullptr, p.wave);
            if (cx) for (int it = p.bid; it < 32; it += p.G) { const SgMerge e{p.PROJ, p.MB, it >> 3, it & 7};
                small_gemm<1, SgMerge>(p, lds, p.Y3 + (size_t)(it >> 3) * 64 * 1536, 1536, p.WBR + (size_t)(it & 7) * 128 * 1536, 1536, 1536, 4, e); })
        PHASE(8, pg8::Gemm g{p.MB, p.WOUT, T, D, D}; pg8::RowOffOrder S; S.init(NLAT, D, p.G, p.bid, 1);
            const bool dry8 = rep_ < ((REPMASK >> 8) & 1);
            pg8::EpiResid E{dry8 ? p.PM + (size_t)NCTX * D : p.XL, dry8 ? p.PM : p.XC, p.MOD + (size_t)(l * 2 + 0) * 6144 + 2 * D, p.MOD + (size_t)(l * 2 + 1) * 6144 + 2 * D};
            pg8::gemm_phase<pg8::EpiResid, pg8::RowOffOrder, false>(lds, g, S, E, nullptr, p.wave);
            if (cx) for (int it = p.bid; it < 32; it += p.G) { const SgResid e{dry8 ? p.PM : p.XC, p.MOD + (size_t)(l * 2 + 1) * 6144 + 2 * D, it >> 3, it & 7};
                small_gemm<1, SgResid>(p, lds, p.MB + (size_t)(it >> 3) * 64 * 1024, 1024, p.WOUT + (size_t)(it & 7) * 128 * 1024, 1024, 1024, 8, e); })
        PHASE(9, row_pass<1>(p, l, lds, cx))
        PHASE(10, { const int nsel = cx ? 32 : 16; if (p.bid < nsel) phase_select(p, lds, cx);
            else { P q; build_P(q, lds, (l + 1) & 1, wave_s); q.WUP = p.WUP; q.WDN = p.WDN;
                convert_weights(q, l + 1, l, lds, (p.bid - nsel) * NWAVES + p.wave, (p.G - nsel) * NWAVES, (l + 1 < DEPTH) ? 0 : CVT_NE, CVT_ALL, true); } })
        PHASE(12, pg8::Gemm g{p.H, p.WUP, NE * ESLOTS, NE * 2048, D}; pg8::ExpertOrderT<true> S{p.G, p.bid, 8, 8, p.IDX}; pg8::EpiSwiGlu E{p.HID};
            pg8::gemm_phase<pg8::EpiSwiGlu, pg8::ExpertOrderT<true>, false>(lds, g, S, E, nullptr, p.wave);
            if (cx) for (int it = p.bid; it < NE * 8; it += p.G) { const int e = it >> 3, t = it & 7; const SgSwiGlu ep{p.HID, e * ESLOTS + CAP_L, t};
                small_gemm<2, SgSwiGlu>(p, lds, p.H, 1024, p.WUP + (size_t)(e * 2048 + 256 * t) * 1024, 1024, 1024, 8, ep, p.IDX + e * ESLOTS + CAP_L); })
        PHASE(13, pg8::Gemm g{p.HID, p.WDN, NE * ESLOTS, NE * 1024, D}; pg8::ExpertOrderT<false> S{p.G, p.bid, 4, 8, nullptr}; pg8::EpiDown E{p.YE, p.GSEL};
            pg8::gemm_phase<pg8::EpiDown, pg8::ExpertOrderT<false>, false>(lds, g, S, E, nullptr, p.wave);
            if (cx) for (int it = p.bid; it < NE * 8; it += p.G) { const int e = it >> 3, cc = it & 7; const SgDown ep{p.YE, p.GSEL, e * ESLOTS + CAP_L, cc};
                small_gemm<1, SgDown>(p, lds, p.HID + (size_t)(e * ESLOTS + CAP_L) * 1024, 1024, p.WDN + (size_t)(e * 1024 + 128 * cc) * 1024, 1024, 1024, 8, ep); })
    }
    if (IN(NPHASES - 1)) { P p; build_P(p, lds, 0, wave_s); row_pass<2>(p, 0, lds); }
#undef IN
#undef SEAM
}

extern "C" void kernel_launch(void* const* d_in, const int* in_sizes, int n_in, void* d_out, int out_size, void* d_ws, size_t ws_size, hipStream_t stream) {
    static int grid = 0;
    if (grid == 0) {
        if (n_in != 33 || out_size != NLAT * D || ws_size < WS_END) { fprintf(stderr, "kernel_launch: unexpected shapes: n_in %d out %d ws %zu (need %zu)\n", n_in, out_size, ws_size, (size_t)WS_END); grid = -1; return; }
        int dev = 0, cus = 0, per_cu = 0;
        if (hipGetDevice(&dev) != hipSuccess || hipDeviceGetAttribute(&cus, hipDeviceAttributeMultiprocessorCount, dev) != hipSuccess) { grid = -1; return; }
        if (hipFuncSetAttribute((const void*)fwd_kernel, hipFuncAttributeMaxDynamicSharedMemorySize, LDS_BYTES) != hipSuccess) { fprintf(stderr, "kernel_launch: hipFuncSetAttribute failed\n"); grid = -1; return; }
        if (hipOccupancyMaxActiveBlocksPerMultiprocessor(&per_cu, (const void*)fwd_kernel, NTHR, LDS_BYTES) != hipSuccess || per_cu < 1) { fprintf(stderr, "kernel_launch: occupancy query says %d\n", per_cu); (void)hipGetLastError(); }
        grid = cus;
    }
    if (grid < 0) return;
    (void)hipMemsetAsync((char*)d_ws + WS_CTL, 0, CTL_BYTES, stream);
    Args a{};
    for (int i = 0; i < 33; ++i) a.in[i] = (const float*)d_in[i];
    a.out = (float*)d_out; a.ws = (unsigned char*)d_ws;
#if MK_PER_PHASE
    for (int ph = 0; ph < NPHASES; ++ph) { a.ph_lo = ph; a.ph_hi = ph + 1; hipLaunchKernelGGL(fwd_kernel, dim3(grid), dim3(NTHR), LDS_BYTES, stream, a); }
#else
    a.ph_lo = 0; a.ph_hi = NPHASES;
    hipLaunchKernelGGL(fwd_kernel, dim3(grid), dim3(NTHR), LDS_BYTES, stream, a);
#endif
}
```
